# Optimizing an MI355X kernel written in HIP

```python
import math
import jax
import jax.numpy as jnp
from jax import lax
import numpy as np

D_MODEL = 1024
BATCH = 2
SEQ = 16384
DEPTH = 2

N_MIXERS = 2
N_S5 = (DEPTH + 1) // 2
N_NSA = DEPTH // 2
RMS_EPS = 1e-6
NEG = -1e30

S5_GROUP = 16
S5_GROUPS = D_MODEL // S5_GROUP
S5_STATE = 64
S5_CHUNK = 128
DT_MIN = 1e-3
DT_MAX = 1e-1

NSA_HEADS = 16
NSA_HEAD_DIM = 64
NSA_KV_GROUPS = 4
NSA_REP = NSA_HEADS // NSA_KV_GROUPS
NSA_Q_W = NSA_HEADS * NSA_HEAD_DIM
NSA_KV_W = NSA_KV_GROUPS * NSA_HEAD_DIM
NSA_N_GATES = 3
NSA_PROJ_SIZES = (NSA_Q_W, NSA_KV_W, NSA_KV_W, NSA_KV_W, NSA_KV_W, NSA_KV_W, NSA_KV_W, NSA_HEADS * NSA_N_GATES)
NSA_PROJ_W = sum(NSA_PROJ_SIZES)
CMP_BLOCK = 32
CMP_STRIDE = 16
CMP_RATIO = CMP_BLOCK // CMP_STRIDE
CMP_HIDDEN = 256
SEL_BLOCK = 64
SEL_RATIO = SEL_BLOCK // CMP_STRIDE
SEL_TOPN = 16
WINDOW = 512
Q_BLOCK = 128
ROPE_THETA = 10000.0

PEER_HEADS = 8
PEER_NKEYS = 128
PEER_EXPERTS = PEER_NKEYS * PEER_NKEYS
PEER_KEY_DIM = 256
PEER_HALF = PEER_KEY_DIM // 2
PEER_TOPK = 16
PEER_CHUNK = 128

kernel_name = 'hybrid_s5_nsa_peer_adaln'


def rmsnorm(x, g):
    xf = x.astype(jnp.float32)
    y = xf * lax.rsqrt(jnp.mean(xf * xf, axis=-1, keepdims=True) + RMS_EPS)
    return (y * g.astype(jnp.float32)).astype(x.dtype)


def modulate(h, shift, scale):
    return h * (1.0 + scale[:, None, :]) + shift[:, None, :]


def rope(x, pos):
    half = x.shape[-1] // 2
    freqs = ROPE_THETA ** (-jnp.arange(half, dtype=jnp.float32) / half)
    ang = pos[:, None] * freqs[None, :]
    cos = jnp.cos(ang)[:, None, :]
    sin = jnp.sin(ang)[:, None, :]
    xf = x.astype(jnp.float32)
    x1, x2 = xf[..., :half], xf[..., half:]
    return jnp.concatenate([x1 * cos - x2 * sin, x1 * sin + x2 * cos], axis=-1).astype(x.dtype)


def s5_mixer(h, w_in, a_re, a_im, log_dt, b_re, b_im, c_re, c_im, d_skip, w_glu):
    b, s, _ = h.shape
    G, P, L = S5_GROUPS, S5_STATE, S5_CHUNK
    u = (h @ w_in).astype(jnp.float32)
    a = lax.complex(a_re.astype(jnp.float32), a_im.astype(jnp.float32))
    dt = jnp.exp(log_dt.astype(jnp.float32))[:, None]
    a_dt = a * dt
    a_bar = jnp.exp(a_dt)
    bmat = lax.complex(b_re.astype(jnp.float32), b_im.astype(jnp.float32))
    b_bar = ((a_bar - 1.0) / a)[..., None] * bmat
    cmat = lax.complex(c_re.astype(jnp.float32), c_im.astype(jnp.float32))
    n_chunks = s // L
    u_chunks = u.reshape(b, n_chunks, L, G, S5_GROUP).transpose(1, 0, 2, 3, 4)
    powers = jnp.exp(a_dt[None] * jnp.arange(1, L + 1, dtype=jnp.float32)[:, None, None])
    a_seq = jnp.broadcast_to(a_bar, (b, L, G, P))

    def combine(e1, e2):
        a1, b1 = e1
        a2, b2 = e2
        return a1 * a2, a2 * b1 + b2

    def step(state, u_c):
        bu = jnp.einsum('blgi,gpi->blgp', u_c.astype(jnp.complex64), b_bar)
        _, h_loc = lax.associative_scan(combine, (a_seq, bu), axis=1)
        hs = h_loc + powers[None] * state[:, None]
        y = jnp.real(jnp.einsum('blgp,gip->blgi', hs, cmat))
        return hs[:, -1], y

    state0 = jnp.zeros((b, G, P), jnp.complex64)
    _, y = lax.scan(step, state0, u_chunks)
    y = y.transpose(1, 0, 2, 3, 4).reshape(b, s, D_MODEL)
    y = jax.nn.gelu(y + d_skip.astype(jnp.float32) * u).astype(h.dtype)
    ya, yg = jnp.split(y @ w_glu, 2, axis=-1)
    return ya * jax.nn.sigmoid(yg)


def _compress(kv, pe, w1, w2):
    b, s, g, d = kv.shape
    nc = s // CMP_STRIDE - CMP_RATIO + 1
    pieces = kv.reshape(b, s // CMP_STRIDE, CMP_STRIDE, g, d)
    blocks = jnp.concatenate([pieces[:, r:r + nc] for r in range(CMP_RATIO)], axis=2)
    blocks = blocks + pe[None, None, :, None, :]
    flat = blocks.transpose(0, 1, 3, 2, 4).reshape(b, nc, g, CMP_BLOCK * d)
    return jax.nn.gelu(flat @ w1) @ w2


def nsa_mixer(h, w_proj, pe_k, pe_v, wk1, wk2, wv1, wv2, w_o):
    b, s, _ = h.shape
    G, R, d = NSA_KV_GROUPS, NSA_REP, NSA_HEAD_DIM
    split_at = [int(v) for v in np.cumsum(NSA_PROJ_SIZES)[:-1]]
    q, kc, vc, ks, vs, kw, vw, gl = jnp.split(h @ w_proj, split_at, axis=-1)
    pos = jnp.arange(s, dtype=jnp.float32)
    q = rope(q.reshape(b, s, NSA_HEADS, d), pos)
    ks = rope(ks.reshape(b, s, G, d), pos)
    kw = rope(kw.reshape(b, s, G, d), pos)
    kc = kc.reshape(b, s, G, d)
    vc = vc.reshape(b, s, G, d)
    vs = vs.reshape(b, s, G, d)
    vw = vw.reshape(b, s, G, d)
    gates = jax.nn.sigmoid(gl.astype(jnp.float32)).reshape(b, s, G, R, NSA_N_GATES)

    k_cmp = _compress(kc, pe_k, wk1, wk2)
    v_cmp = _compress(vc, pe_v, wv1, wv2).astype(jnp.float32)
    nc = k_cmp.shape[1]
    cmp_end = jnp.arange(nc) * CMP_STRIDE + CMP_BLOCK - 1
    k_cmp = rope(k_cmp, cmp_end.astype(jnp.float32)).astype(jnp.float32)

    nsb = s // SEL_BLOCK
    n_sel = min(SEL_TOPN, nsb)
    ks_blk = ks.reshape(b, nsb, SEL_BLOCK, G, d).transpose(0, 3, 1, 2, 4)
    vs_blk = vs.reshape(b, nsb, SEL_BLOCK, G, d).transpose(0, 3, 1, 2, 4)
    kw_pad = jnp.pad(kw, ((0, 0), (WINDOW, 0), (0, 0), (0, 0)))
    vw_pad = jnp.pad(vw, ((0, 0), (WINDOW, 0), (0, 0), (0, 0)))

    nqb = s // Q_BLOCK
    q_blocks = q.reshape(b, nqb, Q_BLOCK, G, R, d).transpose(1, 0, 2, 3, 4, 5)
    g_blocks = gates.reshape(b, nqb, Q_BLOCK, G, R, NSA_N_GATES).transpose(1, 0, 2, 3, 4, 5)
    scale = NSA_HEAD_DIM ** -0.5
    blk = jnp.arange(nsb)
    b_idx = jnp.arange(b)[:, None, None, None]
    g_idx = jnp.arange(G)[None, :, None, None]

    def attend(args):
        qi, qb, gb = args
        t = qi * Q_BLOCK + jnp.arange(Q_BLOCK)
        qf = qb.astype(jnp.float32) * scale
        valid_c = cmp_end[None, :] <= t[:, None]
        sc_c = jnp.einsum('bqgrd,bngd->bqgrn', qf, k_cmp)
        sc_c = jnp.where(valid_c[None, :, None, None, :], sc_c, NEG)
        p_c = jax.nn.softmax(sc_c, axis=-1) * valid_c.any(-1)[None, :, None, None, None]
        o_c = jnp.einsum('bqgrn,bngd->bqgrd', p_c, v_cmp)
        p_grp = p_c.sum(axis=3)
        p_pad = jnp.pad(p_grp, ((0, 0), (0, 0), (0, 0), (CMP_RATIO - 1, SEL_RATIO * nsb - nc)))
        imp = sum(p_pad[..., k:k + SEL_RATIO * nsb:SEL_RATIO] for k in range(SEL_RATIO + CMP_RATIO - 1))
        cur = t // SEL_BLOCK
        forced = (blk[None, :] == 0) | (blk[None, :] == cur[:, None]) | (blk[None, :] == cur[:, None] - 1)
        causal = blk[None, :] * SEL_BLOCK <= t[:, None]
        imp = jnp.where(forced[None, :, None, :], 1e9, jnp.where(causal[None, :, None, :], imp, -1e9))
        _, sel = lax.top_k(imp, n_sel)
        sel = sel.transpose(0, 2, 1, 3)
        k_sel = ks_blk[b_idx, g_idx, sel].astype(jnp.float32)
        v_sel = vs_blk[b_idx, g_idx, sel].astype(jnp.float32)
        sc_s = jnp.einsum('bqgrd,bgqnkd->bqgrnk', qf, k_sel)
        key_pos = sel[..., None] * SEL_BLOCK + jnp.arange(SEL_BLOCK)
        valid_s = (key_pos <= t[None, None, :, None, None]).transpose(0, 2, 1, 3, 4)[:, :, :, None]
        sc_s = jnp.where(valid_s, sc_s, NEG)
        p_s = jax.nn.softmax(sc_s.reshape(b, Q_BLOCK, G, R, n_sel * SEL_BLOCK), axis=-1).reshape(sc_s.shape)
        o_s = jnp.einsum('bqgrnk,bgqnkd->bqgrd', p_s, v_sel)
        k_w = lax.dynamic_slice_in_dim(kw_pad, qi * Q_BLOCK, WINDOW + Q_BLOCK, axis=1).astype(jnp.float32)
        v_w = lax.dynamic_slice_in_dim(vw_pad, qi * Q_BLOCK, WINDOW + Q_BLOCK, axis=1).astype(jnp.float32)
        kpos = qi * Q_BLOCK - WINDOW + jnp.arange(WINDOW + Q_BLOCK)
        valid_w = (kpos[None, :] <= t[:, None]) & (kpos[None, :] > t[:, None] - WINDOW) & (kpos[None, :] >= 0)
        sc_w = jnp.einsum('bqgrd,bkgd->bqgrk', qf, k_w)
        sc_w = jnp.where(valid_w[None, :, None, None, :], sc_w, NEG)
        p_w = jax.nn.softmax(sc_w, axis=-1)
        o_w = jnp.einsum('bqgrk,bkgd->bqgrd', p_w, v_w)
        return gb[..., 0:1] * o_c + gb[..., 1:2] * o_s + gb[..., 2:3] * o_w

    o = lax.map(attend, (jnp.arange(nqb), q_blocks, g_blocks))
    o = o.transpose(1, 0, 2, 3, 4, 5).reshape(b, s, NSA_Q_W).astype(h.dtype)
    return o @ w_o


def peer(h, w_q, sub_keys, u_tab, v_tab):
    b, s, _ = h.shape
    H, K = PEER_HEADS, PEER_TOPK
    qk = (h @ w_q).reshape(b, s, H, 2, PEER_HALF).astype(jnp.float32)
    sc = jnp.einsum('bshcd,hckd->bshck', qk, sub_keys.astype(jnp.float32))
    s1, i1 = lax.top_k(sc[..., 0, :], K)
    s2, i2 = lax.top_k(sc[..., 1, :], K)
    cand = (s1[..., :, None] + s2[..., None, :]).reshape(b, s, H, K * K)
    cidx = (i1[..., :, None] * PEER_NKEYS + i2[..., None, :]).reshape(b, s, H, K * K)
    top_s, top_pos = lax.top_k(cand, K)
    experts = jnp.take_along_axis(cidx, top_pos, axis=-1)
    gates = jax.nn.softmax(top_s, axis=-1)
    n_chunks = (b * s) // PEER_CHUNK
    h_c = h.reshape(n_chunks, PEER_CHUNK, D_MODEL)
    e_c = experts.reshape(n_chunks, PEER_CHUNK, H * K)
    g_c = gates.reshape(n_chunks, PEER_CHUNK, H * K)

    def chunk(args):
        hc, ec, gc = args
        u = u_tab[ec]
        v = v_tab[ec]
        act = jax.nn.gelu(jnp.einsum('cd,ced->ce', hc, u).astype(jnp.float32)) * gc
        return jnp.einsum('ce,ced->cd', act.astype(v.dtype), v)

    out = lax.map(chunk, (h_c, e_c, g_c))
    return out.reshape(b, s, D_MODEL)


def setup_inputs(seed: int = 0) -> dict:
    key = jax.random.key(seed)
    ks = jax.random.split(key, 32)
    D = D_MODEL
    G, P = S5_GROUPS, S5_STATE

    def nrm(k, shape, sc):
        return jax.random.normal(k, shape, jnp.float32) * sc

    n_idx = jnp.arange(P, dtype=jnp.float32)
    return {
        'x': nrm(ks[0], (BATCH, SEQ, D), 1.0),
        'c': nrm(ks[1], (BATCH, D), 1.0),
        'norm1_g': 1.0 + nrm(ks[2], (DEPTH, D), 0.02),
        'norm2_g': 1.0 + nrm(ks[3], (DEPTH, D), 0.02),
        'ada_w': nrm(ks[4], (DEPTH, D, 6 * D), 0.5 * D ** -0.5),
        'ada_b': nrm(ks[5], (DEPTH, 6 * D), 0.02),
        's5_w_in': nrm(ks[6], (N_S5, D, D), D ** -0.5),
        's5_a_re': -0.5 + nrm(ks[7], (N_S5, G, P), 0.01),
        's5_a_im': math.pi * n_idx + nrm(ks[8], (N_S5, G, P), 0.01),
        's5_log_dt': jax.random.uniform(ks[9], (N_S5, G), jnp.float32, math.log(DT_MIN), math.log(DT_MAX)),
        's5_b_re': nrm(ks[10], (N_S5, G, P, S5_GROUP), (2 * S5_GROUP) ** -0.5),
        's5_b_im': nrm(ks[11], (N_S5, G, P, S5_GROUP), (2 * S5_GROUP) ** -0.5),
        's5_c_re': nrm(ks[12], (N_S5, G, S5_GROUP, P), P ** -0.5),
        's5_c_im': nrm(ks[13], (N_S5, G, S5_GROUP, P), P ** -0.5),
        's5_d': nrm(ks[14], (N_S5, D), 1.0),
        's5_w_glu': nrm(ks[15], (N_S5, D, 2 * D), D ** -0.5),
        'nsa_w_proj': nrm(ks[16], (N_NSA, D, NSA_PROJ_W), D ** -0.5),
        'nsa_pe_k': nrm(ks[17], (N_NSA, CMP_BLOCK, NSA_HEAD_DIM), 0.1),
        'nsa_pe_v': nrm(ks[18], (N_NSA, CMP_BLOCK, NSA_HEAD_DIM), 0.1),
        'nsa_wk1': nrm(ks[19], (N_NSA, CMP_BLOCK * NSA_HEAD_DIM, CMP_HIDDEN), (CMP_BLOCK * NSA_HEAD_DIM) ** -0.5),
        'nsa_wk2': nrm(ks[20], (N_NSA, CMP_HIDDEN, NSA_HEAD_DIM), CMP_HIDDEN ** -0.5),
        'nsa_wv1': nrm(ks[21], (N_NSA, CMP_BLOCK * NSA_HEAD_DIM, CMP_HIDDEN), (CMP_BLOCK * NSA_HEAD_DIM) ** -0.5),
        'nsa_wv2': nrm(ks[22], (N_NSA, CMP_HIDDEN, NSA_HEAD_DIM), CMP_HIDDEN ** -0.5),
        'nsa_w_o': nrm(ks[23], (N_NSA, NSA_Q_W, D), NSA_Q_W ** -0.5),
        'peer_w_q': nrm(ks[24], (DEPTH, D, PEER_HEADS * PEER_KEY_DIM), D ** -0.5),
        'peer_sub_keys': nrm(ks[25], (DEPTH, PEER_HEADS, 2, PEER_NKEYS, PEER_HALF), PEER_HALF ** -0.5),
        'peer_u': nrm(ks[26], (DEPTH, PEER_EXPERTS, D), D ** -0.5),
        'peer_v': nrm(ks[27], (DEPTH, PEER_EXPERTS, D), 0.5),
        'final_g': 1.0 + nrm(ks[28], (D,), 0.02),
    }


def reference(x, c, norm1_g, norm2_g, ada_w, ada_b, s5_w_in, s5_a_re, s5_a_im, s5_log_dt,
              s5_b_re, s5_b_im, s5_c_re, s5_c_im, s5_d, s5_w_glu, nsa_w_proj, nsa_pe_k, nsa_pe_v,
              nsa_wk1, nsa_wk2, nsa_wv1, nsa_wv2, nsa_w_o, peer_w_q, peer_sub_keys, peer_u, peer_v,
              final_g):
    c_act = jax.nn.silu(c)
    for i in range(DEPTH):
        mod = c_act @ ada_w[i] + ada_b[i]
        sh1, sc1, g1, sh2, sc2, g2 = jnp.split(mod, 6, axis=-1)
        hm = modulate(rmsnorm(x, norm1_g[i]), sh1, sc1)
        j = i // N_MIXERS
        if i % N_MIXERS == 0:
            y = s5_mixer(hm, s5_w_in[j], s5_a_re[j], s5_a_im[j], s5_log_dt[j], s5_b_re[j], s5_b_im[j],
                         s5_c_re[j], s5_c_im[j], s5_d[j], s5_w_glu[j])
        else:
            y = nsa_mixer(hm, nsa_w_proj[j], nsa_pe_k[j], nsa_pe_v[j], nsa_wk1[j], nsa_wk2[j],
                          nsa_wv1[j], nsa_wv2[j], nsa_w_o[j])
        x = x + g1[:, None, :] * y
        hf = modulate(rmsnorm(x, norm2_g[i]), sh2, sc2)
        x = x + g2[:, None, :] * peer(hf, peer_w_q[i], peer_sub_keys[i], peer_u[i], peer_v[i])
    return rmsnorm(x, final_g)
```

```cpp
#include <hip/hip_runtime.h>
#include <hip/hip_cooperative_groups.h>
#include <cstdio>
#include <cstdint>
namespace cg = cooperative_groups;

#ifndef SINGLE_LAUNCH
#define SINGLE_LAUNCH 1
#endif

typedef unsigned short bf16_t;
typedef short bf16x8 __attribute__((ext_vector_type(8)));
typedef float f32x4 __attribute__((ext_vector_type(4)));
typedef float f32x2 __attribute__((ext_vector_type(2)));
typedef unsigned u32x4 __attribute__((ext_vector_type(4)));
typedef unsigned u32x2 __attribute__((ext_vector_type(2)));
typedef __bf16 bf16x2_t __attribute__((ext_vector_type(2)));

constexpr int D = 1024, BATCH = 2, SEQ = 16384, T = BATCH * SEQ;
constexpr int NTHREADS = 256;
constexpr float RMS_EPS = 1e-6f;
constexpr int S5G = 64, S5P = 64, S5L = 32, S5NCH = T / S5L  , S5CPB = SEQ / S5L  ;
constexpr int NH = 16, HD = 64, NG = 4, NPROJ = 2608, NPROJ_PAD = 2688, NC = 1023, NSB = 256;
constexpr int PH = 8, PK = 16, PNK = 128, PE = 16384;

constexpr size_t MiB = 1ull << 20;
constexpr size_t WS_CTL = 0;
constexpr size_t WS_MOD = 1 * MiB;
constexpr size_t WS_WIN_T = 2 * MiB;
constexpr size_t WS_WGLU_T = 4 * MiB;
constexpr size_t WS_WPROJ_T = 8 * MiB;
constexpr size_t WS_WK1_T = 14 * MiB;
constexpr size_t WS_WV1_T = 15 * MiB;
constexpr size_t WS_WK2_T = 16 * MiB;
constexpr size_t WS_WV2_T = 16 * MiB + 512 * 1024;
constexpr size_t WS_WO_T = 17 * MiB;
constexpr size_t WS_WQ_T = 19 * MiB;
constexpr size_t WS_SUBK = 27 * MiB;
constexpr size_t WS_ROPE = 28 * MiB;
constexpr size_t WS_MISC = 32 * MiB;
constexpr size_t WS_TW = 33 * MiB;
constexpr size_t WS_VG = 73 * MiB;
constexpr size_t WS_PU = 82 * MiB;
constexpr size_t WS_PV = 114 * MiB;
constexpr size_t WS_HM = 146 * MiB;
constexpr size_t WS_C = 210 * MiB;
constexpr size_t WS_UG = WS_C;
constexpr size_t WS_YI = WS_C + 64 * MiB;
constexpr size_t WS_WST = WS_C + 128 * MiB;
constexpr size_t WS_SST = WS_C + 160 * MiB;
constexpr size_t WS_YG = WS_C + 176 * MiB;
constexpr size_t WS_QK = WS_C;
constexpr size_t WS_TOPS = WS_C + 128 * MiB;
constexpr size_t WS_TOPI = WS_C + 160 * MiB;
constexpr size_t WS_EXP = WS_C + 192 * MiB;
constexpr size_t WS_GATE = WS_C + 208 * MiB;
constexpr size_t WS_Q = WS_C;
constexpr size_t WS_KC = WS_C + 64 * MiB;
constexpr size_t WS_VC = WS_C + 81 * MiB;
constexpr size_t WS_KS = WS_C + 98 * MiB;
constexpr size_t WS_VST = WS_C + 114 * MiB;
constexpr size_t WS_KW = WS_C + 130 * MiB;
constexpr size_t WS_VWT = WS_C + 146 * MiB;
constexpr size_t WS_NG = WS_C + 162 * MiB;
constexpr size_t WS_KCMP = WS_C + 170 * MiB;
constexpr size_t WS_VCMPT = WS_C + 171 * MiB;
constexpr size_t WS_HID = WS_C + 172 * MiB;
constexpr size_t WS_O = WS_C + 182 * MiB;
constexpr size_t WS_END = WS_C + 256 * MiB;

constexpr int LDS_BYTES = 73728;

struct Params {
    const float* in[29];
    float* out;
    unsigned char* ws;
    int ph_lo, ph_hi;
};

__device__ __forceinline__ unsigned f2bf(float f) { unsigned u = __builtin_bit_cast(unsigned, f); return (u + 0x7fffu + ((u >> 16) & 1u)) >> 16; }
__device__ __forceinline__ unsigned pk2(float lo, float hi) { return f2bf(lo) | (f2bf(hi) << 16); }
__device__ __forceinline__ float bf2f(unsigned h) { return __builtin_bit_cast(float, h << 16); }
__device__ __forceinline__ float bflo(unsigned w) { return __builtin_bit_cast(float, w << 16); }
__device__ __forceinline__ float bfhi(unsigned w) { return __builtin_bit_cast(float, w & 0xffff0000u); }
__device__ __forceinline__ float gelu_tanh(float x) {
    const float u = 0.7978845608028654f * (x + 0.044715f * x * x * x);
    const float e = __expf(2.0f * u);
    const float th = 1.0f - 2.0f / (e + 1.0f);
    return 0.5f * x * (1.0f + th);
}
__device__ __forceinline__ float sigmoidf_(float x) { return 1.0f / (1.0f + __expf(-x)); }
__device__ __forceinline__ float wave_sum(float v) {
#pragma unroll
    for (int o = 1; o < 64; o <<= 1) v += __shfl_xor(v, o);
    return v;
}
__device__ __forceinline__ float dot2bf(unsigned a, unsigned b, float acc) {
    return __builtin_amdgcn_fdot2_f32_bf16(__builtin_bit_cast(bf16x2_t, a), __builtin_bit_cast(bf16x2_t, b), acc, false);
}

__device__ __forceinline__ void prep_mod_item(const Params& p, int item, float* lds) {
    const int layer = item / 192, cg0 = (item % 192) * 32;
    const int tid = threadIdx.x, col = cg0 + (tid & 31), kg = tid >> 5;
    const float* W = p.in[4] + (size_t)layer * D * 6 * D;
    const float* c = p.in[1];
    float a0 = 0.f, a1 = 0.f;
    for (int k = kg * 128; k < kg * 128 + 128; ++k) {
        const float w = W[(size_t)k * (6 * D) + col];
        const float c0 = c[k], c1 = c[D + k];
        a0 += w * (c0 * sigmoidf_(c0));
        a1 += w * (c1 * sigmoidf_(c1));
    }
    lds[tid] = a0; lds[256 + tid] = a1;
    __syncthreads();
    if (tid < 64) {
        const int b = tid >> 5, cc = tid & 31;
        float s = 0.f;
#pragma unroll
        for (int g = 0; g < 8; ++g) s += lds[b * 256 + g * 32 + cc];
        float* MOD = (float*)(p.ws + WS_MOD);
        MOD[(size_t)(layer * 2 + b) * 6144 + cg0 + cc] = s + p.in[5][(size_t)layer * 6144 + cg0 + cc];
    }
    __syncthreads();
}

template <int MODE>
__device__ __forceinline__ void prep_transpose_item(const float* W, int K, int N, bf16_t* WT, int item, float* lds) {
    const int nbn = (N + 63) / 64, kb = item / nbn, nb = item % nbn, k0 = kb * 64, n0 = nb * 64;
    const int tid = threadIdx.x;
#pragma unroll
    for (int i = 0; i < 16; ++i) {
        const int kk = (tid >> 6) + 4 * i, nn = tid & 63;
        const float v = (n0 + nn < N) ? W[(size_t)(k0 + kk) * N + n0 + nn] : 0.f;
        lds[kk * 65 + nn] = v;
    }
    __syncthreads();
    {
        const int nn = tid >> 2, ks = (tid & 3) * 16;
        const int n = n0 + nn;
        if (n < N) {
            int np = n;
            if (MODE == 1) { const int j = (n < 1024) ? n : n - 1024; np = (j >> 4) * 32 + (j & 15) + ((n < 1024) ? 0 : 16); }
            u32x4 o0, o1;
            const float* s = lds + nn;
            o0.x = pk2(s[(ks + 0) * 65], s[(ks + 1) * 65]); o0.y = pk2(s[(ks + 2) * 65], s[(ks + 3) * 65]);
            o0.z = pk2(s[(ks + 4) * 65], s[(ks + 5) * 65]); o0.w = pk2(s[(ks + 6) * 65], s[(ks + 7) * 65]);
            o1.x = pk2(s[(ks + 8) * 65], s[(ks + 9) * 65]); o1.y = pk2(s[(ks + 10) * 65], s[(ks + 11) * 65]);
            o1.z = pk2(s[(ks + 12) * 65], s[(ks + 13) * 65]); o1.w = pk2(s[(ks + 14) * 65], s[(ks + 15) * 65]);
            u32x4* dst = (u32x4*)(WT + (size_t)np * K + k0 + ks);
            dst[0] = o0; dst[1] = o1;
        }
    }
    __syncthreads();
}

__device__ __forceinline__ void cvt_item(const float* src, bf16_t* dst, int item) {
    const size_t base = (size_t)item * 8192 + threadIdx.x * 8;
#pragma unroll
    for (int i = 0; i < 4; ++i) {
        const size_t o = base + (size_t)i * 2048;
        const f32x4 a = *(const f32x4*)(src + o), b = *(const f32x4*)(src + o + 4);
        u32x4 w; w.x = pk2(a.x, a.y); w.y = pk2(a.z, a.w); w.z = pk2(b.x, b.y); w.w = pk2(b.z, b.w);
        *(u32x4*)(dst + o) = w;
    }
}
__device__ __forceinline__ void zero_item(bf16_t* dst, int item) {
    const size_t base = (size_t)item * 8192 + threadIdx.x * 8;
#pragma unroll
    for (int i = 0; i < 4; ++i) *(u32x4*)(dst + base + (size_t)i * 2048) = (u32x4){0u, 0u, 0u, 0u};
}

struct cpx { float re, im; };
__device__ __forceinline__ cpx cmul(cpx a, cpx b) { return {a.re * b.re - a.im * b.im, a.re * b.im + a.im * b.re}; }
__device__ __forceinline__ cpx cexp_pow(float are, float aim, float dt, int m) {
    const float mag = __expf(are * dt * (float)m);
    const double rev = (double)aim * (double)dt * (double)m * 0.15915494309189535;
    const float fr = (float)(rev - rint(rev));
    return {mag * __builtin_amdgcn_cosf(fr), mag * __builtin_amdgcn_sinf(fr)};
}
__device__ __forceinline__ cpx s5_coef(float are, float aim, float dt) {
    cpx ab = cexp_pow(are, aim, dt, 1);
    const float nr = ab.re - 1.0f, ni = ab.im, den = are * are + aim * aim;
    return {(nr * are + ni * aim) / den, (ni * are - nr * aim) / den};
}

__device__ __forceinline__ void prep_s5_T_item(const Params& p, int item) {
    const int gid = item * 256 + threadIdx.x;
    const int g = gid >> 9, m = (gid >> 4) & 31, i = gid & 15;
    const float* a_re = p.in[7] + g * 64; const float* a_im = p.in[8] + g * 64;
    const float dt = __expf(p.in[9][g]);
    const float* b_re = p.in[10] + (size_t)g * 64 * 16; const float* b_im = p.in[11] + (size_t)g * 64 * 16;
    const float* c_re = p.in[12] + (size_t)g * 16 * 64 + i * 64; const float* c_im = p.in[13] + (size_t)g * 16 * 64 + i * 64;
    float acc[16];
#pragma unroll
    for (int j = 0; j < 16; ++j) acc[j] = 0.f;
    for (int q = 0; q < 64; ++q) {
        const float are = a_re[q], aim = a_im[q];
        cpx z = cmul(cmul({c_re[q], c_im[q]}, cexp_pow(are, aim, dt, m)), s5_coef(are, aim, dt));
        const f32x4* br = (const f32x4*)(b_re + q * 16); const f32x4* bi = (const f32x4*)(b_im + q * 16);
#pragma unroll
        for (int j4 = 0; j4 < 4; ++j4) {
            const f32x4 r = br[j4], im = bi[j4];
            acc[j4 * 4 + 0] += z.re * r.x - z.im * im.x; acc[j4 * 4 + 1] += z.re * r.y - z.im * im.y;
            acc[j4 * 4 + 2] += z.re * r.z - z.im * im.z; acc[j4 * 4 + 3] += z.re * r.w - z.im * im.w;
        }
    }
    u32x4 o0, o1;
    o0.x = pk2(acc[0], acc[1]); o0.y = pk2(acc[2], acc[3]); o0.z = pk2(acc[4], acc[5]); o0.w = pk2(acc[6], acc[7]);
    o1.x = pk2(acc[8], acc[9]); o1.y = pk2(acc[10], acc[11]); o1.z = pk2(acc[12], acc[13]); o1.w = pk2(acc[14], acc[15]);
    bf16_t* TW = (bf16_t*)(p.ws + WS_TW) + (size_t)g * 640 * 512;
    const u32x4 z4 = (u32x4){0u, 0u, 0u, 0u};
    for (int lp = 0; lp + m < 32; ++lp) {
        u32x4* d = (u32x4*)(TW + (size_t)((lp + m) * 16 + i) * 512 + lp * 16);
        d[0] = o0; d[1] = o1;
        if (m > 0) { u32x4* dz = (u32x4*)(TW + (size_t)(lp * 16 + i) * 512 + (lp + m) * 16); dz[0] = z4; dz[1] = z4; }
    }
}
__device__ __forceinline__ void prep_s5_W_item(const Params& p, int item) {
    const int gid = item * 256 + threadIdx.x;
    const int g = gid >> 11, q = (gid >> 5) & 63, lp = gid & 31;
    const float are = p.in[7][g * 64 + q], aim = p.in[8][g * 64 + q];
    const float dt = __expf(p.in[9][g]);
    const cpx z = cmul(cexp_pow(are, aim, dt, 31 - lp), s5_coef(are, aim, dt));
    const float* br = p.in[10] + ((size_t)g * 64 + q) * 16; const float* bi = p.in[11] + ((size_t)g * 64 + q) * 16;
    float wr[16], wi[16];
#pragma unroll
    for (int j = 0; j < 16; ++j) { wr[j] = z.re * br[j] - z.im * bi[j]; wi[j] = z.re * bi[j] + z.im * br[j]; }
    bf16_t* TW = (bf16_t*)(p.ws + WS_TW) + (size_t)g * 640 * 512;
    u32x4* d0 = (u32x4*)(TW + (size_t)(512 + q) * 512 + lp * 16);
    u32x4* d1 = (u32x4*)(TW + (size_t)(576 + q) * 512 + lp * 16);
    d0[0] = (u32x4){pk2(wr[0], wr[1]), pk2(wr[2], wr[3]), pk2(wr[4], wr[5]), pk2(wr[6], wr[7])};
    d0[1] = (u32x4){pk2(wr[8], wr[9]), pk2(wr[10], wr[11]), pk2(wr[12], wr[13]), pk2(wr[14], wr[15])};
    d1[0] = (u32x4){pk2(wi[0], wi[1]), pk2(wi[2], wi[3]), pk2(wi[4], wi[5]), pk2(wi[6], wi[7])};
    d1[1] = (u32x4){pk2(wi[8], wi[9]), pk2(wi[10], wi[11]), pk2(wi[12], wi[13]), pk2(wi[14], wi[15])};
}
__device__ __forceinline__ void prep_s5_V_item(const Params& p, int item) {
    const int gid = item * 256 + threadIdx.x;
    const int g = gid >> 14, l = (gid >> 9) & 31, i = (gid >> 5) & 15, q0 = (gid & 31) * 2;
    const float dt = __expf(p.in[9][g]);
    float vr[2], vi[2];
#pragma unroll
    for (int e = 0; e < 2; ++e) {
        const int q = q0 + e;
        const cpx z = cmul({p.in[12][((size_t)g * 16 + i) * 64 + q], p.in[13][((size_t)g * 16 + i) * 64 + q]}, cexp_pow(p.in[7][g * 64 + q], p.in[8][g * 64 + q], dt, l + 1));
        vr[e] = z.re; vi[e] = -z.im;
    }
    bf16_t* VG = (bf16_t*)(p.ws + WS_VG) + ((size_t)g * 512 + l * 16 + i) * 128;
    *(unsigned*)(VG + q0) = pk2(vr[0], vr[1]);
    *(unsigned*)(VG + 64 + q0) = pk2(vi[0], vi[1]);
}
__device__ __forceinline__ void prep_al_item(const Params& p, int item) {
    const int gid = item * 256 + threadIdx.x;
    const int g = gid >> 6;
    const float dt = __expf(p.in[9][g]);
    const cpx z = cexp_pow(p.in[7][gid], p.in[8][gid], dt, S5L);
    f32x2* AL = (f32x2*)(p.ws + WS_MISC + 4096);
    AL[gid] = (f32x2){z.re, z.im};
}
__device__ __forceinline__ void prep_rope_item(const Params& p, int item) {
    const int gid = item * 256 + threadIdx.x;
    const int pos = gid >> 5, j = gid & 31;
    const float freq = exp2f(-(float)j * (13.287712379549449f / 32.0f));
    const float ang = (float)pos * freq;
    const double rev = (double)ang * 0.15915494309189535;
    const float fr = (float)(rev - rint(rev));
    f32x2* R = (f32x2*)(p.ws + WS_ROPE);
    R[gid] = (f32x2){__builtin_amdgcn_cosf(fr), __builtin_amdgcn_sinf(fr)};
}
__device__ __forceinline__ void prep_cmpbias_item(const Params& p, int item) {
    const float* pe = p.in[17 + item]; const float* w1 = p.in[item == 0 ? 19 : 21];
    const int j = threadIdx.x;
    float s = 0.f;
    for (int k = 0; k < 2048; ++k) s += pe[k] * w1[(size_t)k * 256 + j];
    ((float*)(p.ws + WS_MISC))[item * 256 + j] = s;
}

constexpr int P0_MOD = 384;
constexpr int P0_T_WIN = 16 * 16, P0_T_WGLU = 16 * 32, P0_T_WPROJ = 16 * 41, P0_T_WK1 = 32 * 4, P0_T_WK2 = 4 * 1, P0_T_WO = 16 * 16, P0_T_WQ = 16 * 32;
constexpr int P0_SUBK = (2 * 8 * 2 * 128 * 128) / 8192;
constexpr int P0_TAB = (PE * D) / 8192;
constexpr int P0_S5T = 128, P0_S5W = 512, P0_S5V = 4096, P0_AL = 16, P0_ROPE = 2048, P0_CB = 2, P0_ZERO = 10 + 2;

__device__ void phase_prep(const Params& p, float* lds) {
    const int n0 = P0_MOD;
    const int n1 = n0 + P0_T_WIN, n2 = n1 + P0_T_WGLU, n3 = n2 + P0_T_WPROJ, n4 = n3 + P0_T_WK1, n5 = n4 + P0_T_WK1, n6 = n5 + P0_T_WK2, n7 = n6 + P0_T_WK2,
              n8 = n7 + P0_T_WO, n9 = n8 + P0_T_WQ, n10 = n9 + P0_T_WQ, n11 = n10 + P0_SUBK, n12 = n11 + P0_TAB, n13 = n12 + P0_TAB,
              n14 = n13 + P0_S5T, n15 = n14 + P0_S5W, n16 = n15 + P0_S5V, n17 = n16 + P0_AL, n18 = n17 + P0_ROPE, n19 = n18 + P0_CB, n20 = n19 + 10, n21 = n20 + 2, n22 = n21 + 2;
    unsigned char* ws = p.ws;
    for (int it = blockIdx.x; it < n22; it += gridDim.x) {
        if (it < n0) prep_mod_item(p, it, lds);
        else if (it < n1) prep_transpose_item<0>(p.in[6], 1024, 1024, (bf16_t*)(ws + WS_WIN_T), it - n0, lds);
        else if (it < n2) prep_transpose_item<1>(p.in[15], 1024, 2048, (bf16_t*)(ws + WS_WGLU_T), it - n1, lds);
        else if (it < n3) prep_transpose_item<0>(p.in[16], 1024, NPROJ, (bf16_t*)(ws + WS_WPROJ_T), it - n2, lds);
        else if (it < n4) prep_transpose_item<0>(p.in[19], 2048, 256, (bf16_t*)(ws + WS_WK1_T), it - n3, lds);
        else if (it < n5) prep_transpose_item<0>(p.in[21], 2048, 256, (bf16_t*)(ws + WS_WV1_T), it - n4, lds);
        else if (it < n6) prep_transpose_item<0>(p.in[20], 256, 64, (bf16_t*)(ws + WS_WK2_T), it - n5, lds);
        else if (it < n7) prep_transpose_item<0>(p.in[22], 256, 64, (bf16_t*)(ws + WS_WV2_T), it - n6, lds);
        else if (it < n8) prep_transpose_item<0>(p.in[23], 1024, 1024, (bf16_t*)(ws + WS_WO_T), it - n7, lds);
        else if (it < n9) prep_transpose_item<0>(p.in[24], 1024, 2048, (bf16_t*)(ws + WS_WQ_T), it - n8, lds);
        else if (it < n10) prep_transpose_item<0>(p.in[24] + (size_t)1024 * 2048, 1024, 2048, (bf16_t*)(ws + WS_WQ_T) + (size_t)2048 * 1024, it - n9, lds);
        else if (it < n11) cvt_item(p.in[25], (bf16_t*)(ws + WS_SUBK), it - n10);
        else if (it < n12) cvt_item(p.in[26], (bf16_t*)(ws + WS_PU), it - n11);
        else if (it < n13) cvt_item(p.in[27], (bf16_t*)(ws + WS_PV), it - n12);
        else if (it < n14) prep_s5_T_item(p, it - n13);
        else if (it < n15) prep_s5_W_item(p, it - n14);
        else if (it < n16) prep_s5_V_item(p, it - n15);
        else if (it < n17) prep_al_item(p, it - n16);
        else if (it < n18) prep_rope_item(p, it - n17);
        else if (it < n19) prep_cmpbias_item(p, it - n18);
        else if (it < n20) zero_item((bf16_t*)(ws + WS_WPROJ_T) + (size_t)NPROJ * 1024, it - n19);
        else if (it < n21) zero_item((bf16_t*)(ws + WS_WK2_T) + (size_t)64 * 256, it - n20);
        else zero_item((bf16_t*)(ws + WS_WV2_T) + (size_t)64 * 256, it - n21);
    }
}

__device__ void phase_norm(const Params& p, const float* X, const float* gw, const float* shift, const float* scale  , bf16_t* HM) {
    const int lane = threadIdx.x & 63, wave = threadIdx.x >> 6;
    for (int row = blockIdx.x * 4 + wave; row < T; row += gridDim.x * 4) {
        const int b = row / SEQ;
        const f32x4* xr = (const f32x4*)(X + (size_t)row * D) + lane;
        f32x4 v[4]; float s = 0.f;
#pragma unroll
        for (int j = 0; j < 4; ++j) { v[j] = xr[64 * j]; s += (v[j].x * v[j].x + v[j].y * v[j].y) + (v[j].z * v[j].z + v[j].w * v[j].w); }
        const float rs = rsqrtf(wave_sum(s) * (1.0f / D) + RMS_EPS);
        u32x2* o = (u32x2*)(HM + (size_t)row * D) + lane;
#pragma unroll
        for (int j = 0; j < 4; ++j) {
            const int c = lane * 4 + 256 * j;
            const f32x4 g = *(const f32x4*)(gw + c), sh = *(const f32x4*)(shift + (size_t)b * 6144 + c), sc = *(const f32x4*)(scale + (size_t)b * 6144 + c);
            const float y0 = v[j].x * rs * g.x * (1.f + sc.x) + sh.x, y1 = v[j].y * rs * g.y * (1.f + sc.y) + sh.y;
            const float y2 = v[j].z * rs * g.z * (1.f + sc.z) + sh.z, y3 = v[j].w * rs * g.w * (1.f + sc.w) + sh.w;
            o[64 * j] = (u32x2){pk2(y0, y1), pk2(y2, y3)};
        }
    }
}
__device__ void phase_final_norm(const Params& p, const float* X, float* OUT) {
    const int lane = threadIdx.x & 63, wave = threadIdx.x >> 6;
    const float* gw = p.in[28];
    for (int row = blockIdx.x * 4 + wave; row < T; row += gridDim.x * 4) {
        const f32x4* xr = (const f32x4*)(X + (size_t)row * D) + lane;
        f32x4 v[4]; float s = 0.f;
#pragma unroll
        for (int j = 0; j < 4; ++j) { v[j] = xr[64 * j]; s += (v[j].x * v[j].x + v[j].y * v[j].y) + (v[j].z * v[j].z + v[j].w * v[j].w); }
        const float rs = rsqrtf(wave_sum(s) * (1.0f / D) + RMS_EPS);
        f32x4* o = (f32x4*)(OUT + (size_t)row * D) + lane;
#pragma unroll
        for (int j = 0; j < 4; ++j) {
            const f32x4 g = *(const f32x4*)(gw + lane * 4 + 256 * j);
            o[64 * j] = (f32x4){v[j].x * rs * g.x, v[j].y * rs * g.y, v[j].z * rs * g.z, v[j].w * rs * g.w};
        }
    }
}

struct ALoadPlain {
    const bf16_t* A; size_t lda;
    __device__ __forceinline__ const bf16_t* ptr(int r, int k) const { return A + (size_t)r * lda + k; }
};
struct ALoadGroup {
    const bf16_t* A;
    __device__ __forceinline__ const bf16_t* ptr(int r, int k) const { return A + ((size_t)(k >> 4) * T + r) * 16 + (k & 15); }
};

template <class AL>
__device__ __forceinline__ void gemm_tile(const AL al, const bf16_t* __restrict__ Bt, size_t ldb, int nk, f32x4 (&acc)[4][4], unsigned char* lds) {
    const int tid = threadIdx.x, lane = tid & 63, wid = tid >> 6, wr = wid >> 1, wc = wid & 1, fr = lane & 15, fq = lane >> 4;
    const int lr = tid >> 3, lc = tid & 7;
#pragma unroll
    for (int mi = 0; mi < 4; ++mi)
#pragma unroll
        for (int ni = 0; ni < 4; ++ni) acc[mi][ni] = (f32x4){0.f, 0.f, 0.f, 0.f};
    u32x4 ra[4], rb[4];
    const int soff = lr * 128 + ((lc ^ (lr & 7)) << 4);
#pragma unroll
    for (int i = 0; i < 4; ++i) { ra[i] = *(const u32x4*)al.ptr(lr + 32 * i, lc * 8); rb[i] = *(const u32x4*)(Bt + (size_t)(lr + 32 * i) * ldb + lc * 8); }
#pragma unroll
    for (int i = 0; i < 4; ++i) { *(u32x4*)(lds + soff + i * 4096) = ra[i]; *(u32x4*)(lds + 16384 + soff + i * 4096) = rb[i]; }
    __syncthreads();
    const int aoff = (wr * 64 + fr) * 128, boff = 16384 + (wc * 64 + fr) * 128, sw = fr & 7;
    for (int kt = 0; kt < nk; ++kt) {
        const bool more = (kt + 1 < nk);
        if (more) {
#pragma unroll
            for (int i = 0; i < 4; ++i) { ra[i] = *(const u32x4*)al.ptr(lr + 32 * i, (kt + 1) * 64 + lc * 8); rb[i] = *(const u32x4*)(Bt + (size_t)(lr + 32 * i) * ldb + (kt + 1) * 64 + lc * 8); }
        }
        const unsigned char* buf = lds + (kt & 1) * 32768;
#pragma unroll
        for (int ks = 0; ks < 2; ++ks) {
            bf16x8 af[4], bfr[4];
            const int co = ((ks * 4 + fq) ^ sw) << 4;
#pragma unroll
            for (int mi = 0; mi < 4; ++mi) af[mi] = *(const bf16x8*)(buf + aoff + mi * 2048 + co);
#pragma unroll
            for (int ni = 0; ni < 4; ++ni) bfr[ni] = *(const bf16x8*)(buf + boff + ni * 2048 + co);
#pragma unroll
            for (int mi = 0; mi < 4; ++mi)
#pragma unroll
                for (int ni = 0; ni < 4; ++ni) acc[mi][ni] = __builtin_amdgcn_mfma_f32_16x16x32_bf16(bfr[ni], af[mi], acc[mi][ni], 0, 0, 0);
        }
        if (more) {
            unsigned char* nb = lds + ((kt + 1) & 1) * 32768;
#pragma unroll
            for (int i = 0; i < 4; ++i) { *(u32x4*)(nb + soff + i * 4096) = ra[i]; *(u32x4*)(nb + 16384 + soff + i * 4096) = rb[i]; }
        }
        __syncthreads();
    }
}
__device__ void phase_s5_win(const Params& p, unsigned char* lds) {
    const bf16_t* HM = (const bf16_t*)(p.ws + WS_HM); const bf16_t* WT = (const bf16_t*)(p.ws + WS_WIN_T);
    bf16_t* UG = (bf16_t*)(p.ws + WS_UG);
    const int lane = threadIdx.x & 63, wid = threadIdx.x >> 6, wr = wid >> 1, wc = wid & 1, fr = lane & 15, fq = lane >> 4;
    for (int id = blockIdx.x; id < 256 * 8; id += gridDim.x) {
        const int mt = id >> 3, nt = id & 7;
        f32x4 acc[4][4];
        gemm_tile(ALoadPlain{HM + (size_t)mt * 128 * D, (size_t)D}, WT + (size_t)nt * 128 * D, D, 16, acc, lds);
#pragma unroll
        for (int mi = 0; mi < 4; ++mi)
#pragma unroll
            for (int ni = 0; ni < 4; ++ni) {
                const int t = mt * 128 + wr * 64 + mi * 16 + fr, g = nt * 8 + wc * 4 + ni;
                const f32x4 v = acc[mi][ni];
                *(u32x2*)(UG + ((size_t)g * T + t) * 16 + fq * 4) = (u32x2){pk2(v.x, v.y), pk2(v.z, v.w)};
            }
    }
}
__device__ void phase_s5_a(const Params& p, unsigned char* lds) {
    const bf16_t* UG = (const bf16_t*)(p.ws + WS_UG); const bf16_t* TW = (const bf16_t*)(p.ws + WS_TW);
    bf16_t* YI = (bf16_t*)(p.ws + WS_YI); float* WST = (float*)(p.ws + WS_WST);
    const int lane = threadIdx.x & 63, wid = threadIdx.x >> 6, wr = wid >> 1, wc = wid & 1, fr = lane & 15, fq = lane >> 4;
    for (int id = blockIdx.x; id < 64 * 40; id += gridDim.x) {
        const int g = id / 40, rem = id % 40, mt = rem / 5, nt = rem % 5;
        const int nk = (nt < 4) ? 2 * (nt + 1) : 8;
        f32x4 acc[4][4];
        gemm_tile(ALoadPlain{UG + (size_t)g * T * 16 + (size_t)mt * 128 * 512, (size_t)512}, TW + ((size_t)g * 640 + nt * 128) * 512, 512, nk, acc, lds);
#pragma unroll
        for (int mi = 0; mi < 4; ++mi)
#pragma unroll
            for (int ni = 0; ni < 4; ++ni) {
                const int R = mt * 128 + wr * 64 + mi * 16 + fr, c = wc * 64 + ni * 16 + fq * 4;
                const f32x4 v = acc[mi][ni];
                if (nt < 4) *(u32x2*)(YI + ((size_t)g * 1024 + R) * 512 + nt * 128 + c) = (u32x2){pk2(v.x, v.y), pk2(v.z, v.w)};
                else *(f32x4*)(WST + ((size_t)g * 1024 + R) * 128 + c) = v;
            }
    }
}
__device__ void phase_s5_scan(const Params& p) {
    const int lane = threadIdx.x & 63, wave = threadIdx.x >> 6;
    const float* WST = (const float*)(p.ws + WS_WST); bf16_t* SST = (bf16_t*)(p.ws + WS_SST);
    const f32x2* AL = (const f32x2*)(p.ws + WS_MISC + 4096);
    for (int it = blockIdx.x * 4 + wave; it < 128; it += gridDim.x * 4) {
        const int b = it >> 6, g = it & 63;
        const f32x2 al = AL[g * 64 + lane];
        float sr = 0.f, si = 0.f;
        const float* wbase = WST + ((size_t)g * 1024 + b * 512) * 128 + lane;
        bf16_t* sbase = SST + ((size_t)g * 1024 + b * 512) * 128 + lane;
        for (int n0 = 0; n0 < 512; n0 += 16) {
            float wre[16], wim[16];
#pragma unroll
            for (int j = 0; j < 16; ++j) { wre[j] = wbase[(size_t)(n0 + j) * 128]; wim[j] = wbase[(size_t)(n0 + j) * 128 + 64]; }
#pragma unroll
            for (int j = 0; j < 16; ++j) {
                sbase[(size_t)(n0 + j) * 128] = (bf16_t)f2bf(sr); sbase[(size_t)(n0 + j) * 128 + 64] = (bf16_t)f2bf(si);
                const float nr = al.x * sr - al.y * si + wre[j], ni = al.x * si + al.y * sr + wim[j];
                sr = nr; si = ni;
            }
        }
    }
}
__device__ void phase_s5_b(const Params& p, unsigned char* lds) {
    const bf16_t* SST = (const bf16_t*)(p.ws + WS_SST); const bf16_t* VG = (const bf16_t*)(p.ws + WS_VG);
    const bf16_t* YI = (const bf16_t*)(p.ws + WS_YI); const bf16_t* UG = (const bf16_t*)(p.ws + WS_UG);
    bf16_t* YG = (bf16_t*)(p.ws + WS_YG);
    const float* dsk = p.in[14];
    const int lane = threadIdx.x & 63, wid = threadIdx.x >> 6, wr = wid >> 1, wc = wid & 1, fr = lane & 15, fq = lane >> 4;
    for (int id = blockIdx.x; id < 64 * 32; id += gridDim.x) {
        const int g = id >> 5, mt = (id >> 2) & 7, nt = id & 3;
        f32x4 acc[4][4];
        gemm_tile(ALoadPlain{SST + ((size_t)g * 1024 + mt * 128) * 128, (size_t)128}, VG + ((size_t)g * 512 + nt * 128) * 128, 128, 2, acc, lds);
        const f32x4 dv = *(const f32x4*)(dsk + g * 16 + fq * 4);
#pragma unroll
        for (int mi = 0; mi < 4; ++mi)
#pragma unroll
            for (int ni = 0; ni < 4; ++ni) {
                const int R = mt * 128 + wr * 64 + mi * 16 + fr, c = nt * 128 + wc * 64 + ni * 16 + fq * 4;
                const size_t idx = ((size_t)g * 1024 + R) * 512 + c;
                const u32x2 yi = *(const u32x2*)(YI + idx), uu = *(const u32x2*)(UG + idx);
                const f32x4 v = acc[mi][ni];
                const float y0 = gelu_tanh(v.x + bflo(yi.x) + dv.x * bflo(uu.x)), y1 = gelu_tanh(v.y + bfhi(yi.x) + dv.y * bfhi(uu.x));
                const float y2 = gelu_tanh(v.z + bflo(yi.y) + dv.z * bflo(uu.y)), y3 = gelu_tanh(v.w + bfhi(yi.y) + dv.w * bfhi(uu.y));
                *(u32x2*)(YG + idx) = (u32x2){pk2(y0, y1), pk2(y2, y3)};
            }
    }
}
__device__ void phase_s5_glu(const Params& p, unsigned char* lds) {
    const bf16_t* YG = (const bf16_t*)(p.ws + WS_YG); const bf16_t* WT = (const bf16_t*)(p.ws + WS_WGLU_T);
    const float* MOD = (const float*)(p.ws + WS_MOD);
    const float* X = p.in[0]; float* XO = p.out;
    const int lane = threadIdx.x & 63, wid = threadIdx.x >> 6, wr = wid >> 1, wc = wid & 1, fr = lane & 15, fq = lane >> 4;
    for (int id = blockIdx.x; id < 256 * 16; id += gridDim.x) {
        const int mt = id >> 4, nt = id & 15;
        f32x4 acc[4][4];
        gemm_tile(ALoadGroup{YG + (size_t)mt * 128 * 16}, WT + (size_t)nt * 128 * D, D, 16, acc, lds);
        const int b = (mt * 128) / SEQ;
#pragma unroll
        for (int mi = 0; mi < 4; ++mi)
#pragma unroll
            for (int h = 0; h < 2; ++h) {
                const int t = mt * 128 + wr * 64 + mi * 16 + fr, j = nt * 64 + wc * 32 + h * 16 + fq * 4;
                const f32x4 a = acc[mi][2 * h], gg = acc[mi][2 * h + 1];
                const f32x4 g1 = *(const f32x4*)(MOD + (size_t)(0 * 2 + b) * 6144 + 2048 + j);
                const f32x4 xi = *(const f32x4*)(X + (size_t)t * D + j);
                f32x4 o;
                o.x = xi.x + g1.x * (a.x * sigmoidf_(gg.x)); o.y = xi.y + g1.y * (a.y * sigmoidf_(gg.y));
                o.z = xi.z + g1.z * (a.z * sigmoidf_(gg.z)); o.w = xi.w + g1.w * (a.w * sigmoidf_(gg.w));
                *(f32x4*)(XO + (size_t)t * D + j) = o;
            }
    }
}
__device__ void phase_peer_wq(const Params& p, int layer, unsigned char* lds) {
    const bf16_t* HM = (const bf16_t*)(p.ws + WS_HM); const bf16_t* WT = (const bf16_t*)(p.ws + WS_WQ_T) + (size_t)layer * 2048 * 1024;
    bf16_t* QK = (bf16_t*)(p.ws + WS_QK);
    const int lane = threadIdx.x & 63, wid = threadIdx.x >> 6, wr = wid >> 1, wc = wid & 1, fr = lane & 15, fq = lane >> 4;
    for (int id = blockIdx.x; id < 256 * 16; id += gridDim.x) {
        const int mt = id >> 4, nt = id & 15;
        f32x4 acc[4][4];
        gemm_tile(ALoadPlain{HM + (size_t)mt * 128 * D, (size_t)D}, WT + (size_t)nt * 128 * D, D, 16, acc, lds);
#pragma unroll
        for (int mi = 0; mi < 4; ++mi)
#pragma unroll
            for (int ni = 0; ni < 4; ++ni) {
                const int t = mt * 128 + wr * 64 + mi * 16 + fr, c = nt * 128 + wc * 64 + ni * 16 + fq * 4;
                const f32x4 v = acc[mi][ni];
                *(u32x2*)(QK + (size_t)t * 2048 + c) = (u32x2){pk2(v.x, v.y), pk2(v.z, v.w)};
            }
    }
}
__device__ void phase_peer_topk(const Params& p, int layer, unsigned char* lds) {
    const bf16_t* QK = (const bf16_t*)(p.ws + WS_QK); const bf16_t* SK = (const bf16_t*)(p.ws + WS_SUBK) + (size_t)layer * 8 * 2 * 128 * 128;
    float* TOPS = (float*)(p.ws + WS_TOPS); int* TOPI = (int*)(p.ws + WS_TOPI);
    float* sc = (float*)lds;
    const int tid = threadIdx.x, lane = tid & 63, wid = tid >> 6, wr = wid >> 1, wc = wid & 1, fr = lane & 15, fq = lane >> 4;
    for (int id = blockIdx.x; id < 256 * 16; id += gridDim.x) {
        const int mt = id >> 4, hc = id & 15;
        f32x4 acc[4][4];
        gemm_tile(ALoadPlain{QK + (size_t)mt * 128 * 2048 + hc * 128, (size_t)2048}, SK + (size_t)hc * 128 * 128, 128, 2, acc, lds);
#pragma unroll
        for (int mi = 0; mi < 4; ++mi)
#pragma unroll
            for (int ni = 0; ni < 4; ++ni) {
                const int r = wr * 64 + mi * 16 + fr, c = wc * 64 + ni * 16 + fq * 4;
                float* d = sc + r * 129 + c;
                d[0] = acc[mi][ni].x; d[1] = acc[mi][ni].y; d[2] = acc[mi][ni].z; d[3] = acc[mi][ni].w;
            }
        __syncthreads();
        if (tid < 128) {
            float* row = sc + tid * 129;
            const size_t ob = ((size_t)(mt * 128 + tid) * 16 + hc) * 16;
#pragma unroll 1
            for (int r = 0; r < 16; ++r) {
                float best = row[0]; int bi = 0;
#pragma unroll 8
                for (int k = 1; k < 128; ++k) { const float v = row[k]; if (v > best) { best = v; bi = k; } }
                row[bi] = -3.0e38f;
                TOPS[ob + r] = best; TOPI[ob + r] = bi;
            }
        }
        __syncthreads();
    }
}
__device__ void phase_peer_combine(const Params& p, unsigned char* lds) {
    const float* TOPS = (const float*)(p.ws + WS_TOPS); const int* TOPI = (const int*)(p.ws + WS_TOPI);
    int* EXP = (int*)(p.ws + WS_EXP); float* GATE = (float*)(p.ws + WS_GATE);
    unsigned* L = (unsigned*)lds;
    const int tid = threadIdx.x;
    for (int it = blockIdx.x; it < (T * 8) / 256; it += gridDim.x) {
        const size_t th = (size_t)it * 256 + tid;
        const u32x4* S4 = (const u32x4*)(TOPS + th * 32); const u32x4* I4 = (const u32x4*)(TOPI + th * 32);
#pragma unroll
        for (int a4 = 0; a4 < 8; ++a4) {
            const u32x4 s = S4[a4], i = I4[a4];
            L[(a4 * 4 + 0) * 256 + tid] = s.x; L[(a4 * 4 + 1) * 256 + tid] = s.y; L[(a4 * 4 + 2) * 256 + tid] = s.z; L[(a4 * 4 + 3) * 256 + tid] = s.w;
            L[(32 + a4 * 4 + 0) * 256 + tid] = i.x; L[(32 + a4 * 4 + 1) * 256 + tid] = i.y; L[(32 + a4 * 4 + 2) * 256 + tid] = i.z; L[(32 + a4 * 4 + 3) * 256 + tid] = i.w;
        }
        float val[16];
        const float s20 = __builtin_bit_cast(float, L[16 * 256 + tid]);
#pragma unroll
        for (int a = 0; a < 16; ++a) val[a] = __builtin_bit_cast(float, L[a * 256 + tid]) + s20;
        unsigned long long P = 0ull;
        float ts[16]; int te[16];
#pragma unroll
        for (int r = 0; r < 16; ++r) {
            float best = val[0]; int ba = 0;
#pragma unroll
            for (int a = 1; a < 16; ++a) if (val[a] > best) { best = val[a]; ba = a; }
            const int b = (int)((P >> (4 * ba)) & 15ull);
            const int i1 = (int)L[(32 + ba) * 256 + tid], i2 = (int)L[(48 + b) * 256 + tid];
            ts[r] = best; te[r] = i1 * 128 + i2;
            const int nb = b + 1;
            float newv = -3.0e38f;
            if (nb < 16) { newv = __builtin_bit_cast(float, L[ba * 256 + tid]) + __builtin_bit_cast(float, L[(16 + nb) * 256 + tid]); P += 1ull << (4 * ba); }
#pragma unroll
            for (int a = 0; a < 16; ++a) val[a] = (a == ba) ? newv : val[a];
        }
        const float m0 = ts[0];
        float sum = 0.f;
#pragma unroll
        for (int r = 0; r < 16; ++r) { ts[r] = __expf(ts[r] - m0); sum += ts[r]; }
        const float inv = 1.0f / sum;
#pragma unroll
        for (int r = 0; r < 16; ++r) ts[r] *= inv;
#pragma unroll
        for (int r = 0; r < 16; ++r) { EXP[th * 16 + r] = te[r]; GATE[th * 16 + r] = ts[r]; }
    }
}

__device__ void phase_peer_apply(const Params& p, int layer, unsigned char* lds) {
    const int lane = threadIdx.x & 63, wave = threadIdx.x >> 6;
    float* ldsw = (float*)lds + wave * (64 * 65);
    const bf16_t* HM = (const bf16_t*)(p.ws + WS_HM); const bf16_t* PU = (const bf16_t*)(p.ws + WS_PU); const bf16_t* PV = (const bf16_t*)(p.ws + WS_PV);
    const int* EXP = (const int*)(p.ws + WS_EXP); const float* GATE = (const float*)(p.ws + WS_GATE);
    const float* MOD = (const float*)(p.ws + WS_MOD);
    float* X = p.out;
    for (int t = blockIdx.x * 4 + wave; t < T; t += gridDim.x * 4) {
        const u32x4 ha = *(const u32x4*)(HM + (size_t)t * D + lane * 8), hb = *(const u32x4*)(HM + (size_t)t * D + 512 + lane * 8);
        const int e0 = EXP[(size_t)t * 128 + lane], e1 = EXP[(size_t)t * 128 + 64 + lane];
        const float g0 = GATE[(size_t)t * 128 + lane], g1 = GATE[(size_t)t * 128 + 64 + lane];
        float act0 = 0.f, act1 = 0.f;
#pragma unroll
        for (int half = 0; half < 2; ++half) {
            const int ev = half ? e1 : e0;
#pragma unroll 1
            for (int jg = 0; jg < 8; ++jg) {
                u32x4 ua[8], ub[8];
#pragma unroll
                for (int j = 0; j < 8; ++j) {
                    const int e = __builtin_amdgcn_readlane(ev, jg * 8 + j);
                    const bf16_t* row = PU + (size_t)e * D;
                    ua[j] = *(const u32x4*)(row + lane * 8); ub[j] = *(const u32x4*)(row + 512 + lane * 8);
                }
#pragma unroll
                for (int j = 0; j < 8; ++j) {
                    float s = dot2bf(ua[j].x, ha.x, 0.f); s = dot2bf(ua[j].y, ha.y, s); s = dot2bf(ua[j].z, ha.z, s); s = dot2bf(ua[j].w, ha.w, s);
                    float s2 = dot2bf(ub[j].x, hb.x, 0.f); s2 = dot2bf(ub[j].y, hb.y, s2); s2 = dot2bf(ub[j].z, hb.z, s2); s2 = dot2bf(ub[j].w, hb.w, s2);
                    ldsw[(jg * 8 + j) * 65 + lane] = s + s2;
                }
            }
            float tot = 0.f;
#pragma unroll 16
            for (int k = 0; k < 64; ++k) tot += ldsw[lane * 65 + k];
            const float a = gelu_tanh(tot) * (half ? g1 : g0);
            if (half) act1 = a; else act0 = a;
        }
        float acc[16];
#pragma unroll
        for (int i = 0; i < 16; ++i) acc[i] = 0.f;
#pragma unroll
        for (int half = 0; half < 2; ++half) {
            const int ev = half ? e1 : e0; const float av = half ? act1 : act0;
#pragma unroll 1
            for (int jg = 0; jg < 8; ++jg) {
                u32x4 va[8], vb[8];
#pragma unroll
                for (int j = 0; j < 8; ++j) {
                    const int e = __builtin_amdgcn_readlane(ev, jg * 8 + j);
                    const bf16_t* row = PV + (size_t)e * D;
                    va[j] = *(const u32x4*)(row + lane * 8); vb[j] = *(const u32x4*)(row + 512 + lane * 8);
                }
#pragma unroll
                for (int j = 0; j < 8; ++j) {
                    const float a = __builtin_bit_cast(float, __builtin_amdgcn_readlane(__builtin_bit_cast(int, av), jg * 8 + j));
                    acc[0] += a * bflo(va[j].x); acc[1] += a * bfhi(va[j].x); acc[2] += a * bflo(va[j].y); acc[3] += a * bfhi(va[j].y);
                    acc[4] += a * bflo(va[j].z); acc[5] += a * bfhi(va[j].z); acc[6] += a * bflo(va[j].w); acc[7] += a * bfhi(va[j].w);
                    acc[8] += a * bflo(vb[j].x); acc[9] += a * bfhi(vb[j].x); acc[10] += a * bflo(vb[j].y); acc[11] += a * bfhi(vb[j].y);
                    acc[12] += a * bflo(vb[j].z); acc[13] += a * bfhi(vb[j].z); acc[14] += a * bflo(vb[j].w); acc[15] += a * bfhi(vb[j].w);
                }
            }
        }
        const int b = t / SEQ;
        const float* g2 = MOD + (size_t)(layer * 2 + b) * 6144 + 5120;
        float* xr = X + (size_t)t * D;
#pragma unroll
        for (int hh = 0; hh < 2; ++hh)
#pragma unroll
            for (int q = 0; q < 2; ++q) {
                const int c = hh * 512 + lane * 8 + q * 4;
                const f32x4 g = *(const f32x4*)(g2 + c); f32x4 x = *(const f32x4*)(xr + c);
                x.x += g.x * acc[hh * 8 + q * 4 + 0]; x.y += g.y * acc[hh * 8 + q * 4 + 1]; x.z += g.z * acc[hh * 8 + q * 4 + 2]; x.w += g.w * acc[hh * 8 + q * 4 + 3];
                *(f32x4*)(xr + c) = x;
            }
    }
}
__device__ void phase_tab1(const Params& p) {
    for (int it = blockIdx.x; it < 2 * P0_TAB; it += gridDim.x) {
        if (it < P0_TAB) cvt_item(p.in[26] + (size_t)PE * D, (bf16_t*)(p.ws + WS_PU), it);
        else cvt_item(p.in[27] + (size_t)PE * D, (bf16_t*)(p.ws + WS_PV), it - P0_TAB);
    }
}
__device__ void phase_nsa_proj(const Params& p, unsigned char* lds) {
    const bf16_t* HM = (const bf16_t*)(p.ws + WS_HM); const bf16_t* WT = (const bf16_t*)(p.ws + WS_WPROJ_T);
    const f32x2* ROPE = (const f32x2*)(p.ws + WS_ROPE);
    bf16_t* Q = (bf16_t*)(p.ws + WS_Q); float* NGT = (float*)(p.ws + WS_NG);
    const int lane = threadIdx.x & 63, wid = threadIdx.x >> 6, wr = wid >> 1, wc = wid & 1, fr = lane & 15, fq = lane >> 4;
    for (int id = blockIdx.x; id < 256 * 21; id += gridDim.x) {
        const int mt = id / 21, nt = id % 21;
        f32x4 acc[4][4];
        gemm_tile(ALoadPlain{HM + (size_t)mt * 128 * D, (size_t)D}, WT + (size_t)nt * 128 * D, D, 16, acc, lds);
        const int c0 = nt * 128 + wc * 64;
        if (c0 >= 2624) continue;
        const int b = (mt * 128) / SEQ;
        if (c0 == 2560) {
#pragma unroll
            for (int mi = 0; mi < 4; ++mi)
#pragma unroll
                for (int ni = 0; ni < 3; ++ni) {
                    const int t = mt * 128 + wr * 64 + mi * 16 + fr;
                    const f32x4 v = acc[mi][ni];
                    *(f32x4*)(NGT + (size_t)t * 48 + ni * 16 + fq * 4) = (f32x4){sigmoidf_(v.x), sigmoidf_(v.y), sigmoidf_(v.z), sigmoidf_(v.w)};
                }
            continue;
        }
        int sec = -1, g = 0;
        if (c0 >= 1024) { sec = (c0 - 1024) >> 8; g = ((c0 - 1024) & 255) >> 6; }
        const bool dorope = (sec == -1) || (sec == 2) || (sec == 4);
        const float scl = (sec == -1) ? 0.125f : 1.0f;
        const size_t secoff[6] = {WS_KC, WS_VC, WS_KS, WS_VST, WS_KW, WS_VWT};
        size_t so = WS_Q;
#pragma unroll
        for (int q = 0; q < 6; ++q) if (sec == q) so = secoff[q];
        bf16_t* OUT = (bf16_t*)(p.ws + so);
        const bool vt = (sec == 3) || (sec == 5);
#pragma unroll
        for (int mi = 0; mi < 4; ++mi) {
            const int t = mt * 128 + wr * 64 + mi * 16 + fr, s = t - b * SEQ;
            if (dorope) {
#pragma unroll
                for (int ni = 0; ni < 2; ++ni) {
                    const f32x4* rp = (const f32x4*)(ROPE + (size_t)s * 32 + ni * 16 + fq * 4);
                    const f32x4 r0 = rp[0], r1 = rp[1];
                    const f32x4 x1 = acc[mi][ni], x2 = acc[mi][ni + 2];
                    acc[mi][ni] = (f32x4){x1.x * r0.x - x2.x * r0.y, x1.y * r0.z - x2.y * r0.w, x1.z * r1.x - x2.z * r1.y, x1.w * r1.z - x2.w * r1.w};
                    acc[mi][ni + 2] = (f32x4){x1.x * r0.y + x2.x * r0.x, x1.y * r0.w + x2.y * r0.z, x1.z * r1.y + x2.z * r1.x, x1.w * r1.w + x2.w * r1.z};
                }
            }
#pragma unroll
            for (int ni = 0; ni < 4; ++ni) {
                const f32x4 v = acc[mi][ni] * scl;
                const int d = ni * 16 + fq * 4;
                if (sec == -1) {
                    *(u32x2*)(OUT + (size_t)t * 1024 + c0 + d) = (u32x2){pk2(v.x, v.y), pk2(v.z, v.w)};
                } else if (!vt) {
                    *(u32x2*)(OUT + ((size_t)(b * 4 + g) * SEQ + s) * 64 + d) = (u32x2){pk2(v.x, v.y), pk2(v.z, v.w)};
                } else {
                    bf16_t* o = OUT + ((size_t)(b * 4 + g) * 64 + d) * SEQ + s;
                    o[0] = (bf16_t)f2bf(v.x); o[SEQ] = (bf16_t)f2bf(v.y); o[2 * SEQ] = (bf16_t)f2bf(v.z); o[3 * SEQ] = (bf16_t)f2bf(v.w);
                }
            }
        }
    }
}
__device__ void phase_nsa_cmp1(const Params& p, unsigned char* lds) {
    bf16_t* HID = (bf16_t*)(p.ws + WS_HID);
    const float* bias = (const float*)(p.ws + WS_MISC);
    const int lane = threadIdx.x & 63, wid = threadIdx.x >> 6, wr = wid >> 1, wc = wid & 1, fr = lane & 15, fq = lane >> 4;
    for (int id = blockIdx.x; id < 256; id += gridDim.x) {
        const int kv = id >> 7, bg = (id >> 4) & 7, mt = (id >> 1) & 7, nt = id & 1;
        const bf16_t* A = (const bf16_t*)(p.ws + (kv ? WS_VC : WS_KC)) + (size_t)bg * SEQ * 64 + (size_t)mt * 128 * 1024;
        const bf16_t* B = (const bf16_t*)(p.ws + (kv ? WS_WV1_T : WS_WK1_T)) + (size_t)nt * 128 * 2048;
        f32x4 acc[4][4];
        gemm_tile(ALoadPlain{A, (size_t)1024}, B, 2048, 32, acc, lds);
#pragma unroll
        for (int mi = 0; mi < 4; ++mi)
#pragma unroll
            for (int ni = 0; ni < 4; ++ni) {
                const int n = mt * 128 + wr * 64 + mi * 16 + fr, c = nt * 128 + wc * 64 + ni * 16 + fq * 4;
                const f32x4 bv = *(const f32x4*)(bias + kv * 256 + c);
                const f32x4 v = acc[mi][ni] + bv;
                *(u32x2*)(HID + (((size_t)kv * 8 + bg) * 1024 + n) * 256 + c) = (u32x2){pk2(gelu_tanh(v.x), gelu_tanh(v.y)), pk2(gelu_tanh(v.z), gelu_tanh(v.w))};
            }
    }
}
__device__ void phase_nsa_cmp2(const Params& p, unsigned char* lds) {
    const bf16_t* HID = (const bf16_t*)(p.ws + WS_HID);
    const f32x2* ROPE = (const f32x2*)(p.ws + WS_ROPE);
    bf16_t* KCMP = (bf16_t*)(p.ws + WS_KCMP); bf16_t* VCMPT = (bf16_t*)(p.ws + WS_VCMPT);
    const int lane = threadIdx.x & 63, wid = threadIdx.x >> 6, wr = wid >> 1, wc = wid & 1, fr = lane & 15, fq = lane >> 4;
    for (int id = blockIdx.x; id < 128; id += gridDim.x) {
        const int kv = id >> 6, mt = id & 63;
        const bf16_t* A = HID + ((size_t)kv * 8192 + (size_t)mt * 128) * 256;
        const bf16_t* B = (const bf16_t*)(p.ws + (kv ? WS_WV2_T : WS_WK2_T));
        f32x4 acc[4][4];
        gemm_tile(ALoadPlain{A, (size_t)256}, B, 256, 4, acc, lds);
        if (wc == 1) continue;
#pragma unroll
        for (int mi = 0; mi < 4; ++mi) {
            const int R = mt * 128 + wr * 64 + mi * 16 + fr, bg = R >> 10, n = R & 1023;
            if (kv == 0) {
                int pos = n * 16 + 31; pos = pos > SEQ - 1 ? SEQ - 1 : pos;
#pragma unroll
                for (int ni = 0; ni < 2; ++ni) {
                    const f32x4* rp = (const f32x4*)(ROPE + (size_t)pos * 32 + ni * 16 + fq * 4);
                    const f32x4 r0 = rp[0], r1 = rp[1];
                    const f32x4 x1 = acc[mi][ni], x2 = acc[mi][ni + 2];
                    acc[mi][ni] = (f32x4){x1.x * r0.x - x2.x * r0.y, x1.y * r0.z - x2.y * r0.w, x1.z * r1.x - x2.z * r1.y, x1.w * r1.z - x2.w * r1.w};
                    acc[mi][ni + 2] = (f32x4){x1.x * r0.y + x2.x * r0.x, x1.y * r0.w + x2.y * r0.z, x1.z * r1.y + x2.z * r1.x, x1.w * r1.w + x2.w * r1.z};
                }
#pragma unroll
                for (int ni = 0; ni < 4; ++ni) {
                    const f32x4 v = acc[mi][ni];
                    *(u32x2*)(KCMP + ((size_t)bg * 1024 + n) * 64 + ni * 16 + fq * 4) = (u32x2){pk2(v.x, v.y), pk2(v.z, v.w)};
                }
            } else {
#pragma unroll
                for (int ni = 0; ni < 4; ++ni) {
                    const f32x4 v = acc[mi][ni];
                    bf16_t* o = VCMPT + ((size_t)bg * 64 + ni * 16 + fq * 4) * 1024 + n;
                    o[0] = (bf16_t)f2bf(v.x); o[1024] = (bf16_t)f2bf(v.y); o[2048] = (bf16_t)f2bf(v.z); o[3072] = (bf16_t)f2bf(v.w);
                }
            }
        }
    }
}
__device__ void phase_nsa_wo(const Params& p, unsigned char* lds) {
    const bf16_t* O = (const bf16_t*)(p.ws + WS_O); const bf16_t* WT = (const bf16_t*)(p.ws + WS_WO_T);
    const float* MOD = (const float*)(p.ws + WS_MOD);
    float* X = p.out;
    const int lane = threadIdx.x & 63, wid = threadIdx.x >> 6, wr = wid >> 1, wc = wid & 1, fr = lane & 15, fq = lane >> 4;
    for (int id = blockIdx.x; id < 256 * 8; id += gridDim.x) {
        const int mt = id >> 3, nt = id & 7;
        f32x4 acc[4][4];
        gemm_tile(ALoadPlain{O + (size_t)mt * 128 * D, (size_t)D}, WT + (size_t)nt * 128 * D, D, 16, acc, lds);
        const int b = (mt * 128) / SEQ;
#pragma unroll
        for (int mi = 0; mi < 4; ++mi)
#pragma unroll
            for (int ni = 0; ni < 4; ++ni) {
                const int t = mt * 128 + wr * 64 + mi * 16 + fr, c = nt * 128 + wc * 64 + ni * 16 + fq * 4;
                const f32x4 g1 = *(const f32x4*)(MOD + (size_t)(1 * 2 + b) * 6144 + 2048 + c);
                float* xp = X + (size_t)t * D + c;
                const f32x4 x = *(const f32x4*)xp; const f32x4 v = acc[mi][ni];
                *(f32x4*)xp = (f32x4){x.x + g1.x * v.x, x.y + g1.y * v.y, x.z + g1.z * v.z, x.w + g1.w * v.w};
            }
    }
}
__device__ __forceinline__ bf16x8 pack8(const f32x4 a, const f32x4 b) {
    u32x4 w; w.x = pk2(a.x, a.y); w.y = pk2(a.z, a.w); w.z = pk2(b.x, b.y); w.w = pk2(b.z, b.w);
    return __builtin_bit_cast(bf16x8, w);
}
__device__ __forceinline__ bf16x8 ldv8(const bf16_t* plo, const bf16_t* phi) {
    const u32x2 lo = *(const u32x2*)plo, hi = *(const u32x2*)phi;
    u32x4 w; w.x = lo.x; w.y = lo.y; w.z = hi.x; w.w = hi.y;
    return __builtin_bit_cast(bf16x8, w);
}
__device__ __forceinline__ float red4(float v) { v += __shfl_xor(v, 16); v += __shfl_xor(v, 32); return v; }
__device__ __forceinline__ float max4(float v) { v = fmaxf(v, __shfl_xor(v, 16)); v = fmaxf(v, __shfl_xor(v, 32)); return v; }
#define NEGBIG (-1.0e30f)

__device__ void phase_nsa_attn(const Params& p, unsigned char* lds) {
    const int lane = threadIdx.x & 63, wave = threadIdx.x >> 6, fr = lane & 15, fq = lane >> 4;
    float* IMP = (float*)(lds + wave * 18432);
    int* SEL = (int*)(lds + wave * 18432 + 16640);
    const bf16_t* Q = (const bf16_t*)(p.ws + WS_Q);
    const bf16_t* KCMP = (const bf16_t*)(p.ws + WS_KCMP); const bf16_t* VCMPT = (const bf16_t*)(p.ws + WS_VCMPT);
    const bf16_t* KS = (const bf16_t*)(p.ws + WS_KS); const bf16_t* VST = (const bf16_t*)(p.ws + WS_VST);
    const bf16_t* KW = (const bf16_t*)(p.ws + WS_KW); const bf16_t* VWT = (const bf16_t*)(p.ws + WS_VWT);
    const float* NGT = (const float*)(p.ws + WS_NG);
    bf16_t* O = (bf16_t*)(p.ws + WS_O);
    const f32x4 z4 = (f32x4){0.f, 0.f, 0.f, 0.f};
    for (int bi = blockIdx.x; bi < 2048; bi += gridDim.x) {
        const int bg = bi & 7, quad = 255 - (bi >> 3), t0 = (quad * 4 + wave) * 16, b = bg >> 2, g = bg & 3;
        const int cur = t0 >> 6;
        const size_t tok = (size_t)b * SEQ + t0 + fr;
        const int tq = t0 + fr;
        bf16x8 qf[4][2];
#pragma unroll
        for (int r = 0; r < 4; ++r)
#pragma unroll
            for (int ks = 0; ks < 2; ++ks) qf[r][ks] = *(const bf16x8*)(Q + tok * 1024 + (g * 4 + r) * 64 + ks * 32 + fq * 8);

        const int nmax_tile = (t0 >> 4) - 1, nmax_lane = (t0 >> 4) - 2 + (fr == 15 ? 1 : 0);
        const bf16_t* kcb = KCMP + (size_t)bg * 1024 * 64; const bf16_t* vcb = VCMPT + (size_t)bg * 64 * 1024;
        float mc[4], lc[4];
#pragma unroll
        for (int r = 0; r < 4; ++r) { mc[r] = NEGBIG; lc[r] = 0.f; }
        for (int nb = 0; nb <= nmax_tile; nb += 32) {
            bf16x8 kf[2][2];
#pragma unroll
            for (int f = 0; f < 2; ++f)
#pragma unroll
                for (int ks = 0; ks < 2; ++ks) kf[f][ks] = *(const bf16x8*)(kcb + (size_t)(nb + f * 16 + fr) * 64 + ks * 32 + fq * 8);
#pragma unroll
            for (int r = 0; r < 4; ++r) {
                f32x4 st[2];
#pragma unroll
                for (int f = 0; f < 2; ++f) {
                    st[f] = __builtin_amdgcn_mfma_f32_16x16x32_bf16(kf[f][0], qf[r][0], z4, 0, 0, 0);
                    st[f] = __builtin_amdgcn_mfma_f32_16x16x32_bf16(kf[f][1], qf[r][1], st[f], 0, 0, 0);
                }
                float mx = NEGBIG;
#pragma unroll
                for (int f = 0; f < 2; ++f)
#pragma unroll
                    for (int e = 0; e < 4; ++e) { const int n = nb + f * 16 + fq * 4 + e; if (n <= nmax_lane) mx = fmaxf(mx, st[f][e]); }
                mx = max4(mx);
                const float mn = fmaxf(mc[r], mx);
                float ps = 0.f;
#pragma unroll
                for (int f = 0; f < 2; ++f)
#pragma unroll
                    for (int e = 0; e < 4; ++e) { const int n = nb + f * 16 + fq * 4 + e; if (n <= nmax_lane) ps += __expf(st[f][e] - mn); }
                lc[r] = lc[r] * __expf(mc[r] - mn) + ps; mc[r] = mn;
                __builtin_amdgcn_sched_barrier(0);
            }
        }
        float invl[4];
#pragma unroll
        for (int r = 0; r < 4; ++r) { const float l = red4(lc[r]); invl[r] = l > 0.f ? 1.0f / l : 0.f; }
        for (int i = lane; i < 16 * 260; i += 64) IMP[i] = 0.f;
        f32x4 oc[4][4];
#pragma unroll
        for (int r = 0; r < 4; ++r)
#pragma unroll
            for (int df = 0; df < 4; ++df) oc[r][df] = z4;
        float carry = 0.f;
        for (int nb = 0; nb <= nmax_tile; nb += 32) {
            bf16x8 kf[2][2];
#pragma unroll
            for (int f = 0; f < 2; ++f)
#pragma unroll
                for (int ks = 0; ks < 2; ++ks) kf[f][ks] = *(const bf16x8*)(kcb + (size_t)(nb + f * 16 + fr) * 64 + ks * 32 + fq * 8);
            bf16x8 vf[4];
#pragma unroll
            for (int df = 0; df < 4; ++df) { const bf16_t* vp = vcb + (size_t)(df * 16 + fr) * 1024 + nb + 4 * fq; vf[df] = ldv8(vp, vp + 16); }
            f32x4 pg[2] = {z4, z4};
#pragma unroll
            for (int r = 0; r < 4; ++r) {
                f32x4 st[2];
#pragma unroll
                for (int f = 0; f < 2; ++f) {
                    st[f] = __builtin_amdgcn_mfma_f32_16x16x32_bf16(kf[f][0], qf[r][0], z4, 0, 0, 0);
                    st[f] = __builtin_amdgcn_mfma_f32_16x16x32_bf16(kf[f][1], qf[r][1], st[f], 0, 0, 0);
#pragma unroll
                    for (int e = 0; e < 4; ++e) { const int n = nb + f * 16 + fq * 4 + e; st[f][e] = (n <= nmax_lane) ? __expf(st[f][e] - mc[r]) * invl[r] : 0.f; }
                    pg[f] += st[f];
                }
                const bf16x8 pf = pack8(st[0], st[1]);
#pragma unroll
                for (int df = 0; df < 4; ++df) oc[r][df] = __builtin_amdgcn_mfma_f32_16x16x32_bf16(vf[df], pf, oc[r][df], 0, 0, 0);
                __builtin_amdgcn_sched_barrier(0);
            }
            const int src = (lane - 16) & 63;
            const float s0 = __shfl(pg[0].w, src), s1 = __shfl(pg[1].w, src), sc = __shfl(carry, src);
            const float prev0 = fq > 0 ? s0 : sc, prev1 = fq > 0 ? s1 : s0;
            const float imp0 = (pg[0].x + pg[0].y) + (pg[0].z + pg[0].w) + prev0;
            const float imp1 = (pg[1].x + pg[1].y) + (pg[1].z + pg[1].w) + prev1;
            const int jb = (nb >> 2) + fq;
            IMP[fr * 260 + jb] = imp0; IMP[fr * 260 + jb + 4] = imp1;
            carry = pg[1].w;
        }
        {
            const int nf = cur >= 2 ? 3 : cur + 1;
            if (fq == 0) {
                SEL[fr * 16 + 0] = 0;
                if (cur == 1) SEL[fr * 16 + 1] = 1;
                if (cur >= 2) { SEL[fr * 16 + 1] = cur - 1; SEL[fr * 16 + 2] = cur; }
            }
            const int ncand = cur >= 3 ? cur - 2 : 0, extra = 16 - nf;
            if (ncand <= extra) {
                if (fq == 0) { for (int k = 0; k < extra; ++k) SEL[fr * 16 + nf + k] = (k < ncand) ? 1 + k : -1; }
            } else {
                for (int rnd = 0; rnd < extra; ++rnd) {
                    float bv = -1.0f; int bj = 1 << 20;
                    for (int jb = 1 + fq; jb <= cur - 2; jb += 4) { const float v = IMP[fr * 260 + jb]; if (v > bv) { bv = v; bj = jb; } }
#pragma unroll
                    for (int o = 16; o <= 32; o <<= 1) {
                        const float ov = __shfl_xor(bv, o); const int oj = __shfl_xor(bj, o);
                        if (ov > bv || (ov == bv && oj < bj)) { bv = ov; bj = oj; }
                    }
                    if (fq == 0) SEL[fr * 16 + nf + rnd] = bj;
                    if (((bj - 1) & 3) == fq) IMP[fr * 260 + bj] = -2.0f;
                }
            }
        }
        float* ACC = IMP;
        float gc[4], gs[4], gw[4];
#pragma unroll
        for (int r = 0; r < 4; ++r) { const float* gp = NGT + tok * 48 + (g * 4 + r) * 3; gc[r] = gp[0]; gs[r] = gp[1]; gw[r] = gp[2]; }
        (void)gs;
#pragma unroll
        for (int r = 0; r < 4; ++r)
#pragma unroll
            for (int df = 0; df < 4; ++df) *(f32x4*)(ACC + (fr * 4 + r) * 64 + df * 16 + fq * 4) = oc[r][df] * gc[r];
        {
            const bf16_t* kwb = KW + (size_t)bg * SEQ * 64; const bf16_t* vwb = VWT + (size_t)bg * 64 * SEQ;
            float mw[4], lw[4];
            f32x4 ow[4][4];
#pragma unroll
            for (int r = 0; r < 4; ++r) { mw[r] = NEGBIG; lw[r] = 0.f;
#pragma unroll
                for (int df = 0; df < 4; ++df) ow[r][df] = z4; }
            int kmin = t0 - 511; kmin = kmin < 0 ? 0 : kmin; kmin &= ~31;
            for (int kb = kmin; kb <= t0 + 15; kb += 32) {
                bf16x8 kf[2][2];
#pragma unroll
                for (int f = 0; f < 2; ++f)
#pragma unroll
                    for (int ks = 0; ks < 2; ++ks) kf[f][ks] = *(const bf16x8*)(kwb + (size_t)(kb + f * 16 + fr) * 64 + ks * 32 + fq * 8);
                bf16x8 vf[4];
#pragma unroll
                for (int df = 0; df < 4; ++df) { const bf16_t* vp = vwb + (size_t)(df * 16 + fr) * SEQ + kb + 4 * fq; vf[df] = ldv8(vp, vp + 16); }
#pragma unroll
                for (int r = 0; r < 4; ++r) {
                    f32x4 st[2];
#pragma unroll
                    for (int f = 0; f < 2; ++f) {
                        st[f] = __builtin_amdgcn_mfma_f32_16x16x32_bf16(kf[f][0], qf[r][0], z4, 0, 0, 0);
                        st[f] = __builtin_amdgcn_mfma_f32_16x16x32_bf16(kf[f][1], qf[r][1], st[f], 0, 0, 0);
                    }
                    float mx = NEGBIG;
#pragma unroll
                    for (int f = 0; f < 2; ++f)
#pragma unroll
                        for (int e = 0; e < 4; ++e) { const int key = kb + f * 16 + fq * 4 + e; const bool ok = (key <= tq) && (key > tq - 512); if (ok) mx = fmaxf(mx, st[f][e]); }
                    mx = max4(mx);
                    const float mn = fmaxf(mw[r], mx);
                    const float al = __expf(mw[r] - mn);
                    float ps = 0.f;
#pragma unroll
                    for (int f = 0; f < 2; ++f)
#pragma unroll
                        for (int e = 0; e < 4; ++e) { const int key = kb + f * 16 + fq * 4 + e; const bool ok = (key <= tq) && (key > tq - 512); const float pv = ok ? __expf(st[f][e] - mn) : 0.f; st[f][e] = pv; ps += pv; }
                    lw[r] = lw[r] * al + ps; mw[r] = mn;
                    const bf16x8 pf = pack8(st[0], st[1]);
#pragma unroll
                    for (int df = 0; df < 4; ++df) { ow[r][df] = ow[r][df] * al; ow[r][df] = __builtin_amdgcn_mfma_f32_16x16x32_bf16(vf[df], pf, ow[r][df], 0, 0, 0); }
                    __builtin_amdgcn_sched_barrier(0);
                }
            }
#pragma unroll
            for (int r = 0; r < 4; ++r) {
                const float l = red4(lw[r]); const float sc = gw[r] / l;
#pragma unroll
                for (int df = 0; df < 4; ++df) { f32x4* ap = (f32x4*)(ACC + (fr * 4 + r) * 64 + df * 16 + fq * 4); *ap = *ap + ow[r][df] * sc; }
            }
        }
        {
            const bf16_t* ksb = KS + (size_t)bg * SEQ * 64; const bf16_t* vsb = VST + (size_t)bg * 64 * SEQ;
            const int rr = fr & 3;
            for (int i = 0; i < 16; ++i) {
                const int ti = t0 + i;
                const size_t tk = (size_t)b * SEQ + ti;
                bf16x8 qs[2];
#pragma unroll
                for (int ks = 0; ks < 2; ++ks) qs[ks] = *(const bf16x8*)(Q + tk * 1024 + (g * 4 + rr) * 64 + ks * 32 + fq * 8);
                float ms = NEGBIG, ls = 0.f;
                f32x4 os[4] = {z4, z4, z4, z4};
                for (int k = 0; k < 16; ++k) {
                    const int jb = __builtin_amdgcn_readfirstlane(SEL[i * 16 + k]);
                    if (jb < 0) continue;
#pragma unroll
                    for (int s2 = 0; s2 < 2; ++s2) {
                        const int kb = jb * 64 + s2 * 32;
                        bf16x8 kf[2][2];
#pragma unroll
                        for (int f = 0; f < 2; ++f)
#pragma unroll
                            for (int ks = 0; ks < 2; ++ks) kf[f][ks] = *(const bf16x8*)(ksb + (size_t)(kb + f * 16 + fr) * 64 + ks * 32 + fq * 8);
                        bf16x8 vf[4];
#pragma unroll
                        for (int df = 0; df < 4; ++df) { const bf16_t* vp = vsb + (size_t)(df * 16 + fr) * SEQ + kb + 4 * fq; vf[df] = ldv8(vp, vp + 16); }
                        f32x4 st[2];
#pragma unroll
                        for (int f = 0; f < 2; ++f) {
                            st[f] = __builtin_amdgcn_mfma_f32_16x16x32_bf16(kf[f][0], qs[0], z4, 0, 0, 0);
                            st[f] = __builtin_amdgcn_mfma_f32_16x16x32_bf16(kf[f][1], qs[1], st[f], 0, 0, 0);
                        }
                        float mx = NEGBIG;
#pragma unroll
                        for (int f = 0; f < 2; ++f)
#pragma unroll
                            for (int e = 0; e < 4; ++e) { const int key = kb + f * 16 + fq * 4 + e; if (key <= ti) mx = fmaxf(mx, st[f][e]); }
                        mx = max4(mx);
                        const float mn = fmaxf(ms, mx);
                        const float al = __expf(ms - mn);
                        float ps = 0.f;
#pragma unroll
                        for (int f = 0; f < 2; ++f)
#pragma unroll
                            for (int e = 0; e < 4; ++e) { const int key = kb + f * 16 + fq * 4 + e; const float pv = (key <= ti) ? __expf(st[f][e] - mn) : 0.f; st[f][e] = pv; ps += pv; }
                        ls = ls * al + ps; ms = mn;
                        const bf16x8 pf = pack8(st[0], st[1]);
#pragma unroll
                        for (int df = 0; df < 4; ++df) { os[df] = os[df] * al; os[df] = __builtin_amdgcn_mfma_f32_16x16x32_bf16(vf[df], pf, os[df], 0, 0, 0); }
                    }
                }
                const float l = red4(ls);
                if (fr < 4) {
                    const float gsv = NGT[tk * 48 + (g * 4 + fr) * 3 + 1];
                    const float sc = gsv / l;
#pragma unroll
                    for (int df = 0; df < 4; ++df) { f32x4* ap = (f32x4*)(ACC + (i * 4 + fr) * 64 + df * 16 + fq * 4); *ap = *ap + os[df] * sc; }
                }
            }
        }
#pragma unroll
        for (int r = 0; r < 4; ++r)
#pragma unroll
            for (int df = 0; df < 4; ++df) {
                const f32x4 v = *(const f32x4*)(ACC + (fr * 4 + r) * 64 + df * 16 + fq * 4);
                *(u32x2*)(O + tok * 1024 + (g * 4 + r) * 64 + df * 16 + fq * 4) = (u32x2){pk2(v.x, v.y), pk2(v.z, v.w)};
            }
    }
}
constexpr int NPHASES = 24;
__global__ void __launch_bounds__(NTHREADS, 2) mega(Params p) {
    __shared__ __attribute__((aligned(16))) unsigned char lds[LDS_BYTES];
    cg::grid_group grid = cg::this_grid();
    const float* MOD = (const float*)(p.ws + WS_MOD);
    bf16_t* HM = (bf16_t*)(p.ws + WS_HM);
    const int lo = p.ph_lo, hi = p.ph_hi;
#define PHASE(k, call) if (lo <= (k) && (k) < hi) { call; if ((k) + 1 < hi) grid.sync(); }
    PHASE(0, phase_prep(p, (float*)lds))
    PHASE(1, phase_norm(p, p.in[0], p.in[2], MOD + 0, MOD + 1024, HM))
    PHASE(2, phase_s5_win(p, lds))
    PHASE(3, phase_s5_a(p, lds))
    PHASE(4, phase_s5_scan(p))
    PHASE(5, phase_s5_b(p, lds))
    PHASE(6, phase_s5_glu(p, lds))
    PHASE(7, phase_norm(p, p.out, p.in[3], MOD + 3072, MOD + 4096, HM))
    PHASE(8, phase_peer_wq(p, 0, lds))
    PHASE(9, phase_peer_topk(p, 0, lds))
    PHASE(10, phase_peer_combine(p, lds))
    PHASE(11, phase_peer_apply(p, 0, lds))
    PHASE(12, (phase_norm(p, p.out, p.in[2] + D, MOD + 2 * 6144 + 0, MOD + 2 * 6144 + 1024, HM), phase_tab1(p)))
    PHASE(13, phase_nsa_proj(p, lds))
    PHASE(14, phase_nsa_cmp1(p, lds))
    PHASE(15, phase_nsa_cmp2(p, lds))
    PHASE(16, phase_nsa_attn(p, lds))
    PHASE(17, phase_nsa_wo(p, lds))
    PHASE(18, phase_norm(p, p.out, p.in[3] + D, MOD + 2 * 6144 + 3072, MOD + 2 * 6144 + 4096, HM))
    PHASE(19, phase_peer_wq(p, 1, lds))
    PHASE(20, phase_peer_topk(p, 1, lds))
    PHASE(21, phase_peer_combine(p, lds))
    PHASE(22, phase_peer_apply(p, 1, lds))
    PHASE(23, phase_final_norm(p, p.out, p.out))
#undef PHASE
}

extern "C" void kernel_launch(void* const* d_in, const int* in_sizes, int n_in, void* d_out, int out_size, void* d_ws, size_t ws_size, hipStream_t stream) {
    static int grid_blocks = 0;
    if (!grid_blocks) {
        int dev = 0, cus = 0, per_cu = 0;
        hipGetDevice(&dev);
        hipDeviceGetAttribute(&cus, hipDeviceAttributeMultiprocessorCount, dev);
        hipOccupancyMaxActiveBlocksPerMultiprocessor(&per_cu, mega, NTHREADS, 0);
        if (per_cu > 2) per_cu = 2;
        if (per_cu < 1) per_cu = 1;
        grid_blocks = cus * per_cu;
        if (ws_size < WS_END) fprintf(stderr, "kernel_launch: workspace too small: %zu < %zu\n", ws_size, (size_t)WS_END);
        if (n_in != 29) fprintf(stderr, "kernel_launch: expected 29 inputs, got %d\n", n_in);
    }
    Params p{};
    for (int i = 0; i < 29; ++i) p.in[i] = (const float*)d_in[i];
    p.out = (float*)d_out; p.ws = (unsigned char*)d_ws;
#if SINGLE_LAUNCH
    p.ph_lo = 0; p.ph_hi = NPHASES;
    void* args[] = {&p};
    hipError_t e = hipLaunchCooperativeKernel((void*)mega, dim3(grid_blocks), dim3(NTHREADS), args, 0, stream);
    if (e != hipSuccess) fprintf(stderr, "cooperative launch failed: %s (grid %d)\n", hipGetErrorString(e), grid_blocks);
#else
    for (int ph = 0; ph < NPHASES; ++ph) {
        p.ph_lo = ph; p.ph_hi = ph + 1;
        hipLaunchKernelGGL(mega, dim3(grid_blocks), dim3(NTHREADS), 0, stream, p);
    }
#endif
}
```

```cpp
#include <hip/hip_runtime.h>
#include <hip/hip_cooperative_groups.h>
#include <cstdio>
#include <cstdint>
namespace cg = cooperative_groups;

#ifndef SINGLE_LAUNCH
#define SINGLE_LAUNCH 1
#endif

typedef unsigned short bf16_t;
typedef short bf16x8 __attribute__((ext_vector_type(8)));
typedef float f32x4 __attribute__((ext_vector_type(4)));
typedef float f32x2 __attribute__((ext_vector_type(2)));
typedef unsigned u32x4 __attribute__((ext_vector_type(4)));
typedef unsigned u32x2 __attribute__((ext_vector_type(2)));
typedef __bf16 bf16x2_t __attribute__((ext_vector_type(2)));

constexpr int D = 1024, BATCH = 2, SEQ = 16384, T = BATCH * SEQ;
constexpr int NTHREADS = 256;
constexpr float RMS_EPS = 1e-6f;
constexpr int S5G = 64, S5P = 64, S5L = 32, S5NCH = T / S5L  , S5CPB = SEQ / S5L  ;
constexpr int NH = 16, HD = 64, NG = 4, NPROJ = 2608, NPROJ_PAD = 2688, NC = 1023, NSB = 256;
constexpr int PH = 8, PK = 16, PNK = 128, PE = 16384;

constexpr size_t MiB = 1ull << 20;
constexpr size_t WS_CTL = 0;
constexpr size_t WS_MOD = 1 * MiB;
constexpr size_t WS_WIN_T = 2 * MiB;
constexpr size_t WS_WGLU_T = 4 * MiB;
constexpr size_t WS_WPROJ_T = 8 * MiB;
constexpr size_t WS_WK1_T = 14 * MiB;
constexpr size_t WS_WV1_T = 15 * MiB;
constexpr size_t WS_WK2_T = 16 * MiB;
constexpr size_t WS_WV2_T = 16 * MiB + 512 * 1024;
constexpr size_t WS_WO_T = 17 * MiB;
constexpr size_t WS_WQ_T = 19 * MiB;
constexpr size_t WS_SUBK = 27 * MiB;
constexpr size_t WS_ROPE = 28 * MiB;
constexpr size_t WS_MISC = 32 * MiB;
constexpr size_t WS_TW = 33 * MiB;
constexpr size_t WS_VG = 73 * MiB;
constexpr size_t WS_PU = 82 * MiB;
constexpr size_t WS_PV = 114 * MiB;
constexpr size_t WS_HM = 146 * MiB;
constexpr size_t WS_C = 210 * MiB;
constexpr size_t WS_UG = WS_C;
constexpr size_t WS_YI = WS_C + 64 * MiB;
constexpr size_t WS_WST = WS_C + 128 * MiB;
constexpr size_t WS_SST = WS_C + 160 * MiB;
constexpr size_t WS_YG = WS_C + 176 * MiB;
constexpr size_t WS_QK = WS_C;
constexpr size_t WS_TOPS = WS_C + 128 * MiB;
constexpr size_t WS_TOPI = WS_C + 160 * MiB;
constexpr size_t WS_EXP = WS_C + 192 * MiB;
constexpr size_t WS_GATE = WS_C + 208 * MiB;
constexpr size_t WS_Q = WS_C;
constexpr size_t WS_KC = WS_C + 64 * MiB;
constexpr size_t WS_VC = WS_C + 81 * MiB;
constexpr size_t WS_KS = WS_C + 98 * MiB;
constexpr size_t WS_VST = WS_C + 114 * MiB;
constexpr size_t WS_KW = WS_C + 130 * MiB;
constexpr size_t WS_VWT = WS_C + 146 * MiB;
constexpr size_t WS_NG = WS_C + 162 * MiB;
constexpr size_t WS_KCMP = WS_C + 170 * MiB;
constexpr size_t WS_VCMPT = WS_C + 171 * MiB;
constexpr size_t WS_HID = WS_C + 172 * MiB;
constexpr size_t WS_O = WS_C + 182 * MiB;
constexpr size_t WS_END = WS_C + 256 * MiB;

constexpr int LDS_BYTES = 73728;

struct Params {
    const float* in[29];
    float* out;
    unsigned char* ws;
    int ph_lo, ph_hi;
};

__device__ __forceinline__ unsigned f2bf(float f) { unsigned u = __builtin_bit_cast(unsigned, f); return (u + 0x7fffu + ((u >> 16) & 1u)) >> 16; }
__device__ __forceinline__ unsigned pk2(float lo, float hi) { return f2bf(lo) | (f2bf(hi) << 16); }
__device__ __forceinline__ float bf2f(unsigned h) { return __builtin_bit_cast(float, h << 16); }
__device__ __forceinline__ float bflo(unsigned w) { return __builtin_bit_cast(float, w << 16); }
__device__ __forceinline__ float bfhi(unsigned w) { return __builtin_bit_cast(float, w & 0xffff0000u); }
__device__ __forceinline__ float gelu_tanh(float x) {
    const float u = 0.7978845608028654f * (x + 0.044715f * x * x * x);
    const float e = __expf(2.0f * u);
    const float th = 1.0f - 2.0f / (e + 1.0f);
    return 0.5f * x * (1.0f + th);
}
__device__ __forceinline__ float sigmoidf_(float x) { return 1.0f / (1.0f + __expf(-x)); }
__device__ __forceinline__ float wave_sum(float v) {
#pragma unroll
    for (int o = 1; o < 64; o <<= 1) v += __shfl_xor(v, o);
    return v;
}
__device__ __forceinline__ float dot2bf(unsigned a, unsigned b, float acc) {
    return __builtin_amdgcn_fdot2_f32_bf16(__builtin_bit_cast(bf16x2_t, a), __builtin_bit_cast(bf16x2_t, b), acc, false);
}

#define LAS __attribute__((address_space(3)))
#define XB_TMO      128
#define XB_XCNT(j)  (256  + 64 * (j))
#define XB_XSUB(j)  (1280 + 64 * (j))
#define XB_XGEN(j)  (2304 + 64 * (j))
#define XB_TOP      3328
#define XB_TOPGEN   3392
#define XCD_BAR_WORDS 3456
#define XB_SPIN_CAP (1u << 24)

__device__ __forceinline__ unsigned xb_ld(unsigned* p)              { return __hip_atomic_load(p, __ATOMIC_RELAXED, __HIP_MEMORY_SCOPE_AGENT); }
__device__ __forceinline__ unsigned xb_add(unsigned* p, unsigned v) { return __hip_atomic_fetch_add(p, v, __ATOMIC_RELAXED, __HIP_MEMORY_SCOPE_AGENT); }
__device__ __forceinline__ unsigned xb_xcc_id() { return (unsigned)__builtin_amdgcn_s_getreg((3 << 11) | 20) & 0xFu; }
#define XB_SPIN(cond, bar) do { unsigned _sp = 0; while (cond) { __builtin_amdgcn_s_sleep(1); \
    if ((++_sp & 255u) == 0u) { if (xb_ld(&(bar)[XB_TMO])) break; if (_sp > XB_SPIN_CAP) { atomicAdd(&(bar)[XB_TMO], 1u); break; } } } } while (0)

struct XcdBarrier {
    unsigned* bar; unsigned x;
    volatile LAS unsigned* st;
};

__device__ __forceinline__ XcdBarrier xcd_barrier_post(unsigned* bar, volatile LAS unsigned* st) {
    XcdBarrier b; b.bar = bar; b.x = xb_xcc_id(); b.st = st;
    if (threadIdx.x == 0) (void)xb_add(&bar[XB_XCNT(b.x)], 1u);
    return b;
}
__device__ __forceinline__ void xcd_barrier_complete(unsigned* bar, unsigned x, unsigned& nloc, unsigned& nx) {
    const unsigned G = gridDim.x * gridDim.y * gridDim.z;
    unsigned sum, cnt, mine, sp = 0u;
    for (;;) {
        sum = 0u; cnt = 0u; mine = 0u;
#pragma unroll
        for (unsigned j = 0; j < 16; ++j) { const unsigned c = xb_ld(&bar[XB_XCNT(j)]); sum += c; cnt += (c > 0u) ? 1u : 0u; mine = (j == x) ? c : mine; }
        if (sum == G) break;
        __builtin_amdgcn_s_sleep(1);
        if ((++sp & 255u) == 0u) { if (xb_ld(&bar[XB_TMO])) break; if (sp > XB_SPIN_CAP) { atomicAdd(&bar[XB_TMO], 1u); break; } }
    }
    nloc = mine > 0u ? mine : 1u; nx = cnt > 0u ? cnt : 1u;
}

__device__ __forceinline__ void xcd_barrier(const XcdBarrier& b) {
    asm volatile("s_waitcnt vmcnt(0)" ::: "memory");
    __syncthreads();
    if (threadIdx.x == 0) {
        unsigned* bar = b.bar;
        __builtin_amdgcn_s_waitcnt(0);
        unsigned nloc = b.st[0], nx = b.st[1];
        if (nloc == 0u) { xcd_barrier_complete(bar, b.x, nloc, nx); b.st[0] = nloc; b.st[1] = nx; }
        const unsigned old = xb_add(&bar[XB_XSUB(b.x)], 1u);
        const unsigned gen = old / nloc;
        if (old + 1u == (gen + 1u) * nloc) {
            __builtin_amdgcn_fence(__ATOMIC_RELEASE, "agent");
            asm volatile("s_waitcnt vmcnt(0)" ::: "memory");
            const unsigned og = xb_add(&bar[XB_TOP], 1u);
            const unsigned tg = og / nx;
            if (og + 1u == (tg + 1u) * nx) xb_add(&bar[XB_TOPGEN], 1u);
            else XB_SPIN(xb_ld(&bar[XB_TOPGEN]) == tg, bar);
            __builtin_amdgcn_fence(__ATOMIC_ACQUIRE, "agent");
            xb_add(&bar[XB_XGEN(b.x)], 1u);
            asm volatile("s_waitcnt vmcnt(0)" ::: "memory");
        } else {
            XB_SPIN(xb_ld(&bar[XB_XGEN(b.x)]) == gen, bar);
            __builtin_amdgcn_fence(__ATOMIC_ACQUIRE, "agent");
            asm volatile("s_waitcnt vmcnt(0)" ::: "memory");
        }
    }
    __syncthreads();
}
__device__ __forceinline__ void prep_mod_item(const Params& p, int item, float* lds) {
    const int layer = item / 192, cg0 = (item % 192) * 32;
    const int tid = threadIdx.x, col = cg0 + (tid & 31), kg = tid >> 5;
    const float* W = p.in[4] + (size_t)layer * D * 6 * D;
    const float* c = p.in[1];
    float a0 = 0.f, a1 = 0.f;
    for (int k = kg * 128; k < kg * 128 + 128; ++k) {
        const float w = W[(size_t)k * (6 * D) + col];
        const float c0 = c[k], c1 = c[D + k];
        a0 += w * (c0 * sigmoidf_(c0));
        a1 += w * (c1 * sigmoidf_(c1));
    }
    lds[tid] = a0; lds[256 + tid] = a1;
    __syncthreads();
    if (tid < 64) {
        const int b = tid >> 5, cc = tid & 31;
        float s = 0.f;
#pragma unroll
        for (int g = 0; g < 8; ++g) s += lds[b * 256 + g * 32 + cc];
        float* MOD = (float*)(p.ws + WS_MOD);
        MOD[(size_t)(layer * 2 + b) * 6144 + cg0 + cc] = s + p.in[5][(size_t)layer * 6144 + cg0 + cc];
    }
    __syncthreads();
}

template <int MODE>
__device__ __forceinline__ void prep_transpose_item(const float* W, int K, int N, bf16_t* WT, int item, float* lds) {
    const int nbn = (N + 63) / 64, kb = item / nbn, nb = item % nbn, k0 = kb * 64, n0 = nb * 64;
    const int tid = threadIdx.x;
#pragma unroll
    for (int i = 0; i < 16; ++i) {
        const int kk = (tid >> 6) + 4 * i, nn = tid & 63;
        const float v = (n0 + nn < N) ? W[(size_t)(k0 + kk) * N + n0 + nn] : 0.f;
        lds[kk * 65 + nn] = v;
    }
    __syncthreads();
    {
        const int nn = tid >> 2, ks = (tid & 3) * 16;
        const int n = n0 + nn;
        if (n < N) {
            int np = n;
            if (MODE == 1) { const int j = (n < 1024) ? n : n - 1024; np = (j >> 4) * 32 + (j & 15) + ((n < 1024) ? 0 : 16); }
            u32x4 o0, o1;
            const float* s = lds + nn;
            o0.x = pk2(s[(ks + 0) * 65], s[(ks + 1) * 65]); o0.y = pk2(s[(ks + 2) * 65], s[(ks + 3) * 65]);
            o0.z = pk2(s[(ks + 4) * 65], s[(ks + 5) * 65]); o0.w = pk2(s[(ks + 6) * 65], s[(ks + 7) * 65]);
            o1.x = pk2(s[(ks + 8) * 65], s[(ks + 9) * 65]); o1.y = pk2(s[(ks + 10) * 65], s[(ks + 11) * 65]);
            o1.z = pk2(s[(ks + 12) * 65], s[(ks + 13) * 65]); o1.w = pk2(s[(ks + 14) * 65], s[(ks + 15) * 65]);
            u32x4* dst = (u32x4*)(WT + (size_t)np * K + k0 + ks);
            dst[0] = o0; dst[1] = o1;
        }
    }
    __syncthreads();
}

__device__ __forceinline__ void cvt_item(const float* src, bf16_t* dst, int item) {
    const size_t base = (size_t)item * 8192 + threadIdx.x * 8;
#pragma unroll
    for (int i = 0; i < 4; ++i) {
        const size_t o = base + (size_t)i * 2048;
        const f32x4 a = *(const f32x4*)(src + o), b = *(const f32x4*)(src + o + 4);
        u32x4 w; w.x = pk2(a.x, a.y); w.y = pk2(a.z, a.w); w.z = pk2(b.x, b.y); w.w = pk2(b.z, b.w);
        *(u32x4*)(dst + o) = w;
    }
}
__device__ __forceinline__ void zero_item(bf16_t* dst, int item) {
    const size_t base = (size_t)item * 8192 + threadIdx.x * 8;
#pragma unroll
    for (int i = 0; i < 4; ++i) *(u32x4*)(dst + base + (size_t)i * 2048) = (u32x4){0u, 0u, 0u, 0u};
}

struct cpx { float re, im; };
__device__ __forceinline__ cpx cmul(cpx a, cpx b) { return {a.re * b.re - a.im * b.im, a.re * b.im + a.im * b.re}; }
__device__ __forceinline__ cpx cexp_pow(float are, float aim, float dt, int m) {
    const float mag = __expf(are * dt * (float)m);
    const double rev = (double)aim * (double)dt * (double)m * 0.15915494309189535;
    const float fr = (float)(rev - rint(rev));
    return {mag * __builtin_amdgcn_cosf(fr), mag * __builtin_amdgcn_sinf(fr)};
}
__device__ __forceinline__ cpx s5_coef(float are, float aim, float dt) {
    cpx ab = cexp_pow(are, aim, dt, 1);
    const float nr = ab.re - 1.0f, ni = ab.im, den = are * are + aim * aim;
    return {(nr * are + ni * aim) / den, (ni * are - nr * aim) / den};
}

__device__ __forceinline__ void prep_s5_T_item(const Params& p, int item) {
    const int gid = item * 256 + threadIdx.x;
    const int g = gid >> 9, m = (gid >> 4) & 31, i = gid & 15;
    const float* a_re = p.in[7] + g * 64; const float* a_im = p.in[8] + g * 64;
    const float dt = __expf(p.in[9][g]);
    const float* b_re = p.in[10] + (size_t)g * 64 * 16; const float* b_im = p.in[11] + (size_t)g * 64 * 16;
    const float* c_re = p.in[12] + (size_t)g * 16 * 64 + i * 64; const float* c_im = p.in[13] + (size_t)g * 16 * 64 + i * 64;
    float acc[16];
#pragma unroll
    for (int j = 0; j < 16; ++j) acc[j] = 0.f;
    for (int q = 0; q < 64; ++q) {
        const float are = a_re[q], aim = a_im[q];
        cpx z = cmul(cmul({c_re[q], c_im[q]}, cexp_pow(are, aim, dt, m)), s5_coef(are, aim, dt));
        const f32x4* br = (const f32x4*)(b_re + q * 16); const f32x4* bi = (const f32x4*)(b_im + q * 16);
#pragma unroll
        for (int j4 = 0; j4 < 4; ++j4) {
            const f32x4 r = br[j4], im = bi[j4];
            acc[j4 * 4 + 0] += z.re * r.x - z.im * im.x; acc[j4 * 4 + 1] += z.re * r.y - z.im * im.y;
            acc[j4 * 4 + 2] += z.re * r.z - z.im * im.z; acc[j4 * 4 + 3] += z.re * r.w - z.im * im.w;
        }
    }
    u32x4 o0, o1;
    o0.x = pk2(acc[0], acc[1]); o0.y = pk2(acc[2], acc[3]); o0.z = pk2(acc[4], acc[5]); o0.w = pk2(acc[6], acc[7]);
    o1.x = pk2(acc[8], acc[9]); o1.y = pk2(acc[10], acc[11]); o1.z = pk2(acc[12], acc[13]); o1.w = pk2(acc[14], acc[15]);
    bf16_t* TW = (bf16_t*)(p.ws + WS_TW) + (size_t)g * 640 * 512;
    const u32x4 z4 = (u32x4){0u, 0u, 0u, 0u};
    for (int lp = 0; lp + m < 32; ++lp) {
        u32x4* d = (u32x4*)(TW + (size_t)((lp + m) * 16 + i) * 512 + lp * 16);
        d[0] = o0; d[1] = o1;
        if (m > 0) { u32x4* dz = (u32x4*)(TW + (size_t)(lp * 16 + i) * 512 + (lp + m) * 16); dz[0] = z4; dz[1] = z4; }
    }
}
__device__ __forceinline__ void prep_s5_W_item(const Params& p, int item) {
    const int gid = item * 256 + threadIdx.x;
    const int g = gid >> 11, q = (gid >> 5) & 63, lp = gid & 31;
    const float are = p.in[7][g * 64 + q], aim = p.in[8][g * 64 + q];
    const float dt = __expf(p.in[9][g]);
    const cpx z = cmul(cexp_pow(are, aim, dt, 31 - lp), s5_coef(are, aim, dt));
    const float* br = p.in[10] + ((size_t)g * 64 + q) * 16; const float* bi = p.in[11] + ((size_t)g * 64 + q) * 16;
    float wr[16], wi[16];
#pragma unroll
    for (int j = 0; j < 16; ++j) { wr[j] = z.re * br[j] - z.im * bi[j]; wi[j] = z.re * bi[j] + z.im * br[j]; }
    bf16_t* TW = (bf16_t*)(p.ws + WS_TW) + (size_t)g * 640 * 512;
    u32x4* d0 = (u32x4*)(TW + (size_t)(512 + q) * 512 + lp * 16);
    u32x4* d1 = (u32x4*)(TW + (size_t)(576 + q) * 512 + lp * 16);
    d0[0] = (u32x4){pk2(wr[0], wr[1]), pk2(wr[2], wr[3]), pk2(wr[4], wr[5]), pk2(wr[6], wr[7])};
    d0[1] = (u32x4){pk2(wr[8], wr[9]), pk2(wr[10], wr[11]), pk2(wr[12], wr[13]), pk2(wr[14], wr[15])};
    d1[0] = (u32x4){pk2(wi[0], wi[1]), pk2(wi[2], wi[3]), pk2(wi[4], wi[5]), pk2(wi[6], wi[7])};
    d1[1] = (u32x4){pk2(wi[8], wi[9]), pk2(wi[10], wi[11]), pk2(wi[12], wi[13]), pk2(wi[14], wi[15])};
}
__device__ __forceinline__ void prep_s5_V_item(const Params& p, int item) {
    const int gid = item * 256 + threadIdx.x;
    const int g = gid >> 14, l = (gid >> 9) & 31, i = (gid >> 5) & 15, q0 = (gid & 31) * 2;
    const float dt = __expf(p.in[9][g]);
    float vr[2], vi[2];
#pragma unroll
    for (int e = 0; e < 2; ++e) {
        const int q = q0 + e;
        const cpx z = cmul({p.in[12][((size_t)g * 16 + i) * 64 + q], p.in[13][((size_t)g * 16 + i) * 64 + q]}, cexp_pow(p.in[7][g * 64 + q], p.in[8][g * 64 + q], dt, l + 1));
        vr[e] = z.re; vi[e] = -z.im;
    }
    bf16_t* VG = (bf16_t*)(p.ws + WS_VG) + ((size_t)g * 512 + l * 16 + i) * 128;
    *(unsigned*)(VG + q0) = pk2(vr[0], vr[1]);
    *(unsigned*)(VG + 64 + q0) = pk2(vi[0], vi[1]);
}
__device__ __forceinline__ void prep_al_item(const Params& p, int item) {
    const int gid = item * 256 + threadIdx.x;
    const int g = gid >> 6;
    const float dt = __expf(p.in[9][g]);
    const cpx z = cexp_pow(p.in[7][gid], p.in[8][gid], dt, S5L);
    f32x2* AL = (f32x2*)(p.ws + WS_MISC + 4096);
    AL[gid] = (f32x2){z.re, z.im};
}
__device__ __forceinline__ void prep_rope_item(const Params& p, int item) {
    const int gid = item * 256 + threadIdx.x;
    const int pos = gid >> 5, j = gid & 31;
    const float freq = exp2f(-(float)j * (13.287712379549449f / 32.0f));
    const float ang = (float)pos * freq;
    const double rev = (double)ang * 0.15915494309189535;
    const float fr = (float)(rev - rint(rev));
    f32x2* R = (f32x2*)(p.ws + WS_ROPE);
    R[gid] = (f32x2){__builtin_amdgcn_cosf(fr), __builtin_amdgcn_sinf(fr)};
}
__device__ __forceinline__ void prep_cmpbias_item(const Params& p, int item) {
    const float* pe = p.in[17 + item]; const float* w1 = p.in[item == 0 ? 19 : 21];
    const int j = threadIdx.x;
    float s = 0.f;
    for (int k = 0; k < 2048; ++k) s += pe[k] * w1[(size_t)k * 256 + j];
    ((float*)(p.ws + WS_MISC))[item * 256 + j] = s;
}

constexpr int P0_MOD = 384;
constexpr int P0_T_WIN = 16 * 16, P0_T_WGLU = 16 * 32, P0_T_WPROJ = 16 * 41, P0_T_WK1 = 32 * 4, P0_T_WK2 = 4 * 1, P0_T_WO = 16 * 16, P0_T_WQ = 16 * 32;
constexpr int P0_SUBK = (2 * 8 * 2 * 128 * 128) / 8192;
constexpr int P0_TAB = (PE * D) / 8192;
constexpr int P0_S5T = 128, P0_S5W = 512, P0_S5V = 4096, P0_AL = 16, P0_ROPE = 2048, P0_CB = 2, P0_ZERO = 10 + 2;

__device__ __forceinline__ void phase_prep(const Params& p, float* lds) {
    const int n0 = P0_MOD;
    const int n1 = n0 + P0_T_WIN, n2 = n1 + P0_T_WGLU, n3 = n2 + P0_T_WPROJ, n4 = n3 + P0_T_WK1, n5 = n4 + P0_T_WK1, n6 = n5 + P0_T_WK2, n7 = n6 + P0_T_WK2,
              n8 = n7 + P0_T_WO, n9 = n8 + P0_T_WQ, n10 = n9 + P0_T_WQ, n11 = n10 + P0_SUBK, n12 = n11 + P0_TAB, n13 = n12 + P0_TAB,
              n14 = n13 + P0_S5T, n15 = n14 + P0_S5W, n16 = n15 + P0_S5V, n17 = n16 + P0_AL, n18 = n17 + P0_ROPE, n19 = n18 + P0_CB, n20 = n19 + 10, n21 = n20 + 2, n22 = n21 + 2;
    unsigned char* ws = p.ws;
    for (int it = blockIdx.x; it < n22; it += gridDim.x) {
        if (it < n0) prep_mod_item(p, it, lds);
        else if (it < n1) prep_transpose_item<0>(p.in[6], 1024, 1024, (bf16_t*)(ws + WS_WIN_T), it - n0, lds);
        else if (it < n2) prep_transpose_item<1>(p.in[15], 1024, 2048, (bf16_t*)(ws + WS_WGLU_T), it - n1, lds);
        else if (it < n3) prep_transpose_item<0>(p.in[16], 1024, NPROJ, (bf16_t*)(ws + WS_WPROJ_T), it - n2, lds);
        else if (it < n4) prep_transpose_item<0>(p.in[19], 2048, 256, (bf16_t*)(ws + WS_WK1_T), it - n3, lds);
        else if (it < n5) prep_transpose_item<0>(p.in[21], 2048, 256, (bf16_t*)(ws + WS_WV1_T), it - n4, lds);
        else if (it < n6) prep_transpose_item<0>(p.in[20], 256, 64, (bf16_t*)(ws + WS_WK2_T), it - n5, lds);
        else if (it < n7) prep_transpose_item<0>(p.in[22], 256, 64, (bf16_t*)(ws + WS_WV2_T), it - n6, lds);
        else if (it < n8) prep_transpose_item<0>(p.in[23], 1024, 1024, (bf16_t*)(ws + WS_WO_T), it - n7, lds);
        else if (it < n9) prep_transpose_item<0>(p.in[24], 1024, 2048, (bf16_t*)(ws + WS_WQ_T), it - n8, lds);
        else if (it < n10) prep_transpose_item<0>(p.in[24] + (size_t)1024 * 2048, 1024, 2048, (bf16_t*)(ws + WS_WQ_T) + (size_t)2048 * 1024, it - n9, lds);
        else if (it < n11) cvt_item(p.in[25], (bf16_t*)(ws + WS_SUBK), it - n10);
        else if (it < n12) cvt_item(p.in[26], (bf16_t*)(ws + WS_PU), it - n11);
        else if (it < n13) cvt_item(p.in[27], (bf16_t*)(ws + WS_PV), it - n12);
        else if (it < n14) prep_s5_T_item(p, it - n13);
        else if (it < n15) prep_s5_W_item(p, it - n14);
        else if (it < n16) prep_s5_V_item(p, it - n15);
        else if (it < n17) prep_al_item(p, it - n16);
        else if (it < n18) prep_rope_item(p, it - n17);
        else if (it < n19) prep_cmpbias_item(p, it - n18);
        else if (it < n20) zero_item((bf16_t*)(ws + WS_WPROJ_T) + (size_t)NPROJ * 1024, it - n19);
        else if (it < n21) zero_item((bf16_t*)(ws + WS_WK2_T) + (size_t)64 * 256, it - n20);
        else zero_item((bf16_t*)(ws + WS_WV2_T) + (size_t)64 * 256, it - n21);
    }
}

__device__ __forceinline__ void phase_norm(const Params& p, const float* X, const float* gw, const float* shift, const float* scale  , bf16_t* HM) {
    const int lane = threadIdx.x & 63, wave = threadIdx.x >> 6;
    for (int row = blockIdx.x * 4 + wave; row < T; row += gridDim.x * 4) {
        const int b = row / SEQ;
        const f32x4* xr = (const f32x4*)(X + (size_t)row * D) + lane;
        f32x4 v[4]; float s = 0.f;
#pragma unroll
        for (int j = 0; j < 4; ++j) { v[j] = xr[64 * j]; s += (v[j].x * v[j].x + v[j].y * v[j].y) + (v[j].z * v[j].z + v[j].w * v[j].w); }
        const float rs = rsqrtf(wave_sum(s) * (1.0f / D) + RMS_EPS);
        u32x2* o = (u32x2*)(HM + (size_t)row * D) + lane;
#pragma unroll
        for (int j = 0; j < 4; ++j) {
            const int c = lane * 4 + 256 * j;
            const f32x4 g = *(const f32x4*)(gw + c), sh = *(const f32x4*)(shift + (size_t)b * 6144 + c), sc = *(const f32x4*)(scale + (size_t)b * 6144 + c);
            const float y0 = v[j].x * rs * g.x * (1.f + sc.x) + sh.x, y1 = v[j].y * rs * g.y * (1.f + sc.y) + sh.y;
            const float y2 = v[j].z * rs * g.z * (1.f + sc.z) + sh.z, y3 = v[j].w * rs * g.w * (1.f + sc.w) + sh.w;
            o[64 * j] = (u32x2){pk2(y0, y1), pk2(y2, y3)};
        }
    }
}
__device__ __forceinline__ void phase_final_norm(const Params& p, const float* X, float* OUT, bool dry) {
    const int lane = threadIdx.x & 63, wave = threadIdx.x >> 6;
    const float* gw = p.in[28];
    for (int row = blockIdx.x * 4 + wave; row < T; row += gridDim.x * 4) {
        const f32x4* xr = (const f32x4*)(X + (size_t)row * D) + lane;
        f32x4 v[4]; float s = 0.f;
#pragma unroll
        for (int j = 0; j < 4; ++j) { v[j] = xr[64 * j]; s += (v[j].x * v[j].x + v[j].y * v[j].y) + (v[j].z * v[j].z + v[j].w * v[j].w); }
        const float rs = rsqrtf(wave_sum(s) * (1.0f / D) + RMS_EPS);
        f32x4* o = (f32x4*)(OUT + (size_t)row * D) + lane;
#pragma unroll
        for (int j = 0; j < 4; ++j) {
            const f32x4 g = *(const f32x4*)(gw + lane * 4 + 256 * j);
            if (!dry) o[64 * j] = (f32x4){v[j].x * rs * g.x, v[j].y * rs * g.y, v[j].z * rs * g.z, v[j].w * rs * g.w};
        }
    }
}

struct ALoadPlain {
    const bf16_t* A; size_t lda;
    __device__ __forceinline__ const bf16_t* ptr(int r, int k) const { return A + (size_t)r * lda + k; }
};
struct ALoadGroup {
    const bf16_t* A;
    __device__ __forceinline__ const bf16_t* ptr(int r, int k) const { return A + ((size_t)(k >> 4) * T + r) * 16 + (k & 15); }
};

template <class AL>
__device__ __forceinline__ void gemm_tile(const AL al, const bf16_t* __restrict__ Bt, size_t ldb, int nk, f32x4 (&acc)[4][4], unsigned char* lds) {
    const int tid = threadIdx.x, lane = tid & 63, wid = tid >> 6, wr = wid >> 1, wc = wid & 1, fr = lane & 15, fq = lane >> 4;
    const int lr = tid >> 3, lc = tid & 7;
#pragma unroll
    for (int mi = 0; mi < 4; ++mi)
#pragma unroll
        for (int ni = 0; ni < 4; ++ni) acc[mi][ni] = (f32x4){0.f, 0.f, 0.f, 0.f};
    u32x4 ra[4], rb[4];
    const int soff = lr * 128 + ((lc ^ (lr & 7)) << 4);
#pragma unroll
    for (int i = 0; i < 4; ++i) { ra[i] = *(const u32x4*)al.ptr(lr + 32 * i, lc * 8); rb[i] = *(const u32x4*)(Bt + (size_t)(lr + 32 * i) * ldb + lc * 8); }
#pragma unroll
    for (int i = 0; i < 4; ++i) { *(u32x4*)(lds + soff + i * 4096) = ra[i]; *(u32x4*)(lds + 16384 + soff + i * 4096) = rb[i]; }
    __syncthreads();
    const int aoff = (wr * 64 + fr) * 128, boff = 16384 + (wc * 64 + fr) * 128, sw = fr & 7;
    for (int kt = 0; kt < nk; ++kt) {
        const bool more = (kt + 1 < nk);
        if (more) {
#pragma unroll
            for (int i = 0; i < 4; ++i) { ra[i] = *(const u32x4*)al.ptr(lr + 32 * i, (kt + 1) * 64 + lc * 8); rb[i] = *(const u32x4*)(Bt + (size_t)(lr + 32 * i) * ldb + (kt + 1) * 64 + lc * 8); }
        }
        const unsigned char* buf = lds + (kt & 1) * 32768;
#pragma unroll
        for (int ks = 0; ks < 2; ++ks) {
            bf16x8 af[4], bfr[4];
            const int co = ((ks * 4 + fq) ^ sw) << 4;
#pragma unroll
            for (int mi = 0; mi < 4; ++mi) af[mi] = *(const bf16x8*)(buf + aoff + mi * 2048 + co);
#pragma unroll
            for (int ni = 0; ni < 4; ++ni) bfr[ni] = *(const bf16x8*)(buf + boff + ni * 2048 + co);
#pragma unroll
            for (int mi = 0; mi < 4; ++mi)
#pragma unroll
                for (int ni = 0; ni < 4; ++ni) acc[mi][ni] = __builtin_amdgcn_mfma_f32_16x16x32_bf16(bfr[ni], af[mi], acc[mi][ni], 0, 0, 0);
        }
        if (more) {
            unsigned char* nb = lds + ((kt + 1) & 1) * 32768;
#pragma unroll
            for (int i = 0; i < 4; ++i) { *(u32x4*)(nb + soff + i * 4096) = ra[i]; *(u32x4*)(nb + 16384 + soff + i * 4096) = rb[i]; }
        }
        __syncthreads();
    }
}
__device__ __forceinline__ void phase_s5_win(const Params& p, unsigned char* lds) {
    const bf16_t* HM = (const bf16_t*)(p.ws + WS_HM); const bf16_t* WT = (const bf16_t*)(p.ws + WS_WIN_T);
    bf16_t* UG = (bf16_t*)(p.ws + WS_UG);
    const int lane = threadIdx.x & 63, wid = threadIdx.x >> 6, wr = wid >> 1, wc = wid & 1, fr = lane & 15, fq = lane >> 4;
    for (int id = blockIdx.x; id < 256 * 8; id += gridDim.x) {
        const int mt = id >> 3, nt = id & 7;
        f32x4 acc[4][4];
        gemm_tile(ALoadPlain{HM + (size_t)mt * 128 * D, (size_t)D}, WT + (size_t)nt * 128 * D, D, 16, acc, lds);
#pragma unroll
        for (int mi = 0; mi < 4; ++mi)
#pragma unroll
            for (int ni = 0; ni < 4; ++ni) {
                const int t = mt * 128 + wr * 64 + mi * 16 + fr, g = nt * 8 + wc * 4 + ni;
                const f32x4 v = acc[mi][ni];
                *(u32x2*)(UG + ((size_t)g * T + t) * 16 + fq * 4) = (u32x2){pk2(v.x, v.y), pk2(v.z, v.w)};
            }
    }
}
__device__ __forceinline__ void phase_s5_a(const Params& p, unsigned char* lds) {
    const bf16_t* UG = (const bf16_t*)(p.ws + WS_UG); const bf16_t* TW = (const bf16_t*)(p.ws + WS_TW);
    bf16_t* YI = (bf16_t*)(p.ws + WS_YI); float* WST = (float*)(p.ws + WS_WST);
    const int lane = threadIdx.x & 63, wid = threadIdx.x >> 6, wr = wid >> 1, wc = wid & 1, fr = lane & 15, fq = lane >> 4;
    for (int id = blockIdx.x; id < 64 * 40; id += gridDim.x) {
        const int g = id / 40, rem = id % 40, mt = rem / 5, nt = rem % 5;
        const int nk = (nt < 4) ? 2 * (nt + 1) : 8;
        f32x4 acc[4][4];
        gemm_tile(ALoadPlain{UG + (size_t)g * T * 16 + (size_t)mt * 128 * 512, (size_t)512}, TW + ((size_t)g * 640 + nt * 128) * 512, 512, nk, acc, lds);
#pragma unroll
        for (int mi = 0; mi < 4; ++mi)
#pragma unroll
            for (int ni = 0; ni < 4; ++ni) {
                const int R = mt * 128 + wr * 64 + mi * 16 + fr, c = wc * 64 + ni * 16 + fq * 4;
                const f32x4 v = acc[mi][ni];
                if (nt < 4) *(u32x2*)(YI + ((size_t)g * 1024 + R) * 512 + nt * 128 + c) = (u32x2){pk2(v.x, v.y), pk2(v.z, v.w)};
                else *(f32x4*)(WST + ((size_t)g * 1024 + R) * 128 + c) = v;
            }
    }
}
__device__ __forceinline__ void phase_s5_scan(const Params& p) {
    const int lane = threadIdx.x & 63, wave = threadIdx.x >> 6;
    const float* WST = (const float*)(p.ws + WS_WST); bf16_t* SST = (bf16_t*)(p.ws + WS_SST);
    const f32x2* AL = (const f32x2*)(p.ws + WS_MISC + 4096);
    for (int it = blockIdx.x * 4 + wave; it < 128; it += gridDim.x * 4) {
        const int b = it >> 6, g = it & 63;
        const f32x2 al = AL[g * 64 + lane];
        float sr = 0.f, si = 0.f;
        const float* wbase = WST + ((size_t)g * 1024 + b * 512) * 128 + lane;
        bf16_t* sbase = SST + ((size_t)g * 1024 + b * 512) * 128 + lane;
        for (int n0 = 0; n0 < 512; n0 += 16) {
            float wre[16], wim[16];
#pragma unroll
            for (int j = 0; j < 16; ++j) { wre[j] = wbase[(size_t)(n0 + j) * 128]; wim[j] = wbase[(size_t)(n0 + j) * 128 + 64]; }
#pragma unroll
            for (int j = 0; j < 16; ++j) {
                sbase[(size_t)(n0 + j) * 128] = (bf16_t)f2bf(sr); sbase[(size_t)(n0 + j) * 128 + 64] = (bf16_t)f2bf(si);
                const float nr = al.x * sr - al.y * si + wre[j], ni = al.x * si + al.y * sr + wim[j];
                sr = nr; si = ni;
            }
        }
    }
}
__device__ __forceinline__ void phase_s5_b(const Params& p, unsigned char* lds) {
    const bf16_t* SST = (const bf16_t*)(p.ws + WS_SST); const bf16_t* VG = (const bf16_t*)(p.ws + WS_VG);
    const bf16_t* YI = (const bf16_t*)(p.ws + WS_YI); const bf16_t* UG = (const bf16_t*)(p.ws + WS_UG);
    bf16_t* YG = (bf16_t*)(p.ws + WS_YG);
    const float* dsk = p.in[14];
    const int lane = threadIdx.x & 63, wid = threadIdx.x >> 6, wr = wid >> 1, wc = wid & 1, fr = lane & 15, fq = lane >> 4;
    for (int id = blockIdx.x; id < 64 * 32; id += gridDim.x) {
        const int g = id >> 5, mt = (id >> 2) & 7, nt = id & 3;
        f32x4 acc[4][4];
        gemm_tile(ALoadPlain{SST + ((size_t)g * 1024 + mt * 128) * 128, (size_t)128}, VG + ((size_t)g * 512 + nt * 128) * 128, 128, 2, acc, lds);
        const f32x4 dv = *(const f32x4*)(dsk + g * 16 + fq * 4);
#pragma unroll
        for (int mi = 0; mi < 4; ++mi)
#pragma unroll
            for (int ni = 0; ni < 4; ++ni) {
                const int R = mt * 128 + wr * 64 + mi * 16 + fr, c = nt * 128 + wc * 64 + ni * 16 + fq * 4;
                const size_t idx = ((size_t)g * 1024 + R) * 512 + c;
                const u32x2 yi = *(const u32x2*)(YI + idx), uu = *(const u32x2*)(UG + idx);
                const f32x4 v = acc[mi][ni];
                const float y0 = gelu_tanh(v.x + bflo(yi.x) + dv.x * bflo(uu.x)), y1 = gelu_tanh(v.y + bfhi(yi.x) + dv.y * bfhi(uu.x));
                const float y2 = gelu_tanh(v.z + bflo(yi.y) + dv.z * bflo(uu.y)), y3 = gelu_tanh(v.w + bfhi(yi.y) + dv.w * bfhi(uu.y));
                *(u32x2*)(YG + idx) = (u32x2){pk2(y0, y1), pk2(y2, y3)};
            }
    }
}
__device__ __forceinline__ void phase_s5_glu(const Params& p, unsigned char* lds) {
    const bf16_t* YG = (const bf16_t*)(p.ws + WS_YG); const bf16_t* WT = (const bf16_t*)(p.ws + WS_WGLU_T);
    const float* MOD = (const float*)(p.ws + WS_MOD);
    const float* X = p.in[0]; float* XO = p.out;
    const int lane = threadIdx.x & 63, wid = threadIdx.x >> 6, wr = wid >> 1, wc = wid & 1, fr = lane & 15, fq = lane >> 4;
    for (int id = blockIdx.x; id < 256 * 16; id += gridDim.x) {
        const int mt = id >> 4, nt = id & 15;
        f32x4 acc[4][4];
        gemm_tile(ALoadGroup{YG + (size_t)mt * 128 * 16}, WT + (size_t)nt * 128 * D, D, 16, acc, lds);
        const int b = (mt * 128) / SEQ;
#pragma unroll
        for (int mi = 0; mi < 4; ++mi)
#pragma unroll
            for (int h = 0; h < 2; ++h) {
                const int t = mt * 128 + wr * 64 + mi * 16 + fr, j = nt * 64 + wc * 32 + h * 16 + fq * 4;
                const f32x4 a = acc[mi][2 * h], gg = acc[mi][2 * h + 1];
                const f32x4 g1 = *(const f32x4*)(MOD + (size_t)(0 * 2 + b) * 6144 + 2048 + j);
                const f32x4 xi = *(const f32x4*)(X + (size_t)t * D + j);
                f32x4 o;
                o.x = xi.x + g1.x * (a.x * sigmoidf_(gg.x)); o.y = xi.y + g1.y * (a.y * sigmoidf_(gg.y));
                o.z = xi.z + g1.z * (a.z * sigmoidf_(gg.z)); o.w = xi.w + g1.w * (a.w * sigmoidf_(gg.w));
                *(f32x4*)(XO + (size_t)t * D + j) = o;
            }
    }
}
__device__ __forceinline__ void phase_peer_wq(const Params& p, int layer, unsigned char* lds) {
    const bf16_t* HM = (const bf16_t*)(p.ws + WS_HM); const bf16_t* WT = (const bf16_t*)(p.ws + WS_WQ_T) + (size_t)layer * 2048 * 1024;
    bf16_t* QK = (bf16_t*)(p.ws + WS_QK);
    const int lane = threadIdx.x & 63, wid = threadIdx.x >> 6, wr = wid >> 1, wc = wid & 1, fr = lane & 15, fq = lane >> 4;
    for (int id = blockIdx.x; id < 256 * 16; id += gridDim.x) {
        const int mt = id >> 4, nt = id & 15;
        f32x4 acc[4][4];
        gemm_tile(ALoadPlain{HM + (size_t)mt * 128 * D, (size_t)D}, WT + (size_t)nt * 128 * D, D, 16, acc, lds);
#pragma unroll
        for (int mi = 0; mi < 4; ++mi)
#pragma unroll
            for (int ni = 0; ni < 4; ++ni) {
                const int t = mt * 128 + wr * 64 + mi * 16 + fr, c = nt * 128 + wc * 64 + ni * 16 + fq * 4;
                const f32x4 v = acc[mi][ni];
                *(u32x2*)(QK + (size_t)t * 2048 + c) = (u32x2){pk2(v.x, v.y), pk2(v.z, v.w)};
            }
    }
}
__device__ __forceinline__ void phase_peer_topk(const Params& p, int layer, unsigned char* lds) {
    const bf16_t* QK = (const bf16_t*)(p.ws + WS_QK); const bf16_t* SK = (const bf16_t*)(p.ws + WS_SUBK) + (size_t)layer * 8 * 2 * 128 * 128;
    float* TOPS = (float*)(p.ws + WS_TOPS); int* TOPI = (int*)(p.ws + WS_TOPI);
    float* sc = (float*)lds;
    const int tid = threadIdx.x, lane = tid & 63, wid = tid >> 6, wr = wid >> 1, wc = wid & 1, fr = lane & 15, fq = lane >> 4;
    for (int id = blockIdx.x; id < 256 * 16; id += gridDim.x) {
        const int mt = id >> 4, hc = id & 15;
        f32x4 acc[4][4];
        gemm_tile(ALoadPlain{QK + (size_t)mt * 128 * 2048 + hc * 128, (size_t)2048}, SK + (size_t)hc * 128 * 128, 128, 2, acc, lds);
#pragma unroll
        for (int mi = 0; mi < 4; ++mi)
#pragma unroll
            for (int ni = 0; ni < 4; ++ni) {
                const int r = wr * 64 + mi * 16 + fr, c = wc * 64 + ni * 16 + fq * 4;
                float* d = sc + r * 129 + c;
                d[0] = acc[mi][ni].x; d[1] = acc[mi][ni].y; d[2] = acc[mi][ni].z; d[3] = acc[mi][ni].w;
            }
        __syncthreads();
        if (tid < 128) {
            float* row = sc + tid * 129;
            const size_t ob = ((size_t)(mt * 128 + tid) * 16 + hc) * 16;
#pragma unroll 1
            for (int r = 0; r < 16; ++r) {
                float best = row[0]; int bi = 0;
#pragma unroll 8
                for (int k = 1; k < 128; ++k) { const float v = row[k]; if (v > best) { best = v; bi = k; } }
                row[bi] = -3.0e38f;
                TOPS[ob + r] = best; TOPI[ob + r] = bi;
            }
        }
        __syncthreads();
    }
}
__device__ __forceinline__ void phase_peer_combine(const Params& p, unsigned char* lds) {
    const float* TOPS = (const float*)(p.ws + WS_TOPS); const int* TOPI = (const int*)(p.ws + WS_TOPI);
    int* EXP = (int*)(p.ws + WS_EXP); float* GATE = (float*)(p.ws + WS_GATE);
    unsigned* L = (unsigned*)lds;
    const int tid = threadIdx.x;
    for (int it = blockIdx.x; it < (T * 8) / 256; it += gridDim.x) {
        const size_t th = (size_t)it * 256 + tid;
        const u32x4* S4 = (const u32x4*)(TOPS + th * 32); const u32x4* I4 = (const u32x4*)(TOPI + th * 32);
#pragma unroll
        for (int a4 = 0; a4 < 8; ++a4) {
            const u32x4 s = S4[a4], i = I4[a4];
            L[(a4 * 4 + 0) * 256 + tid] = s.x; L[(a4 * 4 + 1) * 256 + tid] = s.y; L[(a4 * 4 + 2) * 256 + tid] = s.z; L[(a4 * 4 + 3) * 256 + tid] = s.w;
            L[(32 + a4 * 4 + 0) * 256 + tid] = i.x; L[(32 + a4 * 4 + 1) * 256 + tid] = i.y; L[(32 + a4 * 4 + 2) * 256 + tid] = i.z; L[(32 + a4 * 4 + 3) * 256 + tid] = i.w;
        }
        float val[16];
        const float s20 = __builtin_bit_cast(float, L[16 * 256 + tid]);
#pragma unroll
        for (int a = 0; a < 16; ++a) val[a] = __builtin_bit_cast(float, L[a * 256 + tid]) + s20;
        unsigned long long P = 0ull;
        float ts[16]; int te[16];
#pragma unroll
        for (int r = 0; r < 16; ++r) {
            float best = val[0]; int ba = 0;
#pragma unroll
            for (int a = 1; a < 16; ++a) if (val[a] > best) { best = val[a]; ba = a; }
            const int b = (int)((P >> (4 * ba)) & 15ull);
            const int i1 = (int)L[(32 + ba) * 256 + tid], i2 = (int)L[(48 + b) * 256 + tid];
            ts[r] = best; te[r] = i1 * 128 + i2;
            const int nb = b + 1;
            float newv = -3.0e38f;
            if (nb < 16) { newv = __builtin_bit_cast(float, L[ba * 256 + tid]) + __builtin_bit_cast(float, L[(16 + nb) * 256 + tid]); P += 1ull << (4 * ba); }
#pragma unroll
            for (int a = 0; a < 16; ++a) val[a] = (a == ba) ? newv : val[a];
        }
        const float m0 = ts[0];
        float sum = 0.f;
#pragma unroll
        for (int r = 0; r < 16; ++r) { ts[r] = __expf(ts[r] - m0); sum += ts[r]; }
        const float inv = 1.0f / sum;
#pragma unroll
        for (int r = 0; r < 16; ++r) ts[r] *= inv;
#pragma unroll
        for (int r = 0; r < 16; ++r) { EXP[th * 16 + r] = te[r]; GATE[th * 16 + r] = ts[r]; }
    }
}

__device__ __forceinline__ void phase_peer_apply(const Params& p, int layer, unsigned char* lds, bool dry) {
    const int lane = threadIdx.x & 63, wave = threadIdx.x >> 6;
    float* ldsw = (float*)lds + wave * (64 * 65);
    const bf16_t* HM = (const bf16_t*)(p.ws + WS_HM); const bf16_t* PU = (const bf16_t*)(p.ws + WS_PU); const bf16_t* PV = (const bf16_t*)(p.ws + WS_PV);
    const int* EXP = (const int*)(p.ws + WS_EXP); const float* GATE = (const float*)(p.ws + WS_GATE);
    const float* MOD = (const float*)(p.ws + WS_MOD);
    float* X = p.out;
    for (int t = blockIdx.x * 4 + wave; t < T; t += gridDim.x * 4) {
        const u32x4 ha = *(const u32x4*)(HM + (size_t)t * D + lane * 8), hb = *(const u32x4*)(HM + (size_t)t * D + 512 + lane * 8);
        const int e0 = EXP[(size_t)t * 128 + lane], e1 = EXP[(size_t)t * 128 + 64 + lane];
        const float g0 = GATE[(size_t)t * 128 + lane], g1 = GATE[(size_t)t * 128 + 64 + lane];
        float act0 = 0.f, act1 = 0.f;
#pragma unroll
        for (int half = 0; half < 2; ++half) {
            const int ev = half ? e1 : e0;
#pragma unroll 1
            for (int jg = 0; jg < 8; ++jg) {
                u32x4 ua[8], ub[8];
#pragma unroll
                for (int j = 0; j < 8; ++j) {
                    const int e = __builtin_amdgcn_readlane(ev, jg * 8 + j);
                    const bf16_t* row = PU + (size_t)e * D;
                    ua[j] = *(const u32x4*)(row + lane * 8); ub[j] = *(const u32x4*)(row + 512 + lane * 8);
                }
#pragma unroll
                for (int j = 0; j < 8; ++j) {
                    float s = dot2bf(ua[j].x, ha.x, 0.f); s = dot2bf(ua[j].y, ha.y, s); s = dot2bf(ua[j].z, ha.z, s); s = dot2bf(ua[j].w, ha.w, s);
                    float s2 = dot2bf(ub[j].x, hb.x, 0.f); s2 = dot2bf(ub[j].y, hb.y, s2); s2 = dot2bf(ub[j].z, hb.z, s2); s2 = dot2bf(ub[j].w, hb.w, s2);
                    ldsw[(jg * 8 + j) * 65 + lane] = s + s2;
                }
            }
            float tot = 0.f;
#pragma unroll 16
            for (int k = 0; k < 64; ++k) tot += ldsw[lane * 65 + k];
            const float a = gelu_tanh(tot) * (half ? g1 : g0);
            if (half) act1 = a; else act0 = a;
        }
        float acc[16];
#pragma unroll
        for (int i = 0; i < 16; ++i) acc[i] = 0.f;
#pragma unroll
        for (int half = 0; half < 2; ++half) {
            const int ev = half ? e1 : e0; const float av = half ? act1 : act0;
#pragma unroll 1
            for (int jg = 0; jg < 8; ++jg) {
                u32x4 va[8], vb[8];
#pragma unroll
                for (int j = 0; j < 8; ++j) {
                    const int e = __builtin_amdgcn_readlane(ev, jg * 8 + j);
                    const bf16_t* row = PV + (size_t)e * D;
                    va[j] = *(const u32x4*)(row + lane * 8); vb[j] = *(const u32x4*)(row + 512 + lane * 8);
                }
#pragma unroll
                for (int j = 0; j < 8; ++j) {
                    const float a = __builtin_bit_cast(float, __builtin_amdgcn_readlane(__builtin_bit_cast(int, av), jg * 8 + j));
                    acc[0] += a * bflo(va[j].x); acc[1] += a * bfhi(va[j].x); acc[2] += a * bflo(va[j].y); acc[3] += a * bfhi(va[j].y);
                    acc[4] += a * bflo(va[j].z); acc[5] += a * bfhi(va[j].z); acc[6] += a * bflo(va[j].w); acc[7] += a * bfhi(va[j].w);
                    acc[8] += a * bflo(vb[j].x); acc[9] += a * bfhi(vb[j].x); acc[10] += a * bflo(vb[j].y); acc[11] += a * bfhi(vb[j].y);
                    acc[12] += a * bflo(vb[j].z); acc[13] += a * bfhi(vb[j].z); acc[14] += a * bflo(vb[j].w); acc[15] += a * bfhi(vb[j].w);
                }
            }
        }
        const int b = t / SEQ;
        const float* g2 = MOD + (size_t)(layer * 2 + b) * 6144 + 5120;
        float* xr = X + (size_t)t * D;
#pragma unroll
        for (int hh = 0; hh < 2; ++hh)
#pragma unroll
            for (int q = 0; q < 2; ++q) {
                const int c = hh * 512 + lane * 8 + q * 4;
                const f32x4 g = *(const f32x4*)(g2 + c); f32x4 x = *(const f32x4*)(xr + c);
                x.x += g.x * acc[hh * 8 + q * 4 + 0]; x.y += g.y * acc[hh * 8 + q * 4 + 1]; x.z += g.z * acc[hh * 8 + q * 4 + 2]; x.w += g.w * acc[hh * 8 + q * 4 + 3];
                if (!dry) *(f32x4*)(xr + c) = x;
            }
    }
}
__device__ __forceinline__ void phase_tab1(const Params& p) {
    for (int it = blockIdx.x; it < 2 * P0_TAB; it += gridDim.x) {
        if (it < P0_TAB) cvt_item(p.in[26] + (size_t)PE * D, (bf16_t*)(p.ws + WS_PU), it);
        else cvt_item(p.in[27] + (size_t)PE * D, (bf16_t*)(p.ws + WS_PV), it - P0_TAB);
    }
}
__device__ __forceinline__ void phase_nsa_proj(const Params& p, unsigned char* lds) {
    const bf16_t* HM = (const bf16_t*)(p.ws + WS_HM); const bf16_t* WT = (const bf16_t*)(p.ws + WS_WPROJ_T);
    const f32x2* ROPE = (const f32x2*)(p.ws + WS_ROPE);
    bf16_t* Q = (bf16_t*)(p.ws + WS_Q); float* NGT = (float*)(p.ws + WS_NG);
    const int lane = threadIdx.x & 63, wid = threadIdx.x >> 6, wr = wid >> 1, wc = wid & 1, fr = lane & 15, fq = lane >> 4;
    for (int id = blockIdx.x; id < 256 * 21; id += gridDim.x) {
        const int mt = id / 21, nt = id % 21;
        f32x4 acc[4][4];
        gemm_tile(ALoadPlain{HM + (size_t)mt * 128 * D, (size_t)D}, WT + (size_t)nt * 128 * D, D, 16, acc, lds);
        const int c0 = nt * 128 + wc * 64;
        if (c0 >= 2624) continue;
        const int b = (mt * 128) / SEQ;
        if (c0 == 2560) {
#pragma unroll
            for (int mi = 0; mi < 4; ++mi)
#pragma unroll
                for (int ni = 0; ni < 3; ++ni) {
                    const int t = mt * 128 + wr * 64 + mi * 16 + fr;
                    const f32x4 v = acc[mi][ni];
                    *(f32x4*)(NGT + (size_t)t * 48 + ni * 16 + fq * 4) = (f32x4){sigmoidf_(v.x), sigmoidf_(v.y), sigmoidf_(v.z), sigmoidf_(v.w)};
                }
            continue;
        }
        int sec = -1, g = 0;
        if (c0 >= 1024) { sec = (c0 - 1024) >> 8; g = ((c0 - 1024) & 255) >> 6; }
        const bool dorope = (sec == -1) || (sec == 2) || (sec == 4);
        const float scl = (sec == -1) ? 0.125f : 1.0f;
        const size_t secoff[6] = {WS_KC, WS_VC, WS_KS, WS_VST, WS_KW, WS_VWT};
        size_t so = WS_Q;
#pragma unroll
        for (int q = 0; q < 6; ++q) if (sec == q) so = secoff[q];
        bf16_t* OUT = (bf16_t*)(p.ws + so);
        const bool vt = (sec == 3) || (sec == 5);
#pragma unroll
        for (int mi = 0; mi < 4; ++mi) {
            const int t = mt * 128 + wr * 64 + mi * 16 + fr, s = t - b * SEQ;
            if (dorope) {
#pragma unroll
                for (int ni = 0; ni < 2; ++ni) {
                    const f32x4* rp = (const f32x4*)(ROPE + (size_t)s * 32 + ni * 16 + fq * 4);
                    const f32x4 r0 = rp[0], r1 = rp[1];
                    const f32x4 x1 = acc[mi][ni], x2 = acc[mi][ni + 2];
                    acc[mi][ni] = (f32x4){x1.x * r0.x - x2.x * r0.y, x1.y * r0.z - x2.y * r0.w, x1.z * r1.x - x2.z * r1.y, x1.w * r1.z - x2.w * r1.w};
                    acc[mi][ni + 2] = (f32x4){x1.x * r0.y + x2.x * r0.x, x1.y * r0.w + x2.y * r0.z, x1.z * r1.y + x2.z * r1.x, x1.w * r1.w + x2.w * r1.z};
                }
            }
#pragma unroll
            for (int ni = 0; ni < 4; ++ni) {
                const f32x4 v = acc[mi][ni] * scl;
                const int d = ni * 16 + fq * 4;
                if (sec == -1) {
                    *(u32x2*)(OUT + (size_t)t * 1024 + c0 + d) = (u32x2){pk2(v.x, v.y), pk2(v.z, v.w)};
                } else if (!vt) {
                    *(u32x2*)(OUT + ((size_t)(b * 4 + g) * SEQ + s) * 64 + d) = (u32x2){pk2(v.x, v.y), pk2(v.z, v.w)};
                } else {
                    bf16_t* o = OUT + ((size_t)(b * 4 + g) * 64 + d) * SEQ + s;
                    o[0] = (bf16_t)f2bf(v.x); o[SEQ] = (bf16_t)f2bf(v.y); o[2 * SEQ] = (bf16_t)f2bf(v.z); o[3 * SEQ] = (bf16_t)f2bf(v.w);
                }
            }
        }
    }
}
__device__ __forceinline__ void phase_nsa_cmp1(const Params& p, unsigned char* lds) {
    bf16_t* HID = (bf16_t*)(p.ws + WS_HID);
    const float* bias = (const float*)(p.ws + WS_MISC);
    const int lane = threadIdx.x & 63, wid = threadIdx.x >> 6, wr = wid >> 1, wc = wid & 1, fr = lane & 15, fq = lane >> 4;
    for (int id = blockIdx.x; id < 256; id += gridDim.x) {
        const int kv = id >> 7, bg = (id >> 4) & 7, mt = (id >> 1) & 7, nt = id & 1;
        const bf16_t* A = (const bf16_t*)(p.ws + (kv ? WS_VC : WS_KC)) + (size_t)bg * SEQ * 64 + (size_t)mt * 128 * 1024;
        const bf16_t* B = (const bf16_t*)(p.ws + (kv ? WS_WV1_T : WS_WK1_T)) + (size_t)nt * 128 * 2048;
        f32x4 acc[4][4];
        gemm_tile(ALoadPlain{A, (size_t)1024}, B, 2048, 32, acc, lds);
#pragma unroll
        for (int mi = 0; mi < 4; ++mi)
#pragma unroll
            for (int ni = 0; ni < 4; ++ni) {
                const int n = mt * 128 + wr * 64 + mi * 16 + fr, c = nt * 128 + wc * 64 + ni * 16 + fq * 4;
                const f32x4 bv = *(const f32x4*)(bias + kv * 256 + c);
                const f32x4 v = acc[mi][ni] + bv;
                *(u32x2*)(HID + (((size_t)kv * 8 + bg) * 1024 + n) * 256 + c) = (u32x2){pk2(gelu_tanh(v.x), gelu_tanh(v.y)), pk2(gelu_tanh(v.z), gelu_tanh(v.w))};
            }
    }
}
__device__ __forceinline__ void phase_nsa_cmp2(const Params& p, unsigned char* lds) {
    const bf16_t* HID = (const bf16_t*)(p.ws + WS_HID);
    const f32x2* ROPE = (const f32x2*)(p.ws + WS_ROPE);
    bf16_t* KCMP = (bf16_t*)(p.ws + WS_KCMP); bf16_t* VCMPT = (bf16_t*)(p.ws + WS_VCMPT);
    const int lane = threadIdx.x & 63, wid = threadIdx.x >> 6, wr = wid >> 1, wc = wid & 1, fr = lane & 15, fq = lane >> 4;
    for (int id = blockIdx.x; id < 128; id += gridDim.x) {
        const int kv = id >> 6, mt = id & 63;
        const bf16_t* A = HID + ((size_t)kv * 8192 + (size_t)mt * 128) * 256;
        const bf16_t* B = (const bf16_t*)(p.ws + (kv ? WS_WV2_T : WS_WK2_T));
        f32x4 acc[4][4];
        gemm_tile(ALoadPlain{A, (size_t)256}, B, 256, 4, acc, lds);
        if (wc == 1) continue;
#pragma unroll
        for (int mi = 0; mi < 4; ++mi) {
            const int R = mt * 128 + wr * 64 + mi * 16 + fr, bg = R >> 10, n = R & 1023;
            if (kv == 0) {
                int pos = n * 16 + 31; pos = pos > SEQ - 1 ? SEQ - 1 : pos;
#pragma unroll
                for (int ni = 0; ni < 2; ++ni) {
                    const f32x4* rp = (const f32x4*)(ROPE + (size_t)pos * 32 + ni * 16 + fq * 4);
                    const f32x4 r0 = rp[0], r1 = rp[1];
                    const f32x4 x1 = acc[mi][ni], x2 = acc[mi][ni + 2];
                    acc[mi][ni] = (f32x4){x1.x * r0.x - x2.x * r0.y, x1.y * r0.z - x2.y * r0.w, x1.z * r1.x - x2.z * r1.y, x1.w * r1.z - x2.w * r1.w};
                    acc[mi][ni + 2] = (f32x4){x1.x * r0.y + x2.x * r0.x, x1.y * r0.w + x2.y * r0.z, x1.z * r1.y + x2.z * r1.x, x1.w * r1.w + x2.w * r1.z};
                }
#pragma unroll
                for (int ni = 0; ni < 4; ++ni) {
                    const f32x4 v = acc[mi][ni];
                    *(u32x2*)(KCMP + ((size_t)bg * 1024 + n) * 64 + ni * 16 + fq * 4) = (u32x2){pk2(v.x, v.y), pk2(v.z, v.w)};
                }
            } else {
#pragma unroll
                for (int ni = 0; ni < 4; ++ni) {
                    const f32x4 v = acc[mi][ni];
                    bf16_t* o = VCMPT + ((size_t)bg * 64 + ni * 16 + fq * 4) * 1024 + n;
                    o[0] = (bf16_t)f2bf(v.x); o[1024] = (bf16_t)f2bf(v.y); o[2048] = (bf16_t)f2bf(v.z); o[3072] = (bf16_t)f2bf(v.w);
                }
            }
        }
    }
}
__device__ __forceinline__ void phase_nsa_wo(const Params& p, unsigned char* lds, bool dry) {
    const bf16_t* O = (const bf16_t*)(p.ws + WS_O); const bf16_t* WT = (const bf16_t*)(p.ws + WS_WO_T);
    const float* MOD = (const float*)(p.ws + WS_MOD);
    float* X = p.out;
    const int lane = threadIdx.x & 63, wid = threadIdx.x >> 6, wr = wid >> 1, wc = wid & 1, fr = lane & 15, fq = lane >> 4;
    for (int id = blockIdx.x; id < 256 * 8; id += gridDim.x) {
        const int mt = id >> 3, nt = id & 7;
        f32x4 acc[4][4];
        gemm_tile(ALoadPlain{O + (size_t)mt * 128 * D, (size_t)D}, WT + (size_t)nt * 128 * D, D, 16, acc, lds);
        const int b = (mt * 128) / SEQ;
#pragma unroll
        for (int mi = 0; mi < 4; ++mi)
#pragma unroll
            for (int ni = 0; ni < 4; ++ni) {
                const int t = mt * 128 + wr * 64 + mi * 16 + fr, c = nt * 128 + wc * 64 + ni * 16 + fq * 4;
                const f32x4 g1 = *(const f32x4*)(MOD + (size_t)(1 * 2 + b) * 6144 + 2048 + c);
                float* xp = X + (size_t)t * D + c;
                const f32x4 x = *(const f32x4*)xp; const f32x4 v = acc[mi][ni];
                if (!dry) *(f32x4*)xp = (f32x4){x.x + g1.x * v.x, x.y + g1.y * v.y, x.z + g1.z * v.z, x.w + g1.w * v.w};
            }
    }
}
__device__ __forceinline__ bf16x8 pack8(const f32x4 a, const f32x4 b) {
    u32x4 w; w.x = pk2(a.x, a.y); w.y = pk2(a.z, a.w); w.z = pk2(b.x, b.y); w.w = pk2(b.z, b.w);
    return __builtin_bit_cast(bf16x8, w);
}
__device__ __forceinline__ bf16x8 ldv8(const bf16_t* plo, const bf16_t* phi) {
    const u32x2 lo = *(const u32x2*)plo, hi = *(const u32x2*)phi;
    u32x4 w; w.x = lo.x; w.y = lo.y; w.z = hi.x; w.w = hi.y;
    return __builtin_bit_cast(bf16x8, w);
}
__device__ __forceinline__ float red4(float v) { v += __shfl_xor(v, 16); v += __shfl_xor(v, 32); return v; }
__device__ __forceinline__ float max4(float v) { v = fmaxf(v, __shfl_xor(v, 16)); v = fmaxf(v, __shfl_xor(v, 32)); return v; }
#define NEGBIG (-1.0e30f)

__device__ __forceinline__ void phase_nsa_attn(const Params& p, unsigned char* lds) {
    const int lane = threadIdx.x & 63, wave = threadIdx.x >> 6, fr = lane & 15, fq = lane >> 4;
    float* IMP = (float*)(lds + wave * 18432);
    int* SEL = (int*)(lds + wave * 18432 + 16640);
    const bf16_t* Q = (const bf16_t*)(p.ws + WS_Q);
    const bf16_t* KCMP = (const bf16_t*)(p.ws + WS_KCMP); const bf16_t* VCMPT = (const bf16_t*)(p.ws + WS_VCMPT);
    const bf16_t* KS = (const bf16_t*)(p.ws + WS_KS); const bf16_t* VST = (const bf16_t*)(p.ws + WS_VST);
    const bf16_t* KW = (const bf16_t*)(p.ws + WS_KW); const bf16_t* VWT = (const bf16_t*)(p.ws + WS_VWT);
    const float* NGT = (const float*)(p.ws + WS_NG);
    bf16_t* O = (bf16_t*)(p.ws + WS_O);
    const f32x4 z4 = (f32x4){0.f, 0.f, 0.f, 0.f};
    for (int bi = blockIdx.x; bi < 2048; bi += gridDim.x) {
        const int bg = bi & 7, quad = 255 - (bi >> 3), t0 = (quad * 4 + wave) * 16, b = bg >> 2, g = bg & 3;
        const int cur = t0 >> 6;
        const size_t tok = (size_t)b * SEQ + t0 + fr;
        const int tq = t0 + fr;
        bf16x8 qf[4][2];
#pragma unroll
        for (int r = 0; r < 4; ++r)
#pragma unroll
            for (int ks = 0; ks < 2; ++ks) qf[r][ks] = *(const bf16x8*)(Q + tok * 1024 + (g * 4 + r) * 64 + ks * 32 + fq * 8);

        const int nmax_tile = (t0 >> 4) - 1, nmax_lane = (t0 >> 4) - 2 + (fr == 15 ? 1 : 0);
        const bf16_t* kcb = KCMP + (size_t)bg * 1024 * 64; const bf16_t* vcb = VCMPT + (size_t)bg * 64 * 1024;
        float mc[4], lc[4];
#pragma unroll
        for (int r = 0; r < 4; ++r) { mc[r] = NEGBIG; lc[r] = 0.f; }
        for (int nb = 0; nb <= nmax_tile; nb += 32) {
            bf16x8 kf[2][2];
#pragma unroll
            for (int f = 0; f < 2; ++f)
#pragma unroll
                for (int ks = 0; ks < 2; ++ks) kf[f][ks] = *(const bf16x8*)(kcb + (size_t)(nb + f * 16 + fr) * 64 + ks * 32 + fq * 8);
#pragma unroll
            for (int r = 0; r < 4; ++r) {
                f32x4 st[2];
#pragma unroll
                for (int f = 0; f < 2; ++f) {
                    st[f] = __builtin_amdgcn_mfma_f32_16x16x32_bf16(kf[f][0], qf[r][0], z4, 0, 0, 0);
                    st[f] = __builtin_amdgcn_mfma_f32_16x16x32_bf16(kf[f][1], qf[r][1], st[f], 0, 0, 0);
                }
                float mx = NEGBIG;
#pragma unroll
                for (int f = 0; f < 2; ++f)
#pragma unroll
                    for (int e = 0; e < 4; ++e) { const int n = nb + f * 16 + fq * 4 + e; if (n <= nmax_lane) mx = fmaxf(mx, st[f][e]); }
                mx = max4(mx);
                const float mn = fmaxf(mc[r], mx);
                float ps = 0.f;
#pragma unroll
                for (int f = 0; f < 2; ++f)
#pragma unroll
                    for (int e = 0; e < 4; ++e) { const int n = nb + f * 16 + fq * 4 + e; if (n <= nmax_lane) ps += __expf(st[f][e] - mn); }
                lc[r] = lc[r] * __expf(mc[r] - mn) + ps; mc[r] = mn;
                __builtin_amdgcn_sched_barrier(0);
            }
        }
        float invl[4];
#pragma unroll
        for (int r = 0; r < 4; ++r) { const float l = red4(lc[r]); invl[r] = l > 0.f ? 1.0f / l : 0.f; }
        for (int i = lane; i < 16 * 260; i += 64) IMP[i] = 0.f;
        f32x4 oc[4][4];
#pragma unroll
        for (int r = 0; r < 4; ++r)
#pragma unroll
            for (int df = 0; df < 4; ++df) oc[r][df] = z4;
        float carry = 0.f;
        for (int nb = 0; nb <= nmax_tile; nb += 32) {
            bf16x8 kf[2][2];
#pragma unroll
            for (int f = 0; f < 2; ++f)
#pragma unroll
                for (int ks = 0; ks < 2; ++ks) kf[f][ks] = *(const bf16x8*)(kcb + (size_t)(nb + f * 16 + fr) * 64 + ks * 32 + fq * 8);
            bf16x8 vf[4];
#pragma unroll
            for (int df = 0; df < 4; ++df) { const bf16_t* vp = vcb + (size_t)(df * 16 + fr) * 1024 + nb + 4 * fq; vf[df] = ldv8(vp, vp + 16); }
            f32x4 pg[2] = {z4, z4};
#pragma unroll
            for (int r = 0; r < 4; ++r) {
                f32x4 st[2];
#pragma unroll
                for (int f = 0; f < 2; ++f) {
                    st[f] = __builtin_amdgcn_mfma_f32_16x16x32_bf16(kf[f][0], qf[r][0], z4, 0, 0, 0);
                    st[f] = __builtin_amdgcn_mfma_f32_16x16x32_bf16(kf[f][1], qf[r][1], st[f], 0, 0, 0);
#pragma unroll
                    for (int e = 0; e < 4; ++e) { const int n = nb + f * 16 + fq * 4 + e; st[f][e] = (n <= nmax_lane) ? __expf(st[f][e] - mc[r]) * invl[r] : 0.f; }
                    pg[f] += st[f];
                }
                const bf16x8 pf = pack8(st[0], st[1]);
#pragma unroll
                for (int df = 0; df < 4; ++df) oc[r][df] = __builtin_amdgcn_mfma_f32_16x16x32_bf16(vf[df], pf, oc[r][df], 0, 0, 0);
                __builtin_amdgcn_sched_barrier(0);
            }
            const int src = (lane - 16) & 63;
            const float s0 = __shfl(pg[0].w, src), s1 = __shfl(pg[1].w, src), sc = __shfl(carry, src);
            const float prev0 = fq > 0 ? s0 : sc, prev1 = fq > 0 ? s1 : s0;
            const float imp0 = (pg[0].x + pg[0].y) + (pg[0].z + pg[0].w) + prev0;
            const float imp1 = (pg[1].x + pg[1].y) + (pg[1].z + pg[1].w) + prev1;
            const int jb = (nb >> 2) + fq;
            IMP[fr * 260 + jb] = imp0; IMP[fr * 260 + jb + 4] = imp1;
            carry = pg[1].w;
        }
        {
            const int nf = cur >= 2 ? 3 : cur + 1;
            if (fq == 0) {
                SEL[fr * 16 + 0] = 0;
                if (cur == 1) SEL[fr * 16 + 1] = 1;
                if (cur >= 2) { SEL[fr * 16 + 1] = cur - 1; SEL[fr * 16 + 2] = cur; }
            }
            const int ncand = cur >= 3 ? cur - 2 : 0, extra = 16 - nf;
            if (ncand <= extra) {
                if (fq == 0) { for (int k = 0; k < extra; ++k) SEL[fr * 16 + nf + k] = (k < ncand) ? 1 + k : -1; }
            } else {
                for (int rnd = 0; rnd < extra; ++rnd) {
                    float bv = -1.0f; int bj = 1 << 20;
                    for (int jb = 1 + fq; jb <= cur - 2; jb += 4) { const float v = IMP[fr * 260 + jb]; if (v > bv) { bv = v; bj = jb; } }
#pragma unroll
                    for (int o = 16; o <= 32; o <<= 1) {
                        const float ov = __shfl_xor(bv, o); const int oj = __shfl_xor(bj, o);
                        if (ov > bv || (ov == bv && oj < bj)) { bv = ov; bj = oj; }
                    }
                    if (fq == 0) SEL[fr * 16 + nf + rnd] = bj;
                    if (((bj - 1) & 3) == fq) IMP[fr * 260 + bj] = -2.0f;
                }
            }
        }
        float* ACC = IMP;
        float gc[4], gs[4], gw[4];
#pragma unroll
        for (int r = 0; r < 4; ++r) { const float* gp = NGT + tok * 48 + (g * 4 + r) * 3; gc[r] = gp[0]; gs[r] = gp[1]; gw[r] = gp[2]; }
        (void)gs;
#pragma unroll
        for (int r = 0; r < 4; ++r)
#pragma unroll
            for (int df = 0; df < 4; ++df) *(f32x4*)(ACC + (fr * 4 + r) * 64 + df * 16 + fq * 4) = oc[r][df] * gc[r];
        {
            const bf16_t* kwb = KW + (size_t)bg * SEQ * 64; const bf16_t* vwb = VWT + (size_t)bg * 64 * SEQ;
            float mw[4], lw[4];
            f32x4 ow[4][4];
#pragma unroll
            for (int r = 0; r < 4; ++r) { mw[r] = NEGBIG; lw[r] = 0.f;
#pragma unroll
                for (int df = 0; df < 4; ++df) ow[r][df] = z4; }
            int kmin = t0 - 511; kmin = kmin < 0 ? 0 : kmin; kmin &= ~31;
            for (int kb = kmin; kb <= t0 + 15; kb += 32) {
                bf16x8 kf[2][2];
#pragma unroll
                for (int f = 0; f < 2; ++f)
#pragma unroll
                    for (int ks = 0; ks < 2; ++ks) kf[f][ks] = *(const bf16x8*)(kwb + (size_t)(kb + f * 16 + fr) * 64 + ks * 32 + fq * 8);
                bf16x8 vf[4];
#pragma unroll
                for (int df = 0; df < 4; ++df) { const bf16_t* vp = vwb + (size_t)(df * 16 + fr) * SEQ + kb + 4 * fq; vf[df] = ldv8(vp, vp + 16); }
#pragma unroll
                for (int r = 0; r < 4; ++r) {
                    f32x4 st[2];
#pragma unroll
                    for (int f = 0; f < 2; ++f) {
                        st[f] = __builtin_amdgcn_mfma_f32_16x16x32_bf16(kf[f][0], qf[r][0], z4, 0, 0, 0);
                        st[f] = __builtin_amdgcn_mfma_f32_16x16x32_bf16(kf[f][1], qf[r][1], st[f], 0, 0, 0);
                    }
                    float mx = NEGBIG;
#pragma unroll
                    for (int f = 0; f < 2; ++f)
#pragma unroll
                        for (int e = 0; e < 4; ++e) { const int key = kb + f * 16 + fq * 4 + e; const bool ok = (key <= tq) && (key > tq - 512); if (ok) mx = fmaxf(mx, st[f][e]); }
                    mx = max4(mx);
                    const float mn = fmaxf(mw[r], mx);
                    const float al = __expf(mw[r] - mn);
                    float ps = 0.f;
#pragma unroll
                    for (int f = 0; f < 2; ++f)
#pragma unroll
                        for (int e = 0; e < 4; ++e) { const int key = kb + f * 16 + fq * 4 + e; const bool ok = (key <= tq) && (key > tq - 512); const float pv = ok ? __expf(st[f][e] - mn) : 0.f; st[f][e] = pv; ps += pv; }
                    lw[r] = lw[r] * al + ps; mw[r] = mn;
                    const bf16x8 pf = pack8(st[0], st[1]);
#pragma unroll
                    for (int df = 0; df < 4; ++df) { ow[r][df] = ow[r][df] * al; ow[r][df] = __builtin_amdgcn_mfma_f32_16x16x32_bf16(vf[df], pf, ow[r][df], 0, 0, 0); }
                    __builtin_amdgcn_sched_barrier(0);
                }
            }
#pragma unroll
            for (int r = 0; r < 4; ++r) {
                const float l = red4(lw[r]); const float sc = gw[r] / l;
#pragma unroll
                for (int df = 0; df < 4; ++df) { f32x4* ap = (f32x4*)(ACC + (fr * 4 + r) * 64 + df * 16 + fq * 4); *ap = *ap + ow[r][df] * sc; }
            }
        }
        {
            const bf16_t* ksb = KS + (size_t)bg * SEQ * 64; const bf16_t* vsb = VST + (size_t)bg * 64 * SEQ;
            const int rr = fr & 3;
            for (int i = 0; i < 16; ++i) {
                const int ti = t0 + i;
                const size_t tk = (size_t)b * SEQ + ti;
                bf16x8 qs[2];
#pragma unroll
                for (int ks = 0; ks < 2; ++ks) qs[ks] = *(const bf16x8*)(Q + tk * 1024 + (g * 4 + rr) * 64 + ks * 32 + fq * 8);
                float ms = NEGBIG, ls = 0.f;
                f32x4 os[4] = {z4, z4, z4, z4};
                for (int k = 0; k < 16; ++k) {
                    const int jb = __builtin_amdgcn_readfirstlane(SEL[i * 16 + k]);
                    if (jb < 0) continue;
#pragma unroll
                    for (int s2 = 0; s2 < 2; ++s2) {
                        const int kb = jb * 64 + s2 * 32;
                        bf16x8 kf[2][2];
#pragma unroll
                        for (int f = 0; f < 2; ++f)
#pragma unroll
                            for (int ks = 0; ks < 2; ++ks) kf[f][ks] = *(const bf16x8*)(ksb + (size_t)(kb + f * 16 + fr) * 64 + ks * 32 + fq * 8);
                        bf16x8 vf[4];
#pragma unroll
                        for (int df = 0; df < 4; ++df) { const bf16_t* vp = vsb + (size_t)(df * 16 + fr) * SEQ + kb + 4 * fq; vf[df] = ldv8(vp, vp + 16); }
                        f32x4 st[2];
#pragma unroll
                        for (int f = 0; f < 2; ++f) {
                            st[f] = __builtin_amdgcn_mfma_f32_16x16x32_bf16(kf[f][0], qs[0], z4, 0, 0, 0);
                            st[f] = __builtin_amdgcn_mfma_f32_16x16x32_bf16(kf[f][1], qs[1], st[f], 0, 0, 0);
                        }
                        float mx = NEGBIG;
#pragma unroll
                        for (int f = 0; f < 2; ++f)
#pragma unroll
                            for (int e = 0; e < 4; ++e) { const int key = kb + f * 16 + fq * 4 + e; if (key <= ti) mx = fmaxf(mx, st[f][e]); }
                        mx = max4(mx);
                        const float mn = fmaxf(ms, mx);
                        const float al = __expf(ms - mn);
                        float ps = 0.f;
#pragma unroll
                        for (int f = 0; f < 2; ++f)
#pragma unroll
                            for (int e = 0; e < 4; ++e) { const int key = kb + f * 16 + fq * 4 + e; const float pv = (key <= ti) ? __expf(st[f][e] - mn) : 0.f; st[f][e] = pv; ps += pv; }
                        ls = ls * al + ps; ms = mn;
                        const bf16x8 pf = pack8(st[0], st[1]);
#pragma unroll
                        for (int df = 0; df < 4; ++df) { os[df] = os[df] * al; os[df] = __builtin_amdgcn_mfma_f32_16x16x32_bf16(vf[df], pf, os[df], 0, 0, 0); }
                    }
                }
                const float l = red4(ls);
                if (fr < 4) {
                    const float gsv = NGT[tk * 48 + (g * 4 + fr) * 3 + 1];
                    const float sc = gsv / l;
#pragma unroll
                    for (int df = 0; df < 4; ++df) { f32x4* ap = (f32x4*)(ACC + (i * 4 + fr) * 64 + df * 16 + fq * 4); *ap = *ap + os[df] * sc; }
                }
            }
        }
#pragma unroll
        for (int r = 0; r < 4; ++r)
#pragma unroll
            for (int df = 0; df < 4; ++df) {
                const f32x4 v = *(const f32x4*)(ACC + (fr * 4 + r) * 64 + df * 16 + fq * 4);
                *(u32x2*)(O + tok * 1024 + (g * 4 + r) * 64 + df * 16 + fq * 4) = (u32x2){pk2(v.x, v.y), pk2(v.z, v.w)};
            }
    }
}
constexpr int NPHASES = 24;
#ifndef PROBE_PHASE
#define PROBE_PHASE (-1)
#endif
#ifndef PROBE_REPS
#define PROBE_REPS 1
#endif
__global__ void __launch_bounds__(NTHREADS, 2) mega(Params p) {
    __shared__ __attribute__((aligned(16))) unsigned char lds[LDS_BYTES];
    __shared__ __attribute__((aligned(16))) unsigned bar_st[4];
    cg::grid_group grid = cg::this_grid();
    const float* MOD = (const float*)(p.ws + WS_MOD);
    bf16_t* HM = (bf16_t*)(p.ws + WS_HM);
    if (threadIdx.x < 4) bar_st[threadIdx.x] = 0u;
    __syncthreads();
    XcdBarrier bar = xcd_barrier_post((unsigned*)(p.ws + WS_CTL), (volatile LAS unsigned*)bar_st);
    const int lo = p.ph_lo, hi = p.ph_hi;
    const bool dry0 = (p.ph_hi < 0);
#define PHASE(k, call, drycall) if (lo <= (k) && (k) < hi) { \
        if (PROBE_PHASE == (k)) { for (int rep = 0; rep < PROBE_REPS; ++rep) { const bool dry = !dry0; drycall; __syncthreads(); } } \
        { const bool dry = dry0; call; } \
        if ((k) + 1 < hi) { if ((k) == 0) grid.sync(); else xcd_barrier(bar); } }
    PHASE(0, phase_prep(p, (float*)lds), phase_prep(p, (float*)lds))
    PHASE(1, phase_norm(p, p.in[0], p.in[2], MOD + 0, MOD + 1024, HM), phase_norm(p, p.in[0], p.in[2], MOD + 0, MOD + 1024, HM))
    PHASE(2, phase_s5_win(p, lds), phase_s5_win(p, lds))
    PHASE(3, phase_s5_a(p, lds), phase_s5_a(p, lds))
    PHASE(4, phase_s5_scan(p), phase_s5_scan(p))
    PHASE(5, phase_s5_b(p, lds), phase_s5_b(p, lds))
    PHASE(6, phase_s5_glu(p, lds), phase_s5_glu(p, lds))
    PHASE(7, phase_norm(p, p.out, p.in[3], MOD + 3072, MOD + 4096, HM), phase_norm(p, p.out, p.in[3], MOD + 3072, MOD + 4096, HM))
    PHASE(8, phase_peer_wq(p, 0, lds), phase_peer_wq(p, 0, lds))
    PHASE(9, phase_peer_topk(p, 0, lds), phase_peer_topk(p, 0, lds))
    PHASE(10, phase_peer_combine(p, lds), phase_peer_combine(p, lds))
    PHASE(11, phase_peer_apply(p, 0, lds, dry), phase_peer_apply(p, 0, lds, dry))
    PHASE(12, (phase_norm(p, p.out, p.in[2] + D, MOD + 2 * 6144 + 0, MOD + 2 * 6144 + 1024, HM), phase_tab1(p)), (phase_norm(p, p.out, p.in[2] + D, MOD + 2 * 6144 + 0, MOD + 2 * 6144 + 1024, HM), phase_tab1(p)))
    PHASE(13, phase_nsa_proj(p, lds), phase_nsa_proj(p, lds))
    PHASE(14, phase_nsa_cmp1(p, lds), phase_nsa_cmp1(p, lds))
    PHASE(15, phase_nsa_cmp2(p, lds), phase_nsa_cmp2(p, lds))
    PHASE(16, phase_nsa_attn(p, lds), phase_nsa_attn(p, lds))
    PHASE(17, phase_nsa_wo(p, lds, dry), phase_nsa_wo(p, lds, dry))
    PHASE(18, phase_norm(p, p.out, p.in[3] + D, MOD + 2 * 6144 + 3072, MOD + 2 * 6144 + 4096, HM), phase_norm(p, p.out, p.in[3] + D, MOD + 2 * 6144 + 3072, MOD + 2 * 6144 + 4096, HM))
    PHASE(19, phase_peer_wq(p, 1, lds), phase_peer_wq(p, 1, lds))
    PHASE(20, phase_peer_topk(p, 1, lds), phase_peer_topk(p, 1, lds))
    PHASE(21, phase_peer_combine(p, lds), phase_peer_combine(p, lds))
    PHASE(22, phase_peer_apply(p, 1, lds, dry), phase_peer_apply(p, 1, lds, dry))
    PHASE(23, phase_final_norm(p, p.out, p.out, dry), phase_final_norm(p, p.out, p.out, dry))
#undef PHASE
}

extern "C" void kernel_launch(void* const* d_in, const int* in_sizes, int n_in, void* d_out, int out_size, void* d_ws, size_t ws_size, hipStream_t stream) {
    static int grid_blocks = 0;
    if (!grid_blocks) {
        int dev = 0, cus = 0, per_cu = 0;
        hipGetDevice(&dev);
        hipDeviceGetAttribute(&cus, hipDeviceAttributeMultiprocessorCount, dev);
        hipOccupancyMaxActiveBlocksPerMultiprocessor(&per_cu, mega, NTHREADS, 0);
        if (per_cu > 2) per_cu = 2;
        if (per_cu < 1) per_cu = 1;
        grid_blocks = cus * per_cu;
        if (ws_size < WS_END) fprintf(stderr, "kernel_launch: workspace too small: %zu < %zu\n", ws_size, (size_t)WS_END);
        if (n_in != 29) fprintf(stderr, "kernel_launch: expected 29 inputs, got %d\n", n_in);
    }
    hipMemsetAsync((unsigned char*)d_ws + WS_CTL, 0, 16384, stream);
    Params p{};
    for (int i = 0; i < 29; ++i) p.in[i] = (const float*)d_in[i];
    p.out = (float*)d_out; p.ws = (unsigned char*)d_ws;
#if SINGLE_LAUNCH
    p.ph_lo = 0; p.ph_hi = NPHASES;
    void* args[] = {&p};
    hipError_t e = hipLaunchCooperativeKernel((void*)mega, dim3(grid_blocks), dim3(NTHREADS), args, 0, stream);
    if (e != hipSuccess) fprintf(stderr, "cooperative launch failed: %s (grid %d)\n", hipGetErrorString(e), grid_blocks);
#else
    for (int ph = 0; ph < NPHASES; ++ph) {
        p.ph_lo = ph; p.ph_hi = ph + 1;
        hipLaunchKernelGGL(mega, dim3(grid_blocks), dim3(NTHREADS), 0, stream, p);
    }
#endif
}
```

```cpp
#include <hip/hip_runtime.h>
#include <hip/hip_cooperative_groups.h>
#include <cstdio>
#include <cstdint>
namespace cg = cooperative_groups;

#ifndef SINGLE_LAUNCH
#define SINGLE_LAUNCH 1
#endif

typedef unsigned short bf16_t;
typedef short bf16x8 __attribute__((ext_vector_type(8)));
typedef float f32x4 __attribute__((ext_vector_type(4)));
typedef float f32x2 __attribute__((ext_vector_type(2)));
typedef unsigned u32x4 __attribute__((ext_vector_type(4)));
typedef unsigned u32x2 __attribute__((ext_vector_type(2)));
typedef __bf16 bf16x2_t __attribute__((ext_vector_type(2)));

constexpr int D = 1024, BATCH = 2, SEQ = 16384, T = BATCH * SEQ;
constexpr int NTHREADS = 256;
constexpr float RMS_EPS = 1e-6f;
constexpr int S5G = 64, S5P = 64, S5L = 32, S5NCH = T / S5L  , S5CPB = SEQ / S5L  ;
constexpr int NH = 16, HD = 64, NG = 4, NPROJ = 2608, NPROJ_PAD = 2688, NC = 1023, NSB = 256;
constexpr int PH = 8, PK = 16, PNK = 128, PE = 16384;

constexpr size_t MiB = 1ull << 20;
constexpr size_t WS_CTL = 0;
constexpr size_t WS_MOD = 1 * MiB;
constexpr size_t WS_WIN_T = 2 * MiB;
constexpr size_t WS_WGLU_T = 4 * MiB;
constexpr size_t WS_WPROJ_T = 8 * MiB;
constexpr size_t WS_WK1_T = 14 * MiB;
constexpr size_t WS_WV1_T = 15 * MiB;
constexpr size_t WS_WK2_T = 16 * MiB;
constexpr size_t WS_WV2_T = 16 * MiB + 512 * 1024;
constexpr size_t WS_WO_T = 17 * MiB;
constexpr size_t WS_WQ_T = 19 * MiB;
constexpr size_t WS_SUBK = 27 * MiB;
constexpr size_t WS_ROPE = 28 * MiB;
constexpr size_t WS_MISC = 32 * MiB;
constexpr size_t WS_TW = 33 * MiB;
constexpr size_t WS_VG = 73 * MiB;
constexpr size_t WS_PU = 82 * MiB;
constexpr size_t WS_PV = 114 * MiB;
constexpr size_t WS_HM = 146 * MiB;
constexpr size_t WS_C = 210 * MiB;
constexpr size_t WS_UG = WS_C;
constexpr size_t WS_YI = WS_C + 64 * MiB;
constexpr size_t WS_WST = WS_C + 128 * MiB;
constexpr size_t WS_SST = WS_C + 160 * MiB;
constexpr size_t WS_YG = WS_C + 176 * MiB;
constexpr size_t WS_QK = WS_C;
constexpr size_t WS_TOPS = WS_C + 128 * MiB;
constexpr size_t WS_TOPI = WS_C + 160 * MiB;
constexpr size_t WS_EXP = WS_C + 192 * MiB;
constexpr size_t WS_GATE = WS_C + 208 * MiB;
constexpr size_t WS_Q = WS_C;
constexpr size_t WS_KC = WS_C + 64 * MiB;
constexpr size_t WS_VC = WS_C + 81 * MiB;
constexpr size_t WS_KS = WS_C + 98 * MiB;
constexpr size_t WS_VST = WS_C + 114 * MiB;
constexpr size_t WS_KW = WS_C + 130 * MiB;
constexpr size_t WS_VWT = WS_C + 146 * MiB;
constexpr size_t WS_NG = WS_C + 162 * MiB;
constexpr size_t WS_KCMP = WS_C + 170 * MiB;
constexpr size_t WS_VCMPT = WS_C + 171 * MiB;
constexpr size_t WS_HID = WS_C + 172 * MiB;
constexpr size_t WS_O = WS_C + 182 * MiB;
constexpr size_t WS_END = WS_C + 256 * MiB;

constexpr int LDS_BYTES = 73728;

struct Params {
    const float* in[29];
    float* out;
    unsigned char* ws;
    int ph_lo, ph_hi;
};

__device__ __forceinline__ unsigned f2bf(float f) { unsigned u = __builtin_bit_cast(unsigned, f); return (u + 0x7fffu + ((u >> 16) & 1u)) >> 16; }
__device__ __forceinline__ unsigned pk2(float lo, float hi) { return f2bf(lo) | (f2bf(hi) << 16); }
__device__ __forceinline__ float bf2f(unsigned h) { return __builtin_bit_cast(float, h << 16); }
__device__ __forceinline__ float bflo(unsigned w) { return __builtin_bit_cast(float, w << 16); }
__device__ __forceinline__ float bfhi(unsigned w) { return __builtin_bit_cast(float, w & 0xffff0000u); }
__device__ __forceinline__ float gelu_tanh(float x) {
    const float u = 0.7978845608028654f * (x + 0.044715f * x * x * x);
    const float e = __expf(2.0f * u);
    const float th = 1.0f - 2.0f / (e + 1.0f);
    return 0.5f * x * (1.0f + th);
}
__device__ __forceinline__ float sigmoidf_(float x) { return 1.0f / (1.0f + __expf(-x)); }
__device__ __forceinline__ float wave_sum(float v) {
#pragma unroll
    for (int o = 1; o < 64; o <<= 1) v += __shfl_xor(v, o);
    return v;
}
__device__ __forceinline__ float dot2bf(unsigned a, unsigned b, float acc) {
    return __builtin_amdgcn_fdot2_f32_bf16(__builtin_bit_cast(bf16x2_t, a), __builtin_bit_cast(bf16x2_t, b), acc, false);
}

#define LAS __attribute__((address_space(3)))
#define XB_TMO      128
#define XB_XCNT(j)  (256  + 64 * (j))
#define XB_XSUB(j)  (1280 + 64 * (j))
#define XB_XGEN(j)  (2304 + 64 * (j))
#define XB_TOP      3328
#define XB_TOPGEN   3392
#define XCD_BAR_WORDS 3456
#define XB_SPIN_CAP (1u << 24)

__device__ __forceinline__ unsigned xb_ld(unsigned* p)              { return __hip_atomic_load(p, __ATOMIC_RELAXED, __HIP_MEMORY_SCOPE_AGENT); }
__device__ __forceinline__ unsigned xb_add(unsigned* p, unsigned v) { return __hip_atomic_fetch_add(p, v, __ATOMIC_RELAXED, __HIP_MEMORY_SCOPE_AGENT); }
__device__ __forceinline__ unsigned xb_xcc_id() { return (unsigned)__builtin_amdgcn_s_getreg((3 << 11) | 20) & 0xFu; }
#define XB_SPIN(cond, bar) do { unsigned _sp = 0; while (cond) { __builtin_amdgcn_s_sleep(1); \
    if ((++_sp & 255u) == 0u) { if (xb_ld(&(bar)[XB_TMO])) break; if (_sp > XB_SPIN_CAP) { atomicAdd(&(bar)[XB_TMO], 1u); break; } } } } while (0)

struct XcdBarrier {
    unsigned* bar; unsigned x;
    volatile LAS unsigned* st;
};

__device__ __forceinline__ XcdBarrier xcd_barrier_post(unsigned* bar, volatile LAS unsigned* st) {
    XcdBarrier b; b.bar = bar; b.x = xb_xcc_id(); b.st = st;
    if (threadIdx.x == 0) (void)xb_add(&bar[XB_XCNT(b.x)], 1u);
    return b;
}
__device__ __forceinline__ void xcd_barrier_complete(unsigned* bar, unsigned x, unsigned& nloc, unsigned& nx) {
    const unsigned G = gridDim.x * gridDim.y * gridDim.z;
    unsigned sum, cnt, mine, sp = 0u;
    for (;;) {
        sum = 0u; cnt = 0u; mine = 0u;
#pragma unroll
        for (unsigned j = 0; j < 16; ++j) { const unsigned c = xb_ld(&bar[XB_XCNT(j)]); sum += c; cnt += (c > 0u) ? 1u : 0u; mine = (j == x) ? c : mine; }
        if (sum == G) break;
        __builtin_amdgcn_s_sleep(1);
        if ((++sp & 255u) == 0u) { if (xb_ld(&bar[XB_TMO])) break; if (sp > XB_SPIN_CAP) { atomicAdd(&bar[XB_TMO], 1u); break; } }
    }
    nloc = mine > 0u ? mine : 1u; nx = cnt > 0u ? cnt : 1u;
}

__device__ __forceinline__ void xcd_barrier(const XcdBarrier& b) {
    asm volatile("s_waitcnt vmcnt(0)" ::: "memory");
    __syncthreads();
    if (threadIdx.x == 0) {
        unsigned* bar = b.bar;
        __builtin_amdgcn_s_waitcnt(0);
        unsigned nloc = b.st[0], nx = b.st[1];
        if (nloc == 0u) { xcd_barrier_complete(bar, b.x, nloc, nx); b.st[0] = nloc; b.st[1] = nx; }
        const unsigned old = xb_add(&bar[XB_XSUB(b.x)], 1u);
        const unsigned gen = old / nloc;
        if (old + 1u == (gen + 1u) * nloc) {
            __builtin_amdgcn_fence(__ATOMIC_RELEASE, "agent");
            asm volatile("s_waitcnt vmcnt(0)" ::: "memory");
            const unsigned og = xb_add(&bar[XB_TOP], 1u);
            const unsigned tg = og / nx;
            if (og + 1u == (tg + 1u) * nx) xb_add(&bar[XB_TOPGEN], 1u);
            else XB_SPIN(xb_ld(&bar[XB_TOPGEN]) == tg, bar);
            __builtin_amdgcn_fence(__ATOMIC_ACQUIRE, "agent");
            xb_add(&bar[XB_XGEN(b.x)], 1u);
            asm volatile("s_waitcnt vmcnt(0)" ::: "memory");
        } else {
            XB_SPIN(xb_ld(&bar[XB_XGEN(b.x)]) == gen, bar);
            __builtin_amdgcn_fence(__ATOMIC_ACQUIRE, "agent");
            asm volatile("s_waitcnt vmcnt(0)" ::: "memory");
        }
    }
    __syncthreads();
}
__device__ __forceinline__ void prep_mod_item(const Params& p, int item, float* lds) {
    const int layer = item / 192, cg0 = (item % 192) * 32;
    const int tid = threadIdx.x, col = cg0 + (tid & 31), kg = tid >> 5;
    const float* W = p.in[4] + (size_t)layer * D * 6 * D;
    const float* c = p.in[1];
    float a0 = 0.f, a1 = 0.f;
    for (int k = kg * 128; k < kg * 128 + 128; ++k) {
        const float w = W[(size_t)k * (6 * D) + col];
        const float c0 = c[k], c1 = c[D + k];
        a0 += w * (c0 * sigmoidf_(c0));
        a1 += w * (c1 * sigmoidf_(c1));
    }
    lds[tid] = a0; lds[256 + tid] = a1;
    __syncthreads();
    if (tid < 64) {
        const int b = tid >> 5, cc = tid & 31;
        float s = 0.f;
#pragma unroll
        for (int g = 0; g < 8; ++g) s += lds[b * 256 + g * 32 + cc];
        float* MOD = (float*)(p.ws + WS_MOD);
        MOD[(size_t)(layer * 2 + b) * 6144 + cg0 + cc] = s + p.in[5][(size_t)layer * 6144 + cg0 + cc];
    }
    __syncthreads();
}

template <int MODE>
__device__ __forceinline__ void prep_transpose_item(const float* W, int K, int N, bf16_t* WT, int item, float* lds) {
    const int nbn = (N + 63) / 64, kb = item / nbn, nb = item % nbn, k0 = kb * 64, n0 = nb * 64;
    const int tid = threadIdx.x;
#pragma unroll
    for (int i = 0; i < 16; ++i) {
        const int kk = (tid >> 6) + 4 * i, nn = tid & 63;
        const float v = (n0 + nn < N) ? W[(size_t)(k0 + kk) * N + n0 + nn] : 0.f;
        lds[kk * 65 + nn] = v;
    }
    __syncthreads();
    {
        const int nn = tid >> 2, ks = (tid & 3) * 16;
        const int n = n0 + nn;
        if (n < N) {
            int np = n;
            if (MODE == 1) { const int j = (n < 1024) ? n : n - 1024; np = (j >> 4) * 32 + (j & 15) + ((n < 1024) ? 0 : 16); }
            u32x4 o0, o1;
            const float* s = lds + nn;
            o0.x = pk2(s[(ks + 0) * 65], s[(ks + 1) * 65]); o0.y = pk2(s[(ks + 2) * 65], s[(ks + 3) * 65]);
            o0.z = pk2(s[(ks + 4) * 65], s[(ks + 5) * 65]); o0.w = pk2(s[(ks + 6) * 65], s[(ks + 7) * 65]);
            o1.x = pk2(s[(ks + 8) * 65], s[(ks + 9) * 65]); o1.y = pk2(s[(ks + 10) * 65], s[(ks + 11) * 65]);
            o1.z = pk2(s[(ks + 12) * 65], s[(ks + 13) * 65]); o1.w = pk2(s[(ks + 14) * 65], s[(ks + 15) * 65]);
            u32x4* dst = (u32x4*)(WT + (size_t)np * K + k0 + ks);
            dst[0] = o0; dst[1] = o1;
        }
    }
    __syncthreads();
}

__device__ __forceinline__ void cvt_item(const float* src, bf16_t* dst, int item) {
    const size_t base = (size_t)item * 8192 + threadIdx.x * 8;
#pragma unroll
    for (int i = 0; i < 4; ++i) {
        const size_t o = base + (size_t)i * 2048;
        const f32x4 a = *(const f32x4*)(src + o), b = *(const f32x4*)(src + o + 4);
        u32x4 w; w.x = pk2(a.x, a.y); w.y = pk2(a.z, a.w); w.z = pk2(b.x, b.y); w.w = pk2(b.z, b.w);
        *(u32x4*)(dst + o) = w;
    }
}
__device__ __forceinline__ void zero_item(bf16_t* dst, int item) {
    const size_t base = (size_t)item * 8192 + threadIdx.x * 8;
#pragma unroll
    for (int i = 0; i < 4; ++i) *(u32x4*)(dst + base + (size_t)i * 2048) = (u32x4){0u, 0u, 0u, 0u};
}

struct cpx { float re, im; };
__device__ __forceinline__ cpx cmul(cpx a, cpx b) { return {a.re * b.re - a.im * b.im, a.re * b.im + a.im * b.re}; }
__device__ __forceinline__ cpx cexp_pow(float are, float aim, float dt, int m) {
    const float mag = __expf(are * dt * (float)m);
    const double rev = (double)aim * (double)dt * (double)m * 0.15915494309189535;
    const float fr = (float)(rev - rint(rev));
    return {mag * __builtin_amdgcn_cosf(fr), mag * __builtin_amdgcn_sinf(fr)};
}
__device__ __forceinline__ cpx s5_coef(float are, float aim, float dt) {
    cpx ab = cexp_pow(are, aim, dt, 1);
    const float nr = ab.re - 1.0f, ni = ab.im, den = are * are + aim * aim;
    return {(nr * are + ni * aim) / den, (ni * are - nr * aim) / den};
}

__device__ __forceinline__ void prep_s5_T_item(const Params& p, int item) {
    const int gid = item * 256 + threadIdx.x;
    const int g = gid >> 9, m = (gid >> 4) & 31, i = gid & 15;
    const float* a_re = p.in[7] + g * 64; const float* a_im = p.in[8] + g * 64;
    const float dt = __expf(p.in[9][g]);
    const float* b_re = p.in[10] + (size_t)g * 64 * 16; const float* b_im = p.in[11] + (size_t)g * 64 * 16;
    const float* c_re = p.in[12] + (size_t)g * 16 * 64 + i * 64; const float* c_im = p.in[13] + (size_t)g * 16 * 64 + i * 64;
    float acc[16];
#pragma unroll
    for (int j = 0; j < 16; ++j) acc[j] = 0.f;
    for (int q = 0; q < 64; ++q) {
        const float are = a_re[q], aim = a_im[q];
        cpx z = cmul(cmul({c_re[q], c_im[q]}, cexp_pow(are, aim, dt, m)), s5_coef(are, aim, dt));
        const f32x4* br = (const f32x4*)(b_re + q * 16); const f32x4* bi = (const f32x4*)(b_im + q * 16);
#pragma unroll
        for (int j4 = 0; j4 < 4; ++j4) {
            const f32x4 r = br[j4], im = bi[j4];
            acc[j4 * 4 + 0] += z.re * r.x - z.im * im.x; acc[j4 * 4 + 1] += z.re * r.y - z.im * im.y;
            acc[j4 * 4 + 2] += z.re * r.z - z.im * im.z; acc[j4 * 4 + 3] += z.re * r.w - z.im * im.w;
        }
    }
    u32x4 o0, o1;
    o0.x = pk2(acc[0], acc[1]); o0.y = pk2(acc[2], acc[3]); o0.z = pk2(acc[4], acc[5]); o0.w = pk2(acc[6], acc[7]);
    o1.x = pk2(acc[8], acc[9]); o1.y = pk2(acc[10], acc[11]); o1.z = pk2(acc[12], acc[13]); o1.w = pk2(acc[14], acc[15]);
    bf16_t* TW = (bf16_t*)(p.ws + WS_TW) + (size_t)g * 640 * 512;
    const u32x4 z4 = (u32x4){0u, 0u, 0u, 0u};
    for (int lp = 0; lp + m < 32; ++lp) {
        u32x4* d = (u32x4*)(TW + (size_t)((lp + m) * 16 + i) * 512 + lp * 16);
        d[0] = o0; d[1] = o1;
        if (m > 0) { u32x4* dz = (u32x4*)(TW + (size_t)(lp * 16 + i) * 512 + (lp + m) * 16); dz[0] = z4; dz[1] = z4; }
    }
}
__device__ __forceinline__ void prep_s5_W_item(const Params& p, int item) {
    const int gid = item * 256 + threadIdx.x;
    const int g = gid >> 11, q = (gid >> 5) & 63, lp = gid & 31;
    const float are = p.in[7][g * 64 + q], aim = p.in[8][g * 64 + q];
    const float dt = __expf(p.in[9][g]);
    const cpx z = cmul(cexp_pow(are, aim, dt, 31 - lp), s5_coef(are, aim, dt));
    const float* br = p.in[10] + ((size_t)g * 64 + q) * 16; const float* bi = p.in[11] + ((size_t)g * 64 + q) * 16;
    float wr[16], wi[16];
#pragma unroll
    for (int j = 0; j < 16; ++j) { wr[j] = z.re * br[j] - z.im * bi[j]; wi[j] = z.re * bi[j] + z.im * br[j]; }
    bf16_t* TW = (bf16_t*)(p.ws + WS_TW) + (size_t)g * 640 * 512;
    u32x4* d0 = (u32x4*)(TW + (size_t)(512 + q) * 512 + lp * 16);
    u32x4* d1 = (u32x4*)(TW + (size_t)(576 + q) * 512 + lp * 16);
    d0[0] = (u32x4){pk2(wr[0], wr[1]), pk2(wr[2], wr[3]), pk2(wr[4], wr[5]), pk2(wr[6], wr[7])};
    d0[1] = (u32x4){pk2(wr[8], wr[9]), pk2(wr[10], wr[11]), pk2(wr[12], wr[13]), pk2(wr[14], wr[15])};
    d1[0] = (u32x4){pk2(wi[0], wi[1]), pk2(wi[2], wi[3]), pk2(wi[4], wi[5]), pk2(wi[6], wi[7])};
    d1[1] = (u32x4){pk2(wi[8], wi[9]), pk2(wi[10], wi[11]), pk2(wi[12], wi[13]), pk2(wi[14], wi[15])};
}
__device__ __forceinline__ void prep_s5_V_item(const Params& p, int item) {
    const int gid = item * 256 + threadIdx.x;
    const int g = gid >> 14, l = (gid >> 9) & 31, i = (gid >> 5) & 15, q0 = (gid & 31) * 2;
    const float dt = __expf(p.in[9][g]);
    float vr[2], vi[2];
#pragma unroll
    for (int e = 0; e < 2; ++e) {
        const int q = q0 + e;
        const cpx z = cmul({p.in[12][((size_t)g * 16 + i) * 64 + q], p.in[13][((size_t)g * 16 + i) * 64 + q]}, cexp_pow(p.in[7][g * 64 + q], p.in[8][g * 64 + q], dt, l + 1));
        vr[e] = z.re; vi[e] = -z.im;
    }
    bf16_t* VG = (bf16_t*)(p.ws + WS_VG) + ((size_t)g * 512 + l * 16 + i) * 128;
    *(unsigned*)(VG + q0) = pk2(vr[0], vr[1]);
    *(unsigned*)(VG + 64 + q0) = pk2(vi[0], vi[1]);
}
__device__ __forceinline__ void prep_al_item(const Params& p, int item) {
    const int gid = item * 256 + threadIdx.x;
    const int g = gid >> 6;
    const float dt = __expf(p.in[9][g]);
    const cpx z = cexp_pow(p.in[7][gid], p.in[8][gid], dt, S5L);
    f32x2* AL = (f32x2*)(p.ws + WS_MISC + 4096);
    AL[gid] = (f32x2){z.re, z.im};
}
__device__ __forceinline__ void prep_rope_item(const Params& p, int item) {
    const int gid = item * 256 + threadIdx.x;
    const int pos = gid >> 5, j = gid & 31;
    const float freq = exp2f(-(float)j * (13.287712379549449f / 32.0f));
    const float ang = (float)pos * freq;
    const double rev = (double)ang * 0.15915494309189535;
    const float fr = (float)(rev - rint(rev));
    f32x2* R = (f32x2*)(p.ws + WS_ROPE);
    R[gid] = (f32x2){__builtin_amdgcn_cosf(fr), __builtin_amdgcn_sinf(fr)};
}
__device__ __forceinline__ void prep_cmpbias_item(const Params& p, int item) {
    const float* pe = p.in[17 + item]; const float* w1 = p.in[item == 0 ? 19 : 21];
    const int j = threadIdx.x;
    float s = 0.f;
    for (int k = 0; k < 2048; ++k) s += pe[k] * w1[(size_t)k * 256 + j];
    ((float*)(p.ws + WS_MISC))[item * 256 + j] = s;
}

constexpr int P0_MOD = 384;
constexpr int P0_T_WIN = 16 * 16, P0_T_WGLU = 16 * 32, P0_T_WPROJ = 16 * 41, P0_T_WK1 = 32 * 4, P0_T_WK2 = 4 * 1, P0_T_WO = 16 * 16, P0_T_WQ = 16 * 32;
constexpr int P0_SUBK = (2 * 8 * 2 * 128 * 128) / 8192;
constexpr int P0_TAB = (PE * D) / 8192;
constexpr int P0_S5T = 128, P0_S5W = 512, P0_S5V = 4096, P0_AL = 16, P0_ROPE = 2048, P0_CB = 2, P0_ZERO = 10 + 2;

__device__ __forceinline__ void phase_prep(const Params& p, float* lds) {
    const int n0 = P0_MOD;
    const int n1 = n0 + P0_T_WIN, n2 = n1 + P0_T_WGLU, n3 = n2 + P0_T_WPROJ, n4 = n3 + P0_T_WK1, n5 = n4 + P0_T_WK1, n6 = n5 + P0_T_WK2, n7 = n6 + P0_T_WK2,
              n8 = n7 + P0_T_WO, n9 = n8 + P0_T_WQ, n10 = n9 + P0_T_WQ, n11 = n10 + P0_SUBK, n12 = n11 + P0_TAB, n13 = n12 + P0_TAB,
              n14 = n13 + P0_S5T, n15 = n14 + P0_S5W, n16 = n15 + P0_S5V, n17 = n16 + P0_AL, n18 = n17 + P0_ROPE, n19 = n18 + P0_CB, n20 = n19 + 10, n21 = n20 + 2, n22 = n21 + 2;
    unsigned char* ws = p.ws;
    for (int it = blockIdx.x; it < n22; it += gridDim.x) {
        if (it < n0) prep_mod_item(p, it, lds);
        else if (it < n1) prep_transpose_item<0>(p.in[6], 1024, 1024, (bf16_t*)(ws + WS_WIN_T), it - n0, lds);
        else if (it < n2) prep_transpose_item<1>(p.in[15], 1024, 2048, (bf16_t*)(ws + WS_WGLU_T), it - n1, lds);
        else if (it < n3) prep_transpose_item<0>(p.in[16], 1024, NPROJ, (bf16_t*)(ws + WS_WPROJ_T), it - n2, lds);
        else if (it < n4) prep_transpose_item<0>(p.in[19], 2048, 256, (bf16_t*)(ws + WS_WK1_T), it - n3, lds);
        else if (it < n5) prep_transpose_item<0>(p.in[21], 2048, 256, (bf16_t*)(ws + WS_WV1_T), it - n4, lds);
        else if (it < n6) prep_transpose_item<0>(p.in[20], 256, 64, (bf16_t*)(ws + WS_WK2_T), it - n5, lds);
        else if (it < n7) prep_transpose_item<0>(p.in[22], 256, 64, (bf16_t*)(ws + WS_WV2_T), it - n6, lds);
        else if (it < n8) prep_transpose_item<0>(p.in[23], 1024, 1024, (bf16_t*)(ws + WS_WO_T), it - n7, lds);
        else if (it < n9) prep_transpose_item<0>(p.in[24], 1024, 2048, (bf16_t*)(ws + WS_WQ_T), it - n8, lds);
        else if (it < n10) prep_transpose_item<0>(p.in[24] + (size_t)1024 * 2048, 1024, 2048, (bf16_t*)(ws + WS_WQ_T) + (size_t)2048 * 1024, it - n9, lds);
        else if (it < n11) cvt_item(p.in[25], (bf16_t*)(ws + WS_SUBK), it - n10);
        else if (it < n12) cvt_item(p.in[26], (bf16_t*)(ws + WS_PU), it - n11);
        else if (it < n13) cvt_item(p.in[27], (bf16_t*)(ws + WS_PV), it - n12);
        else if (it < n14) prep_s5_T_item(p, it - n13);
        else if (it < n15) prep_s5_W_item(p, it - n14);
        else if (it < n16) prep_s5_V_item(p, it - n15);
        else if (it < n17) prep_al_item(p, it - n16);
        else if (it < n18) prep_rope_item(p, it - n17);
        else if (it < n19) prep_cmpbias_item(p, it - n18);
        else if (it < n20) zero_item((bf16_t*)(ws + WS_WPROJ_T) + (size_t)NPROJ * 1024, it - n19);
        else if (it < n21) zero_item((bf16_t*)(ws + WS_WK2_T) + (size_t)64 * 256, it - n20);
        else zero_item((bf16_t*)(ws + WS_WV2_T) + (size_t)64 * 256, it - n21);
    }
}

__device__ __forceinline__ void phase_norm(const Params& p, const float* X, const float* gw, const float* shift, const float* scale  , bf16_t* HM) {
    const int lane = threadIdx.x & 63, wave = threadIdx.x >> 6;
    for (int row = blockIdx.x * 4 + wave; row < T; row += gridDim.x * 4) {
        const int b = row / SEQ;
        const f32x4* xr = (const f32x4*)(X + (size_t)row * D) + lane;
        f32x4 v[4]; float s = 0.f;
#pragma unroll
        for (int j = 0; j < 4; ++j) { v[j] = xr[64 * j]; s += (v[j].x * v[j].x + v[j].y * v[j].y) + (v[j].z * v[j].z + v[j].w * v[j].w); }
        const float rs = rsqrtf(wave_sum(s) * (1.0f / D) + RMS_EPS);
        u32x2* o = (u32x2*)(HM + (size_t)row * D) + lane;
#pragma unroll
        for (int j = 0; j < 4; ++j) {
            const int c = lane * 4 + 256 * j;
            const f32x4 g = *(const f32x4*)(gw + c), sh = *(const f32x4*)(shift + (size_t)b * 6144 + c), sc = *(const f32x4*)(scale + (size_t)b * 6144 + c);
            const float y0 = v[j].x * rs * g.x * (1.f + sc.x) + sh.x, y1 = v[j].y * rs * g.y * (1.f + sc.y) + sh.y;
            const float y2 = v[j].z * rs * g.z * (1.f + sc.z) + sh.z, y3 = v[j].w * rs * g.w * (1.f + sc.w) + sh.w;
            o[64 * j] = (u32x2){pk2(y0, y1), pk2(y2, y3)};
        }
    }
}
__device__ __forceinline__ void phase_final_norm(const Params& p, const float* X, float* OUT, bool dry) {
    const int lane = threadIdx.x & 63, wave = threadIdx.x >> 6;
    const float* gw = p.in[28];
    for (int row = blockIdx.x * 4 + wave; row < T; row += gridDim.x * 4) {
        const f32x4* xr = (const f32x4*)(X + (size_t)row * D) + lane;
        f32x4 v[4]; float s = 0.f;
#pragma unroll
        for (int j = 0; j < 4; ++j) { v[j] = xr[64 * j]; s += (v[j].x * v[j].x + v[j].y * v[j].y) + (v[j].z * v[j].z + v[j].w * v[j].w); }
        const float rs = rsqrtf(wave_sum(s) * (1.0f / D) + RMS_EPS);
        f32x4* o = (f32x4*)(OUT + (size_t)row * D) + lane;
#pragma unroll
        for (int j = 0; j < 4; ++j) {
            const f32x4 g = *(const f32x4*)(gw + lane * 4 + 256 * j);
            if (!dry) o[64 * j] = (f32x4){v[j].x * rs * g.x, v[j].y * rs * g.y, v[j].z * rs * g.z, v[j].w * rs * g.w};
        }
    }
}

struct ALoadPlain {
    const bf16_t* A; size_t lda;
    __device__ __forceinline__ const bf16_t* ptr(int r, int k) const { return A + (size_t)r * lda + k; }
};
struct ALoadGroup {
    const bf16_t* A;
    __device__ __forceinline__ const bf16_t* ptr(int r, int k) const { return A + ((size_t)(k >> 4) * T + r) * 16 + (k & 15); }
};

template <class AL>
__device__ __forceinline__ void gemm_tile(const AL al, const bf16_t* __restrict__ Bt, size_t ldb, int nk, f32x4 (&acc)[4][4], unsigned char* lds) {
    const int tid = threadIdx.x, lane = tid & 63, wid = tid >> 6, wr = wid >> 1, wc = wid & 1, fr = lane & 15, fq = lane >> 4;
    const int lr = tid >> 3, lc = tid & 7;
#pragma unroll
    for (int mi = 0; mi < 4; ++mi)
#pragma unroll
        for (int ni = 0; ni < 4; ++ni) acc[mi][ni] = (f32x4){0.f, 0.f, 0.f, 0.f};
    u32x4 ra[4], rb[4];
    const int soff = lr * 128 + ((lc ^ (lr & 7)) << 4);
#pragma unroll
    for (int i = 0; i < 4; ++i) { ra[i] = *(const u32x4*)al.ptr(lr + 32 * i, lc * 8); rb[i] = *(const u32x4*)(Bt + (size_t)(lr + 32 * i) * ldb + lc * 8); }
#pragma unroll
    for (int i = 0; i < 4; ++i) { *(u32x4*)(lds + soff + i * 4096) = ra[i]; *(u32x4*)(lds + 16384 + soff + i * 4096) = rb[i]; }
    __syncthreads();
    const int aoff = (wr * 64 + fr) * 128, boff = 16384 + (wc * 64 + fr) * 128, sw = fr & 7;
    for (int kt = 0; kt < nk; ++kt) {
        const bool more = (kt + 1 < nk);
        if (more) {
#pragma unroll
            for (int i = 0; i < 4; ++i) { ra[i] = *(const u32x4*)al.ptr(lr + 32 * i, (kt + 1) * 64 + lc * 8); rb[i] = *(const u32x4*)(Bt + (size_t)(lr + 32 * i) * ldb + (kt + 1) * 64 + lc * 8); }
        }
        const unsigned char* buf = lds + (kt & 1) * 32768;
#pragma unroll
        for (int ks = 0; ks < 2; ++ks) {
            bf16x8 af[4], bfr[4];
            const int co = ((ks * 4 + fq) ^ sw) << 4;
#pragma unroll
            for (int mi = 0; mi < 4; ++mi) af[mi] = *(const bf16x8*)(buf + aoff + mi * 2048 + co);
#pragma unroll
            for (int ni = 0; ni < 4; ++ni) bfr[ni] = *(const bf16x8*)(buf + boff + ni * 2048 + co);
#pragma unroll
            for (int mi = 0; mi < 4; ++mi)
#pragma unroll
                for (int ni = 0; ni < 4; ++ni) acc[mi][ni] = __builtin_amdgcn_mfma_f32_16x16x32_bf16(bfr[ni], af[mi], acc[mi][ni], 0, 0, 0);
        }
        if (more) {
            unsigned char* nb = lds + ((kt + 1) & 1) * 32768;
#pragma unroll
            for (int i = 0; i < 4; ++i) { *(u32x4*)(nb + soff + i * 4096) = ra[i]; *(u32x4*)(nb + 16384 + soff + i * 4096) = rb[i]; }
        }
        __syncthreads();
    }
}
__device__ __forceinline__ void phase_s5_win(const Params& p, unsigned char* lds) {
    const bf16_t* HM = (const bf16_t*)(p.ws + WS_HM); const bf16_t* WT = (const bf16_t*)(p.ws + WS_WIN_T);
    bf16_t* UG = (bf16_t*)(p.ws + WS_UG);
    const int lane = threadIdx.x & 63, wid = threadIdx.x >> 6, wr = wid >> 1, wc = wid & 1, fr = lane & 15, fq = lane >> 4;
    for (int id = blockIdx.x; id < 256 * 8; id += gridDim.x) {
        const int mt = id >> 3, nt = id & 7;
        f32x4 acc[4][4];
        gemm_tile(ALoadPlain{HM + (size_t)mt * 128 * D, (size_t)D}, WT + (size_t)nt * 128 * D, D, 16, acc, lds);
#pragma unroll
        for (int mi = 0; mi < 4; ++mi)
#pragma unroll
            for (int ni = 0; ni < 4; ++ni) {
                const int t = mt * 128 + wr * 64 + mi * 16 + fr, g = nt * 8 + wc * 4 + ni;
                const f32x4 v = acc[mi][ni];
                *(u32x2*)(UG + ((size_t)g * T + t) * 16 + fq * 4) = (u32x2){pk2(v.x, v.y), pk2(v.z, v.w)};
            }
    }
}
__device__ __forceinline__ void phase_s5_a(const Params& p, unsigned char* lds) {
    const bf16_t* UG = (const bf16_t*)(p.ws + WS_UG); const bf16_t* TW = (const bf16_t*)(p.ws + WS_TW);
    bf16_t* YI = (bf16_t*)(p.ws + WS_YI); float* WST = (float*)(p.ws + WS_WST);
    const int lane = threadIdx.x & 63, wid = threadIdx.x >> 6, wr = wid >> 1, wc = wid & 1, fr = lane & 15, fq = lane >> 4;
    for (int id = blockIdx.x; id < 64 * 40; id += gridDim.x) {
        const int g = id / 40, rem = id % 40, mt = rem / 5, nt = rem % 5;
        const int nk = (nt < 4) ? 2 * (nt + 1) : 8;
        f32x4 acc[4][4];
        gemm_tile(ALoadPlain{UG + (size_t)g * T * 16 + (size_t)mt * 128 * 512, (size_t)512}, TW + ((size_t)g * 640 + nt * 128) * 512, 512, nk, acc, lds);
#pragma unroll
        for (int mi = 0; mi < 4; ++mi)
#pragma unroll
            for (int ni = 0; ni < 4; ++ni) {
                const int R = mt * 128 + wr * 64 + mi * 16 + fr, c = wc * 64 + ni * 16 + fq * 4;
                const f32x4 v = acc[mi][ni];
                if (nt < 4) *(u32x2*)(YI + ((size_t)g * 1024 + R) * 512 + nt * 128 + c) = (u32x2){pk2(v.x, v.y), pk2(v.z, v.w)};
                else *(f32x4*)(WST + ((size_t)g * 1024 + R) * 128 + c) = v;
            }
    }
}
__device__ __forceinline__ void phase_s5_scan(const Params& p) {
    const int lane = threadIdx.x & 63, wave = threadIdx.x >> 6;
    const float* WST = (const float*)(p.ws + WS_WST); bf16_t* SST = (bf16_t*)(p.ws + WS_SST);
    const f32x2* AL = (const f32x2*)(p.ws + WS_MISC + 4096);
    for (int it = blockIdx.x * 4 + wave; it < 128; it += gridDim.x * 4) {
        const int b = it >> 6, g = it & 63;
        const f32x2 al = AL[g * 64 + lane];
        float sr = 0.f, si = 0.f;
        const float* wbase = WST + ((size_t)g * 1024 + b * 512) * 128 + lane;
        bf16_t* sbase = SST + ((size_t)g * 1024 + b * 512) * 128 + lane;
        for (int n0 = 0; n0 < 512; n0 += 16) {
            float wre[16], wim[16];
#pragma unroll
            for (int j = 0; j < 16; ++j) { wre[j] = wbase[(size_t)(n0 + j) * 128]; wim[j] = wbase[(size_t)(n0 + j) * 128 + 64]; }
#pragma unroll
            for (int j = 0; j < 16; ++j) {
                sbase[(size_t)(n0 + j) * 128] = (bf16_t)f2bf(sr); sbase[(size_t)(n0 + j) * 128 + 64] = (bf16_t)f2bf(si);
                const float nr = al.x * sr - al.y * si + wre[j], ni = al.x * si + al.y * sr + wim[j];
                sr = nr; si = ni;
            }
        }
    }
}
__device__ __forceinline__ void phase_s5_b(const Params& p, unsigned char* lds) {
    const bf16_t* SST = (const bf16_t*)(p.ws + WS_SST); const bf16_t* VG = (const bf16_t*)(p.ws + WS_VG);
    const bf16_t* YI = (const bf16_t*)(p.ws + WS_YI); const bf16_t* UG = (const bf16_t*)(p.ws + WS_UG);
    bf16_t* YG = (bf16_t*)(p.ws + WS_YG);
    const float* dsk = p.in[14];
    const int lane = threadIdx.x & 63, wid = threadIdx.x >> 6, wr = wid >> 1, wc = wid & 1, fr = lane & 15, fq = lane >> 4;
    for (int id = blockIdx.x; id < 64 * 32; id += gridDim.x) {
        const int g = id >> 5, mt = (id >> 2) & 7, nt = id & 3;
        f32x4 acc[4][4];
        gemm_tile(ALoadPlain{SST + ((size_t)g * 1024 + mt * 128) * 128, (size_t)128}, VG + ((size_t)g * 512 + nt * 128) * 128, 128, 2, acc, lds);
        const f32x4 dv = *(const f32x4*)(dsk + g * 16 + fq * 4);
#pragma unroll
        for (int mi = 0; mi < 4; ++mi)
#pragma unroll
            for (int ni = 0; ni < 4; ++ni) {
                const int R = mt * 128 + wr * 64 + mi * 16 + fr, c = nt * 128 + wc * 64 + ni * 16 + fq * 4;
                const size_t idx = ((size_t)g * 1024 + R) * 512 + c;
                const u32x2 yi = *(const u32x2*)(YI + idx), uu = *(const u32x2*)(UG + idx);
                const f32x4 v = acc[mi][ni];
                const float y0 = gelu_tanh(v.x + bflo(yi.x) + dv.x * bflo(uu.x)), y1 = gelu_tanh(v.y + bfhi(yi.x) + dv.y * bfhi(uu.x));
                const float y2 = gelu_tanh(v.z + bflo(yi.y) + dv.z * bflo(uu.y)), y3 = gelu_tanh(v.w + bfhi(yi.y) + dv.w * bfhi(uu.y));
                *(u32x2*)(YG + idx) = (u32x2){pk2(y0, y1), pk2(y2, y3)};
            }
    }
}
__device__ __forceinline__ void phase_s5_glu(const Params& p, unsigned char* lds) {
    const bf16_t* YG = (const bf16_t*)(p.ws + WS_YG); const bf16_t* WT = (const bf16_t*)(p.ws + WS_WGLU_T);
    const float* MOD = (const float*)(p.ws + WS_MOD);
    const float* X = p.in[0]; float* XO = p.out;
    const int lane = threadIdx.x & 63, wid = threadIdx.x >> 6, wr = wid >> 1, wc = wid & 1, fr = lane & 15, fq = lane >> 4;
    for (int id = blockIdx.x; id < 256 * 16; id += gridDim.x) {
        const int mt = id >> 4, nt = id & 15;
        f32x4 acc[4][4];
        gemm_tile(ALoadGroup{YG + (size_t)mt * 128 * 16}, WT + (size_t)nt * 128 * D, D, 16, acc, lds);
        const int b = (mt * 128) / SEQ;
#pragma unroll
        for (int mi = 0; mi < 4; ++mi)
#pragma unroll
            for (int h = 0; h < 2; ++h) {
                const int t = mt * 128 + wr * 64 + mi * 16 + fr, j = nt * 64 + wc * 32 + h * 16 + fq * 4;
                const f32x4 a = acc[mi][2 * h], gg = acc[mi][2 * h + 1];
                const f32x4 g1 = *(const f32x4*)(MOD + (size_t)(0 * 2 + b) * 6144 + 2048 + j);
                const f32x4 xi = *(const f32x4*)(X + (size_t)t * D + j);
                f32x4 o;
                o.x = xi.x + g1.x * (a.x * sigmoidf_(gg.x)); o.y = xi.y + g1.y * (a.y * sigmoidf_(gg.y));
                o.z = xi.z + g1.z * (a.z * sigmoidf_(gg.z)); o.w = xi.w + g1.w * (a.w * sigmoidf_(gg.w));
                *(f32x4*)(XO + (size_t)t * D + j) = o;
            }
    }
}
__device__ __forceinline__ void phase_peer_wq(const Params& p, int layer, unsigned char* lds) {
    const bf16_t* HM = (const bf16_t*)(p.ws + WS_HM); const bf16_t* WT = (const bf16_t*)(p.ws + WS_WQ_T) + (size_t)layer * 2048 * 1024;
    bf16_t* QK = (bf16_t*)(p.ws + WS_QK);
    const int lane = threadIdx.x & 63, wid = threadIdx.x >> 6, wr = wid >> 1, wc = wid & 1, fr = lane & 15, fq = lane >> 4;
    for (int id = blockIdx.x; id < 256 * 16; id += gridDim.x) {
        const int mt = id >> 4, nt = id & 15;
        f32x4 acc[4][4];
        gemm_tile(ALoadPlain{HM + (size_t)mt * 128 * D, (size_t)D}, WT + (size_t)nt * 128 * D, D, 16, acc, lds);
#pragma unroll
        for (int mi = 0; mi < 4; ++mi)
#pragma unroll
            for (int ni = 0; ni < 4; ++ni) {
                const int t = mt * 128 + wr * 64 + mi * 16 + fr, c = nt * 128 + wc * 64 + ni * 16 + fq * 4;
                const f32x4 v = acc[mi][ni];
                *(u32x2*)(QK + (size_t)t * 2048 + c) = (u32x2){pk2(v.x, v.y), pk2(v.z, v.w)};
            }
    }
}
__device__ __forceinline__ void phase_peer_topk(const Params& p, int layer, unsigned char* lds) {
    const bf16_t* QK = (const bf16_t*)(p.ws + WS_QK); const bf16_t* SK = (const bf16_t*)(p.ws + WS_SUBK) + (size_t)layer * 8 * 2 * 128 * 128;
    float* TOPS = (float*)(p.ws + WS_TOPS); int* TOPI = (int*)(p.ws + WS_TOPI);
    float* sc = (float*)lds;
    const int tid = threadIdx.x, lane = tid & 63, wid = tid >> 6, wr = wid >> 1, wc = wid & 1, fr = lane & 15, fq = lane >> 4;
    for (int id = blockIdx.x; id < 256 * 16; id += gridDim.x) {
        const int mt = id >> 4, hc = id & 15;
        f32x4 acc[4][4];
        gemm_tile(ALoadPlain{QK + (size_t)mt * 128 * 2048 + hc * 128, (size_t)2048}, SK + (size_t)hc * 128 * 128, 128, 2, acc, lds);
#pragma unroll
        for (int mi = 0; mi < 4; ++mi)
#pragma unroll
            for (int ni = 0; ni < 4; ++ni) {
                const int r = wr * 64 + mi * 16 + fr, c = wc * 64 + ni * 16 + fq * 4;
                float* d = sc + r * 129 + c;
                d[0] = acc[mi][ni].x; d[1] = acc[mi][ni].y; d[2] = acc[mi][ni].z; d[3] = acc[mi][ni].w;
            }
        __syncthreads();
        if (tid < 128) {
            float* row = sc + tid * 129;
            const size_t ob = ((size_t)(mt * 128 + tid) * 16 + hc) * 16;
#pragma unroll 1
            for (int r = 0; r < 16; ++r) {
                float best = row[0]; int bi = 0;
#pragma unroll 8
                for (int k = 1; k < 128; ++k) { const float v = row[k]; if (v > best) { best = v; bi = k; } }
                row[bi] = -3.0e38f;
                TOPS[ob + r] = best; TOPI[ob + r] = bi;
            }
        }
        __syncthreads();
    }
}
__device__ __forceinline__ void phase_peer_combine(const Params& p, unsigned char* lds) {
    const float* TOPS = (const float*)(p.ws + WS_TOPS); const int* TOPI = (const int*)(p.ws + WS_TOPI);
    int* EXP = (int*)(p.ws + WS_EXP); float* GATE = (float*)(p.ws + WS_GATE);
    unsigned* L = (unsigned*)lds;
    const int tid = threadIdx.x;
    for (int it = blockIdx.x; it < (T * 8) / 256; it += gridDim.x) {
        const size_t th = (size_t)it * 256 + tid;
        const u32x4* S4 = (const u32x4*)(TOPS + th * 32); const u32x4* I4 = (const u32x4*)(TOPI + th * 32);
#pragma unroll
        for (int a4 = 0; a4 < 8; ++a4) {
            const u32x4 s = S4[a4], i = I4[a4];
            L[(a4 * 4 + 0) * 256 + tid] = s.x; L[(a4 * 4 + 1) * 256 + tid] = s.y; L[(a4 * 4 + 2) * 256 + tid] = s.z; L[(a4 * 4 + 3) * 256 + tid] = s.w;
            L[(32 + a4 * 4 + 0) * 256 + tid] = i.x; L[(32 + a4 * 4 + 1) * 256 + tid] = i.y; L[(32 + a4 * 4 + 2) * 256 + tid] = i.z; L[(32 + a4 * 4 + 3) * 256 + tid] = i.w;
        }
        float val[16];
        const float s20 = __builtin_bit_cast(float, L[16 * 256 + tid]);
#pragma unroll
        for (int a = 0; a < 16; ++a) val[a] = __builtin_bit_cast(float, L[a * 256 + tid]) + s20;
        unsigned long long P = 0ull;
        float ts[16]; int te[16];
#pragma unroll
        for (int r = 0; r < 16; ++r) {
            float best = val[0]; int ba = 0;
#pragma unroll
            for (int a = 1; a < 16; ++a) if (val[a] > best) { best = val[a]; ba = a; }
            const int b = (int)((P >> (4 * ba)) & 15ull);
            const int i1 = (int)L[(32 + ba) * 256 + tid], i2 = (int)L[(48 + b) * 256 + tid];
            ts[r] = best; te[r] = i1 * 128 + i2;
            const int nb = b + 1;
            float newv = -3.0e38f;
            if (nb < 16) { newv = __builtin_bit_cast(float, L[ba * 256 + tid]) + __builtin_bit_cast(float, L[(16 + nb) * 256 + tid]); P += 1ull << (4 * ba); }
#pragma unroll
            for (int a = 0; a < 16; ++a) val[a] = (a == ba) ? newv : val[a];
        }
        const float m0 = ts[0];
        float sum = 0.f;
#pragma unroll
        for (int r = 0; r < 16; ++r) { ts[r] = __expf(ts[r] - m0); sum += ts[r]; }
        const float inv = 1.0f / sum;
#pragma unroll
        for (int r = 0; r < 16; ++r) ts[r] *= inv;
#pragma unroll
        for (int r = 0; r < 16; ++r) { EXP[th * 16 + r] = te[r]; GATE[th * 16 + r] = ts[r]; }
    }
}

__device__ __forceinline__ void phase_peer_apply(const Params& p, int layer, unsigned char* lds, bool dry) {
    const int lane = threadIdx.x & 63, wave = threadIdx.x >> 6;
    float* ldsw = (float*)lds + wave * (64 * 65);
    const bf16_t* HM = (const bf16_t*)(p.ws + WS_HM); const bf16_t* PU = (const bf16_t*)(p.ws + WS_PU); const bf16_t* PV = (const bf16_t*)(p.ws + WS_PV);
    const int* EXP = (const int*)(p.ws + WS_EXP); const float* GATE = (const float*)(p.ws + WS_GATE);
    const float* MOD = (const float*)(p.ws + WS_MOD);
    float* X = p.out;
    for (int t = blockIdx.x * 4 + wave; t < T; t += gridDim.x * 4) {
        const u32x4 ha = *(const u32x4*)(HM + (size_t)t * D + lane * 8), hb = *(const u32x4*)(HM + (size_t)t * D + 512 + lane * 8);
        const int e0 = EXP[(size_t)t * 128 + lane], e1 = EXP[(size_t)t * 128 + 64 + lane];
        const float g0 = GATE[(size_t)t * 128 + lane], g1 = GATE[(size_t)t * 128 + 64 + lane];
        float act0 = 0.f, act1 = 0.f;
#pragma unroll
        for (int half = 0; half < 2; ++half) {
            const int ev = half ? e1 : e0;
#pragma unroll 1
            for (int jg = 0; jg < 8; ++jg) {
                u32x4 ua[8], ub[8];
#pragma unroll
                for (int j = 0; j < 8; ++j) {
                    const int e = __builtin_amdgcn_readlane(ev, jg * 8 + j);
                    const bf16_t* row = PU + (size_t)e * D;
                    ua[j] = *(const u32x4*)(row + lane * 8); ub[j] = *(const u32x4*)(row + 512 + lane * 8);
                }
#pragma unroll
                for (int j = 0; j < 8; ++j) {
                    float s = dot2bf(ua[j].x, ha.x, 0.f); s = dot2bf(ua[j].y, ha.y, s); s = dot2bf(ua[j].z, ha.z, s); s = dot2bf(ua[j].w, ha.w, s);
                    float s2 = dot2bf(ub[j].x, hb.x, 0.f); s2 = dot2bf(ub[j].y, hb.y, s2); s2 = dot2bf(ub[j].z, hb.z, s2); s2 = dot2bf(ub[j].w, hb.w, s2);
                    ldsw[(jg * 8 + j) * 65 + lane] = s + s2;
                }
            }
            float tot = 0.f;
#pragma unroll 16
            for (int k = 0; k < 64; ++k) tot += ldsw[lane * 65 + k];
            const float a = gelu_tanh(tot) * (half ? g1 : g0);
            if (half) act1 = a; else act0 = a;
        }
        float acc[16];
#pragma unroll
        for (int i = 0; i < 16; ++i) acc[i] = 0.f;
#pragma unroll
        for (int half = 0; half < 2; ++half) {
            const int ev = half ? e1 : e0; const float av = half ? act1 : act0;
#pragma unroll 1
            for (int jg = 0; jg < 8; ++jg) {
                u32x4 va[8], vb[8];
#pragma unroll
                for (int j = 0; j < 8; ++j) {
                    const int e = __builtin_amdgcn_readlane(ev, jg * 8 + j);
                    const bf16_t* row = PV + (size_t)e * D;
                    va[j] = *(const u32x4*)(row + lane * 8); vb[j] = *(const u32x4*)(row + 512 + lane * 8);
                }
#pragma unroll
                for (int j = 0; j < 8; ++j) {
                    const float a = __builtin_bit_cast(float, __builtin_amdgcn_readlane(__builtin_bit_cast(int, av), jg * 8 + j));
                    acc[0] += a * bflo(va[j].x); acc[1] += a * bfhi(va[j].x); acc[2] += a * bflo(va[j].y); acc[3] += a * bfhi(va[j].y);
                    acc[4] += a * bflo(va[j].z); acc[5] += a * bfhi(va[j].z); acc[6] += a * bflo(va[j].w); acc[7] += a * bfhi(va[j].w);
                    acc[8] += a * bflo(vb[j].x); acc[9] += a * bfhi(vb[j].x); acc[10] += a * bflo(vb[j].y); acc[11] += a * bfhi(vb[j].y);
                    acc[12] += a * bflo(vb[j].z); acc[13] += a * bfhi(vb[j].z); acc[14] += a * bflo(vb[j].w); acc[15] += a * bfhi(vb[j].w);
                }
            }
        }
        const int b = t / SEQ;
        const float* g2 = MOD + (size_t)(layer * 2 + b) * 6144 + 5120;
        float* xr = X + (size_t)t * D;
#pragma unroll
        for (int hh = 0; hh < 2; ++hh)
#pragma unroll
            for (int q = 0; q < 2; ++q) {
                const int c = hh * 512 + lane * 8 + q * 4;
                const f32x4 g = *(const f32x4*)(g2 + c); f32x4 x = *(const f32x4*)(xr + c);
                x.x += g.x * acc[hh * 8 + q * 4 + 0]; x.y += g.y * acc[hh * 8 + q * 4 + 1]; x.z += g.z * acc[hh * 8 + q * 4 + 2]; x.w += g.w * acc[hh * 8 + q * 4 + 3];
                if (!dry) *(f32x4*)(xr + c) = x;
            }
    }
}
__device__ __forceinline__ void phase_tab1(const Params& p) {
    for (int it = blockIdx.x; it < 2 * P0_TAB; it += gridDim.x) {
        if (it < P0_TAB) cvt_item(p.in[26] + (size_t)PE * D, (bf16_t*)(p.ws + WS_PU), it);
        else cvt_item(p.in[27] + (size_t)PE * D, (bf16_t*)(p.ws + WS_PV), it - P0_TAB);
    }
}
__device__ __forceinline__ void phase_nsa_proj(const Params& p, unsigned char* lds) {
    const bf16_t* HM = (const bf16_t*)(p.ws + WS_HM); const bf16_t* WT = (const bf16_t*)(p.ws + WS_WPROJ_T);
    const f32x2* ROPE = (const f32x2*)(p.ws + WS_ROPE);
    bf16_t* Q = (bf16_t*)(p.ws + WS_Q); float* NGT = (float*)(p.ws + WS_NG);
    const int lane = threadIdx.x & 63, wid = threadIdx.x >> 6, wr = wid >> 1, wc = wid & 1, fr = lane & 15, fq = lane >> 4;
    for (int id = blockIdx.x; id < 256 * 21; id += gridDim.x) {
        const int mt = id / 21, nt = id % 21;
        f32x4 acc[4][4];
        gemm_tile(ALoadPlain{HM + (size_t)mt * 128 * D, (size_t)D}, WT + (size_t)nt * 128 * D, D, 16, acc, lds);
        const int c0 = nt * 128 + wc * 64;
        if (c0 >= 2624) continue;
        const int b = (mt * 128) / SEQ;
        if (c0 == 2560) {
#pragma unroll
            for (int mi = 0; mi < 4; ++mi)
#pragma unroll
                for (int ni = 0; ni < 3; ++ni) {
                    const int t = mt * 128 + wr * 64 + mi * 16 + fr;
                    const f32x4 v = acc[mi][ni];
                    *(f32x4*)(NGT + (size_t)t * 48 + ni * 16 + fq * 4) = (f32x4){sigmoidf_(v.x), sigmoidf_(v.y), sigmoidf_(v.z), sigmoidf_(v.w)};
                }
            continue;
        }
        int sec = -1, g = 0;
        if (c0 >= 1024) { sec = (c0 - 1024) >> 8; g = ((c0 - 1024) & 255) >> 6; }
        const bool dorope = (sec == -1) || (sec == 2) || (sec == 4);
        const float scl = (sec == -1) ? 0.125f : 1.0f;
        const size_t secoff[6] = {WS_KC, WS_VC, WS_KS, WS_VST, WS_KW, WS_VWT};
        size_t so = WS_Q;
#pragma unroll
        for (int q = 0; q < 6; ++q) if (sec == q) so = secoff[q];
        bf16_t* OUT = (bf16_t*)(p.ws + so);
        const bool vt = (sec == 3) || (sec == 5);
#pragma unroll
        for (int mi = 0; mi < 4; ++mi) {
            const int t = mt * 128 + wr * 64 + mi * 16 + fr, s = t - b * SEQ;
            if (dorope) {
#pragma unroll
                for (int ni = 0; ni < 2; ++ni) {
                    const f32x4* rp = (const f32x4*)(ROPE + (size_t)s * 32 + ni * 16 + fq * 4);
                    const f32x4 r0 = rp[0], r1 = rp[1];
                    const f32x4 x1 = acc[mi][ni], x2 = acc[mi][ni + 2];
                    acc[mi][ni] = (f32x4){x1.x * r0.x - x2.x * r0.y, x1.y * r0.z - x2.y * r0.w, x1.z * r1.x - x2.z * r1.y, x1.w * r1.z - x2.w * r1.w};
                    acc[mi][ni + 2] = (f32x4){x1.x * r0.y + x2.x * r0.x, x1.y * r0.w + x2.y * r0.z, x1.z * r1.y + x2.z * r1.x, x1.w * r1.w + x2.w * r1.z};
                }
            }
#pragma unroll
            for (int ni = 0; ni < 4; ++ni) {
                const f32x4 v = acc[mi][ni] * scl;
                const int d = ni * 16 + fq * 4;
                if (sec == -1) {
                    *(u32x2*)(OUT + (size_t)t * 1024 + c0 + d) = (u32x2){pk2(v.x, v.y), pk2(v.z, v.w)};
                } else if (!vt) {
                    *(u32x2*)(OUT + ((size_t)(b * 4 + g) * SEQ + s) * 64 + d) = (u32x2){pk2(v.x, v.y), pk2(v.z, v.w)};
                } else {
                    bf16_t* o = OUT + ((size_t)(b * 4 + g) * 64 + d) * SEQ + s;
                    o[0] = (bf16_t)f2bf(v.x); o[SEQ] = (bf16_t)f2bf(v.y); o[2 * SEQ] = (bf16_t)f2bf(v.z); o[3 * SEQ] = (bf16_t)f2bf(v.w);
                }
            }
        }
    }
}
__device__ __forceinline__ void phase_nsa_cmp1(const Params& p, unsigned char* lds) {
    bf16_t* HID = (bf16_t*)(p.ws + WS_HID);
    const float* bias = (const float*)(p.ws + WS_MISC);
    const int lane = threadIdx.x & 63, wid = threadIdx.x >> 6, wr = wid >> 1, wc = wid & 1, fr = lane & 15, fq = lane >> 4;
    for (int id = blockIdx.x; id < 256; id += gridDim.x) {
        const int kv = id >> 7, bg = (id >> 4) & 7, mt = (id >> 1) & 7, nt = id & 1;
        const bf16_t* A = (const bf16_t*)(p.ws + (kv ? WS_VC : WS_KC)) + (size_t)bg * SEQ * 64 + (size_t)mt * 128 * 1024;
        const bf16_t* B = (const bf16_t*)(p.ws + (kv ? WS_WV1_T : WS_WK1_T)) + (size_t)nt * 128 * 2048;
        f32x4 acc[4][4];
        gemm_tile(ALoadPlain{A, (size_t)1024}, B, 2048, 32, acc, lds);
#pragma unroll
        for (int mi = 0; mi < 4; ++mi)
#pragma unroll
            for (int ni = 0; ni < 4; ++ni) {
                const int n = mt * 128 + wr * 64 + mi * 16 + fr, c = nt * 128 + wc * 64 + ni * 16 + fq * 4;
                const f32x4 bv = *(const f32x4*)(bias + kv * 256 + c);
                const f32x4 v = acc[mi][ni] + bv;
                *(u32x2*)(HID + (((size_t)kv * 8 + bg) * 1024 + n) * 256 + c) = (u32x2){pk2(gelu_tanh(v.x), gelu_tanh(v.y)), pk2(gelu_tanh(v.z), gelu_tanh(v.w))};
            }
    }
}
__device__ __forceinline__ void phase_nsa_cmp2(const Params& p, unsigned char* lds) {
    const bf16_t* HID = (const bf16_t*)(p.ws + WS_HID);
    const f32x2* ROPE = (const f32x2*)(p.ws + WS_ROPE);
    bf16_t* KCMP = (bf16_t*)(p.ws + WS_KCMP); bf16_t* VCMPT = (bf16_t*)(p.ws + WS_VCMPT);
    const int lane = threadIdx.x & 63, wid = threadIdx.x >> 6, wr = wid >> 1, wc = wid & 1, fr = lane & 15, fq = lane >> 4;
    for (int id = blockIdx.x; id < 128; id += gridDim.x) {
        const int kv = id >> 6, mt = id & 63;
        const bf16_t* A = HID + ((size_t)kv * 8192 + (size_t)mt * 128) * 256;
        const bf16_t* B = (const bf16_t*)(p.ws + (kv ? WS_WV2_T : WS_WK2_T));
        f32x4 acc[4][4];
        gemm_tile(ALoadPlain{A, (size_t)256}, B, 256, 4, acc, lds);
        if (wc == 1) continue;
#pragma unroll
        for (int mi = 0; mi < 4; ++mi) {
            const int R = mt * 128 + wr * 64 + mi * 16 + fr, bg = R >> 10, n = R & 1023;
            if (kv == 0) {
                int pos = n * 16 + 31; pos = pos > SEQ - 1 ? SEQ - 1 : pos;
#pragma unroll
                for (int ni = 0; ni < 2; ++ni) {
                    const f32x4* rp = (const f32x4*)(ROPE + (size_t)pos * 32 + ni * 16 + fq * 4);
                    const f32x4 r0 = rp[0], r1 = rp[1];
                    const f32x4 x1 = acc[mi][ni], x2 = acc[mi][ni + 2];
                    acc[mi][ni] = (f32x4){x1.x * r0.x - x2.x * r0.y, x1.y * r0.z - x2.y * r0.w, x1.z * r1.x - x2.z * r1.y, x1.w * r1.z - x2.w * r1.w};
                    acc[mi][ni + 2] = (f32x4){x1.x * r0.y + x2.x * r0.x, x1.y * r0.w + x2.y * r0.z, x1.z * r1.y + x2.z * r1.x, x1.w * r1.w + x2.w * r1.z};
                }
#pragma unroll
                for (int ni = 0; ni < 4; ++ni) {
                    const f32x4 v = acc[mi][ni];
                    *(u32x2*)(KCMP + ((size_t)bg * 1024 + n) * 64 + ni * 16 + fq * 4) = (u32x2){pk2(v.x, v.y), pk2(v.z, v.w)};
                }
            } else {
#pragma unroll
                for (int ni = 0; ni < 4; ++ni) {
                    const f32x4 v = acc[mi][ni];
                    bf16_t* o = VCMPT + ((size_t)bg * 64 + ni * 16 + fq * 4) * 1024 + n;
                    o[0] = (bf16_t)f2bf(v.x); o[1024] = (bf16_t)f2bf(v.y); o[2048] = (bf16_t)f2bf(v.z); o[3072] = (bf16_t)f2bf(v.w);
                }
            }
        }
    }
}
__device__ __forceinline__ void phase_nsa_wo(const Params& p, unsigned char* lds, bool dry) {
    const bf16_t* O = (const bf16_t*)(p.ws + WS_O); const bf16_t* WT = (const bf16_t*)(p.ws + WS_WO_T);
    const float* MOD = (const float*)(p.ws + WS_MOD);
    float* X = p.out;
    const int lane = threadIdx.x & 63, wid = threadIdx.x >> 6, wr = wid >> 1, wc = wid & 1, fr = lane & 15, fq = lane >> 4;
    for (int id = blockIdx.x; id < 256 * 8; id += gridDim.x) {
        const int mt = id >> 3, nt = id & 7;
        f32x4 acc[4][4];
        gemm_tile(ALoadPlain{O + (size_t)mt * 128 * D, (size_t)D}, WT + (size_t)nt * 128 * D, D, 16, acc, lds);
        const int b = (mt * 128) / SEQ;
#pragma unroll
        for (int mi = 0; mi < 4; ++mi)
#pragma unroll
            for (int ni = 0; ni < 4; ++ni) {
                const int t = mt * 128 + wr * 64 + mi * 16 + fr, c = nt * 128 + wc * 64 + ni * 16 + fq * 4;
                const f32x4 g1 = *(const f32x4*)(MOD + (size_t)(1 * 2 + b) * 6144 + 2048 + c);
                float* xp = X + (size_t)t * D + c;
                const f32x4 x = *(const f32x4*)xp; const f32x4 v = acc[mi][ni];
                if (!dry) *(f32x4*)xp = (f32x4){x.x + g1.x * v.x, x.y + g1.y * v.y, x.z + g1.z * v.z, x.w + g1.w * v.w};
            }
    }
}
__device__ __forceinline__ bf16x8 pack8(const f32x4 a, const f32x4 b) {
    u32x4 w; w.x = pk2(a.x, a.y); w.y = pk2(a.z, a.w); w.z = pk2(b.x, b.y); w.w = pk2(b.z, b.w);
    return __builtin_bit_cast(bf16x8, w);
}
__device__ __forceinline__ bf16x8 ldv8(const bf16_t* plo, const bf16_t* phi) {
    const u32x2 lo = *(const u32x2*)plo, hi = *(const u32x2*)phi;
    u32x4 w; w.x = lo.x; w.y = lo.y; w.z = hi.x; w.w = hi.y;
    return __builtin_bit_cast(bf16x8, w);
}
__device__ __forceinline__ float red4(float v) { v += __shfl_xor(v, 16); v += __shfl_xor(v, 32); return v; }
__device__ __forceinline__ float max4(float v) { v = fmaxf(v, __shfl_xor(v, 16)); v = fmaxf(v, __shfl_xor(v, 32)); return v; }
#define NEGBIG (-1.0e30f)

__device__ __forceinline__ void phase_nsa_attn(const Params& p, unsigned char* lds, const int rep_cmp, const int rep_win, const int rep_sel) {
    const int lane = threadIdx.x & 63, wave = threadIdx.x >> 6, fr = lane & 15, fq = lane >> 4;
    unsigned char* WL = lds + wave * 18432;
    float* IMP = (float*)WL;
    int* SEL = (int*)(WL + 17408);
    const bf16_t* Q = (const bf16_t*)(p.ws + WS_Q);
    const bf16_t* KCMP = (const bf16_t*)(p.ws + WS_KCMP); const bf16_t* VCMPT = (const bf16_t*)(p.ws + WS_VCMPT);
    const bf16_t* KS = (const bf16_t*)(p.ws + WS_KS); const bf16_t* VST = (const bf16_t*)(p.ws + WS_VST);
    const bf16_t* KW = (const bf16_t*)(p.ws + WS_KW); const bf16_t* VWT = (const bf16_t*)(p.ws + WS_VWT);
    const float* NGT = (const float*)(p.ws + WS_NG);
    bf16_t* O = (bf16_t*)(p.ws + WS_O);
    const f32x4 z4 = (f32x4){0.f, 0.f, 0.f, 0.f};
    for (int bi = blockIdx.x; bi < 2048; bi += gridDim.x) {
        const int bg = bi & 7, quad = 255 - (bi >> 3), t0 = (quad * 4 + wave) * 16, b = bg >> 2, g = bg & 3;
        const int cur = t0 >> 6;
        const size_t tok = (size_t)b * SEQ + t0 + fr;
        const int tq = t0 + fr;
        bf16x8 qf[4][2];
#pragma unroll
        for (int r = 0; r < 4; ++r)
#pragma unroll
            for (int ks = 0; ks < 2; ++ks) qf[r][ks] = *(const bf16x8*)(Q + tok * 1024 + (g * 4 + r) * 64 + ks * 32 + fq * 8);
        float gc[4], gw[4];
#pragma unroll
        for (int r = 0; r < 4; ++r) { const float* gp = NGT + tok * 48 + (g * 4 + r) * 3; gc[r] = gp[0]; gw[r] = gp[2]; }
        f32x4 acc[4][4];
        for (int rep = 0; rep < rep_win; ++rep) {
            const bf16_t* kwb = KW + (size_t)bg * SEQ * 64; const bf16_t* vwb = VWT + (size_t)bg * 64 * SEQ;
            float mw[4], lw[4];
#pragma unroll
            for (int r = 0; r < 4; ++r) { mw[r] = NEGBIG; lw[r] = 0.f;
#pragma unroll
                for (int df = 0; df < 4; ++df) acc[r][df] = z4; }
            int kmin = t0 - 511; kmin = kmin < 0 ? 0 : kmin; kmin &= ~31;
            for (int kb = kmin; kb <= t0 + 15; kb += 32) {
                bf16x8 kf[2][2];
#pragma unroll
                for (int f = 0; f < 2; ++f)
#pragma unroll
                    for (int ks = 0; ks < 2; ++ks) kf[f][ks] = *(const bf16x8*)(kwb + (size_t)(kb + f * 16 + fr) * 64 + ks * 32 + fq * 8);
                bf16x8 vf[4];
#pragma unroll
                for (int df = 0; df < 4; ++df) { const bf16_t* vp = vwb + (size_t)(df * 16 + fr) * SEQ + kb + 4 * fq; vf[df] = ldv8(vp, vp + 16); }
#pragma unroll
                for (int r = 0; r < 4; ++r) {
                    f32x4 st[2];
#pragma unroll
                    for (int f = 0; f < 2; ++f) {
                        st[f] = __builtin_amdgcn_mfma_f32_16x16x32_bf16(kf[f][0], qf[r][0], z4, 0, 0, 0);
                        st[f] = __builtin_amdgcn_mfma_f32_16x16x32_bf16(kf[f][1], qf[r][1], st[f], 0, 0, 0);
                    }
                    float mx = NEGBIG;
#pragma unroll
                    for (int f = 0; f < 2; ++f)
#pragma unroll
                        for (int e = 0; e < 4; ++e) { const int key = kb + f * 16 + fq * 4 + e; const bool ok = (key <= tq) && (key > tq - 512); if (ok) mx = fmaxf(mx, st[f][e]); }
                    mx = max4(mx);
                    const float mn = fmaxf(mw[r], mx);
                    const float al = __expf(mw[r] - mn);
                    float ps = 0.f;
#pragma unroll
                    for (int f = 0; f < 2; ++f)
#pragma unroll
                        for (int e = 0; e < 4; ++e) { const int key = kb + f * 16 + fq * 4 + e; const bool ok = (key <= tq) && (key > tq - 512); const float pv = ok ? __expf(st[f][e] - mn) : 0.f; st[f][e] = pv; ps += pv; }
                    lw[r] = lw[r] * al + ps; mw[r] = mn;
                    const bf16x8 pf = pack8(st[0], st[1]);
#pragma unroll
                    for (int df = 0; df < 4; ++df) { acc[r][df] = acc[r][df] * al; acc[r][df] = __builtin_amdgcn_mfma_f32_16x16x32_bf16(vf[df], pf, acc[r][df], 0, 0, 0); }
                    __builtin_amdgcn_sched_barrier(0);
                }
            }
#pragma unroll
            for (int r = 0; r < 4; ++r) {
                const float l = red4(lw[r]); const float sc = gw[r] / l;
#pragma unroll
                for (int df = 0; df < 4; ++df) acc[r][df] = acc[r][df] * sc;
            }
        }
        const int nmax_tile = (t0 >> 4) - 1, nmax_lane = (t0 >> 4) - 2 + (fr == 15 ? 1 : 0);
        const bf16_t* kcb = KCMP + (size_t)bg * 1024 * 64; const bf16_t* vcb = VCMPT + (size_t)bg * 64 * 1024;
        for (int rep = 0; rep < rep_cmp; ++rep) {
            const bool dry = (rep + 1 < rep_cmp);
            float mc[4], lc[4], invl[4];
#pragma unroll
            for (int r = 0; r < 4; ++r) { mc[r] = NEGBIG; lc[r] = 0.f; }
            for (int nb = 0; nb <= nmax_tile; nb += 32) {
                bf16x8 kf[2][2];
#pragma unroll
                for (int f = 0; f < 2; ++f)
#pragma unroll
                    for (int ks = 0; ks < 2; ++ks) kf[f][ks] = *(const bf16x8*)(kcb + (size_t)(nb + f * 16 + fr) * 64 + ks * 32 + fq * 8);
#pragma unroll
                for (int r = 0; r < 4; ++r) {
                    f32x4 st[2];
#pragma unroll
                    for (int f = 0; f < 2; ++f) {
                        st[f] = __builtin_amdgcn_mfma_f32_16x16x32_bf16(kf[f][0], qf[r][0], z4, 0, 0, 0);
                        st[f] = __builtin_amdgcn_mfma_f32_16x16x32_bf16(kf[f][1], qf[r][1], st[f], 0, 0, 0);
                    }
                    float mx = NEGBIG;
#pragma unroll
                    for (int f = 0; f < 2; ++f)
#pragma unroll
                        for (int e = 0; e < 4; ++e) { const int n = nb + f * 16 + fq * 4 + e; if (n <= nmax_lane) mx = fmaxf(mx, st[f][e]); }
                    mx = max4(mx);
                    const float mn = fmaxf(mc[r], mx);
                    float ps = 0.f;
#pragma unroll
                    for (int f = 0; f < 2; ++f)
#pragma unroll
                        for (int e = 0; e < 4; ++e) { const int n = nb + f * 16 + fq * 4 + e; if (n <= nmax_lane) ps += __expf(st[f][e] - mn); }
                    lc[r] = lc[r] * __expf(mc[r] - mn) + ps; mc[r] = mn;
                    __builtin_amdgcn_sched_barrier(0);
                }
            }
#pragma unroll
            for (int r = 0; r < 4; ++r) { const float l = red4(lc[r]); invl[r] = l > 0.f ? 1.0f / l : 0.f; }
            for (int i = lane; i < 16 * 260; i += 64) IMP[i] = 0.f;
            float carry = 0.f;
            for (int nb = 0; nb <= nmax_tile; nb += 32) {
                bf16x8 kf[2][2];
#pragma unroll
                for (int f = 0; f < 2; ++f)
#pragma unroll
                    for (int ks = 0; ks < 2; ++ks) kf[f][ks] = *(const bf16x8*)(kcb + (size_t)(nb + f * 16 + fr) * 64 + ks * 32 + fq * 8);
                bf16x8 vf[4];
#pragma unroll
                for (int df = 0; df < 4; ++df) { const bf16_t* vp = vcb + (size_t)(df * 16 + fr) * 1024 + nb + 4 * fq; vf[df] = ldv8(vp, vp + 16); }
                f32x4 pg[2] = {z4, z4};
#pragma unroll
                for (int r = 0; r < 4; ++r) {
                    f32x4 st[2];
#pragma unroll
                    for (int f = 0; f < 2; ++f) {
                        st[f] = __builtin_amdgcn_mfma_f32_16x16x32_bf16(kf[f][0], qf[r][0], z4, 0, 0, 0);
                        st[f] = __builtin_amdgcn_mfma_f32_16x16x32_bf16(kf[f][1], qf[r][1], st[f], 0, 0, 0);
#pragma unroll
                        for (int e = 0; e < 4; ++e) { const int n = nb + f * 16 + fq * 4 + e; st[f][e] = (n <= nmax_lane) ? __expf(st[f][e] - mc[r]) * invl[r] : 0.f; }
                        pg[f] += st[f];
                    }
                    const float gg = dry ? 0.f : gc[r];
                    const bf16x8 pf = pack8(st[0] * gg, st[1] * gg);
#pragma unroll
                    for (int df = 0; df < 4; ++df) acc[r][df] = __builtin_amdgcn_mfma_f32_16x16x32_bf16(vf[df], pf, acc[r][df], 0, 0, 0);
                    __builtin_amdgcn_sched_barrier(0);
                }
                const int src = (lane - 16) & 63;
                const float s0 = __shfl(pg[0].w, src), s1 = __shfl(pg[1].w, src), sc = __shfl(carry, src);
                const float prev0 = fq > 0 ? s0 : sc, prev1 = fq > 0 ? s1 : s0;
                const float imp0 = (pg[0].x + pg[0].y) + (pg[0].z + pg[0].w) + prev0;
                const float imp1 = (pg[1].x + pg[1].y) + (pg[1].z + pg[1].w) + prev1;
                const int jb = (nb >> 2) + fq;
                IMP[fr * 260 + jb] = imp0; IMP[fr * 260 + jb + 4] = imp1;
                carry = pg[1].w;
            }
        }
        {
            const int nf = cur >= 2 ? 3 : cur + 1;
            if (fq == 0) {
                SEL[fr * 16 + 0] = 0;
                if (cur == 1) SEL[fr * 16 + 1] = 1;
                if (cur >= 2) { SEL[fr * 16 + 1] = cur - 1; SEL[fr * 16 + 2] = cur; }
            }
            const int ncand = cur >= 3 ? cur - 2 : 0, extra = 16 - nf;
            if (ncand <= extra) {
                if (fq == 0) { for (int k = 0; k < extra; ++k) SEL[fr * 16 + nf + k] = (k < ncand) ? 1 + k : -1; }
            } else {
                for (int rnd = 0; rnd < extra; ++rnd) {
                    float bv = -1.0f; int bj = 1 << 20;
                    for (int jb = 1 + fq; jb <= cur - 2; jb += 4) { const float v = IMP[fr * 260 + jb]; if (v > bv) { bv = v; bj = jb; } }
#pragma unroll
                    for (int o = 16; o <= 32; o <<= 1) {
                        const float ov = __shfl_xor(bv, o); const int oj = __shfl_xor(bj, o);
                        if (ov > bv || (ov == bv && oj < bj)) { bv = ov; bj = oj; }
                    }
                    if (fq == 0) SEL[fr * 16 + nf + rnd] = bj;
                    if (((bj - 1) & 3) == fq) IMP[fr * 260 + bj] = -2.0f;
                }
            }
        }
        u32x2 accp[4][4];
#pragma unroll
        for (int r = 0; r < 4; ++r)
#pragma unroll
            for (int df = 0; df < 4; ++df) accp[r][df] = (u32x2){pk2(acc[r][df].x, acc[r][df].y), pk2(acc[r][df].z, acc[r][df].w)};
        for (int rep = 0; rep < rep_sel; ++rep) {
            const bool dry = (rep + 1 < rep_sel);
            const bf16_t* ksb = KS + (size_t)bg * SEQ * 64; const bf16_t* vsb = VST + (size_t)bg * 64 * SEQ;
            unsigned char* KL = WL; unsigned char* VL = WL + 8192;
            const int nv = cur + 1 < 16 ? cur + 1 : 16, total = 16 * nv;
            const int lrow = lane >> 3, lch = lane & 7;
            const int kwoff = lrow * 128 + ((lch ^ (lrow & 7)) << 4), vwoff = lrow * 144 + lch * 16;
            const int rr = fr & 3;
            u32x4 sk[8], sv[8];
            const unsigned koff = (unsigned)(lrow * 64 + lch * 8), voff = (unsigned)(lrow * SEQ + lch * 8);
            int jbn = __builtin_amdgcn_readfirstlane(SEL[0]);
            {
                const bf16_t* kb_ = ksb + (size_t)jbn * 4096; const bf16_t* vb_ = vsb + (size_t)jbn * 64;
#pragma unroll
                for (int j = 0; j < 8; ++j) { sk[j] = *(const u32x4*)(kb_ + j * 512 + koff); sv[j] = *(const u32x4*)(vb_ + (size_t)j * 8 * SEQ + voff); }
            }
            bf16x8 qs[2];
            float ms = NEGBIG, ls = 0.f;
            f32x4 os[4] = {z4, z4, z4, z4};
            int i = 0, k = 0;
            for (int v = 0; v < total; ++v) {
                const int jb = jbn;
#pragma unroll
                for (int j = 0; j < 8; ++j) { *(u32x4*)(KL + kwoff + j * 1024) = sk[j]; *(u32x4*)(VL + vwoff + j * 1152) = sv[j]; }
                if (v + 1 < total) {
                    int k2 = k + 1, i2 = i; if (k2 == nv) { k2 = 0; i2 = i + 1; }
                    jbn = __builtin_amdgcn_readfirstlane(SEL[i2 * 16 + k2]);
                    const bf16_t* kb_ = ksb + (size_t)jbn * 4096; const bf16_t* vb_ = vsb + (size_t)jbn * 64;
#pragma unroll
                    for (int j = 0; j < 8; ++j) { sk[j] = *(const u32x4*)(kb_ + j * 512 + koff); sv[j] = *(const u32x4*)(vb_ + (size_t)j * 8 * SEQ + voff); }
                }
                __builtin_amdgcn_sched_barrier(0);
                const int ti = t0 + i;
                if (k == 0) {
                    const size_t tk = (size_t)b * SEQ + ti;
#pragma unroll
                    for (int ks = 0; ks < 2; ++ks) qs[ks] = *(const bf16x8*)(Q + tk * 1024 + (g * 4 + rr) * 64 + ks * 32 + fq * 8);
                    ms = NEGBIG; ls = 0.f;
#pragma unroll
                    for (int df = 0; df < 4; ++df) os[df] = z4;
                }
                f32x4 st[4];
#pragma unroll
                for (int f = 0; f < 4; ++f) {
                    const bf16x8 k0 = *(const bf16x8*)(KL + (f * 16 + fr) * 128 + (((0 + fq) ^ (fr & 7)) << 4));
                    const bf16x8 k1 = *(const bf16x8*)(KL + (f * 16 + fr) * 128 + (((4 + fq) ^ (fr & 7)) << 4));
                    st[f] = __builtin_amdgcn_mfma_f32_16x16x32_bf16(k0, qs[0], z4, 0, 0, 0);
                    st[f] = __builtin_amdgcn_mfma_f32_16x16x32_bf16(k1, qs[1], st[f], 0, 0, 0);
                }
                if (jb == cur) {
#pragma unroll
                    for (int f = 0; f < 4; ++f)
#pragma unroll
                        for (int e = 0; e < 4; ++e) { const int key = jb * 64 + f * 16 + fq * 4 + e; if (key > ti) st[f][e] = NEGBIG; }
                }
                float mx = NEGBIG;
#pragma unroll
                for (int f = 0; f < 4; ++f) mx = fmaxf(mx, fmaxf(fmaxf(st[f].x, st[f].y), fmaxf(st[f].z, st[f].w)));
                mx = max4(mx);
                const float mn = fmaxf(ms, mx);
                const float al = __expf(ms - mn);
                float ps = 0.f;
#pragma unroll
                for (int f = 0; f < 4; ++f)
#pragma unroll
                    for (int e = 0; e < 4; ++e) { const float pv = (st[f][e] > -1.0e29f) ? __expf(st[f][e] - mn) : 0.f; st[f][e] = pv; ps += pv; }
                ls = ls * al + ps; ms = mn;
#pragma unroll
                for (int df = 0; df < 4; ++df) os[df] = os[df] * al;
#pragma unroll
                for (int s = 0; s < 2; ++s) {
                    const bf16x8 pf = pack8(st[2 * s], st[2 * s + 1]);
#pragma unroll
                    for (int df = 0; df < 4; ++df) {
                        const unsigned char* vp = VL + (df * 16 + fr) * 144 + (32 * s + 4 * fq) * 2;
                        const u32x2 lo = *(const u32x2*)vp, hi = *(const u32x2*)(vp + 32);
                        u32x4 w; w.x = lo.x; w.y = lo.y; w.z = hi.x; w.w = hi.y;
                        os[df] = __builtin_amdgcn_mfma_f32_16x16x32_bf16(__builtin_bit_cast(bf16x8, w), pf, os[df], 0, 0, 0);
                    }
                }
                if (k == nv - 1) {
                    const float l = red4(ls);
                    const float gsv = NGT[((size_t)b * SEQ + ti) * 48 + (g * 4 + rr) * 3 + 1];
                    const float sc = dry ? 0.f : gsv / l;
#pragma unroll
                    for (int df = 0; df < 4; ++df) {
                        const f32x4 val = os[df] * sc;
#pragma unroll
                        for (int r = 0; r < 4; ++r) {
                            const int srcl = r + 16 * fq;
                            const float t0_ = __shfl(val.x, srcl), t1_ = __shfl(val.y, srcl), t2_ = __shfl(val.z, srcl), t3_ = __shfl(val.w, srcl);
                            if (fr == i) {
                                const u32x2 c = accp[r][df];
                                accp[r][df] = (u32x2){pk2(bflo(c.x) + t0_, bfhi(c.x) + t1_), pk2(bflo(c.y) + t2_, bfhi(c.y) + t3_)};
                            }
                        }
                    }
                }
                ++k; if (k == nv) { k = 0; ++i; }
            }
        }
#pragma unroll
        for (int r = 0; r < 4; ++r)
#pragma unroll
            for (int df = 0; df < 4; ++df) {
                *(u32x2*)(O + tok * 1024 + (g * 4 + r) * 64 + df * 16 + fq * 4) = accp[r][df];
            }
    }
}
constexpr int NPHASES = 24;
#ifndef PROBE_PHASE
#define PROBE_PHASE (-1)
#endif
#ifndef ATT_REP_CMP
#define ATT_REP_CMP 1
#endif
#ifndef ATT_REP_WIN
#define ATT_REP_WIN 1
#endif
#ifndef ATT_REP_SEL
#define ATT_REP_SEL 1
#endif
#ifndef TS_PHASE
#define TS_PHASE (-1)
#endif
#ifndef TS_MULT
#define TS_MULT 4
#endif
#ifndef PROBE_REPS
#define PROBE_REPS 1
#endif
__global__ void __launch_bounds__(NTHREADS, 2) mega(Params p) {
    __shared__ __attribute__((aligned(16))) unsigned char lds[LDS_BYTES];
    __shared__ __attribute__((aligned(16))) unsigned bar_st[4];
    cg::grid_group grid = cg::this_grid();
    const float* MOD = (const float*)(p.ws + WS_MOD);
    bf16_t* HM = (bf16_t*)(p.ws + WS_HM);
    if (threadIdx.x < 4) bar_st[threadIdx.x] = 0u;
    __syncthreads();
    XcdBarrier bar = xcd_barrier_post((unsigned*)(p.ws + WS_CTL), (volatile LAS unsigned*)bar_st);
    const int lo = p.ph_lo, hi = p.ph_hi;
    const bool dry0 = (p.ph_hi < 0);
    const int opq = (p.ph_hi < 0) ? 1 : 0;
    unsigned long long ts_a = 0ull, ts_b = 0ull;
#define PHASE(k, call, drycall) if (lo <= (k) && (k) < hi) { \
        if (TS_PHASE == (k)) ts_a = __builtin_amdgcn_s_memrealtime(); \
        if (PROBE_PHASE == (k)) { for (int rep = 0; rep < PROBE_REPS; ++rep) { const bool dry = !dry0; drycall; __syncthreads(); } } \
        { const bool dry = dry0; call; } \
        if ((k) + 1 < hi) { if ((k) == 0) grid.sync(); else xcd_barrier(bar); } \
        if (TS_PHASE == (k)) ts_b = __builtin_amdgcn_s_memrealtime(); }
    PHASE(0, phase_prep(p, (float*)lds), phase_prep(p, (float*)lds))
    PHASE(1, phase_norm(p, p.in[0], p.in[2], MOD + 0, MOD + 1024, HM), phase_norm(p, p.in[0], p.in[2], MOD + 0, MOD + 1024, HM))
    PHASE(2, phase_s5_win(p, lds), phase_s5_win(p, lds))
    PHASE(3, phase_s5_a(p, lds), phase_s5_a(p, lds))
    PHASE(4, phase_s5_scan(p), phase_s5_scan(p))
    PHASE(5, phase_s5_b(p, lds), phase_s5_b(p, lds))
    PHASE(6, phase_s5_glu(p, lds), phase_s5_glu(p, lds))
    PHASE(7, phase_norm(p, p.out, p.in[3], MOD + 3072, MOD + 4096, HM), phase_norm(p, p.out, p.in[3], MOD + 3072, MOD + 4096, HM))
    PHASE(8, phase_peer_wq(p, 0, lds), phase_peer_wq(p, 0, lds))
    PHASE(9, phase_peer_topk(p, 0, lds), phase_peer_topk(p, 0, lds))
    PHASE(10, phase_peer_combine(p, lds), phase_peer_combine(p, lds))
    PHASE(11, phase_peer_apply(p, 0, lds, dry), phase_peer_apply(p, 0, lds, dry))
    PHASE(12, (phase_norm(p, p.out, p.in[2] + D, MOD + 2 * 6144 + 0, MOD + 2 * 6144 + 1024, HM), phase_tab1(p)), (phase_norm(p, p.out, p.in[2] + D, MOD + 2 * 6144 + 0, MOD + 2 * 6144 + 1024, HM), phase_tab1(p)))
    PHASE(13, phase_nsa_proj(p, lds), phase_nsa_proj(p, lds))
    PHASE(14, phase_nsa_cmp1(p, lds), phase_nsa_cmp1(p, lds))
    PHASE(15, phase_nsa_cmp2(p, lds), phase_nsa_cmp2(p, lds))
    PHASE(16, phase_nsa_attn(p, lds, ATT_REP_CMP + opq, ATT_REP_WIN + opq, ATT_REP_SEL + opq), phase_nsa_attn(p, lds, 1 + opq, 1 + opq, 1 + opq))
    PHASE(17, phase_nsa_wo(p, lds, dry), phase_nsa_wo(p, lds, dry))
    PHASE(18, phase_norm(p, p.out, p.in[3] + D, MOD + 2 * 6144 + 3072, MOD + 2 * 6144 + 4096, HM), phase_norm(p, p.out, p.in[3] + D, MOD + 2 * 6144 + 3072, MOD + 2 * 6144 + 4096, HM))
    PHASE(19, phase_peer_wq(p, 1, lds), phase_peer_wq(p, 1, lds))
    PHASE(20, phase_peer_topk(p, 1, lds), phase_peer_topk(p, 1, lds))
    PHASE(21, phase_peer_combine(p, lds), phase_peer_combine(p, lds))
    PHASE(22, phase_peer_apply(p, 1, lds, dry), phase_peer_apply(p, 1, lds, dry))
    PHASE(23, phase_final_norm(p, p.out, p.out, dry), phase_final_norm(p, p.out, p.out, dry))
#undef PHASE
    if (TS_PHASE >= 0 && blockIdx.x == 0 && threadIdx.x == 0) {
        const unsigned long long t0 = __builtin_amdgcn_s_memrealtime(), want = (ts_b - ts_a) * TS_MULT;
        while (__builtin_amdgcn_s_memrealtime() - t0 < want) __builtin_amdgcn_s_sleep(8);
    }
}

extern "C" void kernel_launch(void* const* d_in, const int* in_sizes, int n_in, void* d_out, int out_size, void* d_ws, size_t ws_size, hipStream_t stream) {
    static int grid_blocks = 0;
    if (!grid_blocks) {
        int dev = 0, cus = 0, per_cu = 0;
        hipGetDevice(&dev);
        hipDeviceGetAttribute(&cus, hipDeviceAttributeMultiprocessorCount, dev);
        hipOccupancyMaxActiveBlocksPerMultiprocessor(&per_cu, mega, NTHREADS, 0);
        if (per_cu > 2) per_cu = 2;
        if (per_cu < 1) per_cu = 1;
        grid_blocks = cus * per_cu;
        if (ws_size < WS_END) fprintf(stderr, "kernel_launch: workspace too small: %zu < %zu\n", ws_size, (size_t)WS_END);
        if (n_in != 29) fprintf(stderr, "kernel_launch: expected 29 inputs, got %d\n", n_in);
    }
    hipMemsetAsync((unsigned char*)d_ws + WS_CTL, 0, 16384, stream);
    Params p{};
    for (int i = 0; i < 29; ++i) p.in[i] = (const float*)d_in[i];
    p.out = (float*)d_out; p.ws = (unsigned char*)d_ws;
#if SINGLE_LAUNCH
    p.ph_lo = 0; p.ph_hi = NPHASES;
    void* args[] = {&p};
    hipError_t e = hipLaunchCooperativeKernel((void*)mega, dim3(grid_blocks), dim3(NTHREADS), args, 0, stream);
    if (e != hipSuccess) fprintf(stderr, "cooperative launch failed: %s (grid %d)\n", hipGetErrorString(e), grid_blocks);
#else
    for (int ph = 0; ph < NPHASES; ++ph) {
        p.ph_lo = ph; p.ph_hi = ph + 1;
        hipLaunchKernelGGL(mega, dim3(grid_blocks), dim3(NTHREADS), 0, stream, p);
    }
#endif
}
```

```cpp
#include <hip/hip_runtime.h>
#include <hip/hip_cooperative_groups.h>
#include <cstdio>
#include <cstdint>
namespace cg = cooperative_groups;

#ifndef SINGLE_LAUNCH
#define SINGLE_LAUNCH 1
#endif

typedef unsigned short bf16_t;
typedef short bf16x8 __attribute__((ext_vector_type(8)));
typedef float f32x4 __attribute__((ext_vector_type(4)));
typedef float f32x2 __attribute__((ext_vector_type(2)));
typedef unsigned u32x4 __attribute__((ext_vector_type(4)));
typedef unsigned u32x2 __attribute__((ext_vector_type(2)));
typedef __bf16 bf16x2_t __attribute__((ext_vector_type(2)));

constexpr int D = 1024, BATCH = 2, SEQ = 16384, T = BATCH * SEQ;
constexpr int NTHREADS = 256;
constexpr float RMS_EPS = 1e-6f;
constexpr int S5G = 64, S5P = 64, S5L = 32, S5NCH = T / S5L  , S5CPB = SEQ / S5L  ;
constexpr int NH = 16, HD = 64, NG = 4, NPROJ = 2608, NPROJ_PAD = 2688, NC = 1023, NSB = 256;
constexpr int PH = 8, PK = 16, PNK = 128, PE = 16384;

constexpr size_t MiB = 1ull << 20;
constexpr size_t WS_CTL = 0;
constexpr size_t WS_MOD = 1 * MiB;
constexpr size_t WS_WIN_T = 2 * MiB;
constexpr size_t WS_WGLU_T = 4 * MiB;
constexpr size_t WS_WPROJ_T = 8 * MiB;
constexpr size_t WS_WK1_T = 14 * MiB;
constexpr size_t WS_WV1_T = 15 * MiB;
constexpr size_t WS_WK2_T = 16 * MiB;
constexpr size_t WS_WV2_T = 16 * MiB + 512 * 1024;
constexpr size_t WS_WO_T = 17 * MiB;
constexpr size_t WS_WQ_T = 19 * MiB;
constexpr size_t WS_SUBK = 27 * MiB;
constexpr size_t WS_ROPE = 28 * MiB;
constexpr size_t WS_MISC = 32 * MiB;
constexpr size_t WS_TW = 33 * MiB;
constexpr size_t WS_VG = 73 * MiB;
constexpr size_t WS_PU = 82 * MiB;
constexpr size_t WS_PV = 114 * MiB;
constexpr size_t WS_HM = 146 * MiB;
constexpr size_t WS_C = 210 * MiB;
constexpr size_t WS_UG = WS_C;
constexpr size_t WS_YI = WS_C + 64 * MiB;
constexpr size_t WS_WST = WS_C + 128 * MiB;
constexpr size_t WS_SST = WS_C + 160 * MiB;
constexpr size_t WS_YG = WS_C + 176 * MiB;
constexpr size_t WS_QK = WS_C;
constexpr size_t WS_TOPS = WS_C + 128 * MiB;
constexpr size_t WS_TOPI = WS_C + 160 * MiB;
constexpr size_t WS_EXP = WS_C + 192 * MiB;
constexpr size_t WS_GATE = WS_C + 208 * MiB;
constexpr size_t WS_Q = WS_C;
constexpr size_t WS_KC = WS_C + 64 * MiB;
constexpr size_t WS_VC = WS_C + 81 * MiB;
constexpr size_t WS_KS = WS_C + 98 * MiB;
constexpr size_t WS_VST = WS_C + 114 * MiB;
constexpr size_t WS_KW = WS_C + 130 * MiB;
constexpr size_t WS_VWT = WS_C + 146 * MiB;
constexpr size_t WS_NG = WS_C + 162 * MiB;
constexpr size_t WS_KCMP = WS_C + 170 * MiB;
constexpr size_t WS_VCMPT = WS_C + 171 * MiB;
constexpr size_t WS_HID = WS_C + 172 * MiB;
constexpr size_t WS_O = WS_C + 182 * MiB;
constexpr size_t WS_END = WS_C + 256 * MiB;

constexpr int LDS_BYTES = 73728;

struct Params {
    const float* in[29];
    float* out;
    unsigned char* ws;
    int ph_lo, ph_hi;
};

__device__ __forceinline__ unsigned f2bf(float f) { unsigned u = __builtin_bit_cast(unsigned, f); return (u + 0x7fffu + ((u >> 16) & 1u)) >> 16; }
__device__ __forceinline__ unsigned pk2(float lo, float hi) { return f2bf(lo) | (f2bf(hi) << 16); }
__device__ __forceinline__ float bf2f(unsigned h) { return __builtin_bit_cast(float, h << 16); }
__device__ __forceinline__ float bflo(unsigned w) { return __builtin_bit_cast(float, w << 16); }
__device__ __forceinline__ float bfhi(unsigned w) { return __builtin_bit_cast(float, w & 0xffff0000u); }
__device__ __forceinline__ float gelu_tanh(float x) {
    const float u = 0.7978845608028654f * (x + 0.044715f * x * x * x);
    const float e = __expf(2.0f * u);
    const float th = 1.0f - 2.0f / (e + 1.0f);
    return 0.5f * x * (1.0f + th);
}
__device__ __forceinline__ float sigmoidf_(float x) { return 1.0f / (1.0f + __expf(-x)); }
__device__ __forceinline__ float wave_sum(float v) {
#pragma unroll
    for (int o = 1; o < 64; o <<= 1) v += __shfl_xor(v, o);
    return v;
}
__device__ __forceinline__ float dot2bf(unsigned a, unsigned b, float acc) {
    return __builtin_amdgcn_fdot2_f32_bf16(__builtin_bit_cast(bf16x2_t, a), __builtin_bit_cast(bf16x2_t, b), acc, false);
}

#define LAS __attribute__((address_space(3)))
#define XB_TMO      128
#define XB_XCNT(j)  (256  + 64 * (j))
#define XB_XSUB(j)  (1280 + 64 * (j))
#define XB_XGEN(j)  (2304 + 64 * (j))
#define XB_TOP      3328
#define XB_TOPGEN   3392
#define XCD_BAR_WORDS 3456
#define XB_SPIN_CAP (1u << 24)

__device__ __forceinline__ unsigned xb_ld(unsigned* p)              { return __hip_atomic_load(p, __ATOMIC_RELAXED, __HIP_MEMORY_SCOPE_AGENT); }
__device__ __forceinline__ unsigned xb_add(unsigned* p, unsigned v) { return __hip_atomic_fetch_add(p, v, __ATOMIC_RELAXED, __HIP_MEMORY_SCOPE_AGENT); }
__device__ __forceinline__ unsigned xb_xcc_id() { return (unsigned)__builtin_amdgcn_s_getreg((3 << 11) | 20) & 0xFu; }
#define XB_SPIN(cond, bar) do { unsigned _sp = 0; while (cond) { __builtin_amdgcn_s_sleep(1); \
    if ((++_sp & 255u) == 0u) { if (xb_ld(&(bar)[XB_TMO])) break; if (_sp > XB_SPIN_CAP) { atomicAdd(&(bar)[XB_TMO], 1u); break; } } } } while (0)

struct XcdBarrier {
    unsigned* bar; unsigned x;
    volatile LAS unsigned* st;
};

__device__ __forceinline__ XcdBarrier xcd_barrier_post(unsigned* bar, volatile LAS unsigned* st) {
    XcdBarrier b; b.bar = bar; b.x = xb_xcc_id(); b.st = st;
    if (threadIdx.x == 0) (void)xb_add(&bar[XB_XCNT(b.x)], 1u);
    return b;
}
__device__ __forceinline__ void xcd_barrier_complete(unsigned* bar, unsigned x, unsigned& nloc, unsigned& nx) {
    const unsigned G = gridDim.x * gridDim.y * gridDim.z;
    unsigned sum, cnt, mine, sp = 0u;
    for (;;) {
        sum = 0u; cnt = 0u; mine = 0u;
#pragma unroll
        for (unsigned j = 0; j < 16; ++j) { const unsigned c = xb_ld(&bar[XB_XCNT(j)]); sum += c; cnt += (c > 0u) ? 1u : 0u; mine = (j == x) ? c : mine; }
        if (sum == G) break;
        __builtin_amdgcn_s_sleep(1);
        if ((++sp & 255u) == 0u) { if (xb_ld(&bar[XB_TMO])) break; if (sp > XB_SPIN_CAP) { atomicAdd(&bar[XB_TMO], 1u); break; } }
    }
    nloc = mine > 0u ? mine : 1u; nx = cnt > 0u ? cnt : 1u;
}

__device__ __forceinline__ void xcd_barrier(const XcdBarrier& b) {
    asm volatile("s_waitcnt vmcnt(0)" ::: "memory");
    __syncthreads();
    if (threadIdx.x == 0) {
        unsigned* bar = b.bar;
        __builtin_amdgcn_s_waitcnt(0);
        unsigned nloc = b.st[0], nx = b.st[1];
        if (nloc == 0u) { xcd_barrier_complete(bar, b.x, nloc, nx); b.st[0] = nloc; b.st[1] = nx; }
        const unsigned old = xb_add(&bar[XB_XSUB(b.x)], 1u);
        const unsigned gen = old / nloc;
        if (old + 1u == (gen + 1u) * nloc) {
            __builtin_amdgcn_fence(__ATOMIC_RELEASE, "agent");
            asm volatile("s_waitcnt vmcnt(0)" ::: "memory");
            const unsigned og = xb_add(&bar[XB_TOP], 1u);
            const unsigned tg = og / nx;
            if (og + 1u == (tg + 1u) * nx) xb_add(&bar[XB_TOPGEN], 1u);
            else XB_SPIN(xb_ld(&bar[XB_TOPGEN]) == tg, bar);
            __builtin_amdgcn_fence(__ATOMIC_ACQUIRE, "agent");
            xb_add(&bar[XB_XGEN(b.x)], 1u);
            asm volatile("s_waitcnt vmcnt(0)" ::: "memory");
        } else {
            XB_SPIN(xb_ld(&bar[XB_XGEN(b.x)]) == gen, bar);
            __builtin_amdgcn_fence(__ATOMIC_ACQUIRE, "agent");
            asm volatile("s_waitcnt vmcnt(0)" ::: "memory");
        }
    }
    __syncthreads();
}
__device__ __forceinline__ void prep_mod_item(const Params& p, int item, float* lds) {
    const int layer = item / 192, cg0 = (item % 192) * 32;
    const int tid = threadIdx.x, col = cg0 + (tid & 31), kg = tid >> 5;
    const float* W = p.in[4] + (size_t)layer * D * 6 * D;
    const float* c = p.in[1];
    float a0 = 0.f, a1 = 0.f;
    for (int k = kg * 128; k < kg * 128 + 128; ++k) {
        const float w = W[(size_t)k * (6 * D) + col];
        const float c0 = c[k], c1 = c[D + k];
        a0 += w * (c0 * sigmoidf_(c0));
        a1 += w * (c1 * sigmoidf_(c1));
    }
    lds[tid] = a0; lds[256 + tid] = a1;
    __syncthreads();
    if (tid < 64) {
        const int b = tid >> 5, cc = tid & 31;
        float s = 0.f;
#pragma unroll
        for (int g = 0; g < 8; ++g) s += lds[b * 256 + g * 32 + cc];
        float* MOD = (float*)(p.ws + WS_MOD);
        MOD[(size_t)(layer * 2 + b) * 6144 + cg0 + cc] = s + p.in[5][(size_t)layer * 6144 + cg0 + cc];
    }
    __syncthreads();
}

template <int MODE>
__device__ __forceinline__ void prep_transpose_item(const float* W, int K, int N, bf16_t* WT, int item, float* lds) {
    const int nbn = (N + 63) / 64, kb = item / nbn, nb = item % nbn, k0 = kb * 64, n0 = nb * 64;
    const int tid = threadIdx.x;
#pragma unroll
    for (int i = 0; i < 16; ++i) {
        const int kk = (tid >> 6) + 4 * i, nn = tid & 63;
        const float v = (n0 + nn < N) ? W[(size_t)(k0 + kk) * N + n0 + nn] : 0.f;
        lds[kk * 65 + nn] = v;
    }
    __syncthreads();
    {
        const int nn = tid >> 2, ks = (tid & 3) * 16;
        const int n = n0 + nn;
        if (n < N) {
            int np = n;
            if (MODE == 1) { const int j = (n < 1024) ? n : n - 1024; np = (j >> 4) * 32 + (j & 15) + ((n < 1024) ? 0 : 16); }
            u32x4 o0, o1;
            const float* s = lds + nn;
            o0.x = pk2(s[(ks + 0) * 65], s[(ks + 1) * 65]); o0.y = pk2(s[(ks + 2) * 65], s[(ks + 3) * 65]);
            o0.z = pk2(s[(ks + 4) * 65], s[(ks + 5) * 65]); o0.w = pk2(s[(ks + 6) * 65], s[(ks + 7) * 65]);
            o1.x = pk2(s[(ks + 8) * 65], s[(ks + 9) * 65]); o1.y = pk2(s[(ks + 10) * 65], s[(ks + 11) * 65]);
            o1.z = pk2(s[(ks + 12) * 65], s[(ks + 13) * 65]); o1.w = pk2(s[(ks + 14) * 65], s[(ks + 15) * 65]);
            u32x4* dst = (u32x4*)(WT + (size_t)np * K + k0 + ks);
            dst[0] = o0; dst[1] = o1;
        }
    }
    __syncthreads();
}

__device__ __forceinline__ void cvt_item(const float* src, bf16_t* dst, int item) {
    const size_t base = (size_t)item * 8192 + threadIdx.x * 8;
#pragma unroll
    for (int i = 0; i < 4; ++i) {
        const size_t o = base + (size_t)i * 2048;
        const f32x4 a = *(const f32x4*)(src + o), b = *(const f32x4*)(src + o + 4);
        u32x4 w; w.x = pk2(a.x, a.y); w.y = pk2(a.z, a.w); w.z = pk2(b.x, b.y); w.w = pk2(b.z, b.w);
        *(u32x4*)(dst + o) = w;
    }
}
__device__ __forceinline__ void zero_item(bf16_t* dst, int item) {
    const size_t base = (size_t)item * 8192 + threadIdx.x * 8;
#pragma unroll
    for (int i = 0; i < 4; ++i) *(u32x4*)(dst + base + (size_t)i * 2048) = (u32x4){0u, 0u, 0u, 0u};
}

struct cpx { float re, im; };
__device__ __forceinline__ cpx cmul(cpx a, cpx b) { return {a.re * b.re - a.im * b.im, a.re * b.im + a.im * b.re}; }
__device__ __forceinline__ cpx cexp_pow(float are, float aim, float dt, int m) {
    const float mag = __expf(are * dt * (float)m);
    const double rev = (double)aim * (double)dt * (double)m * 0.15915494309189535;
    const float fr = (float)(rev - rint(rev));
    return {mag * __builtin_amdgcn_cosf(fr), mag * __builtin_amdgcn_sinf(fr)};
}
__device__ __forceinline__ cpx s5_coef(float are, float aim, float dt) {
    cpx ab = cexp_pow(are, aim, dt, 1);
    const float nr = ab.re - 1.0f, ni = ab.im, den = are * are + aim * aim;
    return {(nr * are + ni * aim) / den, (ni * are - nr * aim) / den};
}

__device__ __forceinline__ void prep_s5_T_item(const Params& p, int item) {
    const int gid = item * 256 + threadIdx.x;
    const int g = gid >> 9, m = (gid >> 4) & 31, i = gid & 15;
    const float* a_re = p.in[7] + g * 64; const float* a_im = p.in[8] + g * 64;
    const float dt = __expf(p.in[9][g]);
    const float* b_re = p.in[10] + (size_t)g * 64 * 16; const float* b_im = p.in[11] + (size_t)g * 64 * 16;
    const float* c_re = p.in[12] + (size_t)g * 16 * 64 + i * 64; const float* c_im = p.in[13] + (size_t)g * 16 * 64 + i * 64;
    float acc[16];
#pragma unroll
    for (int j = 0; j < 16; ++j) acc[j] = 0.f;
    for (int q = 0; q < 64; ++q) {
        const float are = a_re[q], aim = a_im[q];
        cpx z = cmul(cmul({c_re[q], c_im[q]}, cexp_pow(are, aim, dt, m)), s5_coef(are, aim, dt));
        const f32x4* br = (const f32x4*)(b_re + q * 16); const f32x4* bi = (const f32x4*)(b_im + q * 16);
#pragma unroll
        for (int j4 = 0; j4 < 4; ++j4) {
            const f32x4 r = br[j4], im = bi[j4];
            acc[j4 * 4 + 0] += z.re * r.x - z.im * im.x; acc[j4 * 4 + 1] += z.re * r.y - z.im * im.y;
            acc[j4 * 4 + 2] += z.re * r.z - z.im * im.z; acc[j4 * 4 + 3] += z.re * r.w - z.im * im.w;
        }
    }
    u32x4 o0, o1;
    o0.x = pk2(acc[0], acc[1]); o0.y = pk2(acc[2], acc[3]); o0.z = pk2(acc[4], acc[5]); o0.w = pk2(acc[6], acc[7]);
    o1.x = pk2(acc[8], acc[9]); o1.y = pk2(acc[10], acc[11]); o1.z = pk2(acc[12], acc[13]); o1.w = pk2(acc[14], acc[15]);
    bf16_t* TW = (bf16_t*)(p.ws + WS_TW) + (size_t)g * 640 * 512;
    const u32x4 z4 = (u32x4){0u, 0u, 0u, 0u};
    for (int lp = 0; lp + m < 32; ++lp) {
        u32x4* d = (u32x4*)(TW + (size_t)((lp + m) * 16 + i) * 512 + lp * 16);
        d[0] = o0; d[1] = o1;
        if (m > 0) { u32x4* dz = (u32x4*)(TW + (size_t)(lp * 16 + i) * 512 + (lp + m) * 16); dz[0] = z4; dz[1] = z4; }
    }
}
__device__ __forceinline__ void prep_s5_W_item(const Params& p, int item) {
    const int gid = item * 256 + threadIdx.x;
    const int g = gid >> 11, q = (gid >> 5) & 63, lp = gid & 31;
    const float are = p.in[7][g * 64 + q], aim = p.in[8][g * 64 + q];
    const float dt = __expf(p.in[9][g]);
    const cpx z = cmul(cexp_pow(are, aim, dt, 31 - lp), s5_coef(are, aim, dt));
    const float* br = p.in[10] + ((size_t)g * 64 + q) * 16; const float* bi = p.in[11] + ((size_t)g * 64 + q) * 16;
    float wr[16], wi[16];
#pragma unroll
    for (int j = 0; j < 16; ++j) { wr[j] = z.re * br[j] - z.im * bi[j]; wi[j] = z.re * bi[j] + z.im * br[j]; }
    bf16_t* TW = (bf16_t*)(p.ws + WS_TW) + (size_t)g * 640 * 512;
    u32x4* d0 = (u32x4*)(TW + (size_t)(512 + q) * 512 + lp * 16);
    u32x4* d1 = (u32x4*)(TW + (size_t)(576 + q) * 512 + lp * 16);
    d0[0] = (u32x4){pk2(wr[0], wr[1]), pk2(wr[2], wr[3]), pk2(wr[4], wr[5]), pk2(wr[6], wr[7])};
    d0[1] = (u32x4){pk2(wr[8], wr[9]), pk2(wr[10], wr[11]), pk2(wr[12], wr[13]), pk2(wr[14], wr[15])};
    d1[0] = (u32x4){pk2(wi[0], wi[1]), pk2(wi[2], wi[3]), pk2(wi[4], wi[5]), pk2(wi[6], wi[7])};
    d1[1] = (u32x4){pk2(wi[8], wi[9]), pk2(wi[10], wi[11]), pk2(wi[12], wi[13]), pk2(wi[14], wi[15])};
}
__device__ __forceinline__ void prep_s5_V_item(const Params& p, int item) {
    const int gid = item * 256 + threadIdx.x;
    const int g = gid >> 14, l = (gid >> 9) & 31, i = (gid >> 5) & 15, q0 = (gid & 31) * 2;
    const float dt = __expf(p.in[9][g]);
    float vr[2], vi[2];
#pragma unroll
    for (int e = 0; e < 2; ++e) {
        const int q = q0 + e;
        const cpx z = cmul({p.in[12][((size_t)g * 16 + i) * 64 + q], p.in[13][((size_t)g * 16 + i) * 64 + q]}, cexp_pow(p.in[7][g * 64 + q], p.in[8][g * 64 + q], dt, l + 1));
        vr[e] = z.re; vi[e] = -z.im;
    }
    bf16_t* VG = (bf16_t*)(p.ws + WS_VG) + ((size_t)g * 512 + l * 16 + i) * 128;
    *(unsigned*)(VG + q0) = pk2(vr[0], vr[1]);
    *(unsigned*)(VG + 64 + q0) = pk2(vi[0], vi[1]);
}
__device__ __forceinline__ void prep_al_item(const Params& p, int item) {
    const int gid = item * 256 + threadIdx.x;
    const int g = gid >> 6;
    const float dt = __expf(p.in[9][g]);
    const cpx z = cexp_pow(p.in[7][gid], p.in[8][gid], dt, S5L);
    f32x2* AL = (f32x2*)(p.ws + WS_MISC + 4096);
    AL[gid] = (f32x2){z.re, z.im};
}
__device__ __forceinline__ void prep_rope_item(const Params& p, int item) {
    const int gid = item * 256 + threadIdx.x;
    const int pos = gid >> 5, j = gid & 31;
    const float freq = exp2f(-(float)j * (13.287712379549449f / 32.0f));
    const float ang = (float)pos * freq;
    const double rev = (double)ang * 0.15915494309189535;
    const float fr = (float)(rev - rint(rev));
    f32x2* R = (f32x2*)(p.ws + WS_ROPE);
    R[gid] = (f32x2){__builtin_amdgcn_cosf(fr), __builtin_amdgcn_sinf(fr)};
}
__device__ __forceinline__ void prep_cmpbias_item(const Params& p, int item, float* lds) {
    const int kv = item >> 3, cg0 = (item & 7) * 32;
    const float* pe = p.in[17 + kv]; const float* w1 = p.in[kv == 0 ? 19 : 21];
    const int tid = threadIdx.x, col = cg0 + (tid & 31), kg = tid >> 5;
    float s = 0.f;
#pragma unroll 8
    for (int k = kg * 256; k < kg * 256 + 256; ++k) s += pe[k] * w1[(size_t)k * 256 + col];
    lds[tid] = s;
    __syncthreads();
    if (tid < 32) {
        float t = 0.f;
#pragma unroll
        for (int q = 0; q < 8; ++q) t += lds[q * 32 + tid];
        ((float*)(p.ws + WS_MISC))[kv * 256 + cg0 + tid] = t;
    }
    __syncthreads();
}

__device__ __forceinline__ void cvt_fp8_item(const float* src, unsigned char* dst, float* inv_scale, int item) {
    const int lane = threadIdx.x & 63, row = item * 4 + (threadIdx.x >> 6);
    const f32x4* sp = (const f32x4*)(src + (size_t)row * D + lane * 16);
    const f32x4 a = sp[0], b = sp[1], c = sp[2], d = sp[3];
    float m = fmaxf(fmaxf(fmaxf(fabsf(a.x), fabsf(a.y)), fmaxf(fabsf(a.z), fabsf(a.w))), fmaxf(fmaxf(fabsf(b.x), fabsf(b.y)), fmaxf(fabsf(b.z), fabsf(b.w))));
    m = fmaxf(m, fmaxf(fmaxf(fmaxf(fabsf(c.x), fabsf(c.y)), fmaxf(fabsf(c.z), fabsf(c.w))), fmaxf(fmaxf(fabsf(d.x), fabsf(d.y)), fmaxf(fabsf(d.z), fabsf(d.w)))));
#pragma unroll
    for (int o = 1; o < 64; o <<= 1) m = fmaxf(m, __shfl_xor(m, o));
    const float sc = m > 0.f ? 224.0f / m : 1.0f;
    u32x4 w;
    int t = 0;
    t = __builtin_amdgcn_cvt_pk_fp8_f32(a.x * sc, a.y * sc, t, false); t = __builtin_amdgcn_cvt_pk_fp8_f32(a.z * sc, a.w * sc, t, true); w.x = (unsigned)t;
    t = __builtin_amdgcn_cvt_pk_fp8_f32(b.x * sc, b.y * sc, t, false); t = __builtin_amdgcn_cvt_pk_fp8_f32(b.z * sc, b.w * sc, t, true); w.y = (unsigned)t;
    t = __builtin_amdgcn_cvt_pk_fp8_f32(c.x * sc, c.y * sc, t, false); t = __builtin_amdgcn_cvt_pk_fp8_f32(c.z * sc, c.w * sc, t, true); w.z = (unsigned)t;
    t = __builtin_amdgcn_cvt_pk_fp8_f32(d.x * sc, d.y * sc, t, false); t = __builtin_amdgcn_cvt_pk_fp8_f32(d.z * sc, d.w * sc, t, true); w.w = (unsigned)t;
    *(u32x4*)(dst + (size_t)row * D + lane * 16) = w;
    if (lane == 0) inv_scale[row] = m > 0.f ? m / 224.0f : 1.0f;
}
constexpr int P0_MOD = 384;
constexpr int P0_T_WIN = 16 * 16, P0_T_WGLU = 16 * 32, P0_T_WPROJ = 16 * 41, P0_T_WK1 = 32 * 4, P0_T_WK2 = 4 * 1, P0_T_WO = 16 * 16, P0_T_WQ = 16 * 32;
constexpr int P0_SUBK = (2 * 8 * 2 * 128 * 128) / 8192;
constexpr int P0_TAB = PE / 4;
constexpr int P0_S5T = 128, P0_S5W = 512, P0_S5V = 4096, P0_AL = 16, P0_ROPE = 2048, P0_CB = 16, P0_ZERO = 10 + 2;

__device__ __forceinline__ void phase_prep(const Params& p, float* lds) {
    const int n0 = P0_MOD;
    const int n1 = n0 + P0_T_WIN, n2 = n1 + P0_T_WGLU, n3 = n2 + P0_T_WPROJ, n4 = n3 + P0_T_WK1, n5 = n4 + P0_T_WK1, n6 = n5 + P0_T_WK2, n7 = n6 + P0_T_WK2,
              n8 = n7 + P0_T_WO, n9 = n8 + P0_T_WQ, n10 = n9 + P0_T_WQ, n11 = n10 + P0_SUBK, n12 = n11 + P0_TAB, n13 = n12 + P0_TAB,
              n14 = n13 + P0_S5T, n15 = n14 + P0_S5W, n16 = n15 + P0_S5V, n17 = n16 + P0_AL, n18 = n17 + P0_ROPE, n19 = n18 + P0_CB, n20 = n19 + 10, n21 = n20 + 2, n22 = n21 + 2;
    unsigned char* ws = p.ws;
    for (int it = blockIdx.x; it < n22; it += gridDim.x) {
        if (it < n0) prep_mod_item(p, it, lds);
        else if (it < n1) prep_transpose_item<0>(p.in[6], 1024, 1024, (bf16_t*)(ws + WS_WIN_T), it - n0, lds);
        else if (it < n2) prep_transpose_item<1>(p.in[15], 1024, 2048, (bf16_t*)(ws + WS_WGLU_T), it - n1, lds);
        else if (it < n3) prep_transpose_item<0>(p.in[16], 1024, NPROJ, (bf16_t*)(ws + WS_WPROJ_T), it - n2, lds);
        else if (it < n4) prep_transpose_item<0>(p.in[19], 2048, 256, (bf16_t*)(ws + WS_WK1_T), it - n3, lds);
        else if (it < n5) prep_transpose_item<0>(p.in[21], 2048, 256, (bf16_t*)(ws + WS_WV1_T), it - n4, lds);
        else if (it < n6) prep_transpose_item<0>(p.in[20], 256, 64, (bf16_t*)(ws + WS_WK2_T), it - n5, lds);
        else if (it < n7) prep_transpose_item<0>(p.in[22], 256, 64, (bf16_t*)(ws + WS_WV2_T), it - n6, lds);
        else if (it < n8) prep_transpose_item<0>(p.in[23], 1024, 1024, (bf16_t*)(ws + WS_WO_T), it - n7, lds);
        else if (it < n9) prep_transpose_item<0>(p.in[24], 1024, 2048, (bf16_t*)(ws + WS_WQ_T), it - n8, lds);
        else if (it < n10) prep_transpose_item<0>(p.in[24] + (size_t)1024 * 2048, 1024, 2048, (bf16_t*)(ws + WS_WQ_T) + (size_t)2048 * 1024, it - n9, lds);
        else if (it < n11) cvt_item(p.in[25], (bf16_t*)(ws + WS_SUBK), it - n10);
        else if (it < n12) cvt_fp8_item(p.in[26], ws + WS_PU, (float*)(ws + WS_PU + 24 * MiB), it - n11);
        else if (it < n13) cvt_fp8_item(p.in[27], ws + WS_PV, (float*)(ws + WS_PV + 24 * MiB), it - n12);
        else if (it < n14) prep_s5_T_item(p, it - n13);
        else if (it < n15) prep_s5_W_item(p, it - n14);
        else if (it < n16) prep_s5_V_item(p, it - n15);
        else if (it < n17) prep_al_item(p, it - n16);
        else if (it < n18) prep_rope_item(p, it - n17);
        else if (it < n19) prep_cmpbias_item(p, it - n18, lds);
        else if (it < n20) zero_item((bf16_t*)(ws + WS_WPROJ_T) + (size_t)NPROJ * 1024, it - n19);
        else if (it < n21) zero_item((bf16_t*)(ws + WS_WK2_T) + (size_t)64 * 256, it - n20);
        else zero_item((bf16_t*)(ws + WS_WV2_T) + (size_t)64 * 256, it - n21);
    }
}

__device__ __forceinline__ void phase_norm(const Params& p, const float* X, const float* gw, const float* shift, const float* scale  , bf16_t* HM) {
    const int lane = threadIdx.x & 63, wave = threadIdx.x >> 6;
    for (int row = blockIdx.x * 4 + wave; row < T; row += gridDim.x * 4) {
        const int b = row / SEQ;
        const f32x4* xr = (const f32x4*)(X + (size_t)row * D) + lane;
        f32x4 v[4]; float s = 0.f;
#pragma unroll
        for (int j = 0; j < 4; ++j) { v[j] = xr[64 * j]; s += (v[j].x * v[j].x + v[j].y * v[j].y) + (v[j].z * v[j].z + v[j].w * v[j].w); }
        const float rs = rsqrtf(wave_sum(s) * (1.0f / D) + RMS_EPS);
        u32x2* o = (u32x2*)(HM + (size_t)row * D) + lane;
#pragma unroll
        for (int j = 0; j < 4; ++j) {
            const int c = lane * 4 + 256 * j;
            const f32x4 g = *(const f32x4*)(gw + c), sh = *(const f32x4*)(shift + (size_t)b * 6144 + c), sc = *(const f32x4*)(scale + (size_t)b * 6144 + c);
            const float y0 = v[j].x * rs * g.x * (1.f + sc.x) + sh.x, y1 = v[j].y * rs * g.y * (1.f + sc.y) + sh.y;
            const float y2 = v[j].z * rs * g.z * (1.f + sc.z) + sh.z, y3 = v[j].w * rs * g.w * (1.f + sc.w) + sh.w;
            o[64 * j] = (u32x2){pk2(y0, y1), pk2(y2, y3)};
        }
    }
}
__device__ __forceinline__ void phase_final_norm(const Params& p, const float* X, float* OUT, bool dry) {
    const int lane = threadIdx.x & 63, wave = threadIdx.x >> 6;
    const float* gw = p.in[28];
    for (int row = blockIdx.x * 4 + wave; row < T; row += gridDim.x * 4) {
        const f32x4* xr = (const f32x4*)(X + (size_t)row * D) + lane;
        f32x4 v[4]; float s = 0.f;
#pragma unroll
        for (int j = 0; j < 4; ++j) { v[j] = xr[64 * j]; s += (v[j].x * v[j].x + v[j].y * v[j].y) + (v[j].z * v[j].z + v[j].w * v[j].w); }
        const float rs = rsqrtf(wave_sum(s) * (1.0f / D) + RMS_EPS);
        f32x4* o = (f32x4*)(OUT + (size_t)row * D) + lane;
#pragma unroll
        for (int j = 0; j < 4; ++j) {
            const f32x4 g = *(const f32x4*)(gw + lane * 4 + 256 * j);
            if (!dry) o[64 * j] = (f32x4){v[j].x * rs * g.x, v[j].y * rs * g.y, v[j].z * rs * g.z, v[j].w * rs * g.w};
        }
    }
}

struct ALoadPlain {
    const bf16_t* A; size_t lda;
    __device__ __forceinline__ const bf16_t* ptr(int r, int k) const { return A + (size_t)r * lda + k; }
};
struct ALoadGroup {
    const bf16_t* A;
    __device__ __forceinline__ const bf16_t* ptr(int r, int k) const { return A + ((size_t)(k >> 4) * T + r) * 16 + (k & 15); }
};

template <class AL>
__device__ __forceinline__ void gemm_tile(const AL al, const bf16_t* __restrict__ Bt, size_t ldb, int nk, f32x4 (&acc)[4][4], unsigned char* lds) {
    const int tid = threadIdx.x, lane = tid & 63, wid = tid >> 6, wr = wid >> 1, wc = wid & 1, fr = lane & 15, fq = lane >> 4;
    const int lr = tid >> 3, lc = tid & 7;
#pragma unroll
    for (int mi = 0; mi < 4; ++mi)
#pragma unroll
        for (int ni = 0; ni < 4; ++ni) acc[mi][ni] = (f32x4){0.f, 0.f, 0.f, 0.f};
    u32x4 ra[4], rb[4];
    const int soff = lr * 128 + ((lc ^ (lr & 7)) << 4);
#pragma unroll
    for (int i = 0; i < 4; ++i) { ra[i] = *(const u32x4*)al.ptr(lr + 32 * i, lc * 8); rb[i] = *(const u32x4*)(Bt + (size_t)(lr + 32 * i) * ldb + lc * 8); }
#pragma unroll
    for (int i = 0; i < 4; ++i) { *(u32x4*)(lds + soff + i * 4096) = ra[i]; *(u32x4*)(lds + 16384 + soff + i * 4096) = rb[i]; }
    __syncthreads();
    const int aoff = (wr * 64 + fr) * 128, boff = 16384 + (wc * 64 + fr) * 128, sw = fr & 7;
    for (int kt = 0; kt < nk; ++kt) {
        const bool more = (kt + 1 < nk);
        if (more) {
#pragma unroll
            for (int i = 0; i < 4; ++i) { ra[i] = *(const u32x4*)al.ptr(lr + 32 * i, (kt + 1) * 64 + lc * 8); rb[i] = *(const u32x4*)(Bt + (size_t)(lr + 32 * i) * ldb + (kt + 1) * 64 + lc * 8); }
        }
        const unsigned char* buf = lds + (kt & 1) * 32768;
#pragma unroll
        for (int ks = 0; ks < 2; ++ks) {
            bf16x8 af[4], bfr[4];
            const int co = ((ks * 4 + fq) ^ sw) << 4;
#pragma unroll
            for (int mi = 0; mi < 4; ++mi) af[mi] = *(const bf16x8*)(buf + aoff + mi * 2048 + co);
#pragma unroll
            for (int ni = 0; ni < 4; ++ni) bfr[ni] = *(const bf16x8*)(buf + boff + ni * 2048 + co);
#pragma unroll
            for (int mi = 0; mi < 4; ++mi)
#pragma unroll
                for (int ni = 0; ni < 4; ++ni) acc[mi][ni] = __builtin_amdgcn_mfma_f32_16x16x32_bf16(bfr[ni], af[mi], acc[mi][ni], 0, 0, 0);
        }
        if (more) {
            unsigned char* nb = lds + ((kt + 1) & 1) * 32768;
#pragma unroll
            for (int i = 0; i < 4; ++i) { *(u32x4*)(nb + soff + i * 4096) = ra[i]; *(u32x4*)(nb + 16384 + soff + i * 4096) = rb[i]; }
        }
        __syncthreads();
    }
}
__device__ __forceinline__ void phase_s5_win(const Params& p, unsigned char* lds) {
    const bf16_t* HM = (const bf16_t*)(p.ws + WS_HM); const bf16_t* WT = (const bf16_t*)(p.ws + WS_WIN_T);
    bf16_t* UG = (bf16_t*)(p.ws + WS_UG);
    const int lane = threadIdx.x & 63, wid = threadIdx.x >> 6, wr = wid >> 1, wc = wid & 1, fr = lane & 15, fq = lane >> 4;
    for (int id = blockIdx.x; id < 256 * 8; id += gridDim.x) {
        const int mt = id >> 3, nt = id & 7;
        f32x4 acc[4][4];
        gemm_tile(ALoadPlain{HM + (size_t)mt * 128 * D, (size_t)D}, WT + (size_t)nt * 128 * D, D, 16, acc, lds);
#pragma unroll
        for (int mi = 0; mi < 4; ++mi)
#pragma unroll
            for (int ni = 0; ni < 4; ++ni) {
                const int t = mt * 128 + wr * 64 + mi * 16 + fr, g = nt * 8 + wc * 4 + ni;
                const f32x4 v = acc[mi][ni];
                *(u32x2*)(UG + ((size_t)g * T + t) * 16 + fq * 4) = (u32x2){pk2(v.x, v.y), pk2(v.z, v.w)};
            }
    }
}
__device__ __forceinline__ void phase_s5_a(const Params& p, unsigned char* lds) {
    const bf16_t* UG = (const bf16_t*)(p.ws + WS_UG); const bf16_t* TW = (const bf16_t*)(p.ws + WS_TW);
    bf16_t* YI = (bf16_t*)(p.ws + WS_YI); float* WST = (float*)(p.ws + WS_WST);
    const int lane = threadIdx.x & 63, wid = threadIdx.x >> 6, wr = wid >> 1, wc = wid & 1, fr = lane & 15, fq = lane >> 4;
    for (int id = blockIdx.x; id < 64 * 40; id += gridDim.x) {
        const int g = id / 40, rem = id % 40, mt = rem / 5, nt = rem % 5;
        const int nk = (nt < 4) ? 2 * (nt + 1) : 8;
        f32x4 acc[4][4];
        gemm_tile(ALoadPlain{UG + (size_t)g * T * 16 + (size_t)mt * 128 * 512, (size_t)512}, TW + ((size_t)g * 640 + nt * 128) * 512, 512, nk, acc, lds);
#pragma unroll
        for (int mi = 0; mi < 4; ++mi)
#pragma unroll
            for (int ni = 0; ni < 4; ++ni) {
                const int R = mt * 128 + wr * 64 + mi * 16 + fr, c = wc * 64 + ni * 16 + fq * 4;
                const f32x4 v = acc[mi][ni];
                if (nt < 4) *(u32x2*)(YI + ((size_t)g * 1024 + R) * 512 + nt * 128 + c) = (u32x2){pk2(v.x, v.y), pk2(v.z, v.w)};
                else *(f32x4*)(WST + ((size_t)g * 1024 + R) * 128 + c) = v;
            }
    }
}
__device__ __forceinline__ void phase_s5_scan(const Params& p) {
    const int lane = threadIdx.x & 63, wave = threadIdx.x >> 6;
    const float* WST = (const float*)(p.ws + WS_WST); bf16_t* SST = (bf16_t*)(p.ws + WS_SST);
    const f32x2* AL = (const f32x2*)(p.ws + WS_MISC + 4096);
    for (int it = blockIdx.x * 4 + wave; it < 128; it += gridDim.x * 4) {
        const int b = it >> 6, g = it & 63;
        const f32x2 al = AL[g * 64 + lane];
        float sr = 0.f, si = 0.f;
        const float* wbase = WST + ((size_t)g * 1024 + b * 512) * 128 + lane;
        bf16_t* sbase = SST + ((size_t)g * 1024 + b * 512) * 128 + lane;
        for (int n0 = 0; n0 < 512; n0 += 16) {
            float wre[16], wim[16];
#pragma unroll
            for (int j = 0; j < 16; ++j) { wre[j] = wbase[(size_t)(n0 + j) * 128]; wim[j] = wbase[(size_t)(n0 + j) * 128 + 64]; }
#pragma unroll
            for (int j = 0; j < 16; ++j) {
                sbase[(size_t)(n0 + j) * 128] = (bf16_t)f2bf(sr); sbase[(size_t)(n0 + j) * 128 + 64] = (bf16_t)f2bf(si);
                const float nr = al.x * sr - al.y * si + wre[j], ni = al.x * si + al.y * sr + wim[j];
                sr = nr; si = ni;
            }
        }
    }
}
__device__ __forceinline__ void phase_s5_b(const Params& p, unsigned char* lds) {
    const bf16_t* SST = (const bf16_t*)(p.ws + WS_SST); const bf16_t* VG = (const bf16_t*)(p.ws + WS_VG);
    const bf16_t* YI = (const bf16_t*)(p.ws + WS_YI); const bf16_t* UG = (const bf16_t*)(p.ws + WS_UG);
    bf16_t* YG = (bf16_t*)(p.ws + WS_YG);
    const float* dsk = p.in[14];
    const int lane = threadIdx.x & 63, wid = threadIdx.x >> 6, wr = wid >> 1, wc = wid & 1, fr = lane & 15, fq = lane >> 4;
    for (int id = blockIdx.x; id < 64 * 32; id += gridDim.x) {
        const int g = id >> 5, mt = (id >> 2) & 7, nt = id & 3;
        f32x4 acc[4][4];
        gemm_tile(ALoadPlain{SST + ((size_t)g * 1024 + mt * 128) * 128, (size_t)128}, VG + ((size_t)g * 512 + nt * 128) * 128, 128, 2, acc, lds);
        const f32x4 dv = *(const f32x4*)(dsk + g * 16 + fq * 4);
#pragma unroll
        for (int mi = 0; mi < 4; ++mi)
#pragma unroll
            for (int ni = 0; ni < 4; ++ni) {
                const int R = mt * 128 + wr * 64 + mi * 16 + fr, c = nt * 128 + wc * 64 + ni * 16 + fq * 4;
                const size_t idx = ((size_t)g * 1024 + R) * 512 + c;
                const u32x2 yi = *(const u32x2*)(YI + idx), uu = *(const u32x2*)(UG + idx);
                const f32x4 v = acc[mi][ni];
                const float y0 = gelu_tanh(v.x + bflo(yi.x) + dv.x * bflo(uu.x)), y1 = gelu_tanh(v.y + bfhi(yi.x) + dv.y * bfhi(uu.x));
                const float y2 = gelu_tanh(v.z + bflo(yi.y) + dv.z * bflo(uu.y)), y3 = gelu_tanh(v.w + bfhi(yi.y) + dv.w * bfhi(uu.y));
                *(u32x2*)(YG + idx) = (u32x2){pk2(y0, y1), pk2(y2, y3)};
            }
    }
}
__device__ __forceinline__ void phase_s5_glu(const Params& p, unsigned char* lds) {
    const bf16_t* YG = (const bf16_t*)(p.ws + WS_YG); const bf16_t* WT = (const bf16_t*)(p.ws + WS_WGLU_T);
    const float* MOD = (const float*)(p.ws + WS_MOD);
    const float* X = p.in[0]; float* XO = p.out;
    const int lane = threadIdx.x & 63, wid = threadIdx.x >> 6, wr = wid >> 1, wc = wid & 1, fr = lane & 15, fq = lane >> 4;
    for (int id = blockIdx.x; id < 256 * 16; id += gridDim.x) {
        const int mt = id >> 4, nt = id & 15;
        f32x4 acc[4][4];
        gemm_tile(ALoadGroup{YG + (size_t)mt * 128 * 16}, WT + (size_t)nt * 128 * D, D, 16, acc, lds);
        const int b = (mt * 128) / SEQ;
#pragma unroll
        for (int mi = 0; mi < 4; ++mi)
#pragma unroll
            for (int h = 0; h < 2; ++h) {
                const int t = mt * 128 + wr * 64 + mi * 16 + fr, j = nt * 64 + wc * 32 + h * 16 + fq * 4;
                const f32x4 a = acc[mi][2 * h], gg = acc[mi][2 * h + 1];
                const f32x4 g1 = *(const f32x4*)(MOD + (size_t)(0 * 2 + b) * 6144 + 2048 + j);
                const f32x4 xi = *(const f32x4*)(X + (size_t)t * D + j);
                f32x4 o;
                o.x = xi.x + g1.x * (a.x * sigmoidf_(gg.x)); o.y = xi.y + g1.y * (a.y * sigmoidf_(gg.y));
                o.z = xi.z + g1.z * (a.z * sigmoidf_(gg.z)); o.w = xi.w + g1.w * (a.w * sigmoidf_(gg.w));
                *(f32x4*)(XO + (size_t)t * D + j) = o;
            }
    }
}
__device__ __forceinline__ void phase_peer_wq(const Params& p, int layer, unsigned char* lds) {
    const bf16_t* HM = (const bf16_t*)(p.ws + WS_HM); const bf16_t* WT = (const bf16_t*)(p.ws + WS_WQ_T) + (size_t)layer * 2048 * 1024;
    bf16_t* QK = (bf16_t*)(p.ws + WS_QK);
    const int lane = threadIdx.x & 63, wid = threadIdx.x >> 6, wr = wid >> 1, wc = wid & 1, fr = lane & 15, fq = lane >> 4;
    for (int id = blockIdx.x; id < 256 * 16; id += gridDim.x) {
        const int mt = id >> 4, nt = id & 15;
        f32x4 acc[4][4];
        gemm_tile(ALoadPlain{HM + (size_t)mt * 128 * D, (size_t)D}, WT + (size_t)nt * 128 * D, D, 16, acc, lds);
#pragma unroll
        for (int mi = 0; mi < 4; ++mi)
#pragma unroll
            for (int ni = 0; ni < 4; ++ni) {
                const int t = mt * 128 + wr * 64 + mi * 16 + fr, c = nt * 128 + wc * 64 + ni * 16 + fq * 4;
                const f32x4 v = acc[mi][ni];
                *(u32x2*)(QK + (size_t)t * 2048 + c) = (u32x2){pk2(v.x, v.y), pk2(v.z, v.w)};
            }
    }
}
__device__ __forceinline__ void phase_peer_topk(const Params& p, int layer, unsigned char* lds) {
    const bf16_t* QK = (const bf16_t*)(p.ws + WS_QK); const bf16_t* SK = (const bf16_t*)(p.ws + WS_SUBK) + (size_t)layer * 8 * 2 * 128 * 128;
    float* TOPS = (float*)(p.ws + WS_TOPS); int* TOPI = (int*)(p.ws + WS_TOPI);
    float* sc = (float*)lds;
    const int tid = threadIdx.x, lane = tid & 63, wid = tid >> 6, wr = wid >> 1, wc = wid & 1, fr = lane & 15, fq = lane >> 4;
    for (int id = blockIdx.x; id < 256 * 16; id += gridDim.x) {
        const int mt = id >> 4, hc = id & 15;
        f32x4 acc[4][4];
        gemm_tile(ALoadPlain{QK + (size_t)mt * 128 * 2048 + hc * 128, (size_t)2048}, SK + (size_t)hc * 128 * 128, 128, 2, acc, lds);
#pragma unroll
        for (int mi = 0; mi < 4; ++mi)
#pragma unroll
            for (int ni = 0; ni < 4; ++ni) {
                const int r = wr * 64 + mi * 16 + fr, c = wc * 64 + ni * 16 + fq * 4;
                float* d = sc + r * 129 + c;
                d[0] = acc[mi][ni].x; d[1] = acc[mi][ni].y; d[2] = acc[mi][ni].z; d[3] = acc[mi][ni].w;
            }
        __syncthreads();
        if (tid < 128) {
            float* row = sc + tid * 129;
            const size_t ob = ((size_t)(mt * 128 + tid) * 16 + hc) * 16;
#pragma unroll 1
            for (int r = 0; r < 16; ++r) {
                float best = row[0]; int bi = 0;
#pragma unroll 8
                for (int k = 1; k < 128; ++k) { const float v = row[k]; if (v > best) { best = v; bi = k; } }
                row[bi] = -3.0e38f;
                TOPS[ob + r] = best; TOPI[ob + r] = bi;
            }
        }
        __syncthreads();
    }
}
__device__ __forceinline__ void phase_peer_combine(const Params& p, unsigned char* lds) {
    const float* TOPS = (const float*)(p.ws + WS_TOPS); const int* TOPI = (const int*)(p.ws + WS_TOPI);
    int* EXP = (int*)(p.ws + WS_EXP); float* GATE = (float*)(p.ws + WS_GATE);
    unsigned* L = (unsigned*)lds;
    const int tid = threadIdx.x;
    for (int it = blockIdx.x; it < (T * 8) / 256; it += gridDim.x) {
        const size_t th = (size_t)it * 256 + tid;
        const u32x4* S4 = (const u32x4*)(TOPS + th * 32); const u32x4* I4 = (const u32x4*)(TOPI + th * 32);
#pragma unroll
        for (int a4 = 0; a4 < 8; ++a4) {
            const u32x4 s = S4[a4], i = I4[a4];
            L[(a4 * 4 + 0) * 256 + tid] = s.x; L[(a4 * 4 + 1) * 256 + tid] = s.y; L[(a4 * 4 + 2) * 256 + tid] = s.z; L[(a4 * 4 + 3) * 256 + tid] = s.w;
            L[(32 + a4 * 4 + 0) * 256 + tid] = i.x; L[(32 + a4 * 4 + 1) * 256 + tid] = i.y; L[(32 + a4 * 4 + 2) * 256 + tid] = i.z; L[(32 + a4 * 4 + 3) * 256 + tid] = i.w;
        }
        float val[16];
        const float s20 = __builtin_bit_cast(float, L[16 * 256 + tid]);
#pragma unroll
        for (int a = 0; a < 16; ++a) val[a] = __builtin_bit_cast(float, L[a * 256 + tid]) + s20;
        unsigned long long P = 0ull;
        float ts[16]; int te[16];
#pragma unroll
        for (int r = 0; r < 16; ++r) {
            float best = val[0]; int ba = 0;
#pragma unroll
            for (int a = 1; a < 16; ++a) if (val[a] > best) { best = val[a]; ba = a; }
            const int b = (int)((P >> (4 * ba)) & 15ull);
            const int i1 = (int)L[(32 + ba) * 256 + tid], i2 = (int)L[(48 + b) * 256 + tid];
            ts[r] = best; te[r] = i1 * 128 + i2;
            const int nb = b + 1;
            float newv = -3.0e38f;
            if (nb < 16) { newv = __builtin_bit_cast(float, L[ba * 256 + tid]) + __builtin_bit_cast(float, L[(16 + nb) * 256 + tid]); P += 1ull << (4 * ba); }
#pragma unroll
            for (int a = 0; a < 16; ++a) val[a] = (a == ba) ? newv : val[a];
        }
        const float m0 = ts[0];
        float sum = 0.f;
#pragma unroll
        for (int r = 0; r < 16; ++r) { ts[r] = __expf(ts[r] - m0); sum += ts[r]; }
        const float inv = 1.0f / sum;
#pragma unroll
        for (int r = 0; r < 16; ++r) ts[r] *= inv;
#pragma unroll
        for (int r = 0; r < 16; ++r) { EXP[th * 16 + r] = te[r]; GATE[th * 16 + r] = ts[r]; }
    }
}

__device__ __forceinline__ void fma8(const unsigned w0, const unsigned w1, const float a, float* acc) {
    const f32x2 p0 = __builtin_amdgcn_cvt_pk_f32_fp8((int)w0, false), p1 = __builtin_amdgcn_cvt_pk_f32_fp8((int)w0, true);
    const f32x2 p2 = __builtin_amdgcn_cvt_pk_f32_fp8((int)w1, false), p3 = __builtin_amdgcn_cvt_pk_f32_fp8((int)w1, true);
    acc[0] += a * p0.x; acc[1] += a * p0.y; acc[2] += a * p1.x; acc[3] += a * p1.y;
    acc[4] += a * p2.x; acc[5] += a * p2.y; acc[6] += a * p3.x; acc[7] += a * p3.y;
}
__device__ __forceinline__ float dot8(const unsigned w0, const unsigned w1, const float* h, float s) {
    const f32x2 p0 = __builtin_amdgcn_cvt_pk_f32_fp8((int)w0, false), p1 = __builtin_amdgcn_cvt_pk_f32_fp8((int)w0, true);
    const f32x2 p2 = __builtin_amdgcn_cvt_pk_f32_fp8((int)w1, false), p3 = __builtin_amdgcn_cvt_pk_f32_fp8((int)w1, true);
    s += p0.x * h[0]; s += p0.y * h[1]; s += p1.x * h[2]; s += p1.y * h[3];
    s += p2.x * h[4]; s += p2.y * h[5]; s += p3.x * h[6]; s += p3.y * h[7];
    return s;
}
__device__ __forceinline__ void phase_peer_apply(const Params& p, int layer, unsigned char* lds, bool dry) {
    const int lane = threadIdx.x & 63, wave = threadIdx.x >> 6;
    float* ldsw = (float*)lds + wave * (64 * 65);
    const bf16_t* HM = (const bf16_t*)(p.ws + WS_HM);
    const unsigned char* PU = p.ws + WS_PU; const unsigned char* PV = p.ws + WS_PV;
    const float* SU = (const float*)(p.ws + WS_PU + 24 * MiB); const float* SV = (const float*)(p.ws + WS_PV + 24 * MiB);
    const int* EXP = (const int*)(p.ws + WS_EXP); const float* GATE = (const float*)(p.ws + WS_GATE);
    const float* MOD = (const float*)(p.ws + WS_MOD);
    float* X = p.out;
    for (int t = blockIdx.x * 4 + wave; t < T; t += gridDim.x * 4) {
        const u32x4 ha = *(const u32x4*)(HM + (size_t)t * D + lane * 16), hb = *(const u32x4*)(HM + (size_t)t * D + lane * 16 + 8);
        float hf[16];
        hf[0] = bflo(ha.x); hf[1] = bfhi(ha.x); hf[2] = bflo(ha.y); hf[3] = bfhi(ha.y); hf[4] = bflo(ha.z); hf[5] = bfhi(ha.z); hf[6] = bflo(ha.w); hf[7] = bfhi(ha.w);
        hf[8] = bflo(hb.x); hf[9] = bfhi(hb.x); hf[10] = bflo(hb.y); hf[11] = bfhi(hb.y); hf[12] = bflo(hb.z); hf[13] = bfhi(hb.z); hf[14] = bflo(hb.w); hf[15] = bfhi(hb.w);
        const int e0 = EXP[(size_t)t * 128 + lane], e1 = EXP[(size_t)t * 128 + 64 + lane];
        const float g0 = GATE[(size_t)t * 128 + lane], g1 = GATE[(size_t)t * 128 + 64 + lane];
        const float su0 = SU[e0], su1 = SU[e1], sv0 = SV[e0], sv1 = SV[e1];
        float act0 = 0.f, act1 = 0.f;
#pragma unroll
        for (int half = 0; half < 2; ++half) {
            const int ev = half ? e1 : e0;
#pragma unroll 1
            for (int jg = 0; jg < 4; ++jg) {
                u32x4 ua[16];
#pragma unroll
                for (int j = 0; j < 16; ++j) {
                    const int e = __builtin_amdgcn_readlane(ev, jg * 16 + j);
                    ua[j] = *(const u32x4*)(PU + (size_t)e * D + lane * 16);
                }
#pragma unroll
                for (int j = 0; j < 16; ++j) {
                    float s = dot8(ua[j].x, ua[j].y, hf, 0.f);
                    s = dot8(ua[j].z, ua[j].w, hf + 8, s);
                    ldsw[(jg * 16 + j) * 65 + lane] = s;
                }
            }
            float tot = 0.f;
#pragma unroll 16
            for (int k = 0; k < 64; ++k) tot += ldsw[lane * 65 + k];
            const float a = gelu_tanh(tot * (half ? su1 : su0)) * (half ? g1 : g0) * (half ? sv1 : sv0);
            if (half) act1 = a; else act0 = a;
        }
        float acc[16];
#pragma unroll
        for (int i = 0; i < 16; ++i) acc[i] = 0.f;
#pragma unroll
        for (int half = 0; half < 2; ++half) {
            const int ev = half ? e1 : e0; const float av = half ? act1 : act0;
#pragma unroll 1
            for (int jg = 0; jg < 4; ++jg) {
                u32x4 va[16];
#pragma unroll
                for (int j = 0; j < 16; ++j) {
                    const int e = __builtin_amdgcn_readlane(ev, jg * 16 + j);
                    va[j] = *(const u32x4*)(PV + (size_t)e * D + lane * 16);
                }
#pragma unroll
                for (int j = 0; j < 16; ++j) {
                    const float a = __builtin_bit_cast(float, __builtin_amdgcn_readlane(__builtin_bit_cast(int, av), jg * 16 + j));
                    fma8(va[j].x, va[j].y, a, acc);
                    fma8(va[j].z, va[j].w, a, acc + 8);
                }
            }
        }
        const int b = t / SEQ;
        const float* g2 = MOD + (size_t)(layer * 2 + b) * 6144 + 5120;
        float* xr = X + (size_t)t * D + lane * 16;
#pragma unroll
        for (int q = 0; q < 4; ++q) {
            const f32x4 g = *(const f32x4*)(g2 + lane * 16 + q * 4); f32x4 x = *(const f32x4*)(xr + q * 4);
            x.x += g.x * acc[q * 4 + 0]; x.y += g.y * acc[q * 4 + 1]; x.z += g.z * acc[q * 4 + 2]; x.w += g.w * acc[q * 4 + 3];
            if (!dry) *(f32x4*)(xr + q * 4) = x;
        }
    }
}
__device__ __forceinline__ void phase_tab1(const Params& p) {
    for (int it = blockIdx.x; it < 2 * P0_TAB; it += gridDim.x) {
        if (it < P0_TAB) cvt_fp8_item(p.in[26] + (size_t)PE * D, p.ws + WS_PU, (float*)(p.ws + WS_PU + 24 * MiB), it);
        else cvt_fp8_item(p.in[27] + (size_t)PE * D, p.ws + WS_PV, (float*)(p.ws + WS_PV + 24 * MiB), it - P0_TAB);
    }
}
__device__ __forceinline__ void phase_nsa_proj(const Params& p, unsigned char* lds) {
    const bf16_t* HM = (const bf16_t*)(p.ws + WS_HM); const bf16_t* WT = (const bf16_t*)(p.ws + WS_WPROJ_T);
    const f32x2* ROPE = (const f32x2*)(p.ws + WS_ROPE);
    bf16_t* Q = (bf16_t*)(p.ws + WS_Q); float* NGT = (float*)(p.ws + WS_NG);
    const int lane = threadIdx.x & 63, wid = threadIdx.x >> 6, wr = wid >> 1, wc = wid & 1, fr = lane & 15, fq = lane >> 4;
    for (int id = blockIdx.x; id < 256 * 21; id += gridDim.x) {
        const int mt = id / 21, nt = id % 21;
        f32x4 acc[4][4];
        gemm_tile(ALoadPlain{HM + (size_t)mt * 128 * D, (size_t)D}, WT + (size_t)nt * 128 * D, D, 16, acc, lds);
        const int c0 = nt * 128 + wc * 64;
        if (c0 >= 2624) continue;
        const int b = (mt * 128) / SEQ;
        if (c0 == 2560) {
#pragma unroll
            for (int mi = 0; mi < 4; ++mi)
#pragma unroll
                for (int ni = 0; ni < 3; ++ni) {
                    const int t = mt * 128 + wr * 64 + mi * 16 + fr;
                    const f32x4 v = acc[mi][ni];
                    *(f32x4*)(NGT + (size_t)t * 48 + ni * 16 + fq * 4) = (f32x4){sigmoidf_(v.x), sigmoidf_(v.y), sigmoidf_(v.z), sigmoidf_(v.w)};
                }
            continue;
        }
        int sec = -1, g = 0;
        if (c0 >= 1024) { sec = (c0 - 1024) >> 8; g = ((c0 - 1024) & 255) >> 6; }
        const bool dorope = (sec == -1) || (sec == 2) || (sec == 4);
        const float scl = (sec == -1) ? 0.125f : 1.0f;
        const size_t secoff[6] = {WS_KC, WS_VC, WS_KS, WS_VST, WS_KW, WS_VWT};
        size_t so = WS_Q;
#pragma unroll
        for (int q = 0; q < 6; ++q) if (sec == q) so = secoff[q];
        bf16_t* OUT = (bf16_t*)(p.ws + so);
        const bool vt = (sec == 3) || (sec == 5);
#pragma unroll
        for (int mi = 0; mi < 4; ++mi) {
            const int t = mt * 128 + wr * 64 + mi * 16 + fr, s = t - b * SEQ;
            if (dorope) {
#pragma unroll
                for (int ni = 0; ni < 2; ++ni) {
                    const f32x4* rp = (const f32x4*)(ROPE + (size_t)s * 32 + ni * 16 + fq * 4);
                    const f32x4 r0 = rp[0], r1 = rp[1];
                    const f32x4 x1 = acc[mi][ni], x2 = acc[mi][ni + 2];
                    acc[mi][ni] = (f32x4){x1.x * r0.x - x2.x * r0.y, x1.y * r0.z - x2.y * r0.w, x1.z * r1.x - x2.z * r1.y, x1.w * r1.z - x2.w * r1.w};
                    acc[mi][ni + 2] = (f32x4){x1.x * r0.y + x2.x * r0.x, x1.y * r0.w + x2.y * r0.z, x1.z * r1.y + x2.z * r1.x, x1.w * r1.w + x2.w * r1.z};
                }
            }
#pragma unroll
            for (int ni = 0; ni < 4; ++ni) {
                const f32x4 v = acc[mi][ni] * scl;
                const int d = ni * 16 + fq * 4;
                if (sec == -1) {
                    *(u32x2*)(OUT + (size_t)t * 1024 + c0 + d) = (u32x2){pk2(v.x, v.y), pk2(v.z, v.w)};
                } else if (!vt) {
                    *(u32x2*)(OUT + ((size_t)(b * 4 + g) * SEQ + s) * 64 + d) = (u32x2){pk2(v.x, v.y), pk2(v.z, v.w)};
                } else {
                    bf16_t* o = OUT + ((size_t)(b * 4 + g) * 64 + d) * SEQ + s;
                    o[0] = (bf16_t)f2bf(v.x); o[SEQ] = (bf16_t)f2bf(v.y); o[2 * SEQ] = (bf16_t)f2bf(v.z); o[3 * SEQ] = (bf16_t)f2bf(v.w);
                }
            }
        }
    }
}
__device__ __forceinline__ void phase_nsa_cmp1(const Params& p, unsigned char* lds) {
    bf16_t* HID = (bf16_t*)(p.ws + WS_HID);
    const float* bias = (const float*)(p.ws + WS_MISC);
    const int lane = threadIdx.x & 63, wid = threadIdx.x >> 6, wr = wid >> 1, wc = wid & 1, fr = lane & 15, fq = lane >> 4;
    for (int id = blockIdx.x; id < 256; id += gridDim.x) {
        const int kv = id >> 7, bg = (id >> 4) & 7, mt = (id >> 1) & 7, nt = id & 1;
        const bf16_t* A = (const bf16_t*)(p.ws + (kv ? WS_VC : WS_KC)) + (size_t)bg * SEQ * 64 + (size_t)mt * 128 * 1024;
        const bf16_t* B = (const bf16_t*)(p.ws + (kv ? WS_WV1_T : WS_WK1_T)) + (size_t)nt * 128 * 2048;
        f32x4 acc[4][4];
        gemm_tile(ALoadPlain{A, (size_t)1024}, B, 2048, 32, acc, lds);
#pragma unroll
        for (int mi = 0; mi < 4; ++mi)
#pragma unroll
            for (int ni = 0; ni < 4; ++ni) {
                const int n = mt * 128 + wr * 64 + mi * 16 + fr, c = nt * 128 + wc * 64 + ni * 16 + fq * 4;
                const f32x4 bv = *(const f32x4*)(bias + kv * 256 + c);
                const f32x4 v = acc[mi][ni] + bv;
                *(u32x2*)(HID + (((size_t)kv * 8 + bg) * 1024 + n) * 256 + c) = (u32x2){pk2(gelu_tanh(v.x), gelu_tanh(v.y)), pk2(gelu_tanh(v.z), gelu_tanh(v.w))};
            }
    }
}
__device__ __forceinline__ void phase_nsa_cmp2(const Params& p, unsigned char* lds) {
    const bf16_t* HID = (const bf16_t*)(p.ws + WS_HID);
    const f32x2* ROPE = (const f32x2*)(p.ws + WS_ROPE);
    bf16_t* KCMP = (bf16_t*)(p.ws + WS_KCMP); bf16_t* VCMPT = (bf16_t*)(p.ws + WS_VCMPT);
    const int lane = threadIdx.x & 63, wid = threadIdx.x >> 6, wr = wid >> 1, wc = wid & 1, fr = lane & 15, fq = lane >> 4;
    for (int id = blockIdx.x; id < 128; id += gridDim.x) {
        const int kv = id >> 6, mt = id & 63;
        const bf16_t* A = HID + ((size_t)kv * 8192 + (size_t)mt * 128) * 256;
        const bf16_t* B = (const bf16_t*)(p.ws + (kv ? WS_WV2_T : WS_WK2_T));
        f32x4 acc[4][4];
        gemm_tile(ALoadPlain{A, (size_t)256}, B, 256, 4, acc, lds);
        if (wc == 1) continue;
#pragma unroll
        for (int mi = 0; mi < 4; ++mi) {
            const int R = mt * 128 + wr * 64 + mi * 16 + fr, bg = R >> 10, n = R & 1023;
            if (kv == 0) {
                int pos = n * 16 + 31; pos = pos > SEQ - 1 ? SEQ - 1 : pos;
#pragma unroll
                for (int ni = 0; ni < 2; ++ni) {
                    const f32x4* rp = (const f32x4*)(ROPE + (size_t)pos * 32 + ni * 16 + fq * 4);
                    const f32x4 r0 = rp[0], r1 = rp[1];
                    const f32x4 x1 = acc[mi][ni], x2 = acc[mi][ni + 2];
                    acc[mi][ni] = (f32x4){x1.x * r0.x - x2.x * r0.y, x1.y * r0.z - x2.y * r0.w, x1.z * r1.x - x2.z * r1.y, x1.w * r1.z - x2.w * r1.w};
                    acc[mi][ni + 2] = (f32x4){x1.x * r0.y + x2.x * r0.x, x1.y * r0.w + x2.y * r0.z, x1.z * r1.y + x2.z * r1.x, x1.w * r1.w + x2.w * r1.z};
                }
#pragma unroll
                for (int ni = 0; ni < 4; ++ni) {
                    const f32x4 v = acc[mi][ni];
                    *(u32x2*)(KCMP + ((size_t)bg * 1024 + n) * 64 + ni * 16 + fq * 4) = (u32x2){pk2(v.x, v.y), pk2(v.z, v.w)};
                }
            } else {
#pragma unroll
                for (int ni = 0; ni < 4; ++ni) {
                    const f32x4 v = acc[mi][ni];
                    bf16_t* o = VCMPT + ((size_t)bg * 64 + ni * 16 + fq * 4) * 1024 + n;
                    o[0] = (bf16_t)f2bf(v.x); o[1024] = (bf16_t)f2bf(v.y); o[2048] = (bf16_t)f2bf(v.z); o[3072] = (bf16_t)f2bf(v.w);
                }
            }
        }
    }
}
__device__ __forceinline__ void phase_nsa_wo(const Params& p, unsigned char* lds, bool dry) {
    const bf16_t* O = (const bf16_t*)(p.ws + WS_O); const bf16_t* WT = (const bf16_t*)(p.ws + WS_WO_T);
    const float* MOD = (const float*)(p.ws + WS_MOD);
    float* X = p.out;
    const int lane = threadIdx.x & 63, wid = threadIdx.x >> 6, wr = wid >> 1, wc = wid & 1, fr = lane & 15, fq = lane >> 4;
    for (int id = blockIdx.x; id < 256 * 8; id += gridDim.x) {
        const int mt = id >> 3, nt = id & 7;
        f32x4 acc[4][4];
        gemm_tile(ALoadPlain{O + (size_t)mt * 128 * D, (size_t)D}, WT + (size_t)nt * 128 * D, D, 16, acc, lds);
        const int b = (mt * 128) / SEQ;
#pragma unroll
        for (int mi = 0; mi < 4; ++mi)
#pragma unroll
            for (int ni = 0; ni < 4; ++ni) {
                const int t = mt * 128 + wr * 64 + mi * 16 + fr, c = nt * 128 + wc * 64 + ni * 16 + fq * 4;
                const f32x4 g1 = *(const f32x4*)(MOD + (size_t)(1 * 2 + b) * 6144 + 2048 + c);
                float* xp = X + (size_t)t * D + c;
                const f32x4 x = *(const f32x4*)xp; const f32x4 v = acc[mi][ni];
                if (!dry) *(f32x4*)xp = (f32x4){x.x + g1.x * v.x, x.y + g1.y * v.y, x.z + g1.z * v.z, x.w + g1.w * v.w};
            }
    }
}
__device__ __forceinline__ bf16x8 pack8(const f32x4 a, const f32x4 b) {
    u32x4 w; w.x = pk2(a.x, a.y); w.y = pk2(a.z, a.w); w.z = pk2(b.x, b.y); w.w = pk2(b.z, b.w);
    return __builtin_bit_cast(bf16x8, w);
}
__device__ __forceinline__ bf16x8 ldv8(const bf16_t* plo, const bf16_t* phi) {
    const u32x2 lo = *(const u32x2*)plo, hi = *(const u32x2*)phi;
    u32x4 w; w.x = lo.x; w.y = lo.y; w.z = hi.x; w.w = hi.y;
    return __builtin_bit_cast(bf16x8, w);
}
__device__ __forceinline__ float red4(float v) { v += __shfl_xor(v, 16); v += __shfl_xor(v, 32); return v; }
__device__ __forceinline__ float max4(float v) { v = fmaxf(v, __shfl_xor(v, 16)); v = fmaxf(v, __shfl_xor(v, 32)); return v; }
#define NEGBIG (-1.0e30f)

__device__ __forceinline__ void phase_nsa_attn(const Params& p, unsigned char* lds, const int rep_cmp, const int rep_win, const int rep_sel) {
    const int lane = threadIdx.x & 63, wave = threadIdx.x >> 6, fr = lane & 15, fq = lane >> 4;
    unsigned char* WL = lds + wave * 18432;
    float* IMP = (float*)WL;
    int* SEL = (int*)(WL + 17408);
    const bf16_t* Q = (const bf16_t*)(p.ws + WS_Q);
    const bf16_t* KCMP = (const bf16_t*)(p.ws + WS_KCMP); const bf16_t* VCMPT = (const bf16_t*)(p.ws + WS_VCMPT);
    const bf16_t* KS = (const bf16_t*)(p.ws + WS_KS); const bf16_t* VST = (const bf16_t*)(p.ws + WS_VST);
    const bf16_t* KW = (const bf16_t*)(p.ws + WS_KW); const bf16_t* VWT = (const bf16_t*)(p.ws + WS_VWT);
    const float* NGT = (const float*)(p.ws + WS_NG);
    bf16_t* O = (bf16_t*)(p.ws + WS_O);
    const f32x4 z4 = (f32x4){0.f, 0.f, 0.f, 0.f};
    for (int bi = blockIdx.x; bi < 2048; bi += gridDim.x) {
        const int bg = bi & 7, quad = 255 - (bi >> 3), t0 = (quad * 4 + wave) * 16, b = bg >> 2, g = bg & 3;
        const int cur = t0 >> 6;
        const size_t tok = (size_t)b * SEQ + t0 + fr;
        const int tq = t0 + fr;
        bf16x8 qf[4][2];
#pragma unroll
        for (int r = 0; r < 4; ++r)
#pragma unroll
            for (int ks = 0; ks < 2; ++ks) qf[r][ks] = *(const bf16x8*)(Q + tok * 1024 + (g * 4 + r) * 64 + ks * 32 + fq * 8);
        float gc[4], gw[4];
#pragma unroll
        for (int r = 0; r < 4; ++r) { const float* gp = NGT + tok * 48 + (g * 4 + r) * 3; gc[r] = gp[0]; gw[r] = gp[2]; }
        f32x4 acc[4][4];
        for (int rep = 0; rep < rep_win; ++rep) {
            const bf16_t* kwb = KW + (size_t)bg * SEQ * 64; const bf16_t* vwb = VWT + (size_t)bg * 64 * SEQ;
            float mw[4], lw[4];
#pragma unroll
            for (int r = 0; r < 4; ++r) { mw[r] = NEGBIG; lw[r] = 0.f;
#pragma unroll
                for (int df = 0; df < 4; ++df) acc[r][df] = z4; }
            int kmin = t0 - 511; kmin = kmin < 0 ? 0 : kmin; kmin &= ~31;
            for (int kb = kmin; kb <= t0 + 15; kb += 32) {
                bf16x8 kf[2][2];
#pragma unroll
                for (int f = 0; f < 2; ++f)
#pragma unroll
                    for (int ks = 0; ks < 2; ++ks) kf[f][ks] = *(const bf16x8*)(kwb + (size_t)(kb + f * 16 + fr) * 64 + ks * 32 + fq * 8);
                bf16x8 vf[4];
#pragma unroll
                for (int df = 0; df < 4; ++df) { const bf16_t* vp = vwb + (size_t)(df * 16 + fr) * SEQ + kb + 4 * fq; vf[df] = ldv8(vp, vp + 16); }
#pragma unroll
                for (int r = 0; r < 4; ++r) {
                    f32x4 st[2];
#pragma unroll
                    for (int f = 0; f < 2; ++f) {
                        st[f] = __builtin_amdgcn_mfma_f32_16x16x32_bf16(kf[f][0], qf[r][0], z4, 0, 0, 0);
                        st[f] = __builtin_amdgcn_mfma_f32_16x16x32_bf16(kf[f][1], qf[r][1], st[f], 0, 0, 0);
                    }
                    float mx = NEGBIG;
#pragma unroll
                    for (int f = 0; f < 2; ++f)
#pragma unroll
                        for (int e = 0; e < 4; ++e) { const int key = kb + f * 16 + fq * 4 + e; const bool ok = (key <= tq) && (key > tq - 512); if (ok) mx = fmaxf(mx, st[f][e]); }
                    mx = max4(mx);
                    const float mn = fmaxf(mw[r], mx);
                    const float al = __expf(mw[r] - mn);
                    float ps = 0.f;
#pragma unroll
                    for (int f = 0; f < 2; ++f)
#pragma unroll
                        for (int e = 0; e < 4; ++e) { const int key = kb + f * 16 + fq * 4 + e; const bool ok = (key <= tq) && (key > tq - 512); const float pv = ok ? __expf(st[f][e] - mn) : 0.f; st[f][e] = pv; ps += pv; }
                    lw[r] = lw[r] * al + ps; mw[r] = mn;
                    const bf16x8 pf = pack8(st[0], st[1]);
#pragma unroll
                    for (int df = 0; df < 4; ++df) { acc[r][df] = acc[r][df] * al; acc[r][df] = __builtin_amdgcn_mfma_f32_16x16x32_bf16(vf[df], pf, acc[r][df], 0, 0, 0); }
                    __builtin_amdgcn_sched_barrier(0);
                }
            }
#pragma unroll
            for (int r = 0; r < 4; ++r) {
                const float l = red4(lw[r]); const float sc = gw[r] / l;
#pragma unroll
                for (int df = 0; df < 4; ++df) acc[r][df] = acc[r][df] * sc;
            }
        }
        const int nmax_tile = (t0 >> 4) - 1, nmax_lane = (t0 >> 4) - 2 + (fr == 15 ? 1 : 0);
        const bf16_t* kcb = KCMP + (size_t)bg * 1024 * 64; const bf16_t* vcb = VCMPT + (size_t)bg * 64 * 1024;
        for (int rep = 0; rep < rep_cmp; ++rep) {
            const bool dry = (rep + 1 < rep_cmp);
            float mc[4], lc[4], invl[4];
#pragma unroll
            for (int r = 0; r < 4; ++r) { mc[r] = NEGBIG; lc[r] = 0.f; }
            for (int nb = 0; nb <= nmax_tile; nb += 32) {
                bf16x8 kf[2][2];
#pragma unroll
                for (int f = 0; f < 2; ++f)
#pragma unroll
                    for (int ks = 0; ks < 2; ++ks) kf[f][ks] = *(const bf16x8*)(kcb + (size_t)(nb + f * 16 + fr) * 64 + ks * 32 + fq * 8);
#pragma unroll
                for (int r = 0; r < 4; ++r) {
                    f32x4 st[2];
#pragma unroll
                    for (int f = 0; f < 2; ++f) {
                        st[f] = __builtin_amdgcn_mfma_f32_16x16x32_bf16(kf[f][0], qf[r][0], z4, 0, 0, 0);
                        st[f] = __builtin_amdgcn_mfma_f32_16x16x32_bf16(kf[f][1], qf[r][1], st[f], 0, 0, 0);
                    }
                    float mx = NEGBIG;
#pragma unroll
                    for (int f = 0; f < 2; ++f)
#pragma unroll
                        for (int e = 0; e < 4; ++e) { const int n = nb + f * 16 + fq * 4 + e; if (n <= nmax_lane) mx = fmaxf(mx, st[f][e]); }
                    mx = max4(mx);
                    const float mn = fmaxf(mc[r], mx);
                    float ps = 0.f;
#pragma unroll
                    for (int f = 0; f < 2; ++f)
#pragma unroll
                        for (int e = 0; e < 4; ++e) { const int n = nb + f * 16 + fq * 4 + e; if (n <= nmax_lane) ps += __expf(st[f][e] - mn); }
                    lc[r] = lc[r] * __expf(mc[r] - mn) + ps; mc[r] = mn;
                    __builtin_amdgcn_sched_barrier(0);
                }
            }
#pragma unroll
            for (int r = 0; r < 4; ++r) { const float l = red4(lc[r]); invl[r] = l > 0.f ? 1.0f / l : 0.f; }
            for (int i = lane; i < 16 * 260; i += 64) IMP[i] = 0.f;
            float carry = 0.f;
            for (int nb = 0; nb <= nmax_tile; nb += 32) {
                bf16x8 kf[2][2];
#pragma unroll
                for (int f = 0; f < 2; ++f)
#pragma unroll
                    for (int ks = 0; ks < 2; ++ks) kf[f][ks] = *(const bf16x8*)(kcb + (size_t)(nb + f * 16 + fr) * 64 + ks * 32 + fq * 8);
                bf16x8 vf[4];
#pragma unroll
                for (int df = 0; df < 4; ++df) { const bf16_t* vp = vcb + (size_t)(df * 16 + fr) * 1024 + nb + 4 * fq; vf[df] = ldv8(vp, vp + 16); }
                f32x4 pg[2] = {z4, z4};
#pragma unroll
                for (int r = 0; r < 4; ++r) {
                    f32x4 st[2];
#pragma unroll
                    for (int f = 0; f < 2; ++f) {
                        st[f] = __builtin_amdgcn_mfma_f32_16x16x32_bf16(kf[f][0], qf[r][0], z4, 0, 0, 0);
                        st[f] = __builtin_amdgcn_mfma_f32_16x16x32_bf16(kf[f][1], qf[r][1], st[f], 0, 0, 0);
#pragma unroll
                        for (int e = 0; e < 4; ++e) { const int n = nb + f * 16 + fq * 4 + e; st[f][e] = (n <= nmax_lane) ? __expf(st[f][e] - mc[r]) * invl[r] : 0.f; }
                        pg[f] += st[f];
                    }
                    const float gg = dry ? 0.f : gc[r];
                    const bf16x8 pf = pack8(st[0] * gg, st[1] * gg);
#pragma unroll
                    for (int df = 0; df < 4; ++df) acc[r][df] = __builtin_amdgcn_mfma_f32_16x16x32_bf16(vf[df], pf, acc[r][df], 0, 0, 0);
                    __builtin_amdgcn_sched_barrier(0);
                }
                const int src = (lane - 16) & 63;
                const float s0 = __shfl(pg[0].w, src), s1 = __shfl(pg[1].w, src), sc = __shfl(carry, src);
                const float prev0 = fq > 0 ? s0 : sc, prev1 = fq > 0 ? s1 : s0;
                const float imp0 = (pg[0].x + pg[0].y) + (pg[0].z + pg[0].w) + prev0;
                const float imp1 = (pg[1].x + pg[1].y) + (pg[1].z + pg[1].w) + prev1;
                const int jb = (nb >> 2) + fq;
                IMP[fr * 260 + jb] = imp0; IMP[fr * 260 + jb + 4] = imp1;
                carry = pg[1].w;
            }
        }
        {
            const int nf = cur >= 2 ? 3 : cur + 1;
            if (fq == 0) {
                SEL[fr * 16 + 0] = 0;
                if (cur == 1) SEL[fr * 16 + 1] = 1;
                if (cur >= 2) { SEL[fr * 16 + 1] = cur - 1; SEL[fr * 16 + 2] = cur; }
            }
            const int ncand = cur >= 3 ? cur - 2 : 0, extra = 16 - nf;
            if (ncand <= extra) {
                if (fq == 0) { for (int k = 0; k < extra; ++k) SEL[fr * 16 + nf + k] = (k < ncand) ? 1 + k : -1; }
            } else {
                for (int rnd = 0; rnd < extra; ++rnd) {
                    float bv = -1.0f; int bj = 1 << 20;
                    for (int jb = 1 + fq; jb <= cur - 2; jb += 4) { const float v = IMP[fr * 260 + jb]; if (v > bv) { bv = v; bj = jb; } }
#pragma unroll
                    for (int o = 16; o <= 32; o <<= 1) {
                        const float ov = __shfl_xor(bv, o); const int oj = __shfl_xor(bj, o);
                        if (ov > bv || (ov == bv && oj < bj)) { bv = ov; bj = oj; }
                    }
                    if (fq == 0) SEL[fr * 16 + nf + rnd] = bj;
                    if (((bj - 1) & 3) == fq) IMP[fr * 260 + bj] = -2.0f;
                }
            }
        }
        u32x2 accp[4][4];
#pragma unroll
        for (int r = 0; r < 4; ++r)
#pragma unroll
            for (int df = 0; df < 4; ++df) accp[r][df] = (u32x2){pk2(acc[r][df].x, acc[r][df].y), pk2(acc[r][df].z, acc[r][df].w)};
        for (int rep = 0; rep < rep_sel; ++rep) {
            const bool dry = (rep + 1 < rep_sel);
            const bf16_t* ksb = KS + (size_t)bg * SEQ * 64; const bf16_t* vsb = VST + (size_t)bg * 64 * SEQ;
            unsigned char* KL = WL; unsigned char* VL = WL + 8192;
            const int nv = cur + 1 < 16 ? cur + 1 : 16, total = 16 * nv;
            const int lrow = lane >> 3, lch = lane & 7;
            const int kwoff = lrow * 128 + ((lch ^ (lrow & 7)) << 4), vwoff = lrow * 144 + lch * 16;
            const int rr = fr & 3;
            u32x4 sk[8], sv[8];
            const unsigned koff = (unsigned)(lrow * 64 + lch * 8), voff = (unsigned)(lrow * SEQ + lch * 8);
            int jbn = __builtin_amdgcn_readfirstlane(SEL[0]);
            {
                const bf16_t* kb_ = ksb + (size_t)jbn * 4096; const bf16_t* vb_ = vsb + (size_t)jbn * 64;
#pragma unroll
                for (int j = 0; j < 8; ++j) { sk[j] = *(const u32x4*)(kb_ + j * 512 + koff); sv[j] = *(const u32x4*)(vb_ + (size_t)j * 8 * SEQ + voff); }
            }
            bf16x8 qs[2];
            float ms = NEGBIG, ls = 0.f;
            f32x4 os[4] = {z4, z4, z4, z4};
            int i = 0, k = 0;
            for (int v = 0; v < total; ++v) {
                const int jb = jbn;
#pragma unroll
                for (int j = 0; j < 8; ++j) { *(u32x4*)(KL + kwoff + j * 1024) = sk[j]; *(u32x4*)(VL + vwoff + j * 1152) = sv[j]; }
                if (v + 1 < total) {
                    int k2 = k + 1, i2 = i; if (k2 == nv) { k2 = 0; i2 = i + 1; }
                    jbn = __builtin_amdgcn_readfirstlane(SEL[i2 * 16 + k2]);
                    const bf16_t* kb_ = ksb + (size_t)jbn * 4096; const bf16_t* vb_ = vsb + (size_t)jbn * 64;
#pragma unroll
                    for (int j = 0; j < 8; ++j) { sk[j] = *(const u32x4*)(kb_ + j * 512 + koff); sv[j] = *(const u32x4*)(vb_ + (size_t)j * 8 * SEQ + voff); }
                }
                __builtin_amdgcn_sched_barrier(0);
                const int ti = t0 + i;
                if (k == 0) {
                    const size_t tk = (size_t)b * SEQ + ti;
#pragma unroll
                    for (int ks = 0; ks < 2; ++ks) qs[ks] = *(const bf16x8*)(Q + tk * 1024 + (g * 4 + rr) * 64 + ks * 32 + fq * 8);
                    ms = NEGBIG; ls = 0.f;
#pragma unroll
                    for (int df = 0; df < 4; ++df) os[df] = z4;
                }
                f32x4 st[4];
#pragma unroll
                for (int f = 0; f < 4; ++f) {
                    const bf16x8 k0 = *(const bf16x8*)(KL + (f * 16 + fr) * 128 + (((0 + fq) ^ (fr & 7)) << 4));
                    const bf16x8 k1 = *(const bf16x8*)(KL + (f * 16 + fr) * 128 + (((4 + fq) ^ (fr & 7)) << 4));
                    st[f] = __builtin_amdgcn_mfma_f32_16x16x32_bf16(k0, qs[0], z4, 0, 0, 0);
                    st[f] = __builtin_amdgcn_mfma_f32_16x16x32_bf16(k1, qs[1], st[f], 0, 0, 0);
                }
                if (jb == cur) {
#pragma unroll
                    for (int f = 0; f < 4; ++f)
#pragma unroll
                        for (int e = 0; e < 4; ++e) { const int key = jb * 64 + f * 16 + fq * 4 + e; if (key > ti) st[f][e] = NEGBIG; }
                }
                float mx = NEGBIG;
#pragma unroll
                for (int f = 0; f < 4; ++f) mx = fmaxf(mx, fmaxf(fmaxf(st[f].x, st[f].y), fmaxf(st[f].z, st[f].w)));
                mx = max4(mx);
                const float mn = fmaxf(ms, mx);
                const float al = __expf(ms - mn);
                float ps = 0.f;
#pragma unroll
                for (int f = 0; f < 4; ++f)
#pragma unroll
                    for (int e = 0; e < 4; ++e) { const float pv = (st[f][e] > -1.0e29f) ? __expf(st[f][e] - mn) : 0.f; st[f][e] = pv; ps += pv; }
                ls = ls * al + ps; ms = mn;
#pragma unroll
                for (int df = 0; df < 4; ++df) os[df] = os[df] * al;
#pragma unroll
                for (int s = 0; s < 2; ++s) {
                    const bf16x8 pf = pack8(st[2 * s], st[2 * s + 1]);
#pragma unroll
                    for (int df = 0; df < 4; ++df) {
                        const unsigned char* vp = VL + (df * 16 + fr) * 144 + (32 * s + 4 * fq) * 2;
                        const u32x2 lo = *(const u32x2*)vp, hi = *(const u32x2*)(vp + 32);
                        u32x4 w; w.x = lo.x; w.y = lo.y; w.z = hi.x; w.w = hi.y;
                        os[df] = __builtin_amdgcn_mfma_f32_16x16x32_bf16(__builtin_bit_cast(bf16x8, w), pf, os[df], 0, 0, 0);
                    }
                }
                if (k == nv - 1) {
                    const float l = red4(ls);
                    const float gsv = NGT[((size_t)b * SEQ + ti) * 48 + (g * 4 + rr) * 3 + 1];
                    const float sc = dry ? 0.f : gsv / l;
#pragma unroll
                    for (int df = 0; df < 4; ++df) {
                        const f32x4 val = os[df] * sc;
#pragma unroll
                        for (int r = 0; r < 4; ++r) {
                            const int srcl = r + 16 * fq;
                            const float t0_ = __shfl(val.x, srcl), t1_ = __shfl(val.y, srcl), t2_ = __shfl(val.z, srcl), t3_ = __shfl(val.w, srcl);
                            if (fr == i) {
                                const u32x2 c = accp[r][df];
                                accp[r][df] = (u32x2){pk2(bflo(c.x) + t0_, bfhi(c.x) + t1_), pk2(bflo(c.y) + t2_, bfhi(c.y) + t3_)};
                            }
                        }
                    }
                }
                ++k; if (k == nv) { k = 0; ++i; }
            }
        }
#pragma unroll
        for (int r = 0; r < 4; ++r)
#pragma unroll
            for (int df = 0; df < 4; ++df) {
                *(u32x2*)(O + tok * 1024 + (g * 4 + r) * 64 + df * 16 + fq * 4) = accp[r][df];
            }
    }
}
constexpr int NPHASES = 24;
#ifndef PROBE_PHASE
#define PROBE_PHASE (-1)
#endif
#ifndef ATT_REP_CMP
#define ATT_REP_CMP 1
#endif
#ifndef ATT_REP_WIN
#define ATT_REP_WIN 1
#endif
#ifndef ATT_REP_SEL
#define ATT_REP_SEL 1
#endif
#ifndef TS_PHASE
#define TS_PHASE (-1)
#endif
#ifndef TS_MULT
#define TS_MULT 4
#endif
#ifndef PROBE_REPS
#define PROBE_REPS 1
#endif
__global__ void __launch_bounds__(NTHREADS, 2) mega(Params p) {
    __shared__ __attribute__((aligned(16))) unsigned char lds[LDS_BYTES];
    __shared__ __attribute__((aligned(16))) unsigned bar_st[4];
    cg::grid_group grid = cg::this_grid();
    const float* MOD = (const float*)(p.ws + WS_MOD);
    bf16_t* HM = (bf16_t*)(p.ws + WS_HM);
    if (threadIdx.x < 4) bar_st[threadIdx.x] = 0u;
    __syncthreads();
    XcdBarrier bar = xcd_barrier_post((unsigned*)(p.ws + WS_CTL), (volatile LAS unsigned*)bar_st);
    const int lo = p.ph_lo, hi = p.ph_hi;
    const bool dry0 = (p.ph_hi < 0);
    const int opq = (p.ph_hi < 0) ? 1 : 0;
    unsigned long long ts_a = 0ull, ts_b = 0ull;
#define PHASE(k, call, drycall) if (lo <= (k) && (k) < hi) { \
        if (TS_PHASE == (k)) ts_a = __builtin_amdgcn_s_memrealtime(); \
        if (PROBE_PHASE == (k)) { for (int rep = 0; rep < PROBE_REPS; ++rep) { const bool dry = !dry0; drycall; __syncthreads(); } } \
        { const bool dry = dry0; call; } \
        if ((k) + 1 < hi) { if ((k) == 0) grid.sync(); else xcd_barrier(bar); } \
        if (TS_PHASE == (k)) ts_b = __builtin_amdgcn_s_memrealtime(); }
    PHASE(0, phase_prep(p, (float*)lds), phase_prep(p, (float*)lds))
    PHASE(1, phase_norm(p, p.in[0], p.in[2], MOD + 0, MOD + 1024, HM), phase_norm(p, p.in[0], p.in[2], MOD + 0, MOD + 1024, HM))
    PHASE(2, phase_s5_win(p, lds), phase_s5_win(p, lds))
    PHASE(3, phase_s5_a(p, lds), phase_s5_a(p, lds))
    PHASE(4, phase_s5_scan(p), phase_s5_scan(p))
    PHASE(5, phase_s5_b(p, lds), phase_s5_b(p, lds))
    PHASE(6, phase_s5_glu(p, lds), phase_s5_glu(p, lds))
    PHASE(7, phase_norm(p, p.out, p.in[3], MOD + 3072, MOD + 4096, HM), phase_norm(p, p.out, p.in[3], MOD + 3072, MOD + 4096, HM))
    PHASE(8, phase_peer_wq(p, 0, lds), phase_peer_wq(p, 0, lds))
    PHASE(9, phase_peer_topk(p, 0, lds), phase_peer_topk(p, 0, lds))
    PHASE(10, phase_peer_combine(p, lds), phase_peer_combine(p, lds))
    PHASE(11, phase_peer_apply(p, 0, lds, dry), phase_peer_apply(p, 0, lds, dry))
    PHASE(12, (phase_norm(p, p.out, p.in[2] + D, MOD + 2 * 6144 + 0, MOD + 2 * 6144 + 1024, HM), phase_tab1(p)), (phase_norm(p, p.out, p.in[2] + D, MOD + 2 * 6144 + 0, MOD + 2 * 6144 + 1024, HM), phase_tab1(p)))
    PHASE(13, phase_nsa_proj(p, lds), phase_nsa_proj(p, lds))
    PHASE(14, phase_nsa_cmp1(p, lds), phase_nsa_cmp1(p, lds))
    PHASE(15, phase_nsa_cmp2(p, lds), phase_nsa_cmp2(p, lds))
    PHASE(16, phase_nsa_attn(p, lds, ATT_REP_CMP + opq, ATT_REP_WIN + opq, ATT_REP_SEL + opq), phase_nsa_attn(p, lds, 1 + opq, 1 + opq, 1 + opq))
    PHASE(17, phase_nsa_wo(p, lds, dry), phase_nsa_wo(p, lds, dry))
    PHASE(18, phase_norm(p, p.out, p.in[3] + D, MOD + 2 * 6144 + 3072, MOD + 2 * 6144 + 4096, HM), phase_norm(p, p.out, p.in[3] + D, MOD + 2 * 6144 + 3072, MOD + 2 * 6144 + 4096, HM))
    PHASE(19, phase_peer_wq(p, 1, lds), phase_peer_wq(p, 1, lds))
    PHASE(20, phase_peer_topk(p, 1, lds), phase_peer_topk(p, 1, lds))
    PHASE(21, phase_peer_combine(p, lds), phase_peer_combine(p, lds))
    PHASE(22, phase_peer_apply(p, 1, lds, dry), phase_peer_apply(p, 1, lds, dry))
    PHASE(23, phase_final_norm(p, p.out, p.out, dry), phase_final_norm(p, p.out, p.out, dry))
#undef PHASE
    if (TS_PHASE >= 0 && blockIdx.x == 0 && threadIdx.x == 0) {
        const unsigned long long t0 = __builtin_amdgcn_s_memrealtime(), want = (ts_b - ts_a) * TS_MULT;
        while (__builtin_amdgcn_s_memrealtime() - t0 < want) __builtin_amdgcn_s_sleep(8);
    }
}

extern "C" void kernel_launch(void* const* d_in, const int* in_sizes, int n_in, void* d_out, int out_size, void* d_ws, size_t ws_size, hipStream_t stream) {
    static int grid_blocks = 0;
    if (!grid_blocks) {
        int dev = 0, cus = 0, per_cu = 0;
        hipGetDevice(&dev);
        hipDeviceGetAttribute(&cus, hipDeviceAttributeMultiprocessorCount, dev);
        hipOccupancyMaxActiveBlocksPerMultiprocessor(&per_cu, mega, NTHREADS, 0);
        if (per_cu > 2) per_cu = 2;
        if (per_cu < 1) per_cu = 1;
        grid_blocks = cus * per_cu;
        if (ws_size < WS_END) fprintf(stderr, "kernel_launch: workspace too small: %zu < %zu\n", ws_size, (size_t)WS_END);
        if (n_in != 29) fprintf(stderr, "kernel_launch: expected 29 inputs, got %d\n", n_in);
    }
    hipMemsetAsync((unsigned char*)d_ws + WS_CTL, 0, 16384, stream);
    Params p{};
    for (int i = 0; i < 29; ++i) p.in[i] = (const float*)d_in[i];
    p.out = (float*)d_out; p.ws = (unsigned char*)d_ws;
#if SINGLE_LAUNCH
    p.ph_lo = 0; p.ph_hi = NPHASES;
    void* args[] = {&p};
    hipError_t e = hipLaunchCooperativeKernel((void*)mega, dim3(grid_blocks), dim3(NTHREADS), args, 0, stream);
    if (e != hipSuccess) fprintf(stderr, "cooperative launch failed: %s (grid %d)\n", hipGetErrorString(e), grid_blocks);
#else
    for (int ph = 0; ph < NPHASES; ++ph) {
        p.ph_lo = ph; p.ph_hi = ph + 1;
        hipLaunchKernelGGL(mega, dim3(grid_blocks), dim3(NTHREADS), 0, stream, p);
    }
#endif
}
```

```cpp
#include <hip/hip_runtime.h>
#include <hip/hip_cooperative_groups.h>
#include <cstdio>
#include <cstdint>
namespace cg = cooperative_groups;

#ifndef SINGLE_LAUNCH
#define SINGLE_LAUNCH 1
#endif

typedef unsigned short bf16_t;
typedef short bf16x8 __attribute__((ext_vector_type(8)));
typedef float f32x4 __attribute__((ext_vector_type(4)));
typedef float f32x2 __attribute__((ext_vector_type(2)));
typedef unsigned u32x4 __attribute__((ext_vector_type(4)));
typedef unsigned u32x2 __attribute__((ext_vector_type(2)));
typedef __bf16 bf16x2_t __attribute__((ext_vector_type(2)));

constexpr int D = 1024, BATCH = 2, SEQ = 16384, T = BATCH * SEQ;
constexpr int NTHREADS = 256;
constexpr float RMS_EPS = 1e-6f;
constexpr int S5G = 64, S5P = 64, S5L = 32, S5NCH = T / S5L  , S5CPB = SEQ / S5L  ;
constexpr int NH = 16, HD = 64, NG = 4, NPROJ = 2608, NPROJ_PAD = 2688, NC = 1023, NSB = 256;
constexpr int PH = 8, PK = 16, PNK = 128, PE = 16384;

constexpr size_t MiB = 1ull << 20;
constexpr size_t WS_CTL = 0;
constexpr size_t WS_MOD = 1 * MiB;
constexpr size_t WS_WIN_T = 2 * MiB;
constexpr size_t WS_WGLU_T = 4 * MiB;
constexpr size_t WS_WPROJ_T = 8 * MiB;
constexpr size_t WS_WK1_T = 14 * MiB;
constexpr size_t WS_WV1_T = 15 * MiB;
constexpr size_t WS_WK2_T = 16 * MiB;
constexpr size_t WS_WV2_T = 16 * MiB + 512 * 1024;
constexpr size_t WS_WO_T = 17 * MiB;
constexpr size_t WS_WQ_T = 19 * MiB;
constexpr size_t WS_SUBK = 27 * MiB;
constexpr size_t WS_ROPE = 28 * MiB;
constexpr size_t WS_MISC = 32 * MiB;
constexpr size_t WS_TW = 33 * MiB;
constexpr size_t WS_VG = 73 * MiB;
constexpr size_t WS_PU = 82 * MiB;
constexpr size_t WS_PV = 114 * MiB;
constexpr size_t WS_HM = 146 * MiB;
constexpr size_t WS_C = 210 * MiB;
constexpr size_t WS_UG = WS_C;
constexpr size_t WS_YI = WS_C + 64 * MiB;
constexpr size_t WS_WST = WS_C + 128 * MiB;
constexpr size_t WS_SST = WS_C + 160 * MiB;
constexpr size_t WS_YG = WS_C + 176 * MiB;
constexpr size_t WS_QK = WS_C;
constexpr size_t WS_TOPS = WS_C + 128 * MiB;
constexpr size_t WS_TOPI = WS_C + 160 * MiB;
constexpr size_t WS_EXP = WS_C + 192 * MiB;
constexpr size_t WS_GATE = WS_C + 208 * MiB;
constexpr size_t WS_Q = WS_C;
constexpr size_t WS_KC = WS_C + 64 * MiB;
constexpr size_t WS_VC = WS_C + 81 * MiB;
constexpr size_t WS_KS = WS_C + 98 * MiB;
constexpr size_t WS_VST = WS_C + 114 * MiB;
constexpr size_t WS_KW = WS_C + 130 * MiB;
constexpr size_t WS_VWT = WS_C + 146 * MiB;
constexpr size_t WS_NG = WS_C + 162 * MiB;
constexpr size_t WS_KCMP = WS_C + 170 * MiB;
constexpr size_t WS_VCMPT = WS_C + 171 * MiB;
constexpr size_t WS_HID = WS_C + 172 * MiB;
constexpr size_t WS_O = WS_C + 182 * MiB;
constexpr size_t WS_END = WS_C + 256 * MiB;

constexpr int LDS_BYTES = 73728;

struct Params {
    const float* in[29];
    float* out;
    unsigned char* ws;
    int ph_lo, ph_hi;
};

__device__ __forceinline__ unsigned f2bf(float f) { unsigned u = __builtin_bit_cast(unsigned, f); return (u + 0x7fffu + ((u >> 16) & 1u)) >> 16; }
__device__ __forceinline__ unsigned pk2(float lo, float hi) { return f2bf(lo) | (f2bf(hi) << 16); }
__device__ __forceinline__ float bf2f(unsigned h) { return __builtin_bit_cast(float, h << 16); }
__device__ __forceinline__ float bflo(unsigned w) { return __builtin_bit_cast(float, w << 16); }
__device__ __forceinline__ float bfhi(unsigned w) { return __builtin_bit_cast(float, w & 0xffff0000u); }
__device__ __forceinline__ float gelu_tanh(float x) {
    const float u = 0.7978845608028654f * (x + 0.044715f * x * x * x);
    const float e = __expf(2.0f * u);
    const float th = 1.0f - 2.0f / (e + 1.0f);
    return 0.5f * x * (1.0f + th);
}
__device__ __forceinline__ float sigmoidf_(float x) { return 1.0f / (1.0f + __expf(-x)); }
__device__ __forceinline__ float wave_sum(float v) {
#pragma unroll
    for (int o = 1; o < 64; o <<= 1) v += __shfl_xor(v, o);
    return v;
}
__device__ __forceinline__ float dot2bf(unsigned a, unsigned b, float acc) {
    return __builtin_amdgcn_fdot2_f32_bf16(__builtin_bit_cast(bf16x2_t, a), __builtin_bit_cast(bf16x2_t, b), acc, false);
}

#define LAS __attribute__((address_space(3)))
#define XB_TMO      128
#define XB_XCNT(j)  (256  + 64 * (j))
#define XB_XSUB(j)  (1280 + 64 * (j))
#define XB_XGEN(j)  (2304 + 64 * (j))
#define XB_TOP      3328
#define XB_TOPGEN   3392
#define XCD_BAR_WORDS 3456
#define XB_SPIN_CAP (1u << 24)

__device__ __forceinline__ unsigned xb_ld(unsigned* p)              { return __hip_atomic_load(p, __ATOMIC_RELAXED, __HIP_MEMORY_SCOPE_AGENT); }
__device__ __forceinline__ unsigned xb_add(unsigned* p, unsigned v) { return __hip_atomic_fetch_add(p, v, __ATOMIC_RELAXED, __HIP_MEMORY_SCOPE_AGENT); }
__device__ __forceinline__ unsigned xb_xcc_id() { return (unsigned)__builtin_amdgcn_s_getreg((3 << 11) | 20) & 0xFu; }
#define XB_SPIN(cond, bar) do { unsigned _sp = 0; while (cond) { __builtin_amdgcn_s_sleep(1); \
    if ((++_sp & 255u) == 0u) { if (xb_ld(&(bar)[XB_TMO])) break; if (_sp > XB_SPIN_CAP) { atomicAdd(&(bar)[XB_TMO], 1u); break; } } } } while (0)

struct XcdBarrier {
    unsigned* bar; unsigned x;
    volatile LAS unsigned* st;
};

__device__ __forceinline__ XcdBarrier xcd_barrier_post(unsigned* bar, volatile LAS unsigned* st) {
    XcdBarrier b; b.bar = bar; b.x = xb_xcc_id(); b.st = st;
    if (threadIdx.x == 0) (void)xb_add(&bar[XB_XCNT(b.x)], 1u);
    return b;
}
__device__ __forceinline__ void xcd_barrier_complete(unsigned* bar, unsigned x, unsigned& nloc, unsigned& nx) {
    const unsigned G = gridDim.x * gridDim.y * gridDim.z;
    unsigned sum, cnt, mine, sp = 0u;
    for (;;) {
        sum = 0u; cnt = 0u; mine = 0u;
#pragma unroll
        for (unsigned j = 0; j < 16; ++j) { const unsigned c = xb_ld(&bar[XB_XCNT(j)]); sum += c; cnt += (c > 0u) ? 1u : 0u; mine = (j == x) ? c : mine; }
        if (sum == G) break;
        __builtin_amdgcn_s_sleep(1);
        if ((++sp & 255u) == 0u) { if (xb_ld(&bar[XB_TMO])) break; if (sp > XB_SPIN_CAP) { atomicAdd(&bar[XB_TMO], 1u); break; } }
    }
    nloc = mine > 0u ? mine : 1u; nx = cnt > 0u ? cnt : 1u;
}

__device__ __forceinline__ void xcd_barrier(const XcdBarrier& b) {
    asm volatile("s_waitcnt vmcnt(0)" ::: "memory");
    __syncthreads();
    if (threadIdx.x == 0) {
        unsigned* bar = b.bar;
        __builtin_amdgcn_s_waitcnt(0);
        unsigned nloc = b.st[0], nx = b.st[1];
        if (nloc == 0u) { xcd_barrier_complete(bar, b.x, nloc, nx); b.st[0] = nloc; b.st[1] = nx; }
        const unsigned old = xb_add(&bar[XB_XSUB(b.x)], 1u);
        const unsigned gen = old / nloc;
        if (old + 1u == (gen + 1u) * nloc) {
            __builtin_amdgcn_fence(__ATOMIC_RELEASE, "agent");
            asm volatile("s_waitcnt vmcnt(0)" ::: "memory");
            const unsigned og = xb_add(&bar[XB_TOP], 1u);
            const unsigned tg = og / nx;
            if (og + 1u == (tg + 1u) * nx) xb_add(&bar[XB_TOPGEN], 1u);
            else XB_SPIN(xb_ld(&bar[XB_TOPGEN]) == tg, bar);
            __builtin_amdgcn_fence(__ATOMIC_ACQUIRE, "agent");
            xb_add(&bar[XB_XGEN(b.x)], 1u);
            asm volatile("s_waitcnt vmcnt(0)" ::: "memory");
        } else {
            XB_SPIN(xb_ld(&bar[XB_XGEN(b.x)]) == gen, bar);
            __builtin_amdgcn_fence(__ATOMIC_ACQUIRE, "agent");
            asm volatile("s_waitcnt vmcnt(0)" ::: "memory");
        }
    }
    __syncthreads();
}
__device__ __forceinline__ void prep_mod_item(const Params& p, int item, float* lds) {
    const int layer = item / 192, cg0 = (item % 192) * 32;
    const int tid = threadIdx.x, col = cg0 + (tid & 31), kg = tid >> 5;
    const float* W = p.in[4] + (size_t)layer * D * 6 * D;
    const float* c = p.in[1];
    float a0 = 0.f, a1 = 0.f;
    for (int k = kg * 128; k < kg * 128 + 128; ++k) {
        const float w = W[(size_t)k * (6 * D) + col];
        const float c0 = c[k], c1 = c[D + k];
        a0 += w * (c0 * sigmoidf_(c0));
        a1 += w * (c1 * sigmoidf_(c1));
    }
    lds[tid] = a0; lds[256 + tid] = a1;
    __syncthreads();
    if (tid < 64) {
        const int b = tid >> 5, cc = tid & 31;
        float s = 0.f;
#pragma unroll
        for (int g = 0; g < 8; ++g) s += lds[b * 256 + g * 32 + cc];
        float* MOD = (float*)(p.ws + WS_MOD);
        MOD[(size_t)(layer * 2 + b) * 6144 + cg0 + cc] = s + p.in[5][(size_t)layer * 6144 + cg0 + cc];
    }
    __syncthreads();
}

template <int MODE>
__device__ __forceinline__ void prep_transpose_item(const float* W, int K, int N, bf16_t* WT, int item, float* lds) {
    const int nbn = (N + 63) / 64, kb = item / nbn, nb = item % nbn, k0 = kb * 64, n0 = nb * 64;
    const int tid = threadIdx.x;
#pragma unroll
    for (int i = 0; i < 16; ++i) {
        const int kk = (tid >> 6) + 4 * i, nn = tid & 63;
        const float v = (n0 + nn < N) ? W[(size_t)(k0 + kk) * N + n0 + nn] : 0.f;
        lds[kk * 65 + nn] = v;
    }
    __syncthreads();
    {
        const int nn = tid >> 2, ks = (tid & 3) * 16;
        const int n = n0 + nn;
        if (n < N) {
            int np = n;
            if (MODE == 1) { const int j = (n < 1024) ? n : n - 1024; np = (j >> 4) * 32 + (j & 15) + ((n < 1024) ? 0 : 16); }
            u32x4 o0, o1;
            const float* s = lds + nn;
            o0.x = pk2(s[(ks + 0) * 65], s[(ks + 1) * 65]); o0.y = pk2(s[(ks + 2) * 65], s[(ks + 3) * 65]);
            o0.z = pk2(s[(ks + 4) * 65], s[(ks + 5) * 65]); o0.w = pk2(s[(ks + 6) * 65], s[(ks + 7) * 65]);
            o1.x = pk2(s[(ks + 8) * 65], s[(ks + 9) * 65]); o1.y = pk2(s[(ks + 10) * 65], s[(ks + 11) * 65]);
            o1.z = pk2(s[(ks + 12) * 65], s[(ks + 13) * 65]); o1.w = pk2(s[(ks + 14) * 65], s[(ks + 15) * 65]);
            u32x4* dst = (u32x4*)(WT + (size_t)np * K + k0 + ks);
            dst[0] = o0; dst[1] = o1;
        }
    }
    __syncthreads();
}

__device__ __forceinline__ void cvt_item(const float* src, bf16_t* dst, int item) {
    const size_t base = (size_t)item * 8192 + threadIdx.x * 8;
#pragma unroll
    for (int i = 0; i < 4; ++i) {
        const size_t o = base + (size_t)i * 2048;
        const f32x4 a = *(const f32x4*)(src + o), b = *(const f32x4*)(src + o + 4);
        u32x4 w; w.x = pk2(a.x, a.y); w.y = pk2(a.z, a.w); w.z = pk2(b.x, b.y); w.w = pk2(b.z, b.w);
        *(u32x4*)(dst + o) = w;
    }
}
__device__ __forceinline__ void zero_item(bf16_t* dst, int item) {
    const size_t base = (size_t)item * 8192 + threadIdx.x * 8;
#pragma unroll
    for (int i = 0; i < 4; ++i) *(u32x4*)(dst + base + (size_t)i * 2048) = (u32x4){0u, 0u, 0u, 0u};
}

struct cpx { float re, im; };
__device__ __forceinline__ cpx cmul(cpx a, cpx b) { return {a.re * b.re - a.im * b.im, a.re * b.im + a.im * b.re}; }
__device__ __forceinline__ cpx cexp_pow(float are, float aim, float dt, int m) {
    const float mag = __expf(are * dt * (float)m);
    const double rev = (double)aim * (double)dt * (double)m * 0.15915494309189535;
    const float fr = (float)(rev - rint(rev));
    return {mag * __builtin_amdgcn_cosf(fr), mag * __builtin_amdgcn_sinf(fr)};
}
__device__ __forceinline__ cpx s5_coef(float are, float aim, float dt) {
    cpx ab = cexp_pow(are, aim, dt, 1);
    const float nr = ab.re - 1.0f, ni = ab.im, den = are * are + aim * aim;
    return {(nr * are + ni * aim) / den, (ni * are - nr * aim) / den};
}

__device__ __forceinline__ void prep_s5_T_item(const Params& p, int item) {
    const int gid = item * 256 + threadIdx.x;
    const int g = gid >> 9, m = (gid >> 4) & 31, i = gid & 15;
    const float* a_re = p.in[7] + g * 64; const float* a_im = p.in[8] + g * 64;
    const float dt = __expf(p.in[9][g]);
    const float* b_re = p.in[10] + (size_t)g * 64 * 16; const float* b_im = p.in[11] + (size_t)g * 64 * 16;
    const float* c_re = p.in[12] + (size_t)g * 16 * 64 + i * 64; const float* c_im = p.in[13] + (size_t)g * 16 * 64 + i * 64;
    float acc[16];
#pragma unroll
    for (int j = 0; j < 16; ++j) acc[j] = 0.f;
    for (int q = 0; q < 64; ++q) {
        const float are = a_re[q], aim = a_im[q];
        cpx z = cmul(cmul({c_re[q], c_im[q]}, cexp_pow(are, aim, dt, m)), s5_coef(are, aim, dt));
        const f32x4* br = (const f32x4*)(b_re + q * 16); const f32x4* bi = (const f32x4*)(b_im + q * 16);
#pragma unroll
        for (int j4 = 0; j4 < 4; ++j4) {
            const f32x4 r = br[j4], im = bi[j4];
            acc[j4 * 4 + 0] += z.re * r.x - z.im * im.x; acc[j4 * 4 + 1] += z.re * r.y - z.im * im.y;
            acc[j4 * 4 + 2] += z.re * r.z - z.im * im.z; acc[j4 * 4 + 3] += z.re * r.w - z.im * im.w;
        }
    }
    u32x4 o0, o1;
    o0.x = pk2(acc[0], acc[1]); o0.y = pk2(acc[2], acc[3]); o0.z = pk2(acc[4], acc[5]); o0.w = pk2(acc[6], acc[7]);
    o1.x = pk2(acc[8], acc[9]); o1.y = pk2(acc[10], acc[11]); o1.z = pk2(acc[12], acc[13]); o1.w = pk2(acc[14], acc[15]);
    bf16_t* TW = (bf16_t*)(p.ws + WS_TW) + (size_t)g * 640 * 512;
    const u32x4 z4 = (u32x4){0u, 0u, 0u, 0u};
    for (int lp = 0; lp + m < 32; ++lp) {
        u32x4* d = (u32x4*)(TW + (size_t)((lp + m) * 16 + i) * 512 + lp * 16);
        d[0] = o0; d[1] = o1;
        if (m > 0) { u32x4* dz = (u32x4*)(TW + (size_t)(lp * 16 + i) * 512 + (lp + m) * 16); dz[0] = z4; dz[1] = z4; }
    }
}
__device__ __forceinline__ void prep_s5_W_item(const Params& p, int item) {
    const int gid = item * 256 + threadIdx.x;
    const int g = gid >> 11, q = (gid >> 5) & 63, lp = gid & 31;
    const float are = p.in[7][g * 64 + q], aim = p.in[8][g * 64 + q];
    const float dt = __expf(p.in[9][g]);
    const cpx z = cmul(cexp_pow(are, aim, dt, 31 - lp), s5_coef(are, aim, dt));
    const float* br = p.in[10] + ((size_t)g * 64 + q) * 16; const float* bi = p.in[11] + ((size_t)g * 64 + q) * 16;
    float wr[16], wi[16];
#pragma unroll
    for (int j = 0; j < 16; ++j) { wr[j] = z.re * br[j] - z.im * bi[j]; wi[j] = z.re * bi[j] + z.im * br[j]; }
    bf16_t* TW = (bf16_t*)(p.ws + WS_TW) + (size_t)g * 640 * 512;
    u32x4* d0 = (u32x4*)(TW + (size_t)(512 + q) * 512 + lp * 16);
    u32x4* d1 = (u32x4*)(TW + (size_t)(576 + q) * 512 + lp * 16);
    d0[0] = (u32x4){pk2(wr[0], wr[1]), pk2(wr[2], wr[3]), pk2(wr[4], wr[5]), pk2(wr[6], wr[7])};
    d0[1] = (u32x4){pk2(wr[8], wr[9]), pk2(wr[10], wr[11]), pk2(wr[12], wr[13]), pk2(wr[14], wr[15])};
    d1[0] = (u32x4){pk2(wi[0], wi[1]), pk2(wi[2], wi[3]), pk2(wi[4], wi[5]), pk2(wi[6], wi[7])};
    d1[1] = (u32x4){pk2(wi[8], wi[9]), pk2(wi[10], wi[11]), pk2(wi[12], wi[13]), pk2(wi[14], wi[15])};
}
__device__ __forceinline__ void prep_s5_V_item(const Params& p, int item) {
    const int gid = item * 256 + threadIdx.x;
    const int g = gid >> 14, l = (gid >> 9) & 31, i = (gid >> 5) & 15, q0 = (gid & 31) * 2;
    const float dt = __expf(p.in[9][g]);
    float vr[2], vi[2];
#pragma unroll
    for (int e = 0; e < 2; ++e) {
        const int q = q0 + e;
        const cpx z = cmul({p.in[12][((size_t)g * 16 + i) * 64 + q], p.in[13][((size_t)g * 16 + i) * 64 + q]}, cexp_pow(p.in[7][g * 64 + q], p.in[8][g * 64 + q], dt, l + 1));
        vr[e] = z.re; vi[e] = -z.im;
    }
    bf16_t* VG = (bf16_t*)(p.ws + WS_VG) + ((size_t)g * 512 + l * 16 + i) * 128;
    *(unsigned*)(VG + q0) = pk2(vr[0], vr[1]);
    *(unsigned*)(VG + 64 + q0) = pk2(vi[0], vi[1]);
}
__device__ __forceinline__ void prep_al_item(const Params& p, int item) {
    const int gid = item * 256 + threadIdx.x;
    const int g = gid >> 6;
    const float dt = __expf(p.in[9][g]);
    const cpx z = cexp_pow(p.in[7][gid], p.in[8][gid], dt, S5L);
    f32x2* AL = (f32x2*)(p.ws + WS_MISC + 4096);
    AL[gid] = (f32x2){z.re, z.im};
}
__device__ __forceinline__ void prep_rope_item(const Params& p, int item) {
    const int gid = item * 256 + threadIdx.x;
    const int pos = gid >> 5, j = gid & 31;
    const float freq = exp2f(-(float)j * (13.287712379549449f / 32.0f));
    const float ang = (float)pos * freq;
    const double rev = (double)ang * 0.15915494309189535;
    const float fr = (float)(rev - rint(rev));
    f32x2* R = (f32x2*)(p.ws + WS_ROPE);
    R[gid] = (f32x2){__builtin_amdgcn_cosf(fr), __builtin_amdgcn_sinf(fr)};
}
__device__ __forceinline__ void prep_cmpbias_item(const Params& p, int item, float* lds) {
    const int kv = item >> 3, cg0 = (item & 7) * 32;
    const float* pe = p.in[17 + kv]; const float* w1 = p.in[kv == 0 ? 19 : 21];
    const int tid = threadIdx.x, col = cg0 + (tid & 31), kg = tid >> 5;
    float s = 0.f;
#pragma unroll 8
    for (int k = kg * 256; k < kg * 256 + 256; ++k) s += pe[k] * w1[(size_t)k * 256 + col];
    lds[tid] = s;
    __syncthreads();
    if (tid < 32) {
        float t = 0.f;
#pragma unroll
        for (int q = 0; q < 8; ++q) t += lds[q * 32 + tid];
        ((float*)(p.ws + WS_MISC))[kv * 256 + cg0 + tid] = t;
    }
    __syncthreads();
}

__device__ __forceinline__ void cvt_fp8_item(const float* src, unsigned char* dst, float* inv_scale, int item) {
    const int lane = threadIdx.x & 63, row = item * 4 + (threadIdx.x >> 6);
    const f32x4* sp = (const f32x4*)(src + (size_t)row * D + lane * 16);
    const f32x4 a = sp[0], b = sp[1], c = sp[2], d = sp[3];
    float m = fmaxf(fmaxf(fmaxf(fabsf(a.x), fabsf(a.y)), fmaxf(fabsf(a.z), fabsf(a.w))), fmaxf(fmaxf(fabsf(b.x), fabsf(b.y)), fmaxf(fabsf(b.z), fabsf(b.w))));
    m = fmaxf(m, fmaxf(fmaxf(fmaxf(fabsf(c.x), fabsf(c.y)), fmaxf(fabsf(c.z), fabsf(c.w))), fmaxf(fmaxf(fabsf(d.x), fabsf(d.y)), fmaxf(fabsf(d.z), fabsf(d.w)))));
#pragma unroll
    for (int o = 1; o < 64; o <<= 1) m = fmaxf(m, __shfl_xor(m, o));
    const float sc = m > 0.f ? 224.0f / m : 1.0f;
    u32x4 w;
    int t = 0;
    t = __builtin_amdgcn_cvt_pk_fp8_f32(a.x * sc, a.y * sc, t, false); t = __builtin_amdgcn_cvt_pk_fp8_f32(a.z * sc, a.w * sc, t, true); w.x = (unsigned)t;
    t = __builtin_amdgcn_cvt_pk_fp8_f32(b.x * sc, b.y * sc, t, false); t = __builtin_amdgcn_cvt_pk_fp8_f32(b.z * sc, b.w * sc, t, true); w.y = (unsigned)t;
    t = __builtin_amdgcn_cvt_pk_fp8_f32(c.x * sc, c.y * sc, t, false); t = __builtin_amdgcn_cvt_pk_fp8_f32(c.z * sc, c.w * sc, t, true); w.z = (unsigned)t;
    t = __builtin_amdgcn_cvt_pk_fp8_f32(d.x * sc, d.y * sc, t, false); t = __builtin_amdgcn_cvt_pk_fp8_f32(d.z * sc, d.w * sc, t, true); w.w = (unsigned)t;
    *(u32x4*)(dst + (size_t)row * D + lane * 16) = w;
    if (lane == 0) inv_scale[row] = m > 0.f ? m / 224.0f : 1.0f;
}
constexpr int P0_MOD = 384;
constexpr int P0_T_WIN = 16 * 16, P0_T_WGLU = 16 * 32, P0_T_WPROJ = 16 * 41, P0_T_WK1 = 32 * 4, P0_T_WK2 = 4 * 1, P0_T_WO = 16 * 16, P0_T_WQ = 16 * 32;
constexpr int P0_SUBK = (2 * 8 * 2 * 128 * 128) / 8192;
constexpr int P0_TAB = PE / 4;
constexpr int P0_S5T = 128, P0_S5W = 512, P0_S5V = 4096, P0_AL = 16, P0_ROPE = 2048, P0_CB = 16, P0_ZERO = 10 + 2;

__device__ __forceinline__ void phase_prep(const Params& p, float* lds) {
    const int n0 = P0_MOD;
    const int n1 = n0 + P0_T_WIN, n2 = n1 + P0_T_WGLU, n3 = n2 + P0_T_WPROJ, n4 = n3 + P0_T_WK1, n5 = n4 + P0_T_WK1, n6 = n5 + P0_T_WK2, n7 = n6 + P0_T_WK2,
              n8 = n7 + P0_T_WO, n9 = n8 + P0_T_WQ, n10 = n9 + P0_T_WQ, n11 = n10 + P0_SUBK, n12 = n11 + P0_TAB, n13 = n12 + P0_TAB,
              n14 = n13 + P0_S5T, n15 = n14 + P0_S5W, n16 = n15 + P0_S5V, n17 = n16 + P0_AL, n18 = n17 + P0_ROPE, n19 = n18 + P0_CB, n20 = n19 + 10, n21 = n20 + 2, n22 = n21 + 2;
    unsigned char* ws = p.ws;
    for (int it = blockIdx.x; it < n22; it += gridDim.x) {
        if (it < n0) prep_mod_item(p, it, lds);
        else if (it < n1) prep_transpose_item<0>(p.in[6], 1024, 1024, (bf16_t*)(ws + WS_WIN_T), it - n0, lds);
        else if (it < n2) prep_transpose_item<1>(p.in[15], 1024, 2048, (bf16_t*)(ws + WS_WGLU_T), it - n1, lds);
        else if (it < n3) prep_transpose_item<0>(p.in[16], 1024, NPROJ, (bf16_t*)(ws + WS_WPROJ_T), it - n2, lds);
        else if (it < n4) prep_transpose_item<0>(p.in[19], 2048, 256, (bf16_t*)(ws + WS_WK1_T), it - n3, lds);
        else if (it < n5) prep_transpose_item<0>(p.in[21], 2048, 256, (bf16_t*)(ws + WS_WV1_T), it - n4, lds);
        else if (it < n6) prep_transpose_item<0>(p.in[20], 256, 64, (bf16_t*)(ws + WS_WK2_T), it - n5, lds);
        else if (it < n7) prep_transpose_item<0>(p.in[22], 256, 64, (bf16_t*)(ws + WS_WV2_T), it - n6, lds);
        else if (it < n8) prep_transpose_item<0>(p.in[23], 1024, 1024, (bf16_t*)(ws + WS_WO_T), it - n7, lds);
        else if (it < n9) prep_transpose_item<0>(p.in[24], 1024, 2048, (bf16_t*)(ws + WS_WQ_T), it - n8, lds);
        else if (it < n10) prep_transpose_item<0>(p.in[24] + (size_t)1024 * 2048, 1024, 2048, (bf16_t*)(ws + WS_WQ_T) + (size_t)2048 * 1024, it - n9, lds);
        else if (it < n11) cvt_item(p.in[25], (bf16_t*)(ws + WS_SUBK), it - n10);
        else if (it < n12) cvt_fp8_item(p.in[26], ws + WS_PU, (float*)(ws + WS_PU + 24 * MiB), it - n11);
        else if (it < n13) cvt_fp8_item(p.in[27], ws + WS_PV, (float*)(ws + WS_PV + 24 * MiB), it - n12);
        else if (it < n14) prep_s5_T_item(p, it - n13);
        else if (it < n15) prep_s5_W_item(p, it - n14);
        else if (it < n16) prep_s5_V_item(p, it - n15);
        else if (it < n17) prep_al_item(p, it - n16);
        else if (it < n18) prep_rope_item(p, it - n17);
        else if (it < n19) prep_cmpbias_item(p, it - n18, lds);
        else if (it < n20) zero_item((bf16_t*)(ws + WS_WPROJ_T) + (size_t)NPROJ * 1024, it - n19);
        else if (it < n21) zero_item((bf16_t*)(ws + WS_WK2_T) + (size_t)64 * 256, it - n20);
        else zero_item((bf16_t*)(ws + WS_WV2_T) + (size_t)64 * 256, it - n21);
    }
}

__device__ __forceinline__ void phase_norm(const Params& p, const float* X, const float* gw, const float* shift, const float* scale  , bf16_t* HM) {
    const int lane = threadIdx.x & 63, wave = threadIdx.x >> 6;
    for (int row = blockIdx.x * 4 + wave; row < T; row += gridDim.x * 4) {
        const int b = row / SEQ;
        const f32x4* xr = (const f32x4*)(X + (size_t)row * D) + lane;
        f32x4 v[4]; float s = 0.f;
#pragma unroll
        for (int j = 0; j < 4; ++j) { v[j] = xr[64 * j]; s += (v[j].x * v[j].x + v[j].y * v[j].y) + (v[j].z * v[j].z + v[j].w * v[j].w); }
        const float rs = rsqrtf(wave_sum(s) * (1.0f / D) + RMS_EPS);
        u32x2* o = (u32x2*)(HM + (size_t)row * D) + lane;
#pragma unroll
        for (int j = 0; j < 4; ++j) {
            const int c = lane * 4 + 256 * j;
            const f32x4 g = *(const f32x4*)(gw + c), sh = *(const f32x4*)(shift + (size_t)b * 6144 + c), sc = *(const f32x4*)(scale + (size_t)b * 6144 + c);
            const float y0 = v[j].x * rs * g.x * (1.f + sc.x) + sh.x, y1 = v[j].y * rs * g.y * (1.f + sc.y) + sh.y;
            const float y2 = v[j].z * rs * g.z * (1.f + sc.z) + sh.z, y3 = v[j].w * rs * g.w * (1.f + sc.w) + sh.w;
            o[64 * j] = (u32x2){pk2(y0, y1), pk2(y2, y3)};
        }
    }
}
__device__ __forceinline__ void phase_final_norm(const Params& p, const float* X, float* OUT, bool dry) {
    const int lane = threadIdx.x & 63, wave = threadIdx.x >> 6;
    const float* gw = p.in[28];
    for (int row = blockIdx.x * 4 + wave; row < T; row += gridDim.x * 4) {
        const f32x4* xr = (const f32x4*)(X + (size_t)row * D) + lane;
        f32x4 v[4]; float s = 0.f;
#pragma unroll
        for (int j = 0; j < 4; ++j) { v[j] = xr[64 * j]; s += (v[j].x * v[j].x + v[j].y * v[j].y) + (v[j].z * v[j].z + v[j].w * v[j].w); }
        const float rs = rsqrtf(wave_sum(s) * (1.0f / D) + RMS_EPS);
        f32x4* o = (f32x4*)(OUT + (size_t)row * D) + lane;
#pragma unroll
        for (int j = 0; j < 4; ++j) {
            const f32x4 g = *(const f32x4*)(gw + lane * 4 + 256 * j);
            if (!dry) o[64 * j] = (f32x4){v[j].x * rs * g.x, v[j].y * rs * g.y, v[j].z * rs * g.z, v[j].w * rs * g.w};
        }
    }
}

struct ALoadPlain {
    const bf16_t* A; size_t lda;
    __device__ __forceinline__ const bf16_t* ptr(int r, int k) const { return A + (size_t)r * lda + k; }
};
struct ALoadGroup {
    const bf16_t* A;
    __device__ __forceinline__ const bf16_t* ptr(int r, int k) const { return A + ((size_t)(k >> 4) * T + r) * 16 + (k & 15); }
};

template <class AL>
__device__ __forceinline__ void gemm_tile(const AL al, const bf16_t* __restrict__ Bt, size_t ldb, int nk, f32x4 (&acc)[4][4], unsigned char* lds) {
    const int tid = threadIdx.x, lane = tid & 63, wid = tid >> 6, wr = wid >> 1, wc = wid & 1, fr = lane & 15, fq = lane >> 4;
    const int lr = tid >> 3, lc = tid & 7;
#pragma unroll
    for (int mi = 0; mi < 4; ++mi)
#pragma unroll
        for (int ni = 0; ni < 4; ++ni) acc[mi][ni] = (f32x4){0.f, 0.f, 0.f, 0.f};
    u32x4 ra[4], rb[4];
    const int soff = lr * 128 + ((lc ^ (lr & 7)) << 4);
#pragma unroll
    for (int i = 0; i < 4; ++i) { ra[i] = *(const u32x4*)al.ptr(lr + 32 * i, lc * 8); rb[i] = *(const u32x4*)(Bt + (size_t)(lr + 32 * i) * ldb + lc * 8); }
#pragma unroll
    for (int i = 0; i < 4; ++i) { *(u32x4*)(lds + soff + i * 4096) = ra[i]; *(u32x4*)(lds + 16384 + soff + i * 4096) = rb[i]; }
    __syncthreads();
    const int aoff = (wr * 64 + fr) * 128, boff = 16384 + (wc * 64 + fr) * 128, sw = fr & 7;
    for (int kt = 0; kt < nk; ++kt) {
        const bool more = (kt + 1 < nk);
        if (more) {
#pragma unroll
            for (int i = 0; i < 4; ++i) { ra[i] = *(const u32x4*)al.ptr(lr + 32 * i, (kt + 1) * 64 + lc * 8); rb[i] = *(const u32x4*)(Bt + (size_t)(lr + 32 * i) * ldb + (kt + 1) * 64 + lc * 8); }
        }
        const unsigned char* buf = lds + (kt & 1) * 32768;
#pragma unroll
        for (int ks = 0; ks < 2; ++ks) {
            bf16x8 af[4], bfr[4];
            const int co = ((ks * 4 + fq) ^ sw) << 4;
#pragma unroll
            for (int mi = 0; mi < 4; ++mi) af[mi] = *(const bf16x8*)(buf + aoff + mi * 2048 + co);
#pragma unroll
            for (int ni = 0; ni < 4; ++ni) bfr[ni] = *(const bf16x8*)(buf + boff + ni * 2048 + co);
#pragma unroll
            for (int mi = 0; mi < 4; ++mi)
#pragma unroll
                for (int ni = 0; ni < 4; ++ni) acc[mi][ni] = __builtin_amdgcn_mfma_f32_16x16x32_bf16(bfr[ni], af[mi], acc[mi][ni], 0, 0, 0);
        }
        if (more) {
            unsigned char* nb = lds + ((kt + 1) & 1) * 32768;
#pragma unroll
            for (int i = 0; i < 4; ++i) { *(u32x4*)(nb + soff + i * 4096) = ra[i]; *(u32x4*)(nb + 16384 + soff + i * 4096) = rb[i]; }
        }
        __syncthreads();
    }
}
__device__ __forceinline__ void phase_s5_win(const Params& p, unsigned char* lds) {
    const bf16_t* HM = (const bf16_t*)(p.ws + WS_HM); const bf16_t* WT = (const bf16_t*)(p.ws + WS_WIN_T);
    bf16_t* UG = (bf16_t*)(p.ws + WS_UG);
    const int lane = threadIdx.x & 63, wid = threadIdx.x >> 6, wr = wid >> 1, wc = wid & 1, fr = lane & 15, fq = lane >> 4;
    for (int id = blockIdx.x; id < 256 * 8; id += gridDim.x) {
        const int mt = id >> 3, nt = id & 7;
        f32x4 acc[4][4];
        gemm_tile(ALoadPlain{HM + (size_t)mt * 128 * D, (size_t)D}, WT + (size_t)nt * 128 * D, D, 16, acc, lds);
#pragma unroll
        for (int mi = 0; mi < 4; ++mi)
#pragma unroll
            for (int ni = 0; ni < 4; ++ni) {
                const int t = mt * 128 + wr * 64 + mi * 16 + fr, g = nt * 8 + wc * 4 + ni;
                const f32x4 v = acc[mi][ni];
                *(u32x2*)(UG + ((size_t)g * T + t) * 16 + fq * 4) = (u32x2){pk2(v.x, v.y), pk2(v.z, v.w)};
            }
    }
}
__device__ __forceinline__ void phase_s5_a(const Params& p, unsigned char* lds) {
    const bf16_t* UG = (const bf16_t*)(p.ws + WS_UG); const bf16_t* TW = (const bf16_t*)(p.ws + WS_TW);
    bf16_t* YI = (bf16_t*)(p.ws + WS_YI); float* WST = (float*)(p.ws + WS_WST);
    const int lane = threadIdx.x & 63, wid = threadIdx.x >> 6, wr = wid >> 1, wc = wid & 1, fr = lane & 15, fq = lane >> 4;
    for (int id = blockIdx.x; id < 64 * 40; id += gridDim.x) {
        const int g = id / 40, rem = id % 40, mt = rem / 5, nt = rem % 5;
        const int nk = (nt < 4) ? 2 * (nt + 1) : 8;
        f32x4 acc[4][4];
        gemm_tile(ALoadPlain{UG + (size_t)g * T * 16 + (size_t)mt * 128 * 512, (size_t)512}, TW + ((size_t)g * 640 + nt * 128) * 512, 512, nk, acc, lds);
#pragma unroll
        for (int mi = 0; mi < 4; ++mi)
#pragma unroll
            for (int ni = 0; ni < 4; ++ni) {
                const int R = mt * 128 + wr * 64 + mi * 16 + fr, c = wc * 64 + ni * 16 + fq * 4;
                const f32x4 v = acc[mi][ni];
                if (nt < 4) *(u32x2*)(YI + ((size_t)g * 1024 + R) * 512 + nt * 128 + c) = (u32x2){pk2(v.x, v.y), pk2(v.z, v.w)};
                else *(f32x4*)(WST + ((size_t)g * 1024 + R) * 128 + c) = v;
            }
    }
}
__device__ __forceinline__ void phase_s5_scan(const Params& p) {
    const int lane = threadIdx.x & 63, wave = threadIdx.x >> 6;
    const float* WST = (const float*)(p.ws + WS_WST); bf16_t* SST = (bf16_t*)(p.ws + WS_SST);
    const f32x2* AL = (const f32x2*)(p.ws + WS_MISC + 4096);
    for (int it = blockIdx.x * 4 + wave; it < 128; it += gridDim.x * 4) {
        const int b = it >> 6, g = it & 63;
        const f32x2 al = AL[g * 64 + lane];
        float sr = 0.f, si = 0.f;
        const float* wbase = WST + ((size_t)g * 1024 + b * 512) * 128 + lane;
        bf16_t* sbase = SST + ((size_t)g * 1024 + b * 512) * 128 + lane;
        for (int n0 = 0; n0 < 512; n0 += 16) {
            float wre[16], wim[16];
#pragma unroll
            for (int j = 0; j < 16; ++j) { wre[j] = wbase[(size_t)(n0 + j) * 128]; wim[j] = wbase[(size_t)(n0 + j) * 128 + 64]; }
#pragma unroll
            for (int j = 0; j < 16; ++j) {
                sbase[(size_t)(n0 + j) * 128] = (bf16_t)f2bf(sr); sbase[(size_t)(n0 + j) * 128 + 64] = (bf16_t)f2bf(si);
                const float nr = al.x * sr - al.y * si + wre[j], ni = al.x * si + al.y * sr + wim[j];
                sr = nr; si = ni;
            }
        }
    }
}
__device__ __forceinline__ void phase_s5_b(const Params& p, unsigned char* lds) {
    const bf16_t* SST = (const bf16_t*)(p.ws + WS_SST); const bf16_t* VG = (const bf16_t*)(p.ws + WS_VG);
    const bf16_t* YI = (const bf16_t*)(p.ws + WS_YI); const bf16_t* UG = (const bf16_t*)(p.ws + WS_UG);
    bf16_t* YG = (bf16_t*)(p.ws + WS_YG);
    const float* dsk = p.in[14];
    const int lane = threadIdx.x & 63, wid = threadIdx.x >> 6, wr = wid >> 1, wc = wid & 1, fr = lane & 15, fq = lane >> 4;
    for (int id = blockIdx.x; id < 64 * 32; id += gridDim.x) {
        const int g = id >> 5, mt = (id >> 2) & 7, nt = id & 3;
        f32x4 acc[4][4];
        gemm_tile(ALoadPlain{SST + ((size_t)g * 1024 + mt * 128) * 128, (size_t)128}, VG + ((size_t)g * 512 + nt * 128) * 128, 128, 2, acc, lds);
        const f32x4 dv = *(const f32x4*)(dsk + g * 16 + fq * 4);
#pragma unroll
        for (int mi = 0; mi < 4; ++mi)
#pragma unroll
            for (int ni = 0; ni < 4; ++ni) {
                const int R = mt * 128 + wr * 64 + mi * 16 + fr, c = nt * 128 + wc * 64 + ni * 16 + fq * 4;
                const size_t idx = ((size_t)g * 1024 + R) * 512 + c;
                const u32x2 yi = *(const u32x2*)(YI + idx), uu = *(const u32x2*)(UG + idx);
                const f32x4 v = acc[mi][ni];
                const float y0 = gelu_tanh(v.x + bflo(yi.x) + dv.x * bflo(uu.x)), y1 = gelu_tanh(v.y + bfhi(yi.x) + dv.y * bfhi(uu.x));
                const float y2 = gelu_tanh(v.z + bflo(yi.y) + dv.z * bflo(uu.y)), y3 = gelu_tanh(v.w + bfhi(yi.y) + dv.w * bfhi(uu.y));
                *(u32x2*)(YG + idx) = (u32x2){pk2(y0, y1), pk2(y2, y3)};
            }
    }
}
__device__ __forceinline__ void phase_s5_glu(const Params& p, unsigned char* lds) {
    const bf16_t* YG = (const bf16_t*)(p.ws + WS_YG); const bf16_t* WT = (const bf16_t*)(p.ws + WS_WGLU_T);
    const float* MOD = (const float*)(p.ws + WS_MOD);
    const float* X = p.in[0]; float* XO = p.out;
    const int lane = threadIdx.x & 63, wid = threadIdx.x >> 6, wr = wid >> 1, wc = wid & 1, fr = lane & 15, fq = lane >> 4;
    for (int id = blockIdx.x; id < 256 * 16; id += gridDim.x) {
        const int mt = id >> 4, nt = id & 15;
        f32x4 acc[4][4];
        gemm_tile(ALoadGroup{YG + (size_t)mt * 128 * 16}, WT + (size_t)nt * 128 * D, D, 16, acc, lds);
        const int b = (mt * 128) / SEQ;
#pragma unroll
        for (int mi = 0; mi < 4; ++mi)
#pragma unroll
            for (int h = 0; h < 2; ++h) {
                const int t = mt * 128 + wr * 64 + mi * 16 + fr, j = nt * 64 + wc * 32 + h * 16 + fq * 4;
                const f32x4 a = acc[mi][2 * h], gg = acc[mi][2 * h + 1];
                const f32x4 g1 = *(const f32x4*)(MOD + (size_t)(0 * 2 + b) * 6144 + 2048 + j);
                const f32x4 xi = *(const f32x4*)(X + (size_t)t * D + j);
                f32x4 o;
                o.x = xi.x + g1.x * (a.x * sigmoidf_(gg.x)); o.y = xi.y + g1.y * (a.y * sigmoidf_(gg.y));
                o.z = xi.z + g1.z * (a.z * sigmoidf_(gg.z)); o.w = xi.w + g1.w * (a.w * sigmoidf_(gg.w));
                *(f32x4*)(XO + (size_t)t * D + j) = o;
            }
    }
}
__device__ __forceinline__ void phase_peer_wq(const Params& p, int layer, unsigned char* lds) {
    const bf16_t* HM = (const bf16_t*)(p.ws + WS_HM); const bf16_t* WT = (const bf16_t*)(p.ws + WS_WQ_T) + (size_t)layer * 2048 * 1024;
    bf16_t* QK = (bf16_t*)(p.ws + WS_QK);
    const int lane = threadIdx.x & 63, wid = threadIdx.x >> 6, wr = wid >> 1, wc = wid & 1, fr = lane & 15, fq = lane >> 4;
    for (int id = blockIdx.x; id < 256 * 16; id += gridDim.x) {
        const int mt = id >> 4, nt = id & 15;
        f32x4 acc[4][4];
        gemm_tile(ALoadPlain{HM + (size_t)mt * 128 * D, (size_t)D}, WT + (size_t)nt * 128 * D, D, 16, acc, lds);
#pragma unroll
        for (int mi = 0; mi < 4; ++mi)
#pragma unroll
            for (int ni = 0; ni < 4; ++ni) {
                const int t = mt * 128 + wr * 64 + mi * 16 + fr, c = nt * 128 + wc * 64 + ni * 16 + fq * 4;
                const f32x4 v = acc[mi][ni];
                *(u32x2*)(QK + (size_t)t * 2048 + c) = (u32x2){pk2(v.x, v.y), pk2(v.z, v.w)};
            }
    }
}
__device__ __forceinline__ void ce_(unsigned& a, unsigned& b, const bool up) { const unsigned lo = a < b ? a : b, hi = a < b ? b : a; a = up ? lo : hi; b = up ? hi : lo; }
__device__ __forceinline__ void bitonic_sort16(unsigned* x, const bool asc) {
#pragma unroll
    for (int k = 2; k <= 16; k <<= 1)
#pragma unroll
        for (int j = k >> 1; j > 0; j >>= 1)
#pragma unroll
            for (int i = 0; i < 16; ++i) { const int l = i ^ j; if (l > i) ce_(x[i], x[l], ((i & k) == 0) == asc); }
}
__device__ __forceinline__ void bitonic_merge16(unsigned* x, const bool asc) {
#pragma unroll
    for (int j = 8; j > 0; j >>= 1)
#pragma unroll
        for (int i = 0; i < 16; ++i) { const int l = i ^ j; if (l > i) ce_(x[i], x[l], asc); }
}
__device__ __forceinline__ void phase_peer_topk(const Params& p, int layer, unsigned char* lds) {
    const bf16_t* QK = (const bf16_t*)(p.ws + WS_QK); const bf16_t* SK = (const bf16_t*)(p.ws + WS_SUBK) + (size_t)layer * 8 * 2 * 128 * 128;
    float* TOPS = (float*)(p.ws + WS_TOPS); int* TOPI = (int*)(p.ws + WS_TOPI);
    float* sc = (float*)lds;
    const int tid = threadIdx.x, lane = tid & 63, wid = tid >> 6, wr = wid >> 1, wc = wid & 1, fr = lane & 15, fq = lane >> 4;
    for (int id = blockIdx.x; id < 256 * 16; id += gridDim.x) {
        const int mt = id >> 4, hc = id & 15;
        f32x4 acc[4][4];
        gemm_tile(ALoadPlain{QK + (size_t)mt * 128 * 2048 + hc * 128, (size_t)2048}, SK + (size_t)hc * 128 * 128, 128, 2, acc, lds);
#pragma unroll
        for (int mi = 0; mi < 4; ++mi)
#pragma unroll
            for (int ni = 0; ni < 4; ++ni) {
                const int r = wr * 64 + mi * 16 + fr, c = wc * 64 + ni * 16 + fq * 4;
                float* d = sc + r * 129 + c;
                d[0] = acc[mi][ni].x; d[1] = acc[mi][ni].y; d[2] = acc[mi][ni].z; d[3] = acc[mi][ni].w;
            }
        __syncthreads();
        {
            const int row = tid >> 1, half = tid & 1;
            unsigned x[64];
            const float* rp = sc + row * 129 + half * 64;
#pragma unroll
            for (int j = 0; j < 64; ++j) {
                const unsigned bits = __builtin_bit_cast(unsigned, rp[j]);
                const unsigned u = bits ^ ((unsigned)((int)bits >> 31) | 0x80000000u);
                x[j] = (u & 0xFFFFFF80u) | (unsigned)(127 - (half * 64 + j));
            }
            bitonic_sort16(x, true); bitonic_sort16(x + 16, false); bitonic_sort16(x + 32, true); bitonic_sort16(x + 48, false);
#pragma unroll
            for (int i = 0; i < 16; ++i) { x[i] = x[i] > x[16 + i] ? x[i] : x[16 + i]; x[32 + i] = x[32 + i] > x[48 + i] ? x[32 + i] : x[48 + i]; }
            bitonic_merge16(x, true); bitonic_merge16(x + 32, false);
#pragma unroll
            for (int i = 0; i < 16; ++i) x[i] = x[i] > x[32 + i] ? x[i] : x[32 + i];
            bitonic_merge16(x, false);
            unsigned y[16];
#pragma unroll
            for (int i = 0; i < 16; ++i) { const unsigned o = (unsigned)__shfl_xor((int)x[15 - i], 1); y[i] = x[i] > o ? x[i] : o; }
            bitonic_merge16(y, false);
            const size_t ob = ((size_t)(mt * 128 + row) * 16 + hc) * 16;
            if (half == 0) {
                float v[16];
#pragma unroll
                for (int i = 0; i < 16; ++i) { const unsigned u = y[i] & 0xFFFFFF80u; const unsigned bits = (u & 0x80000000u) ? (u ^ 0x80000000u) : ~u; v[i] = __builtin_bit_cast(float, bits); }
#pragma unroll
                for (int q = 0; q < 4; ++q) *(f32x4*)(TOPS + ob + q * 4) = (f32x4){v[q * 4], v[q * 4 + 1], v[q * 4 + 2], v[q * 4 + 3]};
            } else {
#pragma unroll
                for (int q = 0; q < 4; ++q) *(u32x4*)(TOPI + ob + q * 4) = (u32x4){127u - (y[q * 4] & 127u), 127u - (y[q * 4 + 1] & 127u), 127u - (y[q * 4 + 2] & 127u), 127u - (y[q * 4 + 3] & 127u)};
            }
        }
        __syncthreads();
    }
}
__device__ __forceinline__ void phase_peer_combine(const Params& p, unsigned char* lds) {
    const float* TOPS = (const float*)(p.ws + WS_TOPS); const int* TOPI = (const int*)(p.ws + WS_TOPI);
    int* EXP = (int*)(p.ws + WS_EXP); float* GATE = (float*)(p.ws + WS_GATE);
    unsigned* L = (unsigned*)lds;
    const int tid = threadIdx.x;
    for (int it = blockIdx.x; it < (T * 8) / 256; it += gridDim.x) {
        const size_t th = (size_t)it * 256 + tid;
        const u32x4* S4 = (const u32x4*)(TOPS + th * 32); const u32x4* I4 = (const u32x4*)(TOPI + th * 32);
#pragma unroll
        for (int a4 = 0; a4 < 8; ++a4) {
            const u32x4 s = S4[a4], i = I4[a4];
            L[(a4 * 4 + 0) * 256 + tid] = s.x; L[(a4 * 4 + 1) * 256 + tid] = s.y; L[(a4 * 4 + 2) * 256 + tid] = s.z; L[(a4 * 4 + 3) * 256 + tid] = s.w;
            L[(32 + a4 * 4 + 0) * 256 + tid] = i.x; L[(32 + a4 * 4 + 1) * 256 + tid] = i.y; L[(32 + a4 * 4 + 2) * 256 + tid] = i.z; L[(32 + a4 * 4 + 3) * 256 + tid] = i.w;
        }
        float val[16];
        const float s20 = __builtin_bit_cast(float, L[16 * 256 + tid]);
#pragma unroll
        for (int a = 0; a < 16; ++a) val[a] = __builtin_bit_cast(float, L[a * 256 + tid]) + s20;
        unsigned long long P = 0ull;
        float ts[16]; int te[16];
#pragma unroll
        for (int r = 0; r < 16; ++r) {
            float best = val[0]; int ba = 0;
#pragma unroll
            for (int a = 1; a < 16; ++a) if (val[a] > best) { best = val[a]; ba = a; }
            const int b = (int)((P >> (4 * ba)) & 15ull);
            const int i1 = (int)L[(32 + ba) * 256 + tid], i2 = (int)L[(48 + b) * 256 + tid];
            ts[r] = best; te[r] = i1 * 128 + i2;
            const int nb = b + 1;
            float newv = -3.0e38f;
            if (nb < 16) { newv = __builtin_bit_cast(float, L[ba * 256 + tid]) + __builtin_bit_cast(float, L[(16 + nb) * 256 + tid]); P += 1ull << (4 * ba); }
#pragma unroll
            for (int a = 0; a < 16; ++a) val[a] = (a == ba) ? newv : val[a];
        }
        const float m0 = ts[0];
        float sum = 0.f;
#pragma unroll
        for (int r = 0; r < 16; ++r) { ts[r] = __expf(ts[r] - m0); sum += ts[r]; }
        const float inv = 1.0f / sum;
#pragma unroll
        for (int r = 0; r < 16; ++r) ts[r] *= inv;
#pragma unroll
        for (int r = 0; r < 16; ++r) { EXP[th * 16 + r] = te[r]; GATE[th * 16 + r] = ts[r]; }
    }
}

__device__ __forceinline__ void fma8(const unsigned w0, const unsigned w1, const float a, float* acc) {
    const f32x2 p0 = __builtin_amdgcn_cvt_pk_f32_fp8((int)w0, false), p1 = __builtin_amdgcn_cvt_pk_f32_fp8((int)w0, true);
    const f32x2 p2 = __builtin_amdgcn_cvt_pk_f32_fp8((int)w1, false), p3 = __builtin_amdgcn_cvt_pk_f32_fp8((int)w1, true);
    acc[0] += a * p0.x; acc[1] += a * p0.y; acc[2] += a * p1.x; acc[3] += a * p1.y;
    acc[4] += a * p2.x; acc[5] += a * p2.y; acc[6] += a * p3.x; acc[7] += a * p3.y;
}
__device__ __forceinline__ float dot8(const unsigned w0, const unsigned w1, const float* h, float s) {
    const f32x2 p0 = __builtin_amdgcn_cvt_pk_f32_fp8((int)w0, false), p1 = __builtin_amdgcn_cvt_pk_f32_fp8((int)w0, true);
    const f32x2 p2 = __builtin_amdgcn_cvt_pk_f32_fp8((int)w1, false), p3 = __builtin_amdgcn_cvt_pk_f32_fp8((int)w1, true);
    s += p0.x * h[0]; s += p0.y * h[1]; s += p1.x * h[2]; s += p1.y * h[3];
    s += p2.x * h[4]; s += p2.y * h[5]; s += p3.x * h[6]; s += p3.y * h[7];
    return s;
}
__device__ __forceinline__ void phase_peer_apply(const Params& p, int layer, unsigned char* lds, bool dry) {
    const int lane = threadIdx.x & 63, wave = threadIdx.x >> 6;
    float* ldsw = (float*)lds + wave * (64 * 65);
    const bf16_t* HM = (const bf16_t*)(p.ws + WS_HM);
    const unsigned char* PU = p.ws + WS_PU; const unsigned char* PV = p.ws + WS_PV;
    const float* SU = (const float*)(p.ws + WS_PU + 24 * MiB); const float* SV = (const float*)(p.ws + WS_PV + 24 * MiB);
    const int* EXP = (const int*)(p.ws + WS_EXP); const float* GATE = (const float*)(p.ws + WS_GATE);
    const float* MOD = (const float*)(p.ws + WS_MOD);
    float* X = p.out;
    for (int t = blockIdx.x * 4 + wave; t < T; t += gridDim.x * 4) {
        const u32x4 ha = *(const u32x4*)(HM + (size_t)t * D + lane * 16), hb = *(const u32x4*)(HM + (size_t)t * D + lane * 16 + 8);
        float hf[16];
        hf[0] = bflo(ha.x); hf[1] = bfhi(ha.x); hf[2] = bflo(ha.y); hf[3] = bfhi(ha.y); hf[4] = bflo(ha.z); hf[5] = bfhi(ha.z); hf[6] = bflo(ha.w); hf[7] = bfhi(ha.w);
        hf[8] = bflo(hb.x); hf[9] = bfhi(hb.x); hf[10] = bflo(hb.y); hf[11] = bfhi(hb.y); hf[12] = bflo(hb.z); hf[13] = bfhi(hb.z); hf[14] = bflo(hb.w); hf[15] = bfhi(hb.w);
        const int e0 = EXP[(size_t)t * 128 + lane], e1 = EXP[(size_t)t * 128 + 64 + lane];
        const float g0 = GATE[(size_t)t * 128 + lane], g1 = GATE[(size_t)t * 128 + 64 + lane];
        const float su0 = SU[e0], su1 = SU[e1], sv0 = SV[e0], sv1 = SV[e1];
        float act0 = 0.f, act1 = 0.f;
#pragma unroll
        for (int half = 0; half < 2; ++half) {
            const int ev = half ? e1 : e0;
#pragma unroll 1
            for (int jg = 0; jg < 4; ++jg) {
                u32x4 ua[16];
#pragma unroll
                for (int j = 0; j < 16; ++j) {
                    const int e = __builtin_amdgcn_readlane(ev, jg * 16 + j);
                    ua[j] = *(const u32x4*)(PU + (size_t)e * D + lane * 16);
                }
#pragma unroll
                for (int j = 0; j < 16; ++j) {
                    float s = dot8(ua[j].x, ua[j].y, hf, 0.f);
                    s = dot8(ua[j].z, ua[j].w, hf + 8, s);
                    ldsw[(jg * 16 + j) * 65 + lane] = s;
                }
            }
            float tot = 0.f;
#pragma unroll 16
            for (int k = 0; k < 64; ++k) tot += ldsw[lane * 65 + k];
            const float a = gelu_tanh(tot * (half ? su1 : su0)) * (half ? g1 : g0) * (half ? sv1 : sv0);
            if (half) act1 = a; else act0 = a;
        }
        float acc[16];
#pragma unroll
        for (int i = 0; i < 16; ++i) acc[i] = 0.f;
#pragma unroll
        for (int half = 0; half < 2; ++half) {
            const int ev = half ? e1 : e0; const float av = half ? act1 : act0;
#pragma unroll 1
            for (int jg = 0; jg < 4; ++jg) {
                u32x4 va[16];
#pragma unroll
                for (int j = 0; j < 16; ++j) {
                    const int e = __builtin_amdgcn_readlane(ev, jg * 16 + j);
                    va[j] = *(const u32x4*)(PV + (size_t)e * D + lane * 16);
                }
#pragma unroll
                for (int j = 0; j < 16; ++j) {
                    const float a = __builtin_bit_cast(float, __builtin_amdgcn_readlane(__builtin_bit_cast(int, av), jg * 16 + j));
                    fma8(va[j].x, va[j].y, a, acc);
                    fma8(va[j].z, va[j].w, a, acc + 8);
                }
            }
        }
        const int b = t / SEQ;
        const float* g2 = MOD + (size_t)(layer * 2 + b) * 6144 + 5120;
        float* xr = X + (size_t)t * D + lane * 16;
#pragma unroll
        for (int q = 0; q < 4; ++q) {
            const f32x4 g = *(const f32x4*)(g2 + lane * 16 + q * 4); f32x4 x = *(const f32x4*)(xr + q * 4);
            x.x += g.x * acc[q * 4 + 0]; x.y += g.y * acc[q * 4 + 1]; x.z += g.z * acc[q * 4 + 2]; x.w += g.w * acc[q * 4 + 3];
            if (!dry) *(f32x4*)(xr + q * 4) = x;
        }
    }
}
__device__ __forceinline__ void phase_tab1(const Params& p) {
    for (int it = blockIdx.x; it < 2 * P0_TAB; it += gridDim.x) {
        if (it < P0_TAB) cvt_fp8_item(p.in[26] + (size_t)PE * D, p.ws + WS_PU, (float*)(p.ws + WS_PU + 24 * MiB), it);
        else cvt_fp8_item(p.in[27] + (size_t)PE * D, p.ws + WS_PV, (float*)(p.ws + WS_PV + 24 * MiB), it - P0_TAB);
    }
}
__device__ __forceinline__ void phase_nsa_proj(const Params& p, unsigned char* lds) {
    const bf16_t* HM = (const bf16_t*)(p.ws + WS_HM); const bf16_t* WT = (const bf16_t*)(p.ws + WS_WPROJ_T);
    const f32x2* ROPE = (const f32x2*)(p.ws + WS_ROPE);
    bf16_t* Q = (bf16_t*)(p.ws + WS_Q); float* NGT = (float*)(p.ws + WS_NG);
    const int lane = threadIdx.x & 63, wid = threadIdx.x >> 6, wr = wid >> 1, wc = wid & 1, fr = lane & 15, fq = lane >> 4;
    for (int id = blockIdx.x; id < 256 * 21; id += gridDim.x) {
        const int mt = id / 21, nt = id % 21;
        f32x4 acc[4][4];
        gemm_tile(ALoadPlain{HM + (size_t)mt * 128 * D, (size_t)D}, WT + (size_t)nt * 128 * D, D, 16, acc, lds);
        const int c0 = nt * 128 + wc * 64;
        if (c0 >= 2624) continue;
        const int b = (mt * 128) / SEQ;
        if (c0 == 2560) {
#pragma unroll
            for (int mi = 0; mi < 4; ++mi)
#pragma unroll
                for (int ni = 0; ni < 3; ++ni) {
                    const int t = mt * 128 + wr * 64 + mi * 16 + fr;
                    const f32x4 v = acc[mi][ni];
                    *(f32x4*)(NGT + (size_t)t * 48 + ni * 16 + fq * 4) = (f32x4){sigmoidf_(v.x), sigmoidf_(v.y), sigmoidf_(v.z), sigmoidf_(v.w)};
                }
            continue;
        }
        int sec = -1, g = 0;
        if (c0 >= 1024) { sec = (c0 - 1024) >> 8; g = ((c0 - 1024) & 255) >> 6; }
        const bool dorope = (sec == -1) || (sec == 2) || (sec == 4);
        const float scl = (sec == -1) ? 0.125f : 1.0f;
        const size_t secoff[6] = {WS_KC, WS_VC, WS_KS, WS_VST, WS_KW, WS_VWT};
        size_t so = WS_Q;
#pragma unroll
        for (int q = 0; q < 6; ++q) if (sec == q) so = secoff[q];
        bf16_t* OUT = (bf16_t*)(p.ws + so);
        const bool vt = (sec == 3) || (sec == 5);
#pragma unroll
        for (int mi = 0; mi < 4; ++mi) {
            const int t = mt * 128 + wr * 64 + mi * 16 + fr, s = t - b * SEQ;
            if (dorope) {
#pragma unroll
                for (int ni = 0; ni < 2; ++ni) {
                    const f32x4* rp = (const f32x4*)(ROPE + (size_t)s * 32 + ni * 16 + fq * 4);
                    const f32x4 r0 = rp[0], r1 = rp[1];
                    const f32x4 x1 = acc[mi][ni], x2 = acc[mi][ni + 2];
                    acc[mi][ni] = (f32x4){x1.x * r0.x - x2.x * r0.y, x1.y * r0.z - x2.y * r0.w, x1.z * r1.x - x2.z * r1.y, x1.w * r1.z - x2.w * r1.w};
                    acc[mi][ni + 2] = (f32x4){x1.x * r0.y + x2.x * r0.x, x1.y * r0.w + x2.y * r0.z, x1.z * r1.y + x2.z * r1.x, x1.w * r1.w + x2.w * r1.z};
                }
            }
#pragma unroll
            for (int ni = 0; ni < 4; ++ni) {
                const f32x4 v = acc[mi][ni] * scl;
                const int d = ni * 16 + fq * 4;
                if (sec == -1) {
                    *(u32x2*)(OUT + (size_t)t * 1024 + c0 + d) = (u32x2){pk2(v.x, v.y), pk2(v.z, v.w)};
                } else if (!vt) {
                    *(u32x2*)(OUT + ((size_t)(b * 4 + g) * SEQ + s) * 64 + d) = (u32x2){pk2(v.x, v.y), pk2(v.z, v.w)};
                } else {
                    bf16_t* o = OUT + ((size_t)(b * 4 + g) * 64 + d) * SEQ + s;
                    o[0] = (bf16_t)f2bf(v.x); o[SEQ] = (bf16_t)f2bf(v.y); o[2 * SEQ] = (bf16_t)f2bf(v.z); o[3 * SEQ] = (bf16_t)f2bf(v.w);
                }
            }
        }
    }
}
__device__ __forceinline__ void phase_nsa_cmp1(const Params& p, unsigned char* lds) {
    bf16_t* HID = (bf16_t*)(p.ws + WS_HID);
    const float* bias = (const float*)(p.ws + WS_MISC);
    const int lane = threadIdx.x & 63, wid = threadIdx.x >> 6, wr = wid >> 1, wc = wid & 1, fr = lane & 15, fq = lane >> 4;
    for (int id = blockIdx.x; id < 256; id += gridDim.x) {
        const int kv = id >> 7, bg = (id >> 4) & 7, mt = (id >> 1) & 7, nt = id & 1;
        const bf16_t* A = (const bf16_t*)(p.ws + (kv ? WS_VC : WS_KC)) + (size_t)bg * SEQ * 64 + (size_t)mt * 128 * 1024;
        const bf16_t* B = (const bf16_t*)(p.ws + (kv ? WS_WV1_T : WS_WK1_T)) + (size_t)nt * 128 * 2048;
        f32x4 acc[4][4];
        gemm_tile(ALoadPlain{A, (size_t)1024}, B, 2048, 32, acc, lds);
#pragma unroll
        for (int mi = 0; mi < 4; ++mi)
#pragma unroll
            for (int ni = 0; ni < 4; ++ni) {
                const int n = mt * 128 + wr * 64 + mi * 16 + fr, c = nt * 128 + wc * 64 + ni * 16 + fq * 4;
                const f32x4 bv = *(const f32x4*)(bias + kv * 256 + c);
                const f32x4 v = acc[mi][ni] + bv;
                *(u32x2*)(HID + (((size_t)kv * 8 + bg) * 1024 + n) * 256 + c) = (u32x2){pk2(gelu_tanh(v.x), gelu_tanh(v.y)), pk2(gelu_tanh(v.z), gelu_tanh(v.w))};
            }
    }
}
__device__ __forceinline__ void phase_nsa_cmp2(const Params& p, unsigned char* lds) {
    const bf16_t* HID = (const bf16_t*)(p.ws + WS_HID);
    const f32x2* ROPE = (const f32x2*)(p.ws + WS_ROPE);
    bf16_t* KCMP = (bf16_t*)(p.ws + WS_KCMP); bf16_t* VCMPT = (bf16_t*)(p.ws + WS_VCMPT);
    const int lane = threadIdx.x & 63, wid = threadIdx.x >> 6, wr = wid >> 1, wc = wid & 1, fr = lane & 15, fq = lane >> 4;
    for (int id = blockIdx.x; id < 128; id += gridDim.x) {
        const int kv = id >> 6, mt = id & 63;
        const bf16_t* A = HID + ((size_t)kv * 8192 + (size_t)mt * 128) * 256;
        const bf16_t* B = (const bf16_t*)(p.ws + (kv ? WS_WV2_T : WS_WK2_T));
        f32x4 acc[4][4];
        gemm_tile(ALoadPlain{A, (size_t)256}, B, 256, 4, acc, lds);
        if (wc == 1) continue;
#pragma unroll
        for (int mi = 0; mi < 4; ++mi) {
            const int R = mt * 128 + wr * 64 + mi * 16 + fr, bg = R >> 10, n = R & 1023;
            if (kv == 0) {
                int pos = n * 16 + 31; pos = pos > SEQ - 1 ? SEQ - 1 : pos;
#pragma unroll
                for (int ni = 0; ni < 2; ++ni) {
                    const f32x4* rp = (const f32x4*)(ROPE + (size_t)pos * 32 + ni * 16 + fq * 4);
                    const f32x4 r0 = rp[0], r1 = rp[1];
                    const f32x4 x1 = acc[mi][ni], x2 = acc[mi][ni + 2];
                    acc[mi][ni] = (f32x4){x1.x * r0.x - x2.x * r0.y, x1.y * r0.z - x2.y * r0.w, x1.z * r1.x - x2.z * r1.y, x1.w * r1.z - x2.w * r1.w};
                    acc[mi][ni + 2] = (f32x4){x1.x * r0.y + x2.x * r0.x, x1.y * r0.w + x2.y * r0.z, x1.z * r1.y + x2.z * r1.x, x1.w * r1.w + x2.w * r1.z};
                }
#pragma unroll
                for (int ni = 0; ni < 4; ++ni) {
                    const f32x4 v = acc[mi][ni];
                    *(u32x2*)(KCMP + ((size_t)bg * 1024 + n) * 64 + ni * 16 + fq * 4) = (u32x2){pk2(v.x, v.y), pk2(v.z, v.w)};
                }
            } else {
#pragma unroll
                for (int ni = 0; ni < 4; ++ni) {
                    const f32x4 v = acc[mi][ni];
                    bf16_t* o = VCMPT + ((size_t)bg * 64 + ni * 16 + fq * 4) * 1024 + n;
                    o[0] = (bf16_t)f2bf(v.x); o[1024] = (bf16_t)f2bf(v.y); o[2048] = (bf16_t)f2bf(v.z); o[3072] = (bf16_t)f2bf(v.w);
                }
            }
        }
    }
}
__device__ __forceinline__ void phase_nsa_wo(const Params& p, unsigned char* lds, bool dry) {
    const bf16_t* O = (const bf16_t*)(p.ws + WS_O); const bf16_t* WT = (const bf16_t*)(p.ws + WS_WO_T);
    const float* MOD = (const float*)(p.ws + WS_MOD);
    float* X = p.out;
    const int lane = threadIdx.x & 63, wid = threadIdx.x >> 6, wr = wid >> 1, wc = wid & 1, fr = lane & 15, fq = lane >> 4;
    for (int id = blockIdx.x; id < 256 * 8; id += gridDim.x) {
        const int mt = id >> 3, nt = id & 7;
        f32x4 acc[4][4];
        gemm_tile(ALoadPlain{O + (size_t)mt * 128 * D, (size_t)D}, WT + (size_t)nt * 128 * D, D, 16, acc, lds);
        const int b = (mt * 128) / SEQ;
#pragma unroll
        for (int mi = 0; mi < 4; ++mi)
#pragma unroll
            for (int ni = 0; ni < 4; ++ni) {
                const int t = mt * 128 + wr * 64 + mi * 16 + fr, c = nt * 128 + wc * 64 + ni * 16 + fq * 4;
                const f32x4 g1 = *(const f32x4*)(MOD + (size_t)(1 * 2 + b) * 6144 + 2048 + c);
                float* xp = X + (size_t)t * D + c;
                const f32x4 x = *(const f32x4*)xp; const f32x4 v = acc[mi][ni];
                if (!dry) *(f32x4*)xp = (f32x4){x.x + g1.x * v.x, x.y + g1.y * v.y, x.z + g1.z * v.z, x.w + g1.w * v.w};
            }
    }
}
__device__ __forceinline__ bf16x8 pack8(const f32x4 a, const f32x4 b) {
    u32x4 w; w.x = pk2(a.x, a.y); w.y = pk2(a.z, a.w); w.z = pk2(b.x, b.y); w.w = pk2(b.z, b.w);
    return __builtin_bit_cast(bf16x8, w);
}
__device__ __forceinline__ bf16x8 ldv8(const bf16_t* plo, const bf16_t* phi) {
    const u32x2 lo = *(const u32x2*)plo, hi = *(const u32x2*)phi;
    u32x4 w; w.x = lo.x; w.y = lo.y; w.z = hi.x; w.w = hi.y;
    return __builtin_bit_cast(bf16x8, w);
}
__device__ __forceinline__ float red4(float v) { v += __shfl_xor(v, 16); v += __shfl_xor(v, 32); return v; }
__device__ __forceinline__ float max4(float v) { v = fmaxf(v, __shfl_xor(v, 16)); v = fmaxf(v, __shfl_xor(v, 32)); return v; }
#define NEGBIG (-1.0e30f)

__device__ __forceinline__ void phase_nsa_attn(const Params& p, unsigned char* lds, const int rep_cmp, const int rep_win, const int rep_sel) {
    const int lane = threadIdx.x & 63, wave = threadIdx.x >> 6, fr = lane & 15, fq = lane >> 4;
    unsigned char* WL = lds + wave * 18432;
    float* IMP = (float*)WL;
    int* SEL = (int*)(WL + 17408);
    const bf16_t* Q = (const bf16_t*)(p.ws + WS_Q);
    const bf16_t* KCMP = (const bf16_t*)(p.ws + WS_KCMP); const bf16_t* VCMPT = (const bf16_t*)(p.ws + WS_VCMPT);
    const bf16_t* KS = (const bf16_t*)(p.ws + WS_KS); const bf16_t* VST = (const bf16_t*)(p.ws + WS_VST);
    const bf16_t* KW = (const bf16_t*)(p.ws + WS_KW); const bf16_t* VWT = (const bf16_t*)(p.ws + WS_VWT);
    const float* NGT = (const float*)(p.ws + WS_NG);
    bf16_t* O = (bf16_t*)(p.ws + WS_O);
    const f32x4 z4 = (f32x4){0.f, 0.f, 0.f, 0.f};
    for (int bi = blockIdx.x; bi < 2048; bi += gridDim.x) {
        const int bg = bi & 7, quad = 255 - (bi >> 3), t0 = (quad * 4 + wave) * 16, b = bg >> 2, g = bg & 3;
        const int cur = t0 >> 6;
        const size_t tok = (size_t)b * SEQ + t0 + fr;
        const int tq = t0 + fr;
        bf16x8 qf[4][2];
#pragma unroll
        for (int r = 0; r < 4; ++r)
#pragma unroll
            for (int ks = 0; ks < 2; ++ks) qf[r][ks] = *(const bf16x8*)(Q + tok * 1024 + (g * 4 + r) * 64 + ks * 32 + fq * 8);
        float gc[4], gw[4];
#pragma unroll
        for (int r = 0; r < 4; ++r) { const float* gp = NGT + tok * 48 + (g * 4 + r) * 3; gc[r] = gp[0]; gw[r] = gp[2]; }
        f32x4 acc[4][4];
        for (int rep = 0; rep < rep_win; ++rep) {
            const bf16_t* kwb = KW + (size_t)bg * SEQ * 64; const bf16_t* vwb = VWT + (size_t)bg * 64 * SEQ;
            float mw[4], lw[4];
#pragma unroll
            for (int r = 0; r < 4; ++r) { mw[r] = NEGBIG; lw[r] = 0.f;
#pragma unroll
                for (int df = 0; df < 4; ++df) acc[r][df] = z4; }
            int kmin = t0 - 511; kmin = kmin < 0 ? 0 : kmin; kmin &= ~31;
            for (int kb = kmin; kb <= t0 + 15; kb += 32) {
                bf16x8 kf[2][2];
#pragma unroll
                for (int f = 0; f < 2; ++f)
#pragma unroll
                    for (int ks = 0; ks < 2; ++ks) kf[f][ks] = *(const bf16x8*)(kwb + (size_t)(kb + f * 16 + fr) * 64 + ks * 32 + fq * 8);
                bf16x8 vf[4];
#pragma unroll
                for (int df = 0; df < 4; ++df) { const bf16_t* vp = vwb + (size_t)(df * 16 + fr) * SEQ + kb + 4 * fq; vf[df] = ldv8(vp, vp + 16); }
#pragma unroll
                for (int r = 0; r < 4; ++r) {
                    f32x4 st[2];
#pragma unroll
                    for (int f = 0; f < 2; ++f) {
                        st[f] = __builtin_amdgcn_mfma_f32_16x16x32_bf16(kf[f][0], qf[r][0], z4, 0, 0, 0);
                        st[f] = __builtin_amdgcn_mfma_f32_16x16x32_bf16(kf[f][1], qf[r][1], st[f], 0, 0, 0);
                    }
                    float mx = NEGBIG;
#pragma unroll
                    for (int f = 0; f < 2; ++f)
#pragma unroll
                        for (int e = 0; e < 4; ++e) { const int key = kb + f * 16 + fq * 4 + e; const bool ok = (key <= tq) && (key > tq - 512); if (ok) mx = fmaxf(mx, st[f][e]); }
                    mx = max4(mx);
                    const float mn = fmaxf(mw[r], mx);
                    const float al = __expf(mw[r] - mn);
                    float ps = 0.f;
#pragma unroll
                    for (int f = 0; f < 2; ++f)
#pragma unroll
                        for (int e = 0; e < 4; ++e) { const int key = kb + f * 16 + fq * 4 + e; const bool ok = (key <= tq) && (key > tq - 512); const float pv = ok ? __expf(st[f][e] - mn) : 0.f; st[f][e] = pv; ps += pv; }
                    lw[r] = lw[r] * al + ps; mw[r] = mn;
                    const bf16x8 pf = pack8(st[0], st[1]);
#pragma unroll
                    for (int df = 0; df < 4; ++df) { acc[r][df] = acc[r][df] * al; acc[r][df] = __builtin_amdgcn_mfma_f32_16x16x32_bf16(vf[df], pf, acc[r][df], 0, 0, 0); }
                    __builtin_amdgcn_sched_barrier(0);
                }
            }
#pragma unroll
            for (int r = 0; r < 4; ++r) {
                const float l = red4(lw[r]); const float sc = gw[r] / l;
#pragma unroll
                for (int df = 0; df < 4; ++df) acc[r][df] = acc[r][df] * sc;
            }
        }
        const int nmax_tile = (t0 >> 4) - 1, nmax_lane = (t0 >> 4) - 2 + (fr == 15 ? 1 : 0);
        const bf16_t* kcb = KCMP + (size_t)bg * 1024 * 64; const bf16_t* vcb = VCMPT + (size_t)bg * 64 * 1024;
        for (int rep = 0; rep < rep_cmp; ++rep) {
            const bool dry = (rep + 1 < rep_cmp);
            float mc[4], lc[4], invl[4];
#pragma unroll
            for (int r = 0; r < 4; ++r) { mc[r] = NEGBIG; lc[r] = 0.f; }
            for (int nb = 0; nb <= nmax_tile; nb += 32) {
                bf16x8 kf[2][2];
#pragma unroll
                for (int f = 0; f < 2; ++f)
#pragma unroll
                    for (int ks = 0; ks < 2; ++ks) kf[f][ks] = *(const bf16x8*)(kcb + (size_t)(nb + f * 16 + fr) * 64 + ks * 32 + fq * 8);
#pragma unroll
                for (int r = 0; r < 4; ++r) {
                    f32x4 st[2];
#pragma unroll
                    for (int f = 0; f < 2; ++f) {
                        st[f] = __builtin_amdgcn_mfma_f32_16x16x32_bf16(kf[f][0], qf[r][0], z4, 0, 0, 0);
                        st[f] = __builtin_amdgcn_mfma_f32_16x16x32_bf16(kf[f][1], qf[r][1], st[f], 0, 0, 0);
                    }
                    float mx = NEGBIG;
#pragma unroll
                    for (int f = 0; f < 2; ++f)
#pragma unroll
                        for (int e = 0; e < 4; ++e) { const int n = nb + f * 16 + fq * 4 + e; if (n <= nmax_lane) mx = fmaxf(mx, st[f][e]); }
                    mx = max4(mx);
                    const float mn = fmaxf(mc[r], mx);
                    float ps = 0.f;
#pragma unroll
                    for (int f = 0; f < 2; ++f)
#pragma unroll
                        for (int e = 0; e < 4; ++e) { const int n = nb + f * 16 + fq * 4 + e; if (n <= nmax_lane) ps += __expf(st[f][e] - mn); }
                    lc[r] = lc[r] * __expf(mc[r] - mn) + ps; mc[r] = mn;
                    __builtin_amdgcn_sched_barrier(0);
                }
            }
#pragma unroll
            for (int r = 0; r < 4; ++r) { const float l = red4(lc[r]); invl[r] = l > 0.f ? 1.0f / l : 0.f; }
            for (int i = lane; i < 16 * 260; i += 64) IMP[i] = 0.f;
            float carry = 0.f;
            for (int nb = 0; nb <= nmax_tile; nb += 32) {
                bf16x8 kf[2][2];
#pragma unroll
                for (int f = 0; f < 2; ++f)
#pragma unroll
                    for (int ks = 0; ks < 2; ++ks) kf[f][ks] = *(const bf16x8*)(kcb + (size_t)(nb + f * 16 + fr) * 64 + ks * 32 + fq * 8);
                bf16x8 vf[4];
#pragma unroll
                for (int df = 0; df < 4; ++df) { const bf16_t* vp = vcb + (size_t)(df * 16 + fr) * 1024 + nb + 4 * fq; vf[df] = ldv8(vp, vp + 16); }
                f32x4 pg[2] = {z4, z4};
#pragma unroll
                for (int r = 0; r < 4; ++r) {
                    f32x4 st[2];
#pragma unroll
                    for (int f = 0; f < 2; ++f) {
                        st[f] = __builtin_amdgcn_mfma_f32_16x16x32_bf16(kf[f][0], qf[r][0], z4, 0, 0, 0);
                        st[f] = __builtin_amdgcn_mfma_f32_16x16x32_bf16(kf[f][1], qf[r][1], st[f], 0, 0, 0);
#pragma unroll
                        for (int e = 0; e < 4; ++e) { const int n = nb + f * 16 + fq * 4 + e; st[f][e] = (n <= nmax_lane) ? __expf(st[f][e] - mc[r]) * invl[r] : 0.f; }
                        pg[f] += st[f];
                    }
                    const float gg = dry ? 0.f : gc[r];
                    const bf16x8 pf = pack8(st[0] * gg, st[1] * gg);
#pragma unroll
                    for (int df = 0; df < 4; ++df) acc[r][df] = __builtin_amdgcn_mfma_f32_16x16x32_bf16(vf[df], pf, acc[r][df], 0, 0, 0);
                    __builtin_amdgcn_sched_barrier(0);
                }
                const int src = (lane - 16) & 63;
                const float s0 = __shfl(pg[0].w, src), s1 = __shfl(pg[1].w, src), sc = __shfl(carry, src);
                const float prev0 = fq > 0 ? s0 : sc, prev1 = fq > 0 ? s1 : s0;
                const float imp0 = (pg[0].x + pg[0].y) + (pg[0].z + pg[0].w) + prev0;
                const float imp1 = (pg[1].x + pg[1].y) + (pg[1].z + pg[1].w) + prev1;
                const int jb = (nb >> 2) + fq;
                IMP[fr * 260 + jb] = imp0; IMP[fr * 260 + jb + 4] = imp1;
                carry = pg[1].w;
            }
        }
        {
            const int nf = cur >= 2 ? 3 : cur + 1;
            if (fq == 0) {
                SEL[fr * 16 + 0] = 0;
                if (cur == 1) SEL[fr * 16 + 1] = 1;
                if (cur >= 2) { SEL[fr * 16 + 1] = cur - 1; SEL[fr * 16 + 2] = cur; }
            }
            const int ncand = cur >= 3 ? cur - 2 : 0, extra = 16 - nf;
            if (ncand <= extra) {
                if (fq == 0) { for (int k = 0; k < extra; ++k) SEL[fr * 16 + nf + k] = (k < ncand) ? 1 + k : -1; }
            } else {
                for (int rnd = 0; rnd < extra; ++rnd) {
                    float bv = -1.0f; int bj = 1 << 20;
                    for (int jb = 1 + fq; jb <= cur - 2; jb += 4) { const float v = IMP[fr * 260 + jb]; if (v > bv) { bv = v; bj = jb; } }
#pragma unroll
                    for (int o = 16; o <= 32; o <<= 1) {
                        const float ov = __shfl_xor(bv, o); const int oj = __shfl_xor(bj, o);
                        if (ov > bv || (ov == bv && oj < bj)) { bv = ov; bj = oj; }
                    }
                    if (fq == 0) SEL[fr * 16 + nf + rnd] = bj;
                    if (((bj - 1) & 3) == fq) IMP[fr * 260 + bj] = -2.0f;
                }
            }
        }
        u32x2 accp[4][4];
#pragma unroll
        for (int r = 0; r < 4; ++r)
#pragma unroll
            for (int df = 0; df < 4; ++df) accp[r][df] = (u32x2){pk2(acc[r][df].x, acc[r][df].y), pk2(acc[r][df].z, acc[r][df].w)};
        for (int rep = 0; rep < rep_sel; ++rep) {
            const bool dry = (rep + 1 < rep_sel);
            const bf16_t* ksb = KS + (size_t)bg * SEQ * 64; const bf16_t* vsb = VST + (size_t)bg * 64 * SEQ;
            unsigned char* KL = WL; unsigned char* VL = WL + 8192;
            const int nv = cur + 1 < 16 ? cur + 1 : 16, total = 16 * nv;
            const int lrow = lane >> 3, lch = lane & 7;
            const int kwoff = lrow * 128 + ((lch ^ (lrow & 7)) << 4), vwoff = lrow * 144 + lch * 16;
            const int rr = fr & 3;
            u32x4 sk[8], sv[8];
            const unsigned koff = (unsigned)(lrow * 64 + lch * 8), voff = (unsigned)(lrow * SEQ + lch * 8);
            int jbn = __builtin_amdgcn_readfirstlane(SEL[0]);
            {
                const bf16_t* kb_ = ksb + (size_t)jbn * 4096; const bf16_t* vb_ = vsb + (size_t)jbn * 64;
#pragma unroll
                for (int j = 0; j < 8; ++j) { sk[j] = *(const u32x4*)(kb_ + j * 512 + koff); sv[j] = *(const u32x4*)(vb_ + (size_t)j * 8 * SEQ + voff); }
            }
            bf16x8 qs[2];
            float ms = NEGBIG, ls = 0.f;
            f32x4 os[4] = {z4, z4, z4, z4};
            int i = 0, k = 0;
            for (int v = 0; v < total; ++v) {
                const int jb = jbn;
#pragma unroll
                for (int j = 0; j < 8; ++j) { *(u32x4*)(KL + kwoff + j * 1024) = sk[j]; *(u32x4*)(VL + vwoff + j * 1152) = sv[j]; }
                if (v + 1 < total) {
                    int k2 = k + 1, i2 = i; if (k2 == nv) { k2 = 0; i2 = i + 1; }
                    jbn = __builtin_amdgcn_readfirstlane(SEL[i2 * 16 + k2]);
                    const bf16_t* kb_ = ksb + (size_t)jbn * 4096; const bf16_t* vb_ = vsb + (size_t)jbn * 64;
#pragma unroll
                    for (int j = 0; j < 8; ++j) { sk[j] = *(const u32x4*)(kb_ + j * 512 + koff); sv[j] = *(const u32x4*)(vb_ + (size_t)j * 8 * SEQ + voff); }
                }
                __builtin_amdgcn_sched_barrier(0);
                const int ti = t0 + i;
                if (k == 0) {
                    const size_t tk = (size_t)b * SEQ + ti;
#pragma unroll
                    for (int ks = 0; ks < 2; ++ks) qs[ks] = *(const bf16x8*)(Q + tk * 1024 + (g * 4 + rr) * 64 + ks * 32 + fq * 8);
                    ms = NEGBIG; ls = 0.f;
#pragma unroll
                    for (int df = 0; df < 4; ++df) os[df] = z4;
                }
                f32x4 st[4];
#pragma unroll
                for (int f = 0; f < 4; ++f) {
                    const bf16x8 k0 = *(const bf16x8*)(KL + (f * 16 + fr) * 128 + (((0 + fq) ^ (fr & 7)) << 4));
                    const bf16x8 k1 = *(const bf16x8*)(KL + (f * 16 + fr) * 128 + (((4 + fq) ^ (fr & 7)) << 4));
                    st[f] = __builtin_amdgcn_mfma_f32_16x16x32_bf16(k0, qs[0], z4, 0, 0, 0);
                    st[f] = __builtin_amdgcn_mfma_f32_16x16x32_bf16(k1, qs[1], st[f], 0, 0, 0);
                }
                if (jb == cur) {
#pragma unroll
                    for (int f = 0; f < 4; ++f)
#pragma unroll
                        for (int e = 0; e < 4; ++e) { const int key = jb * 64 + f * 16 + fq * 4 + e; if (key > ti) st[f][e] = NEGBIG; }
                }
                float mx = NEGBIG;
#pragma unroll
                for (int f = 0; f < 4; ++f) mx = fmaxf(mx, fmaxf(fmaxf(st[f].x, st[f].y), fmaxf(st[f].z, st[f].w)));
                mx = max4(mx);
                const float mn = fmaxf(ms, mx);
                const float al = __expf(ms - mn);
                float ps = 0.f;
#pragma unroll
                for (int f = 0; f < 4; ++f)
#pragma unroll
                    for (int e = 0; e < 4; ++e) { const float pv = (st[f][e] > -1.0e29f) ? __expf(st[f][e] - mn) : 0.f; st[f][e] = pv; ps += pv; }
                ls = ls * al + ps; ms = mn;
#pragma unroll
                for (int df = 0; df < 4; ++df) os[df] = os[df] * al;
#pragma unroll
                for (int s = 0; s < 2; ++s) {
                    const bf16x8 pf = pack8(st[2 * s], st[2 * s + 1]);
#pragma unroll
                    for (int df = 0; df < 4; ++df) {
                        const unsigned char* vp = VL + (df * 16 + fr) * 144 + (32 * s + 4 * fq) * 2;
                        const u32x2 lo = *(const u32x2*)vp, hi = *(const u32x2*)(vp + 32);
                        u32x4 w; w.x = lo.x; w.y = lo.y; w.z = hi.x; w.w = hi.y;
                        os[df] = __builtin_amdgcn_mfma_f32_16x16x32_bf16(__builtin_bit_cast(bf16x8, w), pf, os[df], 0, 0, 0);
                    }
                }
                if (k == nv - 1) {
                    const float l = red4(ls);
                    const float gsv = NGT[((size_t)b * SEQ + ti) * 48 + (g * 4 + rr) * 3 + 1];
                    const float sc = dry ? 0.f : gsv / l;
#pragma unroll
                    for (int df = 0; df < 4; ++df) {
                        const f32x4 val = os[df] * sc;
#pragma unroll
                        for (int r = 0; r < 4; ++r) {
                            const int srcl = r + 16 * fq;
                            const float t0_ = __shfl(val.x, srcl), t1_ = __shfl(val.y, srcl), t2_ = __shfl(val.z, srcl), t3_ = __shfl(val.w, srcl);
                            if (fr == i) {
                                const u32x2 c = accp[r][df];
                                accp[r][df] = (u32x2){pk2(bflo(c.x) + t0_, bfhi(c.x) + t1_), pk2(bflo(c.y) + t2_, bfhi(c.y) + t3_)};
                            }
                        }
                    }
                }
                ++k; if (k == nv) { k = 0; ++i; }
            }
        }
#pragma unroll
        for (int r = 0; r < 4; ++r)
#pragma unroll
            for (int df = 0; df < 4; ++df) {
                *(u32x2*)(O + tok * 1024 + (g * 4 + r) * 64 + df * 16 + fq * 4) = accp[r][df];
            }
    }
}
constexpr int NPHASES = 24;
#ifndef PROBE_PHASE
#define PROBE_PHASE (-1)
#endif
#ifndef ATT_REP_CMP
#define ATT_REP_CMP 1
#endif
#ifndef ATT_REP_WIN
#define ATT_REP_WIN 1
#endif
#ifndef ATT_REP_SEL
#define ATT_REP_SEL 1
#endif
#ifndef TS_PHASE
#define TS_PHASE (-1)
#endif
#ifndef TS_MULT
#define TS_MULT 4
#endif
#ifndef PROBE_REPS
#define PROBE_REPS 1
#endif
__global__ void __launch_bounds__(NTHREADS, 2) mega(Params p) {
    __shared__ __attribute__((aligned(16))) unsigned char lds[LDS_BYTES];
    __shared__ __attribute__((aligned(16))) unsigned bar_st[4];
    cg::grid_group grid = cg::this_grid();
    const float* MOD = (const float*)(p.ws + WS_MOD);
    bf16_t* HM = (bf16_t*)(p.ws + WS_HM);
    if (threadIdx.x < 4) bar_st[threadIdx.x] = 0u;
    __syncthreads();
    XcdBarrier bar = xcd_barrier_post((unsigned*)(p.ws + WS_CTL), (volatile LAS unsigned*)bar_st);
    const int lo = p.ph_lo, hi = p.ph_hi;
    const bool dry0 = (p.ph_hi < 0);
    const int opq = (p.ph_hi < 0) ? 1 : 0;
    unsigned long long ts_a = 0ull, ts_b = 0ull;
#define PHASE(k, call, drycall) if (lo <= (k) && (k) < hi) { \
        if (TS_PHASE == (k)) ts_a = __builtin_amdgcn_s_memrealtime(); \
        if (PROBE_PHASE == (k)) { for (int rep = 0; rep < PROBE_REPS; ++rep) { const bool dry = !dry0; drycall; __syncthreads(); } } \
        { const bool dry = dry0; call; } \
        if ((k) + 1 < hi) { if ((k) == 0) grid.sync(); else xcd_barrier(bar); } \
        if (TS_PHASE == (k)) ts_b = __builtin_amdgcn_s_memrealtime(); }
    PHASE(0, phase_prep(p, (float*)lds), phase_prep(p, (float*)lds))
    PHASE(1, phase_norm(p, p.in[0], p.in[2], MOD + 0, MOD + 1024, HM), phase_norm(p, p.in[0], p.in[2], MOD + 0, MOD + 1024, HM))
    PHASE(2, phase_s5_win(p, lds), phase_s5_win(p, lds))
    PHASE(3, phase_s5_a(p, lds), phase_s5_a(p, lds))
    PHASE(4, phase_s5_scan(p), phase_s5_scan(p))
    PHASE(5, phase_s5_b(p, lds), phase_s5_b(p, lds))
    PHASE(6, phase_s5_glu(p, lds), phase_s5_glu(p, lds))
    PHASE(7, phase_norm(p, p.out, p.in[3], MOD + 3072, MOD + 4096, HM), phase_norm(p, p.out, p.in[3], MOD + 3072, MOD + 4096, HM))
    PHASE(8, phase_peer_wq(p, 0, lds), phase_peer_wq(p, 0, lds))
    PHASE(9, phase_peer_topk(p, 0, lds), phase_peer_topk(p, 0, lds))
    PHASE(10, phase_peer_combine(p, lds), phase_peer_combine(p, lds))
    PHASE(11, phase_peer_apply(p, 0, lds, dry), phase_peer_apply(p, 0, lds, dry))
    PHASE(12, (phase_norm(p, p.out, p.in[2] + D, MOD + 2 * 6144 + 0, MOD + 2 * 6144 + 1024, HM), phase_tab1(p)), (phase_norm(p, p.out, p.in[2] + D, MOD + 2 * 6144 + 0, MOD + 2 * 6144 + 1024, HM), phase_tab1(p)))
    PHASE(13, phase_nsa_proj(p, lds), phase_nsa_proj(p, lds))
    PHASE(14, phase_nsa_cmp1(p, lds), phase_nsa_cmp1(p, lds))
    PHASE(15, phase_nsa_cmp2(p, lds), phase_nsa_cmp2(p, lds))
    PHASE(16, phase_nsa_attn(p, lds, ATT_REP_CMP + opq, ATT_REP_WIN + opq, ATT_REP_SEL + opq), phase_nsa_attn(p, lds, 1 + opq, 1 + opq, 1 + opq))
    PHASE(17, phase_nsa_wo(p, lds, dry), phase_nsa_wo(p, lds, dry))
    PHASE(18, phase_norm(p, p.out, p.in[3] + D, MOD + 2 * 6144 + 3072, MOD + 2 * 6144 + 4096, HM), phase_norm(p, p.out, p.in[3] + D, MOD + 2 * 6144 + 3072, MOD + 2 * 6144 + 4096, HM))
    PHASE(19, phase_peer_wq(p, 1, lds), phase_peer_wq(p, 1, lds))
    PHASE(20, phase_peer_topk(p, 1, lds), phase_peer_topk(p, 1, lds))
    PHASE(21, phase_peer_combine(p, lds), phase_peer_combine(p, lds))
    PHASE(22, phase_peer_apply(p, 1, lds, dry), phase_peer_apply(p, 1, lds, dry))
    PHASE(23, phase_final_norm(p, p.out, p.out, dry), phase_final_norm(p, p.out, p.out, dry))
#undef PHASE
    if (TS_PHASE >= 0 && blockIdx.x == 0 && threadIdx.x == 0) {
        const unsigned long long t0 = __builtin_amdgcn_s_memrealtime(), want = (ts_b - ts_a) * TS_MULT;
        while (__builtin_amdgcn_s_memrealtime() - t0 < want) __builtin_amdgcn_s_sleep(8);
    }
}

extern "C" void kernel_launch(void* const* d_in, const int* in_sizes, int n_in, void* d_out, int out_size, void* d_ws, size_t ws_size, hipStream_t stream) {
    static int grid_blocks = 0;
    if (!grid_blocks) {
        int dev = 0, cus = 0, per_cu = 0;
        hipGetDevice(&dev);
        hipDeviceGetAttribute(&cus, hipDeviceAttributeMultiprocessorCount, dev);
        hipOccupancyMaxActiveBlocksPerMultiprocessor(&per_cu, mega, NTHREADS, 0);
        if (per_cu > 2) per_cu = 2;
        if (per_cu < 1) per_cu = 1;
        grid_blocks = cus * per_cu;
        if (ws_size < WS_END) fprintf(stderr, "kernel_launch: workspace too small: %zu < %zu\n", ws_size, (size_t)WS_END);
        if (n_in != 29) fprintf(stderr, "kernel_launch: expected 29 inputs, got %d\n", n_in);
    }
    hipMemsetAsync((unsigned char*)d_ws + WS_CTL, 0, 16384, stream);
    Params p{};
    for (int i = 0; i < 29; ++i) p.in[i] = (const float*)d_in[i];
    p.out = (float*)d_out; p.ws = (unsigned char*)d_ws;
#if SINGLE_LAUNCH
    p.ph_lo = 0; p.ph_hi = NPHASES;
    void* args[] = {&p};
    hipError_t e = hipLaunchCooperativeKernel((void*)mega, dim3(grid_blocks), dim3(NTHREADS), args, 0, stream);
    if (e != hipSuccess) fprintf(stderr, "cooperative launch failed: %s (grid %d)\n", hipGetErrorString(e), grid_blocks);
#else
    for (int ph = 0; ph < NPHASES; ++ph) {
        p.ph_lo = ph; p.ph_hi = ph + 1;
        hipLaunchKernelGGL(mega, dim3(grid_blocks), dim3(NTHREADS), 0, stream, p);
    }
#endif
}
```

```cpp
#include <hip/hip_runtime.h>
#include <hip/hip_cooperative_groups.h>
#include <cstdio>
#include <cstdint>
namespace cg = cooperative_groups;

#ifndef SINGLE_LAUNCH
#define SINGLE_LAUNCH 1
#endif

typedef unsigned short bf16_t;
typedef short bf16x8 __attribute__((ext_vector_type(8)));
typedef float f32x4 __attribute__((ext_vector_type(4)));
typedef float f32x2 __attribute__((ext_vector_type(2)));
typedef unsigned u32x4 __attribute__((ext_vector_type(4)));
typedef unsigned u32x2 __attribute__((ext_vector_type(2)));
typedef __bf16 bf16x2_t __attribute__((ext_vector_type(2)));

constexpr int D = 1024, BATCH = 2, SEQ = 16384, T = BATCH * SEQ;
constexpr int NTHREADS = 256;
constexpr float RMS_EPS = 1e-6f;
constexpr int S5G = 64, S5P = 64, S5L = 32, S5NCH = T / S5L  , S5CPB = SEQ / S5L  ;
constexpr int NH = 16, HD = 64, NG = 4, NPROJ = 2608, NPROJ_PAD = 2688, NC = 1023, NSB = 256;
constexpr int PH = 8, PK = 16, PNK = 128, PE = 16384;

constexpr size_t MiB = 1ull << 20;
constexpr size_t WS_CTL = 0;
constexpr size_t WS_MOD = 1 * MiB;
constexpr size_t WS_WIN_T = 2 * MiB;
constexpr size_t WS_WGLU_T = 4 * MiB;
constexpr size_t WS_WPROJ_T = 8 * MiB;
constexpr size_t WS_WK1_T = 14 * MiB;
constexpr size_t WS_WV1_T = 15 * MiB;
constexpr size_t WS_WK2_T = 16 * MiB;
constexpr size_t WS_WV2_T = 16 * MiB + 512 * 1024;
constexpr size_t WS_WO_T = 17 * MiB;
constexpr size_t WS_WQ_T = 19 * MiB;
constexpr size_t WS_SUBK = 27 * MiB;
constexpr size_t WS_ROPE = 28 * MiB;
constexpr size_t WS_MISC = 32 * MiB;
constexpr size_t WS_TW = 33 * MiB;
constexpr size_t WS_VG = 73 * MiB;
constexpr size_t WS_PU = 82 * MiB;
constexpr size_t WS_PV = 114 * MiB;
constexpr size_t WS_HM = 146 * MiB;
constexpr size_t WS_C = 210 * MiB;
constexpr size_t WS_UG = WS_C;
constexpr size_t WS_YI = WS_C + 64 * MiB;
constexpr size_t WS_WST = WS_C + 128 * MiB;
constexpr size_t WS_SST = WS_C + 160 * MiB;
constexpr size_t WS_YG = WS_C + 176 * MiB;
constexpr size_t WS_QK = WS_C;
constexpr size_t WS_TOPS = WS_C + 128 * MiB;
constexpr size_t WS_TOPI = WS_C + 160 * MiB;
constexpr size_t WS_EXP = WS_C + 192 * MiB;
constexpr size_t WS_GATE = WS_C + 208 * MiB;
constexpr size_t WS_Q = WS_C;
constexpr size_t WS_KC = WS_C + 64 * MiB;
constexpr size_t WS_VC = WS_C + 81 * MiB;
constexpr size_t WS_KS = WS_C + 98 * MiB;
constexpr size_t WS_VST = WS_C + 114 * MiB;
constexpr size_t WS_KW = WS_C + 130 * MiB;
constexpr size_t WS_VWT = WS_C + 146 * MiB;
constexpr size_t WS_NG = WS_C + 162 * MiB;
constexpr size_t WS_KCMP = WS_C + 170 * MiB;
constexpr size_t WS_VCMPT = WS_C + 171 * MiB;
constexpr size_t WS_HID = WS_C + 172 * MiB;
constexpr size_t WS_O = WS_C + 182 * MiB;
constexpr size_t WS_END = WS_C + 256 * MiB;

constexpr int LDS_BYTES = 73728;

struct Params {
    const float* in[29];
    float* out;
    unsigned char* ws;
    int ph_lo, ph_hi;
};

__device__ __forceinline__ unsigned f2bf(float f) { unsigned u = __builtin_bit_cast(unsigned, f); return (u + 0x7fffu + ((u >> 16) & 1u)) >> 16; }
__device__ __forceinline__ unsigned pk2(float lo, float hi) { return f2bf(lo) | (f2bf(hi) << 16); }
__device__ __forceinline__ float bf2f(unsigned h) { return __builtin_bit_cast(float, h << 16); }
__device__ __forceinline__ float bflo(unsigned w) { return __builtin_bit_cast(float, w << 16); }
__device__ __forceinline__ float bfhi(unsigned w) { return __builtin_bit_cast(float, w & 0xffff0000u); }
__device__ __forceinline__ float gelu_tanh(float x) {
    const float u = 0.7978845608028654f * (x + 0.044715f * x * x * x);
    const float e = __expf(2.0f * u);
    const float th = 1.0f - 2.0f / (e + 1.0f);
    return 0.5f * x * (1.0f + th);
}
__device__ __forceinline__ float sigmoidf_(float x) { return 1.0f / (1.0f + __expf(-x)); }
__device__ __forceinline__ float wave_sum(float v) {
#pragma unroll
    for (int o = 1; o < 64; o <<= 1) v += __shfl_xor(v, o);
    return v;
}
__device__ __forceinline__ float dot2bf(unsigned a, unsigned b, float acc) {
    return __builtin_amdgcn_fdot2_f32_bf16(__builtin_bit_cast(bf16x2_t, a), __builtin_bit_cast(bf16x2_t, b), acc, false);
}

#define LAS __attribute__((address_space(3)))
#define XB_TMO      128
#define XB_XCNT(j)  (256  + 64 * (j))
#define XB_XSUB(j)  (1280 + 64 * (j))
#define XB_XGEN(j)  (2304 + 64 * (j))
#define XB_TOP      3328
#define XB_TOPGEN   3392
#define XCD_BAR_WORDS 3456
#define XB_SPIN_CAP (1u << 24)

__device__ __forceinline__ unsigned xb_ld(unsigned* p)              { return __hip_atomic_load(p, __ATOMIC_RELAXED, __HIP_MEMORY_SCOPE_AGENT); }
__device__ __forceinline__ unsigned xb_add(unsigned* p, unsigned v) { return __hip_atomic_fetch_add(p, v, __ATOMIC_RELAXED, __HIP_MEMORY_SCOPE_AGENT); }
__device__ __forceinline__ unsigned xb_xcc_id() { return (unsigned)__builtin_amdgcn_s_getreg((3 << 11) | 20) & 0xFu; }
#define XB_SPIN(cond, bar) do { unsigned _sp = 0; while (cond) { __builtin_amdgcn_s_sleep(1); \
    if ((++_sp & 255u) == 0u) { if (xb_ld(&(bar)[XB_TMO])) break; if (_sp > XB_SPIN_CAP) { atomicAdd(&(bar)[XB_TMO], 1u); break; } } } } while (0)

struct XcdBarrier {
    unsigned* bar; unsigned x;
    volatile LAS unsigned* st;
};

__device__ __forceinline__ XcdBarrier xcd_barrier_post(unsigned* bar, volatile LAS unsigned* st) {
    XcdBarrier b; b.bar = bar; b.x = xb_xcc_id(); b.st = st;
    if (threadIdx.x == 0) (void)xb_add(&bar[XB_XCNT(b.x)], 1u);
    return b;
}
__device__ __forceinline__ void xcd_barrier_complete(unsigned* bar, unsigned x, unsigned& nloc, unsigned& nx) {
    const unsigned G = gridDim.x * gridDim.y * gridDim.z;
    unsigned sum, cnt, mine, sp = 0u;
    for (;;) {
        sum = 0u; cnt = 0u; mine = 0u;
#pragma unroll
        for (unsigned j = 0; j < 16; ++j) { const unsigned c = xb_ld(&bar[XB_XCNT(j)]); sum += c; cnt += (c > 0u) ? 1u : 0u; mine = (j == x) ? c : mine; }
        if (sum == G) break;
        __builtin_amdgcn_s_sleep(1);
        if ((++sp & 255u) == 0u) { if (xb_ld(&bar[XB_TMO])) break; if (sp > XB_SPIN_CAP) { atomicAdd(&bar[XB_TMO], 1u); break; } }
    }
    nloc = mine > 0u ? mine : 1u; nx = cnt > 0u ? cnt : 1u;
}

__device__ __forceinline__ void xcd_barrier(const XcdBarrier& b) {
    asm volatile("s_waitcnt vmcnt(0)" ::: "memory");
    __syncthreads();
    if (threadIdx.x == 0) {
        unsigned* bar = b.bar;
        __builtin_amdgcn_s_waitcnt(0);
        unsigned nloc = b.st[0], nx = b.st[1];
        if (nloc == 0u) { xcd_barrier_complete(bar, b.x, nloc, nx); b.st[0] = nloc; b.st[1] = nx; }
        const unsigned old = xb_add(&bar[XB_XSUB(b.x)], 1u);
        const unsigned gen = old / nloc;
        if (old + 1u == (gen + 1u) * nloc) {
            __builtin_amdgcn_fence(__ATOMIC_RELEASE, "agent");
            asm volatile("s_waitcnt vmcnt(0)" ::: "memory");
            const unsigned og = xb_add(&bar[XB_TOP], 1u);
            const unsigned tg = og / nx;
            if (og + 1u == (tg + 1u) * nx) xb_add(&bar[XB_TOPGEN], 1u);
            else XB_SPIN(xb_ld(&bar[XB_TOPGEN]) == tg, bar);
            __builtin_amdgcn_fence(__ATOMIC_ACQUIRE, "agent");
            xb_add(&bar[XB_XGEN(b.x)], 1u);
            asm volatile("s_waitcnt vmcnt(0)" ::: "memory");
        } else {
            XB_SPIN(xb_ld(&bar[XB_XGEN(b.x)]) == gen, bar);
            __builtin_amdgcn_fence(__ATOMIC_ACQUIRE, "agent");
            asm volatile("s_waitcnt vmcnt(0)" ::: "memory");
        }
    }
    __syncthreads();
}
__device__ __forceinline__ void prep_mod_item(const Params& p, int item, float* lds) {
    const int layer = item / 192, cg0 = (item % 192) * 32;
    const int tid = threadIdx.x, col = cg0 + (tid & 31), kg = tid >> 5;
    const float* W = p.in[4] + (size_t)layer * D * 6 * D;
    const float* c = p.in[1];
    float a0 = 0.f, a1 = 0.f;
    for (int k = kg * 128; k < kg * 128 + 128; ++k) {
        const float w = W[(size_t)k * (6 * D) + col];
        const float c0 = c[k], c1 = c[D + k];
        a0 += w * (c0 * sigmoidf_(c0));
        a1 += w * (c1 * sigmoidf_(c1));
    }
    lds[tid] = a0; lds[256 + tid] = a1;
    __syncthreads();
    if (tid < 64) {
        const int b = tid >> 5, cc = tid & 31;
        float s = 0.f;
#pragma unroll
        for (int g = 0; g < 8; ++g) s += lds[b * 256 + g * 32 + cc];
        float* MOD = (float*)(p.ws + WS_MOD);
        MOD[(size_t)(layer * 2 + b) * 6144 + cg0 + cc] = s + p.in[5][(size_t)layer * 6144 + cg0 + cc];
    }
    __syncthreads();
}

template <int MODE>
__device__ __forceinline__ void prep_transpose_item(const float* W, int K, int N, bf16_t* WT, int item, float* lds) {
    const int nbn = (N + 63) / 64, kb = item / nbn, nb = item % nbn, k0 = kb * 64, n0 = nb * 64;
    const int tid = threadIdx.x;
#pragma unroll
    for (int i = 0; i < 16; ++i) {
        const int kk = (tid >> 6) + 4 * i, nn = tid & 63;
        const float v = (n0 + nn < N) ? W[(size_t)(k0 + kk) * N + n0 + nn] : 0.f;
        lds[kk * 65 + nn] = v;
    }
    __syncthreads();
    {
        const int nn = tid >> 2, ks = (tid & 3) * 16;
        const int n = n0 + nn;
        if (n < N) {
            int np = n;
            if (MODE == 1) { const int j = (n < 1024) ? n : n - 1024; np = (j >> 4) * 32 + (j & 15) + ((n < 1024) ? 0 : 16); }
            u32x4 o0, o1;
            const float* s = lds + nn;
            o0.x = pk2(s[(ks + 0) * 65], s[(ks + 1) * 65]); o0.y = pk2(s[(ks + 2) * 65], s[(ks + 3) * 65]);
            o0.z = pk2(s[(ks + 4) * 65], s[(ks + 5) * 65]); o0.w = pk2(s[(ks + 6) * 65], s[(ks + 7) * 65]);
            o1.x = pk2(s[(ks + 8) * 65], s[(ks + 9) * 65]); o1.y = pk2(s[(ks + 10) * 65], s[(ks + 11) * 65]);
            o1.z = pk2(s[(ks + 12) * 65], s[(ks + 13) * 65]); o1.w = pk2(s[(ks + 14) * 65], s[(ks + 15) * 65]);
            u32x4* dst = (u32x4*)(WT + (size_t)np * K + k0 + ks);
            dst[0] = o0; dst[1] = o1;
        }
    }
    __syncthreads();
}

__device__ __forceinline__ void cvt_item(const float* src, bf16_t* dst, int item) {
    const size_t base = (size_t)item * 8192 + threadIdx.x * 8;
#pragma unroll
    for (int i = 0; i < 4; ++i) {
        const size_t o = base + (size_t)i * 2048;
        const f32x4 a = *(const f32x4*)(src + o), b = *(const f32x4*)(src + o + 4);
        u32x4 w; w.x = pk2(a.x, a.y); w.y = pk2(a.z, a.w); w.z = pk2(b.x, b.y); w.w = pk2(b.z, b.w);
        *(u32x4*)(dst + o) = w;
    }
}
__device__ __forceinline__ void zero_item(bf16_t* dst, int item) {
    const size_t base = (size_t)item * 8192 + threadIdx.x * 8;
#pragma unroll
    for (int i = 0; i < 4; ++i) *(u32x4*)(dst + base + (size_t)i * 2048) = (u32x4){0u, 0u, 0u, 0u};
}

struct cpx { float re, im; };
__device__ __forceinline__ cpx cmul(cpx a, cpx b) { return {a.re * b.re - a.im * b.im, a.re * b.im + a.im * b.re}; }
__device__ __forceinline__ cpx cexp_pow(float are, float aim, float dt, int m) {
    const float mag = __expf(are * dt * (float)m);
    const double rev = (double)aim * (double)dt * (double)m * 0.15915494309189535;
    const float fr = (float)(rev - rint(rev));
    return {mag * __builtin_amdgcn_cosf(fr), mag * __builtin_amdgcn_sinf(fr)};
}
__device__ __forceinline__ cpx s5_coef(float are, float aim, float dt) {
    cpx ab = cexp_pow(are, aim, dt, 1);
    const float nr = ab.re - 1.0f, ni = ab.im, den = are * are + aim * aim;
    return {(nr * are + ni * aim) / den, (ni * are - nr * aim) / den};
}

__device__ __forceinline__ void prep_s5_T_item(const Params& p, int item) {
    const int gid = item * 256 + threadIdx.x;
    const int g = gid >> 9, m = (gid >> 4) & 31, i = gid & 15;
    const float* a_re = p.in[7] + g * 64; const float* a_im = p.in[8] + g * 64;
    const float dt = __expf(p.in[9][g]);
    const float* b_re = p.in[10] + (size_t)g * 64 * 16; const float* b_im = p.in[11] + (size_t)g * 64 * 16;
    const float* c_re = p.in[12] + (size_t)g * 16 * 64 + i * 64; const float* c_im = p.in[13] + (size_t)g * 16 * 64 + i * 64;
    float acc[16];
#pragma unroll
    for (int j = 0; j < 16; ++j) acc[j] = 0.f;
    for (int q = 0; q < 64; ++q) {
        const float are = a_re[q], aim = a_im[q];
        cpx z = cmul(cmul({c_re[q], c_im[q]}, cexp_pow(are, aim, dt, m)), s5_coef(are, aim, dt));
        const f32x4* br = (const f32x4*)(b_re + q * 16); const f32x4* bi = (const f32x4*)(b_im + q * 16);
#pragma unroll
        for (int j4 = 0; j4 < 4; ++j4) {
            const f32x4 r = br[j4], im = bi[j4];
            acc[j4 * 4 + 0] += z.re * r.x - z.im * im.x; acc[j4 * 4 + 1] += z.re * r.y - z.im * im.y;
            acc[j4 * 4 + 2] += z.re * r.z - z.im * im.z; acc[j4 * 4 + 3] += z.re * r.w - z.im * im.w;
        }
    }
    u32x4 o0, o1;
    o0.x = pk2(acc[0], acc[1]); o0.y = pk2(acc[2], acc[3]); o0.z = pk2(acc[4], acc[5]); o0.w = pk2(acc[6], acc[7]);
    o1.x = pk2(acc[8], acc[9]); o1.y = pk2(acc[10], acc[11]); o1.z = pk2(acc[12], acc[13]); o1.w = pk2(acc[14], acc[15]);
    bf16_t* TW = (bf16_t*)(p.ws + WS_TW) + (size_t)g * 640 * 512;
    const u32x4 z4 = (u32x4){0u, 0u, 0u, 0u};
    for (int lp = 0; lp + m < 32; ++lp) {
        u32x4* d = (u32x4*)(TW + (size_t)((lp + m) * 16 + i) * 512 + lp * 16);
        d[0] = o0; d[1] = o1;
        if (m > 0) { u32x4* dz = (u32x4*)(TW + (size_t)(lp * 16 + i) * 512 + (lp + m) * 16); dz[0] = z4; dz[1] = z4; }
    }
}
__device__ __forceinline__ void prep_s5_W_item(const Params& p, int item) {
    const int gid = item * 256 + threadIdx.x;
    const int g = gid >> 11, q = (gid >> 5) & 63, lp = gid & 31;
    const float are = p.in[7][g * 64 + q], aim = p.in[8][g * 64 + q];
    const float dt = __expf(p.in[9][g]);
    const cpx z = cmul(cexp_pow(are, aim, dt, 31 - lp), s5_coef(are, aim, dt));
    const float* br = p.in[10] + ((size_t)g * 64 + q) * 16; const float* bi = p.in[11] + ((size_t)g * 64 + q) * 16;
    float wr[16], wi[16];
#pragma unroll
    for (int j = 0; j < 16; ++j) { wr[j] = z.re * br[j] - z.im * bi[j]; wi[j] = z.re * bi[j] + z.im * br[j]; }
    bf16_t* TW = (bf16_t*)(p.ws + WS_TW) + (size_t)g * 640 * 512;
    u32x4* d0 = (u32x4*)(TW + (size_t)(512 + q) * 512 + lp * 16);
    u32x4* d1 = (u32x4*)(TW + (size_t)(576 + q) * 512 + lp * 16);
    d0[0] = (u32x4){pk2(wr[0], wr[1]), pk2(wr[2], wr[3]), pk2(wr[4], wr[5]), pk2(wr[6], wr[7])};
    d0[1] = (u32x4){pk2(wr[8], wr[9]), pk2(wr[10], wr[11]), pk2(wr[12], wr[13]), pk2(wr[14], wr[15])};
    d1[0] = (u32x4){pk2(wi[0], wi[1]), pk2(wi[2], wi[3]), pk2(wi[4], wi[5]), pk2(wi[6], wi[7])};
    d1[1] = (u32x4){pk2(wi[8], wi[9]), pk2(wi[10], wi[11]), pk2(wi[12], wi[13]), pk2(wi[14], wi[15])};
}
__device__ __forceinline__ void prep_s5_V_item(const Params& p, int item) {
    const int gid = item * 256 + threadIdx.x;
    const int g = gid >> 14, l = (gid >> 9) & 31, i = (gid >> 5) & 15, q0 = (gid & 31) * 2;
    const float dt = __expf(p.in[9][g]);
    float vr[2], vi[2];
#pragma unroll
    for (int e = 0; e < 2; ++e) {
        const int q = q0 + e;
        const cpx z = cmul({p.in[12][((size_t)g * 16 + i) * 64 + q], p.in[13][((size_t)g * 16 + i) * 64 + q]}, cexp_pow(p.in[7][g * 64 + q], p.in[8][g * 64 + q], dt, l + 1));
        vr[e] = z.re; vi[e] = -z.im;
    }
    bf16_t* VG = (bf16_t*)(p.ws + WS_VG) + ((size_t)g * 512 + l * 16 + i) * 128;
    *(unsigned*)(VG + q0) = pk2(vr[0], vr[1]);
    *(unsigned*)(VG + 64 + q0) = pk2(vi[0], vi[1]);
}
__device__ __forceinline__ void prep_al_item(const Params& p, int item) {
    const int gid = item * 256 + threadIdx.x;
    const int g = gid >> 6;
    const float dt = __expf(p.in[9][g]);
    const cpx z = cexp_pow(p.in[7][gid], p.in[8][gid], dt, S5L);
    f32x2* AL = (f32x2*)(p.ws + WS_MISC + 4096);
    AL[gid] = (f32x2){z.re, z.im};
}
__device__ __forceinline__ void prep_rope_item(const Params& p, int item) {
    const int gid = item * 256 + threadIdx.x;
    const int pos = gid >> 5, j = gid & 31;
    const float freq = exp2f(-(float)j * (13.287712379549449f / 32.0f));
    const float ang = (float)pos * freq;
    const double rev = (double)ang * 0.15915494309189535;
    const float fr = (float)(rev - rint(rev));
    f32x2* R = (f32x2*)(p.ws + WS_ROPE);
    R[gid] = (f32x2){__builtin_amdgcn_cosf(fr), __builtin_amdgcn_sinf(fr)};
}
__device__ __forceinline__ void prep_cmpbias_item(const Params& p, int item, float* lds) {
    const int kv = item >> 3, cg0 = (item & 7) * 32;
    const float* pe = p.in[17 + kv]; const float* w1 = p.in[kv == 0 ? 19 : 21];
    const int tid = threadIdx.x, col = cg0 + (tid & 31), kg = tid >> 5;
    float s = 0.f;
#pragma unroll 8
    for (int k = kg * 256; k < kg * 256 + 256; ++k) s += pe[k] * w1[(size_t)k * 256 + col];
    lds[tid] = s;
    __syncthreads();
    if (tid < 32) {
        float t = 0.f;
#pragma unroll
        for (int q = 0; q < 8; ++q) t += lds[q * 32 + tid];
        ((float*)(p.ws + WS_MISC))[kv * 256 + cg0 + tid] = t;
    }
    __syncthreads();
}

__device__ __forceinline__ void cvt_fp8_item(const float* src, unsigned char* dst, float* inv_scale, int item) {
    const int lane = threadIdx.x & 63, row = item * 4 + (threadIdx.x >> 6);
    const f32x4* sp = (const f32x4*)(src + (size_t)row * D + lane * 16);
    const f32x4 a = sp[0], b = sp[1], c = sp[2], d = sp[3];
    float m = fmaxf(fmaxf(fmaxf(fabsf(a.x), fabsf(a.y)), fmaxf(fabsf(a.z), fabsf(a.w))), fmaxf(fmaxf(fabsf(b.x), fabsf(b.y)), fmaxf(fabsf(b.z), fabsf(b.w))));
    m = fmaxf(m, fmaxf(fmaxf(fmaxf(fabsf(c.x), fabsf(c.y)), fmaxf(fabsf(c.z), fabsf(c.w))), fmaxf(fmaxf(fabsf(d.x), fabsf(d.y)), fmaxf(fabsf(d.z), fabsf(d.w)))));
#pragma unroll
    for (int o = 1; o < 64; o <<= 1) m = fmaxf(m, __shfl_xor(m, o));
    const float sc = m > 0.f ? 224.0f / m : 1.0f;
    u32x4 w;
    int t = 0;
    t = __builtin_amdgcn_cvt_pk_fp8_f32(a.x * sc, a.y * sc, t, false); t = __builtin_amdgcn_cvt_pk_fp8_f32(a.z * sc, a.w * sc, t, true); w.x = (unsigned)t;
    t = __builtin_amdgcn_cvt_pk_fp8_f32(b.x * sc, b.y * sc, t, false); t = __builtin_amdgcn_cvt_pk_fp8_f32(b.z * sc, b.w * sc, t, true); w.y = (unsigned)t;
    t = __builtin_amdgcn_cvt_pk_fp8_f32(c.x * sc, c.y * sc, t, false); t = __builtin_amdgcn_cvt_pk_fp8_f32(c.z * sc, c.w * sc, t, true); w.z = (unsigned)t;
    t = __builtin_amdgcn_cvt_pk_fp8_f32(d.x * sc, d.y * sc, t, false); t = __builtin_amdgcn_cvt_pk_fp8_f32(d.z * sc, d.w * sc, t, true); w.w = (unsigned)t;
    *(u32x4*)(dst + (size_t)row * D + lane * 16) = w;
    if (lane == 0) inv_scale[row] = m > 0.f ? m / 224.0f : 1.0f;
}
constexpr int P0_MOD = 384;
constexpr int P0_T_WIN = 16 * 16, P0_T_WGLU = 16 * 32, P0_T_WPROJ = 16 * 41, P0_T_WK1 = 32 * 4, P0_T_WK2 = 4 * 1, P0_T_WO = 16 * 16, P0_T_WQ = 16 * 32;
constexpr int P0_SUBK = (2 * 8 * 2 * 128 * 128) / 8192;
constexpr int P0_TAB = PE / 4;
constexpr int P0_S5T = 128, P0_S5W = 512, P0_S5V = 4096, P0_AL = 16, P0_ROPE = 2048, P0_CB = 16, P0_ZERO = 10 + 2;

__device__ __forceinline__ void phase_prep(const Params& p, float* lds) {
    const int n0 = P0_MOD;
    const int n1 = n0 + P0_T_WIN, n2 = n1 + P0_T_WGLU, n3 = n2 + P0_T_WPROJ, n4 = n3 + P0_T_WK1, n5 = n4 + P0_T_WK1, n6 = n5 + P0_T_WK2, n7 = n6 + P0_T_WK2,
              n8 = n7 + P0_T_WO, n9 = n8 + P0_T_WQ, n10 = n9 + P0_T_WQ, n11 = n10 + P0_SUBK, n12 = n11 + P0_TAB, n13 = n12 + P0_TAB,
              n14 = n13 + P0_S5T, n15 = n14 + P0_S5W, n16 = n15 + P0_S5V, n17 = n16 + P0_AL, n18 = n17 + P0_ROPE, n19 = n18 + P0_CB, n20 = n19 + 10, n21 = n20 + 2, n22 = n21 + 2;
    unsigned char* ws = p.ws;
    for (int it = blockIdx.x; it < n22; it += gridDim.x) {
        if (it < n0) prep_mod_item(p, it, lds);
        else if (it < n1) prep_transpose_item<0>(p.in[6], 1024, 1024, (bf16_t*)(ws + WS_WIN_T), it - n0, lds);
        else if (it < n2) prep_transpose_item<1>(p.in[15], 1024, 2048, (bf16_t*)(ws + WS_WGLU_T), it - n1, lds);
        else if (it < n3) prep_transpose_item<0>(p.in[16], 1024, NPROJ, (bf16_t*)(ws + WS_WPROJ_T), it - n2, lds);
        else if (it < n4) prep_transpose_item<0>(p.in[19], 2048, 256, (bf16_t*)(ws + WS_WK1_T), it - n3, lds);
        else if (it < n5) prep_transpose_item<0>(p.in[21], 2048, 256, (bf16_t*)(ws + WS_WV1_T), it - n4, lds);
        else if (it < n6) prep_transpose_item<0>(p.in[20], 256, 64, (bf16_t*)(ws + WS_WK2_T), it - n5, lds);
        else if (it < n7) prep_transpose_item<0>(p.in[22], 256, 64, (bf16_t*)(ws + WS_WV2_T), it - n6, lds);
        else if (it < n8) prep_transpose_item<0>(p.in[23], 1024, 1024, (bf16_t*)(ws + WS_WO_T), it - n7, lds);
        else if (it < n9) prep_transpose_item<0>(p.in[24], 1024, 2048, (bf16_t*)(ws + WS_WQ_T), it - n8, lds);
        else if (it < n10) prep_transpose_item<0>(p.in[24] + (size_t)1024 * 2048, 1024, 2048, (bf16_t*)(ws + WS_WQ_T) + (size_t)2048 * 1024, it - n9, lds);
        else if (it < n11) cvt_item(p.in[25], (bf16_t*)(ws + WS_SUBK), it - n10);
        else if (it < n12) cvt_fp8_item(p.in[26], ws + WS_PU, (float*)(ws + WS_PU + 24 * MiB), it - n11);
        else if (it < n13) cvt_fp8_item(p.in[27], ws + WS_PV, (float*)(ws + WS_PV + 24 * MiB), it - n12);
        else if (it < n14) prep_s5_T_item(p, it - n13);
        else if (it < n15) prep_s5_W_item(p, it - n14);
        else if (it < n16) prep_s5_V_item(p, it - n15);
        else if (it < n17) prep_al_item(p, it - n16);
        else if (it < n18) prep_rope_item(p, it - n17);
        else if (it < n19) prep_cmpbias_item(p, it - n18, lds);
        else if (it < n20) zero_item((bf16_t*)(ws + WS_WPROJ_T) + (size_t)NPROJ * 1024, it - n19);
        else if (it < n21) zero_item((bf16_t*)(ws + WS_WK2_T) + (size_t)64 * 256, it - n20);
        else zero_item((bf16_t*)(ws + WS_WV2_T) + (size_t)64 * 256, it - n21);
    }
}

__device__ __forceinline__ void phase_norm(const Params& p, const float* X, const float* gw, const float* shift, const float* scale  , bf16_t* HM) {
    const int lane = threadIdx.x & 63, wave = threadIdx.x >> 6;
    for (int row = blockIdx.x * 4 + wave; row < T; row += gridDim.x * 4) {
        const int b = row / SEQ;
        const f32x4* xr = (const f32x4*)(X + (size_t)row * D) + lane;
        f32x4 v[4]; float s = 0.f;
#pragma unroll
        for (int j = 0; j < 4; ++j) { v[j] = xr[64 * j]; s += (v[j].x * v[j].x + v[j].y * v[j].y) + (v[j].z * v[j].z + v[j].w * v[j].w); }
        const float rs = rsqrtf(wave_sum(s) * (1.0f / D) + RMS_EPS);
        u32x2* o = (u32x2*)(HM + (size_t)row * D) + lane;
#pragma unroll
        for (int j = 0; j < 4; ++j) {
            const int c = lane * 4 + 256 * j;
            const f32x4 g = *(const f32x4*)(gw + c), sh = *(const f32x4*)(shift + (size_t)b * 6144 + c), sc = *(const f32x4*)(scale + (size_t)b * 6144 + c);
            const float y0 = v[j].x * rs * g.x * (1.f + sc.x) + sh.x, y1 = v[j].y * rs * g.y * (1.f + sc.y) + sh.y;
            const float y2 = v[j].z * rs * g.z * (1.f + sc.z) + sh.z, y3 = v[j].w * rs * g.w * (1.f + sc.w) + sh.w;
            o[64 * j] = (u32x2){pk2(y0, y1), pk2(y2, y3)};
        }
    }
}
__device__ __forceinline__ void phase_final_norm(const Params& p, const float* X, float* OUT, bool dry) {
    const int lane = threadIdx.x & 63, wave = threadIdx.x >> 6;
    const float* gw = p.in[28];
    for (int row = blockIdx.x * 4 + wave; row < T; row += gridDim.x * 4) {
        const f32x4* xr = (const f32x4*)(X + (size_t)row * D) + lane;
        f32x4 v[4]; float s = 0.f;
#pragma unroll
        for (int j = 0; j < 4; ++j) { v[j] = xr[64 * j]; s += (v[j].x * v[j].x + v[j].y * v[j].y) + (v[j].z * v[j].z + v[j].w * v[j].w); }
        const float rs = rsqrtf(wave_sum(s) * (1.0f / D) + RMS_EPS);
        f32x4* o = (f32x4*)(OUT + (size_t)row * D) + lane;
#pragma unroll
        for (int j = 0; j < 4; ++j) {
            const f32x4 g = *(const f32x4*)(gw + lane * 4 + 256 * j);
            if (!dry) o[64 * j] = (f32x4){v[j].x * rs * g.x, v[j].y * rs * g.y, v[j].z * rs * g.z, v[j].w * rs * g.w};
        }
    }
}

__device__ __forceinline__ int vblock() { const int G = gridDim.x, bx = blockIdx.x; return (G % 8 == 0) ? (bx % 8) * (G / 8) + bx / 8 : bx; }
struct ALoadPlain {
    const bf16_t* A; size_t lda;
    __device__ __forceinline__ const bf16_t* ptr(int r, int k) const { return A + (size_t)r * lda + k; }
};
struct ALoadGroup {
    const bf16_t* A;
    __device__ __forceinline__ const bf16_t* ptr(int r, int k) const { return A + ((size_t)(k >> 4) * T + r) * 16 + (k & 15); }
};

template <class AL>
__device__ __forceinline__ void gemm_tile(const AL al, const bf16_t* __restrict__ Bt, size_t ldb, int nk, f32x4 (&acc)[4][4], unsigned char* lds) {
    const int tid = threadIdx.x, lane = tid & 63, wid = tid >> 6, wr = wid >> 1, wc = wid & 1, fr = lane & 15, fq = lane >> 4;
    const int lr = tid >> 3, lc = tid & 7;
#pragma unroll
    for (int mi = 0; mi < 4; ++mi)
#pragma unroll
        for (int ni = 0; ni < 4; ++ni) acc[mi][ni] = (f32x4){0.f, 0.f, 0.f, 0.f};
    u32x4 ra[4], rb[4];
    const int soff = lr * 128 + ((lc ^ (lr & 7)) << 4);
#pragma unroll
    for (int i = 0; i < 4; ++i) { ra[i] = *(const u32x4*)al.ptr(lr + 32 * i, lc * 8); rb[i] = *(const u32x4*)(Bt + (size_t)(lr + 32 * i) * ldb + lc * 8); }
#pragma unroll
    for (int i = 0; i < 4; ++i) { *(u32x4*)(lds + soff + i * 4096) = ra[i]; *(u32x4*)(lds + 16384 + soff + i * 4096) = rb[i]; }
    __syncthreads();
    const int aoff = (wr * 64 + fr) * 128, boff = 16384 + (wc * 64 + fr) * 128, sw = fr & 7;
    for (int kt = 0; kt < nk; ++kt) {
        const bool more = (kt + 1 < nk);
        if (more) {
#pragma unroll
            for (int i = 0; i < 4; ++i) { ra[i] = *(const u32x4*)al.ptr(lr + 32 * i, (kt + 1) * 64 + lc * 8); rb[i] = *(const u32x4*)(Bt + (size_t)(lr + 32 * i) * ldb + (kt + 1) * 64 + lc * 8); }
        }
        const unsigned char* buf = lds + (kt & 1) * 32768;
#pragma unroll
        for (int ks = 0; ks < 2; ++ks) {
            bf16x8 af[4], bfr[4];
            const int co = ((ks * 4 + fq) ^ sw) << 4;
#pragma unroll
            for (int mi = 0; mi < 4; ++mi) af[mi] = *(const bf16x8*)(buf + aoff + mi * 2048 + co);
#pragma unroll
            for (int ni = 0; ni < 4; ++ni) bfr[ni] = *(const bf16x8*)(buf + boff + ni * 2048 + co);
#pragma unroll
            for (int mi = 0; mi < 4; ++mi)
#pragma unroll
                for (int ni = 0; ni < 4; ++ni) acc[mi][ni] = __builtin_amdgcn_mfma_f32_16x16x32_bf16(bfr[ni], af[mi], acc[mi][ni], 0, 0, 0);
        }
        if (more) {
            unsigned char* nb = lds + ((kt + 1) & 1) * 32768;
#pragma unroll
            for (int i = 0; i < 4; ++i) { *(u32x4*)(nb + soff + i * 4096) = ra[i]; *(u32x4*)(nb + 16384 + soff + i * 4096) = rb[i]; }
        }
        __syncthreads();
    }
}
__device__ __forceinline__ void phase_s5_win(const Params& p, unsigned char* lds) {
    const bf16_t* HM = (const bf16_t*)(p.ws + WS_HM); const bf16_t* WT = (const bf16_t*)(p.ws + WS_WIN_T);
    bf16_t* UG = (bf16_t*)(p.ws + WS_UG);
    const int lane = threadIdx.x & 63, wid = threadIdx.x >> 6, wr = wid >> 1, wc = wid & 1, fr = lane & 15, fq = lane >> 4;
    for (int id = vblock(); id < 256 * 8; id += gridDim.x) {
        const int mt = id >> 3, nt = id & 7;
        f32x4 acc[4][4];
        gemm_tile(ALoadPlain{HM + (size_t)mt * 128 * D, (size_t)D}, WT + (size_t)nt * 128 * D, D, 16, acc, lds);
#pragma unroll
        for (int mi = 0; mi < 4; ++mi)
#pragma unroll
            for (int ni = 0; ni < 4; ++ni) {
                const int t = mt * 128 + wr * 64 + mi * 16 + fr, g = nt * 8 + wc * 4 + ni;
                const f32x4 v = acc[mi][ni];
                *(u32x2*)(UG + ((size_t)g * T + t) * 16 + fq * 4) = (u32x2){pk2(v.x, v.y), pk2(v.z, v.w)};
            }
    }
}
__device__ __forceinline__ void phase_s5_a(const Params& p, unsigned char* lds) {
    const bf16_t* UG = (const bf16_t*)(p.ws + WS_UG); const bf16_t* TW = (const bf16_t*)(p.ws + WS_TW);
    bf16_t* YI = (bf16_t*)(p.ws + WS_YI); float* WST = (float*)(p.ws + WS_WST);
    const int lane = threadIdx.x & 63, wid = threadIdx.x >> 6, wr = wid >> 1, wc = wid & 1, fr = lane & 15, fq = lane >> 4;
    for (int id = vblock(); id < 64 * 40; id += gridDim.x) {
        const int g = id / 40, rem = id % 40, mt = rem / 5, nt = rem % 5;
        const int nk = (nt < 4) ? 2 * (nt + 1) : 8;
        f32x4 acc[4][4];
        gemm_tile(ALoadPlain{UG + (size_t)g * T * 16 + (size_t)mt * 128 * 512, (size_t)512}, TW + ((size_t)g * 640 + nt * 128) * 512, 512, nk, acc, lds);
#pragma unroll
        for (int mi = 0; mi < 4; ++mi)
#pragma unroll
            for (int ni = 0; ni < 4; ++ni) {
                const int R = mt * 128 + wr * 64 + mi * 16 + fr, c = wc * 64 + ni * 16 + fq * 4;
                const f32x4 v = acc[mi][ni];
                if (nt < 4) *(u32x2*)(YI + ((size_t)g * 1024 + R) * 512 + nt * 128 + c) = (u32x2){pk2(v.x, v.y), pk2(v.z, v.w)};
                else *(f32x4*)(WST + ((size_t)g * 1024 + R) * 128 + c) = v;
            }
    }
}
__device__ __forceinline__ void phase_s5_scan(const Params& p) {
    const int lane = threadIdx.x & 63, wave = threadIdx.x >> 6;
    const float* WST = (const float*)(p.ws + WS_WST); bf16_t* SST = (bf16_t*)(p.ws + WS_SST);
    const f32x2* AL = (const f32x2*)(p.ws + WS_MISC + 4096);
    for (int it = blockIdx.x * 4 + wave; it < 128; it += gridDim.x * 4) {
        const int b = it >> 6, g = it & 63;
        const f32x2 al = AL[g * 64 + lane];
        float sr = 0.f, si = 0.f;
        const float* wbase = WST + ((size_t)g * 1024 + b * 512) * 128 + lane;
        bf16_t* sbase = SST + ((size_t)g * 1024 + b * 512) * 128 + lane;
        for (int n0 = 0; n0 < 512; n0 += 16) {
            float wre[16], wim[16];
#pragma unroll
            for (int j = 0; j < 16; ++j) { wre[j] = wbase[(size_t)(n0 + j) * 128]; wim[j] = wbase[(size_t)(n0 + j) * 128 + 64]; }
#pragma unroll
            for (int j = 0; j < 16; ++j) {
                sbase[(size_t)(n0 + j) * 128] = (bf16_t)f2bf(sr); sbase[(size_t)(n0 + j) * 128 + 64] = (bf16_t)f2bf(si);
                const float nr = al.x * sr - al.y * si + wre[j], ni = al.x * si + al.y * sr + wim[j];
                sr = nr; si = ni;
            }
        }
    }
}
__device__ __forceinline__ void phase_s5_b(const Params& p, unsigned char* lds) {
    const bf16_t* SST = (const bf16_t*)(p.ws + WS_SST); const bf16_t* VG = (const bf16_t*)(p.ws + WS_VG);
    const bf16_t* YI = (const bf16_t*)(p.ws + WS_YI); const bf16_t* UG = (const bf16_t*)(p.ws + WS_UG);
    bf16_t* YG = (bf16_t*)(p.ws + WS_YG);
    const float* dsk = p.in[14];
    const int lane = threadIdx.x & 63, wid = threadIdx.x >> 6, wr = wid >> 1, wc = wid & 1, fr = lane & 15, fq = lane >> 4;
    for (int id = vblock(); id < 64 * 32; id += gridDim.x) {
        const int g = id >> 5, mt = (id >> 2) & 7, nt = id & 3;
        f32x4 acc[4][4];
        gemm_tile(ALoadPlain{SST + ((size_t)g * 1024 + mt * 128) * 128, (size_t)128}, VG + ((size_t)g * 512 + nt * 128) * 128, 128, 2, acc, lds);
        const f32x4 dv = *(const f32x4*)(dsk + g * 16 + fq * 4);
#pragma unroll
        for (int mi = 0; mi < 4; ++mi)
#pragma unroll
            for (int ni = 0; ni < 4; ++ni) {
                const int R = mt * 128 + wr * 64 + mi * 16 + fr, c = nt * 128 + wc * 64 + ni * 16 + fq * 4;
                const size_t idx = ((size_t)g * 1024 + R) * 512 + c;
                const u32x2 yi = *(const u32x2*)(YI + idx), uu = *(const u32x2*)(UG + idx);
                const f32x4 v = acc[mi][ni];
                const float y0 = gelu_tanh(v.x + bflo(yi.x) + dv.x * bflo(uu.x)), y1 = gelu_tanh(v.y + bfhi(yi.x) + dv.y * bfhi(uu.x));
                const float y2 = gelu_tanh(v.z + bflo(yi.y) + dv.z * bflo(uu.y)), y3 = gelu_tanh(v.w + bfhi(yi.y) + dv.w * bfhi(uu.y));
                *(u32x2*)(YG + idx) = (u32x2){pk2(y0, y1), pk2(y2, y3)};
            }
    }
}
__device__ __forceinline__ void phase_s5_glu(const Params& p, unsigned char* lds) {
    const bf16_t* YG = (const bf16_t*)(p.ws + WS_YG); const bf16_t* WT = (const bf16_t*)(p.ws + WS_WGLU_T);
    const float* MOD = (const float*)(p.ws + WS_MOD);
    const float* X = p.in[0]; float* XO = p.out;
    const int lane = threadIdx.x & 63, wid = threadIdx.x >> 6, wr = wid >> 1, wc = wid & 1, fr = lane & 15, fq = lane >> 4;
    for (int id = vblock(); id < 256 * 16; id += gridDim.x) {
        const int mt = id >> 4, nt = id & 15;
        f32x4 acc[4][4];
        gemm_tile(ALoadGroup{YG + (size_t)mt * 128 * 16}, WT + (size_t)nt * 128 * D, D, 16, acc, lds);
        const int b = (mt * 128) / SEQ;
#pragma unroll
        for (int mi = 0; mi < 4; ++mi)
#pragma unroll
            for (int h = 0; h < 2; ++h) {
                const int t = mt * 128 + wr * 64 + mi * 16 + fr, j = nt * 64 + wc * 32 + h * 16 + fq * 4;
                const f32x4 a = acc[mi][2 * h], gg = acc[mi][2 * h + 1];
                const f32x4 g1 = *(const f32x4*)(MOD + (size_t)(0 * 2 + b) * 6144 + 2048 + j);
                const f32x4 xi = *(const f32x4*)(X + (size_t)t * D + j);
                f32x4 o;
                o.x = xi.x + g1.x * (a.x * sigmoidf_(gg.x)); o.y = xi.y + g1.y * (a.y * sigmoidf_(gg.y));
                o.z = xi.z + g1.z * (a.z * sigmoidf_(gg.z)); o.w = xi.w + g1.w * (a.w * sigmoidf_(gg.w));
                *(f32x4*)(XO + (size_t)t * D + j) = o;
            }
    }
}
__device__ __forceinline__ void phase_peer_wq(const Params& p, int layer, unsigned char* lds) {
    const bf16_t* HM = (const bf16_t*)(p.ws + WS_HM); const bf16_t* WT = (const bf16_t*)(p.ws + WS_WQ_T) + (size_t)layer * 2048 * 1024;
    bf16_t* QK = (bf16_t*)(p.ws + WS_QK);
    const int lane = threadIdx.x & 63, wid = threadIdx.x >> 6, wr = wid >> 1, wc = wid & 1, fr = lane & 15, fq = lane >> 4;
    for (int id = vblock(); id < 256 * 16; id += gridDim.x) {
        const int mt = id >> 4, nt = id & 15;
        f32x4 acc[4][4];
        gemm_tile(ALoadPlain{HM + (size_t)mt * 128 * D, (size_t)D}, WT + (size_t)nt * 128 * D, D, 16, acc, lds);
#pragma unroll
        for (int mi = 0; mi < 4; ++mi)
#pragma unroll
            for (int ni = 0; ni < 4; ++ni) {
                const int t = mt * 128 + wr * 64 + mi * 16 + fr, c = nt * 128 + wc * 64 + ni * 16 + fq * 4;
                const f32x4 v = acc[mi][ni];
                *(u32x2*)(QK + (size_t)t * 2048 + c) = (u32x2){pk2(v.x, v.y), pk2(v.z, v.w)};
            }
    }
}
__device__ __forceinline__ void ce_(unsigned& a, unsigned& b, const bool up) { const unsigned lo = a < b ? a : b, hi = a < b ? b : a; a = up ? lo : hi; b = up ? hi : lo; }
__device__ __forceinline__ void bitonic_sort16(unsigned* x, const bool asc) {
#pragma unroll
    for (int k = 2; k <= 16; k <<= 1)
#pragma unroll
        for (int j = k >> 1; j > 0; j >>= 1)
#pragma unroll
            for (int i = 0; i < 16; ++i) { const int l = i ^ j; if (l > i) ce_(x[i], x[l], ((i & k) == 0) == asc); }
}
__device__ __forceinline__ void bitonic_merge16(unsigned* x, const bool asc) {
#pragma unroll
    for (int j = 8; j > 0; j >>= 1)
#pragma unroll
        for (int i = 0; i < 16; ++i) { const int l = i ^ j; if (l > i) ce_(x[i], x[l], asc); }
}
__device__ __forceinline__ void phase_peer_topk(const Params& p, int layer, unsigned char* lds) {
    const bf16_t* QK = (const bf16_t*)(p.ws + WS_QK); const bf16_t* SK = (const bf16_t*)(p.ws + WS_SUBK) + (size_t)layer * 8 * 2 * 128 * 128;
    float* TOPS = (float*)(p.ws + WS_TOPS); int* TOPI = (int*)(p.ws + WS_TOPI);
    float* sc = (float*)lds;
    const int tid = threadIdx.x, lane = tid & 63, wid = tid >> 6, wr = wid >> 1, wc = wid & 1, fr = lane & 15, fq = lane >> 4;
    for (int id = vblock(); id < 256 * 16; id += gridDim.x) {
        const int mt = id >> 4, hc = id & 15;
        f32x4 acc[4][4];
        gemm_tile(ALoadPlain{QK + (size_t)mt * 128 * 2048 + hc * 128, (size_t)2048}, SK + (size_t)hc * 128 * 128, 128, 2, acc, lds);
#pragma unroll
        for (int mi = 0; mi < 4; ++mi)
#pragma unroll
            for (int ni = 0; ni < 4; ++ni) {
                const int r = wr * 64 + mi * 16 + fr, c = wc * 64 + ni * 16 + fq * 4;
                float* d = sc + r * 129 + c;
                d[0] = acc[mi][ni].x; d[1] = acc[mi][ni].y; d[2] = acc[mi][ni].z; d[3] = acc[mi][ni].w;
            }
        __syncthreads();
        {
            const int row = tid >> 1, half = tid & 1;
            unsigned x[64];
            const float* rp = sc + row * 129 + half * 64;
#pragma unroll
            for (int j = 0; j < 64; ++j) {
                const unsigned bits = __builtin_bit_cast(unsigned, rp[j]);
                const unsigned u = bits ^ ((unsigned)((int)bits >> 31) | 0x80000000u);
                x[j] = (u & 0xFFFFFF80u) | (unsigned)(127 - (half * 64 + j));
            }
            bitonic_sort16(x, true); bitonic_sort16(x + 16, false); bitonic_sort16(x + 32, true); bitonic_sort16(x + 48, false);
#pragma unroll
            for (int i = 0; i < 16; ++i) { x[i] = x[i] > x[16 + i] ? x[i] : x[16 + i]; x[32 + i] = x[32 + i] > x[48 + i] ? x[32 + i] : x[48 + i]; }
            bitonic_merge16(x, true); bitonic_merge16(x + 32, false);
#pragma unroll
            for (int i = 0; i < 16; ++i) x[i] = x[i] > x[32 + i] ? x[i] : x[32 + i];
            bitonic_merge16(x, false);
            unsigned y[16];
#pragma unroll
            for (int i = 0; i < 16; ++i) { const unsigned o = (unsigned)__shfl_xor((int)x[15 - i], 1); y[i] = x[i] > o ? x[i] : o; }
            bitonic_merge16(y, false);
            const size_t ob = ((size_t)(mt * 128 + row) * 16 + hc) * 16;
            if (half == 0) {
                float v[16];
#pragma unroll
                for (int i = 0; i < 16; ++i) { const unsigned u = y[i] & 0xFFFFFF80u; const unsigned bits = (u & 0x80000000u) ? (u ^ 0x80000000u) : ~u; v[i] = __builtin_bit_cast(float, bits); }
#pragma unroll
                for (int q = 0; q < 4; ++q) *(f32x4*)(TOPS + ob + q * 4) = (f32x4){v[q * 4], v[q * 4 + 1], v[q * 4 + 2], v[q * 4 + 3]};
            } else {
#pragma unroll
                for (int q = 0; q < 4; ++q) *(u32x4*)(TOPI + ob + q * 4) = (u32x4){127u - (y[q * 4] & 127u), 127u - (y[q * 4 + 1] & 127u), 127u - (y[q * 4 + 2] & 127u), 127u - (y[q * 4 + 3] & 127u)};
            }
        }
        __syncthreads();
    }
}
__device__ __forceinline__ void phase_peer_combine(const Params& p, unsigned char* lds) {
    const float* TOPS = (const float*)(p.ws + WS_TOPS); const int* TOPI = (const int*)(p.ws + WS_TOPI);
    int* EXP = (int*)(p.ws + WS_EXP); float* GATE = (float*)(p.ws + WS_GATE);
    unsigned* L = (unsigned*)lds;
    const int tid = threadIdx.x;
    for (int it = blockIdx.x; it < (T * 8) / 256; it += gridDim.x) {
        const size_t th = (size_t)it * 256 + tid;
        const u32x4* S4 = (const u32x4*)(TOPS + th * 32); const u32x4* I4 = (const u32x4*)(TOPI + th * 32);
#pragma unroll
        for (int a4 = 0; a4 < 8; ++a4) {
            const u32x4 s = S4[a4], i = I4[a4];
            L[(a4 * 4 + 0) * 256 + tid] = s.x; L[(a4 * 4 + 1) * 256 + tid] = s.y; L[(a4 * 4 + 2) * 256 + tid] = s.z; L[(a4 * 4 + 3) * 256 + tid] = s.w;
            L[(32 + a4 * 4 + 0) * 256 + tid] = i.x; L[(32 + a4 * 4 + 1) * 256 + tid] = i.y; L[(32 + a4 * 4 + 2) * 256 + tid] = i.z; L[(32 + a4 * 4 + 3) * 256 + tid] = i.w;
        }
        float val[16];
        const float s20 = __builtin_bit_cast(float, L[16 * 256 + tid]);
#pragma unroll
        for (int a = 0; a < 16; ++a) val[a] = __builtin_bit_cast(float, L[a * 256 + tid]) + s20;
        unsigned long long P = 0ull;
        float ts[16]; int te[16];
#pragma unroll
        for (int r = 0; r < 16; ++r) {
            float best = val[0]; int ba = 0;
#pragma unroll
            for (int a = 1; a < 16; ++a) if (val[a] > best) { best = val[a]; ba = a; }
            const int b = (int)((P >> (4 * ba)) & 15ull);
            const int i1 = (int)L[(32 + ba) * 256 + tid], i2 = (int)L[(48 + b) * 256 + tid];
            ts[r] = best; te[r] = i1 * 128 + i2;
            const int nb = b + 1;
            float newv = -3.0e38f;
            if (nb < 16) { newv = __builtin_bit_cast(float, L[ba * 256 + tid]) + __builtin_bit_cast(float, L[(16 + nb) * 256 + tid]); P += 1ull << (4 * ba); }
#pragma unroll
            for (int a = 0; a < 16; ++a) val[a] = (a == ba) ? newv : val[a];
        }
        const float m0 = ts[0];
        float sum = 0.f;
#pragma unroll
        for (int r = 0; r < 16; ++r) { ts[r] = __expf(ts[r] - m0); sum += ts[r]; }
        const float inv = 1.0f / sum;
#pragma unroll
        for (int r = 0; r < 16; ++r) ts[r] *= inv;
#pragma unroll
        for (int r = 0; r < 16; ++r) { EXP[th * 16 + r] = te[r]; GATE[th * 16 + r] = ts[r]; }
    }
}

__device__ __forceinline__ void fma8(const unsigned w0, const unsigned w1, const float a, float* acc) {
    const f32x2 p0 = __builtin_amdgcn_cvt_pk_f32_fp8((int)w0, false), p1 = __builtin_amdgcn_cvt_pk_f32_fp8((int)w0, true);
    const f32x2 p2 = __builtin_amdgcn_cvt_pk_f32_fp8((int)w1, false), p3 = __builtin_amdgcn_cvt_pk_f32_fp8((int)w1, true);
    acc[0] += a * p0.x; acc[1] += a * p0.y; acc[2] += a * p1.x; acc[3] += a * p1.y;
    acc[4] += a * p2.x; acc[5] += a * p2.y; acc[6] += a * p3.x; acc[7] += a * p3.y;
}
__device__ __forceinline__ float dot8(const unsigned w0, const unsigned w1, const float* h, float s) {
    const f32x2 p0 = __builtin_amdgcn_cvt_pk_f32_fp8((int)w0, false), p1 = __builtin_amdgcn_cvt_pk_f32_fp8((int)w0, true);
    const f32x2 p2 = __builtin_amdgcn_cvt_pk_f32_fp8((int)w1, false), p3 = __builtin_amdgcn_cvt_pk_f32_fp8((int)w1, true);
    s += p0.x * h[0]; s += p0.y * h[1]; s += p1.x * h[2]; s += p1.y * h[3];
    s += p2.x * h[4]; s += p2.y * h[5]; s += p3.x * h[6]; s += p3.y * h[7];
    return s;
}
__device__ __forceinline__ void phase_peer_apply(const Params& p, int layer, unsigned char* lds, bool dry) {
    const int lane = threadIdx.x & 63, wave = threadIdx.x >> 6;
    float* ldsw = (float*)lds + wave * (64 * 65);
    const bf16_t* HM = (const bf16_t*)(p.ws + WS_HM);
    const unsigned char* PU = p.ws + WS_PU; const unsigned char* PV = p.ws + WS_PV;
    const float* SU = (const float*)(p.ws + WS_PU + 24 * MiB); const float* SV = (const float*)(p.ws + WS_PV + 24 * MiB);
    const int* EXP = (const int*)(p.ws + WS_EXP); const float* GATE = (const float*)(p.ws + WS_GATE);
    const float* MOD = (const float*)(p.ws + WS_MOD);
    float* X = p.out;
    for (int t = blockIdx.x * 4 + wave; t < T; t += gridDim.x * 4) {
        const u32x4 ha = *(const u32x4*)(HM + (size_t)t * D + lane * 16), hb = *(const u32x4*)(HM + (size_t)t * D + lane * 16 + 8);
        float hf[16];
        hf[0] = bflo(ha.x); hf[1] = bfhi(ha.x); hf[2] = bflo(ha.y); hf[3] = bfhi(ha.y); hf[4] = bflo(ha.z); hf[5] = bfhi(ha.z); hf[6] = bflo(ha.w); hf[7] = bfhi(ha.w);
        hf[8] = bflo(hb.x); hf[9] = bfhi(hb.x); hf[10] = bflo(hb.y); hf[11] = bfhi(hb.y); hf[12] = bflo(hb.z); hf[13] = bfhi(hb.z); hf[14] = bflo(hb.w); hf[15] = bfhi(hb.w);
        const int e0 = EXP[(size_t)t * 128 + lane], e1 = EXP[(size_t)t * 128 + 64 + lane];
        const float g0 = GATE[(size_t)t * 128 + lane], g1 = GATE[(size_t)t * 128 + 64 + lane];
        const float su0 = SU[e0], su1 = SU[e1], sv0 = SV[e0], sv1 = SV[e1];
        float act0 = 0.f, act1 = 0.f;
#pragma unroll
        for (int half = 0; half < 2; ++half) {
            const int ev = half ? e1 : e0;
#pragma unroll 1
            for (int jg = 0; jg < 4; ++jg) {
                u32x4 ua[16];
#pragma unroll
                for (int j = 0; j < 16; ++j) {
                    const int e = __builtin_amdgcn_readlane(ev, jg * 16 + j);
                    ua[j] = *(const u32x4*)(PU + (size_t)e * D + lane * 16);
                }
#pragma unroll
                for (int j = 0; j < 16; ++j) {
                    float s = dot8(ua[j].x, ua[j].y, hf, 0.f);
                    s = dot8(ua[j].z, ua[j].w, hf + 8, s);
                    ldsw[(jg * 16 + j) * 65 + lane] = s;
                }
            }
            float tot = 0.f;
#pragma unroll 16
            for (int k = 0; k < 64; ++k) tot += ldsw[lane * 65 + k];
            const float a = gelu_tanh(tot * (half ? su1 : su0)) * (half ? g1 : g0) * (half ? sv1 : sv0);
            if (half) act1 = a; else act0 = a;
        }
        float acc[16];
#pragma unroll
        for (int i = 0; i < 16; ++i) acc[i] = 0.f;
#pragma unroll
        for (int half = 0; half < 2; ++half) {
            const int ev = half ? e1 : e0; const float av = half ? act1 : act0;
#pragma unroll 1
            for (int jg = 0; jg < 4; ++jg) {
                u32x4 va[16];
#pragma unroll
                for (int j = 0; j < 16; ++j) {
                    const int e = __builtin_amdgcn_readlane(ev, jg * 16 + j);
                    va[j] = *(const u32x4*)(PV + (size_t)e * D + lane * 16);
                }
#pragma unroll
                for (int j = 0; j < 16; ++j) {
                    const float a = __builtin_bit_cast(float, __builtin_amdgcn_readlane(__builtin_bit_cast(int, av), jg * 16 + j));
                    fma8(va[j].x, va[j].y, a, acc);
                    fma8(va[j].z, va[j].w, a, acc + 8);
                }
            }
        }
        const int b = t / SEQ;
        const float* g2 = MOD + (size_t)(layer * 2 + b) * 6144 + 5120;
        float* xr = X + (size_t)t * D + lane * 16;
#pragma unroll
        for (int q = 0; q < 4; ++q) {
            const f32x4 g = *(const f32x4*)(g2 + lane * 16 + q * 4); f32x4 x = *(const f32x4*)(xr + q * 4);
            x.x += g.x * acc[q * 4 + 0]; x.y += g.y * acc[q * 4 + 1]; x.z += g.z * acc[q * 4 + 2]; x.w += g.w * acc[q * 4 + 3];
            if (!dry) *(f32x4*)(xr + q * 4) = x;
        }
    }
}
__device__ __forceinline__ void phase_tab1(const Params& p) {
    for (int it = blockIdx.x; it < 2 * P0_TAB; it += gridDim.x) {
        if (it < P0_TAB) cvt_fp8_item(p.in[26] + (size_t)PE * D, p.ws + WS_PU, (float*)(p.ws + WS_PU + 24 * MiB), it);
        else cvt_fp8_item(p.in[27] + (size_t)PE * D, p.ws + WS_PV, (float*)(p.ws + WS_PV + 24 * MiB), it - P0_TAB);
    }
}
__device__ __forceinline__ void phase_nsa_proj(const Params& p, unsigned char* lds) {
    const bf16_t* HM = (const bf16_t*)(p.ws + WS_HM); const bf16_t* WT = (const bf16_t*)(p.ws + WS_WPROJ_T);
    const f32x2* ROPE = (const f32x2*)(p.ws + WS_ROPE);
    bf16_t* Q = (bf16_t*)(p.ws + WS_Q); float* NGT = (float*)(p.ws + WS_NG);
    const int lane = threadIdx.x & 63, wid = threadIdx.x >> 6, wr = wid >> 1, wc = wid & 1, fr = lane & 15, fq = lane >> 4;
    for (int id = vblock(); id < 256 * 21; id += gridDim.x) {
        const int mt = id / 21, nt = id % 21;
        f32x4 acc[4][4];
        gemm_tile(ALoadPlain{HM + (size_t)mt * 128 * D, (size_t)D}, WT + (size_t)nt * 128 * D, D, 16, acc, lds);
        const int c0 = nt * 128 + wc * 64;
        if (c0 >= 2624) continue;
        const int b = (mt * 128) / SEQ;
        if (c0 == 2560) {
#pragma unroll
            for (int mi = 0; mi < 4; ++mi)
#pragma unroll
                for (int ni = 0; ni < 3; ++ni) {
                    const int t = mt * 128 + wr * 64 + mi * 16 + fr;
                    const f32x4 v = acc[mi][ni];
                    *(f32x4*)(NGT + (size_t)t * 48 + ni * 16 + fq * 4) = (f32x4){sigmoidf_(v.x), sigmoidf_(v.y), sigmoidf_(v.z), sigmoidf_(v.w)};
                }
            continue;
        }
        int sec = -1, g = 0;
        if (c0 >= 1024) { sec = (c0 - 1024) >> 8; g = ((c0 - 1024) & 255) >> 6; }
        const bool dorope = (sec == -1) || (sec == 2) || (sec == 4);
        const float scl = (sec == -1) ? 0.125f : 1.0f;
        const size_t secoff[6] = {WS_KC, WS_VC, WS_KS, WS_VST, WS_KW, WS_VWT};
        size_t so = WS_Q;
#pragma unroll
        for (int q = 0; q < 6; ++q) if (sec == q) so = secoff[q];
        bf16_t* OUT = (bf16_t*)(p.ws + so);
        const bool vt = (sec == 3) || (sec == 5);
#pragma unroll
        for (int mi = 0; mi < 4; ++mi) {
            const int t = mt * 128 + wr * 64 + mi * 16 + fr, s = t - b * SEQ;
            if (dorope) {
#pragma unroll
                for (int ni = 0; ni < 2; ++ni) {
                    const f32x4* rp = (const f32x4*)(ROPE + (size_t)s * 32 + ni * 16 + fq * 4);
                    const f32x4 r0 = rp[0], r1 = rp[1];
                    const f32x4 x1 = acc[mi][ni], x2 = acc[mi][ni + 2];
                    acc[mi][ni] = (f32x4){x1.x * r0.x - x2.x * r0.y, x1.y * r0.z - x2.y * r0.w, x1.z * r1.x - x2.z * r1.y, x1.w * r1.z - x2.w * r1.w};
                    acc[mi][ni + 2] = (f32x4){x1.x * r0.y + x2.x * r0.x, x1.y * r0.w + x2.y * r0.z, x1.z * r1.y + x2.z * r1.x, x1.w * r1.w + x2.w * r1.z};
                }
            }
#pragma unroll
            for (int ni = 0; ni < 4; ++ni) {
                const f32x4 v = acc[mi][ni] * scl;
                const int d = ni * 16 + fq * 4;
                if (sec == -1) {
                    *(u32x2*)(OUT + (size_t)t * 1024 + c0 + d) = (u32x2){pk2(v.x, v.y), pk2(v.z, v.w)};
                } else if (!vt) {
                    *(u32x2*)(OUT + ((size_t)(b * 4 + g) * SEQ + s) * 64 + d) = (u32x2){pk2(v.x, v.y), pk2(v.z, v.w)};
                } else {
                    bf16_t* o = OUT + ((size_t)(b * 4 + g) * 64 + d) * SEQ + s;
                    o[0] = (bf16_t)f2bf(v.x); o[SEQ] = (bf16_t)f2bf(v.y); o[2 * SEQ] = (bf16_t)f2bf(v.z); o[3 * SEQ] = (bf16_t)f2bf(v.w);
                }
            }
        }
    }
}
__device__ __forceinline__ void phase_nsa_cmp1(const Params& p, unsigned char* lds) {
    bf16_t* HID = (bf16_t*)(p.ws + WS_HID);
    const float* bias = (const float*)(p.ws + WS_MISC);
    const int lane = threadIdx.x & 63, wid = threadIdx.x >> 6, wr = wid >> 1, wc = wid & 1, fr = lane & 15, fq = lane >> 4;
    for (int id = vblock(); id < 256; id += gridDim.x) {
        const int kv = id >> 7, bg = (id >> 4) & 7, mt = (id >> 1) & 7, nt = id & 1;
        const bf16_t* A = (const bf16_t*)(p.ws + (kv ? WS_VC : WS_KC)) + (size_t)bg * SEQ * 64 + (size_t)mt * 128 * 1024;
        const bf16_t* B = (const bf16_t*)(p.ws + (kv ? WS_WV1_T : WS_WK1_T)) + (size_t)nt * 128 * 2048;
        f32x4 acc[4][4];
        gemm_tile(ALoadPlain{A, (size_t)1024}, B, 2048, 32, acc, lds);
#pragma unroll
        for (int mi = 0; mi < 4; ++mi)
#pragma unroll
            for (int ni = 0; ni < 4; ++ni) {
                const int n = mt * 128 + wr * 64 + mi * 16 + fr, c = nt * 128 + wc * 64 + ni * 16 + fq * 4;
                const f32x4 bv = *(const f32x4*)(bias + kv * 256 + c);
                const f32x4 v = acc[mi][ni] + bv;
                *(u32x2*)(HID + (((size_t)kv * 8 + bg) * 1024 + n) * 256 + c) = (u32x2){pk2(gelu_tanh(v.x), gelu_tanh(v.y)), pk2(gelu_tanh(v.z), gelu_tanh(v.w))};
            }
    }
}
__device__ __forceinline__ void phase_nsa_cmp2(const Params& p, unsigned char* lds) {
    const bf16_t* HID = (const bf16_t*)(p.ws + WS_HID);
    const f32x2* ROPE = (const f32x2*)(p.ws + WS_ROPE);
    bf16_t* KCMP = (bf16_t*)(p.ws + WS_KCMP); bf16_t* VCMPT = (bf16_t*)(p.ws + WS_VCMPT);
    const int lane = threadIdx.x & 63, wid = threadIdx.x >> 6, wr = wid >> 1, wc = wid & 1, fr = lane & 15, fq = lane >> 4;
    for (int id = vblock(); id < 128; id += gridDim.x) {
        const int kv = id >> 6, mt = id & 63;
        const bf16_t* A = HID + ((size_t)kv * 8192 + (size_t)mt * 128) * 256;
        const bf16_t* B = (const bf16_t*)(p.ws + (kv ? WS_WV2_T : WS_WK2_T));
        f32x4 acc[4][4];
        gemm_tile(ALoadPlain{A, (size_t)256}, B, 256, 4, acc, lds);
        if (wc == 1) continue;
#pragma unroll
        for (int mi = 0; mi < 4; ++mi) {
            const int R = mt * 128 + wr * 64 + mi * 16 + fr, bg = R >> 10, n = R & 1023;
            if (kv == 0) {
                int pos = n * 16 + 31; pos = pos > SEQ - 1 ? SEQ - 1 : pos;
#pragma unroll
                for (int ni = 0; ni < 2; ++ni) {
                    const f32x4* rp = (const f32x4*)(ROPE + (size_t)pos * 32 + ni * 16 + fq * 4);
                    const f32x4 r0 = rp[0], r1 = rp[1];
                    const f32x4 x1 = acc[mi][ni], x2 = acc[mi][ni + 2];
                    acc[mi][ni] = (f32x4){x1.x * r0.x - x2.x * r0.y, x1.y * r0.z - x2.y * r0.w, x1.z * r1.x - x2.z * r1.y, x1.w * r1.z - x2.w * r1.w};
                    acc[mi][ni + 2] = (f32x4){x1.x * r0.y + x2.x * r0.x, x1.y * r0.w + x2.y * r0.z, x1.z * r1.y + x2.z * r1.x, x1.w * r1.w + x2.w * r1.z};
                }
#pragma unroll
                for (int ni = 0; ni < 4; ++ni) {
                    const f32x4 v = acc[mi][ni];
                    *(u32x2*)(KCMP + ((size_t)bg * 1024 + n) * 64 + ni * 16 + fq * 4) = (u32x2){pk2(v.x, v.y), pk2(v.z, v.w)};
                }
            } else {
#pragma unroll
                for (int ni = 0; ni < 4; ++ni) {
                    const f32x4 v = acc[mi][ni];
                    bf16_t* o = VCMPT + ((size_t)bg * 64 + ni * 16 + fq * 4) * 1024 + n;
                    o[0] = (bf16_t)f2bf(v.x); o[1024] = (bf16_t)f2bf(v.y); o[2048] = (bf16_t)f2bf(v.z); o[3072] = (bf16_t)f2bf(v.w);
                }
            }
        }
    }
}
__device__ __forceinline__ void phase_nsa_wo(const Params& p, unsigned char* lds, bool dry) {
    const bf16_t* O = (const bf16_t*)(p.ws + WS_O); const bf16_t* WT = (const bf16_t*)(p.ws + WS_WO_T);
    const float* MOD = (const float*)(p.ws + WS_MOD);
    float* X = p.out;
    const int lane = threadIdx.x & 63, wid = threadIdx.x >> 6, wr = wid >> 1, wc = wid & 1, fr = lane & 15, fq = lane >> 4;
    for (int id = vblock(); id < 256 * 8; id += gridDim.x) {
        const int mt = id >> 3, nt = id & 7;
        f32x4 acc[4][4];
        gemm_tile(ALoadPlain{O + (size_t)mt * 128 * D, (size_t)D}, WT + (size_t)nt * 128 * D, D, 16, acc, lds);
        const int b = (mt * 128) / SEQ;
#pragma unroll
        for (int mi = 0; mi < 4; ++mi)
#pragma unroll
            for (int ni = 0; ni < 4; ++ni) {
                const int t = mt * 128 + wr * 64 + mi * 16 + fr, c = nt * 128 + wc * 64 + ni * 16 + fq * 4;
                const f32x4 g1 = *(const f32x4*)(MOD + (size_t)(1 * 2 + b) * 6144 + 2048 + c);
                float* xp = X + (size_t)t * D + c;
                const f32x4 x = *(const f32x4*)xp; const f32x4 v = acc[mi][ni];
                if (!dry) *(f32x4*)xp = (f32x4){x.x + g1.x * v.x, x.y + g1.y * v.y, x.z + g1.z * v.z, x.w + g1.w * v.w};
            }
    }
}
__device__ __forceinline__ bf16x8 pack8(const f32x4 a, const f32x4 b) {
    u32x4 w; w.x = pk2(a.x, a.y); w.y = pk2(a.z, a.w); w.z = pk2(b.x, b.y); w.w = pk2(b.z, b.w);
    return __builtin_bit_cast(bf16x8, w);
}
__device__ __forceinline__ bf16x8 ldv8(const bf16_t* plo, const bf16_t* phi) {
    const u32x2 lo = *(const u32x2*)plo, hi = *(const u32x2*)phi;
    u32x4 w; w.x = lo.x; w.y = lo.y; w.z = hi.x; w.w = hi.y;
    return __builtin_bit_cast(bf16x8, w);
}
__device__ __forceinline__ float red4(float v) { v += __shfl_xor(v, 16); v += __shfl_xor(v, 32); return v; }
__device__ __forceinline__ float max4(float v) { v = fmaxf(v, __shfl_xor(v, 16)); v = fmaxf(v, __shfl_xor(v, 32)); return v; }
#define NEGBIG (-1.0e30f)

__device__ __forceinline__ void phase_nsa_attn(const Params& p, unsigned char* lds, const int rep_cmp, const int rep_win, const int rep_sel) {
    const int lane = threadIdx.x & 63, wave = threadIdx.x >> 6, fr = lane & 15, fq = lane >> 4;
    unsigned char* WL = lds + wave * 18432;
    float* IMP = (float*)WL;
    int* SEL = (int*)(WL + 17408);
    const bf16_t* Q = (const bf16_t*)(p.ws + WS_Q);
    const bf16_t* KCMP = (const bf16_t*)(p.ws + WS_KCMP); const bf16_t* VCMPT = (const bf16_t*)(p.ws + WS_VCMPT);
    const bf16_t* KS = (const bf16_t*)(p.ws + WS_KS); const bf16_t* VST = (const bf16_t*)(p.ws + WS_VST);
    const bf16_t* KW = (const bf16_t*)(p.ws + WS_KW); const bf16_t* VWT = (const bf16_t*)(p.ws + WS_VWT);
    const float* NGT = (const float*)(p.ws + WS_NG);
    bf16_t* O = (bf16_t*)(p.ws + WS_O);
    const f32x4 z4 = (f32x4){0.f, 0.f, 0.f, 0.f};
    for (int bi = blockIdx.x; bi < 2048; bi += gridDim.x) {
        const int bg = bi & 7, quad = 255 - (bi >> 3), t0 = (quad * 4 + wave) * 16, b = bg >> 2, g = bg & 3;
        const int cur = t0 >> 6;
        const size_t tok = (size_t)b * SEQ + t0 + fr;
        const int tq = t0 + fr;
        bf16x8 qf[4][2];
#pragma unroll
        for (int r = 0; r < 4; ++r)
#pragma unroll
            for (int ks = 0; ks < 2; ++ks) qf[r][ks] = *(const bf16x8*)(Q + tok * 1024 + (g * 4 + r) * 64 + ks * 32 + fq * 8);
        float gc[4], gw[4];
#pragma unroll
        for (int r = 0; r < 4; ++r) { const float* gp = NGT + tok * 48 + (g * 4 + r) * 3; gc[r] = gp[0]; gw[r] = gp[2]; }
        f32x4 acc[4][4];
        for (int rep = 0; rep < rep_win; ++rep) {
            const bf16_t* kwb = KW + (size_t)bg * SEQ * 64; const bf16_t* vwb = VWT + (size_t)bg * 64 * SEQ;
            float mw[4], lw[4];
#pragma unroll
            for (int r = 0; r < 4; ++r) { mw[r] = NEGBIG; lw[r] = 0.f;
#pragma unroll
                for (int df = 0; df < 4; ++df) acc[r][df] = z4; }
            int kmin = t0 - 511; kmin = kmin < 0 ? 0 : kmin; kmin &= ~31;
            for (int kb = kmin; kb <= t0 + 15; kb += 32) {
                bf16x8 kf[2][2];
#pragma unroll
                for (int f = 0; f < 2; ++f)
#pragma unroll
                    for (int ks = 0; ks < 2; ++ks) kf[f][ks] = *(const bf16x8*)(kwb + (size_t)(kb + f * 16 + fr) * 64 + ks * 32 + fq * 8);
                bf16x8 vf[4];
#pragma unroll
                for (int df = 0; df < 4; ++df) { const bf16_t* vp = vwb + (size_t)(df * 16 + fr) * SEQ + kb + 4 * fq; vf[df] = ldv8(vp, vp + 16); }
#pragma unroll
                for (int r = 0; r < 4; ++r) {
                    f32x4 st[2];
#pragma unroll
                    for (int f = 0; f < 2; ++f) {
                        st[f] = __builtin_amdgcn_mfma_f32_16x16x32_bf16(kf[f][0], qf[r][0], z4, 0, 0, 0);
                        st[f] = __builtin_amdgcn_mfma_f32_16x16x32_bf16(kf[f][1], qf[r][1], st[f], 0, 0, 0);
                    }
                    float mx = NEGBIG;
#pragma unroll
                    for (int f = 0; f < 2; ++f)
#pragma unroll
                        for (int e = 0; e < 4; ++e) { const int key = kb + f * 16 + fq * 4 + e; const bool ok = (key <= tq) && (key > tq - 512); if (ok) mx = fmaxf(mx, st[f][e]); }
                    mx = max4(mx);
                    const float mn = fmaxf(mw[r], mx);
                    const float al = __expf(mw[r] - mn);
                    float ps = 0.f;
#pragma unroll
                    for (int f = 0; f < 2; ++f)
#pragma unroll
                        for (int e = 0; e < 4; ++e) { const int key = kb + f * 16 + fq * 4 + e; const bool ok = (key <= tq) && (key > tq - 512); const float pv = ok ? __expf(st[f][e] - mn) : 0.f; st[f][e] = pv; ps += pv; }
                    lw[r] = lw[r] * al + ps; mw[r] = mn;
                    const bf16x8 pf = pack8(st[0], st[1]);
#pragma unroll
                    for (int df = 0; df < 4; ++df) { acc[r][df] = acc[r][df] * al; acc[r][df] = __builtin_amdgcn_mfma_f32_16x16x32_bf16(vf[df], pf, acc[r][df], 0, 0, 0); }
                    __builtin_amdgcn_sched_barrier(0);
                }
            }
#pragma unroll
            for (int r = 0; r < 4; ++r) {
                const float l = red4(lw[r]); const float sc = gw[r] / l;
#pragma unroll
                for (int df = 0; df < 4; ++df) acc[r][df] = acc[r][df] * sc;
            }
        }
        const int nmax_tile = (t0 >> 4) - 1, nmax_lane = (t0 >> 4) - 2 + (fr == 15 ? 1 : 0);
        const bf16_t* kcb = KCMP + (size_t)bg * 1024 * 64; const bf16_t* vcb = VCMPT + (size_t)bg * 64 * 1024;
        for (int rep = 0; rep < rep_cmp; ++rep) {
            const bool dry = (rep + 1 < rep_cmp);
            float mc[4], lc[4], invl[4];
#pragma unroll
            for (int r = 0; r < 4; ++r) { mc[r] = NEGBIG; lc[r] = 0.f; }
            for (int nb = 0; nb <= nmax_tile; nb += 32) {
                bf16x8 kf[2][2];
#pragma unroll
                for (int f = 0; f < 2; ++f)
#pragma unroll
                    for (int ks = 0; ks < 2; ++ks) kf[f][ks] = *(const bf16x8*)(kcb + (size_t)(nb + f * 16 + fr) * 64 + ks * 32 + fq * 8);
#pragma unroll
                for (int r = 0; r < 4; ++r) {
                    f32x4 st[2];
#pragma unroll
                    for (int f = 0; f < 2; ++f) {
                        st[f] = __builtin_amdgcn_mfma_f32_16x16x32_bf16(kf[f][0], qf[r][0], z4, 0, 0, 0);
                        st[f] = __builtin_amdgcn_mfma_f32_16x16x32_bf16(kf[f][1], qf[r][1], st[f], 0, 0, 0);
                    }
                    float mx = NEGBIG;
#pragma unroll
                    for (int f = 0; f < 2; ++f)
#pragma unroll
                        for (int e = 0; e < 4; ++e) { const int n = nb + f * 16 + fq * 4 + e; if (n <= nmax_lane) mx = fmaxf(mx, st[f][e]); }
                    mx = max4(mx);
                    const float mn = fmaxf(mc[r], mx);
                    float ps = 0.f;
#pragma unroll
                    for (int f = 0; f < 2; ++f)
#pragma unroll
                        for (int e = 0; e < 4; ++e) { const int n = nb + f * 16 + fq * 4 + e; if (n <= nmax_lane) ps += __expf(st[f][e] - mn); }
                    lc[r] = lc[r] * __expf(mc[r] - mn) + ps; mc[r] = mn;
                    __builtin_amdgcn_sched_barrier(0);
                }
            }
#pragma unroll
            for (int r = 0; r < 4; ++r) { const float l = red4(lc[r]); invl[r] = l > 0.f ? 1.0f / l : 0.f; }
            for (int i = lane; i < 16 * 260; i += 64) IMP[i] = 0.f;
            float carry = 0.f;
            for (int nb = 0; nb <= nmax_tile; nb += 32) {
                bf16x8 kf[2][2];
#pragma unroll
                for (int f = 0; f < 2; ++f)
#pragma unroll
                    for (int ks = 0; ks < 2; ++ks) kf[f][ks] = *(const bf16x8*)(kcb + (size_t)(nb + f * 16 + fr) * 64 + ks * 32 + fq * 8);
                bf16x8 vf[4];
#pragma unroll
                for (int df = 0; df < 4; ++df) { const bf16_t* vp = vcb + (size_t)(df * 16 + fr) * 1024 + nb + 4 * fq; vf[df] = ldv8(vp, vp + 16); }
                f32x4 pg[2] = {z4, z4};
#pragma unroll
                for (int r = 0; r < 4; ++r) {
                    f32x4 st[2];
#pragma unroll
                    for (int f = 0; f < 2; ++f) {
                        st[f] = __builtin_amdgcn_mfma_f32_16x16x32_bf16(kf[f][0], qf[r][0], z4, 0, 0, 0);
                        st[f] = __builtin_amdgcn_mfma_f32_16x16x32_bf16(kf[f][1], qf[r][1], st[f], 0, 0, 0);
#pragma unroll
                        for (int e = 0; e < 4; ++e) { const int n = nb + f * 16 + fq * 4 + e; st[f][e] = (n <= nmax_lane) ? __expf(st[f][e] - mc[r]) * invl[r] : 0.f; }
                        pg[f] += st[f];
                    }
                    const float gg = dry ? 0.f : gc[r];
                    const bf16x8 pf = pack8(st[0] * gg, st[1] * gg);
#pragma unroll
                    for (int df = 0; df < 4; ++df) acc[r][df] = __builtin_amdgcn_mfma_f32_16x16x32_bf16(vf[df], pf, acc[r][df], 0, 0, 0);
                    __builtin_amdgcn_sched_barrier(0);
                }
                const int src = (lane - 16) & 63;
                const float s0 = __shfl(pg[0].w, src), s1 = __shfl(pg[1].w, src), sc = __shfl(carry, src);
                const float prev0 = fq > 0 ? s0 : sc, prev1 = fq > 0 ? s1 : s0;
                const float imp0 = (pg[0].x + pg[0].y) + (pg[0].z + pg[0].w) + prev0;
                const float imp1 = (pg[1].x + pg[1].y) + (pg[1].z + pg[1].w) + prev1;
                const int jb = (nb >> 2) + fq;
                IMP[fr * 260 + jb] = imp0; IMP[fr * 260 + jb + 4] = imp1;
                carry = pg[1].w;
            }
        }
        {
            const int nf = cur >= 2 ? 3 : cur + 1;
            if (fq == 0) {
                SEL[fr * 16 + 0] = 0;
                if (cur == 1) SEL[fr * 16 + 1] = 1;
                if (cur >= 2) { SEL[fr * 16 + 1] = cur - 1; SEL[fr * 16 + 2] = cur; }
            }
            const int ncand = cur >= 3 ? cur - 2 : 0, extra = 16 - nf;
            if (ncand <= extra) {
                if (fq == 0) { for (int k = 0; k < extra; ++k) SEL[fr * 16 + nf + k] = (k < ncand) ? 1 + k : -1; }
            } else {
                for (int rnd = 0; rnd < extra; ++rnd) {
                    float bv = -1.0f; int bj = 1 << 20;
                    for (int jb = 1 + fq; jb <= cur - 2; jb += 4) { const float v = IMP[fr * 260 + jb]; if (v > bv) { bv = v; bj = jb; } }
#pragma unroll
                    for (int o = 16; o <= 32; o <<= 1) {
                        const float ov = __shfl_xor(bv, o); const int oj = __shfl_xor(bj, o);
                        if (ov > bv || (ov == bv && oj < bj)) { bv = ov; bj = oj; }
                    }
                    if (fq == 0) SEL[fr * 16 + nf + rnd] = bj;
                    if (((bj - 1) & 3) == fq) IMP[fr * 260 + bj] = -2.0f;
                }
            }
        }
        u32x2 accp[4][4];
#pragma unroll
        for (int r = 0; r < 4; ++r)
#pragma unroll
            for (int df = 0; df < 4; ++df) accp[r][df] = (u32x2){pk2(acc[r][df].x, acc[r][df].y), pk2(acc[r][df].z, acc[r][df].w)};
        for (int rep = 0; rep < rep_sel; ++rep) {
            const bool dry = (rep + 1 < rep_sel);
            const bf16_t* ksb = KS + (size_t)bg * SEQ * 64; const bf16_t* vsb = VST + (size_t)bg * 64 * SEQ;
            unsigned char* KL = WL; unsigned char* VL = WL + 8192;
            const int nv = cur + 1 < 16 ? cur + 1 : 16, total = 16 * nv;
            const int lrow = lane >> 3, lch = lane & 7;
            const int kwoff = lrow * 128 + ((lch ^ (lrow & 7)) << 4), vwoff = lrow * 144 + lch * 16;
            const int rr = fr & 3;
            u32x4 sk[8], sv[8];
            const unsigned koff = (unsigned)(lrow * 64 + lch * 8), voff = (unsigned)(lrow * SEQ + lch * 8);
            int jbn = __builtin_amdgcn_readfirstlane(SEL[0]);
            {
                const bf16_t* kb_ = ksb + (size_t)jbn * 4096; const bf16_t* vb_ = vsb + (size_t)jbn * 64;
#pragma unroll
                for (int j = 0; j < 8; ++j) { sk[j] = *(const u32x4*)(kb_ + j * 512 + koff); sv[j] = *(const u32x4*)(vb_ + (size_t)j * 8 * SEQ + voff); }
            }
            bf16x8 qs[2];
            float ms = NEGBIG, ls = 0.f;
            f32x4 os[4] = {z4, z4, z4, z4};
            int i = 0, k = 0;
            for (int v = 0; v < total; ++v) {
                const int jb = jbn;
#pragma unroll
                for (int j = 0; j < 8; ++j) { *(u32x4*)(KL + kwoff + j * 1024) = sk[j]; *(u32x4*)(VL + vwoff + j * 1152) = sv[j]; }
                if (v + 1 < total) {
                    int k2 = k + 1, i2 = i; if (k2 == nv) { k2 = 0; i2 = i + 1; }
                    jbn = __builtin_amdgcn_readfirstlane(SEL[i2 * 16 + k2]);
                    const bf16_t* kb_ = ksb + (size_t)jbn * 4096; const bf16_t* vb_ = vsb + (size_t)jbn * 64;
#pragma unroll
                    for (int j = 0; j < 8; ++j) { sk[j] = *(const u32x4*)(kb_ + j * 512 + koff); sv[j] = *(const u32x4*)(vb_ + (size_t)j * 8 * SEQ + voff); }
                }
                __builtin_amdgcn_sched_barrier(0);
                const int ti = t0 + i;
                if (k == 0) {
                    const size_t tk = (size_t)b * SEQ + ti;
#pragma unroll
                    for (int ks = 0; ks < 2; ++ks) qs[ks] = *(const bf16x8*)(Q + tk * 1024 + (g * 4 + rr) * 64 + ks * 32 + fq * 8);
                    ms = NEGBIG; ls = 0.f;
#pragma unroll
                    for (int df = 0; df < 4; ++df) os[df] = z4;
                }
                f32x4 st[4];
#pragma unroll
                for (int f = 0; f < 4; ++f) {
                    const bf16x8 k0 = *(const bf16x8*)(KL + (f * 16 + fr) * 128 + (((0 + fq) ^ (fr & 7)) << 4));
                    const bf16x8 k1 = *(const bf16x8*)(KL + (f * 16 + fr) * 128 + (((4 + fq) ^ (fr & 7)) << 4));
                    st[f] = __builtin_amdgcn_mfma_f32_16x16x32_bf16(k0, qs[0], z4, 0, 0, 0);
                    st[f] = __builtin_amdgcn_mfma_f32_16x16x32_bf16(k1, qs[1], st[f], 0, 0, 0);
                }
                if (jb == cur) {
#pragma unroll
                    for (int f = 0; f < 4; ++f)
#pragma unroll
                        for (int e = 0; e < 4; ++e) { const int key = jb * 64 + f * 16 + fq * 4 + e; if (key > ti) st[f][e] = NEGBIG; }
                }
                float mx = NEGBIG;
#pragma unroll
                for (int f = 0; f < 4; ++f) mx = fmaxf(mx, fmaxf(fmaxf(st[f].x, st[f].y), fmaxf(st[f].z, st[f].w)));
                mx = max4(mx);
                const float mn = fmaxf(ms, mx);
                const float al = __expf(ms - mn);
                float ps = 0.f;
#pragma unroll
                for (int f = 0; f < 4; ++f)
#pragma unroll
                    for (int e = 0; e < 4; ++e) { const float pv = (st[f][e] > -1.0e29f) ? __expf(st[f][e] - mn) : 0.f; st[f][e] = pv; ps += pv; }
                ls = ls * al + ps; ms = mn;
#pragma unroll
                for (int df = 0; df < 4; ++df) os[df] = os[df] * al;
#pragma unroll
                for (int s = 0; s < 2; ++s) {
                    const bf16x8 pf = pack8(st[2 * s], st[2 * s + 1]);
#pragma unroll
                    for (int df = 0; df < 4; ++df) {
                        const unsigned char* vp = VL + (df * 16 + fr) * 144 + (32 * s + 4 * fq) * 2;
                        const u32x2 lo = *(const u32x2*)vp, hi = *(const u32x2*)(vp + 32);
                        u32x4 w; w.x = lo.x; w.y = lo.y; w.z = hi.x; w.w = hi.y;
                        os[df] = __builtin_amdgcn_mfma_f32_16x16x32_bf16(__builtin_bit_cast(bf16x8, w), pf, os[df], 0, 0, 0);
                    }
                }
                if (k == nv - 1) {
                    const float l = red4(ls);
                    const float gsv = NGT[((size_t)b * SEQ + ti) * 48 + (g * 4 + rr) * 3 + 1];
                    const float sc = dry ? 0.f : gsv / l;
#pragma unroll
                    for (int df = 0; df < 4; ++df) {
                        const f32x4 val = os[df] * sc;
#pragma unroll
                        for (int r = 0; r < 4; ++r) {
                            const int srcl = r + 16 * fq;
                            const float t0_ = __shfl(val.x, srcl), t1_ = __shfl(val.y, srcl), t2_ = __shfl(val.z, srcl), t3_ = __shfl(val.w, srcl);
                            if (fr == i) {
                                const u32x2 c = accp[r][df];
                                accp[r][df] = (u32x2){pk2(bflo(c.x) + t0_, bfhi(c.x) + t1_), pk2(bflo(c.y) + t2_, bfhi(c.y) + t3_)};
                            }
                        }
                    }
                }
                ++k; if (k == nv) { k = 0; ++i; }
            }
        }
#pragma unroll
        for (int r = 0; r < 4; ++r)
#pragma unroll
            for (int df = 0; df < 4; ++df) {
                *(u32x2*)(O + tok * 1024 + (g * 4 + r) * 64 + df * 16 + fq * 4) = accp[r][df];
            }
    }
}
constexpr int NPHASES = 24;
#ifndef PROBE_PHASE
#define PROBE_PHASE (-1)
#endif
#ifndef ATT_REP_CMP
#define ATT_REP_CMP 1
#endif
#ifndef ATT_REP_WIN
#define ATT_REP_WIN 1
#endif
#ifndef ATT_REP_SEL
#define ATT_REP_SEL 1
#endif
#ifndef TS_PHASE
#define TS_PHASE (-1)
#endif
#ifndef TS_MULT
#define TS_MULT 4
#endif
#ifndef PROBE_REPS
#define PROBE_REPS 1
#endif
__global__ void __launch_bounds__(NTHREADS, 2) mega(Params p) {
    __shared__ __attribute__((aligned(16))) unsigned char lds[LDS_BYTES];
    __shared__ __attribute__((aligned(16))) unsigned bar_st[4];
    cg::grid_group grid = cg::this_grid();
    const float* MOD = (const float*)(p.ws + WS_MOD);
    bf16_t* HM = (bf16_t*)(p.ws + WS_HM);
    if (threadIdx.x < 4) bar_st[threadIdx.x] = 0u;
    __syncthreads();
    XcdBarrier bar = xcd_barrier_post((unsigned*)(p.ws + WS_CTL), (volatile LAS unsigned*)bar_st);
    const int lo = p.ph_lo, hi = p.ph_hi;
    const bool dry0 = (p.ph_hi < 0);
    const int opq = (p.ph_hi < 0) ? 1 : 0;
    unsigned long long ts_a = 0ull, ts_b = 0ull;
#define PHASE(k, call, drycall) if (lo <= (k) && (k) < hi) { \
        if (TS_PHASE == (k)) ts_a = __builtin_amdgcn_s_memrealtime(); \
        if (PROBE_PHASE == (k)) { for (int rep = 0; rep < PROBE_REPS; ++rep) { const bool dry = !dry0; drycall; __syncthreads(); } } \
        { const bool dry = dry0; call; } \
        if ((k) + 1 < hi) { if ((k) == 0) grid.sync(); else xcd_barrier(bar); } \
        if (TS_PHASE == (k)) ts_b = __builtin_amdgcn_s_memrealtime(); }
    PHASE(0, phase_prep(p, (float*)lds), phase_prep(p, (float*)lds))
    PHASE(1, phase_norm(p, p.in[0], p.in[2], MOD + 0, MOD + 1024, HM), phase_norm(p, p.in[0], p.in[2], MOD + 0, MOD + 1024, HM))
    PHASE(2, phase_s5_win(p, lds), phase_s5_win(p, lds))
    PHASE(3, phase_s5_a(p, lds), phase_s5_a(p, lds))
    PHASE(4, phase_s5_scan(p), phase_s5_scan(p))
    PHASE(5, phase_s5_b(p, lds), phase_s5_b(p, lds))
    PHASE(6, phase_s5_glu(p, lds), phase_s5_glu(p, lds))
    PHASE(7, phase_norm(p, p.out, p.in[3], MOD + 3072, MOD + 4096, HM), phase_norm(p, p.out, p.in[3], MOD + 3072, MOD + 4096, HM))
    PHASE(8, phase_peer_wq(p, 0, lds), phase_peer_wq(p, 0, lds))
    PHASE(9, phase_peer_topk(p, 0, lds), phase_peer_topk(p, 0, lds))
    PHASE(10, phase_peer_combine(p, lds), phase_peer_combine(p, lds))
    PHASE(11, phase_peer_apply(p, 0, lds, dry), phase_peer_apply(p, 0, lds, dry))
    PHASE(12, (phase_norm(p, p.out, p.in[2] + D, MOD + 2 * 6144 + 0, MOD + 2 * 6144 + 1024, HM), phase_tab1(p)), (phase_norm(p, p.out, p.in[2] + D, MOD + 2 * 6144 + 0, MOD + 2 * 6144 + 1024, HM), phase_tab1(p)))
    PHASE(13, phase_nsa_proj(p, lds), phase_nsa_proj(p, lds))
    PHASE(14, phase_nsa_cmp1(p, lds), phase_nsa_cmp1(p, lds))
    PHASE(15, phase_nsa_cmp2(p, lds), phase_nsa_cmp2(p, lds))
    PHASE(16, phase_nsa_attn(p, lds, ATT_REP_CMP + opq, ATT_REP_WIN + opq, ATT_REP_SEL + opq), phase_nsa_attn(p, lds, 1 + opq, 1 + opq, 1 + opq))
    PHASE(17, phase_nsa_wo(p, lds, dry), phase_nsa_wo(p, lds, dry))
    PHASE(18, phase_norm(p, p.out, p.in[3] + D, MOD + 2 * 6144 + 3072, MOD + 2 * 6144 + 4096, HM), phase_norm(p, p.out, p.in[3] + D, MOD + 2 * 6144 + 3072, MOD + 2 * 6144 + 4096, HM))
    PHASE(19, phase_peer_wq(p, 1, lds), phase_peer_wq(p, 1, lds))
    PHASE(20, phase_peer_topk(p, 1, lds), phase_peer_topk(p, 1, lds))
    PHASE(21, phase_peer_combine(p, lds), phase_peer_combine(p, lds))
    PHASE(22, phase_peer_apply(p, 1, lds, dry), phase_peer_apply(p, 1, lds, dry))
    PHASE(23, phase_final_norm(p, p.out, p.out, dry), phase_final_norm(p, p.out, p.out, dry))
#undef PHASE
    if (TS_PHASE >= 0 && blockIdx.x == 0 && threadIdx.x == 0) {
        const unsigned long long t0 = __builtin_amdgcn_s_memrealtime(), want = (ts_b - ts_a) * TS_MULT;
        while (__builtin_amdgcn_s_memrealtime() - t0 < want) __builtin_amdgcn_s_sleep(8);
    }
}

extern "C" void kernel_launch(void* const* d_in, const int* in_sizes, int n_in, void* d_out, int out_size, void* d_ws, size_t ws_size, hipStream_t stream) {
    static int grid_blocks = 0;
    if (!grid_blocks) {
        int dev = 0, cus = 0, per_cu = 0;
        hipGetDevice(&dev);
        hipDeviceGetAttribute(&cus, hipDeviceAttributeMultiprocessorCount, dev);
        hipOccupancyMaxActiveBlocksPerMultiprocessor(&per_cu, mega, NTHREADS, 0);
        if (per_cu > 2) per_cu = 2;
        if (per_cu < 1) per_cu = 1;
        grid_blocks = cus * per_cu;
        if (ws_size < WS_END) fprintf(stderr, "kernel_launch: workspace too small: %zu < %zu\n", ws_size, (size_t)WS_END);
        if (n_in != 29) fprintf(stderr, "kernel_launch: expected 29 inputs, got %d\n", n_in);
    }
    hipMemsetAsync((unsigned char*)d_ws + WS_CTL, 0, 16384, stream);
    Params p{};
    for (int i = 0; i < 29; ++i) p.in[i] = (const float*)d_in[i];
    p.out = (float*)d_out; p.ws = (unsigned char*)d_ws;
#if SINGLE_LAUNCH
    p.ph_lo = 0; p.ph_hi = NPHASES;
    void* args[] = {&p};
    hipError_t e = hipLaunchCooperativeKernel((void*)mega, dim3(grid_blocks), dim3(NTHREADS), args, 0, stream);
    if (e != hipSuccess) fprintf(stderr, "cooperative launch failed: %s (grid %d)\n", hipGetErrorString(e), grid_blocks);
#else
    for (int ph = 0; ph < NPHASES; ++ph) {
        p.ph_lo = ph; p.ph_hi = ph + 1;
        hipLaunchKernelGGL(mega, dim3(grid_blocks), dim3(NTHREADS), 0, stream, p);
    }
#endif
}
```

```cpp
#include <hip/hip_runtime.h>
#include <hip/hip_cooperative_groups.h>
#include <cstdio>
#include <cstdint>
namespace cg = cooperative_groups;

#ifndef SINGLE_LAUNCH
#define SINGLE_LAUNCH 1
#endif

typedef unsigned short bf16_t;
typedef short bf16x8 __attribute__((ext_vector_type(8)));
typedef float f32x4 __attribute__((ext_vector_type(4)));
typedef float f32x2 __attribute__((ext_vector_type(2)));
typedef unsigned u32x4 __attribute__((ext_vector_type(4)));
typedef unsigned u32x2 __attribute__((ext_vector_type(2)));
typedef __bf16 bf16x2_t __attribute__((ext_vector_type(2)));

constexpr int D = 1024, BATCH = 2, SEQ = 16384, T = BATCH * SEQ;
constexpr int NTHREADS = 256;
constexpr float RMS_EPS = 1e-6f;
constexpr int S5G = 64, S5P = 64, S5L = 32, S5NCH = T / S5L  , S5CPB = SEQ / S5L  ;
constexpr int NH = 16, HD = 64, NG = 4, NPROJ = 2608, NPROJ_PAD = 2688, NC = 1023, NSB = 256;
constexpr int PH = 8, PK = 16, PNK = 128, PE = 16384;

constexpr size_t MiB = 1ull << 20;
constexpr size_t WS_CTL = 0;
constexpr size_t WS_MOD = 1 * MiB;
constexpr size_t WS_WIN_T = 2 * MiB;
constexpr size_t WS_WGLU_T = 4 * MiB;
constexpr size_t WS_WPROJ_T = 8 * MiB;
constexpr size_t WS_WK1_T = 14 * MiB;
constexpr size_t WS_WV1_T = 15 * MiB;
constexpr size_t WS_WK2_T = 16 * MiB;
constexpr size_t WS_WV2_T = 16 * MiB + 512 * 1024;
constexpr size_t WS_WO_T = 17 * MiB;
constexpr size_t WS_WQ_T = 19 * MiB;
constexpr size_t WS_SUBK = 27 * MiB;
constexpr size_t WS_ROPE = 28 * MiB;
constexpr size_t WS_MISC = 32 * MiB;
constexpr size_t WS_TW = 33 * MiB;
constexpr size_t WS_VG = 73 * MiB;
constexpr size_t WS_PU = 82 * MiB;
constexpr size_t WS_PV = 114 * MiB;
constexpr size_t WS_HM = 146 * MiB;
constexpr size_t WS_C = 210 * MiB;
constexpr size_t WS_UG = WS_C;
constexpr size_t WS_YI = WS_C + 64 * MiB;
constexpr size_t WS_WST = WS_C + 128 * MiB;
constexpr size_t WS_SST = WS_C + 160 * MiB;
constexpr size_t WS_YG = WS_C + 176 * MiB;
constexpr size_t WS_QK = WS_C;
constexpr size_t WS_TOPS = WS_C + 128 * MiB;
constexpr size_t WS_TOPI = WS_C + 160 * MiB;
constexpr size_t WS_EXP = WS_C + 192 * MiB;
constexpr size_t WS_GATE = WS_C + 208 * MiB;
constexpr size_t WS_Q = WS_C;
constexpr size_t WS_KC = WS_C + 64 * MiB;
constexpr size_t WS_VC = WS_C + 81 * MiB;
constexpr size_t WS_KS = WS_C + 98 * MiB;
constexpr size_t WS_VST = WS_C + 114 * MiB;
constexpr size_t WS_KW = WS_C + 130 * MiB;
constexpr size_t WS_VWT = WS_C + 146 * MiB;
constexpr size_t WS_NG = WS_C + 162 * MiB;
constexpr size_t WS_KCMP = WS_C + 170 * MiB;
constexpr size_t WS_VCMPT = WS_C + 171 * MiB;
constexpr size_t WS_HID = WS_C + 172 * MiB;
constexpr size_t WS_O = WS_C + 182 * MiB;
constexpr size_t WS_Q8 = WS_C + 246 * MiB;
constexpr size_t WS_END = WS_C + 282 * MiB;

constexpr int LDS_BYTES = 73728;

struct Params {
    const float* in[29];
    float* out;
    unsigned char* ws;
    int ph_lo, ph_hi;
};

__device__ __forceinline__ unsigned f2bf(float f) { unsigned u = __builtin_bit_cast(unsigned, f); return (u + 0x7fffu + ((u >> 16) & 1u)) >> 16; }
__device__ __forceinline__ unsigned pk2(float lo, float hi) { return f2bf(lo) | (f2bf(hi) << 16); }
__device__ __forceinline__ float bf2f(unsigned h) { return __builtin_bit_cast(float, h << 16); }
__device__ __forceinline__ float bflo(unsigned w) { return __builtin_bit_cast(float, w << 16); }
__device__ __forceinline__ float bfhi(unsigned w) { return __builtin_bit_cast(float, w & 0xffff0000u); }
__device__ __forceinline__ float gelu_tanh(float x) {
    const float u = 0.7978845608028654f * (x + 0.044715f * x * x * x);
    const float e = __expf(2.0f * u);
    const float th = 1.0f - 2.0f / (e + 1.0f);
    return 0.5f * x * (1.0f + th);
}
__device__ __forceinline__ float sigmoidf_(float x) { return 1.0f / (1.0f + __expf(-x)); }
__device__ __forceinline__ float wave_sum(float v) {
#pragma unroll
    for (int o = 1; o < 64; o <<= 1) v += __shfl_xor(v, o);
    return v;
}
__device__ __forceinline__ float dot2bf(unsigned a, unsigned b, float acc) {
    return __builtin_amdgcn_fdot2_f32_bf16(__builtin_bit_cast(bf16x2_t, a), __builtin_bit_cast(bf16x2_t, b), acc, false);
}

#define LAS __attribute__((address_space(3)))
#define XB_TMO      128
#define XB_XCNT(j)  (256  + 64 * (j))
#define XB_XSUB(j)  (1280 + 64 * (j))
#define XB_XGEN(j)  (2304 + 64 * (j))
#define XB_TOP      3328
#define XB_TOPGEN   3392
#define XCD_BAR_WORDS 3456
#define XB_SPIN_CAP (1u << 24)

__device__ __forceinline__ unsigned xb_ld(unsigned* p)              { return __hip_atomic_load(p, __ATOMIC_RELAXED, __HIP_MEMORY_SCOPE_AGENT); }
__device__ __forceinline__ unsigned xb_add(unsigned* p, unsigned v) { return __hip_atomic_fetch_add(p, v, __ATOMIC_RELAXED, __HIP_MEMORY_SCOPE_AGENT); }
__device__ __forceinline__ unsigned xb_xcc_id() { return (unsigned)__builtin_amdgcn_s_getreg((3 << 11) | 20) & 0xFu; }
#define XB_SPIN(cond, bar) do { unsigned _sp = 0; while (cond) { __builtin_amdgcn_s_sleep(1); \
    if ((++_sp & 255u) == 0u) { if (xb_ld(&(bar)[XB_TMO])) break; if (_sp > XB_SPIN_CAP) { atomicAdd(&(bar)[XB_TMO], 1u); break; } } } } while (0)

struct XcdBarrier {
    unsigned* bar; unsigned x;
    volatile LAS unsigned* st;
};

__device__ __forceinline__ XcdBarrier xcd_barrier_post(unsigned* bar, volatile LAS unsigned* st) {
    XcdBarrier b; b.bar = bar; b.x = xb_xcc_id(); b.st = st;
    if (threadIdx.x == 0) (void)xb_add(&bar[XB_XCNT(b.x)], 1u);
    return b;
}
__device__ __forceinline__ void xcd_barrier_complete(unsigned* bar, unsigned x, unsigned& nloc, unsigned& nx) {
    const unsigned G = gridDim.x * gridDim.y * gridDim.z;
    unsigned sum, cnt, mine, sp = 0u;
    for (;;) {
        sum = 0u; cnt = 0u; mine = 0u;
#pragma unroll
        for (unsigned j = 0; j < 16; ++j) { const unsigned c = xb_ld(&bar[XB_XCNT(j)]); sum += c; cnt += (c > 0u) ? 1u : 0u; mine = (j == x) ? c : mine; }
        if (sum == G) break;
        __builtin_amdgcn_s_sleep(1);
        if ((++sp & 255u) == 0u) { if (xb_ld(&bar[XB_TMO])) break; if (sp > XB_SPIN_CAP) { atomicAdd(&bar[XB_TMO], 1u); break; } }
    }
    nloc = mine > 0u ? mine : 1u; nx = cnt > 0u ? cnt : 1u;
}

__device__ __forceinline__ void xcd_barrier(const XcdBarrier& b) {
    asm volatile("s_waitcnt vmcnt(0)" ::: "memory");
    __syncthreads();
    if (threadIdx.x == 0) {
        unsigned* bar = b.bar;
        __builtin_amdgcn_s_waitcnt(0);
        unsigned nloc = b.st[0], nx = b.st[1];
        if (nloc == 0u) { xcd_barrier_complete(bar, b.x, nloc, nx); b.st[0] = nloc; b.st[1] = nx; }
        const unsigned old = xb_add(&bar[XB_XSUB(b.x)], 1u);
        const unsigned gen = old / nloc;
        if (old + 1u == (gen + 1u) * nloc) {
            __builtin_amdgcn_fence(__ATOMIC_RELEASE, "agent");
            asm volatile("s_waitcnt vmcnt(0)" ::: "memory");
            const unsigned og = xb_add(&bar[XB_TOP], 1u);
            const unsigned tg = og / nx;
            if (og + 1u == (tg + 1u) * nx) xb_add(&bar[XB_TOPGEN], 1u);
            else XB_SPIN(xb_ld(&bar[XB_TOPGEN]) == tg, bar);
            __builtin_amdgcn_fence(__ATOMIC_ACQUIRE, "agent");
            xb_add(&bar[XB_XGEN(b.x)], 1u);
            asm volatile("s_waitcnt vmcnt(0)" ::: "memory");
        } else {
            XB_SPIN(xb_ld(&bar[XB_XGEN(b.x)]) == gen, bar);
            __builtin_amdgcn_fence(__ATOMIC_ACQUIRE, "agent");
            asm volatile("s_waitcnt vmcnt(0)" ::: "memory");
        }
    }
    __syncthreads();
}
__device__ __forceinline__ void prep_mod_item(const Params& p, int item, float* lds) {
    const int layer = item / 192, cg0 = (item % 192) * 32;
    const int tid = threadIdx.x, col = cg0 + (tid & 31), kg = tid >> 5;
    const float* W = p.in[4] + (size_t)layer * D * 6 * D;
    const float* c = p.in[1];
    float a0 = 0.f, a1 = 0.f;
    for (int k = kg * 128; k < kg * 128 + 128; ++k) {
        const float w = W[(size_t)k * (6 * D) + col];
        const float c0 = c[k], c1 = c[D + k];
        a0 += w * (c0 * sigmoidf_(c0));
        a1 += w * (c1 * sigmoidf_(c1));
    }
    lds[tid] = a0; lds[256 + tid] = a1;
    __syncthreads();
    if (tid < 64) {
        const int b = tid >> 5, cc = tid & 31;
        float s = 0.f;
#pragma unroll
        for (int g = 0; g < 8; ++g) s += lds[b * 256 + g * 32 + cc];
        float* MOD = (float*)(p.ws + WS_MOD);
        MOD[(size_t)(layer * 2 + b) * 6144 + cg0 + cc] = s + p.in[5][(size_t)layer * 6144 + cg0 + cc];
    }
    __syncthreads();
}

template <int MODE>
__device__ __forceinline__ void prep_transpose_item(const float* W, int K, int N, bf16_t* WT, int item, float* lds) {
    const int nbn = (N + 63) / 64, kb = item / nbn, nb = item % nbn, k0 = kb * 64, n0 = nb * 64;
    const int tid = threadIdx.x;
#pragma unroll
    for (int i = 0; i < 16; ++i) {
        const int kk = (tid >> 6) + 4 * i, nn = tid & 63;
        const float v = (n0 + nn < N) ? W[(size_t)(k0 + kk) * N + n0 + nn] : 0.f;
        lds[kk * 65 + nn] = v;
    }
    __syncthreads();
    {
        const int nn = tid >> 2, ks = (tid & 3) * 16;
        const int n = n0 + nn;
        if (n < N) {
            int np = n;
            if (MODE == 1) { const int j = (n < 1024) ? n : n - 1024; np = (j >> 4) * 32 + (j & 15) + ((n < 1024) ? 0 : 16); }
            u32x4 o0, o1;
            const float* s = lds + nn;
            o0.x = pk2(s[(ks + 0) * 65], s[(ks + 1) * 65]); o0.y = pk2(s[(ks + 2) * 65], s[(ks + 3) * 65]);
            o0.z = pk2(s[(ks + 4) * 65], s[(ks + 5) * 65]); o0.w = pk2(s[(ks + 6) * 65], s[(ks + 7) * 65]);
            o1.x = pk2(s[(ks + 8) * 65], s[(ks + 9) * 65]); o1.y = pk2(s[(ks + 10) * 65], s[(ks + 11) * 65]);
            o1.z = pk2(s[(ks + 12) * 65], s[(ks + 13) * 65]); o1.w = pk2(s[(ks + 14) * 65], s[(ks + 15) * 65]);
            u32x4* dst = (u32x4*)(WT + (size_t)np * K + k0 + ks);
            dst[0] = o0; dst[1] = o1;
        }
    }
    __syncthreads();
}

__device__ __forceinline__ void cvt_item(const float* src, bf16_t* dst, int item) {
    const size_t base = (size_t)item * 8192 + threadIdx.x * 8;
#pragma unroll
    for (int i = 0; i < 4; ++i) {
        const size_t o = base + (size_t)i * 2048;
        const f32x4 a = *(const f32x4*)(src + o), b = *(const f32x4*)(src + o + 4);
        u32x4 w; w.x = pk2(a.x, a.y); w.y = pk2(a.z, a.w); w.z = pk2(b.x, b.y); w.w = pk2(b.z, b.w);
        *(u32x4*)(dst + o) = w;
    }
}
__device__ __forceinline__ void zero_item(bf16_t* dst, int item) {
    const size_t base = (size_t)item * 8192 + threadIdx.x * 8;
#pragma unroll
    for (int i = 0; i < 4; ++i) *(u32x4*)(dst + base + (size_t)i * 2048) = (u32x4){0u, 0u, 0u, 0u};
}

struct cpx { float re, im; };
__device__ __forceinline__ cpx cmul(cpx a, cpx b) { return {a.re * b.re - a.im * b.im, a.re * b.im + a.im * b.re}; }
__device__ __forceinline__ cpx cexp_pow(float are, float aim, float dt, int m) {
    const float mag = __expf(are * dt * (float)m);
    const double rev = (double)aim * (double)dt * (double)m * 0.15915494309189535;
    const float fr = (float)(rev - rint(rev));
    return {mag * __builtin_amdgcn_cosf(fr), mag * __builtin_amdgcn_sinf(fr)};
}
__device__ __forceinline__ cpx s5_coef(float are, float aim, float dt) {
    cpx ab = cexp_pow(are, aim, dt, 1);
    const float nr = ab.re - 1.0f, ni = ab.im, den = are * are + aim * aim;
    return {(nr * are + ni * aim) / den, (ni * are - nr * aim) / den};
}

__device__ __forceinline__ void prep_s5_T_item(const Params& p, int item) {
    const int gid = item * 256 + threadIdx.x;
    const int g = gid >> 9, m = (gid >> 4) & 31, i = gid & 15;
    const float* a_re = p.in[7] + g * 64; const float* a_im = p.in[8] + g * 64;
    const float dt = __expf(p.in[9][g]);
    const float* b_re = p.in[10] + (size_t)g * 64 * 16; const float* b_im = p.in[11] + (size_t)g * 64 * 16;
    const float* c_re = p.in[12] + (size_t)g * 16 * 64 + i * 64; const float* c_im = p.in[13] + (size_t)g * 16 * 64 + i * 64;
    float acc[16];
#pragma unroll
    for (int j = 0; j < 16; ++j) acc[j] = 0.f;
    for (int q = 0; q < 64; ++q) {
        const float are = a_re[q], aim = a_im[q];
        cpx z = cmul(cmul({c_re[q], c_im[q]}, cexp_pow(are, aim, dt, m)), s5_coef(are, aim, dt));
        const f32x4* br = (const f32x4*)(b_re + q * 16); const f32x4* bi = (const f32x4*)(b_im + q * 16);
#pragma unroll
        for (int j4 = 0; j4 < 4; ++j4) {
            const f32x4 r = br[j4], im = bi[j4];
            acc[j4 * 4 + 0] += z.re * r.x - z.im * im.x; acc[j4 * 4 + 1] += z.re * r.y - z.im * im.y;
            acc[j4 * 4 + 2] += z.re * r.z - z.im * im.z; acc[j4 * 4 + 3] += z.re * r.w - z.im * im.w;
        }
    }
    u32x4 o0, o1;
    o0.x = pk2(acc[0], acc[1]); o0.y = pk2(acc[2], acc[3]); o0.z = pk2(acc[4], acc[5]); o0.w = pk2(acc[6], acc[7]);
    o1.x = pk2(acc[8], acc[9]); o1.y = pk2(acc[10], acc[11]); o1.z = pk2(acc[12], acc[13]); o1.w = pk2(acc[14], acc[15]);
    bf16_t* TW = (bf16_t*)(p.ws + WS_TW) + (size_t)g * 640 * 512;
    const u32x4 z4 = (u32x4){0u, 0u, 0u, 0u};
    for (int lp = 0; lp + m < 32; ++lp) {
        u32x4* d = (u32x4*)(TW + (size_t)((lp + m) * 16 + i) * 512 + lp * 16);
        d[0] = o0; d[1] = o1;
        if (m > 0) { u32x4* dz = (u32x4*)(TW + (size_t)(lp * 16 + i) * 512 + (lp + m) * 16); dz[0] = z4; dz[1] = z4; }
    }
}
__device__ __forceinline__ void prep_s5_W_item(const Params& p, int item) {
    const int gid = item * 256 + threadIdx.x;
    const int g = gid >> 11, q = (gid >> 5) & 63, lp = gid & 31;
    const float are = p.in[7][g * 64 + q], aim = p.in[8][g * 64 + q];
    const float dt = __expf(p.in[9][g]);
    const cpx z = cmul(cexp_pow(are, aim, dt, 31 - lp), s5_coef(are, aim, dt));
    const float* br = p.in[10] + ((size_t)g * 64 + q) * 16; const float* bi = p.in[11] + ((size_t)g * 64 + q) * 16;
    float wr[16], wi[16];
#pragma unroll
    for (int j = 0; j < 16; ++j) { wr[j] = z.re * br[j] - z.im * bi[j]; wi[j] = z.re * bi[j] + z.im * br[j]; }
    bf16_t* TW = (bf16_t*)(p.ws + WS_TW) + (size_t)g * 640 * 512;
    u32x4* d0 = (u32x4*)(TW + (size_t)(512 + q) * 512 + lp * 16);
    u32x4* d1 = (u32x4*)(TW + (size_t)(576 + q) * 512 + lp * 16);
    d0[0] = (u32x4){pk2(wr[0], wr[1]), pk2(wr[2], wr[3]), pk2(wr[4], wr[5]), pk2(wr[6], wr[7])};
    d0[1] = (u32x4){pk2(wr[8], wr[9]), pk2(wr[10], wr[11]), pk2(wr[12], wr[13]), pk2(wr[14], wr[15])};
    d1[0] = (u32x4){pk2(wi[0], wi[1]), pk2(wi[2], wi[3]), pk2(wi[4], wi[5]), pk2(wi[6], wi[7])};
    d1[1] = (u32x4){pk2(wi[8], wi[9]), pk2(wi[10], wi[11]), pk2(wi[12], wi[13]), pk2(wi[14], wi[15])};
}
__device__ __forceinline__ void prep_s5_V_item(const Params& p, int item) {
    const int gid = item * 256 + threadIdx.x;
    const int g = gid >> 14, l = (gid >> 9) & 31, i = (gid >> 5) & 15, q0 = (gid & 31) * 2;
    const float dt = __expf(p.in[9][g]);
    float vr[2], vi[2];
#pragma unroll
    for (int e = 0; e < 2; ++e) {
        const int q = q0 + e;
        const cpx z = cmul({p.in[12][((size_t)g * 16 + i) * 64 + q], p.in[13][((size_t)g * 16 + i) * 64 + q]}, cexp_pow(p.in[7][g * 64 + q], p.in[8][g * 64 + q], dt, l + 1));
        vr[e] = z.re; vi[e] = -z.im;
    }
    bf16_t* VG = (bf16_t*)(p.ws + WS_VG) + ((size_t)g * 512 + l * 16 + i) * 128;
    *(unsigned*)(VG + q0) = pk2(vr[0], vr[1]);
    *(unsigned*)(VG + 64 + q0) = pk2(vi[0], vi[1]);
}
__device__ __forceinline__ void prep_al_item(const Params& p, int item) {
    const int gid = item * 256 + threadIdx.x;
    const int g = gid >> 6;
    const float dt = __expf(p.in[9][g]);
    const cpx z = cexp_pow(p.in[7][gid], p.in[8][gid], dt, S5L);
    f32x2* AL = (f32x2*)(p.ws + WS_MISC + 4096);
    AL[gid] = (f32x2){z.re, z.im};
}
__device__ __forceinline__ void prep_rope_item(const Params& p, int item) {
    const int gid = item * 256 + threadIdx.x;
    const int pos = gid >> 5, j = gid & 31;
    const float freq = exp2f(-(float)j * (13.287712379549449f / 32.0f));
    const float ang = (float)pos * freq;
    const double rev = (double)ang * 0.15915494309189535;
    const float fr = (float)(rev - rint(rev));
    f32x2* R = (f32x2*)(p.ws + WS_ROPE);
    R[gid] = (f32x2){__builtin_amdgcn_cosf(fr), __builtin_amdgcn_sinf(fr)};
}
__device__ __forceinline__ void prep_cmpbias_item(const Params& p, int item, float* lds) {
    const int kv = item >> 3, cg0 = (item & 7) * 32;
    const float* pe = p.in[17 + kv]; const float* w1 = p.in[kv == 0 ? 19 : 21];
    const int tid = threadIdx.x, col = cg0 + (tid & 31), kg = tid >> 5;
    float s = 0.f;
#pragma unroll 8
    for (int k = kg * 256; k < kg * 256 + 256; ++k) s += pe[k] * w1[(size_t)k * 256 + col];
    lds[tid] = s;
    __syncthreads();
    if (tid < 32) {
        float t = 0.f;
#pragma unroll
        for (int q = 0; q < 8; ++q) t += lds[q * 32 + tid];
        ((float*)(p.ws + WS_MISC))[kv * 256 + cg0 + tid] = t;
    }
    __syncthreads();
}

__device__ __forceinline__ void cvt_fp8_item(const float* src, unsigned char* dst, float* inv_scale, int item) {
    const int lane = threadIdx.x & 63, row = item * 4 + (threadIdx.x >> 6);
    const f32x4* sp = (const f32x4*)(src + (size_t)row * D + lane * 16);
    const f32x4 a = sp[0], b = sp[1], c = sp[2], d = sp[3];
    float m = fmaxf(fmaxf(fmaxf(fabsf(a.x), fabsf(a.y)), fmaxf(fabsf(a.z), fabsf(a.w))), fmaxf(fmaxf(fabsf(b.x), fabsf(b.y)), fmaxf(fabsf(b.z), fabsf(b.w))));
    m = fmaxf(m, fmaxf(fmaxf(fmaxf(fabsf(c.x), fabsf(c.y)), fmaxf(fabsf(c.z), fabsf(c.w))), fmaxf(fmaxf(fabsf(d.x), fabsf(d.y)), fmaxf(fabsf(d.z), fabsf(d.w)))));
#pragma unroll
    for (int o = 1; o < 64; o <<= 1) m = fmaxf(m, __shfl_xor(m, o));
    const float sc = m > 0.f ? 224.0f / m : 1.0f;
    u32x4 w;
    int t = 0;
    t = __builtin_amdgcn_cvt_pk_fp8_f32(a.x * sc, a.y * sc, t, false); t = __builtin_amdgcn_cvt_pk_fp8_f32(a.z * sc, a.w * sc, t, true); w.x = (unsigned)t;
    t = __builtin_amdgcn_cvt_pk_fp8_f32(b.x * sc, b.y * sc, t, false); t = __builtin_amdgcn_cvt_pk_fp8_f32(b.z * sc, b.w * sc, t, true); w.y = (unsigned)t;
    t = __builtin_amdgcn_cvt_pk_fp8_f32(c.x * sc, c.y * sc, t, false); t = __builtin_amdgcn_cvt_pk_fp8_f32(c.z * sc, c.w * sc, t, true); w.z = (unsigned)t;
    t = __builtin_amdgcn_cvt_pk_fp8_f32(d.x * sc, d.y * sc, t, false); t = __builtin_amdgcn_cvt_pk_fp8_f32(d.z * sc, d.w * sc, t, true); w.w = (unsigned)t;
    *(u32x4*)(dst + (size_t)row * D + lane * 16) = w;
    if (lane == 0) inv_scale[row] = m > 0.f ? m / 224.0f : 1.0f;
}
constexpr int P0_MOD = 384;
constexpr int P0_T_WIN = 16 * 16, P0_T_WGLU = 16 * 32, P0_T_WPROJ = 16 * 41, P0_T_WK1 = 32 * 4, P0_T_WK2 = 4 * 1, P0_T_WO = 16 * 16, P0_T_WQ = 16 * 32;
constexpr int P0_SUBK = (2 * 8 * 2 * 128 * 128) / 8192;
constexpr int P0_TAB = PE / 4;
constexpr int P0_S5T = 128, P0_S5W = 512, P0_S5V = 4096, P0_AL = 16, P0_ROPE = 2048, P0_CB = 16, P0_ZERO = 10 + 2;

__device__ __forceinline__ void phase_prep(const Params& p, float* lds) {
    const int n0 = P0_MOD;
    const int n1 = n0 + P0_T_WIN, n2 = n1 + P0_T_WGLU, n3 = n2 + P0_T_WPROJ, n4 = n3 + P0_T_WK1, n5 = n4 + P0_T_WK1, n6 = n5 + P0_T_WK2, n7 = n6 + P0_T_WK2,
              n8 = n7 + P0_T_WO, n9 = n8 + P0_T_WQ, n10 = n9 + P0_T_WQ, n11 = n10 + P0_SUBK, n12 = n11 + P0_TAB, n13 = n12 + P0_TAB,
              n14 = n13 + P0_S5T, n15 = n14 + P0_S5W, n16 = n15 + P0_S5V, n17 = n16 + P0_AL, n18 = n17 + P0_ROPE, n19 = n18 + P0_CB, n20 = n19 + 10, n21 = n20 + 2, n22 = n21 + 2;
    unsigned char* ws = p.ws;
    for (int it = blockIdx.x; it < n22; it += gridDim.x) {
        if (it < n0) prep_mod_item(p, it, lds);
        else if (it < n1) prep_transpose_item<0>(p.in[6], 1024, 1024, (bf16_t*)(ws + WS_WIN_T), it - n0, lds);
        else if (it < n2) prep_transpose_item<1>(p.in[15], 1024, 2048, (bf16_t*)(ws + WS_WGLU_T), it - n1, lds);
        else if (it < n3) prep_transpose_item<0>(p.in[16], 1024, NPROJ, (bf16_t*)(ws + WS_WPROJ_T), it - n2, lds);
        else if (it < n4) prep_transpose_item<0>(p.in[19], 2048, 256, (bf16_t*)(ws + WS_WK1_T), it - n3, lds);
        else if (it < n5) prep_transpose_item<0>(p.in[21], 2048, 256, (bf16_t*)(ws + WS_WV1_T), it - n4, lds);
        else if (it < n6) prep_transpose_item<0>(p.in[20], 256, 64, (bf16_t*)(ws + WS_WK2_T), it - n5, lds);
        else if (it < n7) prep_transpose_item<0>(p.in[22], 256, 64, (bf16_t*)(ws + WS_WV2_T), it - n6, lds);
        else if (it < n8) prep_transpose_item<0>(p.in[23], 1024, 1024, (bf16_t*)(ws + WS_WO_T), it - n7, lds);
        else if (it < n9) prep_transpose_item<0>(p.in[24], 1024, 2048, (bf16_t*)(ws + WS_WQ_T), it - n8, lds);
        else if (it < n10) prep_transpose_item<0>(p.in[24] + (size_t)1024 * 2048, 1024, 2048, (bf16_t*)(ws + WS_WQ_T) + (size_t)2048 * 1024, it - n9, lds);
        else if (it < n11) cvt_item(p.in[25], (bf16_t*)(ws + WS_SUBK), it - n10);
        else if (it < n12) cvt_fp8_item(p.in[26], ws + WS_PU, (float*)(ws + WS_PU + 24 * MiB), it - n11);
        else if (it < n13) cvt_fp8_item(p.in[27], ws + WS_PV, (float*)(ws + WS_PV + 24 * MiB), it - n12);
        else if (it < n14) prep_s5_T_item(p, it - n13);
        else if (it < n15) prep_s5_W_item(p, it - n14);
        else if (it < n16) prep_s5_V_item(p, it - n15);
        else if (it < n17) prep_al_item(p, it - n16);
        else if (it < n18) prep_rope_item(p, it - n17);
        else if (it < n19) prep_cmpbias_item(p, it - n18, lds);
        else if (it < n20) zero_item((bf16_t*)(ws + WS_WPROJ_T) + (size_t)NPROJ * 1024, it - n19);
        else if (it < n21) zero_item((bf16_t*)(ws + WS_WK2_T) + (size_t)64 * 256, it - n20);
        else zero_item((bf16_t*)(ws + WS_WV2_T) + (size_t)64 * 256, it - n21);
    }
}

__device__ __forceinline__ void phase_norm(const Params& p, const float* X, const float* gw, const float* shift, const float* scale  , bf16_t* HM) {
    const int lane = threadIdx.x & 63, wave = threadIdx.x >> 6;
    for (int row = blockIdx.x * 4 + wave; row < T; row += gridDim.x * 4) {
        const int b = row / SEQ;
        const f32x4* xr = (const f32x4*)(X + (size_t)row * D) + lane;
        f32x4 v[4]; float s = 0.f;
#pragma unroll
        for (int j = 0; j < 4; ++j) { v[j] = xr[64 * j]; s += (v[j].x * v[j].x + v[j].y * v[j].y) + (v[j].z * v[j].z + v[j].w * v[j].w); }
        const float rs = rsqrtf(wave_sum(s) * (1.0f / D) + RMS_EPS);
        u32x2* o = (u32x2*)(HM + (size_t)row * D) + lane;
#pragma unroll
        for (int j = 0; j < 4; ++j) {
            const int c = lane * 4 + 256 * j;
            const f32x4 g = *(const f32x4*)(gw + c), sh = *(const f32x4*)(shift + (size_t)b * 6144 + c), sc = *(const f32x4*)(scale + (size_t)b * 6144 + c);
            const float y0 = v[j].x * rs * g.x * (1.f + sc.x) + sh.x, y1 = v[j].y * rs * g.y * (1.f + sc.y) + sh.y;
            const float y2 = v[j].z * rs * g.z * (1.f + sc.z) + sh.z, y3 = v[j].w * rs * g.w * (1.f + sc.w) + sh.w;
            o[64 * j] = (u32x2){pk2(y0, y1), pk2(y2, y3)};
        }
    }
}
__device__ __forceinline__ void phase_final_norm(const Params& p, const float* X, float* OUT, bool dry) {
    const int lane = threadIdx.x & 63, wave = threadIdx.x >> 6;
    const float* gw = p.in[28];
    for (int row = blockIdx.x * 4 + wave; row < T; row += gridDim.x * 4) {
        const f32x4* xr = (const f32x4*)(X + (size_t)row * D) + lane;
        f32x4 v[4]; float s = 0.f;
#pragma unroll
        for (int j = 0; j < 4; ++j) { v[j] = xr[64 * j]; s += (v[j].x * v[j].x + v[j].y * v[j].y) + (v[j].z * v[j].z + v[j].w * v[j].w); }
        const float rs = rsqrtf(wave_sum(s) * (1.0f / D) + RMS_EPS);
        f32x4* o = (f32x4*)(OUT + (size_t)row * D) + lane;
#pragma unroll
        for (int j = 0; j < 4; ++j) {
            const f32x4 g = *(const f32x4*)(gw + lane * 4 + 256 * j);
            if (!dry) o[64 * j] = (f32x4){v[j].x * rs * g.x, v[j].y * rs * g.y, v[j].z * rs * g.z, v[j].w * rs * g.w};
        }
    }
}

__device__ __forceinline__ int vblock() { const int G = gridDim.x, bx = blockIdx.x; return (G % 8 == 0) ? (bx % 8) * (G / 8) + bx / 8 : bx; }
struct ALoadPlain {
    const bf16_t* A; size_t lda;
    __device__ __forceinline__ const bf16_t* ptr(int r, int k) const { return A + (size_t)r * lda + k; }
};
struct ALoadGroup {
    const bf16_t* A;
    __device__ __forceinline__ const bf16_t* ptr(int r, int k) const { return A + ((size_t)(k >> 4) * T + r) * 16 + (k & 15); }
};

template <class AL>
__device__ __forceinline__ void gemm_tile(const AL al, const bf16_t* __restrict__ Bt, size_t ldb, int nk, f32x4 (&acc)[4][4], unsigned char* lds) {
    const int tid = threadIdx.x, lane = tid & 63, wid = tid >> 6, wr = wid >> 1, wc = wid & 1, fr = lane & 15, fq = lane >> 4;
    const int lr = tid >> 3, lc = tid & 7;
#pragma unroll
    for (int mi = 0; mi < 4; ++mi)
#pragma unroll
        for (int ni = 0; ni < 4; ++ni) acc[mi][ni] = (f32x4){0.f, 0.f, 0.f, 0.f};
    u32x4 ra[4], rb[4];
    const int soff = lr * 128 + ((lc ^ (lr & 7)) << 4);
#pragma unroll
    for (int i = 0; i < 4; ++i) { ra[i] = *(const u32x4*)al.ptr(lr + 32 * i, lc * 8); rb[i] = *(const u32x4*)(Bt + (size_t)(lr + 32 * i) * ldb + lc * 8); }
#pragma unroll
    for (int i = 0; i < 4; ++i) { *(u32x4*)(lds + soff + i * 4096) = ra[i]; *(u32x4*)(lds + 16384 + soff + i * 4096) = rb[i]; }
    __syncthreads();
    const int aoff = (wr * 64 + fr) * 128, boff = 16384 + (wc * 64 + fr) * 128, sw = fr & 7;
    for (int kt = 0; kt < nk; ++kt) {
        const bool more = (kt + 1 < nk);
        if (more) {
#pragma unroll
            for (int i = 0; i < 4; ++i) { ra[i] = *(const u32x4*)al.ptr(lr + 32 * i, (kt + 1) * 64 + lc * 8); rb[i] = *(const u32x4*)(Bt + (size_t)(lr + 32 * i) * ldb + (kt + 1) * 64 + lc * 8); }
        }
        const unsigned char* buf = lds + (kt & 1) * 32768;
#pragma unroll
        for (int ks = 0; ks < 2; ++ks) {
            bf16x8 af[4], bfr[4];
            const int co = ((ks * 4 + fq) ^ sw) << 4;
#pragma unroll
            for (int mi = 0; mi < 4; ++mi) af[mi] = *(const bf16x8*)(buf + aoff + mi * 2048 + co);
#pragma unroll
            for (int ni = 0; ni < 4; ++ni) bfr[ni] = *(const bf16x8*)(buf + boff + ni * 2048 + co);
#pragma unroll
            for (int mi = 0; mi < 4; ++mi)
#pragma unroll
                for (int ni = 0; ni < 4; ++ni) acc[mi][ni] = __builtin_amdgcn_mfma_f32_16x16x32_bf16(bfr[ni], af[mi], acc[mi][ni], 0, 0, 0);
        }
        if (more) {
            unsigned char* nb = lds + ((kt + 1) & 1) * 32768;
#pragma unroll
            for (int i = 0; i < 4; ++i) { *(u32x4*)(nb + soff + i * 4096) = ra[i]; *(u32x4*)(nb + 16384 + soff + i * 4096) = rb[i]; }
        }
        __syncthreads();
    }
}
__device__ __forceinline__ void phase_s5_win(const Params& p, unsigned char* lds) {
    const bf16_t* HM = (const bf16_t*)(p.ws + WS_HM); const bf16_t* WT = (const bf16_t*)(p.ws + WS_WIN_T);
    bf16_t* UG = (bf16_t*)(p.ws + WS_UG);
    const int lane = threadIdx.x & 63, wid = threadIdx.x >> 6, wr = wid >> 1, wc = wid & 1, fr = lane & 15, fq = lane >> 4;
    for (int id = vblock(); id < 256 * 8; id += gridDim.x) {
        const int mt = id >> 3, nt = id & 7;
        f32x4 acc[4][4];
        gemm_tile(ALoadPlain{HM + (size_t)mt * 128 * D, (size_t)D}, WT + (size_t)nt * 128 * D, D, 16, acc, lds);
#pragma unroll
        for (int mi = 0; mi < 4; ++mi)
#pragma unroll
            for (int ni = 0; ni < 4; ++ni) {
                const int t = mt * 128 + wr * 64 + mi * 16 + fr, g = nt * 8 + wc * 4 + ni;
                const f32x4 v = acc[mi][ni];
                *(u32x2*)(UG + ((size_t)g * T + t) * 16 + fq * 4) = (u32x2){pk2(v.x, v.y), pk2(v.z, v.w)};
            }
    }
}
__device__ __forceinline__ void phase_s5_a(const Params& p, unsigned char* lds) {
    const bf16_t* UG = (const bf16_t*)(p.ws + WS_UG); const bf16_t* TW = (const bf16_t*)(p.ws + WS_TW);
    bf16_t* YI = (bf16_t*)(p.ws + WS_YI); float* WST = (float*)(p.ws + WS_WST);
    const int lane = threadIdx.x & 63, wid = threadIdx.x >> 6, wr = wid >> 1, wc = wid & 1, fr = lane & 15, fq = lane >> 4;
    for (int id = vblock(); id < 64 * 40; id += gridDim.x) {
        const int g = id / 40, rem = id % 40, mt = rem / 5, nt = rem % 5;
        const int nk = (nt < 4) ? 2 * (nt + 1) : 8;
        f32x4 acc[4][4];
        gemm_tile(ALoadPlain{UG + (size_t)g * T * 16 + (size_t)mt * 128 * 512, (size_t)512}, TW + ((size_t)g * 640 + nt * 128) * 512, 512, nk, acc, lds);
#pragma unroll
        for (int mi = 0; mi < 4; ++mi)
#pragma unroll
            for (int ni = 0; ni < 4; ++ni) {
                const int R = mt * 128 + wr * 64 + mi * 16 + fr, c = wc * 64 + ni * 16 + fq * 4;
                const f32x4 v = acc[mi][ni];
                if (nt < 4) *(u32x2*)(YI + ((size_t)g * 1024 + R) * 512 + nt * 128 + c) = (u32x2){pk2(v.x, v.y), pk2(v.z, v.w)};
                else *(f32x4*)(WST + ((size_t)g * 1024 + R) * 128 + c) = v;
            }
    }
}
__device__ __forceinline__ void phase_s5_scan(const Params& p) {
    const int lane = threadIdx.x & 63, wave = threadIdx.x >> 6;
    const float* WST = (const float*)(p.ws + WS_WST); bf16_t* SST = (bf16_t*)(p.ws + WS_SST);
    const f32x2* AL = (const f32x2*)(p.ws + WS_MISC + 4096);
    for (int it = blockIdx.x * 4 + wave; it < 128; it += gridDim.x * 4) {
        const int b = it >> 6, g = it & 63;
        const f32x2 al = AL[g * 64 + lane];
        float sr = 0.f, si = 0.f;
        const float* wbase = WST + ((size_t)g * 1024 + b * 512) * 128 + lane;
        bf16_t* sbase = SST + ((size_t)g * 1024 + b * 512) * 128 + lane;
        for (int n0 = 0; n0 < 512; n0 += 16) {
            float wre[16], wim[16];
#pragma unroll
            for (int j = 0; j < 16; ++j) { wre[j] = wbase[(size_t)(n0 + j) * 128]; wim[j] = wbase[(size_t)(n0 + j) * 128 + 64]; }
#pragma unroll
            for (int j = 0; j < 16; ++j) {
                sbase[(size_t)(n0 + j) * 128] = (bf16_t)f2bf(sr); sbase[(size_t)(n0 + j) * 128 + 64] = (bf16_t)f2bf(si);
                const float nr = al.x * sr - al.y * si + wre[j], ni = al.x * si + al.y * sr + wim[j];
                sr = nr; si = ni;
            }
        }
    }
}
__device__ __forceinline__ void phase_s5_b(const Params& p, unsigned char* lds) {
    const bf16_t* SST = (const bf16_t*)(p.ws + WS_SST); const bf16_t* VG = (const bf16_t*)(p.ws + WS_VG);
    const bf16_t* YI = (const bf16_t*)(p.ws + WS_YI); const bf16_t* UG = (const bf16_t*)(p.ws + WS_UG);
    bf16_t* YG = (bf16_t*)(p.ws + WS_YG);
    const float* dsk = p.in[14];
    const int lane = threadIdx.x & 63, wid = threadIdx.x >> 6, wr = wid >> 1, wc = wid & 1, fr = lane & 15, fq = lane >> 4;
    for (int id = vblock(); id < 64 * 32; id += gridDim.x) {
        const int g = id >> 5, mt = (id >> 2) & 7, nt = id & 3;
        f32x4 acc[4][4];
        gemm_tile(ALoadPlain{SST + ((size_t)g * 1024 + mt * 128) * 128, (size_t)128}, VG + ((size_t)g * 512 + nt * 128) * 128, 128, 2, acc, lds);
        const f32x4 dv = *(const f32x4*)(dsk + g * 16 + fq * 4);
#pragma unroll
        for (int mi = 0; mi < 4; ++mi)
#pragma unroll
            for (int ni = 0; ni < 4; ++ni) {
                const int R = mt * 128 + wr * 64 + mi * 16 + fr, c = nt * 128 + wc * 64 + ni * 16 + fq * 4;
                const size_t idx = ((size_t)g * 1024 + R) * 512 + c;
                const u32x2 yi = *(const u32x2*)(YI + idx), uu = *(const u32x2*)(UG + idx);
                const f32x4 v = acc[mi][ni];
                const float y0 = gelu_tanh(v.x + bflo(yi.x) + dv.x * bflo(uu.x)), y1 = gelu_tanh(v.y + bfhi(yi.x) + dv.y * bfhi(uu.x));
                const float y2 = gelu_tanh(v.z + bflo(yi.y) + dv.z * bflo(uu.y)), y3 = gelu_tanh(v.w + bfhi(yi.y) + dv.w * bfhi(uu.y));
                *(u32x2*)(YG + idx) = (u32x2){pk2(y0, y1), pk2(y2, y3)};
            }
    }
}
__device__ __forceinline__ void phase_s5_glu(const Params& p, unsigned char* lds) {
    const bf16_t* YG = (const bf16_t*)(p.ws + WS_YG); const bf16_t* WT = (const bf16_t*)(p.ws + WS_WGLU_T);
    const float* MOD = (const float*)(p.ws + WS_MOD);
    const float* X = p.in[0]; float* XO = p.out;
    const int lane = threadIdx.x & 63, wid = threadIdx.x >> 6, wr = wid >> 1, wc = wid & 1, fr = lane & 15, fq = lane >> 4;
    for (int id = vblock(); id < 256 * 16; id += gridDim.x) {
        const int mt = id >> 4, nt = id & 15;
        f32x4 acc[4][4];
        gemm_tile(ALoadGroup{YG + (size_t)mt * 128 * 16}, WT + (size_t)nt * 128 * D, D, 16, acc, lds);
        const int b = (mt * 128) / SEQ;
#pragma unroll
        for (int mi = 0; mi < 4; ++mi)
#pragma unroll
            for (int h = 0; h < 2; ++h) {
                const int t = mt * 128 + wr * 64 + mi * 16 + fr, j = nt * 64 + wc * 32 + h * 16 + fq * 4;
                const f32x4 a = acc[mi][2 * h], gg = acc[mi][2 * h + 1];
                const f32x4 g1 = *(const f32x4*)(MOD + (size_t)(0 * 2 + b) * 6144 + 2048 + j);
                const f32x4 xi = *(const f32x4*)(X + (size_t)t * D + j);
                f32x4 o;
                o.x = xi.x + g1.x * (a.x * sigmoidf_(gg.x)); o.y = xi.y + g1.y * (a.y * sigmoidf_(gg.y));
                o.z = xi.z + g1.z * (a.z * sigmoidf_(gg.z)); o.w = xi.w + g1.w * (a.w * sigmoidf_(gg.w));
                *(f32x4*)(XO + (size_t)t * D + j) = o;
            }
    }
}
__device__ __forceinline__ void phase_peer_wq(const Params& p, int layer, unsigned char* lds) {
    const bf16_t* HM = (const bf16_t*)(p.ws + WS_HM); const bf16_t* WT = (const bf16_t*)(p.ws + WS_WQ_T) + (size_t)layer * 2048 * 1024;
    bf16_t* QK = (bf16_t*)(p.ws + WS_QK);
    const int lane = threadIdx.x & 63, wid = threadIdx.x >> 6, wr = wid >> 1, wc = wid & 1, fr = lane & 15, fq = lane >> 4;
    for (int id = vblock(); id < 256 * 16; id += gridDim.x) {
        const int mt = id >> 4, nt = id & 15;
        f32x4 acc[4][4];
        gemm_tile(ALoadPlain{HM + (size_t)mt * 128 * D, (size_t)D}, WT + (size_t)nt * 128 * D, D, 16, acc, lds);
#pragma unroll
        for (int mi = 0; mi < 4; ++mi)
#pragma unroll
            for (int ni = 0; ni < 4; ++ni) {
                const int t = mt * 128 + wr * 64 + mi * 16 + fr, c = nt * 128 + wc * 64 + ni * 16 + fq * 4;
                const f32x4 v = acc[mi][ni];
                *(u32x2*)(QK + (size_t)t * 2048 + c) = (u32x2){pk2(v.x, v.y), pk2(v.z, v.w)};
            }
    }
}
__device__ __forceinline__ void ce_(unsigned& a, unsigned& b, const bool up) { const unsigned lo = a < b ? a : b, hi = a < b ? b : a; a = up ? lo : hi; b = up ? hi : lo; }
__device__ __forceinline__ void bitonic_sort16(unsigned* x, const bool asc) {
#pragma unroll
    for (int k = 2; k <= 16; k <<= 1)
#pragma unroll
        for (int j = k >> 1; j > 0; j >>= 1)
#pragma unroll
            for (int i = 0; i < 16; ++i) { const int l = i ^ j; if (l > i) ce_(x[i], x[l], ((i & k) == 0) == asc); }
}
__device__ __forceinline__ void bitonic_merge16(unsigned* x, const bool asc) {
#pragma unroll
    for (int j = 8; j > 0; j >>= 1)
#pragma unroll
        for (int i = 0; i < 16; ++i) { const int l = i ^ j; if (l > i) ce_(x[i], x[l], asc); }
}
__device__ __forceinline__ void phase_peer_topk(const Params& p, int layer, unsigned char* lds) {
    const bf16_t* QK = (const bf16_t*)(p.ws + WS_QK); const bf16_t* SK = (const bf16_t*)(p.ws + WS_SUBK) + (size_t)layer * 8 * 2 * 128 * 128;
    float* TOPS = (float*)(p.ws + WS_TOPS); int* TOPI = (int*)(p.ws + WS_TOPI);
    float* sc = (float*)lds;
    const int tid = threadIdx.x, lane = tid & 63, wid = tid >> 6, wr = wid >> 1, wc = wid & 1, fr = lane & 15, fq = lane >> 4;
    for (int id = vblock(); id < 256 * 16; id += gridDim.x) {
        const int mt = id >> 4, hc = id & 15;
        f32x4 acc[4][4];
        gemm_tile(ALoadPlain{QK + (size_t)mt * 128 * 2048 + hc * 128, (size_t)2048}, SK + (size_t)hc * 128 * 128, 128, 2, acc, lds);
#pragma unroll
        for (int mi = 0; mi < 4; ++mi)
#pragma unroll
            for (int ni = 0; ni < 4; ++ni) {
                const int r = wr * 64 + mi * 16 + fr, c = wc * 64 + ni * 16 + fq * 4;
                float* d = sc + r * 129 + c;
                d[0] = acc[mi][ni].x; d[1] = acc[mi][ni].y; d[2] = acc[mi][ni].z; d[3] = acc[mi][ni].w;
            }
        __syncthreads();
        {
            const int row = tid >> 1, half = tid & 1;
            unsigned x[64];
            const float* rp = sc + row * 129 + half * 64;
#pragma unroll
            for (int j = 0; j < 64; ++j) {
                const unsigned bits = __builtin_bit_cast(unsigned, rp[j]);
                const unsigned u = bits ^ ((unsigned)((int)bits >> 31) | 0x80000000u);
                x[j] = (u & 0xFFFFFF80u) | (unsigned)(127 - (half * 64 + j));
            }
            bitonic_sort16(x, true); bitonic_sort16(x + 16, false); bitonic_sort16(x + 32, true); bitonic_sort16(x + 48, false);
#pragma unroll
            for (int i = 0; i < 16; ++i) { x[i] = x[i] > x[16 + i] ? x[i] : x[16 + i]; x[32 + i] = x[32 + i] > x[48 + i] ? x[32 + i] : x[48 + i]; }
            bitonic_merge16(x, true); bitonic_merge16(x + 32, false);
#pragma unroll
            for (int i = 0; i < 16; ++i) x[i] = x[i] > x[32 + i] ? x[i] : x[32 + i];
            bitonic_merge16(x, false);
            unsigned y[16];
#pragma unroll
            for (int i = 0; i < 16; ++i) { const unsigned o = (unsigned)__shfl_xor((int)x[15 - i], 1); y[i] = x[i] > o ? x[i] : o; }
            bitonic_merge16(y, false);
            const size_t ob = ((size_t)(mt * 128 + row) * 16 + hc) * 16;
            if (half == 0) {
                float v[16];
#pragma unroll
                for (int i = 0; i < 16; ++i) { const unsigned u = y[i] & 0xFFFFFF80u; const unsigned bits = (u & 0x80000000u) ? (u ^ 0x80000000u) : ~u; v[i] = __builtin_bit_cast(float, bits); }
#pragma unroll
                for (int q = 0; q < 4; ++q) *(f32x4*)(TOPS + ob + q * 4) = (f32x4){v[q * 4], v[q * 4 + 1], v[q * 4 + 2], v[q * 4 + 3]};
            } else {
#pragma unroll
                for (int q = 0; q < 4; ++q) *(u32x4*)(TOPI + ob + q * 4) = (u32x4){127u - (y[q * 4] & 127u), 127u - (y[q * 4 + 1] & 127u), 127u - (y[q * 4 + 2] & 127u), 127u - (y[q * 4 + 3] & 127u)};
            }
        }
        __syncthreads();
    }
}
__device__ __forceinline__ void phase_peer_combine(const Params& p, unsigned char* lds) {
    const float* TOPS = (const float*)(p.ws + WS_TOPS); const int* TOPI = (const int*)(p.ws + WS_TOPI);
    int* EXP = (int*)(p.ws + WS_EXP); float* GATE = (float*)(p.ws + WS_GATE);
    unsigned* L = (unsigned*)lds;
    const int tid = threadIdx.x;
    for (int it = blockIdx.x; it < (T * 8) / 256; it += gridDim.x) {
        const size_t th = (size_t)it * 256 + tid;
        const u32x4* S4 = (const u32x4*)(TOPS + th * 32); const u32x4* I4 = (const u32x4*)(TOPI + th * 32);
#pragma unroll
        for (int a4 = 0; a4 < 8; ++a4) {
            const u32x4 s = S4[a4], i = I4[a4];
            L[(a4 * 4 + 0) * 256 + tid] = s.x; L[(a4 * 4 + 1) * 256 + tid] = s.y; L[(a4 * 4 + 2) * 256 + tid] = s.z; L[(a4 * 4 + 3) * 256 + tid] = s.w;
            L[(32 + a4 * 4 + 0) * 256 + tid] = i.x; L[(32 + a4 * 4 + 1) * 256 + tid] = i.y; L[(32 + a4 * 4 + 2) * 256 + tid] = i.z; L[(32 + a4 * 4 + 3) * 256 + tid] = i.w;
        }
        float val[16];
        const float s20 = __builtin_bit_cast(float, L[16 * 256 + tid]);
#pragma unroll
        for (int a = 0; a < 16; ++a) val[a] = __builtin_bit_cast(float, L[a * 256 + tid]) + s20;
        unsigned long long P = 0ull;
        float ts[16]; int te[16];
#pragma unroll
        for (int r = 0; r < 16; ++r) {
            float best = val[0]; int ba = 0;
#pragma unroll
            for (int a = 1; a < 16; ++a) if (val[a] > best) { best = val[a]; ba = a; }
            const int b = (int)((P >> (4 * ba)) & 15ull);
            const int i1 = (int)L[(32 + ba) * 256 + tid], i2 = (int)L[(48 + b) * 256 + tid];
            ts[r] = best; te[r] = i1 * 128 + i2;
            const int nb = b + 1;
            float newv = -3.0e38f;
            if (nb < 16) { newv = __builtin_bit_cast(float, L[ba * 256 + tid]) + __builtin_bit_cast(float, L[(16 + nb) * 256 + tid]); P += 1ull << (4 * ba); }
#pragma unroll
            for (int a = 0; a < 16; ++a) val[a] = (a == ba) ? newv : val[a];
        }
        const float m0 = ts[0];
        float sum = 0.f;
#pragma unroll
        for (int r = 0; r < 16; ++r) { ts[r] = __expf(ts[r] - m0); sum += ts[r]; }
        const float inv = 1.0f / sum;
#pragma unroll
        for (int r = 0; r < 16; ++r) ts[r] *= inv;
#pragma unroll
        for (int r = 0; r < 16; ++r) { EXP[th * 16 + r] = te[r]; GATE[th * 16 + r] = ts[r]; }
    }
}

__device__ __forceinline__ void fma8(const unsigned w0, const unsigned w1, const float a, float* acc) {
    const f32x2 p0 = __builtin_amdgcn_cvt_pk_f32_fp8((int)w0, false), p1 = __builtin_amdgcn_cvt_pk_f32_fp8((int)w0, true);
    const f32x2 p2 = __builtin_amdgcn_cvt_pk_f32_fp8((int)w1, false), p3 = __builtin_amdgcn_cvt_pk_f32_fp8((int)w1, true);
    acc[0] += a * p0.x; acc[1] += a * p0.y; acc[2] += a * p1.x; acc[3] += a * p1.y;
    acc[4] += a * p2.x; acc[5] += a * p2.y; acc[6] += a * p3.x; acc[7] += a * p3.y;
}
__device__ __forceinline__ float dot8(const unsigned w0, const unsigned w1, const float* h, float s) {
    const f32x2 p0 = __builtin_amdgcn_cvt_pk_f32_fp8((int)w0, false), p1 = __builtin_amdgcn_cvt_pk_f32_fp8((int)w0, true);
    const f32x2 p2 = __builtin_amdgcn_cvt_pk_f32_fp8((int)w1, false), p3 = __builtin_amdgcn_cvt_pk_f32_fp8((int)w1, true);
    s += p0.x * h[0]; s += p0.y * h[1]; s += p1.x * h[2]; s += p1.y * h[3];
    s += p2.x * h[4]; s += p2.y * h[5]; s += p3.x * h[6]; s += p3.y * h[7];
    return s;
}
__device__ __forceinline__ void phase_peer_apply(const Params& p, int layer, unsigned char* lds, bool dry) {
    const int lane = threadIdx.x & 63, wave = threadIdx.x >> 6;
    float* ldsw = (float*)lds + wave * (64 * 65);
    const bf16_t* HM = (const bf16_t*)(p.ws + WS_HM);
    const unsigned char* PU = p.ws + WS_PU; const unsigned char* PV = p.ws + WS_PV;
    const float* SU = (const float*)(p.ws + WS_PU + 24 * MiB); const float* SV = (const float*)(p.ws + WS_PV + 24 * MiB);
    const int* EXP = (const int*)(p.ws + WS_EXP); const float* GATE = (const float*)(p.ws + WS_GATE);
    const float* MOD = (const float*)(p.ws + WS_MOD);
    float* X = p.out;
    for (int t = blockIdx.x * 4 + wave; t < T; t += gridDim.x * 4) {
        const u32x4 ha = *(const u32x4*)(HM + (size_t)t * D + lane * 16), hb = *(const u32x4*)(HM + (size_t)t * D + lane * 16 + 8);
        float hf[16];
        hf[0] = bflo(ha.x); hf[1] = bfhi(ha.x); hf[2] = bflo(ha.y); hf[3] = bfhi(ha.y); hf[4] = bflo(ha.z); hf[5] = bfhi(ha.z); hf[6] = bflo(ha.w); hf[7] = bfhi(ha.w);
        hf[8] = bflo(hb.x); hf[9] = bfhi(hb.x); hf[10] = bflo(hb.y); hf[11] = bfhi(hb.y); hf[12] = bflo(hb.z); hf[13] = bfhi(hb.z); hf[14] = bflo(hb.w); hf[15] = bfhi(hb.w);
        const int e0 = EXP[(size_t)t * 128 + lane], e1 = EXP[(size_t)t * 128 + 64 + lane];
        const float g0 = GATE[(size_t)t * 128 + lane], g1 = GATE[(size_t)t * 128 + 64 + lane];
        const float su0 = SU[e0], su1 = SU[e1], sv0 = SV[e0], sv1 = SV[e1];
        float act0 = 0.f, act1 = 0.f;
#pragma unroll
        for (int half = 0; half < 2; ++half) {
            const int ev = half ? e1 : e0;
#pragma unroll 1
            for (int jg = 0; jg < 4; ++jg) {
                u32x4 ua[16];
#pragma unroll
                for (int j = 0; j < 16; ++j) {
                    const int e = __builtin_amdgcn_readlane(ev, jg * 16 + j);
                    ua[j] = *(const u32x4*)(PU + (size_t)e * D + lane * 16);
                }
#pragma unroll
                for (int j = 0; j < 16; ++j) {
                    float s = dot8(ua[j].x, ua[j].y, hf, 0.f);
                    s = dot8(ua[j].z, ua[j].w, hf + 8, s);
                    ldsw[(jg * 16 + j) * 65 + lane] = s;
                }
            }
            float tot = 0.f;
#pragma unroll 16
            for (int k = 0; k < 64; ++k) tot += ldsw[lane * 65 + k];
            const float a = gelu_tanh(tot * (half ? su1 : su0)) * (half ? g1 : g0) * (half ? sv1 : sv0);
            if (half) act1 = a; else act0 = a;
        }
        float acc[16];
#pragma unroll
        for (int i = 0; i < 16; ++i) acc[i] = 0.f;
#pragma unroll
        for (int half = 0; half < 2; ++half) {
            const int ev = half ? e1 : e0; const float av = half ? act1 : act0;
#pragma unroll 1
            for (int jg = 0; jg < 4; ++jg) {
                u32x4 va[16];
#pragma unroll
                for (int j = 0; j < 16; ++j) {
                    const int e = __builtin_amdgcn_readlane(ev, jg * 16 + j);
                    va[j] = *(const u32x4*)(PV + (size_t)e * D + lane * 16);
                }
#pragma unroll
                for (int j = 0; j < 16; ++j) {
                    const float a = __builtin_bit_cast(float, __builtin_amdgcn_readlane(__builtin_bit_cast(int, av), jg * 16 + j));
                    fma8(va[j].x, va[j].y, a, acc);
                    fma8(va[j].z, va[j].w, a, acc + 8);
                }
            }
        }
        const int b = t / SEQ;
        const float* g2 = MOD + (size_t)(layer * 2 + b) * 6144 + 5120;
        float* xr = X + (size_t)t * D + lane * 16;
#pragma unroll
        for (int q = 0; q < 4; ++q) {
            const f32x4 g = *(const f32x4*)(g2 + lane * 16 + q * 4); f32x4 x = *(const f32x4*)(xr + q * 4);
            x.x += g.x * acc[q * 4 + 0]; x.y += g.y * acc[q * 4 + 1]; x.z += g.z * acc[q * 4 + 2]; x.w += g.w * acc[q * 4 + 3];
            if (!dry) *(f32x4*)(xr + q * 4) = x;
        }
    }
}
__device__ __forceinline__ void phase_tab1(const Params& p) {
    for (int it = blockIdx.x; it < 2 * P0_TAB; it += gridDim.x) {
        if (it < P0_TAB) cvt_fp8_item(p.in[26] + (size_t)PE * D, p.ws + WS_PU, (float*)(p.ws + WS_PU + 24 * MiB), it);
        else cvt_fp8_item(p.in[27] + (size_t)PE * D, p.ws + WS_PV, (float*)(p.ws + WS_PV + 24 * MiB), it - P0_TAB);
    }
}
__device__ __forceinline__ void phase_nsa_proj(const Params& p, unsigned char* lds) {
    const bf16_t* HM = (const bf16_t*)(p.ws + WS_HM); const bf16_t* WT = (const bf16_t*)(p.ws + WS_WPROJ_T);
    const f32x2* ROPE = (const f32x2*)(p.ws + WS_ROPE);
    bf16_t* Q = (bf16_t*)(p.ws + WS_Q); float* NGT = (float*)(p.ws + WS_NG);
    const int lane = threadIdx.x & 63, wid = threadIdx.x >> 6, wr = wid >> 1, wc = wid & 1, fr = lane & 15, fq = lane >> 4;
    for (int id = vblock(); id < 256 * 21; id += gridDim.x) {
        const int mt = id / 21, nt = id % 21;
        f32x4 acc[4][4];
        gemm_tile(ALoadPlain{HM + (size_t)mt * 128 * D, (size_t)D}, WT + (size_t)nt * 128 * D, D, 16, acc, lds);
        const int c0 = nt * 128 + wc * 64;
        if (c0 >= 2624) continue;
        const int b = (mt * 128) / SEQ;
        if (c0 == 2560) {
#pragma unroll
            for (int mi = 0; mi < 4; ++mi)
#pragma unroll
                for (int ni = 0; ni < 3; ++ni) {
                    const int t = mt * 128 + wr * 64 + mi * 16 + fr;
                    const f32x4 v = acc[mi][ni];
                    *(f32x4*)(NGT + (size_t)t * 48 + ni * 16 + fq * 4) = (f32x4){sigmoidf_(v.x), sigmoidf_(v.y), sigmoidf_(v.z), sigmoidf_(v.w)};
                }
            continue;
        }
        int sec = -1, g = 0;
        if (c0 >= 1024) { sec = (c0 - 1024) >> 8; g = ((c0 - 1024) & 255) >> 6; }
        const bool dorope = (sec == -1) || (sec == 2) || (sec == 4);
        const float scl = (sec == -1) ? 0.125f : 1.0f;
        const size_t secoff[6] = {WS_KC, WS_VC, WS_KS, WS_VST, WS_KW, WS_VWT};
        size_t so = WS_Q;
#pragma unroll
        for (int q = 0; q < 6; ++q) if (sec == q) so = secoff[q];
        bf16_t* OUT = (bf16_t*)(p.ws + so);
        const bool vt = (sec == 3) || (sec == 5);
#pragma unroll
        for (int mi = 0; mi < 4; ++mi) {
            const int t = mt * 128 + wr * 64 + mi * 16 + fr, s = t - b * SEQ;
            if (dorope) {
#pragma unroll
                for (int ni = 0; ni < 2; ++ni) {
                    const f32x4* rp = (const f32x4*)(ROPE + (size_t)s * 32 + ni * 16 + fq * 4);
                    const f32x4 r0 = rp[0], r1 = rp[1];
                    const f32x4 x1 = acc[mi][ni], x2 = acc[mi][ni + 2];
                    acc[mi][ni] = (f32x4){x1.x * r0.x - x2.x * r0.y, x1.y * r0.z - x2.y * r0.w, x1.z * r1.x - x2.z * r1.y, x1.w * r1.z - x2.w * r1.w};
                    acc[mi][ni + 2] = (f32x4){x1.x * r0.y + x2.x * r0.x, x1.y * r0.w + x2.y * r0.z, x1.z * r1.y + x2.z * r1.x, x1.w * r1.w + x2.w * r1.z};
                }
            }
            if (sec == -1 || sec == 2) {
                float am = 0.f;
#pragma unroll
                for (int ni = 0; ni < 4; ++ni) { const f32x4 v = acc[mi][ni] * scl; am = fmaxf(am, fmaxf(fmaxf(fabsf(v.x), fabsf(v.y)), fmaxf(fabsf(v.z), fabsf(v.w)))); }
                am = fmaxf(am, __shfl_xor(am, 16)); am = fmaxf(am, __shfl_xor(am, 32));
                const float qs = am > 0.f ? 224.0f / am : 1.0f;
                unsigned char* O8 = (sec == -1) ? (p.ws + WS_Q8 + (size_t)t * 1024 + c0) : (p.ws + WS_KS + ((size_t)(b * 4 + g) * SEQ + s) * 64);
#pragma unroll
                for (int ni = 0; ni < 4; ++ni) {
                    const f32x4 v = acc[mi][ni] * (scl * qs);
                    int w = 0; w = __builtin_amdgcn_cvt_pk_fp8_f32(v.x, v.y, w, false); w = __builtin_amdgcn_cvt_pk_fp8_f32(v.z, v.w, w, true);
                    *(int*)(O8 + ni * 16 + fq * 4) = w;
                }
                if (fq == 0) {
                    const float inv = am > 0.f ? am / 224.0f : 1.0f;
                    if (sec == -1) ((float*)(p.ws + WS_Q8 + 32 * MiB))[(size_t)t * 16 + (c0 >> 6)] = inv;
                    else ((float*)(p.ws + WS_KS + 12 * MiB))[(size_t)(b * 4 + g) * SEQ + s] = inv;
                }
            }
            if (sec == 2) continue;
#pragma unroll
            for (int ni = 0; ni < 4; ++ni) {
                const f32x4 v = acc[mi][ni] * scl;
                const int d = ni * 16 + fq * 4;
                if (sec == -1) {
                    *(u32x2*)(OUT + (size_t)t * 1024 + c0 + d) = (u32x2){pk2(v.x, v.y), pk2(v.z, v.w)};
                } else if (!vt) {
                    *(u32x2*)(OUT + ((size_t)(b * 4 + g) * SEQ + s) * 64 + d) = (u32x2){pk2(v.x, v.y), pk2(v.z, v.w)};
                } else if (sec == 5) {
                    bf16_t* o = OUT + ((size_t)(b * 4 + g) * 64 + d) * SEQ + s;
                    o[0] = (bf16_t)f2bf(v.x); o[SEQ] = (bf16_t)f2bf(v.y); o[2 * SEQ] = (bf16_t)f2bf(v.z); o[3 * SEQ] = (bf16_t)f2bf(v.w);
                }
            }
        }
        if (sec == 3) {
            const int s0 = mt * 128 + wr * 64 - b * SEQ, jb = s0 >> 6;
            unsigned char* V8 = p.ws + WS_VST + (size_t)((b * 4 + g) * 256 + jb) * 4096;
            float* SV = (float*)(p.ws + WS_VST + 12 * MiB) + (size_t)((b * 4 + g) * 256 + jb) * 64;
#pragma unroll
            for (int ni = 0; ni < 4; ++ni) {
                f32x4 am = (f32x4){0.f, 0.f, 0.f, 0.f};
#pragma unroll
                for (int mi = 0; mi < 4; ++mi) { const f32x4 v = acc[mi][ni]; am.x = fmaxf(am.x, fabsf(v.x)); am.y = fmaxf(am.y, fabsf(v.y)); am.z = fmaxf(am.z, fabsf(v.z)); am.w = fmaxf(am.w, fabsf(v.w)); }
#pragma unroll
                for (int o = 1; o < 16; o <<= 1) { am.x = fmaxf(am.x, __shfl_xor(am.x, o)); am.y = fmaxf(am.y, __shfl_xor(am.y, o)); am.z = fmaxf(am.z, __shfl_xor(am.z, o)); am.w = fmaxf(am.w, __shfl_xor(am.w, o)); }
                const f32x4 qs = (f32x4){am.x > 0.f ? 224.0f / am.x : 1.0f, am.y > 0.f ? 224.0f / am.y : 1.0f, am.z > 0.f ? 224.0f / am.z : 1.0f, am.w > 0.f ? 224.0f / am.w : 1.0f};
                const int d = ni * 16 + fq * 4;
                if (fr == 0) *(f32x4*)(SV + d) = (f32x4){am.x > 0.f ? am.x / 224.0f : 1.0f, am.y > 0.f ? am.y / 224.0f : 1.0f, am.z > 0.f ? am.z / 224.0f : 1.0f, am.w > 0.f ? am.w / 224.0f : 1.0f};
#pragma unroll
                for (int mi = 0; mi < 4; ++mi) {
                    const f32x4 v = acc[mi][ni] * qs;
                    int w = 0; w = __builtin_amdgcn_cvt_pk_fp8_f32(v.x, v.y, w, false); w = __builtin_amdgcn_cvt_pk_fp8_f32(v.z, v.w, w, true);
                    unsigned char* o = V8 + (size_t)d * 64 + mi * 16 + fr;
                    o[0] = (unsigned char)(w & 255); o[64] = (unsigned char)((w >> 8) & 255); o[128] = (unsigned char)((w >> 16) & 255); o[192] = (unsigned char)((unsigned)w >> 24);
                }
            }
        }
    }
}
__device__ __forceinline__ void phase_nsa_cmp1(const Params& p, unsigned char* lds) {
    bf16_t* HID = (bf16_t*)(p.ws + WS_HID);
    const float* bias = (const float*)(p.ws + WS_MISC);
    const int lane = threadIdx.x & 63, wid = threadIdx.x >> 6, wr = wid >> 1, wc = wid & 1, fr = lane & 15, fq = lane >> 4;
    for (int id = vblock(); id < 256; id += gridDim.x) {
        const int kv = id >> 7, bg = (id >> 4) & 7, mt = (id >> 1) & 7, nt = id & 1;
        const bf16_t* A = (const bf16_t*)(p.ws + (kv ? WS_VC : WS_KC)) + (size_t)bg * SEQ * 64 + (size_t)mt * 128 * 1024;
        const bf16_t* B = (const bf16_t*)(p.ws + (kv ? WS_WV1_T : WS_WK1_T)) + (size_t)nt * 128 * 2048;
        f32x4 acc[4][4];
        gemm_tile(ALoadPlain{A, (size_t)1024}, B, 2048, 32, acc, lds);
#pragma unroll
        for (int mi = 0; mi < 4; ++mi)
#pragma unroll
            for (int ni = 0; ni < 4; ++ni) {
                const int n = mt * 128 + wr * 64 + mi * 16 + fr, c = nt * 128 + wc * 64 + ni * 16 + fq * 4;
                const f32x4 bv = *(const f32x4*)(bias + kv * 256 + c);
                const f32x4 v = acc[mi][ni] + bv;
                *(u32x2*)(HID + (((size_t)kv * 8 + bg) * 1024 + n) * 256 + c) = (u32x2){pk2(gelu_tanh(v.x), gelu_tanh(v.y)), pk2(gelu_tanh(v.z), gelu_tanh(v.w))};
            }
    }
}
__device__ __forceinline__ void phase_nsa_cmp2(const Params& p, unsigned char* lds) {
    const bf16_t* HID = (const bf16_t*)(p.ws + WS_HID);
    const f32x2* ROPE = (const f32x2*)(p.ws + WS_ROPE);
    bf16_t* KCMP = (bf16_t*)(p.ws + WS_KCMP); bf16_t* VCMPT = (bf16_t*)(p.ws + WS_VCMPT);
    const int lane = threadIdx.x & 63, wid = threadIdx.x >> 6, wr = wid >> 1, wc = wid & 1, fr = lane & 15, fq = lane >> 4;
    for (int id = vblock(); id < 128; id += gridDim.x) {
        const int kv = id >> 6, mt = id & 63;
        const bf16_t* A = HID + ((size_t)kv * 8192 + (size_t)mt * 128) * 256;
        const bf16_t* B = (const bf16_t*)(p.ws + (kv ? WS_WV2_T : WS_WK2_T));
        f32x4 acc[4][4];
        gemm_tile(ALoadPlain{A, (size_t)256}, B, 256, 4, acc, lds);
        if (wc == 1) continue;
#pragma unroll
        for (int mi = 0; mi < 4; ++mi) {
            const int R = mt * 128 + wr * 64 + mi * 16 + fr, bg = R >> 10, n = R & 1023;
            if (kv == 0) {
                int pos = n * 16 + 31; pos = pos > SEQ - 1 ? SEQ - 1 : pos;
#pragma unroll
                for (int ni = 0; ni < 2; ++ni) {
                    const f32x4* rp = (const f32x4*)(ROPE + (size_t)pos * 32 + ni * 16 + fq * 4);
                    const f32x4 r0 = rp[0], r1 = rp[1];
                    const f32x4 x1 = acc[mi][ni], x2 = acc[mi][ni + 2];
                    acc[mi][ni] = (f32x4){x1.x * r0.x - x2.x * r0.y, x1.y * r0.z - x2.y * r0.w, x1.z * r1.x - x2.z * r1.y, x1.w * r1.z - x2.w * r1.w};
                    acc[mi][ni + 2] = (f32x4){x1.x * r0.y + x2.x * r0.x, x1.y * r0.w + x2.y * r0.z, x1.z * r1.y + x2.z * r1.x, x1.w * r1.w + x2.w * r1.z};
                }
#pragma unroll
                for (int ni = 0; ni < 4; ++ni) {
                    const f32x4 v = acc[mi][ni];
                    *(u32x2*)(KCMP + ((size_t)bg * 1024 + n) * 64 + ni * 16 + fq * 4) = (u32x2){pk2(v.x, v.y), pk2(v.z, v.w)};
                }
            } else {
#pragma unroll
                for (int ni = 0; ni < 4; ++ni) {
                    const f32x4 v = acc[mi][ni];
                    bf16_t* o = VCMPT + ((size_t)bg * 64 + ni * 16 + fq * 4) * 1024 + n;
                    o[0] = (bf16_t)f2bf(v.x); o[1024] = (bf16_t)f2bf(v.y); o[2048] = (bf16_t)f2bf(v.z); o[3072] = (bf16_t)f2bf(v.w);
                }
            }
        }
    }
}
__device__ __forceinline__ void phase_nsa_wo(const Params& p, unsigned char* lds, bool dry) {
    const bf16_t* O = (const bf16_t*)(p.ws + WS_O); const bf16_t* WT = (const bf16_t*)(p.ws + WS_WO_T);
    const float* MOD = (const float*)(p.ws + WS_MOD);
    float* X = p.out;
    const int lane = threadIdx.x & 63, wid = threadIdx.x >> 6, wr = wid >> 1, wc = wid & 1, fr = lane & 15, fq = lane >> 4;
    for (int id = vblock(); id < 256 * 8; id += gridDim.x) {
        const int mt = id >> 3, nt = id & 7;
        f32x4 acc[4][4];
        gemm_tile(ALoadPlain{O + (size_t)mt * 128 * D, (size_t)D}, WT + (size_t)nt * 128 * D, D, 16, acc, lds);
        const int b = (mt * 128) / SEQ;
#pragma unroll
        for (int mi = 0; mi < 4; ++mi)
#pragma unroll
            for (int ni = 0; ni < 4; ++ni) {
                const int t = mt * 128 + wr * 64 + mi * 16 + fr, c = nt * 128 + wc * 64 + ni * 16 + fq * 4;
                const f32x4 g1 = *(const f32x4*)(MOD + (size_t)(1 * 2 + b) * 6144 + 2048 + c);
                float* xp = X + (size_t)t * D + c;
                const f32x4 x = *(const f32x4*)xp; const f32x4 v = acc[mi][ni];
                if (!dry) *(f32x4*)xp = (f32x4){x.x + g1.x * v.x, x.y + g1.y * v.y, x.z + g1.z * v.z, x.w + g1.w * v.w};
            }
    }
}
__device__ __forceinline__ bf16x8 pack8(const f32x4 a, const f32x4 b) {
    u32x4 w; w.x = pk2(a.x, a.y); w.y = pk2(a.z, a.w); w.z = pk2(b.x, b.y); w.w = pk2(b.z, b.w);
    return __builtin_bit_cast(bf16x8, w);
}
__device__ __forceinline__ bf16x8 ldv8(const bf16_t* plo, const bf16_t* phi) {
    const u32x2 lo = *(const u32x2*)plo, hi = *(const u32x2*)phi;
    u32x4 w; w.x = lo.x; w.y = lo.y; w.z = hi.x; w.w = hi.y;
    return __builtin_bit_cast(bf16x8, w);
}
__device__ __forceinline__ float red4(float v) { v += __shfl_xor(v, 16); v += __shfl_xor(v, 32); return v; }
__device__ __forceinline__ float max4(float v) { v = fmaxf(v, __shfl_xor(v, 16)); v = fmaxf(v, __shfl_xor(v, 32)); return v; }
#define NEGBIG (-1.0e30f)

__device__ __forceinline__ void phase_nsa_attn(const Params& p, unsigned char* lds, const int rep_cmp, const int rep_win, const int rep_sel) {
    const int lane = threadIdx.x & 63, wave = threadIdx.x >> 6, fr = lane & 15, fq = lane >> 4;
    unsigned char* WL = lds + wave * 18432;
    float* IMP = (float*)WL;
    int* SEL = (int*)(WL + 17408);
    const bf16_t* Q = (const bf16_t*)(p.ws + WS_Q);
    const bf16_t* KCMP = (const bf16_t*)(p.ws + WS_KCMP); const bf16_t* VCMPT = (const bf16_t*)(p.ws + WS_VCMPT);
    const bf16_t* KW = (const bf16_t*)(p.ws + WS_KW); const bf16_t* VWT = (const bf16_t*)(p.ws + WS_VWT);
    const float* NGT = (const float*)(p.ws + WS_NG);
    bf16_t* O = (bf16_t*)(p.ws + WS_O);
    const f32x4 z4 = (f32x4){0.f, 0.f, 0.f, 0.f};
    for (int bi = blockIdx.x; bi < 2048; bi += gridDim.x) {
        const int bg = bi & 7, quad = 255 - (bi >> 3), t0 = (quad * 4 + wave) * 16, b = bg >> 2, g = bg & 3;
        const int cur = t0 >> 6;
        const size_t tok = (size_t)b * SEQ + t0 + fr;
        const int tq = t0 + fr;
        bf16x8 qf[4][2];
#pragma unroll
        for (int r = 0; r < 4; ++r)
#pragma unroll
            for (int ks = 0; ks < 2; ++ks) qf[r][ks] = *(const bf16x8*)(Q + tok * 1024 + (g * 4 + r) * 64 + ks * 32 + fq * 8);
        float gc[4], gw[4];
#pragma unroll
        for (int r = 0; r < 4; ++r) { const float* gp = NGT + tok * 48 + (g * 4 + r) * 3; gc[r] = gp[0]; gw[r] = gp[2]; }
        f32x4 acc[4][4];
        for (int rep = 0; rep < rep_win; ++rep) {
            const bf16_t* kwb = KW + (size_t)bg * SEQ * 64; const bf16_t* vwb = VWT + (size_t)bg * 64 * SEQ;
            float mw[4], lw[4];
#pragma unroll
            for (int r = 0; r < 4; ++r) { mw[r] = NEGBIG; lw[r] = 0.f;
#pragma unroll
                for (int df = 0; df < 4; ++df) acc[r][df] = z4; }
            int kmin = t0 - 511; kmin = kmin < 0 ? 0 : kmin; kmin &= ~31;
            for (int kb = kmin; kb <= t0 + 15; kb += 32) {
                bf16x8 kf[2][2];
#pragma unroll
                for (int f = 0; f < 2; ++f)
#pragma unroll
                    for (int ks = 0; ks < 2; ++ks) kf[f][ks] = *(const bf16x8*)(kwb + (size_t)(kb + f * 16 + fr) * 64 + ks * 32 + fq * 8);
                bf16x8 vf[4];
#pragma unroll
                for (int df = 0; df < 4; ++df) { const bf16_t* vp = vwb + (size_t)(df * 16 + fr) * SEQ + kb + 4 * fq; vf[df] = ldv8(vp, vp + 16); }
#pragma unroll
                for (int r = 0; r < 4; ++r) {
                    f32x4 st[2];
#pragma unroll
                    for (int f = 0; f < 2; ++f) {
                        st[f] = __builtin_amdgcn_mfma_f32_16x16x32_bf16(kf[f][0], qf[r][0], z4, 0, 0, 0);
                        st[f] = __builtin_amdgcn_mfma_f32_16x16x32_bf16(kf[f][1], qf[r][1], st[f], 0, 0, 0);
                    }
                    float mx = NEGBIG;
#pragma unroll
                    for (int f = 0; f < 2; ++f)
#pragma unroll
                        for (int e = 0; e < 4; ++e) { const int key = kb + f * 16 + fq * 4 + e; const bool ok = (key <= tq) && (key > tq - 512); if (ok) mx = fmaxf(mx, st[f][e]); }
                    mx = max4(mx);
                    const float mn = fmaxf(mw[r], mx);
                    const float al = __expf(mw[r] - mn);
                    float ps = 0.f;
#pragma unroll
                    for (int f = 0; f < 2; ++f)
#pragma unroll
                        for (int e = 0; e < 4; ++e) { const int key = kb + f * 16 + fq * 4 + e; const bool ok = (key <= tq) && (key > tq - 512); const float pv = ok ? __expf(st[f][e] - mn) : 0.f; st[f][e] = pv; ps += pv; }
                    lw[r] = lw[r] * al + ps; mw[r] = mn;
                    const bf16x8 pf = pack8(st[0], st[1]);
#pragma unroll
                    for (int df = 0; df < 4; ++df) { acc[r][df] = acc[r][df] * al; acc[r][df] = __builtin_amdgcn_mfma_f32_16x16x32_bf16(vf[df], pf, acc[r][df], 0, 0, 0); }
                    __builtin_amdgcn_sched_barrier(0);
                }
            }
#pragma unroll
            for (int r = 0; r < 4; ++r) {
                const float l = red4(lw[r]); const float sc = gw[r] / l;
#pragma unroll
                for (int df = 0; df < 4; ++df) acc[r][df] = acc[r][df] * sc;
            }
        }
        const int nmax_tile = (t0 >> 4) - 1, nmax_lane = (t0 >> 4) - 2 + (fr == 15 ? 1 : 0);
        const bf16_t* kcb = KCMP + (size_t)bg * 1024 * 64; const bf16_t* vcb = VCMPT + (size_t)bg * 64 * 1024;
        for (int rep = 0; rep < rep_cmp; ++rep) {
            const bool dry = (rep + 1 < rep_cmp);
            float mc[4], lc[4], invl[4];
#pragma unroll
            for (int r = 0; r < 4; ++r) { mc[r] = NEGBIG; lc[r] = 0.f; }
            for (int nb = 0; nb <= nmax_tile; nb += 32) {
                bf16x8 kf[2][2];
#pragma unroll
                for (int f = 0; f < 2; ++f)
#pragma unroll
                    for (int ks = 0; ks < 2; ++ks) kf[f][ks] = *(const bf16x8*)(kcb + (size_t)(nb + f * 16 + fr) * 64 + ks * 32 + fq * 8);
#pragma unroll
                for (int r = 0; r < 4; ++r) {
                    f32x4 st[2];
#pragma unroll
                    for (int f = 0; f < 2; ++f) {
                        st[f] = __builtin_amdgcn_mfma_f32_16x16x32_bf16(kf[f][0], qf[r][0], z4, 0, 0, 0);
                        st[f] = __builtin_amdgcn_mfma_f32_16x16x32_bf16(kf[f][1], qf[r][1], st[f], 0, 0, 0);
                    }
                    float mx = NEGBIG;
#pragma unroll
                    for (int f = 0; f < 2; ++f)
#pragma unroll
                        for (int e = 0; e < 4; ++e) { const int n = nb + f * 16 + fq * 4 + e; if (n <= nmax_lane) mx = fmaxf(mx, st[f][e]); }
                    mx = max4(mx);
                    const float mn = fmaxf(mc[r], mx);
                    float ps = 0.f;
#pragma unroll
                    for (int f = 0; f < 2; ++f)
#pragma unroll
                        for (int e = 0; e < 4; ++e) { const int n = nb + f * 16 + fq * 4 + e; if (n <= nmax_lane) ps += __expf(st[f][e] - mn); }
                    lc[r] = lc[r] * __expf(mc[r] - mn) + ps; mc[r] = mn;
                    __builtin_amdgcn_sched_barrier(0);
                }
            }
#pragma unroll
            for (int r = 0; r < 4; ++r) { const float l = red4(lc[r]); invl[r] = l > 0.f ? 1.0f / l : 0.f; }
            for (int i = lane; i < 16 * 260; i += 64) IMP[i] = 0.f;
            float carry = 0.f;
            for (int nb = 0; nb <= nmax_tile; nb += 32) {
                bf16x8 kf[2][2];
#pragma unroll
                for (int f = 0; f < 2; ++f)
#pragma unroll
                    for (int ks = 0; ks < 2; ++ks) kf[f][ks] = *(const bf16x8*)(kcb + (size_t)(nb + f * 16 + fr) * 64 + ks * 32 + fq * 8);
                bf16x8 vf[4];
#pragma unroll
                for (int df = 0; df < 4; ++df) { const bf16_t* vp = vcb + (size_t)(df * 16 + fr) * 1024 + nb + 4 * fq; vf[df] = ldv8(vp, vp + 16); }
                f32x4 pg[2] = {z4, z4};
#pragma unroll
                for (int r = 0; r < 4; ++r) {
                    f32x4 st[2];
#pragma unroll
                    for (int f = 0; f < 2; ++f) {
                        st[f] = __builtin_amdgcn_mfma_f32_16x16x32_bf16(kf[f][0], qf[r][0], z4, 0, 0, 0);
                        st[f] = __builtin_amdgcn_mfma_f32_16x16x32_bf16(kf[f][1], qf[r][1], st[f], 0, 0, 0);
#pragma unroll
                        for (int e = 0; e < 4; ++e) { const int n = nb + f * 16 + fq * 4 + e; st[f][e] = (n <= nmax_lane) ? __expf(st[f][e] - mc[r]) * invl[r] : 0.f; }
                        pg[f] += st[f];
                    }
                    const float gg = dry ? 0.f : gc[r];
                    const bf16x8 pf = pack8(st[0] * gg, st[1] * gg);
#pragma unroll
                    for (int df = 0; df < 4; ++df) acc[r][df] = __builtin_amdgcn_mfma_f32_16x16x32_bf16(vf[df], pf, acc[r][df], 0, 0, 0);
                    __builtin_amdgcn_sched_barrier(0);
                }
                const int src = (lane - 16) & 63;
                const float s0 = __shfl(pg[0].w, src), s1 = __shfl(pg[1].w, src), sc = __shfl(carry, src);
                const float prev0 = fq > 0 ? s0 : sc, prev1 = fq > 0 ? s1 : s0;
                const float imp0 = (pg[0].x + pg[0].y) + (pg[0].z + pg[0].w) + prev0;
                const float imp1 = (pg[1].x + pg[1].y) + (pg[1].z + pg[1].w) + prev1;
                const int jb = (nb >> 2) + fq;
                IMP[fr * 260 + jb] = imp0; IMP[fr * 260 + jb + 4] = imp1;
                carry = pg[1].w;
            }
        }
        {
            const int nf = cur >= 2 ? 3 : cur + 1;
            if (fq == 0) {
                SEL[fr * 16 + 0] = 0;
                if (cur == 1) SEL[fr * 16 + 1] = 1;
                if (cur >= 2) { SEL[fr * 16 + 1] = cur - 1; SEL[fr * 16 + 2] = cur; }
            }
            const int ncand = cur >= 3 ? cur - 2 : 0, extra = 16 - nf;
            if (ncand <= extra) {
                if (fq == 0) { for (int k = 0; k < extra; ++k) SEL[fr * 16 + nf + k] = (k < ncand) ? 1 + k : -1; }
            } else {
                for (int rnd = 0; rnd < extra; ++rnd) {
                    float bv = -1.0f; int bj = 1 << 20;
                    for (int jb = 1 + fq; jb <= cur - 2; jb += 4) { const float v = IMP[fr * 260 + jb]; if (v > bv) { bv = v; bj = jb; } }
#pragma unroll
                    for (int o = 16; o <= 32; o <<= 1) {
                        const float ov = __shfl_xor(bv, o); const int oj = __shfl_xor(bj, o);
                        if (ov > bv || (ov == bv && oj < bj)) { bv = ov; bj = oj; }
                    }
                    if (fq == 0) SEL[fr * 16 + nf + rnd] = bj;
                    if (((bj - 1) & 3) == fq) IMP[fr * 260 + bj] = -2.0f;
                }
            }
        }
        u32x2 accp[4][4];
#pragma unroll
        for (int r = 0; r < 4; ++r)
#pragma unroll
            for (int df = 0; df < 4; ++df) accp[r][df] = (u32x2){pk2(acc[r][df].x, acc[r][df].y), pk2(acc[r][df].z, acc[r][df].w)};
        for (int rep = 0; rep < rep_sel; ++rep) {
            const bool dry = (rep + 1 < rep_sel);
            const unsigned char* k8b = p.ws + WS_KS + (size_t)bg * SEQ * 64; const unsigned char* v8b = p.ws + WS_VST + (size_t)bg * 256 * 4096;
            const float* skb = (const float*)(p.ws + WS_KS + 12 * MiB) + (size_t)bg * SEQ; const float* svb = (const float*)(p.ws + WS_VST + 12 * MiB) + (size_t)bg * 256 * 64;
            const unsigned char* Q8 = p.ws + WS_Q8; const float* SQ8 = (const float*)(p.ws + WS_Q8 + 32 * MiB);
            unsigned char* KL = WL; unsigned char* VL = WL + 5120; float* SKL = (float*)(WL + 9728); float* SVL = (float*)(WL + 9984);
            const int nv = cur + 1 < 16 ? cur + 1 : 16, total = 16 * nv;
            const int lrow = lane >> 2, lch = lane & 3;
            const int kwoff = lrow * 80 + lch * 16, vwoff = lrow * 72 + lch * 16;
            const int rr = fr & 3;
            u32x4 sk[4], sv[4]; float ssk, ssv;
            int jbn = __builtin_amdgcn_readfirstlane(SEL[0]);
            {
                const unsigned char* kb_ = k8b + (size_t)jbn * 4096; const unsigned char* vb_ = v8b + (size_t)jbn * 4096;
#pragma unroll
                for (int j = 0; j < 4; ++j) { sk[j] = *(const u32x4*)(kb_ + j * 1024 + lane * 16); sv[j] = *(const u32x4*)(vb_ + j * 1024 + lane * 16); }
                ssk = skb[jbn * 64 + lane]; ssv = svb[jbn * 64 + lane];
            }
            long qs8[2] = {0, 0};
            float sq = 0.f, ms = NEGBIG, ls = 0.f;
            f32x4 os[4] = {z4, z4, z4, z4};
            int i = 0, k = 0;
            for (int v = 0; v < total; ++v) {
                const int jb = jbn;
#pragma unroll
                for (int j = 0; j < 4; ++j) {
                    *(u32x4*)(KL + kwoff + j * 1280) = sk[j];
                    *(u32x2*)(VL + vwoff + j * 1152) = (u32x2){sv[j].x, sv[j].y}; *(u32x2*)(VL + vwoff + j * 1152 + 8) = (u32x2){sv[j].z, sv[j].w};
                }
                SKL[lane] = ssk; SVL[lane] = ssv;
                if (v + 1 < total) {
                    int k2 = k + 1, i2 = i; if (k2 == nv) { k2 = 0; i2 = i + 1; }
                    jbn = __builtin_amdgcn_readfirstlane(SEL[i2 * 16 + k2]);
                    const unsigned char* kb_ = k8b + (size_t)jbn * 4096; const unsigned char* vb_ = v8b + (size_t)jbn * 4096;
#pragma unroll
                    for (int j = 0; j < 4; ++j) { sk[j] = *(const u32x4*)(kb_ + j * 1024 + lane * 16); sv[j] = *(const u32x4*)(vb_ + j * 1024 + lane * 16); }
                    ssk = skb[jbn * 64 + lane]; ssv = svb[jbn * 64 + lane];
                }
                __builtin_amdgcn_sched_barrier(0);
                const int ti = t0 + i;
                if (k == 0) {
                    const size_t tk = (size_t)b * SEQ + ti;
#pragma unroll
                    for (int ks = 0; ks < 2; ++ks) qs8[ks] = *(const long*)(Q8 + tk * 1024 + (g * 4 + rr) * 64 + ks * 32 + fq * 8);
                    sq = SQ8[tk * 16 + g * 4 + rr];
                    ms = NEGBIG; ls = 0.f;
#pragma unroll
                    for (int df = 0; df < 4; ++df) os[df] = z4;
                }
                f32x4 st[4];
#pragma unroll
                for (int f = 0; f < 4; ++f) {
                    const long k0 = *(const long*)(KL + (f * 16 + fr) * 80 + fq * 8);
                    const long k1 = *(const long*)(KL + (f * 16 + fr) * 80 + 32 + fq * 8);
                    st[f] = __builtin_amdgcn_mfma_f32_16x16x32_fp8_fp8(k0, qs8[0], z4, 0, 0, 0);
                    st[f] = __builtin_amdgcn_mfma_f32_16x16x32_fp8_fp8(k1, qs8[1], st[f], 0, 0, 0);
                    const f32x4 kscale = *(const f32x4*)(SKL + f * 16 + fq * 4);
                    st[f] = st[f] * kscale * sq;
                }
                if (jb == cur) {
#pragma unroll
                    for (int f = 0; f < 4; ++f)
#pragma unroll
                        for (int e = 0; e < 4; ++e) { const int key = jb * 64 + f * 16 + fq * 4 + e; if (key > ti) st[f][e] = NEGBIG; }
                }
                float mx = NEGBIG;
#pragma unroll
                for (int f = 0; f < 4; ++f) mx = fmaxf(mx, fmaxf(fmaxf(st[f].x, st[f].y), fmaxf(st[f].z, st[f].w)));
                mx = max4(mx);
                const float mn = fmaxf(ms, mx);
                const float al = __expf(ms - mn);
                float ps = 0.f;
#pragma unroll
                for (int f = 0; f < 4; ++f)
#pragma unroll
                    for (int e = 0; e < 4; ++e) { const float pv = (st[f][e] > -1.0e29f) ? __expf(st[f][e] - mn) : 0.f; st[f][e] = pv; ps += pv; }
                ls = ls * al + ps; ms = mn;
                f32x4 pvacc[4] = {z4, z4, z4, z4};
#pragma unroll
                for (int s = 0; s < 2; ++s) {
                    int w0 = 0, w1 = 0;
                    w0 = __builtin_amdgcn_cvt_pk_fp8_f32(st[2 * s].x * 256.f, st[2 * s].y * 256.f, w0, false); w0 = __builtin_amdgcn_cvt_pk_fp8_f32(st[2 * s].z * 256.f, st[2 * s].w * 256.f, w0, true);
                    w1 = __builtin_amdgcn_cvt_pk_fp8_f32(st[2 * s + 1].x * 256.f, st[2 * s + 1].y * 256.f, w1, false); w1 = __builtin_amdgcn_cvt_pk_fp8_f32(st[2 * s + 1].z * 256.f, st[2 * s + 1].w * 256.f, w1, true);
                    const long pf = (long)(((unsigned long long)(unsigned)w1 << 32) | (unsigned long long)(unsigned)w0);
#pragma unroll
                    for (int df = 0; df < 4; ++df) {
                        const unsigned char* vp = VL + (df * 16 + fr) * 72 + 32 * s + 4 * fq;
                        const unsigned lo = *(const unsigned*)vp, hi = *(const unsigned*)(vp + 16);
                        const long vf = (long)(((unsigned long long)hi << 32) | (unsigned long long)lo);
                        pvacc[df] = __builtin_amdgcn_mfma_f32_16x16x32_fp8_fp8(vf, pf, pvacc[df], 0, 0, 0);
                    }
                }
#pragma unroll
                for (int df = 0; df < 4; ++df) { const f32x4 vscale = *(const f32x4*)(SVL + df * 16 + fq * 4); os[df] = os[df] * al + pvacc[df] * vscale; }
                if (k == nv - 1) {
                    const float l = red4(ls);
                    const float gsv = NGT[((size_t)b * SEQ + ti) * 48 + (g * 4 + rr) * 3 + 1];
                    const float sc = dry ? 0.f : gsv / (l * 256.f);
#pragma unroll
                    for (int df = 0; df < 4; ++df) {
                        const f32x4 val = os[df] * sc;
#pragma unroll
                        for (int r = 0; r < 4; ++r) {
                            const int srcl = r + 16 * fq;
                            const float t0_ = __shfl(val.x, srcl), t1_ = __shfl(val.y, srcl), t2_ = __shfl(val.z, srcl), t3_ = __shfl(val.w, srcl);
                            if (fr == i) {
                                const u32x2 c = accp[r][df];
                                accp[r][df] = (u32x2){pk2(bflo(c.x) + t0_, bfhi(c.x) + t1_), pk2(bflo(c.y) + t2_, bfhi(c.y) + t3_)};
                            }
                        }
                    }
                }
                ++k; if (k == nv) { k = 0; ++i; }
            }
        }
#pragma unroll
        for (int r = 0; r < 4; ++r)
#pragma unroll
            for (int df = 0; df < 4; ++df) {
                *(u32x2*)(O + tok * 1024 + (g * 4 + r) * 64 + df * 16 + fq * 4) = accp[r][df];
            }
    }
}
constexpr int NPHASES = 24;
#ifndef PROBE_PHASE
#define PROBE_PHASE (-1)
#endif
#ifndef ATT_REP_CMP
#define ATT_REP_CMP 1
#endif
#ifndef ATT_REP_WIN
#define ATT_REP_WIN 1
#endif
#ifndef ATT_REP_SEL
#define ATT_REP_SEL 1
#endif
#ifndef TS_PHASE
#define TS_PHASE (-1)
#endif
#ifndef TS_MULT
#define TS_MULT 4
#endif
#ifndef PROBE_REPS
#define PROBE_REPS 1
#endif
__global__ void __launch_bounds__(NTHREADS, 2) mega(Params p) {
    __shared__ __attribute__((aligned(16))) unsigned char lds[LDS_BYTES];
    __shared__ __attribute__((aligned(16))) unsigned bar_st[4];
    cg::grid_group grid = cg::this_grid();
    const float* MOD = (const float*)(p.ws + WS_MOD);
    bf16_t* HM = (bf16_t*)(p.ws + WS_HM);
    if (threadIdx.x < 4) bar_st[threadIdx.x] = 0u;
    __syncthreads();
    XcdBarrier bar = xcd_barrier_post((unsigned*)(p.ws + WS_CTL), (volatile LAS unsigned*)bar_st);
    const int lo = p.ph_lo, hi = p.ph_hi;
    const bool dry0 = (p.ph_hi < 0);
    const int opq = (p.ph_hi < 0) ? 1 : 0;
    unsigned long long ts_a = 0ull, ts_b = 0ull;
#define PHASE(k, call, drycall) if (lo <= (k) && (k) < hi) { \
        if (TS_PHASE == (k)) ts_a = __builtin_amdgcn_s_memrealtime(); \
        if (PROBE_PHASE == (k)) { for (int rep = 0; rep < PROBE_REPS; ++rep) { const bool dry = !dry0; drycall; __syncthreads(); } } \
        { const bool dry = dry0; call; } \
        if ((k) + 1 < hi) { if ((k) == 0) grid.sync(); else xcd_barrier(bar); } \
        if (TS_PHASE == (k)) ts_b = __builtin_amdgcn_s_memrealtime(); }
    PHASE(0, phase_prep(p, (float*)lds), phase_prep(p, (float*)lds))
    PHASE(1, phase_norm(p, p.in[0], p.in[2], MOD + 0, MOD + 1024, HM), phase_norm(p, p.in[0], p.in[2], MOD + 0, MOD + 1024, HM))
    PHASE(2, phase_s5_win(p, lds), phase_s5_win(p, lds))
    PHASE(3, phase_s5_a(p, lds), phase_s5_a(p, lds))
    PHASE(4, phase_s5_scan(p), phase_s5_scan(p))
    PHASE(5, phase_s5_b(p, lds), phase_s5_b(p, lds))
    PHASE(6, phase_s5_glu(p, lds), phase_s5_glu(p, lds))
    PHASE(7, phase_norm(p, p.out, p.in[3], MOD + 3072, MOD + 4096, HM), phase_norm(p, p.out, p.in[3], MOD + 3072, MOD + 4096, HM))
    PHASE(8, phase_peer_wq(p, 0, lds), phase_peer_wq(p, 0, lds))
    PHASE(9, phase_peer_topk(p, 0, lds), phase_peer_topk(p, 0, lds))
    PHASE(10, phase_peer_combine(p, lds), phase_peer_combine(p, lds))
    PHASE(11, phase_peer_apply(p, 0, lds, dry), phase_peer_apply(p, 0, lds, dry))
    PHASE(12, (phase_norm(p, p.out, p.in[2] + D, MOD + 2 * 6144 + 0, MOD + 2 * 6144 + 1024, HM), phase_tab1(p)), (phase_norm(p, p.out, p.in[2] + D, MOD + 2 * 6144 + 0, MOD + 2 * 6144 + 1024, HM), phase_tab1(p)))
    PHASE(13, phase_nsa_proj(p, lds), phase_nsa_proj(p, lds))
    PHASE(14, phase_nsa_cmp1(p, lds), phase_nsa_cmp1(p, lds))
    PHASE(15, phase_nsa_cmp2(p, lds), phase_nsa_cmp2(p, lds))
    PHASE(16, phase_nsa_attn(p, lds, ATT_REP_CMP + opq, ATT_REP_WIN + opq, ATT_REP_SEL + opq), phase_nsa_attn(p, lds, 1 + opq, 1 + opq, 1 + opq))
    PHASE(17, phase_nsa_wo(p, lds, dry), phase_nsa_wo(p, lds, dry))
    PHASE(18, phase_norm(p, p.out, p.in[3] + D, MOD + 2 * 6144 + 3072, MOD + 2 * 6144 + 4096, HM), phase_norm(p, p.out, p.in[3] + D, MOD + 2 * 6144 + 3072, MOD + 2 * 6144 + 4096, HM))
    PHASE(19, phase_peer_wq(p, 1, lds), phase_peer_wq(p, 1, lds))
    PHASE(20, phase_peer_topk(p, 1, lds), phase_peer_topk(p, 1, lds))
    PHASE(21, phase_peer_combine(p, lds), phase_peer_combine(p, lds))
    PHASE(22, phase_peer_apply(p, 1, lds, dry), phase_peer_apply(p, 1, lds, dry))
    PHASE(23, phase_final_norm(p, p.out, p.out, dry), phase_final_norm(p, p.out, p.out, dry))
#undef PHASE
    if (TS_PHASE >= 0 && blockIdx.x == 0 && threadIdx.x == 0) {
        const unsigned long long t0 = __builtin_amdgcn_s_memrealtime(), want = (ts_b - ts_a) * TS_MULT;
        while (__builtin_amdgcn_s_memrealtime() - t0 < want) __builtin_amdgcn_s_sleep(8);
    }
}

extern "C" void kernel_launch(void* const* d_in, const int* in_sizes, int n_in, void* d_out, int out_size, void* d_ws, size_t ws_size, hipStream_t stream) {
    static int grid_blocks = 0;
    if (!grid_blocks) {
        int dev = 0, cus = 0, per_cu = 0;
        hipGetDevice(&dev);
        hipDeviceGetAttribute(&cus, hipDeviceAttributeMultiprocessorCount, dev);
        hipOccupancyMaxActiveBlocksPerMultiprocessor(&per_cu, mega, NTHREADS, 0);
        if (per_cu > 2) per_cu = 2;
        if (per_cu < 1) per_cu = 1;
        grid_blocks = cus * per_cu;
        if (ws_size < WS_END) fprintf(stderr, "kernel_launch: workspace too small: %zu < %zu\n", ws_size, (size_t)WS_END);
        if (n_in != 29) fprintf(stderr, "kernel_launch: expected 29 inputs, got %d\n", n_in);
    }
    hipMemsetAsync((unsigned char*)d_ws + WS_CTL, 0, 16384, stream);
    Params p{};
    for (int i = 0; i < 29; ++i) p.in[i] = (const float*)d_in[i];
    p.out = (float*)d_out; p.ws = (unsigned char*)d_ws;
#if SINGLE_LAUNCH
    p.ph_lo = 0; p.ph_hi = NPHASES;
    void* args[] = {&p};
    hipError_t e = hipLaunchCooperativeKernel((void*)mega, dim3(grid_blocks), dim3(NTHREADS), args, 0, stream);
    if (e != hipSuccess) fprintf(stderr, "cooperative launch failed: %s (grid %d)\n", hipGetErrorString(e), grid_blocks);
#else
    for (int ph = 0; ph < NPHASES; ++ph) {
        p.ph_lo = ph; p.ph_hi = ph + 1;
        hipLaunchKernelGGL(mega, dim3(grid_blocks), dim3(NTHREADS), 0, stream, p);
    }
#endif
}
```

```cpp
#include <hip/hip_runtime.h>
#include <hip/hip_cooperative_groups.h>
#include <cstdio>
#include <cstdint>
namespace cg = cooperative_groups;

#ifndef SINGLE_LAUNCH
#define SINGLE_LAUNCH 1
#endif

typedef unsigned short bf16_t;
typedef short bf16x8 __attribute__((ext_vector_type(8)));
typedef float f32x4 __attribute__((ext_vector_type(4)));
typedef float f32x2 __attribute__((ext_vector_type(2)));
typedef unsigned u32x4 __attribute__((ext_vector_type(4)));
typedef unsigned u32x2 __attribute__((ext_vector_type(2)));
typedef __bf16 bf16x2_t __attribute__((ext_vector_type(2)));

constexpr int D = 1024, BATCH = 2, SEQ = 16384, T = BATCH * SEQ;
constexpr int NTHREADS = 256;
constexpr float RMS_EPS = 1e-6f;
constexpr int S5G = 64, S5P = 64, S5L = 32, S5NCH = T / S5L  , S5CPB = SEQ / S5L  ;
constexpr int NH = 16, HD = 64, NG = 4, NPROJ = 2608, NPROJ_PAD = 2688, NC = 1023, NSB = 256;
constexpr int PH = 8, PK = 16, PNK = 128, PE = 16384;

constexpr size_t MiB = 1ull << 20;
constexpr size_t WS_CTL = 0;
constexpr size_t WS_MOD = 1 * MiB;
constexpr size_t WS_WIN_T = 2 * MiB;
constexpr size_t WS_WGLU_T = 4 * MiB;
constexpr size_t WS_WPROJ_T = 8 * MiB;
constexpr size_t WS_WK1_T = 14 * MiB;
constexpr size_t WS_WV1_T = 15 * MiB;
constexpr size_t WS_WK2_T = 16 * MiB;
constexpr size_t WS_WV2_T = 16 * MiB + 512 * 1024;
constexpr size_t WS_WO_T = 17 * MiB;
constexpr size_t WS_WQ_T = 19 * MiB;
constexpr size_t WS_SUBK = 27 * MiB;
constexpr size_t WS_ROPE = 28 * MiB;
constexpr size_t WS_MISC = 32 * MiB;
constexpr size_t WS_TW = 33 * MiB;
constexpr size_t WS_VG = 73 * MiB;
constexpr size_t WS_PU = 82 * MiB;
constexpr size_t WS_PV = 114 * MiB;
constexpr size_t WS_HM = 146 * MiB;
constexpr size_t WS_C = 210 * MiB;
constexpr size_t WS_UG = WS_C;
constexpr size_t WS_YI = WS_C + 64 * MiB;
constexpr size_t WS_WST = WS_C + 128 * MiB;
constexpr size_t WS_SST = WS_C + 160 * MiB;
constexpr size_t WS_YG = WS_C + 176 * MiB;
constexpr size_t WS_QK = WS_C;
constexpr size_t WS_TOPS = WS_C + 128 * MiB;
constexpr size_t WS_TOPI = WS_C + 160 * MiB;
constexpr size_t WS_EXP = WS_C + 192 * MiB;
constexpr size_t WS_GATE = WS_C + 208 * MiB;
constexpr size_t WS_Q = WS_C;
constexpr size_t WS_KC = WS_C + 64 * MiB;
constexpr size_t WS_VC = WS_C + 81 * MiB;
constexpr size_t WS_KS = WS_C + 98 * MiB;
constexpr size_t WS_VST = WS_C + 114 * MiB;
constexpr size_t WS_KW = WS_C + 130 * MiB;
constexpr size_t WS_VWT = WS_C + 146 * MiB;
constexpr size_t WS_NG = WS_C + 162 * MiB;
constexpr size_t WS_KCMP = WS_C + 170 * MiB;
constexpr size_t WS_VCMPT = WS_C + 171 * MiB;
constexpr size_t WS_HID = WS_C + 172 * MiB;
constexpr size_t WS_O = WS_C + 182 * MiB;
constexpr size_t WS_Q8 = WS_C + 246 * MiB;
constexpr size_t WS_END = WS_C + 282 * MiB;

constexpr int LDS_BYTES = 73728;

struct Params {
    const float* in[29];
    float* out;
    unsigned char* ws;
    int ph_lo, ph_hi;
};

__device__ __forceinline__ unsigned f2bf(float f) { unsigned u = __builtin_bit_cast(unsigned, f); return (u + 0x7fffu + ((u >> 16) & 1u)) >> 16; }
__device__ __forceinline__ unsigned pk2(float lo, float hi) { return f2bf(lo) | (f2bf(hi) << 16); }
__device__ __forceinline__ float bf2f(unsigned h) { return __builtin_bit_cast(float, h << 16); }
__device__ __forceinline__ float bflo(unsigned w) { return __builtin_bit_cast(float, w << 16); }
__device__ __forceinline__ float bfhi(unsigned w) { return __builtin_bit_cast(float, w & 0xffff0000u); }
__device__ __forceinline__ float gelu_tanh(float x) {
    const float u = 0.7978845608028654f * (x + 0.044715f * x * x * x);
    const float e = __expf(2.0f * u);
    const float th = 1.0f - 2.0f / (e + 1.0f);
    return 0.5f * x * (1.0f + th);
}
__device__ __forceinline__ float sigmoidf_(float x) { return 1.0f / (1.0f + __expf(-x)); }
__device__ __forceinline__ float wave_sum(float v) {
#pragma unroll
    for (int o = 1; o < 64; o <<= 1) v += __shfl_xor(v, o);
    return v;
}
__device__ __forceinline__ float dot2bf(unsigned a, unsigned b, float acc) {
    return __builtin_amdgcn_fdot2_f32_bf16(__builtin_bit_cast(bf16x2_t, a), __builtin_bit_cast(bf16x2_t, b), acc, false);
}

#define LAS __attribute__((address_space(3)))
#define XB_TMO      128
#define XB_XCNT(j)  (256  + 64 * (j))
#define XB_XSUB(j)  (1280 + 64 * (j))
#define XB_XGEN(j)  (2304 + 64 * (j))
#define XB_TOP      3328
#define XB_TOPGEN   3392
#define XCD_BAR_WORDS 3456
#define XB_SPIN_CAP (1u << 24)

__device__ __forceinline__ unsigned xb_ld(unsigned* p)              { return __hip_atomic_load(p, __ATOMIC_RELAXED, __HIP_MEMORY_SCOPE_AGENT); }
__device__ __forceinline__ unsigned xb_add(unsigned* p, unsigned v) { return __hip_atomic_fetch_add(p, v, __ATOMIC_RELAXED, __HIP_MEMORY_SCOPE_AGENT); }
__device__ __forceinline__ unsigned xb_xcc_id() { return (unsigned)__builtin_amdgcn_s_getreg((3 << 11) | 20) & 0xFu; }
#define XB_SPIN(cond, bar) do { unsigned _sp = 0; while (cond) { __builtin_amdgcn_s_sleep(1); \
    if ((++_sp & 255u) == 0u) { if (xb_ld(&(bar)[XB_TMO])) break; if (_sp > XB_SPIN_CAP) { atomicAdd(&(bar)[XB_TMO], 1u); break; } } } } while (0)

struct XcdBarrier {
    unsigned* bar; unsigned x;
    volatile LAS unsigned* st;
};

__device__ __forceinline__ XcdBarrier xcd_barrier_post(unsigned* bar, volatile LAS unsigned* st) {
    XcdBarrier b; b.bar = bar; b.x = xb_xcc_id(); b.st = st;
    if (threadIdx.x == 0) (void)xb_add(&bar[XB_XCNT(b.x)], 1u);
    return b;
}
__device__ __forceinline__ void xcd_barrier_complete(unsigned* bar, unsigned x, unsigned& nloc, unsigned& nx) {
    const unsigned G = gridDim.x * gridDim.y * gridDim.z;
    unsigned sum, cnt, mine, sp = 0u;
    for (;;) {
        sum = 0u; cnt = 0u; mine = 0u;
#pragma unroll
        for (unsigned j = 0; j < 16; ++j) { const unsigned c = xb_ld(&bar[XB_XCNT(j)]); sum += c; cnt += (c > 0u) ? 1u : 0u; mine = (j == x) ? c : mine; }
        if (sum == G) break;
        __builtin_amdgcn_s_sleep(1);
        if ((++sp & 255u) == 0u) { if (xb_ld(&bar[XB_TMO])) break; if (sp > XB_SPIN_CAP) { atomicAdd(&bar[XB_TMO], 1u); break; } }
    }
    nloc = mine > 0u ? mine : 1u; nx = cnt > 0u ? cnt : 1u;
}

__device__ __forceinline__ void xcd_barrier(const XcdBarrier& b) {
    asm volatile("s_waitcnt vmcnt(0)" ::: "memory");
    __syncthreads();
    if (threadIdx.x == 0) {
        unsigned* bar = b.bar;
        __builtin_amdgcn_s_waitcnt(0);
        unsigned nloc = b.st[0], nx = b.st[1];
        if (nloc == 0u) { xcd_barrier_complete(bar, b.x, nloc, nx); b.st[0] = nloc; b.st[1] = nx; }
        const unsigned old = xb_add(&bar[XB_XSUB(b.x)], 1u);
        const unsigned gen = old / nloc;
        if (old + 1u == (gen + 1u) * nloc) {
            __builtin_amdgcn_fence(__ATOMIC_RELEASE, "agent");
            asm volatile("s_waitcnt vmcnt(0)" ::: "memory");
            const unsigned og = xb_add(&bar[XB_TOP], 1u);
            const unsigned tg = og / nx;
            if (og + 1u == (tg + 1u) * nx) xb_add(&bar[XB_TOPGEN], 1u);
            else XB_SPIN(xb_ld(&bar[XB_TOPGEN]) == tg, bar);
            __builtin_amdgcn_fence(__ATOMIC_ACQUIRE, "agent");
            xb_add(&bar[XB_XGEN(b.x)], 1u);
            asm volatile("s_waitcnt vmcnt(0)" ::: "memory");
        } else {
            XB_SPIN(xb_ld(&bar[XB_XGEN(b.x)]) == gen, bar);
            __builtin_amdgcn_fence(__ATOMIC_ACQUIRE, "agent");
            asm volatile("s_waitcnt vmcnt(0)" ::: "memory");
        }
    }
    __syncthreads();
}
__device__ __forceinline__ void prep_mod_item(const Params& p, int item, float* lds) {
    const int layer = item / 192, cg0 = (item % 192) * 32;
    const int tid = threadIdx.x, col = cg0 + (tid & 31), kg = tid >> 5;
    const float* W = p.in[4] + (size_t)layer * D * 6 * D;
    const float* c = p.in[1];
    float a0 = 0.f, a1 = 0.f;
    for (int k = kg * 128; k < kg * 128 + 128; ++k) {
        const float w = W[(size_t)k * (6 * D) + col];
        const float c0 = c[k], c1 = c[D + k];
        a0 += w * (c0 * sigmoidf_(c0));
        a1 += w * (c1 * sigmoidf_(c1));
    }
    lds[tid] = a0; lds[256 + tid] = a1;
    __syncthreads();
    if (tid < 64) {
        const int b = tid >> 5, cc = tid & 31;
        float s = 0.f;
#pragma unroll
        for (int g = 0; g < 8; ++g) s += lds[b * 256 + g * 32 + cc];
        float* MOD = (float*)(p.ws + WS_MOD);
        MOD[(size_t)(layer * 2 + b) * 6144 + cg0 + cc] = s + p.in[5][(size_t)layer * 6144 + cg0 + cc];
    }
    __syncthreads();
}

template <int MODE>
__device__ __forceinline__ void prep_transpose_item(const float* W, int K, int N, bf16_t* WT, int item, float* lds) {
    const int nbn = (N + 63) / 64, kb = item / nbn, nb = item % nbn, k0 = kb * 64, n0 = nb * 64;
    const int tid = threadIdx.x;
#pragma unroll
    for (int i = 0; i < 16; ++i) {
        const int kk = (tid >> 6) + 4 * i, nn = tid & 63;
        const float v = (n0 + nn < N) ? W[(size_t)(k0 + kk) * N + n0 + nn] : 0.f;
        lds[kk * 65 + nn] = v;
    }
    __syncthreads();
    {
        const int nn = tid >> 2, ks = (tid & 3) * 16;
        const int n = n0 + nn;
        if (n < N) {
            int np = n;
            if (MODE == 1) { const int j = (n < 1024) ? n : n - 1024; np = (j >> 4) * 32 + (j & 15) + ((n < 1024) ? 0 : 16); }
            u32x4 o0, o1;
            const float* s = lds + nn;
            o0.x = pk2(s[(ks + 0) * 65], s[(ks + 1) * 65]); o0.y = pk2(s[(ks + 2) * 65], s[(ks + 3) * 65]);
            o0.z = pk2(s[(ks + 4) * 65], s[(ks + 5) * 65]); o0.w = pk2(s[(ks + 6) * 65], s[(ks + 7) * 65]);
            o1.x = pk2(s[(ks + 8) * 65], s[(ks + 9) * 65]); o1.y = pk2(s[(ks + 10) * 65], s[(ks + 11) * 65]);
            o1.z = pk2(s[(ks + 12) * 65], s[(ks + 13) * 65]); o1.w = pk2(s[(ks + 14) * 65], s[(ks + 15) * 65]);
            u32x4* dst = (u32x4*)(WT + (size_t)np * K + k0 + ks);
            dst[0] = o0; dst[1] = o1;
        }
    }
    __syncthreads();
}

__device__ __forceinline__ void cvt_item(const float* src, bf16_t* dst, int item) {
    const size_t base = (size_t)item * 8192 + threadIdx.x * 8;
#pragma unroll
    for (int i = 0; i < 4; ++i) {
        const size_t o = base + (size_t)i * 2048;
        const f32x4 a = *(const f32x4*)(src + o), b = *(const f32x4*)(src + o + 4);
        u32x4 w; w.x = pk2(a.x, a.y); w.y = pk2(a.z, a.w); w.z = pk2(b.x, b.y); w.w = pk2(b.z, b.w);
        *(u32x4*)(dst + o) = w;
    }
}
__device__ __forceinline__ void zero_item(bf16_t* dst, int item) {
    const size_t base = (size_t)item * 8192 + threadIdx.x * 8;
#pragma unroll
    for (int i = 0; i < 4; ++i) *(u32x4*)(dst + base + (size_t)i * 2048) = (u32x4){0u, 0u, 0u, 0u};
}

struct cpx { float re, im; };
__device__ __forceinline__ cpx cmul(cpx a, cpx b) { return {a.re * b.re - a.im * b.im, a.re * b.im + a.im * b.re}; }
__device__ __forceinline__ cpx cexp_pow(float are, float aim, float dt, int m) {
    const float mag = __expf(are * dt * (float)m);
    const double rev = (double)aim * (double)dt * (double)m * 0.15915494309189535;
    const float fr = (float)(rev - rint(rev));
    return {mag * __builtin_amdgcn_cosf(fr), mag * __builtin_amdgcn_sinf(fr)};
}
__device__ __forceinline__ cpx s5_coef(float are, float aim, float dt) {
    cpx ab = cexp_pow(are, aim, dt, 1);
    const float nr = ab.re - 1.0f, ni = ab.im, den = are * are + aim * aim;
    return {(nr * are + ni * aim) / den, (ni * are - nr * aim) / den};
}

__device__ __forceinline__ void prep_s5_T_item(const Params& p, int item) {
    const int gid = item * 256 + threadIdx.x;
    const int g = gid >> 9, m = (gid >> 4) & 31, i = gid & 15;
    const float* a_re = p.in[7] + g * 64; const float* a_im = p.in[8] + g * 64;
    const float dt = __expf(p.in[9][g]);
    const float* b_re = p.in[10] + (size_t)g * 64 * 16; const float* b_im = p.in[11] + (size_t)g * 64 * 16;
    const float* c_re = p.in[12] + (size_t)g * 16 * 64 + i * 64; const float* c_im = p.in[13] + (size_t)g * 16 * 64 + i * 64;
    float acc[16];
#pragma unroll
    for (int j = 0; j < 16; ++j) acc[j] = 0.f;
    for (int q = 0; q < 64; ++q) {
        const float are = a_re[q], aim = a_im[q];
        cpx z = cmul(cmul({c_re[q], c_im[q]}, cexp_pow(are, aim, dt, m)), s5_coef(are, aim, dt));
        const f32x4* br = (const f32x4*)(b_re + q * 16); const f32x4* bi = (const f32x4*)(b_im + q * 16);
#pragma unroll
        for (int j4 = 0; j4 < 4; ++j4) {
            const f32x4 r = br[j4], im = bi[j4];
            acc[j4 * 4 + 0] += z.re * r.x - z.im * im.x; acc[j4 * 4 + 1] += z.re * r.y - z.im * im.y;
            acc[j4 * 4 + 2] += z.re * r.z - z.im * im.z; acc[j4 * 4 + 3] += z.re * r.w - z.im * im.w;
        }
    }
    u32x4 o0, o1;
    o0.x = pk2(acc[0], acc[1]); o0.y = pk2(acc[2], acc[3]); o0.z = pk2(acc[4], acc[5]); o0.w = pk2(acc[6], acc[7]);
    o1.x = pk2(acc[8], acc[9]); o1.y = pk2(acc[10], acc[11]); o1.z = pk2(acc[12], acc[13]); o1.w = pk2(acc[14], acc[15]);
    bf16_t* TW = (bf16_t*)(p.ws + WS_TW) + (size_t)g * 640 * 512;
    const u32x4 z4 = (u32x4){0u, 0u, 0u, 0u};
    for (int lp = 0; lp + m < 32; ++lp) {
        u32x4* d = (u32x4*)(TW + (size_t)((lp + m) * 16 + i) * 512 + lp * 16);
        d[0] = o0; d[1] = o1;
        if (m > 0) { u32x4* dz = (u32x4*)(TW + (size_t)(lp * 16 + i) * 512 + (lp + m) * 16); dz[0] = z4; dz[1] = z4; }
    }
}
__device__ __forceinline__ void prep_s5_W_item(const Params& p, int item) {
    const int gid = item * 256 + threadIdx.x;
    const int g = gid >> 11, q = (gid >> 5) & 63, lp = gid & 31;
    const float are = p.in[7][g * 64 + q], aim = p.in[8][g * 64 + q];
    const float dt = __expf(p.in[9][g]);
    const cpx z = cmul(cexp_pow(are, aim, dt, 31 - lp), s5_coef(are, aim, dt));
    const float* br = p.in[10] + ((size_t)g * 64 + q) * 16; const float* bi = p.in[11] + ((size_t)g * 64 + q) * 16;
    float wr[16], wi[16];
#pragma unroll
    for (int j = 0; j < 16; ++j) { wr[j] = z.re * br[j] - z.im * bi[j]; wi[j] = z.re * bi[j] + z.im * br[j]; }
    bf16_t* TW = (bf16_t*)(p.ws + WS_TW) + (size_t)g * 640 * 512;
    u32x4* d0 = (u32x4*)(TW + (size_t)(512 + q) * 512 + lp * 16);
    u32x4* d1 = (u32x4*)(TW + (size_t)(576 + q) * 512 + lp * 16);
    d0[0] = (u32x4){pk2(wr[0], wr[1]), pk2(wr[2], wr[3]), pk2(wr[4], wr[5]), pk2(wr[6], wr[7])};
    d0[1] = (u32x4){pk2(wr[8], wr[9]), pk2(wr[10], wr[11]), pk2(wr[12], wr[13]), pk2(wr[14], wr[15])};
    d1[0] = (u32x4){pk2(wi[0], wi[1]), pk2(wi[2], wi[3]), pk2(wi[4], wi[5]), pk2(wi[6], wi[7])};
    d1[1] = (u32x4){pk2(wi[8], wi[9]), pk2(wi[10], wi[11]), pk2(wi[12], wi[13]), pk2(wi[14], wi[15])};
}
__device__ __forceinline__ void prep_s5_V_item(const Params& p, int item) {
    const int gid = item * 256 + threadIdx.x;
    const int g = gid >> 14, l = (gid >> 9) & 31, i = (gid >> 5) & 15, q0 = (gid & 31) * 2;
    const float dt = __expf(p.in[9][g]);
    float vr[2], vi[2];
#pragma unroll
    for (int e = 0; e < 2; ++e) {
        const int q = q0 + e;
        const cpx z = cmul({p.in[12][((size_t)g * 16 + i) * 64 + q], p.in[13][((size_t)g * 16 + i) * 64 + q]}, cexp_pow(p.in[7][g * 64 + q], p.in[8][g * 64 + q], dt, l + 1));
        vr[e] = z.re; vi[e] = -z.im;
    }
    bf16_t* VG = (bf16_t*)(p.ws + WS_VG) + ((size_t)g * 512 + l * 16 + i) * 128;
    *(unsigned*)(VG + q0) = pk2(vr[0], vr[1]);
    *(unsigned*)(VG + 64 + q0) = pk2(vi[0], vi[1]);
}
__device__ __forceinline__ void prep_al_item(const Params& p, int item) {
    const int gid = item * 256 + threadIdx.x;
    const int g = gid >> 6;
    const float dt = __expf(p.in[9][g]);
    const cpx z = cexp_pow(p.in[7][gid], p.in[8][gid], dt, S5L);
    f32x2* AL = (f32x2*)(p.ws + WS_MISC + 4096);
    AL[gid] = (f32x2){z.re, z.im};
}
__device__ __forceinline__ void prep_rope_item(const Params& p, int item) {
    const int gid = item * 256 + threadIdx.x;
    const int pos = gid >> 5, j = gid & 31;
    const float freq = exp2f(-(float)j * (13.287712379549449f / 32.0f));
    const float ang = (float)pos * freq;
    const double rev = (double)ang * 0.15915494309189535;
    const float fr = (float)(rev - rint(rev));
    f32x2* R = (f32x2*)(p.ws + WS_ROPE);
    R[gid] = (f32x2){__builtin_amdgcn_cosf(fr), __builtin_amdgcn_sinf(fr)};
}
__device__ __forceinline__ void prep_cmpbias_item(const Params& p, int item, float* lds) {
    const int kv = item >> 3, cg0 = (item & 7) * 32;
    const float* pe = p.in[17 + kv]; const float* w1 = p.in[kv == 0 ? 19 : 21];
    const int tid = threadIdx.x, col = cg0 + (tid & 31), kg = tid >> 5;
    float s = 0.f;
#pragma unroll 8
    for (int k = kg * 256; k < kg * 256 + 256; ++k) s += pe[k] * w1[(size_t)k * 256 + col];
    lds[tid] = s;
    __syncthreads();
    if (tid < 32) {
        float t = 0.f;
#pragma unroll
        for (int q = 0; q < 8; ++q) t += lds[q * 32 + tid];
        ((float*)(p.ws + WS_MISC))[kv * 256 + cg0 + tid] = t;
    }
    __syncthreads();
}

__device__ __forceinline__ void cvt_fp8_item(const float* src, unsigned char* dst, float* inv_scale, int item) {
    const int lane = threadIdx.x & 63, row = item * 4 + (threadIdx.x >> 6);
    const f32x4* sp = (const f32x4*)(src + (size_t)row * D + lane * 16);
    const f32x4 a = sp[0], b = sp[1], c = sp[2], d = sp[3];
    float m = fmaxf(fmaxf(fmaxf(fabsf(a.x), fabsf(a.y)), fmaxf(fabsf(a.z), fabsf(a.w))), fmaxf(fmaxf(fabsf(b.x), fabsf(b.y)), fmaxf(fabsf(b.z), fabsf(b.w))));
    m = fmaxf(m, fmaxf(fmaxf(fmaxf(fabsf(c.x), fabsf(c.y)), fmaxf(fabsf(c.z), fabsf(c.w))), fmaxf(fmaxf(fabsf(d.x), fabsf(d.y)), fmaxf(fabsf(d.z), fabsf(d.w)))));
#pragma unroll
    for (int o = 1; o < 64; o <<= 1) m = fmaxf(m, __shfl_xor(m, o));
    const float sc = m > 0.f ? 224.0f / m : 1.0f;
    u32x4 w;
    int t = 0;
    t = __builtin_amdgcn_cvt_pk_fp8_f32(a.x * sc, a.y * sc, t, false); t = __builtin_amdgcn_cvt_pk_fp8_f32(a.z * sc, a.w * sc, t, true); w.x = (unsigned)t;
    t = __builtin_amdgcn_cvt_pk_fp8_f32(b.x * sc, b.y * sc, t, false); t = __builtin_amdgcn_cvt_pk_fp8_f32(b.z * sc, b.w * sc, t, true); w.y = (unsigned)t;
    t = __builtin_amdgcn_cvt_pk_fp8_f32(c.x * sc, c.y * sc, t, false); t = __builtin_amdgcn_cvt_pk_fp8_f32(c.z * sc, c.w * sc, t, true); w.z = (unsigned)t;
    t = __builtin_amdgcn_cvt_pk_fp8_f32(d.x * sc, d.y * sc, t, false); t = __builtin_amdgcn_cvt_pk_fp8_f32(d.z * sc, d.w * sc, t, true); w.w = (unsigned)t;
    *(u32x4*)(dst + (size_t)row * D + lane * 16) = w;
    if (lane == 0) inv_scale[row] = m > 0.f ? m / 224.0f : 1.0f;
}
constexpr int P0_MOD = 384;
constexpr int P0_T_WIN = 16 * 16, P0_T_WGLU = 16 * 32, P0_T_WPROJ = 16 * 41, P0_T_WK1 = 32 * 4, P0_T_WK2 = 4 * 1, P0_T_WO = 16 * 16, P0_T_WQ = 16 * 32;
constexpr int P0_SUBK = (2 * 8 * 2 * 128 * 128) / 8192;
constexpr int P0_TAB = PE / 4;
constexpr int P0_S5T = 128, P0_S5W = 512, P0_S5V = 4096, P0_AL = 16, P0_ROPE = 2048, P0_CB = 16, P0_ZERO = 10 + 2;

__device__ __forceinline__ void phase_prep(const Params& p, float* lds) {
    const int n0 = P0_MOD;
    const int n1 = n0 + P0_T_WIN, n2 = n1 + P0_T_WGLU, n3 = n2 + P0_T_WPROJ, n4 = n3 + P0_T_WK1, n5 = n4 + P0_T_WK1, n6 = n5 + P0_T_WK2, n7 = n6 + P0_T_WK2,
              n8 = n7 + P0_T_WO, n9 = n8 + P0_T_WQ, n10 = n9 + P0_T_WQ, n11 = n10 + P0_SUBK, n12 = n11 + P0_TAB, n13 = n12 + P0_TAB,
              n14 = n13 + P0_S5T, n15 = n14 + P0_S5W, n16 = n15 + P0_S5V, n17 = n16 + P0_AL, n18 = n17 + P0_ROPE, n19 = n18 + P0_CB, n20 = n19 + 10, n21 = n20 + 2, n22 = n21 + 2;
    unsigned char* ws = p.ws;
    for (int it = blockIdx.x; it < n22; it += gridDim.x) {
        if (it < n0) prep_mod_item(p, it, lds);
        else if (it < n1) prep_transpose_item<0>(p.in[6], 1024, 1024, (bf16_t*)(ws + WS_WIN_T), it - n0, lds);
        else if (it < n2) prep_transpose_item<1>(p.in[15], 1024, 2048, (bf16_t*)(ws + WS_WGLU_T), it - n1, lds);
        else if (it < n3) prep_transpose_item<0>(p.in[16], 1024, NPROJ, (bf16_t*)(ws + WS_WPROJ_T), it - n2, lds);
        else if (it < n4) prep_transpose_item<0>(p.in[19], 2048, 256, (bf16_t*)(ws + WS_WK1_T), it - n3, lds);
        else if (it < n5) prep_transpose_item<0>(p.in[21], 2048, 256, (bf16_t*)(ws + WS_WV1_T), it - n4, lds);
        else if (it < n6) prep_transpose_item<0>(p.in[20], 256, 64, (bf16_t*)(ws + WS_WK2_T), it - n5, lds);
        else if (it < n7) prep_transpose_item<0>(p.in[22], 256, 64, (bf16_t*)(ws + WS_WV2_T), it - n6, lds);
        else if (it < n8) prep_transpose_item<0>(p.in[23], 1024, 1024, (bf16_t*)(ws + WS_WO_T), it - n7, lds);
        else if (it < n9) prep_transpose_item<0>(p.in[24], 1024, 2048, (bf16_t*)(ws + WS_WQ_T), it - n8, lds);
        else if (it < n10) prep_transpose_item<0>(p.in[24] + (size_t)1024 * 2048, 1024, 2048, (bf16_t*)(ws + WS_WQ_T) + (size_t)2048 * 1024, it - n9, lds);
        else if (it < n11) cvt_item(p.in[25], (bf16_t*)(ws + WS_SUBK), it - n10);
        else if (it < n12) cvt_fp8_item(p.in[26], ws + WS_PU, (float*)(ws + WS_PU + 24 * MiB), it - n11);
        else if (it < n13) cvt_fp8_item(p.in[27], ws + WS_PV, (float*)(ws + WS_PV + 24 * MiB), it - n12);
        else if (it < n14) prep_s5_T_item(p, it - n13);
        else if (it < n15) prep_s5_W_item(p, it - n14);
        else if (it < n16) prep_s5_V_item(p, it - n15);
        else if (it < n17) prep_al_item(p, it - n16);
        else if (it < n18) prep_rope_item(p, it - n17);
        else if (it < n19) prep_cmpbias_item(p, it - n18, lds);
        else if (it < n20) zero_item((bf16_t*)(ws + WS_WPROJ_T) + (size_t)NPROJ * 1024, it - n19);
        else if (it < n21) zero_item((bf16_t*)(ws + WS_WK2_T) + (size_t)64 * 256, it - n20);
        else zero_item((bf16_t*)(ws + WS_WV2_T) + (size_t)64 * 256, it - n21);
    }
}

__device__ __forceinline__ void phase_norm(const Params& p, const float* X, const float* gw, const float* shift, const float* scale  , bf16_t* HM) {
    const int lane = threadIdx.x & 63, wave = threadIdx.x >> 6;
    for (int row = blockIdx.x * 4 + wave; row < T; row += gridDim.x * 4) {
        const int b = row / SEQ;
        const f32x4* xr = (const f32x4*)(X + (size_t)row * D) + lane;
        f32x4 v[4]; float s = 0.f;
#pragma unroll
        for (int j = 0; j < 4; ++j) { v[j] = xr[64 * j]; s += (v[j].x * v[j].x + v[j].y * v[j].y) + (v[j].z * v[j].z + v[j].w * v[j].w); }
        const float rs = rsqrtf(wave_sum(s) * (1.0f / D) + RMS_EPS);
        u32x2* o = (u32x2*)(HM + (size_t)row * D) + lane;
#pragma unroll
        for (int j = 0; j < 4; ++j) {
            const int c = lane * 4 + 256 * j;
            const f32x4 g = *(const f32x4*)(gw + c), sh = *(const f32x4*)(shift + (size_t)b * 6144 + c), sc = *(const f32x4*)(scale + (size_t)b * 6144 + c);
            const float y0 = v[j].x * rs * g.x * (1.f + sc.x) + sh.x, y1 = v[j].y * rs * g.y * (1.f + sc.y) + sh.y;
            const float y2 = v[j].z * rs * g.z * (1.f + sc.z) + sh.z, y3 = v[j].w * rs * g.w * (1.f + sc.w) + sh.w;
            o[64 * j] = (u32x2){pk2(y0, y1), pk2(y2, y3)};
        }
    }
}
__device__ __forceinline__ void phase_final_norm(const Params& p, const float* X, float* OUT, bool dry) {
    const int lane = threadIdx.x & 63, wave = threadIdx.x >> 6;
    const float* gw = p.in[28];
    for (int row = blockIdx.x * 4 + wave; row < T; row += gridDim.x * 4) {
        const f32x4* xr = (const f32x4*)(X + (size_t)row * D) + lane;
        f32x4 v[4]; float s = 0.f;
#pragma unroll
        for (int j = 0; j < 4; ++j) { v[j] = xr[64 * j]; s += (v[j].x * v[j].x + v[j].y * v[j].y) + (v[j].z * v[j].z + v[j].w * v[j].w); }
        const float rs = rsqrtf(wave_sum(s) * (1.0f / D) + RMS_EPS);
        f32x4* o = (f32x4*)(OUT + (size_t)row * D) + lane;
#pragma unroll
        for (int j = 0; j < 4; ++j) {
            const f32x4 g = *(const f32x4*)(gw + lane * 4 + 256 * j);
            if (!dry) o[64 * j] = (f32x4){v[j].x * rs * g.x, v[j].y * rs * g.y, v[j].z * rs * g.z, v[j].w * rs * g.w};
        }
    }
}

__device__ __forceinline__ int vblock() { const int G = gridDim.x, bx = blockIdx.x; return (G % 8 == 0) ? (bx % 8) * (G / 8) + bx / 8 : bx; }
struct ALoadPlain {
    const bf16_t* A; size_t lda;
    __device__ __forceinline__ const bf16_t* ptr(int r, int k) const { return A + (size_t)r * lda + k; }
};
struct ALoadGroup {
    const bf16_t* A;
    __device__ __forceinline__ const bf16_t* ptr(int r, int k) const { return A + ((size_t)(k >> 4) * T + r) * 16 + (k & 15); }
};

template <class AL>
__device__ __forceinline__ void gemm_tile(const AL al, const bf16_t* __restrict__ Bt, size_t ldb, int nk, f32x4 (&acc)[4][4], unsigned char* lds) {
    const int tid = threadIdx.x, lane = tid & 63, wid = tid >> 6, wr = wid >> 1, wc = wid & 1, fr = lane & 15, fq = lane >> 4;
    const int lr = tid >> 3, lc = tid & 7;
#pragma unroll
    for (int mi = 0; mi < 4; ++mi)
#pragma unroll
        for (int ni = 0; ni < 4; ++ni) acc[mi][ni] = (f32x4){0.f, 0.f, 0.f, 0.f};
    u32x4 ra[4], rb[4];
    const int soff = lr * 128 + ((lc ^ (lr & 7)) << 4);
#pragma unroll
    for (int i = 0; i < 4; ++i) { ra[i] = *(const u32x4*)al.ptr(lr + 32 * i, lc * 8); rb[i] = *(const u32x4*)(Bt + (size_t)(lr + 32 * i) * ldb + lc * 8); }
#pragma unroll
    for (int i = 0; i < 4; ++i) { *(u32x4*)(lds + soff + i * 4096) = ra[i]; *(u32x4*)(lds + 16384 + soff + i * 4096) = rb[i]; }
    __syncthreads();
    const int aoff = (wr * 64 + fr) * 128, boff = 16384 + (wc * 64 + fr) * 128, sw = fr & 7;
    for (int kt = 0; kt < nk; ++kt) {
        const bool more = (kt + 1 < nk);
        if (more) {
#pragma unroll
            for (int i = 0; i < 4; ++i) { ra[i] = *(const u32x4*)al.ptr(lr + 32 * i, (kt + 1) * 64 + lc * 8); rb[i] = *(const u32x4*)(Bt + (size_t)(lr + 32 * i) * ldb + (kt + 1) * 64 + lc * 8); }
        }
        const unsigned char* buf = lds + (kt & 1) * 32768;
#pragma unroll
        for (int ks = 0; ks < 2; ++ks) {
            bf16x8 af[4], bfr[4];
            const int co = ((ks * 4 + fq) ^ sw) << 4;
#pragma unroll
            for (int mi = 0; mi < 4; ++mi) af[mi] = *(const bf16x8*)(buf + aoff + mi * 2048 + co);
#pragma unroll
            for (int ni = 0; ni < 4; ++ni) bfr[ni] = *(const bf16x8*)(buf + boff + ni * 2048 + co);
#pragma unroll
            for (int mi = 0; mi < 4; ++mi)
#pragma unroll
                for (int ni = 0; ni < 4; ++ni) acc[mi][ni] = __builtin_amdgcn_mfma_f32_16x16x32_bf16(bfr[ni], af[mi], acc[mi][ni], 0, 0, 0);
        }
        if (more) {
            unsigned char* nb = lds + ((kt + 1) & 1) * 32768;
#pragma unroll
            for (int i = 0; i < 4; ++i) { *(u32x4*)(nb + soff + i * 4096) = ra[i]; *(u32x4*)(nb + 16384 + soff + i * 4096) = rb[i]; }
        }
        __syncthreads();
    }
}
__device__ __forceinline__ void phase_s5_win(const Params& p, unsigned char* lds) {
    const bf16_t* HM = (const bf16_t*)(p.ws + WS_HM); const bf16_t* WT = (const bf16_t*)(p.ws + WS_WIN_T);
    bf16_t* UG = (bf16_t*)(p.ws + WS_UG);
    const int lane = threadIdx.x & 63, wid = threadIdx.x >> 6, wr = wid >> 1, wc = wid & 1, fr = lane & 15, fq = lane >> 4;
    for (int id = vblock(); id < 256 * 8; id += gridDim.x) {
        const int mt = id >> 3, nt = id & 7;
        f32x4 acc[4][4];
        gemm_tile(ALoadPlain{HM + (size_t)mt * 128 * D, (size_t)D}, WT + (size_t)nt * 128 * D, D, 16, acc, lds);
#pragma unroll
        for (int mi = 0; mi < 4; ++mi)
#pragma unroll
            for (int ni = 0; ni < 4; ++ni) {
                const int t = mt * 128 + wr * 64 + mi * 16 + fr, g = nt * 8 + wc * 4 + ni;
                const f32x4 v = acc[mi][ni];
                *(u32x2*)(UG + ((size_t)g * T + t) * 16 + fq * 4) = (u32x2){pk2(v.x, v.y), pk2(v.z, v.w)};
            }
    }
}
__device__ __forceinline__ void phase_s5_a(const Params& p, unsigned char* lds) {
    const bf16_t* UG = (const bf16_t*)(p.ws + WS_UG); const bf16_t* TW = (const bf16_t*)(p.ws + WS_TW);
    bf16_t* YI = (bf16_t*)(p.ws + WS_YI); float* WST = (float*)(p.ws + WS_WST);
    const int lane = threadIdx.x & 63, wid = threadIdx.x >> 6, wr = wid >> 1, wc = wid & 1, fr = lane & 15, fq = lane >> 4;
    for (int id = vblock(); id < 64 * 40; id += gridDim.x) {
        const int g = id / 40, rem = id % 40, mt = rem / 5, nt = rem % 5;
        const int nk = (nt < 4) ? 2 * (nt + 1) : 8;
        f32x4 acc[4][4];
        gemm_tile(ALoadPlain{UG + (size_t)g * T * 16 + (size_t)mt * 128 * 512, (size_t)512}, TW + ((size_t)g * 640 + nt * 128) * 512, 512, nk, acc, lds);
#pragma unroll
        for (int mi = 0; mi < 4; ++mi)
#pragma unroll
            for (int ni = 0; ni < 4; ++ni) {
                const int R = mt * 128 + wr * 64 + mi * 16 + fr, c = wc * 64 + ni * 16 + fq * 4;
                const f32x4 v = acc[mi][ni];
                if (nt < 4) *(u32x2*)(YI + ((size_t)g * 1024 + R) * 512 + nt * 128 + c) = (u32x2){pk2(v.x, v.y), pk2(v.z, v.w)};
                else *(f32x4*)(WST + ((size_t)g * 1024 + R) * 128 + c) = v;
            }
    }
}
__device__ __forceinline__ void phase_s5_scan(const Params& p) {
    const int lane = threadIdx.x & 63, wave = threadIdx.x >> 6;
    const float* WST = (const float*)(p.ws + WS_WST); bf16_t* SST = (bf16_t*)(p.ws + WS_SST);
    const f32x2* AL = (const f32x2*)(p.ws + WS_MISC + 4096);
    for (int it = blockIdx.x * 4 + wave; it < 128; it += gridDim.x * 4) {
        const int b = it >> 6, g = it & 63;
        const f32x2 al = AL[g * 64 + lane];
        float sr = 0.f, si = 0.f;
        const float* wbase = WST + ((size_t)g * 1024 + b * 512) * 128 + lane;
        bf16_t* sbase = SST + ((size_t)g * 1024 + b * 512) * 128 + lane;
        for (int n0 = 0; n0 < 512; n0 += 16) {
            float wre[16], wim[16];
#pragma unroll
            for (int j = 0; j < 16; ++j) { wre[j] = wbase[(size_t)(n0 + j) * 128]; wim[j] = wbase[(size_t)(n0 + j) * 128 + 64]; }
#pragma unroll
            for (int j = 0; j < 16; ++j) {
                sbase[(size_t)(n0 + j) * 128] = (bf16_t)f2bf(sr); sbase[(size_t)(n0 + j) * 128 + 64] = (bf16_t)f2bf(si);
                const float nr = al.x * sr - al.y * si + wre[j], ni = al.x * si + al.y * sr + wim[j];
                sr = nr; si = ni;
            }
        }
    }
}
__device__ __forceinline__ void phase_s5_b(const Params& p, unsigned char* lds) {
    const bf16_t* SST = (const bf16_t*)(p.ws + WS_SST); const bf16_t* VG = (const bf16_t*)(p.ws + WS_VG);
    const bf16_t* YI = (const bf16_t*)(p.ws + WS_YI); const bf16_t* UG = (const bf16_t*)(p.ws + WS_UG);
    bf16_t* YG = (bf16_t*)(p.ws + WS_YG);
    const float* dsk = p.in[14];
    const int lane = threadIdx.x & 63, wid = threadIdx.x >> 6, wr = wid >> 1, wc = wid & 1, fr = lane & 15, fq = lane >> 4;
    for (int id = vblock(); id < 64 * 32; id += gridDim.x) {
        const int g = id >> 5, mt = (id >> 2) & 7, nt = id & 3;
        f32x4 acc[4][4];
        gemm_tile(ALoadPlain{SST + ((size_t)g * 1024 + mt * 128) * 128, (size_t)128}, VG + ((size_t)g * 512 + nt * 128) * 128, 128, 2, acc, lds);
        const f32x4 dv = *(const f32x4*)(dsk + g * 16 + fq * 4);
#pragma unroll
        for (int mi = 0; mi < 4; ++mi)
#pragma unroll
            for (int ni = 0; ni < 4; ++ni) {
                const int R = mt * 128 + wr * 64 + mi * 16 + fr, c = nt * 128 + wc * 64 + ni * 16 + fq * 4;
                const size_t idx = ((size_t)g * 1024 + R) * 512 + c;
                const u32x2 yi = *(const u32x2*)(YI + idx), uu = *(const u32x2*)(UG + idx);
                const f32x4 v = acc[mi][ni];
                const float y0 = gelu_tanh(v.x + bflo(yi.x) + dv.x * bflo(uu.x)), y1 = gelu_tanh(v.y + bfhi(yi.x) + dv.y * bfhi(uu.x));
                const float y2 = gelu_tanh(v.z + bflo(yi.y) + dv.z * bflo(uu.y)), y3 = gelu_tanh(v.w + bfhi(yi.y) + dv.w * bfhi(uu.y));
                *(u32x2*)(YG + idx) = (u32x2){pk2(y0, y1), pk2(y2, y3)};
            }
    }
}
__device__ __forceinline__ void phase_s5_glu(const Params& p, unsigned char* lds) {
    const bf16_t* YG = (const bf16_t*)(p.ws + WS_YG); const bf16_t* WT = (const bf16_t*)(p.ws + WS_WGLU_T);
    const float* MOD = (const float*)(p.ws + WS_MOD);
    const float* X = p.in[0]; float* XO = p.out;
    const int lane = threadIdx.x & 63, wid = threadIdx.x >> 6, wr = wid >> 1, wc = wid & 1, fr = lane & 15, fq = lane >> 4;
    for (int id = vblock(); id < 256 * 16; id += gridDim.x) {
        const int mt = id >> 4, nt = id & 15;
        f32x4 acc[4][4];
        gemm_tile(ALoadGroup{YG + (size_t)mt * 128 * 16}, WT + (size_t)nt * 128 * D, D, 16, acc, lds);
        const int b = (mt * 128) / SEQ;
#pragma unroll
        for (int mi = 0; mi < 4; ++mi)
#pragma unroll
            for (int h = 0; h < 2; ++h) {
                const int t = mt * 128 + wr * 64 + mi * 16 + fr, j = nt * 64 + wc * 32 + h * 16 + fq * 4;
                const f32x4 a = acc[mi][2 * h], gg = acc[mi][2 * h + 1];
                const f32x4 g1 = *(const f32x4*)(MOD + (size_t)(0 * 2 + b) * 6144 + 2048 + j);
                const f32x4 xi = *(const f32x4*)(X + (size_t)t * D + j);
                f32x4 o;
                o.x = xi.x + g1.x * (a.x * sigmoidf_(gg.x)); o.y = xi.y + g1.y * (a.y * sigmoidf_(gg.y));
                o.z = xi.z + g1.z * (a.z * sigmoidf_(gg.z)); o.w = xi.w + g1.w * (a.w * sigmoidf_(gg.w));
                *(f32x4*)(XO + (size_t)t * D + j) = o;
            }
    }
}
__device__ __forceinline__ void phase_peer_wq(const Params& p, int layer, unsigned char* lds) {
    const bf16_t* HM = (const bf16_t*)(p.ws + WS_HM); const bf16_t* WT = (const bf16_t*)(p.ws + WS_WQ_T) + (size_t)layer * 2048 * 1024;
    bf16_t* QK = (bf16_t*)(p.ws + WS_QK);
    const int lane = threadIdx.x & 63, wid = threadIdx.x >> 6, wr = wid >> 1, wc = wid & 1, fr = lane & 15, fq = lane >> 4;
    for (int id = vblock(); id < 256 * 16; id += gridDim.x) {
        const int mt = id >> 4, nt = id & 15;
        f32x4 acc[4][4];
        gemm_tile(ALoadPlain{HM + (size_t)mt * 128 * D, (size_t)D}, WT + (size_t)nt * 128 * D, D, 16, acc, lds);
#pragma unroll
        for (int mi = 0; mi < 4; ++mi)
#pragma unroll
            for (int ni = 0; ni < 4; ++ni) {
                const int t = mt * 128 + wr * 64 + mi * 16 + fr, c = nt * 128 + wc * 64 + ni * 16 + fq * 4;
                const f32x4 v = acc[mi][ni];
                *(u32x2*)(QK + (size_t)t * 2048 + c) = (u32x2){pk2(v.x, v.y), pk2(v.z, v.w)};
            }
    }
}
__device__ __forceinline__ void ce_(unsigned& a, unsigned& b, const bool up) { const unsigned lo = a < b ? a : b, hi = a < b ? b : a; a = up ? lo : hi; b = up ? hi : lo; }
__device__ __forceinline__ void bitonic_sort16(unsigned* x, const bool asc) {
#pragma unroll
    for (int k = 2; k <= 16; k <<= 1)
#pragma unroll
        for (int j = k >> 1; j > 0; j >>= 1)
#pragma unroll
            for (int i = 0; i < 16; ++i) { const int l = i ^ j; if (l > i) ce_(x[i], x[l], ((i & k) == 0) == asc); }
}
__device__ __forceinline__ void bitonic_merge16(unsigned* x, const bool asc) {
#pragma unroll
    for (int j = 8; j > 0; j >>= 1)
#pragma unroll
        for (int i = 0; i < 16; ++i) { const int l = i ^ j; if (l > i) ce_(x[i], x[l], asc); }
}
__device__ __forceinline__ void phase_peer_topk(const Params& p, int layer, unsigned char* lds) {
    const bf16_t* QK = (const bf16_t*)(p.ws + WS_QK); const bf16_t* SK = (const bf16_t*)(p.ws + WS_SUBK) + (size_t)layer * 8 * 2 * 128 * 128;
    float* TOPS = (float*)(p.ws + WS_TOPS); int* TOPI = (int*)(p.ws + WS_TOPI);
    float* sc = (float*)lds;
    const int tid = threadIdx.x, lane = tid & 63, wid = tid >> 6, wr = wid >> 1, wc = wid & 1, fr = lane & 15, fq = lane >> 4;
    for (int id = vblock(); id < 256 * 16; id += gridDim.x) {
        const int mt = id >> 4, hc = id & 15;
        f32x4 acc[4][4];
        gemm_tile(ALoadPlain{QK + (size_t)mt * 128 * 2048 + hc * 128, (size_t)2048}, SK + (size_t)hc * 128 * 128, 128, 2, acc, lds);
#pragma unroll
        for (int mi = 0; mi < 4; ++mi)
#pragma unroll
            for (int ni = 0; ni < 4; ++ni) {
                const int r = wr * 64 + mi * 16 + fr, c = wc * 64 + ni * 16 + fq * 4;
                float* d = sc + r * 129 + c;
                d[0] = acc[mi][ni].x; d[1] = acc[mi][ni].y; d[2] = acc[mi][ni].z; d[3] = acc[mi][ni].w;
            }
        __syncthreads();
        {
            const int row = tid >> 1, half = tid & 1;
            unsigned x[64];
            const float* rp = sc + row * 129 + half * 64;
#pragma unroll
            for (int j = 0; j < 64; ++j) {
                const unsigned bits = __builtin_bit_cast(unsigned, rp[j]);
                const unsigned u = bits ^ ((unsigned)((int)bits >> 31) | 0x80000000u);
                x[j] = (u & 0xFFFFFF80u) | (unsigned)(127 - (half * 64 + j));
            }
            bitonic_sort16(x, true); bitonic_sort16(x + 16, false); bitonic_sort16(x + 32, true); bitonic_sort16(x + 48, false);
#pragma unroll
            for (int i = 0; i < 16; ++i) { x[i] = x[i] > x[16 + i] ? x[i] : x[16 + i]; x[32 + i] = x[32 + i] > x[48 + i] ? x[32 + i] : x[48 + i]; }
            bitonic_merge16(x, true); bitonic_merge16(x + 32, false);
#pragma unroll
            for (int i = 0; i < 16; ++i) x[i] = x[i] > x[32 + i] ? x[i] : x[32 + i];
            bitonic_merge16(x, false);
            unsigned y[16];
#pragma unroll
            for (int i = 0; i < 16; ++i) { const unsigned o = (unsigned)__shfl_xor((int)x[15 - i], 1); y[i] = x[i] > o ? x[i] : o; }
            bitonic_merge16(y, false);
            const size_t ob = ((size_t)(mt * 128 + row) * 16 + hc) * 16;
            if (half == 0) {
                float v[16];
#pragma unroll
                for (int i = 0; i < 16; ++i) { const unsigned u = y[i] & 0xFFFFFF80u; const unsigned bits = (u & 0x80000000u) ? (u ^ 0x80000000u) : ~u; v[i] = __builtin_bit_cast(float, bits); }
#pragma unroll
                for (int q = 0; q < 4; ++q) *(f32x4*)(TOPS + ob + q * 4) = (f32x4){v[q * 4], v[q * 4 + 1], v[q * 4 + 2], v[q * 4 + 3]};
            } else {
#pragma unroll
                for (int q = 0; q < 4; ++q) *(u32x4*)(TOPI + ob + q * 4) = (u32x4){127u - (y[q * 4] & 127u), 127u - (y[q * 4 + 1] & 127u), 127u - (y[q * 4 + 2] & 127u), 127u - (y[q * 4 + 3] & 127u)};
            }
        }
        __syncthreads();
    }
}
__device__ __forceinline__ void phase_peer_combine(const Params& p, unsigned char* lds) {
    const float* TOPS = (const float*)(p.ws + WS_TOPS); const int* TOPI = (const int*)(p.ws + WS_TOPI);
    int* EXP = (int*)(p.ws + WS_EXP); float* GATE = (float*)(p.ws + WS_GATE);
    unsigned* L = (unsigned*)lds;
    const int tid = threadIdx.x;
    for (int it = blockIdx.x; it < (T * 8) / 256; it += gridDim.x) {
        const size_t th = (size_t)it * 256 + tid;
        const u32x4* S4 = (const u32x4*)(TOPS + th * 32); const u32x4* I4 = (const u32x4*)(TOPI + th * 32);
#pragma unroll
        for (int a4 = 0; a4 < 8; ++a4) {
            const u32x4 s = S4[a4], i = I4[a4];
            L[(a4 * 4 + 0) * 256 + tid] = s.x; L[(a4 * 4 + 1) * 256 + tid] = s.y; L[(a4 * 4 + 2) * 256 + tid] = s.z; L[(a4 * 4 + 3) * 256 + tid] = s.w;
            L[(32 + a4 * 4 + 0) * 256 + tid] = i.x; L[(32 + a4 * 4 + 1) * 256 + tid] = i.y; L[(32 + a4 * 4 + 2) * 256 + tid] = i.z; L[(32 + a4 * 4 + 3) * 256 + tid] = i.w;
        }
        float val[16];
        const float s20 = __builtin_bit_cast(float, L[16 * 256 + tid]);
#pragma unroll
        for (int a = 0; a < 16; ++a) val[a] = __builtin_bit_cast(float, L[a * 256 + tid]) + s20;
        unsigned long long P = 0ull;
        float ts[16]; int te[16];
#pragma unroll
        for (int r = 0; r < 16; ++r) {
            float best = val[0]; int ba = 0;
#pragma unroll
            for (int a = 1; a < 16; ++a) if (val[a] > best) { best = val[a]; ba = a; }
            const int b = (int)((P >> (4 * ba)) & 15ull);
            const int i1 = (int)L[(32 + ba) * 256 + tid], i2 = (int)L[(48 + b) * 256 + tid];
            ts[r] = best; te[r] = i1 * 128 + i2;
            const int nb = b + 1;
            float newv = -3.0e38f;
            if (nb < 16) { newv = __builtin_bit_cast(float, L[ba * 256 + tid]) + __builtin_bit_cast(float, L[(16 + nb) * 256 + tid]); P += 1ull << (4 * ba); }
#pragma unroll
            for (int a = 0; a < 16; ++a) val[a] = (a == ba) ? newv : val[a];
        }
        const float m0 = ts[0];
        float sum = 0.f;
#pragma unroll
        for (int r = 0; r < 16; ++r) { ts[r] = __expf(ts[r] - m0); sum += ts[r]; }
        const float inv = 1.0f / sum;
#pragma unroll
        for (int r = 0; r < 16; ++r) ts[r] *= inv;
#pragma unroll
        for (int r = 0; r < 16; ++r) { EXP[th * 16 + r] = te[r]; GATE[th * 16 + r] = ts[r]; }
    }
}

__device__ __forceinline__ void fma8(const unsigned w0, const unsigned w1, const float a, float* acc) {
    const f32x2 p0 = __builtin_amdgcn_cvt_pk_f32_fp8((int)w0, false), p1 = __builtin_amdgcn_cvt_pk_f32_fp8((int)w0, true);
    const f32x2 p2 = __builtin_amdgcn_cvt_pk_f32_fp8((int)w1, false), p3 = __builtin_amdgcn_cvt_pk_f32_fp8((int)w1, true);
    acc[0] += a * p0.x; acc[1] += a * p0.y; acc[2] += a * p1.x; acc[3] += a * p1.y;
    acc[4] += a * p2.x; acc[5] += a * p2.y; acc[6] += a * p3.x; acc[7] += a * p3.y;
}
__device__ __forceinline__ float dot8(const unsigned w0, const unsigned w1, const float* h, float s) {
    const f32x2 p0 = __builtin_amdgcn_cvt_pk_f32_fp8((int)w0, false), p1 = __builtin_amdgcn_cvt_pk_f32_fp8((int)w0, true);
    const f32x2 p2 = __builtin_amdgcn_cvt_pk_f32_fp8((int)w1, false), p3 = __builtin_amdgcn_cvt_pk_f32_fp8((int)w1, true);
    s += p0.x * h[0]; s += p0.y * h[1]; s += p1.x * h[2]; s += p1.y * h[3];
    s += p2.x * h[4]; s += p2.y * h[5]; s += p3.x * h[6]; s += p3.y * h[7];
    return s;
}
__device__ __forceinline__ void phase_peer_apply(const Params& p, int layer, unsigned char* lds, bool dry) {
    const int lane = threadIdx.x & 63, wave = threadIdx.x >> 6;
    float* ldsw = (float*)lds + wave * (64 * 65);
    const bf16_t* HM = (const bf16_t*)(p.ws + WS_HM);
    const unsigned char* PU = p.ws + WS_PU; const unsigned char* PV = p.ws + WS_PV;
    const float* SU = (const float*)(p.ws + WS_PU + 24 * MiB); const float* SV = (const float*)(p.ws + WS_PV + 24 * MiB);
    const int* EXP = (const int*)(p.ws + WS_EXP); const float* GATE = (const float*)(p.ws + WS_GATE);
    const float* MOD = (const float*)(p.ws + WS_MOD);
    float* X = p.out;
    for (int t = blockIdx.x * 4 + wave; t < T; t += gridDim.x * 4) {
        const u32x4 ha = *(const u32x4*)(HM + (size_t)t * D + lane * 16), hb = *(const u32x4*)(HM + (size_t)t * D + lane * 16 + 8);
        float hf[16];
        hf[0] = bflo(ha.x); hf[1] = bfhi(ha.x); hf[2] = bflo(ha.y); hf[3] = bfhi(ha.y); hf[4] = bflo(ha.z); hf[5] = bfhi(ha.z); hf[6] = bflo(ha.w); hf[7] = bfhi(ha.w);
        hf[8] = bflo(hb.x); hf[9] = bfhi(hb.x); hf[10] = bflo(hb.y); hf[11] = bfhi(hb.y); hf[12] = bflo(hb.z); hf[13] = bfhi(hb.z); hf[14] = bflo(hb.w); hf[15] = bfhi(hb.w);
        const int e0 = EXP[(size_t)t * 128 + lane], e1 = EXP[(size_t)t * 128 + 64 + lane];
        const float g0 = GATE[(size_t)t * 128 + lane], g1 = GATE[(size_t)t * 128 + 64 + lane];
        const float su0 = SU[e0], su1 = SU[e1], sv0 = SV[e0], sv1 = SV[e1];
        float act0 = 0.f, act1 = 0.f;
#pragma unroll
        for (int half = 0; half < 2; ++half) {
            const int ev = half ? e1 : e0;
#pragma unroll 1
            for (int jg = 0; jg < 4; ++jg) {
                u32x4 ua[16];
#pragma unroll
                for (int j = 0; j < 16; ++j) {
                    const int e = __builtin_amdgcn_readlane(ev, jg * 16 + j);
                    ua[j] = *(const u32x4*)(PU + (size_t)e * D + lane * 16);
                }
#pragma unroll
                for (int j = 0; j < 16; ++j) {
                    float s = dot8(ua[j].x, ua[j].y, hf, 0.f);
                    s = dot8(ua[j].z, ua[j].w, hf + 8, s);
                    ldsw[(jg * 16 + j) * 65 + lane] = s;
                }
            }
            float tot = 0.f;
#pragma unroll 16
            for (int k = 0; k < 64; ++k) tot += ldsw[lane * 65 + k];
            const float a = gelu_tanh(tot * (half ? su1 : su0)) * (half ? g1 : g0) * (half ? sv1 : sv0);
            if (half) act1 = a; else act0 = a;
        }
        float acc[16];
#pragma unroll
        for (int i = 0; i < 16; ++i) acc[i] = 0.f;
#pragma unroll
        for (int half = 0; half < 2; ++half) {
            const int ev = half ? e1 : e0; const float av = half ? act1 : act0;
#pragma unroll 1
            for (int jg = 0; jg < 4; ++jg) {
                u32x4 va[16];
#pragma unroll
                for (int j = 0; j < 16; ++j) {
                    const int e = __builtin_amdgcn_readlane(ev, jg * 16 + j);
                    va[j] = *(const u32x4*)(PV + (size_t)e * D + lane * 16);
                }
#pragma unroll
                for (int j = 0; j < 16; ++j) {
                    const float a = __builtin_bit_cast(float, __builtin_amdgcn_readlane(__builtin_bit_cast(int, av), jg * 16 + j));
                    fma8(va[j].x, va[j].y, a, acc);
                    fma8(va[j].z, va[j].w, a, acc + 8);
                }
            }
        }
        const int b = t / SEQ;
        const float* g2 = MOD + (size_t)(layer * 2 + b) * 6144 + 5120;
        float* xr = X + (size_t)t * D + lane * 16;
#pragma unroll
        for (int q = 0; q < 4; ++q) {
            const f32x4 g = *(const f32x4*)(g2 + lane * 16 + q * 4); f32x4 x = *(const f32x4*)(xr + q * 4);
            x.x += g.x * acc[q * 4 + 0]; x.y += g.y * acc[q * 4 + 1]; x.z += g.z * acc[q * 4 + 2]; x.w += g.w * acc[q * 4 + 3];
            if (!dry) *(f32x4*)(xr + q * 4) = x;
        }
    }
}
__device__ __forceinline__ void phase_tab1(const Params& p) {
    for (int it = blockIdx.x; it < 2 * P0_TAB; it += gridDim.x) {
        if (it < P0_TAB) cvt_fp8_item(p.in[26] + (size_t)PE * D, p.ws + WS_PU, (float*)(p.ws + WS_PU + 24 * MiB), it);
        else cvt_fp8_item(p.in[27] + (size_t)PE * D, p.ws + WS_PV, (float*)(p.ws + WS_PV + 24 * MiB), it - P0_TAB);
    }
}
__device__ __forceinline__ void phase_nsa_proj(const Params& p, unsigned char* lds) {
    const bf16_t* HM = (const bf16_t*)(p.ws + WS_HM); const bf16_t* WT = (const bf16_t*)(p.ws + WS_WPROJ_T);
    const f32x2* ROPE = (const f32x2*)(p.ws + WS_ROPE);
    bf16_t* Q = (bf16_t*)(p.ws + WS_Q); float* NGT = (float*)(p.ws + WS_NG);
    const int lane = threadIdx.x & 63, wid = threadIdx.x >> 6, wr = wid >> 1, wc = wid & 1, fr = lane & 15, fq = lane >> 4;
    for (int id = vblock(); id < 256 * 21; id += gridDim.x) {
        const int mt = id / 21, nt = id % 21;
        f32x4 acc[4][4];
        gemm_tile(ALoadPlain{HM + (size_t)mt * 128 * D, (size_t)D}, WT + (size_t)nt * 128 * D, D, 16, acc, lds);
        const int c0 = nt * 128 + wc * 64;
        if (c0 >= 2624) continue;
        const int b = (mt * 128) / SEQ;
        if (c0 == 2560) {
#pragma unroll
            for (int mi = 0; mi < 4; ++mi)
#pragma unroll
                for (int ni = 0; ni < 3; ++ni) {
                    const int t = mt * 128 + wr * 64 + mi * 16 + fr;
                    const f32x4 v = acc[mi][ni];
                    *(f32x4*)(NGT + (size_t)t * 48 + ni * 16 + fq * 4) = (f32x4){sigmoidf_(v.x), sigmoidf_(v.y), sigmoidf_(v.z), sigmoidf_(v.w)};
                }
            continue;
        }
        int sec = -1, g = 0;
        if (c0 >= 1024) { sec = (c0 - 1024) >> 8; g = ((c0 - 1024) & 255) >> 6; }
        const bool dorope = (sec == -1) || (sec == 2) || (sec == 4);
        const float scl = (sec == -1) ? 0.125f : 1.0f;
        const size_t secoff[6] = {WS_KC, WS_VC, WS_KS, WS_VST, WS_KW, WS_VWT};
        size_t so = WS_Q;
#pragma unroll
        for (int q = 0; q < 6; ++q) if (sec == q) so = secoff[q];
        bf16_t* OUT = (bf16_t*)(p.ws + so);
        const bool vt = (sec == 3) || (sec == 5);
        float kblk_am = 0.f;
#pragma unroll
        for (int pass = 0; pass < 2; ++pass) {
        if (pass == 1 && sec == 2) {
#pragma unroll
            for (int o = 1; o < 64; o <<= 1) kblk_am = fmaxf(kblk_am, __shfl_xor(kblk_am, o));
            if (lane == 0) ((float*)(p.ws + WS_KS + 12 * MiB))[(size_t)(b * 4 + g) * 256 + ((mt * 128 + wr * 64 - b * SEQ) >> 6)] = kblk_am > 0.f ? kblk_am / 224.0f : 1.0f;
        }
#pragma unroll
        for (int mi = 0; mi < 4; ++mi) {
            const int t = mt * 128 + wr * 64 + mi * 16 + fr, s = t - b * SEQ;
            if (dorope && pass == 0) {
#pragma unroll
                for (int ni = 0; ni < 2; ++ni) {
                    const f32x4* rp = (const f32x4*)(ROPE + (size_t)s * 32 + ni * 16 + fq * 4);
                    const f32x4 r0 = rp[0], r1 = rp[1];
                    const f32x4 x1 = acc[mi][ni], x2 = acc[mi][ni + 2];
                    acc[mi][ni] = (f32x4){x1.x * r0.x - x2.x * r0.y, x1.y * r0.z - x2.y * r0.w, x1.z * r1.x - x2.z * r1.y, x1.w * r1.z - x2.w * r1.w};
                    acc[mi][ni + 2] = (f32x4){x1.x * r0.y + x2.x * r0.x, x1.y * r0.w + x2.y * r0.z, x1.z * r1.y + x2.z * r1.x, x1.w * r1.w + x2.w * r1.z};
                }
            }
            if (pass == 0) {
                if (sec == 2) {
#pragma unroll
                    for (int ni = 0; ni < 4; ++ni) { const f32x4 v = acc[mi][ni]; kblk_am = fmaxf(kblk_am, fmaxf(fmaxf(fabsf(v.x), fabsf(v.y)), fmaxf(fabsf(v.z), fabsf(v.w)))); }
                }
                continue;
            }
            if (sec == -1 || sec == 2) {
                float am = kblk_am;
                if (sec == -1) {
                    am = 0.f;
#pragma unroll
                    for (int ni = 0; ni < 4; ++ni) { const f32x4 v = acc[mi][ni] * scl; am = fmaxf(am, fmaxf(fmaxf(fabsf(v.x), fabsf(v.y)), fmaxf(fabsf(v.z), fabsf(v.w)))); }
                    am = fmaxf(am, __shfl_xor(am, 16)); am = fmaxf(am, __shfl_xor(am, 32));
                }
                const float qs = am > 0.f ? 224.0f / am : 1.0f;
                unsigned char* O8 = (sec == -1) ? (p.ws + WS_Q8 + (size_t)t * 1024 + c0) : (p.ws + WS_KS + ((size_t)(b * 4 + g) * SEQ + s) * 64);
#pragma unroll
                for (int ni = 0; ni < 4; ++ni) {
                    const f32x4 v = acc[mi][ni] * (scl * qs);
                    int w = 0; w = __builtin_amdgcn_cvt_pk_fp8_f32(v.x, v.y, w, false); w = __builtin_amdgcn_cvt_pk_fp8_f32(v.z, v.w, w, true);
                    *(int*)(O8 + ni * 16 + fq * 4) = w;
                }
                if (fq == 0 && sec == -1) ((float*)(p.ws + WS_Q8 + 32 * MiB))[(size_t)t * 16 + (c0 >> 6)] = am > 0.f ? am / 224.0f : 1.0f;
            }
            if (sec == 2) continue;
#pragma unroll
            for (int ni = 0; ni < 4; ++ni) {
                const f32x4 v = acc[mi][ni] * scl;
                const int d = ni * 16 + fq * 4;
                if (sec == -1) {
                    *(u32x2*)(OUT + (size_t)t * 1024 + c0 + d) = (u32x2){pk2(v.x, v.y), pk2(v.z, v.w)};
                } else if (!vt) {
                    *(u32x2*)(OUT + ((size_t)(b * 4 + g) * SEQ + s) * 64 + d) = (u32x2){pk2(v.x, v.y), pk2(v.z, v.w)};
                } else if (sec == 5) {
                    bf16_t* o = OUT + ((size_t)(b * 4 + g) * 64 + d) * SEQ + s;
                    o[0] = (bf16_t)f2bf(v.x); o[SEQ] = (bf16_t)f2bf(v.y); o[2 * SEQ] = (bf16_t)f2bf(v.z); o[3 * SEQ] = (bf16_t)f2bf(v.w);
                }
            }
        }
        }
        if (sec == 3) {
            const int s0 = mt * 128 + wr * 64 - b * SEQ, jb = s0 >> 6;
            unsigned char* V8 = p.ws + WS_VST + (size_t)((b * 4 + g) * 256 + jb) * 4096;
            float am = 0.f;
#pragma unroll
            for (int mi = 0; mi < 4; ++mi)
#pragma unroll
                for (int ni = 0; ni < 4; ++ni) { const f32x4 v = acc[mi][ni]; am = fmaxf(am, fmaxf(fmaxf(fabsf(v.x), fabsf(v.y)), fmaxf(fabsf(v.z), fabsf(v.w)))); }
#pragma unroll
            for (int o = 1; o < 64; o <<= 1) am = fmaxf(am, __shfl_xor(am, o));
            const float qs = am > 0.f ? 224.0f / am : 1.0f;
            if (lane == 0) ((float*)(p.ws + WS_VST + 12 * MiB))[(size_t)(b * 4 + g) * 256 + jb] = am > 0.f ? am / 224.0f : 1.0f;
#pragma unroll
            for (int ni = 0; ni < 4; ++ni) {
                const int d = ni * 16 + fq * 4;
#pragma unroll
                for (int mi = 0; mi < 4; ++mi) {
                    const f32x4 v = acc[mi][ni] * qs;
                    int w = 0; w = __builtin_amdgcn_cvt_pk_fp8_f32(v.x, v.y, w, false); w = __builtin_amdgcn_cvt_pk_fp8_f32(v.z, v.w, w, true);
                    unsigned char* o = V8 + (size_t)d * 64 + mi * 16 + fr;
                    o[0] = (unsigned char)(w & 255); o[64] = (unsigned char)((w >> 8) & 255); o[128] = (unsigned char)((w >> 16) & 255); o[192] = (unsigned char)((unsigned)w >> 24);
                }
            }
        }
    }
}
__device__ __forceinline__ void phase_nsa_cmp1(const Params& p, unsigned char* lds) {
    bf16_t* HID = (bf16_t*)(p.ws + WS_HID);
    const float* bias = (const float*)(p.ws + WS_MISC);
    const int lane = threadIdx.x & 63, wid = threadIdx.x >> 6, wr = wid >> 1, wc = wid & 1, fr = lane & 15, fq = lane >> 4;
    for (int id = vblock(); id < 256; id += gridDim.x) {
        const int kv = id >> 7, bg = (id >> 4) & 7, mt = (id >> 1) & 7, nt = id & 1;
        const bf16_t* A = (const bf16_t*)(p.ws + (kv ? WS_VC : WS_KC)) + (size_t)bg * SEQ * 64 + (size_t)mt * 128 * 1024;
        const bf16_t* B = (const bf16_t*)(p.ws + (kv ? WS_WV1_T : WS_WK1_T)) + (size_t)nt * 128 * 2048;
        f32x4 acc[4][4];
        gemm_tile(ALoadPlain{A, (size_t)1024}, B, 2048, 32, acc, lds);
#pragma unroll
        for (int mi = 0; mi < 4; ++mi)
#pragma unroll
            for (int ni = 0; ni < 4; ++ni) {
                const int n = mt * 128 + wr * 64 + mi * 16 + fr, c = nt * 128 + wc * 64 + ni * 16 + fq * 4;
                const f32x4 bv = *(const f32x4*)(bias + kv * 256 + c);
                const f32x4 v = acc[mi][ni] + bv;
                *(u32x2*)(HID + (((size_t)kv * 8 + bg) * 1024 + n) * 256 + c) = (u32x2){pk2(gelu_tanh(v.x), gelu_tanh(v.y)), pk2(gelu_tanh(v.z), gelu_tanh(v.w))};
            }
    }
}
__device__ __forceinline__ void phase_nsa_cmp2(const Params& p, unsigned char* lds) {
    const bf16_t* HID = (const bf16_t*)(p.ws + WS_HID);
    const f32x2* ROPE = (const f32x2*)(p.ws + WS_ROPE);
    bf16_t* KCMP = (bf16_t*)(p.ws + WS_KCMP); bf16_t* VCMPT = (bf16_t*)(p.ws + WS_VCMPT);
    const int lane = threadIdx.x & 63, wid = threadIdx.x >> 6, wr = wid >> 1, wc = wid & 1, fr = lane & 15, fq = lane >> 4;
    for (int id = vblock(); id < 128; id += gridDim.x) {
        const int kv = id >> 6, mt = id & 63;
        const bf16_t* A = HID + ((size_t)kv * 8192 + (size_t)mt * 128) * 256;
        const bf16_t* B = (const bf16_t*)(p.ws + (kv ? WS_WV2_T : WS_WK2_T));
        f32x4 acc[4][4];
        gemm_tile(ALoadPlain{A, (size_t)256}, B, 256, 4, acc, lds);
        if (wc == 1) continue;
#pragma unroll
        for (int mi = 0; mi < 4; ++mi) {
            const int R = mt * 128 + wr * 64 + mi * 16 + fr, bg = R >> 10, n = R & 1023;
            if (kv == 0) {
                int pos = n * 16 + 31; pos = pos > SEQ - 1 ? SEQ - 1 : pos;
#pragma unroll
                for (int ni = 0; ni < 2; ++ni) {
                    const f32x4* rp = (const f32x4*)(ROPE + (size_t)pos * 32 + ni * 16 + fq * 4);
                    const f32x4 r0 = rp[0], r1 = rp[1];
                    const f32x4 x1 = acc[mi][ni], x2 = acc[mi][ni + 2];
                    acc[mi][ni] = (f32x4){x1.x * r0.x - x2.x * r0.y, x1.y * r0.z - x2.y * r0.w, x1.z * r1.x - x2.z * r1.y, x1.w * r1.z - x2.w * r1.w};
                    acc[mi][ni + 2] = (f32x4){x1.x * r0.y + x2.x * r0.x, x1.y * r0.w + x2.y * r0.z, x1.z * r1.y + x2.z * r1.x, x1.w * r1.w + x2.w * r1.z};
                }
#pragma unroll
                for (int ni = 0; ni < 4; ++ni) {
                    const f32x4 v = acc[mi][ni];
                    *(u32x2*)(KCMP + ((size_t)bg * 1024 + n) * 64 + ni * 16 + fq * 4) = (u32x2){pk2(v.x, v.y), pk2(v.z, v.w)};
                }
            } else {
#pragma unroll
                for (int ni = 0; ni < 4; ++ni) {
                    const f32x4 v = acc[mi][ni];
                    bf16_t* o = VCMPT + ((size_t)bg * 64 + ni * 16 + fq * 4) * 1024 + n;
                    o[0] = (bf16_t)f2bf(v.x); o[1024] = (bf16_t)f2bf(v.y); o[2048] = (bf16_t)f2bf(v.z); o[3072] = (bf16_t)f2bf(v.w);
                }
            }
        }
    }
}
__device__ __forceinline__ void phase_nsa_wo(const Params& p, unsigned char* lds, bool dry) {
    const bf16_t* O = (const bf16_t*)(p.ws + WS_O); const bf16_t* WT = (const bf16_t*)(p.ws + WS_WO_T);
    const float* MOD = (const float*)(p.ws + WS_MOD);
    float* X = p.out;
    const int lane = threadIdx.x & 63, wid = threadIdx.x >> 6, wr = wid >> 1, wc = wid & 1, fr = lane & 15, fq = lane >> 4;
    for (int id = vblock(); id < 256 * 8; id += gridDim.x) {
        const int mt = id >> 3, nt = id & 7;
        f32x4 acc[4][4];
        gemm_tile(ALoadPlain{O + (size_t)mt * 128 * D, (size_t)D}, WT + (size_t)nt * 128 * D, D, 16, acc, lds);
        const int b = (mt * 128) / SEQ;
#pragma unroll
        for (int mi = 0; mi < 4; ++mi)
#pragma unroll
            for (int ni = 0; ni < 4; ++ni) {
                const int t = mt * 128 + wr * 64 + mi * 16 + fr, c = nt * 128 + wc * 64 + ni * 16 + fq * 4;
                const f32x4 g1 = *(const f32x4*)(MOD + (size_t)(1 * 2 + b) * 6144 + 2048 + c);
                float* xp = X + (size_t)t * D + c;
                const f32x4 x = *(const f32x4*)xp; const f32x4 v = acc[mi][ni];
                if (!dry) *(f32x4*)xp = (f32x4){x.x + g1.x * v.x, x.y + g1.y * v.y, x.z + g1.z * v.z, x.w + g1.w * v.w};
            }
    }
}
__device__ __forceinline__ bf16x8 pack8(const f32x4 a, const f32x4 b) {
    u32x4 w; w.x = pk2(a.x, a.y); w.y = pk2(a.z, a.w); w.z = pk2(b.x, b.y); w.w = pk2(b.z, b.w);
    return __builtin_bit_cast(bf16x8, w);
}
__device__ __forceinline__ bf16x8 ldv8(const bf16_t* plo, const bf16_t* phi) {
    const u32x2 lo = *(const u32x2*)plo, hi = *(const u32x2*)phi;
    u32x4 w; w.x = lo.x; w.y = lo.y; w.z = hi.x; w.w = hi.y;
    return __builtin_bit_cast(bf16x8, w);
}
__device__ __forceinline__ float red4(float v) { v += __shfl_xor(v, 16); v += __shfl_xor(v, 32); return v; }
__device__ __forceinline__ float max4(float v) { v = fmaxf(v, __shfl_xor(v, 16)); v = fmaxf(v, __shfl_xor(v, 32)); return v; }
#define NEGBIG (-1.0e30f)

__device__ __forceinline__ void phase_nsa_attn(const Params& p, unsigned char* lds, const int rep_cmp, const int rep_win, const int rep_sel) {
    const int lane = threadIdx.x & 63, wave = threadIdx.x >> 6, fr = lane & 15, fq = lane >> 4;
    unsigned char* WL = lds + wave * 18432;
    float* IMP = (float*)WL;
    int* SEL = (int*)(WL + 17408);
    const bf16_t* Q = (const bf16_t*)(p.ws + WS_Q);
    const bf16_t* KCMP = (const bf16_t*)(p.ws + WS_KCMP); const bf16_t* VCMPT = (const bf16_t*)(p.ws + WS_VCMPT);
    const bf16_t* KW = (const bf16_t*)(p.ws + WS_KW); const bf16_t* VWT = (const bf16_t*)(p.ws + WS_VWT);
    const float* NGT = (const float*)(p.ws + WS_NG);
    bf16_t* O = (bf16_t*)(p.ws + WS_O);
    const f32x4 z4 = (f32x4){0.f, 0.f, 0.f, 0.f};
    for (int bi = blockIdx.x; bi < 2048; bi += gridDim.x) {
        const int bg = bi & 7, quad = 255 - (bi >> 3), t0 = (quad * 4 + wave) * 16, b = bg >> 2, g = bg & 3;
        const int cur = t0 >> 6;
        const size_t tok = (size_t)b * SEQ + t0 + fr;
        const int tq = t0 + fr;
        bf16x8 qf[4][2];
#pragma unroll
        for (int r = 0; r < 4; ++r)
#pragma unroll
            for (int ks = 0; ks < 2; ++ks) qf[r][ks] = *(const bf16x8*)(Q + tok * 1024 + (g * 4 + r) * 64 + ks * 32 + fq * 8);
        float gc[4], gw[4];
#pragma unroll
        for (int r = 0; r < 4; ++r) { const float* gp = NGT + tok * 48 + (g * 4 + r) * 3; gc[r] = gp[0]; gw[r] = gp[2]; }
        f32x4 acc[4][4];
        for (int rep = 0; rep < rep_win; ++rep) {
            const bf16_t* kwb = KW + (size_t)bg * SEQ * 64; const bf16_t* vwb = VWT + (size_t)bg * 64 * SEQ;
            float mw[4], lw[4];
#pragma unroll
            for (int r = 0; r < 4; ++r) { mw[r] = NEGBIG; lw[r] = 0.f;
#pragma unroll
                for (int df = 0; df < 4; ++df) acc[r][df] = z4; }
            int kmin = t0 - 511; kmin = kmin < 0 ? 0 : kmin; kmin &= ~31;
            for (int kb = kmin; kb <= t0 + 15; kb += 32) {
                bf16x8 kf[2][2];
#pragma unroll
                for (int f = 0; f < 2; ++f)
#pragma unroll
                    for (int ks = 0; ks < 2; ++ks) kf[f][ks] = *(const bf16x8*)(kwb + (size_t)(kb + f * 16 + fr) * 64 + ks * 32 + fq * 8);
                bf16x8 vf[4];
#pragma unroll
                for (int df = 0; df < 4; ++df) { const bf16_t* vp = vwb + (size_t)(df * 16 + fr) * SEQ + kb + 4 * fq; vf[df] = ldv8(vp, vp + 16); }
#pragma unroll
                for (int r = 0; r < 4; ++r) {
                    f32x4 st[2];
#pragma unroll
                    for (int f = 0; f < 2; ++f) {
                        st[f] = __builtin_amdgcn_mfma_f32_16x16x32_bf16(kf[f][0], qf[r][0], z4, 0, 0, 0);
                        st[f] = __builtin_amdgcn_mfma_f32_16x16x32_bf16(kf[f][1], qf[r][1], st[f], 0, 0, 0);
                    }
                    float mx = NEGBIG;
#pragma unroll
                    for (int f = 0; f < 2; ++f)
#pragma unroll
                        for (int e = 0; e < 4; ++e) { const int key = kb + f * 16 + fq * 4 + e; const bool ok = (key <= tq) && (key > tq - 512); if (ok) mx = fmaxf(mx, st[f][e]); }
                    mx = max4(mx);
                    const float mn = fmaxf(mw[r], mx);
                    const float al = __expf(mw[r] - mn);
                    float ps = 0.f;
#pragma unroll
                    for (int f = 0; f < 2; ++f)
#pragma unroll
                        for (int e = 0; e < 4; ++e) { const int key = kb + f * 16 + fq * 4 + e; const bool ok = (key <= tq) && (key > tq - 512); const float pv = ok ? __expf(st[f][e] - mn) : 0.f; st[f][e] = pv; ps += pv; }
                    lw[r] = lw[r] * al + ps; mw[r] = mn;
                    const bf16x8 pf = pack8(st[0], st[1]);
#pragma unroll
                    for (int df = 0; df < 4; ++df) { acc[r][df] = acc[r][df] * al; acc[r][df] = __builtin_amdgcn_mfma_f32_16x16x32_bf16(vf[df], pf, acc[r][df], 0, 0, 0); }
                    __builtin_amdgcn_sched_barrier(0);
                }
            }
#pragma unroll
            for (int r = 0; r < 4; ++r) {
                const float l = red4(lw[r]); const float sc = gw[r] / l;
#pragma unroll
                for (int df = 0; df < 4; ++df) acc[r][df] = acc[r][df] * sc;
            }
        }
        const int nmax_tile = (t0 >> 4) - 1, nmax_lane = (t0 >> 4) - 2 + (fr == 15 ? 1 : 0);
        const bf16_t* kcb = KCMP + (size_t)bg * 1024 * 64; const bf16_t* vcb = VCMPT + (size_t)bg * 64 * 1024;
        for (int rep = 0; rep < rep_cmp; ++rep) {
            const bool dry = (rep + 1 < rep_cmp);
            float mc[4], lc[4], invl[4];
#pragma unroll
            for (int r = 0; r < 4; ++r) { mc[r] = NEGBIG; lc[r] = 0.f; }
            for (int nb = 0; nb <= nmax_tile; nb += 32) {
                bf16x8 kf[2][2];
#pragma unroll
                for (int f = 0; f < 2; ++f)
#pragma unroll
                    for (int ks = 0; ks < 2; ++ks) kf[f][ks] = *(const bf16x8*)(kcb + (size_t)(nb + f * 16 + fr) * 64 + ks * 32 + fq * 8);
#pragma unroll
                for (int r = 0; r < 4; ++r) {
                    f32x4 st[2];
#pragma unroll
                    for (int f = 0; f < 2; ++f) {
                        st[f] = __builtin_amdgcn_mfma_f32_16x16x32_bf16(kf[f][0], qf[r][0], z4, 0, 0, 0);
                        st[f] = __builtin_amdgcn_mfma_f32_16x16x32_bf16(kf[f][1], qf[r][1], st[f], 0, 0, 0);
                    }
                    float mx = NEGBIG;
#pragma unroll
                    for (int f = 0; f < 2; ++f)
#pragma unroll
                        for (int e = 0; e < 4; ++e) { const int n = nb + f * 16 + fq * 4 + e; if (n <= nmax_lane) mx = fmaxf(mx, st[f][e]); }
                    mx = max4(mx);
                    const float mn = fmaxf(mc[r], mx);
                    float ps = 0.f;
#pragma unroll
                    for (int f = 0; f < 2; ++f)
#pragma unroll
                        for (int e = 0; e < 4; ++e) { const int n = nb + f * 16 + fq * 4 + e; if (n <= nmax_lane) ps += __expf(st[f][e] - mn); }
                    lc[r] = lc[r] * __expf(mc[r] - mn) + ps; mc[r] = mn;
                    __builtin_amdgcn_sched_barrier(0);
                }
            }
#pragma unroll
            for (int r = 0; r < 4; ++r) { const float l = red4(lc[r]); invl[r] = l > 0.f ? 1.0f / l : 0.f; }
            for (int i = lane; i < 16 * 260; i += 64) IMP[i] = 0.f;
            float carry = 0.f;
            for (int nb = 0; nb <= nmax_tile; nb += 32) {
                bf16x8 kf[2][2];
#pragma unroll
                for (int f = 0; f < 2; ++f)
#pragma unroll
                    for (int ks = 0; ks < 2; ++ks) kf[f][ks] = *(const bf16x8*)(kcb + (size_t)(nb + f * 16 + fr) * 64 + ks * 32 + fq * 8);
                bf16x8 vf[4];
#pragma unroll
                for (int df = 0; df < 4; ++df) { const bf16_t* vp = vcb + (size_t)(df * 16 + fr) * 1024 + nb + 4 * fq; vf[df] = ldv8(vp, vp + 16); }
                f32x4 pg[2] = {z4, z4};
#pragma unroll
                for (int r = 0; r < 4; ++r) {
                    f32x4 st[2];
#pragma unroll
                    for (int f = 0; f < 2; ++f) {
                        st[f] = __builtin_amdgcn_mfma_f32_16x16x32_bf16(kf[f][0], qf[r][0], z4, 0, 0, 0);
                        st[f] = __builtin_amdgcn_mfma_f32_16x16x32_bf16(kf[f][1], qf[r][1], st[f], 0, 0, 0);
#pragma unroll
                        for (int e = 0; e < 4; ++e) { const int n = nb + f * 16 + fq * 4 + e; st[f][e] = (n <= nmax_lane) ? __expf(st[f][e] - mc[r]) * invl[r] : 0.f; }
                        pg[f] += st[f];
                    }
                    const float gg = dry ? 0.f : gc[r];
                    const bf16x8 pf = pack8(st[0] * gg, st[1] * gg);
#pragma unroll
                    for (int df = 0; df < 4; ++df) acc[r][df] = __builtin_amdgcn_mfma_f32_16x16x32_bf16(vf[df], pf, acc[r][df], 0, 0, 0);
                    __builtin_amdgcn_sched_barrier(0);
                }
                const int src = (lane - 16) & 63;
                const float s0 = __shfl(pg[0].w, src), s1 = __shfl(pg[1].w, src), sc = __shfl(carry, src);
                const float prev0 = fq > 0 ? s0 : sc, prev1 = fq > 0 ? s1 : s0;
                const float imp0 = (pg[0].x + pg[0].y) + (pg[0].z + pg[0].w) + prev0;
                const float imp1 = (pg[1].x + pg[1].y) + (pg[1].z + pg[1].w) + prev1;
                const int jb = (nb >> 2) + fq;
                IMP[fr * 260 + jb] = imp0; IMP[fr * 260 + jb + 4] = imp1;
                carry = pg[1].w;
            }
        }
        {
            const int nf = cur >= 2 ? 3 : cur + 1;
            if (fq == 0) {
                SEL[fr * 16 + 0] = 0;
                if (cur == 1) SEL[fr * 16 + 1] = 1;
                if (cur >= 2) { SEL[fr * 16 + 1] = cur - 1; SEL[fr * 16 + 2] = cur; }
            }
            const int ncand = cur >= 3 ? cur - 2 : 0, extra = 16 - nf;
            if (ncand <= extra) {
                if (fq == 0) { for (int k = 0; k < extra; ++k) SEL[fr * 16 + nf + k] = (k < ncand) ? 1 + k : -1; }
            } else {
                for (int rnd = 0; rnd < extra; ++rnd) {
                    float bv = -1.0f; int bj = 1 << 20;
                    for (int jb = 1 + fq; jb <= cur - 2; jb += 4) { const float v = IMP[fr * 260 + jb]; if (v > bv) { bv = v; bj = jb; } }
#pragma unroll
                    for (int o = 16; o <= 32; o <<= 1) {
                        const float ov = __shfl_xor(bv, o); const int oj = __shfl_xor(bj, o);
                        if (ov > bv || (ov == bv && oj < bj)) { bv = ov; bj = oj; }
                    }
                    if (fq == 0) SEL[fr * 16 + nf + rnd] = bj;
                    if (((bj - 1) & 3) == fq) IMP[fr * 260 + bj] = -2.0f;
                }
            }
        }
#pragma unroll
        for (int r = 0; r < 4; ++r)
#pragma unroll
            for (int df = 0; df < 4; ++df) {
                const f32x4 v = acc[r][df];
                *(u32x2*)(O + tok * 1024 + (g * 4 + r) * 64 + df * 16 + fq * 4) = (u32x2){pk2(v.x, v.y), pk2(v.z, v.w)};
            }
        asm volatile("s_waitcnt vmcnt(0)" ::: "memory");
        unsigned selp[4];
        {
            const u32x4* sp = (const u32x4*)(SEL + fr * 16);
#pragma unroll
            for (int q = 0; q < 4; ++q) { const u32x4 w = sp[q]; selp[q] = (w.x & 255u) | ((w.y & 255u) << 8) | ((w.z & 255u) << 16) | ((w.w & 255u) << 24); }
        }
        for (int rep = 0; rep < rep_sel; ++rep) {
            const bool dry = (rep + 1 < rep_sel);
            const unsigned char* k8b = p.ws + WS_KS + (size_t)bg * SEQ * 64; const unsigned char* v8b = p.ws + WS_VST + (size_t)bg * 256 * 4096;
            const float* skb = (const float*)(p.ws + WS_KS + 12 * MiB) + (size_t)bg * 256; const float* svb = (const float*)(p.ws + WS_VST + 12 * MiB) + (size_t)bg * 256;
            const unsigned char* Q8 = p.ws + WS_Q8; const float* SQ8 = (const float*)(p.ws + WS_Q8 + 32 * MiB);
            const int nv = cur + 1 < 16 ? cur + 1 : 16, npair = (nv + 1) >> 1, total = 16 * npair;
            const int lrow = lane >> 2, lch = lane & 3;
            const int woff = lrow * 72 + lch * 16;
            const int rr = fr & 3;
            u32x4 sk[2][4], sv[2][4]; float ssk[2], ssv[2];
            int jbn[2];
#define SEL_GET(tokI, slotK) ((int)(((unsigned)__builtin_amdgcn_readlane((int)(((slotK) >> 2) == 0 ? selp[0] : ((slotK) >> 2) == 1 ? selp[1] : ((slotK) >> 2) == 2 ? selp[2] : selp[3]), (tokI)) >> (((slotK) & 3) * 8)) & 255u))
#define SEL_ISSUE(tokI, pairP) do { \
                const int k0_ = 2 * (pairP), k1_ = (2 * (pairP) + 1 < nv) ? 2 * (pairP) + 1 : k0_; \
                jbn[0] = SEL_GET(tokI, k0_); jbn[1] = SEL_GET(tokI, k1_); \
                _Pragma("unroll") for (int u = 0; u < 2; ++u) { \
                    const unsigned char* kb_ = k8b + (size_t)jbn[u] * 4096; const unsigned char* vb_ = v8b + (size_t)jbn[u] * 4096; \
                    _Pragma("unroll") for (int j = 0; j < 4; ++j) { sk[u][j] = *(const u32x4*)(kb_ + j * 1024 + lane * 16); sv[u][j] = *(const u32x4*)(vb_ + j * 1024 + lane * 16); } \
                    ssk[u] = skb[jbn[u]]; ssv[u] = svb[jbn[u]]; } } while (0)
            SEL_ISSUE(0, 0);
            long qs8[2] = {0, 0};
            float sq = 0.f, ms = NEGBIG, ls = 0.f;
            f32x4 os[4] = {z4, z4, z4, z4};
            u32x2 oprev[4] = {(u32x2){0u, 0u}, (u32x2){0u, 0u}, (u32x2){0u, 0u}, (u32x2){0u, 0u}};
            int i = 0, pp = 0;
            for (int v = 0; v < total; ++v) {
                const int jb0 = jbn[0], jb1 = jbn[1];
                const bool second_valid = (2 * pp + 1 < nv);
                const float ck0 = ssk[0], ck1 = ssk[1], cv0 = ssv[0], cv1 = ssv[1];
#pragma unroll
                for (int u = 0; u < 2; ++u)
#pragma unroll
                    for (int j = 0; j < 4; ++j) {
                        unsigned char* kd = WL + u * 9216 + woff + j * 1152; unsigned char* vd = kd + 4608;
                        *(u32x2*)kd = (u32x2){sk[u][j].x, sk[u][j].y}; *(u32x2*)(kd + 8) = (u32x2){sk[u][j].z, sk[u][j].w};
                        *(u32x2*)vd = (u32x2){sv[u][j].x, sv[u][j].y}; *(u32x2*)(vd + 8) = (u32x2){sv[u][j].z, sv[u][j].w};
                    }
                if (v + 1 < total) {
                    int p2 = pp + 1, i2 = i; if (p2 == npair) { p2 = 0; i2 = i + 1; }
                    SEL_ISSUE(i2, p2);
                }
                __builtin_amdgcn_sched_barrier(0);
                const int ti = t0 + i;
                if (pp == 0) {
                    const size_t tk = (size_t)b * SEQ + ti;
#pragma unroll
                    for (int ks = 0; ks < 2; ++ks) qs8[ks] = *(const long*)(Q8 + tk * 1024 + (g * 4 + rr) * 64 + ks * 32 + fq * 8);
                    sq = SQ8[tk * 16 + g * 4 + rr] * 1.4426950408889634f;
                    ms = NEGBIG; ls = 0.f;
#pragma unroll
                    for (int df = 0; df < 4; ++df) { os[df] = z4; oprev[df] = *(const u32x2*)(O + tk * 1024 + (g * 4 + rr) * 64 + df * 16 + fq * 4); }
                }
                f32x4 st[2][4];
#pragma unroll
                for (int u = 0; u < 2; ++u)
#pragma unroll
                    for (int f = 0; f < 4; ++f) {
                        const unsigned char* kp = WL + u * 9216 + (f * 16 + fr) * 72 + fq * 8;
                        const long k0 = *(const long*)kp, k1 = *(const long*)(kp + 32);
                        st[u][f] = __builtin_amdgcn_mfma_f32_16x16x32_fp8_fp8(k0, qs8[0], z4, 0, 0, 0);
                        st[u][f] = __builtin_amdgcn_mfma_f32_16x16x32_fp8_fp8(k1, qs8[1], st[u][f], 0, 0, 0);
                    }
                const float c0_ = sq * ck0, c1_ = sq * ck1;
                if (jb0 == cur || jb1 == cur || !second_valid) {
#pragma unroll
                    for (int u = 0; u < 2; ++u) {
                        const int jbu = u ? jb1 : jb0;
                        const bool allbad = (u == 1) && !second_valid;
#pragma unroll
                        for (int f = 0; f < 4; ++f)
#pragma unroll
                            for (int e = 0; e < 4; ++e) { const int key = jbu * 64 + f * 16 + fq * 4 + e; if (allbad || key > ti) st[u][f][e] = NEGBIG; }
                    }
                }
                float mx0 = NEGBIG, mx1 = NEGBIG;
#pragma unroll
                for (int f = 0; f < 4; ++f) { mx0 = fmaxf(mx0, fmaxf(fmaxf(st[0][f].x, st[0][f].y), fmaxf(st[0][f].z, st[0][f].w))); mx1 = fmaxf(mx1, fmaxf(fmaxf(st[1][f].x, st[1][f].y), fmaxf(st[1][f].z, st[1][f].w))); }
                const float mx = max4(fmaxf(mx0 > -1.0e29f ? mx0 * c0_ : NEGBIG, mx1 > -1.0e29f ? mx1 * c1_ : NEGBIG));
                const float mn = fmaxf(ms, mx);
                const float al = __builtin_amdgcn_exp2f(ms - mn);
                const float off = 8.0f - mn;
                float ps = 0.f;
#pragma unroll
                for (int u = 0; u < 2; ++u) {
                    const float cu = u ? c1_ : c0_;
#pragma unroll
                    for (int f = 0; f < 4; ++f)
#pragma unroll
                        for (int e = 0; e < 4; ++e) { const float pv = (st[u][f][e] > -1.0e29f) ? __builtin_amdgcn_exp2f(st[u][f][e] * cu + off) : 0.f; st[u][f][e] = pv; ps += pv; }
                }
                ls = ls * al + ps; ms = mn;
#pragma unroll
                for (int df = 0; df < 4; ++df) os[df] = os[df] * al;
#pragma unroll
                for (int u = 0; u < 2; ++u) {
                    f32x4 pvacc[4] = {z4, z4, z4, z4};
#pragma unroll
                    for (int s = 0; s < 2; ++s) {
                        int w0 = 0, w1 = 0;
                        w0 = __builtin_amdgcn_cvt_pk_fp8_f32(st[u][2 * s].x, st[u][2 * s].y, w0, false); w0 = __builtin_amdgcn_cvt_pk_fp8_f32(st[u][2 * s].z, st[u][2 * s].w, w0, true);
                        w1 = __builtin_amdgcn_cvt_pk_fp8_f32(st[u][2 * s + 1].x, st[u][2 * s + 1].y, w1, false); w1 = __builtin_amdgcn_cvt_pk_fp8_f32(st[u][2 * s + 1].z, st[u][2 * s + 1].w, w1, true);
                        const long pf = (long)(((unsigned long long)(unsigned)w1 << 32) | (unsigned long long)(unsigned)w0);
#pragma unroll
                        for (int df = 0; df < 4; ++df) {
                            const unsigned char* vp = WL + u * 9216 + 4608 + (df * 16 + fr) * 72 + 32 * s + 4 * fq;
                            const unsigned lo = *(const unsigned*)vp, hi = *(const unsigned*)(vp + 16);
                            const long vf = (long)(((unsigned long long)hi << 32) | (unsigned long long)lo);
                            pvacc[df] = __builtin_amdgcn_mfma_f32_16x16x32_fp8_fp8(vf, pf, pvacc[df], 0, 0, 0);
                        }
                    }
                    const float cvu = u ? cv1 : cv0;
#pragma unroll
                    for (int df = 0; df < 4; ++df) os[df] = os[df] + pvacc[df] * cvu;
                    __builtin_amdgcn_sched_barrier(0);
                }
                if (pp == npair - 1) {
                    const float l = red4(ls);
                    const float gsv = NGT[((size_t)b * SEQ + ti) * 48 + (g * 4 + rr) * 3 + 1];
                    const float sc = gsv / l;
                    if (fr < 4 && !dry) {
                        bf16_t* op = O + ((size_t)b * SEQ + ti) * 1024 + (g * 4 + fr) * 64 + fq * 4;
#pragma unroll
                        for (int df = 0; df < 4; ++df) {
                            const f32x4 val = os[df] * sc; const u32x2 c = oprev[df];
                            *(u32x2*)(op + df * 16) = (u32x2){pk2(bflo(c.x) + val.x, bfhi(c.x) + val.y), pk2(bflo(c.y) + val.z, bfhi(c.y) + val.w)};
                        }
                    }
                }
                ++pp; if (pp == npair) { pp = 0; ++i; }
            }
#undef SEL_GET
#undef SEL_ISSUE
        }
    }
}
constexpr int NPHASES = 24;
#ifndef PROBE_PHASE
#define PROBE_PHASE (-1)
#endif
#ifndef ATT_REP_CMP
#define ATT_REP_CMP 1
#endif
#ifndef ATT_REP_WIN
#define ATT_REP_WIN 1
#endif
#ifndef ATT_REP_SEL
#define ATT_REP_SEL 1
#endif
#ifndef TS_PHASE
#define TS_PHASE (-1)
#endif
#ifndef TS_MULT
#define TS_MULT 4
#endif
#ifndef PROBE_REPS
#define PROBE_REPS 1
#endif
__global__ void __launch_bounds__(NTHREADS, 2) mega(Params p) {
    __shared__ __attribute__((aligned(16))) unsigned char lds[LDS_BYTES];
    __shared__ __attribute__((aligned(16))) unsigned bar_st[4];
    cg::grid_group grid = cg::this_grid();
    const float* MOD = (const float*)(p.ws + WS_MOD);
    bf16_t* HM = (bf16_t*)(p.ws + WS_HM);
    if (threadIdx.x < 4) bar_st[threadIdx.x] = 0u;
    __syncthreads();
    XcdBarrier bar = xcd_barrier_post((unsigned*)(p.ws + WS_CTL), (volatile LAS unsigned*)bar_st);
    const int lo = p.ph_lo, hi = p.ph_hi;
    const bool dry0 = (p.ph_hi < 0);
    const int opq = (p.ph_hi < 0) ? 1 : 0;
    unsigned long long ts_a = 0ull, ts_b = 0ull;
#define PHASE(k, call, drycall) if (lo <= (k) && (k) < hi) { \
        if (TS_PHASE == (k)) ts_a = __builtin_amdgcn_s_memrealtime(); \
        if (PROBE_PHASE == (k)) { for (int rep = 0; rep < PROBE_REPS; ++rep) { const bool dry = !dry0; drycall; __syncthreads(); } } \
        { const bool dry = dry0; call; } \
        if ((k) + 1 < hi) { if ((k) == 0) grid.sync(); else xcd_barrier(bar); } \
        if (TS_PHASE == (k)) ts_b = __builtin_amdgcn_s_memrealtime(); }
    PHASE(0, phase_prep(p, (float*)lds), phase_prep(p, (float*)lds))
    PHASE(1, phase_norm(p, p.in[0], p.in[2], MOD + 0, MOD + 1024, HM), phase_norm(p, p.in[0], p.in[2], MOD + 0, MOD + 1024, HM))
    PHASE(2, phase_s5_win(p, lds), phase_s5_win(p, lds))
    PHASE(3, phase_s5_a(p, lds), phase_s5_a(p, lds))
    PHASE(4, phase_s5_scan(p), phase_s5_scan(p))
    PHASE(5, phase_s5_b(p, lds), phase_s5_b(p, lds))
    PHASE(6, phase_s5_glu(p, lds), phase_s5_glu(p, lds))
    PHASE(7, phase_norm(p, p.out, p.in[3], MOD + 3072, MOD + 4096, HM), phase_norm(p, p.out, p.in[3], MOD + 3072, MOD + 4096, HM))
    PHASE(8, phase_peer_wq(p, 0, lds), phase_peer_wq(p, 0, lds))
    PHASE(9, phase_peer_topk(p, 0, lds), phase_peer_topk(p, 0, lds))
    PHASE(10, phase_peer_combine(p, lds), phase_peer_combine(p, lds))
    PHASE(11, phase_peer_apply(p, 0, lds, dry), phase_peer_apply(p, 0, lds, dry))
    PHASE(12, (phase_norm(p, p.out, p.in[2] + D, MOD + 2 * 6144 + 0, MOD + 2 * 6144 + 1024, HM), phase_tab1(p)), (phase_norm(p, p.out, p.in[2] + D, MOD + 2 * 6144 + 0, MOD + 2 * 6144 + 1024, HM), phase_tab1(p)))
    PHASE(13, phase_nsa_proj(p, lds), phase_nsa_proj(p, lds))
    PHASE(14, phase_nsa_cmp1(p, lds), phase_nsa_cmp1(p, lds))
    PHASE(15, phase_nsa_cmp2(p, lds), phase_nsa_cmp2(p, lds))
    PHASE(16, phase_nsa_attn(p, lds, ATT_REP_CMP + opq, ATT_REP_WIN + opq, ATT_REP_SEL + opq), phase_nsa_attn(p, lds, 1 + opq, 1 + opq, 1 + opq))
    PHASE(17, phase_nsa_wo(p, lds, dry), phase_nsa_wo(p, lds, dry))
    PHASE(18, phase_norm(p, p.out, p.in[3] + D, MOD + 2 * 6144 + 3072, MOD + 2 * 6144 + 4096, HM), phase_norm(p, p.out, p.in[3] + D, MOD + 2 * 6144 + 3072, MOD + 2 * 6144 + 4096, HM))
    PHASE(19, phase_peer_wq(p, 1, lds), phase_peer_wq(p, 1, lds))
    PHASE(20, phase_peer_topk(p, 1, lds), phase_peer_topk(p, 1, lds))
    PHASE(21, phase_peer_combine(p, lds), phase_peer_combine(p, lds))
    PHASE(22, phase_peer_apply(p, 1, lds, dry), phase_peer_apply(p, 1, lds, dry))
    PHASE(23, phase_final_norm(p, p.out, p.out, dry), phase_final_norm(p, p.out, p.out, dry))
#undef PHASE
    if (TS_PHASE >= 0 && blockIdx.x == 0 && threadIdx.x == 0) {
        const unsigned long long t0 = __builtin_amdgcn_s_memrealtime(), want = (ts_b - ts_a) * TS_MULT;
        while (__builtin_amdgcn_s_memrealtime() - t0 < want) __builtin_amdgcn_s_sleep(8);
    }
}

extern "C" void kernel_launch(void* const* d_in, const int* in_sizes, int n_in, void* d_out, int out_size, void* d_ws, size_t ws_size, hipStream_t stream) {
    static int grid_blocks = 0;
    if (!grid_blocks) {
        int dev = 0, cus = 0, per_cu = 0;
        hipGetDevice(&dev);
        hipDeviceGetAttribute(&cus, hipDeviceAttributeMultiprocessorCount, dev);
        hipOccupancyMaxActiveBlocksPerMultiprocessor(&per_cu, mega, NTHREADS, 0);
        if (per_cu > 2) per_cu = 2;
        if (per_cu < 1) per_cu = 1;
        grid_blocks = cus * per_cu;
        if (ws_size < WS_END) fprintf(stderr, "kernel_launch: workspace too small: %zu < %zu\n", ws_size, (size_t)WS_END);
        if (n_in != 29) fprintf(stderr, "kernel_launch: expected 29 inputs, got %d\n", n_in);
    }
    hipMemsetAsync((unsigned char*)d_ws + WS_CTL, 0, 16384, stream);
    Params p{};
    for (int i = 0; i < 29; ++i) p.in[i] = (const float*)d_in[i];
    p.out = (float*)d_out; p.ws = (unsigned char*)d_ws;
#if SINGLE_LAUNCH
    p.ph_lo = 0; p.ph_hi = NPHASES;
    void* args[] = {&p};
    hipError_t e = hipLaunchCooperativeKernel((void*)mega, dim3(grid_blocks), dim3(NTHREADS), args, 0, stream);
    if (e != hipSuccess) fprintf(stderr, "cooperative launch failed: %s (grid %d)\n", hipGetErrorString(e), grid_blocks);
#else
    for (int ph = 0; ph < NPHASES; ++ph) {
        p.ph_lo = ph; p.ph_hi = ph + 1;
        hipLaunchKernelGGL(mega, dim3(grid_blocks), dim3(NTHREADS), 0, stream, p);
    }
#endif
}
```

```cpp
#include <hip/hip_runtime.h>
#include <hip/hip_cooperative_groups.h>
#include <cstdio>
#include <cstdint>
namespace cg = cooperative_groups;

#ifndef SINGLE_LAUNCH
#define SINGLE_LAUNCH 1
#endif

typedef unsigned short bf16_t;
typedef short bf16x8 __attribute__((ext_vector_type(8)));
typedef float f32x4 __attribute__((ext_vector_type(4)));
typedef float f32x2 __attribute__((ext_vector_type(2)));
typedef unsigned u32x4 __attribute__((ext_vector_type(4)));
typedef unsigned u32x2 __attribute__((ext_vector_type(2)));
typedef __bf16 bf16x2_t __attribute__((ext_vector_type(2)));

constexpr int D = 1024, BATCH = 2, SEQ = 16384, T = BATCH * SEQ;
constexpr int NTHREADS = 256;
constexpr float RMS_EPS = 1e-6f;
constexpr int S5G = 64, S5P = 64, S5L = 32, S5NCH = T / S5L  , S5CPB = SEQ / S5L  ;
constexpr int NH = 16, HD = 64, NG = 4, NPROJ = 2608, NPROJ_PAD = 2688, NC = 1023, NSB = 256;
constexpr int PH = 8, PK = 16, PNK = 128, PE = 16384;

constexpr size_t MiB = 1ull << 20;
constexpr size_t WS_CTL = 0;
constexpr size_t WS_MOD = 1 * MiB;
constexpr size_t WS_WIN_T = 2 * MiB;
constexpr size_t WS_WGLU_T = 4 * MiB;
constexpr size_t WS_WPROJ_T = 8 * MiB;
constexpr size_t WS_WK1_T = 14 * MiB;
constexpr size_t WS_WV1_T = 15 * MiB;
constexpr size_t WS_WK2_T = 16 * MiB;
constexpr size_t WS_WV2_T = 16 * MiB + 512 * 1024;
constexpr size_t WS_WO_T = 17 * MiB;
constexpr size_t WS_WQ_T = 19 * MiB;
constexpr size_t WS_SUBK = 27 * MiB;
constexpr size_t WS_ROPE = 28 * MiB;
constexpr size_t WS_MISC = 32 * MiB;
constexpr size_t WS_TW = 33 * MiB;
constexpr size_t WS_VG = 73 * MiB;
constexpr size_t WS_PU = 82 * MiB;
constexpr size_t WS_PV = 114 * MiB;
constexpr size_t WS_HM = 146 * MiB;
constexpr size_t WS_C = 210 * MiB;
constexpr size_t WS_UG = WS_C;
constexpr size_t WS_YI = WS_C + 64 * MiB;
constexpr size_t WS_WST = WS_C + 128 * MiB;
constexpr size_t WS_SST = WS_C + 160 * MiB;
constexpr size_t WS_YG = WS_C + 176 * MiB;
constexpr size_t WS_QK = WS_C;
constexpr size_t WS_TOPS = WS_C + 128 * MiB;
constexpr size_t WS_TOPI = WS_C + 160 * MiB;
constexpr size_t WS_EXP = WS_C + 192 * MiB;
constexpr size_t WS_GATE = WS_C + 208 * MiB;
constexpr size_t WS_ACT = WS_C + 224 * MiB;
constexpr size_t WS_Q = WS_C;
constexpr size_t WS_KC = WS_C + 64 * MiB;
constexpr size_t WS_VC = WS_C + 81 * MiB;
constexpr size_t WS_KS = WS_C + 98 * MiB;
constexpr size_t WS_VST = WS_C + 114 * MiB;
constexpr size_t WS_KW = WS_C + 130 * MiB;
constexpr size_t WS_VWT = WS_C + 146 * MiB;
constexpr size_t WS_NG = WS_C + 162 * MiB;
constexpr size_t WS_KCMP = WS_C + 170 * MiB;
constexpr size_t WS_VCMPT = WS_C + 171 * MiB;
constexpr size_t WS_HID = WS_C + 172 * MiB;
constexpr size_t WS_O = WS_C + 182 * MiB;
constexpr size_t WS_Q8 = WS_C + 246 * MiB;
constexpr size_t WS_END = WS_C + 282 * MiB;

constexpr int LDS_BYTES = 73728;

struct Params {
    const float* in[29];
    float* out;
    unsigned char* ws;
    int ph_lo, ph_hi;
};

__device__ __forceinline__ unsigned f2bf(float f) { unsigned u = __builtin_bit_cast(unsigned, f); return (u + 0x7fffu + ((u >> 16) & 1u)) >> 16; }
__device__ __forceinline__ unsigned pk2(float lo, float hi) { return f2bf(lo) | (f2bf(hi) << 16); }
__device__ __forceinline__ float bf2f(unsigned h) { return __builtin_bit_cast(float, h << 16); }
__device__ __forceinline__ float bflo(unsigned w) { return __builtin_bit_cast(float, w << 16); }
__device__ __forceinline__ float bfhi(unsigned w) { return __builtin_bit_cast(float, w & 0xffff0000u); }
__device__ __forceinline__ float gelu_tanh(float x) {
    const float u = 0.7978845608028654f * (x + 0.044715f * x * x * x);
    const float e = __expf(2.0f * u);
    const float th = 1.0f - 2.0f / (e + 1.0f);
    return 0.5f * x * (1.0f + th);
}
__device__ __forceinline__ float sigmoidf_(float x) { return 1.0f / (1.0f + __expf(-x)); }
__device__ __forceinline__ float wave_sum(float v) {
#pragma unroll
    for (int o = 1; o < 64; o <<= 1) v += __shfl_xor(v, o);
    return v;
}
__device__ __forceinline__ float dot2bf(unsigned a, unsigned b, float acc) {
    return __builtin_amdgcn_fdot2_f32_bf16(__builtin_bit_cast(bf16x2_t, a), __builtin_bit_cast(bf16x2_t, b), acc, false);
}

#define LAS __attribute__((address_space(3)))
#define XB_TMO      128
#define XB_XCNT(j)  (256  + 64 * (j))
#define XB_XSUB(j)  (1280 + 64 * (j))
#define XB_XGEN(j)  (2304 + 64 * (j))
#define XB_TOP      3328
#define XB_TOPGEN   3392
#define XCD_BAR_WORDS 3456
#define XB_SPIN_CAP (1u << 24)

__device__ __forceinline__ unsigned xb_ld(unsigned* p)              { return __hip_atomic_load(p, __ATOMIC_RELAXED, __HIP_MEMORY_SCOPE_AGENT); }
__device__ __forceinline__ unsigned xb_add(unsigned* p, unsigned v) { return __hip_atomic_fetch_add(p, v, __ATOMIC_RELAXED, __HIP_MEMORY_SCOPE_AGENT); }
__device__ __forceinline__ unsigned xb_xcc_id() { return (unsigned)__builtin_amdgcn_s_getreg((3 << 11) | 20) & 0xFu; }
#define XB_SPIN(cond, bar) do { unsigned _sp = 0; while (cond) { __builtin_amdgcn_s_sleep(1); \
    if ((++_sp & 255u) == 0u) { if (xb_ld(&(bar)[XB_TMO])) break; if (_sp > XB_SPIN_CAP) { atomicAdd(&(bar)[XB_TMO], 1u); break; } } } } while (0)

struct XcdBarrier {
    unsigned* bar; unsigned x;
    volatile LAS unsigned* st;
};

__device__ __forceinline__ XcdBarrier xcd_barrier_post(unsigned* bar, volatile LAS unsigned* st) {
    XcdBarrier b; b.bar = bar; b.x = xb_xcc_id(); b.st = st;
    if (threadIdx.x == 0) (void)xb_add(&bar[XB_XCNT(b.x)], 1u);
    return b;
}
__device__ __forceinline__ void xcd_barrier_complete(unsigned* bar, unsigned x, unsigned& nloc, unsigned& nx) {
    const unsigned G = gridDim.x * gridDim.y * gridDim.z;
    unsigned sum, cnt, mine, sp = 0u;
    for (;;) {
        sum = 0u; cnt = 0u; mine = 0u;
#pragma unroll
        for (unsigned j = 0; j < 16; ++j) { const unsigned c = xb_ld(&bar[XB_XCNT(j)]); sum += c; cnt += (c > 0u) ? 1u : 0u; mine = (j == x) ? c : mine; }
        if (sum == G) break;
        __builtin_amdgcn_s_sleep(1);
        if ((++sp & 255u) == 0u) { if (xb_ld(&bar[XB_TMO])) break; if (sp > XB_SPIN_CAP) { atomicAdd(&bar[XB_TMO], 1u); break; } }
    }
    nloc = mine > 0u ? mine : 1u; nx = cnt > 0u ? cnt : 1u;
}

__device__ __forceinline__ void xcd_barrier(const XcdBarrier& b) {
    asm volatile("s_waitcnt vmcnt(0)" ::: "memory");
    __syncthreads();
    if (threadIdx.x == 0) {
        unsigned* bar = b.bar;
        __builtin_amdgcn_s_waitcnt(0);
        unsigned nloc = b.st[0], nx = b.st[1];
        if (nloc == 0u) { xcd_barrier_complete(bar, b.x, nloc, nx); b.st[0] = nloc; b.st[1] = nx; }
        const unsigned old = xb_add(&bar[XB_XSUB(b.x)], 1u);
        const unsigned gen = old / nloc;
        if (old + 1u == (gen + 1u) * nloc) {
            __builtin_amdgcn_fence(__ATOMIC_RELEASE, "agent");
            asm volatile("s_waitcnt vmcnt(0)" ::: "memory");
            const unsigned og = xb_add(&bar[XB_TOP], 1u);
            const unsigned tg = og / nx;
            if (og + 1u == (tg + 1u) * nx) xb_add(&bar[XB_TOPGEN], 1u);
            else XB_SPIN(xb_ld(&bar[XB_TOPGEN]) == tg, bar);
            __builtin_amdgcn_fence(__ATOMIC_ACQUIRE, "agent");
            xb_add(&bar[XB_XGEN(b.x)], 1u);
            asm volatile("s_waitcnt vmcnt(0)" ::: "memory");
        } else {
            XB_SPIN(xb_ld(&bar[XB_XGEN(b.x)]) == gen, bar);
            __builtin_amdgcn_fence(__ATOMIC_ACQUIRE, "agent");
            asm volatile("s_waitcnt vmcnt(0)" ::: "memory");
        }
    }
    __syncthreads();
}
__device__ __forceinline__ void prep_mod_item(const Params& p, int item, float* lds) {
    const int layer = item / 192, cg0 = (item % 192) * 32;
    const int tid = threadIdx.x, col = cg0 + (tid & 31), kg = tid >> 5;
    const float* W = p.in[4] + (size_t)layer * D * 6 * D;
    const float* c = p.in[1];
    float a0 = 0.f, a1 = 0.f;
    for (int k = kg * 128; k < kg * 128 + 128; ++k) {
        const float w = W[(size_t)k * (6 * D) + col];
        const float c0 = c[k], c1 = c[D + k];
        a0 += w * (c0 * sigmoidf_(c0));
        a1 += w * (c1 * sigmoidf_(c1));
    }
    lds[tid] = a0; lds[256 + tid] = a1;
    __syncthreads();
    if (tid < 64) {
        const int b = tid >> 5, cc = tid & 31;
        float s = 0.f;
#pragma unroll
        for (int g = 0; g < 8; ++g) s += lds[b * 256 + g * 32 + cc];
        float* MOD = (float*)(p.ws + WS_MOD);
        MOD[(size_t)(layer * 2 + b) * 6144 + cg0 + cc] = s + p.in[5][(size_t)layer * 6144 + cg0 + cc];
    }
    __syncthreads();
}

template <int MODE>
__device__ __forceinline__ void prep_transpose_item(const float* W, int K, int N, bf16_t* WT, int item, float* lds) {
    const int nbn = (N + 63) / 64, kb = item / nbn, nb = item % nbn, k0 = kb * 64, n0 = nb * 64;
    const int tid = threadIdx.x;
#pragma unroll
    for (int i = 0; i < 16; ++i) {
        const int kk = (tid >> 6) + 4 * i, nn = tid & 63;
        const float v = (n0 + nn < N) ? W[(size_t)(k0 + kk) * N + n0 + nn] : 0.f;
        lds[kk * 65 + nn] = v;
    }
    __syncthreads();
    {
        const int nn = tid >> 2, ks = (tid & 3) * 16;
        const int n = n0 + nn;
        if (n < N) {
            int np = n;
            if (MODE == 1) { const int j = (n < 1024) ? n : n - 1024; np = (j >> 4) * 32 + (j & 15) + ((n < 1024) ? 0 : 16); }
            u32x4 o0, o1;
            const float* s = lds + nn;
            o0.x = pk2(s[(ks + 0) * 65], s[(ks + 1) * 65]); o0.y = pk2(s[(ks + 2) * 65], s[(ks + 3) * 65]);
            o0.z = pk2(s[(ks + 4) * 65], s[(ks + 5) * 65]); o0.w = pk2(s[(ks + 6) * 65], s[(ks + 7) * 65]);
            o1.x = pk2(s[(ks + 8) * 65], s[(ks + 9) * 65]); o1.y = pk2(s[(ks + 10) * 65], s[(ks + 11) * 65]);
            o1.z = pk2(s[(ks + 12) * 65], s[(ks + 13) * 65]); o1.w = pk2(s[(ks + 14) * 65], s[(ks + 15) * 65]);
            u32x4* dst = (u32x4*)(WT + (size_t)np * K + k0 + ks);
            dst[0] = o0; dst[1] = o1;
        }
    }
    __syncthreads();
}

__device__ __forceinline__ void cvt_item(const float* src, bf16_t* dst, int item) {
    const size_t base = (size_t)item * 8192 + threadIdx.x * 8;
#pragma unroll
    for (int i = 0; i < 4; ++i) {
        const size_t o = base + (size_t)i * 2048;
        const f32x4 a = *(const f32x4*)(src + o), b = *(const f32x4*)(src + o + 4);
        u32x4 w; w.x = pk2(a.x, a.y); w.y = pk2(a.z, a.w); w.z = pk2(b.x, b.y); w.w = pk2(b.z, b.w);
        *(u32x4*)(dst + o) = w;
    }
}
__device__ __forceinline__ void zero_item(bf16_t* dst, int item) {
    const size_t base = (size_t)item * 8192 + threadIdx.x * 8;
#pragma unroll
    for (int i = 0; i < 4; ++i) *(u32x4*)(dst + base + (size_t)i * 2048) = (u32x4){0u, 0u, 0u, 0u};
}

struct cpx { float re, im; };
__device__ __forceinline__ cpx cmul(cpx a, cpx b) { return {a.re * b.re - a.im * b.im, a.re * b.im + a.im * b.re}; }
__device__ __forceinline__ cpx cexp_pow(float are, float aim, float dt, int m) {
    const float mag = __expf(are * dt * (float)m);
    const double rev = (double)aim * (double)dt * (double)m * 0.15915494309189535;
    const float fr = (float)(rev - rint(rev));
    return {mag * __builtin_amdgcn_cosf(fr), mag * __builtin_amdgcn_sinf(fr)};
}
__device__ __forceinline__ cpx s5_coef(float are, float aim, float dt) {
    cpx ab = cexp_pow(are, aim, dt, 1);
    const float nr = ab.re - 1.0f, ni = ab.im, den = are * are + aim * aim;
    return {(nr * are + ni * aim) / den, (ni * are - nr * aim) / den};
}

__device__ __forceinline__ void prep_s5_T_item(const Params& p, int item) {
    const int gid = item * 256 + threadIdx.x;
    const int g = gid >> 9, m = (gid >> 4) & 31, i = gid & 15;
    const float* a_re = p.in[7] + g * 64; const float* a_im = p.in[8] + g * 64;
    const float dt = __expf(p.in[9][g]);
    const float* b_re = p.in[10] + (size_t)g * 64 * 16; const float* b_im = p.in[11] + (size_t)g * 64 * 16;
    const float* c_re = p.in[12] + (size_t)g * 16 * 64 + i * 64; const float* c_im = p.in[13] + (size_t)g * 16 * 64 + i * 64;
    float acc[16];
#pragma unroll
    for (int j = 0; j < 16; ++j) acc[j] = 0.f;
    for (int q = 0; q < 64; ++q) {
        const float are = a_re[q], aim = a_im[q];
        cpx z = cmul(cmul({c_re[q], c_im[q]}, cexp_pow(are, aim, dt, m)), s5_coef(are, aim, dt));
        const f32x4* br = (const f32x4*)(b_re + q * 16); const f32x4* bi = (const f32x4*)(b_im + q * 16);
#pragma unroll
        for (int j4 = 0; j4 < 4; ++j4) {
            const f32x4 r = br[j4], im = bi[j4];
            acc[j4 * 4 + 0] += z.re * r.x - z.im * im.x; acc[j4 * 4 + 1] += z.re * r.y - z.im * im.y;
            acc[j4 * 4 + 2] += z.re * r.z - z.im * im.z; acc[j4 * 4 + 3] += z.re * r.w - z.im * im.w;
        }
    }
    u32x4 o0, o1;
    o0.x = pk2(acc[0], acc[1]); o0.y = pk2(acc[2], acc[3]); o0.z = pk2(acc[4], acc[5]); o0.w = pk2(acc[6], acc[7]);
    o1.x = pk2(acc[8], acc[9]); o1.y = pk2(acc[10], acc[11]); o1.z = pk2(acc[12], acc[13]); o1.w = pk2(acc[14], acc[15]);
    bf16_t* TW = (bf16_t*)(p.ws + WS_TW) + (size_t)g * 640 * 512;
    const u32x4 z4 = (u32x4){0u, 0u, 0u, 0u};
    for (int lp = 0; lp + m < 32; ++lp) {
        u32x4* d = (u32x4*)(TW + (size_t)((lp + m) * 16 + i) * 512 + lp * 16);
        d[0] = o0; d[1] = o1;
        if (m > 0) { u32x4* dz = (u32x4*)(TW + (size_t)(lp * 16 + i) * 512 + (lp + m) * 16); dz[0] = z4; dz[1] = z4; }
    }
}
__device__ __forceinline__ void prep_s5_W_item(const Params& p, int item) {
    const int gid = item * 256 + threadIdx.x;
    const int g = gid >> 11, q = (gid >> 5) & 63, lp = gid & 31;
    const float are = p.in[7][g * 64 + q], aim = p.in[8][g * 64 + q];
    const float dt = __expf(p.in[9][g]);
    const cpx z = cmul(cexp_pow(are, aim, dt, 31 - lp), s5_coef(are, aim, dt));
    const float* br = p.in[10] + ((size_t)g * 64 + q) * 16; const float* bi = p.in[11] + ((size_t)g * 64 + q) * 16;
    float wr[16], wi[16];
#pragma unroll
    for (int j = 0; j < 16; ++j) { wr[j] = z.re * br[j] - z.im * bi[j]; wi[j] = z.re * bi[j] + z.im * br[j]; }
    bf16_t* TW = (bf16_t*)(p.ws + WS_TW) + (size_t)g * 640 * 512;
    u32x4* d0 = (u32x4*)(TW + (size_t)(512 + q) * 512 + lp * 16);
    u32x4* d1 = (u32x4*)(TW + (size_t)(576 + q) * 512 + lp * 16);
    d0[0] = (u32x4){pk2(wr[0], wr[1]), pk2(wr[2], wr[3]), pk2(wr[4], wr[5]), pk2(wr[6], wr[7])};
    d0[1] = (u32x4){pk2(wr[8], wr[9]), pk2(wr[10], wr[11]), pk2(wr[12], wr[13]), pk2(wr[14], wr[15])};
    d1[0] = (u32x4){pk2(wi[0], wi[1]), pk2(wi[2], wi[3]), pk2(wi[4], wi[5]), pk2(wi[6], wi[7])};
    d1[1] = (u32x4){pk2(wi[8], wi[9]), pk2(wi[10], wi[11]), pk2(wi[12], wi[13]), pk2(wi[14], wi[15])};
}
__device__ __forceinline__ void prep_s5_V_item(const Params& p, int item) {
    const int gid = item * 256 + threadIdx.x;
    const int g = gid >> 14, l = (gid >> 9) & 31, i = (gid >> 5) & 15, q0 = (gid & 31) * 2;
    const float dt = __expf(p.in[9][g]);
    float vr[2], vi[2];
#pragma unroll
    for (int e = 0; e < 2; ++e) {
        const int q = q0 + e;
        const cpx z = cmul({p.in[12][((size_t)g * 16 + i) * 64 + q], p.in[13][((size_t)g * 16 + i) * 64 + q]}, cexp_pow(p.in[7][g * 64 + q], p.in[8][g * 64 + q], dt, l + 1));
        vr[e] = z.re; vi[e] = -z.im;
    }
    bf16_t* VG = (bf16_t*)(p.ws + WS_VG) + ((size_t)g * 512 + l * 16 + i) * 128;
    *(unsigned*)(VG + q0) = pk2(vr[0], vr[1]);
    *(unsigned*)(VG + 64 + q0) = pk2(vi[0], vi[1]);
}
__device__ __forceinline__ void prep_al_item(const Params& p, int item) {
    const int gid = item * 256 + threadIdx.x;
    const int g = gid >> 6;
    const float dt = __expf(p.in[9][g]);
    const cpx z = cexp_pow(p.in[7][gid], p.in[8][gid], dt, S5L);
    f32x2* AL = (f32x2*)(p.ws + WS_MISC + 4096);
    AL[gid] = (f32x2){z.re, z.im};
}
__device__ __forceinline__ void prep_rope_item(const Params& p, int item) {
    const int gid = item * 256 + threadIdx.x;
    const int pos = gid >> 5, j = gid & 31;
    const float freq = exp2f(-(float)j * (13.287712379549449f / 32.0f));
    const float ang = (float)pos * freq;
    const double rev = (double)ang * 0.15915494309189535;
    const float fr = (float)(rev - rint(rev));
    f32x2* R = (f32x2*)(p.ws + WS_ROPE);
    R[gid] = (f32x2){__builtin_amdgcn_cosf(fr), __builtin_amdgcn_sinf(fr)};
}
__device__ __forceinline__ void prep_cmpbias_item(const Params& p, int item, float* lds) {
    const int kv = item >> 3, cg0 = (item & 7) * 32;
    const float* pe = p.in[17 + kv]; const float* w1 = p.in[kv == 0 ? 19 : 21];
    const int tid = threadIdx.x, col = cg0 + (tid & 31), kg = tid >> 5;
    float s = 0.f;
#pragma unroll 8
    for (int k = kg * 256; k < kg * 256 + 256; ++k) s += pe[k] * w1[(size_t)k * 256 + col];
    lds[tid] = s;
    __syncthreads();
    if (tid < 32) {
        float t = 0.f;
#pragma unroll
        for (int q = 0; q < 8; ++q) t += lds[q * 32 + tid];
        ((float*)(p.ws + WS_MISC))[kv * 256 + cg0 + tid] = t;
    }
    __syncthreads();
}

__device__ __forceinline__ void cvt_fp8_item(const float* src, unsigned char* dst, float* inv_scale, int item, const bool slice_major) {
    const int lane = threadIdx.x & 63, row = item * 4 + (threadIdx.x >> 6);
    const f32x4* sp = (const f32x4*)(src + (size_t)row * D + lane * 16);
    const f32x4 a = sp[0], b = sp[1], c = sp[2], d = sp[3];
    float m = fmaxf(fmaxf(fmaxf(fabsf(a.x), fabsf(a.y)), fmaxf(fabsf(a.z), fabsf(a.w))), fmaxf(fmaxf(fabsf(b.x), fabsf(b.y)), fmaxf(fabsf(b.z), fabsf(b.w))));
    m = fmaxf(m, fmaxf(fmaxf(fmaxf(fabsf(c.x), fabsf(c.y)), fmaxf(fabsf(c.z), fabsf(c.w))), fmaxf(fmaxf(fabsf(d.x), fabsf(d.y)), fmaxf(fabsf(d.z), fabsf(d.w)))));
#pragma unroll
    for (int o = 1; o < 64; o <<= 1) m = fmaxf(m, __shfl_xor(m, o));
    const float sc = m > 0.f ? 224.0f / m : 1.0f;
    u32x4 w;
    int t = 0;
    t = __builtin_amdgcn_cvt_pk_fp8_f32(a.x * sc, a.y * sc, t, false); t = __builtin_amdgcn_cvt_pk_fp8_f32(a.z * sc, a.w * sc, t, true); w.x = (unsigned)t;
    t = __builtin_amdgcn_cvt_pk_fp8_f32(b.x * sc, b.y * sc, t, false); t = __builtin_amdgcn_cvt_pk_fp8_f32(b.z * sc, b.w * sc, t, true); w.y = (unsigned)t;
    t = __builtin_amdgcn_cvt_pk_fp8_f32(c.x * sc, c.y * sc, t, false); t = __builtin_amdgcn_cvt_pk_fp8_f32(c.z * sc, c.w * sc, t, true); w.z = (unsigned)t;
    t = __builtin_amdgcn_cvt_pk_fp8_f32(d.x * sc, d.y * sc, t, false); t = __builtin_amdgcn_cvt_pk_fp8_f32(d.z * sc, d.w * sc, t, true); w.w = (unsigned)t;
    if (slice_major) *(u32x4*)(dst + (size_t)(lane >> 3) * (PE * 128) + (size_t)row * 128 + (lane & 7) * 16) = w;
    else *(u32x4*)(dst + (size_t)row * D + lane * 16) = w;
    if (lane == 0) inv_scale[row] = m > 0.f ? m / 224.0f : 1.0f;
}
constexpr int P0_MOD = 384;
constexpr int P0_T_WIN = 16 * 16, P0_T_WGLU = 16 * 32, P0_T_WPROJ = 16 * 41, P0_T_WK1 = 32 * 4, P0_T_WK2 = 4 * 1, P0_T_WO = 16 * 16, P0_T_WQ = 16 * 32;
constexpr int P0_SUBK = (2 * 8 * 2 * 128 * 128) / 8192;
constexpr int P0_TAB = PE / 4;
constexpr int P0_S5T = 128, P0_S5W = 512, P0_S5V = 4096, P0_AL = 16, P0_ROPE = 2048, P0_CB = 16, P0_ZERO = 10 + 2;

__device__ __forceinline__ void phase_prep(const Params& p, float* lds) {
    const int n0 = P0_MOD;
    const int n1 = n0 + P0_T_WIN, n2 = n1 + P0_T_WGLU, n3 = n2 + P0_T_WPROJ, n4 = n3 + P0_T_WK1, n5 = n4 + P0_T_WK1, n6 = n5 + P0_T_WK2, n7 = n6 + P0_T_WK2,
              n8 = n7 + P0_T_WO, n9 = n8 + P0_T_WQ, n10 = n9 + P0_T_WQ, n11 = n10 + P0_SUBK, n12 = n11 + P0_TAB, n13 = n12 + P0_TAB,
              n14 = n13 + P0_S5T, n15 = n14 + P0_S5W, n16 = n15 + P0_S5V, n17 = n16 + P0_AL, n18 = n17 + P0_ROPE, n19 = n18 + P0_CB, n20 = n19 + 10, n21 = n20 + 2, n22 = n21 + 2;
    unsigned char* ws = p.ws;
    for (int it = blockIdx.x; it < n22; it += gridDim.x) {
        if (it < n0) prep_mod_item(p, it, lds);
        else if (it < n1) prep_transpose_item<0>(p.in[6], 1024, 1024, (bf16_t*)(ws + WS_WIN_T), it - n0, lds);
        else if (it < n2) prep_transpose_item<1>(p.in[15], 1024, 2048, (bf16_t*)(ws + WS_WGLU_T), it - n1, lds);
        else if (it < n3) prep_transpose_item<0>(p.in[16], 1024, NPROJ, (bf16_t*)(ws + WS_WPROJ_T), it - n2, lds);
        else if (it < n4) prep_transpose_item<0>(p.in[19], 2048, 256, (bf16_t*)(ws + WS_WK1_T), it - n3, lds);
        else if (it < n5) prep_transpose_item<0>(p.in[21], 2048, 256, (bf16_t*)(ws + WS_WV1_T), it - n4, lds);
        else if (it < n6) prep_transpose_item<0>(p.in[20], 256, 64, (bf16_t*)(ws + WS_WK2_T), it - n5, lds);
        else if (it < n7) prep_transpose_item<0>(p.in[22], 256, 64, (bf16_t*)(ws + WS_WV2_T), it - n6, lds);
        else if (it < n8) prep_transpose_item<0>(p.in[23], 1024, 1024, (bf16_t*)(ws + WS_WO_T), it - n7, lds);
        else if (it < n9) prep_transpose_item<0>(p.in[24], 1024, 2048, (bf16_t*)(ws + WS_WQ_T), it - n8, lds);
        else if (it < n10) prep_transpose_item<0>(p.in[24] + (size_t)1024 * 2048, 1024, 2048, (bf16_t*)(ws + WS_WQ_T) + (size_t)2048 * 1024, it - n9, lds);
        else if (it < n11) cvt_item(p.in[25], (bf16_t*)(ws + WS_SUBK), it - n10);
        else if (it < n12) cvt_fp8_item(p.in[26], ws + WS_PU, (float*)(ws + WS_PU + 24 * MiB), it - n11, false);
        else if (it < n13) cvt_fp8_item(p.in[27], ws + WS_PV, (float*)(ws + WS_PV + 24 * MiB), it - n12, false);
        else if (it < n14) prep_s5_T_item(p, it - n13);
        else if (it < n15) prep_s5_W_item(p, it - n14);
        else if (it < n16) prep_s5_V_item(p, it - n15);
        else if (it < n17) prep_al_item(p, it - n16);
        else if (it < n18) prep_rope_item(p, it - n17);
        else if (it < n19) prep_cmpbias_item(p, it - n18, lds);
        else if (it < n20) zero_item((bf16_t*)(ws + WS_WPROJ_T) + (size_t)NPROJ * 1024, it - n19);
        else if (it < n21) zero_item((bf16_t*)(ws + WS_WK2_T) + (size_t)64 * 256, it - n20);
        else zero_item((bf16_t*)(ws + WS_WV2_T) + (size_t)64 * 256, it - n21);
    }
}

__device__ __forceinline__ void phase_norm(const Params& p, const float* X, const float* gw, const float* shift, const float* scale  , bf16_t* HM) {
    const int lane = threadIdx.x & 63, wave = threadIdx.x >> 6;
    for (int row = blockIdx.x * 4 + wave; row < T; row += gridDim.x * 4) {
        const int b = row / SEQ;
        const f32x4* xr = (const f32x4*)(X + (size_t)row * D) + lane;
        f32x4 v[4]; float s = 0.f;
#pragma unroll
        for (int j = 0; j < 4; ++j) { v[j] = xr[64 * j]; s += (v[j].x * v[j].x + v[j].y * v[j].y) + (v[j].z * v[j].z + v[j].w * v[j].w); }
        const float rs = rsqrtf(wave_sum(s) * (1.0f / D) + RMS_EPS);
        u32x2* o = (u32x2*)(HM + (size_t)row * D) + lane;
#pragma unroll
        for (int j = 0; j < 4; ++j) {
            const int c = lane * 4 + 256 * j;
            const f32x4 g = *(const f32x4*)(gw + c), sh = *(const f32x4*)(shift + (size_t)b * 6144 + c), sc = *(const f32x4*)(scale + (size_t)b * 6144 + c);
            const float y0 = v[j].x * rs * g.x * (1.f + sc.x) + sh.x, y1 = v[j].y * rs * g.y * (1.f + sc.y) + sh.y;
            const float y2 = v[j].z * rs * g.z * (1.f + sc.z) + sh.z, y3 = v[j].w * rs * g.w * (1.f + sc.w) + sh.w;
            o[64 * j] = (u32x2){pk2(y0, y1), pk2(y2, y3)};
        }
    }
}
__device__ __forceinline__ void phase_final_norm(const Params& p, const float* X, float* OUT, bool dry) {
    const int lane = threadIdx.x & 63, wave = threadIdx.x >> 6;
    const float* gw = p.in[28];
    for (int row = blockIdx.x * 4 + wave; row < T; row += gridDim.x * 4) {
        const f32x4* xr = (const f32x4*)(X + (size_t)row * D) + lane;
        f32x4 v[4]; float s = 0.f;
#pragma unroll
        for (int j = 0; j < 4; ++j) { v[j] = xr[64 * j]; s += (v[j].x * v[j].x + v[j].y * v[j].y) + (v[j].z * v[j].z + v[j].w * v[j].w); }
        const float rs = rsqrtf(wave_sum(s) * (1.0f / D) + RMS_EPS);
        f32x4* o = (f32x4*)(OUT + (size_t)row * D) + lane;
#pragma unroll
        for (int j = 0; j < 4; ++j) {
            const f32x4 g = *(const f32x4*)(gw + lane * 4 + 256 * j);
            if (!dry) o[64 * j] = (f32x4){v[j].x * rs * g.x, v[j].y * rs * g.y, v[j].z * rs * g.z, v[j].w * rs * g.w};
        }
    }
}

__device__ __forceinline__ int vblock() { const int G = gridDim.x, bx = blockIdx.x; return (G % 8 == 0) ? (bx % 8) * (G / 8) + bx / 8 : bx; }
struct ALoadPlain {
    const bf16_t* A; size_t lda;
    __device__ __forceinline__ const bf16_t* base(int kt) const { return A + kt * 64; }
    __device__ __forceinline__ unsigned off(int r, int lc) const { return (unsigned)r * (unsigned)lda + (unsigned)lc * 8u; }
};
struct ALoadGroup {
    const bf16_t* A;
    __device__ __forceinline__ const bf16_t* base(int kt) const { return A + (size_t)kt * 4 * T * 16; }
    __device__ __forceinline__ unsigned off(int r, int lc) const { return ((unsigned)(lc >> 1) * (unsigned)T + (unsigned)r) * 16u + (unsigned)(lc & 1) * 8u; }
};

template <class AL>
__device__ __forceinline__ void gemm_tile2(const AL al, const bf16_t* __restrict__ Bt, size_t ldb, int nk, f32x4 (&acc)[4][4], unsigned char* lds) {
    const int tid = threadIdx.x, lane = tid & 63, wid = tid >> 6, wr = wid >> 1, wc = wid & 1, fr = lane & 15, fq = lane >> 4;
    const int lr = tid >> 3, lc = tid & 7;
#pragma unroll
    for (int mi = 0; mi < 4; ++mi)
#pragma unroll
        for (int ni = 0; ni < 4; ++ni) acc[mi][ni] = (f32x4){0.f, 0.f, 0.f, 0.f};
    u32x4 ra0[4], rb0[4], ra1[4], rb1[4];
    const int soff = lr * 128 + ((lc ^ (lr & 7)) << 4);
    unsigned offA[4], offB[4];
#pragma unroll
    for (int i = 0; i < 4; ++i) { offA[i] = al.off(lr + 32 * i, lc); offB[i] = (unsigned)(lr + 32 * i) * (unsigned)ldb + (unsigned)lc * 8u; }
#define GT_LOAD(RA, RB, kt_) do { const bf16_t* ab_ = al.base(kt_); const bf16_t* bb_ = Bt + (kt_) * 64; _Pragma("unroll") for (int i = 0; i < 4; ++i) { RA[i] = *(const u32x4*)(ab_ + offA[i]); RB[i] = *(const u32x4*)(bb_ + offB[i]); } } while (0)
#define GT_STORE(RA, RB, buf_) do { unsigned char* nb_ = lds + (buf_) * 32768; _Pragma("unroll") for (int i = 0; i < 4; ++i) { *(u32x4*)(nb_ + soff + i * 4096) = RA[i]; *(u32x4*)(nb_ + 16384 + soff + i * 4096) = RB[i]; } } while (0)
    const int aoff = (wr * 64 + fr) * 128, boff = 16384 + (wc * 64 + fr) * 128, sw = fr & 7;
#define GT_MATH(buf_) do { const unsigned char* bp_ = lds + (buf_) * 32768; _Pragma("unroll") for (int ks = 0; ks < 2; ++ks) { bf16x8 af[4], bfr[4]; const int co = ((ks * 4 + fq) ^ sw) << 4; \
        _Pragma("unroll") for (int mi = 0; mi < 4; ++mi) af[mi] = *(const bf16x8*)(bp_ + aoff + mi * 2048 + co); \
        _Pragma("unroll") for (int ni = 0; ni < 4; ++ni) bfr[ni] = *(const bf16x8*)(bp_ + boff + ni * 2048 + co); \
        _Pragma("unroll") for (int mi = 0; mi < 4; ++mi) _Pragma("unroll") for (int ni = 0; ni < 4; ++ni) acc[mi][ni] = __builtin_amdgcn_mfma_f32_16x16x32_bf16(bfr[ni], af[mi], acc[mi][ni], 0, 0, 0); } } while (0)
    GT_LOAD(ra0, rb0, 0);
    if (nk > 1) GT_LOAD(ra1, rb1, 1);
    GT_STORE(ra0, rb0, 0);
    __syncthreads();
    for (int kt = 0; kt < nk; kt += 2) {
        if (kt + 2 < nk) GT_LOAD(ra0, rb0, kt + 2);
        __builtin_amdgcn_sched_barrier(0);
        GT_MATH(0);
        __builtin_amdgcn_sched_barrier(0);
        if (kt + 1 < nk) GT_STORE(ra1, rb1, 1);
        __syncthreads();
        if (kt + 1 >= nk) break;
        if (kt + 3 < nk) GT_LOAD(ra1, rb1, kt + 3);
        __builtin_amdgcn_sched_barrier(0);
        GT_MATH(1);
        __builtin_amdgcn_sched_barrier(0);
        if (kt + 2 < nk) GT_STORE(ra0, rb0, 0);
        __syncthreads();
    }
#undef GT_LOAD
#undef GT_STORE
#undef GT_MATH
}

template <class AL>
__device__ __forceinline__ void gemm_tile1(const AL al, const bf16_t* __restrict__ Bt, size_t ldb, int nk, f32x4 (&acc)[4][4], unsigned char* lds) {
    const int tid = threadIdx.x, lane = tid & 63, wid = tid >> 6, wr = wid >> 1, wc = wid & 1, fr = lane & 15, fq = lane >> 4;
    const int lr = tid >> 3, lc = tid & 7;
#pragma unroll
    for (int mi = 0; mi < 4; ++mi)
#pragma unroll
        for (int ni = 0; ni < 4; ++ni) acc[mi][ni] = (f32x4){0.f, 0.f, 0.f, 0.f};
    u32x4 ra[4], rb[4];
    const int soff = lr * 128 + ((lc ^ (lr & 7)) << 4);
#pragma unroll
    for (int i = 0; i < 4; ++i) { ra[i] = *(const u32x4*)(al.base(0) + al.off(lr + 32 * i, lc)); rb[i] = *(const u32x4*)(Bt + (size_t)(lr + 32 * i) * ldb + lc * 8); }
#pragma unroll
    for (int i = 0; i < 4; ++i) { *(u32x4*)(lds + soff + i * 4096) = ra[i]; *(u32x4*)(lds + 16384 + soff + i * 4096) = rb[i]; }
    __syncthreads();
    const int aoff = (wr * 64 + fr) * 128, boff = 16384 + (wc * 64 + fr) * 128, sw = fr & 7;
    for (int kt = 0; kt < nk; ++kt) {
        const bool more = (kt + 1 < nk);
        if (more) {
#pragma unroll
            for (int i = 0; i < 4; ++i) { ra[i] = *(const u32x4*)(al.base(kt + 1) + al.off(lr + 32 * i, lc)); rb[i] = *(const u32x4*)(Bt + (size_t)(lr + 32 * i) * ldb + (kt + 1) * 64 + lc * 8); }
        }
        const unsigned char* buf = lds + (kt & 1) * 32768;
#pragma unroll
        for (int ks = 0; ks < 2; ++ks) {
            bf16x8 af[4], bfr[4];
            const int co = ((ks * 4 + fq) ^ sw) << 4;
#pragma unroll
            for (int mi = 0; mi < 4; ++mi) af[mi] = *(const bf16x8*)(buf + aoff + mi * 2048 + co);
#pragma unroll
            for (int ni = 0; ni < 4; ++ni) bfr[ni] = *(const bf16x8*)(buf + boff + ni * 2048 + co);
#pragma unroll
            for (int mi = 0; mi < 4; ++mi)
#pragma unroll
                for (int ni = 0; ni < 4; ++ni) acc[mi][ni] = __builtin_amdgcn_mfma_f32_16x16x32_bf16(bfr[ni], af[mi], acc[mi][ni], 0, 0, 0);
        }
        if (more) {
            unsigned char* nb = lds + ((kt + 1) & 1) * 32768;
#pragma unroll
            for (int i = 0; i < 4; ++i) { *(u32x4*)(nb + soff + i * 4096) = ra[i]; *(u32x4*)(nb + 16384 + soff + i * 4096) = rb[i]; }
        }
        __syncthreads();
    }
}
__device__ __forceinline__ void phase_s5_win(const Params& p, unsigned char* lds) {
    const bf16_t* HM = (const bf16_t*)(p.ws + WS_HM); const bf16_t* WT = (const bf16_t*)(p.ws + WS_WIN_T);
    bf16_t* UG = (bf16_t*)(p.ws + WS_UG);
    const int lane = threadIdx.x & 63, wid = threadIdx.x >> 6, wr = wid >> 1, wc = wid & 1, fr = lane & 15, fq = lane >> 4;
    for (int id = vblock(); id < 256 * 8; id += gridDim.x) {
        const int mt = id >> 3, nt = id & 7;
        f32x4 acc[4][4];
        gemm_tile2(ALoadPlain{HM + (size_t)mt * 128 * D, (size_t)D}, WT + (size_t)nt * 128 * D, D, 16, acc, lds);
#pragma unroll
        for (int mi = 0; mi < 4; ++mi)
#pragma unroll
            for (int ni = 0; ni < 4; ++ni) {
                const int t = mt * 128 + wr * 64 + mi * 16 + fr, g = nt * 8 + wc * 4 + ni;
                const f32x4 v = acc[mi][ni];
                *(u32x2*)(UG + ((size_t)g * T + t) * 16 + fq * 4) = (u32x2){pk2(v.x, v.y), pk2(v.z, v.w)};
            }
    }
}
__device__ __forceinline__ void phase_s5_a(const Params& p, unsigned char* lds) {
    const bf16_t* UG = (const bf16_t*)(p.ws + WS_UG); const bf16_t* TW = (const bf16_t*)(p.ws + WS_TW);
    bf16_t* YI = (bf16_t*)(p.ws + WS_YI); float* WST = (float*)(p.ws + WS_WST);
    const int lane = threadIdx.x & 63, wid = threadIdx.x >> 6, wr = wid >> 1, wc = wid & 1, fr = lane & 15, fq = lane >> 4;
    for (int id = vblock(); id < 64 * 40; id += gridDim.x) {
        const int g = id / 40, rem = id % 40, mt = rem / 5, nt = rem % 5;
        const int nk = (nt < 4) ? 2 * (nt + 1) : 8;
        f32x4 acc[4][4];
        gemm_tile1(ALoadPlain{UG + (size_t)g * T * 16 + (size_t)mt * 128 * 512, (size_t)512}, TW + ((size_t)g * 640 + nt * 128) * 512, 512, nk, acc, lds);
#pragma unroll
        for (int mi = 0; mi < 4; ++mi)
#pragma unroll
            for (int ni = 0; ni < 4; ++ni) {
                const int R = mt * 128 + wr * 64 + mi * 16 + fr, c = wc * 64 + ni * 16 + fq * 4;
                const f32x4 v = acc[mi][ni];
                if (nt < 4) *(u32x2*)(YI + ((size_t)g * 1024 + R) * 512 + nt * 128 + c) = (u32x2){pk2(v.x, v.y), pk2(v.z, v.w)};
                else *(f32x4*)(WST + ((size_t)g * 1024 + R) * 128 + c) = v;
            }
    }
}
__device__ __forceinline__ void phase_s5_scan(const Params& p) {
    const int lane = threadIdx.x & 63, wave = threadIdx.x >> 6;
    const float* WST = (const float*)(p.ws + WS_WST); bf16_t* SST = (bf16_t*)(p.ws + WS_SST);
    const f32x2* AL = (const f32x2*)(p.ws + WS_MISC + 4096);
    for (int it = blockIdx.x * 4 + wave; it < 128; it += gridDim.x * 4) {
        const int b = it >> 6, g = it & 63;
        const f32x2 al = AL[g * 64 + lane];
        float sr = 0.f, si = 0.f;
        const float* wbase = WST + ((size_t)g * 1024 + b * 512) * 128 + lane;
        bf16_t* sbase = SST + ((size_t)g * 1024 + b * 512) * 128 + lane;
        for (int n0 = 0; n0 < 512; n0 += 16) {
            float wre[16], wim[16];
#pragma unroll
            for (int j = 0; j < 16; ++j) { wre[j] = wbase[(size_t)(n0 + j) * 128]; wim[j] = wbase[(size_t)(n0 + j) * 128 + 64]; }
#pragma unroll
            for (int j = 0; j < 16; ++j) {
                sbase[(size_t)(n0 + j) * 128] = (bf16_t)f2bf(sr); sbase[(size_t)(n0 + j) * 128 + 64] = (bf16_t)f2bf(si);
                const float nr = al.x * sr - al.y * si + wre[j], ni = al.x * si + al.y * sr + wim[j];
                sr = nr; si = ni;
            }
        }
    }
}
__device__ __forceinline__ void phase_s5_b(const Params& p, unsigned char* lds) {
    const bf16_t* SST = (const bf16_t*)(p.ws + WS_SST); const bf16_t* VG = (const bf16_t*)(p.ws + WS_VG);
    const bf16_t* YI = (const bf16_t*)(p.ws + WS_YI); const bf16_t* UG = (const bf16_t*)(p.ws + WS_UG);
    bf16_t* YG = (bf16_t*)(p.ws + WS_YG);
    const float* dsk = p.in[14];
    const int lane = threadIdx.x & 63, wid = threadIdx.x >> 6, wr = wid >> 1, wc = wid & 1, fr = lane & 15, fq = lane >> 4;
    for (int id = vblock(); id < 64 * 32; id += gridDim.x) {
        const int g = id >> 5, mt = (id >> 2) & 7, nt = id & 3;
        f32x4 acc[4][4];
        gemm_tile1(ALoadPlain{SST + ((size_t)g * 1024 + mt * 128) * 128, (size_t)128}, VG + ((size_t)g * 512 + nt * 128) * 128, 128, 2, acc, lds);
        const f32x4 dv = *(const f32x4*)(dsk + g * 16 + fq * 4);
#pragma unroll
        for (int mi = 0; mi < 4; ++mi)
#pragma unroll
            for (int ni = 0; ni < 4; ++ni) {
                const int R = mt * 128 + wr * 64 + mi * 16 + fr, c = nt * 128 + wc * 64 + ni * 16 + fq * 4;
                const size_t idx = ((size_t)g * 1024 + R) * 512 + c;
                const u32x2 yi = *(const u32x2*)(YI + idx), uu = *(const u32x2*)(UG + idx);
                const f32x4 v = acc[mi][ni];
                const float y0 = gelu_tanh(v.x + bflo(yi.x) + dv.x * bflo(uu.x)), y1 = gelu_tanh(v.y + bfhi(yi.x) + dv.y * bfhi(uu.x));
                const float y2 = gelu_tanh(v.z + bflo(yi.y) + dv.z * bflo(uu.y)), y3 = gelu_tanh(v.w + bfhi(yi.y) + dv.w * bfhi(uu.y));
                *(u32x2*)(YG + idx) = (u32x2){pk2(y0, y1), pk2(y2, y3)};
            }
    }
}
__device__ __forceinline__ void phase_s5_glu(const Params& p, unsigned char* lds) {
    const bf16_t* YG = (const bf16_t*)(p.ws + WS_YG); const bf16_t* WT = (const bf16_t*)(p.ws + WS_WGLU_T);
    const float* MOD = (const float*)(p.ws + WS_MOD);
    const float* X = p.in[0]; float* XO = p.out;
    const int lane = threadIdx.x & 63, wid = threadIdx.x >> 6, wr = wid >> 1, wc = wid & 1, fr = lane & 15, fq = lane >> 4;
    for (int id = vblock(); id < 256 * 16; id += gridDim.x) {
        const int mt = id >> 4, nt = id & 15;
        f32x4 acc[4][4];
        gemm_tile2(ALoadGroup{YG + (size_t)mt * 128 * 16}, WT + (size_t)nt * 128 * D, D, 16, acc, lds);
        const int b = (mt * 128) / SEQ;
#pragma unroll
        for (int mi = 0; mi < 4; ++mi)
#pragma unroll
            for (int h = 0; h < 2; ++h) {
                const int t = mt * 128 + wr * 64 + mi * 16 + fr, j = nt * 64 + wc * 32 + h * 16 + fq * 4;
                const f32x4 a = acc[mi][2 * h], gg = acc[mi][2 * h + 1];
                const f32x4 g1 = *(const f32x4*)(MOD + (size_t)(0 * 2 + b) * 6144 + 2048 + j);
                const f32x4 xi = *(const f32x4*)(X + (size_t)t * D + j);
                f32x4 o;
                o.x = xi.x + g1.x * (a.x * sigmoidf_(gg.x)); o.y = xi.y + g1.y * (a.y * sigmoidf_(gg.y));
                o.z = xi.z + g1.z * (a.z * sigmoidf_(gg.z)); o.w = xi.w + g1.w * (a.w * sigmoidf_(gg.w));
                *(f32x4*)(XO + (size_t)t * D + j) = o;
            }
    }
}
__device__ __forceinline__ void phase_peer_wq(const Params& p, int layer, unsigned char* lds) {
    const bf16_t* HM = (const bf16_t*)(p.ws + WS_HM); const bf16_t* WT = (const bf16_t*)(p.ws + WS_WQ_T) + (size_t)layer * 2048 * 1024;
    bf16_t* QK = (bf16_t*)(p.ws + WS_QK);
    const int lane = threadIdx.x & 63, wid = threadIdx.x >> 6, wr = wid >> 1, wc = wid & 1, fr = lane & 15, fq = lane >> 4;
    for (int id = vblock(); id < 256 * 16; id += gridDim.x) {
        const int mt = id >> 4, nt = id & 15;
        f32x4 acc[4][4];
        gemm_tile2(ALoadPlain{HM + (size_t)mt * 128 * D, (size_t)D}, WT + (size_t)nt * 128 * D, D, 16, acc, lds);
#pragma unroll
        for (int mi = 0; mi < 4; ++mi)
#pragma unroll
            for (int ni = 0; ni < 4; ++ni) {
                const int t = mt * 128 + wr * 64 + mi * 16 + fr, c = nt * 128 + wc * 64 + ni * 16 + fq * 4;
                const f32x4 v = acc[mi][ni];
                *(u32x2*)(QK + (size_t)t * 2048 + c) = (u32x2){pk2(v.x, v.y), pk2(v.z, v.w)};
            }
    }
}
__device__ __forceinline__ void ce_(unsigned& a, unsigned& b, const bool up) { const unsigned lo = a < b ? a : b, hi = a < b ? b : a; a = up ? lo : hi; b = up ? hi : lo; }
__device__ __forceinline__ void bitonic_sort16(unsigned* x, const bool asc) {
#pragma unroll
    for (int k = 2; k <= 16; k <<= 1)
#pragma unroll
        for (int j = k >> 1; j > 0; j >>= 1)
#pragma unroll
            for (int i = 0; i < 16; ++i) { const int l = i ^ j; if (l > i) ce_(x[i], x[l], ((i & k) == 0) == asc); }
}
__device__ __forceinline__ void bitonic_merge16(unsigned* x, const bool asc) {
#pragma unroll
    for (int j = 8; j > 0; j >>= 1)
#pragma unroll
        for (int i = 0; i < 16; ++i) { const int l = i ^ j; if (l > i) ce_(x[i], x[l], asc); }
}
__device__ __forceinline__ void phase_peer_topk(const Params& p, int layer, unsigned char* lds) {
    const bf16_t* QK = (const bf16_t*)(p.ws + WS_QK); const bf16_t* SK = (const bf16_t*)(p.ws + WS_SUBK) + (size_t)layer * 8 * 2 * 128 * 128;
    float* TOPS = (float*)(p.ws + WS_TOPS); int* TOPI = (int*)(p.ws + WS_TOPI);
    float* sc = (float*)lds;
    const int tid = threadIdx.x, lane = tid & 63, wid = tid >> 6, wr = wid >> 1, wc = wid & 1, fr = lane & 15, fq = lane >> 4;
    for (int id = vblock(); id < 256 * 16; id += gridDim.x) {
        const int mt = id >> 4, hc = id & 15;
        f32x4 acc[4][4];
        gemm_tile1(ALoadPlain{QK + (size_t)mt * 128 * 2048 + hc * 128, (size_t)2048}, SK + (size_t)hc * 128 * 128, 128, 2, acc, lds);
#pragma unroll
        for (int mi = 0; mi < 4; ++mi)
#pragma unroll
            for (int ni = 0; ni < 4; ++ni) {
                const int r = wr * 64 + mi * 16 + fr, c = wc * 64 + ni * 16 + fq * 4;
                float* d = sc + r * 129 + c;
                d[0] = acc[mi][ni].x; d[1] = acc[mi][ni].y; d[2] = acc[mi][ni].z; d[3] = acc[mi][ni].w;
            }
        __syncthreads();
        {
            const int row = tid >> 1, half = tid & 1;
            unsigned x[64];
            const float* rp = sc + row * 129 + half * 64;
#pragma unroll
            for (int j = 0; j < 64; ++j) {
                const unsigned bits = __builtin_bit_cast(unsigned, rp[j]);
                const unsigned u = bits ^ ((unsigned)((int)bits >> 31) | 0x80000000u);
                x[j] = (u & 0xFFFFFF80u) | (unsigned)(127 - (half * 64 + j));
            }
            bitonic_sort16(x, true); bitonic_sort16(x + 16, false); bitonic_sort16(x + 32, true); bitonic_sort16(x + 48, false);
#pragma unroll
            for (int i = 0; i < 16; ++i) { x[i] = x[i] > x[16 + i] ? x[i] : x[16 + i]; x[32 + i] = x[32 + i] > x[48 + i] ? x[32 + i] : x[48 + i]; }
            bitonic_merge16(x, true); bitonic_merge16(x + 32, false);
#pragma unroll
            for (int i = 0; i < 16; ++i) x[i] = x[i] > x[32 + i] ? x[i] : x[32 + i];
            bitonic_merge16(x, false);
            unsigned y[16];
#pragma unroll
            for (int i = 0; i < 16; ++i) { const unsigned o = (unsigned)__shfl_xor((int)x[15 - i], 1); y[i] = x[i] > o ? x[i] : o; }
            bitonic_merge16(y, false);
            const size_t ob = ((size_t)(mt * 128 + row) * 16 + hc) * 16;
            if (half == 0) {
                float v[16];
#pragma unroll
                for (int i = 0; i < 16; ++i) { const unsigned u = y[i] & 0xFFFFFF80u; const unsigned bits = (u & 0x80000000u) ? (u ^ 0x80000000u) : ~u; v[i] = __builtin_bit_cast(float, bits); }
#pragma unroll
                for (int q = 0; q < 4; ++q) *(f32x4*)(TOPS + ob + q * 4) = (f32x4){v[q * 4], v[q * 4 + 1], v[q * 4 + 2], v[q * 4 + 3]};
            } else {
#pragma unroll
                for (int q = 0; q < 4; ++q) *(u32x4*)(TOPI + ob + q * 4) = (u32x4){127u - (y[q * 4] & 127u), 127u - (y[q * 4 + 1] & 127u), 127u - (y[q * 4 + 2] & 127u), 127u - (y[q * 4 + 3] & 127u)};
            }
        }
        __syncthreads();
    }
}
__device__ __forceinline__ void phase_peer_combine(const Params& p, unsigned char* lds) {
    const float* TOPS = (const float*)(p.ws + WS_TOPS); const int* TOPI = (const int*)(p.ws + WS_TOPI);
    int* EXP = (int*)(p.ws + WS_EXP); float* GATE = (float*)(p.ws + WS_GATE);
    unsigned* L = (unsigned*)lds;
    const int tid = threadIdx.x;
    for (int it = blockIdx.x; it < (T * 8) / 256; it += gridDim.x) {
        const size_t th = (size_t)it * 256 + tid;
        const u32x4* S4 = (const u32x4*)(TOPS + th * 32); const u32x4* I4 = (const u32x4*)(TOPI + th * 32);
#pragma unroll
        for (int a4 = 0; a4 < 8; ++a4) {
            const u32x4 s = S4[a4], i = I4[a4];
            L[(a4 * 4 + 0) * 256 + tid] = s.x; L[(a4 * 4 + 1) * 256 + tid] = s.y; L[(a4 * 4 + 2) * 256 + tid] = s.z; L[(a4 * 4 + 3) * 256 + tid] = s.w;
            L[(32 + a4 * 4 + 0) * 256 + tid] = i.x; L[(32 + a4 * 4 + 1) * 256 + tid] = i.y; L[(32 + a4 * 4 + 2) * 256 + tid] = i.z; L[(32 + a4 * 4 + 3) * 256 + tid] = i.w;
        }
        float val[16];
        const float s20 = __builtin_bit_cast(float, L[16 * 256 + tid]);
#pragma unroll
        for (int a = 0; a < 16; ++a) val[a] = __builtin_bit_cast(float, L[a * 256 + tid]) + s20;
        unsigned long long P = 0ull;
        float ts[16]; int te[16];
#pragma unroll
        for (int r = 0; r < 16; ++r) {
            float best = val[0]; int ba = 0;
#pragma unroll
            for (int a = 1; a < 16; ++a) if (val[a] > best) { best = val[a]; ba = a; }
            const int b = (int)((P >> (4 * ba)) & 15ull);
            const int i1 = (int)L[(32 + ba) * 256 + tid], i2 = (int)L[(48 + b) * 256 + tid];
            ts[r] = best; te[r] = i1 * 128 + i2;
            const int nb = b + 1;
            float newv = -3.0e38f;
            if (nb < 16) { newv = __builtin_bit_cast(float, L[ba * 256 + tid]) + __builtin_bit_cast(float, L[(16 + nb) * 256 + tid]); P += 1ull << (4 * ba); }
#pragma unroll
            for (int a = 0; a < 16; ++a) val[a] = (a == ba) ? newv : val[a];
        }
        const float m0 = ts[0];
        float sum = 0.f;
#pragma unroll
        for (int r = 0; r < 16; ++r) { ts[r] = __expf(ts[r] - m0); sum += ts[r]; }
        const float inv = 1.0f / sum;
#pragma unroll
        for (int r = 0; r < 16; ++r) ts[r] *= inv;
#pragma unroll
        for (int r = 0; r < 16; ++r) { EXP[th * 16 + r] = te[r]; GATE[th * 16 + r] = ts[r]; }
    }
}

__device__ __forceinline__ void fma8(const unsigned w0, const unsigned w1, const float a, float* acc) {
    const f32x2 p0 = __builtin_amdgcn_cvt_pk_f32_fp8((int)w0, false), p1 = __builtin_amdgcn_cvt_pk_f32_fp8((int)w0, true);
    const f32x2 p2 = __builtin_amdgcn_cvt_pk_f32_fp8((int)w1, false), p3 = __builtin_amdgcn_cvt_pk_f32_fp8((int)w1, true);
    acc[0] += a * p0.x; acc[1] += a * p0.y; acc[2] += a * p1.x; acc[3] += a * p1.y;
    acc[4] += a * p2.x; acc[5] += a * p2.y; acc[6] += a * p3.x; acc[7] += a * p3.y;
}
__device__ __forceinline__ float dot8(const unsigned w0, const unsigned w1, const float* h, float s) {
    const f32x2 p0 = __builtin_amdgcn_cvt_pk_f32_fp8((int)w0, false), p1 = __builtin_amdgcn_cvt_pk_f32_fp8((int)w0, true);
    const f32x2 p2 = __builtin_amdgcn_cvt_pk_f32_fp8((int)w1, false), p3 = __builtin_amdgcn_cvt_pk_f32_fp8((int)w1, true);
    s += p0.x * h[0]; s += p0.y * h[1]; s += p1.x * h[2]; s += p1.y * h[3];
    s += p2.x * h[4]; s += p2.y * h[5]; s += p3.x * h[6]; s += p3.y * h[7];
    return s;
}
__device__ __forceinline__ void phase_peer_apply(const Params& p, int layer, unsigned char* lds, bool dry) {
    const int lane = threadIdx.x & 63, wave = threadIdx.x >> 6;
    float* ldsw = (float*)lds + wave * (64 * 65);
    const bf16_t* HM = (const bf16_t*)(p.ws + WS_HM);
    const unsigned char* PU = p.ws + WS_PU; const unsigned char* PV = p.ws + WS_PV;
    const float* SU = (const float*)(p.ws + WS_PU + 24 * MiB); const float* SV = (const float*)(p.ws + WS_PV + 24 * MiB);
    const int* EXP = (const int*)(p.ws + WS_EXP); const float* GATE = (const float*)(p.ws + WS_GATE);
    const float* MOD = (const float*)(p.ws + WS_MOD);
    float* X = p.out;
    for (int t = blockIdx.x * 4 + wave; t < T; t += gridDim.x * 4) {
        const u32x4 ha = *(const u32x4*)(HM + (size_t)t * D + lane * 16), hb = *(const u32x4*)(HM + (size_t)t * D + lane * 16 + 8);
        float hf[16];
        hf[0] = bflo(ha.x); hf[1] = bfhi(ha.x); hf[2] = bflo(ha.y); hf[3] = bfhi(ha.y); hf[4] = bflo(ha.z); hf[5] = bfhi(ha.z); hf[6] = bflo(ha.w); hf[7] = bfhi(ha.w);
        hf[8] = bflo(hb.x); hf[9] = bfhi(hb.x); hf[10] = bflo(hb.y); hf[11] = bfhi(hb.y); hf[12] = bflo(hb.z); hf[13] = bfhi(hb.z); hf[14] = bflo(hb.w); hf[15] = bfhi(hb.w);
        const int e0 = EXP[(size_t)t * 128 + lane], e1 = EXP[(size_t)t * 128 + 64 + lane];
        const float g0 = GATE[(size_t)t * 128 + lane], g1 = GATE[(size_t)t * 128 + 64 + lane];
        const float su0 = SU[e0], su1 = SU[e1], sv0 = SV[e0], sv1 = SV[e1];
        u32x4 buf[16];
        float act0 = 0.f, act1 = 0.f;
        float acc[16];
#pragma unroll
        for (int i = 0; i < 16; ++i) acc[i] = 0.f;
#pragma unroll
        for (int j = 0; j < 16; ++j) { const int e_ = __builtin_amdgcn_readlane(e0, j); buf[j] = *(const u32x4*)(PU + (size_t)e_ * D + lane * 16); }
#pragma unroll
        for (int bt = 0; bt < 16; ++bt) {
#pragma unroll
            for (int j = 0; j < 16; ++j) {
                if (bt < 8) {
                    float s_ = dot8(buf[j].x, buf[j].y, hf, 0.f); s_ = dot8(buf[j].z, buf[j].w, hf + 8, s_);
                    ldsw[((bt & 3) * 16 + j) * 65 + lane] = s_;
                } else {
                    const float av_ = ((bt & 7) < 4) ? act0 : act1;
                    const float a_ = __builtin_bit_cast(float, __builtin_amdgcn_readlane(__builtin_bit_cast(int, av_), (bt & 3) * 16 + j));
                    fma8(buf[j].x, buf[j].y, a_, acc); fma8(buf[j].z, buf[j].w, a_, acc + 8);
                }
                if (bt + 1 < 16) {
                    const int nb = bt + 1;
                    const int e_ = __builtin_amdgcn_readlane(((nb & 7) < 4) ? e0 : e1, (nb & 3) * 16 + j);
                    buf[j] = *(const u32x4*)(((nb < 8) ? PU : PV) + (size_t)e_ * D + lane * 16);
                }
            }
            if (bt == 3 || bt == 7) {
                float tot_ = 0.f;
#pragma unroll 16
                for (int q = 0; q < 64; ++q) tot_ += ldsw[lane * 65 + q];
                if (bt == 3) act0 = gelu_tanh(tot_ * su0) * g0 * sv0; else act1 = gelu_tanh(tot_ * su1) * g1 * sv1;
            }
        }
        const int b = t / SEQ;
        const float* g2 = MOD + (size_t)(layer * 2 + b) * 6144 + 5120;
        float* xr = X + (size_t)t * D + lane * 16;
        f32x4 xs[4]; float ss = 0.f;
#pragma unroll
        for (int q = 0; q < 4; ++q) {
            const f32x4 g = *(const f32x4*)(g2 + lane * 16 + q * 4); f32x4 x = *(const f32x4*)(xr + q * 4);
            x.x += g.x * acc[q * 4 + 0]; x.y += g.y * acc[q * 4 + 1]; x.z += g.z * acc[q * 4 + 2]; x.w += g.w * acc[q * 4 + 3];
            xs[q] = x; ss += (x.x * x.x + x.y * x.y) + (x.z * x.z + x.w * x.w);
        }
        const float rs = rsqrtf(wave_sum(ss) * (1.0f / D) + RMS_EPS);
        if (!dry) {
            if (layer == 0) {
                const float* gw = p.in[2] + D + lane * 16; const float* sh = MOD + (size_t)(2 + b) * 6144 + lane * 16; const float* sc = sh + 1024;
                u32x4 o[2];
#pragma unroll
                for (int q = 0; q < 4; ++q) {
                    *(f32x4*)(xr + q * 4) = xs[q];
                    const f32x4 g = *(const f32x4*)(gw + q * 4), s1 = *(const f32x4*)(sc + q * 4), s0 = *(const f32x4*)(sh + q * 4);
                    const float y0 = xs[q].x * rs * g.x * (1.f + s1.x) + s0.x, y1 = xs[q].y * rs * g.y * (1.f + s1.y) + s0.y;
                    const float y2 = xs[q].z * rs * g.z * (1.f + s1.z) + s0.z, y3 = xs[q].w * rs * g.w * (1.f + s1.w) + s0.w;
                    if (q & 1) { o[q >> 1].z = pk2(y0, y1); o[q >> 1].w = pk2(y2, y3); } else { o[q >> 1].x = pk2(y0, y1); o[q >> 1].y = pk2(y2, y3); }
                }
                bf16_t* hm = (bf16_t*)(p.ws + WS_HM) + (size_t)t * D + lane * 16;
                *(u32x4*)hm = o[0]; *(u32x4*)(hm + 8) = o[1];
            } else {
                const float* gw = p.in[28] + lane * 16;
#pragma unroll
                for (int q = 0; q < 4; ++q) {
                    const f32x4 g = *(const f32x4*)(gw + q * 4);
                    *(f32x4*)(xr + q * 4) = (f32x4){xs[q].x * rs * g.x, xs[q].y * rs * g.y, xs[q].z * rs * g.z, xs[q].w * rs * g.w};
                }
            }
        }
    }
}
__device__ __forceinline__ void phase_tab1(const Params& p) {
    for (int it = blockIdx.x; it < 2 * P0_TAB; it += gridDim.x) {
        if (it < P0_TAB) cvt_fp8_item(p.in[26] + (size_t)PE * D, p.ws + WS_PU, (float*)(p.ws + WS_PU + 24 * MiB), it, false);
        else cvt_fp8_item(p.in[27] + (size_t)PE * D, p.ws + WS_PV, (float*)(p.ws + WS_PV + 24 * MiB), it - P0_TAB, false);
    }
}
__device__ __forceinline__ void phase_nsa_proj(const Params& p, unsigned char* lds) {
    const bf16_t* HM = (const bf16_t*)(p.ws + WS_HM); const bf16_t* WT = (const bf16_t*)(p.ws + WS_WPROJ_T);
    const f32x2* ROPE = (const f32x2*)(p.ws + WS_ROPE);
    bf16_t* Q = (bf16_t*)(p.ws + WS_Q); float* NGT = (float*)(p.ws + WS_NG);
    const int lane = threadIdx.x & 63, wid = threadIdx.x >> 6, wr = wid >> 1, wc = wid & 1, fr = lane & 15, fq = lane >> 4;
    for (int id = vblock(); id < 256 * 21; id += gridDim.x) {
        const int mt = id / 21, nt = id % 21;
        f32x4 acc[4][4];
        gemm_tile2(ALoadPlain{HM + (size_t)mt * 128 * D, (size_t)D}, WT + (size_t)nt * 128 * D, D, 16, acc, lds);
        const int c0 = nt * 128 + wc * 64;
        if (c0 >= 2624) continue;
        const int b = (mt * 128) / SEQ;
        if (c0 == 2560) {
#pragma unroll
            for (int mi = 0; mi < 4; ++mi)
#pragma unroll
                for (int ni = 0; ni < 3; ++ni) {
                    const int t = mt * 128 + wr * 64 + mi * 16 + fr;
                    const f32x4 v = acc[mi][ni];
                    *(f32x4*)(NGT + (size_t)t * 48 + ni * 16 + fq * 4) = (f32x4){sigmoidf_(v.x), sigmoidf_(v.y), sigmoidf_(v.z), sigmoidf_(v.w)};
                }
            continue;
        }
        int sec = -1, g = 0;
        if (c0 >= 1024) { sec = (c0 - 1024) >> 8; g = ((c0 - 1024) & 255) >> 6; }
        const bool dorope = (sec == -1) || (sec == 2) || (sec == 4);
        const float scl = (sec == -1) ? 0.125f : 1.0f;
        const size_t secoff[6] = {WS_KC, WS_VC, WS_KS, WS_VST, WS_KW, WS_VWT};
        size_t so = WS_Q;
#pragma unroll
        for (int q = 0; q < 6; ++q) if (sec == q) so = secoff[q];
        bf16_t* OUT = (bf16_t*)(p.ws + so);
        const bool vt = (sec == 3) || (sec == 5);
        float kblk_am = 0.f;
#pragma unroll
        for (int pass = 0; pass < 2; ++pass) {
        if (pass == 1 && sec == 2) {
#pragma unroll
            for (int o = 1; o < 64; o <<= 1) kblk_am = fmaxf(kblk_am, __shfl_xor(kblk_am, o));
            if (lane == 0) ((float*)(p.ws + WS_KS + 12 * MiB))[(size_t)(b * 4 + g) * 256 + ((mt * 128 + wr * 64 - b * SEQ) >> 6)] = kblk_am > 0.f ? kblk_am / 224.0f : 1.0f;
        }
#pragma unroll
        for (int mi = 0; mi < 4; ++mi) {
            const int t = mt * 128 + wr * 64 + mi * 16 + fr, s = t - b * SEQ;
            if (dorope && pass == 0) {
#pragma unroll
                for (int ni = 0; ni < 2; ++ni) {
                    const f32x4* rp = (const f32x4*)(ROPE + (size_t)s * 32 + ni * 16 + fq * 4);
                    const f32x4 r0 = rp[0], r1 = rp[1];
                    const f32x4 x1 = acc[mi][ni], x2 = acc[mi][ni + 2];
                    acc[mi][ni] = (f32x4){x1.x * r0.x - x2.x * r0.y, x1.y * r0.z - x2.y * r0.w, x1.z * r1.x - x2.z * r1.y, x1.w * r1.z - x2.w * r1.w};
                    acc[mi][ni + 2] = (f32x4){x1.x * r0.y + x2.x * r0.x, x1.y * r0.w + x2.y * r0.z, x1.z * r1.y + x2.z * r1.x, x1.w * r1.w + x2.w * r1.z};
                }
            }
            if (pass == 0) {
                if (sec == 2) {
#pragma unroll
                    for (int ni = 0; ni < 4; ++ni) { const f32x4 v = acc[mi][ni]; kblk_am = fmaxf(kblk_am, fmaxf(fmaxf(fabsf(v.x), fabsf(v.y)), fmaxf(fabsf(v.z), fabsf(v.w)))); }
                }
                continue;
            }
            if (sec == -1 || sec == 2) {
                float am = kblk_am;
                if (sec == -1) {
                    am = 0.f;
#pragma unroll
                    for (int ni = 0; ni < 4; ++ni) { const f32x4 v = acc[mi][ni] * scl; am = fmaxf(am, fmaxf(fmaxf(fabsf(v.x), fabsf(v.y)), fmaxf(fabsf(v.z), fabsf(v.w)))); }
                    am = fmaxf(am, __shfl_xor(am, 16)); am = fmaxf(am, __shfl_xor(am, 32));
                }
                const float qs = am > 0.f ? 224.0f / am : 1.0f;
                unsigned char* O8 = (sec == -1) ? (p.ws + WS_Q8 + (size_t)t * 1024 + c0) : (p.ws + WS_KS + ((size_t)(b * 4 + g) * SEQ + s) * 64);
#pragma unroll
                for (int ni = 0; ni < 4; ++ni) {
                    const f32x4 v = acc[mi][ni] * (scl * qs);
                    int w = 0; w = __builtin_amdgcn_cvt_pk_fp8_f32(v.x, v.y, w, false); w = __builtin_amdgcn_cvt_pk_fp8_f32(v.z, v.w, w, true);
                    *(int*)(O8 + ni * 16 + fq * 4) = w;
                }
                if (fq == 0 && sec == -1) ((float*)(p.ws + WS_Q8 + 32 * MiB))[(size_t)t * 16 + (c0 >> 6)] = am > 0.f ? am / 224.0f : 1.0f;
            }
            if (sec == 2) continue;
#pragma unroll
            for (int ni = 0; ni < 4; ++ni) {
                const f32x4 v = acc[mi][ni] * scl;
                const int d = ni * 16 + fq * 4;
                if (sec == -1) {
                    *(u32x2*)(OUT + (size_t)t * 1024 + c0 + d) = (u32x2){pk2(v.x, v.y), pk2(v.z, v.w)};
                } else if (!vt) {
                    *(u32x2*)(OUT + ((size_t)(b * 4 + g) * SEQ + s) * 64 + d) = (u32x2){pk2(v.x, v.y), pk2(v.z, v.w)};
                } else if (sec == 5) {
                    bf16_t* o = OUT + ((size_t)(b * 4 + g) * 64 + d) * SEQ + s;
                    o[0] = (bf16_t)f2bf(v.x); o[SEQ] = (bf16_t)f2bf(v.y); o[2 * SEQ] = (bf16_t)f2bf(v.z); o[3 * SEQ] = (bf16_t)f2bf(v.w);
                }
            }
        }
        }
        if (sec == 3) {
            const int s0 = mt * 128 + wr * 64 - b * SEQ, jb = s0 >> 6;
            unsigned char* V8 = p.ws + WS_VST + (size_t)((b * 4 + g) * 256 + jb) * 4096;
            float am = 0.f;
#pragma unroll
            for (int mi = 0; mi < 4; ++mi)
#pragma unroll
                for (int ni = 0; ni < 4; ++ni) { const f32x4 v = acc[mi][ni]; am = fmaxf(am, fmaxf(fmaxf(fabsf(v.x), fabsf(v.y)), fmaxf(fabsf(v.z), fabsf(v.w)))); }
#pragma unroll
            for (int o = 1; o < 64; o <<= 1) am = fmaxf(am, __shfl_xor(am, o));
            const float qs = am > 0.f ? 224.0f / am : 1.0f;
            if (lane == 0) ((float*)(p.ws + WS_VST + 12 * MiB))[(size_t)(b * 4 + g) * 256 + jb] = am > 0.f ? am / 224.0f : 1.0f;
#pragma unroll
            for (int ni = 0; ni < 4; ++ni) {
                const int d = ni * 16 + fq * 4;
#pragma unroll
                for (int mi = 0; mi < 4; ++mi) {
                    const f32x4 v = acc[mi][ni] * qs;
                    int w = 0; w = __builtin_amdgcn_cvt_pk_fp8_f32(v.x, v.y, w, false); w = __builtin_amdgcn_cvt_pk_fp8_f32(v.z, v.w, w, true);
                    unsigned char* o = V8 + (size_t)d * 64 + mi * 16 + fr;
                    o[0] = (unsigned char)(w & 255); o[64] = (unsigned char)((w >> 8) & 255); o[128] = (unsigned char)((w >> 16) & 255); o[192] = (unsigned char)((unsigned)w >> 24);
                }
            }
        }
    }
}
__device__ __forceinline__ void phase_nsa_cmp1(const Params& p, unsigned char* lds) {
    bf16_t* HID = (bf16_t*)(p.ws + WS_HID);
    const float* bias = (const float*)(p.ws + WS_MISC);
    const int lane = threadIdx.x & 63, wid = threadIdx.x >> 6, wr = wid >> 1, wc = wid & 1, fr = lane & 15, fq = lane >> 4;
    for (int id = vblock(); id < 256; id += gridDim.x) {
        const int kv = id >> 7, bg = (id >> 4) & 7, mt = (id >> 1) & 7, nt = id & 1;
        const bf16_t* A = (const bf16_t*)(p.ws + (kv ? WS_VC : WS_KC)) + (size_t)bg * SEQ * 64 + (size_t)mt * 128 * 1024;
        const bf16_t* B = (const bf16_t*)(p.ws + (kv ? WS_WV1_T : WS_WK1_T)) + (size_t)nt * 128 * 2048;
        f32x4 acc[4][4];
        gemm_tile2(ALoadPlain{A, (size_t)1024}, B, 2048, 32, acc, lds);
#pragma unroll
        for (int mi = 0; mi < 4; ++mi)
#pragma unroll
            for (int ni = 0; ni < 4; ++ni) {
                const int n = mt * 128 + wr * 64 + mi * 16 + fr, c = nt * 128 + wc * 64 + ni * 16 + fq * 4;
                const f32x4 bv = *(const f32x4*)(bias + kv * 256 + c);
                const f32x4 v = acc[mi][ni] + bv;
                *(u32x2*)(HID + (((size_t)kv * 8 + bg) * 1024 + n) * 256 + c) = (u32x2){pk2(gelu_tanh(v.x), gelu_tanh(v.y)), pk2(gelu_tanh(v.z), gelu_tanh(v.w))};
            }
    }
}
__device__ __forceinline__ void phase_nsa_cmp2(const Params& p, unsigned char* lds) {
    const bf16_t* HID = (const bf16_t*)(p.ws + WS_HID);
    const f32x2* ROPE = (const f32x2*)(p.ws + WS_ROPE);
    bf16_t* KCMP = (bf16_t*)(p.ws + WS_KCMP); bf16_t* VCMPT = (bf16_t*)(p.ws + WS_VCMPT);
    const int lane = threadIdx.x & 63, wid = threadIdx.x >> 6, wr = wid >> 1, wc = wid & 1, fr = lane & 15, fq = lane >> 4;
    for (int id = vblock(); id < 128; id += gridDim.x) {
        const int kv = id >> 6, mt = id & 63;
        const bf16_t* A = HID + ((size_t)kv * 8192 + (size_t)mt * 128) * 256;
        const bf16_t* B = (const bf16_t*)(p.ws + (kv ? WS_WV2_T : WS_WK2_T));
        f32x4 acc[4][4];
        gemm_tile1(ALoadPlain{A, (size_t)256}, B, 256, 4, acc, lds);
        if (wc == 1) continue;
#pragma unroll
        for (int mi = 0; mi < 4; ++mi) {
            const int R = mt * 128 + wr * 64 + mi * 16 + fr, bg = R >> 10, n = R & 1023;
            if (kv == 0) {
                int pos = n * 16 + 31; pos = pos > SEQ - 1 ? SEQ - 1 : pos;
#pragma unroll
                for (int ni = 0; ni < 2; ++ni) {
                    const f32x4* rp = (const f32x4*)(ROPE + (size_t)pos * 32 + ni * 16 + fq * 4);
                    const f32x4 r0 = rp[0], r1 = rp[1];
                    const f32x4 x1 = acc[mi][ni], x2 = acc[mi][ni + 2];
                    acc[mi][ni] = (f32x4){x1.x * r0.x - x2.x * r0.y, x1.y * r0.z - x2.y * r0.w, x1.z * r1.x - x2.z * r1.y, x1.w * r1.z - x2.w * r1.w};
                    acc[mi][ni + 2] = (f32x4){x1.x * r0.y + x2.x * r0.x, x1.y * r0.w + x2.y * r0.z, x1.z * r1.y + x2.z * r1.x, x1.w * r1.w + x2.w * r1.z};
                }
#pragma unroll
                for (int ni = 0; ni < 4; ++ni) {
                    const f32x4 v = acc[mi][ni];
                    *(u32x2*)(KCMP + ((size_t)bg * 1024 + n) * 64 + ni * 16 + fq * 4) = (u32x2){pk2(v.x, v.y), pk2(v.z, v.w)};
                }
            } else {
#pragma unroll
                for (int ni = 0; ni < 4; ++ni) {
                    const f32x4 v = acc[mi][ni];
                    bf16_t* o = VCMPT + ((size_t)bg * 64 + ni * 16 + fq * 4) * 1024 + n;
                    o[0] = (bf16_t)f2bf(v.x); o[1024] = (bf16_t)f2bf(v.y); o[2048] = (bf16_t)f2bf(v.z); o[3072] = (bf16_t)f2bf(v.w);
                }
            }
        }
    }
}
__device__ __forceinline__ void phase_nsa_wo(const Params& p, unsigned char* lds, bool dry) {
    const bf16_t* O = (const bf16_t*)(p.ws + WS_O); const bf16_t* WT = (const bf16_t*)(p.ws + WS_WO_T);
    const float* MOD = (const float*)(p.ws + WS_MOD);
    float* X = p.out;
    const int lane = threadIdx.x & 63, wid = threadIdx.x >> 6, wr = wid >> 1, wc = wid & 1, fr = lane & 15, fq = lane >> 4;
    for (int id = vblock(); id < 256 * 8; id += gridDim.x) {
        const int mt = id >> 3, nt = id & 7;
        f32x4 acc[4][4];
        gemm_tile2(ALoadPlain{O + (size_t)mt * 128 * D, (size_t)D}, WT + (size_t)nt * 128 * D, D, 16, acc, lds);
        const int b = (mt * 128) / SEQ;
#pragma unroll
        for (int mi = 0; mi < 4; ++mi)
#pragma unroll
            for (int ni = 0; ni < 4; ++ni) {
                const int t = mt * 128 + wr * 64 + mi * 16 + fr, c = nt * 128 + wc * 64 + ni * 16 + fq * 4;
                const f32x4 g1 = *(const f32x4*)(MOD + (size_t)(1 * 2 + b) * 6144 + 2048 + c);
                float* xp = X + (size_t)t * D + c;
                const f32x4 x = *(const f32x4*)xp; const f32x4 v = acc[mi][ni];
                if (!dry) *(f32x4*)xp = (f32x4){x.x + g1.x * v.x, x.y + g1.y * v.y, x.z + g1.z * v.z, x.w + g1.w * v.w};
            }
    }
}
__device__ __forceinline__ bf16x8 pack8(const f32x4 a, const f32x4 b) {
    u32x4 w; w.x = pk2(a.x, a.y); w.y = pk2(a.z, a.w); w.z = pk2(b.x, b.y); w.w = pk2(b.z, b.w);
    return __builtin_bit_cast(bf16x8, w);
}
__device__ __forceinline__ bf16x8 ldv8(const bf16_t* plo, const bf16_t* phi) {
    const u32x2 lo = *(const u32x2*)plo, hi = *(const u32x2*)phi;
    u32x4 w; w.x = lo.x; w.y = lo.y; w.z = hi.x; w.w = hi.y;
    return __builtin_bit_cast(bf16x8, w);
}
__device__ __forceinline__ float red4(float v) { v += __shfl_xor(v, 16); v += __shfl_xor(v, 32); return v; }
__device__ __forceinline__ float max4(float v) { v = fmaxf(v, __shfl_xor(v, 16)); v = fmaxf(v, __shfl_xor(v, 32)); return v; }
#define NEGBIG (-1.0e30f)

__device__ __forceinline__ void phase_nsa_attn(const Params& p, unsigned char* lds, const int rep_cmp, const int rep_win, const int rep_sel) {
    const int lane = threadIdx.x & 63, wave = threadIdx.x >> 6, fr = lane & 15, fq = lane >> 4;
    unsigned char* WL = lds + wave * 18432;
    float* IMP = (float*)WL;
    int* SEL = (int*)(WL + 17408);
    const bf16_t* Q = (const bf16_t*)(p.ws + WS_Q);
    const bf16_t* KCMP = (const bf16_t*)(p.ws + WS_KCMP); const bf16_t* VCMPT = (const bf16_t*)(p.ws + WS_VCMPT);
    const bf16_t* KW = (const bf16_t*)(p.ws + WS_KW); const bf16_t* VWT = (const bf16_t*)(p.ws + WS_VWT);
    const float* NGT = (const float*)(p.ws + WS_NG);
    bf16_t* O = (bf16_t*)(p.ws + WS_O);
    const f32x4 z4 = (f32x4){0.f, 0.f, 0.f, 0.f};
    for (int bi = blockIdx.x; bi < 2048; bi += gridDim.x) {
        const int bg = bi & 7, quad = 255 - (bi >> 3), t0 = (quad * 4 + wave) * 16, b = bg >> 2, g = bg & 3;
        const int cur = t0 >> 6;
        const size_t tok = (size_t)b * SEQ + t0 + fr;
        const int tq = t0 + fr;
        bf16x8 qf[4][2];
#pragma unroll
        for (int r = 0; r < 4; ++r)
#pragma unroll
            for (int ks = 0; ks < 2; ++ks) qf[r][ks] = *(const bf16x8*)(Q + tok * 1024 + (g * 4 + r) * 64 + ks * 32 + fq * 8);
        float gc[4], gw[4];
#pragma unroll
        for (int r = 0; r < 4; ++r) { const float* gp = NGT + tok * 48 + (g * 4 + r) * 3; gc[r] = gp[0]; gw[r] = gp[2]; }
        f32x4 acc[4][4];
        for (int rep = 0; rep < rep_win; ++rep) {
            const bf16_t* kwb = KW + (size_t)bg * SEQ * 64; const bf16_t* vwb = VWT + (size_t)bg * 64 * SEQ;
            float mw[4], lw[4];
#pragma unroll
            for (int r = 0; r < 4; ++r) { mw[r] = NEGBIG; lw[r] = 0.f;
#pragma unroll
                for (int df = 0; df < 4; ++df) acc[r][df] = z4; }
            int kmin = t0 - 511; kmin = kmin < 0 ? 0 : kmin; kmin &= ~31;
            for (int kb = kmin; kb <= t0 + 15; kb += 32) {
                bf16x8 kf[2][2];
#pragma unroll
                for (int f = 0; f < 2; ++f)
#pragma unroll
                    for (int ks = 0; ks < 2; ++ks) kf[f][ks] = *(const bf16x8*)(kwb + (size_t)(kb + f * 16 + fr) * 64 + ks * 32 + fq * 8);
                bf16x8 vf[4];
#pragma unroll
                for (int df = 0; df < 4; ++df) { const bf16_t* vp = vwb + (size_t)(df * 16 + fr) * SEQ + kb + 4 * fq; vf[df] = ldv8(vp, vp + 16); }
#pragma unroll
                for (int r = 0; r < 4; ++r) {
                    f32x4 st[2];
#pragma unroll
                    for (int f = 0; f < 2; ++f) {
                        st[f] = __builtin_amdgcn_mfma_f32_16x16x32_bf16(kf[f][0], qf[r][0], z4, 0, 0, 0);
                        st[f] = __builtin_amdgcn_mfma_f32_16x16x32_bf16(kf[f][1], qf[r][1], st[f], 0, 0, 0);
                    }
                    float mx = NEGBIG;
#pragma unroll
                    for (int f = 0; f < 2; ++f)
#pragma unroll
                        for (int e = 0; e < 4; ++e) { const int key = kb + f * 16 + fq * 4 + e; const bool ok = (key <= tq) && (key > tq - 512); if (ok) mx = fmaxf(mx, st[f][e]); }
                    mx = max4(mx);
                    const float mn = fmaxf(mw[r], mx);
                    const float al = __expf(mw[r] - mn);
                    float ps = 0.f;
#pragma unroll
                    for (int f = 0; f < 2; ++f)
#pragma unroll
                        for (int e = 0; e < 4; ++e) { const int key = kb + f * 16 + fq * 4 + e; const bool ok = (key <= tq) && (key > tq - 512); const float pv = ok ? __expf(st[f][e] - mn) : 0.f; st[f][e] = pv; ps += pv; }
                    lw[r] = lw[r] * al + ps; mw[r] = mn;
                    const bf16x8 pf = pack8(st[0], st[1]);
#pragma unroll
                    for (int df = 0; df < 4; ++df) { acc[r][df] = acc[r][df] * al; acc[r][df] = __builtin_amdgcn_mfma_f32_16x16x32_bf16(vf[df], pf, acc[r][df], 0, 0, 0); }
                    __builtin_amdgcn_sched_barrier(0);
                }
            }
#pragma unroll
            for (int r = 0; r < 4; ++r) {
                const float l = red4(lw[r]); const float sc = gw[r] / l;
#pragma unroll
                for (int df = 0; df < 4; ++df) acc[r][df] = acc[r][df] * sc;
            }
        }
        const int nmax_tile = (t0 >> 4) - 1, nmax_lane = (t0 >> 4) - 2 + (fr == 15 ? 1 : 0);
        const bf16_t* kcb = KCMP + (size_t)bg * 1024 * 64; const bf16_t* vcb = VCMPT + (size_t)bg * 64 * 1024;
        for (int rep = 0; rep < rep_cmp; ++rep) {
            const bool dry = (rep + 1 < rep_cmp);
            float mc[4], lc[4], invl[4];
#pragma unroll
            for (int r = 0; r < 4; ++r) { mc[r] = NEGBIG; lc[r] = 0.f; }
            for (int nb = 0; nb <= nmax_tile; nb += 32) {
                bf16x8 kf[2][2];
#pragma unroll
                for (int f = 0; f < 2; ++f)
#pragma unroll
                    for (int ks = 0; ks < 2; ++ks) kf[f][ks] = *(const bf16x8*)(kcb + (size_t)(nb + f * 16 + fr) * 64 + ks * 32 + fq * 8);
#pragma unroll
                for (int r = 0; r < 4; ++r) {
                    f32x4 st[2];
#pragma unroll
                    for (int f = 0; f < 2; ++f) {
                        st[f] = __builtin_amdgcn_mfma_f32_16x16x32_bf16(kf[f][0], qf[r][0], z4, 0, 0, 0);
                        st[f] = __builtin_amdgcn_mfma_f32_16x16x32_bf16(kf[f][1], qf[r][1], st[f], 0, 0, 0);
                    }
                    float mx = NEGBIG;
#pragma unroll
                    for (int f = 0; f < 2; ++f)
#pragma unroll
                        for (int e = 0; e < 4; ++e) { const int n = nb + f * 16 + fq * 4 + e; if (n <= nmax_lane) mx = fmaxf(mx, st[f][e]); }
                    mx = max4(mx);
                    const float mn = fmaxf(mc[r], mx);
                    float ps = 0.f;
#pragma unroll
                    for (int f = 0; f < 2; ++f)
#pragma unroll
                        for (int e = 0; e < 4; ++e) { const int n = nb + f * 16 + fq * 4 + e; if (n <= nmax_lane) ps += __expf(st[f][e] - mn); }
                    lc[r] = lc[r] * __expf(mc[r] - mn) + ps; mc[r] = mn;
                    __builtin_amdgcn_sched_barrier(0);
                }
            }
#pragma unroll
            for (int r = 0; r < 4; ++r) { const float l = red4(lc[r]); invl[r] = l > 0.f ? 1.0f / l : 0.f; }
            for (int i = lane; i < 16 * 260; i += 64) IMP[i] = 0.f;
            float carry = 0.f;
            for (int nb = 0; nb <= nmax_tile; nb += 32) {
                bf16x8 kf[2][2];
#pragma unroll
                for (int f = 0; f < 2; ++f)
#pragma unroll
                    for (int ks = 0; ks < 2; ++ks) kf[f][ks] = *(const bf16x8*)(kcb + (size_t)(nb + f * 16 + fr) * 64 + ks * 32 + fq * 8);
                bf16x8 vf[4];
#pragma unroll
                for (int df = 0; df < 4; ++df) { const bf16_t* vp = vcb + (size_t)(df * 16 + fr) * 1024 + nb + 4 * fq; vf[df] = ldv8(vp, vp + 16); }
                f32x4 pg[2] = {z4, z4};
#pragma unroll
                for (int r = 0; r < 4; ++r) {
                    f32x4 st[2];
#pragma unroll
                    for (int f = 0; f < 2; ++f) {
                        st[f] = __builtin_amdgcn_mfma_f32_16x16x32_bf16(kf[f][0], qf[r][0], z4, 0, 0, 0);
                        st[f] = __builtin_amdgcn_mfma_f32_16x16x32_bf16(kf[f][1], qf[r][1], st[f], 0, 0, 0);
#pragma unroll
                        for (int e = 0; e < 4; ++e) { const int n = nb + f * 16 + fq * 4 + e; st[f][e] = (n <= nmax_lane) ? __expf(st[f][e] - mc[r]) * invl[r] : 0.f; }
                        pg[f] += st[f];
                    }
                    const float gg = dry ? 0.f : gc[r];
                    const bf16x8 pf = pack8(st[0] * gg, st[1] * gg);
#pragma unroll
                    for (int df = 0; df < 4; ++df) acc[r][df] = __builtin_amdgcn_mfma_f32_16x16x32_bf16(vf[df], pf, acc[r][df], 0, 0, 0);
                    __builtin_amdgcn_sched_barrier(0);
                }
                const int src = (lane - 16) & 63;
                const float s0 = __shfl(pg[0].w, src), s1 = __shfl(pg[1].w, src), sc = __shfl(carry, src);
                const float prev0 = fq > 0 ? s0 : sc, prev1 = fq > 0 ? s1 : s0;
                const float imp0 = (pg[0].x + pg[0].y) + (pg[0].z + pg[0].w) + prev0;
                const float imp1 = (pg[1].x + pg[1].y) + (pg[1].z + pg[1].w) + prev1;
                const int jb = (nb >> 2) + fq;
                IMP[fr * 260 + jb] = imp0; IMP[fr * 260 + jb + 4] = imp1;
                carry = pg[1].w;
            }
        }
        {
            const int nf = cur >= 2 ? 3 : cur + 1;
            if (fq == 0) {
                SEL[fr * 16 + 0] = 0;
                if (cur == 1) SEL[fr * 16 + 1] = 1;
                if (cur >= 2) { SEL[fr * 16 + 1] = cur - 1; SEL[fr * 16 + 2] = cur; }
            }
            const int ncand = cur >= 3 ? cur - 2 : 0, extra = 16 - nf;
            if (ncand <= extra) {
                if (fq == 0) { for (int k = 0; k < extra; ++k) SEL[fr * 16 + nf + k] = (k < ncand) ? 1 + k : -1; }
            } else {
                for (int rnd = 0; rnd < extra; ++rnd) {
                    float bv = -1.0f; int bj = 1 << 20;
                    for (int jb = 1 + fq; jb <= cur - 2; jb += 4) { const float v = IMP[fr * 260 + jb]; if (v > bv) { bv = v; bj = jb; } }
#pragma unroll
                    for (int o = 16; o <= 32; o <<= 1) {
                        const float ov = __shfl_xor(bv, o); const int oj = __shfl_xor(bj, o);
                        if (ov > bv || (ov == bv && oj < bj)) { bv = ov; bj = oj; }
                    }
                    if (fq == 0) SEL[fr * 16 + nf + rnd] = bj;
                    if (((bj - 1) & 3) == fq) IMP[fr * 260 + bj] = -2.0f;
                }
            }
        }
#pragma unroll
        for (int r = 0; r < 4; ++r)
#pragma unroll
            for (int df = 0; df < 4; ++df) {
                const f32x4 v = acc[r][df];
                *(u32x2*)(O + tok * 1024 + (g * 4 + r) * 64 + df * 16 + fq * 4) = (u32x2){pk2(v.x, v.y), pk2(v.z, v.w)};
            }
        asm volatile("s_waitcnt vmcnt(0)" ::: "memory");
        unsigned selp[4];
        {
            const u32x4* sp = (const u32x4*)(SEL + fr * 16);
#pragma unroll
            for (int q = 0; q < 4; ++q) { const u32x4 w = sp[q]; selp[q] = (w.x & 255u) | ((w.y & 255u) << 8) | ((w.z & 255u) << 16) | ((w.w & 255u) << 24); }
        }
        for (int rep = 0; rep < rep_sel; ++rep) {
            const bool dry = (rep + 1 < rep_sel);
            const unsigned char* k8b = p.ws + WS_KS + (size_t)bg * SEQ * 64; const unsigned char* v8b = p.ws + WS_VST + (size_t)bg * 256 * 4096;
            const float* skb = (const float*)(p.ws + WS_KS + 12 * MiB) + (size_t)bg * 256; const float* svb = (const float*)(p.ws + WS_VST + 12 * MiB) + (size_t)bg * 256;
            const unsigned char* Q8 = p.ws + WS_Q8; const float* SQ8 = (const float*)(p.ws + WS_Q8 + 32 * MiB);
            const int nv = cur + 1 < 16 ? cur + 1 : 16, npair = (nv + 1) >> 1, total = 16 * npair;
            const int lrow = lane >> 2, lch = lane & 3;
            const int woff = lrow * 72 + lch * 16;
            const int rr = fr & 3;
            u32x4 sk[2][4], sv[2][4]; float ssk[2], ssv[2];
            int jbn[2];
#define SEL_GET(tokI, slotK) ((int)(((unsigned)__builtin_amdgcn_readlane((int)(((slotK) >> 2) == 0 ? selp[0] : ((slotK) >> 2) == 1 ? selp[1] : ((slotK) >> 2) == 2 ? selp[2] : selp[3]), (tokI)) >> (((slotK) & 3) * 8)) & 255u))
#define SEL_ISSUE(tokI, pairP) do { \
                const int k0_ = 2 * (pairP), k1_ = (2 * (pairP) + 1 < nv) ? 2 * (pairP) + 1 : k0_; \
                jbn[0] = SEL_GET(tokI, k0_); jbn[1] = SEL_GET(tokI, k1_); \
                _Pragma("unroll") for (int u = 0; u < 2; ++u) { \
                    const unsigned char* kb_ = k8b + (size_t)jbn[u] * 4096; const unsigned char* vb_ = v8b + (size_t)jbn[u] * 4096; \
                    _Pragma("unroll") for (int j = 0; j < 4; ++j) { sk[u][j] = *(const u32x4*)(kb_ + j * 1024 + lane * 16); sv[u][j] = *(const u32x4*)(vb_ + j * 1024 + lane * 16); } \
                    ssk[u] = skb[jbn[u]]; ssv[u] = svb[jbn[u]]; } } while (0)
            SEL_ISSUE(0, 0);
            long qs8[2] = {0, 0};
            float sq = 0.f, ms = NEGBIG, ls = 0.f;
            f32x4 os[4] = {z4, z4, z4, z4};
            u32x2 oprev[4] = {(u32x2){0u, 0u}, (u32x2){0u, 0u}, (u32x2){0u, 0u}, (u32x2){0u, 0u}};
            int i = 0, pp = 0;
            for (int v = 0; v < total; ++v) {
                const int jb0 = jbn[0], jb1 = jbn[1];
                const bool second_valid = (2 * pp + 1 < nv);
                const float ck0 = ssk[0], ck1 = ssk[1], cv0 = ssv[0], cv1 = ssv[1];
#pragma unroll
                for (int u = 0; u < 2; ++u)
#pragma unroll
                    for (int j = 0; j < 4; ++j) {
                        unsigned char* kd = WL + u * 9216 + woff + j * 1152; unsigned char* vd = kd + 4608;
                        *(u32x2*)kd = (u32x2){sk[u][j].x, sk[u][j].y}; *(u32x2*)(kd + 8) = (u32x2){sk[u][j].z, sk[u][j].w};
                        *(u32x2*)vd = (u32x2){sv[u][j].x, sv[u][j].y}; *(u32x2*)(vd + 8) = (u32x2){sv[u][j].z, sv[u][j].w};
                    }
                if (v + 1 < total) {
                    int p2 = pp + 1, i2 = i; if (p2 == npair) { p2 = 0; i2 = i + 1; }
                    SEL_ISSUE(i2, p2);
                }
                __builtin_amdgcn_sched_barrier(0);
                const int ti = t0 + i;
                if (pp == 0) {
                    const size_t tk = (size_t)b * SEQ + ti;
#pragma unroll
                    for (int ks = 0; ks < 2; ++ks) qs8[ks] = *(const long*)(Q8 + tk * 1024 + (g * 4 + rr) * 64 + ks * 32 + fq * 8);
                    sq = SQ8[tk * 16 + g * 4 + rr] * 1.4426950408889634f;
                    ms = NEGBIG; ls = 0.f;
#pragma unroll
                    for (int df = 0; df < 4; ++df) { os[df] = z4; oprev[df] = *(const u32x2*)(O + tk * 1024 + (g * 4 + rr) * 64 + df * 16 + fq * 4); }
                }
                f32x4 st[2][4];
#pragma unroll
                for (int u = 0; u < 2; ++u)
#pragma unroll
                    for (int f = 0; f < 4; ++f) {
                        const unsigned char* kp = WL + u * 9216 + (f * 16 + fr) * 72 + fq * 8;
                        const long k0 = *(const long*)kp, k1 = *(const long*)(kp + 32);
                        st[u][f] = __builtin_amdgcn_mfma_f32_16x16x32_fp8_fp8(k0, qs8[0], z4, 0, 0, 0);
                        st[u][f] = __builtin_amdgcn_mfma_f32_16x16x32_fp8_fp8(k1, qs8[1], st[u][f], 0, 0, 0);
                    }
                const float c0_ = sq * ck0, c1_ = sq * ck1;
                if (jb0 == cur || jb1 == cur || !second_valid) {
#pragma unroll
                    for (int u = 0; u < 2; ++u) {
                        const int jbu = u ? jb1 : jb0;
                        const bool allbad = (u == 1) && !second_valid;
#pragma unroll
                        for (int f = 0; f < 4; ++f)
#pragma unroll
                            for (int e = 0; e < 4; ++e) { const int key = jbu * 64 + f * 16 + fq * 4 + e; if (allbad || key > ti) st[u][f][e] = NEGBIG; }
                    }
                }
                float mx0 = NEGBIG, mx1 = NEGBIG;
#pragma unroll
                for (int f = 0; f < 4; ++f) { mx0 = fmaxf(mx0, fmaxf(fmaxf(st[0][f].x, st[0][f].y), fmaxf(st[0][f].z, st[0][f].w))); mx1 = fmaxf(mx1, fmaxf(fmaxf(st[1][f].x, st[1][f].y), fmaxf(st[1][f].z, st[1][f].w))); }
                const float mx = max4(fmaxf(mx0 > -1.0e29f ? mx0 * c0_ : NEGBIG, mx1 > -1.0e29f ? mx1 * c1_ : NEGBIG));
                const float mn = fmaxf(ms, mx);
                const float al = __builtin_amdgcn_exp2f(ms - mn);
                const float off = 8.0f - mn;
                float ps = 0.f;
#pragma unroll
                for (int u = 0; u < 2; ++u) {
                    const float cu = u ? c1_ : c0_;
#pragma unroll
                    for (int f = 0; f < 4; ++f)
#pragma unroll
                        for (int e = 0; e < 4; ++e) { const float pv = (st[u][f][e] > -1.0e29f) ? __builtin_amdgcn_exp2f(st[u][f][e] * cu + off) : 0.f; st[u][f][e] = pv; ps += pv; }
                }
                ls = ls * al + ps; ms = mn;
#pragma unroll
                for (int df = 0; df < 4; ++df) os[df] = os[df] * al;
#pragma unroll
                for (int u = 0; u < 2; ++u) {
                    f32x4 pvacc[4] = {z4, z4, z4, z4};
#pragma unroll
                    for (int s = 0; s < 2; ++s) {
                        int w0 = 0, w1 = 0;
                        w0 = __builtin_amdgcn_cvt_pk_fp8_f32(st[u][2 * s].x, st[u][2 * s].y, w0, false); w0 = __builtin_amdgcn_cvt_pk_fp8_f32(st[u][2 * s].z, st[u][2 * s].w, w0, true);
                        w1 = __builtin_amdgcn_cvt_pk_fp8_f32(st[u][2 * s + 1].x, st[u][2 * s + 1].y, w1, false); w1 = __builtin_amdgcn_cvt_pk_fp8_f32(st[u][2 * s + 1].z, st[u][2 * s + 1].w, w1, true);
                        const long pf = (long)(((unsigned long long)(unsigned)w1 << 32) | (unsigned long long)(unsigned)w0);
#pragma unroll
                        for (int df = 0; df < 4; ++df) {
                            const unsigned char* vp = WL + u * 9216 + 4608 + (df * 16 + fr) * 72 + 32 * s + 4 * fq;
                            const unsigned lo = *(const unsigned*)vp, hi = *(const unsigned*)(vp + 16);
                            const long vf = (long)(((unsigned long long)hi << 32) | (unsigned long long)lo);
                            pvacc[df] = __builtin_amdgcn_mfma_f32_16x16x32_fp8_fp8(vf, pf, pvacc[df], 0, 0, 0);
                        }
                    }
                    const float cvu = u ? cv1 : cv0;
#pragma unroll
                    for (int df = 0; df < 4; ++df) os[df] = os[df] + pvacc[df] * cvu;
                    __builtin_amdgcn_sched_barrier(0);
                }
                if (pp == npair - 1) {
                    const float l = red4(ls);
                    const float gsv = NGT[((size_t)b * SEQ + ti) * 48 + (g * 4 + rr) * 3 + 1];
                    const float sc = gsv / l;
                    if (fr < 4 && !dry) {
                        bf16_t* op = O + ((size_t)b * SEQ + ti) * 1024 + (g * 4 + fr) * 64 + fq * 4;
#pragma unroll
                        for (int df = 0; df < 4; ++df) {
                            const f32x4 val = os[df] * sc; const u32x2 c = oprev[df];
                            *(u32x2*)(op + df * 16) = (u32x2){pk2(bflo(c.x) + val.x, bfhi(c.x) + val.y), pk2(bflo(c.y) + val.z, bfhi(c.y) + val.w)};
                        }
                    }
                }
                ++pp; if (pp == npair) { pp = 0; ++i; }
            }
#undef SEL_GET
#undef SEL_ISSUE
        }
    }
}
constexpr int NPHASES = 23;
#ifndef PROBE_PHASE
#define PROBE_PHASE (-1)
#endif
#ifndef ATT_REP_CMP
#define ATT_REP_CMP 1
#endif
#ifndef ATT_REP_WIN
#define ATT_REP_WIN 1
#endif
#ifndef ATT_REP_SEL
#define ATT_REP_SEL 1
#endif
#ifndef TS_PHASE
#define TS_PHASE (-1)
#endif
#ifndef TS_MULT
#define TS_MULT 4
#endif
#ifndef PROBE_REPS
#define PROBE_REPS 1
#endif
__global__ void __launch_bounds__(NTHREADS, 2) mega(Params p) {
    __shared__ __attribute__((aligned(16))) unsigned char lds[LDS_BYTES];
    __shared__ __attribute__((aligned(16))) unsigned bar_st[4];
    cg::grid_group grid = cg::this_grid();
    const float* MOD = (const float*)(p.ws + WS_MOD);
    bf16_t* HM = (bf16_t*)(p.ws + WS_HM);
    if (threadIdx.x < 4) bar_st[threadIdx.x] = 0u;
    __syncthreads();
    XcdBarrier bar = xcd_barrier_post((unsigned*)(p.ws + WS_CTL), (volatile LAS unsigned*)bar_st);
    const int lo = p.ph_lo, hi = p.ph_hi;
    const bool dry0 = (p.ph_hi < 0);
    const int opq = (p.ph_hi < 0) ? 1 : 0;
    unsigned long long ts_a = 0ull, ts_b = 0ull;
#define PHASE(k, call, drycall) if (lo <= (k) && (k) < hi) { \
        if (TS_PHASE == (k)) ts_a = __builtin_amdgcn_s_memrealtime(); \
        if (PROBE_PHASE == (k)) { for (int rep = 0; rep < PROBE_REPS; ++rep) { const bool dry = !dry0; drycall; __syncthreads(); } } \
        { const bool dry = dry0; call; } \
        if ((k) + 1 < hi) { if ((k) == 0) grid.sync(); else xcd_barrier(bar); } \
        if (TS_PHASE == (k)) ts_b = __builtin_amdgcn_s_memrealtime(); }
    PHASE(0, phase_prep(p, (float*)lds), phase_prep(p, (float*)lds))
    PHASE(1, phase_norm(p, p.in[0], p.in[2], MOD + 0, MOD + 1024, HM), phase_norm(p, p.in[0], p.in[2], MOD + 0, MOD + 1024, HM))
    PHASE(2, phase_s5_win(p, lds), phase_s5_win(p, lds))
    PHASE(3, phase_s5_a(p, lds), phase_s5_a(p, lds))
    PHASE(4, phase_s5_scan(p), phase_s5_scan(p))
    PHASE(5, phase_s5_b(p, lds), phase_s5_b(p, lds))
    PHASE(6, phase_s5_glu(p, lds), phase_s5_glu(p, lds))
    PHASE(7, phase_norm(p, p.out, p.in[3], MOD + 3072, MOD + 4096, HM), phase_norm(p, p.out, p.in[3], MOD + 3072, MOD + 4096, HM))
    PHASE(8, phase_peer_wq(p, 0, lds), phase_peer_wq(p, 0, lds))
    PHASE(9, phase_peer_topk(p, 0, lds), phase_peer_topk(p, 0, lds))
    PHASE(10, phase_peer_combine(p, lds), phase_peer_combine(p, lds))
    PHASE(11, phase_peer_apply(p, 0, lds, dry), phase_peer_apply(p, 0, lds, dry))
    PHASE(12, phase_tab1(p), phase_tab1(p))
    PHASE(13, phase_nsa_proj(p, lds), phase_nsa_proj(p, lds))
    PHASE(14, phase_nsa_cmp1(p, lds), phase_nsa_cmp1(p, lds))
    PHASE(15, phase_nsa_cmp2(p, lds), phase_nsa_cmp2(p, lds))
    PHASE(16, phase_nsa_attn(p, lds, ATT_REP_CMP + opq, ATT_REP_WIN + opq, ATT_REP_SEL + opq), phase_nsa_attn(p, lds, 1 + opq, 1 + opq, 1 + opq))
    PHASE(17, phase_nsa_wo(p, lds, dry), phase_nsa_wo(p, lds, dry))
    PHASE(18, phase_norm(p, p.out, p.in[3] + D, MOD + 2 * 6144 + 3072, MOD + 2 * 6144 + 4096, HM), phase_norm(p, p.out, p.in[3] + D, MOD + 2 * 6144 + 3072, MOD + 2 * 6144 + 4096, HM))
    PHASE(19, phase_peer_wq(p, 1, lds), phase_peer_wq(p, 1, lds))
    PHASE(20, phase_peer_topk(p, 1, lds), phase_peer_topk(p, 1, lds))
    PHASE(21, phase_peer_combine(p, lds), phase_peer_combine(p, lds))
    PHASE(22, phase_peer_apply(p, 1, lds, dry), phase_peer_apply(p, 1, lds, dry))
#undef PHASE
    if (TS_PHASE >= 0 && blockIdx.x == 0 && threadIdx.x == 0) {
        const unsigned long long t0 = __builtin_amdgcn_s_memrealtime(), want = (ts_b - ts_a) * TS_MULT;
        while (__builtin_amdgcn_s_memrealtime() - t0 < want) __builtin_amdgcn_s_sleep(8);
    }
}

extern "C" void kernel_launch(void* const* d_in, const int* in_sizes, int n_in, void* d_out, int out_size, void* d_ws, size_t ws_size, hipStream_t stream) {
    static int grid_blocks = 0;
    if (!grid_blocks) {
        int dev = 0, cus = 0, per_cu = 0;
        hipGetDevice(&dev);
        hipDeviceGetAttribute(&cus, hipDeviceAttributeMultiprocessorCount, dev);
        hipOccupancyMaxActiveBlocksPerMultiprocessor(&per_cu, mega, NTHREADS, 0);
        if (per_cu > 2) per_cu = 2;
        if (per_cu < 1) per_cu = 1;
        grid_blocks = cus * per_cu;
        if (ws_size < WS_END) fprintf(stderr, "kernel_launch: workspace too small: %zu < %zu\n", ws_size, (size_t)WS_END);
        if (n_in != 29) fprintf(stderr, "kernel_launch: expected 29 inputs, got %d\n", n_in);
    }
    hipMemsetAsync((unsigned char*)d_ws + WS_CTL, 0, 16384, stream);
    Params p{};
    for (int i = 0; i < 29; ++i) p.in[i] = (const float*)d_in[i];
    p.out = (float*)d_out; p.ws = (unsigned char*)d_ws;
#if SINGLE_LAUNCH
    p.ph_lo = 0; p.ph_hi = NPHASES;
    void* args[] = {&p};
    hipError_t e = hipLaunchCooperativeKernel((void*)mega, dim3(grid_blocks), dim3(NTHREADS), args, 0, stream);
    if (e != hipSuccess) fprintf(stderr, "cooperative launch failed: %s (grid %d)\n", hipGetErrorString(e), grid_blocks);
#else
    for (int ph = 0; ph < NPHASES; ++ph) {
        p.ph_lo = ph; p.ph_hi = ph + 1;
        hipLaunchKernelGGL(mega, dim3(grid_blocks), dim3(NTHREADS), 0, stream, p);
    }
#endif
}
```

```cpp
#include <hip/hip_runtime.h>
#include <hip/hip_cooperative_groups.h>
#include <cstdio>
#include <cstdint>
namespace cg = cooperative_groups;

#ifndef SINGLE_LAUNCH
#define SINGLE_LAUNCH 1
#endif

typedef unsigned short bf16_t;
typedef short bf16x8 __attribute__((ext_vector_type(8)));
typedef float f32x4 __attribute__((ext_vector_type(4)));
typedef float f32x2 __attribute__((ext_vector_type(2)));
typedef unsigned u32x4 __attribute__((ext_vector_type(4)));
typedef unsigned u32x2 __attribute__((ext_vector_type(2)));
typedef __bf16 bf16x2_t __attribute__((ext_vector_type(2)));

constexpr int D = 1024, BATCH = 2, SEQ = 16384, T = BATCH * SEQ;
constexpr int NTHREADS = 256;
constexpr float RMS_EPS = 1e-6f;
constexpr int S5G = 64, S5P = 64, S5L = 32, S5NCH = T / S5L  , S5CPB = SEQ / S5L  ;
constexpr int NH = 16, HD = 64, NG = 4, NPROJ = 2608, NPROJ_PAD = 2688, NC = 1023, NSB = 256;
constexpr int PH = 8, PK = 16, PNK = 128, PE = 16384;

constexpr size_t MiB = 1ull << 20;
constexpr size_t WS_CTL = 0;
constexpr size_t WS_MOD = 1 * MiB;
constexpr size_t WS_WIN_T = 2 * MiB;
constexpr size_t WS_WGLU_T = 4 * MiB;
constexpr size_t WS_WPROJ_T = 8 * MiB;
constexpr size_t WS_WK1_T = 14 * MiB;
constexpr size_t WS_WV1_T = 15 * MiB;
constexpr size_t WS_WK2_T = 16 * MiB;
constexpr size_t WS_WV2_T = 16 * MiB + 512 * 1024;
constexpr size_t WS_WO_T = 17 * MiB;
constexpr size_t WS_WQ_T = 19 * MiB;
constexpr size_t WS_SUBK = 27 * MiB;
constexpr size_t WS_ROPE = 28 * MiB;
constexpr size_t WS_MISC = 32 * MiB;
constexpr size_t WS_TW = 33 * MiB;
constexpr size_t WS_VG = 73 * MiB;
constexpr size_t WS_PU = 82 * MiB;
constexpr size_t WS_PV = 114 * MiB;
constexpr size_t WS_HM = 146 * MiB;
constexpr size_t WS_C = 210 * MiB;
constexpr size_t WS_UG = WS_C;
constexpr size_t WS_YI = WS_C + 64 * MiB;
constexpr size_t WS_WST = WS_C + 128 * MiB;
constexpr size_t WS_SST = WS_C + 160 * MiB;
constexpr size_t WS_YG = WS_C + 176 * MiB;
constexpr size_t WS_QK = WS_C;
constexpr size_t WS_TOPS = WS_C + 128 * MiB;
constexpr size_t WS_TOPI = WS_C + 160 * MiB;
constexpr size_t WS_EXP = WS_C + 192 * MiB;
constexpr size_t WS_GATE = WS_C + 208 * MiB;
constexpr size_t WS_ACT = WS_C + 224 * MiB;
constexpr size_t WS_Q = WS_C;
constexpr size_t WS_KC = WS_C + 64 * MiB;
constexpr size_t WS_VC = WS_C + 81 * MiB;
constexpr size_t WS_KS = WS_C + 98 * MiB;
constexpr size_t WS_VST = WS_C + 114 * MiB;
constexpr size_t WS_KW = WS_C + 130 * MiB;
constexpr size_t WS_VWT = WS_C + 146 * MiB;
constexpr size_t WS_NG = WS_C + 162 * MiB;
constexpr size_t WS_KCMP = WS_C + 170 * MiB;
constexpr size_t WS_VCMPT = WS_C + 171 * MiB;
constexpr size_t WS_HID = WS_C + 172 * MiB;
constexpr size_t WS_O = WS_C + 182 * MiB;
constexpr size_t WS_Q8 = WS_C + 246 * MiB;
constexpr size_t WS_END = WS_C + 282 * MiB;

constexpr int LDS_BYTES = 73728;

struct Params {
    const float* in[29];
    float* out;
    unsigned char* ws;
    int ph_lo, ph_hi;
};

__device__ __forceinline__ unsigned f2bf(float f) { unsigned u = __builtin_bit_cast(unsigned, f); return (u + 0x7fffu + ((u >> 16) & 1u)) >> 16; }
__device__ __forceinline__ unsigned pk2(float lo, float hi) { return f2bf(lo) | (f2bf(hi) << 16); }
__device__ __forceinline__ float bf2f(unsigned h) { return __builtin_bit_cast(float, h << 16); }
__device__ __forceinline__ float bflo(unsigned w) { return __builtin_bit_cast(float, w << 16); }
__device__ __forceinline__ float bfhi(unsigned w) { return __builtin_bit_cast(float, w & 0xffff0000u); }
__device__ __forceinline__ float gelu_tanh(float x) {
    const float u = 0.7978845608028654f * (x + 0.044715f * x * x * x);
    const float e = __expf(2.0f * u);
    const float th = 1.0f - 2.0f / (e + 1.0f);
    return 0.5f * x * (1.0f + th);
}
__device__ __forceinline__ float sigmoidf_(float x) { return 1.0f / (1.0f + __expf(-x)); }
__device__ __forceinline__ float wave_sum(float v) {
#pragma unroll
    for (int o = 1; o < 64; o <<= 1) v += __shfl_xor(v, o);
    return v;
}
__device__ __forceinline__ float dot2bf(unsigned a, unsigned b, float acc) {
    return __builtin_amdgcn_fdot2_f32_bf16(__builtin_bit_cast(bf16x2_t, a), __builtin_bit_cast(bf16x2_t, b), acc, false);
}

#define LAS __attribute__((address_space(3)))
#define XB_TMO      128
#define XB_XCNT(j)  (256  + 64 * (j))
#define XB_XSUB(j)  (1280 + 64 * (j))
#define XB_XGEN(j)  (2304 + 64 * (j))
#define XB_TOP      3328
#define XB_TOPGEN   3392
#define XCD_BAR_WORDS 3456
#define XB_SPIN_CAP (1u << 24)

__device__ __forceinline__ unsigned xb_ld(unsigned* p)              { return __hip_atomic_load(p, __ATOMIC_RELAXED, __HIP_MEMORY_SCOPE_AGENT); }
__device__ __forceinline__ unsigned xb_add(unsigned* p, unsigned v) { return __hip_atomic_fetch_add(p, v, __ATOMIC_RELAXED, __HIP_MEMORY_SCOPE_AGENT); }
__device__ __forceinline__ unsigned xb_xcc_id() { return (unsigned)__builtin_amdgcn_s_getreg((3 << 11) | 20) & 0xFu; }
#define XB_SPIN(cond, bar) do { unsigned _sp = 0; while (cond) { __builtin_amdgcn_s_sleep(1); \
    if ((++_sp & 255u) == 0u) { if (xb_ld(&(bar)[XB_TMO])) break; if (_sp > XB_SPIN_CAP) { atomicAdd(&(bar)[XB_TMO], 1u); break; } } } } while (0)

struct XcdBarrier {
    unsigned* bar; unsigned x;
    volatile LAS unsigned* st;
};

__device__ __forceinline__ XcdBarrier xcd_barrier_post(unsigned* bar, volatile LAS unsigned* st) {
    XcdBarrier b; b.bar = bar; b.x = xb_xcc_id(); b.st = st;
    if (threadIdx.x == 0) (void)xb_add(&bar[XB_XCNT(b.x)], 1u);
    return b;
}
__device__ __forceinline__ void xcd_barrier_complete(unsigned* bar, unsigned x, unsigned& nloc, unsigned& nx) {
    const unsigned G = gridDim.x * gridDim.y * gridDim.z;
    unsigned sum, cnt, mine, sp = 0u;
    for (;;) {
        sum = 0u; cnt = 0u; mine = 0u;
#pragma unroll
        for (unsigned j = 0; j < 16; ++j) { const unsigned c = xb_ld(&bar[XB_XCNT(j)]); sum += c; cnt += (c > 0u) ? 1u : 0u; mine = (j == x) ? c : mine; }
        if (sum == G) break;
        __builtin_amdgcn_s_sleep(1);
        if ((++sp & 255u) == 0u) { if (xb_ld(&bar[XB_TMO])) break; if (sp > XB_SPIN_CAP) { atomicAdd(&bar[XB_TMO], 1u); break; } }
    }
    nloc = mine > 0u ? mine : 1u; nx = cnt > 0u ? cnt : 1u;
}

__device__ __forceinline__ void xcd_barrier(const XcdBarrier& b) {
    asm volatile("s_waitcnt vmcnt(0)" ::: "memory");
    __syncthreads();
    if (threadIdx.x == 0) {
        unsigned* bar = b.bar;
        __builtin_amdgcn_s_waitcnt(0);
        unsigned nloc = b.st[0], nx = b.st[1];
        if (nloc == 0u) { xcd_barrier_complete(bar, b.x, nloc, nx); b.st[0] = nloc; b.st[1] = nx; }
        const unsigned old = xb_add(&bar[XB_XSUB(b.x)], 1u);
        const unsigned gen = old / nloc;
        if (old + 1u == (gen + 1u) * nloc) {
            __builtin_amdgcn_fence(__ATOMIC_RELEASE, "agent");
            asm volatile("s_waitcnt vmcnt(0)" ::: "memory");
            const unsigned og = xb_add(&bar[XB_TOP], 1u);
            const unsigned tg = og / nx;
            if (og + 1u == (tg + 1u) * nx) xb_add(&bar[XB_TOPGEN], 1u);
            else XB_SPIN(xb_ld(&bar[XB_TOPGEN]) == tg, bar);
            __builtin_amdgcn_fence(__ATOMIC_ACQUIRE, "agent");
            xb_add(&bar[XB_XGEN(b.x)], 1u);
            asm volatile("s_waitcnt vmcnt(0)" ::: "memory");
        } else {
            XB_SPIN(xb_ld(&bar[XB_XGEN(b.x)]) == gen, bar);
            __builtin_amdgcn_fence(__ATOMIC_ACQUIRE, "agent");
            asm volatile("s_waitcnt vmcnt(0)" ::: "memory");
        }
    }
    __syncthreads();
}
__device__ __forceinline__ void prep_mod_item(const Params& p, int item, float* lds) {
    const int layer = item / 192, cg0 = (item % 192) * 32;
    const int tid = threadIdx.x, col = cg0 + (tid & 31), kg = tid >> 5;
    const float* W = p.in[4] + (size_t)layer * D * 6 * D + col;
    const float* c = p.in[1];
    float* cact = lds + 512;
#pragma unroll
    for (int i = 0; i < 8; ++i) { const int q = tid + 256 * i; const float v = c[q]; cact[q] = v * sigmoidf_(v); }
    __syncthreads();
    float a0 = 0.f, a1 = 0.f;
    for (int k0 = kg * 128; k0 < kg * 128 + 128; k0 += 16) {
        float w[16];
#pragma unroll
        for (int u = 0; u < 16; ++u) w[u] = W[(size_t)(k0 + u) * (6 * D)];
#pragma unroll
        for (int u = 0; u < 16; ++u) { a0 += w[u] * cact[k0 + u]; a1 += w[u] * cact[1024 + k0 + u]; }
    }
    lds[tid] = a0; lds[256 + tid] = a1;
    __syncthreads();
    if (tid < 64) {
        const int b = tid >> 5, cc = tid & 31;
        float s = 0.f;
#pragma unroll
        for (int g = 0; g < 8; ++g) s += lds[b * 256 + g * 32 + cc];
        float* MOD = (float*)(p.ws + WS_MOD);
        MOD[(size_t)(layer * 2 + b) * 6144 + cg0 + cc] = s + p.in[5][(size_t)layer * 6144 + cg0 + cc];
    }
    __syncthreads();
}

template <int MODE>
__device__ __forceinline__ void prep_transpose_item(const float* W, int K, int N, bf16_t* WT, int item, float* lds) {
    const int nbn = (N + 63) / 64, kb = item / nbn, nb = item % nbn, k0 = kb * 64, n0 = nb * 64;
    const int tid = threadIdx.x;
#pragma unroll
    for (int i = 0; i < 16; ++i) {
        const int kk = (tid >> 6) + 4 * i, nn = tid & 63;
        const float v = (n0 + nn < N) ? W[(size_t)(k0 + kk) * N + n0 + nn] : 0.f;
        lds[kk * 65 + nn] = v;
    }
    __syncthreads();
    {
        const int nn = tid >> 2, ks = (tid & 3) * 16;
        const int n = n0 + nn;
        if (n < N) {
            int np = n;
            if (MODE == 1) { const int j = (n < 1024) ? n : n - 1024; np = (j >> 4) * 32 + (j & 15) + ((n < 1024) ? 0 : 16); }
            u32x4 o0, o1;
            const float* s = lds + nn;
            o0.x = pk2(s[(ks + 0) * 65], s[(ks + 1) * 65]); o0.y = pk2(s[(ks + 2) * 65], s[(ks + 3) * 65]);
            o0.z = pk2(s[(ks + 4) * 65], s[(ks + 5) * 65]); o0.w = pk2(s[(ks + 6) * 65], s[(ks + 7) * 65]);
            o1.x = pk2(s[(ks + 8) * 65], s[(ks + 9) * 65]); o1.y = pk2(s[(ks + 10) * 65], s[(ks + 11) * 65]);
            o1.z = pk2(s[(ks + 12) * 65], s[(ks + 13) * 65]); o1.w = pk2(s[(ks + 14) * 65], s[(ks + 15) * 65]);
            u32x4* dst = (u32x4*)(WT + (size_t)np * K + k0 + ks);
            dst[0] = o0; dst[1] = o1;
        }
    }
    __syncthreads();
}

__device__ __forceinline__ void cvt_item(const float* src, bf16_t* dst, int item) {
    const size_t base = (size_t)item * 8192 + threadIdx.x * 8;
#pragma unroll
    for (int i = 0; i < 4; ++i) {
        const size_t o = base + (size_t)i * 2048;
        const f32x4 a = *(const f32x4*)(src + o), b = *(const f32x4*)(src + o + 4);
        u32x4 w; w.x = pk2(a.x, a.y); w.y = pk2(a.z, a.w); w.z = pk2(b.x, b.y); w.w = pk2(b.z, b.w);
        *(u32x4*)(dst + o) = w;
    }
}
__device__ __forceinline__ void zero_item(bf16_t* dst, int item) {
    const size_t base = (size_t)item * 8192 + threadIdx.x * 8;
#pragma unroll
    for (int i = 0; i < 4; ++i) *(u32x4*)(dst + base + (size_t)i * 2048) = (u32x4){0u, 0u, 0u, 0u};
}

struct cpx { float re, im; };
__device__ __forceinline__ cpx cmul(cpx a, cpx b) { return {a.re * b.re - a.im * b.im, a.re * b.im + a.im * b.re}; }
__device__ __forceinline__ cpx cexp_pow(float are, float aim, float dt, int m) {
    const float mag = __expf(are * dt * (float)m);
    const double rev = (double)aim * (double)dt * (double)m * 0.15915494309189535;
    const float fr = (float)(rev - rint(rev));
    return {mag * __builtin_amdgcn_cosf(fr), mag * __builtin_amdgcn_sinf(fr)};
}
__device__ __forceinline__ cpx s5_coef(float are, float aim, float dt) {
    cpx ab = cexp_pow(are, aim, dt, 1);
    const float nr = ab.re - 1.0f, ni = ab.im, den = are * are + aim * aim;
    return {(nr * are + ni * aim) / den, (ni * are - nr * aim) / den};
}

__device__ __forceinline__ void prep_s5_T_item(const Params& p, int item) {
    const int gid = item * 256 + threadIdx.x;
    const int g = gid >> 9, m = (gid >> 4) & 31, i = gid & 15;
    const float* a_re = p.in[7] + g * 64; const float* a_im = p.in[8] + g * 64;
    const float dt = __expf(p.in[9][g]);
    const float* b_re = p.in[10] + (size_t)g * 64 * 16; const float* b_im = p.in[11] + (size_t)g * 64 * 16;
    const float* c_re = p.in[12] + (size_t)g * 16 * 64 + i * 64; const float* c_im = p.in[13] + (size_t)g * 16 * 64 + i * 64;
    float acc[16];
#pragma unroll
    for (int j = 0; j < 16; ++j) acc[j] = 0.f;
    for (int q = 0; q < 64; ++q) {
        const float are = a_re[q], aim = a_im[q];
        cpx z = cmul(cmul({c_re[q], c_im[q]}, cexp_pow(are, aim, dt, m)), s5_coef(are, aim, dt));
        const f32x4* br = (const f32x4*)(b_re + q * 16); const f32x4* bi = (const f32x4*)(b_im + q * 16);
#pragma unroll
        for (int j4 = 0; j4 < 4; ++j4) {
            const f32x4 r = br[j4], im = bi[j4];
            acc[j4 * 4 + 0] += z.re * r.x - z.im * im.x; acc[j4 * 4 + 1] += z.re * r.y - z.im * im.y;
            acc[j4 * 4 + 2] += z.re * r.z - z.im * im.z; acc[j4 * 4 + 3] += z.re * r.w - z.im * im.w;
        }
    }
    u32x4 o0, o1;
    o0.x = pk2(acc[0], acc[1]); o0.y = pk2(acc[2], acc[3]); o0.z = pk2(acc[4], acc[5]); o0.w = pk2(acc[6], acc[7]);
    o1.x = pk2(acc[8], acc[9]); o1.y = pk2(acc[10], acc[11]); o1.z = pk2(acc[12], acc[13]); o1.w = pk2(acc[14], acc[15]);
    bf16_t* TW = (bf16_t*)(p.ws + WS_TW) + (size_t)g * 640 * 512;
    const u32x4 z4 = (u32x4){0u, 0u, 0u, 0u};
    for (int lp = 0; lp + m < 32; ++lp) {
        u32x4* d = (u32x4*)(TW + (size_t)((lp + m) * 16 + i) * 512 + lp * 16);
        d[0] = o0; d[1] = o1;
        if (m > 0) { u32x4* dz = (u32x4*)(TW + (size_t)(lp * 16 + i) * 512 + (lp + m) * 16); dz[0] = z4; dz[1] = z4; }
    }
}
__device__ __forceinline__ void prep_s5_W_item(const Params& p, int item) {
    const int gid = item * 256 + threadIdx.x;
    const int g = gid >> 11, q = (gid >> 5) & 63, lp = gid & 31;
    const float are = p.in[7][g * 64 + q], aim = p.in[8][g * 64 + q];
    const float dt = __expf(p.in[9][g]);
    const cpx z = cmul(cexp_pow(are, aim, dt, 31 - lp), s5_coef(are, aim, dt));
    const float* br = p.in[10] + ((size_t)g * 64 + q) * 16; const float* bi = p.in[11] + ((size_t)g * 64 + q) * 16;
    float wr[16], wi[16];
#pragma unroll
    for (int j = 0; j < 16; ++j) { wr[j] = z.re * br[j] - z.im * bi[j]; wi[j] = z.re * bi[j] + z.im * br[j]; }
    bf16_t* TW = (bf16_t*)(p.ws + WS_TW) + (size_t)g * 640 * 512;
    u32x4* d0 = (u32x4*)(TW + (size_t)(512 + q) * 512 + lp * 16);
    u32x4* d1 = (u32x4*)(TW + (size_t)(576 + q) * 512 + lp * 16);
    d0[0] = (u32x4){pk2(wr[0], wr[1]), pk2(wr[2], wr[3]), pk2(wr[4], wr[5]), pk2(wr[6], wr[7])};
    d0[1] = (u32x4){pk2(wr[8], wr[9]), pk2(wr[10], wr[11]), pk2(wr[12], wr[13]), pk2(wr[14], wr[15])};
    d1[0] = (u32x4){pk2(wi[0], wi[1]), pk2(wi[2], wi[3]), pk2(wi[4], wi[5]), pk2(wi[6], wi[7])};
    d1[1] = (u32x4){pk2(wi[8], wi[9]), pk2(wi[10], wi[11]), pk2(wi[12], wi[13]), pk2(wi[14], wi[15])};
}
__device__ __forceinline__ void prep_s5_V_item(const Params& p, int item) {
    const int gid = item * 256 + threadIdx.x;
    const int g = gid >> 14, l = (gid >> 9) & 31, i = (gid >> 5) & 15, q0 = (gid & 31) * 2;
    const float dt = __expf(p.in[9][g]);
    float vr[2], vi[2];
#pragma unroll
    for (int e = 0; e < 2; ++e) {
        const int q = q0 + e;
        const cpx z = cmul({p.in[12][((size_t)g * 16 + i) * 64 + q], p.in[13][((size_t)g * 16 + i) * 64 + q]}, cexp_pow(p.in[7][g * 64 + q], p.in[8][g * 64 + q], dt, l + 1));
        vr[e] = z.re; vi[e] = -z.im;
    }
    bf16_t* VG = (bf16_t*)(p.ws + WS_VG) + ((size_t)g * 512 + l * 16 + i) * 128;
    *(unsigned*)(VG + q0) = pk2(vr[0], vr[1]);
    *(unsigned*)(VG + 64 + q0) = pk2(vi[0], vi[1]);
}
__device__ __forceinline__ void prep_al_item(const Params& p, int item) {
    const int gid = item * 256 + threadIdx.x;
    const int g = gid >> 6;
    const float dt = __expf(p.in[9][g]);
    const cpx z = cexp_pow(p.in[7][gid], p.in[8][gid], dt, S5L);
    f32x2* AL = (f32x2*)(p.ws + WS_MISC + 4096);
    AL[gid] = (f32x2){z.re, z.im};
}
__device__ __forceinline__ void prep_rope_item(const Params& p, int item) {
    const int gid = item * 256 + threadIdx.x;
    const int pos = gid >> 5, j = gid & 31;
    const float freq = exp2f(-(float)j * (13.287712379549449f / 32.0f));
    const float ang = (float)pos * freq;
    const double rev = (double)ang * 0.15915494309189535;
    const float fr = (float)(rev - rint(rev));
    f32x2* R = (f32x2*)(p.ws + WS_ROPE);
    R[gid] = (f32x2){__builtin_amdgcn_cosf(fr), __builtin_amdgcn_sinf(fr)};
}
__device__ __forceinline__ void prep_cmpbias_item(const Params& p, int item, float* lds) {
    const int kv = item >> 3, cg0 = (item & 7) * 32;
    const float* pe = p.in[17 + kv]; const float* w1 = p.in[kv == 0 ? 19 : 21];
    const int tid = threadIdx.x, col = cg0 + (tid & 31), kg = tid >> 5;
    float s = 0.f;
#pragma unroll 8
    for (int k = kg * 256; k < kg * 256 + 256; ++k) s += pe[k] * w1[(size_t)k * 256 + col];
    lds[tid] = s;
    __syncthreads();
    if (tid < 32) {
        float t = 0.f;
#pragma unroll
        for (int q = 0; q < 8; ++q) t += lds[q * 32 + tid];
        ((float*)(p.ws + WS_MISC))[kv * 256 + cg0 + tid] = t;
    }
    __syncthreads();
}

__device__ __forceinline__ void cvt_fp8_item(const float* src, unsigned char* dst, float* inv_scale, int item, const bool slice_major) {
    const int lane = threadIdx.x & 63, row0 = item * 16 + (threadIdx.x >> 6) * 4;
    f32x4 v[4][4];
#pragma unroll
    for (int r = 0; r < 4; ++r) {
        const f32x4* sp = (const f32x4*)(src + (size_t)(row0 + r) * D + lane * 16);
#pragma unroll
        for (int q = 0; q < 4; ++q) v[r][q] = sp[q];
    }
#pragma unroll
    for (int r = 0; r < 4; ++r) {
        float m = 0.f;
#pragma unroll
        for (int q = 0; q < 4; ++q) m = fmaxf(m, fmaxf(fmaxf(fabsf(v[r][q].x), fabsf(v[r][q].y)), fmaxf(fabsf(v[r][q].z), fabsf(v[r][q].w))));
#pragma unroll
        for (int o = 1; o < 64; o <<= 1) m = fmaxf(m, __shfl_xor(m, o));
        const float sc = m > 0.f ? 224.0f / m : 1.0f;
        unsigned w[4];
#pragma unroll
        for (int q = 0; q < 4; ++q) { int t = 0; t = __builtin_amdgcn_cvt_pk_fp8_f32(v[r][q].x * sc, v[r][q].y * sc, t, false); t = __builtin_amdgcn_cvt_pk_fp8_f32(v[r][q].z * sc, v[r][q].w * sc, t, true); w[q] = (unsigned)t; }
        const int row = row0 + r;
        const u32x4 wv = (u32x4){w[0], w[1], w[2], w[3]};
        if (slice_major) *(u32x4*)(dst + (size_t)(lane >> 3) * (PE * 128) + (size_t)row * 128 + (lane & 7) * 16) = wv;
        else *(u32x4*)(dst + (size_t)row * D + lane * 16) = wv;
        if (lane == 0) inv_scale[row] = m > 0.f ? m / 224.0f : 1.0f;
    }
}
constexpr int P0_MOD = 384;
constexpr int P0_T_WIN = 16 * 16, P0_T_WGLU = 16 * 32, P0_T_WPROJ = 16 * 41, P0_T_WK1 = 32 * 4, P0_T_WK2 = 4 * 1, P0_T_WO = 16 * 16, P0_T_WQ = 16 * 32;
constexpr int P0_SUBK = (2 * 8 * 2 * 128 * 128) / 8192;
constexpr int P0_TAB = PE / 16;
constexpr int P0_S5T = 128, P0_S5W = 512, P0_S5V = 4096, P0_AL = 16, P0_ROPE = 2048, P0_CB = 16, P0_ZERO = 10 + 2;

__device__ __forceinline__ void phase_prep(const Params& p, float* lds) {
    const int n0 = P0_MOD;
    const int n1 = n0 + P0_T_WIN, n2 = n1 + P0_T_WGLU, n3 = n2 + P0_T_WPROJ, n4 = n3 + P0_T_WK1, n5 = n4 + P0_T_WK1, n6 = n5 + P0_T_WK2, n7 = n6 + P0_T_WK2,
              n8 = n7 + P0_T_WO, n9 = n8 + P0_T_WQ, n10 = n9 + P0_T_WQ, n11 = n10 + P0_SUBK, n12 = n11 + P0_TAB, n13 = n12 + P0_TAB,
              n14 = n13 + P0_S5T, n15 = n14 + P0_S5W, n16 = n15 + P0_S5V, n17 = n16 + P0_AL, n18 = n17 + P0_ROPE, n19 = n18 + P0_CB, n20 = n19 + 10, n21 = n20 + 2, n22 = n21 + 2;
    unsigned char* ws = p.ws;
#ifndef PREP_DUP_LO
#define PREP_DUP_LO 0
#define PREP_DUP_HI 0
#endif
    const int dupn = (PREP_DUP_HI) - (PREP_DUP_LO);
    for (int it0 = blockIdx.x; it0 < n22 + dupn; it0 += gridDim.x) {
        const int it = it0 < n22 ? it0 : (PREP_DUP_LO) + (it0 - n22);
        if (it < n0) prep_mod_item(p, it, lds);
        else if (it < n1) prep_transpose_item<0>(p.in[6], 1024, 1024, (bf16_t*)(ws + WS_WIN_T), it - n0, lds);
        else if (it < n2) prep_transpose_item<1>(p.in[15], 1024, 2048, (bf16_t*)(ws + WS_WGLU_T), it - n1, lds);
        else if (it < n3) prep_transpose_item<0>(p.in[16], 1024, NPROJ, (bf16_t*)(ws + WS_WPROJ_T), it - n2, lds);
        else if (it < n4) prep_transpose_item<0>(p.in[19], 2048, 256, (bf16_t*)(ws + WS_WK1_T), it - n3, lds);
        else if (it < n5) prep_transpose_item<0>(p.in[21], 2048, 256, (bf16_t*)(ws + WS_WV1_T), it - n4, lds);
        else if (it < n6) prep_transpose_item<0>(p.in[20], 256, 64, (bf16_t*)(ws + WS_WK2_T), it - n5, lds);
        else if (it < n7) prep_transpose_item<0>(p.in[22], 256, 64, (bf16_t*)(ws + WS_WV2_T), it - n6, lds);
        else if (it < n8) prep_transpose_item<0>(p.in[23], 1024, 1024, (bf16_t*)(ws + WS_WO_T), it - n7, lds);
        else if (it < n9) prep_transpose_item<0>(p.in[24], 1024, 2048, (bf16_t*)(ws + WS_WQ_T), it - n8, lds);
        else if (it < n10) prep_transpose_item<0>(p.in[24] + (size_t)1024 * 2048, 1024, 2048, (bf16_t*)(ws + WS_WQ_T) + (size_t)2048 * 1024, it - n9, lds);
        else if (it < n11) cvt_item(p.in[25], (bf16_t*)(ws + WS_SUBK), it - n10);
        else if (it < n12) cvt_fp8_item(p.in[26], ws + WS_PU, (float*)(ws + WS_PU + 24 * MiB), it - n11, false);
        else if (it < n13) cvt_fp8_item(p.in[27], ws + WS_PV, (float*)(ws + WS_PV + 24 * MiB), it - n12, false);
        else if (it < n14) prep_s5_T_item(p, it - n13);
        else if (it < n15) prep_s5_W_item(p, it - n14);
        else if (it < n16) prep_s5_V_item(p, it - n15);
        else if (it < n17) prep_al_item(p, it - n16);
        else if (it < n18) prep_rope_item(p, it - n17);
        else if (it < n19) prep_cmpbias_item(p, it - n18, lds);
        else if (it < n20) zero_item((bf16_t*)(ws + WS_WPROJ_T) + (size_t)NPROJ * 1024, it - n19);
        else if (it < n21) zero_item((bf16_t*)(ws + WS_WK2_T) + (size_t)64 * 256, it - n20);
        else zero_item((bf16_t*)(ws + WS_WV2_T) + (size_t)64 * 256, it - n21);
    }
}

__device__ __forceinline__ void phase_norm(const Params& p, const float* X, const float* gw, const float* shift, const float* scale  , bf16_t* HM) {
    const int lane = threadIdx.x & 63, wave = threadIdx.x >> 6;
    for (int row = blockIdx.x * 4 + wave; row < T; row += gridDim.x * 4) {
        const int b = row / SEQ;
        const f32x4* xr = (const f32x4*)(X + (size_t)row * D) + lane;
        f32x4 v[4]; float s = 0.f;
#pragma unroll
        for (int j = 0; j < 4; ++j) { v[j] = xr[64 * j]; s += (v[j].x * v[j].x + v[j].y * v[j].y) + (v[j].z * v[j].z + v[j].w * v[j].w); }
        const float rs = rsqrtf(wave_sum(s) * (1.0f / D) + RMS_EPS);
        u32x2* o = (u32x2*)(HM + (size_t)row * D) + lane;
#pragma unroll
        for (int j = 0; j < 4; ++j) {
            const int c = lane * 4 + 256 * j;
            const f32x4 g = *(const f32x4*)(gw + c), sh = *(const f32x4*)(shift + (size_t)b * 6144 + c), sc = *(const f32x4*)(scale + (size_t)b * 6144 + c);
            const float y0 = v[j].x * rs * g.x * (1.f + sc.x) + sh.x, y1 = v[j].y * rs * g.y * (1.f + sc.y) + sh.y;
            const float y2 = v[j].z * rs * g.z * (1.f + sc.z) + sh.z, y3 = v[j].w * rs * g.w * (1.f + sc.w) + sh.w;
            o[64 * j] = (u32x2){pk2(y0, y1), pk2(y2, y3)};
        }
    }
}
__device__ __forceinline__ void phase_final_norm(const Params& p, const float* X, float* OUT, bool dry) {
    const int lane = threadIdx.x & 63, wave = threadIdx.x >> 6;
    const float* gw = p.in[28];
    for (int row = blockIdx.x * 4 + wave; row < T; row += gridDim.x * 4) {
        const f32x4* xr = (const f32x4*)(X + (size_t)row * D) + lane;
        f32x4 v[4]; float s = 0.f;
#pragma unroll
        for (int j = 0; j < 4; ++j) { v[j] = xr[64 * j]; s += (v[j].x * v[j].x + v[j].y * v[j].y) + (v[j].z * v[j].z + v[j].w * v[j].w); }
        const float rs = rsqrtf(wave_sum(s) * (1.0f / D) + RMS_EPS);
        f32x4* o = (f32x4*)(OUT + (size_t)row * D) + lane;
#pragma unroll
        for (int j = 0; j < 4; ++j) {
            const f32x4 g = *(const f32x4*)(gw + lane * 4 + 256 * j);
            if (!dry) o[64 * j] = (f32x4){v[j].x * rs * g.x, v[j].y * rs * g.y, v[j].z * rs * g.z, v[j].w * rs * g.w};
        }
    }
}

__device__ __forceinline__ int vblock() { const int G = gridDim.x, bx = blockIdx.x; return (G % 8 == 0) ? (bx % 8) * (G / 8) + bx / 8 : bx; }
struct ALoadPlain {
    const bf16_t* A; size_t lda;
    __device__ __forceinline__ const bf16_t* base(int kt) const { return A + kt * 64; }
    __device__ __forceinline__ unsigned off(int r, int lc) const { return (unsigned)r * (unsigned)lda + (unsigned)lc * 8u; }
};
struct ALoadGroup {
    const bf16_t* A;
    __device__ __forceinline__ const bf16_t* base(int kt) const { return A + (size_t)kt * 4 * T * 16; }
    __device__ __forceinline__ unsigned off(int r, int lc) const { return ((unsigned)(lc >> 1) * (unsigned)T + (unsigned)r) * 16u + (unsigned)(lc & 1) * 8u; }
};

template <class AL>
__device__ __forceinline__ void gemm_tile2(const AL al, const bf16_t* __restrict__ Bt, size_t ldb, int nk, f32x4 (&acc)[4][4], unsigned char* lds) {
    const int tid = threadIdx.x, lane = tid & 63, wid = tid >> 6, wr = wid >> 1, wc = wid & 1, fr = lane & 15, fq = lane >> 4;
    const int lr = tid >> 3, lc = tid & 7;
#pragma unroll
    for (int mi = 0; mi < 4; ++mi)
#pragma unroll
        for (int ni = 0; ni < 4; ++ni) acc[mi][ni] = (f32x4){0.f, 0.f, 0.f, 0.f};
    u32x4 ra0[4], rb0[4], ra1[4], rb1[4];
    const int soff = lr * 128 + ((lc ^ (lr & 7)) << 4);
    unsigned offA[4], offB[4];
#pragma unroll
    for (int i = 0; i < 4; ++i) { offA[i] = al.off(lr + 32 * i, lc); offB[i] = (unsigned)(lr + 32 * i) * (unsigned)ldb + (unsigned)lc * 8u; }
#define GT_LOAD(RA, RB, kt_) do { const bf16_t* ab_ = al.base(kt_); const bf16_t* bb_ = Bt + (kt_) * 64; _Pragma("unroll") for (int i = 0; i < 4; ++i) { RA[i] = *(const u32x4*)(ab_ + offA[i]); RB[i] = *(const u32x4*)(bb_ + offB[i]); } } while (0)
#define GT_STORE(RA, RB, buf_) do { unsigned char* nb_ = lds + (buf_) * 32768; _Pragma("unroll") for (int i = 0; i < 4; ++i) { *(u32x4*)(nb_ + soff + i * 4096) = RA[i]; *(u32x4*)(nb_ + 16384 + soff + i * 4096) = RB[i]; } } while (0)
    const int aoff = (wr * 64 + fr) * 128, boff = 16384 + (wc * 64 + fr) * 128, sw = fr & 7;
#define GT_MATH(buf_) do { const unsigned char* bp_ = lds + (buf_) * 32768; _Pragma("unroll") for (int ks = 0; ks < 2; ++ks) { bf16x8 af[4], bfr[4]; const int co = ((ks * 4 + fq) ^ sw) << 4; \
        _Pragma("unroll") for (int mi = 0; mi < 4; ++mi) af[mi] = *(const bf16x8*)(bp_ + aoff + mi * 2048 + co); \
        _Pragma("unroll") for (int ni = 0; ni < 4; ++ni) bfr[ni] = *(const bf16x8*)(bp_ + boff + ni * 2048 + co); \
        _Pragma("unroll") for (int mi = 0; mi < 4; ++mi) _Pragma("unroll") for (int ni = 0; ni < 4; ++ni) acc[mi][ni] = __builtin_amdgcn_mfma_f32_16x16x32_bf16(bfr[ni], af[mi], acc[mi][ni], 0, 0, 0); } } while (0)
    GT_LOAD(ra0, rb0, 0);
    if (nk > 1) GT_LOAD(ra1, rb1, 1);
    GT_STORE(ra0, rb0, 0);
    __syncthreads();
    for (int kt = 0; kt < nk; kt += 2) {
        if (kt + 2 < nk) GT_LOAD(ra0, rb0, kt + 2);
        __builtin_amdgcn_sched_barrier(0);
        GT_MATH(0);
        __builtin_amdgcn_sched_barrier(0);
        if (kt + 1 < nk) GT_STORE(ra1, rb1, 1);
        __syncthreads();
        if (kt + 1 >= nk) break;
        if (kt + 3 < nk) GT_LOAD(ra1, rb1, kt + 3);
        __builtin_amdgcn_sched_barrier(0);
        GT_MATH(1);
        __builtin_amdgcn_sched_barrier(0);
        if (kt + 2 < nk) GT_STORE(ra0, rb0, 0);
        __syncthreads();
    }
#undef GT_LOAD
#undef GT_STORE
#undef GT_MATH
}

template <class AL>
__device__ __forceinline__ void gemm_tile1(const AL al, const bf16_t* __restrict__ Bt, size_t ldb, int nk, f32x4 (&acc)[4][4], unsigned char* lds) {
    const int tid = threadIdx.x, lane = tid & 63, wid = tid >> 6, wr = wid >> 1, wc = wid & 1, fr = lane & 15, fq = lane >> 4;
    const int lr = tid >> 3, lc = tid & 7;
#pragma unroll
    for (int mi = 0; mi < 4; ++mi)
#pragma unroll
        for (int ni = 0; ni < 4; ++ni) acc[mi][ni] = (f32x4){0.f, 0.f, 0.f, 0.f};
    u32x4 ra[4], rb[4];
    const int soff = lr * 128 + ((lc ^ (lr & 7)) << 4);
#pragma unroll
    for (int i = 0; i < 4; ++i) { ra[i] = *(const u32x4*)(al.base(0) + al.off(lr + 32 * i, lc)); rb[i] = *(const u32x4*)(Bt + (size_t)(lr + 32 * i) * ldb + lc * 8); }
#pragma unroll
    for (int i = 0; i < 4; ++i) { *(u32x4*)(lds + soff + i * 4096) = ra[i]; *(u32x4*)(lds + 16384 + soff + i * 4096) = rb[i]; }
    __syncthreads();
    const int aoff = (wr * 64 + fr) * 128, boff = 16384 + (wc * 64 + fr) * 128, sw = fr & 7;
    for (int kt = 0; kt < nk; ++kt) {
        const bool more = (kt + 1 < nk);
        if (more) {
#pragma unroll
            for (int i = 0; i < 4; ++i) { ra[i] = *(const u32x4*)(al.base(kt + 1) + al.off(lr + 32 * i, lc)); rb[i] = *(const u32x4*)(Bt + (size_t)(lr + 32 * i) * ldb + (kt + 1) * 64 + lc * 8); }
        }
        const unsigned char* buf = lds + (kt & 1) * 32768;
#pragma unroll
        for (int ks = 0; ks < 2; ++ks) {
            bf16x8 af[4], bfr[4];
            const int co = ((ks * 4 + fq) ^ sw) << 4;
#pragma unroll
            for (int mi = 0; mi < 4; ++mi) af[mi] = *(const bf16x8*)(buf + aoff + mi * 2048 + co);
#pragma unroll
            for (int ni = 0; ni < 4; ++ni) bfr[ni] = *(const bf16x8*)(buf + boff + ni * 2048 + co);
#pragma unroll
            for (int mi = 0; mi < 4; ++mi)
#pragma unroll
                for (int ni = 0; ni < 4; ++ni) acc[mi][ni] = __builtin_amdgcn_mfma_f32_16x16x32_bf16(bfr[ni], af[mi], acc[mi][ni], 0, 0, 0);
        }
        if (more) {
            unsigned char* nb = lds + ((kt + 1) & 1) * 32768;
#pragma unroll
            for (int i = 0; i < 4; ++i) { *(u32x4*)(nb + soff + i * 4096) = ra[i]; *(u32x4*)(nb + 16384 + soff + i * 4096) = rb[i]; }
        }
        __syncthreads();
    }
}
__device__ __forceinline__ void phase_s5_win(const Params& p, unsigned char* lds) {
    const bf16_t* HM = (const bf16_t*)(p.ws + WS_HM); const bf16_t* WT = (const bf16_t*)(p.ws + WS_WIN_T);
    bf16_t* UG = (bf16_t*)(p.ws + WS_UG);
    const int lane = threadIdx.x & 63, wid = threadIdx.x >> 6, wr = wid >> 1, wc = wid & 1, fr = lane & 15, fq = lane >> 4;
    for (int id = vblock(); id < 256 * 8; id += gridDim.x) {
        const int mt = id >> 3, nt = id & 7;
        f32x4 acc[4][4];
        gemm_tile1(ALoadPlain{HM + (size_t)mt * 128 * D, (size_t)D}, WT + (size_t)nt * 128 * D, D, 16, acc, lds);
#pragma unroll
        for (int mi = 0; mi < 4; ++mi)
#pragma unroll
            for (int ni = 0; ni < 4; ++ni) {
                const int t = mt * 128 + wr * 64 + mi * 16 + fr, g = nt * 8 + wc * 4 + ni;
                const f32x4 v = acc[mi][ni];
                *(u32x2*)(UG + ((size_t)g * T + t) * 16 + fq * 4) = (u32x2){pk2(v.x, v.y), pk2(v.z, v.w)};
            }
    }
}
__device__ __forceinline__ void phase_s5_a(const Params& p, unsigned char* lds) {
    const bf16_t* UG = (const bf16_t*)(p.ws + WS_UG); const bf16_t* TW = (const bf16_t*)(p.ws + WS_TW);
    bf16_t* YI = (bf16_t*)(p.ws + WS_YI); float* WST = (float*)(p.ws + WS_WST);
    const int lane = threadIdx.x & 63, wid = threadIdx.x >> 6, wr = wid >> 1, wc = wid & 1, fr = lane & 15, fq = lane >> 4;
    for (int id = vblock(); id < 64 * 40; id += gridDim.x) {
        const int g = id / 40, rem = id % 40, mt = rem / 5, nt = rem % 5;
        const int nk = (nt < 4) ? 2 * (nt + 1) : 8;
        f32x4 acc[4][4];
        gemm_tile1(ALoadPlain{UG + (size_t)g * T * 16 + (size_t)mt * 128 * 512, (size_t)512}, TW + ((size_t)g * 640 + nt * 128) * 512, 512, nk, acc, lds);
#pragma unroll
        for (int mi = 0; mi < 4; ++mi)
#pragma unroll
            for (int ni = 0; ni < 4; ++ni) {
                const int R = mt * 128 + wr * 64 + mi * 16 + fr, c = wc * 64 + ni * 16 + fq * 4;
                const f32x4 v = acc[mi][ni];
                if (nt < 4) *(u32x2*)(YI + ((size_t)g * 1024 + R) * 512 + nt * 128 + c) = (u32x2){pk2(v.x, v.y), pk2(v.z, v.w)};
                else *(f32x4*)(WST + ((size_t)g * 1024 + R) * 128 + c) = v;
            }
    }
}
__device__ __forceinline__ void phase_s5_scan(const Params& p) {
    const int lane = threadIdx.x & 63, wave = threadIdx.x >> 6;
    const float* WST = (const float*)(p.ws + WS_WST); bf16_t* SST = (bf16_t*)(p.ws + WS_SST);
    const f32x2* AL = (const f32x2*)(p.ws + WS_MISC + 4096);
    for (int it = blockIdx.x * 4 + wave; it < 128; it += gridDim.x * 4) {
        const int b = it >> 6, g = it & 63;
        const f32x2 al = AL[g * 64 + lane];
        float sr = 0.f, si = 0.f;
        const float* wbase = WST + ((size_t)g * 1024 + b * 512) * 128 + lane;
        bf16_t* sbase = SST + ((size_t)g * 1024 + b * 512) * 128 + lane;
        for (int n0 = 0; n0 < 512; n0 += 16) {
            float wre[16], wim[16];
#pragma unroll
            for (int j = 0; j < 16; ++j) { wre[j] = wbase[(size_t)(n0 + j) * 128]; wim[j] = wbase[(size_t)(n0 + j) * 128 + 64]; }
#pragma unroll
            for (int j = 0; j < 16; ++j) {
                sbase[(size_t)(n0 + j) * 128] = (bf16_t)f2bf(sr); sbase[(size_t)(n0 + j) * 128 + 64] = (bf16_t)f2bf(si);
                const float nr = al.x * sr - al.y * si + wre[j], ni = al.x * si + al.y * sr + wim[j];
                sr = nr; si = ni;
            }
        }
    }
}
__device__ __forceinline__ void phase_s5_b(const Params& p, unsigned char* lds) {
    const bf16_t* SST = (const bf16_t*)(p.ws + WS_SST); const bf16_t* VG = (const bf16_t*)(p.ws + WS_VG);
    const bf16_t* YI = (const bf16_t*)(p.ws + WS_YI); const bf16_t* UG = (const bf16_t*)(p.ws + WS_UG);
    bf16_t* YG = (bf16_t*)(p.ws + WS_YG);
    const float* dsk = p.in[14];
    const int lane = threadIdx.x & 63, wid = threadIdx.x >> 6, wr = wid >> 1, wc = wid & 1, fr = lane & 15, fq = lane >> 4;
    for (int id = vblock(); id < 64 * 32; id += gridDim.x) {
        const int g = id >> 5, mt = (id >> 2) & 7, nt = id & 3;
        f32x4 acc[4][4];
        gemm_tile1(ALoadPlain{SST + ((size_t)g * 1024 + mt * 128) * 128, (size_t)128}, VG + ((size_t)g * 512 + nt * 128) * 128, 128, 2, acc, lds);
        const f32x4 dv = *(const f32x4*)(dsk + g * 16 + fq * 4);
#pragma unroll
        for (int mi = 0; mi < 4; ++mi)
#pragma unroll
            for (int ni = 0; ni < 4; ++ni) {
                const int R = mt * 128 + wr * 64 + mi * 16 + fr, c = nt * 128 + wc * 64 + ni * 16 + fq * 4;
                const size_t idx = ((size_t)g * 1024 + R) * 512 + c;
                const u32x2 yi = *(const u32x2*)(YI + idx), uu = *(const u32x2*)(UG + idx);
                const f32x4 v = acc[mi][ni];
                const float y0 = gelu_tanh(v.x + bflo(yi.x) + dv.x * bflo(uu.x)), y1 = gelu_tanh(v.y + bfhi(yi.x) + dv.y * bfhi(uu.x));
                const float y2 = gelu_tanh(v.z + bflo(yi.y) + dv.z * bflo(uu.y)), y3 = gelu_tanh(v.w + bfhi(yi.y) + dv.w * bfhi(uu.y));
                *(u32x2*)(YG + idx) = (u32x2){pk2(y0, y1), pk2(y2, y3)};
            }
    }
}
__device__ __forceinline__ void phase_s5_glu(const Params& p, unsigned char* lds) {
    const bf16_t* YG = (const bf16_t*)(p.ws + WS_YG); const bf16_t* WT = (const bf16_t*)(p.ws + WS_WGLU_T);
    const float* MOD = (const float*)(p.ws + WS_MOD);
    const float* X = p.in[0]; float* XO = p.out;
    const int lane = threadIdx.x & 63, wid = threadIdx.x >> 6, wr = wid >> 1, wc = wid & 1, fr = lane & 15, fq = lane >> 4;
    for (int id = vblock(); id < 256 * 16; id += gridDim.x) {
        const int mt = id >> 4, nt = id & 15;
        f32x4 acc[4][4];
        gemm_tile1(ALoadGroup{YG + (size_t)mt * 128 * 16}, WT + (size_t)nt * 128 * D, D, 16, acc, lds);
        const int b = (mt * 128) / SEQ;
#pragma unroll
        for (int mi = 0; mi < 4; ++mi)
#pragma unroll
            for (int h = 0; h < 2; ++h) {
                const int t = mt * 128 + wr * 64 + mi * 16 + fr, j = nt * 64 + wc * 32 + h * 16 + fq * 4;
                const f32x4 a = acc[mi][2 * h], gg = acc[mi][2 * h + 1];
                const f32x4 g1 = *(const f32x4*)(MOD + (size_t)(0 * 2 + b) * 6144 + 2048 + j);
                const f32x4 xi = *(const f32x4*)(X + (size_t)t * D + j);
                f32x4 o;
                o.x = xi.x + g1.x * (a.x * sigmoidf_(gg.x)); o.y = xi.y + g1.y * (a.y * sigmoidf_(gg.y));
                o.z = xi.z + g1.z * (a.z * sigmoidf_(gg.z)); o.w = xi.w + g1.w * (a.w * sigmoidf_(gg.w));
                *(f32x4*)(XO + (size_t)t * D + j) = o;
            }
    }
}
__device__ __forceinline__ void phase_peer_wq(const Params& p, int layer, unsigned char* lds) {
    const bf16_t* HM = (const bf16_t*)(p.ws + WS_HM); const bf16_t* WT = (const bf16_t*)(p.ws + WS_WQ_T) + (size_t)layer * 2048 * 1024;
    bf16_t* QK = (bf16_t*)(p.ws + WS_QK);
    const int lane = threadIdx.x & 63, wid = threadIdx.x >> 6, wr = wid >> 1, wc = wid & 1, fr = lane & 15, fq = lane >> 4;
    for (int id = vblock(); id < 256 * 16; id += gridDim.x) {
        const int mt = id >> 4, nt = id & 15;
        f32x4 acc[4][4];
        gemm_tile1(ALoadPlain{HM + (size_t)mt * 128 * D, (size_t)D}, WT + (size_t)nt * 128 * D, D, 16, acc, lds);
#pragma unroll
        for (int mi = 0; mi < 4; ++mi)
#pragma unroll
            for (int ni = 0; ni < 4; ++ni) {
                const int t = mt * 128 + wr * 64 + mi * 16 + fr, c = nt * 128 + wc * 64 + ni * 16 + fq * 4;
                const f32x4 v = acc[mi][ni];
                *(u32x2*)(QK + (size_t)t * 2048 + c) = (u32x2){pk2(v.x, v.y), pk2(v.z, v.w)};
            }
    }
}
__device__ __forceinline__ void ce_(unsigned& a, unsigned& b, const bool up) { const unsigned lo = a < b ? a : b, hi = a < b ? b : a; a = up ? lo : hi; b = up ? hi : lo; }
__device__ __forceinline__ void bitonic_sort16(unsigned* x, const bool asc) {
#pragma unroll
    for (int k = 2; k <= 16; k <<= 1)
#pragma unroll
        for (int j = k >> 1; j > 0; j >>= 1)
#pragma unroll
            for (int i = 0; i < 16; ++i) { const int l = i ^ j; if (l > i) ce_(x[i], x[l], ((i & k) == 0) == asc); }
}
__device__ __forceinline__ void bitonic_merge16(unsigned* x, const bool asc) {
#pragma unroll
    for (int j = 8; j > 0; j >>= 1)
#pragma unroll
        for (int i = 0; i < 16; ++i) { const int l = i ^ j; if (l > i) ce_(x[i], x[l], asc); }
}
__device__ __forceinline__ void phase_peer_topk(const Params& p, int layer, unsigned char* lds) {
    const bf16_t* QK = (const bf16_t*)(p.ws + WS_QK); const bf16_t* SK = (const bf16_t*)(p.ws + WS_SUBK) + (size_t)layer * 8 * 2 * 128 * 128;
    float* TOPS = (float*)(p.ws + WS_TOPS); int* TOPI = (int*)(p.ws + WS_TOPI);
    float* sc = (float*)lds;
    const int tid = threadIdx.x, lane = tid & 63, wid = tid >> 6, wr = wid >> 1, wc = wid & 1, fr = lane & 15, fq = lane >> 4;
    for (int id = vblock(); id < 256 * 16; id += gridDim.x) {
        const int mt = id >> 4, hc = id & 15;
        f32x4 acc[4][4];
        gemm_tile1(ALoadPlain{QK + (size_t)mt * 128 * 2048 + hc * 128, (size_t)2048}, SK + (size_t)hc * 128 * 128, 128, 2, acc, lds);
#pragma unroll
        for (int mi = 0; mi < 4; ++mi)
#pragma unroll
            for (int ni = 0; ni < 4; ++ni) {
                const int r = wr * 64 + mi * 16 + fr, c = wc * 64 + ni * 16 + fq * 4;
                float* d = sc + r * 129 + c;
                d[0] = acc[mi][ni].x; d[1] = acc[mi][ni].y; d[2] = acc[mi][ni].z; d[3] = acc[mi][ni].w;
            }
        __syncthreads();
        {
            const int row = tid >> 1, half = tid & 1;
            unsigned x[64];
            const float* rp = sc + row * 129 + half * 64;
#pragma unroll
            for (int j = 0; j < 64; ++j) {
                const unsigned bits = __builtin_bit_cast(unsigned, rp[j]);
                const unsigned u = bits ^ ((unsigned)((int)bits >> 31) | 0x80000000u);
                x[j] = (u & 0xFFFFFF80u) | (unsigned)(127 - (half * 64 + j));
            }
            bitonic_sort16(x, true); bitonic_sort16(x + 16, false); bitonic_sort16(x + 32, true); bitonic_sort16(x + 48, false);
#pragma unroll
            for (int i = 0; i < 16; ++i) { x[i] = x[i] > x[16 + i] ? x[i] : x[16 + i]; x[32 + i] = x[32 + i] > x[48 + i] ? x[32 + i] : x[48 + i]; }
            bitonic_merge16(x, true); bitonic_merge16(x + 32, false);
#pragma unroll
            for (int i = 0; i < 16; ++i) x[i] = x[i] > x[32 + i] ? x[i] : x[32 + i];
            bitonic_merge16(x, false);
            unsigned y[16];
#pragma unroll
            for (int i = 0; i < 16; ++i) { const unsigned o = (unsigned)__shfl_xor((int)x[15 - i], 1); y[i] = x[i] > o ? x[i] : o; }
            bitonic_merge16(y, false);
            const size_t ob = ((size_t)(mt * 128 + row) * 16 + hc) * 16;
            if (half == 0) {
                float v[16];
#pragma unroll
                for (int i = 0; i < 16; ++i) { const unsigned u = y[i] & 0xFFFFFF80u; const unsigned bits = (u & 0x80000000u) ? (u ^ 0x80000000u) : ~u; v[i] = __builtin_bit_cast(float, bits); }
#pragma unroll
                for (int q = 0; q < 4; ++q) *(f32x4*)(TOPS + ob + q * 4) = (f32x4){v[q * 4], v[q * 4 + 1], v[q * 4 + 2], v[q * 4 + 3]};
            } else {
#pragma unroll
                for (int q = 0; q < 4; ++q) *(u32x4*)(TOPI + ob + q * 4) = (u32x4){127u - (y[q * 4] & 127u), 127u - (y[q * 4 + 1] & 127u), 127u - (y[q * 4 + 2] & 127u), 127u - (y[q * 4 + 3] & 127u)};
            }
        }
        __syncthreads();
    }
}
__device__ __forceinline__ void phase_peer_combine(const Params& p, unsigned char* lds) {
    const float* TOPS = (const float*)(p.ws + WS_TOPS); const int* TOPI = (const int*)(p.ws + WS_TOPI);
    int* EXP = (int*)(p.ws + WS_EXP); float* GATE = (float*)(p.ws + WS_GATE);
    unsigned* L = (unsigned*)lds;
    const int tid = threadIdx.x;
    for (int it = blockIdx.x; it < (T * 8) / 256; it += gridDim.x) {
        const size_t th = (size_t)it * 256 + tid;
        const u32x4* S4 = (const u32x4*)(TOPS + th * 32); const u32x4* I4 = (const u32x4*)(TOPI + th * 32);
#pragma unroll
        for (int a4 = 0; a4 < 8; ++a4) {
            const u32x4 s = S4[a4], i = I4[a4];
            L[(a4 * 4 + 0) * 256 + tid] = s.x; L[(a4 * 4 + 1) * 256 + tid] = s.y; L[(a4 * 4 + 2) * 256 + tid] = s.z; L[(a4 * 4 + 3) * 256 + tid] = s.w;
            L[(32 + a4 * 4 + 0) * 256 + tid] = i.x; L[(32 + a4 * 4 + 1) * 256 + tid] = i.y; L[(32 + a4 * 4 + 2) * 256 + tid] = i.z; L[(32 + a4 * 4 + 3) * 256 + tid] = i.w;
        }
        float val[16];
        const float s20 = __builtin_bit_cast(float, L[16 * 256 + tid]);
#pragma unroll
        for (int a = 0; a < 16; ++a) val[a] = __builtin_bit_cast(float, L[a * 256 + tid]) + s20;
        unsigned long long P = 0ull;
        float ts[16]; int te[16];
#pragma unroll
        for (int r = 0; r < 16; ++r) {
            float best = val[0]; int ba = 0;
#pragma unroll
            for (int a = 1; a < 16; ++a) if (val[a] > best) { best = val[a]; ba = a; }
            const int b = (int)((P >> (4 * ba)) & 15ull);
            const int i1 = (int)L[(32 + ba) * 256 + tid], i2 = (int)L[(48 + b) * 256 + tid];
            ts[r] = best; te[r] = i1 * 128 + i2;
            const int nb = b + 1;
            float newv = -3.0e38f;
            if (nb < 16) { newv = __builtin_bit_cast(float, L[ba * 256 + tid]) + __builtin_bit_cast(float, L[(16 + nb) * 256 + tid]); P += 1ull << (4 * ba); }
#pragma unroll
            for (int a = 0; a < 16; ++a) val[a] = (a == ba) ? newv : val[a];
        }
        const float m0 = ts[0];
        float sum = 0.f;
#pragma unroll
        for (int r = 0; r < 16; ++r) { ts[r] = __expf(ts[r] - m0); sum += ts[r]; }
        const float inv = 1.0f / sum;
#pragma unroll
        for (int r = 0; r < 16; ++r) ts[r] *= inv;
#pragma unroll
        for (int r = 0; r < 16; ++r) { EXP[th * 16 + r] = te[r]; GATE[th * 16 + r] = ts[r]; }
    }
}

__device__ __forceinline__ void fma8(const unsigned w0, const unsigned w1, const float a, float* acc) {
    const f32x2 p0 = __builtin_amdgcn_cvt_pk_f32_fp8((int)w0, false), p1 = __builtin_amdgcn_cvt_pk_f32_fp8((int)w0, true);
    const f32x2 p2 = __builtin_amdgcn_cvt_pk_f32_fp8((int)w1, false), p3 = __builtin_amdgcn_cvt_pk_f32_fp8((int)w1, true);
    acc[0] += a * p0.x; acc[1] += a * p0.y; acc[2] += a * p1.x; acc[3] += a * p1.y;
    acc[4] += a * p2.x; acc[5] += a * p2.y; acc[6] += a * p3.x; acc[7] += a * p3.y;
}
__device__ __forceinline__ float dot8(const unsigned w0, const unsigned w1, const float* h, float s) {
    const f32x2 p0 = __builtin_amdgcn_cvt_pk_f32_fp8((int)w0, false), p1 = __builtin_amdgcn_cvt_pk_f32_fp8((int)w0, true);
    const f32x2 p2 = __builtin_amdgcn_cvt_pk_f32_fp8((int)w1, false), p3 = __builtin_amdgcn_cvt_pk_f32_fp8((int)w1, true);
    s += p0.x * h[0]; s += p0.y * h[1]; s += p1.x * h[2]; s += p1.y * h[3];
    s += p2.x * h[4]; s += p2.y * h[5]; s += p3.x * h[6]; s += p3.y * h[7];
    return s;
}
__device__ __forceinline__ void phase_peer_apply(const Params& p, int layer, unsigned char* lds, bool dry) {
    const int lane = threadIdx.x & 63, wave = threadIdx.x >> 6;
    float* ldsw = (float*)lds + wave * (64 * 65);
    const bf16_t* HM = (const bf16_t*)(p.ws + WS_HM);
    const unsigned char* PU = p.ws + WS_PU; const unsigned char* PV = p.ws + WS_PV;
    const float* SU = (const float*)(p.ws + WS_PU + 24 * MiB); const float* SV = (const float*)(p.ws + WS_PV + 24 * MiB);
    const int* EXP = (const int*)(p.ws + WS_EXP); const float* GATE = (const float*)(p.ws + WS_GATE);
    const float* MOD = (const float*)(p.ws + WS_MOD);
    float* X = p.out;
    for (int t = blockIdx.x * 4 + wave; t < T; t += gridDim.x * 4) {
        const u32x4 ha = *(const u32x4*)(HM + (size_t)t * D + lane * 16), hb = *(const u32x4*)(HM + (size_t)t * D + lane * 16 + 8);
        float hf[16];
        hf[0] = bflo(ha.x); hf[1] = bfhi(ha.x); hf[2] = bflo(ha.y); hf[3] = bfhi(ha.y); hf[4] = bflo(ha.z); hf[5] = bfhi(ha.z); hf[6] = bflo(ha.w); hf[7] = bfhi(ha.w);
        hf[8] = bflo(hb.x); hf[9] = bfhi(hb.x); hf[10] = bflo(hb.y); hf[11] = bfhi(hb.y); hf[12] = bflo(hb.z); hf[13] = bfhi(hb.z); hf[14] = bflo(hb.w); hf[15] = bfhi(hb.w);
        const int e0_ = EXP[(size_t)t * 128 + lane], e1_ = EXP[(size_t)t * 128 + 64 + lane];
        const float g0 = GATE[(size_t)t * 128 + lane], g1 = GATE[(size_t)t * 128 + 64 + lane];
        const float su0 = SU[e0_], su1 = SU[e1_], sv0 = SV[e0_], sv1 = SV[e1_];
        u32x4 buf[16];
        float act0 = 0.f, act1 = 0.f;
        float acc[16];
#pragma unroll
        for (int i = 0; i < 16; ++i) acc[i] = 0.f;
#ifndef APPLY_L2PROBE
#define APPLY_L2PROBE 0
#endif
        for (int prep_ = 0; prep_ < 1 + APPLY_L2PROBE; ++prep_) {
        const int emask = (APPLY_L2PROBE && prep_ == 0) ? 2047 : 0x7fffffff;
        const int e0 = e0_ & emask, e1 = e1_ & emask;
#pragma unroll
        for (int j = 0; j < 16; ++j) { const int e_ = __builtin_amdgcn_readlane(e0, j); buf[j] = *(const u32x4*)(PU + (size_t)e_ * D + lane * 16); }
#pragma unroll
        for (int bt = 0; bt < 16; ++bt) {
#pragma unroll
            for (int j = 0; j < 16; ++j) {
                if (bt < 8) {
                    float s_ = dot8(buf[j].x, buf[j].y, hf, 0.f); s_ = dot8(buf[j].z, buf[j].w, hf + 8, s_);
                    ldsw[((bt & 3) * 16 + j) * 65 + lane] = s_;
                } else {
                    const float av_ = ((bt & 7) < 4) ? act0 : act1;
                    const float a_ = __builtin_bit_cast(float, __builtin_amdgcn_readlane(__builtin_bit_cast(int, av_), (bt & 3) * 16 + j));
                    fma8(buf[j].x, buf[j].y, a_, acc); fma8(buf[j].z, buf[j].w, a_, acc + 8);
                }
                if (bt + 1 < 16) {
                    const int nb = bt + 1;
                    const int e_ = __builtin_amdgcn_readlane(((nb & 7) < 4) ? e0 : e1, (nb & 3) * 16 + j);
                    buf[j] = *(const u32x4*)(((nb < 8) ? PU : PV) + (size_t)e_ * D + lane * 16);
                }
            }
            if (bt == 3 || bt == 7) {
                float tot_ = 0.f;
#pragma unroll 16
                for (int q = 0; q < 64; ++q) tot_ += ldsw[lane * 65 + q];
                if (bt == 3) act0 = gelu_tanh(tot_ * su0) * g0 * sv0; else act1 = gelu_tanh(tot_ * su1) * g1 * sv1;
            }
        }
        if (APPLY_L2PROBE && prep_ == 0 && p.ph_hi >= 0) {
#pragma unroll
            for (int i = 0; i < 16; ++i) acc[i] = 0.f;
        }
        }
        const int b = t / SEQ;
        const float* g2 = MOD + (size_t)(layer * 2 + b) * 6144 + 5120;
        float* xr = X + (size_t)t * D + lane * 16;
        f32x4 xs[4]; float ss = 0.f;
#pragma unroll
        for (int q = 0; q < 4; ++q) {
            const f32x4 g = *(const f32x4*)(g2 + lane * 16 + q * 4); f32x4 x = *(const f32x4*)(xr + q * 4);
            x.x += g.x * acc[q * 4 + 0]; x.y += g.y * acc[q * 4 + 1]; x.z += g.z * acc[q * 4 + 2]; x.w += g.w * acc[q * 4 + 3];
            xs[q] = x; ss += (x.x * x.x + x.y * x.y) + (x.z * x.z + x.w * x.w);
        }
        const float rs = rsqrtf(wave_sum(ss) * (1.0f / D) + RMS_EPS);
        if (!dry) {
            if (layer == 0) {
                const float* gw = p.in[2] + D + lane * 16; const float* sh = MOD + (size_t)(2 + b) * 6144 + lane * 16; const float* sc = sh + 1024;
                u32x4 o[2];
#pragma unroll
                for (int q = 0; q < 4; ++q) {
                    *(f32x4*)(xr + q * 4) = xs[q];
                    const f32x4 g = *(const f32x4*)(gw + q * 4), s1 = *(const f32x4*)(sc + q * 4), s0 = *(const f32x4*)(sh + q * 4);
                    const float y0 = xs[q].x * rs * g.x * (1.f + s1.x) + s0.x, y1 = xs[q].y * rs * g.y * (1.f + s1.y) + s0.y;
                    const float y2 = xs[q].z * rs * g.z * (1.f + s1.z) + s0.z, y3 = xs[q].w * rs * g.w * (1.f + s1.w) + s0.w;
                    if (q & 1) { o[q >> 1].z = pk2(y0, y1); o[q >> 1].w = pk2(y2, y3); } else { o[q >> 1].x = pk2(y0, y1); o[q >> 1].y = pk2(y2, y3); }
                }
                bf16_t* hm = (bf16_t*)(p.ws + WS_HM) + (size_t)t * D + lane * 16;
                *(u32x4*)hm = o[0]; *(u32x4*)(hm + 8) = o[1];
            } else {
                const float* gw = p.in[28] + lane * 16;
#pragma unroll
                for (int q = 0; q < 4; ++q) {
                    const f32x4 g = *(const f32x4*)(gw + q * 4);
                    *(f32x4*)(xr + q * 4) = (f32x4){xs[q].x * rs * g.x, xs[q].y * rs * g.y, xs[q].z * rs * g.z, xs[q].w * rs * g.w};
                }
            }
        }
    }
}
__device__ __forceinline__ void phase_tab1(const Params& p) {
    for (int it = blockIdx.x; it < 2 * P0_TAB; it += gridDim.x) {
        if (it < P0_TAB) cvt_fp8_item(p.in[26] + (size_t)PE * D, p.ws + WS_PU, (float*)(p.ws + WS_PU + 24 * MiB), it, false);
        else cvt_fp8_item(p.in[27] + (size_t)PE * D, p.ws + WS_PV, (float*)(p.ws + WS_PV + 24 * MiB), it - P0_TAB, false);
    }
}
__device__ __forceinline__ void phase_nsa_proj(const Params& p, unsigned char* lds) {
    const bf16_t* HM = (const bf16_t*)(p.ws + WS_HM); const bf16_t* WT = (const bf16_t*)(p.ws + WS_WPROJ_T);
    const f32x2* ROPE = (const f32x2*)(p.ws + WS_ROPE);
    bf16_t* Q = (bf16_t*)(p.ws + WS_Q); float* NGT = (float*)(p.ws + WS_NG);
    const int lane = threadIdx.x & 63, wid = threadIdx.x >> 6, wr = wid >> 1, wc = wid & 1, fr = lane & 15, fq = lane >> 4;
    for (int id = vblock(); id < 256 * 21; id += gridDim.x) {
        const int mt = id / 21, nt = id % 21;
        f32x4 acc[4][4];
        gemm_tile1(ALoadPlain{HM + (size_t)mt * 128 * D, (size_t)D}, WT + (size_t)nt * 128 * D, D, 16, acc, lds);
        const int c0 = nt * 128 + wc * 64;
        if (c0 >= 2624) continue;
        const int b = (mt * 128) / SEQ;
        if (c0 == 2560) {
#pragma unroll
            for (int mi = 0; mi < 4; ++mi)
#pragma unroll
                for (int ni = 0; ni < 3; ++ni) {
                    const int t = mt * 128 + wr * 64 + mi * 16 + fr;
                    const f32x4 v = acc[mi][ni];
                    *(f32x4*)(NGT + (size_t)t * 48 + ni * 16 + fq * 4) = (f32x4){sigmoidf_(v.x), sigmoidf_(v.y), sigmoidf_(v.z), sigmoidf_(v.w)};
                }
            continue;
        }
        int sec = -1, g = 0;
        if (c0 >= 1024) { sec = (c0 - 1024) >> 8; g = ((c0 - 1024) & 255) >> 6; }
        const bool dorope = (sec == -1) || (sec == 2) || (sec == 4);
        const float scl = (sec == -1) ? 0.125f : 1.0f;
        const size_t secoff[6] = {WS_KC, WS_VC, WS_KS, WS_VST, WS_KW, WS_VWT};
        size_t so = WS_Q;
#pragma unroll
        for (int q = 0; q < 6; ++q) if (sec == q) so = secoff[q];
        bf16_t* OUT = (bf16_t*)(p.ws + so);
        const bool vt = (sec == 3) || (sec == 5);
        float kblk_am = 0.f;
#pragma unroll
        for (int pass = 0; pass < 2; ++pass) {
        if (pass == 1 && sec == 2) {
#pragma unroll
            for (int o = 1; o < 64; o <<= 1) kblk_am = fmaxf(kblk_am, __shfl_xor(kblk_am, o));
            if (lane == 0) ((float*)(p.ws + WS_KS + 12 * MiB))[(size_t)(b * 4 + g) * 256 + ((mt * 128 + wr * 64 - b * SEQ) >> 6)] = kblk_am > 0.f ? kblk_am / 224.0f : 1.0f;
        }
#pragma unroll
        for (int mi = 0; mi < 4; ++mi) {
            const int t = mt * 128 + wr * 64 + mi * 16 + fr, s = t - b * SEQ;
            if (dorope && pass == 0) {
#pragma unroll
                for (int ni = 0; ni < 2; ++ni) {
                    const f32x4* rp = (const f32x4*)(ROPE + (size_t)s * 32 + ni * 16 + fq * 4);
                    const f32x4 r0 = rp[0], r1 = rp[1];
                    const f32x4 x1 = acc[mi][ni], x2 = acc[mi][ni + 2];
                    acc[mi][ni] = (f32x4){x1.x * r0.x - x2.x * r0.y, x1.y * r0.z - x2.y * r0.w, x1.z * r1.x - x2.z * r1.y, x1.w * r1.z - x2.w * r1.w};
                    acc[mi][ni + 2] = (f32x4){x1.x * r0.y + x2.x * r0.x, x1.y * r0.w + x2.y * r0.z, x1.z * r1.y + x2.z * r1.x, x1.w * r1.w + x2.w * r1.z};
                }
            }
            if (pass == 0) {
                if (sec == 2) {
#pragma unroll
                    for (int ni = 0; ni < 4; ++ni) { const f32x4 v = acc[mi][ni]; kblk_am = fmaxf(kblk_am, fmaxf(fmaxf(fabsf(v.x), fabsf(v.y)), fmaxf(fabsf(v.z), fabsf(v.w)))); }
                }
                continue;
            }
            if (sec == -1 || sec == 2) {
                float am = kblk_am;
                if (sec == -1) {
                    am = 0.f;
#pragma unroll
                    for (int ni = 0; ni < 4; ++ni) { const f32x4 v = acc[mi][ni] * scl; am = fmaxf(am, fmaxf(fmaxf(fabsf(v.x), fabsf(v.y)), fmaxf(fabsf(v.z), fabsf(v.w)))); }
                    am = fmaxf(am, __shfl_xor(am, 16)); am = fmaxf(am, __shfl_xor(am, 32));
                }
                const float qs = am > 0.f ? 224.0f / am : 1.0f;
                unsigned char* O8 = (sec == -1) ? (p.ws + WS_Q8 + (size_t)t * 1024 + c0) : (p.ws + WS_KS + ((size_t)(b * 4 + g) * SEQ + s) * 64);
#pragma unroll
                for (int ni = 0; ni < 4; ++ni) {
                    const f32x4 v = acc[mi][ni] * (scl * qs);
                    int w = 0; w = __builtin_amdgcn_cvt_pk_fp8_f32(v.x, v.y, w, false); w = __builtin_amdgcn_cvt_pk_fp8_f32(v.z, v.w, w, true);
                    *(int*)(O8 + ni * 16 + fq * 4) = w;
                }
                if (fq == 0 && sec == -1) ((float*)(p.ws + WS_Q8 + 32 * MiB))[(size_t)t * 16 + (c0 >> 6)] = am > 0.f ? am / 224.0f : 1.0f;
            }
            if (sec == 2) continue;
#pragma unroll
            for (int ni = 0; ni < 4; ++ni) {
                const f32x4 v = acc[mi][ni] * scl;
                const int d = ni * 16 + fq * 4;
                if (sec == -1) {
                    *(u32x2*)(OUT + (size_t)t * 1024 + c0 + d) = (u32x2){pk2(v.x, v.y), pk2(v.z, v.w)};
                } else if (sec == 4) {
                    const size_t idx = (size_t)(b * 4 + g) * SEQ * 64 + (size_t)(s >> 5) * 2048 + ((((s >> 4) & 1) * 2 + (ni >> 1)) * 16 + (s & 15)) * 32 + ((ni & 1) * 2 + (fq >> 1)) * 8 + (fq & 1) * 4;
                    *(u32x2*)(OUT + idx) = (u32x2){pk2(v.x, v.y), pk2(v.z, v.w)};
                } else if (!vt) {
                    *(u32x2*)(OUT + ((size_t)(b * 4 + g) * SEQ + s) * 64 + d) = (u32x2){pk2(v.x, v.y), pk2(v.z, v.w)};
                } else if (sec == 5) {
                    const int key = s & 31;
                    bf16_t* o = OUT + (size_t)(b * 4 + g) * SEQ * 64 + (size_t)(s >> 5) * 2048 + ((ni * 2 + (key >> 4)) * 16 + fq * 4) * 16 + ((key >> 2) & 3) * 4 + (key & 3);
                    o[0] = (bf16_t)f2bf(v.x); o[16] = (bf16_t)f2bf(v.y); o[32] = (bf16_t)f2bf(v.z); o[48] = (bf16_t)f2bf(v.w);
                }
            }
        }
        }
        if (sec == 3) {
            const int s0 = mt * 128 + wr * 64 - b * SEQ, jb = s0 >> 6;
            unsigned char* V8 = p.ws + WS_VST + (size_t)((b * 4 + g) * 256 + jb) * 4096;
            float am = 0.f;
#pragma unroll
            for (int mi = 0; mi < 4; ++mi)
#pragma unroll
                for (int ni = 0; ni < 4; ++ni) { const f32x4 v = acc[mi][ni]; am = fmaxf(am, fmaxf(fmaxf(fabsf(v.x), fabsf(v.y)), fmaxf(fabsf(v.z), fabsf(v.w)))); }
#pragma unroll
            for (int o = 1; o < 64; o <<= 1) am = fmaxf(am, __shfl_xor(am, o));
            const float qs = am > 0.f ? 224.0f / am : 1.0f;
            if (lane == 0) ((float*)(p.ws + WS_VST + 12 * MiB))[(size_t)(b * 4 + g) * 256 + jb] = am > 0.f ? am / 224.0f : 1.0f;
#pragma unroll
            for (int ni = 0; ni < 4; ++ni) {
                const int d = ni * 16 + fq * 4;
#pragma unroll
                for (int mi = 0; mi < 4; ++mi) {
                    const f32x4 v = acc[mi][ni] * qs;
                    int w = 0; w = __builtin_amdgcn_cvt_pk_fp8_f32(v.x, v.y, w, false); w = __builtin_amdgcn_cvt_pk_fp8_f32(v.z, v.w, w, true);
                    unsigned char* o = V8 + (size_t)d * 64 + mi * 16 + fr;
                    o[0] = (unsigned char)(w & 255); o[64] = (unsigned char)((w >> 8) & 255); o[128] = (unsigned char)((w >> 16) & 255); o[192] = (unsigned char)((unsigned)w >> 24);
                }
            }
        }
    }
}
__device__ __forceinline__ void phase_nsa_cmp1(const Params& p, unsigned char* lds) {
    bf16_t* HID = (bf16_t*)(p.ws + WS_HID);
    const float* bias = (const float*)(p.ws + WS_MISC);
    const int lane = threadIdx.x & 63, wid = threadIdx.x >> 6, wr = wid >> 1, wc = wid & 1, fr = lane & 15, fq = lane >> 4;
    for (int id = vblock(); id < 256; id += gridDim.x) {
        const int kv = id >> 7, bg = (id >> 4) & 7, mt = (id >> 1) & 7, nt = id & 1;
        const bf16_t* A = (const bf16_t*)(p.ws + (kv ? WS_VC : WS_KC)) + (size_t)bg * SEQ * 64 + (size_t)mt * 128 * 1024;
        const bf16_t* B = (const bf16_t*)(p.ws + (kv ? WS_WV1_T : WS_WK1_T)) + (size_t)nt * 128 * 2048;
        f32x4 acc[4][4];
        gemm_tile1(ALoadPlain{A, (size_t)1024}, B, 2048, 32, acc, lds);
#pragma unroll
        for (int mi = 0; mi < 4; ++mi)
#pragma unroll
            for (int ni = 0; ni < 4; ++ni) {
                const int n = mt * 128 + wr * 64 + mi * 16 + fr, c = nt * 128 + wc * 64 + ni * 16 + fq * 4;
                const f32x4 bv = *(const f32x4*)(bias + kv * 256 + c);
                const f32x4 v = acc[mi][ni] + bv;
                *(u32x2*)(HID + (((size_t)kv * 8 + bg) * 1024 + n) * 256 + c) = (u32x2){pk2(gelu_tanh(v.x), gelu_tanh(v.y)), pk2(gelu_tanh(v.z), gelu_tanh(v.w))};
            }
    }
}
__device__ __forceinline__ void phase_nsa_cmp2(const Params& p, unsigned char* lds) {
    const bf16_t* HID = (const bf16_t*)(p.ws + WS_HID);
    const f32x2* ROPE = (const f32x2*)(p.ws + WS_ROPE);
    bf16_t* KCMP = (bf16_t*)(p.ws + WS_KCMP); bf16_t* VCMPT = (bf16_t*)(p.ws + WS_VCMPT);
    const int lane = threadIdx.x & 63, wid = threadIdx.x >> 6, wr = wid >> 1, wc = wid & 1, fr = lane & 15, fq = lane >> 4;
    for (int id = vblock(); id < 128; id += gridDim.x) {
        const int kv = id >> 6, mt = id & 63;
        const bf16_t* A = HID + ((size_t)kv * 8192 + (size_t)mt * 128) * 256;
        const bf16_t* B = (const bf16_t*)(p.ws + (kv ? WS_WV2_T : WS_WK2_T));
        f32x4 acc[4][4];
        gemm_tile1(ALoadPlain{A, (size_t)256}, B, 256, 4, acc, lds);
        if (wc == 1) continue;
#pragma unroll
        for (int mi = 0; mi < 4; ++mi) {
            const int R = mt * 128 + wr * 64 + mi * 16 + fr, bg = R >> 10, n = R & 1023;
            if (kv == 0) {
                int pos = n * 16 + 31; pos = pos > SEQ - 1 ? SEQ - 1 : pos;
#pragma unroll
                for (int ni = 0; ni < 2; ++ni) {
                    const f32x4* rp = (const f32x4*)(ROPE + (size_t)pos * 32 + ni * 16 + fq * 4);
                    const f32x4 r0 = rp[0], r1 = rp[1];
                    const f32x4 x1 = acc[mi][ni], x2 = acc[mi][ni + 2];
                    acc[mi][ni] = (f32x4){x1.x * r0.x - x2.x * r0.y, x1.y * r0.z - x2.y * r0.w, x1.z * r1.x - x2.z * r1.y, x1.w * r1.z - x2.w * r1.w};
                    acc[mi][ni + 2] = (f32x4){x1.x * r0.y + x2.x * r0.x, x1.y * r0.w + x2.y * r0.z, x1.z * r1.y + x2.z * r1.x, x1.w * r1.w + x2.w * r1.z};
                }
#pragma unroll
                for (int ni = 0; ni < 4; ++ni) {
                    const f32x4 v = acc[mi][ni];
                    const size_t idx = (size_t)bg * 1024 * 64 + (size_t)(n >> 5) * 2048 + ((((n >> 4) & 1) * 2 + (ni >> 1)) * 16 + (n & 15)) * 32 + ((ni & 1) * 2 + (fq >> 1)) * 8 + (fq & 1) * 4;
                    *(u32x2*)(KCMP + idx) = (u32x2){pk2(v.x, v.y), pk2(v.z, v.w)};
                }
            } else {
#pragma unroll
                for (int ni = 0; ni < 4; ++ni) {
                    const f32x4 v = acc[mi][ni];
                    const int key = n & 31;
                    bf16_t* o = VCMPT + (size_t)bg * 1024 * 64 + (size_t)(n >> 5) * 2048 + ((ni * 2 + (key >> 4)) * 16 + fq * 4) * 16 + ((key >> 2) & 3) * 4 + (key & 3);
                    o[0] = (bf16_t)f2bf(v.x); o[16] = (bf16_t)f2bf(v.y); o[32] = (bf16_t)f2bf(v.z); o[48] = (bf16_t)f2bf(v.w);
                }
            }
        }
    }
}
__device__ __forceinline__ void phase_nsa_wo(const Params& p, unsigned char* lds, bool dry) {
    const bf16_t* O = (const bf16_t*)(p.ws + WS_O); const bf16_t* WT = (const bf16_t*)(p.ws + WS_WO_T);
    const float* MOD = (const float*)(p.ws + WS_MOD);
    float* X = p.out;
    const int lane = threadIdx.x & 63, wid = threadIdx.x >> 6, wr = wid >> 1, wc = wid & 1, fr = lane & 15, fq = lane >> 4;
    for (int id = vblock(); id < 256 * 8; id += gridDim.x) {
        const int mt = id >> 3, nt = id & 7;
        f32x4 acc[4][4];
        gemm_tile1(ALoadPlain{O + (size_t)mt * 128 * D, (size_t)D}, WT + (size_t)nt * 128 * D, D, 16, acc, lds);
        const int b = (mt * 128) / SEQ;
#pragma unroll
        for (int mi = 0; mi < 4; ++mi)
#pragma unroll
            for (int ni = 0; ni < 4; ++ni) {
                const int t = mt * 128 + wr * 64 + mi * 16 + fr, c = nt * 128 + wc * 64 + ni * 16 + fq * 4;
                const f32x4 g1 = *(const f32x4*)(MOD + (size_t)(1 * 2 + b) * 6144 + 2048 + c);
                float* xp = X + (size_t)t * D + c;
                const f32x4 x = *(const f32x4*)xp; const f32x4 v = acc[mi][ni];
                if (!dry) *(f32x4*)xp = (f32x4){x.x + g1.x * v.x, x.y + g1.y * v.y, x.z + g1.z * v.z, x.w + g1.w * v.w};
            }
    }
}
__device__ __forceinline__ bf16x8 pack8(const f32x4 a, const f32x4 b) {
    u32x4 w; w.x = pk2(a.x, a.y); w.y = pk2(a.z, a.w); w.z = pk2(b.x, b.y); w.w = pk2(b.z, b.w);
    return __builtin_bit_cast(bf16x8, w);
}
__device__ __forceinline__ bf16x8 ldv8(const bf16_t* plo, const bf16_t* phi) {
    const u32x2 lo = *(const u32x2*)plo, hi = *(const u32x2*)phi;
    u32x4 w; w.x = lo.x; w.y = lo.y; w.z = hi.x; w.w = hi.y;
    return __builtin_bit_cast(bf16x8, w);
}
__device__ __forceinline__ float red4(float v) { v += __shfl_xor(v, 16); v += __shfl_xor(v, 32); return v; }
__device__ __forceinline__ float max4(float v) { v = fmaxf(v, __shfl_xor(v, 16)); v = fmaxf(v, __shfl_xor(v, 32)); return v; }
#define NEGBIG (-1.0e30f)

__device__ __forceinline__ void phase_nsa_attn(const Params& p, unsigned char* lds, const int rep_cmp, const int rep_win, const int rep_sel) {
    const int lane = threadIdx.x & 63, wave = threadIdx.x >> 6, fr = lane & 15, fq = lane >> 4;
    unsigned char* WL = lds + wave * 18432;
    float* IMP = (float*)WL;
    int* SEL = (int*)(WL + 17408);
    const bf16_t* Q = (const bf16_t*)(p.ws + WS_Q);
    const bf16_t* KCMP = (const bf16_t*)(p.ws + WS_KCMP); const bf16_t* VCMPT = (const bf16_t*)(p.ws + WS_VCMPT);
    const bf16_t* KW = (const bf16_t*)(p.ws + WS_KW); const bf16_t* VWT = (const bf16_t*)(p.ws + WS_VWT);
    const float* NGT = (const float*)(p.ws + WS_NG);
    bf16_t* O = (bf16_t*)(p.ws + WS_O);
    const f32x4 z4 = (f32x4){0.f, 0.f, 0.f, 0.f};
    for (int bi = blockIdx.x; bi < 2048; bi += gridDim.x) {
        const int bg = bi & 7, quad = 255 - (bi >> 3), t0 = (quad * 4 + wave) * 16, b = bg >> 2, g = bg & 3;
        const int cur = t0 >> 6;
        const size_t tok = (size_t)b * SEQ + t0 + fr;
        const int tq = t0 + fr;
        bf16x8 qf[4][2];
#pragma unroll
        for (int r = 0; r < 4; ++r)
#pragma unroll
            for (int ks = 0; ks < 2; ++ks) qf[r][ks] = *(const bf16x8*)(Q + tok * 1024 + (g * 4 + r) * 64 + ks * 32 + fq * 8);
        f32x4 acc[4][4];
        for (int rep = 0; rep < rep_win; ++rep) {
            const bf16_t* kwb = KW + (size_t)bg * SEQ * 64; const bf16_t* vwb = VWT + (size_t)bg * SEQ * 64;
            float mw[4], lw[4];
#pragma unroll
            for (int r = 0; r < 4; ++r) { mw[r] = NEGBIG; lw[r] = 0.f;
#pragma unroll
                for (int df = 0; df < 4; ++df) acc[r][df] = z4; }
            int kmin = t0 - 511; kmin = kmin < 0 ? 0 : kmin; kmin &= ~31;
            bf16x8 nkf[2][2];
#define WIN_LOAD(kb_) do { _Pragma("unroll") for (int f = 0; f < 2; ++f) _Pragma("unroll") for (int ks = 0; ks < 2; ++ks) nkf[f][ks] = *(const bf16x8*)(kwb + (size_t)((kb_) >> 5) * 2048 + ((f * 2 + ks) * 16 + fr) * 32 + fq * 8); } while (0)
            WIN_LOAD(kmin);
            for (int kb = kmin; kb <= t0 + 15; kb += 32) {
                bf16x8 kf[2][2], vf[4];
#pragma unroll
                for (int f = 0; f < 2; ++f) { kf[f][0] = nkf[f][0]; kf[f][1] = nkf[f][1]; }
#pragma unroll
                for (int df = 0; df < 4; ++df) { const bf16_t* vp = vwb + (size_t)(kb >> 5) * 2048 + (df * 32 + fr) * 16 + fq * 4; vf[df] = ldv8(vp, vp + 256); }
                { const int kn = (kb + 32 <= t0 + 15) ? kb + 32 : kb; WIN_LOAD(kn); }
#pragma unroll
                for (int r = 0; r < 4; ++r) {
                    f32x4 st[2];
#pragma unroll
                    for (int f = 0; f < 2; ++f) {
                        st[f] = __builtin_amdgcn_mfma_f32_16x16x32_bf16(kf[f][0], qf[r][0], z4, 0, 0, 0);
                        st[f] = __builtin_amdgcn_mfma_f32_16x16x32_bf16(kf[f][1], qf[r][1], st[f], 0, 0, 0);
                    }
                    float mx = NEGBIG;
#pragma unroll
                    for (int f = 0; f < 2; ++f)
#pragma unroll
                        for (int e = 0; e < 4; ++e) { const int key = kb + f * 16 + fq * 4 + e; const bool ok = (key <= tq) && (key > tq - 512); if (ok) mx = fmaxf(mx, st[f][e]); }
                    mx = max4(mx);
                    const float mn = fmaxf(mw[r], mx);
                    const float al = __expf(mw[r] - mn);
                    float ps = 0.f;
#pragma unroll
                    for (int f = 0; f < 2; ++f)
#pragma unroll
                        for (int e = 0; e < 4; ++e) { const int key = kb + f * 16 + fq * 4 + e; const bool ok = (key <= tq) && (key > tq - 512); const float pv = ok ? __expf(st[f][e] - mn) : 0.f; st[f][e] = pv; ps += pv; }
                    lw[r] = lw[r] * al + ps; mw[r] = mn;
                    const bf16x8 pf = pack8(st[0], st[1]);
#pragma unroll
                    for (int df = 0; df < 4; ++df) { acc[r][df] = acc[r][df] * al; acc[r][df] = __builtin_amdgcn_mfma_f32_16x16x32_bf16(vf[df], pf, acc[r][df], 0, 0, 0); }
                    __builtin_amdgcn_sched_barrier(0);
                }
            }
#pragma unroll
            for (int r = 0; r < 4; ++r) {
                const float l = red4(lw[r]); const float sc = NGT[tok * 48 + (g * 4 + r) * 3 + 2] / l;
#pragma unroll
                for (int df = 0; df < 4; ++df) acc[r][df] = acc[r][df] * sc;
            }
#undef WIN_LOAD
        }
        const int nmax_tile = (t0 >> 4) - 1, nmax_lane = (t0 >> 4) - 2 + (fr == 15 ? 1 : 0);
        const bf16_t* kcb = KCMP + (size_t)bg * 1024 * 64; const bf16_t* vcb = VCMPT + (size_t)bg * 64 * 1024;
        for (int rep = 0; rep < rep_cmp; ++rep) {
            const bool dry = (rep + 1 < rep_cmp);
            float mc[4], lc[4], invl[4];
#pragma unroll
            for (int r = 0; r < 4; ++r) { mc[r] = NEGBIG; lc[r] = 0.f; }
            bf16x8 nkc[2][2], nvc[4];
#define CMPK_LOAD(nb_) do { _Pragma("unroll") for (int f = 0; f < 2; ++f) _Pragma("unroll") for (int ks = 0; ks < 2; ++ks) nkc[f][ks] = *(const bf16x8*)(kcb + (size_t)((nb_) >> 5) * 2048 + ((f * 2 + ks) * 16 + fr) * 32 + fq * 8); } while (0)
#define CMPV_LOAD(nb_) do { _Pragma("unroll") for (int df = 0; df < 4; ++df) { const bf16_t* vp = vcb + (size_t)((nb_) >> 5) * 2048 + (df * 32 + fr) * 16 + fq * 4; nvc[df] = ldv8(vp, vp + 256); } } while (0)
            CMPK_LOAD(0);
            for (int nb = 0; nb <= nmax_tile; nb += 32) {
                bf16x8 kf[2][2];
#pragma unroll
                for (int f = 0; f < 2; ++f) { kf[f][0] = nkc[f][0]; kf[f][1] = nkc[f][1]; }
                { const int nn = (nb + 32 <= nmax_tile) ? nb + 32 : 0; CMPK_LOAD(nn); }
#pragma unroll
                for (int r = 0; r < 4; ++r) {
                    f32x4 st[2];
#pragma unroll
                    for (int f = 0; f < 2; ++f) {
                        st[f] = __builtin_amdgcn_mfma_f32_16x16x32_bf16(kf[f][0], qf[r][0], z4, 0, 0, 0);
                        st[f] = __builtin_amdgcn_mfma_f32_16x16x32_bf16(kf[f][1], qf[r][1], st[f], 0, 0, 0);
                    }
                    float mx = NEGBIG;
#pragma unroll
                    for (int f = 0; f < 2; ++f)
#pragma unroll
                        for (int e = 0; e < 4; ++e) { const int n = nb + f * 16 + fq * 4 + e; if (n <= nmax_lane) mx = fmaxf(mx, st[f][e]); }
                    mx = max4(mx);
                    const float mn = fmaxf(mc[r], mx);
                    float ps = 0.f;
#pragma unroll
                    for (int f = 0; f < 2; ++f)
#pragma unroll
                        for (int e = 0; e < 4; ++e) { const int n = nb + f * 16 + fq * 4 + e; if (n <= nmax_lane) ps += __expf(st[f][e] - mn); }
                    lc[r] = lc[r] * __expf(mc[r] - mn) + ps; mc[r] = mn;
                    __builtin_amdgcn_sched_barrier(0);
                }
            }
#pragma unroll
            for (int r = 0; r < 4; ++r) { const float l = red4(lc[r]); invl[r] = l > 0.f ? 1.0f / l : 0.f; }
            for (int i = lane; i < 16 * 260; i += 64) IMP[i] = 0.f;
            float carry = 0.f;
            float gc[4];
#pragma unroll
            for (int r = 0; r < 4; ++r) gc[r] = NGT[tok * 48 + (g * 4 + r) * 3];
            for (int nb = 0; nb <= nmax_tile; nb += 32) {
                bf16x8 kf[2][2], vf[4];
#pragma unroll
                for (int f = 0; f < 2; ++f) { kf[f][0] = nkc[f][0]; kf[f][1] = nkc[f][1]; }
                CMPV_LOAD(nb);
#pragma unroll
                for (int df = 0; df < 4; ++df) vf[df] = nvc[df];
                { const int nn = (nb + 32 <= nmax_tile) ? nb + 32 : nb; CMPK_LOAD(nn); }
                f32x4 pg[2] = {z4, z4};
#pragma unroll
                for (int r = 0; r < 4; ++r) {
                    f32x4 st[2];
#pragma unroll
                    for (int f = 0; f < 2; ++f) {
                        st[f] = __builtin_amdgcn_mfma_f32_16x16x32_bf16(kf[f][0], qf[r][0], z4, 0, 0, 0);
                        st[f] = __builtin_amdgcn_mfma_f32_16x16x32_bf16(kf[f][1], qf[r][1], st[f], 0, 0, 0);
#pragma unroll
                        for (int e = 0; e < 4; ++e) { const int n = nb + f * 16 + fq * 4 + e; st[f][e] = (n <= nmax_lane) ? __expf(st[f][e] - mc[r]) * invl[r] : 0.f; }
                        pg[f] += st[f];
                    }
                    const float gg = dry ? 0.f : gc[r];
                    const bf16x8 pf = pack8(st[0] * gg, st[1] * gg);
#pragma unroll
                    for (int df = 0; df < 4; ++df) acc[r][df] = __builtin_amdgcn_mfma_f32_16x16x32_bf16(vf[df], pf, acc[r][df], 0, 0, 0);
                    __builtin_amdgcn_sched_barrier(0);
                }
                const int src = (lane - 16) & 63;
                const float s0 = __shfl(pg[0].w, src), s1 = __shfl(pg[1].w, src), sc = __shfl(carry, src);
                const float prev0 = fq > 0 ? s0 : sc, prev1 = fq > 0 ? s1 : s0;
                const float imp0 = (pg[0].x + pg[0].y) + (pg[0].z + pg[0].w) + prev0;
                const float imp1 = (pg[1].x + pg[1].y) + (pg[1].z + pg[1].w) + prev1;
                const int jb = (nb >> 2) + fq;
                IMP[fr * 260 + jb] = imp0; IMP[fr * 260 + jb + 4] = imp1;
                carry = pg[1].w;
            }
#undef CMPK_LOAD
#undef CMPV_LOAD
        }
        {
            const int nf = cur >= 2 ? 3 : cur + 1;
            if (fq == 0) {
                SEL[fr * 16 + 0] = 0;
                if (cur == 1) SEL[fr * 16 + 1] = 1;
                if (cur >= 2) { SEL[fr * 16 + 1] = cur - 1; SEL[fr * 16 + 2] = cur; }
            }
            const int ncand = cur >= 3 ? cur - 2 : 0, extra = 16 - nf;
            if (ncand <= extra) {
                if (fq == 0) { for (int k = 0; k < extra; ++k) SEL[fr * 16 + nf + k] = (k < ncand) ? 1 + k : -1; }
            } else {
                for (int rnd = 0; rnd < extra; ++rnd) {
                    float bv = -1.0f; int bj = 1 << 20;
                    for (int jb = 1 + fq; jb <= cur - 2; jb += 4) { const float v = IMP[fr * 260 + jb]; if (v > bv) { bv = v; bj = jb; } }
#pragma unroll
                    for (int o = 16; o <= 32; o <<= 1) {
                        const float ov = __shfl_xor(bv, o); const int oj = __shfl_xor(bj, o);
                        if (ov > bv || (ov == bv && oj < bj)) { bv = ov; bj = oj; }
                    }
                    if (fq == 0) SEL[fr * 16 + nf + rnd] = bj;
                    if (((bj - 1) & 3) == fq) IMP[fr * 260 + bj] = -2.0f;
                }
            }
        }
#pragma unroll
        for (int r = 0; r < 4; ++r)
#pragma unroll
            for (int df = 0; df < 4; ++df) {
                const f32x4 v = acc[r][df];
                *(u32x2*)(O + tok * 1024 + (g * 4 + r) * 64 + df * 16 + fq * 4) = (u32x2){pk2(v.x, v.y), pk2(v.z, v.w)};
            }
        asm volatile("s_waitcnt vmcnt(0)" ::: "memory");
        unsigned selp[4];
        {
            const u32x4* sp = (const u32x4*)(SEL + fr * 16);
#pragma unroll
            for (int q = 0; q < 4; ++q) { const u32x4 w = sp[q]; selp[q] = (w.x & 255u) | ((w.y & 255u) << 8) | ((w.z & 255u) << 16) | ((w.w & 255u) << 24); }
        }
        for (int rep = 0; rep < rep_sel; ++rep) {
            const bool dry = (rep + 1 < rep_sel);
            const unsigned char* k8b = p.ws + WS_KS + (size_t)bg * SEQ * 64; const unsigned char* v8b = p.ws + WS_VST + (size_t)bg * 256 * 4096;
            const float* skb = (const float*)(p.ws + WS_KS + 12 * MiB) + (size_t)bg * 256; const float* svb = (const float*)(p.ws + WS_VST + 12 * MiB) + (size_t)bg * 256;
            const unsigned char* Q8 = p.ws + WS_Q8; const float* SQ8 = (const float*)(p.ws + WS_Q8 + 32 * MiB);
            const int nv = cur + 1 < 16 ? cur + 1 : 16, npair = (nv + 1) >> 1, total = 16 * npair;
            const int lrow = lane >> 2, lch = lane & 3;
            const int woff = lrow * 72 + lch * 16;
            const int rr = fr & 3;
            u32x4 sk[2][4], sv[2][4]; float ssk[2], ssv[2];
            int jbn[2];
#define SEL_GET(tokI, slotK) ((int)(((unsigned)__builtin_amdgcn_readlane((int)(((slotK) >> 2) == 0 ? selp[0] : ((slotK) >> 2) == 1 ? selp[1] : ((slotK) >> 2) == 2 ? selp[2] : selp[3]), (tokI)) >> (((slotK) & 3) * 8)) & 255u))
#define SEL_ISSUE(tokI, pairP) do { \
                const int k0_ = 2 * (pairP), k1_ = (2 * (pairP) + 1 < nv) ? 2 * (pairP) + 1 : k0_; \
                jbn[0] = SEL_GET(tokI, k0_); jbn[1] = SEL_GET(tokI, k1_); \
                _Pragma("unroll") for (int u = 0; u < 2; ++u) { \
                    const unsigned char* kb_ = k8b + (size_t)jbn[u] * 4096; const unsigned char* vb_ = v8b + (size_t)jbn[u] * 4096; \
                    _Pragma("unroll") for (int j = 0; j < 4; ++j) { sk[u][j] = *(const u32x4*)(kb_ + j * 1024 + lane * 16); sv[u][j] = *(const u32x4*)(vb_ + j * 1024 + lane * 16); } \
                    ssk[u] = skb[jbn[u]]; ssv[u] = svb[jbn[u]]; } } while (0)
            SEL_ISSUE(0, 0);
            long qs8[2] = {0, 0};
            float sq = 0.f, ms = NEGBIG, ls = 0.f;
            f32x4 os[4] = {z4, z4, z4, z4};
            u32x2 oprev[4] = {(u32x2){0u, 0u}, (u32x2){0u, 0u}, (u32x2){0u, 0u}, (u32x2){0u, 0u}};
            int i = 0, pp = 0;
            for (int v = 0; v < total; ++v) {
                const int jb0 = jbn[0], jb1 = jbn[1];
                const bool second_valid = (2 * pp + 1 < nv);
                const float ck0 = ssk[0], ck1 = ssk[1], cv0 = ssv[0], cv1 = ssv[1];
#pragma unroll
                for (int u = 0; u < 2; ++u)
#pragma unroll
                    for (int j = 0; j < 4; ++j) {
                        unsigned char* kd = WL + u * 9216 + woff + j * 1152; unsigned char* vd = kd + 4608;
                        *(u32x2*)kd = (u32x2){sk[u][j].x, sk[u][j].y}; *(u32x2*)(kd + 8) = (u32x2){sk[u][j].z, sk[u][j].w};
                        *(u32x2*)vd = (u32x2){sv[u][j].x, sv[u][j].y}; *(u32x2*)(vd + 8) = (u32x2){sv[u][j].z, sv[u][j].w};
                    }
                if (v + 1 < total) {
                    int p2 = pp + 1, i2 = i; if (p2 == npair) { p2 = 0; i2 = i + 1; }
                    SEL_ISSUE(i2, p2);
                }
                __builtin_amdgcn_sched_barrier(0);
                const int ti = t0 + i;
                if (pp == 0) {
                    const size_t tk = (size_t)b * SEQ + ti;
#pragma unroll
                    for (int ks = 0; ks < 2; ++ks) qs8[ks] = *(const long*)(Q8 + tk * 1024 + (g * 4 + rr) * 64 + ks * 32 + fq * 8);
                    sq = SQ8[tk * 16 + g * 4 + rr] * 1.4426950408889634f;
                    ms = NEGBIG; ls = 0.f;
#pragma unroll
                    for (int df = 0; df < 4; ++df) { os[df] = z4; oprev[df] = *(const u32x2*)(O + tk * 1024 + (g * 4 + rr) * 64 + df * 16 + fq * 4); }
                }
                f32x4 st[2][4];
#pragma unroll
                for (int u = 0; u < 2; ++u)
#pragma unroll
                    for (int f = 0; f < 4; ++f) {
                        const unsigned char* kp = WL + u * 9216 + (f * 16 + fr) * 72 + fq * 8;
                        const long k0 = *(const long*)kp, k1 = *(const long*)(kp + 32);
                        st[u][f] = __builtin_amdgcn_mfma_f32_16x16x32_fp8_fp8(k0, qs8[0], z4, 0, 0, 0);
                        st[u][f] = __builtin_amdgcn_mfma_f32_16x16x32_fp8_fp8(k1, qs8[1], st[u][f], 0, 0, 0);
                    }
                const float c0_ = sq * ck0, c1_ = sq * ck1;
                if (jb0 == cur || jb1 == cur || !second_valid) {
#pragma unroll
                    for (int u = 0; u < 2; ++u) {
                        const int jbu = u ? jb1 : jb0;
                        const bool allbad = (u == 1) && !second_valid;
#pragma unroll
                        for (int f = 0; f < 4; ++f)
#pragma unroll
                            for (int e = 0; e < 4; ++e) { const int key = jbu * 64 + f * 16 + fq * 4 + e; if (allbad || key > ti) st[u][f][e] = NEGBIG; }
                    }
                }
                float mx0 = NEGBIG, mx1 = NEGBIG;
#pragma unroll
                for (int f = 0; f < 4; ++f) { mx0 = fmaxf(mx0, fmaxf(fmaxf(st[0][f].x, st[0][f].y), fmaxf(st[0][f].z, st[0][f].w))); mx1 = fmaxf(mx1, fmaxf(fmaxf(st[1][f].x, st[1][f].y), fmaxf(st[1][f].z, st[1][f].w))); }
                const float mx = max4(fmaxf(mx0 > -1.0e29f ? mx0 * c0_ : NEGBIG, mx1 > -1.0e29f ? mx1 * c1_ : NEGBIG));
                const float mn = fmaxf(ms, mx);
                const float al = __builtin_amdgcn_exp2f(ms - mn);
                const float off = 8.0f - mn;
                float ps = 0.f;
#pragma unroll
                for (int u = 0; u < 2; ++u) {
                    const float cu = u ? c1_ : c0_;
#pragma unroll
                    for (int f = 0; f < 4; ++f)
#pragma unroll
                        for (int e = 0; e < 4; ++e) { const float pv = (st[u][f][e] > -1.0e29f) ? __builtin_amdgcn_exp2f(st[u][f][e] * cu + off) : 0.f; st[u][f][e] = pv; ps += pv; }
                }
                ls = ls * al + ps; ms = mn;
#pragma unroll
                for (int df = 0; df < 4; ++df) os[df] = os[df] * al;
#pragma unroll
                for (int u = 0; u < 2; ++u) {
                    f32x4 pvacc[4] = {z4, z4, z4, z4};
#pragma unroll
                    for (int s = 0; s < 2; ++s) {
                        int w0 = 0, w1 = 0;
                        w0 = __builtin_amdgcn_cvt_pk_fp8_f32(st[u][2 * s].x, st[u][2 * s].y, w0, false); w0 = __builtin_amdgcn_cvt_pk_fp8_f32(st[u][2 * s].z, st[u][2 * s].w, w0, true);
                        w1 = __builtin_amdgcn_cvt_pk_fp8_f32(st[u][2 * s + 1].x, st[u][2 * s + 1].y, w1, false); w1 = __builtin_amdgcn_cvt_pk_fp8_f32(st[u][2 * s + 1].z, st[u][2 * s + 1].w, w1, true);
                        const long pf = (long)(((unsigned long long)(unsigned)w1 << 32) | (unsigned long long)(unsigned)w0);
#pragma unroll
                        for (int df = 0; df < 4; ++df) {
                            const unsigned char* vp = WL + u * 9216 + 4608 + (df * 16 + fr) * 72 + 32 * s + 4 * fq;
                            const unsigned lo = *(const unsigned*)vp, hi = *(const unsigned*)(vp + 16);
                            const long vf = (long)(((unsigned long long)hi << 32) | (unsigned long long)lo);
                            pvacc[df] = __builtin_amdgcn_mfma_f32_16x16x32_fp8_fp8(vf, pf, pvacc[df], 0, 0, 0);
                        }
                    }
                    const float cvu = u ? cv1 : cv0;
#pragma unroll
                    for (int df = 0; df < 4; ++df) os[df] = os[df] + pvacc[df] * cvu;
                    __builtin_amdgcn_sched_barrier(0);
                }
                if (pp == npair - 1) {
                    const float l = red4(ls);
                    const float gsv = NGT[((size_t)b * SEQ + ti) * 48 + (g * 4 + rr) * 3 + 1];
                    const float sc = gsv / l;
                    if (fr < 4 && !dry) {
                        bf16_t* op = O + ((size_t)b * SEQ + ti) * 1024 + (g * 4 + fr) * 64 + fq * 4;
#pragma unroll
                        for (int df = 0; df < 4; ++df) {
                            const f32x4 val = os[df] * sc; const u32x2 c = oprev[df];
                            *(u32x2*)(op + df * 16) = (u32x2){pk2(bflo(c.x) + val.x, bfhi(c.x) + val.y), pk2(bflo(c.y) + val.z, bfhi(c.y) + val.w)};
                        }
                    }
                }
                ++pp; if (pp == npair) { pp = 0; ++i; }
            }
#undef SEL_GET
#undef SEL_ISSUE
        }
    }
}
constexpr int NPHASES = 23;
#ifndef PROBE_PHASE
#define PROBE_PHASE (-1)
#endif
#ifndef ATT_REP_CMP
#define ATT_REP_CMP 1
#endif
#ifndef ATT_REP_WIN
#define ATT_REP_WIN 1
#endif
#ifndef ATT_REP_SEL
#define ATT_REP_SEL 1
#endif
#ifndef TS_PHASE
#define TS_PHASE (-1)
#endif
#ifndef TS_MULT
#define TS_MULT 4
#endif
#ifndef PROBE_REPS
#define PROBE_REPS 1
#endif
__global__ void __launch_bounds__(NTHREADS, 2) mega(Params p) {
    __shared__ __attribute__((aligned(16))) unsigned char lds[LDS_BYTES];
    __shared__ __attribute__((aligned(16))) unsigned bar_st[4];
    cg::grid_group grid = cg::this_grid();
    const float* MOD = (const float*)(p.ws + WS_MOD);
    bf16_t* HM = (bf16_t*)(p.ws + WS_HM);
    if (threadIdx.x < 4) bar_st[threadIdx.x] = 0u;
    __syncthreads();
    XcdBarrier bar = xcd_barrier_post((unsigned*)(p.ws + WS_CTL), (volatile LAS unsigned*)bar_st);
    const int lo = p.ph_lo, hi = p.ph_hi;
    const bool dry0 = (p.ph_hi < 0);
    const int opq = (p.ph_hi < 0) ? 1 : 0;
    unsigned long long ts_a = 0ull, ts_b = 0ull;
#define PHASE(k, call, drycall) if (lo <= (k) && (k) < hi) { \
        if (TS_PHASE == (k)) ts_a = __builtin_amdgcn_s_memrealtime(); \
        if (PROBE_PHASE == (k)) { for (int rep = 0; rep < PROBE_REPS; ++rep) { const bool dry = !dry0; drycall; __syncthreads(); } } \
        { const bool dry = dry0; call; } \
        if ((k) + 1 < hi) { if ((k) == 0) grid.sync(); else xcd_barrier(bar); } \
        if (TS_PHASE == (k)) ts_b = __builtin_amdgcn_s_memrealtime(); }
    PHASE(0, phase_prep(p, (float*)lds), phase_prep(p, (float*)lds))
    PHASE(1, phase_norm(p, p.in[0], p.in[2], MOD + 0, MOD + 1024, HM), phase_norm(p, p.in[0], p.in[2], MOD + 0, MOD + 1024, HM))
    PHASE(2, phase_s5_win(p, lds), phase_s5_win(p, lds))
    PHASE(3, phase_s5_a(p, lds), phase_s5_a(p, lds))
    PHASE(4, phase_s5_scan(p), phase_s5_scan(p))
    PHASE(5, phase_s5_b(p, lds), phase_s5_b(p, lds))
    PHASE(6, phase_s5_glu(p, lds), phase_s5_glu(p, lds))
    PHASE(7, phase_norm(p, p.out, p.in[3], MOD + 3072, MOD + 4096, HM), phase_norm(p, p.out, p.in[3], MOD + 3072, MOD + 4096, HM))
    PHASE(8, phase_peer_wq(p, 0, lds), phase_peer_wq(p, 0, lds))
    PHASE(9, phase_peer_topk(p, 0, lds), phase_peer_topk(p, 0, lds))
    PHASE(10, phase_peer_combine(p, lds), phase_peer_combine(p, lds))
    PHASE(11, phase_peer_apply(p, 0, lds, dry), phase_peer_apply(p, 0, lds, dry))
    PHASE(12, phase_tab1(p), phase_tab1(p))
    PHASE(13, phase_nsa_proj(p, lds), phase_nsa_proj(p, lds))
    PHASE(14, phase_nsa_cmp1(p, lds), phase_nsa_cmp1(p, lds))
    PHASE(15, phase_nsa_cmp2(p, lds), phase_nsa_cmp2(p, lds))
    PHASE(16, phase_nsa_attn(p, lds, ATT_REP_CMP + opq, ATT_REP_WIN + opq, ATT_REP_SEL + opq), phase_nsa_attn(p, lds, 1 + opq, 1 + opq, 1 + opq))
    PHASE(17, phase_nsa_wo(p, lds, dry), phase_nsa_wo(p, lds, dry))
    PHASE(18, phase_norm(p, p.out, p.in[3] + D, MOD + 2 * 6144 + 3072, MOD + 2 * 6144 + 4096, HM), phase_norm(p, p.out, p.in[3] + D, MOD + 2 * 6144 + 3072, MOD + 2 * 6144 + 4096, HM))
    PHASE(19, phase_peer_wq(p, 1, lds), phase_peer_wq(p, 1, lds))
    PHASE(20, phase_peer_topk(p, 1, lds), phase_peer_topk(p, 1, lds))
    PHASE(21, phase_peer_combine(p, lds), phase_peer_combine(p, lds))
    PHASE(22, phase_peer_apply(p, 1, lds, dry), phase_peer_apply(p, 1, lds, dry))
#undef PHASE
    if (TS_PHASE >= 0 && blockIdx.x == 0 && threadIdx.x == 0) {
        const unsigned long long t0 = __builtin_amdgcn_s_memrealtime(), want = (ts_b - ts_a) * TS_MULT;
        while (__builtin_amdgcn_s_memrealtime() - t0 < want) __builtin_amdgcn_s_sleep(8);
    }
}

extern "C" void kernel_launch(void* const* d_in, const int* in_sizes, int n_in, void* d_out, int out_size, void* d_ws, size_t ws_size, hipStream_t stream) {
    static int grid_blocks = 0;
    if (!grid_blocks) {
        int dev = 0, cus = 0, per_cu = 0;
        hipGetDevice(&dev);
        hipDeviceGetAttribute(&cus, hipDeviceAttributeMultiprocessorCount, dev);
        hipOccupancyMaxActiveBlocksPerMultiprocessor(&per_cu, mega, NTHREADS, 0);
        if (per_cu > 2) per_cu = 2;
        if (per_cu < 1) per_cu = 1;
        grid_blocks = cus * per_cu;
        if (ws_size < WS_END) fprintf(stderr, "kernel_launch: workspace too small: %zu < %zu\n", ws_size, (size_t)WS_END);
        if (n_in != 29) fprintf(stderr, "kernel_launch: expected 29 inputs, got %d\n", n_in);
    }
    hipMemsetAsync((unsigned char*)d_ws + WS_CTL, 0, 16384, stream);
    Params p{};
    for (int i = 0; i < 29; ++i) p.in[i] = (const float*)d_in[i];
    p.out = (float*)d_out; p.ws = (unsigned char*)d_ws;
#if SINGLE_LAUNCH
    p.ph_lo = 0; p.ph_hi = NPHASES;
    void* args[] = {&p};
    hipError_t e = hipLaunchCooperativeKernel((void*)mega, dim3(grid_blocks), dim3(NTHREADS), args, 0, stream);
    if (e != hipSuccess) fprintf(stderr, "cooperative launch failed: %s (grid %d)\n", hipGetErrorString(e), grid_blocks);
#else
    for (int ph = 0; ph < NPHASES; ++ph) {
        p.ph_lo = ph; p.ph_hi = ph + 1;
        hipLaunchKernelGGL(mega, dim3(grid_blocks), dim3(NTHREADS), 0, stream, p);
    }
#endif
}
```

```cpp
#include <hip/hip_runtime.h>
#include <hip/hip_cooperative_groups.h>
#include <cstdio>
#include <cstdint>
namespace cg = cooperative_groups;

#ifndef SINGLE_LAUNCH
#define SINGLE_LAUNCH 1
#endif

typedef unsigned short bf16_t;
typedef short bf16x8 __attribute__((ext_vector_type(8)));
typedef float f32x4 __attribute__((ext_vector_type(4)));
typedef float f32x2 __attribute__((ext_vector_type(2)));
typedef unsigned u32x4 __attribute__((ext_vector_type(4)));
typedef unsigned u32x2 __attribute__((ext_vector_type(2)));
typedef __bf16 bf16x2_t __attribute__((ext_vector_type(2)));

constexpr int D = 1024, BATCH = 2, SEQ = 16384, T = BATCH * SEQ;
constexpr int NTHREADS = 256;
constexpr float RMS_EPS = 1e-6f;
constexpr int S5G = 64, S5P = 64, S5L = 32, S5NCH = T / S5L  , S5CPB = SEQ / S5L  ;
constexpr int NH = 16, HD = 64, NG = 4, NPROJ = 2608, NPROJ_PAD = 2688, NC = 1023, NSB = 256;
constexpr int PH = 8, PK = 16, PNK = 128, PE = 16384;

constexpr size_t MiB = 1ull << 20;
constexpr size_t WS_CTL = 0;
constexpr size_t WS_MOD = 1 * MiB;
constexpr size_t WS_WIN_T = 2 * MiB;
constexpr size_t WS_WGLU_T = 4 * MiB;
constexpr size_t WS_WPROJ_T = 8 * MiB;
constexpr size_t WS_WK1_T = 14 * MiB;
constexpr size_t WS_WV1_T = 15 * MiB;
constexpr size_t WS_WK2_T = 16 * MiB;
constexpr size_t WS_WV2_T = 16 * MiB + 512 * 1024;
constexpr size_t WS_WO_T = 17 * MiB;
constexpr size_t WS_WQ_T = 19 * MiB;
constexpr size_t WS_SUBK = 27 * MiB;
constexpr size_t WS_ROPE = 28 * MiB;
constexpr size_t WS_MISC = 32 * MiB;
constexpr size_t WS_TW = 33 * MiB;
constexpr size_t WS_VG = 73 * MiB;
constexpr size_t WS_PU = 82 * MiB;
constexpr size_t WS_PV = 114 * MiB;
constexpr size_t WS_HM = 146 * MiB;
constexpr size_t WS_C = 210 * MiB;
constexpr size_t WS_UG = WS_C;
constexpr size_t WS_YI = WS_C + 64 * MiB;
constexpr size_t WS_WST = WS_C + 128 * MiB;
constexpr size_t WS_SST = WS_C + 160 * MiB;
constexpr size_t WS_YG = WS_C + 176 * MiB;
constexpr size_t WS_QK = WS_C;
constexpr size_t WS_TOPS = WS_C + 128 * MiB;
constexpr size_t WS_TOPI = WS_C + 160 * MiB;
constexpr size_t WS_EXP = WS_C + 192 * MiB;
constexpr size_t WS_GATE = WS_C + 208 * MiB;
constexpr size_t WS_ACT = WS_C + 224 * MiB;
constexpr size_t WS_Q = WS_C;
constexpr size_t WS_KC = WS_C + 64 * MiB;
constexpr size_t WS_VC = WS_C + 81 * MiB;
constexpr size_t WS_KS = WS_C + 98 * MiB;
constexpr size_t WS_VST = WS_C + 114 * MiB;
constexpr size_t WS_KW = WS_C + 130 * MiB;
constexpr size_t WS_VWT = WS_C + 146 * MiB;
constexpr size_t WS_NG = WS_C + 162 * MiB;
constexpr size_t WS_KCMP = WS_C + 170 * MiB;
constexpr size_t WS_VCMPT = WS_C + 171 * MiB;
constexpr size_t WS_HID = WS_C + 172 * MiB;
constexpr size_t WS_O = WS_C + 182 * MiB;
constexpr size_t WS_Q8 = WS_C + 246 * MiB;
constexpr size_t WS_END = WS_C + 282 * MiB;

constexpr int LDS_BYTES = 73728;

struct Params {
    const float* in[29];
    float* out;
    unsigned char* ws;
    int ph_lo, ph_hi;
};

__device__ __forceinline__ unsigned f2bf(float f) { unsigned u = __builtin_bit_cast(unsigned, f); return (u + 0x7fffu + ((u >> 16) & 1u)) >> 16; }
__device__ __forceinline__ unsigned pk2(float lo, float hi) { return f2bf(lo) | (f2bf(hi) << 16); }
__device__ __forceinline__ float bf2f(unsigned h) { return __builtin_bit_cast(float, h << 16); }
__device__ __forceinline__ float bflo(unsigned w) { return __builtin_bit_cast(float, w << 16); }
__device__ __forceinline__ float bfhi(unsigned w) { return __builtin_bit_cast(float, w & 0xffff0000u); }
__device__ __forceinline__ float gelu_tanh(float x) {
    const float u = 0.7978845608028654f * (x + 0.044715f * x * x * x);
    const float e = __expf(2.0f * u);
    const float th = 1.0f - 2.0f / (e + 1.0f);
    return 0.5f * x * (1.0f + th);
}
__device__ __forceinline__ float sigmoidf_(float x) { return 1.0f / (1.0f + __expf(-x)); }
__device__ __forceinline__ float wave_sum(float v) {
#pragma unroll
    for (int o = 1; o < 64; o <<= 1) v += __shfl_xor(v, o);
    return v;
}
__device__ __forceinline__ float dot2bf(unsigned a, unsigned b, float acc) {
    return __builtin_amdgcn_fdot2_f32_bf16(__builtin_bit_cast(bf16x2_t, a), __builtin_bit_cast(bf16x2_t, b), acc, false);
}

#define LAS __attribute__((address_space(3)))
#define XB_TMO      128
#define XB_XCNT(j)  (256  + 64 * (j))
#define XB_XSUB(j)  (1280 + 64 * (j))
#define XB_XGEN(j)  (2304 + 64 * (j))
#define XB_TOP      3328
#define XB_TOPGEN   3392
#define XCD_BAR_WORDS 3456
#define XB_SPIN_CAP (1u << 24)

__device__ __forceinline__ unsigned xb_ld(unsigned* p)              { return __hip_atomic_load(p, __ATOMIC_RELAXED, __HIP_MEMORY_SCOPE_AGENT); }
__device__ __forceinline__ unsigned xb_add(unsigned* p, unsigned v) { return __hip_atomic_fetch_add(p, v, __ATOMIC_RELAXED, __HIP_MEMORY_SCOPE_AGENT); }
__device__ __forceinline__ unsigned xb_xcc_id() { return (unsigned)__builtin_amdgcn_s_getreg((3 << 11) | 20) & 0xFu; }
#define XB_SPIN(cond, bar) do { unsigned _sp = 0; while (cond) { __builtin_amdgcn_s_sleep(1); \
    if ((++_sp & 255u) == 0u) { if (xb_ld(&(bar)[XB_TMO])) break; if (_sp > XB_SPIN_CAP) { atomicAdd(&(bar)[XB_TMO], 1u); break; } } } } while (0)

struct XcdBarrier {
    unsigned* bar; unsigned x;
    volatile LAS unsigned* st;
};

__device__ __forceinline__ XcdBarrier xcd_barrier_post(unsigned* bar, volatile LAS unsigned* st) {
    XcdBarrier b; b.bar = bar; b.x = xb_xcc_id(); b.st = st;
    if (threadIdx.x == 0) (void)xb_add(&bar[XB_XCNT(b.x)], 1u);
    return b;
}
__device__ __forceinline__ void xcd_barrier_complete(unsigned* bar, unsigned x, unsigned& nloc, unsigned& nx) {
    const unsigned G = gridDim.x * gridDim.y * gridDim.z;
    unsigned sum, cnt, mine, sp = 0u;
    for (;;) {
        sum = 0u; cnt = 0u; mine = 0u;
#pragma unroll
        for (unsigned j = 0; j < 16; ++j) { const unsigned c = xb_ld(&bar[XB_XCNT(j)]); sum += c; cnt += (c > 0u) ? 1u : 0u; mine = (j == x) ? c : mine; }
        if (sum == G) break;
        __builtin_amdgcn_s_sleep(1);
        if ((++sp & 255u) == 0u) { if (xb_ld(&bar[XB_TMO])) break; if (sp > XB_SPIN_CAP) { atomicAdd(&bar[XB_TMO], 1u); break; } }
    }
    nloc = mine > 0u ? mine : 1u; nx = cnt > 0u ? cnt : 1u;
}

__device__ __forceinline__ void xcd_barrier(const XcdBarrier& b) {
    asm volatile("s_waitcnt vmcnt(0)" ::: "memory");
    __syncthreads();
    if (threadIdx.x == 0) {
        unsigned* bar = b.bar;
        __builtin_amdgcn_s_waitcnt(0);
        unsigned nloc = b.st[0], nx = b.st[1];
        if (nloc == 0u) { xcd_barrier_complete(bar, b.x, nloc, nx); b.st[0] = nloc; b.st[1] = nx; }
        const unsigned old = xb_add(&bar[XB_XSUB(b.x)], 1u);
        const unsigned gen = old / nloc;
        if (old + 1u == (gen + 1u) * nloc) {
            __builtin_amdgcn_fence(__ATOMIC_RELEASE, "agent");
            asm volatile("s_waitcnt vmcnt(0)" ::: "memory");
            const unsigned og = xb_add(&bar[XB_TOP], 1u);
            const unsigned tg = og / nx;
            if (og + 1u == (tg + 1u) * nx) xb_add(&bar[XB_TOPGEN], 1u);
            else XB_SPIN(xb_ld(&bar[XB_TOPGEN]) == tg, bar);
            __builtin_amdgcn_fence(__ATOMIC_ACQUIRE, "agent");
            xb_add(&bar[XB_XGEN(b.x)], 1u);
            asm volatile("s_waitcnt vmcnt(0)" ::: "memory");
        } else {
            XB_SPIN(xb_ld(&bar[XB_XGEN(b.x)]) == gen, bar);
            __builtin_amdgcn_fence(__ATOMIC_ACQUIRE, "agent");
            asm volatile("s_waitcnt vmcnt(0)" ::: "memory");
        }
    }
    __syncthreads();
}
__device__ __forceinline__ void prep_mod_item(const Params& p, int item, float* lds) {
    const int layer = item / 192, cg0 = (item % 192) * 32;
    const int tid = threadIdx.x, col = cg0 + (tid & 31), kg = tid >> 5;
    const float* W = p.in[4] + (size_t)layer * D * 6 * D + col;
    const float* c = p.in[1];
    float* cact = lds + 512;
#pragma unroll
    for (int i = 0; i < 8; ++i) { const int q = tid + 256 * i; const float v = c[q]; cact[q] = v * sigmoidf_(v); }
    __syncthreads();
    float a0 = 0.f, a1 = 0.f;
    for (int k0 = kg * 128; k0 < kg * 128 + 128; k0 += 16) {
        float w[16];
#pragma unroll
        for (int u = 0; u < 16; ++u) w[u] = W[(size_t)(k0 + u) * (6 * D)];
#pragma unroll
        for (int u = 0; u < 16; ++u) { a0 += w[u] * cact[k0 + u]; a1 += w[u] * cact[1024 + k0 + u]; }
    }
    lds[tid] = a0; lds[256 + tid] = a1;
    __syncthreads();
    if (tid < 64) {
        const int b = tid >> 5, cc = tid & 31;
        float s = 0.f;
#pragma unroll
        for (int g = 0; g < 8; ++g) s += lds[b * 256 + g * 32 + cc];
        float* MOD = (float*)(p.ws + WS_MOD);
        MOD[(size_t)(layer * 2 + b) * 6144 + cg0 + cc] = s + p.in[5][(size_t)layer * 6144 + cg0 + cc];
    }
    __syncthreads();
}

template <int MODE>
__device__ __forceinline__ void prep_transpose_item(const float* W, int K, int N, bf16_t* WT, int item, float* lds) {
    const int nbn = (N + 63) / 64, kb = item / nbn, nb = item % nbn, k0 = kb * 64, n0 = nb * 64;
    const int tid = threadIdx.x;
#pragma unroll
    for (int i = 0; i < 16; ++i) {
        const int kk = (tid >> 6) + 4 * i, nn = tid & 63;
        const float v = (n0 + nn < N) ? W[(size_t)(k0 + kk) * N + n0 + nn] : 0.f;
        lds[kk * 65 + nn] = v;
    }
    __syncthreads();
    {
        const int nn = tid >> 2, ks = (tid & 3) * 16;
        const int n = n0 + nn;
        if (n < N) {
            int np = n;
            if (MODE == 1) { const int j = (n < 1024) ? n : n - 1024; np = (j >> 4) * 32 + (j & 15) + ((n < 1024) ? 0 : 16); }
            u32x4 o0, o1;
            const float* s = lds + nn;
            o0.x = pk2(s[(ks + 0) * 65], s[(ks + 1) * 65]); o0.y = pk2(s[(ks + 2) * 65], s[(ks + 3) * 65]);
            o0.z = pk2(s[(ks + 4) * 65], s[(ks + 5) * 65]); o0.w = pk2(s[(ks + 6) * 65], s[(ks + 7) * 65]);
            o1.x = pk2(s[(ks + 8) * 65], s[(ks + 9) * 65]); o1.y = pk2(s[(ks + 10) * 65], s[(ks + 11) * 65]);
            o1.z = pk2(s[(ks + 12) * 65], s[(ks + 13) * 65]); o1.w = pk2(s[(ks + 14) * 65], s[(ks + 15) * 65]);
            u32x4* dst = (u32x4*)(WT + (size_t)np * K + k0 + ks);
            dst[0] = o0; dst[1] = o1;
        }
    }
    __syncthreads();
}

__device__ __forceinline__ void cvt_item(const float* src, bf16_t* dst, int item) {
    const size_t base = (size_t)item * 8192 + threadIdx.x * 8;
#pragma unroll
    for (int i = 0; i < 4; ++i) {
        const size_t o = base + (size_t)i * 2048;
        const f32x4 a = *(const f32x4*)(src + o), b = *(const f32x4*)(src + o + 4);
        u32x4 w; w.x = pk2(a.x, a.y); w.y = pk2(a.z, a.w); w.z = pk2(b.x, b.y); w.w = pk2(b.z, b.w);
        *(u32x4*)(dst + o) = w;
    }
}
__device__ __forceinline__ void zero_item(bf16_t* dst, int item) {
    const size_t base = (size_t)item * 8192 + threadIdx.x * 8;
#pragma unroll
    for (int i = 0; i < 4; ++i) *(u32x4*)(dst + base + (size_t)i * 2048) = (u32x4){0u, 0u, 0u, 0u};
}

struct cpx { float re, im; };
__device__ __forceinline__ cpx cmul(cpx a, cpx b) { return {a.re * b.re - a.im * b.im, a.re * b.im + a.im * b.re}; }
__device__ __forceinline__ cpx cexp_pow(float are, float aim, float dt, int m) {
    const float mag = __expf(are * dt * (float)m);
    const double rev = (double)aim * (double)dt * (double)m * 0.15915494309189535;
    const float fr = (float)(rev - rint(rev));
    return {mag * __builtin_amdgcn_cosf(fr), mag * __builtin_amdgcn_sinf(fr)};
}
__device__ __forceinline__ cpx s5_coef(float are, float aim, float dt) {
    cpx ab = cexp_pow(are, aim, dt, 1);
    const float nr = ab.re - 1.0f, ni = ab.im, den = are * are + aim * aim;
    return {(nr * are + ni * aim) / den, (ni * are - nr * aim) / den};
}

__device__ __forceinline__ void prep_s5_T_item(const Params& p, int item) {
    const int gid = item * 256 + threadIdx.x;
    const int g = gid >> 9, m = (gid >> 4) & 31, i = gid & 15;
    const float* a_re = p.in[7] + g * 64; const float* a_im = p.in[8] + g * 64;
    const float dt = __expf(p.in[9][g]);
    const float* b_re = p.in[10] + (size_t)g * 64 * 16; const float* b_im = p.in[11] + (size_t)g * 64 * 16;
    const float* c_re = p.in[12] + (size_t)g * 16 * 64 + i * 64; const float* c_im = p.in[13] + (size_t)g * 16 * 64 + i * 64;
    float acc[16];
#pragma unroll
    for (int j = 0; j < 16; ++j) acc[j] = 0.f;
    for (int q = 0; q < 64; ++q) {
        const float are = a_re[q], aim = a_im[q];
        cpx z = cmul(cmul({c_re[q], c_im[q]}, cexp_pow(are, aim, dt, m)), s5_coef(are, aim, dt));
        const f32x4* br = (const f32x4*)(b_re + q * 16); const f32x4* bi = (const f32x4*)(b_im + q * 16);
#pragma unroll
        for (int j4 = 0; j4 < 4; ++j4) {
            const f32x4 r = br[j4], im = bi[j4];
            acc[j4 * 4 + 0] += z.re * r.x - z.im * im.x; acc[j4 * 4 + 1] += z.re * r.y - z.im * im.y;
            acc[j4 * 4 + 2] += z.re * r.z - z.im * im.z; acc[j4 * 4 + 3] += z.re * r.w - z.im * im.w;
        }
    }
    u32x4 o0, o1;
    o0.x = pk2(acc[0], acc[1]); o0.y = pk2(acc[2], acc[3]); o0.z = pk2(acc[4], acc[5]); o0.w = pk2(acc[6], acc[7]);
    o1.x = pk2(acc[8], acc[9]); o1.y = pk2(acc[10], acc[11]); o1.z = pk2(acc[12], acc[13]); o1.w = pk2(acc[14], acc[15]);
    bf16_t* TW = (bf16_t*)(p.ws + WS_TW) + (size_t)g * 640 * 512;
    const u32x4 z4 = (u32x4){0u, 0u, 0u, 0u};
    for (int lp = 0; lp + m < 32; ++lp) {
        u32x4* d = (u32x4*)(TW + (size_t)((lp + m) * 16 + i) * 512 + lp * 16);
        d[0] = o0; d[1] = o1;
        if (m > 0) { u32x4* dz = (u32x4*)(TW + (size_t)(lp * 16 + i) * 512 + (lp + m) * 16); dz[0] = z4; dz[1] = z4; }
    }
}
__device__ __forceinline__ void prep_s5_W_item(const Params& p, int item) {
    const int gid = item * 256 + threadIdx.x;
    const int g = gid >> 11, q = (gid >> 5) & 63, lp = gid & 31;
    const float are = p.in[7][g * 64 + q], aim = p.in[8][g * 64 + q];
    const float dt = __expf(p.in[9][g]);
    const cpx z = cmul(cexp_pow(are, aim, dt, 31 - lp), s5_coef(are, aim, dt));
    const float* br = p.in[10] + ((size_t)g * 64 + q) * 16; const float* bi = p.in[11] + ((size_t)g * 64 + q) * 16;
    float wr[16], wi[16];
#pragma unroll
    for (int j = 0; j < 16; ++j) { wr[j] = z.re * br[j] - z.im * bi[j]; wi[j] = z.re * bi[j] + z.im * br[j]; }
    bf16_t* TW = (bf16_t*)(p.ws + WS_TW) + (size_t)g * 640 * 512;
    u32x4* d0 = (u32x4*)(TW + (size_t)(512 + q) * 512 + lp * 16);
    u32x4* d1 = (u32x4*)(TW + (size_t)(576 + q) * 512 + lp * 16);
    d0[0] = (u32x4){pk2(wr[0], wr[1]), pk2(wr[2], wr[3]), pk2(wr[4], wr[5]), pk2(wr[6], wr[7])};
    d0[1] = (u32x4){pk2(wr[8], wr[9]), pk2(wr[10], wr[11]), pk2(wr[12], wr[13]), pk2(wr[14], wr[15])};
    d1[0] = (u32x4){pk2(wi[0], wi[1]), pk2(wi[2], wi[3]), pk2(wi[4], wi[5]), pk2(wi[6], wi[7])};
    d1[1] = (u32x4){pk2(wi[8], wi[9]), pk2(wi[10], wi[11]), pk2(wi[12], wi[13]), pk2(wi[14], wi[15])};
}
__device__ __forceinline__ void prep_s5_V_item(const Params& p, int item) {
    const int gid = item * 256 + threadIdx.x;
    const int g = gid >> 14, l = (gid >> 9) & 31, i = (gid >> 5) & 15, q0 = (gid & 31) * 2;
    const float dt = __expf(p.in[9][g]);
    float vr[2], vi[2];
#pragma unroll
    for (int e = 0; e < 2; ++e) {
        const int q = q0 + e;
        const cpx z = cmul({p.in[12][((size_t)g * 16 + i) * 64 + q], p.in[13][((size_t)g * 16 + i) * 64 + q]}, cexp_pow(p.in[7][g * 64 + q], p.in[8][g * 64 + q], dt, l + 1));
        vr[e] = z.re; vi[e] = -z.im;
    }
    bf16_t* VG = (bf16_t*)(p.ws + WS_VG) + ((size_t)g * 512 + l * 16 + i) * 128;
    *(unsigned*)(VG + q0) = pk2(vr[0], vr[1]);
    *(unsigned*)(VG + 64 + q0) = pk2(vi[0], vi[1]);
}
__device__ __forceinline__ void prep_al_item(const Params& p, int item) {
    const int gid = item * 256 + threadIdx.x;
    const int g = gid >> 6;
    const float dt = __expf(p.in[9][g]);
    const cpx z = cexp_pow(p.in[7][gid], p.in[8][gid], dt, S5L);
    f32x2* AL = (f32x2*)(p.ws + WS_MISC + 4096);
    AL[gid] = (f32x2){z.re, z.im};
}
__device__ __forceinline__ void prep_rope_item(const Params& p, int item) {
    const int gid = item * 256 + threadIdx.x;
    const int pos = gid >> 5, j = gid & 31;
    const float freq = exp2f(-(float)j * (13.287712379549449f / 32.0f));
    const float ang = (float)pos * freq;
    const double rev = (double)ang * 0.15915494309189535;
    const float fr = (float)(rev - rint(rev));
    f32x2* R = (f32x2*)(p.ws + WS_ROPE);
    R[gid] = (f32x2){__builtin_amdgcn_cosf(fr), __builtin_amdgcn_sinf(fr)};
}
__device__ __forceinline__ void prep_cmpbias_item(const Params& p, int item, float* lds) {
    const int kv = item >> 3, cg0 = (item & 7) * 32;
    const float* pe = p.in[17 + kv]; const float* w1 = p.in[kv == 0 ? 19 : 21];
    const int tid = threadIdx.x, col = cg0 + (tid & 31), kg = tid >> 5;
    float s = 0.f;
#pragma unroll 8
    for (int k = kg * 256; k < kg * 256 + 256; ++k) s += pe[k] * w1[(size_t)k * 256 + col];
    lds[tid] = s;
    __syncthreads();
    if (tid < 32) {
        float t = 0.f;
#pragma unroll
        for (int q = 0; q < 8; ++q) t += lds[q * 32 + tid];
        ((float*)(p.ws + WS_MISC))[kv * 256 + cg0 + tid] = t;
    }
    __syncthreads();
}

__device__ __forceinline__ void cvt_fp8_item(const float* src, unsigned char* dst, float* inv_scale, int item, const bool slice_major) {
    const int lane = threadIdx.x & 63, row0 = item * 16 + (threadIdx.x >> 6) * 4;
    f32x4 v[4][4];
#pragma unroll
    for (int r = 0; r < 4; ++r) {
        const f32x4* sp = (const f32x4*)(src + (size_t)(row0 + r) * D + lane * 16);
#pragma unroll
        for (int q = 0; q < 4; ++q) v[r][q] = sp[q];
    }
#pragma unroll
    for (int r = 0; r < 4; ++r) {
        float m = 0.f;
#pragma unroll
        for (int q = 0; q < 4; ++q) m = fmaxf(m, fmaxf(fmaxf(fabsf(v[r][q].x), fabsf(v[r][q].y)), fmaxf(fabsf(v[r][q].z), fabsf(v[r][q].w))));
#pragma unroll
        for (int o = 1; o < 64; o <<= 1) m = fmaxf(m, __shfl_xor(m, o));
        const float sc = m > 0.f ? 224.0f / m : 1.0f;
        unsigned w[4];
#pragma unroll
        for (int q = 0; q < 4; ++q) { int t = 0; t = __builtin_amdgcn_cvt_pk_fp8_f32(v[r][q].x * sc, v[r][q].y * sc, t, false); t = __builtin_amdgcn_cvt_pk_fp8_f32(v[r][q].z * sc, v[r][q].w * sc, t, true); w[q] = (unsigned)t; }
        const int row = row0 + r;
        const u32x4 wv = (u32x4){w[0], w[1], w[2], w[3]};
        if (slice_major) *(u32x4*)(dst + (size_t)(lane >> 3) * (PE * 128) + (size_t)row * 128 + (lane & 7) * 16) = wv;
        else *(u32x4*)(dst + (size_t)row * D + lane * 16) = wv;
        if (lane == 0) inv_scale[row] = m > 0.f ? m / 224.0f : 1.0f;
    }
}
constexpr int P0_MOD = 384;
constexpr int P0_T_WIN = 16 * 16, P0_T_WGLU = 16 * 32, P0_T_WPROJ = 16 * 41, P0_T_WK1 = 32 * 4, P0_T_WK2 = 4 * 1, P0_T_WO = 16 * 16, P0_T_WQ = 16 * 32;
constexpr int P0_SUBK = (2 * 8 * 2 * 128 * 128) / 8192;
constexpr int P0_TAB = PE / 16;
constexpr int P0_S5T = 128, P0_S5W = 512, P0_S5V = 4096, P0_AL = 16, P0_ROPE = 2048, P0_CB = 16, P0_ZERO = 10 + 2;

__device__ __forceinline__ void phase_prep(const Params& p, float* lds) {
    const int n0 = P0_MOD;
    const int n1 = n0 + P0_T_WIN, n2 = n1 + P0_T_WGLU, n3 = n2 + P0_T_WPROJ, n4 = n3 + P0_T_WK1, n5 = n4 + P0_T_WK1, n6 = n5 + P0_T_WK2, n7 = n6 + P0_T_WK2,
              n8 = n7 + P0_T_WO, n9 = n8 + P0_T_WQ, n10 = n9 + P0_T_WQ, n11 = n10 + P0_SUBK, n12 = n11 + P0_TAB, n13 = n12 + P0_TAB,
              n14 = n13 + P0_S5T, n15 = n14 + P0_S5W, n16 = n15 + P0_S5V, n17 = n16 + P0_AL, n18 = n17 + P0_ROPE, n19 = n18 + P0_CB, n20 = n19 + 10, n21 = n20 + 2, n22 = n21 + 2;
    unsigned char* ws = p.ws;
#ifndef PREP_DUP_LO
#define PREP_DUP_LO 0
#define PREP_DUP_HI 0
#endif
    const int dupn = (PREP_DUP_HI) - (PREP_DUP_LO);
    for (int it0 = blockIdx.x; it0 < n22 + dupn; it0 += gridDim.x) {
        const int it = it0 < n22 ? it0 : (PREP_DUP_LO) + (it0 - n22);
        if (it < n0) prep_mod_item(p, it, lds);
        else if (it < n1) prep_transpose_item<0>(p.in[6], 1024, 1024, (bf16_t*)(ws + WS_WIN_T), it - n0, lds);
        else if (it < n2) prep_transpose_item<1>(p.in[15], 1024, 2048, (bf16_t*)(ws + WS_WGLU_T), it - n1, lds);
        else if (it < n3) prep_transpose_item<0>(p.in[16], 1024, NPROJ, (bf16_t*)(ws + WS_WPROJ_T), it - n2, lds);
        else if (it < n4) prep_transpose_item<0>(p.in[19], 2048, 256, (bf16_t*)(ws + WS_WK1_T), it - n3, lds);
        else if (it < n5) prep_transpose_item<0>(p.in[21], 2048, 256, (bf16_t*)(ws + WS_WV1_T), it - n4, lds);
        else if (it < n6) prep_transpose_item<0>(p.in[20], 256, 64, (bf16_t*)(ws + WS_WK2_T), it - n5, lds);
        else if (it < n7) prep_transpose_item<0>(p.in[22], 256, 64, (bf16_t*)(ws + WS_WV2_T), it - n6, lds);
        else if (it < n8) prep_transpose_item<0>(p.in[23], 1024, 1024, (bf16_t*)(ws + WS_WO_T), it - n7, lds);
        else if (it < n9) prep_transpose_item<0>(p.in[24], 1024, 2048, (bf16_t*)(ws + WS_WQ_T), it - n8, lds);
        else if (it < n10) prep_transpose_item<0>(p.in[24] + (size_t)1024 * 2048, 1024, 2048, (bf16_t*)(ws + WS_WQ_T) + (size_t)2048 * 1024, it - n9, lds);
        else if (it < n11) cvt_item(p.in[25], (bf16_t*)(ws + WS_SUBK), it - n10);
        else if (it < n12) cvt_fp8_item(p.in[26], ws + WS_PU, (float*)(ws + WS_PU + 24 * MiB), it - n11, false);
        else if (it < n13) cvt_fp8_item(p.in[27], ws + WS_PV, (float*)(ws + WS_PV + 24 * MiB), it - n12, false);
        else if (it < n14) prep_s5_T_item(p, it - n13);
        else if (it < n15) prep_s5_W_item(p, it - n14);
        else if (it < n16) prep_s5_V_item(p, it - n15);
        else if (it < n17) prep_al_item(p, it - n16);
        else if (it < n18) prep_rope_item(p, it - n17);
        else if (it < n19) prep_cmpbias_item(p, it - n18, lds);
        else if (it < n20) zero_item((bf16_t*)(ws + WS_WPROJ_T) + (size_t)NPROJ * 1024, it - n19);
        else if (it < n21) zero_item((bf16_t*)(ws + WS_WK2_T) + (size_t)64 * 256, it - n20);
        else zero_item((bf16_t*)(ws + WS_WV2_T) + (size_t)64 * 256, it - n21);
    }
}

__device__ __forceinline__ void phase_norm(const Params& p, const float* X, const float* gw, const float* shift, const float* scale  , bf16_t* HM) {
    const int lane = threadIdx.x & 63, wave = threadIdx.x >> 6;
    for (int row = blockIdx.x * 4 + wave; row < T; row += gridDim.x * 4) {
        const int b = row / SEQ;
        const f32x4* xr = (const f32x4*)(X + (size_t)row * D) + lane;
        f32x4 v[4]; float s = 0.f;
#pragma unroll
        for (int j = 0; j < 4; ++j) { v[j] = xr[64 * j]; s += (v[j].x * v[j].x + v[j].y * v[j].y) + (v[j].z * v[j].z + v[j].w * v[j].w); }
        const float rs = rsqrtf(wave_sum(s) * (1.0f / D) + RMS_EPS);
        u32x2* o = (u32x2*)(HM + (size_t)row * D) + lane;
#pragma unroll
        for (int j = 0; j < 4; ++j) {
            const int c = lane * 4 + 256 * j;
            const f32x4 g = *(const f32x4*)(gw + c), sh = *(const f32x4*)(shift + (size_t)b * 6144 + c), sc = *(const f32x4*)(scale + (size_t)b * 6144 + c);
            const float y0 = v[j].x * rs * g.x * (1.f + sc.x) + sh.x, y1 = v[j].y * rs * g.y * (1.f + sc.y) + sh.y;
            const float y2 = v[j].z * rs * g.z * (1.f + sc.z) + sh.z, y3 = v[j].w * rs * g.w * (1.f + sc.w) + sh.w;
            o[64 * j] = (u32x2){pk2(y0, y1), pk2(y2, y3)};
        }
    }
}
__device__ __forceinline__ void phase_final_norm(const Params& p, const float* X, float* OUT, bool dry) {
    const int lane = threadIdx.x & 63, wave = threadIdx.x >> 6;
    const float* gw = p.in[28];
    for (int row = blockIdx.x * 4 + wave; row < T; row += gridDim.x * 4) {
        const f32x4* xr = (const f32x4*)(X + (size_t)row * D) + lane;
        f32x4 v[4]; float s = 0.f;
#pragma unroll
        for (int j = 0; j < 4; ++j) { v[j] = xr[64 * j]; s += (v[j].x * v[j].x + v[j].y * v[j].y) + (v[j].z * v[j].z + v[j].w * v[j].w); }
        const float rs = rsqrtf(wave_sum(s) * (1.0f / D) + RMS_EPS);
        f32x4* o = (f32x4*)(OUT + (size_t)row * D) + lane;
#pragma unroll
        for (int j = 0; j < 4; ++j) {
            const f32x4 g = *(const f32x4*)(gw + lane * 4 + 256 * j);
            if (!dry) o[64 * j] = (f32x4){v[j].x * rs * g.x, v[j].y * rs * g.y, v[j].z * rs * g.z, v[j].w * rs * g.w};
        }
    }
}

__device__ __forceinline__ int vblock() { const int G = gridDim.x, bx = blockIdx.x; return (G % 8 == 0) ? (bx % 8) * (G / 8) + bx / 8 : bx; }
struct ALoadPlain {
    const bf16_t* A; size_t lda;
    __device__ __forceinline__ const bf16_t* base(int kt) const { return A + kt * 64; }
    __device__ __forceinline__ unsigned off(int r, int lc) const { return (unsigned)r * (unsigned)lda + (unsigned)lc * 8u; }
};
struct ALoadGroup {
    const bf16_t* A;
    __device__ __forceinline__ const bf16_t* base(int kt) const { return A + (size_t)kt * 4 * T * 16; }
    __device__ __forceinline__ unsigned off(int r, int lc) const { return ((unsigned)(lc >> 1) * (unsigned)T + (unsigned)r) * 16u + (unsigned)(lc & 1) * 8u; }
};

template <class AL>
__device__ __forceinline__ void gemm_tile2(const AL al, const bf16_t* __restrict__ Bt, size_t ldb, int nk, f32x4 (&acc)[4][4], unsigned char* lds) {
    const int tid = threadIdx.x, lane = tid & 63, wid = tid >> 6, wr = wid >> 1, wc = wid & 1, fr = lane & 15, fq = lane >> 4;
    const int lr = tid >> 3, lc = tid & 7;
#pragma unroll
    for (int mi = 0; mi < 4; ++mi)
#pragma unroll
        for (int ni = 0; ni < 4; ++ni) acc[mi][ni] = (f32x4){0.f, 0.f, 0.f, 0.f};
    u32x4 ra0[4], rb0[4], ra1[4], rb1[4];
    const int soff = lr * 128 + ((lc ^ (lr & 7)) << 4);
    unsigned offA[4], offB[4];
#pragma unroll
    for (int i = 0; i < 4; ++i) { offA[i] = al.off(lr + 32 * i, lc); offB[i] = (unsigned)(lr + 32 * i) * (unsigned)ldb + (unsigned)lc * 8u; }
#define GT_LOAD(RA, RB, kt_) do { const bf16_t* ab_ = al.base(kt_); const bf16_t* bb_ = Bt + (kt_) * 64; _Pragma("unroll") for (int i = 0; i < 4; ++i) { RA[i] = *(const u32x4*)(ab_ + offA[i]); RB[i] = *(const u32x4*)(bb_ + offB[i]); } } while (0)
#define GT_STORE(RA, RB, buf_) do { unsigned char* nb_ = lds + (buf_) * 32768; _Pragma("unroll") for (int i = 0; i < 4; ++i) { *(u32x4*)(nb_ + soff + i * 4096) = RA[i]; *(u32x4*)(nb_ + 16384 + soff + i * 4096) = RB[i]; } } while (0)
    const int aoff = (wr * 64 + fr) * 128, boff = 16384 + (wc * 64 + fr) * 128, sw = fr & 7;
#define GT_MATH(buf_) do { const unsigned char* bp_ = lds + (buf_) * 32768; _Pragma("unroll") for (int ks = 0; ks < 2; ++ks) { bf16x8 af[4], bfr[4]; const int co = ((ks * 4 + fq) ^ sw) << 4; \
        _Pragma("unroll") for (int mi = 0; mi < 4; ++mi) af[mi] = *(const bf16x8*)(bp_ + aoff + mi * 2048 + co); \
        _Pragma("unroll") for (int ni = 0; ni < 4; ++ni) bfr[ni] = *(const bf16x8*)(bp_ + boff + ni * 2048 + co); \
        _Pragma("unroll") for (int mi = 0; mi < 4; ++mi) _Pragma("unroll") for (int ni = 0; ni < 4; ++ni) acc[mi][ni] = __builtin_amdgcn_mfma_f32_16x16x32_bf16(bfr[ni], af[mi], acc[mi][ni], 0, 0, 0); } } while (0)
    GT_LOAD(ra0, rb0, 0);
    if (nk > 1) GT_LOAD(ra1, rb1, 1);
    GT_STORE(ra0, rb0, 0);
    __syncthreads();
    for (int kt = 0; kt < nk; kt += 2) {
        if (kt + 2 < nk) GT_LOAD(ra0, rb0, kt + 2);
        __builtin_amdgcn_sched_barrier(0);
        GT_MATH(0);
        __builtin_amdgcn_sched_barrier(0);
        if (kt + 1 < nk) GT_STORE(ra1, rb1, 1);
        __syncthreads();
        if (kt + 1 >= nk) break;
        if (kt + 3 < nk) GT_LOAD(ra1, rb1, kt + 3);
        __builtin_amdgcn_sched_barrier(0);
        GT_MATH(1);
        __builtin_amdgcn_sched_barrier(0);
        if (kt + 2 < nk) GT_STORE(ra0, rb0, 0);
        __syncthreads();
    }
#undef GT_LOAD
#undef GT_STORE
#undef GT_MATH
}

template <class AL>
__device__ __forceinline__ void gemm_tile1(const AL al, const bf16_t* __restrict__ Bt, size_t ldb, int nk, f32x4 (&acc)[4][4], unsigned char* lds) {
    const int tid = threadIdx.x, lane = tid & 63, wid = tid >> 6, wr = wid >> 1, wc = wid & 1, fr = lane & 15, fq = lane >> 4;
    const int lr = tid >> 3, lc = tid & 7;
#pragma unroll
    for (int mi = 0; mi < 4; ++mi)
#pragma unroll
        for (int ni = 0; ni < 4; ++ni) acc[mi][ni] = (f32x4){0.f, 0.f, 0.f, 0.f};
    u32x4 ra[4], rb[4];
    const int soff = lr * 128 + ((lc ^ (lr & 7)) << 4);
#pragma unroll
    for (int i = 0; i < 4; ++i) { ra[i] = *(const u32x4*)(al.base(0) + al.off(lr + 32 * i, lc)); rb[i] = *(const u32x4*)(Bt + (size_t)(lr + 32 * i) * ldb + lc * 8); }
#pragma unroll
    for (int i = 0; i < 4; ++i) { *(u32x4*)(lds + soff + i * 4096) = ra[i]; *(u32x4*)(lds + 16384 + soff + i * 4096) = rb[i]; }
    __syncthreads();
    const int aoff = (wr * 64 + fr) * 128, boff = 16384 + (wc * 64 + fr) * 128, sw = fr & 7;
    for (int kt = 0; kt < nk; ++kt) {
        const bool more = (kt + 1 < nk);
        if (more) {
#pragma unroll
            for (int i = 0; i < 4; ++i) { ra[i] = *(const u32x4*)(al.base(kt + 1) + al.off(lr + 32 * i, lc)); rb[i] = *(const u32x4*)(Bt + (size_t)(lr + 32 * i) * ldb + (kt + 1) * 64 + lc * 8); }
        }
        const unsigned char* buf = lds + (kt & 1) * 32768;
#pragma unroll
        for (int ks = 0; ks < 2; ++ks) {
            bf16x8 af[4], bfr[4];
            const int co = ((ks * 4 + fq) ^ sw) << 4;
#pragma unroll
            for (int mi = 0; mi < 4; ++mi) af[mi] = *(const bf16x8*)(buf + aoff + mi * 2048 + co);
#pragma unroll
            for (int ni = 0; ni < 4; ++ni) bfr[ni] = *(const bf16x8*)(buf + boff + ni * 2048 + co);
#pragma unroll
            for (int mi = 0; mi < 4; ++mi)
#pragma unroll
                for (int ni = 0; ni < 4; ++ni) acc[mi][ni] = __builtin_amdgcn_mfma_f32_16x16x32_bf16(bfr[ni], af[mi], acc[mi][ni], 0, 0, 0);
        }
        if (more) {
            unsigned char* nb = lds + ((kt + 1) & 1) * 32768;
#pragma unroll
            for (int i = 0; i < 4; ++i) { *(u32x4*)(nb + soff + i * 4096) = ra[i]; *(u32x4*)(nb + 16384 + soff + i * 4096) = rb[i]; }
        }
        __syncthreads();
    }
}

template <class AL>
__device__ __forceinline__ void gemm_tile3(const AL al, const bf16_t* __restrict__ Bt, size_t ldb, int nk, f32x4 (&acc)[4][4], unsigned char* lds) {
    const int tid = threadIdx.x, lane = tid & 63, wid = tid >> 6, wr = wid >> 1, wc = wid & 1, fr = lane & 15, fq = lane >> 4;
#pragma unroll
    for (int mi = 0; mi < 4; ++mi)
#pragma unroll
        for (int ni = 0; ni < 4; ++ni) acc[mi][ni] = (f32x4){0.f, 0.f, 0.f, 0.f};
    const int srow = wid * 32 + (lane >> 3), schunk = (lane & 7) ^ ((lane >> 3) & 7);
    unsigned offA[4], offB[4];
#pragma unroll
    for (int i = 0; i < 4; ++i) { offA[i] = al.off(srow + 8 * i, schunk); offB[i] = (unsigned)(srow + 8 * i) * (unsigned)ldb + (unsigned)schunk * 8u; }
#define G3_STAGE(buf_, kt_) do { const bf16_t* ab_ = al.base(kt_); const bf16_t* bb_ = Bt + (kt_) * 64; unsigned char* lb_ = lds + (buf_) * 32768 + wid * 4096; \
        _Pragma("unroll") for (int i = 0; i < 4; ++i) { \
            __builtin_amdgcn_global_load_lds((const unsigned*)(ab_ + offA[i]), (unsigned*)(lb_ + i * 1024), 16, 0, 0); \
            __builtin_amdgcn_global_load_lds((const unsigned*)(bb_ + offB[i]), (unsigned*)(lb_ + 16384 + i * 1024), 16, 0, 0); } } while (0)
    const int aoff = (wr * 64 + fr) * 128, boff = 16384 + (wc * 64 + fr) * 128, sw = fr & 7;
    G3_STAGE(0, 0);
    __syncthreads();
    for (int kt = 0; kt < nk; ++kt) {
        if (kt + 1 < nk) G3_STAGE((kt + 1) & 1, kt + 1);
        const unsigned char* buf = lds + (kt & 1) * 32768;
#pragma unroll
        for (int ks = 0; ks < 2; ++ks) {
            bf16x8 af[4], bfr[4];
            const int co = ((ks * 4 + fq) ^ sw) << 4;
#pragma unroll
            for (int mi = 0; mi < 4; ++mi) af[mi] = *(const bf16x8*)(buf + aoff + mi * 2048 + co);
#pragma unroll
            for (int ni = 0; ni < 4; ++ni) bfr[ni] = *(const bf16x8*)(buf + boff + ni * 2048 + co);
#pragma unroll
            for (int mi = 0; mi < 4; ++mi)
#pragma unroll
                for (int ni = 0; ni < 4; ++ni) acc[mi][ni] = __builtin_amdgcn_mfma_f32_16x16x32_bf16(bfr[ni], af[mi], acc[mi][ni], 0, 0, 0);
        }
        __syncthreads();
    }
#undef G3_STAGE
}
__device__ __forceinline__ void phase_s5_win(const Params& p, unsigned char* lds) {
    const bf16_t* HM = (const bf16_t*)(p.ws + WS_HM); const bf16_t* WT = (const bf16_t*)(p.ws + WS_WIN_T);
    bf16_t* UG = (bf16_t*)(p.ws + WS_UG);
    const int lane = threadIdx.x & 63, wid = threadIdx.x >> 6, wr = wid >> 1, wc = wid & 1, fr = lane & 15, fq = lane >> 4;
    for (int id = vblock(); id < 256 * 8; id += gridDim.x) {
        const int mt = id >> 3, nt = id & 7;
        f32x4 acc[4][4];
        gemm_tile3(ALoadPlain{HM + (size_t)mt * 128 * D, (size_t)D}, WT + (size_t)nt * 128 * D, D, 16, acc, lds);
#pragma unroll
        for (int mi = 0; mi < 4; ++mi)
#pragma unroll
            for (int ni = 0; ni < 4; ++ni) {
                const int t = mt * 128 + wr * 64 + mi * 16 + fr, g = nt * 8 + wc * 4 + ni;
                const f32x4 v = acc[mi][ni];
                *(u32x2*)(UG + ((size_t)g * T + t) * 16 + fq * 4) = (u32x2){pk2(v.x, v.y), pk2(v.z, v.w)};
            }
    }
}
__device__ __forceinline__ void phase_s5_a(const Params& p, unsigned char* lds) {
    const bf16_t* UG = (const bf16_t*)(p.ws + WS_UG); const bf16_t* TW = (const bf16_t*)(p.ws + WS_TW);
    bf16_t* YI = (bf16_t*)(p.ws + WS_YI); float* WST = (float*)(p.ws + WS_WST);
    const int lane = threadIdx.x & 63, wid = threadIdx.x >> 6, wr = wid >> 1, wc = wid & 1, fr = lane & 15, fq = lane >> 4;
    for (int id = vblock(); id < 64 * 40; id += gridDim.x) {
        const int g = id / 40, rem = id % 40, mt = rem / 5, nt = rem % 5;
        const int nk = (nt < 4) ? 2 * (nt + 1) : 8;
        f32x4 acc[4][4];
        gemm_tile3(ALoadPlain{UG + (size_t)g * T * 16 + (size_t)mt * 128 * 512, (size_t)512}, TW + ((size_t)g * 640 + nt * 128) * 512, 512, nk, acc, lds);
#pragma unroll
        for (int mi = 0; mi < 4; ++mi)
#pragma unroll
            for (int ni = 0; ni < 4; ++ni) {
                const int R = mt * 128 + wr * 64 + mi * 16 + fr, c = wc * 64 + ni * 16 + fq * 4;
                const f32x4 v = acc[mi][ni];
                if (nt < 4) *(u32x2*)(YI + ((size_t)g * 1024 + R) * 512 + nt * 128 + c) = (u32x2){pk2(v.x, v.y), pk2(v.z, v.w)};
                else *(f32x4*)(WST + ((size_t)g * 1024 + R) * 128 + c) = v;
            }
    }
}
__device__ __forceinline__ void phase_s5_scan(const Params& p) {
    const int lane = threadIdx.x & 63, wave = threadIdx.x >> 6;
    const float* WST = (const float*)(p.ws + WS_WST); bf16_t* SST = (bf16_t*)(p.ws + WS_SST);
    const f32x2* AL = (const f32x2*)(p.ws + WS_MISC + 4096);
    for (int it = blockIdx.x * 4 + wave; it < 128; it += gridDim.x * 4) {
        const int b = it >> 6, g = it & 63;
        const f32x2 al = AL[g * 64 + lane];
        float sr = 0.f, si = 0.f;
        const float* wbase = WST + ((size_t)g * 1024 + b * 512) * 128 + lane;
        bf16_t* sbase = SST + ((size_t)g * 1024 + b * 512) * 128 + lane;
        for (int n0 = 0; n0 < 512; n0 += 16) {
            float wre[16], wim[16];
#pragma unroll
            for (int j = 0; j < 16; ++j) { wre[j] = wbase[(size_t)(n0 + j) * 128]; wim[j] = wbase[(size_t)(n0 + j) * 128 + 64]; }
#pragma unroll
            for (int j = 0; j < 16; ++j) {
                sbase[(size_t)(n0 + j) * 128] = (bf16_t)f2bf(sr); sbase[(size_t)(n0 + j) * 128 + 64] = (bf16_t)f2bf(si);
                const float nr = al.x * sr - al.y * si + wre[j], ni = al.x * si + al.y * sr + wim[j];
                sr = nr; si = ni;
            }
        }
    }
}
__device__ __forceinline__ void phase_s5_b(const Params& p, unsigned char* lds) {
    const bf16_t* SST = (const bf16_t*)(p.ws + WS_SST); const bf16_t* VG = (const bf16_t*)(p.ws + WS_VG);
    const bf16_t* YI = (const bf16_t*)(p.ws + WS_YI); const bf16_t* UG = (const bf16_t*)(p.ws + WS_UG);
    bf16_t* YG = (bf16_t*)(p.ws + WS_YG);
    const float* dsk = p.in[14];
    const int lane = threadIdx.x & 63, wid = threadIdx.x >> 6, wr = wid >> 1, wc = wid & 1, fr = lane & 15, fq = lane >> 4;
    for (int id = vblock(); id < 64 * 32; id += gridDim.x) {
        const int g = id >> 5, mt = (id >> 2) & 7, nt = id & 3;
        f32x4 acc[4][4];
        gemm_tile3(ALoadPlain{SST + ((size_t)g * 1024 + mt * 128) * 128, (size_t)128}, VG + ((size_t)g * 512 + nt * 128) * 128, 128, 2, acc, lds);
        const f32x4 dv = *(const f32x4*)(dsk + g * 16 + fq * 4);
#pragma unroll
        for (int mi = 0; mi < 4; ++mi)
#pragma unroll
            for (int ni = 0; ni < 4; ++ni) {
                const int R = mt * 128 + wr * 64 + mi * 16 + fr, c = nt * 128 + wc * 64 + ni * 16 + fq * 4;
                const size_t idx = ((size_t)g * 1024 + R) * 512 + c;
                const u32x2 yi = *(const u32x2*)(YI + idx), uu = *(const u32x2*)(UG + idx);
                const f32x4 v = acc[mi][ni];
                const float y0 = gelu_tanh(v.x + bflo(yi.x) + dv.x * bflo(uu.x)), y1 = gelu_tanh(v.y + bfhi(yi.x) + dv.y * bfhi(uu.x));
                const float y2 = gelu_tanh(v.z + bflo(yi.y) + dv.z * bflo(uu.y)), y3 = gelu_tanh(v.w + bfhi(yi.y) + dv.w * bfhi(uu.y));
                *(u32x2*)(YG + idx) = (u32x2){pk2(y0, y1), pk2(y2, y3)};
            }
    }
}
__device__ __forceinline__ void phase_s5_glu(const Params& p, unsigned char* lds) {
    const bf16_t* YG = (const bf16_t*)(p.ws + WS_YG); const bf16_t* WT = (const bf16_t*)(p.ws + WS_WGLU_T);
    const float* MOD = (const float*)(p.ws + WS_MOD);
    const float* X = p.in[0]; float* XO = p.out;
    const int lane = threadIdx.x & 63, wid = threadIdx.x >> 6, wr = wid >> 1, wc = wid & 1, fr = lane & 15, fq = lane >> 4;
    for (int id = vblock(); id < 256 * 16; id += gridDim.x) {
        const int mt = id >> 4, nt = id & 15;
        f32x4 acc[4][4];
        gemm_tile3(ALoadGroup{YG + (size_t)mt * 128 * 16}, WT + (size_t)nt * 128 * D, D, 16, acc, lds);
        const int b = (mt * 128) / SEQ;
#pragma unroll
        for (int mi = 0; mi < 4; ++mi)
#pragma unroll
            for (int h = 0; h < 2; ++h) {
                const int t = mt * 128 + wr * 64 + mi * 16 + fr, j = nt * 64 + wc * 32 + h * 16 + fq * 4;
                const f32x4 a = acc[mi][2 * h], gg = acc[mi][2 * h + 1];
                const f32x4 g1 = *(const f32x4*)(MOD + (size_t)(0 * 2 + b) * 6144 + 2048 + j);
                const f32x4 xi = *(const f32x4*)(X + (size_t)t * D + j);
                f32x4 o;
                o.x = xi.x + g1.x * (a.x * sigmoidf_(gg.x)); o.y = xi.y + g1.y * (a.y * sigmoidf_(gg.y));
                o.z = xi.z + g1.z * (a.z * sigmoidf_(gg.z)); o.w = xi.w + g1.w * (a.w * sigmoidf_(gg.w));
                *(f32x4*)(XO + (size_t)t * D + j) = o;
            }
    }
}
__device__ __forceinline__ void phase_peer_wq(const Params& p, int layer, unsigned char* lds) {
    const bf16_t* HM = (const bf16_t*)(p.ws + WS_HM); const bf16_t* WT = (const bf16_t*)(p.ws + WS_WQ_T) + (size_t)layer * 2048 * 1024;
    bf16_t* QK = (bf16_t*)(p.ws + WS_QK);
    const int lane = threadIdx.x & 63, wid = threadIdx.x >> 6, wr = wid >> 1, wc = wid & 1, fr = lane & 15, fq = lane >> 4;
    for (int id = vblock(); id < 256 * 16; id += gridDim.x) {
        const int mt = id >> 4, nt = id & 15;
        f32x4 acc[4][4];
        gemm_tile3(ALoadPlain{HM + (size_t)mt * 128 * D, (size_t)D}, WT + (size_t)nt * 128 * D, D, 16, acc, lds);
#pragma unroll
        for (int mi = 0; mi < 4; ++mi)
#pragma unroll
            for (int ni = 0; ni < 4; ++ni) {
                const int t = mt * 128 + wr * 64 + mi * 16 + fr, c = nt * 128 + wc * 64 + ni * 16 + fq * 4;
                const f32x4 v = acc[mi][ni];
                *(u32x2*)(QK + (size_t)t * 2048 + c) = (u32x2){pk2(v.x, v.y), pk2(v.z, v.w)};
            }
    }
}
__device__ __forceinline__ void ce_(unsigned& a, unsigned& b, const bool up) { const unsigned lo = a < b ? a : b, hi = a < b ? b : a; a = up ? lo : hi; b = up ? hi : lo; }
__device__ __forceinline__ void bitonic_sort16(unsigned* x, const bool asc) {
#pragma unroll
    for (int k = 2; k <= 16; k <<= 1)
#pragma unroll
        for (int j = k >> 1; j > 0; j >>= 1)
#pragma unroll
            for (int i = 0; i < 16; ++i) { const int l = i ^ j; if (l > i) ce_(x[i], x[l], ((i & k) == 0) == asc); }
}
__device__ __forceinline__ void bitonic_merge16(unsigned* x, const bool asc) {
#pragma unroll
    for (int j = 8; j > 0; j >>= 1)
#pragma unroll
        for (int i = 0; i < 16; ++i) { const int l = i ^ j; if (l > i) ce_(x[i], x[l], asc); }
}
__device__ __forceinline__ void phase_peer_topk(const Params& p, int layer, unsigned char* lds) {
    const bf16_t* QK = (const bf16_t*)(p.ws + WS_QK); const bf16_t* SK = (const bf16_t*)(p.ws + WS_SUBK) + (size_t)layer * 8 * 2 * 128 * 128;
    float* TOPS = (float*)(p.ws + WS_TOPS); int* TOPI = (int*)(p.ws + WS_TOPI);
    float* sc = (float*)lds;
    const int tid = threadIdx.x, lane = tid & 63, wid = tid >> 6, wr = wid >> 1, wc = wid & 1, fr = lane & 15, fq = lane >> 4;
    for (int id = vblock(); id < 256 * 16; id += gridDim.x) {
        const int mt = id >> 4, hc = id & 15;
        f32x4 acc[4][4];
        gemm_tile3(ALoadPlain{QK + (size_t)mt * 128 * 2048 + hc * 128, (size_t)2048}, SK + (size_t)hc * 128 * 128, 128, 2, acc, lds);
#pragma unroll
        for (int mi = 0; mi < 4; ++mi)
#pragma unroll
            for (int ni = 0; ni < 4; ++ni) {
                const int r = wr * 64 + mi * 16 + fr, c = wc * 64 + ni * 16 + fq * 4;
                float* d = sc + r * 129 + c;
                d[0] = acc[mi][ni].x; d[1] = acc[mi][ni].y; d[2] = acc[mi][ni].z; d[3] = acc[mi][ni].w;
            }
        __syncthreads();
        {
            const int row = tid >> 1, half = tid & 1;
            unsigned x[64];
            const float* rp = sc + row * 129 + half * 64;
#pragma unroll
            for (int j = 0; j < 64; ++j) {
                const unsigned bits = __builtin_bit_cast(unsigned, rp[j]);
                const unsigned u = bits ^ ((unsigned)((int)bits >> 31) | 0x80000000u);
                x[j] = (u & 0xFFFFFF80u) | (unsigned)(127 - (half * 64 + j));
            }
            bitonic_sort16(x, true); bitonic_sort16(x + 16, false); bitonic_sort16(x + 32, true); bitonic_sort16(x + 48, false);
#pragma unroll
            for (int i = 0; i < 16; ++i) { x[i] = x[i] > x[16 + i] ? x[i] : x[16 + i]; x[32 + i] = x[32 + i] > x[48 + i] ? x[32 + i] : x[48 + i]; }
            bitonic_merge16(x, true); bitonic_merge16(x + 32, false);
#pragma unroll
            for (int i = 0; i < 16; ++i) x[i] = x[i] > x[32 + i] ? x[i] : x[32 + i];
            bitonic_merge16(x, false);
            unsigned y[16];
#pragma unroll
            for (int i = 0; i < 16; ++i) { const unsigned o = (unsigned)__shfl_xor((int)x[15 - i], 1); y[i] = x[i] > o ? x[i] : o; }
            bitonic_merge16(y, false);
            const size_t ob = ((size_t)(mt * 128 + row) * 16 + hc) * 16;
            if (half == 0) {
                float v[16];
#pragma unroll
                for (int i = 0; i < 16; ++i) { const unsigned u = y[i] & 0xFFFFFF80u; const unsigned bits = (u & 0x80000000u) ? (u ^ 0x80000000u) : ~u; v[i] = __builtin_bit_cast(float, bits); }
#pragma unroll
                for (int q = 0; q < 4; ++q) *(f32x4*)(TOPS + ob + q * 4) = (f32x4){v[q * 4], v[q * 4 + 1], v[q * 4 + 2], v[q * 4 + 3]};
            } else {
#pragma unroll
                for (int q = 0; q < 4; ++q) *(u32x4*)(TOPI + ob + q * 4) = (u32x4){127u - (y[q * 4] & 127u), 127u - (y[q * 4 + 1] & 127u), 127u - (y[q * 4 + 2] & 127u), 127u - (y[q * 4 + 3] & 127u)};
            }
        }
        __syncthreads();
    }
}
__device__ __forceinline__ void phase_peer_combine(const Params& p, unsigned char* lds) {
    const float* TOPS = (const float*)(p.ws + WS_TOPS); const int* TOPI = (const int*)(p.ws + WS_TOPI);
    int* EXP = (int*)(p.ws + WS_EXP); float* GATE = (float*)(p.ws + WS_GATE);
    unsigned* L = (unsigned*)lds;
    const int tid = threadIdx.x;
    for (int it = blockIdx.x; it < (T * 8) / 256; it += gridDim.x) {
        const size_t th = (size_t)it * 256 + tid;
        const u32x4* S4 = (const u32x4*)(TOPS + th * 32); const u32x4* I4 = (const u32x4*)(TOPI + th * 32);
#pragma unroll
        for (int a4 = 0; a4 < 8; ++a4) {
            const u32x4 s = S4[a4], i = I4[a4];
            L[(a4 * 4 + 0) * 256 + tid] = s.x; L[(a4 * 4 + 1) * 256 + tid] = s.y; L[(a4 * 4 + 2) * 256 + tid] = s.z; L[(a4 * 4 + 3) * 256 + tid] = s.w;
            L[(32 + a4 * 4 + 0) * 256 + tid] = i.x; L[(32 + a4 * 4 + 1) * 256 + tid] = i.y; L[(32 + a4 * 4 + 2) * 256 + tid] = i.z; L[(32 + a4 * 4 + 3) * 256 + tid] = i.w;
        }
        float val[16];
        const float s20 = __builtin_bit_cast(float, L[16 * 256 + tid]);
#pragma unroll
        for (int a = 0; a < 16; ++a) val[a] = __builtin_bit_cast(float, L[a * 256 + tid]) + s20;
        unsigned long long P = 0ull;
        float ts[16]; int te[16];
#pragma unroll
        for (int r = 0; r < 16; ++r) {
            float best = val[0]; int ba = 0;
#pragma unroll
            for (int a = 1; a < 16; ++a) if (val[a] > best) { best = val[a]; ba = a; }
            const int b = (int)((P >> (4 * ba)) & 15ull);
            const int i1 = (int)L[(32 + ba) * 256 + tid], i2 = (int)L[(48 + b) * 256 + tid];
            ts[r] = best; te[r] = i1 * 128 + i2;
            const int nb = b + 1;
            float newv = -3.0e38f;
            if (nb < 16) { newv = __builtin_bit_cast(float, L[ba * 256 + tid]) + __builtin_bit_cast(float, L[(16 + nb) * 256 + tid]); P += 1ull << (4 * ba); }
#pragma unroll
            for (int a = 0; a < 16; ++a) val[a] = (a == ba) ? newv : val[a];
        }
        const float m0 = ts[0];
        float sum = 0.f;
#pragma unroll
        for (int r = 0; r < 16; ++r) { ts[r] = __expf(ts[r] - m0); sum += ts[r]; }
        const float inv = 1.0f / sum;
#pragma unroll
        for (int r = 0; r < 16; ++r) ts[r] *= inv;
#pragma unroll
        for (int r = 0; r < 16; ++r) { EXP[th * 16 + r] = te[r]; GATE[th * 16 + r] = ts[r]; }
    }
}

__device__ __forceinline__ void fma8(const unsigned w0, const unsigned w1, const float a, float* acc) {
    const f32x2 p0 = __builtin_amdgcn_cvt_pk_f32_fp8((int)w0, false), p1 = __builtin_amdgcn_cvt_pk_f32_fp8((int)w0, true);
    const f32x2 p2 = __builtin_amdgcn_cvt_pk_f32_fp8((int)w1, false), p3 = __builtin_amdgcn_cvt_pk_f32_fp8((int)w1, true);
    acc[0] += a * p0.x; acc[1] += a * p0.y; acc[2] += a * p1.x; acc[3] += a * p1.y;
    acc[4] += a * p2.x; acc[5] += a * p2.y; acc[6] += a * p3.x; acc[7] += a * p3.y;
}
__device__ __forceinline__ float dot8(const unsigned w0, const unsigned w1, const float* h, float s) {
    const f32x2 p0 = __builtin_amdgcn_cvt_pk_f32_fp8((int)w0, false), p1 = __builtin_amdgcn_cvt_pk_f32_fp8((int)w0, true);
    const f32x2 p2 = __builtin_amdgcn_cvt_pk_f32_fp8((int)w1, false), p3 = __builtin_amdgcn_cvt_pk_f32_fp8((int)w1, true);
    s += p0.x * h[0]; s += p0.y * h[1]; s += p1.x * h[2]; s += p1.y * h[3];
    s += p2.x * h[4]; s += p2.y * h[5]; s += p3.x * h[6]; s += p3.y * h[7];
    return s;
}
__device__ __forceinline__ void phase_peer_apply(const Params& p, int layer, unsigned char* lds, bool dry) {
    const int lane = threadIdx.x & 63, wave = threadIdx.x >> 6;
    float* ldsw = (float*)lds + wave * (64 * 65);
    const bf16_t* HM = (const bf16_t*)(p.ws + WS_HM);
    const unsigned char* PU = p.ws + WS_PU; const unsigned char* PV = p.ws + WS_PV;
    const float* SU = (const float*)(p.ws + WS_PU + 24 * MiB); const float* SV = (const float*)(p.ws + WS_PV + 24 * MiB);
    const int* EXP = (const int*)(p.ws + WS_EXP); const float* GATE = (const float*)(p.ws + WS_GATE);
    const float* MOD = (const float*)(p.ws + WS_MOD);
    float* X = p.out;
    for (int t = blockIdx.x * 4 + wave; t < T; t += gridDim.x * 4) {
        const u32x4 ha = *(const u32x4*)(HM + (size_t)t * D + lane * 16), hb = *(const u32x4*)(HM + (size_t)t * D + lane * 16 + 8);
        float hf[16];
        hf[0] = bflo(ha.x); hf[1] = bfhi(ha.x); hf[2] = bflo(ha.y); hf[3] = bfhi(ha.y); hf[4] = bflo(ha.z); hf[5] = bfhi(ha.z); hf[6] = bflo(ha.w); hf[7] = bfhi(ha.w);
        hf[8] = bflo(hb.x); hf[9] = bfhi(hb.x); hf[10] = bflo(hb.y); hf[11] = bfhi(hb.y); hf[12] = bflo(hb.z); hf[13] = bfhi(hb.z); hf[14] = bflo(hb.w); hf[15] = bfhi(hb.w);
        const int e0_ = EXP[(size_t)t * 128 + lane], e1_ = EXP[(size_t)t * 128 + 64 + lane];
        const float g0 = GATE[(size_t)t * 128 + lane], g1 = GATE[(size_t)t * 128 + 64 + lane];
        const float su0 = SU[e0_], su1 = SU[e1_], sv0 = SV[e0_], sv1 = SV[e1_];
        u32x4 buf[16];
        float act0 = 0.f, act1 = 0.f;
        float acc[16];
#pragma unroll
        for (int i = 0; i < 16; ++i) acc[i] = 0.f;
#ifndef APPLY_L2PROBE
#define APPLY_L2PROBE 0
#endif
        for (int prep_ = 0; prep_ < 1 + APPLY_L2PROBE; ++prep_) {
        const int emask = (APPLY_L2PROBE && prep_ == 0) ? 2047 : 0x7fffffff;
        const int e0 = e0_ & emask, e1 = e1_ & emask;
#pragma unroll
        for (int j = 0; j < 16; ++j) { const int e_ = __builtin_amdgcn_readlane(e0, j); buf[j] = *(const u32x4*)(PU + (size_t)e_ * D + lane * 16); }
#pragma unroll
        for (int bt = 0; bt < 16; ++bt) {
#pragma unroll
            for (int j = 0; j < 16; ++j) {
                if (bt < 8) {
                    float s_ = dot8(buf[j].x, buf[j].y, hf, 0.f); s_ = dot8(buf[j].z, buf[j].w, hf + 8, s_);
                    ldsw[((bt & 3) * 16 + j) * 65 + lane] = s_;
                } else {
                    const float av_ = ((bt & 7) < 4) ? act0 : act1;
                    const float a_ = __builtin_bit_cast(float, __builtin_amdgcn_readlane(__builtin_bit_cast(int, av_), (bt & 3) * 16 + j));
                    fma8(buf[j].x, buf[j].y, a_, acc); fma8(buf[j].z, buf[j].w, a_, acc + 8);
                }
                if (bt + 1 < 16) {
                    const int nb = bt + 1;
                    const int e_ = __builtin_amdgcn_readlane(((nb & 7) < 4) ? e0 : e1, (nb & 3) * 16 + j);
                    buf[j] = *(const u32x4*)(((nb < 8) ? PU : PV) + (size_t)e_ * D + lane * 16);
                }
            }
            if (bt == 3 || bt == 7) {
                float tot_ = 0.f;
#pragma unroll 16
                for (int q = 0; q < 64; ++q) tot_ += ldsw[lane * 65 + q];
                if (bt == 3) act0 = gelu_tanh(tot_ * su0) * g0 * sv0; else act1 = gelu_tanh(tot_ * su1) * g1 * sv1;
            }
        }
        if (APPLY_L2PROBE && prep_ == 0 && p.ph_hi >= 0) {
#pragma unroll
            for (int i = 0; i < 16; ++i) acc[i] = 0.f;
        }
        }
        const int b = t / SEQ;
        const float* g2 = MOD + (size_t)(layer * 2 + b) * 6144 + 5120;
        float* xr = X + (size_t)t * D + lane * 16;
        f32x4 xs[4]; float ss = 0.f;
#pragma unroll
        for (int q = 0; q < 4; ++q) {
            const f32x4 g = *(const f32x4*)(g2 + lane * 16 + q * 4); f32x4 x = *(const f32x4*)(xr + q * 4);
            x.x += g.x * acc[q * 4 + 0]; x.y += g.y * acc[q * 4 + 1]; x.z += g.z * acc[q * 4 + 2]; x.w += g.w * acc[q * 4 + 3];
            xs[q] = x; ss += (x.x * x.x + x.y * x.y) + (x.z * x.z + x.w * x.w);
        }
        const float rs = rsqrtf(wave_sum(ss) * (1.0f / D) + RMS_EPS);
        if (!dry) {
            if (layer == 0) {
                const float* gw = p.in[2] + D + lane * 16; const float* sh = MOD + (size_t)(2 + b) * 6144 + lane * 16; const float* sc = sh + 1024;
                u32x4 o[2];
#pragma unroll
                for (int q = 0; q < 4; ++q) {
                    *(f32x4*)(xr + q * 4) = xs[q];
                    const f32x4 g = *(const f32x4*)(gw + q * 4), s1 = *(const f32x4*)(sc + q * 4), s0 = *(const f32x4*)(sh + q * 4);
                    const float y0 = xs[q].x * rs * g.x * (1.f + s1.x) + s0.x, y1 = xs[q].y * rs * g.y * (1.f + s1.y) + s0.y;
                    const float y2 = xs[q].z * rs * g.z * (1.f + s1.z) + s0.z, y3 = xs[q].w * rs * g.w * (1.f + s1.w) + s0.w;
                    if (q & 1) { o[q >> 1].z = pk2(y0, y1); o[q >> 1].w = pk2(y2, y3); } else { o[q >> 1].x = pk2(y0, y1); o[q >> 1].y = pk2(y2, y3); }
                }
                bf16_t* hm = (bf16_t*)(p.ws + WS_HM) + (size_t)t * D + lane * 16;
                *(u32x4*)hm = o[0]; *(u32x4*)(hm + 8) = o[1];
            } else {
                const float* gw = p.in[28] + lane * 16;
#pragma unroll
                for (int q = 0; q < 4; ++q) {
                    const f32x4 g = *(const f32x4*)(gw + q * 4);
                    *(f32x4*)(xr + q * 4) = (f32x4){xs[q].x * rs * g.x, xs[q].y * rs * g.y, xs[q].z * rs * g.z, xs[q].w * rs * g.w};
                }
            }
        }
    }
}
__device__ __forceinline__ void phase_tab1(const Params& p) {
    for (int it = blockIdx.x; it < 2 * P0_TAB; it += gridDim.x) {
        if (it < P0_TAB) cvt_fp8_item(p.in[26] + (size_t)PE * D, p.ws + WS_PU, (float*)(p.ws + WS_PU + 24 * MiB), it, false);
        else cvt_fp8_item(p.in[27] + (size_t)PE * D, p.ws + WS_PV, (float*)(p.ws + WS_PV + 24 * MiB), it - P0_TAB, false);
    }
}
__device__ __forceinline__ void phase_nsa_proj(const Params& p, unsigned char* lds) {
    const bf16_t* HM = (const bf16_t*)(p.ws + WS_HM); const bf16_t* WT = (const bf16_t*)(p.ws + WS_WPROJ_T);
    const f32x2* ROPE = (const f32x2*)(p.ws + WS_ROPE);
    bf16_t* Q = (bf16_t*)(p.ws + WS_Q); float* NGT = (float*)(p.ws + WS_NG);
    const int lane = threadIdx.x & 63, wid = threadIdx.x >> 6, wr = wid >> 1, wc = wid & 1, fr = lane & 15, fq = lane >> 4;
    for (int id = vblock(); id < 256 * 21; id += gridDim.x) {
        const int mt = id / 21, nt = id % 21;
        f32x4 acc[4][4];
        gemm_tile3(ALoadPlain{HM + (size_t)mt * 128 * D, (size_t)D}, WT + (size_t)nt * 128 * D, D, 16, acc, lds);
        const int c0 = nt * 128 + wc * 64;
        if (c0 >= 2624) continue;
        const int b = (mt * 128) / SEQ;
        if (c0 == 2560) {
#pragma unroll
            for (int mi = 0; mi < 4; ++mi)
#pragma unroll
                for (int ni = 0; ni < 3; ++ni) {
                    const int t = mt * 128 + wr * 64 + mi * 16 + fr;
                    const f32x4 v = acc[mi][ni];
                    *(f32x4*)(NGT + (size_t)t * 48 + ni * 16 + fq * 4) = (f32x4){sigmoidf_(v.x), sigmoidf_(v.y), sigmoidf_(v.z), sigmoidf_(v.w)};
                }
            continue;
        }
        int sec = -1, g = 0;
        if (c0 >= 1024) { sec = (c0 - 1024) >> 8; g = ((c0 - 1024) & 255) >> 6; }
        const bool dorope = (sec == -1) || (sec == 2) || (sec == 4);
        const float scl = (sec == -1) ? 0.125f : 1.0f;
        const size_t secoff[6] = {WS_KC, WS_VC, WS_KS, WS_VST, WS_KW, WS_VWT};
        size_t so = WS_Q;
#pragma unroll
        for (int q = 0; q < 6; ++q) if (sec == q) so = secoff[q];
        bf16_t* OUT = (bf16_t*)(p.ws + so);
        const bool vt = (sec == 3) || (sec == 5);
        float kblk_am = 0.f;
#pragma unroll
        for (int pass = 0; pass < 2; ++pass) {
        if (pass == 1 && sec == 2) {
#pragma unroll
            for (int o = 1; o < 64; o <<= 1) kblk_am = fmaxf(kblk_am, __shfl_xor(kblk_am, o));
            if (lane == 0) ((float*)(p.ws + WS_KS + 12 * MiB))[(size_t)(b * 4 + g) * 256 + ((mt * 128 + wr * 64 - b * SEQ) >> 6)] = kblk_am > 0.f ? kblk_am / 224.0f : 1.0f;
        }
#pragma unroll
        for (int mi = 0; mi < 4; ++mi) {
            const int t = mt * 128 + wr * 64 + mi * 16 + fr, s = t - b * SEQ;
            if (dorope && pass == 0) {
#pragma unroll
                for (int ni = 0; ni < 2; ++ni) {
                    const f32x4* rp = (const f32x4*)(ROPE + (size_t)s * 32 + ni * 16 + fq * 4);
                    const f32x4 r0 = rp[0], r1 = rp[1];
                    const f32x4 x1 = acc[mi][ni], x2 = acc[mi][ni + 2];
                    acc[mi][ni] = (f32x4){x1.x * r0.x - x2.x * r0.y, x1.y * r0.z - x2.y * r0.w, x1.z * r1.x - x2.z * r1.y, x1.w * r1.z - x2.w * r1.w};
                    acc[mi][ni + 2] = (f32x4){x1.x * r0.y + x2.x * r0.x, x1.y * r0.w + x2.y * r0.z, x1.z * r1.y + x2.z * r1.x, x1.w * r1.w + x2.w * r1.z};
                }
            }
            if (pass == 0) {
                if (sec == 2) {
#pragma unroll
                    for (int ni = 0; ni < 4; ++ni) { const f32x4 v = acc[mi][ni]; kblk_am = fmaxf(kblk_am, fmaxf(fmaxf(fabsf(v.x), fabsf(v.y)), fmaxf(fabsf(v.z), fabsf(v.w)))); }
                }
                continue;
            }
            if (sec == -1 || sec == 2) {
                float am = kblk_am;
                if (sec == -1) {
                    am = 0.f;
#pragma unroll
                    for (int ni = 0; ni < 4; ++ni) { const f32x4 v = acc[mi][ni] * scl; am = fmaxf(am, fmaxf(fmaxf(fabsf(v.x), fabsf(v.y)), fmaxf(fabsf(v.z), fabsf(v.w)))); }
                    am = fmaxf(am, __shfl_xor(am, 16)); am = fmaxf(am, __shfl_xor(am, 32));
                }
                const float qs = am > 0.f ? 224.0f / am : 1.0f;
                unsigned char* O8 = (sec == -1) ? (p.ws + WS_Q8 + (size_t)t * 1024 + c0) : (p.ws + WS_KS + ((size_t)(b * 4 + g) * SEQ + s) * 64);
#pragma unroll
                for (int ni = 0; ni < 4; ++ni) {
                    const f32x4 v = acc[mi][ni] * (scl * qs);
                    int w = 0; w = __builtin_amdgcn_cvt_pk_fp8_f32(v.x, v.y, w, false); w = __builtin_amdgcn_cvt_pk_fp8_f32(v.z, v.w, w, true);
                    *(int*)(O8 + ni * 16 + fq * 4) = w;
                }
                if (fq == 0 && sec == -1) ((float*)(p.ws + WS_Q8 + 32 * MiB))[(size_t)t * 16 + (c0 >> 6)] = am > 0.f ? am / 224.0f : 1.0f;
            }
            if (sec == 2) continue;
#pragma unroll
            for (int ni = 0; ni < 4; ++ni) {
                const f32x4 v = acc[mi][ni] * scl;
                const int d = ni * 16 + fq * 4;
                if (sec == -1) {
                    *(u32x2*)(OUT + (size_t)t * 1024 + c0 + d) = (u32x2){pk2(v.x, v.y), pk2(v.z, v.w)};
                } else if (sec == 4) {
                    const size_t idx = (size_t)(b * 4 + g) * SEQ * 64 + (size_t)(s >> 5) * 2048 + ((((s >> 4) & 1) * 2 + (ni >> 1)) * 16 + (s & 15)) * 32 + ((ni & 1) * 2 + (fq >> 1)) * 8 + (fq & 1) * 4;
                    *(u32x2*)(OUT + idx) = (u32x2){pk2(v.x, v.y), pk2(v.z, v.w)};
                } else if (!vt) {
                    *(u32x2*)(OUT + ((size_t)(b * 4 + g) * SEQ + s) * 64 + d) = (u32x2){pk2(v.x, v.y), pk2(v.z, v.w)};
                } else if (sec == 5) {
                    const int key = s & 31;
                    bf16_t* o = OUT + (size_t)(b * 4 + g) * SEQ * 64 + (size_t)(s >> 5) * 2048 + ((ni * 2 + (key >> 4)) * 16 + fq * 4) * 16 + ((key >> 2) & 3) * 4 + (key & 3);
                    o[0] = (bf16_t)f2bf(v.x); o[16] = (bf16_t)f2bf(v.y); o[32] = (bf16_t)f2bf(v.z); o[48] = (bf16_t)f2bf(v.w);
                }
            }
        }
        }
        if (sec == 3) {
            const int s0 = mt * 128 + wr * 64 - b * SEQ, jb = s0 >> 6;
            unsigned char* V8 = p.ws + WS_VST + (size_t)((b * 4 + g) * 256 + jb) * 4096;
            float am = 0.f;
#pragma unroll
            for (int mi = 0; mi < 4; ++mi)
#pragma unroll
                for (int ni = 0; ni < 4; ++ni) { const f32x4 v = acc[mi][ni]; am = fmaxf(am, fmaxf(fmaxf(fabsf(v.x), fabsf(v.y)), fmaxf(fabsf(v.z), fabsf(v.w)))); }
#pragma unroll
            for (int o = 1; o < 64; o <<= 1) am = fmaxf(am, __shfl_xor(am, o));
            const float qs = am > 0.f ? 224.0f / am : 1.0f;
            if (lane == 0) ((float*)(p.ws + WS_VST + 12 * MiB))[(size_t)(b * 4 + g) * 256 + jb] = am > 0.f ? am / 224.0f : 1.0f;
#pragma unroll
            for (int ni = 0; ni < 4; ++ni) {
                const int d = ni * 16 + fq * 4;
#pragma unroll
                for (int mi = 0; mi < 4; ++mi) {
                    const f32x4 v = acc[mi][ni] * qs;
                    int w = 0; w = __builtin_amdgcn_cvt_pk_fp8_f32(v.x, v.y, w, false); w = __builtin_amdgcn_cvt_pk_fp8_f32(v.z, v.w, w, true);
                    unsigned char* o = V8 + (size_t)d * 64 + mi * 16 + fr;
                    o[0] = (unsigned char)(w & 255); o[64] = (unsigned char)((w >> 8) & 255); o[128] = (unsigned char)((w >> 16) & 255); o[192] = (unsigned char)((unsigned)w >> 24);
                }
            }
        }
    }
}
__device__ __forceinline__ void phase_nsa_cmp1(const Params& p, unsigned char* lds) {
    bf16_t* HID = (bf16_t*)(p.ws + WS_HID);
    const float* bias = (const float*)(p.ws + WS_MISC);
    const int lane = threadIdx.x & 63, wid = threadIdx.x >> 6, wr = wid >> 1, wc = wid & 1, fr = lane & 15, fq = lane >> 4;
    for (int id = vblock(); id < 256; id += gridDim.x) {
        const int kv = id >> 7, bg = (id >> 4) & 7, mt = (id >> 1) & 7, nt = id & 1;
        const bf16_t* A = (const bf16_t*)(p.ws + (kv ? WS_VC : WS_KC)) + (size_t)bg * SEQ * 64 + (size_t)mt * 128 * 1024;
        const bf16_t* B = (const bf16_t*)(p.ws + (kv ? WS_WV1_T : WS_WK1_T)) + (size_t)nt * 128 * 2048;
        f32x4 acc[4][4];
        gemm_tile3(ALoadPlain{A, (size_t)1024}, B, 2048, 32, acc, lds);
#pragma unroll
        for (int mi = 0; mi < 4; ++mi)
#pragma unroll
            for (int ni = 0; ni < 4; ++ni) {
                const int n = mt * 128 + wr * 64 + mi * 16 + fr, c = nt * 128 + wc * 64 + ni * 16 + fq * 4;
                const f32x4 bv = *(const f32x4*)(bias + kv * 256 + c);
                const f32x4 v = acc[mi][ni] + bv;
                *(u32x2*)(HID + (((size_t)kv * 8 + bg) * 1024 + n) * 256 + c) = (u32x2){pk2(gelu_tanh(v.x), gelu_tanh(v.y)), pk2(gelu_tanh(v.z), gelu_tanh(v.w))};
            }
    }
}
__device__ __forceinline__ void phase_nsa_cmp2(const Params& p, unsigned char* lds) {
    const bf16_t* HID = (const bf16_t*)(p.ws + WS_HID);
    const f32x2* ROPE = (const f32x2*)(p.ws + WS_ROPE);
    bf16_t* KCMP = (bf16_t*)(p.ws + WS_KCMP); bf16_t* VCMPT = (bf16_t*)(p.ws + WS_VCMPT);
    const int lane = threadIdx.x & 63, wid = threadIdx.x >> 6, wr = wid >> 1, wc = wid & 1, fr = lane & 15, fq = lane >> 4;
    for (int id = vblock(); id < 128; id += gridDim.x) {
        const int kv = id >> 6, mt = id & 63;
        const bf16_t* A = HID + ((size_t)kv * 8192 + (size_t)mt * 128) * 256;
        const bf16_t* B = (const bf16_t*)(p.ws + (kv ? WS_WV2_T : WS_WK2_T));
        f32x4 acc[4][4];
        gemm_tile3(ALoadPlain{A, (size_t)256}, B, 256, 4, acc, lds);
        if (wc == 1) continue;
#pragma unroll
        for (int mi = 0; mi < 4; ++mi) {
            const int R = mt * 128 + wr * 64 + mi * 16 + fr, bg = R >> 10, n = R & 1023;
            if (kv == 0) {
                int pos = n * 16 + 31; pos = pos > SEQ - 1 ? SEQ - 1 : pos;
#pragma unroll
                for (int ni = 0; ni < 2; ++ni) {
                    const f32x4* rp = (const f32x4*)(ROPE + (size_t)pos * 32 + ni * 16 + fq * 4);
                    const f32x4 r0 = rp[0], r1 = rp[1];
                    const f32x4 x1 = acc[mi][ni], x2 = acc[mi][ni + 2];
                    acc[mi][ni] = (f32x4){x1.x * r0.x - x2.x * r0.y, x1.y * r0.z - x2.y * r0.w, x1.z * r1.x - x2.z * r1.y, x1.w * r1.z - x2.w * r1.w};
                    acc[mi][ni + 2] = (f32x4){x1.x * r0.y + x2.x * r0.x, x1.y * r0.w + x2.y * r0.z, x1.z * r1.y + x2.z * r1.x, x1.w * r1.w + x2.w * r1.z};
                }
#pragma unroll
                for (int ni = 0; ni < 4; ++ni) {
                    const f32x4 v = acc[mi][ni];
                    const size_t idx = (size_t)bg * 1024 * 64 + (size_t)(n >> 5) * 2048 + ((((n >> 4) & 1) * 2 + (ni >> 1)) * 16 + (n & 15)) * 32 + ((ni & 1) * 2 + (fq >> 1)) * 8 + (fq & 1) * 4;
                    *(u32x2*)(KCMP + idx) = (u32x2){pk2(v.x, v.y), pk2(v.z, v.w)};
                }
            } else {
#pragma unroll
                for (int ni = 0; ni < 4; ++ni) {
                    const f32x4 v = acc[mi][ni];
                    const int key = n & 31;
                    bf16_t* o = VCMPT + (size_t)bg * 1024 * 64 + (size_t)(n >> 5) * 2048 + ((ni * 2 + (key >> 4)) * 16 + fq * 4) * 16 + ((key >> 2) & 3) * 4 + (key & 3);
                    o[0] = (bf16_t)f2bf(v.x); o[16] = (bf16_t)f2bf(v.y); o[32] = (bf16_t)f2bf(v.z); o[48] = (bf16_t)f2bf(v.w);
                }
            }
        }
    }
}
__device__ __forceinline__ void phase_nsa_wo(const Params& p, unsigned char* lds, bool dry) {
    const bf16_t* O = (const bf16_t*)(p.ws + WS_O); const bf16_t* WT = (const bf16_t*)(p.ws + WS_WO_T);
    const float* MOD = (const float*)(p.ws + WS_MOD);
    float* X = p.out;
    const int lane = threadIdx.x & 63, wid = threadIdx.x >> 6, wr = wid >> 1, wc = wid & 1, fr = lane & 15, fq = lane >> 4;
    for (int id = vblock(); id < 256 * 8; id += gridDim.x) {
        const int mt = id >> 3, nt = id & 7;
        f32x4 acc[4][4];
        gemm_tile3(ALoadPlain{O + (size_t)mt * 128 * D, (size_t)D}, WT + (size_t)nt * 128 * D, D, 16, acc, lds);
        const int b = (mt * 128) / SEQ;
#pragma unroll
        for (int mi = 0; mi < 4; ++mi)
#pragma unroll
            for (int ni = 0; ni < 4; ++ni) {
                const int t = mt * 128 + wr * 64 + mi * 16 + fr, c = nt * 128 + wc * 64 + ni * 16 + fq * 4;
                const f32x4 g1 = *(const f32x4*)(MOD + (size_t)(1 * 2 + b) * 6144 + 2048 + c);
                float* xp = X + (size_t)t * D + c;
                const f32x4 x = *(const f32x4*)xp; const f32x4 v = acc[mi][ni];
                if (!dry) *(f32x4*)xp = (f32x4){x.x + g1.x * v.x, x.y + g1.y * v.y, x.z + g1.z * v.z, x.w + g1.w * v.w};
            }
    }
}
__device__ __forceinline__ bf16x8 pack8(const f32x4 a, const f32x4 b) {
    u32x4 w; w.x = pk2(a.x, a.y); w.y = pk2(a.z, a.w); w.z = pk2(b.x, b.y); w.w = pk2(b.z, b.w);
    return __builtin_bit_cast(bf16x8, w);
}
__device__ __forceinline__ bf16x8 ldv8(const bf16_t* plo, const bf16_t* phi) {
    const u32x2 lo = *(const u32x2*)plo, hi = *(const u32x2*)phi;
    u32x4 w; w.x = lo.x; w.y = lo.y; w.z = hi.x; w.w = hi.y;
    return __builtin_bit_cast(bf16x8, w);
}
__device__ __forceinline__ float red4(float v) { v += __shfl_xor(v, 16); v += __shfl_xor(v, 32); return v; }
__device__ __forceinline__ float max4(float v) { v = fmaxf(v, __shfl_xor(v, 16)); v = fmaxf(v, __shfl_xor(v, 32)); return v; }
#define NEGBIG (-1.0e30f)

__device__ __forceinline__ void phase_nsa_attn(const Params& p, unsigned char* lds, const int rep_cmp, const int rep_win, const int rep_sel) {
    const int lane = threadIdx.x & 63, wave = threadIdx.x >> 6, fr = lane & 15, fq = lane >> 4;
    unsigned char* WL = lds + wave * 18432;
    float* IMP = (float*)WL;
    int* SEL = (int*)(WL + 17408);
    const bf16_t* Q = (const bf16_t*)(p.ws + WS_Q);
    const bf16_t* KCMP = (const bf16_t*)(p.ws + WS_KCMP); const bf16_t* VCMPT = (const bf16_t*)(p.ws + WS_VCMPT);
    const bf16_t* KW = (const bf16_t*)(p.ws + WS_KW); const bf16_t* VWT = (const bf16_t*)(p.ws + WS_VWT);
    const float* NGT = (const float*)(p.ws + WS_NG);
    bf16_t* O = (bf16_t*)(p.ws + WS_O);
    const f32x4 z4 = (f32x4){0.f, 0.f, 0.f, 0.f};
    for (int bi = blockIdx.x; bi < 2048; bi += gridDim.x) {
        const int bg = bi & 7, quad = 255 - (bi >> 3), t0 = (quad * 4 + wave) * 16, b = bg >> 2, g = bg & 3;
        const int cur = t0 >> 6;
        const size_t tok = (size_t)b * SEQ + t0 + fr;
        const int tq = t0 + fr;
        bf16x8 qf[4][2];
#pragma unroll
        for (int r = 0; r < 4; ++r)
#pragma unroll
            for (int ks = 0; ks < 2; ++ks) qf[r][ks] = *(const bf16x8*)(Q + tok * 1024 + (g * 4 + r) * 64 + ks * 32 + fq * 8);
        f32x4 acc[4][4];
        for (int rep = 0; rep < rep_win; ++rep) {
            const bf16_t* kwb = KW + (size_t)bg * SEQ * 64; const bf16_t* vwb = VWT + (size_t)bg * SEQ * 64;
            float mw[4], lw[4];
#pragma unroll
            for (int r = 0; r < 4; ++r) { mw[r] = NEGBIG; lw[r] = 0.f;
#pragma unroll
                for (int df = 0; df < 4; ++df) acc[r][df] = z4; }
            int kmin = t0 - 511; kmin = kmin < 0 ? 0 : kmin; kmin &= ~31;
            bf16x8 nkf[2][2];
#define WIN_LOAD(kb_) do { _Pragma("unroll") for (int f = 0; f < 2; ++f) _Pragma("unroll") for (int ks = 0; ks < 2; ++ks) nkf[f][ks] = *(const bf16x8*)(kwb + (size_t)((kb_) >> 5) * 2048 + ((f * 2 + ks) * 16 + fr) * 32 + fq * 8); } while (0)
            WIN_LOAD(kmin);
            for (int kb = kmin; kb <= t0 + 15; kb += 32) {
                bf16x8 kf[2][2], vf[4];
#pragma unroll
                for (int f = 0; f < 2; ++f) { kf[f][0] = nkf[f][0]; kf[f][1] = nkf[f][1]; }
#pragma unroll
                for (int df = 0; df < 4; ++df) { const bf16_t* vp = vwb + (size_t)(kb >> 5) * 2048 + (df * 32 + fr) * 16 + fq * 4; vf[df] = ldv8(vp, vp + 256); }
                { const int kn = (kb + 32 <= t0 + 15) ? kb + 32 : kb; WIN_LOAD(kn); }
#pragma unroll
                for (int r = 0; r < 4; ++r) {
                    f32x4 st[2];
#pragma unroll
                    for (int f = 0; f < 2; ++f) {
                        st[f] = __builtin_amdgcn_mfma_f32_16x16x32_bf16(kf[f][0], qf[r][0], z4, 0, 0, 0);
                        st[f] = __builtin_amdgcn_mfma_f32_16x16x32_bf16(kf[f][1], qf[r][1], st[f], 0, 0, 0);
                    }
                    float mx = NEGBIG;
#pragma unroll
                    for (int f = 0; f < 2; ++f)
#pragma unroll
                        for (int e = 0; e < 4; ++e) { const int key = kb + f * 16 + fq * 4 + e; const bool ok = (key <= tq) && (key > tq - 512); if (ok) mx = fmaxf(mx, st[f][e]); }
                    mx = max4(mx);
                    const float mn = fmaxf(mw[r], mx);
                    const float al = __expf(mw[r] - mn);
                    float ps = 0.f;
#pragma unroll
                    for (int f = 0; f < 2; ++f)
#pragma unroll
                        for (int e = 0; e < 4; ++e) { const int key = kb + f * 16 + fq * 4 + e; const bool ok = (key <= tq) && (key > tq - 512); const float pv = ok ? __expf(st[f][e] - mn) : 0.f; st[f][e] = pv; ps += pv; }
                    lw[r] = lw[r] * al + ps; mw[r] = mn;
                    const bf16x8 pf = pack8(st[0], st[1]);
#pragma unroll
                    for (int df = 0; df < 4; ++df) { acc[r][df] = acc[r][df] * al; acc[r][df] = __builtin_amdgcn_mfma_f32_16x16x32_bf16(vf[df], pf, acc[r][df], 0, 0, 0); }
                    __builtin_amdgcn_sched_barrier(0);
                }
            }
#pragma unroll
            for (int r = 0; r < 4; ++r) {
                const float l = red4(lw[r]); const float sc = NGT[tok * 48 + (g * 4 + r) * 3 + 2] / l;
#pragma unroll
                for (int df = 0; df < 4; ++df) acc[r][df] = acc[r][df] * sc;
            }
#undef WIN_LOAD
        }
        const int nmax_tile = (t0 >> 4) - 1, nmax_lane = (t0 >> 4) - 2 + (fr == 15 ? 1 : 0);
        const bf16_t* kcb = KCMP + (size_t)bg * 1024 * 64; const bf16_t* vcb = VCMPT + (size_t)bg * 64 * 1024;
        for (int rep = 0; rep < rep_cmp; ++rep) {
            const bool dry = (rep + 1 < rep_cmp);
            float mc[4], lc[4], invl[4];
#pragma unroll
            for (int r = 0; r < 4; ++r) { mc[r] = NEGBIG; lc[r] = 0.f; }
            bf16x8 nkc[2][2], nvc[4];
#define CMPK_LOAD(nb_) do { _Pragma("unroll") for (int f = 0; f < 2; ++f) _Pragma("unroll") for (int ks = 0; ks < 2; ++ks) nkc[f][ks] = *(const bf16x8*)(kcb + (size_t)((nb_) >> 5) * 2048 + ((f * 2 + ks) * 16 + fr) * 32 + fq * 8); } while (0)
#define CMPV_LOAD(nb_) do { _Pragma("unroll") for (int df = 0; df < 4; ++df) { const bf16_t* vp = vcb + (size_t)((nb_) >> 5) * 2048 + (df * 32 + fr) * 16 + fq * 4; nvc[df] = ldv8(vp, vp + 256); } } while (0)
            CMPK_LOAD(0);
            for (int nb = 0; nb <= nmax_tile; nb += 32) {
                bf16x8 kf[2][2];
#pragma unroll
                for (int f = 0; f < 2; ++f) { kf[f][0] = nkc[f][0]; kf[f][1] = nkc[f][1]; }
                { const int nn = (nb + 32 <= nmax_tile) ? nb + 32 : 0; CMPK_LOAD(nn); }
#pragma unroll
                for (int r = 0; r < 4; ++r) {
                    f32x4 st[2];
#pragma unroll
                    for (int f = 0; f < 2; ++f) {
                        st[f] = __builtin_amdgcn_mfma_f32_16x16x32_bf16(kf[f][0], qf[r][0], z4, 0, 0, 0);
                        st[f] = __builtin_amdgcn_mfma_f32_16x16x32_bf16(kf[f][1], qf[r][1], st[f], 0, 0, 0);
                    }
                    float mx = NEGBIG;
#pragma unroll
                    for (int f = 0; f < 2; ++f)
#pragma unroll
                        for (int e = 0; e < 4; ++e) { const int n = nb + f * 16 + fq * 4 + e; if (n <= nmax_lane) mx = fmaxf(mx, st[f][e]); }
                    mx = max4(mx);
                    const float mn = fmaxf(mc[r], mx);
                    float ps = 0.f;
#pragma unroll
                    for (int f = 0; f < 2; ++f)
#pragma unroll
                        for (int e = 0; e < 4; ++e) { const int n = nb + f * 16 + fq * 4 + e; if (n <= nmax_lane) ps += __expf(st[f][e] - mn); }
                    lc[r] = lc[r] * __expf(mc[r] - mn) + ps; mc[r] = mn;
                    __builtin_amdgcn_sched_barrier(0);
                }
            }
#pragma unroll
            for (int r = 0; r < 4; ++r) { const float l = red4(lc[r]); invl[r] = l > 0.f ? 1.0f / l : 0.f; }
            for (int i = lane; i < 16 * 260; i += 64) IMP[i] = 0.f;
            float carry = 0.f;
            float gc[4];
#pragma unroll
            for (int r = 0; r < 4; ++r) gc[r] = NGT[tok * 48 + (g * 4 + r) * 3];
            for (int nb = 0; nb <= nmax_tile; nb += 32) {
                bf16x8 kf[2][2], vf[4];
#pragma unroll
                for (int f = 0; f < 2; ++f) { kf[f][0] = nkc[f][0]; kf[f][1] = nkc[f][1]; }
                CMPV_LOAD(nb);
#pragma unroll
                for (int df = 0; df < 4; ++df) vf[df] = nvc[df];
                { const int nn = (nb + 32 <= nmax_tile) ? nb + 32 : nb; CMPK_LOAD(nn); }
                f32x4 pg[2] = {z4, z4};
#pragma unroll
                for (int r = 0; r < 4; ++r) {
                    f32x4 st[2];
#pragma unroll
                    for (int f = 0; f < 2; ++f) {
                        st[f] = __builtin_amdgcn_mfma_f32_16x16x32_bf16(kf[f][0], qf[r][0], z4, 0, 0, 0);
                        st[f] = __builtin_amdgcn_mfma_f32_16x16x32_bf16(kf[f][1], qf[r][1], st[f], 0, 0, 0);
#pragma unroll
                        for (int e = 0; e < 4; ++e) { const int n = nb + f * 16 + fq * 4 + e; st[f][e] = (n <= nmax_lane) ? __expf(st[f][e] - mc[r]) * invl[r] : 0.f; }
                        pg[f] += st[f];
                    }
                    const float gg = dry ? 0.f : gc[r];
                    const bf16x8 pf = pack8(st[0] * gg, st[1] * gg);
#pragma unroll
                    for (int df = 0; df < 4; ++df) acc[r][df] = __builtin_amdgcn_mfma_f32_16x16x32_bf16(vf[df], pf, acc[r][df], 0, 0, 0);
                    __builtin_amdgcn_sched_barrier(0);
                }
                const int src = (lane - 16) & 63;
                const float s0 = __shfl(pg[0].w, src), s1 = __shfl(pg[1].w, src), sc = __shfl(carry, src);
                const float prev0 = fq > 0 ? s0 : sc, prev1 = fq > 0 ? s1 : s0;
                const float imp0 = (pg[0].x + pg[0].y) + (pg[0].z + pg[0].w) + prev0;
                const float imp1 = (pg[1].x + pg[1].y) + (pg[1].z + pg[1].w) + prev1;
                const int jb = (nb >> 2) + fq;
                IMP[fr * 260 + jb] = imp0; IMP[fr * 260 + jb + 4] = imp1;
                carry = pg[1].w;
            }
#undef CMPK_LOAD
#undef CMPV_LOAD
        }
        {
            const int nf = cur >= 2 ? 3 : cur + 1;
            if (fq == 0) {
                SEL[fr * 16 + 0] = 0;
                if (cur == 1) SEL[fr * 16 + 1] = 1;
                if (cur >= 2) { SEL[fr * 16 + 1] = cur - 1; SEL[fr * 16 + 2] = cur; }
            }
            const int ncand = cur >= 3 ? cur - 2 : 0, extra = 16 - nf;
            if (ncand <= extra) {
                if (fq == 0) { for (int k = 0; k < extra; ++k) SEL[fr * 16 + nf + k] = (k < ncand) ? 1 + k : -1; }
            } else {
                for (int rnd = 0; rnd < extra; ++rnd) {
                    float bv = -1.0f; int bj = 1 << 20;
                    for (int jb = 1 + fq; jb <= cur - 2; jb += 4) { const float v = IMP[fr * 260 + jb]; if (v > bv) { bv = v; bj = jb; } }
#pragma unroll
                    for (int o = 16; o <= 32; o <<= 1) {
                        const float ov = __shfl_xor(bv, o); const int oj = __shfl_xor(bj, o);
                        if (ov > bv || (ov == bv && oj < bj)) { bv = ov; bj = oj; }
                    }
                    if (fq == 0) SEL[fr * 16 + nf + rnd] = bj;
                    if (((bj - 1) & 3) == fq) IMP[fr * 260 + bj] = -2.0f;
                }
            }
        }
#pragma unroll
        for (int r = 0; r < 4; ++r)
#pragma unroll
            for (int df = 0; df < 4; ++df) {
                const f32x4 v = acc[r][df];
                *(u32x2*)(O + tok * 1024 + (g * 4 + r) * 64 + df * 16 + fq * 4) = (u32x2){pk2(v.x, v.y), pk2(v.z, v.w)};
            }
        asm volatile("s_waitcnt vmcnt(0)" ::: "memory");
        unsigned selp[4];
        {
            const u32x4* sp = (const u32x4*)(SEL + fr * 16);
#pragma unroll
            for (int q = 0; q < 4; ++q) { const u32x4 w = sp[q]; selp[q] = (w.x & 255u) | ((w.y & 255u) << 8) | ((w.z & 255u) << 16) | ((w.w & 255u) << 24); }
        }
        for (int rep = 0; rep < rep_sel; ++rep) {
            const bool dry = (rep + 1 < rep_sel);
            const unsigned char* k8b = p.ws + WS_KS + (size_t)bg * SEQ * 64; const unsigned char* v8b = p.ws + WS_VST + (size_t)bg * 256 * 4096;
            const float* skb = (const float*)(p.ws + WS_KS + 12 * MiB) + (size_t)bg * 256; const float* svb = (const float*)(p.ws + WS_VST + 12 * MiB) + (size_t)bg * 256;
            const unsigned char* Q8 = p.ws + WS_Q8; const float* SQ8 = (const float*)(p.ws + WS_Q8 + 32 * MiB);
            const int nv = cur + 1 < 16 ? cur + 1 : 16, npair = (nv + 1) >> 1, total = 16 * npair;
            const int lrow = lane >> 2, lch = lane & 3;
            const int woff = lrow * 72 + lch * 16;
            const int rr = fr & 3;
            u32x4 sk[2][4], sv[2][4]; float ssk[2], ssv[2];
            int jbn[2];
#define SEL_GET(tokI, slotK) ((int)(((unsigned)__builtin_amdgcn_readlane((int)(((slotK) >> 2) == 0 ? selp[0] : ((slotK) >> 2) == 1 ? selp[1] : ((slotK) >> 2) == 2 ? selp[2] : selp[3]), (tokI)) >> (((slotK) & 3) * 8)) & 255u))
#define SEL_ISSUE(tokI, pairP) do { \
                const int k0_ = 2 * (pairP), k1_ = (2 * (pairP) + 1 < nv) ? 2 * (pairP) + 1 : k0_; \
                jbn[0] = SEL_GET(tokI, k0_); jbn[1] = SEL_GET(tokI, k1_); \
                _Pragma("unroll") for (int u = 0; u < 2; ++u) { \
                    const unsigned char* kb_ = k8b + (size_t)jbn[u] * 4096; const unsigned char* vb_ = v8b + (size_t)jbn[u] * 4096; \
                    _Pragma("unroll") for (int j = 0; j < 4; ++j) { sk[u][j] = *(const u32x4*)(kb_ + j * 1024 + lane * 16); sv[u][j] = *(const u32x4*)(vb_ + j * 1024 + lane * 16); } \
                    ssk[u] = skb[jbn[u]]; ssv[u] = svb[jbn[u]]; } } while (0)
            SEL_ISSUE(0, 0);
            long qs8[2] = {0, 0};
            float sq = 0.f, ms = NEGBIG, ls = 0.f;
            f32x4 os[4] = {z4, z4, z4, z4};
            u32x2 oprev[4] = {(u32x2){0u, 0u}, (u32x2){0u, 0u}, (u32x2){0u, 0u}, (u32x2){0u, 0u}};
            int i = 0, pp = 0;
            for (int v = 0; v < total; ++v) {
                const int jb0 = jbn[0], jb1 = jbn[1];
                const bool second_valid = (2 * pp + 1 < nv);
                const float ck0 = ssk[0], ck1 = ssk[1], cv0 = ssv[0], cv1 = ssv[1];
#pragma unroll
                for (int u = 0; u < 2; ++u)
#pragma unroll
                    for (int j = 0; j < 4; ++j) {
                        unsigned char* kd = WL + u * 9216 + woff + j * 1152; unsigned char* vd = kd + 4608;
                        *(u32x2*)kd = (u32x2){sk[u][j].x, sk[u][j].y}; *(u32x2*)(kd + 8) = (u32x2){sk[u][j].z, sk[u][j].w};
                        *(u32x2*)vd = (u32x2){sv[u][j].x, sv[u][j].y}; *(u32x2*)(vd + 8) = (u32x2){sv[u][j].z, sv[u][j].w};
                    }
                if (v + 1 < total) {
                    int p2 = pp + 1, i2 = i; if (p2 == npair) { p2 = 0; i2 = i + 1; }
                    SEL_ISSUE(i2, p2);
                }
                __builtin_amdgcn_sched_barrier(0);
                const int ti = t0 + i;
                if (pp == 0) {
                    const size_t tk = (size_t)b * SEQ + ti;
#pragma unroll
                    for (int ks = 0; ks < 2; ++ks) qs8[ks] = *(const long*)(Q8 + tk * 1024 + (g * 4 + rr) * 64 + ks * 32 + fq * 8);
                    sq = SQ8[tk * 16 + g * 4 + rr] * 1.4426950408889634f;
                    ms = NEGBIG; ls = 0.f;
#pragma unroll
                    for (int df = 0; df < 4; ++df) { os[df] = z4; oprev[df] = *(const u32x2*)(O + tk * 1024 + (g * 4 + rr) * 64 + df * 16 + fq * 4); }
                }
                f32x4 st[2][4];
#pragma unroll
                for (int u = 0; u < 2; ++u)
#pragma unroll
                    for (int f = 0; f < 4; ++f) {
                        const unsigned char* kp = WL + u * 9216 + (f * 16 + fr) * 72 + fq * 8;
                        const long k0 = *(const long*)kp, k1 = *(const long*)(kp + 32);
                        st[u][f] = __builtin_amdgcn_mfma_f32_16x16x32_fp8_fp8(k0, qs8[0], z4, 0, 0, 0);
                        st[u][f] = __builtin_amdgcn_mfma_f32_16x16x32_fp8_fp8(k1, qs8[1], st[u][f], 0, 0, 0);
                    }
                const float c0_ = sq * ck0, c1_ = sq * ck1;
                if (jb0 == cur || jb1 == cur || !second_valid) {
#pragma unroll
                    for (int u = 0; u < 2; ++u) {
                        const int jbu = u ? jb1 : jb0;
                        const bool allbad = (u == 1) && !second_valid;
#pragma unroll
                        for (int f = 0; f < 4; ++f)
#pragma unroll
                            for (int e = 0; e < 4; ++e) { const int key = jbu * 64 + f * 16 + fq * 4 + e; if (allbad || key > ti) st[u][f][e] = NEGBIG; }
                    }
                }
                float mx0 = NEGBIG, mx1 = NEGBIG;
#pragma unroll
                for (int f = 0; f < 4; ++f) { mx0 = fmaxf(mx0, fmaxf(fmaxf(st[0][f].x, st[0][f].y), fmaxf(st[0][f].z, st[0][f].w))); mx1 = fmaxf(mx1, fmaxf(fmaxf(st[1][f].x, st[1][f].y), fmaxf(st[1][f].z, st[1][f].w))); }
                const float mx = max4(fmaxf(mx0 > -1.0e29f ? mx0 * c0_ : NEGBIG, mx1 > -1.0e29f ? mx1 * c1_ : NEGBIG));
                const float mn = fmaxf(ms, mx);
                const float al = __builtin_amdgcn_exp2f(ms - mn);
                const float off = 8.0f - mn;
                float ps = 0.f;
#pragma unroll
                for (int u = 0; u < 2; ++u) {
                    const float cu = u ? c1_ : c0_;
#pragma unroll
                    for (int f = 0; f < 4; ++f)
#pragma unroll
                        for (int e = 0; e < 4; ++e) { const float pv = (st[u][f][e] > -1.0e29f) ? __builtin_amdgcn_exp2f(st[u][f][e] * cu + off) : 0.f; st[u][f][e] = pv; ps += pv; }
                }
                ls = ls * al + ps; ms = mn;
#pragma unroll
                for (int df = 0; df < 4; ++df) os[df] = os[df] * al;
#pragma unroll
                for (int u = 0; u < 2; ++u) {
                    f32x4 pvacc[4] = {z4, z4, z4, z4};
#pragma unroll
                    for (int s = 0; s < 2; ++s) {
                        int w0 = 0, w1 = 0;
                        w0 = __builtin_amdgcn_cvt_pk_fp8_f32(st[u][2 * s].x, st[u][2 * s].y, w0, false); w0 = __builtin_amdgcn_cvt_pk_fp8_f32(st[u][2 * s].z, st[u][2 * s].w, w0, true);
                        w1 = __builtin_amdgcn_cvt_pk_fp8_f32(st[u][2 * s + 1].x, st[u][2 * s + 1].y, w1, false); w1 = __builtin_amdgcn_cvt_pk_fp8_f32(st[u][2 * s + 1].z, st[u][2 * s + 1].w, w1, true);
                        const long pf = (long)(((unsigned long long)(unsigned)w1 << 32) | (unsigned long long)(unsigned)w0);
#pragma unroll
                        for (int df = 0; df < 4; ++df) {
                            const unsigned char* vp = WL + u * 9216 + 4608 + (df * 16 + fr) * 72 + 32 * s + 4 * fq;
                            const unsigned lo = *(const unsigned*)vp, hi = *(const unsigned*)(vp + 16);
                            const long vf = (long)(((unsigned long long)hi << 32) | (unsigned long long)lo);
                            pvacc[df] = __builtin_amdgcn_mfma_f32_16x16x32_fp8_fp8(vf, pf, pvacc[df], 0, 0, 0);
                        }
                    }
                    const float cvu = u ? cv1 : cv0;
#pragma unroll
                    for (int df = 0; df < 4; ++df) os[df] = os[df] + pvacc[df] * cvu;
                    __builtin_amdgcn_sched_barrier(0);
                }
                if (pp == npair - 1) {
                    const float l = red4(ls);
                    const float gsv = NGT[((size_t)b * SEQ + ti) * 48 + (g * 4 + rr) * 3 + 1];
                    const float sc = gsv / l;
                    if (fr < 4 && !dry) {
                        bf16_t* op = O + ((size_t)b * SEQ + ti) * 1024 + (g * 4 + fr) * 64 + fq * 4;
#pragma unroll
                        for (int df = 0; df < 4; ++df) {
                            const f32x4 val = os[df] * sc; const u32x2 c = oprev[df];
                            *(u32x2*)(op + df * 16) = (u32x2){pk2(bflo(c.x) + val.x, bfhi(c.x) + val.y), pk2(bflo(c.y) + val.z, bfhi(c.y) + val.w)};
                        }
                    }
                }
                ++pp; if (pp == npair) { pp = 0; ++i; }
            }
#undef SEL_GET
#undef SEL_ISSUE
        }
    }
}
constexpr int NPHASES = 23;
#ifndef PROBE_PHASE
#define PROBE_PHASE (-1)
#endif
#ifndef ATT_REP_CMP
#define ATT_REP_CMP 1
#endif
#ifndef ATT_REP_WIN
#define ATT_REP_WIN 1
#endif
#ifndef ATT_REP_SEL
#define ATT_REP_SEL 1
#endif
#ifndef TS_PHASE
#define TS_PHASE (-1)
#endif
#ifndef TS_MULT
#define TS_MULT 4
#endif
#ifndef PROBE_REPS
#define PROBE_REPS 1
#endif
__global__ void __launch_bounds__(NTHREADS, 2) mega(Params p) {
    __shared__ __attribute__((aligned(1024))) unsigned char lds[LDS_BYTES + 16];
    unsigned* bar_st = (unsigned*)(lds + LDS_BYTES);
    cg::grid_group grid = cg::this_grid();
    const float* MOD = (const float*)(p.ws + WS_MOD);
    bf16_t* HM = (bf16_t*)(p.ws + WS_HM);
    if (threadIdx.x < 4) bar_st[threadIdx.x] = 0u;
    __syncthreads();
    XcdBarrier bar = xcd_barrier_post((unsigned*)(p.ws + WS_CTL), (volatile LAS unsigned*)bar_st);
    const int lo = p.ph_lo, hi = p.ph_hi;
    const bool dry0 = (p.ph_hi < 0);
    const int opq = (p.ph_hi < 0) ? 1 : 0;
    unsigned long long ts_a = 0ull, ts_b = 0ull;
#define PHASE(k, call, drycall) if (lo <= (k) && (k) < hi) { \
        if (TS_PHASE == (k)) ts_a = __builtin_amdgcn_s_memrealtime(); \
        if (PROBE_PHASE == (k)) { for (int rep = 0; rep < PROBE_REPS; ++rep) { const bool dry = !dry0; drycall; __syncthreads(); } } \
        { const bool dry = dry0; call; } \
        if ((k) + 1 < hi) { if ((k) == 0) grid.sync(); else xcd_barrier(bar); } \
        if (TS_PHASE == (k)) ts_b = __builtin_amdgcn_s_memrealtime(); }
    PHASE(0, phase_prep(p, (float*)lds), phase_prep(p, (float*)lds))
    PHASE(1, phase_norm(p, p.in[0], p.in[2], MOD + 0, MOD + 1024, HM), phase_norm(p, p.in[0], p.in[2], MOD + 0, MOD + 1024, HM))
    PHASE(2, phase_s5_win(p, lds), phase_s5_win(p, lds))
    PHASE(3, phase_s5_a(p, lds), phase_s5_a(p, lds))
    PHASE(4, phase_s5_scan(p), phase_s5_scan(p))
    PHASE(5, phase_s5_b(p, lds), phase_s5_b(p, lds))
    PHASE(6, phase_s5_glu(p, lds), phase_s5_glu(p, lds))
    PHASE(7, phase_norm(p, p.out, p.in[3], MOD + 3072, MOD + 4096, HM), phase_norm(p, p.out, p.in[3], MOD + 3072, MOD + 4096, HM))
    PHASE(8, phase_peer_wq(p, 0, lds), phase_peer_wq(p, 0, lds))
    PHASE(9, phase_peer_topk(p, 0, lds), phase_peer_topk(p, 0, lds))
    PHASE(10, phase_peer_combine(p, lds), phase_peer_combine(p, lds))
    PHASE(11, phase_peer_apply(p, 0, lds, dry), phase_peer_apply(p, 0, lds, dry))
    PHASE(12, phase_tab1(p), phase_tab1(p))
    PHASE(13, phase_nsa_proj(p, lds), phase_nsa_proj(p, lds))
    PHASE(14, phase_nsa_cmp1(p, lds), phase_nsa_cmp1(p, lds))
    PHASE(15, phase_nsa_cmp2(p, lds), phase_nsa_cmp2(p, lds))
    PHASE(16, phase_nsa_attn(p, lds, ATT_REP_CMP + opq, ATT_REP_WIN + opq, ATT_REP_SEL + opq), phase_nsa_attn(p, lds, 1 + opq, 1 + opq, 1 + opq))
    PHASE(17, phase_nsa_wo(p, lds, dry), phase_nsa_wo(p, lds, dry))
    PHASE(18, phase_norm(p, p.out, p.in[3] + D, MOD + 2 * 6144 + 3072, MOD + 2 * 6144 + 4096, HM), phase_norm(p, p.out, p.in[3] + D, MOD + 2 * 6144 + 3072, MOD + 2 * 6144 + 4096, HM))
    PHASE(19, phase_peer_wq(p, 1, lds), phase_peer_wq(p, 1, lds))
    PHASE(20, phase_peer_topk(p, 1, lds), phase_peer_topk(p, 1, lds))
    PHASE(21, phase_peer_combine(p, lds), phase_peer_combine(p, lds))
    PHASE(22, phase_peer_apply(p, 1, lds, dry), phase_peer_apply(p, 1, lds, dry))
#undef PHASE
    if (TS_PHASE >= 0 && blockIdx.x == 0 && threadIdx.x == 0) {
        const unsigned long long t0 = __builtin_amdgcn_s_memrealtime(), want = (ts_b - ts_a) * TS_MULT;
        while (__builtin_amdgcn_s_memrealtime() - t0 < want) __builtin_amdgcn_s_sleep(8);
    }
}

extern "C" void kernel_launch(void* const* d_in, const int* in_sizes, int n_in, void* d_out, int out_size, void* d_ws, size_t ws_size, hipStream_t stream) {
    static int grid_blocks = 0;
    if (!grid_blocks) {
        int dev = 0, cus = 0, per_cu = 0;
        hipGetDevice(&dev);
        hipDeviceGetAttribute(&cus, hipDeviceAttributeMultiprocessorCount, dev);
        hipOccupancyMaxActiveBlocksPerMultiprocessor(&per_cu, mega, NTHREADS, 0);
        if (per_cu > 2) per_cu = 2;
        if (per_cu < 1) per_cu = 1;
        grid_blocks = cus * per_cu;
        if (ws_size < WS_END) fprintf(stderr, "kernel_launch: workspace too small: %zu < %zu\n", ws_size, (size_t)WS_END);
        if (n_in != 29) fprintf(stderr, "kernel_launch: expected 29 inputs, got %d\n", n_in);
    }
    hipMemsetAsync((unsigned char*)d_ws + WS_CTL, 0, 16384, stream);
    Params p{};
    for (int i = 0; i < 29; ++i) p.in[i] = (const float*)d_in[i];
    p.out = (float*)d_out; p.ws = (unsigned char*)d_ws;
#if SINGLE_LAUNCH
    p.ph_lo = 0; p.ph_hi = NPHASES;
    void* args[] = {&p};
    hipError_t e = hipLaunchCooperativeKernel((void*)mega, dim3(grid_blocks), dim3(NTHREADS), args, 0, stream);
    if (e != hipSuccess) fprintf(stderr, "cooperative launch failed: %s (grid %d)\n", hipGetErrorString(e), grid_blocks);
#else
    for (int ph = 0; ph < NPHASES; ++ph) {
        p.ph_lo = ph; p.ph_hi = ph + 1;
        hipLaunchKernelGGL(mega, dim3(grid_blocks), dim3(NTHREADS), 0, stream, p);
    }
#endif
}
```

```cpp
#include <hip/hip_runtime.h>
#include <hip/hip_cooperative_groups.h>
#include <cstdio>
#include <cstdint>
namespace cg = cooperative_groups;

#ifndef SINGLE_LAUNCH
#define SINGLE_LAUNCH 1
#endif

typedef unsigned short bf16_t;
typedef short bf16x8 __attribute__((ext_vector_type(8)));
typedef float f32x4 __attribute__((ext_vector_type(4)));
typedef float f32x2 __attribute__((ext_vector_type(2)));
typedef unsigned u32x4 __attribute__((ext_vector_type(4)));
typedef unsigned u32x2 __attribute__((ext_vector_type(2)));
typedef __bf16 bf16x2_t __attribute__((ext_vector_type(2)));

constexpr int D = 1024, BATCH = 2, SEQ = 16384, T = BATCH * SEQ;
constexpr int NTHREADS = 256;
constexpr float RMS_EPS = 1e-6f;
constexpr int S5G = 64, S5P = 64, S5L = 32, S5NCH = T / S5L  , S5CPB = SEQ / S5L  ;
constexpr int NH = 16, HD = 64, NG = 4, NPROJ = 2608, NPROJ_PAD = 2688, NC = 1023, NSB = 256;
constexpr int PH = 8, PK = 16, PNK = 128, PE = 16384;

constexpr size_t MiB = 1ull << 20;
constexpr size_t WS_CTL = 0;
constexpr size_t WS_MOD = 1 * MiB;
constexpr size_t WS_WIN_T = 2 * MiB;
constexpr size_t WS_WGLU_T = 4 * MiB;
constexpr size_t WS_WPROJ_T = 8 * MiB;
constexpr size_t WS_WK1_T = 14 * MiB;
constexpr size_t WS_WV1_T = 15 * MiB;
constexpr size_t WS_WK2_T = 16 * MiB;
constexpr size_t WS_WV2_T = 16 * MiB + 512 * 1024;
constexpr size_t WS_WO_T = 17 * MiB;
constexpr size_t WS_WQ_T = 19 * MiB;
constexpr size_t WS_SUBK = 27 * MiB;
constexpr size_t WS_ROPE = 28 * MiB;
constexpr size_t WS_MISC = 32 * MiB;
constexpr size_t WS_TW = 33 * MiB;
constexpr size_t WS_VG = 73 * MiB;
constexpr size_t WS_PU = 82 * MiB;
constexpr size_t WS_PV = 114 * MiB;
constexpr size_t WS_HM = 146 * MiB;
constexpr size_t WS_C = 210 * MiB;
constexpr size_t WS_UG = WS_C;
constexpr size_t WS_YI = WS_C + 64 * MiB;
constexpr size_t WS_WST = WS_C + 128 * MiB;
constexpr size_t WS_SST = WS_C + 160 * MiB;
constexpr size_t WS_YG = WS_C + 176 * MiB;
constexpr size_t WS_QK = WS_C;
constexpr size_t WS_TOPS = WS_C + 128 * MiB;
constexpr size_t WS_TOPI = WS_C + 160 * MiB;
constexpr size_t WS_EXP = WS_C + 192 * MiB;
constexpr size_t WS_GATE = WS_C + 208 * MiB;
constexpr size_t WS_ACT = WS_C + 224 * MiB;
constexpr size_t WS_Q = WS_C;
constexpr size_t WS_KC = WS_C + 64 * MiB;
constexpr size_t WS_VC = WS_C + 81 * MiB;
constexpr size_t WS_KS = WS_C + 98 * MiB;
constexpr size_t WS_VST = WS_C + 114 * MiB;
constexpr size_t WS_KW = WS_C + 130 * MiB;
constexpr size_t WS_VWT = WS_C + 146 * MiB;
constexpr size_t WS_NG = WS_C + 162 * MiB;
constexpr size_t WS_KCMP = WS_C + 170 * MiB;
constexpr size_t WS_VCMPT = WS_C + 171 * MiB;
constexpr size_t WS_HID = WS_C + 172 * MiB;
constexpr size_t WS_O = WS_C + 182 * MiB;
constexpr size_t WS_Q8 = WS_C + 246 * MiB;
constexpr size_t WS_END = WS_C + 282 * MiB;

constexpr int LDS_BYTES = 73728;

struct Params {
    const float* in[29];
    float* out;
    unsigned char* ws;
    int ph_lo, ph_hi;
};

__device__ __forceinline__ unsigned f2bf(float f) { unsigned u = __builtin_bit_cast(unsigned, f); return (u + 0x7fffu + ((u >> 16) & 1u)) >> 16; }
__device__ __forceinline__ unsigned pk2(float lo, float hi) { return f2bf(lo) | (f2bf(hi) << 16); }
__device__ __forceinline__ float bf2f(unsigned h) { return __builtin_bit_cast(float, h << 16); }
__device__ __forceinline__ float bflo(unsigned w) { return __builtin_bit_cast(float, w << 16); }
__device__ __forceinline__ float bfhi(unsigned w) { return __builtin_bit_cast(float, w & 0xffff0000u); }
__device__ __forceinline__ float gelu_tanh(float x) {
    const float u = 0.7978845608028654f * (x + 0.044715f * x * x * x);
    const float e = __expf(2.0f * u);
    const float th = 1.0f - 2.0f / (e + 1.0f);
    return 0.5f * x * (1.0f + th);
}
__device__ __forceinline__ float sigmoidf_(float x) { return 1.0f / (1.0f + __expf(-x)); }
__device__ __forceinline__ float wave_sum(float v) {
#pragma unroll
    for (int o = 1; o < 64; o <<= 1) v += __shfl_xor(v, o);
    return v;
}
__device__ __forceinline__ float dot2bf(unsigned a, unsigned b, float acc) {
    return __builtin_amdgcn_fdot2_f32_bf16(__builtin_bit_cast(bf16x2_t, a), __builtin_bit_cast(bf16x2_t, b), acc, false);
}

#define LAS __attribute__((address_space(3)))
#define XB_TMO      128
#define XB_XCNT(j)  (256  + 64 * (j))
#define XB_XSUB(j)  (1280 + 64 * (j))
#define XB_XGEN(j)  (2304 + 64 * (j))
#define XB_TOP      3328
#define XB_TOPGEN   3392
#define XCD_BAR_WORDS 3456
#define XB_SPIN_CAP (1u << 24)

__device__ __forceinline__ unsigned xb_ld(unsigned* p)              { return __hip_atomic_load(p, __ATOMIC_RELAXED, __HIP_MEMORY_SCOPE_AGENT); }
__device__ __forceinline__ unsigned xb_add(unsigned* p, unsigned v) { return __hip_atomic_fetch_add(p, v, __ATOMIC_RELAXED, __HIP_MEMORY_SCOPE_AGENT); }
__device__ __forceinline__ unsigned xb_xcc_id() { return (unsigned)__builtin_amdgcn_s_getreg((3 << 11) | 20) & 0xFu; }
#define XB_SPIN(cond, bar) do { unsigned _sp = 0; while (cond) { __builtin_amdgcn_s_sleep(1); \
    if ((++_sp & 255u) == 0u) { if (xb_ld(&(bar)[XB_TMO])) break; if (_sp > XB_SPIN_CAP) { atomicAdd(&(bar)[XB_TMO], 1u); break; } } } } while (0)

struct XcdBarrier {
    unsigned* bar; unsigned x;
    volatile LAS unsigned* st;
};

__device__ __forceinline__ XcdBarrier xcd_barrier_post(unsigned* bar, volatile LAS unsigned* st) {
    XcdBarrier b; b.bar = bar; b.x = xb_xcc_id(); b.st = st;
    if (threadIdx.x == 0) (void)xb_add(&bar[XB_XCNT(b.x)], 1u);
    return b;
}
__device__ __forceinline__ void xcd_barrier_complete(unsigned* bar, unsigned x, unsigned& nloc, unsigned& nx) {
    const unsigned G = gridDim.x * gridDim.y * gridDim.z;
    unsigned sum, cnt, mine, sp = 0u;
    for (;;) {
        sum = 0u; cnt = 0u; mine = 0u;
#pragma unroll
        for (unsigned j = 0; j < 16; ++j) { const unsigned c = xb_ld(&bar[XB_XCNT(j)]); sum += c; cnt += (c > 0u) ? 1u : 0u; mine = (j == x) ? c : mine; }
        if (sum == G) break;
        __builtin_amdgcn_s_sleep(1);
        if ((++sp & 255u) == 0u) { if (xb_ld(&bar[XB_TMO])) break; if (sp > XB_SPIN_CAP) { atomicAdd(&bar[XB_TMO], 1u); break; } }
    }
    nloc = mine > 0u ? mine : 1u; nx = cnt > 0u ? cnt : 1u;
}

__device__ __forceinline__ void xcd_barrier(const XcdBarrier& b) {
    asm volatile("s_waitcnt vmcnt(0)" ::: "memory");
    __syncthreads();
    if (threadIdx.x == 0) {
        unsigned* bar = b.bar;
        __builtin_amdgcn_s_waitcnt(0);
        unsigned nloc = b.st[0], nx = b.st[1];
        if (nloc == 0u) { xcd_barrier_complete(bar, b.x, nloc, nx); b.st[0] = nloc; b.st[1] = nx; }
        const unsigned old = xb_add(&bar[XB_XSUB(b.x)], 1u);
        const unsigned gen = old / nloc;
        if (old + 1u == (gen + 1u) * nloc) {
            __builtin_amdgcn_fence(__ATOMIC_RELEASE, "agent");
            asm volatile("s_waitcnt vmcnt(0)" ::: "memory");
            const unsigned og = xb_add(&bar[XB_TOP], 1u);
            const unsigned tg = og / nx;
            if (og + 1u == (tg + 1u) * nx) xb_add(&bar[XB_TOPGEN], 1u);
            else XB_SPIN(xb_ld(&bar[XB_TOPGEN]) == tg, bar);
            __builtin_amdgcn_fence(__ATOMIC_ACQUIRE, "agent");
            xb_add(&bar[XB_XGEN(b.x)], 1u);
            asm volatile("s_waitcnt vmcnt(0)" ::: "memory");
        } else {
            XB_SPIN(xb_ld(&bar[XB_XGEN(b.x)]) == gen, bar);
            __builtin_amdgcn_fence(__ATOMIC_ACQUIRE, "agent");
            asm volatile("s_waitcnt vmcnt(0)" ::: "memory");
        }
    }
    __syncthreads();
}
__device__ __forceinline__ void prep_mod_item(const Params& p, int item, float* lds) {
    const int layer = item / 192, cg0 = (item % 192) * 32;
    const int tid = threadIdx.x, col = cg0 + (tid & 31), kg = tid >> 5;
    const float* W = p.in[4] + (size_t)layer * D * 6 * D + col;
    const float* c = p.in[1];
    float* cact = lds + 512;
#pragma unroll
    for (int i = 0; i < 8; ++i) { const int q = tid + 256 * i; const float v = c[q]; cact[q] = v * sigmoidf_(v); }
    __syncthreads();
    float a0 = 0.f, a1 = 0.f;
    for (int k0 = kg * 128; k0 < kg * 128 + 128; k0 += 16) {
        float w[16];
#pragma unroll
        for (int u = 0; u < 16; ++u) w[u] = W[(size_t)(k0 + u) * (6 * D)];
#pragma unroll
        for (int u = 0; u < 16; ++u) { a0 += w[u] * cact[k0 + u]; a1 += w[u] * cact[1024 + k0 + u]; }
    }
    lds[tid] = a0; lds[256 + tid] = a1;
    __syncthreads();
    if (tid < 64) {
        const int b = tid >> 5, cc = tid & 31;
        float s = 0.f;
#pragma unroll
        for (int g = 0; g < 8; ++g) s += lds[b * 256 + g * 32 + cc];
        float* MOD = (float*)(p.ws + WS_MOD);
        MOD[(size_t)(layer * 2 + b) * 6144 + cg0 + cc] = s + p.in[5][(size_t)layer * 6144 + cg0 + cc];
    }
    __syncthreads();
}

template <int MODE>
__device__ __forceinline__ void prep_transpose_item(const float* W, int K, int N, bf16_t* WT, int item, float* lds) {
    const int nbn = (N + 63) / 64, kb = item / nbn, nb = item % nbn, k0 = kb * 64, n0 = nb * 64;
    const int tid = threadIdx.x;
#pragma unroll
    for (int i = 0; i < 16; ++i) {
        const int kk = (tid >> 6) + 4 * i, nn = tid & 63;
        const float v = (n0 + nn < N) ? W[(size_t)(k0 + kk) * N + n0 + nn] : 0.f;
        lds[kk * 65 + nn] = v;
    }
    __syncthreads();
    {
        const int nn = tid >> 2, ks = (tid & 3) * 16;
        const int n = n0 + nn;
        if (n < N) {
            int np = n;
            if (MODE == 1) { const int j = (n < 1024) ? n : n - 1024; np = (j >> 4) * 32 + (j & 15) + ((n < 1024) ? 0 : 16); }
            u32x4 o0, o1;
            const float* s = lds + nn;
            o0.x = pk2(s[(ks + 0) * 65], s[(ks + 1) * 65]); o0.y = pk2(s[(ks + 2) * 65], s[(ks + 3) * 65]);
            o0.z = pk2(s[(ks + 4) * 65], s[(ks + 5) * 65]); o0.w = pk2(s[(ks + 6) * 65], s[(ks + 7) * 65]);
            o1.x = pk2(s[(ks + 8) * 65], s[(ks + 9) * 65]); o1.y = pk2(s[(ks + 10) * 65], s[(ks + 11) * 65]);
            o1.z = pk2(s[(ks + 12) * 65], s[(ks + 13) * 65]); o1.w = pk2(s[(ks + 14) * 65], s[(ks + 15) * 65]);
            u32x4* dst = (u32x4*)(WT + (size_t)np * K + k0 + ks);
            dst[0] = o0; dst[1] = o1;
        }
    }
    __syncthreads();
}

__device__ __forceinline__ void cvt_item(const float* src, bf16_t* dst, int item) {
    const size_t base = (size_t)item * 8192 + threadIdx.x * 8;
#pragma unroll
    for (int i = 0; i < 4; ++i) {
        const size_t o = base + (size_t)i * 2048;
        const f32x4 a = *(const f32x4*)(src + o), b = *(const f32x4*)(src + o + 4);
        u32x4 w; w.x = pk2(a.x, a.y); w.y = pk2(a.z, a.w); w.z = pk2(b.x, b.y); w.w = pk2(b.z, b.w);
        *(u32x4*)(dst + o) = w;
    }
}
__device__ __forceinline__ void zero_item(bf16_t* dst, int item) {
    const size_t base = (size_t)item * 8192 + threadIdx.x * 8;
#pragma unroll
    for (int i = 0; i < 4; ++i) *(u32x4*)(dst + base + (size_t)i * 2048) = (u32x4){0u, 0u, 0u, 0u};
}

struct cpx { float re, im; };
__device__ __forceinline__ cpx cmul(cpx a, cpx b) { return {a.re * b.re - a.im * b.im, a.re * b.im + a.im * b.re}; }
__device__ __forceinline__ cpx cexp_pow(float are, float aim, float dt, int m) {
    const float mag = __expf(are * dt * (float)m);
    const double rev = (double)aim * (double)dt * (double)m * 0.15915494309189535;
    const float fr = (float)(rev - rint(rev));
    return {mag * __builtin_amdgcn_cosf(fr), mag * __builtin_amdgcn_sinf(fr)};
}
__device__ __forceinline__ cpx s5_coef(float are, float aim, float dt) {
    cpx ab = cexp_pow(are, aim, dt, 1);
    const float nr = ab.re - 1.0f, ni = ab.im, den = are * are + aim * aim;
    return {(nr * are + ni * aim) / den, (ni * are - nr * aim) / den};
}

__device__ __forceinline__ void prep_s5_T_item(const Params& p, int item) {
    const int gid = item * 256 + threadIdx.x;
    const int g = gid >> 9, m = (gid >> 4) & 31, i = gid & 15;
    const float* a_re = p.in[7] + g * 64; const float* a_im = p.in[8] + g * 64;
    const float dt = __expf(p.in[9][g]);
    const float* b_re = p.in[10] + (size_t)g * 64 * 16; const float* b_im = p.in[11] + (size_t)g * 64 * 16;
    const float* c_re = p.in[12] + (size_t)g * 16 * 64 + i * 64; const float* c_im = p.in[13] + (size_t)g * 16 * 64 + i * 64;
    float acc[16];
#pragma unroll
    for (int j = 0; j < 16; ++j) acc[j] = 0.f;
    for (int q = 0; q < 64; ++q) {
        const float are = a_re[q], aim = a_im[q];
        cpx z = cmul(cmul({c_re[q], c_im[q]}, cexp_pow(are, aim, dt, m)), s5_coef(are, aim, dt));
        const f32x4* br = (const f32x4*)(b_re + q * 16); const f32x4* bi = (const f32x4*)(b_im + q * 16);
#pragma unroll
        for (int j4 = 0; j4 < 4; ++j4) {
            const f32x4 r = br[j4], im = bi[j4];
            acc[j4 * 4 + 0] += z.re * r.x - z.im * im.x; acc[j4 * 4 + 1] += z.re * r.y - z.im * im.y;
            acc[j4 * 4 + 2] += z.re * r.z - z.im * im.z; acc[j4 * 4 + 3] += z.re * r.w - z.im * im.w;
        }
    }
    u32x4 o0, o1;
    o0.x = pk2(acc[0], acc[1]); o0.y = pk2(acc[2], acc[3]); o0.z = pk2(acc[4], acc[5]); o0.w = pk2(acc[6], acc[7]);
    o1.x = pk2(acc[8], acc[9]); o1.y = pk2(acc[10], acc[11]); o1.z = pk2(acc[12], acc[13]); o1.w = pk2(acc[14], acc[15]);
    bf16_t* TW = (bf16_t*)(p.ws + WS_TW) + (size_t)g * 640 * 512;
    const u32x4 z4 = (u32x4){0u, 0u, 0u, 0u};
    for (int lp = 0; lp + m < 32; ++lp) {
        u32x4* d = (u32x4*)(TW + (size_t)((lp + m) * 16 + i) * 512 + lp * 16);
        d[0] = o0; d[1] = o1;
        if (m > 0) { u32x4* dz = (u32x4*)(TW + (size_t)(lp * 16 + i) * 512 + (lp + m) * 16); dz[0] = z4; dz[1] = z4; }
    }
}
__device__ __forceinline__ void prep_s5_W_item(const Params& p, int item) {
    const int gid = item * 256 + threadIdx.x;
    const int g = gid >> 11, q = (gid >> 5) & 63, lp = gid & 31;
    const float are = p.in[7][g * 64 + q], aim = p.in[8][g * 64 + q];
    const float dt = __expf(p.in[9][g]);
    const cpx z = cmul(cexp_pow(are, aim, dt, 31 - lp), s5_coef(are, aim, dt));
    const float* br = p.in[10] + ((size_t)g * 64 + q) * 16; const float* bi = p.in[11] + ((size_t)g * 64 + q) * 16;
    float wr[16], wi[16];
#pragma unroll
    for (int j = 0; j < 16; ++j) { wr[j] = z.re * br[j] - z.im * bi[j]; wi[j] = z.re * bi[j] + z.im * br[j]; }
    bf16_t* TW = (bf16_t*)(p.ws + WS_TW) + (size_t)g * 640 * 512;
    u32x4* d0 = (u32x4*)(TW + (size_t)(512 + q) * 512 + lp * 16);
    u32x4* d1 = (u32x4*)(TW + (size_t)(576 + q) * 512 + lp * 16);
    d0[0] = (u32x4){pk2(wr[0], wr[1]), pk2(wr[2], wr[3]), pk2(wr[4], wr[5]), pk2(wr[6], wr[7])};
    d0[1] = (u32x4){pk2(wr[8], wr[9]), pk2(wr[10], wr[11]), pk2(wr[12], wr[13]), pk2(wr[14], wr[15])};
    d1[0] = (u32x4){pk2(wi[0], wi[1]), pk2(wi[2], wi[3]), pk2(wi[4], wi[5]), pk2(wi[6], wi[7])};
    d1[1] = (u32x4){pk2(wi[8], wi[9]), pk2(wi[10], wi[11]), pk2(wi[12], wi[13]), pk2(wi[14], wi[15])};
}
__device__ __forceinline__ void prep_s5_V_item(const Params& p, int item) {
    const int gid = item * 256 + threadIdx.x;
    const int g = gid >> 14, l = (gid >> 9) & 31, i = (gid >> 5) & 15, q0 = (gid & 31) * 2;
    const float dt = __expf(p.in[9][g]);
    float vr[2], vi[2];
#pragma unroll
    for (int e = 0; e < 2; ++e) {
        const int q = q0 + e;
        const cpx z = cmul({p.in[12][((size_t)g * 16 + i) * 64 + q], p.in[13][((size_t)g * 16 + i) * 64 + q]}, cexp_pow(p.in[7][g * 64 + q], p.in[8][g * 64 + q], dt, l + 1));
        vr[e] = z.re; vi[e] = -z.im;
    }
    bf16_t* VG = (bf16_t*)(p.ws + WS_VG) + ((size_t)g * 512 + l * 16 + i) * 128;
    *(unsigned*)(VG + q0) = pk2(vr[0], vr[1]);
    *(unsigned*)(VG + 64 + q0) = pk2(vi[0], vi[1]);
}
__device__ __forceinline__ void prep_al_item(const Params& p, int item) {
    const int gid = item * 256 + threadIdx.x;
    const int g = gid >> 6;
    const float dt = __expf(p.in[9][g]);
    const cpx z = cexp_pow(p.in[7][gid], p.in[8][gid], dt, S5L);
    f32x2* AL = (f32x2*)(p.ws + WS_MISC + 4096);
    AL[gid] = (f32x2){z.re, z.im};
}
__device__ __forceinline__ void prep_rope_item(const Params& p, int item) {
    const int gid = item * 256 + threadIdx.x;
    const int pos = gid >> 5, j = gid & 31;
    const float freq = exp2f(-(float)j * (13.287712379549449f / 32.0f));
    const float ang = (float)pos * freq;
    const double rev = (double)ang * 0.15915494309189535;
    const float fr = (float)(rev - rint(rev));
    f32x2* R = (f32x2*)(p.ws + WS_ROPE);
    R[gid] = (f32x2){__builtin_amdgcn_cosf(fr), __builtin_amdgcn_sinf(fr)};
}
__device__ __forceinline__ void prep_cmpbias_item(const Params& p, int item, float* lds) {
    const int kv = item >> 3, cg0 = (item & 7) * 32;
    const float* pe = p.in[17 + kv]; const float* w1 = p.in[kv == 0 ? 19 : 21];
    const int tid = threadIdx.x, col = cg0 + (tid & 31), kg = tid >> 5;
    float s = 0.f;
#pragma unroll 8
    for (int k = kg * 256; k < kg * 256 + 256; ++k) s += pe[k] * w1[(size_t)k * 256 + col];
    lds[tid] = s;
    __syncthreads();
    if (tid < 32) {
        float t = 0.f;
#pragma unroll
        for (int q = 0; q < 8; ++q) t += lds[q * 32 + tid];
        ((float*)(p.ws + WS_MISC))[kv * 256 + cg0 + tid] = t;
    }
    __syncthreads();
}

__device__ __forceinline__ void cvt_fp8_item(const float* src, unsigned char* dst, float* inv_scale, int item, const bool slice_major) {
    const int lane = threadIdx.x & 63, row0 = item * 16 + (threadIdx.x >> 6) * 4;
    f32x4 v[4][4];
#pragma unroll
    for (int r = 0; r < 4; ++r) {
        const f32x4* sp = (const f32x4*)(src + (size_t)(row0 + r) * D + lane * 16);
#pragma unroll
        for (int q = 0; q < 4; ++q) v[r][q] = sp[q];
    }
#pragma unroll
    for (int r = 0; r < 4; ++r) {
        float m = 0.f;
#pragma unroll
        for (int q = 0; q < 4; ++q) m = fmaxf(m, fmaxf(fmaxf(fabsf(v[r][q].x), fabsf(v[r][q].y)), fmaxf(fabsf(v[r][q].z), fabsf(v[r][q].w))));
#pragma unroll
        for (int o = 1; o < 64; o <<= 1) m = fmaxf(m, __shfl_xor(m, o));
        const float sc = m > 0.f ? 224.0f / m : 1.0f;
        unsigned w[4];
#pragma unroll
        for (int q = 0; q < 4; ++q) { int t = 0; t = __builtin_amdgcn_cvt_pk_fp8_f32(v[r][q].x * sc, v[r][q].y * sc, t, false); t = __builtin_amdgcn_cvt_pk_fp8_f32(v[r][q].z * sc, v[r][q].w * sc, t, true); w[q] = (unsigned)t; }
        const int row = row0 + r;
        const u32x4 wv = (u32x4){w[0], w[1], w[2], w[3]};
        if (slice_major) *(u32x4*)(dst + (size_t)(lane >> 3) * (PE * 128) + (size_t)row * 128 + (lane & 7) * 16) = wv;
        else *(u32x4*)(dst + (size_t)row * D + lane * 16) = wv;
        if (lane == 0) inv_scale[row] = m > 0.f ? m / 224.0f : 1.0f;
    }
}
constexpr int P0_MOD = 384;
constexpr int P0_T_WIN = 16 * 16, P0_T_WGLU = 16 * 32, P0_T_WPROJ = 16 * 41, P0_T_WK1 = 32 * 4, P0_T_WK2 = 4 * 1, P0_T_WO = 16 * 16, P0_T_WQ = 16 * 32;
constexpr int P0_SUBK = (2 * 8 * 2 * 128 * 128) / 8192;
constexpr int P0_TAB = PE / 16;
constexpr int P0_S5T = 128, P0_S5W = 512, P0_S5V = 4096, P0_AL = 16, P0_ROPE = 2048, P0_CB = 16, P0_ZERO = 10 + 2;

__device__ __forceinline__ void phase_prep(const Params& p, float* lds) {
    const int n0 = P0_MOD;
    const int n1 = n0 + P0_T_WIN, n2 = n1 + P0_T_WGLU, n3 = n2 + P0_T_WPROJ, n4 = n3 + P0_T_WK1, n5 = n4 + P0_T_WK1, n6 = n5 + P0_T_WK2, n7 = n6 + P0_T_WK2,
              n8 = n7 + P0_T_WO, n9 = n8 + P0_T_WQ, n10 = n9 + P0_T_WQ, n11 = n10 + P0_SUBK, n12 = n11 + P0_TAB, n13 = n12 + P0_TAB,
              n14 = n13 + P0_S5T, n15 = n14 + P0_S5W, n16 = n15 + P0_S5V, n17 = n16 + P0_AL, n18 = n17 + P0_ROPE, n19 = n18 + P0_CB, n20 = n19 + 10, n21 = n20 + 2, n22 = n21 + 2;
    unsigned char* ws = p.ws;
#ifndef PREP_DUP_LO
#define PREP_DUP_LO 0
#define PREP_DUP_HI 0
#endif
    const int dupn = (PREP_DUP_HI) - (PREP_DUP_LO);
    for (int it0 = blockIdx.x; it0 < n22 + dupn; it0 += gridDim.x) {
        const int it = it0 < n22 ? it0 : (PREP_DUP_LO) + (it0 - n22);
        if (it < n0) prep_mod_item(p, it, lds);
        else if (it < n1) prep_transpose_item<0>(p.in[6], 1024, 1024, (bf16_t*)(ws + WS_WIN_T), it - n0, lds);
        else if (it < n2) prep_transpose_item<1>(p.in[15], 1024, 2048, (bf16_t*)(ws + WS_WGLU_T), it - n1, lds);
        else if (it < n3) prep_transpose_item<0>(p.in[16], 1024, NPROJ, (bf16_t*)(ws + WS_WPROJ_T), it - n2, lds);
        else if (it < n4) prep_transpose_item<0>(p.in[19], 2048, 256, (bf16_t*)(ws + WS_WK1_T), it - n3, lds);
        else if (it < n5) prep_transpose_item<0>(p.in[21], 2048, 256, (bf16_t*)(ws + WS_WV1_T), it - n4, lds);
        else if (it < n6) prep_transpose_item<0>(p.in[20], 256, 64, (bf16_t*)(ws + WS_WK2_T), it - n5, lds);
        else if (it < n7) prep_transpose_item<0>(p.in[22], 256, 64, (bf16_t*)(ws + WS_WV2_T), it - n6, lds);
        else if (it < n8) prep_transpose_item<0>(p.in[23], 1024, 1024, (bf16_t*)(ws + WS_WO_T), it - n7, lds);
        else if (it < n9) prep_transpose_item<0>(p.in[24], 1024, 2048, (bf16_t*)(ws + WS_WQ_T), it - n8, lds);
        else if (it < n10) prep_transpose_item<0>(p.in[24] + (size_t)1024 * 2048, 1024, 2048, (bf16_t*)(ws + WS_WQ_T) + (size_t)2048 * 1024, it - n9, lds);
        else if (it < n11) cvt_item(p.in[25], (bf16_t*)(ws + WS_SUBK), it - n10);
        else if (it < n12) cvt_fp8_item(p.in[26], ws + WS_PU, (float*)(ws + WS_PU + 24 * MiB), it - n11, false);
        else if (it < n13) cvt_fp8_item(p.in[27], ws + WS_PV, (float*)(ws + WS_PV + 24 * MiB), it - n12, false);
        else if (it < n14) prep_s5_T_item(p, it - n13);
        else if (it < n15) prep_s5_W_item(p, it - n14);
        else if (it < n16) prep_s5_V_item(p, it - n15);
        else if (it < n17) prep_al_item(p, it - n16);
        else if (it < n18) prep_rope_item(p, it - n17);
        else if (it < n19) prep_cmpbias_item(p, it - n18, lds);
        else if (it < n20) zero_item((bf16_t*)(ws + WS_WPROJ_T) + (size_t)NPROJ * 1024, it - n19);
        else if (it < n21) zero_item((bf16_t*)(ws + WS_WK2_T) + (size_t)64 * 256, it - n20);
        else zero_item((bf16_t*)(ws + WS_WV2_T) + (size_t)64 * 256, it - n21);
    }
}

__device__ __forceinline__ void phase_norm(const Params& p, const float* X, const float* gw, const float* shift, const float* scale  , bf16_t* HM) {
    const int lane = threadIdx.x & 63, wave = threadIdx.x >> 6;
    for (int row = blockIdx.x * 4 + wave; row < T; row += gridDim.x * 4) {
        const int b = row / SEQ;
        const f32x4* xr = (const f32x4*)(X + (size_t)row * D) + lane;
        f32x4 v[4]; float s = 0.f;
#pragma unroll
        for (int j = 0; j < 4; ++j) { v[j] = xr[64 * j]; s += (v[j].x * v[j].x + v[j].y * v[j].y) + (v[j].z * v[j].z + v[j].w * v[j].w); }
        const float rs = rsqrtf(wave_sum(s) * (1.0f / D) + RMS_EPS);
        u32x2* o = (u32x2*)(HM + (size_t)row * D) + lane;
#pragma unroll
        for (int j = 0; j < 4; ++j) {
            const int c = lane * 4 + 256 * j;
            const f32x4 g = *(const f32x4*)(gw + c), sh = *(const f32x4*)(shift + (size_t)b * 6144 + c), sc = *(const f32x4*)(scale + (size_t)b * 6144 + c);
            const float y0 = v[j].x * rs * g.x * (1.f + sc.x) + sh.x, y1 = v[j].y * rs * g.y * (1.f + sc.y) + sh.y;
            const float y2 = v[j].z * rs * g.z * (1.f + sc.z) + sh.z, y3 = v[j].w * rs * g.w * (1.f + sc.w) + sh.w;
            o[64 * j] = (u32x2){pk2(y0, y1), pk2(y2, y3)};
        }
    }
}
__device__ __forceinline__ void phase_final_norm(const Params& p, const float* X, float* OUT, bool dry) {
    const int lane = threadIdx.x & 63, wave = threadIdx.x >> 6;
    const float* gw = p.in[28];
    for (int row = blockIdx.x * 4 + wave; row < T; row += gridDim.x * 4) {
        const f32x4* xr = (const f32x4*)(X + (size_t)row * D) + lane;
        f32x4 v[4]; float s = 0.f;
#pragma unroll
        for (int j = 0; j < 4; ++j) { v[j] = xr[64 * j]; s += (v[j].x * v[j].x + v[j].y * v[j].y) + (v[j].z * v[j].z + v[j].w * v[j].w); }
        const float rs = rsqrtf(wave_sum(s) * (1.0f / D) + RMS_EPS);
        f32x4* o = (f32x4*)(OUT + (size_t)row * D) + lane;
#pragma unroll
        for (int j = 0; j < 4; ++j) {
            const f32x4 g = *(const f32x4*)(gw + lane * 4 + 256 * j);
            if (!dry) o[64 * j] = (f32x4){v[j].x * rs * g.x, v[j].y * rs * g.y, v[j].z * rs * g.z, v[j].w * rs * g.w};
        }
    }
}

__device__ __forceinline__ int vblock() { const int G = gridDim.x, bx = blockIdx.x; return (G % 8 == 0) ? (bx % 8) * (G / 8) + bx / 8 : bx; }
struct ALoadPlain {
    const bf16_t* A; size_t lda;
    __device__ __forceinline__ const bf16_t* base(int kt) const { return A + kt * 64; }
    __device__ __forceinline__ unsigned off(int r, int lc) const { return (unsigned)r * (unsigned)lda + (unsigned)lc * 8u; }
};
struct ALoadGroup {
    const bf16_t* A;
    __device__ __forceinline__ const bf16_t* base(int kt) const { return A + (size_t)kt * 4 * T * 16; }
    __device__ __forceinline__ unsigned off(int r, int lc) const { return ((unsigned)(lc >> 1) * (unsigned)T + (unsigned)r) * 16u + (unsigned)(lc & 1) * 8u; }
};

template <class AL>
__device__ __forceinline__ void gemm_tile2(const AL al, const bf16_t* __restrict__ Bt, size_t ldb, int nk, f32x4 (&acc)[4][4], unsigned char* lds) {
    const int tid = threadIdx.x, lane = tid & 63, wid = tid >> 6, wr = wid >> 1, wc = wid & 1, fr = lane & 15, fq = lane >> 4;
    const int lr = tid >> 3, lc = tid & 7;
#pragma unroll
    for (int mi = 0; mi < 4; ++mi)
#pragma unroll
        for (int ni = 0; ni < 4; ++ni) acc[mi][ni] = (f32x4){0.f, 0.f, 0.f, 0.f};
    u32x4 ra0[4], rb0[4], ra1[4], rb1[4];
    const int soff = lr * 128 + ((lc ^ (lr & 7)) << 4);
    unsigned offA[4], offB[4];
#pragma unroll
    for (int i = 0; i < 4; ++i) { offA[i] = al.off(lr + 32 * i, lc); offB[i] = (unsigned)(lr + 32 * i) * (unsigned)ldb + (unsigned)lc * 8u; }
#define GT_LOAD(RA, RB, kt_) do { const bf16_t* ab_ = al.base(kt_); const bf16_t* bb_ = Bt + (kt_) * 64; _Pragma("unroll") for (int i = 0; i < 4; ++i) { RA[i] = *(const u32x4*)(ab_ + offA[i]); RB[i] = *(const u32x4*)(bb_ + offB[i]); } } while (0)
#define GT_STORE(RA, RB, buf_) do { unsigned char* nb_ = lds + (buf_) * 32768; _Pragma("unroll") for (int i = 0; i < 4; ++i) { *(u32x4*)(nb_ + soff + i * 4096) = RA[i]; *(u32x4*)(nb_ + 16384 + soff + i * 4096) = RB[i]; } } while (0)
    const int aoff = (wr * 64 + fr) * 128, boff = 16384 + (wc * 64 + fr) * 128, sw = fr & 7;
#define GT_MATH(buf_) do { const unsigned char* bp_ = lds + (buf_) * 32768; _Pragma("unroll") for (int ks = 0; ks < 2; ++ks) { bf16x8 af[4], bfr[4]; const int co = ((ks * 4 + fq) ^ sw) << 4; \
        _Pragma("unroll") for (int mi = 0; mi < 4; ++mi) af[mi] = *(const bf16x8*)(bp_ + aoff + mi * 2048 + co); \
        _Pragma("unroll") for (int ni = 0; ni < 4; ++ni) bfr[ni] = *(const bf16x8*)(bp_ + boff + ni * 2048 + co); \
        _Pragma("unroll") for (int mi = 0; mi < 4; ++mi) _Pragma("unroll") for (int ni = 0; ni < 4; ++ni) acc[mi][ni] = __builtin_amdgcn_mfma_f32_16x16x32_bf16(bfr[ni], af[mi], acc[mi][ni], 0, 0, 0); } } while (0)
    GT_LOAD(ra0, rb0, 0);
    if (nk > 1) GT_LOAD(ra1, rb1, 1);
    GT_STORE(ra0, rb0, 0);
    __syncthreads();
    for (int kt = 0; kt < nk; kt += 2) {
        if (kt + 2 < nk) GT_LOAD(ra0, rb0, kt + 2);
        __builtin_amdgcn_sched_barrier(0);
        GT_MATH(0);
        __builtin_amdgcn_sched_barrier(0);
        if (kt + 1 < nk) GT_STORE(ra1, rb1, 1);
        __syncthreads();
        if (kt + 1 >= nk) break;
        if (kt + 3 < nk) GT_LOAD(ra1, rb1, kt + 3);
        __builtin_amdgcn_sched_barrier(0);
        GT_MATH(1);
        __builtin_amdgcn_sched_barrier(0);
        if (kt + 2 < nk) GT_STORE(ra0, rb0, 0);
        __syncthreads();
    }
#undef GT_LOAD
#undef GT_STORE
#undef GT_MATH
}

template <class AL>
__device__ __forceinline__ void gemm_tile1(const AL al, const bf16_t* __restrict__ Bt, size_t ldb, int nk, f32x4 (&acc)[4][4], unsigned char* lds) {
    const int tid = threadIdx.x, lane = tid & 63, wid = tid >> 6, wr = wid >> 1, wc = wid & 1, fr = lane & 15, fq = lane >> 4;
    const int lr = tid >> 3, lc = tid & 7;
#pragma unroll
    for (int mi = 0; mi < 4; ++mi)
#pragma unroll
        for (int ni = 0; ni < 4; ++ni) acc[mi][ni] = (f32x4){0.f, 0.f, 0.f, 0.f};
    u32x4 ra[4], rb[4];
    const int soff = lr * 128 + ((lc ^ (lr & 7)) << 4);
#pragma unroll
    for (int i = 0; i < 4; ++i) { ra[i] = *(const u32x4*)(al.base(0) + al.off(lr + 32 * i, lc)); rb[i] = *(const u32x4*)(Bt + (size_t)(lr + 32 * i) * ldb + lc * 8); }
#pragma unroll
    for (int i = 0; i < 4; ++i) { *(u32x4*)(lds + soff + i * 4096) = ra[i]; *(u32x4*)(lds + 16384 + soff + i * 4096) = rb[i]; }
    __syncthreads();
    const int aoff = (wr * 64 + fr) * 128, boff = 16384 + (wc * 64 + fr) * 128, sw = fr & 7;
    for (int kt = 0; kt < nk; ++kt) {
        const bool more = (kt + 1 < nk);
        if (more) {
#pragma unroll
            for (int i = 0; i < 4; ++i) { ra[i] = *(const u32x4*)(al.base(kt + 1) + al.off(lr + 32 * i, lc)); rb[i] = *(const u32x4*)(Bt + (size_t)(lr + 32 * i) * ldb + (kt + 1) * 64 + lc * 8); }
        }
        const unsigned char* buf = lds + (kt & 1) * 32768;
#pragma unroll
        for (int ks = 0; ks < 2; ++ks) {
            bf16x8 af[4], bfr[4];
            const int co = ((ks * 4 + fq) ^ sw) << 4;
#pragma unroll
            for (int mi = 0; mi < 4; ++mi) af[mi] = *(const bf16x8*)(buf + aoff + mi * 2048 + co);
#pragma unroll
            for (int ni = 0; ni < 4; ++ni) bfr[ni] = *(const bf16x8*)(buf + boff + ni * 2048 + co);
#pragma unroll
            for (int mi = 0; mi < 4; ++mi)
#pragma unroll
                for (int ni = 0; ni < 4; ++ni) acc[mi][ni] = __builtin_amdgcn_mfma_f32_16x16x32_bf16(bfr[ni], af[mi], acc[mi][ni], 0, 0, 0);
        }
        if (more) {
            unsigned char* nb = lds + ((kt + 1) & 1) * 32768;
#pragma unroll
            for (int i = 0; i < 4; ++i) { *(u32x4*)(nb + soff + i * 4096) = ra[i]; *(u32x4*)(nb + 16384 + soff + i * 4096) = rb[i]; }
        }
        __syncthreads();
    }
}

template <class AL>
__device__ __forceinline__ void gemm_tile3(const AL al, const bf16_t* __restrict__ Bt, size_t ldb, int nk, f32x4 (&acc)[4][4], unsigned char* lds) {
    const int tid = threadIdx.x, lane = tid & 63, wid = tid >> 6, wr = wid >> 1, wc = wid & 1, fr = lane & 15, fq = lane >> 4;
#pragma unroll
    for (int mi = 0; mi < 4; ++mi)
#pragma unroll
        for (int ni = 0; ni < 4; ++ni) acc[mi][ni] = (f32x4){0.f, 0.f, 0.f, 0.f};
    const int srow = wid * 32 + (lane >> 3), schunk = (lane & 7) ^ ((lane >> 3) & 7);
    unsigned offA[4], offB[4];
#pragma unroll
    for (int i = 0; i < 4; ++i) { offA[i] = al.off(srow + 8 * i, schunk); offB[i] = (unsigned)(srow + 8 * i) * (unsigned)ldb + (unsigned)schunk * 8u; }
#define G3_STAGE(buf_, kt_) do { const bf16_t* ab_ = al.base(kt_); const bf16_t* bb_ = Bt + (kt_) * 64; unsigned char* lb_ = lds + (buf_) * 32768 + wid * 4096; \
        _Pragma("unroll") for (int i = 0; i < 4; ++i) { \
            __builtin_amdgcn_global_load_lds((const unsigned*)(ab_ + offA[i]), (unsigned*)(lb_ + i * 1024), 16, 0, 0); \
            __builtin_amdgcn_global_load_lds((const unsigned*)(bb_ + offB[i]), (unsigned*)(lb_ + 16384 + i * 1024), 16, 0, 0); } } while (0)
    const int aoff = (wr * 64 + fr) * 128, boff = 16384 + (wc * 64 + fr) * 128, sw = fr & 7;
    G3_STAGE(0, 0);
    __syncthreads();
    for (int kt = 0; kt < nk; ++kt) {
        if (kt + 1 < nk) G3_STAGE((kt + 1) & 1, kt + 1);
        const unsigned char* buf = lds + (kt & 1) * 32768;
#pragma unroll
        for (int ks = 0; ks < 2; ++ks) {
            bf16x8 af[4], bfr[4];
            const int co = ((ks * 4 + fq) ^ sw) << 4;
#pragma unroll
            for (int mi = 0; mi < 4; ++mi) af[mi] = *(const bf16x8*)(buf + aoff + mi * 2048 + co);
#pragma unroll
            for (int ni = 0; ni < 4; ++ni) bfr[ni] = *(const bf16x8*)(buf + boff + ni * 2048 + co);
#pragma unroll
            for (int mi = 0; mi < 4; ++mi)
#pragma unroll
                for (int ni = 0; ni < 4; ++ni) acc[mi][ni] = __builtin_amdgcn_mfma_f32_16x16x32_bf16(bfr[ni], af[mi], acc[mi][ni], 0, 0, 0);
        }
        __syncthreads();
    }
#undef G3_STAGE
}
__device__ __forceinline__ void phase_s5_win(const Params& p, unsigned char* lds) {
    const bf16_t* HM = (const bf16_t*)(p.ws + WS_HM); const bf16_t* WT = (const bf16_t*)(p.ws + WS_WIN_T);
    bf16_t* UG = (bf16_t*)(p.ws + WS_UG);
    const int lane = threadIdx.x & 63, wid = threadIdx.x >> 6, wr = wid >> 1, wc = wid & 1, fr = lane & 15, fq = lane >> 4;
    for (int id = vblock(); id < 256 * 8; id += gridDim.x) {
        const int mt = id >> 3, nt = id & 7;
        f32x4 acc[4][4];
        gemm_tile3(ALoadPlain{HM + (size_t)mt * 128 * D, (size_t)D}, WT + (size_t)nt * 128 * D, D, 16, acc, lds);
#pragma unroll
        for (int mi = 0; mi < 4; ++mi)
#pragma unroll
            for (int ni = 0; ni < 4; ++ni) {
                const int t = mt * 128 + wr * 64 + mi * 16 + fr, g = nt * 8 + wc * 4 + ni;
                const f32x4 v = acc[mi][ni];
                *(u32x2*)(UG + ((size_t)g * T + t) * 16 + fq * 4) = (u32x2){pk2(v.x, v.y), pk2(v.z, v.w)};
            }
    }
}
__device__ __forceinline__ void phase_s5_a(const Params& p, unsigned char* lds) {
    const bf16_t* UG = (const bf16_t*)(p.ws + WS_UG); const bf16_t* TW = (const bf16_t*)(p.ws + WS_TW);
    bf16_t* YI = (bf16_t*)(p.ws + WS_YI); float* WST = (float*)(p.ws + WS_WST);
    const int lane = threadIdx.x & 63, wid = threadIdx.x >> 6, wr = wid >> 1, wc = wid & 1, fr = lane & 15, fq = lane >> 4;
    for (int id = vblock(); id < 64 * 40; id += gridDim.x) {
        const int g = id / 40, rem = id % 40, mt = rem / 5, nt = rem % 5;
        const int nk = (nt < 4) ? 2 * (nt + 1) : 8;
        f32x4 acc[4][4];
        gemm_tile3(ALoadPlain{UG + (size_t)g * T * 16 + (size_t)mt * 128 * 512, (size_t)512}, TW + ((size_t)g * 640 + nt * 128) * 512, 512, nk, acc, lds);
#pragma unroll
        for (int mi = 0; mi < 4; ++mi)
#pragma unroll
            for (int ni = 0; ni < 4; ++ni) {
                const int R = mt * 128 + wr * 64 + mi * 16 + fr, c = wc * 64 + ni * 16 + fq * 4;
                const f32x4 v = acc[mi][ni];
                if (nt < 4) *(u32x2*)(YI + ((size_t)g * 1024 + R) * 512 + nt * 128 + c) = (u32x2){pk2(v.x, v.y), pk2(v.z, v.w)};
                else *(f32x4*)(WST + ((size_t)g * 1024 + R) * 128 + c) = v;
            }
    }
}
__device__ __forceinline__ void phase_s5_scan(const Params& p) {
    const int lane = threadIdx.x & 63, wave = threadIdx.x >> 6;
    const float* WST = (const float*)(p.ws + WS_WST); bf16_t* SST = (bf16_t*)(p.ws + WS_SST);
    const f32x2* AL = (const f32x2*)(p.ws + WS_MISC + 4096);
    for (int it = blockIdx.x * 4 + wave; it < 128; it += gridDim.x * 4) {
        const int b = it >> 6, g = it & 63;
        const f32x2 al = AL[g * 64 + lane];
        float sr = 0.f, si = 0.f;
        const float* wbase = WST + ((size_t)g * 1024 + b * 512) * 128 + lane;
        bf16_t* sbase = SST + ((size_t)g * 1024 + b * 512) * 128 + lane;
        for (int n0 = 0; n0 < 512; n0 += 16) {
            float wre[16], wim[16];
#pragma unroll
            for (int j = 0; j < 16; ++j) { wre[j] = wbase[(size_t)(n0 + j) * 128]; wim[j] = wbase[(size_t)(n0 + j) * 128 + 64]; }
#pragma unroll
            for (int j = 0; j < 16; ++j) {
                sbase[(size_t)(n0 + j) * 128] = (bf16_t)f2bf(sr); sbase[(size_t)(n0 + j) * 128 + 64] = (bf16_t)f2bf(si);
                const float nr = al.x * sr - al.y * si + wre[j], ni = al.x * si + al.y * sr + wim[j];
                sr = nr; si = ni;
            }
        }
    }
}
__device__ __forceinline__ void phase_s5_b(const Params& p, unsigned char* lds) {
    const bf16_t* SST = (const bf16_t*)(p.ws + WS_SST); const bf16_t* VG = (const bf16_t*)(p.ws + WS_VG);
    const bf16_t* YI = (const bf16_t*)(p.ws + WS_YI); const bf16_t* UG = (const bf16_t*)(p.ws + WS_UG);
    bf16_t* YG = (bf16_t*)(p.ws + WS_YG);
    const float* dsk = p.in[14];
    const int lane = threadIdx.x & 63, wid = threadIdx.x >> 6, wr = wid >> 1, wc = wid & 1, fr = lane & 15, fq = lane >> 4;
    for (int id = vblock(); id < 64 * 32; id += gridDim.x) {
        const int g = id >> 5, mt = (id >> 2) & 7, nt = id & 3;
        f32x4 acc[4][4];
        gemm_tile3(ALoadPlain{SST + ((size_t)g * 1024 + mt * 128) * 128, (size_t)128}, VG + ((size_t)g * 512 + nt * 128) * 128, 128, 2, acc, lds);
        const f32x4 dv = *(const f32x4*)(dsk + g * 16 + fq * 4);
#pragma unroll
        for (int mi = 0; mi < 4; ++mi)
#pragma unroll
            for (int ni = 0; ni < 4; ++ni) {
                const int R = mt * 128 + wr * 64 + mi * 16 + fr, c = nt * 128 + wc * 64 + ni * 16 + fq * 4;
                const size_t idx = ((size_t)g * 1024 + R) * 512 + c;
                const u32x2 yi = *(const u32x2*)(YI + idx), uu = *(const u32x2*)(UG + idx);
                const f32x4 v = acc[mi][ni];
                const float y0 = gelu_tanh(v.x + bflo(yi.x) + dv.x * bflo(uu.x)), y1 = gelu_tanh(v.y + bfhi(yi.x) + dv.y * bfhi(uu.x));
                const float y2 = gelu_tanh(v.z + bflo(yi.y) + dv.z * bflo(uu.y)), y3 = gelu_tanh(v.w + bfhi(yi.y) + dv.w * bfhi(uu.y));
                *(u32x2*)(YG + idx) = (u32x2){pk2(y0, y1), pk2(y2, y3)};
            }
    }
}
__device__ __forceinline__ void phase_s5_glu(const Params& p, unsigned char* lds) {
    const bf16_t* YG = (const bf16_t*)(p.ws + WS_YG); const bf16_t* WT = (const bf16_t*)(p.ws + WS_WGLU_T);
    const float* MOD = (const float*)(p.ws + WS_MOD);
    const float* X = p.in[0]; float* XO = p.out;
    const int lane = threadIdx.x & 63, wid = threadIdx.x >> 6, wr = wid >> 1, wc = wid & 1, fr = lane & 15, fq = lane >> 4;
    for (int id = vblock(); id < 256 * 16; id += gridDim.x) {
        const int mt = id >> 4, nt = id & 15;
        f32x4 acc[4][4];
        gemm_tile3(ALoadGroup{YG + (size_t)mt * 128 * 16}, WT + (size_t)nt * 128 * D, D, 16, acc, lds);
        const int b = (mt * 128) / SEQ;
#pragma unroll
        for (int mi = 0; mi < 4; ++mi)
#pragma unroll
            for (int h = 0; h < 2; ++h) {
                const int t = mt * 128 + wr * 64 + mi * 16 + fr, j = nt * 64 + wc * 32 + h * 16 + fq * 4;
                const f32x4 a = acc[mi][2 * h], gg = acc[mi][2 * h + 1];
                const f32x4 g1 = *(const f32x4*)(MOD + (size_t)(0 * 2 + b) * 6144 + 2048 + j);
                const f32x4 xi = *(const f32x4*)(X + (size_t)t * D + j);
                f32x4 o;
                o.x = xi.x + g1.x * (a.x * sigmoidf_(gg.x)); o.y = xi.y + g1.y * (a.y * sigmoidf_(gg.y));
                o.z = xi.z + g1.z * (a.z * sigmoidf_(gg.z)); o.w = xi.w + g1.w * (a.w * sigmoidf_(gg.w));
                *(f32x4*)(XO + (size_t)t * D + j) = o;
            }
    }
}
__device__ __forceinline__ void phase_peer_wq(const Params& p, int layer, unsigned char* lds) {
    const bf16_t* HM = (const bf16_t*)(p.ws + WS_HM); const bf16_t* WT = (const bf16_t*)(p.ws + WS_WQ_T) + (size_t)layer * 2048 * 1024;
    bf16_t* QK = (bf16_t*)(p.ws + WS_QK);
    const int lane = threadIdx.x & 63, wid = threadIdx.x >> 6, wr = wid >> 1, wc = wid & 1, fr = lane & 15, fq = lane >> 4;
    for (int id = vblock(); id < 256 * 16; id += gridDim.x) {
        const int mt = id >> 4, nt = id & 15;
        f32x4 acc[4][4];
        gemm_tile3(ALoadPlain{HM + (size_t)mt * 128 * D, (size_t)D}, WT + (size_t)nt * 128 * D, D, 16, acc, lds);
#pragma unroll
        for (int mi = 0; mi < 4; ++mi)
#pragma unroll
            for (int ni = 0; ni < 4; ++ni) {
                const int t = mt * 128 + wr * 64 + mi * 16 + fr, c = nt * 128 + wc * 64 + ni * 16 + fq * 4;
                const f32x4 v = acc[mi][ni];
                *(u32x2*)(QK + (size_t)t * 2048 + c) = (u32x2){pk2(v.x, v.y), pk2(v.z, v.w)};
            }
    }
}
__device__ __forceinline__ void ce_(unsigned& a, unsigned& b, const bool up) { const unsigned lo = a < b ? a : b, hi = a < b ? b : a; a = up ? lo : hi; b = up ? hi : lo; }
__device__ __forceinline__ void bitonic_sort16(unsigned* x, const bool asc) {
#pragma unroll
    for (int k = 2; k <= 16; k <<= 1)
#pragma unroll
        for (int j = k >> 1; j > 0; j >>= 1)
#pragma unroll
            for (int i = 0; i < 16; ++i) { const int l = i ^ j; if (l > i) ce_(x[i], x[l], ((i & k) == 0) == asc); }
}
__device__ __forceinline__ void bitonic_merge16(unsigned* x, const bool asc) {
#pragma unroll
    for (int j = 8; j > 0; j >>= 1)
#pragma unroll
        for (int i = 0; i < 16; ++i) { const int l = i ^ j; if (l > i) ce_(x[i], x[l], asc); }
}
__device__ __forceinline__ void phase_peer_topk(const Params& p, int layer, unsigned char* lds) {
    const bf16_t* QK = (const bf16_t*)(p.ws + WS_QK); const bf16_t* SK = (const bf16_t*)(p.ws + WS_SUBK) + (size_t)layer * 8 * 2 * 128 * 128;
    float* TOPS = (float*)(p.ws + WS_TOPS); int* TOPI = (int*)(p.ws + WS_TOPI);
    float* sc = (float*)lds;
    const int tid = threadIdx.x, lane = tid & 63, wid = tid >> 6, wr = wid >> 1, wc = wid & 1, fr = lane & 15, fq = lane >> 4;
    for (int id = vblock(); id < 256 * 16; id += gridDim.x) {
        const int mt = id >> 4, hc = id & 15;
        f32x4 acc[4][4];
        gemm_tile3(ALoadPlain{QK + (size_t)mt * 128 * 2048 + hc * 128, (size_t)2048}, SK + (size_t)hc * 128 * 128, 128, 2, acc, lds);
#pragma unroll
        for (int mi = 0; mi < 4; ++mi)
#pragma unroll
            for (int ni = 0; ni < 4; ++ni) {
                const int r = wr * 64 + mi * 16 + fr, c = wc * 64 + ni * 16 + fq * 4;
                float* d = sc + r * 129 + c;
                d[0] = acc[mi][ni].x; d[1] = acc[mi][ni].y; d[2] = acc[mi][ni].z; d[3] = acc[mi][ni].w;
            }
        __syncthreads();
        {
            const int row = tid >> 1, half = tid & 1;
            unsigned x[64];
            const float* rp = sc + row * 129 + half * 64;
#pragma unroll
            for (int j = 0; j < 64; ++j) {
                const unsigned bits = __builtin_bit_cast(unsigned, rp[j]);
                const unsigned u = bits ^ ((unsigned)((int)bits >> 31) | 0x80000000u);
                x[j] = (u & 0xFFFFFF80u) | (unsigned)(127 - (half * 64 + j));
            }
            bitonic_sort16(x, true); bitonic_sort16(x + 16, false); bitonic_sort16(x + 32, true); bitonic_sort16(x + 48, false);
#pragma unroll
            for (int i = 0; i < 16; ++i) { x[i] = x[i] > x[16 + i] ? x[i] : x[16 + i]; x[32 + i] = x[32 + i] > x[48 + i] ? x[32 + i] : x[48 + i]; }
            bitonic_merge16(x, true); bitonic_merge16(x + 32, false);
#pragma unroll
            for (int i = 0; i < 16; ++i) x[i] = x[i] > x[32 + i] ? x[i] : x[32 + i];
            bitonic_merge16(x, false);
            unsigned y[16];
#pragma unroll
            for (int i = 0; i < 16; ++i) { const unsigned o = (unsigned)__shfl_xor((int)x[15 - i], 1); y[i] = x[i] > o ? x[i] : o; }
            bitonic_merge16(y, false);
            const size_t ob = ((size_t)(mt * 128 + row) * 16 + hc) * 16;
            if (half == 0) {
                float v[16];
#pragma unroll
                for (int i = 0; i < 16; ++i) { const unsigned u = y[i] & 0xFFFFFF80u; const unsigned bits = (u & 0x80000000u) ? (u ^ 0x80000000u) : ~u; v[i] = __builtin_bit_cast(float, bits); }
#pragma unroll
                for (int q = 0; q < 4; ++q) *(f32x4*)(TOPS + ob + q * 4) = (f32x4){v[q * 4], v[q * 4 + 1], v[q * 4 + 2], v[q * 4 + 3]};
            } else {
#pragma unroll
                for (int q = 0; q < 4; ++q) *(u32x4*)(TOPI + ob + q * 4) = (u32x4){127u - (y[q * 4] & 127u), 127u - (y[q * 4 + 1] & 127u), 127u - (y[q * 4 + 2] & 127u), 127u - (y[q * 4 + 3] & 127u)};
            }
        }
        __syncthreads();
    }
}
__device__ __forceinline__ void phase_peer_combine(const Params& p, unsigned char* lds) {
    const float* TOPS = (const float*)(p.ws + WS_TOPS); const int* TOPI = (const int*)(p.ws + WS_TOPI);
    int* EXP = (int*)(p.ws + WS_EXP); float* GATE = (float*)(p.ws + WS_GATE);
    unsigned* L = (unsigned*)lds;
    const int tid = threadIdx.x;
    for (int it = blockIdx.x; it < (T * 8) / 256; it += gridDim.x) {
        const size_t th = (size_t)it * 256 + tid;
        const u32x4* S4 = (const u32x4*)(TOPS + th * 32); const u32x4* I4 = (const u32x4*)(TOPI + th * 32);
#pragma unroll
        for (int a4 = 0; a4 < 8; ++a4) {
            const u32x4 s = S4[a4], i = I4[a4];
            L[(a4 * 4 + 0) * 256 + tid] = s.x; L[(a4 * 4 + 1) * 256 + tid] = s.y; L[(a4 * 4 + 2) * 256 + tid] = s.z; L[(a4 * 4 + 3) * 256 + tid] = s.w;
            L[(32 + a4 * 4 + 0) * 256 + tid] = i.x; L[(32 + a4 * 4 + 1) * 256 + tid] = i.y; L[(32 + a4 * 4 + 2) * 256 + tid] = i.z; L[(32 + a4 * 4 + 3) * 256 + tid] = i.w;
        }
        float val[16];
        const float s20 = __builtin_bit_cast(float, L[16 * 256 + tid]);
#pragma unroll
        for (int a = 0; a < 16; ++a) val[a] = __builtin_bit_cast(float, L[a * 256 + tid]) + s20;
        unsigned long long P = 0ull;
        float ts[16]; int te[16];
#pragma unroll
        for (int r = 0; r < 16; ++r) {
            float best = val[0]; int ba = 0;
#pragma unroll
            for (int a = 1; a < 16; ++a) if (val[a] > best) { best = val[a]; ba = a; }
            const int b = (int)((P >> (4 * ba)) & 15ull);
            const int i1 = (int)L[(32 + ba) * 256 + tid], i2 = (int)L[(48 + b) * 256 + tid];
            ts[r] = best; te[r] = i1 * 128 + i2;
            const int nb = b + 1;
            float newv = -3.0e38f;
            if (nb < 16) { newv = __builtin_bit_cast(float, L[ba * 256 + tid]) + __builtin_bit_cast(float, L[(16 + nb) * 256 + tid]); P += 1ull << (4 * ba); }
#pragma unroll
            for (int a = 0; a < 16; ++a) val[a] = (a == ba) ? newv : val[a];
        }
        const float m0 = ts[0];
        float sum = 0.f;
#pragma unroll
        for (int r = 0; r < 16; ++r) { ts[r] = __expf(ts[r] - m0); sum += ts[r]; }
        const float inv = 1.0f / sum;
#pragma unroll
        for (int r = 0; r < 16; ++r) ts[r] *= inv;
#pragma unroll
        for (int r = 0; r < 16; ++r) { EXP[th * 16 + r] = te[r]; GATE[th * 16 + r] = ts[r]; }
    }
}

__device__ __forceinline__ void fma8(const unsigned w0, const unsigned w1, const float a, float* acc) {
    const f32x2 p0 = __builtin_amdgcn_cvt_pk_f32_fp8((int)w0, false), p1 = __builtin_amdgcn_cvt_pk_f32_fp8((int)w0, true);
    const f32x2 p2 = __builtin_amdgcn_cvt_pk_f32_fp8((int)w1, false), p3 = __builtin_amdgcn_cvt_pk_f32_fp8((int)w1, true);
    acc[0] += a * p0.x; acc[1] += a * p0.y; acc[2] += a * p1.x; acc[3] += a * p1.y;
    acc[4] += a * p2.x; acc[5] += a * p2.y; acc[6] += a * p3.x; acc[7] += a * p3.y;
}
__device__ __forceinline__ float dot8(const unsigned w0, const unsigned w1, const float* h, float s) {
    const f32x2 p0 = __builtin_amdgcn_cvt_pk_f32_fp8((int)w0, false), p1 = __builtin_amdgcn_cvt_pk_f32_fp8((int)w0, true);
    const f32x2 p2 = __builtin_amdgcn_cvt_pk_f32_fp8((int)w1, false), p3 = __builtin_amdgcn_cvt_pk_f32_fp8((int)w1, true);
    s += p0.x * h[0]; s += p0.y * h[1]; s += p1.x * h[2]; s += p1.y * h[3];
    s += p2.x * h[4]; s += p2.y * h[5]; s += p3.x * h[6]; s += p3.y * h[7];
    return s;
}
__device__ __forceinline__ void phase_peer_apply(const Params& p, int layer, unsigned char* lds, bool dry) {
    const int lane = threadIdx.x & 63, wave = threadIdx.x >> 6;
    float* ldsw = (float*)lds + wave * (64 * 65);
    const bf16_t* HM = (const bf16_t*)(p.ws + WS_HM);
    const unsigned char* PU = p.ws + WS_PU; const unsigned char* PV = p.ws + WS_PV;
    const float* SU = (const float*)(p.ws + WS_PU + 24 * MiB); const float* SV = (const float*)(p.ws + WS_PV + 24 * MiB);
    const int* EXP = (const int*)(p.ws + WS_EXP); const float* GATE = (const float*)(p.ws + WS_GATE);
    const float* MOD = (const float*)(p.ws + WS_MOD);
    float* X = p.out;
    for (int t = blockIdx.x * 4 + wave; t < T; t += gridDim.x * 4) {
        const u32x4 ha = *(const u32x4*)(HM + (size_t)t * D + lane * 16), hb = *(const u32x4*)(HM + (size_t)t * D + lane * 16 + 8);
        float hf[16];
        hf[0] = bflo(ha.x); hf[1] = bfhi(ha.x); hf[2] = bflo(ha.y); hf[3] = bfhi(ha.y); hf[4] = bflo(ha.z); hf[5] = bfhi(ha.z); hf[6] = bflo(ha.w); hf[7] = bfhi(ha.w);
        hf[8] = bflo(hb.x); hf[9] = bfhi(hb.x); hf[10] = bflo(hb.y); hf[11] = bfhi(hb.y); hf[12] = bflo(hb.z); hf[13] = bfhi(hb.z); hf[14] = bflo(hb.w); hf[15] = bfhi(hb.w);
        const int e0_ = EXP[(size_t)t * 128 + lane], e1_ = EXP[(size_t)t * 128 + 64 + lane];
        const float g0 = GATE[(size_t)t * 128 + lane], g1 = GATE[(size_t)t * 128 + 64 + lane];
        const float su0 = SU[e0_], su1 = SU[e1_], sv0 = SV[e0_], sv1 = SV[e1_];
        u32x4 buf[16];
        float act0 = 0.f, act1 = 0.f;
        float acc[16];
#pragma unroll
        for (int i = 0; i < 16; ++i) acc[i] = 0.f;
#ifndef APPLY_L2PROBE
#define APPLY_L2PROBE 0
#endif
        for (int prep_ = 0; prep_ < 1 + APPLY_L2PROBE; ++prep_) {
        const int emask = (APPLY_L2PROBE && prep_ == 0) ? 2047 : 0x7fffffff;
        const int e0 = e0_ & emask, e1 = e1_ & emask;
#pragma unroll
        for (int j = 0; j < 16; ++j) { const int e_ = __builtin_amdgcn_readlane(e0, j); buf[j] = *(const u32x4*)(PU + (size_t)e_ * D + lane * 16); }
#pragma unroll
        for (int bt = 0; bt < 16; ++bt) {
#pragma unroll
            for (int j = 0; j < 16; ++j) {
                if (bt < 8) {
                    float s_ = dot8(buf[j].x, buf[j].y, hf, 0.f); s_ = dot8(buf[j].z, buf[j].w, hf + 8, s_);
                    ldsw[((bt & 3) * 16 + j) * 65 + lane] = s_;
                } else {
                    const float av_ = ((bt & 7) < 4) ? act0 : act1;
                    const float a_ = __builtin_bit_cast(float, __builtin_amdgcn_readlane(__builtin_bit_cast(int, av_), (bt & 3) * 16 + j));
                    fma8(buf[j].x, buf[j].y, a_, acc); fma8(buf[j].z, buf[j].w, a_, acc + 8);
                }
                if (bt + 1 < 16) {
                    const int nb = bt + 1;
                    const int e_ = __builtin_amdgcn_readlane(((nb & 7) < 4) ? e0 : e1, (nb & 3) * 16 + j);
                    buf[j] = *(const u32x4*)(((nb < 8) ? PU : PV) + (size_t)e_ * D + lane * 16);
                }
            }
            if (bt == 3 || bt == 7) {
                float tot_ = 0.f;
#pragma unroll 16
                for (int q = 0; q < 64; ++q) tot_ += ldsw[lane * 65 + q];
                if (bt == 3) act0 = gelu_tanh(tot_ * su0) * g0 * sv0; else act1 = gelu_tanh(tot_ * su1) * g1 * sv1;
            }
        }
        if (APPLY_L2PROBE && prep_ == 0 && p.ph_hi >= 0) {
#pragma unroll
            for (int i = 0; i < 16; ++i) acc[i] = 0.f;
        }
        }
        const int b = t / SEQ;
        const float* g2 = MOD + (size_t)(layer * 2 + b) * 6144 + 5120;
        float* xr = X + (size_t)t * D + lane * 16;
        f32x4 xs[4]; float ss = 0.f;
#pragma unroll
        for (int q = 0; q < 4; ++q) {
            const f32x4 g = *(const f32x4*)(g2 + lane * 16 + q * 4); f32x4 x = *(const f32x4*)(xr + q * 4);
            x.x += g.x * acc[q * 4 + 0]; x.y += g.y * acc[q * 4 + 1]; x.z += g.z * acc[q * 4 + 2]; x.w += g.w * acc[q * 4 + 3];
            xs[q] = x; ss += (x.x * x.x + x.y * x.y) + (x.z * x.z + x.w * x.w);
        }
        const float rs = rsqrtf(wave_sum(ss) * (1.0f / D) + RMS_EPS);
        if (!dry) {
            if (layer == 0) {
                const float* gw = p.in[2] + D + lane * 16; const float* sh = MOD + (size_t)(2 + b) * 6144 + lane * 16; const float* sc = sh + 1024;
                u32x4 o[2];
#pragma unroll
                for (int q = 0; q < 4; ++q) {
                    *(f32x4*)(xr + q * 4) = xs[q];
                    const f32x4 g = *(const f32x4*)(gw + q * 4), s1 = *(const f32x4*)(sc + q * 4), s0 = *(const f32x4*)(sh + q * 4);
                    const float y0 = xs[q].x * rs * g.x * (1.f + s1.x) + s0.x, y1 = xs[q].y * rs * g.y * (1.f + s1.y) + s0.y;
                    const float y2 = xs[q].z * rs * g.z * (1.f + s1.z) + s0.z, y3 = xs[q].w * rs * g.w * (1.f + s1.w) + s0.w;
                    if (q & 1) { o[q >> 1].z = pk2(y0, y1); o[q >> 1].w = pk2(y2, y3); } else { o[q >> 1].x = pk2(y0, y1); o[q >> 1].y = pk2(y2, y3); }
                }
                bf16_t* hm = (bf16_t*)(p.ws + WS_HM) + (size_t)t * D + lane * 16;
                *(u32x4*)hm = o[0]; *(u32x4*)(hm + 8) = o[1];
            } else {
                const float* gw = p.in[28] + lane * 16;
#pragma unroll
                for (int q = 0; q < 4; ++q) {
                    const f32x4 g = *(const f32x4*)(gw + q * 4);
                    *(f32x4*)(xr + q * 4) = (f32x4){xs[q].x * rs * g.x, xs[q].y * rs * g.y, xs[q].z * rs * g.z, xs[q].w * rs * g.w};
                }
            }
        }
    }
}
__device__ __forceinline__ void phase_tab1(const Params& p) {
    for (int it = blockIdx.x; it < 2 * P0_TAB; it += gridDim.x) {
        if (it < P0_TAB) cvt_fp8_item(p.in[26] + (size_t)PE * D, p.ws + WS_PU, (float*)(p.ws + WS_PU + 24 * MiB), it, false);
        else cvt_fp8_item(p.in[27] + (size_t)PE * D, p.ws + WS_PV, (float*)(p.ws + WS_PV + 24 * MiB), it - P0_TAB, false);
    }
}
__device__ __forceinline__ void phase_nsa_proj(const Params& p, unsigned char* lds) {
    const bf16_t* HM = (const bf16_t*)(p.ws + WS_HM); const bf16_t* WT = (const bf16_t*)(p.ws + WS_WPROJ_T);
    const f32x2* ROPE = (const f32x2*)(p.ws + WS_ROPE);
    bf16_t* Q = (bf16_t*)(p.ws + WS_Q); float* NGT = (float*)(p.ws + WS_NG);
    const int lane = threadIdx.x & 63, wid = threadIdx.x >> 6, wr = wid >> 1, wc = wid & 1, fr = lane & 15, fq = lane >> 4;
    for (int id = vblock(); id < 256 * 21; id += gridDim.x) {
        const int mt = id / 21, nt = id % 21;
        f32x4 acc[4][4];
        gemm_tile3(ALoadPlain{HM + (size_t)mt * 128 * D, (size_t)D}, WT + (size_t)nt * 128 * D, D, 16, acc, lds);
        const int c0 = nt * 128 + wc * 64;
        if (c0 >= 2624) continue;
        const int b = (mt * 128) / SEQ;
        if (c0 == 2560) {
#pragma unroll
            for (int mi = 0; mi < 4; ++mi)
#pragma unroll
                for (int ni = 0; ni < 3; ++ni) {
                    const int t = mt * 128 + wr * 64 + mi * 16 + fr;
                    const f32x4 v = acc[mi][ni];
                    *(f32x4*)(NGT + (size_t)t * 48 + ni * 16 + fq * 4) = (f32x4){sigmoidf_(v.x), sigmoidf_(v.y), sigmoidf_(v.z), sigmoidf_(v.w)};
                }
            continue;
        }
        int sec = -1, g = 0;
        if (c0 >= 1024) { sec = (c0 - 1024) >> 8; g = ((c0 - 1024) & 255) >> 6; }
        const bool dorope = (sec == -1) || (sec == 2) || (sec == 4);
        const float scl = (sec == -1) ? 0.125f : 1.0f;
        const size_t secoff[6] = {WS_KC, WS_VC, WS_KS, WS_VST, WS_KW, WS_VWT};
        size_t so = WS_Q;
#pragma unroll
        for (int q = 0; q < 6; ++q) if (sec == q) so = secoff[q];
        bf16_t* OUT = (bf16_t*)(p.ws + so);
        const bool vt = (sec == 3) || (sec == 5);
        float kblk_am = 0.f;
#pragma unroll
        for (int pass = 0; pass < 2; ++pass) {
        if (pass == 1 && sec == 2) {
#pragma unroll
            for (int o = 1; o < 64; o <<= 1) kblk_am = fmaxf(kblk_am, __shfl_xor(kblk_am, o));
            if (lane == 0) ((float*)(p.ws + WS_KS + 12 * MiB))[(size_t)(b * 4 + g) * 256 + ((mt * 128 + wr * 64 - b * SEQ) >> 6)] = kblk_am > 0.f ? kblk_am / 224.0f : 1.0f;
        }
#pragma unroll
        for (int mi = 0; mi < 4; ++mi) {
            const int t = mt * 128 + wr * 64 + mi * 16 + fr, s = t - b * SEQ;
            if (dorope && pass == 0) {
#pragma unroll
                for (int ni = 0; ni < 2; ++ni) {
                    const f32x4* rp = (const f32x4*)(ROPE + (size_t)s * 32 + ni * 16 + fq * 4);
                    const f32x4 r0 = rp[0], r1 = rp[1];
                    const f32x4 x1 = acc[mi][ni], x2 = acc[mi][ni + 2];
                    acc[mi][ni] = (f32x4){x1.x * r0.x - x2.x * r0.y, x1.y * r0.z - x2.y * r0.w, x1.z * r1.x - x2.z * r1.y, x1.w * r1.z - x2.w * r1.w};
                    acc[mi][ni + 2] = (f32x4){x1.x * r0.y + x2.x * r0.x, x1.y * r0.w + x2.y * r0.z, x1.z * r1.y + x2.z * r1.x, x1.w * r1.w + x2.w * r1.z};
                }
            }
            if (pass == 0) {
                if (sec == 2) {
#pragma unroll
                    for (int ni = 0; ni < 4; ++ni) { const f32x4 v = acc[mi][ni]; kblk_am = fmaxf(kblk_am, fmaxf(fmaxf(fabsf(v.x), fabsf(v.y)), fmaxf(fabsf(v.z), fabsf(v.w)))); }
                }
                continue;
            }
            if (sec == -1 || sec == 2) {
                float am = kblk_am;
                if (sec == -1) {
                    am = 0.f;
#pragma unroll
                    for (int ni = 0; ni < 4; ++ni) { const f32x4 v = acc[mi][ni] * scl; am = fmaxf(am, fmaxf(fmaxf(fabsf(v.x), fabsf(v.y)), fmaxf(fabsf(v.z), fabsf(v.w)))); }
                    am = fmaxf(am, __shfl_xor(am, 16)); am = fmaxf(am, __shfl_xor(am, 32));
                }
                const float qs = am > 0.f ? 224.0f / am : 1.0f;
                unsigned char* O8 = (sec == -1) ? (p.ws + WS_Q8 + (size_t)t * 1024 + c0) : (p.ws + WS_KS + ((size_t)(b * 4 + g) * SEQ + s) * 64);
#pragma unroll
                for (int ni = 0; ni < 4; ++ni) {
                    const f32x4 v = acc[mi][ni] * (scl * qs);
                    int w = 0; w = __builtin_amdgcn_cvt_pk_fp8_f32(v.x, v.y, w, false); w = __builtin_amdgcn_cvt_pk_fp8_f32(v.z, v.w, w, true);
                    *(int*)(O8 + ni * 16 + fq * 4) = w;
                }
                if (fq == 0 && sec == -1) ((float*)(p.ws + WS_Q8 + 32 * MiB))[(size_t)t * 16 + (c0 >> 6)] = am > 0.f ? am / 224.0f : 1.0f;
            }
            if (sec == 2) continue;
#pragma unroll
            for (int ni = 0; ni < 4; ++ni) {
                const f32x4 v = acc[mi][ni] * scl;
                const int d = ni * 16 + fq * 4;
                if (sec == -1) {
                    *(u32x2*)(OUT + (size_t)t * 1024 + c0 + d) = (u32x2){pk2(v.x, v.y), pk2(v.z, v.w)};
                } else if (sec == 4) {
                    const size_t idx = (size_t)(b * 4 + g) * SEQ * 64 + (size_t)(s >> 5) * 2048 + ((((s >> 4) & 1) * 2 + (ni >> 1)) * 16 + (s & 15)) * 32 + ((ni & 1) * 2 + (fq >> 1)) * 8 + (fq & 1) * 4;
                    *(u32x2*)(OUT + idx) = (u32x2){pk2(v.x, v.y), pk2(v.z, v.w)};
                } else if (!vt) {
                    *(u32x2*)(OUT + ((size_t)(b * 4 + g) * SEQ + s) * 64 + d) = (u32x2){pk2(v.x, v.y), pk2(v.z, v.w)};
                } else if (sec == 5) {
                    const int key = s & 31;
                    bf16_t* o = OUT + (size_t)(b * 4 + g) * SEQ * 64 + (size_t)(s >> 5) * 2048 + ((ni * 2 + (key >> 4)) * 16 + fq * 4) * 16 + ((key >> 2) & 3) * 4 + (key & 3);
                    o[0] = (bf16_t)f2bf(v.x); o[16] = (bf16_t)f2bf(v.y); o[32] = (bf16_t)f2bf(v.z); o[48] = (bf16_t)f2bf(v.w);
                }
            }
        }
        }
        if (sec == 3) {
            const int s0 = mt * 128 + wr * 64 - b * SEQ, jb = s0 >> 6;
            unsigned char* V8 = p.ws + WS_VST + (size_t)((b * 4 + g) * 256 + jb) * 4096;
            float am = 0.f;
#pragma unroll
            for (int mi = 0; mi < 4; ++mi)
#pragma unroll
                for (int ni = 0; ni < 4; ++ni) { const f32x4 v = acc[mi][ni]; am = fmaxf(am, fmaxf(fmaxf(fabsf(v.x), fabsf(v.y)), fmaxf(fabsf(v.z), fabsf(v.w)))); }
#pragma unroll
            for (int o = 1; o < 64; o <<= 1) am = fmaxf(am, __shfl_xor(am, o));
            const float qs = am > 0.f ? 224.0f / am : 1.0f;
            if (lane == 0) ((float*)(p.ws + WS_VST + 12 * MiB))[(size_t)(b * 4 + g) * 256 + jb] = am > 0.f ? am / 224.0f : 1.0f;
#pragma unroll
            for (int ni = 0; ni < 4; ++ni) {
                const int d = ni * 16 + fq * 4;
#pragma unroll
                for (int mi = 0; mi < 4; ++mi) {
                    const f32x4 v = acc[mi][ni] * qs;
                    int w = 0; w = __builtin_amdgcn_cvt_pk_fp8_f32(v.x, v.y, w, false); w = __builtin_amdgcn_cvt_pk_fp8_f32(v.z, v.w, w, true);
                    unsigned char* o = V8 + (size_t)d * 64 + mi * 16 + fr;
                    o[0] = (unsigned char)(w & 255); o[64] = (unsigned char)((w >> 8) & 255); o[128] = (unsigned char)((w >> 16) & 255); o[192] = (unsigned char)((unsigned)w >> 24);
                }
            }
        }
    }
}
__device__ __forceinline__ void phase_nsa_cmp1(const Params& p, unsigned char* lds) {
    bf16_t* HID = (bf16_t*)(p.ws + WS_HID);
    const float* bias = (const float*)(p.ws + WS_MISC);
    const int lane = threadIdx.x & 63, wid = threadIdx.x >> 6, wr = wid >> 1, wc = wid & 1, fr = lane & 15, fq = lane >> 4;
    for (int id = vblock(); id < 256; id += gridDim.x) {
        const int kv = id >> 7, bg = (id >> 4) & 7, mt = (id >> 1) & 7, nt = id & 1;
        const bf16_t* A = (const bf16_t*)(p.ws + (kv ? WS_VC : WS_KC)) + (size_t)bg * SEQ * 64 + (size_t)mt * 128 * 1024;
        const bf16_t* B = (const bf16_t*)(p.ws + (kv ? WS_WV1_T : WS_WK1_T)) + (size_t)nt * 128 * 2048;
        f32x4 acc[4][4];
        gemm_tile3(ALoadPlain{A, (size_t)1024}, B, 2048, 32, acc, lds);
#pragma unroll
        for (int mi = 0; mi < 4; ++mi)
#pragma unroll
            for (int ni = 0; ni < 4; ++ni) {
                const int n = mt * 128 + wr * 64 + mi * 16 + fr, c = nt * 128 + wc * 64 + ni * 16 + fq * 4;
                const f32x4 bv = *(const f32x4*)(bias + kv * 256 + c);
                const f32x4 v = acc[mi][ni] + bv;
                *(u32x2*)(HID + (((size_t)kv * 8 + bg) * 1024 + n) * 256 + c) = (u32x2){pk2(gelu_tanh(v.x), gelu_tanh(v.y)), pk2(gelu_tanh(v.z), gelu_tanh(v.w))};
            }
    }
}
__device__ __forceinline__ void phase_nsa_cmp2(const Params& p, unsigned char* lds) {
    const bf16_t* HID = (const bf16_t*)(p.ws + WS_HID);
    const f32x2* ROPE = (const f32x2*)(p.ws + WS_ROPE);
    bf16_t* KCMP = (bf16_t*)(p.ws + WS_KCMP); bf16_t* VCMPT = (bf16_t*)(p.ws + WS_VCMPT);
    const int lane = threadIdx.x & 63, wid = threadIdx.x >> 6, wr = wid >> 1, wc = wid & 1, fr = lane & 15, fq = lane >> 4;
    for (int id = vblock(); id < 128; id += gridDim.x) {
        const int kv = id >> 6, mt = id & 63;
        const bf16_t* A = HID + ((size_t)kv * 8192 + (size_t)mt * 128) * 256;
        const bf16_t* B = (const bf16_t*)(p.ws + (kv ? WS_WV2_T : WS_WK2_T));
        f32x4 acc[4][4];
        gemm_tile3(ALoadPlain{A, (size_t)256}, B, 256, 4, acc, lds);
        if (wc == 1) continue;
#pragma unroll
        for (int mi = 0; mi < 4; ++mi) {
            const int R = mt * 128 + wr * 64 + mi * 16 + fr, bg = R >> 10, n = R & 1023;
            if (kv == 0) {
                int pos = n * 16 + 31; pos = pos > SEQ - 1 ? SEQ - 1 : pos;
#pragma unroll
                for (int ni = 0; ni < 2; ++ni) {
                    const f32x4* rp = (const f32x4*)(ROPE + (size_t)pos * 32 + ni * 16 + fq * 4);
                    const f32x4 r0 = rp[0], r1 = rp[1];
                    const f32x4 x1 = acc[mi][ni], x2 = acc[mi][ni + 2];
                    acc[mi][ni] = (f32x4){x1.x * r0.x - x2.x * r0.y, x1.y * r0.z - x2.y * r0.w, x1.z * r1.x - x2.z * r1.y, x1.w * r1.z - x2.w * r1.w};
                    acc[mi][ni + 2] = (f32x4){x1.x * r0.y + x2.x * r0.x, x1.y * r0.w + x2.y * r0.z, x1.z * r1.y + x2.z * r1.x, x1.w * r1.w + x2.w * r1.z};
                }
#pragma unroll
                for (int ni = 0; ni < 4; ++ni) {
                    const f32x4 v = acc[mi][ni];
                    const size_t idx = (size_t)bg * 1024 * 64 + (size_t)(n >> 5) * 2048 + ((((n >> 4) & 1) * 2 + (ni >> 1)) * 16 + (n & 15)) * 32 + ((ni & 1) * 2 + (fq >> 1)) * 8 + (fq & 1) * 4;
                    *(u32x2*)(KCMP + idx) = (u32x2){pk2(v.x, v.y), pk2(v.z, v.w)};
                }
            } else {
#pragma unroll
                for (int ni = 0; ni < 4; ++ni) {
                    const f32x4 v = acc[mi][ni];
                    const int key = n & 31;
                    bf16_t* o = VCMPT + (size_t)bg * 1024 * 64 + (size_t)(n >> 5) * 2048 + ((ni * 2 + (key >> 4)) * 16 + fq * 4) * 16 + ((key >> 2) & 3) * 4 + (key & 3);
                    o[0] = (bf16_t)f2bf(v.x); o[16] = (bf16_t)f2bf(v.y); o[32] = (bf16_t)f2bf(v.z); o[48] = (bf16_t)f2bf(v.w);
                }
            }
        }
    }
}
__device__ __forceinline__ void phase_nsa_wo(const Params& p, unsigned char* lds, bool dry) {
    const bf16_t* O = (const bf16_t*)(p.ws + WS_O); const bf16_t* WT = (const bf16_t*)(p.ws + WS_WO_T);
    const float* MOD = (const float*)(p.ws + WS_MOD);
    float* X = p.out;
    const int lane = threadIdx.x & 63, wid = threadIdx.x >> 6, wr = wid >> 1, wc = wid & 1, fr = lane & 15, fq = lane >> 4;
    for (int id = vblock(); id < 256 * 8; id += gridDim.x) {
        const int mt = id >> 3, nt = id & 7;
        f32x4 acc[4][4];
        gemm_tile3(ALoadPlain{O + (size_t)mt * 128 * D, (size_t)D}, WT + (size_t)nt * 128 * D, D, 16, acc, lds);
        const int b = (mt * 128) / SEQ;
#pragma unroll
        for (int mi = 0; mi < 4; ++mi)
#pragma unroll
            for (int ni = 0; ni < 4; ++ni) {
                const int t = mt * 128 + wr * 64 + mi * 16 + fr, c = nt * 128 + wc * 64 + ni * 16 + fq * 4;
                const f32x4 g1 = *(const f32x4*)(MOD + (size_t)(1 * 2 + b) * 6144 + 2048 + c);
                float* xp = X + (size_t)t * D + c;
                const f32x4 x = *(const f32x4*)xp; const f32x4 v = acc[mi][ni];
                if (!dry) *(f32x4*)xp = (f32x4){x.x + g1.x * v.x, x.y + g1.y * v.y, x.z + g1.z * v.z, x.w + g1.w * v.w};
            }
    }
}
__device__ __forceinline__ bf16x8 pack8(const f32x4 a, const f32x4 b) {
    u32x4 w; w.x = pk2(a.x, a.y); w.y = pk2(a.z, a.w); w.z = pk2(b.x, b.y); w.w = pk2(b.z, b.w);
    return __builtin_bit_cast(bf16x8, w);
}
__device__ __forceinline__ bf16x8 ldv8(const bf16_t* plo, const bf16_t* phi) {
    const u32x2 lo = *(const u32x2*)plo, hi = *(const u32x2*)phi;
    u32x4 w; w.x = lo.x; w.y = lo.y; w.z = hi.x; w.w = hi.y;
    return __builtin_bit_cast(bf16x8, w);
}
__device__ __forceinline__ float red4(float v) { v += __shfl_xor(v, 16); v += __shfl_xor(v, 32); return v; }
__device__ __forceinline__ float max4(float v) { v = fmaxf(v, __shfl_xor(v, 16)); v = fmaxf(v, __shfl_xor(v, 32)); return v; }
#define NEGBIG (-1.0e30f)

__device__ __forceinline__ void phase_nsa_attn(const Params& p, unsigned char* lds, const int rep_cmp, const int rep_win, const int rep_sel) {
    const int lane = threadIdx.x & 63, wave = threadIdx.x >> 6, fr = lane & 15, fq = lane >> 4;
    unsigned char* WL = lds + wave * 18432;
    float* IMP = (float*)WL;
    int* SEL = (int*)(WL + 17408);
    const bf16_t* Q = (const bf16_t*)(p.ws + WS_Q);
    const bf16_t* KCMP = (const bf16_t*)(p.ws + WS_KCMP); const bf16_t* VCMPT = (const bf16_t*)(p.ws + WS_VCMPT);
    const bf16_t* KW = (const bf16_t*)(p.ws + WS_KW); const bf16_t* VWT = (const bf16_t*)(p.ws + WS_VWT);
    const float* NGT = (const float*)(p.ws + WS_NG);
    bf16_t* O = (bf16_t*)(p.ws + WS_O);
    const f32x4 z4 = (f32x4){0.f, 0.f, 0.f, 0.f};
    for (int bi = blockIdx.x; bi < 2048; bi += gridDim.x) {
        const int bg = bi & 7, quad = 255 - (bi >> 3), t0 = (quad * 4 + wave) * 16, b = bg >> 2, g = bg & 3;
        const int cur = t0 >> 6;
        const size_t tok = (size_t)b * SEQ + t0 + fr;
        const int tq = t0 + fr;
        bf16x8 qf[4][2];
#pragma unroll
        for (int r = 0; r < 4; ++r)
#pragma unroll
            for (int ks = 0; ks < 2; ++ks) qf[r][ks] = *(const bf16x8*)(Q + tok * 1024 + (g * 4 + r) * 64 + ks * 32 + fq * 8);
        f32x4 acc[4][4];
        for (int rep = 0; rep < rep_win; ++rep) {
            const bf16_t* kwb = KW + (size_t)bg * SEQ * 64; const bf16_t* vwb = VWT + (size_t)bg * SEQ * 64;
            float mw[4], lw[4];
#pragma unroll
            for (int r = 0; r < 4; ++r) { mw[r] = NEGBIG; lw[r] = 0.f;
#pragma unroll
                for (int df = 0; df < 4; ++df) acc[r][df] = z4; }
            int kmin = t0 - 511; kmin = kmin < 0 ? 0 : kmin; kmin &= ~31;
            bf16x8 nkf[2][2];
#define WIN_LOAD(kb_) do { _Pragma("unroll") for (int f = 0; f < 2; ++f) _Pragma("unroll") for (int ks = 0; ks < 2; ++ks) nkf[f][ks] = *(const bf16x8*)(kwb + (size_t)((kb_) >> 5) * 2048 + ((f * 2 + ks) * 16 + fr) * 32 + fq * 8); } while (0)
            WIN_LOAD(kmin);
            for (int kb = kmin; kb <= t0 + 15; kb += 32) {
                bf16x8 kf[2][2], vf[4];
#pragma unroll
                for (int f = 0; f < 2; ++f) { kf[f][0] = nkf[f][0]; kf[f][1] = nkf[f][1]; }
#pragma unroll
                for (int df = 0; df < 4; ++df) { const bf16_t* vp = vwb + (size_t)(kb >> 5) * 2048 + (df * 32 + fr) * 16 + fq * 4; vf[df] = ldv8(vp, vp + 256); }
                { const int kn = (kb + 32 <= t0 + 15) ? kb + 32 : kb; WIN_LOAD(kn); }
#pragma unroll
                for (int r = 0; r < 4; ++r) {
                    f32x4 st[2];
#pragma unroll
                    for (int f = 0; f < 2; ++f) {
                        st[f] = __builtin_amdgcn_mfma_f32_16x16x32_bf16(kf[f][0], qf[r][0], z4, 0, 0, 0);
                        st[f] = __builtin_amdgcn_mfma_f32_16x16x32_bf16(kf[f][1], qf[r][1], st[f], 0, 0, 0);
                    }
                    float mx = NEGBIG;
#pragma unroll
                    for (int f = 0; f < 2; ++f)
#pragma unroll
                        for (int e = 0; e < 4; ++e) { const int key = kb + f * 16 + fq * 4 + e; const bool ok = (key <= tq) && (key > tq - 512); if (ok) mx = fmaxf(mx, st[f][e]); }
                    mx = max4(mx);
                    const float mn = fmaxf(mw[r], mx);
                    const float al = __expf(mw[r] - mn);
                    float ps = 0.f;
#pragma unroll
                    for (int f = 0; f < 2; ++f)
#pragma unroll
                        for (int e = 0; e < 4; ++e) { const int key = kb + f * 16 + fq * 4 + e; const bool ok = (key <= tq) && (key > tq - 512); const float pv = ok ? __expf(st[f][e] - mn) : 0.f; st[f][e] = pv; ps += pv; }
                    lw[r] = lw[r] * al + ps; mw[r] = mn;
                    const bf16x8 pf = pack8(st[0], st[1]);
#pragma unroll
                    for (int df = 0; df < 4; ++df) { acc[r][df] = acc[r][df] * al; acc[r][df] = __builtin_amdgcn_mfma_f32_16x16x32_bf16(vf[df], pf, acc[r][df], 0, 0, 0); }
                    __builtin_amdgcn_sched_barrier(0);
                }
            }
#pragma unroll
            for (int r = 0; r < 4; ++r) {
                const float l = red4(lw[r]); const float sc = NGT[tok * 48 + (g * 4 + r) * 3 + 2] / l;
#pragma unroll
                for (int df = 0; df < 4; ++df) acc[r][df] = acc[r][df] * sc;
            }
#undef WIN_LOAD
        }
        const int nmax_tile = (t0 >> 4) - 1, nmax_lane = (t0 >> 4) - 2 + (fr == 15 ? 1 : 0);
        const bf16_t* kcb = KCMP + (size_t)bg * 1024 * 64; const bf16_t* vcb = VCMPT + (size_t)bg * 64 * 1024;
        for (int rep = 0; rep < rep_cmp; ++rep) {
            const bool dry = (rep + 1 < rep_cmp);
            float mc[4], lc[4], invl[4];
#pragma unroll
            for (int r = 0; r < 4; ++r) { mc[r] = NEGBIG; lc[r] = 0.f; }
            bf16x8 nkc[2][2], nvc[4];
#define CMPK_LOAD(nb_) do { _Pragma("unroll") for (int f = 0; f < 2; ++f) _Pragma("unroll") for (int ks = 0; ks < 2; ++ks) nkc[f][ks] = *(const bf16x8*)(kcb + (size_t)((nb_) >> 5) * 2048 + ((f * 2 + ks) * 16 + fr) * 32 + fq * 8); } while (0)
#define CMPV_LOAD(nb_) do { _Pragma("unroll") for (int df = 0; df < 4; ++df) { const bf16_t* vp = vcb + (size_t)((nb_) >> 5) * 2048 + (df * 32 + fr) * 16 + fq * 4; nvc[df] = ldv8(vp, vp + 256); } } while (0)
            CMPK_LOAD(0);
            for (int nb = 0; nb <= nmax_tile; nb += 32) {
                bf16x8 kf[2][2];
#pragma unroll
                for (int f = 0; f < 2; ++f) { kf[f][0] = nkc[f][0]; kf[f][1] = nkc[f][1]; }
                { const int nn = (nb + 32 <= nmax_tile) ? nb + 32 : 0; CMPK_LOAD(nn); }
#pragma unroll
                for (int r = 0; r < 4; ++r) {
                    f32x4 st[2];
#pragma unroll
                    for (int f = 0; f < 2; ++f) {
                        st[f] = __builtin_amdgcn_mfma_f32_16x16x32_bf16(kf[f][0], qf[r][0], z4, 0, 0, 0);
                        st[f] = __builtin_amdgcn_mfma_f32_16x16x32_bf16(kf[f][1], qf[r][1], st[f], 0, 0, 0);
                    }
                    float mx = NEGBIG;
#pragma unroll
                    for (int f = 0; f < 2; ++f)
#pragma unroll
                        for (int e = 0; e < 4; ++e) { const int n = nb + f * 16 + fq * 4 + e; if (n <= nmax_lane) mx = fmaxf(mx, st[f][e]); }
                    mx = max4(mx);
                    const float mn = fmaxf(mc[r], mx);
                    float ps = 0.f;
#pragma unroll
                    for (int f = 0; f < 2; ++f)
#pragma unroll
                        for (int e = 0; e < 4; ++e) { const int n = nb + f * 16 + fq * 4 + e; if (n <= nmax_lane) ps += __expf(st[f][e] - mn); }
                    lc[r] = lc[r] * __expf(mc[r] - mn) + ps; mc[r] = mn;
                    __builtin_amdgcn_sched_barrier(0);
                }
            }
#pragma unroll
            for (int r = 0; r < 4; ++r) { const float l = red4(lc[r]); invl[r] = l > 0.f ? 1.0f / l : 0.f; }
            for (int i = lane; i < 16 * 260; i += 64) IMP[i] = 0.f;
            float carry = 0.f;
            float gc[4];
#pragma unroll
            for (int r = 0; r < 4; ++r) gc[r] = NGT[tok * 48 + (g * 4 + r) * 3];
            for (int nb = 0; nb <= nmax_tile; nb += 32) {
                bf16x8 kf[2][2], vf[4];
#pragma unroll
                for (int f = 0; f < 2; ++f) { kf[f][0] = nkc[f][0]; kf[f][1] = nkc[f][1]; }
                CMPV_LOAD(nb);
#pragma unroll
                for (int df = 0; df < 4; ++df) vf[df] = nvc[df];
                { const int nn = (nb + 32 <= nmax_tile) ? nb + 32 : nb; CMPK_LOAD(nn); }
                f32x4 pg[2] = {z4, z4};
#pragma unroll
                for (int r = 0; r < 4; ++r) {
                    f32x4 st[2];
#pragma unroll
                    for (int f = 0; f < 2; ++f) {
                        st[f] = __builtin_amdgcn_mfma_f32_16x16x32_bf16(kf[f][0], qf[r][0], z4, 0, 0, 0);
                        st[f] = __builtin_amdgcn_mfma_f32_16x16x32_bf16(kf[f][1], qf[r][1], st[f], 0, 0, 0);
#pragma unroll
                        for (int e = 0; e < 4; ++e) { const int n = nb + f * 16 + fq * 4 + e; st[f][e] = (n <= nmax_lane) ? __expf(st[f][e] - mc[r]) * invl[r] : 0.f; }
                        pg[f] += st[f];
                    }
                    const float gg = dry ? 0.f : gc[r];
                    const bf16x8 pf = pack8(st[0] * gg, st[1] * gg);
#pragma unroll
                    for (int df = 0; df < 4; ++df) acc[r][df] = __builtin_amdgcn_mfma_f32_16x16x32_bf16(vf[df], pf, acc[r][df], 0, 0, 0);
                    __builtin_amdgcn_sched_barrier(0);
                }
                const int src = (lane - 16) & 63;
                const float s0 = __shfl(pg[0].w, src), s1 = __shfl(pg[1].w, src), sc = __shfl(carry, src);
                const float prev0 = fq > 0 ? s0 : sc, prev1 = fq > 0 ? s1 : s0;
                const float imp0 = (pg[0].x + pg[0].y) + (pg[0].z + pg[0].w) + prev0;
                const float imp1 = (pg[1].x + pg[1].y) + (pg[1].z + pg[1].w) + prev1;
                const int jb = (nb >> 2) + fq;
                IMP[fr * 260 + jb] = imp0; IMP[fr * 260 + jb + 4] = imp1;
                carry = pg[1].w;
            }
#undef CMPK_LOAD
#undef CMPV_LOAD
        }
        {
            const int nf = cur >= 2 ? 3 : cur + 1;
            if (fq == 0) {
                SEL[fr * 16 + 0] = 0;
                if (cur == 1) SEL[fr * 16 + 1] = 1;
                if (cur >= 2) { SEL[fr * 16 + 1] = cur - 1; SEL[fr * 16 + 2] = cur; }
            }
            const int ncand = cur >= 3 ? cur - 2 : 0, extra = 16 - nf;
            if (ncand <= extra) {
                if (fq == 0) { for (int k = 0; k < extra; ++k) SEL[fr * 16 + nf + k] = (k < ncand) ? 1 + k : -1; }
            } else {
                for (int rnd = 0; rnd < extra; ++rnd) {
                    float bv = -1.0f; int bj = 1 << 20;
                    for (int jb = 1 + fq; jb <= cur - 2; jb += 4) { const float v = IMP[fr * 260 + jb]; if (v > bv) { bv = v; bj = jb; } }
#pragma unroll
                    for (int o = 16; o <= 32; o <<= 1) {
                        const float ov = __shfl_xor(bv, o); const int oj = __shfl_xor(bj, o);
                        if (ov > bv || (ov == bv && oj < bj)) { bv = ov; bj = oj; }
                    }
                    if (fq == 0) SEL[fr * 16 + nf + rnd] = bj;
                    if (((bj - 1) & 3) == fq) IMP[fr * 260 + bj] = -2.0f;
                }
            }
        }
#pragma unroll
        for (int r = 0; r < 4; ++r)
#pragma unroll
            for (int df = 0; df < 4; ++df) {
                const f32x4 v = acc[r][df];
                *(u32x2*)(O + tok * 1024 + (g * 4 + r) * 64 + df * 16 + fq * 4) = (u32x2){pk2(v.x, v.y), pk2(v.z, v.w)};
            }
        asm volatile("s_waitcnt vmcnt(0)" ::: "memory");
        unsigned selp[4];
        {
            const u32x4* sp = (const u32x4*)(SEL + fr * 16);
#pragma unroll
            for (int q = 0; q < 4; ++q) { const u32x4 w = sp[q]; selp[q] = (w.x & 255u) | ((w.y & 255u) << 8) | ((w.z & 255u) << 16) | ((w.w & 255u) << 24); }
        }
        for (int rep = 0; rep < rep_sel; ++rep) {
            const bool dry = (rep + 1 < rep_sel);
            const unsigned char* k8b = p.ws + WS_KS + (size_t)bg * SEQ * 64; const unsigned char* v8b = p.ws + WS_VST + (size_t)bg * 256 * 4096;
            const float* skb = (const float*)(p.ws + WS_KS + 12 * MiB) + (size_t)bg * 256; const float* svb = (const float*)(p.ws + WS_VST + 12 * MiB) + (size_t)bg * 256;
            const unsigned char* Q8 = p.ws + WS_Q8; const float* SQ8 = (const float*)(p.ws + WS_Q8 + 32 * MiB);
            const int nv = cur + 1 < 16 ? cur + 1 : 16, npair = (nv + 1) >> 1, total = 16 * npair;
            const int lrow = lane >> 2, lch = lane & 3;
            const int woff = lrow * 72 + lch * 16;
            const int rr = fr & 3;
            u32x4 sk[2][4], sv[2][4]; float ssk[2], ssv[2];
            int jbn[2];
#define SEL_GET(tokI, slotK) ((int)(((unsigned)__builtin_amdgcn_readlane((int)(((slotK) >> 2) == 0 ? selp[0] : ((slotK) >> 2) == 1 ? selp[1] : ((slotK) >> 2) == 2 ? selp[2] : selp[3]), (tokI)) >> (((slotK) & 3) * 8)) & 255u))
#define SEL_ISSUE(tokI, pairP) do { \
                const int k0_ = 2 * (pairP), k1_ = (2 * (pairP) + 1 < nv) ? 2 * (pairP) + 1 : k0_; \
                jbn[0] = SEL_GET(tokI, k0_); jbn[1] = SEL_GET(tokI, k1_); \
                _Pragma("unroll") for (int u = 0; u < 2; ++u) { \
                    const unsigned char* kb_ = k8b + (size_t)jbn[u] * 4096; const unsigned char* vb_ = v8b + (size_t)jbn[u] * 4096; \
                    _Pragma("unroll") for (int j = 0; j < 4; ++j) { sk[u][j] = *(const u32x4*)(kb_ + j * 1024 + lane * 16); sv[u][j] = *(const u32x4*)(vb_ + j * 1024 + lane * 16); } \
                    ssk[u] = skb[jbn[u]]; ssv[u] = svb[jbn[u]]; } } while (0)
            SEL_ISSUE(0, 0);
            long qs8[2] = {0, 0};
            float sq = 0.f, ms = NEGBIG, ls = 0.f;
            f32x4 os[4] = {z4, z4, z4, z4};
            u32x2 oprev[4] = {(u32x2){0u, 0u}, (u32x2){0u, 0u}, (u32x2){0u, 0u}, (u32x2){0u, 0u}};
            int i = 0, pp = 0;
            for (int v = 0; v < total; ++v) {
                const int jb0 = jbn[0], jb1 = jbn[1];
                const bool second_valid = (2 * pp + 1 < nv);
                const float ck0 = ssk[0], ck1 = ssk[1], cv0 = ssv[0], cv1 = ssv[1];
#pragma unroll
                for (int u = 0; u < 2; ++u)
#pragma unroll
                    for (int j = 0; j < 4; ++j) {
                        unsigned char* kd = WL + u * 9216 + woff + j * 1152; unsigned char* vd = kd + 4608;
                        *(u32x2*)kd = (u32x2){sk[u][j].x, sk[u][j].y}; *(u32x2*)(kd + 8) = (u32x2){sk[u][j].z, sk[u][j].w};
                        *(u32x2*)vd = (u32x2){sv[u][j].x, sv[u][j].y}; *(u32x2*)(vd + 8) = (u32x2){sv[u][j].z, sv[u][j].w};
                    }
                if (v + 1 < total) {
                    int p2 = pp + 1, i2 = i; if (p2 == npair) { p2 = 0; i2 = i + 1; }
                    SEL_ISSUE(i2, p2);
                }
                __builtin_amdgcn_sched_barrier(0);
                const int ti = t0 + i;
                if (pp == 0) {
                    const size_t tk = (size_t)b * SEQ + ti;
#pragma unroll
                    for (int ks = 0; ks < 2; ++ks) qs8[ks] = *(const long*)(Q8 + tk * 1024 + (g * 4 + rr) * 64 + ks * 32 + fq * 8);
                    sq = SQ8[tk * 16 + g * 4 + rr] * 1.4426950408889634f;
                    ms = NEGBIG; ls = 0.f;
#pragma unroll
                    for (int df = 0; df < 4; ++df) { os[df] = z4; oprev[df] = *(const u32x2*)(O + tk * 1024 + (g * 4 + rr) * 64 + df * 16 + fq * 4); }
                }
                f32x4 st[2][4];
#pragma unroll
                for (int u = 0; u < 2; ++u)
#pragma unroll
                    for (int f = 0; f < 4; ++f) {
                        const unsigned char* kp = WL + u * 9216 + (32 * (f >> 1) + 8 * (fr >> 2) + 4 * (f & 1) + (fr & 3)) * 72 + fq * 8;
                        const long k0 = *(const long*)kp, k1 = *(const long*)(kp + 32);
                        st[u][f] = __builtin_amdgcn_mfma_f32_16x16x32_fp8_fp8(k0, qs8[0], z4, 0, 0, 0);
                        st[u][f] = __builtin_amdgcn_mfma_f32_16x16x32_fp8_fp8(k1, qs8[1], st[u][f], 0, 0, 0);
                    }
                const float c0_ = sq * ck0, c1_ = sq * ck1;
                if (jb0 == cur || jb1 == cur || !second_valid) {
#pragma unroll
                    for (int u = 0; u < 2; ++u) {
                        const int jbu = u ? jb1 : jb0;
                        const bool allbad = (u == 1) && !second_valid;
#pragma unroll
                        for (int f = 0; f < 4; ++f)
#pragma unroll
                            for (int e = 0; e < 4; ++e) { const int key = jbu * 64 + 32 * (f >> 1) + 8 * fq + 4 * (f & 1) + e; if (allbad || key > ti) st[u][f][e] = NEGBIG; }
                    }
                }
                float mx0 = NEGBIG, mx1 = NEGBIG;
#pragma unroll
                for (int f = 0; f < 4; ++f) { mx0 = fmaxf(mx0, fmaxf(fmaxf(st[0][f].x, st[0][f].y), fmaxf(st[0][f].z, st[0][f].w))); mx1 = fmaxf(mx1, fmaxf(fmaxf(st[1][f].x, st[1][f].y), fmaxf(st[1][f].z, st[1][f].w))); }
                const float mx = max4(fmaxf(mx0 > -1.0e29f ? mx0 * c0_ : NEGBIG, mx1 > -1.0e29f ? mx1 * c1_ : NEGBIG));
                const float mn = fmaxf(ms, mx);
                const float al = __builtin_amdgcn_exp2f(ms - mn);
                const float off = 8.0f - mn;
                float ps = 0.f;
                long pfw[2][2];
#pragma unroll
                for (int u = 0; u < 2; ++u) {
                    const float cu = u ? c1_ : c0_;
#pragma unroll
                    for (int f = 0; f < 4; ++f)
#pragma unroll
                        for (int e = 0; e < 4; ++e) { const float pv = __builtin_amdgcn_exp2f(st[u][f][e] * cu + off); st[u][f][e] = pv; ps += pv; }
#pragma unroll
                    for (int s = 0; s < 2; ++s) {
                        int w0 = 0, w1 = 0;
                        w0 = __builtin_amdgcn_cvt_pk_fp8_f32(st[u][2 * s].x, st[u][2 * s].y, w0, false); w0 = __builtin_amdgcn_cvt_pk_fp8_f32(st[u][2 * s].z, st[u][2 * s].w, w0, true);
                        w1 = __builtin_amdgcn_cvt_pk_fp8_f32(st[u][2 * s + 1].x, st[u][2 * s + 1].y, w1, false); w1 = __builtin_amdgcn_cvt_pk_fp8_f32(st[u][2 * s + 1].z, st[u][2 * s + 1].w, w1, true);
                        pfw[u][s] = (long)(((unsigned long long)(unsigned)w1 << 32) | (unsigned long long)(unsigned)w0);
                    }
                }
                ls = ls * al + ps; ms = mn;
#pragma unroll
                for (int df = 0; df < 4; ++df) os[df] = os[df] * al;
#pragma unroll
                for (int u = 0; u < 2; ++u) {
                    f32x4 pvacc[4] = {z4, z4, z4, z4};
#pragma unroll
                    for (int s = 0; s < 2; ++s) {
#pragma unroll
                        for (int df = 0; df < 4; ++df) {
                            const long vf = *(const long*)(WL + u * 9216 + 4608 + (df * 16 + fr) * 72 + 32 * s + 8 * fq);
                            pvacc[df] = __builtin_amdgcn_mfma_f32_16x16x32_fp8_fp8(vf, pfw[u][s], pvacc[df], 0, 0, 0);
                        }
                    }
                    const float cvu = u ? cv1 : cv0;
#pragma unroll
                    for (int df = 0; df < 4; ++df) os[df] = os[df] + pvacc[df] * cvu;
                    __builtin_amdgcn_sched_barrier(0);
                }
                if (pp == npair - 1) {
                    const float l = red4(ls);
                    const float gsv = NGT[((size_t)b * SEQ + ti) * 48 + (g * 4 + rr) * 3 + 1];
                    const float sc = gsv / l;
                    if (fr < 4 && !dry) {
                        bf16_t* op = O + ((size_t)b * SEQ + ti) * 1024 + (g * 4 + fr) * 64 + fq * 4;
#pragma unroll
                        for (int df = 0; df < 4; ++df) {
                            const f32x4 val = os[df] * sc; const u32x2 c = oprev[df];
                            *(u32x2*)(op + df * 16) = (u32x2){pk2(bflo(c.x) + val.x, bfhi(c.x) + val.y), pk2(bflo(c.y) + val.z, bfhi(c.y) + val.w)};
                        }
                    }
                }
                ++pp; if (pp == npair) { pp = 0; ++i; }
            }
#undef SEL_GET
#undef SEL_ISSUE
        }
    }
}
constexpr int NPHASES = 23;
#ifndef PROBE_PHASE
#define PROBE_PHASE (-1)
#endif
#ifndef ATT_REP_CMP
#define ATT_REP_CMP 1
#endif
#ifndef ATT_REP_WIN
#define ATT_REP_WIN 1
#endif
#ifndef ATT_REP_SEL
#define ATT_REP_SEL 1
#endif
#ifndef TS_PHASE
#define TS_PHASE (-1)
#endif
#ifndef TS_MULT
#define TS_MULT 4
#endif
#ifndef PROBE_REPS
#define PROBE_REPS 1
#endif
__global__ void __launch_bounds__(NTHREADS, 2) mega(Params p) {
    __shared__ __attribute__((aligned(1024))) unsigned char lds[LDS_BYTES + 16];
    unsigned* bar_st = (unsigned*)(lds + LDS_BYTES);
    cg::grid_group grid = cg::this_grid();
    const float* MOD = (const float*)(p.ws + WS_MOD);
    bf16_t* HM = (bf16_t*)(p.ws + WS_HM);
    if (threadIdx.x < 4) bar_st[threadIdx.x] = 0u;
    __syncthreads();
    XcdBarrier bar = xcd_barrier_post((unsigned*)(p.ws + WS_CTL), (volatile LAS unsigned*)bar_st);
    const int lo = p.ph_lo, hi = p.ph_hi;
    const bool dry0 = (p.ph_hi < 0);
    const int opq = (p.ph_hi < 0) ? 1 : 0;
    unsigned long long ts_a = 0ull, ts_b = 0ull;
#define PHASE(k, call, drycall) if (lo <= (k) && (k) < hi) { \
        if (TS_PHASE == (k)) ts_a = __builtin_amdgcn_s_memrealtime(); \
        if (PROBE_PHASE == (k)) { for (int rep = 0; rep < PROBE_REPS; ++rep) { const bool dry = !dry0; drycall; __syncthreads(); } } \
        { const bool dry = dry0; call; } \
        if ((k) + 1 < hi) { if ((k) == 0) grid.sync(); else xcd_barrier(bar); } \
        if (TS_PHASE == (k)) ts_b = __builtin_amdgcn_s_memrealtime(); }
    PHASE(0, phase_prep(p, (float*)lds), phase_prep(p, (float*)lds))
    PHASE(1, phase_norm(p, p.in[0], p.in[2], MOD + 0, MOD + 1024, HM), phase_norm(p, p.in[0], p.in[2], MOD + 0, MOD + 1024, HM))
    PHASE(2, phase_s5_win(p, lds), phase_s5_win(p, lds))
    PHASE(3, phase_s5_a(p, lds), phase_s5_a(p, lds))
    PHASE(4, phase_s5_scan(p), phase_s5_scan(p))
    PHASE(5, phase_s5_b(p, lds), phase_s5_b(p, lds))
    PHASE(6, phase_s5_glu(p, lds), phase_s5_glu(p, lds))
    PHASE(7, phase_norm(p, p.out, p.in[3], MOD + 3072, MOD + 4096, HM), phase_norm(p, p.out, p.in[3], MOD + 3072, MOD + 4096, HM))
    PHASE(8, phase_peer_wq(p, 0, lds), phase_peer_wq(p, 0, lds))
    PHASE(9, phase_peer_topk(p, 0, lds), phase_peer_topk(p, 0, lds))
    PHASE(10, phase_peer_combine(p, lds), phase_peer_combine(p, lds))
    PHASE(11, phase_peer_apply(p, 0, lds, dry), phase_peer_apply(p, 0, lds, dry))
    PHASE(12, phase_tab1(p), phase_tab1(p))
    PHASE(13, phase_nsa_proj(p, lds), phase_nsa_proj(p, lds))
    PHASE(14, phase_nsa_cmp1(p, lds), phase_nsa_cmp1(p, lds))
    PHASE(15, phase_nsa_cmp2(p, lds), phase_nsa_cmp2(p, lds))
    PHASE(16, phase_nsa_attn(p, lds, ATT_REP_CMP + opq, ATT_REP_WIN + opq, ATT_REP_SEL + opq), phase_nsa_attn(p, lds, 1 + opq, 1 + opq, 1 + opq))
    PHASE(17, phase_nsa_wo(p, lds, dry), phase_nsa_wo(p, lds, dry))
    PHASE(18, phase_norm(p, p.out, p.in[3] + D, MOD + 2 * 6144 + 3072, MOD + 2 * 6144 + 4096, HM), phase_norm(p, p.out, p.in[3] + D, MOD + 2 * 6144 + 3072, MOD + 2 * 6144 + 4096, HM))
    PHASE(19, phase_peer_wq(p, 1, lds), phase_peer_wq(p, 1, lds))
    PHASE(20, phase_peer_topk(p, 1, lds), phase_peer_topk(p, 1, lds))
    PHASE(21, phase_peer_combine(p, lds), phase_peer_combine(p, lds))
    PHASE(22, phase_peer_apply(p, 1, lds, dry), phase_peer_apply(p, 1, lds, dry))
#undef PHASE
    if (TS_PHASE >= 0 && blockIdx.x == 0 && threadIdx.x == 0) {
        const unsigned long long t0 = __builtin_amdgcn_s_memrealtime(), want = (ts_b - ts_a) * TS_MULT;
        while (__builtin_amdgcn_s_memrealtime() - t0 < want) __builtin_amdgcn_s_sleep(8);
    }
}

extern "C" void kernel_launch(void* const* d_in, const int* in_sizes, int n_in, void* d_out, int out_size, void* d_ws, size_t ws_size, hipStream_t stream) {
    static int grid_blocks = 0;
    if (!grid_blocks) {
        int dev = 0, cus = 0, per_cu = 0;
        hipGetDevice(&dev);
        hipDeviceGetAttribute(&cus, hipDeviceAttributeMultiprocessorCount, dev);
        hipOccupancyMaxActiveBlocksPerMultiprocessor(&per_cu, mega, NTHREADS, 0);
        if (per_cu > 2) per_cu = 2;
        if (per_cu < 1) per_cu = 1;
        grid_blocks = cus * per_cu;
        if (ws_size < WS_END) fprintf(stderr, "kernel_launch: workspace too small: %zu < %zu\n", ws_size, (size_t)WS_END);
        if (n_in != 29) fprintf(stderr, "kernel_launch: expected 29 inputs, got %d\n", n_in);
    }
    hipMemsetAsync((unsigned char*)d_ws + WS_CTL, 0, 16384, stream);
    Params p{};
    for (int i = 0; i < 29; ++i) p.in[i] = (const float*)d_in[i];
    p.out = (float*)d_out; p.ws = (unsigned char*)d_ws;
#if SINGLE_LAUNCH
    p.ph_lo = 0; p.ph_hi = NPHASES;
    void* args[] = {&p};
    hipError_t e = hipLaunchCooperativeKernel((void*)mega, dim3(grid_blocks), dim3(NTHREADS), args, 0, stream);
    if (e != hipSuccess) fprintf(stderr, "cooperative launch failed: %s (grid %d)\n", hipGetErrorString(e), grid_blocks);
#else
    for (int ph = 0; ph < NPHASES; ++ph) {
        p.ph_lo = ph; p.ph_hi = ph + 1;
        hipLaunchKernelGGL(mega, dim3(grid_blocks), dim3(NTHREADS), 0, stream, p);
    }
#endif
}
```

```cpp
#include <hip/hip_runtime.h>
#include <hip/hip_cooperative_groups.h>
#include <cstdio>
#include <cstdint>
namespace cg = cooperative_groups;

#ifndef SINGLE_LAUNCH
#define SINGLE_LAUNCH 1
#endif

typedef unsigned short bf16_t;
typedef short bf16x8 __attribute__((ext_vector_type(8)));
typedef float f32x4 __attribute__((ext_vector_type(4)));
typedef float f32x2 __attribute__((ext_vector_type(2)));
typedef unsigned u32x4 __attribute__((ext_vector_type(4)));
typedef unsigned u32x2 __attribute__((ext_vector_type(2)));
typedef __bf16 bf16x2_t __attribute__((ext_vector_type(2)));

constexpr int D = 1024, BATCH = 2, SEQ = 16384, T = BATCH * SEQ;
constexpr int NTHREADS = 256;
constexpr float RMS_EPS = 1e-6f;
constexpr int S5G = 64, S5P = 64, S5L = 32, S5NCH = T / S5L  , S5CPB = SEQ / S5L  ;
constexpr int NH = 16, HD = 64, NG = 4, NPROJ = 2608, NPROJ_PAD = 2688, NC = 1023, NSB = 256;
constexpr int PH = 8, PK = 16, PNK = 128, PE = 16384;

constexpr size_t MiB = 1ull << 20;
constexpr size_t WS_CTL = 0;
constexpr size_t WS_MOD = 1 * MiB;
constexpr size_t WS_WIN_T = 2 * MiB;
constexpr size_t WS_WGLU_T = 4 * MiB;
constexpr size_t WS_WPROJ_T = 8 * MiB;
constexpr size_t WS_WK1_T = 14 * MiB;
constexpr size_t WS_WV1_T = 15 * MiB;
constexpr size_t WS_WK2_T = 16 * MiB;
constexpr size_t WS_WV2_T = 16 * MiB + 512 * 1024;
constexpr size_t WS_WO_T = 17 * MiB;
constexpr size_t WS_WQ_T = 19 * MiB;
constexpr size_t WS_SUBK = 27 * MiB;
constexpr size_t WS_ROPE = 28 * MiB;
constexpr size_t WS_MISC = 32 * MiB;
constexpr size_t WS_TW = 33 * MiB;
constexpr size_t WS_VG = 73 * MiB;
constexpr size_t WS_PU = 82 * MiB;
constexpr size_t WS_PV = 114 * MiB;
constexpr size_t WS_HM = 146 * MiB;
constexpr size_t WS_C = 210 * MiB;
constexpr size_t WS_UG = WS_C;
constexpr size_t WS_YI = WS_C + 64 * MiB;
constexpr size_t WS_WST = WS_C + 128 * MiB;
constexpr size_t WS_SST = WS_C + 160 * MiB;
constexpr size_t WS_YG = WS_C + 176 * MiB;
constexpr size_t WS_QK = WS_C;
constexpr size_t WS_TOPS = WS_C + 128 * MiB;
constexpr size_t WS_TOPI = WS_C + 160 * MiB;
constexpr size_t WS_EXP = WS_C + 192 * MiB;
constexpr size_t WS_GATE = WS_C + 208 * MiB;
constexpr size_t WS_ACT = WS_C + 224 * MiB;
constexpr size_t WS_Q = WS_C;
constexpr size_t WS_KC = WS_C + 64 * MiB;
constexpr size_t WS_VC = WS_C + 81 * MiB;
constexpr size_t WS_KS = WS_C + 98 * MiB;
constexpr size_t WS_VST = WS_C + 114 * MiB;
constexpr size_t WS_KW = WS_C + 130 * MiB;
constexpr size_t WS_VWT = WS_C + 146 * MiB;
constexpr size_t WS_NG = WS_C + 162 * MiB;
constexpr size_t WS_KCMP = WS_C + 170 * MiB;
constexpr size_t WS_VCMPT = WS_C + 171 * MiB;
constexpr size_t WS_HID = WS_C + 172 * MiB;
constexpr size_t WS_O = WS_C + 182 * MiB;
constexpr size_t WS_Q8 = WS_C + 246 * MiB;
constexpr size_t WS_END = WS_C + 282 * MiB;

constexpr int LDS_BYTES = 73728;

struct Params {
    const float* in[29];
    float* out;
    unsigned char* ws;
    int ph_lo, ph_hi;
};

__device__ __forceinline__ unsigned f2bf(float f) { unsigned u = __builtin_bit_cast(unsigned, f); return (u + 0x7fffu + ((u >> 16) & 1u)) >> 16; }
__device__ __forceinline__ unsigned pk2(float lo, float hi) { return f2bf(lo) | (f2bf(hi) << 16); }
__device__ __forceinline__ float bf2f(unsigned h) { return __builtin_bit_cast(float, h << 16); }
__device__ __forceinline__ float bflo(unsigned w) { return __builtin_bit_cast(float, w << 16); }
__device__ __forceinline__ float bfhi(unsigned w) { return __builtin_bit_cast(float, w & 0xffff0000u); }
__device__ __forceinline__ float gelu_tanh(float x) {
    const float u = 0.7978845608028654f * (x + 0.044715f * x * x * x);
    const float e = __expf(2.0f * u);
    const float th = 1.0f - 2.0f / (e + 1.0f);
    return 0.5f * x * (1.0f + th);
}
__device__ __forceinline__ float sigmoidf_(float x) { return 1.0f / (1.0f + __expf(-x)); }
__device__ __forceinline__ float wave_sum(float v) {
#pragma unroll
    for (int o = 1; o < 64; o <<= 1) v += __shfl_xor(v, o);
    return v;
}
__device__ __forceinline__ float dot2bf(unsigned a, unsigned b, float acc) {
    return __builtin_amdgcn_fdot2_f32_bf16(__builtin_bit_cast(bf16x2_t, a), __builtin_bit_cast(bf16x2_t, b), acc, false);
}

#define LAS __attribute__((address_space(3)))
#define XB_TMO      128
#define XB_XCNT(j)  (256  + 64 * (j))
#define XB_XSUB(j)  (1280 + 64 * (j))
#define XB_XGEN(j)  (2304 + 64 * (j))
#define XB_TOP      3328
#define XB_TOPGEN   3392
#define XCD_BAR_WORDS 3456
#define XB_SPIN_CAP (1u << 24)

__device__ __forceinline__ unsigned xb_ld(unsigned* p)              { return __hip_atomic_load(p, __ATOMIC_RELAXED, __HIP_MEMORY_SCOPE_AGENT); }
__device__ __forceinline__ unsigned xb_add(unsigned* p, unsigned v) { return __hip_atomic_fetch_add(p, v, __ATOMIC_RELAXED, __HIP_MEMORY_SCOPE_AGENT); }
__device__ __forceinline__ unsigned xb_xcc_id() { return (unsigned)__builtin_amdgcn_s_getreg((3 << 11) | 20) & 0xFu; }
#define XB_SPIN(cond, bar) do { unsigned _sp = 0; while (cond) { __builtin_amdgcn_s_sleep(1); \
    if ((++_sp & 255u) == 0u) { if (xb_ld(&(bar)[XB_TMO])) break; if (_sp > XB_SPIN_CAP) { atomicAdd(&(bar)[XB_TMO], 1u); break; } } } } while (0)

struct XcdBarrier {
    unsigned* bar; unsigned x;
    volatile LAS unsigned* st;
};

__device__ __forceinline__ XcdBarrier xcd_barrier_post(unsigned* bar, volatile LAS unsigned* st) {
    XcdBarrier b; b.bar = bar; b.x = xb_xcc_id(); b.st = st;
    if (threadIdx.x == 0) (void)xb_add(&bar[XB_XCNT(b.x)], 1u);
    return b;
}
__device__ __forceinline__ void xcd_barrier_complete(unsigned* bar, unsigned x, unsigned& nloc, unsigned& nx) {
    const unsigned G = gridDim.x * gridDim.y * gridDim.z;
    unsigned sum, cnt, mine, sp = 0u;
    for (;;) {
        sum = 0u; cnt = 0u; mine = 0u;
#pragma unroll
        for (unsigned j = 0; j < 16; ++j) { const unsigned c = xb_ld(&bar[XB_XCNT(j)]); sum += c; cnt += (c > 0u) ? 1u : 0u; mine = (j == x) ? c : mine; }
        if (sum == G) break;
        __builtin_amdgcn_s_sleep(1);
        if ((++sp & 255u) == 0u) { if (xb_ld(&bar[XB_TMO])) break; if (sp > XB_SPIN_CAP) { atomicAdd(&bar[XB_TMO], 1u); break; } }
    }
    nloc = mine > 0u ? mine : 1u; nx = cnt > 0u ? cnt : 1u;
}

__device__ __forceinline__ void xcd_barrier(const XcdBarrier& b) {
    asm volatile("s_waitcnt vmcnt(0)" ::: "memory");
    __syncthreads();
    if (threadIdx.x == 0) {
        unsigned* bar = b.bar;
        __builtin_amdgcn_s_waitcnt(0);
        unsigned nloc = b.st[0], nx = b.st[1];
        if (nloc == 0u) { xcd_barrier_complete(bar, b.x, nloc, nx); b.st[0] = nloc; b.st[1] = nx; }
        const unsigned old = xb_add(&bar[XB_XSUB(b.x)], 1u);
        const unsigned gen = old / nloc;
        if (old + 1u == (gen + 1u) * nloc) {
            __builtin_amdgcn_fence(__ATOMIC_RELEASE, "agent");
            asm volatile("s_waitcnt vmcnt(0)" ::: "memory");
            const unsigned og = xb_add(&bar[XB_TOP], 1u);
            const unsigned tg = og / nx;
            if (og + 1u == (tg + 1u) * nx) xb_add(&bar[XB_TOPGEN], 1u);
            else XB_SPIN(xb_ld(&bar[XB_TOPGEN]) == tg, bar);
            __builtin_amdgcn_fence(__ATOMIC_ACQUIRE, "agent");
            xb_add(&bar[XB_XGEN(b.x)], 1u);
            asm volatile("s_waitcnt vmcnt(0)" ::: "memory");
        } else {
            XB_SPIN(xb_ld(&bar[XB_XGEN(b.x)]) == gen, bar);
            __builtin_amdgcn_fence(__ATOMIC_ACQUIRE, "agent");
            asm volatile("s_waitcnt vmcnt(0)" ::: "memory");
        }
    }
    __syncthreads();
}
__device__ __forceinline__ void prep_mod_item(const Params& p, int item, float* lds) {
    const int layer = item / 192, cg0 = (item % 192) * 32;
    const int tid = threadIdx.x, col = cg0 + (tid & 31), kg = tid >> 5;
    const float* W = p.in[4] + (size_t)layer * D * 6 * D + col;
    const float* c = p.in[1];
    float* cact = lds + 512;
#pragma unroll
    for (int i = 0; i < 8; ++i) { const int q = tid + 256 * i; const float v = c[q]; cact[q] = v * sigmoidf_(v); }
    __syncthreads();
    float a0 = 0.f, a1 = 0.f;
    for (int k0 = kg * 128; k0 < kg * 128 + 128; k0 += 16) {
        float w[16];
#pragma unroll
        for (int u = 0; u < 16; ++u) w[u] = W[(size_t)(k0 + u) * (6 * D)];
#pragma unroll
        for (int u = 0; u < 16; ++u) { a0 += w[u] * cact[k0 + u]; a1 += w[u] * cact[1024 + k0 + u]; }
    }
    lds[tid] = a0; lds[256 + tid] = a1;
    __syncthreads();
    if (tid < 64) {
        const int b = tid >> 5, cc = tid & 31;
        float s = 0.f;
#pragma unroll
        for (int g = 0; g < 8; ++g) s += lds[b * 256 + g * 32 + cc];
        float* MOD = (float*)(p.ws + WS_MOD);
        MOD[(size_t)(layer * 2 + b) * 6144 + cg0 + cc] = s + p.in[5][(size_t)layer * 6144 + cg0 + cc];
    }
    __syncthreads();
}

template <int MODE>
__device__ __forceinline__ void prep_transpose_item(const float* W, int K, int N, bf16_t* WT, int item, float* lds) {
    const int nbn = (N + 63) / 64, kb = item / nbn, nb = item % nbn, k0 = kb * 64, n0 = nb * 64;
    const int tid = threadIdx.x;
#pragma unroll
    for (int i = 0; i < 16; ++i) {
        const int kk = (tid >> 6) + 4 * i, nn = tid & 63;
        const float v = (n0 + nn < N) ? W[(size_t)(k0 + kk) * N + n0 + nn] : 0.f;
        lds[kk * 65 + nn] = v;
    }
    __syncthreads();
    {
        const int nn = tid >> 2, ks = (tid & 3) * 16;
        const int n = n0 + nn;
        if (n < N) {
            int np = n;
            if (MODE == 1) { const int j = (n < 1024) ? n : n - 1024; np = (j >> 4) * 32 + (j & 15) + ((n < 1024) ? 0 : 16); }
            u32x4 o0, o1;
            const float* s = lds + nn;
            o0.x = pk2(s[(ks + 0) * 65], s[(ks + 1) * 65]); o0.y = pk2(s[(ks + 2) * 65], s[(ks + 3) * 65]);
            o0.z = pk2(s[(ks + 4) * 65], s[(ks + 5) * 65]); o0.w = pk2(s[(ks + 6) * 65], s[(ks + 7) * 65]);
            o1.x = pk2(s[(ks + 8) * 65], s[(ks + 9) * 65]); o1.y = pk2(s[(ks + 10) * 65], s[(ks + 11) * 65]);
            o1.z = pk2(s[(ks + 12) * 65], s[(ks + 13) * 65]); o1.w = pk2(s[(ks + 14) * 65], s[(ks + 15) * 65]);
            u32x4* dst = (u32x4*)(WT + (size_t)np * K + k0 + ks);
            dst[0] = o0; dst[1] = o1;
        }
    }
    __syncthreads();
}

__device__ __forceinline__ void cvt_item(const float* src, bf16_t* dst, int item) {
    const size_t base = (size_t)item * 8192 + threadIdx.x * 8;
#pragma unroll
    for (int i = 0; i < 4; ++i) {
        const size_t o = base + (size_t)i * 2048;
        const f32x4 a = *(const f32x4*)(src + o), b = *(const f32x4*)(src + o + 4);
        u32x4 w; w.x = pk2(a.x, a.y); w.y = pk2(a.z, a.w); w.z = pk2(b.x, b.y); w.w = pk2(b.z, b.w);
        *(u32x4*)(dst + o) = w;
    }
}
__device__ __forceinline__ void zero_item(bf16_t* dst, int item) {
    const size_t base = (size_t)item * 8192 + threadIdx.x * 8;
#pragma unroll
    for (int i = 0; i < 4; ++i) *(u32x4*)(dst + base + (size_t)i * 2048) = (u32x4){0u, 0u, 0u, 0u};
}

struct cpx { float re, im; };
__device__ __forceinline__ cpx cmul(cpx a, cpx b) { return {a.re * b.re - a.im * b.im, a.re * b.im + a.im * b.re}; }
__device__ __forceinline__ cpx cexp_pow(float are, float aim, float dt, int m) {
    const float mag = __expf(are * dt * (float)m);
    const double rev = (double)aim * (double)dt * (double)m * 0.15915494309189535;
    const float fr = (float)(rev - rint(rev));
    return {mag * __builtin_amdgcn_cosf(fr), mag * __builtin_amdgcn_sinf(fr)};
}
__device__ __forceinline__ cpx s5_coef(float are, float aim, float dt) {
    cpx ab = cexp_pow(are, aim, dt, 1);
    const float nr = ab.re - 1.0f, ni = ab.im, den = are * are + aim * aim;
    return {(nr * are + ni * aim) / den, (ni * are - nr * aim) / den};
}

__device__ __forceinline__ void prep_s5_T_item(const Params& p, int item) {
    const int gid = item * 256 + threadIdx.x;
    const int g = gid >> 9, m = (gid >> 4) & 31, i = gid & 15;
    const float* a_re = p.in[7] + g * 64; const float* a_im = p.in[8] + g * 64;
    const float dt = __expf(p.in[9][g]);
    const float* b_re = p.in[10] + (size_t)g * 64 * 16; const float* b_im = p.in[11] + (size_t)g * 64 * 16;
    const float* c_re = p.in[12] + (size_t)g * 16 * 64 + i * 64; const float* c_im = p.in[13] + (size_t)g * 16 * 64 + i * 64;
    float acc[16];
#pragma unroll
    for (int j = 0; j < 16; ++j) acc[j] = 0.f;
    for (int q = 0; q < 64; ++q) {
        const float are = a_re[q], aim = a_im[q];
        cpx z = cmul(cmul({c_re[q], c_im[q]}, cexp_pow(are, aim, dt, m)), s5_coef(are, aim, dt));
        const f32x4* br = (const f32x4*)(b_re + q * 16); const f32x4* bi = (const f32x4*)(b_im + q * 16);
#pragma unroll
        for (int j4 = 0; j4 < 4; ++j4) {
            const f32x4 r = br[j4], im = bi[j4];
            acc[j4 * 4 + 0] += z.re * r.x - z.im * im.x; acc[j4 * 4 + 1] += z.re * r.y - z.im * im.y;
            acc[j4 * 4 + 2] += z.re * r.z - z.im * im.z; acc[j4 * 4 + 3] += z.re * r.w - z.im * im.w;
        }
    }
    u32x4 o0, o1;
    o0.x = pk2(acc[0], acc[1]); o0.y = pk2(acc[2], acc[3]); o0.z = pk2(acc[4], acc[5]); o0.w = pk2(acc[6], acc[7]);
    o1.x = pk2(acc[8], acc[9]); o1.y = pk2(acc[10], acc[11]); o1.z = pk2(acc[12], acc[13]); o1.w = pk2(acc[14], acc[15]);
    bf16_t* TW = (bf16_t*)(p.ws + WS_TW) + (size_t)g * 640 * 512;
    const u32x4 z4 = (u32x4){0u, 0u, 0u, 0u};
    for (int lp = 0; lp + m < 32; ++lp) {
        u32x4* d = (u32x4*)(TW + (size_t)((lp + m) * 16 + i) * 512 + lp * 16);
        d[0] = o0; d[1] = o1;
        if (m > 0) { u32x4* dz = (u32x4*)(TW + (size_t)(lp * 16 + i) * 512 + (lp + m) * 16); dz[0] = z4; dz[1] = z4; }
    }
}
__device__ __forceinline__ void prep_s5_W_item(const Params& p, int item) {
    const int gid = item * 256 + threadIdx.x;
    const int g = gid >> 11, q = (gid >> 5) & 63, lp = gid & 31;
    const float are = p.in[7][g * 64 + q], aim = p.in[8][g * 64 + q];
    const float dt = __expf(p.in[9][g]);
    const cpx z = cmul(cexp_pow(are, aim, dt, 31 - lp), s5_coef(are, aim, dt));
    const float* br = p.in[10] + ((size_t)g * 64 + q) * 16; const float* bi = p.in[11] + ((size_t)g * 64 + q) * 16;
    float wr[16], wi[16];
#pragma unroll
    for (int j = 0; j < 16; ++j) { wr[j] = z.re * br[j] - z.im * bi[j]; wi[j] = z.re * bi[j] + z.im * br[j]; }
    bf16_t* TW = (bf16_t*)(p.ws + WS_TW) + (size_t)g * 640 * 512;
    u32x4* d0 = (u32x4*)(TW + (size_t)(512 + q) * 512 + lp * 16);
    u32x4* d1 = (u32x4*)(TW + (size_t)(576 + q) * 512 + lp * 16);
    d0[0] = (u32x4){pk2(wr[0], wr[1]), pk2(wr[2], wr[3]), pk2(wr[4], wr[5]), pk2(wr[6], wr[7])};
    d0[1] = (u32x4){pk2(wr[8], wr[9]), pk2(wr[10], wr[11]), pk2(wr[12], wr[13]), pk2(wr[14], wr[15])};
    d1[0] = (u32x4){pk2(wi[0], wi[1]), pk2(wi[2], wi[3]), pk2(wi[4], wi[5]), pk2(wi[6], wi[7])};
    d1[1] = (u32x4){pk2(wi[8], wi[9]), pk2(wi[10], wi[11]), pk2(wi[12], wi[13]), pk2(wi[14], wi[15])};
}
__device__ __forceinline__ void prep_s5_V_item(const Params& p, int item) {
    const int gid = item * 256 + threadIdx.x;
    const int g = gid >> 14, l = (gid >> 9) & 31, i = (gid >> 5) & 15, q0 = (gid & 31) * 2;
    const float dt = __expf(p.in[9][g]);
    float vr[2], vi[2];
#pragma unroll
    for (int e = 0; e < 2; ++e) {
        const int q = q0 + e;
        const cpx z = cmul({p.in[12][((size_t)g * 16 + i) * 64 + q], p.in[13][((size_t)g * 16 + i) * 64 + q]}, cexp_pow(p.in[7][g * 64 + q], p.in[8][g * 64 + q], dt, l + 1));
        vr[e] = z.re; vi[e] = -z.im;
    }
    bf16_t* VG = (bf16_t*)(p.ws + WS_VG) + ((size_t)g * 512 + l * 16 + i) * 128;
    *(unsigned*)(VG + q0) = pk2(vr[0], vr[1]);
    *(unsigned*)(VG + 64 + q0) = pk2(vi[0], vi[1]);
}
__device__ __forceinline__ void prep_al_item(const Params& p, int item) {
    const int gid = item * 256 + threadIdx.x;
    const int g = gid >> 6;
    const float dt = __expf(p.in[9][g]);
    const cpx z = cexp_pow(p.in[7][gid], p.in[8][gid], dt, S5L);
    f32x2* AL = (f32x2*)(p.ws + WS_MISC + 4096);
    AL[gid] = (f32x2){z.re, z.im};
}
__device__ __forceinline__ void prep_rope_item(const Params& p, int item) {
    const int gid = item * 256 + threadIdx.x;
    const int pos = gid >> 5, j = gid & 31;
    const float freq = exp2f(-(float)j * (13.287712379549449f / 32.0f));
    const float ang = (float)pos * freq;
    const double rev = (double)ang * 0.15915494309189535;
    const float fr = (float)(rev - rint(rev));
    f32x2* R = (f32x2*)(p.ws + WS_ROPE);
    R[gid] = (f32x2){__builtin_amdgcn_cosf(fr), __builtin_amdgcn_sinf(fr)};
}
__device__ __forceinline__ void prep_cmpbias_item(const Params& p, int item, float* lds) {
    const int kv = item >> 3, cg0 = (item & 7) * 32;
    const float* pe = p.in[17 + kv]; const float* w1 = p.in[kv == 0 ? 19 : 21];
    const int tid = threadIdx.x, col = cg0 + (tid & 31), kg = tid >> 5;
    float s = 0.f;
#pragma unroll 8
    for (int k = kg * 256; k < kg * 256 + 256; ++k) s += pe[k] * w1[(size_t)k * 256 + col];
    lds[tid] = s;
    __syncthreads();
    if (tid < 32) {
        float t = 0.f;
#pragma unroll
        for (int q = 0; q < 8; ++q) t += lds[q * 32 + tid];
        ((float*)(p.ws + WS_MISC))[kv * 256 + cg0 + tid] = t;
    }
    __syncthreads();
}

__device__ __forceinline__ void cvt_fp8_item(const float* src, unsigned char* dst, float* inv_scale, int item, const bool slice_major) {
    const int lane = threadIdx.x & 63, row0 = item * 16 + (threadIdx.x >> 6) * 4;
    f32x4 v[4][4];
#pragma unroll
    for (int r = 0; r < 4; ++r) {
        const f32x4* sp = (const f32x4*)(src + (size_t)(row0 + r) * D + lane * 16);
#pragma unroll
        for (int q = 0; q < 4; ++q) v[r][q] = sp[q];
    }
#pragma unroll
    for (int r = 0; r < 4; ++r) {
        float m = 0.f;
#pragma unroll
        for (int q = 0; q < 4; ++q) m = fmaxf(m, fmaxf(fmaxf(fabsf(v[r][q].x), fabsf(v[r][q].y)), fmaxf(fabsf(v[r][q].z), fabsf(v[r][q].w))));
#pragma unroll
        for (int o = 1; o < 64; o <<= 1) m = fmaxf(m, __shfl_xor(m, o));
        const float sc = m > 0.f ? 224.0f / m : 1.0f;
        unsigned w[4];
#pragma unroll
        for (int q = 0; q < 4; ++q) { int t = 0; t = __builtin_amdgcn_cvt_pk_fp8_f32(v[r][q].x * sc, v[r][q].y * sc, t, false); t = __builtin_amdgcn_cvt_pk_fp8_f32(v[r][q].z * sc, v[r][q].w * sc, t, true); w[q] = (unsigned)t; }
        const int row = row0 + r;
        const u32x4 wv = (u32x4){w[0], w[1], w[2], w[3]};
        if (slice_major) *(u32x4*)(dst + (size_t)(lane >> 3) * (PE * 128) + (size_t)row * 128 + (lane & 7) * 16) = wv;
        else *(u32x4*)(dst + (size_t)row * D + lane * 16) = wv;
        if (lane == 0) inv_scale[row] = m > 0.f ? m / 224.0f : 1.0f;
    }
}
constexpr int P0_MOD = 384;
constexpr int P0_T_WIN = 16 * 16, P0_T_WGLU = 16 * 32, P0_T_WPROJ = 16 * 41, P0_T_WK1 = 32 * 4, P0_T_WK2 = 4 * 1, P0_T_WO = 16 * 16, P0_T_WQ = 16 * 32;
constexpr int P0_SUBK = (2 * 8 * 2 * 128 * 128) / 8192;
constexpr int P0_TAB = PE / 16;
constexpr int P0_S5T = 128, P0_S5W = 512, P0_S5V = 4096, P0_AL = 16, P0_ROPE = 2048, P0_CB = 16, P0_ZERO = 10 + 2;

__device__ __forceinline__ void phase_prep(const Params& p, float* lds, const int part) {
    const int n0 = P0_MOD;
    const int n1 = n0 + P0_T_WIN, n2 = n1 + P0_T_WGLU, n3 = n2 + P0_T_WPROJ, n4 = n3 + P0_T_WK1, n5 = n4 + P0_T_WK1, n6 = n5 + P0_T_WK2, n7 = n6 + P0_T_WK2,
              n8 = n7 + P0_T_WO, n9 = n8 + P0_T_WQ, n10 = n9 + P0_T_WQ, n11 = n10 + P0_SUBK, n12 = n11 + P0_TAB, n13 = n12 + P0_TAB,
              n14 = n13 + P0_S5T, n15 = n14 + P0_S5W, n16 = n15 + P0_S5V, n17 = n16 + P0_AL, n18 = n17 + P0_ROPE, n19 = n18 + P0_CB, n20 = n19 + 10, n21 = n20 + 2, n22 = n21 + 2;
    unsigned char* ws = p.ws;
#ifndef PREP_DUP_LO
#define PREP_DUP_LO 0
#define PREP_DUP_HI 0
#endif
    const int dupn = (PREP_DUP_HI) - (PREP_DUP_LO);
    const int nB = (n8 - n2) + (n10 - n9) + (n22 - n17);
    const int first = part == 0 ? (int)blockIdx.x : (int)blockIdx.x - 32, stride = part == 0 ? (int)gridDim.x : (int)gridDim.x - 32;
    if (first < 0 || stride <= 0) return;
    const int total = part == 0 ? (n22 - nB) + dupn : nB;
    for (int it0 = first; it0 < total; it0 += stride) {
        int it;
        if (part == 0) {
            it = it0;
            if (it >= n2) it += (n8 - n2);
            if (it >= n9) it += (n10 - n9);
            if (it0 >= (n22 - nB)) it = (PREP_DUP_LO) + (it0 - (n22 - nB));
        } else {
            it = n2 + it0;
            if (it >= n8) it += (n9 - n8);
            if (it >= n10) it += (n17 - n10);
        }
        if (it < n0) prep_mod_item(p, it, lds);
        else if (it < n1) prep_transpose_item<0>(p.in[6], 1024, 1024, (bf16_t*)(ws + WS_WIN_T), it - n0, lds);
        else if (it < n2) prep_transpose_item<1>(p.in[15], 1024, 2048, (bf16_t*)(ws + WS_WGLU_T), it - n1, lds);
        else if (it < n3) prep_transpose_item<0>(p.in[16], 1024, NPROJ, (bf16_t*)(ws + WS_WPROJ_T), it - n2, lds);
        else if (it < n4) prep_transpose_item<0>(p.in[19], 2048, 256, (bf16_t*)(ws + WS_WK1_T), it - n3, lds);
        else if (it < n5) prep_transpose_item<0>(p.in[21], 2048, 256, (bf16_t*)(ws + WS_WV1_T), it - n4, lds);
        else if (it < n6) prep_transpose_item<0>(p.in[20], 256, 64, (bf16_t*)(ws + WS_WK2_T), it - n5, lds);
        else if (it < n7) prep_transpose_item<0>(p.in[22], 256, 64, (bf16_t*)(ws + WS_WV2_T), it - n6, lds);
        else if (it < n8) prep_transpose_item<0>(p.in[23], 1024, 1024, (bf16_t*)(ws + WS_WO_T), it - n7, lds);
        else if (it < n9) prep_transpose_item<0>(p.in[24], 1024, 2048, (bf16_t*)(ws + WS_WQ_T), it - n8, lds);
        else if (it < n10) prep_transpose_item<0>(p.in[24] + (size_t)1024 * 2048, 1024, 2048, (bf16_t*)(ws + WS_WQ_T) + (size_t)2048 * 1024, it - n9, lds);
        else if (it < n11) cvt_item(p.in[25], (bf16_t*)(ws + WS_SUBK), it - n10);
        else if (it < n12) cvt_fp8_item(p.in[26], ws + WS_PU, (float*)(ws + WS_PU + 24 * MiB), it - n11, false);
        else if (it < n13) cvt_fp8_item(p.in[27], ws + WS_PV, (float*)(ws + WS_PV + 24 * MiB), it - n12, false);
        else if (it < n14) prep_s5_T_item(p, it - n13);
        else if (it < n15) prep_s5_W_item(p, it - n14);
        else if (it < n16) prep_s5_V_item(p, it - n15);
        else if (it < n17) prep_al_item(p, it - n16);
        else if (it < n18) prep_rope_item(p, it - n17);
        else if (it < n19) prep_cmpbias_item(p, it - n18, lds);
        else if (it < n20) zero_item((bf16_t*)(ws + WS_WPROJ_T) + (size_t)NPROJ * 1024, it - n19);
        else if (it < n21) zero_item((bf16_t*)(ws + WS_WK2_T) + (size_t)64 * 256, it - n20);
        else zero_item((bf16_t*)(ws + WS_WV2_T) + (size_t)64 * 256, it - n21);
    }
}

__device__ __forceinline__ void phase_norm(const Params& p, const float* X, const float* gw, const float* shift, const float* scale  , bf16_t* HM) {
    const int lane = threadIdx.x & 63, wave = threadIdx.x >> 6;
    for (int row = blockIdx.x * 4 + wave; row < T; row += gridDim.x * 4) {
        const int b = row / SEQ;
        const f32x4* xr = (const f32x4*)(X + (size_t)row * D) + lane;
        f32x4 v[4]; float s = 0.f;
#pragma unroll
        for (int j = 0; j < 4; ++j) { v[j] = xr[64 * j]; s += (v[j].x * v[j].x + v[j].y * v[j].y) + (v[j].z * v[j].z + v[j].w * v[j].w); }
        const float rs = rsqrtf(wave_sum(s) * (1.0f / D) + RMS_EPS);
        u32x2* o = (u32x2*)(HM + (size_t)row * D) + lane;
#pragma unroll
        for (int j = 0; j < 4; ++j) {
            const int c = lane * 4 + 256 * j;
            const f32x4 g = *(const f32x4*)(gw + c), sh = *(const f32x4*)(shift + (size_t)b * 6144 + c), sc = *(const f32x4*)(scale + (size_t)b * 6144 + c);
            const float y0 = v[j].x * rs * g.x * (1.f + sc.x) + sh.x, y1 = v[j].y * rs * g.y * (1.f + sc.y) + sh.y;
            const float y2 = v[j].z * rs * g.z * (1.f + sc.z) + sh.z, y3 = v[j].w * rs * g.w * (1.f + sc.w) + sh.w;
            o[64 * j] = (u32x2){pk2(y0, y1), pk2(y2, y3)};
        }
    }
}
__device__ __forceinline__ void phase_final_norm(const Params& p, const float* X, float* OUT, bool dry) {
    const int lane = threadIdx.x & 63, wave = threadIdx.x >> 6;
    const float* gw = p.in[28];
    for (int row = blockIdx.x * 4 + wave; row < T; row += gridDim.x * 4) {
        const f32x4* xr = (const f32x4*)(X + (size_t)row * D) + lane;
        f32x4 v[4]; float s = 0.f;
#pragma unroll
        for (int j = 0; j < 4; ++j) { v[j] = xr[64 * j]; s += (v[j].x * v[j].x + v[j].y * v[j].y) + (v[j].z * v[j].z + v[j].w * v[j].w); }
        const float rs = rsqrtf(wave_sum(s) * (1.0f / D) + RMS_EPS);
        f32x4* o = (f32x4*)(OUT + (size_t)row * D) + lane;
#pragma unroll
        for (int j = 0; j < 4; ++j) {
            const f32x4 g = *(const f32x4*)(gw + lane * 4 + 256 * j);
            if (!dry) o[64 * j] = (f32x4){v[j].x * rs * g.x, v[j].y * rs * g.y, v[j].z * rs * g.z, v[j].w * rs * g.w};
        }
    }
}

__device__ __forceinline__ int vblock() { const int G = gridDim.x, bx = blockIdx.x; return (G % 8 == 0) ? (bx % 8) * (G / 8) + bx / 8 : bx; }
struct ALoadPlain {
    const bf16_t* A; size_t lda;
    __device__ __forceinline__ const bf16_t* base(int kt) const { return A + kt * 64; }
    __device__ __forceinline__ unsigned off(int r, int lc) const { return (unsigned)r * (unsigned)lda + (unsigned)lc * 8u; }
};
struct ALoadGroup {
    const bf16_t* A;
    __device__ __forceinline__ const bf16_t* base(int kt) const { return A + (size_t)kt * 4 * T * 16; }
    __device__ __forceinline__ unsigned off(int r, int lc) const { return ((unsigned)(lc >> 1) * (unsigned)T + (unsigned)r) * 16u + (unsigned)(lc & 1) * 8u; }
};

template <class AL>
__device__ __forceinline__ void gemm_tile2(const AL al, const bf16_t* __restrict__ Bt, size_t ldb, int nk, f32x4 (&acc)[4][4], unsigned char* lds) {
    const int tid = threadIdx.x, lane = tid & 63, wid = tid >> 6, wr = wid >> 1, wc = wid & 1, fr = lane & 15, fq = lane >> 4;
    const int lr = tid >> 3, lc = tid & 7;
#pragma unroll
    for (int mi = 0; mi < 4; ++mi)
#pragma unroll
        for (int ni = 0; ni < 4; ++ni) acc[mi][ni] = (f32x4){0.f, 0.f, 0.f, 0.f};
    u32x4 ra0[4], rb0[4], ra1[4], rb1[4];
    const int soff = lr * 128 + ((lc ^ (lr & 7)) << 4);
    unsigned offA[4], offB[4];
#pragma unroll
    for (int i = 0; i < 4; ++i) { offA[i] = al.off(lr + 32 * i, lc); offB[i] = (unsigned)(lr + 32 * i) * (unsigned)ldb + (unsigned)lc * 8u; }
#define GT_LOAD(RA, RB, kt_) do { const bf16_t* ab_ = al.base(kt_); const bf16_t* bb_ = Bt + (kt_) * 64; _Pragma("unroll") for (int i = 0; i < 4; ++i) { RA[i] = *(const u32x4*)(ab_ + offA[i]); RB[i] = *(const u32x4*)(bb_ + offB[i]); } } while (0)
#define GT_STORE(RA, RB, buf_) do { unsigned char* nb_ = lds + (buf_) * 32768; _Pragma("unroll") for (int i = 0; i < 4; ++i) { *(u32x4*)(nb_ + soff + i * 4096) = RA[i]; *(u32x4*)(nb_ + 16384 + soff + i * 4096) = RB[i]; } } while (0)
    const int aoff = (wr * 64 + fr) * 128, boff = 16384 + (wc * 64 + fr) * 128, sw = fr & 7;
#define GT_MATH(buf_) do { const unsigned char* bp_ = lds + (buf_) * 32768; _Pragma("unroll") for (int ks = 0; ks < 2; ++ks) { bf16x8 af[4], bfr[4]; const int co = ((ks * 4 + fq) ^ sw) << 4; \
        _Pragma("unroll") for (int mi = 0; mi < 4; ++mi) af[mi] = *(const bf16x8*)(bp_ + aoff + mi * 2048 + co); \
        _Pragma("unroll") for (int ni = 0; ni < 4; ++ni) bfr[ni] = *(const bf16x8*)(bp_ + boff + ni * 2048 + co); \
        _Pragma("unroll") for (int mi = 0; mi < 4; ++mi) _Pragma("unroll") for (int ni = 0; ni < 4; ++ni) acc[mi][ni] = __builtin_amdgcn_mfma_f32_16x16x32_bf16(bfr[ni], af[mi], acc[mi][ni], 0, 0, 0); } } while (0)
    GT_LOAD(ra0, rb0, 0);
    if (nk > 1) GT_LOAD(ra1, rb1, 1);
    GT_STORE(ra0, rb0, 0);
    __syncthreads();
    for (int kt = 0; kt < nk; kt += 2) {
        if (kt + 2 < nk) GT_LOAD(ra0, rb0, kt + 2);
        __builtin_amdgcn_sched_barrier(0);
        GT_MATH(0);
        __builtin_amdgcn_sched_barrier(0);
        if (kt + 1 < nk) GT_STORE(ra1, rb1, 1);
        __syncthreads();
        if (kt + 1 >= nk) break;
        if (kt + 3 < nk) GT_LOAD(ra1, rb1, kt + 3);
        __builtin_amdgcn_sched_barrier(0);
        GT_MATH(1);
        __builtin_amdgcn_sched_barrier(0);
        if (kt + 2 < nk) GT_STORE(ra0, rb0, 0);
        __syncthreads();
    }
#undef GT_LOAD
#undef GT_STORE
#undef GT_MATH
}

template <class AL>
__device__ __forceinline__ void gemm_tile1(const AL al, const bf16_t* __restrict__ Bt, size_t ldb, int nk, f32x4 (&acc)[4][4], unsigned char* lds) {
    const int tid = threadIdx.x, lane = tid & 63, wid = tid >> 6, wr = wid >> 1, wc = wid & 1, fr = lane & 15, fq = lane >> 4;
    const int lr = tid >> 3, lc = tid & 7;
#pragma unroll
    for (int mi = 0; mi < 4; ++mi)
#pragma unroll
        for (int ni = 0; ni < 4; ++ni) acc[mi][ni] = (f32x4){0.f, 0.f, 0.f, 0.f};
    u32x4 ra[4], rb[4];
    const int soff = lr * 128 + ((lc ^ (lr & 7)) << 4);
#pragma unroll
    for (int i = 0; i < 4; ++i) { ra[i] = *(const u32x4*)(al.base(0) + al.off(lr + 32 * i, lc)); rb[i] = *(const u32x4*)(Bt + (size_t)(lr + 32 * i) * ldb + lc * 8); }
#pragma unroll
    for (int i = 0; i < 4; ++i) { *(u32x4*)(lds + soff + i * 4096) = ra[i]; *(u32x4*)(lds + 16384 + soff + i * 4096) = rb[i]; }
    __syncthreads();
    const int aoff = (wr * 64 + fr) * 128, boff = 16384 + (wc * 64 + fr) * 128, sw = fr & 7;
    for (int kt = 0; kt < nk; ++kt) {
        const bool more = (kt + 1 < nk);
        if (more) {
#pragma unroll
            for (int i = 0; i < 4; ++i) { ra[i] = *(const u32x4*)(al.base(kt + 1) + al.off(lr + 32 * i, lc)); rb[i] = *(const u32x4*)(Bt + (size_t)(lr + 32 * i) * ldb + (kt + 1) * 64 + lc * 8); }
        }
        const unsigned char* buf = lds + (kt & 1) * 32768;
#pragma unroll
        for (int ks = 0; ks < 2; ++ks) {
            bf16x8 af[4], bfr[4];
            const int co = ((ks * 4 + fq) ^ sw) << 4;
#pragma unroll
            for (int mi = 0; mi < 4; ++mi) af[mi] = *(const bf16x8*)(buf + aoff + mi * 2048 + co);
#pragma unroll
            for (int ni = 0; ni < 4; ++ni) bfr[ni] = *(const bf16x8*)(buf + boff + ni * 2048 + co);
#pragma unroll
            for (int mi = 0; mi < 4; ++mi)
#pragma unroll
                for (int ni = 0; ni < 4; ++ni) acc[mi][ni] = __builtin_amdgcn_mfma_f32_16x16x32_bf16(bfr[ni], af[mi], acc[mi][ni], 0, 0, 0);
        }
        if (more) {
            unsigned char* nb = lds + ((kt + 1) & 1) * 32768;
#pragma unroll
            for (int i = 0; i < 4; ++i) { *(u32x4*)(nb + soff + i * 4096) = ra[i]; *(u32x4*)(nb + 16384 + soff + i * 4096) = rb[i]; }
        }
        __syncthreads();
    }
}

template <class AL>
__device__ __forceinline__ void gemm_tile3(const AL al, const bf16_t* __restrict__ Bt, size_t ldb, int nk, f32x4 (&acc)[4][4], unsigned char* lds) {
    const int tid = threadIdx.x, lane = tid & 63, wid = tid >> 6, wr = wid >> 1, wc = wid & 1, fr = lane & 15, fq = lane >> 4;
#pragma unroll
    for (int mi = 0; mi < 4; ++mi)
#pragma unroll
        for (int ni = 0; ni < 4; ++ni) acc[mi][ni] = (f32x4){0.f, 0.f, 0.f, 0.f};
    const int srow = wid * 32 + (lane >> 3), schunk = (lane & 7) ^ ((lane >> 3) & 7);
    unsigned offA[4], offB[4];
#pragma unroll
    for (int i = 0; i < 4; ++i) { offA[i] = al.off(srow + 8 * i, schunk); offB[i] = (unsigned)(srow + 8 * i) * (unsigned)ldb + (unsigned)schunk * 8u; }
#define G3_STAGE(buf_, kt_) do { const bf16_t* ab_ = al.base(kt_); const bf16_t* bb_ = Bt + (kt_) * 64; unsigned char* lb_ = lds + (buf_) * 32768 + wid * 4096; \
        _Pragma("unroll") for (int i = 0; i < 4; ++i) { \
            __builtin_amdgcn_global_load_lds((const unsigned*)(ab_ + offA[i]), (unsigned*)(lb_ + i * 1024), 16, 0, 0); \
            __builtin_amdgcn_global_load_lds((const unsigned*)(bb_ + offB[i]), (unsigned*)(lb_ + 16384 + i * 1024), 16, 0, 0); } } while (0)
    const int aoff = (wr * 64 + fr) * 128, boff = 16384 + (wc * 64 + fr) * 128, sw = fr & 7;
    G3_STAGE(0, 0);
    __syncthreads();
    for (int kt = 0; kt < nk; ++kt) {
        if (kt + 1 < nk) G3_STAGE((kt + 1) & 1, kt + 1);
        const unsigned char* buf = lds + (kt & 1) * 32768;
#pragma unroll
        for (int ks = 0; ks < 2; ++ks) {
            bf16x8 af[4], bfr[4];
            const int co = ((ks * 4 + fq) ^ sw) << 4;
#pragma unroll
            for (int mi = 0; mi < 4; ++mi) af[mi] = *(const bf16x8*)(buf + aoff + mi * 2048 + co);
#pragma unroll
            for (int ni = 0; ni < 4; ++ni) bfr[ni] = *(const bf16x8*)(buf + boff + ni * 2048 + co);
#pragma unroll
            for (int mi = 0; mi < 4; ++mi)
#pragma unroll
                for (int ni = 0; ni < 4; ++ni) acc[mi][ni] = __builtin_amdgcn_mfma_f32_16x16x32_bf16(bfr[ni], af[mi], acc[mi][ni], 0, 0, 0);
        }
        __syncthreads();
    }
#undef G3_STAGE
}
__device__ __forceinline__ void phase_s5_win(const Params& p, unsigned char* lds) {
    const bf16_t* HM = (const bf16_t*)(p.ws + WS_HM); const bf16_t* WT = (const bf16_t*)(p.ws + WS_WIN_T);
    bf16_t* UG = (bf16_t*)(p.ws + WS_UG);
    const int lane = threadIdx.x & 63, wid = threadIdx.x >> 6, wr = wid >> 1, wc = wid & 1, fr = lane & 15, fq = lane >> 4;
    for (int id = vblock(); id < 256 * 8; id += gridDim.x) {
        const int mt = id >> 3, nt = id & 7;
        f32x4 acc[4][4];
        gemm_tile3(ALoadPlain{HM + (size_t)mt * 128 * D, (size_t)D}, WT + (size_t)nt * 128 * D, D, 16, acc, lds);
#pragma unroll
        for (int mi = 0; mi < 4; ++mi)
#pragma unroll
            for (int ni = 0; ni < 4; ++ni) {
                const int t = mt * 128 + wr * 64 + mi * 16 + fr, g = nt * 8 + wc * 4 + ni;
                const f32x4 v = acc[mi][ni];
                *(u32x2*)(UG + ((size_t)g * T + t) * 16 + fq * 4) = (u32x2){pk2(v.x, v.y), pk2(v.z, v.w)};
            }
    }
}
__device__ __forceinline__ void phase_s5_a(const Params& p, unsigned char* lds) {
    const bf16_t* UG = (const bf16_t*)(p.ws + WS_UG); const bf16_t* TW = (const bf16_t*)(p.ws + WS_TW);
    bf16_t* YI = (bf16_t*)(p.ws + WS_YI); float* WST = (float*)(p.ws + WS_WST);
    const int lane = threadIdx.x & 63, wid = threadIdx.x >> 6, wr = wid >> 1, wc = wid & 1, fr = lane & 15, fq = lane >> 4;
    for (int id = vblock(); id < 64 * 40; id += gridDim.x) {
        const int g = id / 40, rem = id % 40, mt = rem / 5, nt = rem % 5;
        const int nk = (nt < 4) ? 2 * (nt + 1) : 8;
        f32x4 acc[4][4];
        gemm_tile3(ALoadPlain{UG + (size_t)g * T * 16 + (size_t)mt * 128 * 512, (size_t)512}, TW + ((size_t)g * 640 + nt * 128) * 512, 512, nk, acc, lds);
#pragma unroll
        for (int mi = 0; mi < 4; ++mi)
#pragma unroll
            for (int ni = 0; ni < 4; ++ni) {
                const int R = mt * 128 + wr * 64 + mi * 16 + fr, c = wc * 64 + ni * 16 + fq * 4;
                const f32x4 v = acc[mi][ni];
                if (nt < 4) *(u32x2*)(YI + ((size_t)g * 1024 + R) * 512 + nt * 128 + c) = (u32x2){pk2(v.x, v.y), pk2(v.z, v.w)};
                else *(f32x4*)(WST + ((size_t)g * 1024 + R) * 128 + c) = v;
            }
    }
}
__device__ __forceinline__ void phase_s5_scan(const Params& p) {
    const int lane = threadIdx.x & 63, wave = threadIdx.x >> 6;
    const float* WST = (const float*)(p.ws + WS_WST); bf16_t* SST = (bf16_t*)(p.ws + WS_SST);
    const f32x2* AL = (const f32x2*)(p.ws + WS_MISC + 4096);
    for (int it = blockIdx.x * 4 + wave; it < 128; it += gridDim.x * 4) {
        const int b = it >> 6, g = it & 63;
        const f32x2 al = AL[g * 64 + lane];
        float sr = 0.f, si = 0.f;
        const float* wbase = WST + ((size_t)g * 1024 + b * 512) * 128 + lane;
        bf16_t* sbase = SST + ((size_t)g * 1024 + b * 512) * 128 + lane;
        for (int n0 = 0; n0 < 512; n0 += 16) {
            float wre[16], wim[16];
#pragma unroll
            for (int j = 0; j < 16; ++j) { wre[j] = wbase[(size_t)(n0 + j) * 128]; wim[j] = wbase[(size_t)(n0 + j) * 128 + 64]; }
#pragma unroll
            for (int j = 0; j < 16; ++j) {
                sbase[(size_t)(n0 + j) * 128] = (bf16_t)f2bf(sr); sbase[(size_t)(n0 + j) * 128 + 64] = (bf16_t)f2bf(si);
                const float nr = al.x * sr - al.y * si + wre[j], ni = al.x * si + al.y * sr + wim[j];
                sr = nr; si = ni;
            }
        }
    }
}
__device__ __forceinline__ void phase_s5_b(const Params& p, unsigned char* lds) {
    const bf16_t* SST = (const bf16_t*)(p.ws + WS_SST); const bf16_t* VG = (const bf16_t*)(p.ws + WS_VG);
    const bf16_t* YI = (const bf16_t*)(p.ws + WS_YI); const bf16_t* UG = (const bf16_t*)(p.ws + WS_UG);
    bf16_t* YG = (bf16_t*)(p.ws + WS_YG);
    const float* dsk = p.in[14];
    const int lane = threadIdx.x & 63, wid = threadIdx.x >> 6, wr = wid >> 1, wc = wid & 1, fr = lane & 15, fq = lane >> 4;
    for (int id = vblock(); id < 64 * 32; id += gridDim.x) {
        const int g = id >> 5, mt = (id >> 2) & 7, nt = id & 3;
        f32x4 acc[4][4];
        gemm_tile3(ALoadPlain{SST + ((size_t)g * 1024 + mt * 128) * 128, (size_t)128}, VG + ((size_t)g * 512 + nt * 128) * 128, 128, 2, acc, lds);
        const f32x4 dv = *(const f32x4*)(dsk + g * 16 + fq * 4);
#pragma unroll
        for (int mi = 0; mi < 4; ++mi)
#pragma unroll
            for (int ni = 0; ni < 4; ++ni) {
                const int R = mt * 128 + wr * 64 + mi * 16 + fr, c = nt * 128 + wc * 64 + ni * 16 + fq * 4;
                const size_t idx = ((size_t)g * 1024 + R) * 512 + c;
                const u32x2 yi = *(const u32x2*)(YI + idx), uu = *(const u32x2*)(UG + idx);
                const f32x4 v = acc[mi][ni];
                const float y0 = gelu_tanh(v.x + bflo(yi.x) + dv.x * bflo(uu.x)), y1 = gelu_tanh(v.y + bfhi(yi.x) + dv.y * bfhi(uu.x));
                const float y2 = gelu_tanh(v.z + bflo(yi.y) + dv.z * bflo(uu.y)), y3 = gelu_tanh(v.w + bfhi(yi.y) + dv.w * bfhi(uu.y));
                *(u32x2*)(YG + idx) = (u32x2){pk2(y0, y1), pk2(y2, y3)};
            }
    }
}
__device__ __forceinline__ void phase_s5_glu(const Params& p, unsigned char* lds) {
    const bf16_t* YG = (const bf16_t*)(p.ws + WS_YG); const bf16_t* WT = (const bf16_t*)(p.ws + WS_WGLU_T);
    const float* MOD = (const float*)(p.ws + WS_MOD);
    const float* X = p.in[0]; float* XO = p.out;
    const int lane = threadIdx.x & 63, wid = threadIdx.x >> 6, wr = wid >> 1, wc = wid & 1, fr = lane & 15, fq = lane >> 4;
    for (int id = vblock(); id < 256 * 16; id += gridDim.x) {
        const int mt = id >> 4, nt = id & 15;
        f32x4 acc[4][4];
        gemm_tile3(ALoadGroup{YG + (size_t)mt * 128 * 16}, WT + (size_t)nt * 128 * D, D, 16, acc, lds);
        const int b = (mt * 128) / SEQ;
#pragma unroll
        for (int mi = 0; mi < 4; ++mi)
#pragma unroll
            for (int h = 0; h < 2; ++h) {
                const int t = mt * 128 + wr * 64 + mi * 16 + fr, j = nt * 64 + wc * 32 + h * 16 + fq * 4;
                const f32x4 a = acc[mi][2 * h], gg = acc[mi][2 * h + 1];
                const f32x4 g1 = *(const f32x4*)(MOD + (size_t)(0 * 2 + b) * 6144 + 2048 + j);
                const f32x4 xi = *(const f32x4*)(X + (size_t)t * D + j);
                f32x4 o;
                o.x = xi.x + g1.x * (a.x * sigmoidf_(gg.x)); o.y = xi.y + g1.y * (a.y * sigmoidf_(gg.y));
                o.z = xi.z + g1.z * (a.z * sigmoidf_(gg.z)); o.w = xi.w + g1.w * (a.w * sigmoidf_(gg.w));
                *(f32x4*)(XO + (size_t)t * D + j) = o;
            }
    }
}
__device__ __forceinline__ void phase_peer_wq(const Params& p, int layer, unsigned char* lds) {
    const bf16_t* HM = (const bf16_t*)(p.ws + WS_HM); const bf16_t* WT = (const bf16_t*)(p.ws + WS_WQ_T) + (size_t)layer * 2048 * 1024;
    bf16_t* QK = (bf16_t*)(p.ws + WS_QK);
    const int lane = threadIdx.x & 63, wid = threadIdx.x >> 6, wr = wid >> 1, wc = wid & 1, fr = lane & 15, fq = lane >> 4;
    for (int id = vblock(); id < 256 * 16; id += gridDim.x) {
        const int mt = id >> 4, nt = id & 15;
        f32x4 acc[4][4];
        gemm_tile3(ALoadPlain{HM + (size_t)mt * 128 * D, (size_t)D}, WT + (size_t)nt * 128 * D, D, 16, acc, lds);
#pragma unroll
        for (int mi = 0; mi < 4; ++mi)
#pragma unroll
            for (int ni = 0; ni < 4; ++ni) {
                const int t = mt * 128 + wr * 64 + mi * 16 + fr, c = nt * 128 + wc * 64 + ni * 16 + fq * 4;
                const f32x4 v = acc[mi][ni];
                *(u32x2*)(QK + (size_t)t * 2048 + c) = (u32x2){pk2(v.x, v.y), pk2(v.z, v.w)};
            }
    }
}
__device__ __forceinline__ void ce_(unsigned& a, unsigned& b, const bool up) { const unsigned lo = a < b ? a : b, hi = a < b ? b : a; a = up ? lo : hi; b = up ? hi : lo; }
__device__ __forceinline__ void bitonic_sort16(unsigned* x, const bool asc) {
#pragma unroll
    for (int k = 2; k <= 16; k <<= 1)
#pragma unroll
        for (int j = k >> 1; j > 0; j >>= 1)
#pragma unroll
            for (int i = 0; i < 16; ++i) { const int l = i ^ j; if (l > i) ce_(x[i], x[l], ((i & k) == 0) == asc); }
}
__device__ __forceinline__ void bitonic_merge16(unsigned* x, const bool asc) {
#pragma unroll
    for (int j = 8; j > 0; j >>= 1)
#pragma unroll
        for (int i = 0; i < 16; ++i) { const int l = i ^ j; if (l > i) ce_(x[i], x[l], asc); }
}
__device__ __forceinline__ void phase_peer_topk(const Params& p, int layer, unsigned char* lds) {
    const bf16_t* QK = (const bf16_t*)(p.ws + WS_QK); const bf16_t* SK = (const bf16_t*)(p.ws + WS_SUBK) + (size_t)layer * 8 * 2 * 128 * 128;
    float* TOPS = (float*)(p.ws + WS_TOPS); int* TOPI = (int*)(p.ws + WS_TOPI);
    float* sc = (float*)lds;
    const int tid = threadIdx.x, lane = tid & 63, wid = tid >> 6, wr = wid >> 1, wc = wid & 1, fr = lane & 15, fq = lane >> 4;
    for (int id = vblock(); id < 256 * 16; id += gridDim.x) {
        const int mt = id >> 4, hc = id & 15;
        f32x4 acc[4][4];
        gemm_tile3(ALoadPlain{QK + (size_t)mt * 128 * 2048 + hc * 128, (size_t)2048}, SK + (size_t)hc * 128 * 128, 128, 2, acc, lds);
#pragma unroll
        for (int mi = 0; mi < 4; ++mi)
#pragma unroll
            for (int ni = 0; ni < 4; ++ni) {
                const int r = wr * 64 + mi * 16 + fr, c = wc * 64 + ni * 16 + fq * 4;
                float* d = sc + r * 129 + c;
                d[0] = acc[mi][ni].x; d[1] = acc[mi][ni].y; d[2] = acc[mi][ni].z; d[3] = acc[mi][ni].w;
            }
        __syncthreads();
        {
            const int row = tid >> 1, half = tid & 1;
            unsigned x[64];
            const float* rp = sc + row * 129 + half * 64;
#pragma unroll
            for (int j = 0; j < 64; ++j) {
                const unsigned bits = __builtin_bit_cast(unsigned, rp[j]);
                const unsigned u = bits ^ ((unsigned)((int)bits >> 31) | 0x80000000u);
                x[j] = (u & 0xFFFFFF80u) | (unsigned)(127 - (half * 64 + j));
            }
            bitonic_sort16(x, true); bitonic_sort16(x + 16, false); bitonic_sort16(x + 32, true); bitonic_sort16(x + 48, false);
#pragma unroll
            for (int i = 0; i < 16; ++i) { x[i] = x[i] > x[16 + i] ? x[i] : x[16 + i]; x[32 + i] = x[32 + i] > x[48 + i] ? x[32 + i] : x[48 + i]; }
            bitonic_merge16(x, true); bitonic_merge16(x + 32, false);
#pragma unroll
            for (int i = 0; i < 16; ++i) x[i] = x[i] > x[32 + i] ? x[i] : x[32 + i];
            bitonic_merge16(x, false);
            unsigned y[16];
#pragma unroll
            for (int i = 0; i < 16; ++i) { const unsigned o = (unsigned)__shfl_xor((int)x[15 - i], 1); y[i] = x[i] > o ? x[i] : o; }
            bitonic_merge16(y, false);
            const size_t ob = ((size_t)(mt * 128 + row) * 16 + hc) * 16;
            if (half == 0) {
                float v[16];
#pragma unroll
                for (int i = 0; i < 16; ++i) { const unsigned u = y[i] & 0xFFFFFF80u; const unsigned bits = (u & 0x80000000u) ? (u ^ 0x80000000u) : ~u; v[i] = __builtin_bit_cast(float, bits); }
#pragma unroll
                for (int q = 0; q < 4; ++q) *(f32x4*)(TOPS + ob + q * 4) = (f32x4){v[q * 4], v[q * 4 + 1], v[q * 4 + 2], v[q * 4 + 3]};
            } else {
#pragma unroll
                for (int q = 0; q < 4; ++q) *(u32x4*)(TOPI + ob + q * 4) = (u32x4){127u - (y[q * 4] & 127u), 127u - (y[q * 4 + 1] & 127u), 127u - (y[q * 4 + 2] & 127u), 127u - (y[q * 4 + 3] & 127u)};
            }
        }
        __syncthreads();
    }
}
__device__ __forceinline__ void phase_peer_combine(const Params& p, unsigned char* lds) {
    const float* TOPS = (const float*)(p.ws + WS_TOPS); const int* TOPI = (const int*)(p.ws + WS_TOPI);
    int* EXP = (int*)(p.ws + WS_EXP); float* GATE = (float*)(p.ws + WS_GATE);
    unsigned* L = (unsigned*)lds;
    const int tid = threadIdx.x;
    for (int it = blockIdx.x; it < (T * 8) / 256; it += gridDim.x) {
        const size_t th = (size_t)it * 256 + tid;
        const u32x4* S4 = (const u32x4*)(TOPS + th * 32); const u32x4* I4 = (const u32x4*)(TOPI + th * 32);
#pragma unroll
        for (int a4 = 0; a4 < 8; ++a4) {
            const u32x4 s = S4[a4], i = I4[a4];
            L[(a4 * 4 + 0) * 256 + tid] = s.x; L[(a4 * 4 + 1) * 256 + tid] = s.y; L[(a4 * 4 + 2) * 256 + tid] = s.z; L[(a4 * 4 + 3) * 256 + tid] = s.w;
            L[(32 + a4 * 4 + 0) * 256 + tid] = i.x; L[(32 + a4 * 4 + 1) * 256 + tid] = i.y; L[(32 + a4 * 4 + 2) * 256 + tid] = i.z; L[(32 + a4 * 4 + 3) * 256 + tid] = i.w;
        }
        float val[16];
        const float s20 = __builtin_bit_cast(float, L[16 * 256 + tid]);
#pragma unroll
        for (int a = 0; a < 16; ++a) val[a] = __builtin_bit_cast(float, L[a * 256 + tid]) + s20;
        unsigned long long P = 0ull;
        float ts[16]; int te[16];
#pragma unroll
        for (int r = 0; r < 16; ++r) {
            float best = val[0]; int ba = 0;
#pragma unroll
            for (int a = 1; a < 16; ++a) if (val[a] > best) { best = val[a]; ba = a; }
            const int b = (int)((P >> (4 * ba)) & 15ull);
            const int i1 = (int)L[(32 + ba) * 256 + tid], i2 = (int)L[(48 + b) * 256 + tid];
            ts[r] = best; te[r] = i1 * 128 + i2;
            const int nb = b + 1;
            float newv = -3.0e38f;
            if (nb < 16) { newv = __builtin_bit_cast(float, L[ba * 256 + tid]) + __builtin_bit_cast(float, L[(16 + nb) * 256 + tid]); P += 1ull << (4 * ba); }
#pragma unroll
            for (int a = 0; a < 16; ++a) val[a] = (a == ba) ? newv : val[a];
        }
        const float m0 = ts[0];
        float sum = 0.f;
#pragma unroll
        for (int r = 0; r < 16; ++r) { ts[r] = __expf(ts[r] - m0); sum += ts[r]; }
        const float inv = 1.0f / sum;
#pragma unroll
        for (int r = 0; r < 16; ++r) ts[r] *= inv;
#pragma unroll
        for (int r = 0; r < 16; ++r) { EXP[th * 16 + r] = te[r]; GATE[th * 16 + r] = ts[r]; }
    }
}

__device__ __forceinline__ void fma8(const unsigned w0, const unsigned w1, const float a, float* acc) {
    const f32x2 p0 = __builtin_amdgcn_cvt_pk_f32_fp8((int)w0, false), p1 = __builtin_amdgcn_cvt_pk_f32_fp8((int)w0, true);
    const f32x2 p2 = __builtin_amdgcn_cvt_pk_f32_fp8((int)w1, false), p3 = __builtin_amdgcn_cvt_pk_f32_fp8((int)w1, true);
    acc[0] += a * p0.x; acc[1] += a * p0.y; acc[2] += a * p1.x; acc[3] += a * p1.y;
    acc[4] += a * p2.x; acc[5] += a * p2.y; acc[6] += a * p3.x; acc[7] += a * p3.y;
}
__device__ __forceinline__ float dot8(const unsigned w0, const unsigned w1, const float* h, float s) {
    const f32x2 p0 = __builtin_amdgcn_cvt_pk_f32_fp8((int)w0, false), p1 = __builtin_amdgcn_cvt_pk_f32_fp8((int)w0, true);
    const f32x2 p2 = __builtin_amdgcn_cvt_pk_f32_fp8((int)w1, false), p3 = __builtin_amdgcn_cvt_pk_f32_fp8((int)w1, true);
    s += p0.x * h[0]; s += p0.y * h[1]; s += p1.x * h[2]; s += p1.y * h[3];
    s += p2.x * h[4]; s += p2.y * h[5]; s += p3.x * h[6]; s += p3.y * h[7];
    return s;
}
__device__ __forceinline__ void phase_peer_apply(const Params& p, int layer, unsigned char* lds, bool dry) {
    const int lane = threadIdx.x & 63, wave = threadIdx.x >> 6;
    float* ldsw = (float*)lds + wave * (64 * 65);
    const bf16_t* HM = (const bf16_t*)(p.ws + WS_HM);
    const unsigned char* PU = p.ws + WS_PU; const unsigned char* PV = p.ws + WS_PV;
    const float* SU = (const float*)(p.ws + WS_PU + 24 * MiB); const float* SV = (const float*)(p.ws + WS_PV + 24 * MiB);
    const int* EXP = (const int*)(p.ws + WS_EXP); const float* GATE = (const float*)(p.ws + WS_GATE);
    const float* MOD = (const float*)(p.ws + WS_MOD);
    float* X = p.out;
    for (int t = blockIdx.x * 4 + wave; t < T; t += gridDim.x * 4) {
        const u32x4 ha = *(const u32x4*)(HM + (size_t)t * D + lane * 16), hb = *(const u32x4*)(HM + (size_t)t * D + lane * 16 + 8);
        float hf[16];
        hf[0] = bflo(ha.x); hf[1] = bfhi(ha.x); hf[2] = bflo(ha.y); hf[3] = bfhi(ha.y); hf[4] = bflo(ha.z); hf[5] = bfhi(ha.z); hf[6] = bflo(ha.w); hf[7] = bfhi(ha.w);
        hf[8] = bflo(hb.x); hf[9] = bfhi(hb.x); hf[10] = bflo(hb.y); hf[11] = bfhi(hb.y); hf[12] = bflo(hb.z); hf[13] = bfhi(hb.z); hf[14] = bflo(hb.w); hf[15] = bfhi(hb.w);
        const int e0_ = EXP[(size_t)t * 128 + lane], e1_ = EXP[(size_t)t * 128 + 64 + lane];
        const float g0 = GATE[(size_t)t * 128 + lane], g1 = GATE[(size_t)t * 128 + 64 + lane];
        const float su0 = SU[e0_], su1 = SU[e1_], sv0 = SV[e0_], sv1 = SV[e1_];
        u32x4 buf[16];
        float act0 = 0.f, act1 = 0.f;
        float acc[16];
#pragma unroll
        for (int i = 0; i < 16; ++i) acc[i] = 0.f;
#ifndef APPLY_L2PROBE
#define APPLY_L2PROBE 0
#endif
        for (int prep_ = 0; prep_ < 1 + APPLY_L2PROBE; ++prep_) {
        const int emask = (APPLY_L2PROBE && prep_ == 0) ? 2047 : 0x7fffffff;
        const int e0 = e0_ & emask, e1 = e1_ & emask;
#pragma unroll
        for (int j = 0; j < 16; ++j) { const int e_ = __builtin_amdgcn_readlane(e0, j); buf[j] = *(const u32x4*)(PU + (size_t)e_ * D + lane * 16); }
#pragma unroll
        for (int bt = 0; bt < 16; ++bt) {
#pragma unroll
            for (int j = 0; j < 16; ++j) {
                if (bt < 8) {
                    float s_ = dot8(buf[j].x, buf[j].y, hf, 0.f); s_ = dot8(buf[j].z, buf[j].w, hf + 8, s_);
                    ldsw[((bt & 3) * 16 + j) * 65 + lane] = s_;
                } else {
                    const float av_ = ((bt & 7) < 4) ? act0 : act1;
                    const float a_ = __builtin_bit_cast(float, __builtin_amdgcn_readlane(__builtin_bit_cast(int, av_), (bt & 3) * 16 + j));
                    fma8(buf[j].x, buf[j].y, a_, acc); fma8(buf[j].z, buf[j].w, a_, acc + 8);
                }
                if (bt + 1 < 16) {
                    const int nb = bt + 1;
                    const int e_ = __builtin_amdgcn_readlane(((nb & 7) < 4) ? e0 : e1, (nb & 3) * 16 + j);
                    buf[j] = *(const u32x4*)(((nb < 8) ? PU : PV) + (size_t)e_ * D + lane * 16);
                }
            }
            if (bt == 3 || bt == 7) {
                float tot_ = 0.f;
#pragma unroll 16
                for (int q = 0; q < 64; ++q) tot_ += ldsw[lane * 65 + q];
                if (bt == 3) act0 = gelu_tanh(tot_ * su0) * g0 * sv0; else act1 = gelu_tanh(tot_ * su1) * g1 * sv1;
            }
        }
        if (APPLY_L2PROBE && prep_ == 0 && p.ph_hi >= 0) {
#pragma unroll
            for (int i = 0; i < 16; ++i) acc[i] = 0.f;
        }
        }
        const int b = t / SEQ;
        const float* g2 = MOD + (size_t)(layer * 2 + b) * 6144 + 5120;
        float* xr = X + (size_t)t * D + lane * 16;
        f32x4 xs[4]; float ss = 0.f;
#pragma unroll
        for (int q = 0; q < 4; ++q) {
            const f32x4 g = *(const f32x4*)(g2 + lane * 16 + q * 4); f32x4 x = *(const f32x4*)(xr + q * 4);
            x.x += g.x * acc[q * 4 + 0]; x.y += g.y * acc[q * 4 + 1]; x.z += g.z * acc[q * 4 + 2]; x.w += g.w * acc[q * 4 + 3];
            xs[q] = x; ss += (x.x * x.x + x.y * x.y) + (x.z * x.z + x.w * x.w);
        }
        const float rs = rsqrtf(wave_sum(ss) * (1.0f / D) + RMS_EPS);
        if (!dry) {
            if (layer == 0) {
                const float* gw = p.in[2] + D + lane * 16; const float* sh = MOD + (size_t)(2 + b) * 6144 + lane * 16; const float* sc = sh + 1024;
                u32x4 o[2];
#pragma unroll
                for (int q = 0; q < 4; ++q) {
                    *(f32x4*)(xr + q * 4) = xs[q];
                    const f32x4 g = *(const f32x4*)(gw + q * 4), s1 = *(const f32x4*)(sc + q * 4), s0 = *(const f32x4*)(sh + q * 4);
                    const float y0 = xs[q].x * rs * g.x * (1.f + s1.x) + s0.x, y1 = xs[q].y * rs * g.y * (1.f + s1.y) + s0.y;
                    const float y2 = xs[q].z * rs * g.z * (1.f + s1.z) + s0.z, y3 = xs[q].w * rs * g.w * (1.f + s1.w) + s0.w;
                    if (q & 1) { o[q >> 1].z = pk2(y0, y1); o[q >> 1].w = pk2(y2, y3); } else { o[q >> 1].x = pk2(y0, y1); o[q >> 1].y = pk2(y2, y3); }
                }
                bf16_t* hm = (bf16_t*)(p.ws + WS_HM) + (size_t)t * D + lane * 16;
                *(u32x4*)hm = o[0]; *(u32x4*)(hm + 8) = o[1];
            } else {
                const float* gw = p.in[28] + lane * 16;
#pragma unroll
                for (int q = 0; q < 4; ++q) {
                    const f32x4 g = *(const f32x4*)(gw + q * 4);
                    *(f32x4*)(xr + q * 4) = (f32x4){xs[q].x * rs * g.x, xs[q].y * rs * g.y, xs[q].z * rs * g.z, xs[q].w * rs * g.w};
                }
            }
        }
    }
}
__device__ __forceinline__ void phase_tab1(const Params& p) {
    for (int it = blockIdx.x; it < 2 * P0_TAB; it += gridDim.x) {
        if (it < P0_TAB) cvt_fp8_item(p.in[26] + (size_t)PE * D, p.ws + WS_PU, (float*)(p.ws + WS_PU + 24 * MiB), it, false);
        else cvt_fp8_item(p.in[27] + (size_t)PE * D, p.ws + WS_PV, (float*)(p.ws + WS_PV + 24 * MiB), it - P0_TAB, false);
    }
}
__device__ __forceinline__ void phase_nsa_proj(const Params& p, unsigned char* lds) {
    const bf16_t* HM = (const bf16_t*)(p.ws + WS_HM); const bf16_t* WT = (const bf16_t*)(p.ws + WS_WPROJ_T);
    const f32x2* ROPE = (const f32x2*)(p.ws + WS_ROPE);
    bf16_t* Q = (bf16_t*)(p.ws + WS_Q); float* NGT = (float*)(p.ws + WS_NG);
    const int lane = threadIdx.x & 63, wid = threadIdx.x >> 6, wr = wid >> 1, wc = wid & 1, fr = lane & 15, fq = lane >> 4;
    for (int id = vblock(); id < 256 * 21; id += gridDim.x) {
        const int mt = id / 21, nt = id % 21;
        f32x4 acc[4][4];
        gemm_tile3(ALoadPlain{HM + (size_t)mt * 128 * D, (size_t)D}, WT + (size_t)nt * 128 * D, D, 16, acc, lds);
        const int c0 = nt * 128 + wc * 64;
        if (c0 >= 2624) continue;
        const int b = (mt * 128) / SEQ;
        if (c0 == 2560) {
#pragma unroll
            for (int mi = 0; mi < 4; ++mi)
#pragma unroll
                for (int ni = 0; ni < 3; ++ni) {
                    const int t = mt * 128 + wr * 64 + mi * 16 + fr;
                    const f32x4 v = acc[mi][ni];
                    *(f32x4*)(NGT + (size_t)t * 48 + ni * 16 + fq * 4) = (f32x4){sigmoidf_(v.x), sigmoidf_(v.y), sigmoidf_(v.z), sigmoidf_(v.w)};
                }
            continue;
        }
        int sec = -1, g = 0;
        if (c0 >= 1024) { sec = (c0 - 1024) >> 8; g = ((c0 - 1024) & 255) >> 6; }
        const bool dorope = (sec == -1) || (sec == 2) || (sec == 4);
        const float scl = (sec == -1) ? 0.125f : 1.0f;
        const size_t secoff[6] = {WS_KC, WS_VC, WS_KS, WS_VST, WS_KW, WS_VWT};
        size_t so = WS_Q;
#pragma unroll
        for (int q = 0; q < 6; ++q) if (sec == q) so = secoff[q];
        bf16_t* OUT = (bf16_t*)(p.ws + so);
        const bool vt = (sec == 3) || (sec == 5);
        float kblk_am = 0.f;
#pragma unroll
        for (int pass = 0; pass < 2; ++pass) {
        if (pass == 1 && sec == 2) {
#pragma unroll
            for (int o = 1; o < 64; o <<= 1) kblk_am = fmaxf(kblk_am, __shfl_xor(kblk_am, o));
            if (lane == 0) ((float*)(p.ws + WS_KS + 12 * MiB))[(size_t)(b * 4 + g) * 256 + ((mt * 128 + wr * 64 - b * SEQ) >> 6)] = kblk_am > 0.f ? kblk_am / 224.0f : 1.0f;
        }
#pragma unroll
        for (int mi = 0; mi < 4; ++mi) {
            const int t = mt * 128 + wr * 64 + mi * 16 + fr, s = t - b * SEQ;
            if (dorope && pass == 0) {
#pragma unroll
                for (int ni = 0; ni < 2; ++ni) {
                    const f32x4* rp = (const f32x4*)(ROPE + (size_t)s * 32 + ni * 16 + fq * 4);
                    const f32x4 r0 = rp[0], r1 = rp[1];
                    const f32x4 x1 = acc[mi][ni], x2 = acc[mi][ni + 2];
                    acc[mi][ni] = (f32x4){x1.x * r0.x - x2.x * r0.y, x1.y * r0.z - x2.y * r0.w, x1.z * r1.x - x2.z * r1.y, x1.w * r1.z - x2.w * r1.w};
                    acc[mi][ni + 2] = (f32x4){x1.x * r0.y + x2.x * r0.x, x1.y * r0.w + x2.y * r0.z, x1.z * r1.y + x2.z * r1.x, x1.w * r1.w + x2.w * r1.z};
                }
            }
            if (pass == 0) {
                if (sec == 2) {
#pragma unroll
                    for (int ni = 0; ni < 4; ++ni) { const f32x4 v = acc[mi][ni]; kblk_am = fmaxf(kblk_am, fmaxf(fmaxf(fabsf(v.x), fabsf(v.y)), fmaxf(fabsf(v.z), fabsf(v.w)))); }
                }
                continue;
            }
            if (sec == -1 || sec == 2) {
                float am = kblk_am;
                if (sec == -1) {
                    am = 0.f;
#pragma unroll
                    for (int ni = 0; ni < 4; ++ni) { const f32x4 v = acc[mi][ni] * scl; am = fmaxf(am, fmaxf(fmaxf(fabsf(v.x), fabsf(v.y)), fmaxf(fabsf(v.z), fabsf(v.w)))); }
                    am = fmaxf(am, __shfl_xor(am, 16)); am = fmaxf(am, __shfl_xor(am, 32));
                }
                const float qs = am > 0.f ? 224.0f / am : 1.0f;
                unsigned char* O8 = (sec == -1) ? (p.ws + WS_Q8 + (size_t)t * 1024 + c0) : (p.ws + WS_KS + ((size_t)(b * 4 + g) * SEQ + s) * 64);
#pragma unroll
                for (int ni = 0; ni < 4; ++ni) {
                    const f32x4 v = acc[mi][ni] * (scl * qs);
                    int w = 0; w = __builtin_amdgcn_cvt_pk_fp8_f32(v.x, v.y, w, false); w = __builtin_amdgcn_cvt_pk_fp8_f32(v.z, v.w, w, true);
                    *(int*)(O8 + ni * 16 + fq * 4) = w;
                }
                if (fq == 0 && sec == -1) ((float*)(p.ws + WS_Q8 + 32 * MiB))[(size_t)t * 16 + (c0 >> 6)] = am > 0.f ? am / 224.0f : 1.0f;
            }
            if (sec == 2) continue;
#pragma unroll
            for (int ni = 0; ni < 4; ++ni) {
                const f32x4 v = acc[mi][ni] * scl;
                const int d = ni * 16 + fq * 4;
                if (sec == -1) {
                    *(u32x2*)(OUT + (size_t)t * 1024 + c0 + d) = (u32x2){pk2(v.x, v.y), pk2(v.z, v.w)};
                } else if (sec == 4) {
                    const size_t idx = (size_t)(b * 4 + g) * SEQ * 64 + (size_t)(s >> 5) * 2048 + ((((s >> 4) & 1) * 2 + (ni >> 1)) * 16 + (s & 15)) * 32 + ((ni & 1) * 2 + (fq >> 1)) * 8 + (fq & 1) * 4;
                    *(u32x2*)(OUT + idx) = (u32x2){pk2(v.x, v.y), pk2(v.z, v.w)};
                } else if (!vt) {
                    *(u32x2*)(OUT + ((size_t)(b * 4 + g) * SEQ + s) * 64 + d) = (u32x2){pk2(v.x, v.y), pk2(v.z, v.w)};
                } else if (sec == 5) {
                    const int key = s & 31;
                    bf16_t* o = OUT + (size_t)(b * 4 + g) * SEQ * 64 + (size_t)(s >> 5) * 2048 + ((ni * 2 + (key >> 4)) * 16 + fq * 4) * 16 + ((key >> 2) & 3) * 4 + (key & 3);
                    o[0] = (bf16_t)f2bf(v.x); o[16] = (bf16_t)f2bf(v.y); o[32] = (bf16_t)f2bf(v.z); o[48] = (bf16_t)f2bf(v.w);
                }
            }
        }
        }
        if (sec == 3) {
            const int s0 = mt * 128 + wr * 64 - b * SEQ, jb = s0 >> 6;
            unsigned char* V8 = p.ws + WS_VST + (size_t)((b * 4 + g) * 256 + jb) * 4096;
            float am = 0.f;
#pragma unroll
            for (int mi = 0; mi < 4; ++mi)
#pragma unroll
                for (int ni = 0; ni < 4; ++ni) { const f32x4 v = acc[mi][ni]; am = fmaxf(am, fmaxf(fmaxf(fabsf(v.x), fabsf(v.y)), fmaxf(fabsf(v.z), fabsf(v.w)))); }
#pragma unroll
            for (int o = 1; o < 64; o <<= 1) am = fmaxf(am, __shfl_xor(am, o));
            const float qs = am > 0.f ? 224.0f / am : 1.0f;
            if (lane == 0) ((float*)(p.ws + WS_VST + 12 * MiB))[(size_t)(b * 4 + g) * 256 + jb] = am > 0.f ? am / 224.0f : 1.0f;
#pragma unroll
            for (int ni = 0; ni < 4; ++ni) {
                const int d = ni * 16 + fq * 4;
#pragma unroll
                for (int mi = 0; mi < 4; ++mi) {
                    const f32x4 v = acc[mi][ni] * qs;
                    int w = 0; w = __builtin_amdgcn_cvt_pk_fp8_f32(v.x, v.y, w, false); w = __builtin_amdgcn_cvt_pk_fp8_f32(v.z, v.w, w, true);
                    unsigned char* o = V8 + (size_t)d * 64 + mi * 16 + fr;
                    o[0] = (unsigned char)(w & 255); o[64] = (unsigned char)((w >> 8) & 255); o[128] = (unsigned char)((w >> 16) & 255); o[192] = (unsigned char)((unsigned)w >> 24);
                }
            }
        }
    }
}
__device__ __forceinline__ void phase_nsa_cmp1(const Params& p, unsigned char* lds) {
    bf16_t* HID = (bf16_t*)(p.ws + WS_HID);
    const float* bias = (const float*)(p.ws + WS_MISC);
    const int lane = threadIdx.x & 63, wid = threadIdx.x >> 6, wr = wid >> 1, wc = wid & 1, fr = lane & 15, fq = lane >> 4;
    for (int id = vblock(); id < 256; id += gridDim.x) {
        const int kv = id >> 7, bg = (id >> 4) & 7, mt = (id >> 1) & 7, nt = id & 1;
        const bf16_t* A = (const bf16_t*)(p.ws + (kv ? WS_VC : WS_KC)) + (size_t)bg * SEQ * 64 + (size_t)mt * 128 * 1024;
        const bf16_t* B = (const bf16_t*)(p.ws + (kv ? WS_WV1_T : WS_WK1_T)) + (size_t)nt * 128 * 2048;
        f32x4 acc[4][4];
        gemm_tile3(ALoadPlain{A, (size_t)1024}, B, 2048, 32, acc, lds);
#pragma unroll
        for (int mi = 0; mi < 4; ++mi)
#pragma unroll
            for (int ni = 0; ni < 4; ++ni) {
                const int n = mt * 128 + wr * 64 + mi * 16 + fr, c = nt * 128 + wc * 64 + ni * 16 + fq * 4;
                const f32x4 bv = *(const f32x4*)(bias + kv * 256 + c);
                const f32x4 v = acc[mi][ni] + bv;
                *(u32x2*)(HID + (((size_t)kv * 8 + bg) * 1024 + n) * 256 + c) = (u32x2){pk2(gelu_tanh(v.x), gelu_tanh(v.y)), pk2(gelu_tanh(v.z), gelu_tanh(v.w))};
            }
    }
}
__device__ __forceinline__ void phase_nsa_cmp2(const Params& p, unsigned char* lds) {
    const bf16_t* HID = (const bf16_t*)(p.ws + WS_HID);
    const f32x2* ROPE = (const f32x2*)(p.ws + WS_ROPE);
    bf16_t* KCMP = (bf16_t*)(p.ws + WS_KCMP); bf16_t* VCMPT = (bf16_t*)(p.ws + WS_VCMPT);
    const int lane = threadIdx.x & 63, wid = threadIdx.x >> 6, wr = wid >> 1, wc = wid & 1, fr = lane & 15, fq = lane >> 4;
    for (int id = vblock(); id < 128; id += gridDim.x) {
        const int kv = id >> 6, mt = id & 63;
        const bf16_t* A = HID + ((size_t)kv * 8192 + (size_t)mt * 128) * 256;
        const bf16_t* B = (const bf16_t*)(p.ws + (kv ? WS_WV2_T : WS_WK2_T));
        f32x4 acc[4][4];
        gemm_tile3(ALoadPlain{A, (size_t)256}, B, 256, 4, acc, lds);
        if (wc == 1) continue;
#pragma unroll
        for (int mi = 0; mi < 4; ++mi) {
            const int R = mt * 128 + wr * 64 + mi * 16 + fr, bg = R >> 10, n = R & 1023;
            if (kv == 0) {
                int pos = n * 16 + 31; pos = pos > SEQ - 1 ? SEQ - 1 : pos;
#pragma unroll
                for (int ni = 0; ni < 2; ++ni) {
                    const f32x4* rp = (const f32x4*)(ROPE + (size_t)pos * 32 + ni * 16 + fq * 4);
                    const f32x4 r0 = rp[0], r1 = rp[1];
                    const f32x4 x1 = acc[mi][ni], x2 = acc[mi][ni + 2];
                    acc[mi][ni] = (f32x4){x1.x * r0.x - x2.x * r0.y, x1.y * r0.z - x2.y * r0.w, x1.z * r1.x - x2.z * r1.y, x1.w * r1.z - x2.w * r1.w};
                    acc[mi][ni + 2] = (f32x4){x1.x * r0.y + x2.x * r0.x, x1.y * r0.w + x2.y * r0.z, x1.z * r1.y + x2.z * r1.x, x1.w * r1.w + x2.w * r1.z};
                }
#pragma unroll
                for (int ni = 0; ni < 4; ++ni) {
                    const f32x4 v = acc[mi][ni];
                    const size_t idx = (size_t)bg * 1024 * 64 + (size_t)(n >> 5) * 2048 + ((((n >> 4) & 1) * 2 + (ni >> 1)) * 16 + (n & 15)) * 32 + ((ni & 1) * 2 + (fq >> 1)) * 8 + (fq & 1) * 4;
                    *(u32x2*)(KCMP + idx) = (u32x2){pk2(v.x, v.y), pk2(v.z, v.w)};
                }
            } else {
#pragma unroll
                for (int ni = 0; ni < 4; ++ni) {
                    const f32x4 v = acc[mi][ni];
                    const int key = n & 31;
                    bf16_t* o = VCMPT + (size_t)bg * 1024 * 64 + (size_t)(n >> 5) * 2048 + ((ni * 2 + (key >> 4)) * 16 + fq * 4) * 16 + ((key >> 2) & 3) * 4 + (key & 3);
                    o[0] = (bf16_t)f2bf(v.x); o[16] = (bf16_t)f2bf(v.y); o[32] = (bf16_t)f2bf(v.z); o[48] = (bf16_t)f2bf(v.w);
                }
            }
        }
    }
}
__device__ __forceinline__ void phase_nsa_wo(const Params& p, unsigned char* lds, bool dry) {
    const bf16_t* O = (const bf16_t*)(p.ws + WS_O); const bf16_t* WT = (const bf16_t*)(p.ws + WS_WO_T);
    const float* MOD = (const float*)(p.ws + WS_MOD);
    float* X = p.out;
    const int lane = threadIdx.x & 63, wid = threadIdx.x >> 6, wr = wid >> 1, wc = wid & 1, fr = lane & 15, fq = lane >> 4;
    for (int id = vblock(); id < 256 * 8; id += gridDim.x) {
        const int mt = id >> 3, nt = id & 7;
        f32x4 acc[4][4];
        gemm_tile3(ALoadPlain{O + (size_t)mt * 128 * D, (size_t)D}, WT + (size_t)nt * 128 * D, D, 16, acc, lds);
        const int b = (mt * 128) / SEQ;
#pragma unroll
        for (int mi = 0; mi < 4; ++mi)
#pragma unroll
            for (int ni = 0; ni < 4; ++ni) {
                const int t = mt * 128 + wr * 64 + mi * 16 + fr, c = nt * 128 + wc * 64 + ni * 16 + fq * 4;
                const f32x4 g1 = *(const f32x4*)(MOD + (size_t)(1 * 2 + b) * 6144 + 2048 + c);
                float* xp = X + (size_t)t * D + c;
                const f32x4 x = *(const f32x4*)xp; const f32x4 v = acc[mi][ni];
                if (!dry) *(f32x4*)xp = (f32x4){x.x + g1.x * v.x, x.y + g1.y * v.y, x.z + g1.z * v.z, x.w + g1.w * v.w};
            }
    }
}
__device__ __forceinline__ bf16x8 pack8(const f32x4 a, const f32x4 b) {
    u32x4 w; w.x = pk2(a.x, a.y); w.y = pk2(a.z, a.w); w.z = pk2(b.x, b.y); w.w = pk2(b.z, b.w);
    return __builtin_bit_cast(bf16x8, w);
}
__device__ __forceinline__ bf16x8 ldv8(const bf16_t* plo, const bf16_t* phi) {
    const u32x2 lo = *(const u32x2*)plo, hi = *(const u32x2*)phi;
    u32x4 w; w.x = lo.x; w.y = lo.y; w.z = hi.x; w.w = hi.y;
    return __builtin_bit_cast(bf16x8, w);
}
__device__ __forceinline__ float red4(float v) { v += __shfl_xor(v, 16); v += __shfl_xor(v, 32); return v; }
__device__ __forceinline__ float max4(float v) { v = fmaxf(v, __shfl_xor(v, 16)); v = fmaxf(v, __shfl_xor(v, 32)); return v; }
#define NEGBIG (-1.0e30f)

__device__ __forceinline__ void phase_nsa_attn(const Params& p, unsigned char* lds, const int rep_cmp, const int rep_win, const int rep_sel) {
    const int lane = threadIdx.x & 63, wave = threadIdx.x >> 6, fr = lane & 15, fq = lane >> 4;
    unsigned char* WL = lds + wave * 18432;
    float* IMP = (float*)WL;
    int* SEL = (int*)(WL + 17408);
    const bf16_t* Q = (const bf16_t*)(p.ws + WS_Q);
    const bf16_t* KCMP = (const bf16_t*)(p.ws + WS_KCMP); const bf16_t* VCMPT = (const bf16_t*)(p.ws + WS_VCMPT);
    const bf16_t* KW = (const bf16_t*)(p.ws + WS_KW); const bf16_t* VWT = (const bf16_t*)(p.ws + WS_VWT);
    const float* NGT = (const float*)(p.ws + WS_NG);
    bf16_t* O = (bf16_t*)(p.ws + WS_O);
    const f32x4 z4 = (f32x4){0.f, 0.f, 0.f, 0.f};
    for (int bi = blockIdx.x; bi < 2048; bi += gridDim.x) {
        const int bg = bi & 7, quad = 255 - (bi >> 3), t0 = (quad * 4 + wave) * 16, b = bg >> 2, g = bg & 3;
        const int cur = t0 >> 6;
        const size_t tok = (size_t)b * SEQ + t0 + fr;
        const int tq = t0 + fr;
        bf16x8 qf[4][2];
#pragma unroll
        for (int r = 0; r < 4; ++r)
#pragma unroll
            for (int ks = 0; ks < 2; ++ks) qf[r][ks] = *(const bf16x8*)(Q + tok * 1024 + (g * 4 + r) * 64 + ks * 32 + fq * 8);
        f32x4 acc[4][4];
        for (int rep = 0; rep < rep_win; ++rep) {
            const bf16_t* kwb = KW + (size_t)bg * SEQ * 64; const bf16_t* vwb = VWT + (size_t)bg * SEQ * 64;
            float mw[4], lw[4];
#pragma unroll
            for (int r = 0; r < 4; ++r) { mw[r] = NEGBIG; lw[r] = 0.f;
#pragma unroll
                for (int df = 0; df < 4; ++df) acc[r][df] = z4; }
            int kmin = t0 - 511; kmin = kmin < 0 ? 0 : kmin; kmin &= ~31;
            bf16x8 nkf[2][2];
#define WIN_LOAD(kb_) do { _Pragma("unroll") for (int f = 0; f < 2; ++f) _Pragma("unroll") for (int ks = 0; ks < 2; ++ks) nkf[f][ks] = *(const bf16x8*)(kwb + (size_t)((kb_) >> 5) * 2048 + ((f * 2 + ks) * 16 + fr) * 32 + fq * 8); } while (0)
            WIN_LOAD(kmin);
            for (int kb = kmin; kb <= t0 + 15; kb += 32) {
                bf16x8 kf[2][2], vf[4];
#pragma unroll
                for (int f = 0; f < 2; ++f) { kf[f][0] = nkf[f][0]; kf[f][1] = nkf[f][1]; }
#pragma unroll
                for (int df = 0; df < 4; ++df) { const bf16_t* vp = vwb + (size_t)(kb >> 5) * 2048 + (df * 32 + fr) * 16 + fq * 4; vf[df] = ldv8(vp, vp + 256); }
                { const int kn = (kb + 32 <= t0 + 15) ? kb + 32 : kb; WIN_LOAD(kn); }
#pragma unroll
                for (int r = 0; r < 4; ++r) {
                    f32x4 st[2];
#pragma unroll
                    for (int f = 0; f < 2; ++f) {
                        st[f] = __builtin_amdgcn_mfma_f32_16x16x32_bf16(kf[f][0], qf[r][0], z4, 0, 0, 0);
                        st[f] = __builtin_amdgcn_mfma_f32_16x16x32_bf16(kf[f][1], qf[r][1], st[f], 0, 0, 0);
                    }
                    float mx = NEGBIG;
#pragma unroll
                    for (int f = 0; f < 2; ++f)
#pragma unroll
                        for (int e = 0; e < 4; ++e) { const int key = kb + f * 16 + fq * 4 + e; const bool ok = (key <= tq) && (key > tq - 512); if (ok) mx = fmaxf(mx, st[f][e]); }
                    float mn = mw[r], al = 1.0f;
                    if (__builtin_amdgcn_ballot_w64(mx > mw[r] + 8.0f) != 0ull) { mn = fmaxf(mw[r], max4(mx)); al = __expf(mw[r] - mn); }
                    float ps = 0.f;
#pragma unroll
                    for (int f = 0; f < 2; ++f)
#pragma unroll
                        for (int e = 0; e < 4; ++e) { const int key = kb + f * 16 + fq * 4 + e; const bool ok = (key <= tq) && (key > tq - 512); const float pv = ok ? __expf(st[f][e] - mn) : 0.f; st[f][e] = pv; ps += pv; }
                    lw[r] = lw[r] * al + ps; mw[r] = mn;
                    const bf16x8 pf = pack8(st[0], st[1]);
#pragma unroll
                    for (int df = 0; df < 4; ++df) { acc[r][df] = acc[r][df] * al; acc[r][df] = __builtin_amdgcn_mfma_f32_16x16x32_bf16(vf[df], pf, acc[r][df], 0, 0, 0); }
                    __builtin_amdgcn_sched_barrier(0);
                }
            }
#pragma unroll
            for (int r = 0; r < 4; ++r) {
                const float l = red4(lw[r]); const float sc = NGT[tok * 48 + (g * 4 + r) * 3 + 2] / l;
#pragma unroll
                for (int df = 0; df < 4; ++df) acc[r][df] = acc[r][df] * sc;
            }
#undef WIN_LOAD
        }
        const int nmax_tile = (t0 >> 4) - 1, nmax_lane = (t0 >> 4) - 2 + (fr == 15 ? 1 : 0);
        const bf16_t* kcb = KCMP + (size_t)bg * 1024 * 64; const bf16_t* vcb = VCMPT + (size_t)bg * 64 * 1024;
        for (int rep = 0; rep < rep_cmp; ++rep) {
            const bool dry = (rep + 1 < rep_cmp);
            float mc[4], lc[4], invl[4];
#pragma unroll
            for (int r = 0; r < 4; ++r) { mc[r] = NEGBIG; lc[r] = 0.f; }
            bf16x8 nkc[2][2], nvc[4];
#define CMPK_LOAD(nb_) do { _Pragma("unroll") for (int f = 0; f < 2; ++f) _Pragma("unroll") for (int ks = 0; ks < 2; ++ks) nkc[f][ks] = *(const bf16x8*)(kcb + (size_t)((nb_) >> 5) * 2048 + ((f * 2 + ks) * 16 + fr) * 32 + fq * 8); } while (0)
#define CMPV_LOAD(nb_) do { _Pragma("unroll") for (int df = 0; df < 4; ++df) { const bf16_t* vp = vcb + (size_t)((nb_) >> 5) * 2048 + (df * 32 + fr) * 16 + fq * 4; nvc[df] = ldv8(vp, vp + 256); } } while (0)
            CMPK_LOAD(0);
            for (int nb = 0; nb <= nmax_tile; nb += 32) {
                bf16x8 kf[2][2];
#pragma unroll
                for (int f = 0; f < 2; ++f) { kf[f][0] = nkc[f][0]; kf[f][1] = nkc[f][1]; }
                { const int nn = (nb + 32 <= nmax_tile) ? nb + 32 : 0; CMPK_LOAD(nn); }
#pragma unroll
                for (int r = 0; r < 4; ++r) {
                    f32x4 st[2];
#pragma unroll
                    for (int f = 0; f < 2; ++f) {
                        st[f] = __builtin_amdgcn_mfma_f32_16x16x32_bf16(kf[f][0], qf[r][0], z4, 0, 0, 0);
                        st[f] = __builtin_amdgcn_mfma_f32_16x16x32_bf16(kf[f][1], qf[r][1], st[f], 0, 0, 0);
                    }
                    float mx = NEGBIG;
#pragma unroll
                    for (int f = 0; f < 2; ++f)
#pragma unroll
                        for (int e = 0; e < 4; ++e) { const int n = nb + f * 16 + fq * 4 + e; if (n <= nmax_lane) mx = fmaxf(mx, st[f][e]); }
                    float mn = mc[r];
                    if (__builtin_amdgcn_ballot_w64(mx > mc[r] + 8.0f) != 0ull) mn = fmaxf(mc[r], max4(mx));
                    float ps = 0.f;
#pragma unroll
                    for (int f = 0; f < 2; ++f)
#pragma unroll
                        for (int e = 0; e < 4; ++e) { const int n = nb + f * 16 + fq * 4 + e; if (n <= nmax_lane) ps += __expf(st[f][e] - mn); }
                    lc[r] = lc[r] * __expf(mc[r] - mn) + ps; mc[r] = mn;
                    __builtin_amdgcn_sched_barrier(0);
                }
            }
#pragma unroll
            for (int r = 0; r < 4; ++r) { const float l = red4(lc[r]); invl[r] = l > 0.f ? 1.0f / l : 0.f; }
            for (int i = lane; i < 16 * 260; i += 64) IMP[i] = 0.f;
            float carry = 0.f;
            float gc[4];
#pragma unroll
            for (int r = 0; r < 4; ++r) gc[r] = NGT[tok * 48 + (g * 4 + r) * 3];
            for (int nb = 0; nb <= nmax_tile; nb += 32) {
                bf16x8 kf[2][2], vf[4];
#pragma unroll
                for (int f = 0; f < 2; ++f) { kf[f][0] = nkc[f][0]; kf[f][1] = nkc[f][1]; }
                CMPV_LOAD(nb);
#pragma unroll
                for (int df = 0; df < 4; ++df) vf[df] = nvc[df];
                { const int nn = (nb + 32 <= nmax_tile) ? nb + 32 : nb; CMPK_LOAD(nn); }
                f32x4 pg[2] = {z4, z4};
#pragma unroll
                for (int r = 0; r < 4; ++r) {
                    f32x4 st[2];
#pragma unroll
                    for (int f = 0; f < 2; ++f) {
                        st[f] = __builtin_amdgcn_mfma_f32_16x16x32_bf16(kf[f][0], qf[r][0], z4, 0, 0, 0);
                        st[f] = __builtin_amdgcn_mfma_f32_16x16x32_bf16(kf[f][1], qf[r][1], st[f], 0, 0, 0);
#pragma unroll
                        for (int e = 0; e < 4; ++e) { const int n = nb + f * 16 + fq * 4 + e; st[f][e] = (n <= nmax_lane) ? __expf(st[f][e] - mc[r]) * invl[r] : 0.f; }
                        pg[f] += st[f];
                    }
                    const float gg = dry ? 0.f : gc[r];
                    const bf16x8 pf = pack8(st[0] * gg, st[1] * gg);
#pragma unroll
                    for (int df = 0; df < 4; ++df) acc[r][df] = __builtin_amdgcn_mfma_f32_16x16x32_bf16(vf[df], pf, acc[r][df], 0, 0, 0);
                    __builtin_amdgcn_sched_barrier(0);
                }
                const int src = (lane - 16) & 63;
                const float s0 = __shfl(pg[0].w, src), s1 = __shfl(pg[1].w, src), sc = __shfl(carry, src);
                const float prev0 = fq > 0 ? s0 : sc, prev1 = fq > 0 ? s1 : s0;
                const float imp0 = (pg[0].x + pg[0].y) + (pg[0].z + pg[0].w) + prev0;
                const float imp1 = (pg[1].x + pg[1].y) + (pg[1].z + pg[1].w) + prev1;
                const int jb = (nb >> 2) + fq;
                IMP[fr * 260 + jb] = imp0; IMP[fr * 260 + jb + 4] = imp1;
                carry = pg[1].w;
            }
#undef CMPK_LOAD
#undef CMPV_LOAD
        }
        {
            const int nf = cur >= 2 ? 3 : cur + 1;
            if (fq == 0) {
                SEL[fr * 16 + 0] = 0;
                if (cur == 1) SEL[fr * 16 + 1] = 1;
                if (cur >= 2) { SEL[fr * 16 + 1] = cur - 1; SEL[fr * 16 + 2] = cur; }
            }
            const int ncand = cur >= 3 ? cur - 2 : 0, extra = 16 - nf;
            if (ncand <= extra) {
                if (fq == 0) { for (int k = 0; k < extra; ++k) SEL[fr * 16 + nf + k] = (k < ncand) ? 1 + k : -1; }
            } else {
                for (int rnd = 0; rnd < extra; ++rnd) {
                    float bv = -1.0f; int bj = 1 << 20;
                    for (int jb = 1 + fq; jb <= cur - 2; jb += 4) { const float v = IMP[fr * 260 + jb]; if (v > bv) { bv = v; bj = jb; } }
#pragma unroll
                    for (int o = 16; o <= 32; o <<= 1) {
                        const float ov = __shfl_xor(bv, o); const int oj = __shfl_xor(bj, o);
                        if (ov > bv || (ov == bv && oj < bj)) { bv = ov; bj = oj; }
                    }
                    if (fq == 0) SEL[fr * 16 + nf + rnd] = bj;
                    if (((bj - 1) & 3) == fq) IMP[fr * 260 + bj] = -2.0f;
                }
            }
        }
#pragma unroll
        for (int r = 0; r < 4; ++r)
#pragma unroll
            for (int df = 0; df < 4; ++df) {
                const f32x4 v = acc[r][df];
                *(u32x2*)(O + tok * 1024 + (g * 4 + r) * 64 + df * 16 + fq * 4) = (u32x2){pk2(v.x, v.y), pk2(v.z, v.w)};
            }
        asm volatile("s_waitcnt vmcnt(0)" ::: "memory");
        unsigned selp[4];
        {
            const u32x4* sp = (const u32x4*)(SEL + fr * 16);
#pragma unroll
            for (int q = 0; q < 4; ++q) { const u32x4 w = sp[q]; selp[q] = (w.x & 255u) | ((w.y & 255u) << 8) | ((w.z & 255u) << 16) | ((w.w & 255u) << 24); }
        }
        for (int rep = 0; rep < rep_sel; ++rep) {
            const bool dry = (rep + 1 < rep_sel);
            const unsigned char* k8b = p.ws + WS_KS + (size_t)bg * SEQ * 64; const unsigned char* v8b = p.ws + WS_VST + (size_t)bg * 256 * 4096;
            const float* skb = (const float*)(p.ws + WS_KS + 12 * MiB) + (size_t)bg * 256; const float* svb = (const float*)(p.ws + WS_VST + 12 * MiB) + (size_t)bg * 256;
            const unsigned char* Q8 = p.ws + WS_Q8; const float* SQ8 = (const float*)(p.ws + WS_Q8 + 32 * MiB);
            const int nv = cur + 1 < 16 ? cur + 1 : 16, npair = (nv + 1) >> 1, total = 16 * npair;
            const int lrow = lane >> 2, lch = lane & 3;
            const int woff = lrow * 72 + lch * 16;
            const int rr = fr & 3;
            u32x4 sk[2][4], sv[2][4]; float ssk[2], ssv[2];
            int jbn[2];
#define SEL_GET(tokI, slotK) ((int)(((unsigned)__builtin_amdgcn_readlane((int)(((slotK) >> 2) == 0 ? selp[0] : ((slotK) >> 2) == 1 ? selp[1] : ((slotK) >> 2) == 2 ? selp[2] : selp[3]), (tokI)) >> (((slotK) & 3) * 8)) & 255u))
#define SEL_ISSUE(tokI, pairP) do { \
                const int k0_ = 2 * (pairP), k1_ = (2 * (pairP) + 1 < nv) ? 2 * (pairP) + 1 : k0_; \
                jbn[0] = __builtin_amdgcn_readfirstlane(SEL_GET(tokI, k0_)); jbn[1] = __builtin_amdgcn_readfirstlane(SEL_GET(tokI, k1_)); \
                _Pragma("unroll") for (int u = 0; u < 2; ++u) { \
                    const unsigned char* kb_ = k8b + (size_t)jbn[u] * 4096; const unsigned char* vb_ = v8b + (size_t)jbn[u] * 4096; \
                    _Pragma("unroll") for (int j = 0; j < 4; ++j) { sk[u][j] = *(const u32x4*)(kb_ + j * 1024 + lane * 16); sv[u][j] = *(const u32x4*)(vb_ + j * 1024 + lane * 16); } \
                    ssk[u] = skb[jbn[u]]; ssv[u] = svb[jbn[u]]; } } while (0)
            SEL_ISSUE(0, 0);
            long qs8[2] = {0, 0};
            float sq = 0.f, ms = NEGBIG, ls = 0.f;
            f32x4 os[4] = {z4, z4, z4, z4};
            u32x2 oprev[4] = {(u32x2){0u, 0u}, (u32x2){0u, 0u}, (u32x2){0u, 0u}, (u32x2){0u, 0u}};
            int i = 0, pp = 0;
            for (int v = 0; v < total; ++v) {
                const int jb0 = jbn[0], jb1 = jbn[1];
                const bool second_valid = (2 * pp + 1 < nv);
                const float ck0 = ssk[0], ck1 = ssk[1], cv0 = ssv[0], cv1 = ssv[1];
#pragma unroll
                for (int u = 0; u < 2; ++u)
#pragma unroll
                    for (int j = 0; j < 4; ++j) {
                        unsigned char* kd = WL + u * 9216 + woff + j * 1152; unsigned char* vd = kd + 4608;
                        *(u32x2*)kd = (u32x2){sk[u][j].x, sk[u][j].y}; *(u32x2*)(kd + 8) = (u32x2){sk[u][j].z, sk[u][j].w};
                        *(u32x2*)vd = (u32x2){sv[u][j].x, sv[u][j].y}; *(u32x2*)(vd + 8) = (u32x2){sv[u][j].z, sv[u][j].w};
                    }
                if (v + 1 < total) {
                    int p2 = pp + 1, i2 = i; if (p2 == npair) { p2 = 0; i2 = i + 1; }
                    SEL_ISSUE(i2, p2);
                }
                __builtin_amdgcn_sched_barrier(0);
                const int ti = t0 + i;
                if (pp == 0) {
                    const size_t tk = (size_t)b * SEQ + ti;
#pragma unroll
                    for (int ks = 0; ks < 2; ++ks) qs8[ks] = *(const long*)(Q8 + tk * 1024 + (g * 4 + rr) * 64 + ks * 32 + fq * 8);
                    sq = SQ8[tk * 16 + g * 4 + rr] * 1.4426950408889634f;
                    ms = NEGBIG; ls = 0.f;
#pragma unroll
                    for (int df = 0; df < 4; ++df) { os[df] = z4; oprev[df] = *(const u32x2*)(O + tk * 1024 + (g * 4 + rr) * 64 + df * 16 + fq * 4); }
                }
                f32x4 st[2][4];
#pragma unroll
                for (int u = 0; u < 2; ++u)
#pragma unroll
                    for (int f = 0; f < 4; ++f) {
                        const unsigned char* kp = WL + u * 9216 + (32 * (f >> 1) + 8 * (fr >> 2) + 4 * (f & 1) + (fr & 3)) * 72 + fq * 8;
                        const long k0 = *(const long*)kp, k1 = *(const long*)(kp + 32);
                        st[u][f] = __builtin_amdgcn_mfma_f32_16x16x32_fp8_fp8(k0, qs8[0], z4, 0, 0, 0);
                        st[u][f] = __builtin_amdgcn_mfma_f32_16x16x32_fp8_fp8(k1, qs8[1], st[u][f], 0, 0, 0);
                    }
                const float c0_ = sq * ck0, c1_ = sq * ck1;
                if (jb0 == cur || jb1 == cur || !second_valid) {
#pragma unroll
                    for (int u = 0; u < 2; ++u) {
                        const int jbu = u ? jb1 : jb0;
                        const bool allbad = (u == 1) && !second_valid;
#pragma unroll
                        for (int f = 0; f < 4; ++f)
#pragma unroll
                            for (int e = 0; e < 4; ++e) { const int key = jbu * 64 + 32 * (f >> 1) + 8 * fq + 4 * (f & 1) + e; if (allbad || key > ti) st[u][f][e] = NEGBIG; }
                    }
                }
                float mx0 = NEGBIG, mx1 = NEGBIG;
#pragma unroll
                for (int f = 0; f < 4; ++f) { mx0 = fmaxf(mx0, fmaxf(fmaxf(st[0][f].x, st[0][f].y), fmaxf(st[0][f].z, st[0][f].w))); mx1 = fmaxf(mx1, fmaxf(fmaxf(st[1][f].x, st[1][f].y), fmaxf(st[1][f].z, st[1][f].w))); }
                const float mxl = fmaxf(mx0 > -1.0e29f ? mx0 * c0_ : NEGBIG, mx1 > -1.0e29f ? mx1 * c1_ : NEGBIG);
                float mn = ms, al = 1.0f;
                if (__builtin_amdgcn_ballot_w64(mxl > ms + 4.0f) != 0ull) {
                    mn = fmaxf(ms, max4(mxl));
                    al = __builtin_amdgcn_exp2f(ms - mn);
                }
                const float off = 4.0f - mn;
                float ps = 0.f;
                long pfw[2][2];
#pragma unroll
                for (int u = 0; u < 2; ++u) {
                    const float cu = u ? c1_ : c0_;
#pragma unroll
                    for (int f = 0; f < 4; ++f)
#pragma unroll
                        for (int e = 0; e < 4; ++e) { const float pv = __builtin_amdgcn_exp2f(st[u][f][e] * cu + off); st[u][f][e] = pv; ps += pv; }
#pragma unroll
                    for (int s = 0; s < 2; ++s) {
                        int w0 = 0, w1 = 0;
                        w0 = __builtin_amdgcn_cvt_pk_fp8_f32(st[u][2 * s].x, st[u][2 * s].y, w0, false); w0 = __builtin_amdgcn_cvt_pk_fp8_f32(st[u][2 * s].z, st[u][2 * s].w, w0, true);
                        w1 = __builtin_amdgcn_cvt_pk_fp8_f32(st[u][2 * s + 1].x, st[u][2 * s + 1].y, w1, false); w1 = __builtin_amdgcn_cvt_pk_fp8_f32(st[u][2 * s + 1].z, st[u][2 * s + 1].w, w1, true);
                        pfw[u][s] = (long)(((unsigned long long)(unsigned)w1 << 32) | (unsigned long long)(unsigned)w0);
                    }
                }
                ls = ls * al + ps; ms = mn;
#pragma unroll
                for (int df = 0; df < 4; ++df) os[df] = os[df] * al;
#pragma unroll
                for (int u = 0; u < 2; ++u) {
                    f32x4 pvacc[4] = {z4, z4, z4, z4};
#pragma unroll
                    for (int s = 0; s < 2; ++s) {
#pragma unroll
                        for (int df = 0; df < 4; ++df) {
                            const long vf = *(const long*)(WL + u * 9216 + 4608 + (df * 16 + fr) * 72 + 32 * s + 8 * fq);
                            pvacc[df] = __builtin_amdgcn_mfma_f32_16x16x32_fp8_fp8(vf, pfw[u][s], pvacc[df], 0, 0, 0);
                        }
                    }
                    const float cvu = u ? cv1 : cv0;
#pragma unroll
                    for (int df = 0; df < 4; ++df) os[df] = os[df] + pvacc[df] * cvu;
                    __builtin_amdgcn_sched_barrier(0);
                }
                if (pp == npair - 1) {
                    const float l = red4(ls);
                    const float gsv = NGT[((size_t)b * SEQ + ti) * 48 + (g * 4 + rr) * 3 + 1];
                    const float sc = gsv / l;
                    if (fr < 4 && !dry) {
                        bf16_t* op = O + ((size_t)b * SEQ + ti) * 1024 + (g * 4 + fr) * 64 + fq * 4;
#pragma unroll
                        for (int df = 0; df < 4; ++df) {
                            const f32x4 val = os[df] * sc; const u32x2 c = oprev[df];
                            *(u32x2*)(op + df * 16) = (u32x2){pk2(bflo(c.x) + val.x, bfhi(c.x) + val.y), pk2(bflo(c.y) + val.z, bfhi(c.y) + val.w)};
                        }
                    }
                }
                ++pp; if (pp == npair) { pp = 0; ++i; }
            }
#undef SEL_GET
#undef SEL_ISSUE
        }
    }
}
constexpr int NPHASES = 23;
#ifndef PROBE_PHASE
#define PROBE_PHASE (-1)
#endif
#ifndef ATT_REP_CMP
#define ATT_REP_CMP 1
#endif
#ifndef ATT_REP_WIN
#define ATT_REP_WIN 1
#endif
#ifndef ATT_REP_SEL
#define ATT_REP_SEL 1
#endif
#ifndef TS_PHASE
#define TS_PHASE (-1)
#endif
#ifndef TS_MULT
#define TS_MULT 4
#endif
#ifndef PROBE_REPS
#define PROBE_REPS 1
#endif
__global__ void __launch_bounds__(NTHREADS, 2) mega(Params p) {
    __shared__ __attribute__((aligned(1024))) unsigned char lds[LDS_BYTES + 16];
    unsigned* bar_st = (unsigned*)(lds + LDS_BYTES);
    cg::grid_group grid = cg::this_grid();
    const float* MOD = (const float*)(p.ws + WS_MOD);
    bf16_t* HM = (bf16_t*)(p.ws + WS_HM);
    if (threadIdx.x < 4) bar_st[threadIdx.x] = 0u;
    __syncthreads();
    XcdBarrier bar = xcd_barrier_post((unsigned*)(p.ws + WS_CTL), (volatile LAS unsigned*)bar_st);
    const int lo = p.ph_lo, hi = p.ph_hi;
    const bool dry0 = (p.ph_hi < 0);
    const int opq = (p.ph_hi < 0) ? 1 : 0;
    unsigned long long ts_a = 0ull, ts_b = 0ull;
#define PHASE(k, call, drycall) if (lo <= (k) && (k) < hi) { \
        if (TS_PHASE == (k)) ts_a = __builtin_amdgcn_s_memrealtime(); \
        if (PROBE_PHASE == (k)) { for (int rep = 0; rep < PROBE_REPS; ++rep) { const bool dry = !dry0; drycall; __syncthreads(); } } \
        { const bool dry = dry0; call; } \
        if ((k) + 1 < hi) { if ((k) == 0) grid.sync(); else xcd_barrier(bar); } \
        if (TS_PHASE == (k)) ts_b = __builtin_amdgcn_s_memrealtime(); }
    PHASE(0, phase_prep(p, (float*)lds, 0), phase_prep(p, (float*)lds, 0))
    PHASE(1, phase_norm(p, p.in[0], p.in[2], MOD + 0, MOD + 1024, HM), phase_norm(p, p.in[0], p.in[2], MOD + 0, MOD + 1024, HM))
    PHASE(2, phase_s5_win(p, lds), phase_s5_win(p, lds))
    PHASE(3, phase_s5_a(p, lds), phase_s5_a(p, lds))
    PHASE(4, (phase_s5_scan(p), phase_prep(p, (float*)lds, 1)), (phase_s5_scan(p), phase_prep(p, (float*)lds, 1)))
    PHASE(5, phase_s5_b(p, lds), phase_s5_b(p, lds))
    PHASE(6, phase_s5_glu(p, lds), phase_s5_glu(p, lds))
    PHASE(7, phase_norm(p, p.out, p.in[3], MOD + 3072, MOD + 4096, HM), phase_norm(p, p.out, p.in[3], MOD + 3072, MOD + 4096, HM))
    PHASE(8, phase_peer_wq(p, 0, lds), phase_peer_wq(p, 0, lds))
    PHASE(9, phase_peer_topk(p, 0, lds), phase_peer_topk(p, 0, lds))
    PHASE(10, phase_peer_combine(p, lds), phase_peer_combine(p, lds))
    PHASE(11, phase_peer_apply(p, 0, lds, dry), phase_peer_apply(p, 0, lds, dry))
    PHASE(12, phase_tab1(p), phase_tab1(p))
    PHASE(13, phase_nsa_proj(p, lds), phase_nsa_proj(p, lds))
    PHASE(14, phase_nsa_cmp1(p, lds), phase_nsa_cmp1(p, lds))
    PHASE(15, phase_nsa_cmp2(p, lds), phase_nsa_cmp2(p, lds))
    PHASE(16, phase_nsa_attn(p, lds, ATT_REP_CMP + opq, ATT_REP_WIN + opq, ATT_REP_SEL + opq), phase_nsa_attn(p, lds, 1 + opq, 1 + opq, 1 + opq))
    PHASE(17, phase_nsa_wo(p, lds, dry), phase_nsa_wo(p, lds, dry))
    PHASE(18, phase_norm(p, p.out, p.in[3] + D, MOD + 2 * 6144 + 3072, MOD + 2 * 6144 + 4096, HM), phase_norm(p, p.out, p.in[3] + D, MOD + 2 * 6144 + 3072, MOD + 2 * 6144 + 4096, HM))
    PHASE(19, phase_peer_wq(p, 1, lds), phase_peer_wq(p, 1, lds))
    PHASE(20, phase_peer_topk(p, 1, lds), phase_peer_topk(p, 1, lds))
    PHASE(21, phase_peer_combine(p, lds), phase_peer_combine(p, lds))
    PHASE(22, phase_peer_apply(p, 1, lds, dry), phase_peer_apply(p, 1, lds, dry))
#undef PHASE
    if (TS_PHASE >= 0 && blockIdx.x == 0 && threadIdx.x == 0) {
        const unsigned long long t0 = __builtin_amdgcn_s_memrealtime(), want = (ts_b - ts_a) * TS_MULT;
        while (__builtin_amdgcn_s_memrealtime() - t0 < want) __builtin_amdgcn_s_sleep(8);
    }
}

extern "C" void kernel_launch(void* const* d_in, const int* in_sizes, int n_in, void* d_out, int out_size, void* d_ws, size_t ws_size, hipStream_t stream) {
    static int grid_blocks = 0;
    if (!grid_blocks) {
        int dev = 0, cus = 0, per_cu = 0;
        hipGetDevice(&dev);
        hipDeviceGetAttribute(&cus, hipDeviceAttributeMultiprocessorCount, dev);
        hipOccupancyMaxActiveBlocksPerMultiprocessor(&per_cu, mega, NTHREADS, 0);
        if (per_cu > 2) per_cu = 2;
        if (per_cu < 1) per_cu = 1;
        grid_blocks = cus * per_cu;
        if (ws_size < WS_END) fprintf(stderr, "kernel_launch: workspace too small: %zu < %zu\n", ws_size, (size_t)WS_END);
        if (n_in != 29) fprintf(stderr, "kernel_launch: expected 29 inputs, got %d\n", n_in);
    }
    hipMemsetAsync((unsigned char*)d_ws + WS_CTL, 0, 16384, stream);
    Params p{};
    for (int i = 0; i < 29; ++i) p.in[i] = (const float*)d_in[i];
    p.out = (float*)d_out; p.ws = (unsigned char*)d_ws;
#if SINGLE_LAUNCH
    p.ph_lo = 0; p.ph_hi = NPHASES;
    void* args[] = {&p};
    hipError_t e = hipLaunchCooperativeKernel((void*)mega, dim3(grid_blocks), dim3(NTHREADS), args, 0, stream);
    if (e != hipSuccess) fprintf(stderr, "cooperative launch failed: %s (grid %d)\n", hipGetErrorString(e), grid_blocks);
#else
    for (int ph = 0; ph < NPHASES; ++ph) {
        p.ph_lo = ph; p.ph_hi = ph + 1;
        hipLaunchKernelGGL(mega, dim3(grid_blocks), dim3(NTHREADS), 0, stream, p);
    }
#endif
}
```

```cpp
#include <hip/hip_runtime.h>
#include <hip/hip_cooperative_groups.h>
#include <cstdio>
#include <cstdint>
namespace cg = cooperative_groups;

#ifndef SINGLE_LAUNCH
#define SINGLE_LAUNCH 1
#endif

typedef unsigned short bf16_t;
typedef short bf16x8 __attribute__((ext_vector_type(8)));
typedef float f32x4 __attribute__((ext_vector_type(4)));
typedef float f32x2 __attribute__((ext_vector_type(2)));
typedef unsigned u32x4 __attribute__((ext_vector_type(4)));
typedef unsigned u32x2 __attribute__((ext_vector_type(2)));
typedef __bf16 bf16x2_t __attribute__((ext_vector_type(2)));

constexpr int D = 1024, BATCH = 2, SEQ = 16384, T = BATCH * SEQ;
constexpr int NTHREADS = 256;
constexpr float RMS_EPS = 1e-6f;
constexpr int S5G = 64, S5P = 64, S5L = 32, S5NCH = T / S5L  , S5CPB = SEQ / S5L  ;
constexpr int NH = 16, HD = 64, NG = 4, NPROJ = 2608, NPROJ_PAD = 2688, NC = 1023, NSB = 256;
constexpr int PH = 8, PK = 16, PNK = 128, PE = 16384;

constexpr size_t MiB = 1ull << 20;
constexpr size_t WS_CTL = 0;
constexpr size_t WS_MOD = 1 * MiB;
constexpr size_t WS_WIN_T = 2 * MiB;
constexpr size_t WS_WGLU_T = 4 * MiB;
constexpr size_t WS_WPROJ_T = 8 * MiB;
constexpr size_t WS_WK1_T = 14 * MiB;
constexpr size_t WS_WV1_T = 15 * MiB;
constexpr size_t WS_WK2_T = 16 * MiB;
constexpr size_t WS_WV2_T = 16 * MiB + 512 * 1024;
constexpr size_t WS_WO_T = 17 * MiB;
constexpr size_t WS_WQ_T = 19 * MiB;
constexpr size_t WS_SUBK = 27 * MiB;
constexpr size_t WS_ROPE = 28 * MiB;
constexpr size_t WS_MISC = 32 * MiB;
constexpr size_t WS_TW = 33 * MiB;
constexpr size_t WS_VG = 73 * MiB;
constexpr size_t WS_PU = 82 * MiB;
constexpr size_t WS_PV = 114 * MiB;
constexpr size_t WS_HM = 146 * MiB;
constexpr size_t WS_C = 210 * MiB;
constexpr size_t WS_UG = WS_C;
constexpr size_t WS_YI = WS_C + 64 * MiB;
constexpr size_t WS_WST = WS_C + 128 * MiB;
constexpr size_t WS_SST = WS_C + 160 * MiB;
constexpr size_t WS_YG = WS_C + 176 * MiB;
constexpr size_t WS_QK = WS_C;
constexpr size_t WS_TOPS = WS_C + 128 * MiB;
constexpr size_t WS_TOPI = WS_C + 160 * MiB;
constexpr size_t WS_EXP = WS_C + 192 * MiB;
constexpr size_t WS_GATE = WS_C + 208 * MiB;
constexpr size_t WS_ACT = WS_C + 224 * MiB;
constexpr size_t WS_Q = WS_C;
constexpr size_t WS_KC = WS_C + 64 * MiB;
constexpr size_t WS_VC = WS_C + 81 * MiB;
constexpr size_t WS_KS = WS_C + 98 * MiB;
constexpr size_t WS_VST = WS_C + 114 * MiB;
constexpr size_t WS_KW = WS_C + 130 * MiB;
constexpr size_t WS_VWT = WS_C + 146 * MiB;
constexpr size_t WS_NG = WS_C + 162 * MiB;
constexpr size_t WS_KCMP = WS_C + 170 * MiB;
constexpr size_t WS_VCMPT = WS_C + 171 * MiB;
constexpr size_t WS_HID = WS_C + 172 * MiB;
constexpr size_t WS_O = WS_C + 182 * MiB;
constexpr size_t WS_Q8 = WS_C + 246 * MiB;
constexpr size_t WS_END = WS_C + 282 * MiB;

constexpr int LDS_BYTES = 73728;

struct Params {
    const float* in[29];
    float* out;
    unsigned char* ws;
    int ph_lo, ph_hi;
};

__device__ __forceinline__ unsigned f2bf(float f) { unsigned u = __builtin_bit_cast(unsigned, f); return (u + 0x7fffu + ((u >> 16) & 1u)) >> 16; }
__device__ __forceinline__ unsigned pk2(float lo, float hi) { return f2bf(lo) | (f2bf(hi) << 16); }
__device__ __forceinline__ float bf2f(unsigned h) { return __builtin_bit_cast(float, h << 16); }
__device__ __forceinline__ float bflo(unsigned w) { return __builtin_bit_cast(float, w << 16); }
__device__ __forceinline__ float bfhi(unsigned w) { return __builtin_bit_cast(float, w & 0xffff0000u); }
__device__ __forceinline__ float gelu_tanh(float x) {
    const float u = 0.7978845608028654f * (x + 0.044715f * x * x * x);
    const float e = __expf(2.0f * u);
    const float th = 1.0f - 2.0f / (e + 1.0f);
    return 0.5f * x * (1.0f + th);
}
__device__ __forceinline__ float sigmoidf_(float x) { return 1.0f / (1.0f + __expf(-x)); }
__device__ __forceinline__ float wave_sum(float v) {
#pragma unroll
    for (int o = 1; o < 64; o <<= 1) v += __shfl_xor(v, o);
    return v;
}
__device__ __forceinline__ float dot2bf(unsigned a, unsigned b, float acc) {
    return __builtin_amdgcn_fdot2_f32_bf16(__builtin_bit_cast(bf16x2_t, a), __builtin_bit_cast(bf16x2_t, b), acc, false);
}

#define LAS __attribute__((address_space(3)))
#define XB_TMO      128
#define XB_XCNT(j)  (256  + 64 * (j))
#define XB_XSUB(j)  (1280 + 64 * (j))
#define XB_XGEN(j)  (2304 + 64 * (j))
#define XB_TOP      3328
#define XB_TOPGEN   3392
#define XCD_BAR_WORDS 3456
#define XB_SPIN_CAP (1u << 24)

__device__ __forceinline__ unsigned xb_ld(unsigned* p)              { return __hip_atomic_load(p, __ATOMIC_RELAXED, __HIP_MEMORY_SCOPE_AGENT); }
__device__ __forceinline__ unsigned xb_add(unsigned* p, unsigned v) { return __hip_atomic_fetch_add(p, v, __ATOMIC_RELAXED, __HIP_MEMORY_SCOPE_AGENT); }
__device__ __forceinline__ unsigned xb_xcc_id() { return (unsigned)__builtin_amdgcn_s_getreg((3 << 11) | 20) & 0xFu; }
#define XB_SPIN(cond, bar) do { unsigned _sp = 0; while (cond) { __builtin_amdgcn_s_sleep(1); \
    if ((++_sp & 255u) == 0u) { if (xb_ld(&(bar)[XB_TMO])) break; if (_sp > XB_SPIN_CAP) { atomicAdd(&(bar)[XB_TMO], 1u); break; } } } } while (0)

struct XcdBarrier {
    unsigned* bar; unsigned x;
    volatile LAS unsigned* st;
};

__device__ __forceinline__ XcdBarrier xcd_barrier_post(unsigned* bar, volatile LAS unsigned* st) {
    XcdBarrier b; b.bar = bar; b.x = xb_xcc_id(); b.st = st;
    if (threadIdx.x == 0) (void)xb_add(&bar[XB_XCNT(b.x)], 1u);
    return b;
}
__device__ __forceinline__ void xcd_barrier_complete(unsigned* bar, unsigned x, unsigned& nloc, unsigned& nx) {
    const unsigned G = gridDim.x * gridDim.y * gridDim.z;
    unsigned sum, cnt, mine, sp = 0u;
    for (;;) {
        sum = 0u; cnt = 0u; mine = 0u;
#pragma unroll
        for (unsigned j = 0; j < 16; ++j) { const unsigned c = xb_ld(&bar[XB_XCNT(j)]); sum += c; cnt += (c > 0u) ? 1u : 0u; mine = (j == x) ? c : mine; }
        if (sum == G) break;
        __builtin_amdgcn_s_sleep(1);
        if ((++sp & 255u) == 0u) { if (xb_ld(&bar[XB_TMO])) break; if (sp > XB_SPIN_CAP) { atomicAdd(&bar[XB_TMO], 1u); break; } }
    }
    nloc = mine > 0u ? mine : 1u; nx = cnt > 0u ? cnt : 1u;
}

__device__ __forceinline__ void xcd_barrier(const XcdBarrier& b) {
    asm volatile("s_waitcnt vmcnt(0)" ::: "memory");
    __syncthreads();
    if (threadIdx.x == 0) {
        unsigned* bar = b.bar;
        __builtin_amdgcn_s_waitcnt(0);
        unsigned nloc = b.st[0], nx = b.st[1];
        if (nloc == 0u) { xcd_barrier_complete(bar, b.x, nloc, nx); b.st[0] = nloc; b.st[1] = nx; }
        const unsigned old = xb_add(&bar[XB_XSUB(b.x)], 1u);
        const unsigned gen = old / nloc;
        if (old + 1u == (gen + 1u) * nloc) {
            __builtin_amdgcn_fence(__ATOMIC_RELEASE, "agent");
            asm volatile("s_waitcnt vmcnt(0)" ::: "memory");
            const unsigned og = xb_add(&bar[XB_TOP], 1u);
            const unsigned tg = og / nx;
            if (og + 1u == (tg + 1u) * nx) xb_add(&bar[XB_TOPGEN], 1u);
            else XB_SPIN(xb_ld(&bar[XB_TOPGEN]) == tg, bar);
            __builtin_amdgcn_fence(__ATOMIC_ACQUIRE, "agent");
            xb_add(&bar[XB_XGEN(b.x)], 1u);
            asm volatile("s_waitcnt vmcnt(0)" ::: "memory");
        } else {
            XB_SPIN(xb_ld(&bar[XB_XGEN(b.x)]) == gen, bar);
            __builtin_amdgcn_fence(__ATOMIC_ACQUIRE, "agent");
            asm volatile("s_waitcnt vmcnt(0)" ::: "memory");
        }
    }
    __syncthreads();
}
__device__ __forceinline__ void prep_mod_item(const Params& p, int item, float* lds) {
    const int layer = item / 192, cg0 = (item % 192) * 32;
    const int tid = threadIdx.x, col = cg0 + (tid & 31), kg = tid >> 5;
    const float* W = p.in[4] + (size_t)layer * D * 6 * D + col;
    const float* c = p.in[1];
    float* cact = lds + 512;
#pragma unroll
    for (int i = 0; i < 8; ++i) { const int q = tid + 256 * i; const float v = c[q]; cact[q] = v * sigmoidf_(v); }
    __syncthreads();
    float a0 = 0.f, a1 = 0.f;
    for (int k0 = kg * 128; k0 < kg * 128 + 128; k0 += 16) {
        float w[16];
#pragma unroll
        for (int u = 0; u < 16; ++u) w[u] = W[(size_t)(k0 + u) * (6 * D)];
#pragma unroll
        for (int u = 0; u < 16; ++u) { a0 += w[u] * cact[k0 + u]; a1 += w[u] * cact[1024 + k0 + u]; }
    }
    lds[tid] = a0; lds[256 + tid] = a1;
    __syncthreads();
    if (tid < 64) {
        const int b = tid >> 5, cc = tid & 31;
        float s = 0.f;
#pragma unroll
        for (int g = 0; g < 8; ++g) s += lds[b * 256 + g * 32 + cc];
        float* MOD = (float*)(p.ws + WS_MOD);
        MOD[(size_t)(layer * 2 + b) * 6144 + cg0 + cc] = s + p.in[5][(size_t)layer * 6144 + cg0 + cc];
    }
    __syncthreads();
}

template <int MODE>
__device__ __forceinline__ void prep_transpose_item(const float* W, int K, int N, bf16_t* WT, int item, float* lds) {
    const int nbn = (N + 63) / 64, kb = item / nbn, nb = item % nbn, k0 = kb * 64, n0 = nb * 64;
    const int tid = threadIdx.x;
#pragma unroll
    for (int i = 0; i < 16; ++i) {
        const int kk = (tid >> 6) + 4 * i, nn = tid & 63;
        const float v = (n0 + nn < N) ? W[(size_t)(k0 + kk) * N + n0 + nn] : 0.f;
        lds[kk * 65 + nn] = v;
    }
    __syncthreads();
    {
        const int nn = tid >> 2, ks = (tid & 3) * 16;
        const int n = n0 + nn;
        if (n < N) {
            int np = n;
            if (MODE == 1) { const int j = (n < 1024) ? n : n - 1024; np = (j >> 4) * 32 + (j & 15) + ((n < 1024) ? 0 : 16); }
            u32x4 o0, o1;
            const float* s = lds + nn;
            o0.x = pk2(s[(ks + 0) * 65], s[(ks + 1) * 65]); o0.y = pk2(s[(ks + 2) * 65], s[(ks + 3) * 65]);
            o0.z = pk2(s[(ks + 4) * 65], s[(ks + 5) * 65]); o0.w = pk2(s[(ks + 6) * 65], s[(ks + 7) * 65]);
            o1.x = pk2(s[(ks + 8) * 65], s[(ks + 9) * 65]); o1.y = pk2(s[(ks + 10) * 65], s[(ks + 11) * 65]);
            o1.z = pk2(s[(ks + 12) * 65], s[(ks + 13) * 65]); o1.w = pk2(s[(ks + 14) * 65], s[(ks + 15) * 65]);
            u32x4* dst = (u32x4*)(WT + (size_t)np * K + k0 + ks);
            dst[0] = o0; dst[1] = o1;
        }
    }
    __syncthreads();
}

__device__ __forceinline__ void cvt_item(const float* src, bf16_t* dst, int item) {
    const size_t base = (size_t)item * 8192 + threadIdx.x * 8;
#pragma unroll
    for (int i = 0; i < 4; ++i) {
        const size_t o = base + (size_t)i * 2048;
        const f32x4 a = *(const f32x4*)(src + o), b = *(const f32x4*)(src + o + 4);
        u32x4 w; w.x = pk2(a.x, a.y); w.y = pk2(a.z, a.w); w.z = pk2(b.x, b.y); w.w = pk2(b.z, b.w);
        *(u32x4*)(dst + o) = w;
    }
}
__device__ __forceinline__ void zero_item(bf16_t* dst, int item) {
    const size_t base = (size_t)item * 8192 + threadIdx.x * 8;
#pragma unroll
    for (int i = 0; i < 4; ++i) *(u32x4*)(dst + base + (size_t)i * 2048) = (u32x4){0u, 0u, 0u, 0u};
}

struct cpx { float re, im; };
__device__ __forceinline__ cpx cmul(cpx a, cpx b) { return {a.re * b.re - a.im * b.im, a.re * b.im + a.im * b.re}; }
__device__ __forceinline__ cpx cexp_pow(float are, float aim, float dt, int m) {
    const float mag = __expf(are * dt * (float)m);
    const double rev = (double)aim * (double)dt * (double)m * 0.15915494309189535;
    const float fr = (float)(rev - rint(rev));
    return {mag * __builtin_amdgcn_cosf(fr), mag * __builtin_amdgcn_sinf(fr)};
}
__device__ __forceinline__ cpx s5_coef(float are, float aim, float dt) {
    cpx ab = cexp_pow(are, aim, dt, 1);
    const float nr = ab.re - 1.0f, ni = ab.im, den = are * are + aim * aim;
    return {(nr * are + ni * aim) / den, (ni * are - nr * aim) / den};
}

__device__ __forceinline__ void prep_s5_T_item(const Params& p, int item) {
    const int gid = item * 256 + threadIdx.x;
    const int g = gid >> 9, m = (gid >> 4) & 31, i = gid & 15;
    const float* a_re = p.in[7] + g * 64; const float* a_im = p.in[8] + g * 64;
    const float dt = __expf(p.in[9][g]);
    const float* b_re = p.in[10] + (size_t)g * 64 * 16; const float* b_im = p.in[11] + (size_t)g * 64 * 16;
    const float* c_re = p.in[12] + (size_t)g * 16 * 64 + i * 64; const float* c_im = p.in[13] + (size_t)g * 16 * 64 + i * 64;
    float acc[16];
#pragma unroll
    for (int j = 0; j < 16; ++j) acc[j] = 0.f;
    for (int q = 0; q < 64; ++q) {
        const float are = a_re[q], aim = a_im[q];
        cpx z = cmul(cmul({c_re[q], c_im[q]}, cexp_pow(are, aim, dt, m)), s5_coef(are, aim, dt));
        const f32x4* br = (const f32x4*)(b_re + q * 16); const f32x4* bi = (const f32x4*)(b_im + q * 16);
#pragma unroll
        for (int j4 = 0; j4 < 4; ++j4) {
            const f32x4 r = br[j4], im = bi[j4];
            acc[j4 * 4 + 0] += z.re * r.x - z.im * im.x; acc[j4 * 4 + 1] += z.re * r.y - z.im * im.y;
            acc[j4 * 4 + 2] += z.re * r.z - z.im * im.z; acc[j4 * 4 + 3] += z.re * r.w - z.im * im.w;
        }
    }
    u32x4 o0, o1;
    o0.x = pk2(acc[0], acc[1]); o0.y = pk2(acc[2], acc[3]); o0.z = pk2(acc[4], acc[5]); o0.w = pk2(acc[6], acc[7]);
    o1.x = pk2(acc[8], acc[9]); o1.y = pk2(acc[10], acc[11]); o1.z = pk2(acc[12], acc[13]); o1.w = pk2(acc[14], acc[15]);
    bf16_t* TW = (bf16_t*)(p.ws + WS_TW) + (size_t)g * 640 * 512;
    const u32x4 z4 = (u32x4){0u, 0u, 0u, 0u};
    for (int lp = 0; lp + m < 32; ++lp) {
        u32x4* d = (u32x4*)(TW + (size_t)((lp + m) * 16 + i) * 512 + lp * 16);
        d[0] = o0; d[1] = o1;
        if (m > 0) { u32x4* dz = (u32x4*)(TW + (size_t)(lp * 16 + i) * 512 + (lp + m) * 16); dz[0] = z4; dz[1] = z4; }
    }
}
__device__ __forceinline__ void prep_s5_W_item(const Params& p, int item) {
    const int gid = item * 256 + threadIdx.x;
    const int g = gid >> 11, q = (gid >> 5) & 63, lp = gid & 31;
    const float are = p.in[7][g * 64 + q], aim = p.in[8][g * 64 + q];
    const float dt = __expf(p.in[9][g]);
    const cpx z = cmul(cexp_pow(are, aim, dt, 31 - lp), s5_coef(are, aim, dt));
    const float* br = p.in[10] + ((size_t)g * 64 + q) * 16; const float* bi = p.in[11] + ((size_t)g * 64 + q) * 16;
    float wr[16], wi[16];
#pragma unroll
    for (int j = 0; j < 16; ++j) { wr[j] = z.re * br[j] - z.im * bi[j]; wi[j] = z.re * bi[j] + z.im * br[j]; }
    bf16_t* TW = (bf16_t*)(p.ws + WS_TW) + (size_t)g * 640 * 512;
    u32x4* d0 = (u32x4*)(TW + (size_t)(512 + q) * 512 + lp * 16);
    u32x4* d1 = (u32x4*)(TW + (size_t)(576 + q) * 512 + lp * 16);
    d0[0] = (u32x4){pk2(wr[0], wr[1]), pk2(wr[2], wr[3]), pk2(wr[4], wr[5]), pk2(wr[6], wr[7])};
    d0[1] = (u32x4){pk2(wr[8], wr[9]), pk2(wr[10], wr[11]), pk2(wr[12], wr[13]), pk2(wr[14], wr[15])};
    d1[0] = (u32x4){pk2(wi[0], wi[1]), pk2(wi[2], wi[3]), pk2(wi[4], wi[5]), pk2(wi[6], wi[7])};
    d1[1] = (u32x4){pk2(wi[8], wi[9]), pk2(wi[10], wi[11]), pk2(wi[12], wi[13]), pk2(wi[14], wi[15])};
}
__device__ __forceinline__ void prep_s5_V_item(const Params& p, int item) {
    const int gid = item * 256 + threadIdx.x;
    const int g = gid >> 14, l = (gid >> 9) & 31, i = (gid >> 5) & 15, q0 = (gid & 31) * 2;
    const float dt = __expf(p.in[9][g]);
    float vr[2], vi[2];
#pragma unroll
    for (int e = 0; e < 2; ++e) {
        const int q = q0 + e;
        const cpx z = cmul({p.in[12][((size_t)g * 16 + i) * 64 + q], p.in[13][((size_t)g * 16 + i) * 64 + q]}, cexp_pow(p.in[7][g * 64 + q], p.in[8][g * 64 + q], dt, l + 1));
        vr[e] = z.re; vi[e] = -z.im;
    }
    bf16_t* VG = (bf16_t*)(p.ws + WS_VG) + ((size_t)g * 512 + l * 16 + i) * 128;
    *(unsigned*)(VG + q0) = pk2(vr[0], vr[1]);
    *(unsigned*)(VG + 64 + q0) = pk2(vi[0], vi[1]);
}
__device__ __forceinline__ void prep_al_item(const Params& p, int item) {
    const int gid = item * 256 + threadIdx.x;
    const int g = gid >> 6;
    const float dt = __expf(p.in[9][g]);
    const cpx z = cexp_pow(p.in[7][gid], p.in[8][gid], dt, S5L);
    f32x2* AL = (f32x2*)(p.ws + WS_MISC + 4096);
    AL[gid] = (f32x2){z.re, z.im};
}
__device__ __forceinline__ void prep_rope_item(const Params& p, int item) {
    const int gid = item * 256 + threadIdx.x;
    const int pos = gid >> 5, j = gid & 31;
    const float freq = exp2f(-(float)j * (13.287712379549449f / 32.0f));
    const float ang = (float)pos * freq;
    const double rev = (double)ang * 0.15915494309189535;
    const float fr = (float)(rev - rint(rev));
    f32x2* R = (f32x2*)(p.ws + WS_ROPE);
    R[gid] = (f32x2){__builtin_amdgcn_cosf(fr), __builtin_amdgcn_sinf(fr)};
}
__device__ __forceinline__ void prep_cmpbias_item(const Params& p, int item, float* lds) {
    const int kv = item >> 3, cg0 = (item & 7) * 32;
    const float* pe = p.in[17 + kv]; const float* w1 = p.in[kv == 0 ? 19 : 21];
    const int tid = threadIdx.x, col = cg0 + (tid & 31), kg = tid >> 5;
    float s = 0.f;
#pragma unroll 8
    for (int k = kg * 256; k < kg * 256 + 256; ++k) s += pe[k] * w1[(size_t)k * 256 + col];
    lds[tid] = s;
    __syncthreads();
    if (tid < 32) {
        float t = 0.f;
#pragma unroll
        for (int q = 0; q < 8; ++q) t += lds[q * 32 + tid];
        ((float*)(p.ws + WS_MISC))[kv * 256 + cg0 + tid] = t;
    }
    __syncthreads();
}

__device__ __forceinline__ void cvt_fp8_item(const float* src, unsigned char* dst, float* inv_scale, int item, const bool slice_major) {
    const int lane = threadIdx.x & 63, row0 = item * 16 + (threadIdx.x >> 6) * 4;
    f32x4 v[4][4];
#pragma unroll
    for (int r = 0; r < 4; ++r) {
        const f32x4* sp = (const f32x4*)(src + (size_t)(row0 + r) * D + lane * 16);
#pragma unroll
        for (int q = 0; q < 4; ++q) v[r][q] = sp[q];
    }
#pragma unroll
    for (int r = 0; r < 4; ++r) {
        float m = 0.f;
#pragma unroll
        for (int q = 0; q < 4; ++q) m = fmaxf(m, fmaxf(fmaxf(fabsf(v[r][q].x), fabsf(v[r][q].y)), fmaxf(fabsf(v[r][q].z), fabsf(v[r][q].w))));
#pragma unroll
        for (int o = 1; o < 64; o <<= 1) m = fmaxf(m, __shfl_xor(m, o));
        const float sc = m > 0.f ? 224.0f / m : 1.0f;
        unsigned w[4];
#pragma unroll
        for (int q = 0; q < 4; ++q) { int t = 0; t = __builtin_amdgcn_cvt_pk_fp8_f32(v[r][q].x * sc, v[r][q].y * sc, t, false); t = __builtin_amdgcn_cvt_pk_fp8_f32(v[r][q].z * sc, v[r][q].w * sc, t, true); w[q] = (unsigned)t; }
        const int row = row0 + r;
        const u32x4 wv = (u32x4){w[0], w[1], w[2], w[3]};
        if (slice_major) *(u32x4*)(dst + (size_t)(lane >> 3) * (PE * 128) + (size_t)row * 128 + (lane & 7) * 16) = wv;
        else *(u32x4*)(dst + (size_t)row * D + lane * 16) = wv;
        if (lane == 0) inv_scale[row] = m > 0.f ? m / 224.0f : 1.0f;
    }
}
constexpr int P0_MOD = 384;
constexpr int P0_T_WIN = 16 * 16, P0_T_WGLU = 16 * 32, P0_T_WPROJ = 16 * 41, P0_T_WK1 = 32 * 4, P0_T_WK2 = 4 * 1, P0_T_WO = 16 * 16, P0_T_WQ = 16 * 32;
constexpr int P0_SUBK = (2 * 8 * 2 * 128 * 128) / 8192;
constexpr int P0_TAB = PE / 16;
constexpr int P0_S5T = 128, P0_S5W = 512, P0_S5V = 4096, P0_AL = 16, P0_ROPE = 2048, P0_CB = 16, P0_ZERO = 10 + 2;

__device__ __forceinline__ void phase_prep(const Params& p, float* lds, const int part) {
    const int n0 = P0_MOD;
    const int n1 = n0 + P0_T_WIN, n2 = n1 + P0_T_WGLU, n3 = n2 + P0_T_WPROJ, n4 = n3 + P0_T_WK1, n5 = n4 + P0_T_WK1, n6 = n5 + P0_T_WK2, n7 = n6 + P0_T_WK2,
              n8 = n7 + P0_T_WO, n9 = n8 + P0_T_WQ, n10 = n9 + P0_T_WQ, n11 = n10 + P0_SUBK, n12 = n11 + P0_TAB, n13 = n12 + P0_TAB,
              n14 = n13 + P0_S5T, n15 = n14 + P0_S5W, n16 = n15 + P0_S5V, n17 = n16 + P0_AL, n18 = n17 + P0_ROPE, n19 = n18 + P0_CB, n20 = n19 + 10, n21 = n20 + 2, n22 = n21 + 2;
    unsigned char* ws = p.ws;
#ifndef PREP_DUP_LO
#define PREP_DUP_LO 0
#define PREP_DUP_HI 0
#endif
    const int dupn = (PREP_DUP_HI) - (PREP_DUP_LO);
    const int nB = (n8 - n2) + (n10 - n9) + (n22 - n17);
    const int first = part == 0 ? (int)blockIdx.x : (int)blockIdx.x - 32, stride = part == 0 ? (int)gridDim.x : (int)gridDim.x - 32;
    if (first < 0 || stride <= 0) return;
    const int total = part == 0 ? (n22 - nB) + dupn : nB;
    for (int it0 = first; it0 < total; it0 += stride) {
        int it;
        if (part == 0) {
            it = it0;
            if (it >= n2) it += (n8 - n2);
            if (it >= n9) it += (n10 - n9);
            if (it0 >= (n22 - nB)) it = (PREP_DUP_LO) + (it0 - (n22 - nB));
        } else {
            it = n2 + it0;
            if (it >= n8) it += (n9 - n8);
            if (it >= n10) it += (n17 - n10);
        }
        if (it < n0) prep_mod_item(p, it, lds);
        else if (it < n1) prep_transpose_item<0>(p.in[6], 1024, 1024, (bf16_t*)(ws + WS_WIN_T), it - n0, lds);
        else if (it < n2) prep_transpose_item<1>(p.in[15], 1024, 2048, (bf16_t*)(ws + WS_WGLU_T), it - n1, lds);
        else if (it < n3) prep_transpose_item<0>(p.in[16], 1024, NPROJ, (bf16_t*)(ws + WS_WPROJ_T), it - n2, lds);
        else if (it < n4) prep_transpose_item<0>(p.in[19], 2048, 256, (bf16_t*)(ws + WS_WK1_T), it - n3, lds);
        else if (it < n5) prep_transpose_item<0>(p.in[21], 2048, 256, (bf16_t*)(ws + WS_WV1_T), it - n4, lds);
        else if (it < n6) prep_transpose_item<0>(p.in[20], 256, 64, (bf16_t*)(ws + WS_WK2_T), it - n5, lds);
        else if (it < n7) prep_transpose_item<0>(p.in[22], 256, 64, (bf16_t*)(ws + WS_WV2_T), it - n6, lds);
        else if (it < n8) prep_transpose_item<0>(p.in[23], 1024, 1024, (bf16_t*)(ws + WS_WO_T), it - n7, lds);
        else if (it < n9) prep_transpose_item<0>(p.in[24], 1024, 2048, (bf16_t*)(ws + WS_WQ_T), it - n8, lds);
        else if (it < n10) prep_transpose_item<0>(p.in[24] + (size_t)1024 * 2048, 1024, 2048, (bf16_t*)(ws + WS_WQ_T) + (size_t)2048 * 1024, it - n9, lds);
        else if (it < n11) cvt_item(p.in[25], (bf16_t*)(ws + WS_SUBK), it - n10);
        else if (it < n12) cvt_fp8_item(p.in[26], ws + WS_PU, (float*)(ws + WS_PU + 24 * MiB), it - n11, false);
        else if (it < n13) cvt_fp8_item(p.in[27], ws + WS_PV, (float*)(ws + WS_PV + 24 * MiB), it - n12, false);
        else if (it < n14) prep_s5_T_item(p, it - n13);
        else if (it < n15) prep_s5_W_item(p, it - n14);
        else if (it < n16) prep_s5_V_item(p, it - n15);
        else if (it < n17) prep_al_item(p, it - n16);
        else if (it < n18) prep_rope_item(p, it - n17);
        else if (it < n19) prep_cmpbias_item(p, it - n18, lds);
        else if (it < n20) zero_item((bf16_t*)(ws + WS_WPROJ_T) + (size_t)NPROJ * 1024, it - n19);
        else if (it < n21) zero_item((bf16_t*)(ws + WS_WK2_T) + (size_t)64 * 256, it - n20);
        else zero_item((bf16_t*)(ws + WS_WV2_T) + (size_t)64 * 256, it - n21);
    }
}

__device__ __forceinline__ void phase_norm(const Params& p, const float* X, const float* gw, const float* shift, const float* scale  , bf16_t* HM) {
    const int lane = threadIdx.x & 63, wave = threadIdx.x >> 6;
    for (int row = blockIdx.x * 4 + wave; row < T; row += gridDim.x * 4) {
        const int b = row / SEQ;
        const f32x4* xr = (const f32x4*)(X + (size_t)row * D) + lane;
        f32x4 v[4]; float s = 0.f;
#pragma unroll
        for (int j = 0; j < 4; ++j) { v[j] = xr[64 * j]; s += (v[j].x * v[j].x + v[j].y * v[j].y) + (v[j].z * v[j].z + v[j].w * v[j].w); }
        const float rs = rsqrtf(wave_sum(s) * (1.0f / D) + RMS_EPS);
        u32x2* o = (u32x2*)(HM + (size_t)row * D) + lane;
#pragma unroll
        for (int j = 0; j < 4; ++j) {
            const int c = lane * 4 + 256 * j;
            const f32x4 g = *(const f32x4*)(gw + c), sh = *(const f32x4*)(shift + (size_t)b * 6144 + c), sc = *(const f32x4*)(scale + (size_t)b * 6144 + c);
            const float y0 = v[j].x * rs * g.x * (1.f + sc.x) + sh.x, y1 = v[j].y * rs * g.y * (1.f + sc.y) + sh.y;
            const float y2 = v[j].z * rs * g.z * (1.f + sc.z) + sh.z, y3 = v[j].w * rs * g.w * (1.f + sc.w) + sh.w;
            o[64 * j] = (u32x2){pk2(y0, y1), pk2(y2, y3)};
        }
    }
}
__device__ __forceinline__ void phase_final_norm(const Params& p, const float* X, float* OUT, bool dry) {
    const int lane = threadIdx.x & 63, wave = threadIdx.x >> 6;
    const float* gw = p.in[28];
    for (int row = blockIdx.x * 4 + wave; row < T; row += gridDim.x * 4) {
        const f32x4* xr = (const f32x4*)(X + (size_t)row * D) + lane;
        f32x4 v[4]; float s = 0.f;
#pragma unroll
        for (int j = 0; j < 4; ++j) { v[j] = xr[64 * j]; s += (v[j].x * v[j].x + v[j].y * v[j].y) + (v[j].z * v[j].z + v[j].w * v[j].w); }
        const float rs = rsqrtf(wave_sum(s) * (1.0f / D) + RMS_EPS);
        f32x4* o = (f32x4*)(OUT + (size_t)row * D) + lane;
#pragma unroll
        for (int j = 0; j < 4; ++j) {
            const f32x4 g = *(const f32x4*)(gw + lane * 4 + 256 * j);
            if (!dry) o[64 * j] = (f32x4){v[j].x * rs * g.x, v[j].y * rs * g.y, v[j].z * rs * g.z, v[j].w * rs * g.w};
        }
    }
}

__device__ __forceinline__ int vblock() { const int G = gridDim.x, bx = blockIdx.x; return (G % 8 == 0) ? (bx % 8) * (G / 8) + bx / 8 : bx; }
struct ALoadPlain {
    const bf16_t* A; size_t lda;
    __device__ __forceinline__ const bf16_t* base(int kt) const { return A + kt * 64; }
    __device__ __forceinline__ unsigned off(int r, int lc) const { return (unsigned)r * (unsigned)lda + (unsigned)lc * 8u; }
};
struct ALoadGroup {
    const bf16_t* A;
    __device__ __forceinline__ const bf16_t* base(int kt) const { return A + (size_t)kt * 4 * T * 16; }
    __device__ __forceinline__ unsigned off(int r, int lc) const { return ((unsigned)(lc >> 1) * (unsigned)T + (unsigned)r) * 16u + (unsigned)(lc & 1) * 8u; }
};

template <class AL>
__device__ __forceinline__ void gemm_tile2(const AL al, const bf16_t* __restrict__ Bt, size_t ldb, int nk, f32x4 (&acc)[4][4], unsigned char* lds) {
    const int tid = threadIdx.x, lane = tid & 63, wid = tid >> 6, wr = wid >> 1, wc = wid & 1, fr = lane & 15, fq = lane >> 4;
    const int lr = tid >> 3, lc = tid & 7;
#pragma unroll
    for (int mi = 0; mi < 4; ++mi)
#pragma unroll
        for (int ni = 0; ni < 4; ++ni) acc[mi][ni] = (f32x4){0.f, 0.f, 0.f, 0.f};
    u32x4 ra0[4], rb0[4], ra1[4], rb1[4];
    const int soff = lr * 128 + ((lc ^ (lr & 7)) << 4);
    unsigned offA[4], offB[4];
#pragma unroll
    for (int i = 0; i < 4; ++i) { offA[i] = al.off(lr + 32 * i, lc); offB[i] = (unsigned)(lr + 32 * i) * (unsigned)ldb + (unsigned)lc * 8u; }
#define GT_LOAD(RA, RB, kt_) do { const bf16_t* ab_ = al.base(kt_); const bf16_t* bb_ = Bt + (kt_) * 64; _Pragma("unroll") for (int i = 0; i < 4; ++i) { RA[i] = *(const u32x4*)(ab_ + offA[i]); RB[i] = *(const u32x4*)(bb_ + offB[i]); } } while (0)
#define GT_STORE(RA, RB, buf_) do { unsigned char* nb_ = lds + (buf_) * 32768; _Pragma("unroll") for (int i = 0; i < 4; ++i) { *(u32x4*)(nb_ + soff + i * 4096) = RA[i]; *(u32x4*)(nb_ + 16384 + soff + i * 4096) = RB[i]; } } while (0)
    const int aoff = (wr * 64 + fr) * 128, boff = 16384 + (wc * 64 + fr) * 128, sw = fr & 7;
#define GT_MATH(buf_) do { const unsigned char* bp_ = lds + (buf_) * 32768; _Pragma("unroll") for (int ks = 0; ks < 2; ++ks) { bf16x8 af[4], bfr[4]; const int co = ((ks * 4 + fq) ^ sw) << 4; \
        _Pragma("unroll") for (int mi = 0; mi < 4; ++mi) af[mi] = *(const bf16x8*)(bp_ + aoff + mi * 2048 + co); \
        _Pragma("unroll") for (int ni = 0; ni < 4; ++ni) bfr[ni] = *(const bf16x8*)(bp_ + boff + ni * 2048 + co); \
        _Pragma("unroll") for (int mi = 0; mi < 4; ++mi) _Pragma("unroll") for (int ni = 0; ni < 4; ++ni) acc[mi][ni] = __builtin_amdgcn_mfma_f32_16x16x32_bf16(bfr[ni], af[mi], acc[mi][ni], 0, 0, 0); } } while (0)
    GT_LOAD(ra0, rb0, 0);
    if (nk > 1) GT_LOAD(ra1, rb1, 1);
    GT_STORE(ra0, rb0, 0);
    __syncthreads();
    for (int kt = 0; kt < nk; kt += 2) {
        if (kt + 2 < nk) GT_LOAD(ra0, rb0, kt + 2);
        __builtin_amdgcn_sched_barrier(0);
        GT_MATH(0);
        __builtin_amdgcn_sched_barrier(0);
        if (kt + 1 < nk) GT_STORE(ra1, rb1, 1);
        __syncthreads();
        if (kt + 1 >= nk) break;
        if (kt + 3 < nk) GT_LOAD(ra1, rb1, kt + 3);
        __builtin_amdgcn_sched_barrier(0);
        GT_MATH(1);
        __builtin_amdgcn_sched_barrier(0);
        if (kt + 2 < nk) GT_STORE(ra0, rb0, 0);
        __syncthreads();
    }
#undef GT_LOAD
#undef GT_STORE
#undef GT_MATH
}

template <class AL>
__device__ __forceinline__ void gemm_tile1(const AL al, const bf16_t* __restrict__ Bt, size_t ldb, int nk, f32x4 (&acc)[4][4], unsigned char* lds) {
    const int tid = threadIdx.x, lane = tid & 63, wid = tid >> 6, wr = wid >> 1, wc = wid & 1, fr = lane & 15, fq = lane >> 4;
    const int lr = tid >> 3, lc = tid & 7;
#pragma unroll
    for (int mi = 0; mi < 4; ++mi)
#pragma unroll
        for (int ni = 0; ni < 4; ++ni) acc[mi][ni] = (f32x4){0.f, 0.f, 0.f, 0.f};
    u32x4 ra[4], rb[4];
    const int soff = lr * 128 + ((lc ^ (lr & 7)) << 4);
#pragma unroll
    for (int i = 0; i < 4; ++i) { ra[i] = *(const u32x4*)(al.base(0) + al.off(lr + 32 * i, lc)); rb[i] = *(const u32x4*)(Bt + (size_t)(lr + 32 * i) * ldb + lc * 8); }
#pragma unroll
    for (int i = 0; i < 4; ++i) { *(u32x4*)(lds + soff + i * 4096) = ra[i]; *(u32x4*)(lds + 16384 + soff + i * 4096) = rb[i]; }
    __syncthreads();
    const int aoff = (wr * 64 + fr) * 128, boff = 16384 + (wc * 64 + fr) * 128, sw = fr & 7;
    for (int kt = 0; kt < nk; ++kt) {
        const bool more = (kt + 1 < nk);
        if (more) {
#pragma unroll
            for (int i = 0; i < 4; ++i) { ra[i] = *(const u32x4*)(al.base(kt + 1) + al.off(lr + 32 * i, lc)); rb[i] = *(const u32x4*)(Bt + (size_t)(lr + 32 * i) * ldb + (kt + 1) * 64 + lc * 8); }
        }
        const unsigned char* buf = lds + (kt & 1) * 32768;
#pragma unroll
        for (int ks = 0; ks < 2; ++ks) {
            bf16x8 af[4], bfr[4];
            const int co = ((ks * 4 + fq) ^ sw) << 4;
#pragma unroll
            for (int mi = 0; mi < 4; ++mi) af[mi] = *(const bf16x8*)(buf + aoff + mi * 2048 + co);
#pragma unroll
            for (int ni = 0; ni < 4; ++ni) bfr[ni] = *(const bf16x8*)(buf + boff + ni * 2048 + co);
#pragma unroll
            for (int mi = 0; mi < 4; ++mi)
#pragma unroll
                for (int ni = 0; ni < 4; ++ni) acc[mi][ni] = __builtin_amdgcn_mfma_f32_16x16x32_bf16(bfr[ni], af[mi], acc[mi][ni], 0, 0, 0);
        }
        if (more) {
            unsigned char* nb = lds + ((kt + 1) & 1) * 32768;
#pragma unroll
            for (int i = 0; i < 4; ++i) { *(u32x4*)(nb + soff + i * 4096) = ra[i]; *(u32x4*)(nb + 16384 + soff + i * 4096) = rb[i]; }
        }
        __syncthreads();
    }
}

template <class AL>
__device__ __forceinline__ void gemm_tile3(const AL al, const bf16_t* __restrict__ Bt, size_t ldb, int nk, f32x4 (&acc)[4][4], unsigned char* lds) {
    const int tid = threadIdx.x, lane = tid & 63, wid = tid >> 6, wr = wid >> 1, wc = wid & 1, fr = lane & 15, fq = lane >> 4;
#pragma unroll
    for (int mi = 0; mi < 4; ++mi)
#pragma unroll
        for (int ni = 0; ni < 4; ++ni) acc[mi][ni] = (f32x4){0.f, 0.f, 0.f, 0.f};
    const int srow = wid * 32 + (lane >> 3), schunk = (lane & 7) ^ ((lane >> 3) & 7);
    unsigned offA[4], offB[4];
#pragma unroll
    for (int i = 0; i < 4; ++i) { offA[i] = al.off(srow + 8 * i, schunk); offB[i] = (unsigned)(srow + 8 * i) * (unsigned)ldb + (unsigned)schunk * 8u; }
#define G3_STAGE(buf_, kt_) do { const bf16_t* ab_ = al.base(kt_); const bf16_t* bb_ = Bt + (kt_) * 64; unsigned char* lb_ = lds + (buf_) * 32768 + wid * 4096; \
        _Pragma("unroll") for (int i = 0; i < 4; ++i) { \
            __builtin_amdgcn_global_load_lds((const unsigned*)(ab_ + offA[i]), (unsigned*)(lb_ + i * 1024), 16, 0, 0); \
            __builtin_amdgcn_global_load_lds((const unsigned*)(bb_ + offB[i]), (unsigned*)(lb_ + 16384 + i * 1024), 16, 0, 0); } } while (0)
    const int aoff = (wr * 64 + fr) * 128, boff = 16384 + (wc * 64 + fr) * 128, sw = fr & 7;
    G3_STAGE(0, 0);
    __syncthreads();
    for (int kt = 0; kt < nk; ++kt) {
        if (kt + 1 < nk) G3_STAGE((kt + 1) & 1, kt + 1);
        const unsigned char* buf = lds + (kt & 1) * 32768;
#pragma unroll
        for (int ks = 0; ks < 2; ++ks) {
            bf16x8 af[4], bfr[4];
            const int co = ((ks * 4 + fq) ^ sw) << 4;
#pragma unroll
            for (int mi = 0; mi < 4; ++mi) af[mi] = *(const bf16x8*)(buf + aoff + mi * 2048 + co);
#pragma unroll
            for (int ni = 0; ni < 4; ++ni) bfr[ni] = *(const bf16x8*)(buf + boff + ni * 2048 + co);
#pragma unroll
            for (int mi = 0; mi < 4; ++mi)
#pragma unroll
                for (int ni = 0; ni < 4; ++ni) acc[mi][ni] = __builtin_amdgcn_mfma_f32_16x16x32_bf16(bfr[ni], af[mi], acc[mi][ni], 0, 0, 0);
        }
        __syncthreads();
    }
#undef G3_STAGE
}
__device__ __forceinline__ void phase_s5_win(const Params& p, unsigned char* lds) {
    const bf16_t* HM = (const bf16_t*)(p.ws + WS_HM); const bf16_t* WT = (const bf16_t*)(p.ws + WS_WIN_T);
    bf16_t* UG = (bf16_t*)(p.ws + WS_UG);
    const int lane = threadIdx.x & 63, wid = threadIdx.x >> 6, wr = wid >> 1, wc = wid & 1, fr = lane & 15, fq = lane >> 4;
    for (int id = vblock(); id < 256 * 8; id += gridDim.x) {
        const int mt = id >> 3, nt = id & 7;
        f32x4 acc[4][4];
        gemm_tile3(ALoadPlain{HM + (size_t)mt * 128 * D, (size_t)D}, WT + (size_t)nt * 128 * D, D, 16, acc, lds);
#pragma unroll
        for (int mi = 0; mi < 4; ++mi)
#pragma unroll
            for (int ni = 0; ni < 4; ++ni) {
                const int t = mt * 128 + wr * 64 + mi * 16 + fr, g = nt * 8 + wc * 4 + ni;
                const f32x4 v = acc[mi][ni];
                *(u32x2*)(UG + ((size_t)g * T + t) * 16 + fq * 4) = (u32x2){pk2(v.x, v.y), pk2(v.z, v.w)};
            }
    }
}
__device__ __forceinline__ void phase_s5_a(const Params& p, unsigned char* lds) {
    const bf16_t* UG = (const bf16_t*)(p.ws + WS_UG); const bf16_t* TW = (const bf16_t*)(p.ws + WS_TW);
    bf16_t* YI = (bf16_t*)(p.ws + WS_YI); float* WST = (float*)(p.ws + WS_WST);
    const int lane = threadIdx.x & 63, wid = threadIdx.x >> 6, wr = wid >> 1, wc = wid & 1, fr = lane & 15, fq = lane >> 4;
    for (int id = vblock(); id < 64 * 40; id += gridDim.x) {
        const int g = id / 40, rem = id % 40, mt = rem / 5, nt = rem % 5;
        const int nk = (nt < 4) ? 2 * (nt + 1) : 8;
        f32x4 acc[4][4];
        gemm_tile3(ALoadPlain{UG + (size_t)g * T * 16 + (size_t)mt * 128 * 512, (size_t)512}, TW + ((size_t)g * 640 + nt * 128) * 512, 512, nk, acc, lds);
#pragma unroll
        for (int mi = 0; mi < 4; ++mi)
#pragma unroll
            for (int ni = 0; ni < 4; ++ni) {
                const int R = mt * 128 + wr * 64 + mi * 16 + fr, c = wc * 64 + ni * 16 + fq * 4;
                const f32x4 v = acc[mi][ni];
                if (nt < 4) *(u32x2*)(YI + ((size_t)g * 1024 + R) * 512 + nt * 128 + c) = (u32x2){pk2(v.x, v.y), pk2(v.z, v.w)};
                else *(f32x4*)(WST + ((size_t)g * 1024 + R) * 128 + c) = v;
            }
    }
}
__device__ __forceinline__ void phase_s5_scan(const Params& p) {
    const int lane = threadIdx.x & 63, wave = threadIdx.x >> 6;
    const float* WST = (const float*)(p.ws + WS_WST); bf16_t* SST = (bf16_t*)(p.ws + WS_SST);
    const f32x2* AL = (const f32x2*)(p.ws + WS_MISC + 4096);
    for (int it = blockIdx.x * 4 + wave; it < 128; it += gridDim.x * 4) {
        const int b = it >> 6, g = it & 63;
        const f32x2 al = AL[g * 64 + lane];
        float sr = 0.f, si = 0.f;
        const float* wbase = WST + ((size_t)g * 1024 + b * 512) * 128 + lane;
        bf16_t* sbase = SST + ((size_t)g * 1024 + b * 512) * 128 + lane;
        for (int n0 = 0; n0 < 512; n0 += 16) {
            float wre[16], wim[16];
#pragma unroll
            for (int j = 0; j < 16; ++j) { wre[j] = wbase[(size_t)(n0 + j) * 128]; wim[j] = wbase[(size_t)(n0 + j) * 128 + 64]; }
#pragma unroll
            for (int j = 0; j < 16; ++j) {
                sbase[(size_t)(n0 + j) * 128] = (bf16_t)f2bf(sr); sbase[(size_t)(n0 + j) * 128 + 64] = (bf16_t)f2bf(si);
                const float nr = al.x * sr - al.y * si + wre[j], ni = al.x * si + al.y * sr + wim[j];
                sr = nr; si = ni;
            }
        }
    }
}
__device__ __forceinline__ void phase_s5_b(const Params& p, unsigned char* lds) {
    const bf16_t* SST = (const bf16_t*)(p.ws + WS_SST); const bf16_t* VG = (const bf16_t*)(p.ws + WS_VG);
    const bf16_t* YI = (const bf16_t*)(p.ws + WS_YI); const bf16_t* UG = (const bf16_t*)(p.ws + WS_UG);
    bf16_t* YG = (bf16_t*)(p.ws + WS_YG);
    const float* dsk = p.in[14];
    const int lane = threadIdx.x & 63, wid = threadIdx.x >> 6, wr = wid >> 1, wc = wid & 1, fr = lane & 15, fq = lane >> 4;
    for (int id = vblock(); id < 64 * 32; id += gridDim.x) {
        const int g = id >> 5, mt = (id >> 2) & 7, nt = id & 3;
        f32x4 acc[4][4];
        gemm_tile3(ALoadPlain{SST + ((size_t)g * 1024 + mt * 128) * 128, (size_t)128}, VG + ((size_t)g * 512 + nt * 128) * 128, 128, 2, acc, lds);
        const f32x4 dv = *(const f32x4*)(dsk + g * 16 + fq * 4);
#pragma unroll
        for (int mi = 0; mi < 4; ++mi)
#pragma unroll
            for (int ni = 0; ni < 4; ++ni) {
                const int R = mt * 128 + wr * 64 + mi * 16 + fr, c = nt * 128 + wc * 64 + ni * 16 + fq * 4;
                const size_t idx = ((size_t)g * 1024 + R) * 512 + c;
                const u32x2 yi = *(const u32x2*)(YI + idx), uu = *(const u32x2*)(UG + idx);
                const f32x4 v = acc[mi][ni];
                const float y0 = gelu_tanh(v.x + bflo(yi.x) + dv.x * bflo(uu.x)), y1 = gelu_tanh(v.y + bfhi(yi.x) + dv.y * bfhi(uu.x));
                const float y2 = gelu_tanh(v.z + bflo(yi.y) + dv.z * bflo(uu.y)), y3 = gelu_tanh(v.w + bfhi(yi.y) + dv.w * bfhi(uu.y));
                *(u32x2*)(YG + idx) = (u32x2){pk2(y0, y1), pk2(y2, y3)};
            }
    }
}
__device__ __forceinline__ void phase_s5_glu(const Params& p, unsigned char* lds) {
    const bf16_t* YG = (const bf16_t*)(p.ws + WS_YG); const bf16_t* WT = (const bf16_t*)(p.ws + WS_WGLU_T);
    const float* MOD = (const float*)(p.ws + WS_MOD);
    const float* X = p.in[0]; float* XO = p.out;
    const int lane = threadIdx.x & 63, wid = threadIdx.x >> 6, wr = wid >> 1, wc = wid & 1, fr = lane & 15, fq = lane >> 4;
    for (int id = vblock(); id < 256 * 16; id += gridDim.x) {
        const int mt = id >> 4, nt = id & 15;
        f32x4 acc[4][4];
        gemm_tile3(ALoadGroup{YG + (size_t)mt * 128 * 16}, WT + (size_t)nt * 128 * D, D, 16, acc, lds);
        const int b = (mt * 128) / SEQ;
#pragma unroll
        for (int mi = 0; mi < 4; ++mi)
#pragma unroll
            for (int h = 0; h < 2; ++h) {
                const int t = mt * 128 + wr * 64 + mi * 16 + fr, j = nt * 64 + wc * 32 + h * 16 + fq * 4;
                const f32x4 a = acc[mi][2 * h], gg = acc[mi][2 * h + 1];
                const f32x4 g1 = *(const f32x4*)(MOD + (size_t)(0 * 2 + b) * 6144 + 2048 + j);
                const f32x4 xi = *(const f32x4*)(X + (size_t)t * D + j);
                f32x4 o;
                o.x = xi.x + g1.x * (a.x * sigmoidf_(gg.x)); o.y = xi.y + g1.y * (a.y * sigmoidf_(gg.y));
                o.z = xi.z + g1.z * (a.z * sigmoidf_(gg.z)); o.w = xi.w + g1.w * (a.w * sigmoidf_(gg.w));
                *(f32x4*)(XO + (size_t)t * D + j) = o;
            }
    }
}
__device__ __forceinline__ void phase_peer_wq(const Params& p, int layer, unsigned char* lds) {
    const bf16_t* HM = (const bf16_t*)(p.ws + WS_HM); const bf16_t* WT = (const bf16_t*)(p.ws + WS_WQ_T) + (size_t)layer * 2048 * 1024;
    bf16_t* QK = (bf16_t*)(p.ws + WS_QK);
    const int lane = threadIdx.x & 63, wid = threadIdx.x >> 6, wr = wid >> 1, wc = wid & 1, fr = lane & 15, fq = lane >> 4;
    for (int id = vblock(); id < 256 * 16; id += gridDim.x) {
        const int mt = id >> 4, nt = id & 15;
        f32x4 acc[4][4];
        gemm_tile3(ALoadPlain{HM + (size_t)mt * 128 * D, (size_t)D}, WT + (size_t)nt * 128 * D, D, 16, acc, lds);
#pragma unroll
        for (int mi = 0; mi < 4; ++mi)
#pragma unroll
            for (int ni = 0; ni < 4; ++ni) {
                const int t = mt * 128 + wr * 64 + mi * 16 + fr, c = nt * 128 + wc * 64 + ni * 16 + fq * 4;
                const f32x4 v = acc[mi][ni];
                *(u32x2*)(QK + (size_t)t * 2048 + c) = (u32x2){pk2(v.x, v.y), pk2(v.z, v.w)};
            }
    }
}
__device__ __forceinline__ void ce_(unsigned& a, unsigned& b, const bool up) { const unsigned lo = a < b ? a : b, hi = a < b ? b : a; a = up ? lo : hi; b = up ? hi : lo; }
__device__ __forceinline__ void bitonic_sort16(unsigned* x, const bool asc) {
#pragma unroll
    for (int k = 2; k <= 16; k <<= 1)
#pragma unroll
        for (int j = k >> 1; j > 0; j >>= 1)
#pragma unroll
            for (int i = 0; i < 16; ++i) { const int l = i ^ j; if (l > i) ce_(x[i], x[l], ((i & k) == 0) == asc); }
}
__device__ __forceinline__ void bitonic_merge16(unsigned* x, const bool asc) {
#pragma unroll
    for (int j = 8; j > 0; j >>= 1)
#pragma unroll
        for (int i = 0; i < 16; ++i) { const int l = i ^ j; if (l > i) ce_(x[i], x[l], asc); }
}
__device__ __forceinline__ void phase_peer_topk(const Params& p, int layer, unsigned char* lds) {
    const bf16_t* QK = (const bf16_t*)(p.ws + WS_QK); const bf16_t* SK = (const bf16_t*)(p.ws + WS_SUBK) + (size_t)layer * 8 * 2 * 128 * 128;
    float* TOPS = (float*)(p.ws + WS_TOPS); int* TOPI = (int*)(p.ws + WS_TOPI);
    float* sc = (float*)lds;
    const int tid = threadIdx.x, lane = tid & 63, wid = tid >> 6, wr = wid >> 1, wc = wid & 1, fr = lane & 15, fq = lane >> 4;
    for (int id = vblock(); id < 256 * 16; id += gridDim.x) {
        const int mt = id >> 4, hc = id & 15;
        f32x4 acc[4][4];
        gemm_tile3(ALoadPlain{QK + (size_t)mt * 128 * 2048 + hc * 128, (size_t)2048}, SK + (size_t)hc * 128 * 128, 128, 2, acc, lds);
#pragma unroll
        for (int mi = 0; mi < 4; ++mi)
#pragma unroll
            for (int ni = 0; ni < 4; ++ni) {
                const int r = wr * 64 + mi * 16 + fr, c = wc * 64 + ni * 16 + fq * 4;
                float* d = sc + r * 129 + c;
                d[0] = acc[mi][ni].x; d[1] = acc[mi][ni].y; d[2] = acc[mi][ni].z; d[3] = acc[mi][ni].w;
            }
        __syncthreads();
        {
            const int row = tid >> 1, half = tid & 1;
            unsigned x[64];
            const float* rp = sc + row * 129 + half * 64;
#pragma unroll
            for (int j = 0; j < 64; ++j) {
                const unsigned bits = __builtin_bit_cast(unsigned, rp[j]);
                const unsigned u = bits ^ ((unsigned)((int)bits >> 31) | 0x80000000u);
                x[j] = (u & 0xFFFFFF80u) | (unsigned)(127 - (half * 64 + j));
            }
            bitonic_sort16(x, true); bitonic_sort16(x + 16, false); bitonic_sort16(x + 32, true); bitonic_sort16(x + 48, false);
#pragma unroll
            for (int i = 0; i < 16; ++i) { x[i] = x[i] > x[16 + i] ? x[i] : x[16 + i]; x[32 + i] = x[32 + i] > x[48 + i] ? x[32 + i] : x[48 + i]; }
            bitonic_merge16(x, true); bitonic_merge16(x + 32, false);
#pragma unroll
            for (int i = 0; i < 16; ++i) x[i] = x[i] > x[32 + i] ? x[i] : x[32 + i];
            bitonic_merge16(x, false);
            unsigned y[16];
#pragma unroll
            for (int i = 0; i < 16; ++i) { const unsigned o = (unsigned)__shfl_xor((int)x[15 - i], 1); y[i] = x[i] > o ? x[i] : o; }
            bitonic_merge16(y, false);
            const size_t ob = ((size_t)(mt * 128 + row) * 16 + hc) * 16;
            if (half == 0) {
                float v[16];
#pragma unroll
                for (int i = 0; i < 16; ++i) { const unsigned u = y[i] & 0xFFFFFF80u; const unsigned bits = (u & 0x80000000u) ? (u ^ 0x80000000u) : ~u; v[i] = __builtin_bit_cast(float, bits); }
#pragma unroll
                for (int q = 0; q < 4; ++q) *(f32x4*)(TOPS + ob + q * 4) = (f32x4){v[q * 4], v[q * 4 + 1], v[q * 4 + 2], v[q * 4 + 3]};
            } else {
#pragma unroll
                for (int q = 0; q < 4; ++q) *(u32x4*)(TOPI + ob + q * 4) = (u32x4){127u - (y[q * 4] & 127u), 127u - (y[q * 4 + 1] & 127u), 127u - (y[q * 4 + 2] & 127u), 127u - (y[q * 4 + 3] & 127u)};
            }
        }
        __syncthreads();
    }
}
__device__ __forceinline__ void phase_peer_combine(const Params& p, unsigned char* lds) {
    const float* TOPS = (const float*)(p.ws + WS_TOPS); const int* TOPI = (const int*)(p.ws + WS_TOPI);
    int* EXP = (int*)(p.ws + WS_EXP); float* GATE = (float*)(p.ws + WS_GATE);
    unsigned* L = (unsigned*)lds;
    const int tid = threadIdx.x;
    for (int it = blockIdx.x; it < (T * 8) / 256; it += gridDim.x) {
        const size_t th = (size_t)it * 256 + tid;
        const u32x4* S4 = (const u32x4*)(TOPS + th * 32); const u32x4* I4 = (const u32x4*)(TOPI + th * 32);
#pragma unroll
        for (int a4 = 0; a4 < 8; ++a4) {
            const u32x4 s = S4[a4], i = I4[a4];
            L[(a4 * 4 + 0) * 256 + tid] = s.x; L[(a4 * 4 + 1) * 256 + tid] = s.y; L[(a4 * 4 + 2) * 256 + tid] = s.z; L[(a4 * 4 + 3) * 256 + tid] = s.w;
            L[(32 + a4 * 4 + 0) * 256 + tid] = i.x; L[(32 + a4 * 4 + 1) * 256 + tid] = i.y; L[(32 + a4 * 4 + 2) * 256 + tid] = i.z; L[(32 + a4 * 4 + 3) * 256 + tid] = i.w;
        }
        float val[16];
        const float s20 = __builtin_bit_cast(float, L[16 * 256 + tid]);
#pragma unroll
        for (int a = 0; a < 16; ++a) val[a] = __builtin_bit_cast(float, L[a * 256 + tid]) + s20;
        unsigned long long P = 0ull;
        float ts[16]; int te[16];
#pragma unroll
        for (int r = 0; r < 16; ++r) {
            float best = val[0]; int ba = 0;
#pragma unroll
            for (int a = 1; a < 16; ++a) if (val[a] > best) { best = val[a]; ba = a; }
            const int b = (int)((P >> (4 * ba)) & 15ull);
            const int i1 = (int)L[(32 + ba) * 256 + tid], i2 = (int)L[(48 + b) * 256 + tid];
            ts[r] = best; te[r] = i1 * 128 + i2;
            const int nb = b + 1;
            float newv = -3.0e38f;
            if (nb < 16) { newv = __builtin_bit_cast(float, L[ba * 256 + tid]) + __builtin_bit_cast(float, L[(16 + nb) * 256 + tid]); P += 1ull << (4 * ba); }
#pragma unroll
            for (int a = 0; a < 16; ++a) val[a] = (a == ba) ? newv : val[a];
        }
        const float m0 = ts[0];
        float sum = 0.f;
#pragma unroll
        for (int r = 0; r < 16; ++r) { ts[r] = __expf(ts[r] - m0); sum += ts[r]; }
        const float inv = 1.0f / sum;
#pragma unroll
        for (int r = 0; r < 16; ++r) ts[r] *= inv;
#pragma unroll
        for (int r = 0; r < 16; ++r) { EXP[th * 16 + r] = te[r]; GATE[th * 16 + r] = ts[r]; }
    }
}

__device__ __forceinline__ void fma8(const unsigned w0, const unsigned w1, const float a, float* acc) {
    const f32x2 p0 = __builtin_amdgcn_cvt_pk_f32_fp8((int)w0, false), p1 = __builtin_amdgcn_cvt_pk_f32_fp8((int)w0, true);
    const f32x2 p2 = __builtin_amdgcn_cvt_pk_f32_fp8((int)w1, false), p3 = __builtin_amdgcn_cvt_pk_f32_fp8((int)w1, true);
    acc[0] += a * p0.x; acc[1] += a * p0.y; acc[2] += a * p1.x; acc[3] += a * p1.y;
    acc[4] += a * p2.x; acc[5] += a * p2.y; acc[6] += a * p3.x; acc[7] += a * p3.y;
}
__device__ __forceinline__ float dot8(const unsigned w0, const unsigned w1, const float* h, float s) {
    const f32x2 p0 = __builtin_amdgcn_cvt_pk_f32_fp8((int)w0, false), p1 = __builtin_amdgcn_cvt_pk_f32_fp8((int)w0, true);
    const f32x2 p2 = __builtin_amdgcn_cvt_pk_f32_fp8((int)w1, false), p3 = __builtin_amdgcn_cvt_pk_f32_fp8((int)w1, true);
    s += p0.x * h[0]; s += p0.y * h[1]; s += p1.x * h[2]; s += p1.y * h[3];
    s += p2.x * h[4]; s += p2.y * h[5]; s += p3.x * h[6]; s += p3.y * h[7];
    return s;
}
__device__ __forceinline__ void phase_peer_apply(const Params& p, int layer, unsigned char* lds, bool dry) {
    const int lane = threadIdx.x & 63, wave = threadIdx.x >> 6;
    float* ldsw = (float*)lds + wave * (64 * 65);
    const bf16_t* HM = (const bf16_t*)(p.ws + WS_HM);
    const unsigned char* PU = p.ws + WS_PU; const unsigned char* PV = p.ws + WS_PV;
    const float* SU = (const float*)(p.ws + WS_PU + 24 * MiB); const float* SV = (const float*)(p.ws + WS_PV + 24 * MiB);
    const int* EXP = (const int*)(p.ws + WS_EXP); const float* GATE = (const float*)(p.ws + WS_GATE);
    const float* MOD = (const float*)(p.ws + WS_MOD);
    float* X = p.out;
    for (int t = blockIdx.x * 4 + wave; t < T; t += gridDim.x * 4) {
        const u32x4 ha = *(const u32x4*)(HM + (size_t)t * D + lane * 16), hb = *(const u32x4*)(HM + (size_t)t * D + lane * 16 + 8);
        float hf[16];
        hf[0] = bflo(ha.x); hf[1] = bfhi(ha.x); hf[2] = bflo(ha.y); hf[3] = bfhi(ha.y); hf[4] = bflo(ha.z); hf[5] = bfhi(ha.z); hf[6] = bflo(ha.w); hf[7] = bfhi(ha.w);
        hf[8] = bflo(hb.x); hf[9] = bfhi(hb.x); hf[10] = bflo(hb.y); hf[11] = bfhi(hb.y); hf[12] = bflo(hb.z); hf[13] = bfhi(hb.z); hf[14] = bflo(hb.w); hf[15] = bfhi(hb.w);
        const int e0_ = EXP[(size_t)t * 128 + lane], e1_ = EXP[(size_t)t * 128 + 64 + lane];
        const float g0 = GATE[(size_t)t * 128 + lane], g1 = GATE[(size_t)t * 128 + 64 + lane];
        const float su0 = SU[e0_], su1 = SU[e1_], sv0 = SV[e0_], sv1 = SV[e1_];
        u32x4 buf[16];
        float act0 = 0.f, act1 = 0.f;
        float acc[16];
#pragma unroll
        for (int i = 0; i < 16; ++i) acc[i] = 0.f;
#ifndef APPLY_L2PROBE
#define APPLY_L2PROBE 0
#endif
        for (int prep_ = 0; prep_ < 1 + APPLY_L2PROBE; ++prep_) {
        const int emask = (APPLY_L2PROBE && prep_ == 0) ? 2047 : 0x7fffffff;
        const int e0 = e0_ & emask, e1 = e1_ & emask;
#pragma unroll
        for (int j = 0; j < 16; ++j) { const int e_ = __builtin_amdgcn_readlane(e0, j); buf[j] = *(const u32x4*)(PU + (size_t)e_ * D + lane * 16); }
#pragma unroll
        for (int bt = 0; bt < 16; ++bt) {
#pragma unroll
            for (int j = 0; j < 16; ++j) {
                if (bt < 8) {
                    float s_ = dot8(buf[j].x, buf[j].y, hf, 0.f); s_ = dot8(buf[j].z, buf[j].w, hf + 8, s_);
                    ldsw[((bt & 3) * 16 + j) * 65 + lane] = s_;
                } else {
                    const float av_ = ((bt & 7) < 4) ? act0 : act1;
                    const float a_ = __builtin_bit_cast(float, __builtin_amdgcn_readlane(__builtin_bit_cast(int, av_), (bt & 3) * 16 + j));
                    fma8(buf[j].x, buf[j].y, a_, acc); fma8(buf[j].z, buf[j].w, a_, acc + 8);
                }
                if (bt + 1 < 16) {
                    const int nb = bt + 1;
                    const int e_ = __builtin_amdgcn_readlane(((nb & 7) < 4) ? e0 : e1, (nb & 3) * 16 + j);
                    buf[j] = *(const u32x4*)(((nb < 8) ? PU : PV) + (size_t)e_ * D + lane * 16);
                }
            }
            if (bt == 3 || bt == 7) {
                float tot_ = 0.f;
#pragma unroll 16
                for (int q = 0; q < 64; ++q) tot_ += ldsw[lane * 65 + q];
                if (bt == 3) act0 = gelu_tanh(tot_ * su0) * g0 * sv0; else act1 = gelu_tanh(tot_ * su1) * g1 * sv1;
            }
        }
        if (APPLY_L2PROBE && prep_ == 0 && p.ph_hi >= 0) {
#pragma unroll
            for (int i = 0; i < 16; ++i) acc[i] = 0.f;
        }
        }
        const int b = t / SEQ;
        const float* g2 = MOD + (size_t)(layer * 2 + b) * 6144 + 5120;
        float* xr = X + (size_t)t * D + lane * 16;
        f32x4 xs[4]; float ss = 0.f;
#pragma unroll
        for (int q = 0; q < 4; ++q) {
            const f32x4 g = *(const f32x4*)(g2 + lane * 16 + q * 4); f32x4 x = *(const f32x4*)(xr + q * 4);
            x.x += g.x * acc[q * 4 + 0]; x.y += g.y * acc[q * 4 + 1]; x.z += g.z * acc[q * 4 + 2]; x.w += g.w * acc[q * 4 + 3];
            xs[q] = x; ss += (x.x * x.x + x.y * x.y) + (x.z * x.z + x.w * x.w);
        }
        const float rs = rsqrtf(wave_sum(ss) * (1.0f / D) + RMS_EPS);
        if (!dry) {
            if (layer == 0) {
                const float* gw = p.in[2] + D + lane * 16; const float* sh = MOD + (size_t)(2 + b) * 6144 + lane * 16; const float* sc = sh + 1024;
                u32x4 o[2];
#pragma unroll
                for (int q = 0; q < 4; ++q) {
                    *(f32x4*)(xr + q * 4) = xs[q];
                    const f32x4 g = *(const f32x4*)(gw + q * 4), s1 = *(const f32x4*)(sc + q * 4), s0 = *(const f32x4*)(sh + q * 4);
                    const float y0 = xs[q].x * rs * g.x * (1.f + s1.x) + s0.x, y1 = xs[q].y * rs * g.y * (1.f + s1.y) + s0.y;
                    const float y2 = xs[q].z * rs * g.z * (1.f + s1.z) + s0.z, y3 = xs[q].w * rs * g.w * (1.f + s1.w) + s0.w;
                    if (q & 1) { o[q >> 1].z = pk2(y0, y1); o[q >> 1].w = pk2(y2, y3); } else { o[q >> 1].x = pk2(y0, y1); o[q >> 1].y = pk2(y2, y3); }
                }
                bf16_t* hm = (bf16_t*)(p.ws + WS_HM) + (size_t)t * D + lane * 16;
                *(u32x4*)hm = o[0]; *(u32x4*)(hm + 8) = o[1];
            } else {
                const float* gw = p.in[28] + lane * 16;
#pragma unroll
                for (int q = 0; q < 4; ++q) {
                    const f32x4 g = *(const f32x4*)(gw + q * 4);
                    *(f32x4*)(xr + q * 4) = (f32x4){xs[q].x * rs * g.x, xs[q].y * rs * g.y, xs[q].z * rs * g.z, xs[q].w * rs * g.w};
                }
            }
        }
    }
}
__device__ __forceinline__ void phase_tab1(const Params& p) {
    const int first = vblock() - 256, stride = (int)gridDim.x - 256;
    if (first < 0 || stride <= 0) {
        if (stride <= 0) { for (int it = blockIdx.x; it < 2 * P0_TAB; it += gridDim.x) {
            if (it < P0_TAB) cvt_fp8_item(p.in[26] + (size_t)PE * D, p.ws + WS_PU, (float*)(p.ws + WS_PU + 24 * MiB), it, false);
            else cvt_fp8_item(p.in[27] + (size_t)PE * D, p.ws + WS_PV, (float*)(p.ws + WS_PV + 24 * MiB), it - P0_TAB, false); } }
        return;
    }
    for (int it = first; it < 2 * P0_TAB; it += stride) {
        if (it < P0_TAB) cvt_fp8_item(p.in[26] + (size_t)PE * D, p.ws + WS_PU, (float*)(p.ws + WS_PU + 24 * MiB), it, false);
        else cvt_fp8_item(p.in[27] + (size_t)PE * D, p.ws + WS_PV, (float*)(p.ws + WS_PV + 24 * MiB), it - P0_TAB, false);
    }
}
__device__ __forceinline__ void phase_nsa_proj(const Params& p, unsigned char* lds) {
    const bf16_t* HM = (const bf16_t*)(p.ws + WS_HM); const bf16_t* WT = (const bf16_t*)(p.ws + WS_WPROJ_T);
    const f32x2* ROPE = (const f32x2*)(p.ws + WS_ROPE);
    bf16_t* Q = (bf16_t*)(p.ws + WS_Q); float* NGT = (float*)(p.ws + WS_NG);
    const int lane = threadIdx.x & 63, wid = threadIdx.x >> 6, wr = wid >> 1, wc = wid & 1, fr = lane & 15, fq = lane >> 4;
    for (int id = vblock(); id < 256 * 21; id += gridDim.x) {
        const int mt = id / 21, nt = id % 21;
        f32x4 acc[4][4];
        gemm_tile3(ALoadPlain{HM + (size_t)mt * 128 * D, (size_t)D}, WT + (size_t)nt * 128 * D, D, 16, acc, lds);
        const int c0 = nt * 128 + wc * 64;
        if (c0 >= 2624) continue;
        const int b = (mt * 128) / SEQ;
        if (c0 == 2560) {
#pragma unroll
            for (int mi = 0; mi < 4; ++mi)
#pragma unroll
                for (int ni = 0; ni < 3; ++ni) {
                    const int t = mt * 128 + wr * 64 + mi * 16 + fr;
                    const f32x4 v = acc[mi][ni];
                    *(f32x4*)(NGT + (size_t)t * 48 + ni * 16 + fq * 4) = (f32x4){sigmoidf_(v.x), sigmoidf_(v.y), sigmoidf_(v.z), sigmoidf_(v.w)};
                }
            continue;
        }
        int sec = -1, g = 0;
        if (c0 >= 1024) { sec = (c0 - 1024) >> 8; g = ((c0 - 1024) & 255) >> 6; }
        const bool dorope = (sec == -1) || (sec == 2) || (sec == 4);
        const float scl = (sec == -1) ? 0.125f : 1.0f;
        const size_t secoff[6] = {WS_KC, WS_VC, WS_KS, WS_VST, WS_KW, WS_VWT};
        size_t so = WS_Q;
#pragma unroll
        for (int q = 0; q < 6; ++q) if (sec == q) so = secoff[q];
        bf16_t* OUT = (bf16_t*)(p.ws + so);
        const bool vt = (sec == 3) || (sec == 5);
        float kblk_am = 0.f;
#pragma unroll
        for (int pass = 0; pass < 2; ++pass) {
        if (pass == 1 && sec == 2) {
#pragma unroll
            for (int o = 1; o < 64; o <<= 1) kblk_am = fmaxf(kblk_am, __shfl_xor(kblk_am, o));
            if (lane == 0) ((float*)(p.ws + WS_KS + 12 * MiB))[(size_t)(b * 4 + g) * 256 + ((mt * 128 + wr * 64 - b * SEQ) >> 6)] = kblk_am > 0.f ? kblk_am / 224.0f : 1.0f;
        }
#pragma unroll
        for (int mi = 0; mi < 4; ++mi) {
            const int t = mt * 128 + wr * 64 + mi * 16 + fr, s = t - b * SEQ;
            if (dorope && pass == 0) {
#pragma unroll
                for (int ni = 0; ni < 2; ++ni) {
                    const f32x4* rp = (const f32x4*)(ROPE + (size_t)s * 32 + ni * 16 + fq * 4);
                    const f32x4 r0 = rp[0], r1 = rp[1];
                    const f32x4 x1 = acc[mi][ni], x2 = acc[mi][ni + 2];
                    acc[mi][ni] = (f32x4){x1.x * r0.x - x2.x * r0.y, x1.y * r0.z - x2.y * r0.w, x1.z * r1.x - x2.z * r1.y, x1.w * r1.z - x2.w * r1.w};
                    acc[mi][ni + 2] = (f32x4){x1.x * r0.y + x2.x * r0.x, x1.y * r0.w + x2.y * r0.z, x1.z * r1.y + x2.z * r1.x, x1.w * r1.w + x2.w * r1.z};
                }
            }
            if (pass == 0) {
                if (sec == 2) {
#pragma unroll
                    for (int ni = 0; ni < 4; ++ni) { const f32x4 v = acc[mi][ni]; kblk_am = fmaxf(kblk_am, fmaxf(fmaxf(fabsf(v.x), fabsf(v.y)), fmaxf(fabsf(v.z), fabsf(v.w)))); }
                }
                continue;
            }
            if (sec == -1 || sec == 2) {
                float am = kblk_am;
                if (sec == -1) {
                    am = 0.f;
#pragma unroll
                    for (int ni = 0; ni < 4; ++ni) { const f32x4 v = acc[mi][ni] * scl; am = fmaxf(am, fmaxf(fmaxf(fabsf(v.x), fabsf(v.y)), fmaxf(fabsf(v.z), fabsf(v.w)))); }
                    am = fmaxf(am, __shfl_xor(am, 16)); am = fmaxf(am, __shfl_xor(am, 32));
                }
                const float qs = am > 0.f ? 224.0f / am : 1.0f;
                unsigned char* O8 = (sec == -1) ? (p.ws + WS_Q8 + (size_t)t * 1024 + c0) : (p.ws + WS_KS + ((size_t)(b * 4 + g) * SEQ + s) * 64);
#pragma unroll
                for (int ni = 0; ni < 4; ++ni) {
                    const f32x4 v = acc[mi][ni] * (scl * qs);
                    int w = 0; w = __builtin_amdgcn_cvt_pk_fp8_f32(v.x, v.y, w, false); w = __builtin_amdgcn_cvt_pk_fp8_f32(v.z, v.w, w, true);
                    *(int*)(O8 + ni * 16 + fq * 4) = w;
                }
                if (fq == 0 && sec == -1) ((float*)(p.ws + WS_Q8 + 32 * MiB))[(size_t)t * 16 + (c0 >> 6)] = am > 0.f ? am / 224.0f : 1.0f;
            }
            if (sec == 2) continue;
#pragma unroll
            for (int ni = 0; ni < 4; ++ni) {
                const f32x4 v = acc[mi][ni] * scl;
                const int d = ni * 16 + fq * 4;
                if (sec == -1) {
                    *(u32x2*)(OUT + (size_t)t * 1024 + c0 + d) = (u32x2){pk2(v.x, v.y), pk2(v.z, v.w)};
                } else if (sec == 4) {
                    const size_t idx = (size_t)(b * 4 + g) * SEQ * 64 + (size_t)(s >> 5) * 2048 + ((((s >> 4) & 1) * 2 + (ni >> 1)) * 16 + (s & 15)) * 32 + ((ni & 1) * 2 + (fq >> 1)) * 8 + (fq & 1) * 4;
                    *(u32x2*)(OUT + idx) = (u32x2){pk2(v.x, v.y), pk2(v.z, v.w)};
                } else if (!vt) {
                    *(u32x2*)(OUT + ((size_t)(b * 4 + g) * SEQ + s) * 64 + d) = (u32x2){pk2(v.x, v.y), pk2(v.z, v.w)};
                } else if (sec == 5) {
                    const int key = s & 31;
                    bf16_t* o = OUT + (size_t)(b * 4 + g) * SEQ * 64 + (size_t)(s >> 5) * 2048 + ((ni * 2 + (key >> 4)) * 16 + fq * 4) * 16 + ((key >> 2) & 3) * 4 + (key & 3);
                    o[0] = (bf16_t)f2bf(v.x); o[16] = (bf16_t)f2bf(v.y); o[32] = (bf16_t)f2bf(v.z); o[48] = (bf16_t)f2bf(v.w);
                }
            }
        }
        }
        if (sec == 3) {
            const int s0 = mt * 128 + wr * 64 - b * SEQ, jb = s0 >> 6;
            unsigned char* V8 = p.ws + WS_VST + (size_t)((b * 4 + g) * 256 + jb) * 4096;
            float am = 0.f;
#pragma unroll
            for (int mi = 0; mi < 4; ++mi)
#pragma unroll
                for (int ni = 0; ni < 4; ++ni) { const f32x4 v = acc[mi][ni]; am = fmaxf(am, fmaxf(fmaxf(fabsf(v.x), fabsf(v.y)), fmaxf(fabsf(v.z), fabsf(v.w)))); }
#pragma unroll
            for (int o = 1; o < 64; o <<= 1) am = fmaxf(am, __shfl_xor(am, o));
            const float qs = am > 0.f ? 224.0f / am : 1.0f;
            if (lane == 0) ((float*)(p.ws + WS_VST + 12 * MiB))[(size_t)(b * 4 + g) * 256 + jb] = am > 0.f ? am / 224.0f : 1.0f;
#pragma unroll
            for (int ni = 0; ni < 4; ++ni) {
                const int d = ni * 16 + fq * 4;
#pragma unroll
                for (int mi = 0; mi < 4; ++mi) {
                    const f32x4 v = acc[mi][ni] * qs;
                    int w = 0; w = __builtin_amdgcn_cvt_pk_fp8_f32(v.x, v.y, w, false); w = __builtin_amdgcn_cvt_pk_fp8_f32(v.z, v.w, w, true);
                    unsigned char* o = V8 + (size_t)d * 64 + mi * 16 + fr;
                    o[0] = (unsigned char)(w & 255); o[64] = (unsigned char)((w >> 8) & 255); o[128] = (unsigned char)((w >> 16) & 255); o[192] = (unsigned char)((unsigned)w >> 24);
                }
            }
        }
    }
}
__device__ __forceinline__ void phase_nsa_cmp1(const Params& p, unsigned char* lds) {
    bf16_t* HID = (bf16_t*)(p.ws + WS_HID);
    const float* bias = (const float*)(p.ws + WS_MISC);
    const int lane = threadIdx.x & 63, wid = threadIdx.x >> 6, wr = wid >> 1, wc = wid & 1, fr = lane & 15, fq = lane >> 4;
    for (int id = vblock(); id < 256; id += gridDim.x) {
        const int kv = id >> 7, bg = (id >> 4) & 7, mt = (id >> 1) & 7, nt = id & 1;
        const bf16_t* A = (const bf16_t*)(p.ws + (kv ? WS_VC : WS_KC)) + (size_t)bg * SEQ * 64 + (size_t)mt * 128 * 1024;
        const bf16_t* B = (const bf16_t*)(p.ws + (kv ? WS_WV1_T : WS_WK1_T)) + (size_t)nt * 128 * 2048;
        f32x4 acc[4][4];
        gemm_tile3(ALoadPlain{A, (size_t)1024}, B, 2048, 32, acc, lds);
#pragma unroll
        for (int mi = 0; mi < 4; ++mi)
#pragma unroll
            for (int ni = 0; ni < 4; ++ni) {
                const int n = mt * 128 + wr * 64 + mi * 16 + fr, c = nt * 128 + wc * 64 + ni * 16 + fq * 4;
                const f32x4 bv = *(const f32x4*)(bias + kv * 256 + c);
                const f32x4 v = acc[mi][ni] + bv;
                *(u32x2*)(HID + (((size_t)kv * 8 + bg) * 1024 + n) * 256 + c) = (u32x2){pk2(gelu_tanh(v.x), gelu_tanh(v.y)), pk2(gelu_tanh(v.z), gelu_tanh(v.w))};
            }
    }
}
__device__ __forceinline__ void phase_nsa_cmp2(const Params& p, unsigned char* lds) {
    const bf16_t* HID = (const bf16_t*)(p.ws + WS_HID);
    const f32x2* ROPE = (const f32x2*)(p.ws + WS_ROPE);
    bf16_t* KCMP = (bf16_t*)(p.ws + WS_KCMP); bf16_t* VCMPT = (bf16_t*)(p.ws + WS_VCMPT);
    const int lane = threadIdx.x & 63, wid = threadIdx.x >> 6, wr = wid >> 1, wc = wid & 1, fr = lane & 15, fq = lane >> 4;
    for (int id = vblock(); id < 128; id += gridDim.x) {
        const int kv = id >> 6, mt = id & 63;
        const bf16_t* A = HID + ((size_t)kv * 8192 + (size_t)mt * 128) * 256;
        const bf16_t* B = (const bf16_t*)(p.ws + (kv ? WS_WV2_T : WS_WK2_T));
        f32x4 acc[4][4];
        gemm_tile3(ALoadPlain{A, (size_t)256}, B, 256, 4, acc, lds);
        if (wc == 1) continue;
#pragma unroll
        for (int mi = 0; mi < 4; ++mi) {
            const int R = mt * 128 + wr * 64 + mi * 16 + fr, bg = R >> 10, n = R & 1023;
            if (kv == 0) {
                int pos = n * 16 + 31; pos = pos > SEQ - 1 ? SEQ - 1 : pos;
#pragma unroll
                for (int ni = 0; ni < 2; ++ni) {
                    const f32x4* rp = (const f32x4*)(ROPE + (size_t)pos * 32 + ni * 16 + fq * 4);
                    const f32x4 r0 = rp[0], r1 = rp[1];
                    const f32x4 x1 = acc[mi][ni], x2 = acc[mi][ni + 2];
                    acc[mi][ni] = (f32x4){x1.x * r0.x - x2.x * r0.y, x1.y * r0.z - x2.y * r0.w, x1.z * r1.x - x2.z * r1.y, x1.w * r1.z - x2.w * r1.w};
                    acc[mi][ni + 2] = (f32x4){x1.x * r0.y + x2.x * r0.x, x1.y * r0.w + x2.y * r0.z, x1.z * r1.y + x2.z * r1.x, x1.w * r1.w + x2.w * r1.z};
                }
#pragma unroll
                for (int ni = 0; ni < 4; ++ni) {
                    const f32x4 v = acc[mi][ni];
                    const size_t idx = (size_t)bg * 1024 * 64 + (size_t)(n >> 5) * 2048 + ((((n >> 4) & 1) * 2 + (ni >> 1)) * 16 + (n & 15)) * 32 + ((ni & 1) * 2 + (fq >> 1)) * 8 + (fq & 1) * 4;
                    *(u32x2*)(KCMP + idx) = (u32x2){pk2(v.x, v.y), pk2(v.z, v.w)};
                }
            } else {
#pragma unroll
                for (int ni = 0; ni < 4; ++ni) {
                    const f32x4 v = acc[mi][ni];
                    const int key = n & 31;
                    bf16_t* o = VCMPT + (size_t)bg * 1024 * 64 + (size_t)(n >> 5) * 2048 + ((ni * 2 + (key >> 4)) * 16 + fq * 4) * 16 + ((key >> 2) & 3) * 4 + (key & 3);
                    o[0] = (bf16_t)f2bf(v.x); o[16] = (bf16_t)f2bf(v.y); o[32] = (bf16_t)f2bf(v.z); o[48] = (bf16_t)f2bf(v.w);
                }
            }
        }
    }
}
__device__ __forceinline__ void phase_nsa_wo(const Params& p, unsigned char* lds, bool dry) {
    const bf16_t* O = (const bf16_t*)(p.ws + WS_O); const bf16_t* WT = (const bf16_t*)(p.ws + WS_WO_T);
    const float* MOD = (const float*)(p.ws + WS_MOD);
    float* X = p.out;
    const int lane = threadIdx.x & 63, wid = threadIdx.x >> 6, wr = wid >> 1, wc = wid & 1, fr = lane & 15, fq = lane >> 4;
    for (int id = vblock(); id < 256 * 8; id += gridDim.x) {
        const int mt = id >> 3, nt = id & 7;
        f32x4 acc[4][4];
        gemm_tile3(ALoadPlain{O + (size_t)mt * 128 * D, (size_t)D}, WT + (size_t)nt * 128 * D, D, 16, acc, lds);
        const int b = (mt * 128) / SEQ;
#pragma unroll
        for (int mi = 0; mi < 4; ++mi)
#pragma unroll
            for (int ni = 0; ni < 4; ++ni) {
                const int t = mt * 128 + wr * 64 + mi * 16 + fr, c = nt * 128 + wc * 64 + ni * 16 + fq * 4;
                const f32x4 g1 = *(const f32x4*)(MOD + (size_t)(1 * 2 + b) * 6144 + 2048 + c);
                float* xp = X + (size_t)t * D + c;
                const f32x4 x = *(const f32x4*)xp; const f32x4 v = acc[mi][ni];
                if (!dry) *(f32x4*)xp = (f32x4){x.x + g1.x * v.x, x.y + g1.y * v.y, x.z + g1.z * v.z, x.w + g1.w * v.w};
            }
    }
}
__device__ __forceinline__ bf16x8 pack8(const f32x4 a, const f32x4 b) {
    u32x4 w; w.x = pk2(a.x, a.y); w.y = pk2(a.z, a.w); w.z = pk2(b.x, b.y); w.w = pk2(b.z, b.w);
    return __builtin_bit_cast(bf16x8, w);
}
__device__ __forceinline__ bf16x8 ldv8(const bf16_t* plo, const bf16_t* phi) {
    const u32x2 lo = *(const u32x2*)plo, hi = *(const u32x2*)phi;
    u32x4 w; w.x = lo.x; w.y = lo.y; w.z = hi.x; w.w = hi.y;
    return __builtin_bit_cast(bf16x8, w);
}
__device__ __forceinline__ float red4(float v) { v += __shfl_xor(v, 16); v += __shfl_xor(v, 32); return v; }
__device__ __forceinline__ float max4(float v) { v = fmaxf(v, __shfl_xor(v, 16)); v = fmaxf(v, __shfl_xor(v, 32)); return v; }
#define NEGBIG (-1.0e30f)

__device__ __forceinline__ void phase_nsa_attn(const Params& p, unsigned char* lds, const int rep_cmp, const int rep_win, const int rep_sel) {
    const int lane = threadIdx.x & 63, wave = threadIdx.x >> 6, fr = lane & 15, fq = lane >> 4;
    unsigned char* WL = lds + wave * 18432;
    float* IMP = (float*)WL;
    int* SEL = (int*)(WL + 17408);
    const bf16_t* Q = (const bf16_t*)(p.ws + WS_Q);
    const bf16_t* KCMP = (const bf16_t*)(p.ws + WS_KCMP); const bf16_t* VCMPT = (const bf16_t*)(p.ws + WS_VCMPT);
    const bf16_t* KW = (const bf16_t*)(p.ws + WS_KW); const bf16_t* VWT = (const bf16_t*)(p.ws + WS_VWT);
    const float* NGT = (const float*)(p.ws + WS_NG);
    bf16_t* O = (bf16_t*)(p.ws + WS_O);
    const f32x4 z4 = (f32x4){0.f, 0.f, 0.f, 0.f};
    for (int bi = blockIdx.x; bi < 2048; bi += gridDim.x) {
        const int bg = bi & 7, quad = 255 - (bi >> 3), t0 = (quad * 4 + wave) * 16, b = bg >> 2, g = bg & 3;
        const int cur = t0 >> 6;
        const size_t tok = (size_t)b * SEQ + t0 + fr;
        const int tq = t0 + fr;
        bf16x8 qf[4][2];
#pragma unroll
        for (int r = 0; r < 4; ++r)
#pragma unroll
            for (int ks = 0; ks < 2; ++ks) qf[r][ks] = *(const bf16x8*)(Q + tok * 1024 + (g * 4 + r) * 64 + ks * 32 + fq * 8);
        f32x4 acc[4][4];
        for (int rep = 0; rep < rep_win; ++rep) {
            const bf16_t* kwb = KW + (size_t)bg * SEQ * 64; const bf16_t* vwb = VWT + (size_t)bg * SEQ * 64;
            float mw[4], lw[4];
#pragma unroll
            for (int r = 0; r < 4; ++r) { mw[r] = NEGBIG; lw[r] = 0.f;
#pragma unroll
                for (int df = 0; df < 4; ++df) acc[r][df] = z4; }
            int kmin = t0 - 511; kmin = kmin < 0 ? 0 : kmin; kmin &= ~31;
            bf16x8 nkf[2][2];
#define WIN_LOAD(kb_) do { _Pragma("unroll") for (int f = 0; f < 2; ++f) _Pragma("unroll") for (int ks = 0; ks < 2; ++ks) nkf[f][ks] = *(const bf16x8*)(kwb + (size_t)((kb_) >> 5) * 2048 + ((f * 2 + ks) * 16 + fr) * 32 + fq * 8); } while (0)
            WIN_LOAD(kmin);
            for (int kb = kmin; kb <= t0 + 15; kb += 32) {
                bf16x8 kf[2][2], vf[4];
#pragma unroll
                for (int f = 0; f < 2; ++f) { kf[f][0] = nkf[f][0]; kf[f][1] = nkf[f][1]; }
#pragma unroll
                for (int df = 0; df < 4; ++df) { const bf16_t* vp = vwb + (size_t)(kb >> 5) * 2048 + (df * 32 + fr) * 16 + fq * 4; vf[df] = ldv8(vp, vp + 256); }
                { const int kn = (kb + 32 <= t0 + 15) ? kb + 32 : kb; WIN_LOAD(kn); }
#pragma unroll
                for (int r = 0; r < 4; ++r) {
                    f32x4 st[2];
#pragma unroll
                    for (int f = 0; f < 2; ++f) {
                        st[f] = __builtin_amdgcn_mfma_f32_16x16x32_bf16(kf[f][0], qf[r][0], z4, 0, 0, 0);
                        st[f] = __builtin_amdgcn_mfma_f32_16x16x32_bf16(kf[f][1], qf[r][1], st[f], 0, 0, 0);
                    }
                    float mx = NEGBIG;
#pragma unroll
                    for (int f = 0; f < 2; ++f)
#pragma unroll
                        for (int e = 0; e < 4; ++e) { const int key = kb + f * 16 + fq * 4 + e; const bool ok = (key <= tq) && (key > tq - 512); if (ok) mx = fmaxf(mx, st[f][e]); }
                    float mn = mw[r], al = 1.0f;
                    if (__builtin_amdgcn_ballot_w64(mx > mw[r] + 8.0f) != 0ull) { mn = fmaxf(mw[r], max4(mx)); al = __expf(mw[r] - mn); }
                    float ps = 0.f;
#pragma unroll
                    for (int f = 0; f < 2; ++f)
#pragma unroll
                        for (int e = 0; e < 4; ++e) { const int key = kb + f * 16 + fq * 4 + e; const bool ok = (key <= tq) && (key > tq - 512); const float pv = ok ? __expf(st[f][e] - mn) : 0.f; st[f][e] = pv; ps += pv; }
                    lw[r] = lw[r] * al + ps; mw[r] = mn;
                    const bf16x8 pf = pack8(st[0], st[1]);
#pragma unroll
                    for (int df = 0; df < 4; ++df) { acc[r][df] = acc[r][df] * al; acc[r][df] = __builtin_amdgcn_mfma_f32_16x16x32_bf16(vf[df], pf, acc[r][df], 0, 0, 0); }
                    __builtin_amdgcn_sched_barrier(0);
                }
            }
#pragma unroll
            for (int r = 0; r < 4; ++r) {
                const float l = red4(lw[r]); const float sc = NGT[tok * 48 + (g * 4 + r) * 3 + 2] / l;
#pragma unroll
                for (int df = 0; df < 4; ++df) acc[r][df] = acc[r][df] * sc;
            }
#undef WIN_LOAD
        }
        const int nmax_tile = (t0 >> 4) - 1, nmax_lane = (t0 >> 4) - 2 + (fr == 15 ? 1 : 0);
        const bf16_t* kcb = KCMP + (size_t)bg * 1024 * 64; const bf16_t* vcb = VCMPT + (size_t)bg * 64 * 1024;
        for (int rep = 0; rep < rep_cmp; ++rep) {
            const bool dry = (rep + 1 < rep_cmp);
            float mc[4], lc[4], invl[4];
#pragma unroll
            for (int r = 0; r < 4; ++r) { mc[r] = NEGBIG; lc[r] = 0.f; }
            bf16x8 nkc[2][2], nvc[4];
#define CMPK_LOAD(nb_) do { _Pragma("unroll") for (int f = 0; f < 2; ++f) _Pragma("unroll") for (int ks = 0; ks < 2; ++ks) nkc[f][ks] = *(const bf16x8*)(kcb + (size_t)((nb_) >> 5) * 2048 + ((f * 2 + ks) * 16 + fr) * 32 + fq * 8); } while (0)
#define CMPV_LOAD(nb_) do { _Pragma("unroll") for (int df = 0; df < 4; ++df) { const bf16_t* vp = vcb + (size_t)((nb_) >> 5) * 2048 + (df * 32 + fr) * 16 + fq * 4; nvc[df] = ldv8(vp, vp + 256); } } while (0)
            CMPK_LOAD(0);
            for (int nb = 0; nb <= nmax_tile; nb += 32) {
                bf16x8 kf[2][2];
#pragma unroll
                for (int f = 0; f < 2; ++f) { kf[f][0] = nkc[f][0]; kf[f][1] = nkc[f][1]; }
                { const int nn = (nb + 32 <= nmax_tile) ? nb + 32 : 0; CMPK_LOAD(nn); }
#pragma unroll
                for (int r = 0; r < 4; ++r) {
                    f32x4 st[2];
#pragma unroll
                    for (int f = 0; f < 2; ++f) {
                        st[f] = __builtin_amdgcn_mfma_f32_16x16x32_bf16(kf[f][0], qf[r][0], z4, 0, 0, 0);
                        st[f] = __builtin_amdgcn_mfma_f32_16x16x32_bf16(kf[f][1], qf[r][1], st[f], 0, 0, 0);
                    }
                    float mx = NEGBIG;
#pragma unroll
                    for (int f = 0; f < 2; ++f)
#pragma unroll
                        for (int e = 0; e < 4; ++e) { const int n = nb + f * 16 + fq * 4 + e; if (n <= nmax_lane) mx = fmaxf(mx, st[f][e]); }
                    float mn = mc[r];
                    if (__builtin_amdgcn_ballot_w64(mx > mc[r] + 8.0f) != 0ull) mn = fmaxf(mc[r], max4(mx));
                    float ps = 0.f;
#pragma unroll
                    for (int f = 0; f < 2; ++f)
#pragma unroll
                        for (int e = 0; e < 4; ++e) { const int n = nb + f * 16 + fq * 4 + e; if (n <= nmax_lane) ps += __expf(st[f][e] - mn); }
                    lc[r] = lc[r] * __expf(mc[r] - mn) + ps; mc[r] = mn;
                    __builtin_amdgcn_sched_barrier(0);
                }
            }
#pragma unroll
            for (int r = 0; r < 4; ++r) { const float l = red4(lc[r]); invl[r] = l > 0.f ? 1.0f / l : 0.f; }
            for (int i = lane; i < 16 * 260; i += 64) IMP[i] = 0.f;
            float carry = 0.f;
            float gc[4];
#pragma unroll
            for (int r = 0; r < 4; ++r) gc[r] = NGT[tok * 48 + (g * 4 + r) * 3];
            for (int nb = 0; nb <= nmax_tile; nb += 32) {
                bf16x8 kf[2][2], vf[4];
#pragma unroll
                for (int f = 0; f < 2; ++f) { kf[f][0] = nkc[f][0]; kf[f][1] = nkc[f][1]; }
                CMPV_LOAD(nb);
#pragma unroll
                for (int df = 0; df < 4; ++df) vf[df] = nvc[df];
                { const int nn = (nb + 32 <= nmax_tile) ? nb + 32 : nb; CMPK_LOAD(nn); }
                f32x4 pg[2] = {z4, z4};
#pragma unroll
                for (int r = 0; r < 4; ++r) {
                    f32x4 st[2];
#pragma unroll
                    for (int f = 0; f < 2; ++f) {
                        st[f] = __builtin_amdgcn_mfma_f32_16x16x32_bf16(kf[f][0], qf[r][0], z4, 0, 0, 0);
                        st[f] = __builtin_amdgcn_mfma_f32_16x16x32_bf16(kf[f][1], qf[r][1], st[f], 0, 0, 0);
#pragma unroll
                        for (int e = 0; e < 4; ++e) { const int n = nb + f * 16 + fq * 4 + e; st[f][e] = (n <= nmax_lane) ? __expf(st[f][e] - mc[r]) * invl[r] : 0.f; }
                        pg[f] += st[f];
                    }
                    const float gg = dry ? 0.f : gc[r];
                    const bf16x8 pf = pack8(st[0] * gg, st[1] * gg);
#pragma unroll
                    for (int df = 0; df < 4; ++df) acc[r][df] = __builtin_amdgcn_mfma_f32_16x16x32_bf16(vf[df], pf, acc[r][df], 0, 0, 0);
                    __builtin_amdgcn_sched_barrier(0);
                }
                const int src = (lane - 16) & 63;
                const float s0 = __shfl(pg[0].w, src), s1 = __shfl(pg[1].w, src), sc = __shfl(carry, src);
                const float prev0 = fq > 0 ? s0 : sc, prev1 = fq > 0 ? s1 : s0;
                const float imp0 = (pg[0].x + pg[0].y) + (pg[0].z + pg[0].w) + prev0;
                const float imp1 = (pg[1].x + pg[1].y) + (pg[1].z + pg[1].w) + prev1;
                const int jb = (nb >> 2) + fq;
                IMP[fr * 260 + jb] = imp0; IMP[fr * 260 + jb + 4] = imp1;
                carry = pg[1].w;
            }
#undef CMPK_LOAD
#undef CMPV_LOAD
        }
        {
            const int nf = cur >= 2 ? 3 : cur + 1;
            if (fq == 0) {
                SEL[fr * 16 + 0] = 0;
                if (cur == 1) SEL[fr * 16 + 1] = 1;
                if (cur >= 2) { SEL[fr * 16 + 1] = cur - 1; SEL[fr * 16 + 2] = cur; }
            }
            const int ncand = cur >= 3 ? cur - 2 : 0, extra = 16 - nf;
            if (ncand <= extra) {
                if (fq == 0) { for (int k = 0; k < extra; ++k) SEL[fr * 16 + nf + k] = (k < ncand) ? 1 + k : -1; }
            } else {
                for (int rnd = 0; rnd < extra; ++rnd) {
                    float bv = -1.0f; int bj = 1 << 20;
                    for (int jb = 1 + fq; jb <= cur - 2; jb += 4) { const float v = IMP[fr * 260 + jb]; if (v > bv) { bv = v; bj = jb; } }
#pragma unroll
                    for (int o = 16; o <= 32; o <<= 1) {
                        const float ov = __shfl_xor(bv, o); const int oj = __shfl_xor(bj, o);
                        if (ov > bv || (ov == bv && oj < bj)) { bv = ov; bj = oj; }
                    }
                    if (fq == 0) SEL[fr * 16 + nf + rnd] = bj;
                    if (((bj - 1) & 3) == fq) IMP[fr * 260 + bj] = -2.0f;
                }
            }
        }
#pragma unroll
        for (int r = 0; r < 4; ++r)
#pragma unroll
            for (int df = 0; df < 4; ++df) {
                const f32x4 v = acc[r][df];
                *(u32x2*)(O + tok * 1024 + (g * 4 + r) * 64 + df * 16 + fq * 4) = (u32x2){pk2(v.x, v.y), pk2(v.z, v.w)};
            }
        asm volatile("s_waitcnt vmcnt(0)" ::: "memory");
        unsigned selp[4];
        {
            const u32x4* sp = (const u32x4*)(SEL + fr * 16);
#pragma unroll
            for (int q = 0; q < 4; ++q) { const u32x4 w = sp[q]; selp[q] = (w.x & 255u) | ((w.y & 255u) << 8) | ((w.z & 255u) << 16) | ((w.w & 255u) << 24); }
        }
        for (int rep = 0; rep < rep_sel; ++rep) {
            const bool dry = (rep + 1 < rep_sel);
            const unsigned char* k8b = p.ws + WS_KS + (size_t)bg * SEQ * 64; const unsigned char* v8b = p.ws + WS_VST + (size_t)bg * 256 * 4096;
            const float* skb = (const float*)(p.ws + WS_KS + 12 * MiB) + (size_t)bg * 256; const float* svb = (const float*)(p.ws + WS_VST + 12 * MiB) + (size_t)bg * 256;
            const unsigned char* Q8 = p.ws + WS_Q8; const float* SQ8 = (const float*)(p.ws + WS_Q8 + 32 * MiB);
            const int nv = cur + 1 < 16 ? cur + 1 : 16, npair = (nv + 1) >> 1, total = 16 * npair;
            const int lrow = lane >> 2, lch = lane & 3;
            const int woff = lrow * 72 + lch * 16;
            const int rr = fr & 3;
            u32x4 sk[2][4], sv[2][4]; float ssk[2], ssv[2];
            int jbn[2];
#define SEL_GET(tokI, slotK) ((int)(((unsigned)__builtin_amdgcn_readlane((int)(((slotK) >> 2) == 0 ? selp[0] : ((slotK) >> 2) == 1 ? selp[1] : ((slotK) >> 2) == 2 ? selp[2] : selp[3]), (tokI)) >> (((slotK) & 3) * 8)) & 255u))
#define SEL_ISSUE(tokI, pairP) do { \
                const int k0_ = 2 * (pairP), k1_ = (2 * (pairP) + 1 < nv) ? 2 * (pairP) + 1 : k0_; \
                jbn[0] = __builtin_amdgcn_readfirstlane(SEL_GET(tokI, k0_)); jbn[1] = __builtin_amdgcn_readfirstlane(SEL_GET(tokI, k1_)); \
                _Pragma("unroll") for (int u = 0; u < 2; ++u) { \
                    const unsigned char* kb_ = k8b + (size_t)jbn[u] * 4096; const unsigned char* vb_ = v8b + (size_t)jbn[u] * 4096; \
                    _Pragma("unroll") for (int j = 0; j < 4; ++j) { sk[u][j] = *(const u32x4*)(kb_ + j * 1024 + lane * 16); sv[u][j] = *(const u32x4*)(vb_ + j * 1024 + lane * 16); } \
                    ssk[u] = skb[jbn[u]]; ssv[u] = svb[jbn[u]]; } } while (0)
            SEL_ISSUE(0, 0);
            long qs8[2] = {0, 0};
            float sq = 0.f, ms = NEGBIG, ls = 0.f;
            f32x4 os[4] = {z4, z4, z4, z4};
            u32x2 oprev[4] = {(u32x2){0u, 0u}, (u32x2){0u, 0u}, (u32x2){0u, 0u}, (u32x2){0u, 0u}};
            int i = 0, pp = 0;
            for (int v = 0; v < total; ++v) {
                const int jb0 = jbn[0], jb1 = jbn[1];
                const bool second_valid = (2 * pp + 1 < nv);
                const float ck0 = ssk[0], ck1 = ssk[1], cv0 = ssv[0], cv1 = ssv[1];
#pragma unroll
                for (int u = 0; u < 2; ++u)
#pragma unroll
                    for (int j = 0; j < 4; ++j) {
                        unsigned char* kd = WL + u * 9216 + woff + j * 1152; unsigned char* vd = kd + 4608;
                        *(u32x2*)kd = (u32x2){sk[u][j].x, sk[u][j].y}; *(u32x2*)(kd + 8) = (u32x2){sk[u][j].z, sk[u][j].w};
                        *(u32x2*)vd = (u32x2){sv[u][j].x, sv[u][j].y}; *(u32x2*)(vd + 8) = (u32x2){sv[u][j].z, sv[u][j].w};
                    }
                if (v + 1 < total) {
                    int p2 = pp + 1, i2 = i; if (p2 == npair) { p2 = 0; i2 = i + 1; }
                    SEL_ISSUE(i2, p2);
                }
                __builtin_amdgcn_sched_barrier(0);
                const int ti = t0 + i;
                if (pp == 0) {
                    const size_t tk = (size_t)b * SEQ + ti;
#pragma unroll
                    for (int ks = 0; ks < 2; ++ks) qs8[ks] = *(const long*)(Q8 + tk * 1024 + (g * 4 + rr) * 64 + ks * 32 + fq * 8);
                    sq = SQ8[tk * 16 + g * 4 + rr] * 1.4426950408889634f;
                    ms = NEGBIG; ls = 0.f;
#pragma unroll
                    for (int df = 0; df < 4; ++df) { os[df] = z4; oprev[df] = *(const u32x2*)(O + tk * 1024 + (g * 4 + rr) * 64 + df * 16 + fq * 4); }
                }
                f32x4 st[2][4];
#pragma unroll
                for (int u = 0; u < 2; ++u)
#pragma unroll
                    for (int f = 0; f < 4; ++f) {
                        const unsigned char* kp = WL + u * 9216 + (32 * (f >> 1) + 8 * (fr >> 2) + 4 * (f & 1) + (fr & 3)) * 72 + fq * 8;
                        const long k0 = *(const long*)kp, k1 = *(const long*)(kp + 32);
                        st[u][f] = __builtin_amdgcn_mfma_f32_16x16x32_fp8_fp8(k0, qs8[0], z4, 0, 0, 0);
                        st[u][f] = __builtin_amdgcn_mfma_f32_16x16x32_fp8_fp8(k1, qs8[1], st[u][f], 0, 0, 0);
                    }
                const float c0_ = sq * ck0, c1_ = sq * ck1;
                if (jb0 == cur || jb1 == cur || !second_valid) {
#pragma unroll
                    for (int u = 0; u < 2; ++u) {
                        const int jbu = u ? jb1 : jb0;
                        const bool allbad = (u == 1) && !second_valid;
#pragma unroll
                        for (int f = 0; f < 4; ++f)
#pragma unroll
                            for (int e = 0; e < 4; ++e) { const int key = jbu * 64 + 32 * (f >> 1) + 8 * fq + 4 * (f & 1) + e; if (allbad || key > ti) st[u][f][e] = NEGBIG; }
                    }
                }
                float mx0 = NEGBIG, mx1 = NEGBIG;
#pragma unroll
                for (int f = 0; f < 4; ++f) { mx0 = fmaxf(mx0, fmaxf(fmaxf(st[0][f].x, st[0][f].y), fmaxf(st[0][f].z, st[0][f].w))); mx1 = fmaxf(mx1, fmaxf(fmaxf(st[1][f].x, st[1][f].y), fmaxf(st[1][f].z, st[1][f].w))); }
                const float mxl = fmaxf(mx0 > -1.0e29f ? mx0 * c0_ : NEGBIG, mx1 > -1.0e29f ? mx1 * c1_ : NEGBIG);
                float mn = ms, al = 1.0f;
                if (__builtin_amdgcn_ballot_w64(mxl > ms + 4.0f) != 0ull) {
                    mn = fmaxf(ms, max4(mxl));
                    al = __builtin_amdgcn_exp2f(ms - mn);
                }
                const float off = 4.0f - mn;
                float ps = 0.f;
                long pfw[2][2];
#pragma unroll
                for (int u = 0; u < 2; ++u) {
                    const float cu = u ? c1_ : c0_;
#pragma unroll
                    for (int f = 0; f < 4; ++f)
#pragma unroll
                        for (int e = 0; e < 4; ++e) { const float pv = __builtin_amdgcn_exp2f(st[u][f][e] * cu + off); st[u][f][e] = pv; ps += pv; }
#pragma unroll
                    for (int s = 0; s < 2; ++s) {
                        int w0 = 0, w1 = 0;
                        w0 = __builtin_amdgcn_cvt_pk_fp8_f32(st[u][2 * s].x, st[u][2 * s].y, w0, false); w0 = __builtin_amdgcn_cvt_pk_fp8_f32(st[u][2 * s].z, st[u][2 * s].w, w0, true);
                        w1 = __builtin_amdgcn_cvt_pk_fp8_f32(st[u][2 * s + 1].x, st[u][2 * s + 1].y, w1, false); w1 = __builtin_amdgcn_cvt_pk_fp8_f32(st[u][2 * s + 1].z, st[u][2 * s + 1].w, w1, true);
                        pfw[u][s] = (long)(((unsigned long long)(unsigned)w1 << 32) | (unsigned long long)(unsigned)w0);
                    }
                }
                ls = ls * al + ps; ms = mn;
#pragma unroll
                for (int df = 0; df < 4; ++df) os[df] = os[df] * al;
#pragma unroll
                for (int u = 0; u < 2; ++u) {
                    f32x4 pvacc[4] = {z4, z4, z4, z4};
#pragma unroll
                    for (int s = 0; s < 2; ++s) {
#pragma unroll
                        for (int df = 0; df < 4; ++df) {
                            const long vf = *(const long*)(WL + u * 9216 + 4608 + (df * 16 + fr) * 72 + 32 * s + 8 * fq);
                            pvacc[df] = __builtin_amdgcn_mfma_f32_16x16x32_fp8_fp8(vf, pfw[u][s], pvacc[df], 0, 0, 0);
                        }
                    }
                    const float cvu = u ? cv1 : cv0;
#pragma unroll
                    for (int df = 0; df < 4; ++df) os[df] = os[df] + pvacc[df] * cvu;
                    __builtin_amdgcn_sched_barrier(0);
                }
                if (pp == npair - 1) {
                    const float l = red4(ls);
                    const float gsv = NGT[((size_t)b * SEQ + ti) * 48 + (g * 4 + rr) * 3 + 1];
                    const float sc = gsv / l;
                    if (fr < 4 && !dry) {
                        bf16_t* op = O + ((size_t)b * SEQ + ti) * 1024 + (g * 4 + fr) * 64 + fq * 4;
#pragma unroll
                        for (int df = 0; df < 4; ++df) {
                            const f32x4 val = os[df] * sc; const u32x2 c = oprev[df];
                            *(u32x2*)(op + df * 16) = (u32x2){pk2(bflo(c.x) + val.x, bfhi(c.x) + val.y), pk2(bflo(c.y) + val.z, bfhi(c.y) + val.w)};
                        }
                    }
                }
                ++pp; if (pp == npair) { pp = 0; ++i; }
            }
#undef SEL_GET
#undef SEL_ISSUE
        }
    }
}
constexpr int NPHASES = 22;
#ifndef PROBE_PHASE
#define PROBE_PHASE (-1)
#endif
#ifndef ATT_REP_CMP
#define ATT_REP_CMP 1
#endif
#ifndef ATT_REP_WIN
#define ATT_REP_WIN 1
#endif
#ifndef ATT_REP_SEL
#define ATT_REP_SEL 1
#endif
#ifndef TS_PHASE
#define TS_PHASE (-1)
#endif
#ifndef TS_MULT
#define TS_MULT 4
#endif
#ifndef PROBE_REPS
#define PROBE_REPS 1
#endif
__global__ void __launch_bounds__(NTHREADS, 2) mega(Params p) {
    __shared__ __attribute__((aligned(1024))) unsigned char lds[LDS_BYTES + 16];
    unsigned* bar_st = (unsigned*)(lds + LDS_BYTES);
    cg::grid_group grid = cg::this_grid();
    const float* MOD = (const float*)(p.ws + WS_MOD);
    bf16_t* HM = (bf16_t*)(p.ws + WS_HM);
    if (threadIdx.x < 4) bar_st[threadIdx.x] = 0u;
    __syncthreads();
    XcdBarrier bar = xcd_barrier_post((unsigned*)(p.ws + WS_CTL), (volatile LAS unsigned*)bar_st);
    const int lo = p.ph_lo, hi = p.ph_hi;
    const bool dry0 = (p.ph_hi < 0);
    const int opq = (p.ph_hi < 0) ? 1 : 0;
    const bool never = (p.ph_hi < 0);
    unsigned long long ts_a = 0ull, ts_b = 0ull;
#define PHASE(k, call, drycall) if (lo <= (k) && (k) < hi) { \
        if (TS_PHASE == (k)) ts_a = __builtin_amdgcn_s_memrealtime(); \
        if (PROBE_PHASE == (k)) { for (int rep = 0; rep < PROBE_REPS; ++rep) { const bool dry = !dry0; drycall; __syncthreads(); } } \
        { const bool dry = dry0; call; } \
        if ((k) + 1 < hi) { if (never) grid.sync(); else xcd_barrier(bar); } \
        if (TS_PHASE == (k)) ts_b = __builtin_amdgcn_s_memrealtime(); }
    PHASE(0, phase_prep(p, (float*)lds, 0), phase_prep(p, (float*)lds, 0))
    PHASE(1, phase_norm(p, p.in[0], p.in[2], MOD + 0, MOD + 1024, HM), phase_norm(p, p.in[0], p.in[2], MOD + 0, MOD + 1024, HM))
    PHASE(2, phase_s5_win(p, lds), phase_s5_win(p, lds))
    PHASE(3, phase_s5_a(p, lds), phase_s5_a(p, lds))
    PHASE(4, (phase_s5_scan(p), phase_prep(p, (float*)lds, 1)), (phase_s5_scan(p), phase_prep(p, (float*)lds, 1)))
    PHASE(5, phase_s5_b(p, lds), phase_s5_b(p, lds))
    PHASE(6, phase_s5_glu(p, lds), phase_s5_glu(p, lds))
    PHASE(7, phase_norm(p, p.out, p.in[3], MOD + 3072, MOD + 4096, HM), phase_norm(p, p.out, p.in[3], MOD + 3072, MOD + 4096, HM))
    PHASE(8, phase_peer_wq(p, 0, lds), phase_peer_wq(p, 0, lds))
    PHASE(9, phase_peer_topk(p, 0, lds), phase_peer_topk(p, 0, lds))
    PHASE(10, phase_peer_combine(p, lds), phase_peer_combine(p, lds))
    PHASE(11, phase_peer_apply(p, 0, lds, dry), phase_peer_apply(p, 0, lds, dry))
    PHASE(12, phase_nsa_proj(p, lds), phase_nsa_proj(p, lds))
    PHASE(13, (phase_nsa_cmp1(p, lds), phase_tab1(p)), (phase_nsa_cmp1(p, lds), phase_tab1(p)))
    PHASE(14, phase_nsa_cmp2(p, lds), phase_nsa_cmp2(p, lds))
    PHASE(15, phase_nsa_attn(p, lds, ATT_REP_CMP + opq, ATT_REP_WIN + opq, ATT_REP_SEL + opq), phase_nsa_attn(p, lds, 1 + opq, 1 + opq, 1 + opq))
    PHASE(16, phase_nsa_wo(p, lds, dry), phase_nsa_wo(p, lds, dry))
    PHASE(17, phase_norm(p, p.out, p.in[3] + D, MOD + 2 * 6144 + 3072, MOD + 2 * 6144 + 4096, HM), phase_norm(p, p.out, p.in[3] + D, MOD + 2 * 6144 + 3072, MOD + 2 * 6144 + 4096, HM))
    PHASE(18, phase_peer_wq(p, 1, lds), phase_peer_wq(p, 1, lds))
    PHASE(19, phase_peer_topk(p, 1, lds), phase_peer_topk(p, 1, lds))
    PHASE(20, phase_peer_combine(p, lds), phase_peer_combine(p, lds))
    PHASE(21, phase_peer_apply(p, 1, lds, dry), phase_peer_apply(p, 1, lds, dry))
#undef PHASE
    if (TS_PHASE >= 0 && blockIdx.x == 0 && threadIdx.x == 0) {
        const unsigned long long t0 = __builtin_amdgcn_s_memrealtime(), want = (ts_b - ts_a) * TS_MULT;
        while (__builtin_amdgcn_s_memrealtime() - t0 < want) __builtin_amdgcn_s_sleep(8);
    }
}

extern "C" void kernel_launch(void* const* d_in, const int* in_sizes, int n_in, void* d_out, int out_size, void* d_ws, size_t ws_size, hipStream_t stream) {
    static int grid_blocks = 0;
    if (!grid_blocks) {
        int dev = 0, cus = 0, per_cu = 0;
        hipGetDevice(&dev);
        hipDeviceGetAttribute(&cus, hipDeviceAttributeMultiprocessorCount, dev);
        hipOccupancyMaxActiveBlocksPerMultiprocessor(&per_cu, mega, NTHREADS, 0);
        if (per_cu > 2) per_cu = 2;
        if (per_cu < 1) per_cu = 1;
        grid_blocks = cus * per_cu;
        if (ws_size < WS_END) fprintf(stderr, "kernel_launch: workspace too small: %zu < %zu\n", ws_size, (size_t)WS_END);
        if (n_in != 29) fprintf(stderr, "kernel_launch: expected 29 inputs, got %d\n", n_in);
    }
    hipMemsetAsync((unsigned char*)d_ws + WS_CTL, 0, 16384, stream);
    Params p{};
    for (int i = 0; i < 29; ++i) p.in[i] = (const float*)d_in[i];
    p.out = (float*)d_out; p.ws = (unsigned char*)d_ws;
#if SINGLE_LAUNCH
    p.ph_lo = 0; p.ph_hi = NPHASES;
    void* args[] = {&p};
    hipError_t e = hipLaunchCooperativeKernel((void*)mega, dim3(grid_blocks), dim3(NTHREADS), args, 0, stream);
    if (e != hipSuccess) fprintf(stderr, "cooperative launch failed: %s (grid %d)\n", hipGetErrorString(e), grid_blocks);
#else
    for (int ph = 0; ph < NPHASES; ++ph) {
        p.ph_lo = ph; p.ph_hi = ph + 1;
        hipLaunchKernelGGL(mega, dim3(grid_blocks), dim3(NTHREADS), 0, stream, p);
    }
#endif
}
```

```cpp
#include <hip/hip_runtime.h>
#include <hip/hip_cooperative_groups.h>
#include <cstdio>
#include <cstdint>
namespace cg = cooperative_groups;

#ifndef SINGLE_LAUNCH
#define SINGLE_LAUNCH 1
#endif

typedef unsigned short bf16_t;
typedef short bf16x8 __attribute__((ext_vector_type(8)));
typedef float f32x4 __attribute__((ext_vector_type(4)));
typedef float f32x2 __attribute__((ext_vector_type(2)));
typedef unsigned u32x4 __attribute__((ext_vector_type(4)));
typedef unsigned u32x2 __attribute__((ext_vector_type(2)));
typedef __bf16 bf16x2_t __attribute__((ext_vector_type(2)));

constexpr int D = 1024, BATCH = 2, SEQ = 16384, T = BATCH * SEQ;
constexpr int NTHREADS = 256;
constexpr float RMS_EPS = 1e-6f;
constexpr int S5G = 64, S5P = 64, S5L = 32, S5NCH = T / S5L  , S5CPB = SEQ / S5L  ;
constexpr int NH = 16, HD = 64, NG = 4, NPROJ = 2608, NPROJ_PAD = 2688, NC = 1023, NSB = 256;
constexpr int PH = 8, PK = 16, PNK = 128, PE = 16384;

constexpr size_t MiB = 1ull << 20;
constexpr size_t WS_CTL = 0;
constexpr size_t WS_MOD = 1 * MiB;
constexpr size_t WS_WIN_T = 2 * MiB;
constexpr size_t WS_WGLU_T = 4 * MiB;
constexpr size_t WS_WPROJ_T = 8 * MiB;
constexpr size_t WS_WK1_T = 14 * MiB;
constexpr size_t WS_WV1_T = 15 * MiB;
constexpr size_t WS_WK2_T = 16 * MiB;
constexpr size_t WS_WV2_T = 16 * MiB + 512 * 1024;
constexpr size_t WS_WO_T = 17 * MiB;
constexpr size_t WS_WQ_T = 19 * MiB;
constexpr size_t WS_SUBK = 27 * MiB;
constexpr size_t WS_ROPE = 28 * MiB;
constexpr size_t WS_MISC = 32 * MiB;
constexpr size_t WS_TW = 33 * MiB;
constexpr size_t WS_VG = 73 * MiB;
constexpr size_t WS_PU = 82 * MiB;
constexpr size_t WS_PV = 114 * MiB;
constexpr size_t WS_HM = 146 * MiB;
constexpr size_t WS_C = 210 * MiB;
constexpr size_t WS_UG = WS_C;
constexpr size_t WS_YI = WS_C + 64 * MiB;
constexpr size_t WS_WST = WS_C + 128 * MiB;
constexpr size_t WS_SST = WS_C + 160 * MiB;
constexpr size_t WS_YG = WS_C + 176 * MiB;
constexpr size_t WS_QK = WS_C;
constexpr size_t WS_TOPS = WS_C + 128 * MiB;
constexpr size_t WS_TOPI = WS_C + 160 * MiB;
constexpr size_t WS_EXP = WS_C + 192 * MiB;
constexpr size_t WS_GATE = WS_C + 208 * MiB;
constexpr size_t WS_ACT = WS_C + 224 * MiB;
constexpr size_t WS_Q = WS_C;
constexpr size_t WS_KC = WS_C + 64 * MiB;
constexpr size_t WS_VC = WS_C + 81 * MiB;
constexpr size_t WS_KS = WS_C + 98 * MiB;
constexpr size_t WS_VST = WS_C + 114 * MiB;
constexpr size_t WS_KW = WS_C + 130 * MiB;
constexpr size_t WS_VWT = WS_C + 146 * MiB;
constexpr size_t WS_NG = WS_C + 162 * MiB;
constexpr size_t WS_KCMP = WS_C + 170 * MiB;
constexpr size_t WS_VCMPT = WS_C + 171 * MiB;
constexpr size_t WS_HID = WS_C + 172 * MiB;
constexpr size_t WS_O = WS_C + 182 * MiB;
constexpr size_t WS_Q8 = WS_C + 246 * MiB;
constexpr size_t WS_END = WS_C + 282 * MiB;

constexpr int LDS_BYTES = 73728;

struct Params {
    const float* in[29];
    float* out;
    unsigned char* ws;
    int ph_lo, ph_hi;
};

__device__ __forceinline__ unsigned f2bf(float f) { unsigned u = __builtin_bit_cast(unsigned, f); return (u + 0x7fffu + ((u >> 16) & 1u)) >> 16; }
__device__ __forceinline__ unsigned pk2(float lo, float hi) { return f2bf(lo) | (f2bf(hi) << 16); }
__device__ __forceinline__ float bf2f(unsigned h) { return __builtin_bit_cast(float, h << 16); }
__device__ __forceinline__ float bflo(unsigned w) { return __builtin_bit_cast(float, w << 16); }
__device__ __forceinline__ float bfhi(unsigned w) { return __builtin_bit_cast(float, w & 0xffff0000u); }
__device__ __forceinline__ float gelu_tanh(float x) {
    const float u = 0.7978845608028654f * (x + 0.044715f * x * x * x);
    const float e = __expf(2.0f * u);
    const float th = 1.0f - 2.0f / (e + 1.0f);
    return 0.5f * x * (1.0f + th);
}
__device__ __forceinline__ float sigmoidf_(float x) { return 1.0f / (1.0f + __expf(-x)); }
__device__ __forceinline__ float wave_sum(float v) {
#pragma unroll
    for (int o = 1; o < 64; o <<= 1) v += __shfl_xor(v, o);
    return v;
}
__device__ __forceinline__ float dot2bf(unsigned a, unsigned b, float acc) {
    return __builtin_amdgcn_fdot2_f32_bf16(__builtin_bit_cast(bf16x2_t, a), __builtin_bit_cast(bf16x2_t, b), acc, false);
}

#define LAS __attribute__((address_space(3)))
#define XB_TMO      128
#define XB_XCNT(j)  (256  + 64 * (j))
#define XB_XSUB(j)  (1280 + 64 * (j))
#define XB_XGEN(j)  (2304 + 64 * (j))
#define XB_TOP      3328
#define XB_TOPGEN   3392
#define XCD_BAR_WORDS 3456
#define XB_SPIN_CAP (1u << 24)

__device__ __forceinline__ unsigned xb_ld(unsigned* p)              { return __hip_atomic_load(p, __ATOMIC_RELAXED, __HIP_MEMORY_SCOPE_AGENT); }
__device__ __forceinline__ unsigned xb_add(unsigned* p, unsigned v) { return __hip_atomic_fetch_add(p, v, __ATOMIC_RELAXED, __HIP_MEMORY_SCOPE_AGENT); }
__device__ __forceinline__ unsigned xb_xcc_id() { return (unsigned)__builtin_amdgcn_s_getreg((3 << 11) | 20) & 0xFu; }
#define XB_SPIN(cond, bar) do { unsigned _sp = 0; while (cond) { __builtin_amdgcn_s_sleep(1); \
    if ((++_sp & 255u) == 0u) { if (xb_ld(&(bar)[XB_TMO])) break; if (_sp > XB_SPIN_CAP) { atomicAdd(&(bar)[XB_TMO], 1u); break; } } } } while (0)

struct XcdBarrier {
    unsigned* bar; unsigned x;
    volatile LAS unsigned* st;
};

__device__ __forceinline__ XcdBarrier xcd_barrier_post(unsigned* bar, volatile LAS unsigned* st) {
    XcdBarrier b; b.bar = bar; b.x = xb_xcc_id(); b.st = st;
    if (threadIdx.x == 0) (void)xb_add(&bar[XB_XCNT(b.x)], 1u);
    return b;
}
__device__ __forceinline__ void xcd_barrier_complete(unsigned* bar, unsigned x, unsigned& nloc, unsigned& nx) {
    const unsigned G = gridDim.x * gridDim.y * gridDim.z;
    unsigned sum, cnt, mine, sp = 0u;
    for (;;) {
        sum = 0u; cnt = 0u; mine = 0u;
#pragma unroll
        for (unsigned j = 0; j < 16; ++j) { const unsigned c = xb_ld(&bar[XB_XCNT(j)]); sum += c; cnt += (c > 0u) ? 1u : 0u; mine = (j == x) ? c : mine; }
        if (sum == G) break;
        __builtin_amdgcn_s_sleep(1);
        if ((++sp & 255u) == 0u) { if (xb_ld(&bar[XB_TMO])) break; if (sp > XB_SPIN_CAP) { atomicAdd(&bar[XB_TMO], 1u); break; } }
    }
    nloc = mine > 0u ? mine : 1u; nx = cnt > 0u ? cnt : 1u;
}

__device__ __forceinline__ void xcd_barrier(const XcdBarrier& b) {
    asm volatile("s_waitcnt vmcnt(0)" ::: "memory");
    __syncthreads();
    if (threadIdx.x == 0) {
        unsigned* bar = b.bar;
        __builtin_amdgcn_s_waitcnt(0);
        unsigned nloc = b.st[0], nx = b.st[1];
        if (nloc == 0u) { xcd_barrier_complete(bar, b.x, nloc, nx); b.st[0] = nloc; b.st[1] = nx; }
        const unsigned old = xb_add(&bar[XB_XSUB(b.x)], 1u);
        const unsigned gen = old / nloc;
        if (old + 1u == (gen + 1u) * nloc) {
            __builtin_amdgcn_fence(__ATOMIC_RELEASE, "agent");
            asm volatile("s_waitcnt vmcnt(0)" ::: "memory");
            const unsigned og = xb_add(&bar[XB_TOP], 1u);
            const unsigned tg = og / nx;
            if (og + 1u == (tg + 1u) * nx) xb_add(&bar[XB_TOPGEN], 1u);
            else XB_SPIN(xb_ld(&bar[XB_TOPGEN]) == tg, bar);
            __builtin_amdgcn_fence(__ATOMIC_ACQUIRE, "agent");
            xb_add(&bar[XB_XGEN(b.x)], 1u);
            asm volatile("s_waitcnt vmcnt(0)" ::: "memory");
        } else {
            XB_SPIN(xb_ld(&bar[XB_XGEN(b.x)]) == gen, bar);
            __builtin_amdgcn_fence(__ATOMIC_ACQUIRE, "agent");
            asm volatile("s_waitcnt vmcnt(0)" ::: "memory");
        }
    }
    __syncthreads();
}
__device__ __forceinline__ void prep_mod_item(const Params& p, int item, float* lds) {
    const int layer = item / 192, cg0 = (item % 192) * 32;
    const int tid = threadIdx.x, col = cg0 + (tid & 31), kg = tid >> 5;
    const float* W = p.in[4] + (size_t)layer * D * 6 * D + col;
    const float* c = p.in[1];
    float* cact = lds + 512;
#pragma unroll
    for (int i = 0; i < 8; ++i) { const int q = tid + 256 * i; const float v = c[q]; cact[q] = v * sigmoidf_(v); }
    __syncthreads();
    float a0 = 0.f, a1 = 0.f;
    for (int k0 = kg * 128; k0 < kg * 128 + 128; k0 += 16) {
        float w[16];
#pragma unroll
        for (int u = 0; u < 16; ++u) w[u] = W[(size_t)(k0 + u) * (6 * D)];
#pragma unroll
        for (int u = 0; u < 16; ++u) { a0 += w[u] * cact[k0 + u]; a1 += w[u] * cact[1024 + k0 + u]; }
    }
    lds[tid] = a0; lds[256 + tid] = a1;
    __syncthreads();
    if (tid < 64) {
        const int b = tid >> 5, cc = tid & 31;
        float s = 0.f;
#pragma unroll
        for (int g = 0; g < 8; ++g) s += lds[b * 256 + g * 32 + cc];
        float* MOD = (float*)(p.ws + WS_MOD);
        MOD[(size_t)(layer * 2 + b) * 6144 + cg0 + cc] = s + p.in[5][(size_t)layer * 6144 + cg0 + cc];
    }
    __syncthreads();
}

template <int MODE>
__device__ __forceinline__ void prep_transpose_item(const float* W, int K, int N, bf16_t* WT, int item, float* lds) {
    const int nbn = (N + 63) / 64, kb = item / nbn, nb = item % nbn, k0 = kb * 64, n0 = nb * 64;
    const int tid = threadIdx.x;
#pragma unroll
    for (int i = 0; i < 16; ++i) {
        const int kk = (tid >> 6) + 4 * i, nn = tid & 63;
        const float v = (n0 + nn < N) ? W[(size_t)(k0 + kk) * N + n0 + nn] : 0.f;
        lds[kk * 65 + nn] = v;
    }
    __syncthreads();
    {
        const int nn = tid >> 2, ks = (tid & 3) * 16;
        const int n = n0 + nn;
        if (n < N) {
            int np = n;
            if (MODE == 1) { const int j = (n < 1024) ? n : n - 1024; np = (j >> 4) * 32 + (j & 15) + ((n < 1024) ? 0 : 16); }
            u32x4 o0, o1;
            const float* s = lds + nn;
            o0.x = pk2(s[(ks + 0) * 65], s[(ks + 1) * 65]); o0.y = pk2(s[(ks + 2) * 65], s[(ks + 3) * 65]);
            o0.z = pk2(s[(ks + 4) * 65], s[(ks + 5) * 65]); o0.w = pk2(s[(ks + 6) * 65], s[(ks + 7) * 65]);
            o1.x = pk2(s[(ks + 8) * 65], s[(ks + 9) * 65]); o1.y = pk2(s[(ks + 10) * 65], s[(ks + 11) * 65]);
            o1.z = pk2(s[(ks + 12) * 65], s[(ks + 13) * 65]); o1.w = pk2(s[(ks + 14) * 65], s[(ks + 15) * 65]);
            u32x4* dst = (u32x4*)(WT + (size_t)np * K + k0 + ks);
            dst[0] = o0; dst[1] = o1;
        }
    }
    __syncthreads();
}

__device__ __forceinline__ void cvt_item(const float* src, bf16_t* dst, int item) {
    const size_t base = (size_t)item * 8192 + threadIdx.x * 8;
#pragma unroll
    for (int i = 0; i < 4; ++i) {
        const size_t o = base + (size_t)i * 2048;
        const f32x4 a = *(const f32x4*)(src + o), b = *(const f32x4*)(src + o + 4);
        u32x4 w; w.x = pk2(a.x, a.y); w.y = pk2(a.z, a.w); w.z = pk2(b.x, b.y); w.w = pk2(b.z, b.w);
        *(u32x4*)(dst + o) = w;
    }
}
__device__ __forceinline__ void zero_item(bf16_t* dst, int item) {
    const size_t base = (size_t)item * 8192 + threadIdx.x * 8;
#pragma unroll
    for (int i = 0; i < 4; ++i) *(u32x4*)(dst + base + (size_t)i * 2048) = (u32x4){0u, 0u, 0u, 0u};
}

struct cpx { float re, im; };
__device__ __forceinline__ cpx cmul(cpx a, cpx b) { return {a.re * b.re - a.im * b.im, a.re * b.im + a.im * b.re}; }
__device__ __forceinline__ cpx cexp_pow(float are, float aim, float dt, int m) {
    const float mag = __expf(are * dt * (float)m);
    const double rev = (double)aim * (double)dt * (double)m * 0.15915494309189535;
    const float fr = (float)(rev - rint(rev));
    return {mag * __builtin_amdgcn_cosf(fr), mag * __builtin_amdgcn_sinf(fr)};
}
__device__ __forceinline__ cpx s5_coef(float are, float aim, float dt) {
    cpx ab = cexp_pow(are, aim, dt, 1);
    const float nr = ab.re - 1.0f, ni = ab.im, den = are * are + aim * aim;
    return {(nr * are + ni * aim) / den, (ni * are - nr * aim) / den};
}

__device__ __forceinline__ void prep_s5_T_item(const Params& p, int item) {
    const int gid = item * 256 + threadIdx.x;
    const int g = gid >> 9, m = (gid >> 4) & 31, i = gid & 15;
    const float* a_re = p.in[7] + g * 64; const float* a_im = p.in[8] + g * 64;
    const float dt = __expf(p.in[9][g]);
    const float* b_re = p.in[10] + (size_t)g * 64 * 16; const float* b_im = p.in[11] + (size_t)g * 64 * 16;
    const float* c_re = p.in[12] + (size_t)g * 16 * 64 + i * 64; const float* c_im = p.in[13] + (size_t)g * 16 * 64 + i * 64;
    float acc[16];
#pragma unroll
    for (int j = 0; j < 16; ++j) acc[j] = 0.f;
    for (int q = 0; q < 64; ++q) {
        const float are = a_re[q], aim = a_im[q];
        cpx z = cmul(cmul({c_re[q], c_im[q]}, cexp_pow(are, aim, dt, m)), s5_coef(are, aim, dt));
        const f32x4* br = (const f32x4*)(b_re + q * 16); const f32x4* bi = (const f32x4*)(b_im + q * 16);
#pragma unroll
        for (int j4 = 0; j4 < 4; ++j4) {
            const f32x4 r = br[j4], im = bi[j4];
            acc[j4 * 4 + 0] += z.re * r.x - z.im * im.x; acc[j4 * 4 + 1] += z.re * r.y - z.im * im.y;
            acc[j4 * 4 + 2] += z.re * r.z - z.im * im.z; acc[j4 * 4 + 3] += z.re * r.w - z.im * im.w;
        }
    }
    u32x4 o0, o1;
    o0.x = pk2(acc[0], acc[1]); o0.y = pk2(acc[2], acc[3]); o0.z = pk2(acc[4], acc[5]); o0.w = pk2(acc[6], acc[7]);
    o1.x = pk2(acc[8], acc[9]); o1.y = pk2(acc[10], acc[11]); o1.z = pk2(acc[12], acc[13]); o1.w = pk2(acc[14], acc[15]);
    bf16_t* TW = (bf16_t*)(p.ws + WS_TW) + (size_t)g * 640 * 512;
    const u32x4 z4 = (u32x4){0u, 0u, 0u, 0u};
    for (int lp = 0; lp + m < 32; ++lp) {
        u32x4* d = (u32x4*)(TW + (size_t)((lp + m) * 16 + i) * 512 + lp * 16);
        d[0] = o0; d[1] = o1;
        if (m > 0) { u32x4* dz = (u32x4*)(TW + (size_t)(lp * 16 + i) * 512 + (lp + m) * 16); dz[0] = z4; dz[1] = z4; }
    }
}
__device__ __forceinline__ void prep_s5_W_item(const Params& p, int item) {
    const int gid = item * 256 + threadIdx.x;
    const int g = gid >> 11, q = (gid >> 5) & 63, lp = gid & 31;
    const float are = p.in[7][g * 64 + q], aim = p.in[8][g * 64 + q];
    const float dt = __expf(p.in[9][g]);
    const cpx z = cmul(cexp_pow(are, aim, dt, 31 - lp), s5_coef(are, aim, dt));
    const float* br = p.in[10] + ((size_t)g * 64 + q) * 16; const float* bi = p.in[11] + ((size_t)g * 64 + q) * 16;
    float wr[16], wi[16];
#pragma unroll
    for (int j = 0; j < 16; ++j) { wr[j] = z.re * br[j] - z.im * bi[j]; wi[j] = z.re * bi[j] + z.im * br[j]; }
    bf16_t* TW = (bf16_t*)(p.ws + WS_TW) + (size_t)g * 640 * 512;
    u32x4* d0 = (u32x4*)(TW + (size_t)(512 + q) * 512 + lp * 16);
    u32x4* d1 = (u32x4*)(TW + (size_t)(576 + q) * 512 + lp * 16);
    d0[0] = (u32x4){pk2(wr[0], wr[1]), pk2(wr[2], wr[3]), pk2(wr[4], wr[5]), pk2(wr[6], wr[7])};
    d0[1] = (u32x4){pk2(wr[8], wr[9]), pk2(wr[10], wr[11]), pk2(wr[12], wr[13]), pk2(wr[14], wr[15])};
    d1[0] = (u32x4){pk2(wi[0], wi[1]), pk2(wi[2], wi[3]), pk2(wi[4], wi[5]), pk2(wi[6], wi[7])};
    d1[1] = (u32x4){pk2(wi[8], wi[9]), pk2(wi[10], wi[11]), pk2(wi[12], wi[13]), pk2(wi[14], wi[15])};
}
__device__ __forceinline__ void prep_s5_V_item(const Params& p, int item) {
    const int gid = item * 256 + threadIdx.x;
    const int g = gid >> 14, l = (gid >> 9) & 31, i = (gid >> 5) & 15, q0 = (gid & 31) * 2;
    const float dt = __expf(p.in[9][g]);
    float vr[2], vi[2];
#pragma unroll
    for (int e = 0; e < 2; ++e) {
        const int q = q0 + e;
        const cpx z = cmul({p.in[12][((size_t)g * 16 + i) * 64 + q], p.in[13][((size_t)g * 16 + i) * 64 + q]}, cexp_pow(p.in[7][g * 64 + q], p.in[8][g * 64 + q], dt, l + 1));
        vr[e] = z.re; vi[e] = -z.im;
    }
    bf16_t* VG = (bf16_t*)(p.ws + WS_VG) + ((size_t)g * 512 + l * 16 + i) * 128;
    *(unsigned*)(VG + q0) = pk2(vr[0], vr[1]);
    *(unsigned*)(VG + 64 + q0) = pk2(vi[0], vi[1]);
}
__device__ __forceinline__ void prep_al_item(const Params& p, int item) {
    const int gid = item * 256 + threadIdx.x;
    const int g = gid >> 6;
    const float dt = __expf(p.in[9][g]);
    const cpx z = cexp_pow(p.in[7][gid], p.in[8][gid], dt, S5L);
    f32x2* AL = (f32x2*)(p.ws + WS_MISC + 4096);
    AL[gid] = (f32x2){z.re, z.im};
}
__device__ __forceinline__ void prep_rope_item(const Params& p, int item) {
    const int gid = item * 256 + threadIdx.x;
    const int pos = gid >> 5, j = gid & 31;
    const float freq = exp2f(-(float)j * (13.287712379549449f / 32.0f));
    const float ang = (float)pos * freq;
    const double rev = (double)ang * 0.15915494309189535;
    const float fr = (float)(rev - rint(rev));
    f32x2* R = (f32x2*)(p.ws + WS_ROPE);
    R[gid] = (f32x2){__builtin_amdgcn_cosf(fr), __builtin_amdgcn_sinf(fr)};
}
__device__ __forceinline__ void prep_cmpbias_item(const Params& p, int item, float* lds) {
    const int kv = item >> 3, cg0 = (item & 7) * 32;
    const float* pe = p.in[17 + kv]; const float* w1 = p.in[kv == 0 ? 19 : 21];
    const int tid = threadIdx.x, col = cg0 + (tid & 31), kg = tid >> 5;
    float s = 0.f;
#pragma unroll 8
    for (int k = kg * 256; k < kg * 256 + 256; ++k) s += pe[k] * w1[(size_t)k * 256 + col];
    lds[tid] = s;
    __syncthreads();
    if (tid < 32) {
        float t = 0.f;
#pragma unroll
        for (int q = 0; q < 8; ++q) t += lds[q * 32 + tid];
        ((float*)(p.ws + WS_MISC))[kv * 256 + cg0 + tid] = t;
    }
    __syncthreads();
}

__device__ __forceinline__ void cvt_fp8_item(const float* src, unsigned char* dst, float* inv_scale, int item, const bool slice_major) {
    const int lane = threadIdx.x & 63, row0 = item * 16 + (threadIdx.x >> 6) * 4;
    f32x4 v[4][4];
#pragma unroll
    for (int r = 0; r < 4; ++r) {
        const f32x4* sp = (const f32x4*)(src + (size_t)(row0 + r) * D + lane * 16);
#pragma unroll
        for (int q = 0; q < 4; ++q) v[r][q] = sp[q];
    }
#pragma unroll
    for (int r = 0; r < 4; ++r) {
        float m = 0.f;
#pragma unroll
        for (int q = 0; q < 4; ++q) m = fmaxf(m, fmaxf(fmaxf(fabsf(v[r][q].x), fabsf(v[r][q].y)), fmaxf(fabsf(v[r][q].z), fabsf(v[r][q].w))));
#pragma unroll
        for (int o = 1; o < 64; o <<= 1) m = fmaxf(m, __shfl_xor(m, o));
        const float sc = m > 0.f ? 224.0f / m : 1.0f;
        unsigned w[4];
#pragma unroll
        for (int q = 0; q < 4; ++q) { int t = 0; t = __builtin_amdgcn_cvt_pk_fp8_f32(v[r][q].x * sc, v[r][q].y * sc, t, false); t = __builtin_amdgcn_cvt_pk_fp8_f32(v[r][q].z * sc, v[r][q].w * sc, t, true); w[q] = (unsigned)t; }
        const int row = row0 + r;
        const u32x4 wv = (u32x4){w[0], w[1], w[2], w[3]};
        if (slice_major) *(u32x4*)(dst + (size_t)(lane >> 3) * (PE * 128) + (size_t)row * 128 + (lane & 7) * 16) = wv;
        else *(u32x4*)(dst + (size_t)row * D + lane * 16) = wv;
        if (lane == 0) inv_scale[row] = m > 0.f ? m / 224.0f : 1.0f;
    }
}
constexpr int P0_MOD = 384;
constexpr int P0_T_WIN = 16 * 16, P0_T_WGLU = 16 * 32, P0_T_WPROJ = 16 * 41, P0_T_WK1 = 32 * 4, P0_T_WK2 = 4 * 1, P0_T_WO = 16 * 16, P0_T_WQ = 16 * 32;
constexpr int P0_SUBK = (2 * 8 * 2 * 128 * 128) / 8192;
constexpr int P0_TAB = PE / 16;
constexpr int P0_S5T = 128, P0_S5W = 512, P0_S5V = 4096, P0_AL = 16, P0_ROPE = 2048, P0_CB = 16, P0_ZERO = 10 + 2;

__device__ __forceinline__ void phase_prep(const Params& p, float* lds, const int part) {
    const int n0 = P0_MOD;
    const int n1 = n0 + P0_T_WIN, n2 = n1 + P0_T_WGLU, n3 = n2 + P0_T_WPROJ, n4 = n3 + P0_T_WK1, n5 = n4 + P0_T_WK1, n6 = n5 + P0_T_WK2, n7 = n6 + P0_T_WK2,
              n8 = n7 + P0_T_WO, n9 = n8 + P0_T_WQ, n10 = n9 + P0_T_WQ, n11 = n10 + P0_SUBK, n12 = n11 + P0_TAB, n13 = n12 + P0_TAB,
              n14 = n13 + P0_S5T, n15 = n14 + P0_S5W, n16 = n15 + P0_S5V, n17 = n16 + P0_AL, n18 = n17 + P0_ROPE, n19 = n18 + P0_CB, n20 = n19 + 10, n21 = n20 + 2, n22 = n21 + 2;
    unsigned char* ws = p.ws;
#ifndef PREP_DUP_LO
#define PREP_DUP_LO 0
#define PREP_DUP_HI 0
#endif
    const int dupn = (PREP_DUP_HI) - (PREP_DUP_LO);
    const int nB = (n8 - n2) + (n10 - n9) + (n22 - n17);
    const int first = part == 0 ? (int)blockIdx.x : (int)blockIdx.x - 32, stride = part == 0 ? (int)gridDim.x : (int)gridDim.x - 32;
    if (first < 0 || stride <= 0) return;
    const int total = part == 0 ? (n22 - nB) + dupn : nB;
    for (int it0 = first; it0 < total; it0 += stride) {
        int it;
        if (part == 0) {
            it = it0;
            if (it >= n2) it += (n8 - n2);
            if (it >= n9) it += (n10 - n9);
            if (it0 >= (n22 - nB)) it = (PREP_DUP_LO) + (it0 - (n22 - nB));
        } else {
            it = n2 + it0;
            if (it >= n8) it += (n9 - n8);
            if (it >= n10) it += (n17 - n10);
        }
        if (it < n0) prep_mod_item(p, it, lds);
        else if (it < n1) prep_transpose_item<0>(p.in[6], 1024, 1024, (bf16_t*)(ws + WS_WIN_T), it - n0, lds);
        else if (it < n2) prep_transpose_item<1>(p.in[15], 1024, 2048, (bf16_t*)(ws + WS_WGLU_T), it - n1, lds);
        else if (it < n3) prep_transpose_item<0>(p.in[16], 1024, NPROJ, (bf16_t*)(ws + WS_WPROJ_T), it - n2, lds);
        else if (it < n4) prep_transpose_item<0>(p.in[19], 2048, 256, (bf16_t*)(ws + WS_WK1_T), it - n3, lds);
        else if (it < n5) prep_transpose_item<0>(p.in[21], 2048, 256, (bf16_t*)(ws + WS_WV1_T), it - n4, lds);
        else if (it < n6) prep_transpose_item<0>(p.in[20], 256, 64, (bf16_t*)(ws + WS_WK2_T), it - n5, lds);
        else if (it < n7) prep_transpose_item<0>(p.in[22], 256, 64, (bf16_t*)(ws + WS_WV2_T), it - n6, lds);
        else if (it < n8) prep_transpose_item<0>(p.in[23], 1024, 1024, (bf16_t*)(ws + WS_WO_T), it - n7, lds);
        else if (it < n9) prep_transpose_item<0>(p.in[24], 1024, 2048, (bf16_t*)(ws + WS_WQ_T), it - n8, lds);
        else if (it < n10) prep_transpose_item<0>(p.in[24] + (size_t)1024 * 2048, 1024, 2048, (bf16_t*)(ws + WS_WQ_T) + (size_t)2048 * 1024, it - n9, lds);
        else if (it < n11) cvt_item(p.in[25], (bf16_t*)(ws + WS_SUBK), it - n10);
        else if (it < n12) cvt_fp8_item(p.in[26], ws + WS_PU, (float*)(ws + WS_PU + 24 * MiB), it - n11, false);
        else if (it < n13) cvt_fp8_item(p.in[27], ws + WS_PV, (float*)(ws + WS_PV + 24 * MiB), it - n12, false);
        else if (it < n14) prep_s5_T_item(p, it - n13);
        else if (it < n15) prep_s5_W_item(p, it - n14);
        else if (it < n16) prep_s5_V_item(p, it - n15);
        else if (it < n17) prep_al_item(p, it - n16);
        else if (it < n18) prep_rope_item(p, it - n17);
        else if (it < n19) prep_cmpbias_item(p, it - n18, lds);
        else if (it < n20) zero_item((bf16_t*)(ws + WS_WPROJ_T) + (size_t)NPROJ * 1024, it - n19);
        else if (it < n21) zero_item((bf16_t*)(ws + WS_WK2_T) + (size_t)64 * 256, it - n20);
        else zero_item((bf16_t*)(ws + WS_WV2_T) + (size_t)64 * 256, it - n21);
    }
}

__device__ __forceinline__ void phase_norm(const Params& p, const float* X, const float* gw, const float* shift, const float* scale  , bf16_t* HM) {
    const int lane = threadIdx.x & 63, wave = threadIdx.x >> 6;
    for (int row = blockIdx.x * 4 + wave; row < T; row += gridDim.x * 4) {
        const int b = row / SEQ;
        const f32x4* xr = (const f32x4*)(X + (size_t)row * D) + lane;
        f32x4 v[4]; float s = 0.f;
#pragma unroll
        for (int j = 0; j < 4; ++j) { v[j] = xr[64 * j]; s += (v[j].x * v[j].x + v[j].y * v[j].y) + (v[j].z * v[j].z + v[j].w * v[j].w); }
        const float rs = rsqrtf(wave_sum(s) * (1.0f / D) + RMS_EPS);
        u32x2* o = (u32x2*)(HM + (size_t)row * D) + lane;
#pragma unroll
        for (int j = 0; j < 4; ++j) {
            const int c = lane * 4 + 256 * j;
            const f32x4 g = *(const f32x4*)(gw + c), sh = *(const f32x4*)(shift + (size_t)b * 6144 + c), sc = *(const f32x4*)(scale + (size_t)b * 6144 + c);
            const float y0 = v[j].x * rs * g.x * (1.f + sc.x) + sh.x, y1 = v[j].y * rs * g.y * (1.f + sc.y) + sh.y;
            const float y2 = v[j].z * rs * g.z * (1.f + sc.z) + sh.z, y3 = v[j].w * rs * g.w * (1.f + sc.w) + sh.w;
            o[64 * j] = (u32x2){pk2(y0, y1), pk2(y2, y3)};
        }
    }
}
__device__ __forceinline__ void phase_final_norm(const Params& p, const float* X, float* OUT, bool dry) {
    const int lane = threadIdx.x & 63, wave = threadIdx.x >> 6;
    const float* gw = p.in[28];
    for (int row = blockIdx.x * 4 + wave; row < T; row += gridDim.x * 4) {
        const f32x4* xr = (const f32x4*)(X + (size_t)row * D) + lane;
        f32x4 v[4]; float s = 0.f;
#pragma unroll
        for (int j = 0; j < 4; ++j) { v[j] = xr[64 * j]; s += (v[j].x * v[j].x + v[j].y * v[j].y) + (v[j].z * v[j].z + v[j].w * v[j].w); }
        const float rs = rsqrtf(wave_sum(s) * (1.0f / D) + RMS_EPS);
        f32x4* o = (f32x4*)(OUT + (size_t)row * D) + lane;
#pragma unroll
        for (int j = 0; j < 4; ++j) {
            const f32x4 g = *(const f32x4*)(gw + lane * 4 + 256 * j);
            if (!dry) o[64 * j] = (f32x4){v[j].x * rs * g.x, v[j].y * rs * g.y, v[j].z * rs * g.z, v[j].w * rs * g.w};
        }
    }
}

__device__ __forceinline__ int vblock() { const int G = gridDim.x, bx = blockIdx.x; return (G % 8 == 0) ? (bx % 8) * (G / 8) + bx / 8 : bx; }
struct ALoadPlain {
    const bf16_t* A; size_t lda;
    __device__ __forceinline__ const bf16_t* base(int kt) const { return A + kt * 64; }
    __device__ __forceinline__ unsigned off(int r, int lc) const { return (unsigned)r * (unsigned)lda + (unsigned)lc * 8u; }
};
struct ALoadGroup {
    const bf16_t* A;
    __device__ __forceinline__ const bf16_t* base(int kt) const { return A + (size_t)kt * 4 * T * 16; }
    __device__ __forceinline__ unsigned off(int r, int lc) const { return ((unsigned)(lc >> 1) * (unsigned)T + (unsigned)r) * 16u + (unsigned)(lc & 1) * 8u; }
};

template <class AL>
__device__ __forceinline__ void gemm_tile2(const AL al, const bf16_t* __restrict__ Bt, size_t ldb, int nk, f32x4 (&acc)[4][4], unsigned char* lds) {
    const int tid = threadIdx.x, lane = tid & 63, wid = tid >> 6, wr = wid >> 1, wc = wid & 1, fr = lane & 15, fq = lane >> 4;
    const int lr = tid >> 3, lc = tid & 7;
#pragma unroll
    for (int mi = 0; mi < 4; ++mi)
#pragma unroll
        for (int ni = 0; ni < 4; ++ni) acc[mi][ni] = (f32x4){0.f, 0.f, 0.f, 0.f};
    u32x4 ra0[4], rb0[4], ra1[4], rb1[4];
    const int soff = lr * 128 + ((lc ^ (lr & 7)) << 4);
    unsigned offA[4], offB[4];
#pragma unroll
    for (int i = 0; i < 4; ++i) { offA[i] = al.off(lr + 32 * i, lc); offB[i] = (unsigned)(lr + 32 * i) * (unsigned)ldb + (unsigned)lc * 8u; }
#define GT_LOAD(RA, RB, kt_) do { const bf16_t* ab_ = al.base(kt_); const bf16_t* bb_ = Bt + (kt_) * 64; _Pragma("unroll") for (int i = 0; i < 4; ++i) { RA[i] = *(const u32x4*)(ab_ + offA[i]); RB[i] = *(const u32x4*)(bb_ + offB[i]); } } while (0)
#define GT_STORE(RA, RB, buf_) do { unsigned char* nb_ = lds + (buf_) * 32768; _Pragma("unroll") for (int i = 0; i < 4; ++i) { *(u32x4*)(nb_ + soff + i * 4096) = RA[i]; *(u32x4*)(nb_ + 16384 + soff + i * 4096) = RB[i]; } } while (0)
    const int aoff = (wr * 64 + fr) * 128, boff = 16384 + (wc * 64 + fr) * 128, sw = fr & 7;
#define GT_MATH(buf_) do { const unsigned char* bp_ = lds + (buf_) * 32768; _Pragma("unroll") for (int ks = 0; ks < 2; ++ks) { bf16x8 af[4], bfr[4]; const int co = ((ks * 4 + fq) ^ sw) << 4; \
        _Pragma("unroll") for (int mi = 0; mi < 4; ++mi) af[mi] = *(const bf16x8*)(bp_ + aoff + mi * 2048 + co); \
        _Pragma("unroll") for (int ni = 0; ni < 4; ++ni) bfr[ni] = *(const bf16x8*)(bp_ + boff + ni * 2048 + co); \
        _Pragma("unroll") for (int mi = 0; mi < 4; ++mi) _Pragma("unroll") for (int ni = 0; ni < 4; ++ni) acc[mi][ni] = __builtin_amdgcn_mfma_f32_16x16x32_bf16(bfr[ni], af[mi], acc[mi][ni], 0, 0, 0); } } while (0)
    GT_LOAD(ra0, rb0, 0);
    if (nk > 1) GT_LOAD(ra1, rb1, 1);
    GT_STORE(ra0, rb0, 0);
    __syncthreads();
    for (int kt = 0; kt < nk; kt += 2) {
        if (kt + 2 < nk) GT_LOAD(ra0, rb0, kt + 2);
        __builtin_amdgcn_sched_barrier(0);
        GT_MATH(0);
        __builtin_amdgcn_sched_barrier(0);
        if (kt + 1 < nk) GT_STORE(ra1, rb1, 1);
        __syncthreads();
        if (kt + 1 >= nk) break;
        if (kt + 3 < nk) GT_LOAD(ra1, rb1, kt + 3);
        __builtin_amdgcn_sched_barrier(0);
        GT_MATH(1);
        __builtin_amdgcn_sched_barrier(0);
        if (kt + 2 < nk) GT_STORE(ra0, rb0, 0);
        __syncthreads();
    }
#undef GT_LOAD
#undef GT_STORE
#undef GT_MATH
}

template <class AL>
__device__ __forceinline__ void gemm_tile1(const AL al, const bf16_t* __restrict__ Bt, size_t ldb, int nk, f32x4 (&acc)[4][4], unsigned char* lds) {
    const int tid = threadIdx.x, lane = tid & 63, wid = tid >> 6, wr = wid >> 1, wc = wid & 1, fr = lane & 15, fq = lane >> 4;
    const int lr = tid >> 3, lc = tid & 7;
#pragma unroll
    for (int mi = 0; mi < 4; ++mi)
#pragma unroll
        for (int ni = 0; ni < 4; ++ni) acc[mi][ni] = (f32x4){0.f, 0.f, 0.f, 0.f};
    u32x4 ra[4], rb[4];
    const int soff = lr * 128 + ((lc ^ (lr & 7)) << 4);
#pragma unroll
    for (int i = 0; i < 4; ++i) { ra[i] = *(const u32x4*)(al.base(0) + al.off(lr + 32 * i, lc)); rb[i] = *(const u32x4*)(Bt + (size_t)(lr + 32 * i) * ldb + lc * 8); }
#pragma unroll
    for (int i = 0; i < 4; ++i) { *(u32x4*)(lds + soff + i * 4096) = ra[i]; *(u32x4*)(lds + 16384 + soff + i * 4096) = rb[i]; }
    __syncthreads();
    const int aoff = (wr * 64 + fr) * 128, boff = 16384 + (wc * 64 + fr) * 128, sw = fr & 7;
    for (int kt = 0; kt < nk; ++kt) {
        const bool more = (kt + 1 < nk);
        if (more) {
#pragma unroll
            for (int i = 0; i < 4; ++i) { ra[i] = *(const u32x4*)(al.base(kt + 1) + al.off(lr + 32 * i, lc)); rb[i] = *(const u32x4*)(Bt + (size_t)(lr + 32 * i) * ldb + (kt + 1) * 64 + lc * 8); }
        }
        const unsigned char* buf = lds + (kt & 1) * 32768;
#pragma unroll
        for (int ks = 0; ks < 2; ++ks) {
            bf16x8 af[4], bfr[4];
            const int co = ((ks * 4 + fq) ^ sw) << 4;
#pragma unroll
            for (int mi = 0; mi < 4; ++mi) af[mi] = *(const bf16x8*)(buf + aoff + mi * 2048 + co);
#pragma unroll
            for (int ni = 0; ni < 4; ++ni) bfr[ni] = *(const bf16x8*)(buf + boff + ni * 2048 + co);
#pragma unroll
            for (int mi = 0; mi < 4; ++mi)
#pragma unroll
                for (int ni = 0; ni < 4; ++ni) acc[mi][ni] = __builtin_amdgcn_mfma_f32_16x16x32_bf16(bfr[ni], af[mi], acc[mi][ni], 0, 0, 0);
        }
        if (more) {
            unsigned char* nb = lds + ((kt + 1) & 1) * 32768;
#pragma unroll
            for (int i = 0; i < 4; ++i) { *(u32x4*)(nb + soff + i * 4096) = ra[i]; *(u32x4*)(nb + 16384 + soff + i * 4096) = rb[i]; }
        }
        __syncthreads();
    }
}

template <class AL>
__device__ __forceinline__ void gemm_tile3(const AL al, const bf16_t* __restrict__ Bt, size_t ldb, int nk, f32x4 (&acc)[4][4], unsigned char* lds) {
    const int tid = threadIdx.x, lane = tid & 63, wid = tid >> 6, wr = wid >> 1, wc = wid & 1, fr = lane & 15, fq = lane >> 4;
#pragma unroll
    for (int mi = 0; mi < 4; ++mi)
#pragma unroll
        for (int ni = 0; ni < 4; ++ni) acc[mi][ni] = (f32x4){0.f, 0.f, 0.f, 0.f};
    const int srow = wid * 32 + (lane >> 3), schunk = (lane & 7) ^ ((lane >> 3) & 7);
    unsigned offA[4], offB[4];
#pragma unroll
    for (int i = 0; i < 4; ++i) { offA[i] = al.off(srow + 8 * i, schunk); offB[i] = (unsigned)(srow + 8 * i) * (unsigned)ldb + (unsigned)schunk * 8u; }
#define G3_STAGE(buf_, kt_) do { const bf16_t* ab_ = al.base(kt_); const bf16_t* bb_ = Bt + (kt_) * 64; unsigned char* lb_ = lds + (buf_) * 32768 + wid * 4096; \
        _Pragma("unroll") for (int i = 0; i < 4; ++i) { \
            __builtin_amdgcn_global_load_lds((const unsigned*)(ab_ + offA[i]), (unsigned*)(lb_ + i * 1024), 16, 0, 0); \
            __builtin_amdgcn_global_load_lds((const unsigned*)(bb_ + offB[i]), (unsigned*)(lb_ + 16384 + i * 1024), 16, 0, 0); } } while (0)
    const int aoff = (wr * 64 + fr) * 128, boff = 16384 + (wc * 64 + fr) * 128, sw = fr & 7;
    G3_STAGE(0, 0);
    __syncthreads();
    for (int kt = 0; kt < nk; ++kt) {
        if (kt + 1 < nk) G3_STAGE((kt + 1) & 1, kt + 1);
        const unsigned char* buf = lds + (kt & 1) * 32768;
#pragma unroll
        for (int ks = 0; ks < 2; ++ks) {
            bf16x8 af[4], bfr[4];
            const int co = ((ks * 4 + fq) ^ sw) << 4;
#pragma unroll
            for (int mi = 0; mi < 4; ++mi) af[mi] = *(const bf16x8*)(buf + aoff + mi * 2048 + co);
#pragma unroll
            for (int ni = 0; ni < 4; ++ni) bfr[ni] = *(const bf16x8*)(buf + boff + ni * 2048 + co);
#pragma unroll
            for (int mi = 0; mi < 4; ++mi)
#pragma unroll
                for (int ni = 0; ni < 4; ++ni) acc[mi][ni] = __builtin_amdgcn_mfma_f32_16x16x32_bf16(bfr[ni], af[mi], acc[mi][ni], 0, 0, 0);
        }
        __syncthreads();
    }
#undef G3_STAGE
}

__device__ __forceinline__ void mma_ktile(const unsigned char* buf, f32x4 (&acc)[4][4]) {
    const int tid = threadIdx.x, lane = tid & 63, wid = tid >> 6, wr = wid >> 1, wc = wid & 1, fr = lane & 15, fq = lane >> 4;
    const int aoff = (wr * 64 + fr) * 128, boff = 16384 + (wc * 64 + fr) * 128, sw = fr & 7;
#pragma unroll
    for (int ks = 0; ks < 2; ++ks) {
        bf16x8 af[4], bfr[4];
        const int co = ((ks * 4 + fq) ^ sw) << 4;
#pragma unroll
        for (int mi = 0; mi < 4; ++mi) af[mi] = *(const bf16x8*)(buf + aoff + mi * 2048 + co);
#pragma unroll
        for (int ni = 0; ni < 4; ++ni) bfr[ni] = *(const bf16x8*)(buf + boff + ni * 2048 + co);
#pragma unroll
        for (int mi = 0; mi < 4; ++mi)
#pragma unroll
            for (int ni = 0; ni < 4; ++ni) acc[mi][ni] = __builtin_amdgcn_mfma_f32_16x16x32_bf16(bfr[ni], af[mi], acc[mi][ni], 0, 0, 0);
    }
}
__device__ __forceinline__ void phase_s5_win(const Params& p, unsigned char* lds) {
    const bf16_t* HM = (const bf16_t*)(p.ws + WS_HM); const bf16_t* WT = (const bf16_t*)(p.ws + WS_WIN_T);
    bf16_t* UG = (bf16_t*)(p.ws + WS_UG);
    const int lane = threadIdx.x & 63, wid = threadIdx.x >> 6, wr = wid >> 1, wc = wid & 1, fr = lane & 15, fq = lane >> 4;
    for (int id = vblock(); id < 256 * 8; id += gridDim.x) {
        const int mt = id >> 3, nt = id & 7;
        f32x4 acc[4][4];
        gemm_tile3(ALoadPlain{HM + (size_t)mt * 128 * D, (size_t)D}, WT + (size_t)nt * 128 * D, D, 16, acc, lds);
#pragma unroll
        for (int mi = 0; mi < 4; ++mi)
#pragma unroll
            for (int ni = 0; ni < 4; ++ni) {
                const int t = mt * 128 + wr * 64 + mi * 16 + fr, g = nt * 8 + wc * 4 + ni;
                const f32x4 v = acc[mi][ni];
                *(u32x2*)(UG + ((size_t)g * T + t) * 16 + fq * 4) = (u32x2){pk2(v.x, v.y), pk2(v.z, v.w)};
            }
    }
}
__device__ __forceinline__ void phase_s5_a(const Params& p, unsigned char* lds) {
    const bf16_t* UG = (const bf16_t*)(p.ws + WS_UG); const bf16_t* TW = (const bf16_t*)(p.ws + WS_TW);
    bf16_t* YI = (bf16_t*)(p.ws + WS_YI); float* WST = (float*)(p.ws + WS_WST);
    const int lane = threadIdx.x & 63, wid = threadIdx.x >> 6, wr = wid >> 1, wc = wid & 1, fr = lane & 15, fq = lane >> 4;
    for (int id = vblock(); id < 64 * 40; id += gridDim.x) {
        const int g = id / 40, rem = id % 40, mt = rem / 5, nt = rem % 5;
        const int nk = (nt < 4) ? 2 * (nt + 1) : 8;
        f32x4 acc[4][4];
        gemm_tile3(ALoadPlain{UG + (size_t)g * T * 16 + (size_t)mt * 128 * 512, (size_t)512}, TW + ((size_t)g * 640 + nt * 128) * 512, 512, nk, acc, lds);
#pragma unroll
        for (int mi = 0; mi < 4; ++mi)
#pragma unroll
            for (int ni = 0; ni < 4; ++ni) {
                const int R = mt * 128 + wr * 64 + mi * 16 + fr, c = wc * 64 + ni * 16 + fq * 4;
                const f32x4 v = acc[mi][ni];
                if (nt < 4) *(u32x2*)(YI + ((size_t)g * 1024 + R) * 512 + nt * 128 + c) = (u32x2){pk2(v.x, v.y), pk2(v.z, v.w)};
                else *(f32x4*)(WST + ((size_t)g * 1024 + R) * 128 + c) = v;
            }
    }
}
__device__ __forceinline__ void phase_s5_scan(const Params& p) {
    const int lane = threadIdx.x & 63, wave = threadIdx.x >> 6;
    const float* WST = (const float*)(p.ws + WS_WST); bf16_t* SST = (bf16_t*)(p.ws + WS_SST);
    const f32x2* AL = (const f32x2*)(p.ws + WS_MISC + 4096);
    for (int it = blockIdx.x * 4 + wave; it < 128; it += gridDim.x * 4) {
        const int b = it >> 6, g = it & 63;
        const f32x2 al = AL[g * 64 + lane];
        float sr = 0.f, si = 0.f;
        const float* wbase = WST + ((size_t)g * 1024 + b * 512) * 128 + lane;
        bf16_t* sbase = SST + ((size_t)g * 1024 + b * 512) * 128 + lane;
        for (int n0 = 0; n0 < 512; n0 += 16) {
            float wre[16], wim[16];
#pragma unroll
            for (int j = 0; j < 16; ++j) { wre[j] = wbase[(size_t)(n0 + j) * 128]; wim[j] = wbase[(size_t)(n0 + j) * 128 + 64]; }
#pragma unroll
            for (int j = 0; j < 16; ++j) {
                sbase[(size_t)(n0 + j) * 128] = (bf16_t)f2bf(sr); sbase[(size_t)(n0 + j) * 128 + 64] = (bf16_t)f2bf(si);
                const float nr = al.x * sr - al.y * si + wre[j], ni = al.x * si + al.y * sr + wim[j];
                sr = nr; si = ni;
            }
        }
    }
}
__device__ __forceinline__ void phase_s5_b(const Params& p, unsigned char* lds) {
    const bf16_t* SST = (const bf16_t*)(p.ws + WS_SST); const bf16_t* VG = (const bf16_t*)(p.ws + WS_VG);
    const bf16_t* YI = (const bf16_t*)(p.ws + WS_YI); const bf16_t* UG = (const bf16_t*)(p.ws + WS_UG);
    bf16_t* YG = (bf16_t*)(p.ws + WS_YG);
    const float* dsk = p.in[14];
    const int lane = threadIdx.x & 63, wid = threadIdx.x >> 6, wr = wid >> 1, wc = wid & 1, fr = lane & 15, fq = lane >> 4;
    for (int id = vblock(); id < 64 * 32; id += gridDim.x) {
        const int g = id >> 5, mt = (id >> 2) & 7, nt = id & 3;
        f32x4 acc[4][4];
        gemm_tile3(ALoadPlain{SST + ((size_t)g * 1024 + mt * 128) * 128, (size_t)128}, VG + ((size_t)g * 512 + nt * 128) * 128, 128, 2, acc, lds);
        const f32x4 dv = *(const f32x4*)(dsk + g * 16 + fq * 4);
#pragma unroll
        for (int mi = 0; mi < 4; ++mi)
#pragma unroll
            for (int ni = 0; ni < 4; ++ni) {
                const int R = mt * 128 + wr * 64 + mi * 16 + fr, c = nt * 128 + wc * 64 + ni * 16 + fq * 4;
                const size_t idx = ((size_t)g * 1024 + R) * 512 + c;
                const u32x2 yi = *(const u32x2*)(YI + idx), uu = *(const u32x2*)(UG + idx);
                const f32x4 v = acc[mi][ni];
                const float y0 = gelu_tanh(v.x + bflo(yi.x) + dv.x * bflo(uu.x)), y1 = gelu_tanh(v.y + bfhi(yi.x) + dv.y * bfhi(uu.x));
                const float y2 = gelu_tanh(v.z + bflo(yi.y) + dv.z * bflo(uu.y)), y3 = gelu_tanh(v.w + bfhi(yi.y) + dv.w * bfhi(uu.y));
                *(u32x2*)(YG + idx) = (u32x2){pk2(y0, y1), pk2(y2, y3)};
            }
    }
}
__device__ __forceinline__ void phase_s5_glu(const Params& p, unsigned char* lds) {
    const bf16_t* YG = (const bf16_t*)(p.ws + WS_YG); const bf16_t* WT = (const bf16_t*)(p.ws + WS_WGLU_T);
    const float* MOD = (const float*)(p.ws + WS_MOD);
    const float* X = p.in[0]; float* XO = p.out;
    const int lane = threadIdx.x & 63, wid = threadIdx.x >> 6, wr = wid >> 1, wc = wid & 1, fr = lane & 15, fq = lane >> 4;
    for (int id = vblock(); id < 256 * 16; id += gridDim.x) {
        const int mt = id >> 4, nt = id & 15;
        f32x4 acc[4][4];
        gemm_tile3(ALoadGroup{YG + (size_t)mt * 128 * 16}, WT + (size_t)nt * 128 * D, D, 16, acc, lds);
        const int b = (mt * 128) / SEQ;
#pragma unroll
        for (int mi = 0; mi < 4; ++mi)
#pragma unroll
            for (int h = 0; h < 2; ++h) {
                const int t = mt * 128 + wr * 64 + mi * 16 + fr, j = nt * 64 + wc * 32 + h * 16 + fq * 4;
                const f32x4 a = acc[mi][2 * h], gg = acc[mi][2 * h + 1];
                const f32x4 g1 = *(const f32x4*)(MOD + (size_t)(0 * 2 + b) * 6144 + 2048 + j);
                const f32x4 xi = *(const f32x4*)(X + (size_t)t * D + j);
                f32x4 o;
                o.x = xi.x + g1.x * (a.x * sigmoidf_(gg.x)); o.y = xi.y + g1.y * (a.y * sigmoidf_(gg.y));
                o.z = xi.z + g1.z * (a.z * sigmoidf_(gg.z)); o.w = xi.w + g1.w * (a.w * sigmoidf_(gg.w));
                *(f32x4*)(XO + (size_t)t * D + j) = o;
            }
    }
}
__device__ __forceinline__ void phase_peer_wq(const Params& p, int layer, unsigned char* lds) {
    const bf16_t* HM = (const bf16_t*)(p.ws + WS_HM); const bf16_t* WT = (const bf16_t*)(p.ws + WS_WQ_T) + (size_t)layer * 2048 * 1024;
    bf16_t* QK = (bf16_t*)(p.ws + WS_QK);
    const int lane = threadIdx.x & 63, wid = threadIdx.x >> 6, wr = wid >> 1, wc = wid & 1, fr = lane & 15, fq = lane >> 4;
    for (int id = vblock(); id < 256 * 16; id += gridDim.x) {
        const int mt = id >> 4, nt = id & 15;
        f32x4 acc[4][4];
        gemm_tile3(ALoadPlain{HM + (size_t)mt * 128 * D, (size_t)D}, WT + (size_t)nt * 128 * D, D, 16, acc, lds);
#pragma unroll
        for (int mi = 0; mi < 4; ++mi)
#pragma unroll
            for (int ni = 0; ni < 4; ++ni) {
                const int t = mt * 128 + wr * 64 + mi * 16 + fr, c = nt * 128 + wc * 64 + ni * 16 + fq * 4;
                const f32x4 v = acc[mi][ni];
                *(u32x2*)(QK + (size_t)t * 2048 + c) = (u32x2){pk2(v.x, v.y), pk2(v.z, v.w)};
            }
    }
}
__device__ __forceinline__ void ce_(unsigned& a, unsigned& b, const bool up) { const unsigned lo = a < b ? a : b, hi = a < b ? b : a; a = up ? lo : hi; b = up ? hi : lo; }
__device__ __forceinline__ void bitonic_sort16(unsigned* x, const bool asc) {
#pragma unroll
    for (int k = 2; k <= 16; k <<= 1)
#pragma unroll
        for (int j = k >> 1; j > 0; j >>= 1)
#pragma unroll
            for (int i = 0; i < 16; ++i) { const int l = i ^ j; if (l > i) ce_(x[i], x[l], ((i & k) == 0) == asc); }
}
__device__ __forceinline__ void bitonic_merge16(unsigned* x, const bool asc) {
#pragma unroll
    for (int j = 8; j > 0; j >>= 1)
#pragma unroll
        for (int i = 0; i < 16; ++i) { const int l = i ^ j; if (l > i) ce_(x[i], x[l], asc); }
}
__device__ __forceinline__ void phase_peer_topk(const Params& p, int layer, unsigned char* lds) {
    const bf16_t* QK = (const bf16_t*)(p.ws + WS_QK); const bf16_t* SK = (const bf16_t*)(p.ws + WS_SUBK) + (size_t)layer * 8 * 2 * 128 * 128;
    float* TOPS = (float*)(p.ws + WS_TOPS); int* TOPI = (int*)(p.ws + WS_TOPI);
    float* sc = (float*)lds;
    const int tid = threadIdx.x, lane = tid & 63, wid = tid >> 6, wr = wid >> 1, wc = wid & 1, fr = lane & 15, fq = lane >> 4;
    for (int id = vblock(); id < 256 * 16; id += gridDim.x) {
        const int mt = id >> 4, hc = id & 15;
        f32x4 acc[4][4];
        gemm_tile3(ALoadPlain{QK + (size_t)mt * 128 * 2048 + hc * 128, (size_t)2048}, SK + (size_t)hc * 128 * 128, 128, 2, acc, lds);
#pragma unroll
        for (int mi = 0; mi < 4; ++mi)
#pragma unroll
            for (int ni = 0; ni < 4; ++ni) {
                const int r = wr * 64 + mi * 16 + fr, c = wc * 64 + ni * 16 + fq * 4;
                float* d = sc + r * 129 + c;
                d[0] = acc[mi][ni].x; d[1] = acc[mi][ni].y; d[2] = acc[mi][ni].z; d[3] = acc[mi][ni].w;
            }
        __syncthreads();
        {
            const int row = tid >> 1, half = tid & 1;
            unsigned x[64];
            const float* rp = sc + row * 129 + half * 64;
#pragma unroll
            for (int j = 0; j < 64; ++j) {
                const unsigned bits = __builtin_bit_cast(unsigned, rp[j]);
                const unsigned u = bits ^ ((unsigned)((int)bits >> 31) | 0x80000000u);
                x[j] = (u & 0xFFFFFF80u) | (unsigned)(127 - (half * 64 + j));
            }
            bitonic_sort16(x, true); bitonic_sort16(x + 16, false); bitonic_sort16(x + 32, true); bitonic_sort16(x + 48, false);
#pragma unroll
            for (int i = 0; i < 16; ++i) { x[i] = x[i] > x[16 + i] ? x[i] : x[16 + i]; x[32 + i] = x[32 + i] > x[48 + i] ? x[32 + i] : x[48 + i]; }
            bitonic_merge16(x, true); bitonic_merge16(x + 32, false);
#pragma unroll
            for (int i = 0; i < 16; ++i) x[i] = x[i] > x[32 + i] ? x[i] : x[32 + i];
            bitonic_merge16(x, false);
            unsigned y[16];
#pragma unroll
            for (int i = 0; i < 16; ++i) { const unsigned o = (unsigned)__shfl_xor((int)x[15 - i], 1); y[i] = x[i] > o ? x[i] : o; }
            bitonic_merge16(y, false);
            const size_t ob = ((size_t)(mt * 128 + row) * 16 + hc) * 16;
            if (half == 0) {
                float v[16];
#pragma unroll
                for (int i = 0; i < 16; ++i) { const unsigned u = y[i] & 0xFFFFFF80u; const unsigned bits = (u & 0x80000000u) ? (u ^ 0x80000000u) : ~u; v[i] = __builtin_bit_cast(float, bits); }
#pragma unroll
                for (int q = 0; q < 4; ++q) *(f32x4*)(TOPS + ob + q * 4) = (f32x4){v[q * 4], v[q * 4 + 1], v[q * 4 + 2], v[q * 4 + 3]};
            } else {
#pragma unroll
                for (int q = 0; q < 4; ++q) *(u32x4*)(TOPI + ob + q * 4) = (u32x4){127u - (y[q * 4] & 127u), 127u - (y[q * 4 + 1] & 127u), 127u - (y[q * 4 + 2] & 127u), 127u - (y[q * 4 + 3] & 127u)};
            }
        }
        __syncthreads();
    }
}
__device__ __forceinline__ void phase_peer_wq_topk(const Params& p, int layer, unsigned char* lds) {
    const bf16_t* HM = (const bf16_t*)(p.ws + WS_HM); const bf16_t* WT = (const bf16_t*)(p.ws + WS_WQ_T) + (size_t)layer * 2048 * 1024;
    const bf16_t* SK = (const bf16_t*)(p.ws + WS_SUBK) + (size_t)layer * 8 * 2 * 128 * 128;
    float* TOPS = (float*)(p.ws + WS_TOPS); int* TOPI = (int*)(p.ws + WS_TOPI);
    float* sc = (float*)lds;
    const int tid = threadIdx.x, lane = tid & 63, wid = tid >> 6, wr = wid >> 1, wc = wid & 1, fr = lane & 15, fq = lane >> 4;
    for (int id = vblock(); id < 256 * 16; id += gridDim.x) {
        const int mt = id >> 4, hc = id & 15;
        f32x4 acc[4][4];
        gemm_tile3(ALoadPlain{HM + (size_t)mt * 128 * D, (size_t)D}, WT + (size_t)hc * 128 * D, D, 16, acc, lds);
        {
            const int srow = wid * 32 + (lane >> 3), schunk = (lane & 7) ^ ((lane >> 3) & 7);
            const bf16_t* sk = SK + (size_t)hc * 128 * 128;
#pragma unroll
            for (int kt = 0; kt < 2; ++kt)
#pragma unroll
                for (int i = 0; i < 4; ++i)
                    __builtin_amdgcn_global_load_lds((const unsigned*)(sk + (srow + 8 * i) * 128 + kt * 64 + schunk * 8), (unsigned*)(lds + kt * 32768 + 16384 + wid * 4096 + i * 1024), 16, 0, 0);
        }
#pragma unroll
        for (int mi = 0; mi < 4; ++mi)
#pragma unroll
            for (int ni = 0; ni < 4; ++ni) {
                const int r = wr * 64 + mi * 16 + fr, chunk = ni * 2 + (fq >> 1);
                const f32x4 v = acc[mi][ni];
                *(u32x2*)(lds + wc * 32768 + r * 128 + ((chunk ^ (r & 7)) << 4) + (fq & 1) * 8) = (u32x2){pk2(v.x, v.y), pk2(v.z, v.w)};
            }
        __syncthreads();
#pragma unroll
        for (int mi = 0; mi < 4; ++mi)
#pragma unroll
            for (int ni = 0; ni < 4; ++ni) acc[mi][ni] = (f32x4){0.f, 0.f, 0.f, 0.f};
        mma_ktile(lds, acc); mma_ktile(lds + 32768, acc);
        __syncthreads();
#pragma unroll
        for (int mi = 0; mi < 4; ++mi)
#pragma unroll
            for (int ni = 0; ni < 4; ++ni) {
                const int r = wr * 64 + mi * 16 + fr, c = wc * 64 + ni * 16 + fq * 4;
                float* d = sc + r * 129 + c;
                d[0] = acc[mi][ni].x; d[1] = acc[mi][ni].y; d[2] = acc[mi][ni].z; d[3] = acc[mi][ni].w;
            }
        __syncthreads();
        {
            const int row = tid >> 1, half = tid & 1;
            unsigned x[64];
            const float* rp = sc + row * 129 + half * 64;
#pragma unroll
            for (int j = 0; j < 64; ++j) {
                const unsigned bits = __builtin_bit_cast(unsigned, rp[j]);
                const unsigned u = bits ^ ((unsigned)((int)bits >> 31) | 0x80000000u);
                x[j] = (u & 0xFFFFFF80u) | (unsigned)(127 - (half * 64 + j));
            }
            bitonic_sort16(x, true); bitonic_sort16(x + 16, false); bitonic_sort16(x + 32, true); bitonic_sort16(x + 48, false);
#pragma unroll
            for (int i = 0; i < 16; ++i) { x[i] = x[i] > x[16 + i] ? x[i] : x[16 + i]; x[32 + i] = x[32 + i] > x[48 + i] ? x[32 + i] : x[48 + i]; }
            bitonic_merge16(x, true); bitonic_merge16(x + 32, false);
#pragma unroll
            for (int i = 0; i < 16; ++i) x[i] = x[i] > x[32 + i] ? x[i] : x[32 + i];
            bitonic_merge16(x, false);
            unsigned y[16];
#pragma unroll
            for (int i = 0; i < 16; ++i) { const unsigned o = (unsigned)__shfl_xor((int)x[15 - i], 1); y[i] = x[i] > o ? x[i] : o; }
            bitonic_merge16(y, false);
            const size_t ob = ((size_t)(mt * 128 + row) * 16 + hc) * 16;
            if (half == 0) {
                float v[16];
#pragma unroll
                for (int i = 0; i < 16; ++i) { const unsigned u = y[i] & 0xFFFFFF80u; const unsigned bits = (u & 0x80000000u) ? (u ^ 0x80000000u) : ~u; v[i] = __builtin_bit_cast(float, bits); }
#pragma unroll
                for (int q = 0; q < 4; ++q) *(f32x4*)(TOPS + ob + q * 4) = (f32x4){v[q * 4], v[q * 4 + 1], v[q * 4 + 2], v[q * 4 + 3]};
            } else {
#pragma unroll
                for (int q = 0; q < 4; ++q) *(u32x4*)(TOPI + ob + q * 4) = (u32x4){127u - (y[q * 4] & 127u), 127u - (y[q * 4 + 1] & 127u), 127u - (y[q * 4 + 2] & 127u), 127u - (y[q * 4 + 3] & 127u)};
            }
        }
        __syncthreads();
    }
}
__device__ __forceinline__ void phase_peer_combine(const Params& p, unsigned char* lds) {
    const float* TOPS = (const float*)(p.ws + WS_TOPS); const int* TOPI = (const int*)(p.ws + WS_TOPI);
    int* EXP = (int*)(p.ws + WS_EXP); float* GATE = (float*)(p.ws + WS_GATE);
    unsigned* L = (unsigned*)lds;
    const int tid = threadIdx.x;
    for (int it = blockIdx.x; it < (T * 8) / 256; it += gridDim.x) {
        const size_t th = (size_t)it * 256 + tid;
        const u32x4* S4 = (const u32x4*)(TOPS + th * 32); const u32x4* I4 = (const u32x4*)(TOPI + th * 32);
#pragma unroll
        for (int a4 = 0; a4 < 8; ++a4) {
            const u32x4 s = S4[a4], i = I4[a4];
            L[(a4 * 4 + 0) * 256 + tid] = s.x; L[(a4 * 4 + 1) * 256 + tid] = s.y; L[(a4 * 4 + 2) * 256 + tid] = s.z; L[(a4 * 4 + 3) * 256 + tid] = s.w;
            L[(32 + a4 * 4 + 0) * 256 + tid] = i.x; L[(32 + a4 * 4 + 1) * 256 + tid] = i.y; L[(32 + a4 * 4 + 2) * 256 + tid] = i.z; L[(32 + a4 * 4 + 3) * 256 + tid] = i.w;
        }
        float val[16];
        const float s20 = __builtin_bit_cast(float, L[16 * 256 + tid]);
#pragma unroll
        for (int a = 0; a < 16; ++a) val[a] = __builtin_bit_cast(float, L[a * 256 + tid]) + s20;
        unsigned long long P = 0ull;
        float ts[16]; int te[16];
#pragma unroll
        for (int r = 0; r < 16; ++r) {
            float best = val[0]; int ba = 0;
#pragma unroll
            for (int a = 1; a < 16; ++a) if (val[a] > best) { best = val[a]; ba = a; }
            const int b = (int)((P >> (4 * ba)) & 15ull);
            const int i1 = (int)L[(32 + ba) * 256 + tid], i2 = (int)L[(48 + b) * 256 + tid];
            ts[r] = best; te[r] = i1 * 128 + i2;
            const int nb = b + 1;
            float newv = -3.0e38f;
            if (nb < 16) { newv = __builtin_bit_cast(float, L[ba * 256 + tid]) + __builtin_bit_cast(float, L[(16 + nb) * 256 + tid]); P += 1ull << (4 * ba); }
#pragma unroll
            for (int a = 0; a < 16; ++a) val[a] = (a == ba) ? newv : val[a];
        }
        const float m0 = ts[0];
        float sum = 0.f;
#pragma unroll
        for (int r = 0; r < 16; ++r) { ts[r] = __expf(ts[r] - m0); sum += ts[r]; }
        const float inv = 1.0f / sum;
#pragma unroll
        for (int r = 0; r < 16; ++r) ts[r] *= inv;
#pragma unroll
        for (int r = 0; r < 16; ++r) { EXP[th * 16 + r] = te[r]; GATE[th * 16 + r] = ts[r]; }
    }
}

__device__ __forceinline__ void fma8(const unsigned w0, const unsigned w1, const float a, float* acc) {
    const f32x2 p0 = __builtin_amdgcn_cvt_pk_f32_fp8((int)w0, false), p1 = __builtin_amdgcn_cvt_pk_f32_fp8((int)w0, true);
    const f32x2 p2 = __builtin_amdgcn_cvt_pk_f32_fp8((int)w1, false), p3 = __builtin_amdgcn_cvt_pk_f32_fp8((int)w1, true);
    acc[0] += a * p0.x; acc[1] += a * p0.y; acc[2] += a * p1.x; acc[3] += a * p1.y;
    acc[4] += a * p2.x; acc[5] += a * p2.y; acc[6] += a * p3.x; acc[7] += a * p3.y;
}
__device__ __forceinline__ float dot8(const unsigned w0, const unsigned w1, const float* h, float s) {
    const f32x2 p0 = __builtin_amdgcn_cvt_pk_f32_fp8((int)w0, false), p1 = __builtin_amdgcn_cvt_pk_f32_fp8((int)w0, true);
    const f32x2 p2 = __builtin_amdgcn_cvt_pk_f32_fp8((int)w1, false), p3 = __builtin_amdgcn_cvt_pk_f32_fp8((int)w1, true);
    s += p0.x * h[0]; s += p0.y * h[1]; s += p1.x * h[2]; s += p1.y * h[3];
    s += p2.x * h[4]; s += p2.y * h[5]; s += p3.x * h[6]; s += p3.y * h[7];
    return s;
}
__device__ __forceinline__ void phase_peer_apply(const Params& p, int layer, unsigned char* lds, bool dry) {
    const int lane = threadIdx.x & 63, wave = threadIdx.x >> 6;
    float* ldsw = (float*)lds + wave * (64 * 65);
    const bf16_t* HM = (const bf16_t*)(p.ws + WS_HM);
    const unsigned char* PU = p.ws + WS_PU; const unsigned char* PV = p.ws + WS_PV;
    const float* SU = (const float*)(p.ws + WS_PU + 24 * MiB); const float* SV = (const float*)(p.ws + WS_PV + 24 * MiB);
    const int* EXP = (const int*)(p.ws + WS_EXP); const float* GATE = (const float*)(p.ws + WS_GATE);
    const float* MOD = (const float*)(p.ws + WS_MOD);
    float* X = p.out;
    for (int t = blockIdx.x * 4 + wave; t < T; t += gridDim.x * 4) {
        const u32x4 ha = *(const u32x4*)(HM + (size_t)t * D + lane * 16), hb = *(const u32x4*)(HM + (size_t)t * D + lane * 16 + 8);
        float hf[16];
        hf[0] = bflo(ha.x); hf[1] = bfhi(ha.x); hf[2] = bflo(ha.y); hf[3] = bfhi(ha.y); hf[4] = bflo(ha.z); hf[5] = bfhi(ha.z); hf[6] = bflo(ha.w); hf[7] = bfhi(ha.w);
        hf[8] = bflo(hb.x); hf[9] = bfhi(hb.x); hf[10] = bflo(hb.y); hf[11] = bfhi(hb.y); hf[12] = bflo(hb.z); hf[13] = bfhi(hb.z); hf[14] = bflo(hb.w); hf[15] = bfhi(hb.w);
        const int e0_ = EXP[(size_t)t * 128 + lane], e1_ = EXP[(size_t)t * 128 + 64 + lane];
        const float g0 = GATE[(size_t)t * 128 + lane], g1 = GATE[(size_t)t * 128 + 64 + lane];
        const float su0 = SU[e0_], su1 = SU[e1_], sv0 = SV[e0_], sv1 = SV[e1_];
        u32x4 buf[16];
        float act0 = 0.f, act1 = 0.f;
        float acc[16];
#pragma unroll
        for (int i = 0; i < 16; ++i) acc[i] = 0.f;
#ifndef APPLY_L2PROBE
#define APPLY_L2PROBE 0
#endif
        for (int prep_ = 0; prep_ < 1 + APPLY_L2PROBE; ++prep_) {
        const int emask = (APPLY_L2PROBE && prep_ == 0) ? 2047 : 0x7fffffff;
        const int e0 = e0_ & emask, e1 = e1_ & emask;
#pragma unroll
        for (int j = 0; j < 16; ++j) { const int e_ = __builtin_amdgcn_readlane(e0, j); buf[j] = *(const u32x4*)(PU + (size_t)e_ * D + lane * 16); }
#pragma unroll
        for (int bt = 0; bt < 16; ++bt) {
#pragma unroll
            for (int j = 0; j < 16; ++j) {
                if (bt < 8) {
                    float s_ = dot8(buf[j].x, buf[j].y, hf, 0.f); s_ = dot8(buf[j].z, buf[j].w, hf + 8, s_);
                    ldsw[((bt & 3) * 16 + j) * 65 + lane] = s_;
                } else {
                    const float av_ = ((bt & 7) < 4) ? act0 : act1;
                    const float a_ = __builtin_bit_cast(float, __builtin_amdgcn_readlane(__builtin_bit_cast(int, av_), (bt & 3) * 16 + j));
                    fma8(buf[j].x, buf[j].y, a_, acc); fma8(buf[j].z, buf[j].w, a_, acc + 8);
                }
                if (bt + 1 < 16) {
                    const int nb = bt + 1;
                    const int e_ = __builtin_amdgcn_readlane(((nb & 7) < 4) ? e0 : e1, (nb & 3) * 16 + j);
                    buf[j] = *(const u32x4*)(((nb < 8) ? PU : PV) + (size_t)e_ * D + lane * 16);
                }
            }
            if (bt == 3 || bt == 7) {
                float tot_ = 0.f;
#pragma unroll 16
                for (int q = 0; q < 64; ++q) tot_ += ldsw[lane * 65 + q];
                if (bt == 3) act0 = gelu_tanh(tot_ * su0) * g0 * sv0; else act1 = gelu_tanh(tot_ * su1) * g1 * sv1;
            }
        }
        if (APPLY_L2PROBE && prep_ == 0 && p.ph_hi >= 0) {
#pragma unroll
            for (int i = 0; i < 16; ++i) acc[i] = 0.f;
        }
        }
        const int b = t / SEQ;
        const float* g2 = MOD + (size_t)(layer * 2 + b) * 6144 + 5120;
        float* xr = X + (size_t)t * D + lane * 16;
        f32x4 xs[4]; float ss = 0.f;
#pragma unroll
        for (int q = 0; q < 4; ++q) {
            const f32x4 g = *(const f32x4*)(g2 + lane * 16 + q * 4); f32x4 x = *(const f32x4*)(xr + q * 4);
            x.x += g.x * acc[q * 4 + 0]; x.y += g.y * acc[q * 4 + 1]; x.z += g.z * acc[q * 4 + 2]; x.w += g.w * acc[q * 4 + 3];
            xs[q] = x; ss += (x.x * x.x + x.y * x.y) + (x.z * x.z + x.w * x.w);
        }
        const float rs = rsqrtf(wave_sum(ss) * (1.0f / D) + RMS_EPS);
        if (!dry) {
            if (layer == 0) {
                const float* gw = p.in[2] + D + lane * 16; const float* sh = MOD + (size_t)(2 + b) * 6144 + lane * 16; const float* sc = sh + 1024;
                u32x4 o[2];
#pragma unroll
                for (int q = 0; q < 4; ++q) {
                    *(f32x4*)(xr + q * 4) = xs[q];
                    const f32x4 g = *(const f32x4*)(gw + q * 4), s1 = *(const f32x4*)(sc + q * 4), s0 = *(const f32x4*)(sh + q * 4);
                    const float y0 = xs[q].x * rs * g.x * (1.f + s1.x) + s0.x, y1 = xs[q].y * rs * g.y * (1.f + s1.y) + s0.y;
                    const float y2 = xs[q].z * rs * g.z * (1.f + s1.z) + s0.z, y3 = xs[q].w * rs * g.w * (1.f + s1.w) + s0.w;
                    if (q & 1) { o[q >> 1].z = pk2(y0, y1); o[q >> 1].w = pk2(y2, y3); } else { o[q >> 1].x = pk2(y0, y1); o[q >> 1].y = pk2(y2, y3); }
                }
                bf16_t* hm = (bf16_t*)(p.ws + WS_HM) + (size_t)t * D + lane * 16;
                *(u32x4*)hm = o[0]; *(u32x4*)(hm + 8) = o[1];
            } else {
                const float* gw = p.in[28] + lane * 16;
#pragma unroll
                for (int q = 0; q < 4; ++q) {
                    const f32x4 g = *(const f32x4*)(gw + q * 4);
                    *(f32x4*)(xr + q * 4) = (f32x4){xs[q].x * rs * g.x, xs[q].y * rs * g.y, xs[q].z * rs * g.z, xs[q].w * rs * g.w};
                }
            }
        }
    }
}
__device__ __forceinline__ void phase_tab1(const Params& p) {
    const int first = vblock() - 256, stride = (int)gridDim.x - 256;
    if (first < 0 || stride <= 0) {
        if (stride <= 0) { for (int it = blockIdx.x; it < 2 * P0_TAB; it += gridDim.x) {
            if (it < P0_TAB) cvt_fp8_item(p.in[26] + (size_t)PE * D, p.ws + WS_PU, (float*)(p.ws + WS_PU + 24 * MiB), it, false);
            else cvt_fp8_item(p.in[27] + (size_t)PE * D, p.ws + WS_PV, (float*)(p.ws + WS_PV + 24 * MiB), it - P0_TAB, false); } }
        return;
    }
    for (int it = first; it < 2 * P0_TAB; it += stride) {
        if (it < P0_TAB) cvt_fp8_item(p.in[26] + (size_t)PE * D, p.ws + WS_PU, (float*)(p.ws + WS_PU + 24 * MiB), it, false);
        else cvt_fp8_item(p.in[27] + (size_t)PE * D, p.ws + WS_PV, (float*)(p.ws + WS_PV + 24 * MiB), it - P0_TAB, false);
    }
}
__device__ __forceinline__ void phase_nsa_proj(const Params& p, unsigned char* lds) {
    const bf16_t* HM = (const bf16_t*)(p.ws + WS_HM); const bf16_t* WT = (const bf16_t*)(p.ws + WS_WPROJ_T);
    const f32x2* ROPE = (const f32x2*)(p.ws + WS_ROPE);
    bf16_t* Q = (bf16_t*)(p.ws + WS_Q); float* NGT = (float*)(p.ws + WS_NG);
    const int lane = threadIdx.x & 63, wid = threadIdx.x >> 6, wr = wid >> 1, wc = wid & 1, fr = lane & 15, fq = lane >> 4;
    for (int id = vblock(); id < 256 * 21; id += gridDim.x) {
        const int mt = id / 21, nt = id % 21;
        f32x4 acc[4][4];
        gemm_tile3(ALoadPlain{HM + (size_t)mt * 128 * D, (size_t)D}, WT + (size_t)nt * 128 * D, D, 16, acc, lds);
        const int c0 = nt * 128 + wc * 64;
        if (c0 >= 2624) continue;
        const int b = (mt * 128) / SEQ;
        if (c0 == 2560) {
#pragma unroll
            for (int mi = 0; mi < 4; ++mi)
#pragma unroll
                for (int ni = 0; ni < 3; ++ni) {
                    const int t = mt * 128 + wr * 64 + mi * 16 + fr;
                    const f32x4 v = acc[mi][ni];
                    *(f32x4*)(NGT + (size_t)t * 48 + ni * 16 + fq * 4) = (f32x4){sigmoidf_(v.x), sigmoidf_(v.y), sigmoidf_(v.z), sigmoidf_(v.w)};
                }
            continue;
        }
        int sec = -1, g = 0;
        if (c0 >= 1024) { sec = (c0 - 1024) >> 8; g = ((c0 - 1024) & 255) >> 6; }
        const bool dorope = (sec == -1) || (sec == 2) || (sec == 4);
        const float scl = (sec == -1) ? 0.125f : 1.0f;
        const size_t secoff[6] = {WS_KC, WS_VC, WS_KS, WS_VST, WS_KW, WS_VWT};
        size_t so = WS_Q;
#pragma unroll
        for (int q = 0; q < 6; ++q) if (sec == q) so = secoff[q];
        bf16_t* OUT = (bf16_t*)(p.ws + so);
        const bool vt = (sec == 3) || (sec == 5);
        float kblk_am = 0.f;
#pragma unroll
        for (int pass = 0; pass < 2; ++pass) {
        if (pass == 1 && sec == 2) {
#pragma unroll
            for (int o = 1; o < 64; o <<= 1) kblk_am = fmaxf(kblk_am, __shfl_xor(kblk_am, o));
            if (lane == 0) ((float*)(p.ws + WS_KS + 12 * MiB))[(size_t)(b * 4 + g) * 256 + ((mt * 128 + wr * 64 - b * SEQ) >> 6)] = kblk_am > 0.f ? kblk_am / 224.0f : 1.0f;
        }
#pragma unroll
        for (int mi = 0; mi < 4; ++mi) {
            const int t = mt * 128 + wr * 64 + mi * 16 + fr, s = t - b * SEQ;
            if (dorope && pass == 0) {
#pragma unroll
                for (int ni = 0; ni < 2; ++ni) {
                    const f32x4* rp = (const f32x4*)(ROPE + (size_t)s * 32 + ni * 16 + fq * 4);
                    const f32x4 r0 = rp[0], r1 = rp[1];
                    const f32x4 x1 = acc[mi][ni], x2 = acc[mi][ni + 2];
                    acc[mi][ni] = (f32x4){x1.x * r0.x - x2.x * r0.y, x1.y * r0.z - x2.y * r0.w, x1.z * r1.x - x2.z * r1.y, x1.w * r1.z - x2.w * r1.w};
                    acc[mi][ni + 2] = (f32x4){x1.x * r0.y + x2.x * r0.x, x1.y * r0.w + x2.y * r0.z, x1.z * r1.y + x2.z * r1.x, x1.w * r1.w + x2.w * r1.z};
                }
            }
            if (pass == 0) {
                if (sec == 2) {
#pragma unroll
                    for (int ni = 0; ni < 4; ++ni) { const f32x4 v = acc[mi][ni]; kblk_am = fmaxf(kblk_am, fmaxf(fmaxf(fabsf(v.x), fabsf(v.y)), fmaxf(fabsf(v.z), fabsf(v.w)))); }
                }
                continue;
            }
            if (sec == -1 || sec == 2) {
                float am = kblk_am;
                if (sec == -1) {
                    am = 0.f;
#pragma unroll
                    for (int ni = 0; ni < 4; ++ni) { const f32x4 v = acc[mi][ni] * scl; am = fmaxf(am, fmaxf(fmaxf(fabsf(v.x), fabsf(v.y)), fmaxf(fabsf(v.z), fabsf(v.w)))); }
                    am = fmaxf(am, __shfl_xor(am, 16)); am = fmaxf(am, __shfl_xor(am, 32));
                }
                const float qs = am > 0.f ? 224.0f / am : 1.0f;
                unsigned char* O8 = (sec == -1) ? (p.ws + WS_Q8 + (size_t)t * 1024 + c0) : (p.ws + WS_KS + ((size_t)(b * 4 + g) * SEQ + s) * 64);
#pragma unroll
                for (int ni = 0; ni < 4; ++ni) {
                    const f32x4 v = acc[mi][ni] * (scl * qs);
                    int w = 0; w = __builtin_amdgcn_cvt_pk_fp8_f32(v.x, v.y, w, false); w = __builtin_amdgcn_cvt_pk_fp8_f32(v.z, v.w, w, true);
                    *(int*)(O8 + ni * 16 + fq * 4) = w;
                }
                if (fq == 0 && sec == -1) ((float*)(p.ws + WS_Q8 + 32 * MiB))[(size_t)t * 16 + (c0 >> 6)] = am > 0.f ? am / 224.0f : 1.0f;
            }
            if (sec == 2) continue;
#pragma unroll
            for (int ni = 0; ni < 4; ++ni) {
                const f32x4 v = acc[mi][ni] * scl;
                const int d = ni * 16 + fq * 4;
                if (sec == -1) {
                    *(u32x2*)(OUT + (size_t)t * 1024 + c0 + d) = (u32x2){pk2(v.x, v.y), pk2(v.z, v.w)};
                } else if (sec == 4) {
                    const size_t idx = (size_t)(b * 4 + g) * SEQ * 64 + (size_t)(s >> 5) * 2048 + ((((s >> 4) & 1) * 2 + (ni >> 1)) * 16 + (s & 15)) * 32 + ((ni & 1) * 2 + (fq >> 1)) * 8 + (fq & 1) * 4;
                    *(u32x2*)(OUT + idx) = (u32x2){pk2(v.x, v.y), pk2(v.z, v.w)};
                } else if (!vt) {
                    *(u32x2*)(OUT + ((size_t)(b * 4 + g) * SEQ + s) * 64 + d) = (u32x2){pk2(v.x, v.y), pk2(v.z, v.w)};
                } else if (sec == 5) {
                    const int key = s & 31;
                    bf16_t* o = OUT + (size_t)(b * 4 + g) * SEQ * 64 + (size_t)(s >> 5) * 2048 + ((ni * 2 + (key >> 4)) * 16 + fq * 4) * 16 + ((key >> 2) & 3) * 4 + (key & 3);
                    o[0] = (bf16_t)f2bf(v.x); o[16] = (bf16_t)f2bf(v.y); o[32] = (bf16_t)f2bf(v.z); o[48] = (bf16_t)f2bf(v.w);
                }
            }
        }
        }
        if (sec == 3) {
            const int s0 = mt * 128 + wr * 64 - b * SEQ, jb = s0 >> 6;
            unsigned char* V8 = p.ws + WS_VST + (size_t)((b * 4 + g) * 256 + jb) * 4096;
            float am = 0.f;
#pragma unroll
            for (int mi = 0; mi < 4; ++mi)
#pragma unroll
                for (int ni = 0; ni < 4; ++ni) { const f32x4 v = acc[mi][ni]; am = fmaxf(am, fmaxf(fmaxf(fabsf(v.x), fabsf(v.y)), fmaxf(fabsf(v.z), fabsf(v.w)))); }
#pragma unroll
            for (int o = 1; o < 64; o <<= 1) am = fmaxf(am, __shfl_xor(am, o));
            const float qs = am > 0.f ? 224.0f / am : 1.0f;
            if (lane == 0) ((float*)(p.ws + WS_VST + 12 * MiB))[(size_t)(b * 4 + g) * 256 + jb] = am > 0.f ? am / 224.0f : 1.0f;
#pragma unroll
            for (int ni = 0; ni < 4; ++ni) {
                const int d = ni * 16 + fq * 4;
#pragma unroll
                for (int mi = 0; mi < 4; ++mi) {
                    const f32x4 v = acc[mi][ni] * qs;
                    int w = 0; w = __builtin_amdgcn_cvt_pk_fp8_f32(v.x, v.y, w, false); w = __builtin_amdgcn_cvt_pk_fp8_f32(v.z, v.w, w, true);
                    unsigned char* o = V8 + (size_t)d * 64 + mi * 16 + fr;
                    o[0] = (unsigned char)(w & 255); o[64] = (unsigned char)((w >> 8) & 255); o[128] = (unsigned char)((w >> 16) & 255); o[192] = (unsigned char)((unsigned)w >> 24);
                }
            }
        }
    }
}
__device__ __forceinline__ void phase_nsa_cmp1(const Params& p, unsigned char* lds) {
    bf16_t* HID = (bf16_t*)(p.ws + WS_HID);
    const float* bias = (const float*)(p.ws + WS_MISC);
    const int lane = threadIdx.x & 63, wid = threadIdx.x >> 6, wr = wid >> 1, wc = wid & 1, fr = lane & 15, fq = lane >> 4;
    for (int id = vblock(); id < 256; id += gridDim.x) {
        const int kv = id >> 7, bg = (id >> 4) & 7, mt = (id >> 1) & 7, nt = id & 1;
        const bf16_t* A = (const bf16_t*)(p.ws + (kv ? WS_VC : WS_KC)) + (size_t)bg * SEQ * 64 + (size_t)mt * 128 * 1024;
        const bf16_t* B = (const bf16_t*)(p.ws + (kv ? WS_WV1_T : WS_WK1_T)) + (size_t)nt * 128 * 2048;
        f32x4 acc[4][4];
        gemm_tile3(ALoadPlain{A, (size_t)1024}, B, 2048, 32, acc, lds);
#pragma unroll
        for (int mi = 0; mi < 4; ++mi)
#pragma unroll
            for (int ni = 0; ni < 4; ++ni) {
                const int n = mt * 128 + wr * 64 + mi * 16 + fr, c = nt * 128 + wc * 64 + ni * 16 + fq * 4;
                const f32x4 bv = *(const f32x4*)(bias + kv * 256 + c);
                const f32x4 v = acc[mi][ni] + bv;
                *(u32x2*)(HID + (((size_t)kv * 8 + bg) * 1024 + n) * 256 + c) = (u32x2){pk2(gelu_tanh(v.x), gelu_tanh(v.y)), pk2(gelu_tanh(v.z), gelu_tanh(v.w))};
            }
    }
}
__device__ __forceinline__ void phase_nsa_cmp2(const Params& p, unsigned char* lds) {
    const bf16_t* HID = (const bf16_t*)(p.ws + WS_HID);
    const f32x2* ROPE = (const f32x2*)(p.ws + WS_ROPE);
    bf16_t* KCMP = (bf16_t*)(p.ws + WS_KCMP); bf16_t* VCMPT = (bf16_t*)(p.ws + WS_VCMPT);
    const int lane = threadIdx.x & 63, wid = threadIdx.x >> 6, wr = wid >> 1, wc = wid & 1, fr = lane & 15, fq = lane >> 4;
    for (int id = vblock(); id < 128; id += gridDim.x) {
        const int kv = id >> 6, mt = id & 63;
        const bf16_t* A = HID + ((size_t)kv * 8192 + (size_t)mt * 128) * 256;
        const bf16_t* B = (const bf16_t*)(p.ws + (kv ? WS_WV2_T : WS_WK2_T));
        f32x4 acc[4][4];
        gemm_tile3(ALoadPlain{A, (size_t)256}, B, 256, 4, acc, lds);
        if (wc == 1) continue;
#pragma unroll
        for (int mi = 0; mi < 4; ++mi) {
            const int R = mt * 128 + wr * 64 + mi * 16 + fr, bg = R >> 10, n = R & 1023;
            if (kv == 0) {
                int pos = n * 16 + 31; pos = pos > SEQ - 1 ? SEQ - 1 : pos;
#pragma unroll
                for (int ni = 0; ni < 2; ++ni) {
                    const f32x4* rp = (const f32x4*)(ROPE + (size_t)pos * 32 + ni * 16 + fq * 4);
                    const f32x4 r0 = rp[0], r1 = rp[1];
                    const f32x4 x1 = acc[mi][ni], x2 = acc[mi][ni + 2];
                    acc[mi][ni] = (f32x4){x1.x * r0.x - x2.x * r0.y, x1.y * r0.z - x2.y * r0.w, x1.z * r1.x - x2.z * r1.y, x1.w * r1.z - x2.w * r1.w};
                    acc[mi][ni + 2] = (f32x4){x1.x * r0.y + x2.x * r0.x, x1.y * r0.w + x2.y * r0.z, x1.z * r1.y + x2.z * r1.x, x1.w * r1.w + x2.w * r1.z};
                }
#pragma unroll
                for (int ni = 0; ni < 4; ++ni) {
                    const f32x4 v = acc[mi][ni];
                    const size_t idx = (size_t)bg * 1024 * 64 + (size_t)(n >> 5) * 2048 + ((((n >> 4) & 1) * 2 + (ni >> 1)) * 16 + (n & 15)) * 32 + ((ni & 1) * 2 + (fq >> 1)) * 8 + (fq & 1) * 4;
                    *(u32x2*)(KCMP + idx) = (u32x2){pk2(v.x, v.y), pk2(v.z, v.w)};
                }
            } else {
#pragma unroll
                for (int ni = 0; ni < 4; ++ni) {
                    const f32x4 v = acc[mi][ni];
                    const int key = n & 31;
                    bf16_t* o = VCMPT + (size_t)bg * 1024 * 64 + (size_t)(n >> 5) * 2048 + ((ni * 2 + (key >> 4)) * 16 + fq * 4) * 16 + ((key >> 2) & 3) * 4 + (key & 3);
                    o[0] = (bf16_t)f2bf(v.x); o[16] = (bf16_t)f2bf(v.y); o[32] = (bf16_t)f2bf(v.z); o[48] = (bf16_t)f2bf(v.w);
                }
            }
        }
    }
}
__device__ __forceinline__ void phase_nsa_wo(const Params& p, unsigned char* lds, bool dry) {
    const bf16_t* O = (const bf16_t*)(p.ws + WS_O); const bf16_t* WT = (const bf16_t*)(p.ws + WS_WO_T);
    const float* MOD = (const float*)(p.ws + WS_MOD);
    float* X = p.out;
    const int lane = threadIdx.x & 63, wid = threadIdx.x >> 6, wr = wid >> 1, wc = wid & 1, fr = lane & 15, fq = lane >> 4;
    for (int id = vblock(); id < 256 * 8; id += gridDim.x) {
        const int mt = id >> 3, nt = id & 7;
        f32x4 acc[4][4];
        gemm_tile3(ALoadPlain{O + (size_t)mt * 128 * D, (size_t)D}, WT + (size_t)nt * 128 * D, D, 16, acc, lds);
        const int b = (mt * 128) / SEQ;
#pragma unroll
        for (int mi = 0; mi < 4; ++mi)
#pragma unroll
            for (int ni = 0; ni < 4; ++ni) {
                const int t = mt * 128 + wr * 64 + mi * 16 + fr, c = nt * 128 + wc * 64 + ni * 16 + fq * 4;
                const f32x4 g1 = *(const f32x4*)(MOD + (size_t)(1 * 2 + b) * 6144 + 2048 + c);
                float* xp = X + (size_t)t * D + c;
                const f32x4 x = *(const f32x4*)xp; const f32x4 v = acc[mi][ni];
                if (!dry) *(f32x4*)xp = (f32x4){x.x + g1.x * v.x, x.y + g1.y * v.y, x.z + g1.z * v.z, x.w + g1.w * v.w};
            }
    }
}
__device__ __forceinline__ bf16x8 pack8(const f32x4 a, const f32x4 b) {
    u32x4 w; w.x = pk2(a.x, a.y); w.y = pk2(a.z, a.w); w.z = pk2(b.x, b.y); w.w = pk2(b.z, b.w);
    return __builtin_bit_cast(bf16x8, w);
}
__device__ __forceinline__ bf16x8 ldv8(const bf16_t* plo, const bf16_t* phi) {
    const u32x2 lo = *(const u32x2*)plo, hi = *(const u32x2*)phi;
    u32x4 w; w.x = lo.x; w.y = lo.y; w.z = hi.x; w.w = hi.y;
    return __builtin_bit_cast(bf16x8, w);
}
__device__ __forceinline__ float red4(float v) { v += __shfl_xor(v, 16); v += __shfl_xor(v, 32); return v; }
__device__ __forceinline__ float max4(float v) { v = fmaxf(v, __shfl_xor(v, 16)); v = fmaxf(v, __shfl_xor(v, 32)); return v; }
#define NEGBIG (-1.0e30f)

__device__ __forceinline__ void phase_nsa_attn(const Params& p, unsigned char* lds, const int rep_cmp, const int rep_win, const int rep_sel) {
    const int lane = threadIdx.x & 63, wave = threadIdx.x >> 6, fr = lane & 15, fq = lane >> 4;
    unsigned char* WL = lds + wave * 18432;
    float* IMP = (float*)WL;
    int* SEL = (int*)(WL + 17408);
    const bf16_t* Q = (const bf16_t*)(p.ws + WS_Q);
    const bf16_t* KCMP = (const bf16_t*)(p.ws + WS_KCMP); const bf16_t* VCMPT = (const bf16_t*)(p.ws + WS_VCMPT);
    const bf16_t* KW = (const bf16_t*)(p.ws + WS_KW); const bf16_t* VWT = (const bf16_t*)(p.ws + WS_VWT);
    const float* NGT = (const float*)(p.ws + WS_NG);
    bf16_t* O = (bf16_t*)(p.ws + WS_O);
    const f32x4 z4 = (f32x4){0.f, 0.f, 0.f, 0.f};
    for (int bi = blockIdx.x; bi < 2048; bi += gridDim.x) {
        const int bg = bi & 7, quad = 255 - (bi >> 3), t0 = (quad * 4 + wave) * 16, b = bg >> 2, g = bg & 3;
        const int cur = t0 >> 6;
        const size_t tok = (size_t)b * SEQ + t0 + fr;
        const int tq = t0 + fr;
        bf16x8 qf[4][2];
#pragma unroll
        for (int r = 0; r < 4; ++r)
#pragma unroll
            for (int ks = 0; ks < 2; ++ks) qf[r][ks] = *(const bf16x8*)(Q + tok * 1024 + (g * 4 + r) * 64 + ks * 32 + fq * 8);
        f32x4 acc[4][4];
        for (int rep = 0; rep < rep_win; ++rep) {
            const bf16_t* kwb = KW + (size_t)bg * SEQ * 64; const bf16_t* vwb = VWT + (size_t)bg * SEQ * 64;
            float mw[4], lw[4];
#pragma unroll
            for (int r = 0; r < 4; ++r) { mw[r] = NEGBIG; lw[r] = 0.f;
#pragma unroll
                for (int df = 0; df < 4; ++df) acc[r][df] = z4; }
            int kmin = t0 - 511; kmin = kmin < 0 ? 0 : kmin; kmin &= ~31;
            bf16x8 nkf[2][2];
#define WIN_LOAD(kb_) do { _Pragma("unroll") for (int f = 0; f < 2; ++f) _Pragma("unroll") for (int ks = 0; ks < 2; ++ks) nkf[f][ks] = *(const bf16x8*)(kwb + (size_t)((kb_) >> 5) * 2048 + ((f * 2 + ks) * 16 + fr) * 32 + fq * 8); } while (0)
            WIN_LOAD(kmin);
            for (int kb = kmin; kb <= t0 + 15; kb += 32) {
                bf16x8 kf[2][2], vf[4];
#pragma unroll
                for (int f = 0; f < 2; ++f) { kf[f][0] = nkf[f][0]; kf[f][1] = nkf[f][1]; }
#pragma unroll
                for (int df = 0; df < 4; ++df) { const bf16_t* vp = vwb + (size_t)(kb >> 5) * 2048 + (df * 32 + fr) * 16 + fq * 4; vf[df] = ldv8(vp, vp + 256); }
                { const int kn = (kb + 32 <= t0 + 15) ? kb + 32 : kb; WIN_LOAD(kn); }
#pragma unroll
                for (int r = 0; r < 4; ++r) {
                    f32x4 st[2];
#pragma unroll
                    for (int f = 0; f < 2; ++f) {
                        st[f] = __builtin_amdgcn_mfma_f32_16x16x32_bf16(kf[f][0], qf[r][0], z4, 0, 0, 0);
                        st[f] = __builtin_amdgcn_mfma_f32_16x16x32_bf16(kf[f][1], qf[r][1], st[f], 0, 0, 0);
                    }
                    float mx = NEGBIG;
#pragma unroll
                    for (int f = 0; f < 2; ++f)
#pragma unroll
                        for (int e = 0; e < 4; ++e) { const int key = kb + f * 16 + fq * 4 + e; const bool ok = (key <= tq) && (key > tq - 512); if (ok) mx = fmaxf(mx, st[f][e]); }
                    float mn = mw[r], al = 1.0f;
                    if (__builtin_amdgcn_ballot_w64(mx > mw[r] + 8.0f) != 0ull) { mn = fmaxf(mw[r], max4(mx)); al = __expf(mw[r] - mn); }
                    float ps = 0.f;
#pragma unroll
                    for (int f = 0; f < 2; ++f)
#pragma unroll
                        for (int e = 0; e < 4; ++e) { const int key = kb + f * 16 + fq * 4 + e; const bool ok = (key <= tq) && (key > tq - 512); const float pv = ok ? __expf(st[f][e] - mn) : 0.f; st[f][e] = pv; ps += pv; }
                    lw[r] = lw[r] * al + ps; mw[r] = mn;
                    const bf16x8 pf = pack8(st[0], st[1]);
#pragma unroll
                    for (int df = 0; df < 4; ++df) { acc[r][df] = acc[r][df] * al; acc[r][df] = __builtin_amdgcn_mfma_f32_16x16x32_bf16(vf[df], pf, acc[r][df], 0, 0, 0); }
                    __builtin_amdgcn_sched_barrier(0);
                }
            }
#pragma unroll
            for (int r = 0; r < 4; ++r) {
                const float l = red4(lw[r]); const float sc = NGT[tok * 48 + (g * 4 + r) * 3 + 2] / l;
#pragma unroll
                for (int df = 0; df < 4; ++df) acc[r][df] = acc[r][df] * sc;
            }
#undef WIN_LOAD
        }
        const int nmax_tile = (t0 >> 4) - 1, nmax_lane = (t0 >> 4) - 2 + (fr == 15 ? 1 : 0);
        const bf16_t* kcb = KCMP + (size_t)bg * 1024 * 64; const bf16_t* vcb = VCMPT + (size_t)bg * 64 * 1024;
        for (int rep = 0; rep < rep_cmp; ++rep) {
            const bool dry = (rep + 1 < rep_cmp);
            float mc[4], lc[4], invl[4];
#pragma unroll
            for (int r = 0; r < 4; ++r) { mc[r] = NEGBIG; lc[r] = 0.f; }
            bf16x8 nkc[2][2], nvc[4];
#define CMPK_LOAD(nb_) do { _Pragma("unroll") for (int f = 0; f < 2; ++f) _Pragma("unroll") for (int ks = 0; ks < 2; ++ks) nkc[f][ks] = *(const bf16x8*)(kcb + (size_t)((nb_) >> 5) * 2048 + ((f * 2 + ks) * 16 + fr) * 32 + fq * 8); } while (0)
#define CMPV_LOAD(nb_) do { _Pragma("unroll") for (int df = 0; df < 4; ++df) { const bf16_t* vp = vcb + (size_t)((nb_) >> 5) * 2048 + (df * 32 + fr) * 16 + fq * 4; nvc[df] = ldv8(vp, vp + 256); } } while (0)
            CMPK_LOAD(0);
            for (int nb = 0; nb <= nmax_tile; nb += 32) {
                bf16x8 kf[2][2];
#pragma unroll
                for (int f = 0; f < 2; ++f) { kf[f][0] = nkc[f][0]; kf[f][1] = nkc[f][1]; }
                { const int nn = (nb + 32 <= nmax_tile) ? nb + 32 : 0; CMPK_LOAD(nn); }
#pragma unroll
                for (int r = 0; r < 4; ++r) {
                    f32x4 st[2];
#pragma unroll
                    for (int f = 0; f < 2; ++f) {
                        st[f] = __builtin_amdgcn_mfma_f32_16x16x32_bf16(kf[f][0], qf[r][0], z4, 0, 0, 0);
                        st[f] = __builtin_amdgcn_mfma_f32_16x16x32_bf16(kf[f][1], qf[r][1], st[f], 0, 0, 0);
                    }
                    float mx = NEGBIG;
#pragma unroll
                    for (int f = 0; f < 2; ++f)
#pragma unroll
                        for (int e = 0; e < 4; ++e) { const int n = nb + f * 16 + fq * 4 + e; if (n <= nmax_lane) mx = fmaxf(mx, st[f][e]); }
                    float mn = mc[r];
                    if (__builtin_amdgcn_ballot_w64(mx > mc[r] + 8.0f) != 0ull) mn = fmaxf(mc[r], max4(mx));
                    float ps = 0.f;
#pragma unroll
                    for (int f = 0; f < 2; ++f)
#pragma unroll
                        for (int e = 0; e < 4; ++e) { const int n = nb + f * 16 + fq * 4 + e; if (n <= nmax_lane) ps += __expf(st[f][e] - mn); }
                    lc[r] = lc[r] * __expf(mc[r] - mn) + ps; mc[r] = mn;
                    __builtin_amdgcn_sched_barrier(0);
                }
            }
#pragma unroll
            for (int r = 0; r < 4; ++r) { const float l = red4(lc[r]); invl[r] = l > 0.f ? 1.0f / l : 0.f; }
            for (int i = lane; i < 16 * 260; i += 64) IMP[i] = 0.f;
            float carry = 0.f;
            float gc[4];
#pragma unroll
            for (int r = 0; r < 4; ++r) gc[r] = NGT[tok * 48 + (g * 4 + r) * 3];
            for (int nb = 0; nb <= nmax_tile; nb += 32) {
                bf16x8 kf[2][2], vf[4];
#pragma unroll
                for (int f = 0; f < 2; ++f) { kf[f][0] = nkc[f][0]; kf[f][1] = nkc[f][1]; }
                CMPV_LOAD(nb);
#pragma unroll
                for (int df = 0; df < 4; ++df) vf[df] = nvc[df];
                { const int nn = (nb + 32 <= nmax_tile) ? nb + 32 : nb; CMPK_LOAD(nn); }
                f32x4 pg[2] = {z4, z4};
#pragma unroll
                for (int r = 0; r < 4; ++r) {
                    f32x4 st[2];
#pragma unroll
                    for (int f = 0; f < 2; ++f) {
                        st[f] = __builtin_amdgcn_mfma_f32_16x16x32_bf16(kf[f][0], qf[r][0], z4, 0, 0, 0);
                        st[f] = __builtin_amdgcn_mfma_f32_16x16x32_bf16(kf[f][1], qf[r][1], st[f], 0, 0, 0);
#pragma unroll
                        for (int e = 0; e < 4; ++e) { const int n = nb + f * 16 + fq * 4 + e; st[f][e] = (n <= nmax_lane) ? __expf(st[f][e] - mc[r]) * invl[r] : 0.f; }
                        pg[f] += st[f];
                    }
                    const float gg = dry ? 0.f : gc[r];
                    const bf16x8 pf = pack8(st[0] * gg, st[1] * gg);
#pragma unroll
                    for (int df = 0; df < 4; ++df) acc[r][df] = __builtin_amdgcn_mfma_f32_16x16x32_bf16(vf[df], pf, acc[r][df], 0, 0, 0);
                    __builtin_amdgcn_sched_barrier(0);
                }
                const int src = (lane - 16) & 63;
                const float s0 = __shfl(pg[0].w, src), s1 = __shfl(pg[1].w, src), sc = __shfl(carry, src);
                const float prev0 = fq > 0 ? s0 : sc, prev1 = fq > 0 ? s1 : s0;
                const float imp0 = (pg[0].x + pg[0].y) + (pg[0].z + pg[0].w) + prev0;
                const float imp1 = (pg[1].x + pg[1].y) + (pg[1].z + pg[1].w) + prev1;
                const int jb = (nb >> 2) + fq;
                IMP[fr * 260 + jb] = imp0; IMP[fr * 260 + jb + 4] = imp1;
                carry = pg[1].w;
            }
#undef CMPK_LOAD
#undef CMPV_LOAD
        }
        {
            const int nf = cur >= 2 ? 3 : cur + 1;
            if (fq == 0) {
                SEL[fr * 16 + 0] = 0;
                if (cur == 1) SEL[fr * 16 + 1] = 1;
                if (cur >= 2) { SEL[fr * 16 + 1] = cur - 1; SEL[fr * 16 + 2] = cur; }
            }
            const int ncand = cur >= 3 ? cur - 2 : 0, extra = 16 - nf;
            if (ncand <= extra) {
                if (fq == 0) { for (int k = 0; k < extra; ++k) SEL[fr * 16 + nf + k] = (k < ncand) ? 1 + k : -1; }
            } else {
                for (int rnd = 0; rnd < extra; ++rnd) {
                    float bv = -1.0f; int bj = 1 << 20;
                    for (int jb = 1 + fq; jb <= cur - 2; jb += 4) { const float v = IMP[fr * 260 + jb]; if (v > bv) { bv = v; bj = jb; } }
#pragma unroll
                    for (int o = 16; o <= 32; o <<= 1) {
                        const float ov = __shfl_xor(bv, o); const int oj = __shfl_xor(bj, o);
                        if (ov > bv || (ov == bv && oj < bj)) { bv = ov; bj = oj; }
                    }
                    if (fq == 0) SEL[fr * 16 + nf + rnd] = bj;
                    if (((bj - 1) & 3) == fq) IMP[fr * 260 + bj] = -2.0f;
                }
            }
        }
#pragma unroll
        for (int r = 0; r < 4; ++r)
#pragma unroll
            for (int df = 0; df < 4; ++df) {
                const f32x4 v = acc[r][df];
                *(u32x2*)(O + tok * 1024 + (g * 4 + r) * 64 + df * 16 + fq * 4) = (u32x2){pk2(v.x, v.y), pk2(v.z, v.w)};
            }
        asm volatile("s_waitcnt vmcnt(0)" ::: "memory");
        unsigned selp[4];
        {
            const u32x4* sp = (const u32x4*)(SEL + fr * 16);
#pragma unroll
            for (int q = 0; q < 4; ++q) { const u32x4 w = sp[q]; selp[q] = (w.x & 255u) | ((w.y & 255u) << 8) | ((w.z & 255u) << 16) | ((w.w & 255u) << 24); }
        }
        for (int rep = 0; rep < rep_sel; ++rep) {
            const bool dry = (rep + 1 < rep_sel);
            const unsigned char* k8b = p.ws + WS_KS + (size_t)bg * SEQ * 64; const unsigned char* v8b = p.ws + WS_VST + (size_t)bg * 256 * 4096;
            const float* skb = (const float*)(p.ws + WS_KS + 12 * MiB) + (size_t)bg * 256; const float* svb = (const float*)(p.ws + WS_VST + 12 * MiB) + (size_t)bg * 256;
            const unsigned char* Q8 = p.ws + WS_Q8; const float* SQ8 = (const float*)(p.ws + WS_Q8 + 32 * MiB);
            const int nv = cur + 1 < 16 ? cur + 1 : 16, npair = (nv + 1) >> 1, total = 16 * npair;
            const int lrow = lane >> 2, lch = lane & 3;
            const int woff = lrow * 72 + lch * 16;
            const int rr = fr & 3;
            u32x4 sk[2][4], sv[2][4]; float ssk[2], ssv[2];
            int jbn[2];
#define SEL_GET(tokI, slotK) ((int)(((unsigned)__builtin_amdgcn_readlane((int)(((slotK) >> 2) == 0 ? selp[0] : ((slotK) >> 2) == 1 ? selp[1] : ((slotK) >> 2) == 2 ? selp[2] : selp[3]), (tokI)) >> (((slotK) & 3) * 8)) & 255u))
#define SEL_ISSUE(tokI, pairP) do { \
                const int k0_ = 2 * (pairP), k1_ = (2 * (pairP) + 1 < nv) ? 2 * (pairP) + 1 : k0_; \
                jbn[0] = __builtin_amdgcn_readfirstlane(SEL_GET(tokI, k0_)); jbn[1] = __builtin_amdgcn_readfirstlane(SEL_GET(tokI, k1_)); \
                _Pragma("unroll") for (int u = 0; u < 2; ++u) { \
                    const unsigned char* kb_ = k8b + (size_t)jbn[u] * 4096; const unsigned char* vb_ = v8b + (size_t)jbn[u] * 4096; \
                    _Pragma("unroll") for (int j = 0; j < 4; ++j) { sk[u][j] = *(const u32x4*)(kb_ + j * 1024 + lane * 16); sv[u][j] = *(const u32x4*)(vb_ + j * 1024 + lane * 16); } \
                    ssk[u] = skb[jbn[u]]; ssv[u] = svb[jbn[u]]; } } while (0)
            SEL_ISSUE(0, 0);
            long qs8[2] = {0, 0};
            float sq = 0.f, ms = NEGBIG, ls = 0.f;
            f32x4 os[4] = {z4, z4, z4, z4};
            u32x2 oprev[4] = {(u32x2){0u, 0u}, (u32x2){0u, 0u}, (u32x2){0u, 0u}, (u32x2){0u, 0u}};
            int i = 0, pp = 0;
            for (int v = 0; v < total; ++v) {
                const int jb0 = jbn[0], jb1 = jbn[1];
                const bool second_valid = (2 * pp + 1 < nv);
                const float ck0 = ssk[0], ck1 = ssk[1], cv0 = ssv[0], cv1 = ssv[1];
#pragma unroll
                for (int u = 0; u < 2; ++u)
#pragma unroll
                    for (int j = 0; j < 4; ++j) {
                        unsigned char* kd = WL + u * 9216 + woff + j * 1152; unsigned char* vd = kd + 4608;
                        *(u32x2*)kd = (u32x2){sk[u][j].x, sk[u][j].y}; *(u32x2*)(kd + 8) = (u32x2){sk[u][j].z, sk[u][j].w};
                        *(u32x2*)vd = (u32x2){sv[u][j].x, sv[u][j].y}; *(u32x2*)(vd + 8) = (u32x2){sv[u][j].z, sv[u][j].w};
                    }
                if (v + 1 < total) {
                    int p2 = pp + 1, i2 = i; if (p2 == npair) { p2 = 0; i2 = i + 1; }
                    SEL_ISSUE(i2, p2);
                }
                __builtin_amdgcn_sched_barrier(0);
                const int ti = t0 + i;
                if (pp == 0) {
                    const size_t tk = (size_t)b * SEQ + ti;
#pragma unroll
                    for (int ks = 0; ks < 2; ++ks) qs8[ks] = *(const long*)(Q8 + tk * 1024 + (g * 4 + rr) * 64 + ks * 32 + fq * 8);
                    sq = SQ8[tk * 16 + g * 4 + rr] * 1.4426950408889634f;
                    ms = NEGBIG; ls = 0.f;
#pragma unroll
                    for (int df = 0; df < 4; ++df) { os[df] = z4; oprev[df] = *(const u32x2*)(O + tk * 1024 + (g * 4 + rr) * 64 + df * 16 + fq * 4); }
                }
                f32x4 st[2][4];
#pragma unroll
                for (int u = 0; u < 2; ++u)
#pragma unroll
                    for (int f = 0; f < 4; ++f) {
                        const unsigned char* kp = WL + u * 9216 + (32 * (f >> 1) + 8 * (fr >> 2) + 4 * (f & 1) + (fr & 3)) * 72 + fq * 8;
                        const long k0 = *(const long*)kp, k1 = *(const long*)(kp + 32);
                        st[u][f] = __builtin_amdgcn_mfma_f32_16x16x32_fp8_fp8(k0, qs8[0], z4, 0, 0, 0);
                        st[u][f] = __builtin_amdgcn_mfma_f32_16x16x32_fp8_fp8(k1, qs8[1], st[u][f], 0, 0, 0);
                    }
                const float c0_ = sq * ck0, c1_ = sq * ck1;
                if (jb0 == cur || jb1 == cur || !second_valid) {
#pragma unroll
                    for (int u = 0; u < 2; ++u) {
                        const int jbu = u ? jb1 : jb0;
                        const bool allbad = (u == 1) && !second_valid;
#pragma unroll
                        for (int f = 0; f < 4; ++f)
#pragma unroll
                            for (int e = 0; e < 4; ++e) { const int key = jbu * 64 + 32 * (f >> 1) + 8 * fq + 4 * (f & 1) + e; if (allbad || key > ti) st[u][f][e] = NEGBIG; }
                    }
                }
                float mx0 = NEGBIG, mx1 = NEGBIG;
#pragma unroll
                for (int f = 0; f < 4; ++f) { mx0 = fmaxf(mx0, fmaxf(fmaxf(st[0][f].x, st[0][f].y), fmaxf(st[0][f].z, st[0][f].w))); mx1 = fmaxf(mx1, fmaxf(fmaxf(st[1][f].x, st[1][f].y), fmaxf(st[1][f].z, st[1][f].w))); }
                const float mxl = fmaxf(mx0 > -1.0e29f ? mx0 * c0_ : NEGBIG, mx1 > -1.0e29f ? mx1 * c1_ : NEGBIG);
                float mn = ms, al = 1.0f;
                if (__builtin_amdgcn_ballot_w64(mxl > ms + 4.0f) != 0ull) {
                    mn = fmaxf(ms, max4(mxl));
                    al = __builtin_amdgcn_exp2f(ms - mn);
                }
                const float off = 4.0f - mn;
                float ps = 0.f;
                long pfw[2][2];
#pragma unroll
                for (int u = 0; u < 2; ++u) {
                    const float cu = u ? c1_ : c0_;
#pragma unroll
                    for (int f = 0; f < 4; ++f)
#pragma unroll
                        for (int e = 0; e < 4; ++e) { const float pv = __builtin_amdgcn_exp2f(st[u][f][e] * cu + off); st[u][f][e] = pv; ps += pv; }
#pragma unroll
                    for (int s = 0; s < 2; ++s) {
                        int w0 = 0, w1 = 0;
                        w0 = __builtin_amdgcn_cvt_pk_fp8_f32(st[u][2 * s].x, st[u][2 * s].y, w0, false); w0 = __builtin_amdgcn_cvt_pk_fp8_f32(st[u][2 * s].z, st[u][2 * s].w, w0, true);
                        w1 = __builtin_amdgcn_cvt_pk_fp8_f32(st[u][2 * s + 1].x, st[u][2 * s + 1].y, w1, false); w1 = __builtin_amdgcn_cvt_pk_fp8_f32(st[u][2 * s + 1].z, st[u][2 * s + 1].w, w1, true);
                        pfw[u][s] = (long)(((unsigned long long)(unsigned)w1 << 32) | (unsigned long long)(unsigned)w0);
                    }
                }
                ls = ls * al + ps; ms = mn;
#pragma unroll
                for (int df = 0; df < 4; ++df) os[df] = os[df] * al;
#pragma unroll
                for (int u = 0; u < 2; ++u) {
                    f32x4 pvacc[4] = {z4, z4, z4, z4};
#pragma unroll
                    for (int s = 0; s < 2; ++s) {
#pragma unroll
                        for (int df = 0; df < 4; ++df) {
                            const long vf = *(const long*)(WL + u * 9216 + 4608 + (df * 16 + fr) * 72 + 32 * s + 8 * fq);
                            pvacc[df] = __builtin_amdgcn_mfma_f32_16x16x32_fp8_fp8(vf, pfw[u][s], pvacc[df], 0, 0, 0);
                        }
                    }
                    const float cvu = u ? cv1 : cv0;
#pragma unroll
                    for (int df = 0; df < 4; ++df) os[df] = os[df] + pvacc[df] * cvu;
                    __builtin_amdgcn_sched_barrier(0);
                }
                if (pp == npair - 1) {
                    const float l = red4(ls);
                    const float gsv = NGT[((size_t)b * SEQ + ti) * 48 + (g * 4 + rr) * 3 + 1];
                    const float sc = gsv / l;
                    if (fr < 4 && !dry) {
                        bf16_t* op = O + ((size_t)b * SEQ + ti) * 1024 + (g * 4 + fr) * 64 + fq * 4;
#pragma unroll
                        for (int df = 0; df < 4; ++df) {
                            const f32x4 val = os[df] * sc; const u32x2 c = oprev[df];
                            *(u32x2*)(op + df * 16) = (u32x2){pk2(bflo(c.x) + val.x, bfhi(c.x) + val.y), pk2(bflo(c.y) + val.z, bfhi(c.y) + val.w)};
                        }
                    }
                }
                ++pp; if (pp == npair) { pp = 0; ++i; }
            }
#undef SEL_GET
#undef SEL_ISSUE
        }
    }
}
constexpr int NPHASES = 20;
#ifndef PROBE_PHASE
#define PROBE_PHASE (-1)
#endif
#ifndef ATT_REP_CMP
#define ATT_REP_CMP 1
#endif
#ifndef ATT_REP_WIN
#define ATT_REP_WIN 1
#endif
#ifndef ATT_REP_SEL
#define ATT_REP_SEL 1
#endif
#ifndef TS_PHASE
#define TS_PHASE (-1)
#endif
#ifndef TS_MULT
#define TS_MULT 4
#endif
#ifndef PROBE_REPS
#define PROBE_REPS 1
#endif
__global__ void __launch_bounds__(NTHREADS, 2) mega(Params p) {
    __shared__ __attribute__((aligned(1024))) unsigned char lds[LDS_BYTES + 16];
    unsigned* bar_st = (unsigned*)(lds + LDS_BYTES);
    cg::grid_group grid = cg::this_grid();
    const float* MOD = (const float*)(p.ws + WS_MOD);
    bf16_t* HM = (bf16_t*)(p.ws + WS_HM);
    if (threadIdx.x < 4) bar_st[threadIdx.x] = 0u;
    __syncthreads();
    XcdBarrier bar = xcd_barrier_post((unsigned*)(p.ws + WS_CTL), (volatile LAS unsigned*)bar_st);
    const int lo = p.ph_lo, hi = p.ph_hi;
    const bool dry0 = (p.ph_hi < 0);
    const int opq = (p.ph_hi < 0) ? 1 : 0;
    const bool never = (p.ph_hi < 0);
    unsigned long long ts_a = 0ull, ts_b = 0ull;
#define PHASE(k, call, drycall) if (lo <= (k) && (k) < hi) { \
        if (TS_PHASE == (k)) ts_a = __builtin_amdgcn_s_memrealtime(); \
        if (PROBE_PHASE == (k)) { for (int rep = 0; rep < PROBE_REPS; ++rep) { const bool dry = !dry0; drycall; __syncthreads(); } } \
        { const bool dry = dry0; call; } \
        if ((k) + 1 < hi) { if (never) grid.sync(); else xcd_barrier(bar); } \
        if (TS_PHASE == (k)) ts_b = __builtin_amdgcn_s_memrealtime(); }
    PHASE(0, phase_prep(p, (float*)lds, 0), phase_prep(p, (float*)lds, 0))
    PHASE(1, phase_norm(p, p.in[0], p.in[2], MOD + 0, MOD + 1024, HM), phase_norm(p, p.in[0], p.in[2], MOD + 0, MOD + 1024, HM))
    PHASE(2, phase_s5_win(p, lds), phase_s5_win(p, lds))
    PHASE(3, phase_s5_a(p, lds), phase_s5_a(p, lds))
    PHASE(4, (phase_s5_scan(p), phase_prep(p, (float*)lds, 1)), (phase_s5_scan(p), phase_prep(p, (float*)lds, 1)))
    PHASE(5, phase_s5_b(p, lds), phase_s5_b(p, lds))
    PHASE(6, phase_s5_glu(p, lds), phase_s5_glu(p, lds))
    PHASE(7, phase_norm(p, p.out, p.in[3], MOD + 3072, MOD + 4096, HM), phase_norm(p, p.out, p.in[3], MOD + 3072, MOD + 4096, HM))
    PHASE(8, phase_peer_wq_topk(p, 0, lds), phase_peer_wq_topk(p, 0, lds))
    PHASE(9, phase_peer_combine(p, lds), phase_peer_combine(p, lds))
    PHASE(10, phase_peer_apply(p, 0, lds, dry), phase_peer_apply(p, 0, lds, dry))
    PHASE(11, phase_nsa_proj(p, lds), phase_nsa_proj(p, lds))
    PHASE(12, (phase_nsa_cmp1(p, lds), phase_tab1(p)), (phase_nsa_cmp1(p, lds), phase_tab1(p)))
    PHASE(13, phase_nsa_cmp2(p, lds), phase_nsa_cmp2(p, lds))
    PHASE(14, phase_nsa_attn(p, lds, ATT_REP_CMP + opq, ATT_REP_WIN + opq, ATT_REP_SEL + opq), phase_nsa_attn(p, lds, 1 + opq, 1 + opq, 1 + opq))
    PHASE(15, phase_nsa_wo(p, lds, dry), phase_nsa_wo(p, lds, dry))
    PHASE(16, phase_norm(p, p.out, p.in[3] + D, MOD + 2 * 6144 + 3072, MOD + 2 * 6144 + 4096, HM), phase_norm(p, p.out, p.in[3] + D, MOD + 2 * 6144 + 3072, MOD + 2 * 6144 + 4096, HM))
    PHASE(17, phase_peer_wq_topk(p, 1, lds), phase_peer_wq_topk(p, 1, lds))
    PHASE(18, phase_peer_combine(p, lds), phase_peer_combine(p, lds))
    PHASE(19, phase_peer_apply(p, 1, lds, dry), phase_peer_apply(p, 1, lds, dry))
#undef PHASE
    if (TS_PHASE >= 0 && blockIdx.x == 0 && threadIdx.x == 0) {
        const unsigned long long t0 = __builtin_amdgcn_s_memrealtime(), want = (ts_b - ts_a) * TS_MULT;
        while (__builtin_amdgcn_s_memrealtime() - t0 < want) __builtin_amdgcn_s_sleep(8);
    }
}

extern "C" void kernel_launch(void* const* d_in, const int* in_sizes, int n_in, void* d_out, int out_size, void* d_ws, size_t ws_size, hipStream_t stream) {
    static int grid_blocks = 0;
    if (!grid_blocks) {
        int dev = 0, cus = 0, per_cu = 0;
        hipGetDevice(&dev);
        hipDeviceGetAttribute(&cus, hipDeviceAttributeMultiprocessorCount, dev);
        hipOccupancyMaxActiveBlocksPerMultiprocessor(&per_cu, mega, NTHREADS, 0);
        if (per_cu > 2) per_cu = 2;
        if (per_cu < 1) per_cu = 1;
        grid_blocks = cus * per_cu;
        if (ws_size < WS_END) fprintf(stderr, "kernel_launch: workspace too small: %zu < %zu\n", ws_size, (size_t)WS_END);
        if (n_in != 29) fprintf(stderr, "kernel_launch: expected 29 inputs, got %d\n", n_in);
    }
    hipMemsetAsync((unsigned char*)d_ws + WS_CTL, 0, 16384, stream);
    Params p{};
    for (int i = 0; i < 29; ++i) p.in[i] = (const float*)d_in[i];
    p.out = (float*)d_out; p.ws = (unsigned char*)d_ws;
#if SINGLE_LAUNCH
    p.ph_lo = 0; p.ph_hi = NPHASES;
    void* args[] = {&p};
    hipError_t e = hipLaunchCooperativeKernel((void*)mega, dim3(grid_blocks), dim3(NTHREADS), args, 0, stream);
    if (e != hipSuccess) fprintf(stderr, "cooperative launch failed: %s (grid %d)\n", hipGetErrorString(e), grid_blocks);
#else
    for (int ph = 0; ph < NPHASES; ++ph) {
        p.ph_lo = ph; p.ph_hi = ph + 1;
        hipLaunchKernelGGL(mega, dim3(grid_blocks), dim3(NTHREADS), 0, stream, p);
    }
#endif
}
```

```cpp
#include <hip/hip_runtime.h>
#include <hip/hip_cooperative_groups.h>
#include <cstdio>
#include <cstdint>
namespace cg = cooperative_groups;

#ifndef SINGLE_LAUNCH
#define SINGLE_LAUNCH 1
#endif

typedef unsigned short bf16_t;
typedef short bf16x8 __attribute__((ext_vector_type(8)));
typedef float f32x4 __attribute__((ext_vector_type(4)));
typedef float f32x2 __attribute__((ext_vector_type(2)));
typedef unsigned u32x4 __attribute__((ext_vector_type(4)));
typedef unsigned u32x2 __attribute__((ext_vector_type(2)));
typedef __bf16 bf16x2_t __attribute__((ext_vector_type(2)));

constexpr int D = 1024, BATCH = 2, SEQ = 16384, T = BATCH * SEQ;
constexpr int NTHREADS = 256;
constexpr float RMS_EPS = 1e-6f;
constexpr int S5G = 64, S5P = 64, S5L = 32, S5NCH = T / S5L  , S5CPB = SEQ / S5L  ;
constexpr int NH = 16, HD = 64, NG = 4, NPROJ = 2608, NPROJ_PAD = 2688, NC = 1023, NSB = 256;
constexpr int PH = 8, PK = 16, PNK = 128, PE = 16384;

constexpr size_t MiB = 1ull << 20;
constexpr size_t WS_CTL = 0;
constexpr size_t WS_MOD = 1 * MiB;
constexpr size_t WS_WIN_T = 2 * MiB;
constexpr size_t WS_WGLU_T = 4 * MiB;
constexpr size_t WS_WPROJ_T = 8 * MiB;
constexpr size_t WS_WK1_T = 14 * MiB;
constexpr size_t WS_WV1_T = 15 * MiB;
constexpr size_t WS_WK2_T = 16 * MiB;
constexpr size_t WS_WV2_T = 16 * MiB + 512 * 1024;
constexpr size_t WS_WO_T = 17 * MiB;
constexpr size_t WS_WQ_T = 19 * MiB;
constexpr size_t WS_SUBK = 27 * MiB;
constexpr size_t WS_ROPE = 28 * MiB;
constexpr size_t WS_MISC = 32 * MiB;
constexpr size_t WS_TW = 33 * MiB;
constexpr size_t WS_VG = 73 * MiB;
constexpr size_t WS_PU = 82 * MiB;
constexpr size_t WS_PV = 114 * MiB;
constexpr size_t WS_HM = 146 * MiB;
constexpr size_t WS_C = 210 * MiB;
constexpr size_t WS_UG = WS_C;
constexpr size_t WS_YI = WS_C + 64 * MiB;
constexpr size_t WS_WST = WS_C + 128 * MiB;
constexpr size_t WS_SST = WS_C + 160 * MiB;
constexpr size_t WS_YG = WS_C + 176 * MiB;
constexpr size_t WS_QK = WS_C;
constexpr size_t WS_TOPS = WS_C + 128 * MiB;
constexpr size_t WS_TOPI = WS_C + 160 * MiB;
constexpr size_t WS_EXP = WS_C + 192 * MiB;
constexpr size_t WS_GATE = WS_C + 208 * MiB;
constexpr size_t WS_ACT = WS_C + 224 * MiB;
constexpr size_t WS_Q = WS_C;
constexpr size_t WS_KC = WS_C + 64 * MiB;
constexpr size_t WS_VC = WS_C + 81 * MiB;
constexpr size_t WS_KS = WS_C + 98 * MiB;
constexpr size_t WS_VST = WS_C + 114 * MiB;
constexpr size_t WS_KW = WS_C + 130 * MiB;
constexpr size_t WS_VWT = WS_C + 146 * MiB;
constexpr size_t WS_NG = WS_C + 162 * MiB;
constexpr size_t WS_KCMP = WS_C + 170 * MiB;
constexpr size_t WS_VCMPT = WS_C + 171 * MiB;
constexpr size_t WS_HID = WS_C + 172 * MiB;
constexpr size_t WS_O = WS_C + 182 * MiB;
constexpr size_t WS_Q8 = WS_C + 246 * MiB;
constexpr size_t WS_END = WS_C + 282 * MiB;

constexpr int LDS_BYTES = 74240;

struct Params {
    const float* in[29];
    float* out;
    unsigned char* ws;
    int ph_lo, ph_hi;
};

__device__ __forceinline__ unsigned f2bf(float f) { unsigned u = __builtin_bit_cast(unsigned, f); return (u + 0x7fffu + ((u >> 16) & 1u)) >> 16; }
__device__ __forceinline__ unsigned pk2(float lo, float hi) { return f2bf(lo) | (f2bf(hi) << 16); }
__device__ __forceinline__ float bf2f(unsigned h) { return __builtin_bit_cast(float, h << 16); }
__device__ __forceinline__ float bflo(unsigned w) { return __builtin_bit_cast(float, w << 16); }
__device__ __forceinline__ float bfhi(unsigned w) { return __builtin_bit_cast(float, w & 0xffff0000u); }
__device__ __forceinline__ float gelu_tanh(float x) {
    const float u = 0.7978845608028654f * (x + 0.044715f * x * x * x);
    const float e = __expf(2.0f * u);
    const float th = 1.0f - 2.0f / (e + 1.0f);
    return 0.5f * x * (1.0f + th);
}
__device__ __forceinline__ float sigmoidf_(float x) { return 1.0f / (1.0f + __expf(-x)); }
__device__ __forceinline__ float wave_sum(float v) {
#pragma unroll
    for (int o = 1; o < 64; o <<= 1) v += __shfl_xor(v, o);
    return v;
}
__device__ __forceinline__ float dot2bf(unsigned a, unsigned b, float acc) {
    return __builtin_amdgcn_fdot2_f32_bf16(__builtin_bit_cast(bf16x2_t, a), __builtin_bit_cast(bf16x2_t, b), acc, false);
}

#define LAS __attribute__((address_space(3)))
#define XB_TMO      128
#define XB_XCNT(j)  (256  + 64 * (j))
#define XB_XSUB(j)  (1280 + 64 * (j))
#define XB_XGEN(j)  (2304 + 64 * (j))
#define XB_TOP      3328
#define XB_TOPGEN   3392
#define XCD_BAR_WORDS 3456
#define XB_SPIN_CAP (1u << 24)

__device__ __forceinline__ unsigned xb_ld(unsigned* p)              { return __hip_atomic_load(p, __ATOMIC_RELAXED, __HIP_MEMORY_SCOPE_AGENT); }
__device__ __forceinline__ unsigned xb_add(unsigned* p, unsigned v) { return __hip_atomic_fetch_add(p, v, __ATOMIC_RELAXED, __HIP_MEMORY_SCOPE_AGENT); }
__device__ __forceinline__ unsigned xb_xcc_id() { return (unsigned)__builtin_amdgcn_s_getreg((3 << 11) | 20) & 0xFu; }
#define XB_SPIN(cond, bar) do { unsigned _sp = 0; while (cond) { __builtin_amdgcn_s_sleep(1); \
    if ((++_sp & 255u) == 0u) { if (xb_ld(&(bar)[XB_TMO])) break; if (_sp > XB_SPIN_CAP) { atomicAdd(&(bar)[XB_TMO], 1u); break; } } } } while (0)

struct XcdBarrier {
    unsigned* bar; unsigned x;
    volatile LAS unsigned* st;
};

__device__ __forceinline__ XcdBarrier xcd_barrier_post(unsigned* bar, volatile LAS unsigned* st) {
    XcdBarrier b; b.bar = bar; b.x = xb_xcc_id(); b.st = st;
    if (threadIdx.x == 0) (void)xb_add(&bar[XB_XCNT(b.x)], 1u);
    return b;
}
__device__ __forceinline__ void xcd_barrier_complete(unsigned* bar, unsigned x, unsigned& nloc, unsigned& nx) {
    const unsigned G = gridDim.x * gridDim.y * gridDim.z;
    unsigned sum, cnt, mine, sp = 0u;
    for (;;) {
        sum = 0u; cnt = 0u; mine = 0u;
#pragma unroll
        for (unsigned j = 0; j < 16; ++j) { const unsigned c = xb_ld(&bar[XB_XCNT(j)]); sum += c; cnt += (c > 0u) ? 1u : 0u; mine = (j == x) ? c : mine; }
        if (sum == G) break;
        __builtin_amdgcn_s_sleep(1);
        if ((++sp & 255u) == 0u) { if (xb_ld(&bar[XB_TMO])) break; if (sp > XB_SPIN_CAP) { atomicAdd(&bar[XB_TMO], 1u); break; } }
    }
    nloc = mine > 0u ? mine : 1u; nx = cnt > 0u ? cnt : 1u;
}

__device__ __forceinline__ void xcd_barrier(const XcdBarrier& b) {
    asm volatile("s_waitcnt vmcnt(0)" ::: "memory");
    __syncthreads();
    if (threadIdx.x == 0) {
        unsigned* bar = b.bar;
        __builtin_amdgcn_s_waitcnt(0);
        unsigned nloc = b.st[0], nx = b.st[1];
        if (nloc == 0u) { xcd_barrier_complete(bar, b.x, nloc, nx); b.st[0] = nloc; b.st[1] = nx; }
        const unsigned old = xb_add(&bar[XB_XSUB(b.x)], 1u);
        const unsigned gen = old / nloc;
        if (old + 1u == (gen + 1u) * nloc) {
            __builtin_amdgcn_fence(__ATOMIC_RELEASE, "agent");
            asm volatile("s_waitcnt vmcnt(0)" ::: "memory");
            const unsigned og = xb_add(&bar[XB_TOP], 1u);
            const unsigned tg = og / nx;
            if (og + 1u == (tg + 1u) * nx) xb_add(&bar[XB_TOPGEN], 1u);
            else XB_SPIN(xb_ld(&bar[XB_TOPGEN]) == tg, bar);
            __builtin_amdgcn_fence(__ATOMIC_ACQUIRE, "agent");
            xb_add(&bar[XB_XGEN(b.x)], 1u);
            asm volatile("s_waitcnt vmcnt(0)" ::: "memory");
        } else {
            XB_SPIN(xb_ld(&bar[XB_XGEN(b.x)]) == gen, bar);
            __builtin_amdgcn_fence(__ATOMIC_ACQUIRE, "agent");
            asm volatile("s_waitcnt vmcnt(0)" ::: "memory");
        }
    }
    __syncthreads();
}
__device__ __forceinline__ void prep_mod_item(const Params& p, int item, float* lds) {
    const int layer = item / 192, cg0 = (item % 192) * 32;
    const int tid = threadIdx.x, col = cg0 + (tid & 31), kg = tid >> 5;
    const float* W = p.in[4] + (size_t)layer * D * 6 * D + col;
    const float* c = p.in[1];
    float* cact = lds + 512;
#pragma unroll
    for (int i = 0; i < 8; ++i) { const int q = tid + 256 * i; const float v = c[q]; cact[q] = v * sigmoidf_(v); }
    __syncthreads();
    float a0 = 0.f, a1 = 0.f;
    for (int k0 = kg * 128; k0 < kg * 128 + 128; k0 += 16) {
        float w[16];
#pragma unroll
        for (int u = 0; u < 16; ++u) w[u] = W[(size_t)(k0 + u) * (6 * D)];
#pragma unroll
        for (int u = 0; u < 16; ++u) { a0 += w[u] * cact[k0 + u]; a1 += w[u] * cact[1024 + k0 + u]; }
    }
    lds[tid] = a0; lds[256 + tid] = a1;
    __syncthreads();
    if (tid < 64) {
        const int b = tid >> 5, cc = tid & 31;
        float s = 0.f;
#pragma unroll
        for (int g = 0; g < 8; ++g) s += lds[b * 256 + g * 32 + cc];
        float* MOD = (float*)(p.ws + WS_MOD);
        MOD[(size_t)(layer * 2 + b) * 6144 + cg0 + cc] = s + p.in[5][(size_t)layer * 6144 + cg0 + cc];
    }
    __syncthreads();
}

template <int MODE>
__device__ __forceinline__ void prep_transpose_item(const float* W, int K, int N, bf16_t* WT, int item, float* lds) {
    const int nbn = (N + 63) / 64, kb = item / nbn, nb = item % nbn, k0 = kb * 64, n0 = nb * 64;
    const int tid = threadIdx.x;
#pragma unroll
    for (int i = 0; i < 16; ++i) {
        const int kk = (tid >> 6) + 4 * i, nn = tid & 63;
        const float v = (n0 + nn < N) ? W[(size_t)(k0 + kk) * N + n0 + nn] : 0.f;
        lds[kk * 65 + nn] = v;
    }
    __syncthreads();
    {
        const int nn = tid >> 2, ks = (tid & 3) * 16;
        const int n = n0 + nn;
        if (n < N) {
            int np = n;
            if (MODE == 1) { const int j = (n < 1024) ? n : n - 1024; np = (j >> 4) * 32 + (j & 15) + ((n < 1024) ? 0 : 16); }
            u32x4 o0, o1;
            const float* s = lds + nn;
            o0.x = pk2(s[(ks + 0) * 65], s[(ks + 1) * 65]); o0.y = pk2(s[(ks + 2) * 65], s[(ks + 3) * 65]);
            o0.z = pk2(s[(ks + 4) * 65], s[(ks + 5) * 65]); o0.w = pk2(s[(ks + 6) * 65], s[(ks + 7) * 65]);
            o1.x = pk2(s[(ks + 8) * 65], s[(ks + 9) * 65]); o1.y = pk2(s[(ks + 10) * 65], s[(ks + 11) * 65]);
            o1.z = pk2(s[(ks + 12) * 65], s[(ks + 13) * 65]); o1.w = pk2(s[(ks + 14) * 65], s[(ks + 15) * 65]);
            u32x4* dst = (u32x4*)(WT + (size_t)np * K + k0 + ks);
            dst[0] = o0; dst[1] = o1;
        }
    }
    __syncthreads();
}

__device__ __forceinline__ void cvt_item(const float* src, bf16_t* dst, int item) {
    const size_t base = (size_t)item * 8192 + threadIdx.x * 8;
#pragma unroll
    for (int i = 0; i < 4; ++i) {
        const size_t o = base + (size_t)i * 2048;
        const f32x4 a = *(const f32x4*)(src + o), b = *(const f32x4*)(src + o + 4);
        u32x4 w; w.x = pk2(a.x, a.y); w.y = pk2(a.z, a.w); w.z = pk2(b.x, b.y); w.w = pk2(b.z, b.w);
        *(u32x4*)(dst + o) = w;
    }
}
__device__ __forceinline__ void zero_item(bf16_t* dst, int item) {
    const size_t base = (size_t)item * 8192 + threadIdx.x * 8;
#pragma unroll
    for (int i = 0; i < 4; ++i) *(u32x4*)(dst + base + (size_t)i * 2048) = (u32x4){0u, 0u, 0u, 0u};
}

struct cpx { float re, im; };
__device__ __forceinline__ cpx cmul(cpx a, cpx b) { return {a.re * b.re - a.im * b.im, a.re * b.im + a.im * b.re}; }
__device__ __forceinline__ cpx cexp_pow(float are, float aim, float dt, int m) {
    const float mag = __expf(are * dt * (float)m);
    const double rev = (double)aim * (double)dt * (double)m * 0.15915494309189535;
    const float fr = (float)(rev - rint(rev));
    return {mag * __builtin_amdgcn_cosf(fr), mag * __builtin_amdgcn_sinf(fr)};
}
__device__ __forceinline__ cpx s5_coef(float are, float aim, float dt) {
    cpx ab = cexp_pow(are, aim, dt, 1);
    const float nr = ab.re - 1.0f, ni = ab.im, den = are * are + aim * aim;
    return {(nr * are + ni * aim) / den, (ni * are - nr * aim) / den};
}

__device__ __forceinline__ void prep_s5_T_item(const Params& p, int item) {
    const int gid = item * 256 + threadIdx.x;
    const int g = gid >> 9, m = (gid >> 4) & 31, i = gid & 15;
    const float* a_re = p.in[7] + g * 64; const float* a_im = p.in[8] + g * 64;
    const float dt = __expf(p.in[9][g]);
    const float* b_re = p.in[10] + (size_t)g * 64 * 16; const float* b_im = p.in[11] + (size_t)g * 64 * 16;
    const float* c_re = p.in[12] + (size_t)g * 16 * 64 + i * 64; const float* c_im = p.in[13] + (size_t)g * 16 * 64 + i * 64;
    float acc[16];
#pragma unroll
    for (int j = 0; j < 16; ++j) acc[j] = 0.f;
    for (int q = 0; q < 64; ++q) {
        const float are = a_re[q], aim = a_im[q];
        cpx z = cmul(cmul({c_re[q], c_im[q]}, cexp_pow(are, aim, dt, m)), s5_coef(are, aim, dt));
        const f32x4* br = (const f32x4*)(b_re + q * 16); const f32x4* bi = (const f32x4*)(b_im + q * 16);
#pragma unroll
        for (int j4 = 0; j4 < 4; ++j4) {
            const f32x4 r = br[j4], im = bi[j4];
            acc[j4 * 4 + 0] += z.re * r.x - z.im * im.x; acc[j4 * 4 + 1] += z.re * r.y - z.im * im.y;
            acc[j4 * 4 + 2] += z.re * r.z - z.im * im.z; acc[j4 * 4 + 3] += z.re * r.w - z.im * im.w;
        }
    }
    u32x4 o0, o1;
    o0.x = pk2(acc[0], acc[1]); o0.y = pk2(acc[2], acc[3]); o0.z = pk2(acc[4], acc[5]); o0.w = pk2(acc[6], acc[7]);
    o1.x = pk2(acc[8], acc[9]); o1.y = pk2(acc[10], acc[11]); o1.z = pk2(acc[12], acc[13]); o1.w = pk2(acc[14], acc[15]);
    bf16_t* TW = (bf16_t*)(p.ws + WS_TW) + (size_t)g * 640 * 512;
    const u32x4 z4 = (u32x4){0u, 0u, 0u, 0u};
    for (int lp = 0; lp + m < 32; ++lp) {
        u32x4* d = (u32x4*)(TW + (size_t)((lp + m) * 16 + i) * 512 + lp * 16);
        d[0] = o0; d[1] = o1;
        if (m > 0) { u32x4* dz = (u32x4*)(TW + (size_t)(lp * 16 + i) * 512 + (lp + m) * 16); dz[0] = z4; dz[1] = z4; }
    }
}
__device__ __forceinline__ void prep_s5_W_item(const Params& p, int item) {
    const int gid = item * 256 + threadIdx.x;
    const int g = gid >> 11, q = (gid >> 5) & 63, lp = gid & 31;
    const float are = p.in[7][g * 64 + q], aim = p.in[8][g * 64 + q];
    const float dt = __expf(p.in[9][g]);
    const cpx z = cmul(cexp_pow(are, aim, dt, 31 - lp), s5_coef(are, aim, dt));
    const float* br = p.in[10] + ((size_t)g * 64 + q) * 16; const float* bi = p.in[11] + ((size_t)g * 64 + q) * 16;
    float wr[16], wi[16];
#pragma unroll
    for (int j = 0; j < 16; ++j) { wr[j] = z.re * br[j] - z.im * bi[j]; wi[j] = z.re * bi[j] + z.im * br[j]; }
    bf16_t* TW = (bf16_t*)(p.ws + WS_TW) + (size_t)g * 640 * 512;
    u32x4* d0 = (u32x4*)(TW + (size_t)(512 + q) * 512 + lp * 16);
    u32x4* d1 = (u32x4*)(TW + (size_t)(576 + q) * 512 + lp * 16);
    d0[0] = (u32x4){pk2(wr[0], wr[1]), pk2(wr[2], wr[3]), pk2(wr[4], wr[5]), pk2(wr[6], wr[7])};
    d0[1] = (u32x4){pk2(wr[8], wr[9]), pk2(wr[10], wr[11]), pk2(wr[12], wr[13]), pk2(wr[14], wr[15])};
    d1[0] = (u32x4){pk2(wi[0], wi[1]), pk2(wi[2], wi[3]), pk2(wi[4], wi[5]), pk2(wi[6], wi[7])};
    d1[1] = (u32x4){pk2(wi[8], wi[9]), pk2(wi[10], wi[11]), pk2(wi[12], wi[13]), pk2(wi[14], wi[15])};
}
__device__ __forceinline__ void prep_s5_V_item(const Params& p, int item) {
    const int gid = item * 256 + threadIdx.x;
    const int g = gid >> 14, l = (gid >> 9) & 31, i = (gid >> 5) & 15, q0 = (gid & 31) * 2;
    const float dt = __expf(p.in[9][g]);
    float vr[2], vi[2];
#pragma unroll
    for (int e = 0; e < 2; ++e) {
        const int q = q0 + e;
        const cpx z = cmul({p.in[12][((size_t)g * 16 + i) * 64 + q], p.in[13][((size_t)g * 16 + i) * 64 + q]}, cexp_pow(p.in[7][g * 64 + q], p.in[8][g * 64 + q], dt, l + 1));
        vr[e] = z.re; vi[e] = -z.im;
    }
    bf16_t* VG = (bf16_t*)(p.ws + WS_VG) + ((size_t)g * 512 + l * 16 + i) * 128;
    *(unsigned*)(VG + q0) = pk2(vr[0], vr[1]);
    *(unsigned*)(VG + 64 + q0) = pk2(vi[0], vi[1]);
}
__device__ __forceinline__ void prep_al_item(const Params& p, int item) {
    const int gid = item * 256 + threadIdx.x;
    const int g = gid >> 6;
    const float dt = __expf(p.in[9][g]);
    const cpx z = cexp_pow(p.in[7][gid], p.in[8][gid], dt, S5L);
    f32x2* AL = (f32x2*)(p.ws + WS_MISC + 4096);
    AL[gid] = (f32x2){z.re, z.im};
}
__device__ __forceinline__ void prep_rope_item(const Params& p, int item) {
    const int gid = item * 256 + threadIdx.x;
    const int pos = gid >> 5, j = gid & 31;
    const float freq = exp2f(-(float)j * (13.287712379549449f / 32.0f));
    const float ang = (float)pos * freq;
    const double rev = (double)ang * 0.15915494309189535;
    const float fr = (float)(rev - rint(rev));
    f32x2* R = (f32x2*)(p.ws + WS_ROPE);
    R[gid] = (f32x2){__builtin_amdgcn_cosf(fr), __builtin_amdgcn_sinf(fr)};
}
__device__ __forceinline__ void prep_cmpbias_item(const Params& p, int item, float* lds) {
    const int kv = item >> 3, cg0 = (item & 7) * 32;
    const float* pe = p.in[17 + kv]; const float* w1 = p.in[kv == 0 ? 19 : 21];
    const int tid = threadIdx.x, col = cg0 + (tid & 31), kg = tid >> 5;
    float s = 0.f;
#pragma unroll 8
    for (int k = kg * 256; k < kg * 256 + 256; ++k) s += pe[k] * w1[(size_t)k * 256 + col];
    lds[tid] = s;
    __syncthreads();
    if (tid < 32) {
        float t = 0.f;
#pragma unroll
        for (int q = 0; q < 8; ++q) t += lds[q * 32 + tid];
        ((float*)(p.ws + WS_MISC))[kv * 256 + cg0 + tid] = t;
    }
    __syncthreads();
}

__device__ __forceinline__ void cvt_fp8_item(const float* src, unsigned char* dst, float* inv_scale, int item, const bool slice_major) {
    const int lane = threadIdx.x & 63, row0 = item * 16 + (threadIdx.x >> 6) * 4;
    f32x4 v[4][4];
#pragma unroll
    for (int r = 0; r < 4; ++r) {
        const f32x4* sp = (const f32x4*)(src + (size_t)(row0 + r) * D + lane * 16);
#pragma unroll
        for (int q = 0; q < 4; ++q) v[r][q] = sp[q];
    }
#pragma unroll
    for (int r = 0; r < 4; ++r) {
        float m = 0.f;
#pragma unroll
        for (int q = 0; q < 4; ++q) m = fmaxf(m, fmaxf(fmaxf(fabsf(v[r][q].x), fabsf(v[r][q].y)), fmaxf(fabsf(v[r][q].z), fabsf(v[r][q].w))));
#pragma unroll
        for (int o = 1; o < 64; o <<= 1) m = fmaxf(m, __shfl_xor(m, o));
        const float sc = m > 0.f ? 224.0f / m : 1.0f;
        unsigned w[4];
#pragma unroll
        for (int q = 0; q < 4; ++q) { int t = 0; t = __builtin_amdgcn_cvt_pk_fp8_f32(v[r][q].x * sc, v[r][q].y * sc, t, false); t = __builtin_amdgcn_cvt_pk_fp8_f32(v[r][q].z * sc, v[r][q].w * sc, t, true); w[q] = (unsigned)t; }
        const int row = row0 + r;
        const u32x4 wv = (u32x4){w[0], w[1], w[2], w[3]};
        if (slice_major) *(u32x4*)(dst + (size_t)(lane >> 3) * (PE * 128) + (size_t)row * 128 + (lane & 7) * 16) = wv;
        else *(u32x4*)(dst + (size_t)row * D + lane * 16) = wv;
        if (lane == 0) inv_scale[row] = m > 0.f ? m / 224.0f : 1.0f;
    }
}
constexpr int P0_MOD = 384;
constexpr int P0_T_WIN = 16 * 16, P0_T_WGLU = 16 * 32, P0_T_WPROJ = 16 * 41, P0_T_WK1 = 32 * 4, P0_T_WK2 = 4 * 1, P0_T_WO = 16 * 16, P0_T_WQ = 16 * 32;
constexpr int P0_SUBK = (2 * 8 * 2 * 128 * 128) / 8192;
constexpr int P0_TAB = PE / 16;
constexpr int P0_S5T = 128, P0_S5W = 512, P0_S5V = 4096, P0_AL = 16, P0_ROPE = 2048, P0_CB = 16, P0_ZERO = 10 + 2;

__device__ __forceinline__ void phase_prep(const Params& p, float* lds, const int part) {
    const int n0 = P0_MOD;
    const int n1 = n0 + P0_T_WIN, n2 = n1 + P0_T_WGLU, n3 = n2 + P0_T_WPROJ, n4 = n3 + P0_T_WK1, n5 = n4 + P0_T_WK1, n6 = n5 + P0_T_WK2, n7 = n6 + P0_T_WK2,
              n8 = n7 + P0_T_WO, n9 = n8 + P0_T_WQ, n10 = n9 + P0_T_WQ, n11 = n10 + P0_SUBK, n12 = n11 + P0_TAB, n13 = n12 + P0_TAB,
              n14 = n13 + P0_S5T, n15 = n14 + P0_S5W, n16 = n15 + P0_S5V, n17 = n16 + P0_AL, n18 = n17 + P0_ROPE, n19 = n18 + P0_CB, n20 = n19 + 10, n21 = n20 + 2, n22 = n21 + 2;
    unsigned char* ws = p.ws;
#ifndef PREP_DUP_LO
#define PREP_DUP_LO 0
#define PREP_DUP_HI 0
#endif
    const int dupn = (PREP_DUP_HI) - (PREP_DUP_LO);
    const int nB = (n8 - n2) + (n10 - n9) + (n22 - n17);
    const int first = part == 0 ? (int)blockIdx.x : (int)blockIdx.x - 32, stride = part == 0 ? (int)gridDim.x : (int)gridDim.x - 32;
    if (first < 0 || stride <= 0) return;
    const int total = part == 0 ? (n22 - nB) + dupn : nB;
    for (int it0 = first; it0 < total; it0 += stride) {
        int it;
        if (part == 0) {
            it = it0;
            if (it >= n2) it += (n8 - n2);
            if (it >= n9) it += (n10 - n9);
            if (it0 >= (n22 - nB)) it = (PREP_DUP_LO) + (it0 - (n22 - nB));
        } else {
            it = n2 + it0;
            if (it >= n8) it += (n9 - n8);
            if (it >= n10) it += (n17 - n10);
        }
        if (it < n0) prep_mod_item(p, it, lds);
        else if (it < n1) prep_transpose_item<0>(p.in[6], 1024, 1024, (bf16_t*)(ws + WS_WIN_T), it - n0, lds);
        else if (it < n2) prep_transpose_item<1>(p.in[15], 1024, 2048, (bf16_t*)(ws + WS_WGLU_T), it - n1, lds);
        else if (it < n3) prep_transpose_item<0>(p.in[16], 1024, NPROJ, (bf16_t*)(ws + WS_WPROJ_T), it - n2, lds);
        else if (it < n4) prep_transpose_item<0>(p.in[19], 2048, 256, (bf16_t*)(ws + WS_WK1_T), it - n3, lds);
        else if (it < n5) prep_transpose_item<0>(p.in[21], 2048, 256, (bf16_t*)(ws + WS_WV1_T), it - n4, lds);
        else if (it < n6) prep_transpose_item<0>(p.in[20], 256, 64, (bf16_t*)(ws + WS_WK2_T), it - n5, lds);
        else if (it < n7) prep_transpose_item<0>(p.in[22], 256, 64, (bf16_t*)(ws + WS_WV2_T), it - n6, lds);
        else if (it < n8) prep_transpose_item<0>(p.in[23], 1024, 1024, (bf16_t*)(ws + WS_WO_T), it - n7, lds);
        else if (it < n9) prep_transpose_item<0>(p.in[24], 1024, 2048, (bf16_t*)(ws + WS_WQ_T), it - n8, lds);
        else if (it < n10) prep_transpose_item<0>(p.in[24] + (size_t)1024 * 2048, 1024, 2048, (bf16_t*)(ws + WS_WQ_T) + (size_t)2048 * 1024, it - n9, lds);
        else if (it < n11) cvt_item(p.in[25], (bf16_t*)(ws + WS_SUBK), it - n10);
        else if (it < n12) cvt_fp8_item(p.in[26], ws + WS_PU, (float*)(ws + WS_PU + 24 * MiB), it - n11, false);
        else if (it < n13) cvt_fp8_item(p.in[27], ws + WS_PV, (float*)(ws + WS_PV + 24 * MiB), it - n12, false);
        else if (it < n14) prep_s5_T_item(p, it - n13);
        else if (it < n15) prep_s5_W_item(p, it - n14);
        else if (it < n16) prep_s5_V_item(p, it - n15);
        else if (it < n17) prep_al_item(p, it - n16);
        else if (it < n18) prep_rope_item(p, it - n17);
        else if (it < n19) prep_cmpbias_item(p, it - n18, lds);
        else if (it < n20) zero_item((bf16_t*)(ws + WS_WPROJ_T) + (size_t)NPROJ * 1024, it - n19);
        else if (it < n21) zero_item((bf16_t*)(ws + WS_WK2_T) + (size_t)64 * 256, it - n20);
        else zero_item((bf16_t*)(ws + WS_WV2_T) + (size_t)64 * 256, it - n21);
    }
}

__device__ __forceinline__ void phase_norm(const Params& p, const float* X, const float* gw, const float* shift, const float* scale  , bf16_t* HM) {
    const int lane = threadIdx.x & 63, wave = threadIdx.x >> 6;
    for (int row = blockIdx.x * 4 + wave; row < T; row += gridDim.x * 4) {
        const int b = row / SEQ;
        const f32x4* xr = (const f32x4*)(X + (size_t)row * D) + lane;
        f32x4 v[4]; float s = 0.f;
#pragma unroll
        for (int j = 0; j < 4; ++j) { v[j] = xr[64 * j]; s += (v[j].x * v[j].x + v[j].y * v[j].y) + (v[j].z * v[j].z + v[j].w * v[j].w); }
        const float rs = rsqrtf(wave_sum(s) * (1.0f / D) + RMS_EPS);
        u32x2* o = (u32x2*)(HM + (size_t)row * D) + lane;
#pragma unroll
        for (int j = 0; j < 4; ++j) {
            const int c = lane * 4 + 256 * j;
            const f32x4 g = *(const f32x4*)(gw + c), sh = *(const f32x4*)(shift + (size_t)b * 6144 + c), sc = *(const f32x4*)(scale + (size_t)b * 6144 + c);
            const float y0 = v[j].x * rs * g.x * (1.f + sc.x) + sh.x, y1 = v[j].y * rs * g.y * (1.f + sc.y) + sh.y;
            const float y2 = v[j].z * rs * g.z * (1.f + sc.z) + sh.z, y3 = v[j].w * rs * g.w * (1.f + sc.w) + sh.w;
            o[64 * j] = (u32x2){pk2(y0, y1), pk2(y2, y3)};
        }
    }
}
__device__ __forceinline__ void phase_final_norm(const Params& p, const float* X, float* OUT, bool dry) {
    const int lane = threadIdx.x & 63, wave = threadIdx.x >> 6;
    const float* gw = p.in[28];
    for (int row = blockIdx.x * 4 + wave; row < T; row += gridDim.x * 4) {
        const f32x4* xr = (const f32x4*)(X + (size_t)row * D) + lane;
        f32x4 v[4]; float s = 0.f;
#pragma unroll
        for (int j = 0; j < 4; ++j) { v[j] = xr[64 * j]; s += (v[j].x * v[j].x + v[j].y * v[j].y) + (v[j].z * v[j].z + v[j].w * v[j].w); }
        const float rs = rsqrtf(wave_sum(s) * (1.0f / D) + RMS_EPS);
        f32x4* o = (f32x4*)(OUT + (size_t)row * D) + lane;
#pragma unroll
        for (int j = 0; j < 4; ++j) {
            const f32x4 g = *(const f32x4*)(gw + lane * 4 + 256 * j);
            if (!dry) o[64 * j] = (f32x4){v[j].x * rs * g.x, v[j].y * rs * g.y, v[j].z * rs * g.z, v[j].w * rs * g.w};
        }
    }
}

__device__ __forceinline__ int vblock() { const int G = gridDim.x, bx = blockIdx.x; return (G % 8 == 0) ? (bx % 8) * (G / 8) + bx / 8 : bx; }
struct ALoadPlain {
    const bf16_t* A; size_t lda;
    __device__ __forceinline__ const bf16_t* base(int kt) const { return A + kt * 64; }
    __device__ __forceinline__ unsigned off(int r, int lc) const { return (unsigned)r * (unsigned)lda + (unsigned)lc * 8u; }
};
struct ALoadGroup {
    const bf16_t* A;
    __device__ __forceinline__ const bf16_t* base(int kt) const { return A + (size_t)kt * 4 * T * 16; }
    __device__ __forceinline__ unsigned off(int r, int lc) const { return ((unsigned)(lc >> 1) * (unsigned)T + (unsigned)r) * 16u + (unsigned)(lc & 1) * 8u; }
};

template <class AL>
__device__ __forceinline__ void gemm_tile2(const AL al, const bf16_t* __restrict__ Bt, size_t ldb, int nk, f32x4 (&acc)[4][4], unsigned char* lds) {
    const int tid = threadIdx.x, lane = tid & 63, wid = tid >> 6, wr = wid >> 1, wc = wid & 1, fr = lane & 15, fq = lane >> 4;
    const int lr = tid >> 3, lc = tid & 7;
#pragma unroll
    for (int mi = 0; mi < 4; ++mi)
#pragma unroll
        for (int ni = 0; ni < 4; ++ni) acc[mi][ni] = (f32x4){0.f, 0.f, 0.f, 0.f};
    u32x4 ra0[4], rb0[4], ra1[4], rb1[4];
    const int soff = lr * 128 + ((lc ^ (lr & 7)) << 4);
    unsigned offA[4], offB[4];
#pragma unroll
    for (int i = 0; i < 4; ++i) { offA[i] = al.off(lr + 32 * i, lc); offB[i] = (unsigned)(lr + 32 * i) * (unsigned)ldb + (unsigned)lc * 8u; }
#define GT_LOAD(RA, RB, kt_) do { const bf16_t* ab_ = al.base(kt_); const bf16_t* bb_ = Bt + (kt_) * 64; _Pragma("unroll") for (int i = 0; i < 4; ++i) { RA[i] = *(const u32x4*)(ab_ + offA[i]); RB[i] = *(const u32x4*)(bb_ + offB[i]); } } while (0)
#define GT_STORE(RA, RB, buf_) do { unsigned char* nb_ = lds + (buf_) * 32768; _Pragma("unroll") for (int i = 0; i < 4; ++i) { *(u32x4*)(nb_ + soff + i * 4096) = RA[i]; *(u32x4*)(nb_ + 16384 + soff + i * 4096) = RB[i]; } } while (0)
    const int aoff = (wr * 64 + fr) * 128, boff = 16384 + (wc * 64 + fr) * 128, sw = fr & 7;
#define GT_MATH(buf_) do { const unsigned char* bp_ = lds + (buf_) * 32768; _Pragma("unroll") for (int ks = 0; ks < 2; ++ks) { bf16x8 af[4], bfr[4]; const int co = ((ks * 4 + fq) ^ sw) << 4; \
        _Pragma("unroll") for (int mi = 0; mi < 4; ++mi) af[mi] = *(const bf16x8*)(bp_ + aoff + mi * 2048 + co); \
        _Pragma("unroll") for (int ni = 0; ni < 4; ++ni) bfr[ni] = *(const bf16x8*)(bp_ + boff + ni * 2048 + co); \
        _Pragma("unroll") for (int mi = 0; mi < 4; ++mi) _Pragma("unroll") for (int ni = 0; ni < 4; ++ni) acc[mi][ni] = __builtin_amdgcn_mfma_f32_16x16x32_bf16(bfr[ni], af[mi], acc[mi][ni], 0, 0, 0); } } while (0)
    GT_LOAD(ra0, rb0, 0);
    if (nk > 1) GT_LOAD(ra1, rb1, 1);
    GT_STORE(ra0, rb0, 0);
    __syncthreads();
    for (int kt = 0; kt < nk; kt += 2) {
        if (kt + 2 < nk) GT_LOAD(ra0, rb0, kt + 2);
        __builtin_amdgcn_sched_barrier(0);
        GT_MATH(0);
        __builtin_amdgcn_sched_barrier(0);
        if (kt + 1 < nk) GT_STORE(ra1, rb1, 1);
        __syncthreads();
        if (kt + 1 >= nk) break;
        if (kt + 3 < nk) GT_LOAD(ra1, rb1, kt + 3);
        __builtin_amdgcn_sched_barrier(0);
        GT_MATH(1);
        __builtin_amdgcn_sched_barrier(0);
        if (kt + 2 < nk) GT_STORE(ra0, rb0, 0);
        __syncthreads();
    }
#undef GT_LOAD
#undef GT_STORE
#undef GT_MATH
}

template <class AL>
__device__ __forceinline__ void gemm_tile1(const AL al, const bf16_t* __restrict__ Bt, size_t ldb, int nk, f32x4 (&acc)[4][4], unsigned char* lds) {
    const int tid = threadIdx.x, lane = tid & 63, wid = tid >> 6, wr = wid >> 1, wc = wid & 1, fr = lane & 15, fq = lane >> 4;
    const int lr = tid >> 3, lc = tid & 7;
#pragma unroll
    for (int mi = 0; mi < 4; ++mi)
#pragma unroll
        for (int ni = 0; ni < 4; ++ni) acc[mi][ni] = (f32x4){0.f, 0.f, 0.f, 0.f};
    u32x4 ra[4], rb[4];
    const int soff = lr * 128 + ((lc ^ (lr & 7)) << 4);
#pragma unroll
    for (int i = 0; i < 4; ++i) { ra[i] = *(const u32x4*)(al.base(0) + al.off(lr + 32 * i, lc)); rb[i] = *(const u32x4*)(Bt + (size_t)(lr + 32 * i) * ldb + lc * 8); }
#pragma unroll
    for (int i = 0; i < 4; ++i) { *(u32x4*)(lds + soff + i * 4096) = ra[i]; *(u32x4*)(lds + 16384 + soff + i * 4096) = rb[i]; }
    __syncthreads();
    const int aoff = (wr * 64 + fr) * 128, boff = 16384 + (wc * 64 + fr) * 128, sw = fr & 7;
    for (int kt = 0; kt < nk; ++kt) {
        const bool more = (kt + 1 < nk);
        if (more) {
#pragma unroll
            for (int i = 0; i < 4; ++i) { ra[i] = *(const u32x4*)(al.base(kt + 1) + al.off(lr + 32 * i, lc)); rb[i] = *(const u32x4*)(Bt + (size_t)(lr + 32 * i) * ldb + (kt + 1) * 64 + lc * 8); }
        }
        const unsigned char* buf = lds + (kt & 1) * 32768;
#pragma unroll
        for (int ks = 0; ks < 2; ++ks) {
            bf16x8 af[4], bfr[4];
            const int co = ((ks * 4 + fq) ^ sw) << 4;
#pragma unroll
            for (int mi = 0; mi < 4; ++mi) af[mi] = *(const bf16x8*)(buf + aoff + mi * 2048 + co);
#pragma unroll
            for (int ni = 0; ni < 4; ++ni) bfr[ni] = *(const bf16x8*)(buf + boff + ni * 2048 + co);
#pragma unroll
            for (int mi = 0; mi < 4; ++mi)
#pragma unroll
                for (int ni = 0; ni < 4; ++ni) acc[mi][ni] = __builtin_amdgcn_mfma_f32_16x16x32_bf16(bfr[ni], af[mi], acc[mi][ni], 0, 0, 0);
        }
        if (more) {
            unsigned char* nb = lds + ((kt + 1) & 1) * 32768;
#pragma unroll
            for (int i = 0; i < 4; ++i) { *(u32x4*)(nb + soff + i * 4096) = ra[i]; *(u32x4*)(nb + 16384 + soff + i * 4096) = rb[i]; }
        }
        __syncthreads();
    }
}

template <class AL>
__device__ __forceinline__ void gemm_tile3(const AL al, const bf16_t* __restrict__ Bt, size_t ldb, int nk, f32x4 (&acc)[4][4], unsigned char* lds) {
    const int tid = threadIdx.x, lane = tid & 63, wid = tid >> 6, wr = wid >> 1, wc = wid & 1, fr = lane & 15, fq = lane >> 4;
#pragma unroll
    for (int mi = 0; mi < 4; ++mi)
#pragma unroll
        for (int ni = 0; ni < 4; ++ni) acc[mi][ni] = (f32x4){0.f, 0.f, 0.f, 0.f};
    const int srow = wid * 32 + (lane >> 3), schunk = (lane & 7) ^ ((lane >> 3) & 7);
    unsigned offA[4], offB[4];
#pragma unroll
    for (int i = 0; i < 4; ++i) { offA[i] = al.off(srow + 8 * i, schunk); offB[i] = (unsigned)(srow + 8 * i) * (unsigned)ldb + (unsigned)schunk * 8u; }
#define G3_STAGE(buf_, kt_) do { const bf16_t* ab_ = al.base(kt_); const bf16_t* bb_ = Bt + (kt_) * 64; unsigned char* lb_ = lds + (buf_) * 32768 + wid * 4096; \
        _Pragma("unroll") for (int i = 0; i < 4; ++i) { \
            __builtin_amdgcn_global_load_lds((const unsigned*)(ab_ + offA[i]), (unsigned*)(lb_ + i * 1024), 16, 0, 0); \
            __builtin_amdgcn_global_load_lds((const unsigned*)(bb_ + offB[i]), (unsigned*)(lb_ + 16384 + i * 1024), 16, 0, 0); } } while (0)
    const int aoff = (wr * 64 + fr) * 128, boff = 16384 + (wc * 64 + fr) * 128, sw = fr & 7;
    G3_STAGE(0, 0);
    __syncthreads();
    for (int kt = 0; kt < nk; ++kt) {
        if (kt + 1 < nk) G3_STAGE((kt + 1) & 1, kt + 1);
        const unsigned char* buf = lds + (kt & 1) * 32768;
#pragma unroll
        for (int ks = 0; ks < 2; ++ks) {
            bf16x8 af[4], bfr[4];
            const int co = ((ks * 4 + fq) ^ sw) << 4;
#pragma unroll
            for (int mi = 0; mi < 4; ++mi) af[mi] = *(const bf16x8*)(buf + aoff + mi * 2048 + co);
#pragma unroll
            for (int ni = 0; ni < 4; ++ni) bfr[ni] = *(const bf16x8*)(buf + boff + ni * 2048 + co);
#pragma unroll
            for (int mi = 0; mi < 4; ++mi)
#pragma unroll
                for (int ni = 0; ni < 4; ++ni) acc[mi][ni] = __builtin_amdgcn_mfma_f32_16x16x32_bf16(bfr[ni], af[mi], acc[mi][ni], 0, 0, 0);
        }
        __syncthreads();
    }
#undef G3_STAGE
}

__device__ __forceinline__ void mma_ktile(const unsigned char* buf, f32x4 (&acc)[4][4]) {
    const int tid = threadIdx.x, lane = tid & 63, wid = tid >> 6, wr = wid >> 1, wc = wid & 1, fr = lane & 15, fq = lane >> 4;
    const int aoff = (wr * 64 + fr) * 128, boff = 16384 + (wc * 64 + fr) * 128, sw = fr & 7;
#pragma unroll
    for (int ks = 0; ks < 2; ++ks) {
        bf16x8 af[4], bfr[4];
        const int co = ((ks * 4 + fq) ^ sw) << 4;
#pragma unroll
        for (int mi = 0; mi < 4; ++mi) af[mi] = *(const bf16x8*)(buf + aoff + mi * 2048 + co);
#pragma unroll
        for (int ni = 0; ni < 4; ++ni) bfr[ni] = *(const bf16x8*)(buf + boff + ni * 2048 + co);
#pragma unroll
        for (int mi = 0; mi < 4; ++mi)
#pragma unroll
            for (int ni = 0; ni < 4; ++ni) acc[mi][ni] = __builtin_amdgcn_mfma_f32_16x16x32_bf16(bfr[ni], af[mi], acc[mi][ni], 0, 0, 0);
    }
}
__device__ __forceinline__ void phase_s5_win(const Params& p, unsigned char* lds) {
    const bf16_t* HM = (const bf16_t*)(p.ws + WS_HM); const bf16_t* WT = (const bf16_t*)(p.ws + WS_WIN_T);
    bf16_t* UG = (bf16_t*)(p.ws + WS_UG);
    const int lane = threadIdx.x & 63, wid = threadIdx.x >> 6, wr = wid >> 1, wc = wid & 1, fr = lane & 15, fq = lane >> 4;
    for (int id = vblock(); id < 256 * 8; id += gridDim.x) {
        const int mt = id >> 3, nt = id & 7;
        f32x4 acc[4][4];
        gemm_tile3(ALoadPlain{HM + (size_t)mt * 128 * D, (size_t)D}, WT + (size_t)nt * 128 * D, D, 16, acc, lds);
#pragma unroll
        for (int mi = 0; mi < 4; ++mi)
#pragma unroll
            for (int ni = 0; ni < 4; ++ni) {
                const int t = mt * 128 + wr * 64 + mi * 16 + fr, g = nt * 8 + wc * 4 + ni;
                const f32x4 v = acc[mi][ni];
                *(u32x2*)(UG + ((size_t)g * T + t) * 16 + fq * 4) = (u32x2){pk2(v.x, v.y), pk2(v.z, v.w)};
            }
    }
}
__device__ __forceinline__ void phase_s5_a(const Params& p, unsigned char* lds) {
    const bf16_t* UG = (const bf16_t*)(p.ws + WS_UG); const bf16_t* TW = (const bf16_t*)(p.ws + WS_TW);
    bf16_t* YI = (bf16_t*)(p.ws + WS_YI); float* WST = (float*)(p.ws + WS_WST);
    const int lane = threadIdx.x & 63, wid = threadIdx.x >> 6, wr = wid >> 1, wc = wid & 1, fr = lane & 15, fq = lane >> 4;
    for (int id = vblock(); id < 64 * 40; id += gridDim.x) {
        const int g = id / 40, rem = id % 40, mt = rem / 5, nt = rem % 5;
        const int nk = (nt < 4) ? 2 * (nt + 1) : 8;
        f32x4 acc[4][4];
        gemm_tile3(ALoadPlain{UG + (size_t)g * T * 16 + (size_t)mt * 128 * 512, (size_t)512}, TW + ((size_t)g * 640 + nt * 128) * 512, 512, nk, acc, lds);
#pragma unroll
        for (int mi = 0; mi < 4; ++mi)
#pragma unroll
            for (int ni = 0; ni < 4; ++ni) {
                const int R = mt * 128 + wr * 64 + mi * 16 + fr, c = wc * 64 + ni * 16 + fq * 4;
                const f32x4 v = acc[mi][ni];
                if (nt < 4) *(u32x2*)(YI + ((size_t)g * 1024 + R) * 512 + nt * 128 + c) = (u32x2){pk2(v.x, v.y), pk2(v.z, v.w)};
                else *(f32x4*)(WST + ((size_t)g * 1024 + R) * 128 + c) = v;
            }
    }
}
__device__ __forceinline__ void phase_s5_scan(const Params& p) {
    const int lane = threadIdx.x & 63, wave = threadIdx.x >> 6;
    const float* WST = (const float*)(p.ws + WS_WST); bf16_t* SST = (bf16_t*)(p.ws + WS_SST);
    const f32x2* AL = (const f32x2*)(p.ws + WS_MISC + 4096);
    for (int it = blockIdx.x * 4 + wave; it < 128; it += gridDim.x * 4) {
        const int b = it >> 6, g = it & 63;
        const f32x2 al = AL[g * 64 + lane];
        float sr = 0.f, si = 0.f;
        const float* wbase = WST + ((size_t)g * 1024 + b * 512) * 128 + lane;
        bf16_t* sbase = SST + ((size_t)g * 1024 + b * 512) * 128 + lane;
        for (int n0 = 0; n0 < 512; n0 += 16) {
            float wre[16], wim[16];
#pragma unroll
            for (int j = 0; j < 16; ++j) { wre[j] = wbase[(size_t)(n0 + j) * 128]; wim[j] = wbase[(size_t)(n0 + j) * 128 + 64]; }
#pragma unroll
            for (int j = 0; j < 16; ++j) {
                sbase[(size_t)(n0 + j) * 128] = (bf16_t)f2bf(sr); sbase[(size_t)(n0 + j) * 128 + 64] = (bf16_t)f2bf(si);
                const float nr = al.x * sr - al.y * si + wre[j], ni = al.x * si + al.y * sr + wim[j];
                sr = nr; si = ni;
            }
        }
    }
}
__device__ __forceinline__ void phase_s5_b(const Params& p, unsigned char* lds) {
    const bf16_t* SST = (const bf16_t*)(p.ws + WS_SST); const bf16_t* VG = (const bf16_t*)(p.ws + WS_VG);
    const bf16_t* YI = (const bf16_t*)(p.ws + WS_YI); const bf16_t* UG = (const bf16_t*)(p.ws + WS_UG);
    bf16_t* YG = (bf16_t*)(p.ws + WS_YG);
    const float* dsk = p.in[14];
    const int lane = threadIdx.x & 63, wid = threadIdx.x >> 6, wr = wid >> 1, wc = wid & 1, fr = lane & 15, fq = lane >> 4;
    for (int id = vblock(); id < 64 * 32; id += gridDim.x) {
        const int g = id >> 5, mt = (id >> 2) & 7, nt = id & 3;
        f32x4 acc[4][4];
        gemm_tile3(ALoadPlain{SST + ((size_t)g * 1024 + mt * 128) * 128, (size_t)128}, VG + ((size_t)g * 512 + nt * 128) * 128, 128, 2, acc, lds);
        const f32x4 dv = *(const f32x4*)(dsk + g * 16 + fq * 4);
#pragma unroll
        for (int mi = 0; mi < 4; ++mi)
#pragma unroll
            for (int ni = 0; ni < 4; ++ni) {
                const int R = mt * 128 + wr * 64 + mi * 16 + fr, c = nt * 128 + wc * 64 + ni * 16 + fq * 4;
                const size_t idx = ((size_t)g * 1024 + R) * 512 + c;
                const u32x2 yi = *(const u32x2*)(YI + idx), uu = *(const u32x2*)(UG + idx);
                const f32x4 v = acc[mi][ni];
                const float y0 = gelu_tanh(v.x + bflo(yi.x) + dv.x * bflo(uu.x)), y1 = gelu_tanh(v.y + bfhi(yi.x) + dv.y * bfhi(uu.x));
                const float y2 = gelu_tanh(v.z + bflo(yi.y) + dv.z * bflo(uu.y)), y3 = gelu_tanh(v.w + bfhi(yi.y) + dv.w * bfhi(uu.y));
                *(u32x2*)(YG + idx) = (u32x2){pk2(y0, y1), pk2(y2, y3)};
            }
    }
}
__device__ __forceinline__ void phase_s5_glu(const Params& p, unsigned char* lds) {
    const bf16_t* YG = (const bf16_t*)(p.ws + WS_YG); const bf16_t* WT = (const bf16_t*)(p.ws + WS_WGLU_T);
    const float* MOD = (const float*)(p.ws + WS_MOD);
    const float* X = p.in[0]; float* XO = p.out;
    const int lane = threadIdx.x & 63, wid = threadIdx.x >> 6, wr = wid >> 1, wc = wid & 1, fr = lane & 15, fq = lane >> 4;
    for (int id = vblock(); id < 256 * 16; id += gridDim.x) {
        const int mt = id >> 4, nt = id & 15;
        f32x4 acc[4][4];
        gemm_tile3(ALoadGroup{YG + (size_t)mt * 128 * 16}, WT + (size_t)nt * 128 * D, D, 16, acc, lds);
        const int b = (mt * 128) / SEQ;
#pragma unroll
        for (int mi = 0; mi < 4; ++mi)
#pragma unroll
            for (int h = 0; h < 2; ++h) {
                const int t = mt * 128 + wr * 64 + mi * 16 + fr, j = nt * 64 + wc * 32 + h * 16 + fq * 4;
                const f32x4 a = acc[mi][2 * h], gg = acc[mi][2 * h + 1];
                const f32x4 g1 = *(const f32x4*)(MOD + (size_t)(0 * 2 + b) * 6144 + 2048 + j);
                const f32x4 xi = *(const f32x4*)(X + (size_t)t * D + j);
                f32x4 o;
                o.x = xi.x + g1.x * (a.x * sigmoidf_(gg.x)); o.y = xi.y + g1.y * (a.y * sigmoidf_(gg.y));
                o.z = xi.z + g1.z * (a.z * sigmoidf_(gg.z)); o.w = xi.w + g1.w * (a.w * sigmoidf_(gg.w));
                *(f32x4*)(XO + (size_t)t * D + j) = o;
            }
    }
}
__device__ __forceinline__ void phase_peer_wq(const Params& p, int layer, unsigned char* lds) {
    const bf16_t* HM = (const bf16_t*)(p.ws + WS_HM); const bf16_t* WT = (const bf16_t*)(p.ws + WS_WQ_T) + (size_t)layer * 2048 * 1024;
    bf16_t* QK = (bf16_t*)(p.ws + WS_QK);
    const int lane = threadIdx.x & 63, wid = threadIdx.x >> 6, wr = wid >> 1, wc = wid & 1, fr = lane & 15, fq = lane >> 4;
    for (int id = vblock(); id < 256 * 16; id += gridDim.x) {
        const int mt = id >> 4, nt = id & 15;
        f32x4 acc[4][4];
        gemm_tile3(ALoadPlain{HM + (size_t)mt * 128 * D, (size_t)D}, WT + (size_t)nt * 128 * D, D, 16, acc, lds);
#pragma unroll
        for (int mi = 0; mi < 4; ++mi)
#pragma unroll
            for (int ni = 0; ni < 4; ++ni) {
                const int t = mt * 128 + wr * 64 + mi * 16 + fr, c = nt * 128 + wc * 64 + ni * 16 + fq * 4;
                const f32x4 v = acc[mi][ni];
                *(u32x2*)(QK + (size_t)t * 2048 + c) = (u32x2){pk2(v.x, v.y), pk2(v.z, v.w)};
            }
    }
}
__device__ __forceinline__ void ce_(unsigned& a, unsigned& b, const bool up) { const unsigned lo = a < b ? a : b, hi = a < b ? b : a; a = up ? lo : hi; b = up ? hi : lo; }
__device__ __forceinline__ void bitonic_sort16(unsigned* x, const bool asc) {
#pragma unroll
    for (int k = 2; k <= 16; k <<= 1)
#pragma unroll
        for (int j = k >> 1; j > 0; j >>= 1)
#pragma unroll
            for (int i = 0; i < 16; ++i) { const int l = i ^ j; if (l > i) ce_(x[i], x[l], ((i & k) == 0) == asc); }
}
__device__ __forceinline__ void bitonic_merge16(unsigned* x, const bool asc) {
#pragma unroll
    for (int j = 8; j > 0; j >>= 1)
#pragma unroll
        for (int i = 0; i < 16; ++i) { const int l = i ^ j; if (l > i) ce_(x[i], x[l], asc); }
}
__device__ __forceinline__ void phase_peer_topk(const Params& p, int layer, unsigned char* lds) {
    const bf16_t* QK = (const bf16_t*)(p.ws + WS_QK); const bf16_t* SK = (const bf16_t*)(p.ws + WS_SUBK) + (size_t)layer * 8 * 2 * 128 * 128;
    float* TOPS = (float*)(p.ws + WS_TOPS); int* TOPI = (int*)(p.ws + WS_TOPI);
    float* sc = (float*)lds;
    const int tid = threadIdx.x, lane = tid & 63, wid = tid >> 6, wr = wid >> 1, wc = wid & 1, fr = lane & 15, fq = lane >> 4;
    for (int id = vblock(); id < 256 * 16; id += gridDim.x) {
        const int mt = id >> 4, hc = id & 15;
        f32x4 acc[4][4];
        gemm_tile3(ALoadPlain{QK + (size_t)mt * 128 * 2048 + hc * 128, (size_t)2048}, SK + (size_t)hc * 128 * 128, 128, 2, acc, lds);
#pragma unroll
        for (int mi = 0; mi < 4; ++mi)
#pragma unroll
            for (int ni = 0; ni < 4; ++ni) {
                const int r = wr * 64 + mi * 16 + fr, c = wc * 64 + ni * 16 + fq * 4;
                float* d = sc + r * 129 + c;
                d[0] = acc[mi][ni].x; d[1] = acc[mi][ni].y; d[2] = acc[mi][ni].z; d[3] = acc[mi][ni].w;
            }
        __syncthreads();
        {
            const int row = tid >> 1, half = tid & 1;
            unsigned x[64];
            const float* rp = sc + row * 129 + half * 64;
#pragma unroll
            for (int j = 0; j < 64; ++j) {
                const unsigned bits = __builtin_bit_cast(unsigned, rp[j]);
                const unsigned u = bits ^ ((unsigned)((int)bits >> 31) | 0x80000000u);
                x[j] = (u & 0xFFFFFF80u) | (unsigned)(127 - (half * 64 + j));
            }
            bitonic_sort16(x, true); bitonic_sort16(x + 16, false); bitonic_sort16(x + 32, true); bitonic_sort16(x + 48, false);
#pragma unroll
            for (int i = 0; i < 16; ++i) { x[i] = x[i] > x[16 + i] ? x[i] : x[16 + i]; x[32 + i] = x[32 + i] > x[48 + i] ? x[32 + i] : x[48 + i]; }
            bitonic_merge16(x, true); bitonic_merge16(x + 32, false);
#pragma unroll
            for (int i = 0; i < 16; ++i) x[i] = x[i] > x[32 + i] ? x[i] : x[32 + i];
            bitonic_merge16(x, false);
            unsigned y[16];
#pragma unroll
            for (int i = 0; i < 16; ++i) { const unsigned o = (unsigned)__shfl_xor((int)x[15 - i], 1); y[i] = x[i] > o ? x[i] : o; }
            bitonic_merge16(y, false);
            const size_t ob = ((size_t)(mt * 128 + row) * 16 + hc) * 16;
            if (half == 0) {
                float v[16];
#pragma unroll
                for (int i = 0; i < 16; ++i) { const unsigned u = y[i] & 0xFFFFFF80u; const unsigned bits = (u & 0x80000000u) ? (u ^ 0x80000000u) : ~u; v[i] = __builtin_bit_cast(float, bits); }
#pragma unroll
                for (int q = 0; q < 4; ++q) *(f32x4*)(TOPS + ob + q * 4) = (f32x4){v[q * 4], v[q * 4 + 1], v[q * 4 + 2], v[q * 4 + 3]};
            } else {
#pragma unroll
                for (int q = 0; q < 4; ++q) *(u32x4*)(TOPI + ob + q * 4) = (u32x4){127u - (y[q * 4] & 127u), 127u - (y[q * 4 + 1] & 127u), 127u - (y[q * 4 + 2] & 127u), 127u - (y[q * 4 + 3] & 127u)};
            }
        }
        __syncthreads();
    }
}
__device__ __forceinline__ void phase_peer_wq_topk(const Params& p, int layer, unsigned char* lds) {
    const bf16_t* HM = (const bf16_t*)(p.ws + WS_HM); const bf16_t* WT = (const bf16_t*)(p.ws + WS_WQ_T) + (size_t)layer * 2048 * 1024;
    const bf16_t* SK = (const bf16_t*)(p.ws + WS_SUBK) + (size_t)layer * 8 * 2 * 128 * 128;
    float* TOPS = (float*)(p.ws + WS_TOPS); int* TOPI = (int*)(p.ws + WS_TOPI);
    float* sc = (float*)lds;
    const int tid = threadIdx.x, lane = tid & 63, wid = tid >> 6, wr = wid >> 1, wc = wid & 1, fr = lane & 15, fq = lane >> 4;
    for (int id = vblock(); id < 256 * 16; id += gridDim.x) {
        const int mt = id >> 4, hc = id & 15;
        f32x4 acc[4][4];
        gemm_tile3(ALoadPlain{HM + (size_t)mt * 128 * D, (size_t)D}, WT + (size_t)hc * 128 * D, D, 16, acc, lds);
        {
            const int srow = wid * 32 + (lane >> 3), schunk = (lane & 7) ^ ((lane >> 3) & 7);
            const bf16_t* sk = SK + (size_t)hc * 128 * 128;
#pragma unroll
            for (int kt = 0; kt < 2; ++kt)
#pragma unroll
                for (int i = 0; i < 4; ++i)
                    __builtin_amdgcn_global_load_lds((const unsigned*)(sk + (srow + 8 * i) * 128 + kt * 64 + schunk * 8), (unsigned*)(lds + kt * 32768 + 16384 + wid * 4096 + i * 1024), 16, 0, 0);
        }
#pragma unroll
        for (int mi = 0; mi < 4; ++mi)
#pragma unroll
            for (int ni = 0; ni < 4; ++ni) {
                const int r = wr * 64 + mi * 16 + fr, chunk = ni * 2 + (fq >> 1);
                const f32x4 v = acc[mi][ni];
                *(u32x2*)(lds + wc * 32768 + r * 128 + ((chunk ^ (r & 7)) << 4) + (fq & 1) * 8) = (u32x2){pk2(v.x, v.y), pk2(v.z, v.w)};
            }
        __syncthreads();
#pragma unroll
        for (int mi = 0; mi < 4; ++mi)
#pragma unroll
            for (int ni = 0; ni < 4; ++ni) acc[mi][ni] = (f32x4){0.f, 0.f, 0.f, 0.f};
        mma_ktile(lds, acc); mma_ktile(lds + 32768, acc);
        __syncthreads();
#pragma unroll
        for (int mi = 0; mi < 4; ++mi)
#pragma unroll
            for (int ni = 0; ni < 4; ++ni) {
                const int r = wr * 64 + mi * 16 + fr, c = wc * 64 + ni * 16 + fq * 4;
                float* d = sc + r * 129 + c;
                d[0] = acc[mi][ni].x; d[1] = acc[mi][ni].y; d[2] = acc[mi][ni].z; d[3] = acc[mi][ni].w;
            }
        __syncthreads();
        {
            const int row = tid >> 1, half = tid & 1;
            unsigned x[64];
            const float* rp = sc + row * 129 + half * 64;
#pragma unroll
            for (int j = 0; j < 64; ++j) {
                const unsigned bits = __builtin_bit_cast(unsigned, rp[j]);
                const unsigned u = bits ^ ((unsigned)((int)bits >> 31) | 0x80000000u);
                x[j] = (u & 0xFFFFFF80u) | (unsigned)(127 - (half * 64 + j));
            }
            bitonic_sort16(x, true); bitonic_sort16(x + 16, false); bitonic_sort16(x + 32, true); bitonic_sort16(x + 48, false);
#pragma unroll
            for (int i = 0; i < 16; ++i) { x[i] = x[i] > x[16 + i] ? x[i] : x[16 + i]; x[32 + i] = x[32 + i] > x[48 + i] ? x[32 + i] : x[48 + i]; }
            bitonic_merge16(x, true); bitonic_merge16(x + 32, false);
#pragma unroll
            for (int i = 0; i < 16; ++i) x[i] = x[i] > x[32 + i] ? x[i] : x[32 + i];
            bitonic_merge16(x, false);
            unsigned y[16];
#pragma unroll
            for (int i = 0; i < 16; ++i) { const unsigned o = (unsigned)__shfl_xor((int)x[15 - i], 1); y[i] = x[i] > o ? x[i] : o; }
            bitonic_merge16(y, false);
            const size_t ob = ((size_t)(mt * 128 + row) * 16 + hc) * 16;
            if (half == 0) {
                float v[16];
#pragma unroll
                for (int i = 0; i < 16; ++i) { const unsigned u = y[i] & 0xFFFFFF80u; const unsigned bits = (u & 0x80000000u) ? (u ^ 0x80000000u) : ~u; v[i] = __builtin_bit_cast(float, bits); }
#pragma unroll
                for (int q = 0; q < 4; ++q) *(f32x4*)(TOPS + ob + q * 4) = (f32x4){v[q * 4], v[q * 4 + 1], v[q * 4 + 2], v[q * 4 + 3]};
            } else {
#pragma unroll
                for (int q = 0; q < 4; ++q) *(u32x4*)(TOPI + ob + q * 4) = (u32x4){127u - (y[q * 4] & 127u), 127u - (y[q * 4 + 1] & 127u), 127u - (y[q * 4 + 2] & 127u), 127u - (y[q * 4 + 3] & 127u)};
            }
        }
        __syncthreads();
    }
}
__device__ __forceinline__ void phase_peer_route(const Params& p, int layer, unsigned char* lds) {
    const bf16_t* HM = (const bf16_t*)(p.ws + WS_HM); const bf16_t* WT = (const bf16_t*)(p.ws + WS_WQ_T) + (size_t)layer * 2048 * 1024;
    const bf16_t* SK = (const bf16_t*)(p.ws + WS_SUBK) + (size_t)layer * 8 * 2 * 128 * 128;
    int* EXP = (int*)(p.ws + WS_EXP); float* GATE = (float*)(p.ws + WS_GATE);
    float* sc = (float*)lds;
    unsigned* KEYS0 = (unsigned*)(lds + 66048);
    unsigned* L = (unsigned*)lds;
    const int tid = threadIdx.x, lane = tid & 63, wid = tid >> 6, wr = wid >> 1, wc = wid & 1, fr = lane & 15, fq = lane >> 4;
    for (int id = vblock(); id < 256 * 8; id += gridDim.x) {
        const int mt = id >> 3, h = id & 7;
        const int row = tid >> 1, half = tid & 1;
        unsigned y[16];
#pragma unroll 1
        for (int c = 0; c < 2; ++c) {
            const int hc = h * 2 + c;
            f32x4 acc[4][4];
            gemm_tile3(ALoadPlain{HM + (size_t)mt * 128 * D, (size_t)D}, WT + (size_t)hc * 128 * D, D, 16, acc, lds);
            {
                const int srow = wid * 32 + (lane >> 3), schunk = (lane & 7) ^ ((lane >> 3) & 7);
                const bf16_t* sk = SK + (size_t)hc * 128 * 128;
#pragma unroll
                for (int kt = 0; kt < 2; ++kt)
#pragma unroll
                    for (int i = 0; i < 4; ++i)
                        __builtin_amdgcn_global_load_lds((const unsigned*)(sk + (srow + 8 * i) * 128 + kt * 64 + schunk * 8), (unsigned*)(lds + kt * 32768 + 16384 + wid * 4096 + i * 1024), 16, 0, 0);
            }
#pragma unroll
            for (int mi = 0; mi < 4; ++mi)
#pragma unroll
                for (int ni = 0; ni < 4; ++ni) {
                    const int r = wr * 64 + mi * 16 + fr, chunk = ni * 2 + (fq >> 1);
                    const f32x4 v = acc[mi][ni];
                    *(u32x2*)(lds + wc * 32768 + r * 128 + ((chunk ^ (r & 7)) << 4) + (fq & 1) * 8) = (u32x2){pk2(v.x, v.y), pk2(v.z, v.w)};
                }
            __syncthreads();
#pragma unroll
            for (int mi = 0; mi < 4; ++mi)
#pragma unroll
                for (int ni = 0; ni < 4; ++ni) acc[mi][ni] = (f32x4){0.f, 0.f, 0.f, 0.f};
            mma_ktile(lds, acc); mma_ktile(lds + 32768, acc);
            __syncthreads();
#pragma unroll
            for (int mi = 0; mi < 4; ++mi)
#pragma unroll
                for (int ni = 0; ni < 4; ++ni) {
                    const int r = wr * 64 + mi * 16 + fr, cc = wc * 64 + ni * 16 + fq * 4;
                    float* d = sc + r * 129 + cc;
                    d[0] = acc[mi][ni].x; d[1] = acc[mi][ni].y; d[2] = acc[mi][ni].z; d[3] = acc[mi][ni].w;
                }
            __syncthreads();
            {
                unsigned x[64];
                const float* rp = sc + row * 129 + half * 64;
#pragma unroll
                for (int j = 0; j < 64; ++j) {
                    const unsigned bits = __builtin_bit_cast(unsigned, rp[j]);
                    const unsigned u = bits ^ ((unsigned)((int)bits >> 31) | 0x80000000u);
                    x[j] = (u & 0xFFFFFF80u) | (unsigned)(127 - (half * 64 + j));
                }
                bitonic_sort16(x, true); bitonic_sort16(x + 16, false); bitonic_sort16(x + 32, true); bitonic_sort16(x + 48, false);
#pragma unroll
                for (int i = 0; i < 16; ++i) { x[i] = x[i] > x[16 + i] ? x[i] : x[16 + i]; x[32 + i] = x[32 + i] > x[48 + i] ? x[32 + i] : x[48 + i]; }
                bitonic_merge16(x, true); bitonic_merge16(x + 32, false);
#pragma unroll
                for (int i = 0; i < 16; ++i) x[i] = x[i] > x[32 + i] ? x[i] : x[32 + i];
                bitonic_merge16(x, false);
#pragma unroll
                for (int i = 0; i < 16; ++i) { const unsigned o = (unsigned)__shfl_xor((int)x[15 - i], 1); y[i] = x[i] > o ? x[i] : o; }
                bitonic_merge16(y, false);
            }
            if (c == 0 && half == 0) {
#pragma unroll
                for (int i = 0; i < 16; ++i) KEYS0[i * 128 + row] = y[i];
            }
            __syncthreads();
        }
        {
            unsigned kk[16];
#pragma unroll
            for (int i = 0; i < 16; ++i) kk[i] = half ? KEYS0[i * 128 + row] : y[i];
            const int sb = half ? 0 : 16, ib = half ? 32 : 48;
#pragma unroll
            for (int i = 0; i < 16; ++i) {
                const unsigned u = kk[i] & 0xFFFFFF80u; const unsigned bits = (u & 0x80000000u) ? (u ^ 0x80000000u) : ~u;
                L[(sb + i) * 128 + row] = bits; L[(ib + i) * 128 + row] = 127u - (kk[i] & 127u);
            }
        }
        __syncthreads();
        if (tid < 128) {
            const int col = tid;
            float val[16];
            const float s20 = __builtin_bit_cast(float, L[16 * 128 + col]);
#pragma unroll
            for (int a = 0; a < 16; ++a) val[a] = __builtin_bit_cast(float, L[a * 128 + col]) + s20;
            unsigned long long P = 0ull;
            float ts[16]; int te[16];
#pragma unroll
            for (int r = 0; r < 16; ++r) {
                float best = val[0]; int ba = 0;
#pragma unroll
                for (int a = 1; a < 16; ++a) if (val[a] > best) { best = val[a]; ba = a; }
                const int b = (int)((P >> (4 * ba)) & 15ull);
                const int i1 = (int)L[(32 + ba) * 128 + col], i2 = (int)L[(48 + b) * 128 + col];
                ts[r] = best; te[r] = i1 * 128 + i2;
                const int nb = b + 1;
                float newv = -3.0e38f;
                if (nb < 16) { newv = __builtin_bit_cast(float, L[ba * 128 + col]) + __builtin_bit_cast(float, L[(16 + nb) * 128 + col]); P += 1ull << (4 * ba); }
#pragma unroll
                for (int a = 0; a < 16; ++a) val[a] = (a == ba) ? newv : val[a];
            }
            const float m0 = ts[0];
            float sum = 0.f;
#pragma unroll
            for (int r = 0; r < 16; ++r) { ts[r] = __expf(ts[r] - m0); sum += ts[r]; }
            const float inv = 1.0f / sum;
            const size_t ob = ((size_t)(mt * 128 + col) * 8 + h) * 16;
#pragma unroll
            for (int q = 0; q < 4; ++q) {
                *(u32x4*)(EXP + ob + q * 4) = (u32x4){(unsigned)te[q * 4], (unsigned)te[q * 4 + 1], (unsigned)te[q * 4 + 2], (unsigned)te[q * 4 + 3]};
                *(f32x4*)(GATE + ob + q * 4) = (f32x4){ts[q * 4] * inv, ts[q * 4 + 1] * inv, ts[q * 4 + 2] * inv, ts[q * 4 + 3] * inv};
            }
        }
        __syncthreads();
    }
}
__device__ __forceinline__ void phase_peer_combine(const Params& p, unsigned char* lds) {
    const float* TOPS = (const float*)(p.ws + WS_TOPS); const int* TOPI = (const int*)(p.ws + WS_TOPI);
    int* EXP = (int*)(p.ws + WS_EXP); float* GATE = (float*)(p.ws + WS_GATE);
    unsigned* L = (unsigned*)lds;
    const int tid = threadIdx.x;
    for (int it = blockIdx.x; it < (T * 8) / 256; it += gridDim.x) {
        const size_t th = (size_t)it * 256 + tid;
        const u32x4* S4 = (const u32x4*)(TOPS + th * 32); const u32x4* I4 = (const u32x4*)(TOPI + th * 32);
#pragma unroll
        for (int a4 = 0; a4 < 8; ++a4) {
            const u32x4 s = S4[a4], i = I4[a4];
            L[(a4 * 4 + 0) * 256 + tid] = s.x; L[(a4 * 4 + 1) * 256 + tid] = s.y; L[(a4 * 4 + 2) * 256 + tid] = s.z; L[(a4 * 4 + 3) * 256 + tid] = s.w;
            L[(32 + a4 * 4 + 0) * 256 + tid] = i.x; L[(32 + a4 * 4 + 1) * 256 + tid] = i.y; L[(32 + a4 * 4 + 2) * 256 + tid] = i.z; L[(32 + a4 * 4 + 3) * 256 + tid] = i.w;
        }
        float val[16];
        const float s20 = __builtin_bit_cast(float, L[16 * 256 + tid]);
#pragma unroll
        for (int a = 0; a < 16; ++a) val[a] = __builtin_bit_cast(float, L[a * 256 + tid]) + s20;
        unsigned long long P = 0ull;
        float ts[16]; int te[16];
#pragma unroll
        for (int r = 0; r < 16; ++r) {
            float best = val[0]; int ba = 0;
#pragma unroll
            for (int a = 1; a < 16; ++a) if (val[a] > best) { best = val[a]; ba = a; }
            const int b = (int)((P >> (4 * ba)) & 15ull);
            const int i1 = (int)L[(32 + ba) * 256 + tid], i2 = (int)L[(48 + b) * 256 + tid];
            ts[r] = best; te[r] = i1 * 128 + i2;
            const int nb = b + 1;
            float newv = -3.0e38f;
            if (nb < 16) { newv = __builtin_bit_cast(float, L[ba * 256 + tid]) + __builtin_bit_cast(float, L[(16 + nb) * 256 + tid]); P += 1ull << (4 * ba); }
#pragma unroll
            for (int a = 0; a < 16; ++a) val[a] = (a == ba) ? newv : val[a];
        }
        const float m0 = ts[0];
        float sum = 0.f;
#pragma unroll
        for (int r = 0; r < 16; ++r) { ts[r] = __expf(ts[r] - m0); sum += ts[r]; }
        const float inv = 1.0f / sum;
#pragma unroll
        for (int r = 0; r < 16; ++r) ts[r] *= inv;
#pragma unroll
        for (int r = 0; r < 16; ++r) { EXP[th * 16 + r] = te[r]; GATE[th * 16 + r] = ts[r]; }
    }
}

__device__ __forceinline__ void fma8(const unsigned w0, const unsigned w1, const float a, float* acc) {
    const f32x2 p0 = __builtin_amdgcn_cvt_pk_f32_fp8((int)w0, false), p1 = __builtin_amdgcn_cvt_pk_f32_fp8((int)w0, true);
    const f32x2 p2 = __builtin_amdgcn_cvt_pk_f32_fp8((int)w1, false), p3 = __builtin_amdgcn_cvt_pk_f32_fp8((int)w1, true);
    acc[0] += a * p0.x; acc[1] += a * p0.y; acc[2] += a * p1.x; acc[3] += a * p1.y;
    acc[4] += a * p2.x; acc[5] += a * p2.y; acc[6] += a * p3.x; acc[7] += a * p3.y;
}
__device__ __forceinline__ float dot8(const unsigned w0, const unsigned w1, const float* h, float s) {
    const f32x2 p0 = __builtin_amdgcn_cvt_pk_f32_fp8((int)w0, false), p1 = __builtin_amdgcn_cvt_pk_f32_fp8((int)w0, true);
    const f32x2 p2 = __builtin_amdgcn_cvt_pk_f32_fp8((int)w1, false), p3 = __builtin_amdgcn_cvt_pk_f32_fp8((int)w1, true);
    s += p0.x * h[0]; s += p0.y * h[1]; s += p1.x * h[2]; s += p1.y * h[3];
    s += p2.x * h[4]; s += p2.y * h[5]; s += p3.x * h[6]; s += p3.y * h[7];
    return s;
}
__device__ __forceinline__ void phase_peer_apply(const Params& p, int layer, unsigned char* lds, bool dry) {
    const int lane = threadIdx.x & 63, wave = threadIdx.x >> 6;
    float* ldsw = (float*)lds + wave * (64 * 65);
    const bf16_t* HM = (const bf16_t*)(p.ws + WS_HM);
    const unsigned char* PU = p.ws + WS_PU; const unsigned char* PV = p.ws + WS_PV;
    const float* SU = (const float*)(p.ws + WS_PU + 24 * MiB); const float* SV = (const float*)(p.ws + WS_PV + 24 * MiB);
    const int* EXP = (const int*)(p.ws + WS_EXP); const float* GATE = (const float*)(p.ws + WS_GATE);
    const float* MOD = (const float*)(p.ws + WS_MOD);
    float* X = p.out;
    for (int t = blockIdx.x * 4 + wave; t < T; t += gridDim.x * 4) {
        const u32x4 ha = *(const u32x4*)(HM + (size_t)t * D + lane * 16), hb = *(const u32x4*)(HM + (size_t)t * D + lane * 16 + 8);
        float hf[16];
        hf[0] = bflo(ha.x); hf[1] = bfhi(ha.x); hf[2] = bflo(ha.y); hf[3] = bfhi(ha.y); hf[4] = bflo(ha.z); hf[5] = bfhi(ha.z); hf[6] = bflo(ha.w); hf[7] = bfhi(ha.w);
        hf[8] = bflo(hb.x); hf[9] = bfhi(hb.x); hf[10] = bflo(hb.y); hf[11] = bfhi(hb.y); hf[12] = bflo(hb.z); hf[13] = bfhi(hb.z); hf[14] = bflo(hb.w); hf[15] = bfhi(hb.w);
        const int e0_ = EXP[(size_t)t * 128 + lane], e1_ = EXP[(size_t)t * 128 + 64 + lane];
        const float g0 = GATE[(size_t)t * 128 + lane], g1 = GATE[(size_t)t * 128 + 64 + lane];
        const float su0 = SU[e0_], su1 = SU[e1_], sv0 = SV[e0_], sv1 = SV[e1_];
        u32x4 buf[16];
        float act0 = 0.f, act1 = 0.f;
        float acc[16];
#pragma unroll
        for (int i = 0; i < 16; ++i) acc[i] = 0.f;
#ifndef APPLY_L2PROBE
#define APPLY_L2PROBE 0
#endif
        for (int prep_ = 0; prep_ < 1 + APPLY_L2PROBE; ++prep_) {
        const int emask = (APPLY_L2PROBE && prep_ == 0) ? 2047 : 0x7fffffff;
        const int e0 = e0_ & emask, e1 = e1_ & emask;
#pragma unroll
        for (int j = 0; j < 16; ++j) { const int e_ = __builtin_amdgcn_readlane(e0, j); buf[j] = *(const u32x4*)(PU + (size_t)e_ * D + lane * 16); }
#pragma unroll
        for (int bt = 0; bt < 16; ++bt) {
#pragma unroll
            for (int j = 0; j < 16; ++j) {
                if (bt < 8) {
                    float s_ = dot8(buf[j].x, buf[j].y, hf, 0.f); s_ = dot8(buf[j].z, buf[j].w, hf + 8, s_);
                    ldsw[((bt & 3) * 16 + j) * 65 + lane] = s_;
                } else {
                    const float av_ = ((bt & 7) < 4) ? act0 : act1;
                    const float a_ = __builtin_bit_cast(float, __builtin_amdgcn_readlane(__builtin_bit_cast(int, av_), (bt & 3) * 16 + j));
                    fma8(buf[j].x, buf[j].y, a_, acc); fma8(buf[j].z, buf[j].w, a_, acc + 8);
                }
                if (bt + 1 < 16) {
                    const int nb = bt + 1;
                    const int e_ = __builtin_amdgcn_readlane(((nb & 7) < 4) ? e0 : e1, (nb & 3) * 16 + j);
                    buf[j] = *(const u32x4*)(((nb < 8) ? PU : PV) + (size_t)e_ * D + lane * 16);
                }
            }
            if (bt == 3 || bt == 7) {
                float tot_ = 0.f;
#pragma unroll 16
                for (int q = 0; q < 64; ++q) tot_ += ldsw[lane * 65 + q];
                if (bt == 3) act0 = gelu_tanh(tot_ * su0) * g0 * sv0; else act1 = gelu_tanh(tot_ * su1) * g1 * sv1;
            }
        }
        if (APPLY_L2PROBE && prep_ == 0 && p.ph_hi >= 0) {
#pragma unroll
            for (int i = 0; i < 16; ++i) acc[i] = 0.f;
        }
        }
        const int b = t / SEQ;
        const float* g2 = MOD + (size_t)(layer * 2 + b) * 6144 + 5120;
        float* xr = X + (size_t)t * D + lane * 16;
        f32x4 xs[4]; float ss = 0.f;
#pragma unroll
        for (int q = 0; q < 4; ++q) {
            const f32x4 g = *(const f32x4*)(g2 + lane * 16 + q * 4); f32x4 x = *(const f32x4*)(xr + q * 4);
            x.x += g.x * acc[q * 4 + 0]; x.y += g.y * acc[q * 4 + 1]; x.z += g.z * acc[q * 4 + 2]; x.w += g.w * acc[q * 4 + 3];
            xs[q] = x; ss += (x.x * x.x + x.y * x.y) + (x.z * x.z + x.w * x.w);
        }
        const float rs = rsqrtf(wave_sum(ss) * (1.0f / D) + RMS_EPS);
        if (!dry) {
            if (layer == 0) {
                const float* gw = p.in[2] + D + lane * 16; const float* sh = MOD + (size_t)(2 + b) * 6144 + lane * 16; const float* sc = sh + 1024;
                u32x4 o[2];
#pragma unroll
                for (int q = 0; q < 4; ++q) {
                    *(f32x4*)(xr + q * 4) = xs[q];
                    const f32x4 g = *(const f32x4*)(gw + q * 4), s1 = *(const f32x4*)(sc + q * 4), s0 = *(const f32x4*)(sh + q * 4);
                    const float y0 = xs[q].x * rs * g.x * (1.f + s1.x) + s0.x, y1 = xs[q].y * rs * g.y * (1.f + s1.y) + s0.y;
                    const float y2 = xs[q].z * rs * g.z * (1.f + s1.z) + s0.z, y3 = xs[q].w * rs * g.w * (1.f + s1.w) + s0.w;
                    if (q & 1) { o[q >> 1].z = pk2(y0, y1); o[q >> 1].w = pk2(y2, y3); } else { o[q >> 1].x = pk2(y0, y1); o[q >> 1].y = pk2(y2, y3); }
                }
                bf16_t* hm = (bf16_t*)(p.ws + WS_HM) + (size_t)t * D + lane * 16;
                *(u32x4*)hm = o[0]; *(u32x4*)(hm + 8) = o[1];
            } else {
                const float* gw = p.in[28] + lane * 16;
#pragma unroll
                for (int q = 0; q < 4; ++q) {
                    const f32x4 g = *(const f32x4*)(gw + q * 4);
                    *(f32x4*)(xr + q * 4) = (f32x4){xs[q].x * rs * g.x, xs[q].y * rs * g.y, xs[q].z * rs * g.z, xs[q].w * rs * g.w};
                }
            }
        }
    }
}
__device__ __forceinline__ void phase_tab1(const Params& p) {
    const int first = vblock() - 256, stride = (int)gridDim.x - 256;
    if (first < 0 || stride <= 0) {
        if (stride <= 0) { for (int it = blockIdx.x; it < 2 * P0_TAB; it += gridDim.x) {
            if (it < P0_TAB) cvt_fp8_item(p.in[26] + (size_t)PE * D, p.ws + WS_PU, (float*)(p.ws + WS_PU + 24 * MiB), it, false);
            else cvt_fp8_item(p.in[27] + (size_t)PE * D, p.ws + WS_PV, (float*)(p.ws + WS_PV + 24 * MiB), it - P0_TAB, false); } }
        return;
    }
    for (int it = first; it < 2 * P0_TAB; it += stride) {
        if (it < P0_TAB) cvt_fp8_item(p.in[26] + (size_t)PE * D, p.ws + WS_PU, (float*)(p.ws + WS_PU + 24 * MiB), it, false);
        else cvt_fp8_item(p.in[27] + (size_t)PE * D, p.ws + WS_PV, (float*)(p.ws + WS_PV + 24 * MiB), it - P0_TAB, false);
    }
}
__device__ __forceinline__ void phase_nsa_proj(const Params& p, unsigned char* lds) {
    const bf16_t* HM = (const bf16_t*)(p.ws + WS_HM); const bf16_t* WT = (const bf16_t*)(p.ws + WS_WPROJ_T);
    const f32x2* ROPE = (const f32x2*)(p.ws + WS_ROPE);
    bf16_t* Q = (bf16_t*)(p.ws + WS_Q); float* NGT = (float*)(p.ws + WS_NG);
    const int lane = threadIdx.x & 63, wid = threadIdx.x >> 6, wr = wid >> 1, wc = wid & 1, fr = lane & 15, fq = lane >> 4;
    for (int id = vblock(); id < 256 * 21; id += gridDim.x) {
        const int mt = id / 21, nt = id % 21;
        f32x4 acc[4][4];
        gemm_tile3(ALoadPlain{HM + (size_t)mt * 128 * D, (size_t)D}, WT + (size_t)nt * 128 * D, D, 16, acc, lds);
        const int c0 = nt * 128 + wc * 64;
        if (c0 >= 2624) continue;
        const int b = (mt * 128) / SEQ;
        if (c0 == 2560) {
#pragma unroll
            for (int mi = 0; mi < 4; ++mi)
#pragma unroll
                for (int ni = 0; ni < 3; ++ni) {
                    const int t = mt * 128 + wr * 64 + mi * 16 + fr;
                    const f32x4 v = acc[mi][ni];
                    *(f32x4*)(NGT + (size_t)t * 48 + ni * 16 + fq * 4) = (f32x4){sigmoidf_(v.x), sigmoidf_(v.y), sigmoidf_(v.z), sigmoidf_(v.w)};
                }
            continue;
        }
        int sec = -1, g = 0;
        if (c0 >= 1024) { sec = (c0 - 1024) >> 8; g = ((c0 - 1024) & 255) >> 6; }
        const bool dorope = (sec == -1) || (sec == 2) || (sec == 4);
        const float scl = (sec == -1) ? 0.125f : 1.0f;
        const size_t secoff[6] = {WS_KC, WS_VC, WS_KS, WS_VST, WS_KW, WS_VWT};
        size_t so = WS_Q;
#pragma unroll
        for (int q = 0; q < 6; ++q) if (sec == q) so = secoff[q];
        bf16_t* OUT = (bf16_t*)(p.ws + so);
        const bool vt = (sec == 3) || (sec == 5);
        float kblk_am = 0.f;
#pragma unroll
        for (int pass = 0; pass < 2; ++pass) {
        if (pass == 1 && sec == 2) {
#pragma unroll
            for (int o = 1; o < 64; o <<= 1) kblk_am = fmaxf(kblk_am, __shfl_xor(kblk_am, o));
            if (lane == 0) ((float*)(p.ws + WS_KS + 12 * MiB))[(size_t)(b * 4 + g) * 256 + ((mt * 128 + wr * 64 - b * SEQ) >> 6)] = kblk_am > 0.f ? kblk_am / 224.0f : 1.0f;
        }
#pragma unroll
        for (int mi = 0; mi < 4; ++mi) {
            const int t = mt * 128 + wr * 64 + mi * 16 + fr, s = t - b * SEQ;
            if (dorope && pass == 0) {
#pragma unroll
                for (int ni = 0; ni < 2; ++ni) {
                    const f32x4* rp = (const f32x4*)(ROPE + (size_t)s * 32 + ni * 16 + fq * 4);
                    const f32x4 r0 = rp[0], r1 = rp[1];
                    const f32x4 x1 = acc[mi][ni], x2 = acc[mi][ni + 2];
                    acc[mi][ni] = (f32x4){x1.x * r0.x - x2.x * r0.y, x1.y * r0.z - x2.y * r0.w, x1.z * r1.x - x2.z * r1.y, x1.w * r1.z - x2.w * r1.w};
                    acc[mi][ni + 2] = (f32x4){x1.x * r0.y + x2.x * r0.x, x1.y * r0.w + x2.y * r0.z, x1.z * r1.y + x2.z * r1.x, x1.w * r1.w + x2.w * r1.z};
                }
            }
            if (pass == 0) {
                if (sec == 2) {
#pragma unroll
                    for (int ni = 0; ni < 4; ++ni) { const f32x4 v = acc[mi][ni]; kblk_am = fmaxf(kblk_am, fmaxf(fmaxf(fabsf(v.x), fabsf(v.y)), fmaxf(fabsf(v.z), fabsf(v.w)))); }
                }
                continue;
            }
            if (sec == -1 || sec == 2) {
                float am = kblk_am;
                if (sec == -1) {
                    am = 0.f;
#pragma unroll
                    for (int ni = 0; ni < 4; ++ni) { const f32x4 v = acc[mi][ni] * scl; am = fmaxf(am, fmaxf(fmaxf(fabsf(v.x), fabsf(v.y)), fmaxf(fabsf(v.z), fabsf(v.w)))); }
                    am = fmaxf(am, __shfl_xor(am, 16)); am = fmaxf(am, __shfl_xor(am, 32));
                }
                const float qs = am > 0.f ? 224.0f / am : 1.0f;
                unsigned char* O8 = (sec == -1) ? (p.ws + WS_Q8 + (size_t)t * 1024 + c0) : (p.ws + WS_KS + ((size_t)(b * 4 + g) * SEQ + s) * 64);
#pragma unroll
                for (int ni = 0; ni < 4; ++ni) {
                    const f32x4 v = acc[mi][ni] * (scl * qs);
                    int w = 0; w = __builtin_amdgcn_cvt_pk_fp8_f32(v.x, v.y, w, false); w = __builtin_amdgcn_cvt_pk_fp8_f32(v.z, v.w, w, true);
                    *(int*)(O8 + ni * 16 + fq * 4) = w;
                }
                if (fq == 0 && sec == -1) ((float*)(p.ws + WS_Q8 + 32 * MiB))[(size_t)t * 16 + (c0 >> 6)] = am > 0.f ? am / 224.0f : 1.0f;
            }
            if (sec == 2) continue;
#pragma unroll
            for (int ni = 0; ni < 4; ++ni) {
                const f32x4 v = acc[mi][ni] * scl;
                const int d = ni * 16 + fq * 4;
                if (sec == -1) {
                    *(u32x2*)(OUT + (size_t)t * 1024 + c0 + d) = (u32x2){pk2(v.x, v.y), pk2(v.z, v.w)};
                } else if (sec == 4) {
                    const size_t idx = (size_t)(b * 4 + g) * SEQ * 64 + (size_t)(s >> 5) * 2048 + ((((s >> 4) & 1) * 2 + (ni >> 1)) * 16 + (s & 15)) * 32 + ((ni & 1) * 2 + (fq >> 1)) * 8 + (fq & 1) * 4;
                    *(u32x2*)(OUT + idx) = (u32x2){pk2(v.x, v.y), pk2(v.z, v.w)};
                } else if (!vt) {
                    *(u32x2*)(OUT + ((size_t)(b * 4 + g) * SEQ + s) * 64 + d) = (u32x2){pk2(v.x, v.y), pk2(v.z, v.w)};
                } else if (sec == 5) {
                    const int key = s & 31;
                    bf16_t* o = OUT + (size_t)(b * 4 + g) * SEQ * 64 + (size_t)(s >> 5) * 2048 + ((ni * 2 + (key >> 4)) * 16 + fq * 4) * 16 + ((key >> 2) & 3) * 4 + (key & 3);
                    o[0] = (bf16_t)f2bf(v.x); o[16] = (bf16_t)f2bf(v.y); o[32] = (bf16_t)f2bf(v.z); o[48] = (bf16_t)f2bf(v.w);
                }
            }
        }
        }
        if (sec == 3) {
            const int s0 = mt * 128 + wr * 64 - b * SEQ, jb = s0 >> 6;
            unsigned char* V8 = p.ws + WS_VST + (size_t)((b * 4 + g) * 256 + jb) * 4096;
            float am = 0.f;
#pragma unroll
            for (int mi = 0; mi < 4; ++mi)
#pragma unroll
                for (int ni = 0; ni < 4; ++ni) { const f32x4 v = acc[mi][ni]; am = fmaxf(am, fmaxf(fmaxf(fabsf(v.x), fabsf(v.y)), fmaxf(fabsf(v.z), fabsf(v.w)))); }
#pragma unroll
            for (int o = 1; o < 64; o <<= 1) am = fmaxf(am, __shfl_xor(am, o));
            const float qs = am > 0.f ? 224.0f / am : 1.0f;
            if (lane == 0) ((float*)(p.ws + WS_VST + 12 * MiB))[(size_t)(b * 4 + g) * 256 + jb] = am > 0.f ? am / 224.0f : 1.0f;
#pragma unroll
            for (int ni = 0; ni < 4; ++ni) {
                const int d = ni * 16 + fq * 4;
#pragma unroll
                for (int mi = 0; mi < 4; ++mi) {
                    const f32x4 v = acc[mi][ni] * qs;
                    int w = 0; w = __builtin_amdgcn_cvt_pk_fp8_f32(v.x, v.y, w, false); w = __builtin_amdgcn_cvt_pk_fp8_f32(v.z, v.w, w, true);
                    unsigned char* o = V8 + (size_t)d * 64 + mi * 16 + fr;
                    o[0] = (unsigned char)(w & 255); o[64] = (unsigned char)((w >> 8) & 255); o[128] = (unsigned char)((w >> 16) & 255); o[192] = (unsigned char)((unsigned)w >> 24);
                }
            }
        }
    }
}
__device__ __forceinline__ void phase_nsa_cmp1(const Params& p, unsigned char* lds) {
    bf16_t* HID = (bf16_t*)(p.ws + WS_HID);
    const float* bias = (const float*)(p.ws + WS_MISC);
    const int lane = threadIdx.x & 63, wid = threadIdx.x >> 6, wr = wid >> 1, wc = wid & 1, fr = lane & 15, fq = lane >> 4;
    for (int id = vblock(); id < 256; id += gridDim.x) {
        const int kv = id >> 7, bg = (id >> 4) & 7, mt = (id >> 1) & 7, nt = id & 1;
        const bf16_t* A = (const bf16_t*)(p.ws + (kv ? WS_VC : WS_KC)) + (size_t)bg * SEQ * 64 + (size_t)mt * 128 * 1024;
        const bf16_t* B = (const bf16_t*)(p.ws + (kv ? WS_WV1_T : WS_WK1_T)) + (size_t)nt * 128 * 2048;
        f32x4 acc[4][4];
        gemm_tile3(ALoadPlain{A, (size_t)1024}, B, 2048, 32, acc, lds);
#pragma unroll
        for (int mi = 0; mi < 4; ++mi)
#pragma unroll
            for (int ni = 0; ni < 4; ++ni) {
                const int n = mt * 128 + wr * 64 + mi * 16 + fr, c = nt * 128 + wc * 64 + ni * 16 + fq * 4;
                const f32x4 bv = *(const f32x4*)(bias + kv * 256 + c);
                const f32x4 v = acc[mi][ni] + bv;
                *(u32x2*)(HID + (((size_t)kv * 8 + bg) * 1024 + n) * 256 + c) = (u32x2){pk2(gelu_tanh(v.x), gelu_tanh(v.y)), pk2(gelu_tanh(v.z), gelu_tanh(v.w))};
            }
    }
}
__device__ __forceinline__ void phase_nsa_cmp2(const Params& p, unsigned char* lds) {
    const bf16_t* HID = (const bf16_t*)(p.ws + WS_HID);
    const f32x2* ROPE = (const f32x2*)(p.ws + WS_ROPE);
    bf16_t* KCMP = (bf16_t*)(p.ws + WS_KCMP); bf16_t* VCMPT = (bf16_t*)(p.ws + WS_VCMPT);
    const int lane = threadIdx.x & 63, wid = threadIdx.x >> 6, wr = wid >> 1, wc = wid & 1, fr = lane & 15, fq = lane >> 4;
    for (int id = vblock(); id < 128; id += gridDim.x) {
        const int kv = id >> 6, mt = id & 63;
        const bf16_t* A = HID + ((size_t)kv * 8192 + (size_t)mt * 128) * 256;
        const bf16_t* B = (const bf16_t*)(p.ws + (kv ? WS_WV2_T : WS_WK2_T));
        f32x4 acc[4][4];
        gemm_tile3(ALoadPlain{A, (size_t)256}, B, 256, 4, acc, lds);
        if (wc == 1) continue;
#pragma unroll
        for (int mi = 0; mi < 4; ++mi) {
            const int R = mt * 128 + wr * 64 + mi * 16 + fr, bg = R >> 10, n = R & 1023;
            if (kv == 0) {
                int pos = n * 16 + 31; pos = pos > SEQ - 1 ? SEQ - 1 : pos;
#pragma unroll
                for (int ni = 0; ni < 2; ++ni) {
                    const f32x4* rp = (const f32x4*)(ROPE + (size_t)pos * 32 + ni * 16 + fq * 4);
                    const f32x4 r0 = rp[0], r1 = rp[1];
                    const f32x4 x1 = acc[mi][ni], x2 = acc[mi][ni + 2];
                    acc[mi][ni] = (f32x4){x1.x * r0.x - x2.x * r0.y, x1.y * r0.z - x2.y * r0.w, x1.z * r1.x - x2.z * r1.y, x1.w * r1.z - x2.w * r1.w};
                    acc[mi][ni + 2] = (f32x4){x1.x * r0.y + x2.x * r0.x, x1.y * r0.w + x2.y * r0.z, x1.z * r1.y + x2.z * r1.x, x1.w * r1.w + x2.w * r1.z};
                }
#pragma unroll
                for (int ni = 0; ni < 4; ++ni) {
                    const f32x4 v = acc[mi][ni];
                    const size_t idx = (size_t)bg * 1024 * 64 + (size_t)(n >> 5) * 2048 + ((((n >> 4) & 1) * 2 + (ni >> 1)) * 16 + (n & 15)) * 32 + ((ni & 1) * 2 + (fq >> 1)) * 8 + (fq & 1) * 4;
                    *(u32x2*)(KCMP + idx) = (u32x2){pk2(v.x, v.y), pk2(v.z, v.w)};
                }
            } else {
#pragma unroll
                for (int ni = 0; ni < 4; ++ni) {
                    const f32x4 v = acc[mi][ni];
                    const int key = n & 31;
                    bf16_t* o = VCMPT + (size_t)bg * 1024 * 64 + (size_t)(n >> 5) * 2048 + ((ni * 2 + (key >> 4)) * 16 + fq * 4) * 16 + ((key >> 2) & 3) * 4 + (key & 3);
                    o[0] = (bf16_t)f2bf(v.x); o[16] = (bf16_t)f2bf(v.y); o[32] = (bf16_t)f2bf(v.z); o[48] = (bf16_t)f2bf(v.w);
                }
            }
        }
    }
}
__device__ __forceinline__ void phase_nsa_wo(const Params& p, unsigned char* lds, bool dry) {
    const bf16_t* O = (const bf16_t*)(p.ws + WS_O); const bf16_t* WT = (const bf16_t*)(p.ws + WS_WO_T);
    const float* MOD = (const float*)(p.ws + WS_MOD);
    float* X = p.out;
    const int lane = threadIdx.x & 63, wid = threadIdx.x >> 6, wr = wid >> 1, wc = wid & 1, fr = lane & 15, fq = lane >> 4;
    for (int id = vblock(); id < 256 * 8; id += gridDim.x) {
        const int mt = id >> 3, nt = id & 7;
        f32x4 acc[4][4];
        gemm_tile3(ALoadPlain{O + (size_t)mt * 128 * D, (size_t)D}, WT + (size_t)nt * 128 * D, D, 16, acc, lds);
        const int b = (mt * 128) / SEQ;
#pragma unroll
        for (int mi = 0; mi < 4; ++mi)
#pragma unroll
            for (int ni = 0; ni < 4; ++ni) {
                const int t = mt * 128 + wr * 64 + mi * 16 + fr, c = nt * 128 + wc * 64 + ni * 16 + fq * 4;
                const f32x4 g1 = *(const f32x4*)(MOD + (size_t)(1 * 2 + b) * 6144 + 2048 + c);
                float* xp = X + (size_t)t * D + c;
                const f32x4 x = *(const f32x4*)xp; const f32x4 v = acc[mi][ni];
                if (!dry) *(f32x4*)xp = (f32x4){x.x + g1.x * v.x, x.y + g1.y * v.y, x.z + g1.z * v.z, x.w + g1.w * v.w};
            }
    }
}
__device__ __forceinline__ bf16x8 pack8(const f32x4 a, const f32x4 b) {
    u32x4 w; w.x = pk2(a.x, a.y); w.y = pk2(a.z, a.w); w.z = pk2(b.x, b.y); w.w = pk2(b.z, b.w);
    return __builtin_bit_cast(bf16x8, w);
}
__device__ __forceinline__ bf16x8 ldv8(const bf16_t* plo, const bf16_t* phi) {
    const u32x2 lo = *(const u32x2*)plo, hi = *(const u32x2*)phi;
    u32x4 w; w.x = lo.x; w.y = lo.y; w.z = hi.x; w.w = hi.y;
    return __builtin_bit_cast(bf16x8, w);
}
__device__ __forceinline__ float red4(float v) { v += __shfl_xor(v, 16); v += __shfl_xor(v, 32); return v; }
__device__ __forceinline__ float max4(float v) { v = fmaxf(v, __shfl_xor(v, 16)); v = fmaxf(v, __shfl_xor(v, 32)); return v; }
#define NEGBIG (-1.0e30f)

__device__ __forceinline__ void phase_nsa_attn(const Params& p, unsigned char* lds, const int rep_cmp, const int rep_win, const int rep_sel) {
    const int lane = threadIdx.x & 63, wave = threadIdx.x >> 6, fr = lane & 15, fq = lane >> 4;
    unsigned char* WL = lds + wave * 18432;
    float* IMP = (float*)WL;
    int* SEL = (int*)(WL + 17408);
    const bf16_t* Q = (const bf16_t*)(p.ws + WS_Q);
    const bf16_t* KCMP = (const bf16_t*)(p.ws + WS_KCMP); const bf16_t* VCMPT = (const bf16_t*)(p.ws + WS_VCMPT);
    const bf16_t* KW = (const bf16_t*)(p.ws + WS_KW); const bf16_t* VWT = (const bf16_t*)(p.ws + WS_VWT);
    const float* NGT = (const float*)(p.ws + WS_NG);
    bf16_t* O = (bf16_t*)(p.ws + WS_O);
    const f32x4 z4 = (f32x4){0.f, 0.f, 0.f, 0.f};
    for (int bi = blockIdx.x; bi < 2048; bi += gridDim.x) {
        const int bg = bi & 7, quad = 255 - (bi >> 3), t0 = (quad * 4 + wave) * 16, b = bg >> 2, g = bg & 3;
        const int cur = t0 >> 6;
        const size_t tok = (size_t)b * SEQ + t0 + fr;
        const int tq = t0 + fr;
        bf16x8 qf[4][2];
#pragma unroll
        for (int r = 0; r < 4; ++r)
#pragma unroll
            for (int ks = 0; ks < 2; ++ks) qf[r][ks] = *(const bf16x8*)(Q + tok * 1024 + (g * 4 + r) * 64 + ks * 32 + fq * 8);
        f32x4 acc[4][4];
        for (int rep = 0; rep < rep_win; ++rep) {
            const bf16_t* kwb = KW + (size_t)bg * SEQ * 64; const bf16_t* vwb = VWT + (size_t)bg * SEQ * 64;
            float mw[4], lw[4];
#pragma unroll
            for (int r = 0; r < 4; ++r) { mw[r] = NEGBIG; lw[r] = 0.f;
#pragma unroll
                for (int df = 0; df < 4; ++df) acc[r][df] = z4; }
            int kmin = t0 - 511; kmin = kmin < 0 ? 0 : kmin; kmin &= ~31;
            bf16x8 nkf[2][2];
#define WIN_LOAD(kb_) do { _Pragma("unroll") for (int f = 0; f < 2; ++f) _Pragma("unroll") for (int ks = 0; ks < 2; ++ks) nkf[f][ks] = *(const bf16x8*)(kwb + (size_t)((kb_) >> 5) * 2048 + ((f * 2 + ks) * 16 + fr) * 32 + fq * 8); } while (0)
            WIN_LOAD(kmin);
            for (int kb = kmin; kb <= t0 + 15; kb += 32) {
                bf16x8 kf[2][2], vf[4];
#pragma unroll
                for (int f = 0; f < 2; ++f) { kf[f][0] = nkf[f][0]; kf[f][1] = nkf[f][1]; }
#pragma unroll
                for (int df = 0; df < 4; ++df) { const bf16_t* vp = vwb + (size_t)(kb >> 5) * 2048 + (df * 32 + fr) * 16 + fq * 4; vf[df] = ldv8(vp, vp + 256); }
                { const int kn = (kb + 32 <= t0 + 15) ? kb + 32 : kb; WIN_LOAD(kn); }
#pragma unroll
                for (int r = 0; r < 4; ++r) {
                    f32x4 st[2];
#pragma unroll
                    for (int f = 0; f < 2; ++f) {
                        st[f] = __builtin_amdgcn_mfma_f32_16x16x32_bf16(kf[f][0], qf[r][0], z4, 0, 0, 0);
                        st[f] = __builtin_amdgcn_mfma_f32_16x16x32_bf16(kf[f][1], qf[r][1], st[f], 0, 0, 0);
                    }
                    float mx = NEGBIG;
#pragma unroll
                    for (int f = 0; f < 2; ++f)
#pragma unroll
                        for (int e = 0; e < 4; ++e) { const int key = kb + f * 16 + fq * 4 + e; const bool ok = (key <= tq) && (key > tq - 512); if (ok) mx = fmaxf(mx, st[f][e]); }
                    float mn = mw[r], al = 1.0f;
                    if (__builtin_amdgcn_ballot_w64(mx > mw[r] + 8.0f) != 0ull) { mn = fmaxf(mw[r], max4(mx)); al = __expf(mw[r] - mn); }
                    float ps = 0.f;
#pragma unroll
                    for (int f = 0; f < 2; ++f)
#pragma unroll
                        for (int e = 0; e < 4; ++e) { const int key = kb + f * 16 + fq * 4 + e; const bool ok = (key <= tq) && (key > tq - 512); const float pv = ok ? __expf(st[f][e] - mn) : 0.f; st[f][e] = pv; ps += pv; }
                    lw[r] = lw[r] * al + ps; mw[r] = mn;
                    const bf16x8 pf = pack8(st[0], st[1]);
#pragma unroll
                    for (int df = 0; df < 4; ++df) { acc[r][df] = acc[r][df] * al; acc[r][df] = __builtin_amdgcn_mfma_f32_16x16x32_bf16(vf[df], pf, acc[r][df], 0, 0, 0); }
                    __builtin_amdgcn_sched_barrier(0);
                }
            }
#pragma unroll
            for (int r = 0; r < 4; ++r) {
                const float l = red4(lw[r]); const float sc = NGT[tok * 48 + (g * 4 + r) * 3 + 2] / l;
#pragma unroll
                for (int df = 0; df < 4; ++df) acc[r][df] = acc[r][df] * sc;
            }
#undef WIN_LOAD
        }
        const int nmax_tile = (t0 >> 4) - 1, nmax_lane = (t0 >> 4) - 2 + (fr == 15 ? 1 : 0);
        const bf16_t* kcb = KCMP + (size_t)bg * 1024 * 64; const bf16_t* vcb = VCMPT + (size_t)bg * 64 * 1024;
        for (int rep = 0; rep < rep_cmp; ++rep) {
            const bool dry = (rep + 1 < rep_cmp);
            float mc[4], lc[4], invl[4];
#pragma unroll
            for (int r = 0; r < 4; ++r) { mc[r] = NEGBIG; lc[r] = 0.f; }
            bf16x8 nkc[2][2], nvc[4];
#define CMPK_LOAD(nb_) do { _Pragma("unroll") for (int f = 0; f < 2; ++f) _Pragma("unroll") for (int ks = 0; ks < 2; ++ks) nkc[f][ks] = *(const bf16x8*)(kcb + (size_t)((nb_) >> 5) * 2048 + ((f * 2 + ks) * 16 + fr) * 32 + fq * 8); } while (0)
#define CMPV_LOAD(nb_) do { _Pragma("unroll") for (int df = 0; df < 4; ++df) { const bf16_t* vp = vcb + (size_t)((nb_) >> 5) * 2048 + (df * 32 + fr) * 16 + fq * 4; nvc[df] = ldv8(vp, vp + 256); } } while (0)
            CMPK_LOAD(0);
            for (int nb = 0; nb <= nmax_tile; nb += 32) {
                bf16x8 kf[2][2];
#pragma unroll
                for (int f = 0; f < 2; ++f) { kf[f][0] = nkc[f][0]; kf[f][1] = nkc[f][1]; }
                { const int nn = (nb + 32 <= nmax_tile) ? nb + 32 : 0; CMPK_LOAD(nn); }
#pragma unroll
                for (int r = 0; r < 4; ++r) {
                    f32x4 st[2];
#pragma unroll
                    for (int f = 0; f < 2; ++f) {
                        st[f] = __builtin_amdgcn_mfma_f32_16x16x32_bf16(kf[f][0], qf[r][0], z4, 0, 0, 0);
                        st[f] = __builtin_amdgcn_mfma_f32_16x16x32_bf16(kf[f][1], qf[r][1], st[f], 0, 0, 0);
                    }
                    float mx = NEGBIG;
#pragma unroll
                    for (int f = 0; f < 2; ++f)
#pragma unroll
                        for (int e = 0; e < 4; ++e) { const int n = nb + f * 16 + fq * 4 + e; if (n <= nmax_lane) mx = fmaxf(mx, st[f][e]); }
                    float mn = mc[r];
                    if (__builtin_amdgcn_ballot_w64(mx > mc[r] + 8.0f) != 0ull) mn = fmaxf(mc[r], max4(mx));
                    float ps = 0.f;
#pragma unroll
                    for (int f = 0; f < 2; ++f)
#pragma unroll
                        for (int e = 0; e < 4; ++e) { const int n = nb + f * 16 + fq * 4 + e; if (n <= nmax_lane) ps += __expf(st[f][e] - mn); }
                    lc[r] = lc[r] * __expf(mc[r] - mn) + ps; mc[r] = mn;
                    __builtin_amdgcn_sched_barrier(0);
                }
            }
#pragma unroll
            for (int r = 0; r < 4; ++r) { const float l = red4(lc[r]); invl[r] = l > 0.f ? 1.0f / l : 0.f; }
            for (int i = lane; i < 16 * 260; i += 64) IMP[i] = 0.f;
            float carry = 0.f;
            float gc[4];
#pragma unroll
            for (int r = 0; r < 4; ++r) gc[r] = NGT[tok * 48 + (g * 4 + r) * 3];
            for (int nb = 0; nb <= nmax_tile; nb += 32) {
                bf16x8 kf[2][2], vf[4];
#pragma unroll
                for (int f = 0; f < 2; ++f) { kf[f][0] = nkc[f][0]; kf[f][1] = nkc[f][1]; }
                CMPV_LOAD(nb);
#pragma unroll
                for (int df = 0; df < 4; ++df) vf[df] = nvc[df];
                { const int nn = (nb + 32 <= nmax_tile) ? nb + 32 : nb; CMPK_LOAD(nn); }
                f32x4 pg[2] = {z4, z4};
#pragma unroll
                for (int r = 0; r < 4; ++r) {
                    f32x4 st[2];
#pragma unroll
                    for (int f = 0; f < 2; ++f) {
                        st[f] = __builtin_amdgcn_mfma_f32_16x16x32_bf16(kf[f][0], qf[r][0], z4, 0, 0, 0);
                        st[f] = __builtin_amdgcn_mfma_f32_16x16x32_bf16(kf[f][1], qf[r][1], st[f], 0, 0, 0);
#pragma unroll
                        for (int e = 0; e < 4; ++e) { const int n = nb + f * 16 + fq * 4 + e; st[f][e] = (n <= nmax_lane) ? __expf(st[f][e] - mc[r]) * invl[r] : 0.f; }
                        pg[f] += st[f];
                    }
                    const float gg = dry ? 0.f : gc[r];
                    const bf16x8 pf = pack8(st[0] * gg, st[1] * gg);
#pragma unroll
                    for (int df = 0; df < 4; ++df) acc[r][df] = __builtin_amdgcn_mfma_f32_16x16x32_bf16(vf[df], pf, acc[r][df], 0, 0, 0);
                    __builtin_amdgcn_sched_barrier(0);
                }
                const int src = (lane - 16) & 63;
                const float s0 = __shfl(pg[0].w, src), s1 = __shfl(pg[1].w, src), sc = __shfl(carry, src);
                const float prev0 = fq > 0 ? s0 : sc, prev1 = fq > 0 ? s1 : s0;
                const float imp0 = (pg[0].x + pg[0].y) + (pg[0].z + pg[0].w) + prev0;
                const float imp1 = (pg[1].x + pg[1].y) + (pg[1].z + pg[1].w) + prev1;
                const int jb = (nb >> 2) + fq;
                IMP[fr * 260 + jb] = imp0; IMP[fr * 260 + jb + 4] = imp1;
                carry = pg[1].w;
            }
#undef CMPK_LOAD
#undef CMPV_LOAD
        }
        {
            const int nf = cur >= 2 ? 3 : cur + 1;
            if (fq == 0) {
                SEL[fr * 16 + 0] = 0;
                if (cur == 1) SEL[fr * 16 + 1] = 1;
                if (cur >= 2) { SEL[fr * 16 + 1] = cur - 1; SEL[fr * 16 + 2] = cur; }
            }
            const int ncand = cur >= 3 ? cur - 2 : 0, extra = 16 - nf;
            if (ncand <= extra) {
                if (fq == 0) { for (int k = 0; k < extra; ++k) SEL[fr * 16 + nf + k] = (k < ncand) ? 1 + k : -1; }
            } else {
                for (int rnd = 0; rnd < extra; ++rnd) {
                    float bv = -1.0f; int bj = 1 << 20;
                    for (int jb = 1 + fq; jb <= cur - 2; jb += 4) { const float v = IMP[fr * 260 + jb]; if (v > bv) { bv = v; bj = jb; } }
#pragma unroll
                    for (int o = 16; o <= 32; o <<= 1) {
                        const float ov = __shfl_xor(bv, o); const int oj = __shfl_xor(bj, o);
                        if (ov > bv || (ov == bv && oj < bj)) { bv = ov; bj = oj; }
                    }
                    if (fq == 0) SEL[fr * 16 + nf + rnd] = bj;
                    if (((bj - 1) & 3) == fq) IMP[fr * 260 + bj] = -2.0f;
                }
            }
        }
#pragma unroll
        for (int r = 0; r < 4; ++r)
#pragma unroll
            for (int df = 0; df < 4; ++df) {
                const f32x4 v = acc[r][df];
                *(u32x2*)(O + tok * 1024 + (g * 4 + r) * 64 + df * 16 + fq * 4) = (u32x2){pk2(v.x, v.y), pk2(v.z, v.w)};
            }
        asm volatile("s_waitcnt vmcnt(0)" ::: "memory");
        unsigned selp[4];
        {
            const u32x4* sp = (const u32x4*)(SEL + fr * 16);
#pragma unroll
            for (int q = 0; q < 4; ++q) { const u32x4 w = sp[q]; selp[q] = (w.x & 255u) | ((w.y & 255u) << 8) | ((w.z & 255u) << 16) | ((w.w & 255u) << 24); }
        }
        for (int rep = 0; rep < rep_sel; ++rep) {
            const bool dry = (rep + 1 < rep_sel);
            const unsigned char* k8b = p.ws + WS_KS + (size_t)bg * SEQ * 64; const unsigned char* v8b = p.ws + WS_VST + (size_t)bg * 256 * 4096;
            const float* skb = (const float*)(p.ws + WS_KS + 12 * MiB) + (size_t)bg * 256; const float* svb = (const float*)(p.ws + WS_VST + 12 * MiB) + (size_t)bg * 256;
            const unsigned char* Q8 = p.ws + WS_Q8; const float* SQ8 = (const float*)(p.ws + WS_Q8 + 32 * MiB);
            const int nv = cur + 1 < 16 ? cur + 1 : 16, npair = (nv + 1) >> 1, total = 16 * npair;
            const int lrow = lane >> 2, lch = lane & 3;
            const int woff = lrow * 72 + lch * 16;
            const int rr = fr & 3;
            u32x4 sk[2][4], sv[2][4]; float ssk[2], ssv[2];
            int jbn[2];
#define SEL_GET(tokI, slotK) ((int)(((unsigned)__builtin_amdgcn_readlane((int)(((slotK) >> 2) == 0 ? selp[0] : ((slotK) >> 2) == 1 ? selp[1] : ((slotK) >> 2) == 2 ? selp[2] : selp[3]), (tokI)) >> (((slotK) & 3) * 8)) & 255u))
#define SEL_ISSUE(tokI, pairP) do { \
                const int k0_ = 2 * (pairP), k1_ = (2 * (pairP) + 1 < nv) ? 2 * (pairP) + 1 : k0_; \
                jbn[0] = __builtin_amdgcn_readfirstlane(SEL_GET(tokI, k0_)); jbn[1] = __builtin_amdgcn_readfirstlane(SEL_GET(tokI, k1_)); \
                _Pragma("unroll") for (int u = 0; u < 2; ++u) { \
                    const unsigned char* kb_ = k8b + (size_t)jbn[u] * 4096; const unsigned char* vb_ = v8b + (size_t)jbn[u] * 4096; \
                    _Pragma("unroll") for (int j = 0; j < 4; ++j) { sk[u][j] = *(const u32x4*)(kb_ + j * 1024 + lane * 16); sv[u][j] = *(const u32x4*)(vb_ + j * 1024 + lane * 16); } \
                    ssk[u] = skb[jbn[u]]; ssv[u] = svb[jbn[u]]; } } while (0)
            SEL_ISSUE(0, 0);
            long qs8[2] = {0, 0};
            float sq = 0.f, ms = NEGBIG, ls = 0.f;
            f32x4 os[4] = {z4, z4, z4, z4};
            u32x2 oprev[4] = {(u32x2){0u, 0u}, (u32x2){0u, 0u}, (u32x2){0u, 0u}, (u32x2){0u, 0u}};
            int i = 0, pp = 0;
            for (int v = 0; v < total; ++v) {
                const int jb0 = jbn[0], jb1 = jbn[1];
                const bool second_valid = (2 * pp + 1 < nv);
                const float ck0 = ssk[0], ck1 = ssk[1], cv0 = ssv[0], cv1 = ssv[1];
#pragma unroll
                for (int u = 0; u < 2; ++u)
#pragma unroll
                    for (int j = 0; j < 4; ++j) {
                        unsigned char* kd = WL + u * 9216 + woff + j * 1152; unsigned char* vd = kd + 4608;
                        *(u32x2*)kd = (u32x2){sk[u][j].x, sk[u][j].y}; *(u32x2*)(kd + 8) = (u32x2){sk[u][j].z, sk[u][j].w};
                        *(u32x2*)vd = (u32x2){sv[u][j].x, sv[u][j].y}; *(u32x2*)(vd + 8) = (u32x2){sv[u][j].z, sv[u][j].w};
                    }
                if (v + 1 < total) {
                    int p2 = pp + 1, i2 = i; if (p2 == npair) { p2 = 0; i2 = i + 1; }
                    SEL_ISSUE(i2, p2);
                }
                __builtin_amdgcn_sched_barrier(0);
                const int ti = t0 + i;
                if (pp == 0) {
                    const size_t tk = (size_t)b * SEQ + ti;
#pragma unroll
                    for (int ks = 0; ks < 2; ++ks) qs8[ks] = *(const long*)(Q8 + tk * 1024 + (g * 4 + rr) * 64 + ks * 32 + fq * 8);
                    sq = SQ8[tk * 16 + g * 4 + rr] * 1.4426950408889634f;
                    ms = NEGBIG; ls = 0.f;
#pragma unroll
                    for (int df = 0; df < 4; ++df) { os[df] = z4; oprev[df] = *(const u32x2*)(O + tk * 1024 + (g * 4 + rr) * 64 + df * 16 + fq * 4); }
                }
                f32x4 st[2][4];
#pragma unroll
                for (int u = 0; u < 2; ++u)
#pragma unroll
                    for (int f = 0; f < 4; ++f) {
                        const unsigned char* kp = WL + u * 9216 + (32 * (f >> 1) + 8 * (fr >> 2) + 4 * (f & 1) + (fr & 3)) * 72 + fq * 8;
                        const long k0 = *(const long*)kp, k1 = *(const long*)(kp + 32);
                        st[u][f] = __builtin_amdgcn_mfma_f32_16x16x32_fp8_fp8(k0, qs8[0], z4, 0, 0, 0);
                        st[u][f] = __builtin_amdgcn_mfma_f32_16x16x32_fp8_fp8(k1, qs8[1], st[u][f], 0, 0, 0);
                    }
                const float c0_ = sq * ck0, c1_ = sq * ck1;
                if (jb0 == cur || jb1 == cur || !second_valid) {
#pragma unroll
                    for (int u = 0; u < 2; ++u) {
                        const int jbu = u ? jb1 : jb0;
                        const bool allbad = (u == 1) && !second_valid;
#pragma unroll
                        for (int f = 0; f < 4; ++f)
#pragma unroll
                            for (int e = 0; e < 4; ++e) { const int key = jbu * 64 + 32 * (f >> 1) + 8 * fq + 4 * (f & 1) + e; if (allbad || key > ti) st[u][f][e] = NEGBIG; }
                    }
                }
                float mx0 = NEGBIG, mx1 = NEGBIG;
#pragma unroll
                for (int f = 0; f < 4; ++f) { mx0 = fmaxf(mx0, fmaxf(fmaxf(st[0][f].x, st[0][f].y), fmaxf(st[0][f].z, st[0][f].w))); mx1 = fmaxf(mx1, fmaxf(fmaxf(st[1][f].x, st[1][f].y), fmaxf(st[1][f].z, st[1][f].w))); }
                const float mxl = fmaxf(mx0 > -1.0e29f ? mx0 * c0_ : NEGBIG, mx1 > -1.0e29f ? mx1 * c1_ : NEGBIG);
                float mn = ms, al = 1.0f;
                if (__builtin_amdgcn_ballot_w64(mxl > ms + 4.0f) != 0ull) {
                    mn = fmaxf(ms, max4(mxl));
                    al = __builtin_amdgcn_exp2f(ms - mn);
                }
                const float off = 4.0f - mn;
                float ps = 0.f;
                long pfw[2][2];
#pragma unroll
                for (int u = 0; u < 2; ++u) {
                    const float cu = u ? c1_ : c0_;
#pragma unroll
                    for (int f = 0; f < 4; ++f)
#pragma unroll
                        for (int e = 0; e < 4; ++e) { const float pv = __builtin_amdgcn_exp2f(st[u][f][e] * cu + off); st[u][f][e] = pv; ps += pv; }
#pragma unroll
                    for (int s = 0; s < 2; ++s) {
                        int w0 = 0, w1 = 0;
                        w0 = __builtin_amdgcn_cvt_pk_fp8_f32(st[u][2 * s].x, st[u][2 * s].y, w0, false); w0 = __builtin_amdgcn_cvt_pk_fp8_f32(st[u][2 * s].z, st[u][2 * s].w, w0, true);
                        w1 = __builtin_amdgcn_cvt_pk_fp8_f32(st[u][2 * s + 1].x, st[u][2 * s + 1].y, w1, false); w1 = __builtin_amdgcn_cvt_pk_fp8_f32(st[u][2 * s + 1].z, st[u][2 * s + 1].w, w1, true);
                        pfw[u][s] = (long)(((unsigned long long)(unsigned)w1 << 32) | (unsigned long long)(unsigned)w0);
                    }
                }
                ls = ls * al + ps; ms = mn;
#pragma unroll
                for (int df = 0; df < 4; ++df) os[df] = os[df] * al;
#pragma unroll
                for (int u = 0; u < 2; ++u) {
                    f32x4 pvacc[4] = {z4, z4, z4, z4};
#pragma unroll
                    for (int s = 0; s < 2; ++s) {
#pragma unroll
                        for (int df = 0; df < 4; ++df) {
                            const long vf = *(const long*)(WL + u * 9216 + 4608 + (df * 16 + fr) * 72 + 32 * s + 8 * fq);
                            pvacc[df] = __builtin_amdgcn_mfma_f32_16x16x32_fp8_fp8(vf, pfw[u][s], pvacc[df], 0, 0, 0);
                        }
                    }
                    const float cvu = u ? cv1 : cv0;
#pragma unroll
                    for (int df = 0; df < 4; ++df) os[df] = os[df] + pvacc[df] * cvu;
                    __builtin_amdgcn_sched_barrier(0);
                }
                if (pp == npair - 1) {
                    const float l = red4(ls);
                    const float gsv = NGT[((size_t)b * SEQ + ti) * 48 + (g * 4 + rr) * 3 + 1];
                    const float sc = gsv / l;
                    if (fr < 4 && !dry) {
                        bf16_t* op = O + ((size_t)b * SEQ + ti) * 1024 + (g * 4 + fr) * 64 + fq * 4;
#pragma unroll
                        for (int df = 0; df < 4; ++df) {
                            const f32x4 val = os[df] * sc; const u32x2 c = oprev[df];
                            *(u32x2*)(op + df * 16) = (u32x2){pk2(bflo(c.x) + val.x, bfhi(c.x) + val.y), pk2(bflo(c.y) + val.z, bfhi(c.y) + val.w)};
                        }
                    }
                }
                ++pp; if (pp == npair) { pp = 0; ++i; }
            }
#undef SEL_GET
#undef SEL_ISSUE
        }
    }
}
constexpr int NPHASES = 18;
#ifndef PROBE_PHASE
#define PROBE_PHASE (-1)
#endif
#ifndef ATT_REP_CMP
#define ATT_REP_CMP 1
#endif
#ifndef ATT_REP_WIN
#define ATT_REP_WIN 1
#endif
#ifndef ATT_REP_SEL
#define ATT_REP_SEL 1
#endif
#ifndef TS_PHASE
#define TS_PHASE (-1)
#endif
#ifndef TS_MULT
#define TS_MULT 4
#endif
#ifndef PROBE_REPS
#define PROBE_REPS 1
#endif
__global__ void __launch_bounds__(NTHREADS, 2) mega(Params p) {
    __shared__ __attribute__((aligned(1024))) unsigned char lds[LDS_BYTES + 16];
    unsigned* bar_st = (unsigned*)(lds + LDS_BYTES);
    cg::grid_group grid = cg::this_grid();
    const float* MOD = (const float*)(p.ws + WS_MOD);
    bf16_t* HM = (bf16_t*)(p.ws + WS_HM);
    if (threadIdx.x < 4) bar_st[threadIdx.x] = 0u;
    __syncthreads();
    XcdBarrier bar = xcd_barrier_post((unsigned*)(p.ws + WS_CTL), (volatile LAS unsigned*)bar_st);
    const int lo = p.ph_lo, hi = p.ph_hi;
    const bool dry0 = (p.ph_hi < 0);
    const int opq = (p.ph_hi < 0) ? 1 : 0;
    const bool never = (p.ph_hi < 0);
    unsigned long long ts_a = 0ull, ts_b = 0ull;
#define PHASE(k, call, drycall) if (lo <= (k) && (k) < hi) { \
        if (TS_PHASE == (k)) ts_a = __builtin_amdgcn_s_memrealtime(); \
        if (PROBE_PHASE == (k)) { for (int rep = 0; rep < PROBE_REPS; ++rep) { const bool dry = !dry0; drycall; __syncthreads(); } } \
        { const bool dry = dry0; call; } \
        if ((k) + 1 < hi) { if (never) grid.sync(); else xcd_barrier(bar); } \
        if (TS_PHASE == (k)) ts_b = __builtin_amdgcn_s_memrealtime(); }
    PHASE(0, phase_prep(p, (float*)lds, 0), phase_prep(p, (float*)lds, 0))
    PHASE(1, phase_norm(p, p.in[0], p.in[2], MOD + 0, MOD + 1024, HM), phase_norm(p, p.in[0], p.in[2], MOD + 0, MOD + 1024, HM))
    PHASE(2, phase_s5_win(p, lds), phase_s5_win(p, lds))
    PHASE(3, phase_s5_a(p, lds), phase_s5_a(p, lds))
    PHASE(4, (phase_s5_scan(p), phase_prep(p, (float*)lds, 1)), (phase_s5_scan(p), phase_prep(p, (float*)lds, 1)))
    PHASE(5, phase_s5_b(p, lds), phase_s5_b(p, lds))
    PHASE(6, phase_s5_glu(p, lds), phase_s5_glu(p, lds))
    PHASE(7, phase_norm(p, p.out, p.in[3], MOD + 3072, MOD + 4096, HM), phase_norm(p, p.out, p.in[3], MOD + 3072, MOD + 4096, HM))
    PHASE(8, phase_peer_route(p, 0, lds), phase_peer_route(p, 0, lds))
    PHASE(9, phase_peer_apply(p, 0, lds, dry), phase_peer_apply(p, 0, lds, dry))
    PHASE(10, phase_nsa_proj(p, lds), phase_nsa_proj(p, lds))
    PHASE(11, (phase_nsa_cmp1(p, lds), phase_tab1(p)), (phase_nsa_cmp1(p, lds), phase_tab1(p)))
    PHASE(12, phase_nsa_cmp2(p, lds), phase_nsa_cmp2(p, lds))
    PHASE(13, phase_nsa_attn(p, lds, ATT_REP_CMP + opq, ATT_REP_WIN + opq, ATT_REP_SEL + opq), phase_nsa_attn(p, lds, 1 + opq, 1 + opq, 1 + opq))
    PHASE(14, phase_nsa_wo(p, lds, dry), phase_nsa_wo(p, lds, dry))
    PHASE(15, phase_norm(p, p.out, p.in[3] + D, MOD + 2 * 6144 + 3072, MOD + 2 * 6144 + 4096, HM), phase_norm(p, p.out, p.in[3] + D, MOD + 2 * 6144 + 3072, MOD + 2 * 6144 + 4096, HM))
    PHASE(16, phase_peer_route(p, 1, lds), phase_peer_route(p, 1, lds))
    PHASE(17, phase_peer_apply(p, 1, lds, dry), phase_peer_apply(p, 1, lds, dry))
#undef PHASE
    if (TS_PHASE >= 0 && blockIdx.x == 0 && threadIdx.x == 0) {
        const unsigned long long t0 = __builtin_amdgcn_s_memrealtime(), want = (ts_b - ts_a) * TS_MULT;
        while (__builtin_amdgcn_s_memrealtime() - t0 < want) __builtin_amdgcn_s_sleep(8);
    }
}

extern "C" void kernel_launch(void* const* d_in, const int* in_sizes, int n_in, void* d_out, int out_size, void* d_ws, size_t ws_size, hipStream_t stream) {
    static int grid_blocks = 0;
    if (!grid_blocks) {
        int dev = 0, cus = 0, per_cu = 0;
        hipGetDevice(&dev);
        hipDeviceGetAttribute(&cus, hipDeviceAttributeMultiprocessorCount, dev);
        hipOccupancyMaxActiveBlocksPerMultiprocessor(&per_cu, mega, NTHREADS, 0);
        if (per_cu > 2) per_cu = 2;
        if (per_cu < 1) per_cu = 1;
        grid_blocks = cus * per_cu;
        if (ws_size < WS_END) fprintf(stderr, "kernel_launch: workspace too small: %zu < %zu\n", ws_size, (size_t)WS_END);
        if (n_in != 29) fprintf(stderr, "kernel_launch: expected 29 inputs, got %d\n", n_in);
    }
    hipMemsetAsync((unsigned char*)d_ws + WS_CTL, 0, 16384, stream);
    Params p{};
    for (int i = 0; i < 29; ++i) p.in[i] = (const float*)d_in[i];
    p.out = (float*)d_out; p.ws = (unsigned char*)d_ws;
#if SINGLE_LAUNCH
    p.ph_lo = 0; p.ph_hi = NPHASES;
    void* args[] = {&p};
    hipError_t e = hipLaunchCooperativeKernel((void*)mega, dim3(grid_blocks), dim3(NTHREADS), args, 0, stream);
    if (e != hipSuccess) fprintf(stderr, "cooperative launch failed: %s (grid %d)\n", hipGetErrorString(e), grid_blocks);
#else
    for (int ph = 0; ph < NPHASES; ++ph) {
        p.ph_lo = ph; p.ph_hi = ph + 1;
        hipLaunchKernelGGL(mega, dim3(grid_blocks), dim3(NTHREADS), 0, stream, p);
    }
#endif
}
```

```cpp
#include <hip/hip_runtime.h>
#include <hip/hip_cooperative_groups.h>
#include <cstdio>
#include <cstdint>
namespace cg = cooperative_groups;

#ifndef SINGLE_LAUNCH
#define SINGLE_LAUNCH 1
#endif

typedef unsigned short bf16_t;
typedef short bf16x8 __attribute__((ext_vector_type(8)));
typedef float f32x4 __attribute__((ext_vector_type(4)));
typedef float f32x2 __attribute__((ext_vector_type(2)));
typedef unsigned u32x4 __attribute__((ext_vector_type(4)));
typedef unsigned u32x2 __attribute__((ext_vector_type(2)));
typedef __bf16 bf16x2_t __attribute__((ext_vector_type(2)));

constexpr int D = 1024, BATCH = 2, SEQ = 16384, T = BATCH * SEQ;
constexpr int NTHREADS = 256;
constexpr float RMS_EPS = 1e-6f;
constexpr int S5G = 64, S5P = 64, S5L = 32, S5NCH = T / S5L  , S5CPB = SEQ / S5L  ;
constexpr int NH = 16, HD = 64, NG = 4, NPROJ = 2608, NPROJ_PAD = 2688, NC = 1023, NSB = 256;
constexpr int PH = 8, PK = 16, PNK = 128, PE = 16384;

constexpr size_t MiB = 1ull << 20;
constexpr size_t WS_CTL = 0;
constexpr size_t WS_MOD = 1 * MiB;
constexpr size_t WS_WIN_T = 2 * MiB;
constexpr size_t WS_WGLU_T = 4 * MiB;
constexpr size_t WS_WPROJ_T = 8 * MiB;
constexpr size_t WS_WK1_T = 14 * MiB;
constexpr size_t WS_WV1_T = 15 * MiB;
constexpr size_t WS_WK2_T = 16 * MiB;
constexpr size_t WS_WV2_T = 16 * MiB + 512 * 1024;
constexpr size_t WS_WO_T = 17 * MiB;
constexpr size_t WS_WQ_T = 19 * MiB;
constexpr size_t WS_SUBK = 27 * MiB;
constexpr size_t WS_ROPE = 28 * MiB;
constexpr size_t WS_MISC = 32 * MiB;
constexpr size_t WS_TW = 33 * MiB;
constexpr size_t WS_VG = 73 * MiB;
constexpr size_t WS_PU = 82 * MiB;
constexpr size_t WS_PV = 114 * MiB;
constexpr size_t WS_HM = 146 * MiB;
constexpr size_t WS_C = 210 * MiB;
constexpr size_t WS_UG = WS_C;
constexpr size_t WS_YI = WS_C + 64 * MiB;
constexpr size_t WS_WST = WS_C + 128 * MiB;
constexpr size_t WS_SST = WS_C + 160 * MiB;
constexpr size_t WS_YG = WS_C + 176 * MiB;
constexpr size_t WS_QK = WS_C;
constexpr size_t WS_TOPS = WS_C + 128 * MiB;
constexpr size_t WS_TOPI = WS_C + 160 * MiB;
constexpr size_t WS_EXP = WS_C + 192 * MiB;
constexpr size_t WS_GATE = WS_C + 208 * MiB;
constexpr size_t WS_ACT = WS_C + 224 * MiB;
constexpr size_t WS_Q = WS_C;
constexpr size_t WS_KC = WS_C + 64 * MiB;
constexpr size_t WS_VC = WS_C + 81 * MiB;
constexpr size_t WS_KS = WS_C + 98 * MiB;
constexpr size_t WS_VST = WS_C + 114 * MiB;
constexpr size_t WS_KW = WS_C + 130 * MiB;
constexpr size_t WS_VWT = WS_C + 146 * MiB;
constexpr size_t WS_NG = WS_C + 162 * MiB;
constexpr size_t WS_KCMP = WS_C + 170 * MiB;
constexpr size_t WS_VCMPT = WS_C + 171 * MiB;
constexpr size_t WS_HID = WS_C + 172 * MiB;
constexpr size_t WS_O = WS_C + 182 * MiB;
constexpr size_t WS_Q8 = WS_C + 246 * MiB;
constexpr size_t WS_END = WS_C + 282 * MiB;

constexpr int LDS_BYTES = 74240;

struct Params {
    const float* in[29];
    float* out;
    unsigned char* ws;
    int ph_lo, ph_hi;
};

__device__ __forceinline__ unsigned f2bf(float f) { unsigned u = __builtin_bit_cast(unsigned, f); return (u + 0x7fffu + ((u >> 16) & 1u)) >> 16; }
__device__ __forceinline__ unsigned pk2(float lo, float hi) { return f2bf(lo) | (f2bf(hi) << 16); }
__device__ __forceinline__ float bf2f(unsigned h) { return __builtin_bit_cast(float, h << 16); }
__device__ __forceinline__ float bflo(unsigned w) { return __builtin_bit_cast(float, w << 16); }
__device__ __forceinline__ float bfhi(unsigned w) { return __builtin_bit_cast(float, w & 0xffff0000u); }
__device__ __forceinline__ float gelu_tanh(float x) {
    const float u = 0.7978845608028654f * (x + 0.044715f * x * x * x);
    const float e = __expf(2.0f * u);
    const float th = 1.0f - 2.0f / (e + 1.0f);
    return 0.5f * x * (1.0f + th);
}
__device__ __forceinline__ float sigmoidf_(float x) { return 1.0f / (1.0f + __expf(-x)); }
__device__ __forceinline__ float wave_sum(float v) {
#pragma unroll
    for (int o = 1; o < 64; o <<= 1) v += __shfl_xor(v, o);
    return v;
}
__device__ __forceinline__ float dot2bf(unsigned a, unsigned b, float acc) {
    return __builtin_amdgcn_fdot2_f32_bf16(__builtin_bit_cast(bf16x2_t, a), __builtin_bit_cast(bf16x2_t, b), acc, false);
}

#define LAS __attribute__((address_space(3)))
#define XB_TMO      128
#define XB_XCNT(j)  (256  + 64 * (j))
#define XB_XSUB(j)  (1280 + 64 * (j))
#define XB_XGEN(j)  (2304 + 64 * (j))
#define XB_TOP      3328
#define XB_TOPGEN   3392
#define XCD_BAR_WORDS 3456
#define XB_SPIN_CAP (1u << 24)

__device__ __forceinline__ unsigned xb_ld(unsigned* p)              { return __hip_atomic_load(p, __ATOMIC_RELAXED, __HIP_MEMORY_SCOPE_AGENT); }
__device__ __forceinline__ unsigned xb_add(unsigned* p, unsigned v) { return __hip_atomic_fetch_add(p, v, __ATOMIC_RELAXED, __HIP_MEMORY_SCOPE_AGENT); }
__device__ __forceinline__ unsigned xb_xcc_id() { return (unsigned)__builtin_amdgcn_s_getreg((3 << 11) | 20) & 0xFu; }
#define XB_SPIN(cond, bar) do { unsigned _sp = 0; while (cond) { __builtin_amdgcn_s_sleep(1); \
    if ((++_sp & 255u) == 0u) { if (xb_ld(&(bar)[XB_TMO])) break; if (_sp > XB_SPIN_CAP) { atomicAdd(&(bar)[XB_TMO], 1u); break; } } } } while (0)

struct XcdBarrier {
    unsigned* bar; unsigned x;
    volatile LAS unsigned* st;
};

__device__ __forceinline__ XcdBarrier xcd_barrier_post(unsigned* bar, volatile LAS unsigned* st) {
    XcdBarrier b; b.bar = bar; b.x = xb_xcc_id(); b.st = st;
    if (threadIdx.x == 0) (void)xb_add(&bar[XB_XCNT(b.x)], 1u);
    return b;
}
__device__ __forceinline__ void xcd_barrier_complete(unsigned* bar, unsigned x, unsigned& nloc, unsigned& nx) {
    const unsigned G = gridDim.x * gridDim.y * gridDim.z;
    unsigned sum, cnt, mine, sp = 0u;
    for (;;) {
        sum = 0u; cnt = 0u; mine = 0u;
#pragma unroll
        for (unsigned j = 0; j < 16; ++j) { const unsigned c = xb_ld(&bar[XB_XCNT(j)]); sum += c; cnt += (c > 0u) ? 1u : 0u; mine = (j == x) ? c : mine; }
        if (sum == G) break;
        __builtin_amdgcn_s_sleep(1);
        if ((++sp & 255u) == 0u) { if (xb_ld(&bar[XB_TMO])) break; if (sp > XB_SPIN_CAP) { atomicAdd(&bar[XB_TMO], 1u); break; } }
    }
    nloc = mine > 0u ? mine : 1u; nx = cnt > 0u ? cnt : 1u;
}

__device__ __forceinline__ void xcd_barrier(const XcdBarrier& b) {
    asm volatile("s_waitcnt vmcnt(0)" ::: "memory");
    __syncthreads();
    if (threadIdx.x == 0) {
        unsigned* bar = b.bar;
        __builtin_amdgcn_s_waitcnt(0);
        unsigned nloc = b.st[0], nx = b.st[1];
        if (nloc == 0u) { xcd_barrier_complete(bar, b.x, nloc, nx); b.st[0] = nloc; b.st[1] = nx; }
        const unsigned old = xb_add(&bar[XB_XSUB(b.x)], 1u);
        const unsigned gen = old / nloc;
        if (old + 1u == (gen + 1u) * nloc) {
            __builtin_amdgcn_fence(__ATOMIC_RELEASE, "agent");
            asm volatile("s_waitcnt vmcnt(0)" ::: "memory");
            const unsigned og = xb_add(&bar[XB_TOP], 1u);
            const unsigned tg = og / nx;
            if (og + 1u == (tg + 1u) * nx) xb_add(&bar[XB_TOPGEN], 1u);
            else XB_SPIN(xb_ld(&bar[XB_TOPGEN]) == tg, bar);
            __builtin_amdgcn_fence(__ATOMIC_ACQUIRE, "agent");
            xb_add(&bar[XB_XGEN(b.x)], 1u);
            asm volatile("s_waitcnt vmcnt(0)" ::: "memory");
        } else {
            XB_SPIN(xb_ld(&bar[XB_XGEN(b.x)]) == gen, bar);
            __builtin_amdgcn_fence(__ATOMIC_ACQUIRE, "agent");
            asm volatile("s_waitcnt vmcnt(0)" ::: "memory");
        }
    }
    __syncthreads();
}
__device__ __forceinline__ void prep_mod_item(const Params& p, int item, float* lds) {
    const int layer = item / 192, cg0 = (item % 192) * 32;
    const int tid = threadIdx.x, col = cg0 + (tid & 31), kg = tid >> 5;
    const float* W = p.in[4] + (size_t)layer * D * 6 * D + col;
    const float* c = p.in[1];
    float* cact = lds + 512;
#pragma unroll
    for (int i = 0; i < 8; ++i) { const int q = tid + 256 * i; const float v = c[q]; cact[q] = v * sigmoidf_(v); }
    __syncthreads();
    float a0 = 0.f, a1 = 0.f;
    for (int k0 = kg * 128; k0 < kg * 128 + 128; k0 += 16) {
        float w[16];
#pragma unroll
        for (int u = 0; u < 16; ++u) w[u] = W[(size_t)(k0 + u) * (6 * D)];
#pragma unroll
        for (int u = 0; u < 16; ++u) { a0 += w[u] * cact[k0 + u]; a1 += w[u] * cact[1024 + k0 + u]; }
    }
    lds[tid] = a0; lds[256 + tid] = a1;
    __syncthreads();
    if (tid < 64) {
        const int b = tid >> 5, cc = tid & 31;
        float s = 0.f;
#pragma unroll
        for (int g = 0; g < 8; ++g) s += lds[b * 256 + g * 32 + cc];
        float* MOD = (float*)(p.ws + WS_MOD);
        MOD[(size_t)(layer * 2 + b) * 6144 + cg0 + cc] = s + p.in[5][(size_t)layer * 6144 + cg0 + cc];
    }
    __syncthreads();
}

template <int MODE>
__device__ __forceinline__ void prep_transpose_item(const float* W, int K, int N, bf16_t* WT, int item, float* lds) {
    const int nbn = (N + 63) / 64, kb = item / nbn, nb = item % nbn, k0 = kb * 64, n0 = nb * 64;
    const int tid = threadIdx.x;
#pragma unroll
    for (int i = 0; i < 16; ++i) {
        const int kk = (tid >> 6) + 4 * i, nn = tid & 63;
        const float v = (n0 + nn < N) ? W[(size_t)(k0 + kk) * N + n0 + nn] : 0.f;
        lds[kk * 65 + nn] = v;
    }
    __syncthreads();
    {
        const int nn = tid >> 2, ks = (tid & 3) * 16;
        const int n = n0 + nn;
        if (n < N) {
            int np = n;
            if (MODE == 1) { const int j = (n < 1024) ? n : n - 1024; np = (j >> 4) * 32 + (j & 15) + ((n < 1024) ? 0 : 16); }
            u32x4 o0, o1;
            const float* s = lds + nn;
            o0.x = pk2(s[(ks + 0) * 65], s[(ks + 1) * 65]); o0.y = pk2(s[(ks + 2) * 65], s[(ks + 3) * 65]);
            o0.z = pk2(s[(ks + 4) * 65], s[(ks + 5) * 65]); o0.w = pk2(s[(ks + 6) * 65], s[(ks + 7) * 65]);
            o1.x = pk2(s[(ks + 8) * 65], s[(ks + 9) * 65]); o1.y = pk2(s[(ks + 10) * 65], s[(ks + 11) * 65]);
            o1.z = pk2(s[(ks + 12) * 65], s[(ks + 13) * 65]); o1.w = pk2(s[(ks + 14) * 65], s[(ks + 15) * 65]);
            u32x4* dst = (u32x4*)(WT + (size_t)np * K + k0 + ks);
            dst[0] = o0; dst[1] = o1;
        }
    }
    __syncthreads();
}

__device__ __forceinline__ void cvt_item(const float* src, bf16_t* dst, int item) {
    const size_t base = (size_t)item * 8192 + threadIdx.x * 8;
#pragma unroll
    for (int i = 0; i < 4; ++i) {
        const size_t o = base + (size_t)i * 2048;
        const f32x4 a = *(const f32x4*)(src + o), b = *(const f32x4*)(src + o + 4);
        u32x4 w; w.x = pk2(a.x, a.y); w.y = pk2(a.z, a.w); w.z = pk2(b.x, b.y); w.w = pk2(b.z, b.w);
        *(u32x4*)(dst + o) = w;
    }
}
__device__ __forceinline__ void zero_item(bf16_t* dst, int item) {
    const size_t base = (size_t)item * 8192 + threadIdx.x * 8;
#pragma unroll
    for (int i = 0; i < 4; ++i) *(u32x4*)(dst + base + (size_t)i * 2048) = (u32x4){0u, 0u, 0u, 0u};
}

struct cpx { float re, im; };
__device__ __forceinline__ cpx cmul(cpx a, cpx b) { return {a.re * b.re - a.im * b.im, a.re * b.im + a.im * b.re}; }
__device__ __forceinline__ cpx cexp_pow(float are, float aim, float dt, int m) {
    const float mag = __expf(are * dt * (float)m);
    const double rev = (double)aim * (double)dt * (double)m * 0.15915494309189535;
    const float fr = (float)(rev - rint(rev));
    return {mag * __builtin_amdgcn_cosf(fr), mag * __builtin_amdgcn_sinf(fr)};
}
__device__ __forceinline__ cpx s5_coef(float are, float aim, float dt) {
    cpx ab = cexp_pow(are, aim, dt, 1);
    const float nr = ab.re - 1.0f, ni = ab.im, den = are * are + aim * aim;
    return {(nr * are + ni * aim) / den, (ni * are - nr * aim) / den};
}

__device__ __forceinline__ void prep_s5_T_item(const Params& p, int item) {
    const int gid = item * 256 + threadIdx.x;
    const int g = gid >> 9, m = (gid >> 4) & 31, i = gid & 15;
    const float* a_re = p.in[7] + g * 64; const float* a_im = p.in[8] + g * 64;
    const float dt = __expf(p.in[9][g]);
    const float* b_re = p.in[10] + (size_t)g * 64 * 16; const float* b_im = p.in[11] + (size_t)g * 64 * 16;
    const float* c_re = p.in[12] + (size_t)g * 16 * 64 + i * 64; const float* c_im = p.in[13] + (size_t)g * 16 * 64 + i * 64;
    float acc[16];
#pragma unroll
    for (int j = 0; j < 16; ++j) acc[j] = 0.f;
    for (int q = 0; q < 64; ++q) {
        const float are = a_re[q], aim = a_im[q];
        cpx z = cmul(cmul({c_re[q], c_im[q]}, cexp_pow(are, aim, dt, m)), s5_coef(are, aim, dt));
        const f32x4* br = (const f32x4*)(b_re + q * 16); const f32x4* bi = (const f32x4*)(b_im + q * 16);
#pragma unroll
        for (int j4 = 0; j4 < 4; ++j4) {
            const f32x4 r = br[j4], im = bi[j4];
            acc[j4 * 4 + 0] += z.re * r.x - z.im * im.x; acc[j4 * 4 + 1] += z.re * r.y - z.im * im.y;
            acc[j4 * 4 + 2] += z.re * r.z - z.im * im.z; acc[j4 * 4 + 3] += z.re * r.w - z.im * im.w;
        }
    }
    u32x4 o0, o1;
    o0.x = pk2(acc[0], acc[1]); o0.y = pk2(acc[2], acc[3]); o0.z = pk2(acc[4], acc[5]); o0.w = pk2(acc[6], acc[7]);
    o1.x = pk2(acc[8], acc[9]); o1.y = pk2(acc[10], acc[11]); o1.z = pk2(acc[12], acc[13]); o1.w = pk2(acc[14], acc[15]);
    bf16_t* TW = (bf16_t*)(p.ws + WS_TW) + (size_t)g * 640 * 512;
    const u32x4 z4 = (u32x4){0u, 0u, 0u, 0u};
    for (int lp = 0; lp + m < 32; ++lp) {
        u32x4* d = (u32x4*)(TW + (size_t)((lp + m) * 16 + i) * 512 + lp * 16);
        d[0] = o0; d[1] = o1;
        if (m > 0) { u32x4* dz = (u32x4*)(TW + (size_t)(lp * 16 + i) * 512 + (lp + m) * 16); dz[0] = z4; dz[1] = z4; }
    }
}
__device__ __forceinline__ void prep_s5_W_item(const Params& p, int item) {
    const int gid = item * 256 + threadIdx.x;
    const int g = gid >> 11, q = (gid >> 5) & 63, lp = gid & 31;
    const float are = p.in[7][g * 64 + q], aim = p.in[8][g * 64 + q];
    const float dt = __expf(p.in[9][g]);
    const cpx z = cmul(cexp_pow(are, aim, dt, 31 - lp), s5_coef(are, aim, dt));
    const float* br = p.in[10] + ((size_t)g * 64 + q) * 16; const float* bi = p.in[11] + ((size_t)g * 64 + q) * 16;
    float wr[16], wi[16];
#pragma unroll
    for (int j = 0; j < 16; ++j) { wr[j] = z.re * br[j] - z.im * bi[j]; wi[j] = z.re * bi[j] + z.im * br[j]; }
    bf16_t* TW = (bf16_t*)(p.ws + WS_TW) + (size_t)g * 640 * 512;
    u32x4* d0 = (u32x4*)(TW + (size_t)(512 + q) * 512 + lp * 16);
    u32x4* d1 = (u32x4*)(TW + (size_t)(576 + q) * 512 + lp * 16);
    d0[0] = (u32x4){pk2(wr[0], wr[1]), pk2(wr[2], wr[3]), pk2(wr[4], wr[5]), pk2(wr[6], wr[7])};
    d0[1] = (u32x4){pk2(wr[8], wr[9]), pk2(wr[10], wr[11]), pk2(wr[12], wr[13]), pk2(wr[14], wr[15])};
    d1[0] = (u32x4){pk2(wi[0], wi[1]), pk2(wi[2], wi[3]), pk2(wi[4], wi[5]), pk2(wi[6], wi[7])};
    d1[1] = (u32x4){pk2(wi[8], wi[9]), pk2(wi[10], wi[11]), pk2(wi[12], wi[13]), pk2(wi[14], wi[15])};
}
__device__ __forceinline__ void prep_s5_V_item(const Params& p, int item) {
    const int gid = item * 256 + threadIdx.x;
    const int g = gid >> 14, l = (gid >> 9) & 31, i = (gid >> 5) & 15, q0 = (gid & 31) * 2;
    const float dt = __expf(p.in[9][g]);
    float vr[2], vi[2];
#pragma unroll
    for (int e = 0; e < 2; ++e) {
        const int q = q0 + e;
        const cpx z = cmul({p.in[12][((size_t)g * 16 + i) * 64 + q], p.in[13][((size_t)g * 16 + i) * 64 + q]}, cexp_pow(p.in[7][g * 64 + q], p.in[8][g * 64 + q], dt, l + 1));
        vr[e] = z.re; vi[e] = -z.im;
    }
    bf16_t* VG = (bf16_t*)(p.ws + WS_VG) + ((size_t)g * 512 + l * 16 + i) * 128;
    *(unsigned*)(VG + q0) = pk2(vr[0], vr[1]);
    *(unsigned*)(VG + 64 + q0) = pk2(vi[0], vi[1]);
}
__device__ __forceinline__ void prep_al_item(const Params& p, int item) {
    const int gid = item * 256 + threadIdx.x;
    const int g = gid >> 6;
    const float dt = __expf(p.in[9][g]);
    const cpx z = cexp_pow(p.in[7][gid], p.in[8][gid], dt, S5L);
    f32x2* AL = (f32x2*)(p.ws + WS_MISC + 4096);
    AL[gid] = (f32x2){z.re, z.im};
}
__device__ __forceinline__ void prep_rope_item(const Params& p, int item) {
    const int gid = item * 256 + threadIdx.x;
    const int pos = gid >> 5, j = gid & 31;
    const float freq = exp2f(-(float)j * (13.287712379549449f / 32.0f));
    const float ang = (float)pos * freq;
    const double rev = (double)ang * 0.15915494309189535;
    const float fr = (float)(rev - rint(rev));
    f32x2* R = (f32x2*)(p.ws + WS_ROPE);
    R[gid] = (f32x2){__builtin_amdgcn_cosf(fr), __builtin_amdgcn_sinf(fr)};
}
__device__ __forceinline__ void prep_cmpbias_item(const Params& p, int item, float* lds) {
    const int kv = item >> 3, cg0 = (item & 7) * 32;
    const float* pe = p.in[17 + kv]; const float* w1 = p.in[kv == 0 ? 19 : 21];
    const int tid = threadIdx.x, col = cg0 + (tid & 31), kg = tid >> 5;
    float s = 0.f;
#pragma unroll 8
    for (int k = kg * 256; k < kg * 256 + 256; ++k) s += pe[k] * w1[(size_t)k * 256 + col];
    lds[tid] = s;
    __syncthreads();
    if (tid < 32) {
        float t = 0.f;
#pragma unroll
        for (int q = 0; q < 8; ++q) t += lds[q * 32 + tid];
        ((float*)(p.ws + WS_MISC))[kv * 256 + cg0 + tid] = t;
    }
    __syncthreads();
}

__device__ __forceinline__ void cvt_fp8_item(const float* src, unsigned char* dst, float* inv_scale, int item, const bool slice_major) {
    const int lane = threadIdx.x & 63, row0 = item * 16 + (threadIdx.x >> 6) * 4;
    f32x4 v[4][4];
#pragma unroll
    for (int r = 0; r < 4; ++r) {
        const f32x4* sp = (const f32x4*)(src + (size_t)(row0 + r) * D + lane * 16);
#pragma unroll
        for (int q = 0; q < 4; ++q) v[r][q] = sp[q];
    }
#pragma unroll
    for (int r = 0; r < 4; ++r) {
        float m = 0.f;
#pragma unroll
        for (int q = 0; q < 4; ++q) m = fmaxf(m, fmaxf(fmaxf(fabsf(v[r][q].x), fabsf(v[r][q].y)), fmaxf(fabsf(v[r][q].z), fabsf(v[r][q].w))));
#pragma unroll
        for (int o = 1; o < 64; o <<= 1) m = fmaxf(m, __shfl_xor(m, o));
        const float sc = m > 0.f ? 224.0f / m : 1.0f;
        unsigned w[4];
#pragma unroll
        for (int q = 0; q < 4; ++q) { int t = 0; t = __builtin_amdgcn_cvt_pk_fp8_f32(v[r][q].x * sc, v[r][q].y * sc, t, false); t = __builtin_amdgcn_cvt_pk_fp8_f32(v[r][q].z * sc, v[r][q].w * sc, t, true); w[q] = (unsigned)t; }
        const int row = row0 + r;
        const u32x4 wv = (u32x4){w[0], w[1], w[2], w[3]};
        if (slice_major) *(u32x4*)(dst + (size_t)(lane >> 3) * (PE * 128) + (size_t)row * 128 + (lane & 7) * 16) = wv;
        else *(u32x4*)(dst + (size_t)row * D + lane * 16) = wv;
        if (lane == 0) inv_scale[row] = m > 0.f ? m / 224.0f : 1.0f;
    }
}
constexpr int P0_MOD = 384;
constexpr int P0_T_WIN = 16 * 16, P0_T_WGLU = 16 * 32, P0_T_WPROJ = 16 * 41, P0_T_WK1 = 32 * 4, P0_T_WK2 = 4 * 1, P0_T_WO = 16 * 16, P0_T_WQ = 16 * 32;
constexpr int P0_SUBK = (2 * 8 * 2 * 128 * 128) / 8192;
constexpr int P0_TAB = PE / 16;
constexpr int P0_S5T = 128, P0_S5W = 512, P0_S5V = 4096, P0_AL = 16, P0_ROPE = 2048, P0_CB = 16, P0_ZERO = 10 + 2;

__device__ __forceinline__ void phase_prep(const Params& p, float* lds, const int part) {
    const int n0 = P0_MOD;
    const int n1 = n0 + P0_T_WIN, n2 = n1 + P0_T_WGLU, n3 = n2 + P0_T_WPROJ, n4 = n3 + P0_T_WK1, n5 = n4 + P0_T_WK1, n6 = n5 + P0_T_WK2, n7 = n6 + P0_T_WK2,
              n8 = n7 + P0_T_WO, n9 = n8 + P0_T_WQ, n10 = n9 + P0_T_WQ, n11 = n10 + P0_SUBK, n12 = n11 + P0_TAB, n13 = n12 + P0_TAB,
              n14 = n13 + P0_S5T, n15 = n14 + P0_S5W, n16 = n15 + P0_S5V, n17 = n16 + P0_AL, n18 = n17 + P0_ROPE, n19 = n18 + P0_CB, n20 = n19 + 10, n21 = n20 + 2, n22 = n21 + 2;
    unsigned char* ws = p.ws;
#ifndef PREP_DUP_LO
#define PREP_DUP_LO 0
#define PREP_DUP_HI 0
#endif
    const int dupn = (PREP_DUP_HI) - (PREP_DUP_LO);
    const int nB = (n8 - n2) + (n10 - n9) + (n22 - n17);
    const int first = part == 0 ? (int)blockIdx.x : (int)blockIdx.x - 32, stride = part == 0 ? (int)gridDim.x : (int)gridDim.x - 32;
    if (first < 0 || stride <= 0) return;
    const int total = part == 0 ? (n22 - nB) + dupn : nB;
    for (int it0 = first; it0 < total; it0 += stride) {
        int it;
        if (part == 0) {
            it = it0;
            if (it >= n2) it += (n8 - n2);
            if (it >= n9) it += (n10 - n9);
            if (it0 >= (n22 - nB)) it = (PREP_DUP_LO) + (it0 - (n22 - nB));
        } else {
            it = n2 + it0;
            if (it >= n8) it += (n9 - n8);
            if (it >= n10) it += (n17 - n10);
        }
        if (it < n0) prep_mod_item(p, it, lds);
        else if (it < n1) prep_transpose_item<0>(p.in[6], 1024, 1024, (bf16_t*)(ws + WS_WIN_T), it - n0, lds);
        else if (it < n2) prep_transpose_item<1>(p.in[15], 1024, 2048, (bf16_t*)(ws + WS_WGLU_T), it - n1, lds);
        else if (it < n3) prep_transpose_item<0>(p.in[16], 1024, NPROJ, (bf16_t*)(ws + WS_WPROJ_T), it - n2, lds);
        else if (it < n4) prep_transpose_item<0>(p.in[19], 2048, 256, (bf16_t*)(ws + WS_WK1_T), it - n3, lds);
        else if (it < n5) prep_transpose_item<0>(p.in[21], 2048, 256, (bf16_t*)(ws + WS_WV1_T), it - n4, lds);
        else if (it < n6) prep_transpose_item<0>(p.in[20], 256, 64, (bf16_t*)(ws + WS_WK2_T), it - n5, lds);
        else if (it < n7) prep_transpose_item<0>(p.in[22], 256, 64, (bf16_t*)(ws + WS_WV2_T), it - n6, lds);
        else if (it < n8) prep_transpose_item<0>(p.in[23], 1024, 1024, (bf16_t*)(ws + WS_WO_T), it - n7, lds);
        else if (it < n9) prep_transpose_item<0>(p.in[24], 1024, 2048, (bf16_t*)(ws + WS_WQ_T), it - n8, lds);
        else if (it < n10) prep_transpose_item<0>(p.in[24] + (size_t)1024 * 2048, 1024, 2048, (bf16_t*)(ws + WS_WQ_T) + (size_t)2048 * 1024, it - n9, lds);
        else if (it < n11) cvt_item(p.in[25], (bf16_t*)(ws + WS_SUBK), it - n10);
        else if (it < n12) cvt_fp8_item(p.in[26], ws + WS_PU, (float*)(ws + WS_PU + 24 * MiB), it - n11, false);
        else if (it < n13) cvt_fp8_item(p.in[27], ws + WS_PV, (float*)(ws + WS_PV + 24 * MiB), it - n12, false);
        else if (it < n14) prep_s5_T_item(p, it - n13);
        else if (it < n15) prep_s5_W_item(p, it - n14);
        else if (it < n16) prep_s5_V_item(p, it - n15);
        else if (it < n17) prep_al_item(p, it - n16);
        else if (it < n18) prep_rope_item(p, it - n17);
        else if (it < n19) prep_cmpbias_item(p, it - n18, lds);
        else if (it < n20) zero_item((bf16_t*)(ws + WS_WPROJ_T) + (size_t)NPROJ * 1024, it - n19);
        else if (it < n21) zero_item((bf16_t*)(ws + WS_WK2_T) + (size_t)64 * 256, it - n20);
        else zero_item((bf16_t*)(ws + WS_WV2_T) + (size_t)64 * 256, it - n21);
    }
}

__device__ __forceinline__ void phase_norm(const Params& p, const float* X, const float* gw, const float* shift, const float* scale  , bf16_t* HM) {
    const int lane = threadIdx.x & 63, wave = threadIdx.x >> 6;
    for (int row = blockIdx.x * 4 + wave; row < T; row += gridDim.x * 4) {
        const int b = row / SEQ;
        const f32x4* xr = (const f32x4*)(X + (size_t)row * D) + lane;
        f32x4 v[4]; float s = 0.f;
#pragma unroll
        for (int j = 0; j < 4; ++j) { v[j] = xr[64 * j]; s += (v[j].x * v[j].x + v[j].y * v[j].y) + (v[j].z * v[j].z + v[j].w * v[j].w); }
        const float rs = rsqrtf(wave_sum(s) * (1.0f / D) + RMS_EPS);
        u32x2* o = (u32x2*)(HM + (size_t)row * D) + lane;
#pragma unroll
        for (int j = 0; j < 4; ++j) {
            const int c = lane * 4 + 256 * j;
            const f32x4 g = *(const f32x4*)(gw + c), sh = *(const f32x4*)(shift + (size_t)b * 6144 + c), sc = *(const f32x4*)(scale + (size_t)b * 6144 + c);
            const float y0 = v[j].x * rs * g.x * (1.f + sc.x) + sh.x, y1 = v[j].y * rs * g.y * (1.f + sc.y) + sh.y;
            const float y2 = v[j].z * rs * g.z * (1.f + sc.z) + sh.z, y3 = v[j].w * rs * g.w * (1.f + sc.w) + sh.w;
            o[64 * j] = (u32x2){pk2(y0, y1), pk2(y2, y3)};
        }
    }
}
__device__ __forceinline__ void phase_final_norm(const Params& p, const float* X, float* OUT, bool dry) {
    const int lane = threadIdx.x & 63, wave = threadIdx.x >> 6;
    const float* gw = p.in[28];
    for (int row = blockIdx.x * 4 + wave; row < T; row += gridDim.x * 4) {
        const f32x4* xr = (const f32x4*)(X + (size_t)row * D) + lane;
        f32x4 v[4]; float s = 0.f;
#pragma unroll
        for (int j = 0; j < 4; ++j) { v[j] = xr[64 * j]; s += (v[j].x * v[j].x + v[j].y * v[j].y) + (v[j].z * v[j].z + v[j].w * v[j].w); }
        const float rs = rsqrtf(wave_sum(s) * (1.0f / D) + RMS_EPS);
        f32x4* o = (f32x4*)(OUT + (size_t)row * D) + lane;
#pragma unroll
        for (int j = 0; j < 4; ++j) {
            const f32x4 g = *(const f32x4*)(gw + lane * 4 + 256 * j);
            if (!dry) o[64 * j] = (f32x4){v[j].x * rs * g.x, v[j].y * rs * g.y, v[j].z * rs * g.z, v[j].w * rs * g.w};
        }
    }
}

__device__ __forceinline__ int vblock() { const int G = gridDim.x, bx = blockIdx.x; return (G % 8 == 0) ? (bx % 8) * (G / 8) + bx / 8 : bx; }
struct ALoadPlain {
    const bf16_t* A; size_t lda;
    __device__ __forceinline__ const bf16_t* base(int kt) const { return A + kt * 64; }
    __device__ __forceinline__ unsigned off(int r, int lc) const { return (unsigned)r * (unsigned)lda + (unsigned)lc * 8u; }
};
struct ALoadGroup {
    const bf16_t* A;
    __device__ __forceinline__ const bf16_t* base(int kt) const { return A + (size_t)kt * 4 * T * 16; }
    __device__ __forceinline__ unsigned off(int r, int lc) const { return ((unsigned)(lc >> 1) * (unsigned)T + (unsigned)r) * 16u + (unsigned)(lc & 1) * 8u; }
};

template <class AL>
__device__ __forceinline__ void gemm_tile2(const AL al, const bf16_t* __restrict__ Bt, size_t ldb, int nk, f32x4 (&acc)[4][4], unsigned char* lds) {
    const int tid = threadIdx.x, lane = tid & 63, wid = tid >> 6, wr = wid >> 1, wc = wid & 1, fr = lane & 15, fq = lane >> 4;
    const int lr = tid >> 3, lc = tid & 7;
#pragma unroll
    for (int mi = 0; mi < 4; ++mi)
#pragma unroll
        for (int ni = 0; ni < 4; ++ni) acc[mi][ni] = (f32x4){0.f, 0.f, 0.f, 0.f};
    u32x4 ra0[4], rb0[4], ra1[4], rb1[4];
    const int soff = lr * 128 + ((lc ^ (lr & 7)) << 4);
    unsigned offA[4], offB[4];
#pragma unroll
    for (int i = 0; i < 4; ++i) { offA[i] = al.off(lr + 32 * i, lc); offB[i] = (unsigned)(lr + 32 * i) * (unsigned)ldb + (unsigned)lc * 8u; }
#define GT_LOAD(RA, RB, kt_) do { const bf16_t* ab_ = al.base(kt_); const bf16_t* bb_ = Bt + (kt_) * 64; _Pragma("unroll") for (int i = 0; i < 4; ++i) { RA[i] = *(const u32x4*)(ab_ + offA[i]); RB[i] = *(const u32x4*)(bb_ + offB[i]); } } while (0)
#define GT_STORE(RA, RB, buf_) do { unsigned char* nb_ = lds + (buf_) * 32768; _Pragma("unroll") for (int i = 0; i < 4; ++i) { *(u32x4*)(nb_ + soff + i * 4096) = RA[i]; *(u32x4*)(nb_ + 16384 + soff + i * 4096) = RB[i]; } } while (0)
    const int aoff = (wr * 64 + fr) * 128, boff = 16384 + (wc * 64 + fr) * 128, sw = fr & 7;
#define GT_MATH(buf_) do { const unsigned char* bp_ = lds + (buf_) * 32768; _Pragma("unroll") for (int ks = 0; ks < 2; ++ks) { bf16x8 af[4], bfr[4]; const int co = ((ks * 4 + fq) ^ sw) << 4; \
        _Pragma("unroll") for (int mi = 0; mi < 4; ++mi) af[mi] = *(const bf16x8*)(bp_ + aoff + mi * 2048 + co); \
        _Pragma("unroll") for (int ni = 0; ni < 4; ++ni) bfr[ni] = *(const bf16x8*)(bp_ + boff + ni * 2048 + co); \
        _Pragma("unroll") for (int mi = 0; mi < 4; ++mi) _Pragma("unroll") for (int ni = 0; ni < 4; ++ni) acc[mi][ni] = __builtin_amdgcn_mfma_f32_16x16x32_bf16(bfr[ni], af[mi], acc[mi][ni], 0, 0, 0); } } while (0)
    GT_LOAD(ra0, rb0, 0);
    if (nk > 1) GT_LOAD(ra1, rb1, 1);
    GT_STORE(ra0, rb0, 0);
    __syncthreads();
    for (int kt = 0; kt < nk; kt += 2) {
        if (kt + 2 < nk) GT_LOAD(ra0, rb0, kt + 2);
        __builtin_amdgcn_sched_barrier(0);
        GT_MATH(0);
        __builtin_amdgcn_sched_barrier(0);
        if (kt + 1 < nk) GT_STORE(ra1, rb1, 1);
        __syncthreads();
        if (kt + 1 >= nk) break;
        if (kt + 3 < nk) GT_LOAD(ra1, rb1, kt + 3);
        __builtin_amdgcn_sched_barrier(0);
        GT_MATH(1);
        __builtin_amdgcn_sched_barrier(0);
        if (kt + 2 < nk) GT_STORE(ra0, rb0, 0);
        __syncthreads();
    }
#undef GT_LOAD
#undef GT_STORE
#undef GT_MATH
}

template <class AL>
__device__ __forceinline__ void gemm_tile1(const AL al, const bf16_t* __restrict__ Bt, size_t ldb, int nk, f32x4 (&acc)[4][4], unsigned char* lds) {
    const int tid = threadIdx.x, lane = tid & 63, wid = tid >> 6, wr = wid >> 1, wc = wid & 1, fr = lane & 15, fq = lane >> 4;
    const int lr = tid >> 3, lc = tid & 7;
#pragma unroll
    for (int mi = 0; mi < 4; ++mi)
#pragma unroll
        for (int ni = 0; ni < 4; ++ni) acc[mi][ni] = (f32x4){0.f, 0.f, 0.f, 0.f};
    u32x4 ra[4], rb[4];
    const int soff = lr * 128 + ((lc ^ (lr & 7)) << 4);
#pragma unroll
    for (int i = 0; i < 4; ++i) { ra[i] = *(const u32x4*)(al.base(0) + al.off(lr + 32 * i, lc)); rb[i] = *(const u32x4*)(Bt + (size_t)(lr + 32 * i) * ldb + lc * 8); }
#pragma unroll
    for (int i = 0; i < 4; ++i) { *(u32x4*)(lds + soff + i * 4096) = ra[i]; *(u32x4*)(lds + 16384 + soff + i * 4096) = rb[i]; }
    __syncthreads();
    const int aoff = (wr * 64 + fr) * 128, boff = 16384 + (wc * 64 + fr) * 128, sw = fr & 7;
    for (int kt = 0; kt < nk; ++kt) {
        const bool more = (kt + 1 < nk);
        if (more) {
#pragma unroll
            for (int i = 0; i < 4; ++i) { ra[i] = *(const u32x4*)(al.base(kt + 1) + al.off(lr + 32 * i, lc)); rb[i] = *(const u32x4*)(Bt + (size_t)(lr + 32 * i) * ldb + (kt + 1) * 64 + lc * 8); }
        }
        const unsigned char* buf = lds + (kt & 1) * 32768;
#pragma unroll
        for (int ks = 0; ks < 2; ++ks) {
            bf16x8 af[4], bfr[4];
            const int co = ((ks * 4 + fq) ^ sw) << 4;
#pragma unroll
            for (int mi = 0; mi < 4; ++mi) af[mi] = *(const bf16x8*)(buf + aoff + mi * 2048 + co);
#pragma unroll
            for (int ni = 0; ni < 4; ++ni) bfr[ni] = *(const bf16x8*)(buf + boff + ni * 2048 + co);
#pragma unroll
            for (int mi = 0; mi < 4; ++mi)
#pragma unroll
                for (int ni = 0; ni < 4; ++ni) acc[mi][ni] = __builtin_amdgcn_mfma_f32_16x16x32_bf16(bfr[ni], af[mi], acc[mi][ni], 0, 0, 0);
        }
        if (more) {
            unsigned char* nb = lds + ((kt + 1) & 1) * 32768;
#pragma unroll
            for (int i = 0; i < 4; ++i) { *(u32x4*)(nb + soff + i * 4096) = ra[i]; *(u32x4*)(nb + 16384 + soff + i * 4096) = rb[i]; }
        }
        __syncthreads();
    }
}

template <class AL, bool ZERO = true>
__device__ __forceinline__ void gemm_tile3(const AL al, const bf16_t* __restrict__ Bt, size_t ldb, int nk, f32x4 (&acc)[4][4], unsigned char* lds) {
    const int tid = threadIdx.x, lane = tid & 63, wid = tid >> 6, wr = wid >> 1, wc = wid & 1, fr = lane & 15, fq = lane >> 4;
    if (ZERO) {
#pragma unroll
    for (int mi = 0; mi < 4; ++mi)
#pragma unroll
        for (int ni = 0; ni < 4; ++ni) acc[mi][ni] = (f32x4){0.f, 0.f, 0.f, 0.f};
    }
    const int srow = wid * 32 + (lane >> 3), schunk = (lane & 7) ^ ((lane >> 3) & 7);
    unsigned offA[4], offB[4];
#pragma unroll
    for (int i = 0; i < 4; ++i) { offA[i] = al.off(srow + 8 * i, schunk); offB[i] = (unsigned)(srow + 8 * i) * (unsigned)ldb + (unsigned)schunk * 8u; }
#define G3_STAGE(buf_, kt_) do { const bf16_t* ab_ = al.base(kt_); const bf16_t* bb_ = Bt + (kt_) * 64; unsigned char* lb_ = lds + (buf_) * 32768 + wid * 4096; \
        _Pragma("unroll") for (int i = 0; i < 4; ++i) { \
            __builtin_amdgcn_global_load_lds((const unsigned*)(ab_ + offA[i]), (unsigned*)(lb_ + i * 1024), 16, 0, 0); \
            __builtin_amdgcn_global_load_lds((const unsigned*)(bb_ + offB[i]), (unsigned*)(lb_ + 16384 + i * 1024), 16, 0, 0); } } while (0)
    const int aoff = (wr * 64 + fr) * 128, boff = 16384 + (wc * 64 + fr) * 128, sw = fr & 7;
    G3_STAGE(0, 0);
    __syncthreads();
    for (int kt = 0; kt < nk; ++kt) {
        if (kt + 1 < nk) G3_STAGE((kt + 1) & 1, kt + 1);
        const unsigned char* buf = lds + (kt & 1) * 32768;
#pragma unroll
        for (int ks = 0; ks < 2; ++ks) {
            bf16x8 af[4], bfr[4];
            const int co = ((ks * 4 + fq) ^ sw) << 4;
#pragma unroll
            for (int mi = 0; mi < 4; ++mi) af[mi] = *(const bf16x8*)(buf + aoff + mi * 2048 + co);
#pragma unroll
            for (int ni = 0; ni < 4; ++ni) bfr[ni] = *(const bf16x8*)(buf + boff + ni * 2048 + co);
#pragma unroll
            for (int mi = 0; mi < 4; ++mi)
#pragma unroll
                for (int ni = 0; ni < 4; ++ni) acc[mi][ni] = __builtin_amdgcn_mfma_f32_16x16x32_bf16(bfr[ni], af[mi], acc[mi][ni], 0, 0, 0);
        }
        __syncthreads();
    }
#undef G3_STAGE
}

__device__ __forceinline__ void mma_ktile(const unsigned char* buf, f32x4 (&acc)[4][4]) {
    const int tid = threadIdx.x, lane = tid & 63, wid = tid >> 6, wr = wid >> 1, wc = wid & 1, fr = lane & 15, fq = lane >> 4;
    const int aoff = (wr * 64 + fr) * 128, boff = 16384 + (wc * 64 + fr) * 128, sw = fr & 7;
#pragma unroll
    for (int ks = 0; ks < 2; ++ks) {
        bf16x8 af[4], bfr[4];
        const int co = ((ks * 4 + fq) ^ sw) << 4;
#pragma unroll
        for (int mi = 0; mi < 4; ++mi) af[mi] = *(const bf16x8*)(buf + aoff + mi * 2048 + co);
#pragma unroll
        for (int ni = 0; ni < 4; ++ni) bfr[ni] = *(const bf16x8*)(buf + boff + ni * 2048 + co);
#pragma unroll
        for (int mi = 0; mi < 4; ++mi)
#pragma unroll
            for (int ni = 0; ni < 4; ++ni) acc[mi][ni] = __builtin_amdgcn_mfma_f32_16x16x32_bf16(bfr[ni], af[mi], acc[mi][ni], 0, 0, 0);
    }
}
__device__ __forceinline__ void phase_s5_win(const Params& p, unsigned char* lds) {
    const bf16_t* HM = (const bf16_t*)(p.ws + WS_HM); const bf16_t* WT = (const bf16_t*)(p.ws + WS_WIN_T);
    bf16_t* UG = (bf16_t*)(p.ws + WS_UG);
    const int lane = threadIdx.x & 63, wid = threadIdx.x >> 6, wr = wid >> 1, wc = wid & 1, fr = lane & 15, fq = lane >> 4;
    for (int id = vblock(); id < 256 * 8; id += gridDim.x) {
        const int mt = id >> 3, nt = id & 7;
        f32x4 acc[4][4];
        gemm_tile3(ALoadPlain{HM + (size_t)mt * 128 * D, (size_t)D}, WT + (size_t)nt * 128 * D, D, 16, acc, lds);
#pragma unroll
        for (int mi = 0; mi < 4; ++mi)
#pragma unroll
            for (int ni = 0; ni < 4; ++ni) {
                const int t = mt * 128 + wr * 64 + mi * 16 + fr, g = nt * 8 + wc * 4 + ni;
                const f32x4 v = acc[mi][ni];
                *(u32x2*)(UG + ((size_t)g * T + t) * 16 + fq * 4) = (u32x2){pk2(v.x, v.y), pk2(v.z, v.w)};
            }
    }
}
__device__ __forceinline__ void phase_s5_a(const Params& p, unsigned char* lds) {
    const bf16_t* UG = (const bf16_t*)(p.ws + WS_UG); const bf16_t* TW = (const bf16_t*)(p.ws + WS_TW);
    float* WST = (float*)(p.ws + WS_WST);
    const int lane = threadIdx.x & 63, wid = threadIdx.x >> 6, wr = wid >> 1, wc = wid & 1, fr = lane & 15, fq = lane >> 4;
    for (int id = vblock(); id < 64 * 8; id += gridDim.x) {
        const int g = id >> 3, mt = id & 7;
        f32x4 acc[4][4];
        gemm_tile3(ALoadPlain{UG + (size_t)g * T * 16 + (size_t)mt * 128 * 512, (size_t)512}, TW + ((size_t)g * 640 + 512) * 512, 512, 8, acc, lds);
#pragma unroll
        for (int mi = 0; mi < 4; ++mi)
#pragma unroll
            for (int ni = 0; ni < 4; ++ni) {
                const int R = mt * 128 + wr * 64 + mi * 16 + fr, c = wc * 64 + ni * 16 + fq * 4;
                *(f32x4*)(WST + ((size_t)g * 1024 + R) * 128 + c) = acc[mi][ni];
            }
    }
}
__device__ __forceinline__ void phase_s5_scan(const Params& p) {
    const int lane = threadIdx.x & 63, wave = threadIdx.x >> 6;
    const float* WST = (const float*)(p.ws + WS_WST); bf16_t* SST = (bf16_t*)(p.ws + WS_SST);
    const f32x2* AL = (const f32x2*)(p.ws + WS_MISC + 4096);
    for (int it = blockIdx.x * 4 + wave; it < 128; it += gridDim.x * 4) {
        const int b = it >> 6, g = it & 63;
        const f32x2 al = AL[g * 64 + lane];
        float sr = 0.f, si = 0.f;
        const float* wbase = WST + ((size_t)g * 1024 + b * 512) * 128 + lane;
        bf16_t* sbase = SST + ((size_t)g * 1024 + b * 512) * 128 + lane;
        for (int n0 = 0; n0 < 512; n0 += 16) {
            float wre[16], wim[16];
#pragma unroll
            for (int j = 0; j < 16; ++j) { wre[j] = wbase[(size_t)(n0 + j) * 128]; wim[j] = wbase[(size_t)(n0 + j) * 128 + 64]; }
#pragma unroll
            for (int j = 0; j < 16; ++j) {
                sbase[(size_t)(n0 + j) * 128] = (bf16_t)f2bf(sr); sbase[(size_t)(n0 + j) * 128 + 64] = (bf16_t)f2bf(si);
                const float nr = al.x * sr - al.y * si + wre[j], ni = al.x * si + al.y * sr + wim[j];
                sr = nr; si = ni;
            }
        }
    }
}
__device__ __forceinline__ void phase_s5_b(const Params& p, unsigned char* lds) {
    const bf16_t* SST = (const bf16_t*)(p.ws + WS_SST); const bf16_t* VG = (const bf16_t*)(p.ws + WS_VG);
    const bf16_t* UG = (const bf16_t*)(p.ws + WS_UG); const bf16_t* TW = (const bf16_t*)(p.ws + WS_TW);
    bf16_t* YG = (bf16_t*)(p.ws + WS_YG);
    const float* dsk = p.in[14];
    const int lane = threadIdx.x & 63, wid = threadIdx.x >> 6, wr = wid >> 1, wc = wid & 1, fr = lane & 15, fq = lane >> 4;
    for (int id = vblock(); id < 64 * 32; id += gridDim.x) {
        const int g = id >> 5, mt = (id >> 2) & 7, nt = 3 - (id & 3);
        f32x4 acc[4][4];
        gemm_tile3<ALoadPlain, true>(ALoadPlain{UG + (size_t)g * T * 16 + (size_t)mt * 128 * 512, (size_t)512}, TW + ((size_t)g * 640 + nt * 128) * 512, 512, 2 * (nt + 1), acc, lds);
        gemm_tile3<ALoadPlain, false>(ALoadPlain{SST + ((size_t)g * 1024 + mt * 128) * 128, (size_t)128}, VG + ((size_t)g * 512 + nt * 128) * 128, 128, 2, acc, lds);
        const f32x4 dv = *(const f32x4*)(dsk + g * 16 + fq * 4);
#pragma unroll
        for (int mi = 0; mi < 4; ++mi)
#pragma unroll
            for (int ni = 0; ni < 4; ++ni) {
                const int R = mt * 128 + wr * 64 + mi * 16 + fr, c = nt * 128 + wc * 64 + ni * 16 + fq * 4;
                const size_t idx = ((size_t)g * 1024 + R) * 512 + c;
                const u32x2 uu = *(const u32x2*)(UG + idx);
                const f32x4 v = acc[mi][ni];
                const float y0 = gelu_tanh(v.x + dv.x * bflo(uu.x)), y1 = gelu_tanh(v.y + dv.y * bfhi(uu.x));
                const float y2 = gelu_tanh(v.z + dv.z * bflo(uu.y)), y3 = gelu_tanh(v.w + dv.w * bfhi(uu.y));
                *(u32x2*)(YG + idx) = (u32x2){pk2(y0, y1), pk2(y2, y3)};
            }
    }
}
__device__ __forceinline__ void phase_s5_glu(const Params& p, unsigned char* lds) {
    const bf16_t* YG = (const bf16_t*)(p.ws + WS_YG); const bf16_t* WT = (const bf16_t*)(p.ws + WS_WGLU_T);
    const float* MOD = (const float*)(p.ws + WS_MOD);
    const float* X = p.in[0]; float* XO = p.out;
    const int lane = threadIdx.x & 63, wid = threadIdx.x >> 6, wr = wid >> 1, wc = wid & 1, fr = lane & 15, fq = lane >> 4;
    for (int id = vblock(); id < 256 * 16; id += gridDim.x) {
        const int mt = id >> 4, nt = id & 15;
        f32x4 acc[4][4];
        gemm_tile3(ALoadGroup{YG + (size_t)mt * 128 * 16}, WT + (size_t)nt * 128 * D, D, 16, acc, lds);
        const int b = (mt * 128) / SEQ;
#pragma unroll
        for (int mi = 0; mi < 4; ++mi)
#pragma unroll
            for (int h = 0; h < 2; ++h) {
                const int t = mt * 128 + wr * 64 + mi * 16 + fr, j = nt * 64 + wc * 32 + h * 16 + fq * 4;
                const f32x4 a = acc[mi][2 * h], gg = acc[mi][2 * h + 1];
                const f32x4 g1 = *(const f32x4*)(MOD + (size_t)(0 * 2 + b) * 6144 + 2048 + j);
                const f32x4 xi = *(const f32x4*)(X + (size_t)t * D + j);
                f32x4 o;
                o.x = xi.x + g1.x * (a.x * sigmoidf_(gg.x)); o.y = xi.y + g1.y * (a.y * sigmoidf_(gg.y));
                o.z = xi.z + g1.z * (a.z * sigmoidf_(gg.z)); o.w = xi.w + g1.w * (a.w * sigmoidf_(gg.w));
                *(f32x4*)(XO + (size_t)t * D + j) = o;
            }
    }
}
__device__ __forceinline__ void phase_peer_wq(const Params& p, int layer, unsigned char* lds) {
    const bf16_t* HM = (const bf16_t*)(p.ws + WS_HM); const bf16_t* WT = (const bf16_t*)(p.ws + WS_WQ_T) + (size_t)layer * 2048 * 1024;
    bf16_t* QK = (bf16_t*)(p.ws + WS_QK);
    const int lane = threadIdx.x & 63, wid = threadIdx.x >> 6, wr = wid >> 1, wc = wid & 1, fr = lane & 15, fq = lane >> 4;
    for (int id = vblock(); id < 256 * 16; id += gridDim.x) {
        const int mt = id >> 4, nt = id & 15;
        f32x4 acc[4][4];
        gemm_tile3(ALoadPlain{HM + (size_t)mt * 128 * D, (size_t)D}, WT + (size_t)nt * 128 * D, D, 16, acc, lds);
#pragma unroll
        for (int mi = 0; mi < 4; ++mi)
#pragma unroll
            for (int ni = 0; ni < 4; ++ni) {
                const int t = mt * 128 + wr * 64 + mi * 16 + fr, c = nt * 128 + wc * 64 + ni * 16 + fq * 4;
                const f32x4 v = acc[mi][ni];
                *(u32x2*)(QK + (size_t)t * 2048 + c) = (u32x2){pk2(v.x, v.y), pk2(v.z, v.w)};
            }
    }
}
__device__ __forceinline__ void ce_(unsigned& a, unsigned& b, const bool up) { const unsigned lo = a < b ? a : b, hi = a < b ? b : a; a = up ? lo : hi; b = up ? hi : lo; }
__device__ __forceinline__ void bitonic_sort16(unsigned* x, const bool asc) {
#pragma unroll
    for (int k = 2; k <= 16; k <<= 1)
#pragma unroll
        for (int j = k >> 1; j > 0; j >>= 1)
#pragma unroll
            for (int i = 0; i < 16; ++i) { const int l = i ^ j; if (l > i) ce_(x[i], x[l], ((i & k) == 0) == asc); }
}
__device__ __forceinline__ void bitonic_merge16(unsigned* x, const bool asc) {
#pragma unroll
    for (int j = 8; j > 0; j >>= 1)
#pragma unroll
        for (int i = 0; i < 16; ++i) { const int l = i ^ j; if (l > i) ce_(x[i], x[l], asc); }
}
__device__ __forceinline__ void phase_peer_topk(const Params& p, int layer, unsigned char* lds) {
    const bf16_t* QK = (const bf16_t*)(p.ws + WS_QK); const bf16_t* SK = (const bf16_t*)(p.ws + WS_SUBK) + (size_t)layer * 8 * 2 * 128 * 128;
    float* TOPS = (float*)(p.ws + WS_TOPS); int* TOPI = (int*)(p.ws + WS_TOPI);
    float* sc = (float*)lds;
    const int tid = threadIdx.x, lane = tid & 63, wid = tid >> 6, wr = wid >> 1, wc = wid & 1, fr = lane & 15, fq = lane >> 4;
    for (int id = vblock(); id < 256 * 16; id += gridDim.x) {
        const int mt = id >> 4, hc = id & 15;
        f32x4 acc[4][4];
        gemm_tile3(ALoadPlain{QK + (size_t)mt * 128 * 2048 + hc * 128, (size_t)2048}, SK + (size_t)hc * 128 * 128, 128, 2, acc, lds);
#pragma unroll
        for (int mi = 0; mi < 4; ++mi)
#pragma unroll
            for (int ni = 0; ni < 4; ++ni) {
                const int r = wr * 64 + mi * 16 + fr, c = wc * 64 + ni * 16 + fq * 4;
                float* d = sc + r * 129 + c;
                d[0] = acc[mi][ni].x; d[1] = acc[mi][ni].y; d[2] = acc[mi][ni].z; d[3] = acc[mi][ni].w;
            }
        __syncthreads();
        {
            const int row = tid >> 1, half = tid & 1;
            unsigned x[64];
            const float* rp = sc + row * 129 + half * 64;
#pragma unroll
            for (int j = 0; j < 64; ++j) {
                const unsigned bits = __builtin_bit_cast(unsigned, rp[j]);
                const unsigned u = bits ^ ((unsigned)((int)bits >> 31) | 0x80000000u);
                x[j] = (u & 0xFFFFFF80u) | (unsigned)(127 - (half * 64 + j));
            }
            bitonic_sort16(x, true); bitonic_sort16(x + 16, false); bitonic_sort16(x + 32, true); bitonic_sort16(x + 48, false);
#pragma unroll
            for (int i = 0; i < 16; ++i) { x[i] = x[i] > x[16 + i] ? x[i] : x[16 + i]; x[32 + i] = x[32 + i] > x[48 + i] ? x[32 + i] : x[48 + i]; }
            bitonic_merge16(x, true); bitonic_merge16(x + 32, false);
#pragma unroll
            for (int i = 0; i < 16; ++i) x[i] = x[i] > x[32 + i] ? x[i] : x[32 + i];
            bitonic_merge16(x, false);
            unsigned y[16];
#pragma unroll
            for (int i = 0; i < 16; ++i) { const unsigned o = (unsigned)__shfl_xor((int)x[15 - i], 1); y[i] = x[i] > o ? x[i] : o; }
            bitonic_merge16(y, false);
            const size_t ob = ((size_t)(mt * 128 + row) * 16 + hc) * 16;
            if (half == 0) {
                float v[16];
#pragma unroll
                for (int i = 0; i < 16; ++i) { const unsigned u = y[i] & 0xFFFFFF80u; const unsigned bits = (u & 0x80000000u) ? (u ^ 0x80000000u) : ~u; v[i] = __builtin_bit_cast(float, bits); }
#pragma unroll
                for (int q = 0; q < 4; ++q) *(f32x4*)(TOPS + ob + q * 4) = (f32x4){v[q * 4], v[q * 4 + 1], v[q * 4 + 2], v[q * 4 + 3]};
            } else {
#pragma unroll
                for (int q = 0; q < 4; ++q) *(u32x4*)(TOPI + ob + q * 4) = (u32x4){127u - (y[q * 4] & 127u), 127u - (y[q * 4 + 1] & 127u), 127u - (y[q * 4 + 2] & 127u), 127u - (y[q * 4 + 3] & 127u)};
            }
        }
        __syncthreads();
    }
}
__device__ __forceinline__ void phase_peer_wq_topk(const Params& p, int layer, unsigned char* lds) {
    const bf16_t* HM = (const bf16_t*)(p.ws + WS_HM); const bf16_t* WT = (const bf16_t*)(p.ws + WS_WQ_T) + (size_t)layer * 2048 * 1024;
    const bf16_t* SK = (const bf16_t*)(p.ws + WS_SUBK) + (size_t)layer * 8 * 2 * 128 * 128;
    float* TOPS = (float*)(p.ws + WS_TOPS); int* TOPI = (int*)(p.ws + WS_TOPI);
    float* sc = (float*)lds;
    const int tid = threadIdx.x, lane = tid & 63, wid = tid >> 6, wr = wid >> 1, wc = wid & 1, fr = lane & 15, fq = lane >> 4;
    for (int id = vblock(); id < 256 * 16; id += gridDim.x) {
        const int mt = id >> 4, hc = id & 15;
        f32x4 acc[4][4];
        gemm_tile3(ALoadPlain{HM + (size_t)mt * 128 * D, (size_t)D}, WT + (size_t)hc * 128 * D, D, 16, acc, lds);
        {
            const int srow = wid * 32 + (lane >> 3), schunk = (lane & 7) ^ ((lane >> 3) & 7);
            const bf16_t* sk = SK + (size_t)hc * 128 * 128;
#pragma unroll
            for (int kt = 0; kt < 2; ++kt)
#pragma unroll
                for (int i = 0; i < 4; ++i)
                    __builtin_amdgcn_global_load_lds((const unsigned*)(sk + (srow + 8 * i) * 128 + kt * 64 + schunk * 8), (unsigned*)(lds + kt * 32768 + 16384 + wid * 4096 + i * 1024), 16, 0, 0);
        }
#pragma unroll
        for (int mi = 0; mi < 4; ++mi)
#pragma unroll
            for (int ni = 0; ni < 4; ++ni) {
                const int r = wr * 64 + mi * 16 + fr, chunk = ni * 2 + (fq >> 1);
                const f32x4 v = acc[mi][ni];
                *(u32x2*)(lds + wc * 32768 + r * 128 + ((chunk ^ (r & 7)) << 4) + (fq & 1) * 8) = (u32x2){pk2(v.x, v.y), pk2(v.z, v.w)};
            }
        __syncthreads();
#pragma unroll
        for (int mi = 0; mi < 4; ++mi)
#pragma unroll
            for (int ni = 0; ni < 4; ++ni) acc[mi][ni] = (f32x4){0.f, 0.f, 0.f, 0.f};
        mma_ktile(lds, acc); mma_ktile(lds + 32768, acc);
        __syncthreads();
#pragma unroll
        for (int mi = 0; mi < 4; ++mi)
#pragma unroll
            for (int ni = 0; ni < 4; ++ni) {
                const int r = wr * 64 + mi * 16 + fr, c = wc * 64 + ni * 16 + fq * 4;
                float* d = sc + r * 129 + c;
                d[0] = acc[mi][ni].x; d[1] = acc[mi][ni].y; d[2] = acc[mi][ni].z; d[3] = acc[mi][ni].w;
            }
        __syncthreads();
        {
            const int row = tid >> 1, half = tid & 1;
            unsigned x[64];
            const float* rp = sc + row * 129 + half * 64;
#pragma unroll
            for (int j = 0; j < 64; ++j) {
                const unsigned bits = __builtin_bit_cast(unsigned, rp[j]);
                const unsigned u = bits ^ ((unsigned)((int)bits >> 31) | 0x80000000u);
                x[j] = (u & 0xFFFFFF80u) | (unsigned)(127 - (half * 64 + j));
            }
            bitonic_sort16(x, true); bitonic_sort16(x + 16, false); bitonic_sort16(x + 32, true); bitonic_sort16(x + 48, false);
#pragma unroll
            for (int i = 0; i < 16; ++i) { x[i] = x[i] > x[16 + i] ? x[i] : x[16 + i]; x[32 + i] = x[32 + i] > x[48 + i] ? x[32 + i] : x[48 + i]; }
            bitonic_merge16(x, true); bitonic_merge16(x + 32, false);
#pragma unroll
            for (int i = 0; i < 16; ++i) x[i] = x[i] > x[32 + i] ? x[i] : x[32 + i];
            bitonic_merge16(x, false);
            unsigned y[16];
#pragma unroll
            for (int i = 0; i < 16; ++i) { const unsigned o = (unsigned)__shfl_xor((int)x[15 - i], 1); y[i] = x[i] > o ? x[i] : o; }
            bitonic_merge16(y, false);
            const size_t ob = ((size_t)(mt * 128 + row) * 16 + hc) * 16;
            if (half == 0) {
                float v[16];
#pragma unroll
                for (int i = 0; i < 16; ++i) { const unsigned u = y[i] & 0xFFFFFF80u; const unsigned bits = (u & 0x80000000u) ? (u ^ 0x80000000u) : ~u; v[i] = __builtin_bit_cast(float, bits); }
#pragma unroll
                for (int q = 0; q < 4; ++q) *(f32x4*)(TOPS + ob + q * 4) = (f32x4){v[q * 4], v[q * 4 + 1], v[q * 4 + 2], v[q * 4 + 3]};
            } else {
#pragma unroll
                for (int q = 0; q < 4; ++q) *(u32x4*)(TOPI + ob + q * 4) = (u32x4){127u - (y[q * 4] & 127u), 127u - (y[q * 4 + 1] & 127u), 127u - (y[q * 4 + 2] & 127u), 127u - (y[q * 4 + 3] & 127u)};
            }
        }
        __syncthreads();
    }
}
__device__ __forceinline__ void phase_peer_route(const Params& p, int layer, unsigned char* lds) {
    const bf16_t* HM = (const bf16_t*)(p.ws + WS_HM); const bf16_t* WT = (const bf16_t*)(p.ws + WS_WQ_T) + (size_t)layer * 2048 * 1024;
    const bf16_t* SK = (const bf16_t*)(p.ws + WS_SUBK) + (size_t)layer * 8 * 2 * 128 * 128;
    int* EXP = (int*)(p.ws + WS_EXP); float* GATE = (float*)(p.ws + WS_GATE);
    float* sc = (float*)lds;
    unsigned* KEYS0 = (unsigned*)(lds + 66048);
    unsigned* L = (unsigned*)lds;
    const int tid = threadIdx.x, lane = tid & 63, wid = tid >> 6, wr = wid >> 1, wc = wid & 1, fr = lane & 15, fq = lane >> 4;
    for (int id = vblock(); id < 256 * 8; id += gridDim.x) {
        const int mt = id >> 3, h = id & 7;
        const int row = tid >> 1, half = tid & 1;
        unsigned y[16];
#pragma unroll 1
        for (int c = 0; c < 2; ++c) {
            const int hc = h * 2 + c;
            f32x4 acc[4][4];
            gemm_tile3(ALoadPlain{HM + (size_t)mt * 128 * D, (size_t)D}, WT + (size_t)hc * 128 * D, D, 16, acc, lds);
            {
                const int srow = wid * 32 + (lane >> 3), schunk = (lane & 7) ^ ((lane >> 3) & 7);
                const bf16_t* sk = SK + (size_t)hc * 128 * 128;
#pragma unroll
                for (int kt = 0; kt < 2; ++kt)
#pragma unroll
                    for (int i = 0; i < 4; ++i)
                        __builtin_amdgcn_global_load_lds((const unsigned*)(sk + (srow + 8 * i) * 128 + kt * 64 + schunk * 8), (unsigned*)(lds + kt * 32768 + 16384 + wid * 4096 + i * 1024), 16, 0, 0);
            }
#pragma unroll
            for (int mi = 0; mi < 4; ++mi)
#pragma unroll
                for (int ni = 0; ni < 4; ++ni) {
                    const int r = wr * 64 + mi * 16 + fr, chunk = ni * 2 + (fq >> 1);
                    const f32x4 v = acc[mi][ni];
                    *(u32x2*)(lds + wc * 32768 + r * 128 + ((chunk ^ (r & 7)) << 4) + (fq & 1) * 8) = (u32x2){pk2(v.x, v.y), pk2(v.z, v.w)};
                }
            __syncthreads();
#pragma unroll
            for (int mi = 0; mi < 4; ++mi)
#pragma unroll
                for (int ni = 0; ni < 4; ++ni) acc[mi][ni] = (f32x4){0.f, 0.f, 0.f, 0.f};
            mma_ktile(lds, acc); mma_ktile(lds + 32768, acc);
            __syncthreads();
#pragma unroll
            for (int mi = 0; mi < 4; ++mi)
#pragma unroll
                for (int ni = 0; ni < 4; ++ni) {
                    const int r = wr * 64 + mi * 16 + fr, cc = wc * 64 + ni * 16 + fq * 4;
                    float* d = sc + r * 129 + cc;
                    d[0] = acc[mi][ni].x; d[1] = acc[mi][ni].y; d[2] = acc[mi][ni].z; d[3] = acc[mi][ni].w;
                }
            __syncthreads();
            {
                unsigned x[64];
                const float* rp = sc + row * 129 + half * 64;
#pragma unroll
                for (int j = 0; j < 64; ++j) {
                    const unsigned bits = __builtin_bit_cast(unsigned, rp[j]);
                    const unsigned u = bits ^ ((unsigned)((int)bits >> 31) | 0x80000000u);
                    x[j] = (u & 0xFFFFFF80u) | (unsigned)(127 - (half * 64 + j));
                }
                bitonic_sort16(x, true); bitonic_sort16(x + 16, false); bitonic_sort16(x + 32, true); bitonic_sort16(x + 48, false);
#pragma unroll
                for (int i = 0; i < 16; ++i) { x[i] = x[i] > x[16 + i] ? x[i] : x[16 + i]; x[32 + i] = x[32 + i] > x[48 + i] ? x[32 + i] : x[48 + i]; }
                bitonic_merge16(x, true); bitonic_merge16(x + 32, false);
#pragma unroll
                for (int i = 0; i < 16; ++i) x[i] = x[i] > x[32 + i] ? x[i] : x[32 + i];
                bitonic_merge16(x, false);
#pragma unroll
                for (int i = 0; i < 16; ++i) { const unsigned o = (unsigned)__shfl_xor((int)x[15 - i], 1); y[i] = x[i] > o ? x[i] : o; }
                bitonic_merge16(y, false);
            }
            if (c == 0 && half == 0) {
#pragma unroll
                for (int i = 0; i < 16; ++i) KEYS0[i * 128 + row] = y[i];
            }
            __syncthreads();
        }
        {
            unsigned kk[16];
#pragma unroll
            for (int i = 0; i < 16; ++i) kk[i] = half ? KEYS0[i * 128 + row] : y[i];
            const int sb = half ? 0 : 16, ib = half ? 32 : 48;
#pragma unroll
            for (int i = 0; i < 16; ++i) {
                const unsigned u = kk[i] & 0xFFFFFF80u; const unsigned bits = (u & 0x80000000u) ? (u ^ 0x80000000u) : ~u;
                L[(sb + i) * 128 + row] = bits; L[(ib + i) * 128 + row] = 127u - (kk[i] & 127u);
            }
        }
        __syncthreads();
        if (tid < 128) {
            const int col = tid;
            float val[16];
            const float s20 = __builtin_bit_cast(float, L[16 * 128 + col]);
#pragma unroll
            for (int a = 0; a < 16; ++a) val[a] = __builtin_bit_cast(float, L[a * 128 + col]) + s20;
            unsigned long long P = 0ull;
            float ts[16]; int te[16];
#pragma unroll
            for (int r = 0; r < 16; ++r) {
                float best = val[0]; int ba = 0;
#pragma unroll
                for (int a = 1; a < 16; ++a) if (val[a] > best) { best = val[a]; ba = a; }
                const int b = (int)((P >> (4 * ba)) & 15ull);
                const int i1 = (int)L[(32 + ba) * 128 + col], i2 = (int)L[(48 + b) * 128 + col];
                ts[r] = best; te[r] = i1 * 128 + i2;
                const int nb = b + 1;
                float newv = -3.0e38f;
                if (nb < 16) { newv = __builtin_bit_cast(float, L[ba * 128 + col]) + __builtin_bit_cast(float, L[(16 + nb) * 128 + col]); P += 1ull << (4 * ba); }
#pragma unroll
                for (int a = 0; a < 16; ++a) val[a] = (a == ba) ? newv : val[a];
            }
            const float m0 = ts[0];
            float sum = 0.f;
#pragma unroll
            for (int r = 0; r < 16; ++r) { ts[r] = __expf(ts[r] - m0); sum += ts[r]; }
            const float inv = 1.0f / sum;
            const size_t ob = ((size_t)(mt * 128 + col) * 8 + h) * 16;
#pragma unroll
            for (int q = 0; q < 4; ++q) {
                *(u32x4*)(EXP + ob + q * 4) = (u32x4){(unsigned)te[q * 4], (unsigned)te[q * 4 + 1], (unsigned)te[q * 4 + 2], (unsigned)te[q * 4 + 3]};
                *(f32x4*)(GATE + ob + q * 4) = (f32x4){ts[q * 4] * inv, ts[q * 4 + 1] * inv, ts[q * 4 + 2] * inv, ts[q * 4 + 3] * inv};
            }
        }
        __syncthreads();
    }
}
__device__ __forceinline__ void phase_peer_combine(const Params& p, unsigned char* lds) {
    const float* TOPS = (const float*)(p.ws + WS_TOPS); const int* TOPI = (const int*)(p.ws + WS_TOPI);
    int* EXP = (int*)(p.ws + WS_EXP); float* GATE = (float*)(p.ws + WS_GATE);
    unsigned* L = (unsigned*)lds;
    const int tid = threadIdx.x;
    for (int it = blockIdx.x; it < (T * 8) / 256; it += gridDim.x) {
        const size_t th = (size_t)it * 256 + tid;
        const u32x4* S4 = (const u32x4*)(TOPS + th * 32); const u32x4* I4 = (const u32x4*)(TOPI + th * 32);
#pragma unroll
        for (int a4 = 0; a4 < 8; ++a4) {
            const u32x4 s = S4[a4], i = I4[a4];
            L[(a4 * 4 + 0) * 256 + tid] = s.x; L[(a4 * 4 + 1) * 256 + tid] = s.y; L[(a4 * 4 + 2) * 256 + tid] = s.z; L[(a4 * 4 + 3) * 256 + tid] = s.w;
            L[(32 + a4 * 4 + 0) * 256 + tid] = i.x; L[(32 + a4 * 4 + 1) * 256 + tid] = i.y; L[(32 + a4 * 4 + 2) * 256 + tid] = i.z; L[(32 + a4 * 4 + 3) * 256 + tid] = i.w;
        }
        float val[16];
        const float s20 = __builtin_bit_cast(float, L[16 * 256 + tid]);
#pragma unroll
        for (int a = 0; a < 16; ++a) val[a] = __builtin_bit_cast(float, L[a * 256 + tid]) + s20;
        unsigned long long P = 0ull;
        float ts[16]; int te[16];
#pragma unroll
        for (int r = 0; r < 16; ++r) {
            float best = val[0]; int ba = 0;
#pragma unroll
            for (int a = 1; a < 16; ++a) if (val[a] > best) { best = val[a]; ba = a; }
            const int b = (int)((P >> (4 * ba)) & 15ull);
            const int i1 = (int)L[(32 + ba) * 256 + tid], i2 = (int)L[(48 + b) * 256 + tid];
            ts[r] = best; te[r] = i1 * 128 + i2;
            const int nb = b + 1;
            float newv = -3.0e38f;
            if (nb < 16) { newv = __builtin_bit_cast(float, L[ba * 256 + tid]) + __builtin_bit_cast(float, L[(16 + nb) * 256 + tid]); P += 1ull << (4 * ba); }
#pragma unroll
            for (int a = 0; a < 16; ++a) val[a] = (a == ba) ? newv : val[a];
        }
        const float m0 = ts[0];
        float sum = 0.f;
#pragma unroll
        for (int r = 0; r < 16; ++r) { ts[r] = __expf(ts[r] - m0); sum += ts[r]; }
        const float inv = 1.0f / sum;
#pragma unroll
        for (int r = 0; r < 16; ++r) ts[r] *= inv;
#pragma unroll
        for (int r = 0; r < 16; ++r) { EXP[th * 16 + r] = te[r]; GATE[th * 16 + r] = ts[r]; }
    }
}

__device__ __forceinline__ void fma8(const unsigned w0, const unsigned w1, const float a, float* acc) {
    const f32x2 p0 = __builtin_amdgcn_cvt_pk_f32_fp8((int)w0, false), p1 = __builtin_amdgcn_cvt_pk_f32_fp8((int)w0, true);
    const f32x2 p2 = __builtin_amdgcn_cvt_pk_f32_fp8((int)w1, false), p3 = __builtin_amdgcn_cvt_pk_f32_fp8((int)w1, true);
    acc[0] += a * p0.x; acc[1] += a * p0.y; acc[2] += a * p1.x; acc[3] += a * p1.y;
    acc[4] += a * p2.x; acc[5] += a * p2.y; acc[6] += a * p3.x; acc[7] += a * p3.y;
}
__device__ __forceinline__ float dot8(const unsigned w0, const unsigned w1, const float* h, float s) {
    const f32x2 p0 = __builtin_amdgcn_cvt_pk_f32_fp8((int)w0, false), p1 = __builtin_amdgcn_cvt_pk_f32_fp8((int)w0, true);
    const f32x2 p2 = __builtin_amdgcn_cvt_pk_f32_fp8((int)w1, false), p3 = __builtin_amdgcn_cvt_pk_f32_fp8((int)w1, true);
    s += p0.x * h[0]; s += p0.y * h[1]; s += p1.x * h[2]; s += p1.y * h[3];
    s += p2.x * h[4]; s += p2.y * h[5]; s += p3.x * h[6]; s += p3.y * h[7];
    return s;
}
__device__ __forceinline__ void phase_peer_apply(const Params& p, int layer, unsigned char* lds, bool dry) {
    const int lane = threadIdx.x & 63, wave = threadIdx.x >> 6;
    float* ldsw = (float*)lds + wave * (64 * 65);
    const bf16_t* HM = (const bf16_t*)(p.ws + WS_HM);
    const unsigned char* PU = p.ws + WS_PU; const unsigned char* PV = p.ws + WS_PV;
    const float* SU = (const float*)(p.ws + WS_PU + 24 * MiB); const float* SV = (const float*)(p.ws + WS_PV + 24 * MiB);
    const int* EXP = (const int*)(p.ws + WS_EXP); const float* GATE = (const float*)(p.ws + WS_GATE);
    const float* MOD = (const float*)(p.ws + WS_MOD);
    float* X = p.out;
    for (int t = blockIdx.x * 4 + wave; t < T; t += gridDim.x * 4) {
        const u32x4 ha = *(const u32x4*)(HM + (size_t)t * D + lane * 16), hb = *(const u32x4*)(HM + (size_t)t * D + lane * 16 + 8);
        float hf[16];
        hf[0] = bflo(ha.x); hf[1] = bfhi(ha.x); hf[2] = bflo(ha.y); hf[3] = bfhi(ha.y); hf[4] = bflo(ha.z); hf[5] = bfhi(ha.z); hf[6] = bflo(ha.w); hf[7] = bfhi(ha.w);
        hf[8] = bflo(hb.x); hf[9] = bfhi(hb.x); hf[10] = bflo(hb.y); hf[11] = bfhi(hb.y); hf[12] = bflo(hb.z); hf[13] = bfhi(hb.z); hf[14] = bflo(hb.w); hf[15] = bfhi(hb.w);
        const int e0_ = EXP[(size_t)t * 128 + lane], e1_ = EXP[(size_t)t * 128 + 64 + lane];
        const float g0 = GATE[(size_t)t * 128 + lane], g1 = GATE[(size_t)t * 128 + 64 + lane];
        const float su0 = SU[e0_], su1 = SU[e1_], sv0 = SV[e0_], sv1 = SV[e1_];
        u32x4 buf[16];
        float act0 = 0.f, act1 = 0.f;
        float acc[16];
#pragma unroll
        for (int i = 0; i < 16; ++i) acc[i] = 0.f;
#ifndef APPLY_L2PROBE
#define APPLY_L2PROBE 0
#endif
        for (int prep_ = 0; prep_ < 1 + APPLY_L2PROBE; ++prep_) {
        const int emask = (APPLY_L2PROBE && prep_ == 0) ? 2047 : 0x7fffffff;
        const int e0 = e0_ & emask, e1 = e1_ & emask;
#pragma unroll
        for (int j = 0; j < 16; ++j) { const int e_ = __builtin_amdgcn_readlane(e0, j); buf[j] = *(const u32x4*)(PU + (size_t)e_ * D + lane * 16); }
#pragma unroll
        for (int bt = 0; bt < 16; ++bt) {
#pragma unroll
            for (int j = 0; j < 16; ++j) {
                if (bt < 8) {
                    float s_ = dot8(buf[j].x, buf[j].y, hf, 0.f); s_ = dot8(buf[j].z, buf[j].w, hf + 8, s_);
                    ldsw[((bt & 3) * 16 + j) * 65 + lane] = s_;
                } else {
                    const float av_ = ((bt & 7) < 4) ? act0 : act1;
                    const float a_ = __builtin_bit_cast(float, __builtin_amdgcn_readlane(__builtin_bit_cast(int, av_), (bt & 3) * 16 + j));
                    fma8(buf[j].x, buf[j].y, a_, acc); fma8(buf[j].z, buf[j].w, a_, acc + 8);
                }
                if (bt + 1 < 16) {
                    const int nb = bt + 1;
                    const int e_ = __builtin_amdgcn_readlane(((nb & 7) < 4) ? e0 : e1, (nb & 3) * 16 + j);
                    buf[j] = *(const u32x4*)(((nb < 8) ? PU : PV) + (size_t)e_ * D + lane * 16);
                }
            }
            if (bt == 3 || bt == 7) {
                float tot_ = 0.f;
#pragma unroll 16
                for (int q = 0; q < 64; ++q) tot_ += ldsw[lane * 65 + q];
                if (bt == 3) act0 = gelu_tanh(tot_ * su0) * g0 * sv0; else act1 = gelu_tanh(tot_ * su1) * g1 * sv1;
            }
        }
        if (APPLY_L2PROBE && prep_ == 0 && p.ph_hi >= 0) {
#pragma unroll
            for (int i = 0; i < 16; ++i) acc[i] = 0.f;
        }
        }
        const int b = t / SEQ;
        const float* g2 = MOD + (size_t)(layer * 2 + b) * 6144 + 5120;
        float* xr = X + (size_t)t * D + lane * 16;
        f32x4 xs[4]; float ss = 0.f;
#pragma unroll
        for (int q = 0; q < 4; ++q) {
            const f32x4 g = *(const f32x4*)(g2 + lane * 16 + q * 4); f32x4 x = *(const f32x4*)(xr + q * 4);
            x.x += g.x * acc[q * 4 + 0]; x.y += g.y * acc[q * 4 + 1]; x.z += g.z * acc[q * 4 + 2]; x.w += g.w * acc[q * 4 + 3];
            xs[q] = x; ss += (x.x * x.x + x.y * x.y) + (x.z * x.z + x.w * x.w);
        }
        const float rs = rsqrtf(wave_sum(ss) * (1.0f / D) + RMS_EPS);
        if (!dry) {
            if (layer == 0) {
                const float* gw = p.in[2] + D + lane * 16; const float* sh = MOD + (size_t)(2 + b) * 6144 + lane * 16; const float* sc = sh + 1024;
                u32x4 o[2];
#pragma unroll
                for (int q = 0; q < 4; ++q) {
                    *(f32x4*)(xr + q * 4) = xs[q];
                    const f32x4 g = *(const f32x4*)(gw + q * 4), s1 = *(const f32x4*)(sc + q * 4), s0 = *(const f32x4*)(sh + q * 4);
                    const float y0 = xs[q].x * rs * g.x * (1.f + s1.x) + s0.x, y1 = xs[q].y * rs * g.y * (1.f + s1.y) + s0.y;
                    const float y2 = xs[q].z * rs * g.z * (1.f + s1.z) + s0.z, y3 = xs[q].w * rs * g.w * (1.f + s1.w) + s0.w;
                    if (q & 1) { o[q >> 1].z = pk2(y0, y1); o[q >> 1].w = pk2(y2, y3); } else { o[q >> 1].x = pk2(y0, y1); o[q >> 1].y = pk2(y2, y3); }
                }
                bf16_t* hm = (bf16_t*)(p.ws + WS_HM) + (size_t)t * D + lane * 16;
                *(u32x4*)hm = o[0]; *(u32x4*)(hm + 8) = o[1];
            } else {
                const float* gw = p.in[28] + lane * 16;
#pragma unroll
                for (int q = 0; q < 4; ++q) {
                    const f32x4 g = *(const f32x4*)(gw + q * 4);
                    *(f32x4*)(xr + q * 4) = (f32x4){xs[q].x * rs * g.x, xs[q].y * rs * g.y, xs[q].z * rs * g.z, xs[q].w * rs * g.w};
                }
            }
        }
    }
}
__device__ __forceinline__ void phase_tab1(const Params& p) {
    const int first = vblock() - 256, stride = (int)gridDim.x - 256;
    if (first < 0 || stride <= 0) {
        if (stride <= 0) { for (int it = blockIdx.x; it < 2 * P0_TAB; it += gridDim.x) {
            if (it < P0_TAB) cvt_fp8_item(p.in[26] + (size_t)PE * D, p.ws + WS_PU, (float*)(p.ws + WS_PU + 24 * MiB), it, false);
            else cvt_fp8_item(p.in[27] + (size_t)PE * D, p.ws + WS_PV, (float*)(p.ws + WS_PV + 24 * MiB), it - P0_TAB, false); } }
        return;
    }
    for (int it = first; it < 2 * P0_TAB; it += stride) {
        if (it < P0_TAB) cvt_fp8_item(p.in[26] + (size_t)PE * D, p.ws + WS_PU, (float*)(p.ws + WS_PU + 24 * MiB), it, false);
        else cvt_fp8_item(p.in[27] + (size_t)PE * D, p.ws + WS_PV, (float*)(p.ws + WS_PV + 24 * MiB), it - P0_TAB, false);
    }
}
__device__ __forceinline__ void phase_nsa_proj(const Params& p, unsigned char* lds) {
    const bf16_t* HM = (const bf16_t*)(p.ws + WS_HM); const bf16_t* WT = (const bf16_t*)(p.ws + WS_WPROJ_T);
    const f32x2* ROPE = (const f32x2*)(p.ws + WS_ROPE);
    bf16_t* Q = (bf16_t*)(p.ws + WS_Q); float* NGT = (float*)(p.ws + WS_NG);
    const int lane = threadIdx.x & 63, wid = threadIdx.x >> 6, wr = wid >> 1, wc = wid & 1, fr = lane & 15, fq = lane >> 4;
    for (int id = vblock(); id < 256 * 21; id += gridDim.x) {
        const int mt = id / 21, nt = id % 21;
        f32x4 acc[4][4];
        gemm_tile3(ALoadPlain{HM + (size_t)mt * 128 * D, (size_t)D}, WT + (size_t)nt * 128 * D, D, 16, acc, lds);
        const int c0 = nt * 128 + wc * 64;
        if (c0 >= 2624) continue;
        const int b = (mt * 128) / SEQ;
        if (c0 == 2560) {
#pragma unroll
            for (int mi = 0; mi < 4; ++mi)
#pragma unroll
                for (int ni = 0; ni < 3; ++ni) {
                    const int t = mt * 128 + wr * 64 + mi * 16 + fr;
                    const f32x4 v = acc[mi][ni];
                    *(f32x4*)(NGT + (size_t)t * 48 + ni * 16 + fq * 4) = (f32x4){sigmoidf_(v.x), sigmoidf_(v.y), sigmoidf_(v.z), sigmoidf_(v.w)};
                }
            continue;
        }
        int sec = -1, g = 0;
        if (c0 >= 1024) { sec = (c0 - 1024) >> 8; g = ((c0 - 1024) & 255) >> 6; }
        const bool dorope = (sec == -1) || (sec == 2) || (sec == 4);
        const float scl = (sec == -1) ? 0.125f : 1.0f;
        const size_t secoff[6] = {WS_KC, WS_VC, WS_KS, WS_VST, WS_KW, WS_VWT};
        size_t so = WS_Q;
#pragma unroll
        for (int q = 0; q < 6; ++q) if (sec == q) so = secoff[q];
        bf16_t* OUT = (bf16_t*)(p.ws + so);
        const bool vt = (sec == 3) || (sec == 5);
        float kblk_am = 0.f;
#pragma unroll
        for (int pass = 0; pass < 2; ++pass) {
        if (pass == 1 && sec == 2) {
#pragma unroll
            for (int o = 1; o < 64; o <<= 1) kblk_am = fmaxf(kblk_am, __shfl_xor(kblk_am, o));
            if (lane == 0) ((float*)(p.ws + WS_KS + 12 * MiB))[(size_t)(b * 4 + g) * 256 + ((mt * 128 + wr * 64 - b * SEQ) >> 6)] = kblk_am > 0.f ? kblk_am / 224.0f : 1.0f;
        }
#pragma unroll
        for (int mi = 0; mi < 4; ++mi) {
            const int t = mt * 128 + wr * 64 + mi * 16 + fr, s = t - b * SEQ;
            if (dorope && pass == 0) {
#pragma unroll
                for (int ni = 0; ni < 2; ++ni) {
                    const f32x4* rp = (const f32x4*)(ROPE + (size_t)s * 32 + ni * 16 + fq * 4);
                    const f32x4 r0 = rp[0], r1 = rp[1];
                    const f32x4 x1 = acc[mi][ni], x2 = acc[mi][ni + 2];
                    acc[mi][ni] = (f32x4){x1.x * r0.x - x2.x * r0.y, x1.y * r0.z - x2.y * r0.w, x1.z * r1.x - x2.z * r1.y, x1.w * r1.z - x2.w * r1.w};
                    acc[mi][ni + 2] = (f32x4){x1.x * r0.y + x2.x * r0.x, x1.y * r0.w + x2.y * r0.z, x1.z * r1.y + x2.z * r1.x, x1.w * r1.w + x2.w * r1.z};
                }
            }
            if (pass == 0) {
                if (sec == 2) {
#pragma unroll
                    for (int ni = 0; ni < 4; ++ni) { const f32x4 v = acc[mi][ni]; kblk_am = fmaxf(kblk_am, fmaxf(fmaxf(fabsf(v.x), fabsf(v.y)), fmaxf(fabsf(v.z), fabsf(v.w)))); }
                }
                continue;
            }
            if (sec == -1 || sec == 2) {
                float am = kblk_am;
                if (sec == -1) {
                    am = 0.f;
#pragma unroll
                    for (int ni = 0; ni < 4; ++ni) { const f32x4 v = acc[mi][ni] * scl; am = fmaxf(am, fmaxf(fmaxf(fabsf(v.x), fabsf(v.y)), fmaxf(fabsf(v.z), fabsf(v.w)))); }
                    am = fmaxf(am, __shfl_xor(am, 16)); am = fmaxf(am, __shfl_xor(am, 32));
                }
                const float qs = am > 0.f ? 224.0f / am : 1.0f;
                unsigned char* O8 = (sec == -1) ? (p.ws + WS_Q8 + (size_t)t * 1024 + c0) : (p.ws + WS_KS + ((size_t)(b * 4 + g) * SEQ + s) * 64);
#pragma unroll
                for (int ni = 0; ni < 4; ++ni) {
                    const f32x4 v = acc[mi][ni] * (scl * qs);
                    int w = 0; w = __builtin_amdgcn_cvt_pk_fp8_f32(v.x, v.y, w, false); w = __builtin_amdgcn_cvt_pk_fp8_f32(v.z, v.w, w, true);
                    *(int*)(O8 + ni * 16 + fq * 4) = w;
                }
                if (fq == 0 && sec == -1) ((float*)(p.ws + WS_Q8 + 32 * MiB))[(size_t)t * 16 + (c0 >> 6)] = am > 0.f ? am / 224.0f : 1.0f;
            }
            if (sec == 2) continue;
#pragma unroll
            for (int ni = 0; ni < 4; ++ni) {
                const f32x4 v = acc[mi][ni] * scl;
                const int d = ni * 16 + fq * 4;
                if (sec == -1) {
                    *(u32x2*)(OUT + (size_t)t * 1024 + c0 + d) = (u32x2){pk2(v.x, v.y), pk2(v.z, v.w)};
                } else if (sec == 4) {
                    const size_t idx = (size_t)(b * 4 + g) * SEQ * 64 + (size_t)(s >> 5) * 2048 + ((((s >> 4) & 1) * 2 + (ni >> 1)) * 16 + (s & 15)) * 32 + ((ni & 1) * 2 + (fq >> 1)) * 8 + (fq & 1) * 4;
                    *(u32x2*)(OUT + idx) = (u32x2){pk2(v.x, v.y), pk2(v.z, v.w)};
                } else if (!vt) {
                    *(u32x2*)(OUT + ((size_t)(b * 4 + g) * SEQ + s) * 64 + d) = (u32x2){pk2(v.x, v.y), pk2(v.z, v.w)};
                } else if (sec == 5) {
                    const int key = s & 31;
                    bf16_t* o = OUT + (size_t)(b * 4 + g) * SEQ * 64 + (size_t)(s >> 5) * 2048 + ((ni * 2 + (key >> 4)) * 16 + fq * 4) * 16 + ((key >> 2) & 3) * 4 + (key & 3);
                    o[0] = (bf16_t)f2bf(v.x); o[16] = (bf16_t)f2bf(v.y); o[32] = (bf16_t)f2bf(v.z); o[48] = (bf16_t)f2bf(v.w);
                }
            }
        }
        }
        if (sec == 3) {
            const int s0 = mt * 128 + wr * 64 - b * SEQ, jb = s0 >> 6;
            unsigned char* V8 = p.ws + WS_VST + (size_t)((b * 4 + g) * 256 + jb) * 4096;
            float am = 0.f;
#pragma unroll
            for (int mi = 0; mi < 4; ++mi)
#pragma unroll
                for (int ni = 0; ni < 4; ++ni) { const f32x4 v = acc[mi][ni]; am = fmaxf(am, fmaxf(fmaxf(fabsf(v.x), fabsf(v.y)), fmaxf(fabsf(v.z), fabsf(v.w)))); }
#pragma unroll
            for (int o = 1; o < 64; o <<= 1) am = fmaxf(am, __shfl_xor(am, o));
            const float qs = am > 0.f ? 224.0f / am : 1.0f;
            if (lane == 0) ((float*)(p.ws + WS_VST + 12 * MiB))[(size_t)(b * 4 + g) * 256 + jb] = am > 0.f ? am / 224.0f : 1.0f;
#pragma unroll
            for (int ni = 0; ni < 4; ++ni) {
                const int d = ni * 16 + fq * 4;
#pragma unroll
                for (int mi = 0; mi < 4; ++mi) {
                    const f32x4 v = acc[mi][ni] * qs;
                    int w = 0; w = __builtin_amdgcn_cvt_pk_fp8_f32(v.x, v.y, w, false); w = __builtin_amdgcn_cvt_pk_fp8_f32(v.z, v.w, w, true);
                    unsigned char* o = V8 + (size_t)d * 64 + mi * 16 + fr;
                    o[0] = (unsigned char)(w & 255); o[64] = (unsigned char)((w >> 8) & 255); o[128] = (unsigned char)((w >> 16) & 255); o[192] = (unsigned char)((unsigned)w >> 24);
                }
            }
        }
    }
}
__device__ __forceinline__ void phase_nsa_cmp1(const Params& p, unsigned char* lds) {
    bf16_t* HID = (bf16_t*)(p.ws + WS_HID);
    const float* bias = (const float*)(p.ws + WS_MISC);
    const int lane = threadIdx.x & 63, wid = threadIdx.x >> 6, wr = wid >> 1, wc = wid & 1, fr = lane & 15, fq = lane >> 4;
    for (int id = vblock(); id < 256; id += gridDim.x) {
        const int kv = id >> 7, bg = (id >> 4) & 7, mt = (id >> 1) & 7, nt = id & 1;
        const bf16_t* A = (const bf16_t*)(p.ws + (kv ? WS_VC : WS_KC)) + (size_t)bg * SEQ * 64 + (size_t)mt * 128 * 1024;
        const bf16_t* B = (const bf16_t*)(p.ws + (kv ? WS_WV1_T : WS_WK1_T)) + (size_t)nt * 128 * 2048;
        f32x4 acc[4][4];
        gemm_tile3(ALoadPlain{A, (size_t)1024}, B, 2048, 32, acc, lds);
#pragma unroll
        for (int mi = 0; mi < 4; ++mi)
#pragma unroll
            for (int ni = 0; ni < 4; ++ni) {
                const int n = mt * 128 + wr * 64 + mi * 16 + fr, c = nt * 128 + wc * 64 + ni * 16 + fq * 4;
                const f32x4 bv = *(const f32x4*)(bias + kv * 256 + c);
                const f32x4 v = acc[mi][ni] + bv;
                *(u32x2*)(HID + (((size_t)kv * 8 + bg) * 1024 + n) * 256 + c) = (u32x2){pk2(gelu_tanh(v.x), gelu_tanh(v.y)), pk2(gelu_tanh(v.z), gelu_tanh(v.w))};
            }
    }
}
__device__ __forceinline__ void phase_nsa_cmp2(const Params& p, unsigned char* lds) {
    const bf16_t* HID = (const bf16_t*)(p.ws + WS_HID);
    const f32x2* ROPE = (const f32x2*)(p.ws + WS_ROPE);
    bf16_t* KCMP = (bf16_t*)(p.ws + WS_KCMP); bf16_t* VCMPT = (bf16_t*)(p.ws + WS_VCMPT);
    const int lane = threadIdx.x & 63, wid = threadIdx.x >> 6, wr = wid >> 1, wc = wid & 1, fr = lane & 15, fq = lane >> 4;
    for (int id = vblock(); id < 128; id += gridDim.x) {
        const int kv = id >> 6, mt = id & 63;
        const bf16_t* A = HID + ((size_t)kv * 8192 + (size_t)mt * 128) * 256;
        const bf16_t* B = (const bf16_t*)(p.ws + (kv ? WS_WV2_T : WS_WK2_T));
        f32x4 acc[4][4];
        gemm_tile3(ALoadPlain{A, (size_t)256}, B, 256, 4, acc, lds);
        if (wc == 1) continue;
#pragma unroll
        for (int mi = 0; mi < 4; ++mi) {
            const int R = mt * 128 + wr * 64 + mi * 16 + fr, bg = R >> 10, n = R & 1023;
            if (kv == 0) {
                int pos = n * 16 + 31; pos = pos > SEQ - 1 ? SEQ - 1 : pos;
#pragma unroll
                for (int ni = 0; ni < 2; ++ni) {
                    const f32x4* rp = (const f32x4*)(ROPE + (size_t)pos * 32 + ni * 16 + fq * 4);
                    const f32x4 r0 = rp[0], r1 = rp[1];
                    const f32x4 x1 = acc[mi][ni], x2 = acc[mi][ni + 2];
                    acc[mi][ni] = (f32x4){x1.x * r0.x - x2.x * r0.y, x1.y * r0.z - x2.y * r0.w, x1.z * r1.x - x2.z * r1.y, x1.w * r1.z - x2.w * r1.w};
                    acc[mi][ni + 2] = (f32x4){x1.x * r0.y + x2.x * r0.x, x1.y * r0.w + x2.y * r0.z, x1.z * r1.y + x2.z * r1.x, x1.w * r1.w + x2.w * r1.z};
                }
#pragma unroll
                for (int ni = 0; ni < 4; ++ni) {
                    const f32x4 v = acc[mi][ni];
                    const size_t idx = (size_t)bg * 1024 * 64 + (size_t)(n >> 5) * 2048 + ((((n >> 4) & 1) * 2 + (ni >> 1)) * 16 + (n & 15)) * 32 + ((ni & 1) * 2 + (fq >> 1)) * 8 + (fq & 1) * 4;
                    *(u32x2*)(KCMP + idx) = (u32x2){pk2(v.x, v.y), pk2(v.z, v.w)};
                }
            } else {
#pragma unroll
                for (int ni = 0; ni < 4; ++ni) {
                    const f32x4 v = acc[mi][ni];
                    const int key = n & 31;
                    bf16_t* o = VCMPT + (size_t)bg * 1024 * 64 + (size_t)(n >> 5) * 2048 + ((ni * 2 + (key >> 4)) * 16 + fq * 4) * 16 + ((key >> 2) & 3) * 4 + (key & 3);
                    o[0] = (bf16_t)f2bf(v.x); o[16] = (bf16_t)f2bf(v.y); o[32] = (bf16_t)f2bf(v.z); o[48] = (bf16_t)f2bf(v.w);
                }
            }
        }
    }
}
__device__ __forceinline__ void phase_nsa_wo(const Params& p, unsigned char* lds, bool dry) {
    const bf16_t* O = (const bf16_t*)(p.ws + WS_O); const bf16_t* WT = (const bf16_t*)(p.ws + WS_WO_T);
    const float* MOD = (const float*)(p.ws + WS_MOD);
    float* X = p.out;
    const int lane = threadIdx.x & 63, wid = threadIdx.x >> 6, wr = wid >> 1, wc = wid & 1, fr = lane & 15, fq = lane >> 4;
    for (int id = vblock(); id < 256 * 8; id += gridDim.x) {
        const int mt = id >> 3, nt = id & 7;
        f32x4 acc[4][4];
        gemm_tile3(ALoadPlain{O + (size_t)mt * 128 * D, (size_t)D}, WT + (size_t)nt * 128 * D, D, 16, acc, lds);
        const int b = (mt * 128) / SEQ;
#pragma unroll
        for (int mi = 0; mi < 4; ++mi)
#pragma unroll
            for (int ni = 0; ni < 4; ++ni) {
                const int t = mt * 128 + wr * 64 + mi * 16 + fr, c = nt * 128 + wc * 64 + ni * 16 + fq * 4;
                const f32x4 g1 = *(const f32x4*)(MOD + (size_t)(1 * 2 + b) * 6144 + 2048 + c);
                float* xp = X + (size_t)t * D + c;
                const f32x4 x = *(const f32x4*)xp; const f32x4 v = acc[mi][ni];
                if (!dry) *(f32x4*)xp = (f32x4){x.x + g1.x * v.x, x.y + g1.y * v.y, x.z + g1.z * v.z, x.w + g1.w * v.w};
            }
    }
}
__device__ __forceinline__ bf16x8 pack8(const f32x4 a, const f32x4 b) {
    u32x4 w; w.x = pk2(a.x, a.y); w.y = pk2(a.z, a.w); w.z = pk2(b.x, b.y); w.w = pk2(b.z, b.w);
    return __builtin_bit_cast(bf16x8, w);
}
__device__ __forceinline__ bf16x8 ldv8(const bf16_t* plo, const bf16_t* phi) {
    const u32x2 lo = *(const u32x2*)plo, hi = *(const u32x2*)phi;
    u32x4 w; w.x = lo.x; w.y = lo.y; w.z = hi.x; w.w = hi.y;
    return __builtin_bit_cast(bf16x8, w);
}
__device__ __forceinline__ float red4(float v) { v += __shfl_xor(v, 16); v += __shfl_xor(v, 32); return v; }
__device__ __forceinline__ float max4(float v) { v = fmaxf(v, __shfl_xor(v, 16)); v = fmaxf(v, __shfl_xor(v, 32)); return v; }
#define NEGBIG (-1.0e30f)

__device__ __forceinline__ void phase_nsa_attn(const Params& p, unsigned char* lds, const int rep_cmp, const int rep_win, const int rep_sel) {
    const int lane = threadIdx.x & 63, wave = threadIdx.x >> 6, fr = lane & 15, fq = lane >> 4;
    unsigned char* WL = lds + wave * 18432;
    float* IMP = (float*)WL;
    int* SEL = (int*)(WL + 17408);
    const bf16_t* Q = (const bf16_t*)(p.ws + WS_Q);
    const bf16_t* KCMP = (const bf16_t*)(p.ws + WS_KCMP); const bf16_t* VCMPT = (const bf16_t*)(p.ws + WS_VCMPT);
    const bf16_t* KW = (const bf16_t*)(p.ws + WS_KW); const bf16_t* VWT = (const bf16_t*)(p.ws + WS_VWT);
    const float* NGT = (const float*)(p.ws + WS_NG);
    bf16_t* O = (bf16_t*)(p.ws + WS_O);
    const f32x4 z4 = (f32x4){0.f, 0.f, 0.f, 0.f};
    for (int bi = blockIdx.x; bi < 2048; bi += gridDim.x) {
        const int bg = bi & 7, quad = 255 - (bi >> 3), t0 = (quad * 4 + wave) * 16, b = bg >> 2, g = bg & 3;
        const int cur = t0 >> 6;
        const size_t tok = (size_t)b * SEQ + t0 + fr;
        const int tq = t0 + fr;
        bf16x8 qf[4][2];
#pragma unroll
        for (int r = 0; r < 4; ++r)
#pragma unroll
            for (int ks = 0; ks < 2; ++ks) qf[r][ks] = *(const bf16x8*)(Q + tok * 1024 + (g * 4 + r) * 64 + ks * 32 + fq * 8);
        f32x4 acc[4][4];
        for (int rep = 0; rep < rep_win; ++rep) {
            const bf16_t* kwb = KW + (size_t)bg * SEQ * 64; const bf16_t* vwb = VWT + (size_t)bg * SEQ * 64;
            float mw[4], lw[4];
#pragma unroll
            for (int r = 0; r < 4; ++r) { mw[r] = NEGBIG; lw[r] = 0.f;
#pragma unroll
                for (int df = 0; df < 4; ++df) acc[r][df] = z4; }
            int kmin = t0 - 511; kmin = kmin < 0 ? 0 : kmin; kmin &= ~31;
            bf16x8 nkf[2][2];
#define WIN_LOAD(kb_) do { _Pragma("unroll") for (int f = 0; f < 2; ++f) _Pragma("unroll") for (int ks = 0; ks < 2; ++ks) nkf[f][ks] = *(const bf16x8*)(kwb + (size_t)((kb_) >> 5) * 2048 + ((f * 2 + ks) * 16 + fr) * 32 + fq * 8); } while (0)
            WIN_LOAD(kmin);
            for (int kb = kmin; kb <= t0 + 15; kb += 32) {
                bf16x8 kf[2][2], vf[4];
#pragma unroll
                for (int f = 0; f < 2; ++f) { kf[f][0] = nkf[f][0]; kf[f][1] = nkf[f][1]; }
#pragma unroll
                for (int df = 0; df < 4; ++df) { const bf16_t* vp = vwb + (size_t)(kb >> 5) * 2048 + (df * 32 + fr) * 16 + fq * 4; vf[df] = ldv8(vp, vp + 256); }
                { const int kn = (kb + 32 <= t0 + 15) ? kb + 32 : kb; WIN_LOAD(kn); }
#pragma unroll
                for (int r = 0; r < 4; ++r) {
                    f32x4 st[2];
#pragma unroll
                    for (int f = 0; f < 2; ++f) {
                        st[f] = __builtin_amdgcn_mfma_f32_16x16x32_bf16(kf[f][0], qf[r][0], z4, 0, 0, 0);
                        st[f] = __builtin_amdgcn_mfma_f32_16x16x32_bf16(kf[f][1], qf[r][1], st[f], 0, 0, 0);
                    }
                    float mx = NEGBIG;
#pragma unroll
                    for (int f = 0; f < 2; ++f)
#pragma unroll
                        for (int e = 0; e < 4; ++e) { const int key = kb + f * 16 + fq * 4 + e; const bool ok = (key <= tq) && (key > tq - 512); if (ok) mx = fmaxf(mx, st[f][e]); }
                    float mn = mw[r], al = 1.0f;
                    if (__builtin_amdgcn_ballot_w64(mx > mw[r] + 8.0f) != 0ull) { mn = fmaxf(mw[r], max4(mx)); al = __expf(mw[r] - mn); }
                    float ps = 0.f;
#pragma unroll
                    for (int f = 0; f < 2; ++f)
#pragma unroll
                        for (int e = 0; e < 4; ++e) { const int key = kb + f * 16 + fq * 4 + e; const bool ok = (key <= tq) && (key > tq - 512); const float pv = ok ? __expf(st[f][e] - mn) : 0.f; st[f][e] = pv; ps += pv; }
                    lw[r] = lw[r] * al + ps; mw[r] = mn;
                    const bf16x8 pf = pack8(st[0], st[1]);
#pragma unroll
                    for (int df = 0; df < 4; ++df) { acc[r][df] = acc[r][df] * al; acc[r][df] = __builtin_amdgcn_mfma_f32_16x16x32_bf16(vf[df], pf, acc[r][df], 0, 0, 0); }
                    __builtin_amdgcn_sched_barrier(0);
                }
            }
#pragma unroll
            for (int r = 0; r < 4; ++r) {
                const float l = red4(lw[r]); const float sc = NGT[tok * 48 + (g * 4 + r) * 3 + 2] / l;
#pragma unroll
                for (int df = 0; df < 4; ++df) acc[r][df] = acc[r][df] * sc;
            }
#undef WIN_LOAD
        }
        const int nmax_tile = (t0 >> 4) - 1, nmax_lane = (t0 >> 4) - 2 + (fr == 15 ? 1 : 0);
        const bf16_t* kcb = KCMP + (size_t)bg * 1024 * 64; const bf16_t* vcb = VCMPT + (size_t)bg * 64 * 1024;
        for (int rep = 0; rep < rep_cmp; ++rep) {
            const bool dry = (rep + 1 < rep_cmp);
            float mc[4], lc[4], invl[4];
#pragma unroll
            for (int r = 0; r < 4; ++r) { mc[r] = NEGBIG; lc[r] = 0.f; }
            bf16x8 nkc[2][2], nvc[4];
#define CMPK_LOAD(nb_) do { _Pragma("unroll") for (int f = 0; f < 2; ++f) _Pragma("unroll") for (int ks = 0; ks < 2; ++ks) nkc[f][ks] = *(const bf16x8*)(kcb + (size_t)((nb_) >> 5) * 2048 + ((f * 2 + ks) * 16 + fr) * 32 + fq * 8); } while (0)
#define CMPV_LOAD(nb_) do { _Pragma("unroll") for (int df = 0; df < 4; ++df) { const bf16_t* vp = vcb + (size_t)((nb_) >> 5) * 2048 + (df * 32 + fr) * 16 + fq * 4; nvc[df] = ldv8(vp, vp + 256); } } while (0)
            CMPK_LOAD(0);
            for (int nb = 0; nb <= nmax_tile; nb += 32) {
                bf16x8 kf[2][2];
#pragma unroll
                for (int f = 0; f < 2; ++f) { kf[f][0] = nkc[f][0]; kf[f][1] = nkc[f][1]; }
                { const int nn = (nb + 32 <= nmax_tile) ? nb + 32 : 0; CMPK_LOAD(nn); }
#pragma unroll
                for (int r = 0; r < 4; ++r) {
                    f32x4 st[2];
#pragma unroll
                    for (int f = 0; f < 2; ++f) {
                        st[f] = __builtin_amdgcn_mfma_f32_16x16x32_bf16(kf[f][0], qf[r][0], z4, 0, 0, 0);
                        st[f] = __builtin_amdgcn_mfma_f32_16x16x32_bf16(kf[f][1], qf[r][1], st[f], 0, 0, 0);
                    }
                    float mx = NEGBIG;
#pragma unroll
                    for (int f = 0; f < 2; ++f)
#pragma unroll
                        for (int e = 0; e < 4; ++e) { const int n = nb + f * 16 + fq * 4 + e; if (n <= nmax_lane) mx = fmaxf(mx, st[f][e]); }
                    float mn = mc[r];
                    if (__builtin_amdgcn_ballot_w64(mx > mc[r] + 8.0f) != 0ull) mn = fmaxf(mc[r], max4(mx));
                    float ps = 0.f;
#pragma unroll
                    for (int f = 0; f < 2; ++f)
#pragma unroll
                        for (int e = 0; e < 4; ++e) { const int n = nb + f * 16 + fq * 4 + e; if (n <= nmax_lane) ps += __expf(st[f][e] - mn); }
                    lc[r] = lc[r] * __expf(mc[r] - mn) + ps; mc[r] = mn;
                    __builtin_amdgcn_sched_barrier(0);
                }
            }
#pragma unroll
            for (int r = 0; r < 4; ++r) { const float l = red4(lc[r]); invl[r] = l > 0.f ? 1.0f / l : 0.f; }
            for (int i = lane; i < 16 * 260; i += 64) IMP[i] = 0.f;
            float carry = 0.f;
            float gc[4];
#pragma unroll
            for (int r = 0; r < 4; ++r) gc[r] = NGT[tok * 48 + (g * 4 + r) * 3];
            for (int nb = 0; nb <= nmax_tile; nb += 32) {
                bf16x8 kf[2][2], vf[4];
#pragma unroll
                for (int f = 0; f < 2; ++f) { kf[f][0] = nkc[f][0]; kf[f][1] = nkc[f][1]; }
                CMPV_LOAD(nb);
#pragma unroll
                for (int df = 0; df < 4; ++df) vf[df] = nvc[df];
                { const int nn = (nb + 32 <= nmax_tile) ? nb + 32 : nb; CMPK_LOAD(nn); }
                f32x4 pg[2] = {z4, z4};
#pragma unroll
                for (int r = 0; r < 4; ++r) {
                    f32x4 st[2];
#pragma unroll
                    for (int f = 0; f < 2; ++f) {
                        st[f] = __builtin_amdgcn_mfma_f32_16x16x32_bf16(kf[f][0], qf[r][0], z4, 0, 0, 0);
                        st[f] = __builtin_amdgcn_mfma_f32_16x16x32_bf16(kf[f][1], qf[r][1], st[f], 0, 0, 0);
#pragma unroll
                        for (int e = 0; e < 4; ++e) { const int n = nb + f * 16 + fq * 4 + e; st[f][e] = (n <= nmax_lane) ? __expf(st[f][e] - mc[r]) * invl[r] : 0.f; }
                        pg[f] += st[f];
                    }
                    const float gg = dry ? 0.f : gc[r];
                    const bf16x8 pf = pack8(st[0] * gg, st[1] * gg);
#pragma unroll
                    for (int df = 0; df < 4; ++df) acc[r][df] = __builtin_amdgcn_mfma_f32_16x16x32_bf16(vf[df], pf, acc[r][df], 0, 0, 0);
                    __builtin_amdgcn_sched_barrier(0);
                }
                const int src = (lane - 16) & 63;
                const float s0 = __shfl(pg[0].w, src), s1 = __shfl(pg[1].w, src), sc = __shfl(carry, src);
                const float prev0 = fq > 0 ? s0 : sc, prev1 = fq > 0 ? s1 : s0;
                const float imp0 = (pg[0].x + pg[0].y) + (pg[0].z + pg[0].w) + prev0;
                const float imp1 = (pg[1].x + pg[1].y) + (pg[1].z + pg[1].w) + prev1;
                const int jb = (nb >> 2) + fq;
                IMP[fr * 260 + jb] = imp0; IMP[fr * 260 + jb + 4] = imp1;
                carry = pg[1].w;
            }
#undef CMPK_LOAD
#undef CMPV_LOAD
        }
        {
            const int nf = cur >= 2 ? 3 : cur + 1;
            if (fq == 0) {
                SEL[fr * 16 + 0] = 0;
                if (cur == 1) SEL[fr * 16 + 1] = 1;
                if (cur >= 2) { SEL[fr * 16 + 1] = cur - 1; SEL[fr * 16 + 2] = cur; }
            }
            const int ncand = cur >= 3 ? cur - 2 : 0, extra = 16 - nf;
            if (ncand <= extra) {
                if (fq == 0) { for (int k = 0; k < extra; ++k) SEL[fr * 16 + nf + k] = (k < ncand) ? 1 + k : -1; }
            } else {
                for (int rnd = 0; rnd < extra; ++rnd) {
                    float bv = -1.0f; int bj = 1 << 20;
                    for (int jb = 1 + fq; jb <= cur - 2; jb += 4) { const float v = IMP[fr * 260 + jb]; if (v > bv) { bv = v; bj = jb; } }
#pragma unroll
                    for (int o = 16; o <= 32; o <<= 1) {
                        const float ov = __shfl_xor(bv, o); const int oj = __shfl_xor(bj, o);
                        if (ov > bv || (ov == bv && oj < bj)) { bv = ov; bj = oj; }
                    }
                    if (fq == 0) SEL[fr * 16 + nf + rnd] = bj;
                    if (((bj - 1) & 3) == fq) IMP[fr * 260 + bj] = -2.0f;
                }
            }
        }
#pragma unroll
        for (int r = 0; r < 4; ++r)
#pragma unroll
            for (int df = 0; df < 4; ++df) {
                const f32x4 v = acc[r][df];
                *(u32x2*)(O + tok * 1024 + (g * 4 + r) * 64 + df * 16 + fq * 4) = (u32x2){pk2(v.x, v.y), pk2(v.z, v.w)};
            }
        asm volatile("s_waitcnt vmcnt(0)" ::: "memory");
        unsigned selp[4];
        {
            const u32x4* sp = (const u32x4*)(SEL + fr * 16);
#pragma unroll
            for (int q = 0; q < 4; ++q) { const u32x4 w = sp[q]; selp[q] = (w.x & 255u) | ((w.y & 255u) << 8) | ((w.z & 255u) << 16) | ((w.w & 255u) << 24); }
        }
        for (int rep = 0; rep < rep_sel; ++rep) {
            const bool dry = (rep + 1 < rep_sel);
            const unsigned char* k8b = p.ws + WS_KS + (size_t)bg * SEQ * 64; const unsigned char* v8b = p.ws + WS_VST + (size_t)bg * 256 * 4096;
            const float* skb = (const float*)(p.ws + WS_KS + 12 * MiB) + (size_t)bg * 256; const float* svb = (const float*)(p.ws + WS_VST + 12 * MiB) + (size_t)bg * 256;
            const unsigned char* Q8 = p.ws + WS_Q8; const float* SQ8 = (const float*)(p.ws + WS_Q8 + 32 * MiB);
            const int nv = cur + 1 < 16 ? cur + 1 : 16, npair = (nv + 1) >> 1, total = 16 * npair;
            const int lrow = lane >> 2, lch = lane & 3;
            const int woff = lrow * 72 + lch * 16;
            const int rr = fr & 3;
            u32x4 sk[2][4], sv[2][4]; float ssk[2], ssv[2];
            int jbn[2];
#define SEL_GET(tokI, slotK) ((int)(((unsigned)__builtin_amdgcn_readlane((int)(((slotK) >> 2) == 0 ? selp[0] : ((slotK) >> 2) == 1 ? selp[1] : ((slotK) >> 2) == 2 ? selp[2] : selp[3]), (tokI)) >> (((slotK) & 3) * 8)) & 255u))
#define SEL_ISSUE(tokI, pairP) do { \
                const int k0_ = 2 * (pairP), k1_ = (2 * (pairP) + 1 < nv) ? 2 * (pairP) + 1 : k0_; \
                jbn[0] = __builtin_amdgcn_readfirstlane(SEL_GET(tokI, k0_)); jbn[1] = __builtin_amdgcn_readfirstlane(SEL_GET(tokI, k1_)); \
                _Pragma("unroll") for (int u = 0; u < 2; ++u) { \
                    const unsigned char* kb_ = k8b + (size_t)jbn[u] * 4096; const unsigned char* vb_ = v8b + (size_t)jbn[u] * 4096; \
                    _Pragma("unroll") for (int j = 0; j < 4; ++j) { sk[u][j] = *(const u32x4*)(kb_ + j * 1024 + lane * 16); sv[u][j] = *(const u32x4*)(vb_ + j * 1024 + lane * 16); } \
                    ssk[u] = skb[jbn[u]]; ssv[u] = svb[jbn[u]]; } } while (0)
            SEL_ISSUE(0, 0);
            long qs8[2] = {0, 0};
            float sq = 0.f, ms = NEGBIG, ls = 0.f;
            f32x4 os[4] = {z4, z4, z4, z4};
            u32x2 oprev[4] = {(u32x2){0u, 0u}, (u32x2){0u, 0u}, (u32x2){0u, 0u}, (u32x2){0u, 0u}};
            int i = 0, pp = 0;
            for (int v = 0; v < total; ++v) {
                const int jb0 = jbn[0], jb1 = jbn[1];
                const bool second_valid = (2 * pp + 1 < nv);
                const float ck0 = ssk[0], ck1 = ssk[1], cv0 = ssv[0], cv1 = ssv[1];
#pragma unroll
                for (int u = 0; u < 2; ++u)
#pragma unroll
                    for (int j = 0; j < 4; ++j) {
                        unsigned char* kd = WL + u * 9216 + woff + j * 1152; unsigned char* vd = kd + 4608;
                        *(u32x2*)kd = (u32x2){sk[u][j].x, sk[u][j].y}; *(u32x2*)(kd + 8) = (u32x2){sk[u][j].z, sk[u][j].w};
                        *(u32x2*)vd = (u32x2){sv[u][j].x, sv[u][j].y}; *(u32x2*)(vd + 8) = (u32x2){sv[u][j].z, sv[u][j].w};
                    }
                if (v + 1 < total) {
                    int p2 = pp + 1, i2 = i; if (p2 == npair) { p2 = 0; i2 = i + 1; }
                    SEL_ISSUE(i2, p2);
                }
                __builtin_amdgcn_sched_barrier(0);
                const int ti = t0 + i;
                if (pp == 0) {
                    const size_t tk = (size_t)b * SEQ + ti;
#pragma unroll
                    for (int ks = 0; ks < 2; ++ks) qs8[ks] = *(const long*)(Q8 + tk * 1024 + (g * 4 + rr) * 64 + ks * 32 + fq * 8);
                    sq = SQ8[tk * 16 + g * 4 + rr] * 1.4426950408889634f;
                    ms = NEGBIG; ls = 0.f;
#pragma unroll
                    for (int df = 0; df < 4; ++df) { os[df] = z4; oprev[df] = *(const u32x2*)(O + tk * 1024 + (g * 4 + rr) * 64 + df * 16 + fq * 4); }
                }
                f32x4 st[2][4];
#pragma unroll
                for (int u = 0; u < 2; ++u)
#pragma unroll
                    for (int f = 0; f < 4; ++f) {
                        const unsigned char* kp = WL + u * 9216 + (32 * (f >> 1) + 8 * (fr >> 2) + 4 * (f & 1) + (fr & 3)) * 72 + fq * 8;
                        const long k0 = *(const long*)kp, k1 = *(const long*)(kp + 32);
                        st[u][f] = __builtin_amdgcn_mfma_f32_16x16x32_fp8_fp8(k0, qs8[0], z4, 0, 0, 0);
                        st[u][f] = __builtin_amdgcn_mfma_f32_16x16x32_fp8_fp8(k1, qs8[1], st[u][f], 0, 0, 0);
                    }
                const float c0_ = sq * ck0, c1_ = sq * ck1;
                if (jb0 == cur || jb1 == cur || !second_valid) {
#pragma unroll
                    for (int u = 0; u < 2; ++u) {
                        const int jbu = u ? jb1 : jb0;
                        const bool allbad = (u == 1) && !second_valid;
#pragma unroll
                        for (int f = 0; f < 4; ++f)
#pragma unroll
                            for (int e = 0; e < 4; ++e) { const int key = jbu * 64 + 32 * (f >> 1) + 8 * fq + 4 * (f & 1) + e; if (allbad || key > ti) st[u][f][e] = NEGBIG; }
                    }
                }
                float mx0 = NEGBIG, mx1 = NEGBIG;
#pragma unroll
                for (int f = 0; f < 4; ++f) { mx0 = fmaxf(mx0, fmaxf(fmaxf(st[0][f].x, st[0][f].y), fmaxf(st[0][f].z, st[0][f].w))); mx1 = fmaxf(mx1, fmaxf(fmaxf(st[1][f].x, st[1][f].y), fmaxf(st[1][f].z, st[1][f].w))); }
                const float mxl = fmaxf(mx0 > -1.0e29f ? mx0 * c0_ : NEGBIG, mx1 > -1.0e29f ? mx1 * c1_ : NEGBIG);
                float mn = ms, al = 1.0f;
                if (__builtin_amdgcn_ballot_w64(mxl > ms + 4.0f) != 0ull) {
                    mn = fmaxf(ms, max4(mxl));
                    al = __builtin_amdgcn_exp2f(ms - mn);
                }
                const float off = 4.0f - mn;
                float ps = 0.f;
                long pfw[2][2];
#pragma unroll
                for (int u = 0; u < 2; ++u) {
                    const float cu = u ? c1_ : c0_;
#pragma unroll
                    for (int f = 0; f < 4; ++f)
#pragma unroll
                        for (int e = 0; e < 4; ++e) { const float pv = __builtin_amdgcn_exp2f(st[u][f][e] * cu + off); st[u][f][e] = pv; ps += pv; }
#pragma unroll
                    for (int s = 0; s < 2; ++s) {
                        int w0 = 0, w1 = 0;
                        w0 = __builtin_amdgcn_cvt_pk_fp8_f32(st[u][2 * s].x, st[u][2 * s].y, w0, false); w0 = __builtin_amdgcn_cvt_pk_fp8_f32(st[u][2 * s].z, st[u][2 * s].w, w0, true);
                        w1 = __builtin_amdgcn_cvt_pk_fp8_f32(st[u][2 * s + 1].x, st[u][2 * s + 1].y, w1, false); w1 = __builtin_amdgcn_cvt_pk_fp8_f32(st[u][2 * s + 1].z, st[u][2 * s + 1].w, w1, true);
                        pfw[u][s] = (long)(((unsigned long long)(unsigned)w1 << 32) | (unsigned long long)(unsigned)w0);
                    }
                }
                ls = ls * al + ps; ms = mn;
#pragma unroll
                for (int df = 0; df < 4; ++df) os[df] = os[df] * al;
#pragma unroll
                for (int u = 0; u < 2; ++u) {
                    f32x4 pvacc[4] = {z4, z4, z4, z4};
#pragma unroll
                    for (int s = 0; s < 2; ++s) {
#pragma unroll
                        for (int df = 0; df < 4; ++df) {
                            const long vf = *(const long*)(WL + u * 9216 + 4608 + (df * 16 + fr) * 72 + 32 * s + 8 * fq);
                            pvacc[df] = __builtin_amdgcn_mfma_f32_16x16x32_fp8_fp8(vf, pfw[u][s], pvacc[df], 0, 0, 0);
                        }
                    }
                    const float cvu = u ? cv1 : cv0;
#pragma unroll
                    for (int df = 0; df < 4; ++df) os[df] = os[df] + pvacc[df] * cvu;
                    __builtin_amdgcn_sched_barrier(0);
                }
                if (pp == npair - 1) {
                    const float l = red4(ls);
                    const float gsv = NGT[((size_t)b * SEQ + ti) * 48 + (g * 4 + rr) * 3 + 1];
                    const float sc = gsv / l;
                    if (fr < 4 && !dry) {
                        bf16_t* op = O + ((size_t)b * SEQ + ti) * 1024 + (g * 4 + fr) * 64 + fq * 4;
#pragma unroll
                        for (int df = 0; df < 4; ++df) {
                            const f32x4 val = os[df] * sc; const u32x2 c = oprev[df];
                            *(u32x2*)(op + df * 16) = (u32x2){pk2(bflo(c.x) + val.x, bfhi(c.x) + val.y), pk2(bflo(c.y) + val.z, bfhi(c.y) + val.w)};
                        }
                    }
                }
                ++pp; if (pp == npair) { pp = 0; ++i; }
            }
#undef SEL_GET
#undef SEL_ISSUE
        }
    }
}
constexpr int NPHASES = 18;
#ifndef PROBE_PHASE
#define PROBE_PHASE (-1)
#endif
#ifndef ATT_REP_CMP
#define ATT_REP_CMP 1
#endif
#ifndef ATT_REP_WIN
#define ATT_REP_WIN 1
#endif
#ifndef ATT_REP_SEL
#define ATT_REP_SEL 1
#endif
#ifndef TS_PHASE
#define TS_PHASE (-1)
#endif
#ifndef TS_MULT
#define TS_MULT 4
#endif
#ifndef PROBE_REPS
#define PROBE_REPS 1
#endif
__global__ void __launch_bounds__(NTHREADS, 2) mega(Params p) {
    __shared__ __attribute__((aligned(1024))) unsigned char lds[LDS_BYTES + 16];
    unsigned* bar_st = (unsigned*)(lds + LDS_BYTES);
    cg::grid_group grid = cg::this_grid();
    const float* MOD = (const float*)(p.ws + WS_MOD);
    bf16_t* HM = (bf16_t*)(p.ws + WS_HM);
    if (threadIdx.x < 4) bar_st[threadIdx.x] = 0u;
    __syncthreads();
    XcdBarrier bar = xcd_barrier_post((unsigned*)(p.ws + WS_CTL), (volatile LAS unsigned*)bar_st);
    const int lo = p.ph_lo, hi = p.ph_hi;
    const bool dry0 = (p.ph_hi < 0);
    const int opq = (p.ph_hi < 0) ? 1 : 0;
    const bool never = (p.ph_hi < 0);
    unsigned long long ts_a = 0ull, ts_b = 0ull;
#define PHASE(k, call, drycall) if (lo <= (k) && (k) < hi) { \
        if (TS_PHASE == (k)) ts_a = __builtin_amdgcn_s_memrealtime(); \
        if (PROBE_PHASE == (k)) { for (int rep = 0; rep < PROBE_REPS; ++rep) { const bool dry = !dry0; drycall; __syncthreads(); } } \
        { const bool dry = dry0; call; } \
        if ((k) + 1 < hi) { if (never) grid.sync(); else xcd_barrier(bar); } \
        if (TS_PHASE == (k)) ts_b = __builtin_amdgcn_s_memrealtime(); }
    PHASE(0, phase_prep(p, (float*)lds, 0), phase_prep(p, (float*)lds, 0))
    PHASE(1, phase_norm(p, p.in[0], p.in[2], MOD + 0, MOD + 1024, HM), phase_norm(p, p.in[0], p.in[2], MOD + 0, MOD + 1024, HM))
    PHASE(2, phase_s5_win(p, lds), phase_s5_win(p, lds))
    PHASE(3, phase_s5_a(p, lds), phase_s5_a(p, lds))
    PHASE(4, (phase_s5_scan(p), phase_prep(p, (float*)lds, 1)), (phase_s5_scan(p), phase_prep(p, (float*)lds, 1)))
    PHASE(5, phase_s5_b(p, lds), phase_s5_b(p, lds))
    PHASE(6, phase_s5_glu(p, lds), phase_s5_glu(p, lds))
    PHASE(7, phase_norm(p, p.out, p.in[3], MOD + 3072, MOD + 4096, HM), phase_norm(p, p.out, p.in[3], MOD + 3072, MOD + 4096, HM))
    PHASE(8, phase_peer_route(p, 0, lds), phase_peer_route(p, 0, lds))
    PHASE(9, phase_peer_apply(p, 0, lds, dry), phase_peer_apply(p, 0, lds, dry))
    PHASE(10, phase_nsa_proj(p, lds), phase_nsa_proj(p, lds))
    PHASE(11, (phase_nsa_cmp1(p, lds), phase_tab1(p)), (phase_nsa_cmp1(p, lds), phase_tab1(p)))
    PHASE(12, phase_nsa_cmp2(p, lds), phase_nsa_cmp2(p, lds))
    PHASE(13, phase_nsa_attn(p, lds, ATT_REP_CMP + opq, ATT_REP_WIN + opq, ATT_REP_SEL + opq), phase_nsa_attn(p, lds, 1 + opq, 1 + opq, 1 + opq))
    PHASE(14, phase_nsa_wo(p, lds, dry), phase_nsa_wo(p, lds, dry))
    PHASE(15, phase_norm(p, p.out, p.in[3] + D, MOD + 2 * 6144 + 3072, MOD + 2 * 6144 + 4096, HM), phase_norm(p, p.out, p.in[3] + D, MOD + 2 * 6144 + 3072, MOD + 2 * 6144 + 4096, HM))
    PHASE(16, phase_peer_route(p, 1, lds), phase_peer_route(p, 1, lds))
    PHASE(17, phase_peer_apply(p, 1, lds, dry), phase_peer_apply(p, 1, lds, dry))
#undef PHASE
    if (TS_PHASE >= 0 && blockIdx.x == 0 && threadIdx.x == 0) {
        const unsigned long long t0 = __builtin_amdgcn_s_memrealtime(), want = (ts_b - ts_a) * TS_MULT;
        while (__builtin_amdgcn_s_memrealtime() - t0 < want) __builtin_amdgcn_s_sleep(8);
    }
}

extern "C" void kernel_launch(void* const* d_in, const int* in_sizes, int n_in, void* d_out, int out_size, void* d_ws, size_t ws_size, hipStream_t stream) {
    static int grid_blocks = 0;
    if (!grid_blocks) {
        int dev = 0, cus = 0, per_cu = 0;
        hipGetDevice(&dev);
        hipDeviceGetAttribute(&cus, hipDeviceAttributeMultiprocessorCount, dev);
        hipOccupancyMaxActiveBlocksPerMultiprocessor(&per_cu, mega, NTHREADS, 0);
        if (per_cu > 2) per_cu = 2;
        if (per_cu < 1) per_cu = 1;
        grid_blocks = cus * per_cu;
        if (ws_size < WS_END) fprintf(stderr, "kernel_launch: workspace too small: %zu < %zu\n", ws_size, (size_t)WS_END);
        if (n_in != 29) fprintf(stderr, "kernel_launch: expected 29 inputs, got %d\n", n_in);
    }
    hipMemsetAsync((unsigned char*)d_ws + WS_CTL, 0, 16384, stream);
    Params p{};
    for (int i = 0; i < 29; ++i) p.in[i] = (const float*)d_in[i];
    p.out = (float*)d_out; p.ws = (unsigned char*)d_ws;
#if SINGLE_LAUNCH
    p.ph_lo = 0; p.ph_hi = NPHASES;
    void* args[] = {&p};
    hipError_t e = hipLaunchCooperativeKernel((void*)mega, dim3(grid_blocks), dim3(NTHREADS), args, 0, stream);
    if (e != hipSuccess) fprintf(stderr, "cooperative launch failed: %s (grid %d)\n", hipGetErrorString(e), grid_blocks);
#else
    for (int ph = 0; ph < NPHASES; ++ph) {
        p.ph_lo = ph; p.ph_hi = ph + 1;
        hipLaunchKernelGGL(mega, dim3(grid_blocks), dim3(NTHREADS), 0, stream, p);
    }
#endif
}
```

```cpp
#include <hip/hip_runtime.h>
#include <hip/hip_cooperative_groups.h>
#include <cstdio>
#include <cstdint>
namespace cg = cooperative_groups;

#ifndef SINGLE_LAUNCH
#define SINGLE_LAUNCH 1
#endif

typedef unsigned short bf16_t;
typedef short bf16x8 __attribute__((ext_vector_type(8)));
typedef float f32x4 __attribute__((ext_vector_type(4)));
typedef float f32x2 __attribute__((ext_vector_type(2)));
typedef unsigned u32x4 __attribute__((ext_vector_type(4)));
typedef unsigned u32x2 __attribute__((ext_vector_type(2)));
typedef __bf16 bf16x2_t __attribute__((ext_vector_type(2)));
typedef float v32f __attribute__((ext_vector_type(32)));
typedef float v16f __attribute__((ext_vector_type(16)));
typedef unsigned v6u __attribute__((ext_vector_type(6)));

constexpr int D = 1024, BATCH = 2, SEQ = 16384, T = BATCH * SEQ;
constexpr int NTHREADS = 256;
constexpr float RMS_EPS = 1e-6f;
constexpr int S5G = 64, S5P = 64, S5L = 32, S5NCH = T / S5L  , S5CPB = SEQ / S5L  ;
constexpr int NH = 16, HD = 64, NG = 4, NPROJ = 2608, NPROJ_PAD = 2688, NC = 1023, NSB = 256;
constexpr int PH = 8, PK = 16, PNK = 128, PE = 16384;

constexpr size_t MiB = 1ull << 20;
constexpr size_t WS_CTL = 0;
constexpr size_t WS_MOD = 1 * MiB;
constexpr size_t WS_WIN_T = 2 * MiB;
constexpr size_t WS_WGLU_T = 4 * MiB;
constexpr size_t WS_WPROJ_T = 8 * MiB;
constexpr size_t WS_WK1_T = 14 * MiB;
constexpr size_t WS_WV1_T = 15 * MiB;
constexpr size_t WS_WK2_T = 16 * MiB;
constexpr size_t WS_WV2_T = 16 * MiB + 512 * 1024;
constexpr size_t WS_WO_T = 17 * MiB;
constexpr size_t WS_WQ_T = 19 * MiB;
constexpr size_t WS_SUBK = 27 * MiB;
constexpr size_t WS_ROPE = 28 * MiB;
constexpr size_t WS_MISC = 32 * MiB;
constexpr size_t WS_TW = 33 * MiB;
constexpr size_t WS_VG = 73 * MiB;
constexpr size_t WS_PU = 82 * MiB;
constexpr size_t WS_PV = 114 * MiB;
constexpr size_t WS_HM = 146 * MiB;
constexpr size_t WS_C = 210 * MiB;
constexpr size_t WS_UG = WS_C;
constexpr size_t WS_YI = WS_C + 64 * MiB;
constexpr size_t WS_WST = WS_C + 128 * MiB;
constexpr size_t WS_SST = WS_C + 160 * MiB;
constexpr size_t WS_YG = WS_C + 176 * MiB;
constexpr size_t WS_QK = WS_C;
constexpr size_t WS_TOPS = WS_C + 128 * MiB;
constexpr size_t WS_TOPI = WS_C + 160 * MiB;
constexpr size_t WS_EXP = WS_C + 192 * MiB;
constexpr size_t WS_GATE = WS_C + 208 * MiB;
constexpr size_t WS_ACT = WS_C + 224 * MiB;
constexpr size_t WS_Q = WS_C;
constexpr size_t WS_KC = WS_C + 64 * MiB;
constexpr size_t WS_VC = WS_C + 81 * MiB;
constexpr size_t WS_KS = WS_C + 98 * MiB;
constexpr size_t WS_VST = WS_C + 114 * MiB;
constexpr size_t WS_KW = WS_C + 130 * MiB;
constexpr size_t WS_VWT = WS_C + 146 * MiB;
constexpr size_t WS_NG = WS_C + 162 * MiB;
constexpr size_t WS_KCMP = WS_C + 170 * MiB;
constexpr size_t WS_VCMPT = WS_C + 171 * MiB;
constexpr size_t WS_HID = WS_C + 172 * MiB;
constexpr size_t WS_O = WS_C + 182 * MiB;
constexpr size_t WS_Q8 = WS_C + 246 * MiB;
constexpr size_t WS_END = WS_C + 282 * MiB;

constexpr int LDS_BYTES = 74240;

struct Params {
    const float* in[29];
    float* out;
    unsigned char* ws;
    int ph_lo, ph_hi;
};

__device__ __forceinline__ unsigned f2bf(float f) { unsigned u = __builtin_bit_cast(unsigned, f); return (u + 0x7fffu + ((u >> 16) & 1u)) >> 16; }
__device__ __forceinline__ unsigned pk2(float lo, float hi) { return f2bf(lo) | (f2bf(hi) << 16); }
__device__ __forceinline__ float bf2f(unsigned h) { return __builtin_bit_cast(float, h << 16); }
__device__ __forceinline__ float bflo(unsigned w) { return __builtin_bit_cast(float, w << 16); }
__device__ __forceinline__ float bfhi(unsigned w) { return __builtin_bit_cast(float, w & 0xffff0000u); }
__device__ __forceinline__ float gelu_tanh(float x) {
    const float u = 0.7978845608028654f * (x + 0.044715f * x * x * x);
    const float e = __expf(2.0f * u);
    const float th = 1.0f - 2.0f / (e + 1.0f);
    return 0.5f * x * (1.0f + th);
}
__device__ __forceinline__ float sigmoidf_(float x) { return 1.0f / (1.0f + __expf(-x)); }
__device__ __forceinline__ float wave_sum(float v) {
#pragma unroll
    for (int o = 1; o < 64; o <<= 1) v += __shfl_xor(v, o);
    return v;
}
__device__ __forceinline__ float dot2bf(unsigned a, unsigned b, float acc) {
    return __builtin_amdgcn_fdot2_f32_bf16(__builtin_bit_cast(bf16x2_t, a), __builtin_bit_cast(bf16x2_t, b), acc, false);
}

#define LAS __attribute__((address_space(3)))
#define XB_TMO      128
#define XB_XCNT(j)  (256  + 64 * (j))
#define XB_XSUB(j)  (1280 + 64 * (j))
#define XB_XGEN(j)  (2304 + 64 * (j))
#define XB_TOP      3328
#define XB_TOPGEN   3392
#define XCD_BAR_WORDS 3456
#define XB_SPIN_CAP (1u << 24)

__device__ __forceinline__ unsigned xb_ld(unsigned* p)              { return __hip_atomic_load(p, __ATOMIC_RELAXED, __HIP_MEMORY_SCOPE_AGENT); }
__device__ __forceinline__ unsigned xb_add(unsigned* p, unsigned v) { return __hip_atomic_fetch_add(p, v, __ATOMIC_RELAXED, __HIP_MEMORY_SCOPE_AGENT); }
__device__ __forceinline__ unsigned xb_xcc_id() { return (unsigned)__builtin_amdgcn_s_getreg((3 << 11) | 20) & 0xFu; }
#define XB_SPIN(cond, bar) do { unsigned _sp = 0; while (cond) { __builtin_amdgcn_s_sleep(1); \
    if ((++_sp & 255u) == 0u) { if (xb_ld(&(bar)[XB_TMO])) break; if (_sp > XB_SPIN_CAP) { atomicAdd(&(bar)[XB_TMO], 1u); break; } } } } while (0)

struct XcdBarrier {
    unsigned* bar; unsigned x;
    volatile LAS unsigned* st;
};

__device__ __forceinline__ XcdBarrier xcd_barrier_post(unsigned* bar, volatile LAS unsigned* st) {
    XcdBarrier b; b.bar = bar; b.x = xb_xcc_id(); b.st = st;
    if (threadIdx.x == 0) (void)xb_add(&bar[XB_XCNT(b.x)], 1u);
    return b;
}
__device__ __forceinline__ void xcd_barrier_complete(unsigned* bar, unsigned x, unsigned& nloc, unsigned& nx) {
    const unsigned G = gridDim.x * gridDim.y * gridDim.z;
    unsigned sum, cnt, mine, sp = 0u;
    for (;;) {
        sum = 0u; cnt = 0u; mine = 0u;
#pragma unroll
        for (unsigned j = 0; j < 16; ++j) { const unsigned c = xb_ld(&bar[XB_XCNT(j)]); sum += c; cnt += (c > 0u) ? 1u : 0u; mine = (j == x) ? c : mine; }
        if (sum == G) break;
        __builtin_amdgcn_s_sleep(1);
        if ((++sp & 255u) == 0u) { if (xb_ld(&bar[XB_TMO])) break; if (sp > XB_SPIN_CAP) { atomicAdd(&bar[XB_TMO], 1u); break; } }
    }
    nloc = mine > 0u ? mine : 1u; nx = cnt > 0u ? cnt : 1u;
}

__device__ __forceinline__ void xcd_barrier(const XcdBarrier& b) {
    asm volatile("s_waitcnt vmcnt(0)" ::: "memory");
    __syncthreads();
    if (threadIdx.x == 0) {
        unsigned* bar = b.bar;
        __builtin_amdgcn_s_waitcnt(0);
        unsigned nloc = b.st[0], nx = b.st[1];
        if (nloc == 0u) { xcd_barrier_complete(bar, b.x, nloc, nx); b.st[0] = nloc; b.st[1] = nx; }
        const unsigned old = xb_add(&bar[XB_XSUB(b.x)], 1u);
        const unsigned gen = old / nloc;
        if (old + 1u == (gen + 1u) * nloc) {
            __builtin_amdgcn_fence(__ATOMIC_RELEASE, "agent");
            asm volatile("s_waitcnt vmcnt(0)" ::: "memory");
            const unsigned og = xb_add(&bar[XB_TOP], 1u);
            const unsigned tg = og / nx;
            if (og + 1u == (tg + 1u) * nx) xb_add(&bar[XB_TOPGEN], 1u);
            else XB_SPIN(xb_ld(&bar[XB_TOPGEN]) == tg, bar);
            __builtin_amdgcn_fence(__ATOMIC_ACQUIRE, "agent");
            xb_add(&bar[XB_XGEN(b.x)], 1u);
            asm volatile("s_waitcnt vmcnt(0)" ::: "memory");
        } else {
            XB_SPIN(xb_ld(&bar[XB_XGEN(b.x)]) == gen, bar);
            __builtin_amdgcn_fence(__ATOMIC_ACQUIRE, "agent");
            asm volatile("s_waitcnt vmcnt(0)" ::: "memory");
        }
    }
    __syncthreads();
}
__device__ __forceinline__ void prep_mod_item(const Params& p, int item, float* lds) {
    const int layer = item / 192, cg0 = (item % 192) * 32;
    const int tid = threadIdx.x, col = cg0 + (tid & 31), kg = tid >> 5;
    const float* W = p.in[4] + (size_t)layer * D * 6 * D + col;
    const float* c = p.in[1];
    float* cact = lds + 512;
#pragma unroll
    for (int i = 0; i < 8; ++i) { const int q = tid + 256 * i; const float v = c[q]; cact[q] = v * sigmoidf_(v); }
    __syncthreads();
    float a0 = 0.f, a1 = 0.f;
    for (int k0 = kg * 128; k0 < kg * 128 + 128; k0 += 16) {
        float w[16];
#pragma unroll
        for (int u = 0; u < 16; ++u) w[u] = W[(size_t)(k0 + u) * (6 * D)];
#pragma unroll
        for (int u = 0; u < 16; ++u) { a0 += w[u] * cact[k0 + u]; a1 += w[u] * cact[1024 + k0 + u]; }
    }
    lds[tid] = a0; lds[256 + tid] = a1;
    __syncthreads();
    if (tid < 64) {
        const int b = tid >> 5, cc = tid & 31;
        float s = 0.f;
#pragma unroll
        for (int g = 0; g < 8; ++g) s += lds[b * 256 + g * 32 + cc];
        float* MOD = (float*)(p.ws + WS_MOD);
        MOD[(size_t)(layer * 2 + b) * 6144 + cg0 + cc] = s + p.in[5][(size_t)layer * 6144 + cg0 + cc];
    }
    __syncthreads();
}

template <int MODE>
__device__ __forceinline__ void prep_transpose_item(const float* W, int K, int N, bf16_t* WT, int item, float* lds) {
    const int nbn = (N + 63) / 64, kb = item / nbn, nb = item % nbn, k0 = kb * 64, n0 = nb * 64;
    const int tid = threadIdx.x;
#pragma unroll
    for (int i = 0; i < 16; ++i) {
        const int kk = (tid >> 6) + 4 * i, nn = tid & 63;
        const float v = (n0 + nn < N) ? W[(size_t)(k0 + kk) * N + n0 + nn] : 0.f;
        lds[kk * 65 + nn] = v;
    }
    __syncthreads();
    {
        const int nn = tid >> 2, ks = (tid & 3) * 16;
        const int n = n0 + nn;
        if (n < N) {
            int np = n;
            if (MODE == 1) { const int j = (n < 1024) ? n : n - 1024; np = (j >> 4) * 32 + (j & 15) + ((n < 1024) ? 0 : 16); }
            u32x4 o0, o1;
            const float* s = lds + nn;
            o0.x = pk2(s[(ks + 0) * 65], s[(ks + 1) * 65]); o0.y = pk2(s[(ks + 2) * 65], s[(ks + 3) * 65]);
            o0.z = pk2(s[(ks + 4) * 65], s[(ks + 5) * 65]); o0.w = pk2(s[(ks + 6) * 65], s[(ks + 7) * 65]);
            o1.x = pk2(s[(ks + 8) * 65], s[(ks + 9) * 65]); o1.y = pk2(s[(ks + 10) * 65], s[(ks + 11) * 65]);
            o1.z = pk2(s[(ks + 12) * 65], s[(ks + 13) * 65]); o1.w = pk2(s[(ks + 14) * 65], s[(ks + 15) * 65]);
            u32x4* dst = (u32x4*)(WT + (size_t)np * K + k0 + ks);
            dst[0] = o0; dst[1] = o1;
        }
    }
    __syncthreads();
}

__device__ __forceinline__ void cvt_item(const float* src, bf16_t* dst, int item) {
    const size_t base = (size_t)item * 8192 + threadIdx.x * 8;
#pragma unroll
    for (int i = 0; i < 4; ++i) {
        const size_t o = base + (size_t)i * 2048;
        const f32x4 a = *(const f32x4*)(src + o), b = *(const f32x4*)(src + o + 4);
        u32x4 w; w.x = pk2(a.x, a.y); w.y = pk2(a.z, a.w); w.z = pk2(b.x, b.y); w.w = pk2(b.z, b.w);
        *(u32x4*)(dst + o) = w;
    }
}
__device__ __forceinline__ void zero_item(bf16_t* dst, int item) {
    const size_t base = (size_t)item * 8192 + threadIdx.x * 8;
#pragma unroll
    for (int i = 0; i < 4; ++i) *(u32x4*)(dst + base + (size_t)i * 2048) = (u32x4){0u, 0u, 0u, 0u};
}

struct cpx { float re, im; };
__device__ __forceinline__ cpx cmul(cpx a, cpx b) { return {a.re * b.re - a.im * b.im, a.re * b.im + a.im * b.re}; }
__device__ __forceinline__ cpx cexp_pow(float are, float aim, float dt, int m) {
    const float mag = __expf(are * dt * (float)m);
    const double rev = (double)aim * (double)dt * (double)m * 0.15915494309189535;
    const float fr = (float)(rev - rint(rev));
    return {mag * __builtin_amdgcn_cosf(fr), mag * __builtin_amdgcn_sinf(fr)};
}
__device__ __forceinline__ cpx s5_coef(float are, float aim, float dt) {
    cpx ab = cexp_pow(are, aim, dt, 1);
    const float nr = ab.re - 1.0f, ni = ab.im, den = are * are + aim * aim;
    return {(nr * are + ni * aim) / den, (ni * are - nr * aim) / den};
}

__device__ __forceinline__ void prep_s5_T_item(const Params& p, int item) {
    const int gid = item * 256 + threadIdx.x;
    const int g = gid >> 9, m = (gid >> 4) & 31, i = gid & 15;
    const float* a_re = p.in[7] + g * 64; const float* a_im = p.in[8] + g * 64;
    const float dt = __expf(p.in[9][g]);
    const float* b_re = p.in[10] + (size_t)g * 64 * 16; const float* b_im = p.in[11] + (size_t)g * 64 * 16;
    const float* c_re = p.in[12] + (size_t)g * 16 * 64 + i * 64; const float* c_im = p.in[13] + (size_t)g * 16 * 64 + i * 64;
    float acc[16];
#pragma unroll
    for (int j = 0; j < 16; ++j) acc[j] = 0.f;
    for (int q = 0; q < 64; ++q) {
        const float are = a_re[q], aim = a_im[q];
        cpx z = cmul(cmul({c_re[q], c_im[q]}, cexp_pow(are, aim, dt, m)), s5_coef(are, aim, dt));
        const f32x4* br = (const f32x4*)(b_re + q * 16); const f32x4* bi = (const f32x4*)(b_im + q * 16);
#pragma unroll
        for (int j4 = 0; j4 < 4; ++j4) {
            const f32x4 r = br[j4], im = bi[j4];
            acc[j4 * 4 + 0] += z.re * r.x - z.im * im.x; acc[j4 * 4 + 1] += z.re * r.y - z.im * im.y;
            acc[j4 * 4 + 2] += z.re * r.z - z.im * im.z; acc[j4 * 4 + 3] += z.re * r.w - z.im * im.w;
        }
    }
    u32x4 o0, o1;
    o0.x = pk2(acc[0], acc[1]); o0.y = pk2(acc[2], acc[3]); o0.z = pk2(acc[4], acc[5]); o0.w = pk2(acc[6], acc[7]);
    o1.x = pk2(acc[8], acc[9]); o1.y = pk2(acc[10], acc[11]); o1.z = pk2(acc[12], acc[13]); o1.w = pk2(acc[14], acc[15]);
    bf16_t* TW = (bf16_t*)(p.ws + WS_TW) + (size_t)g * 640 * 512;
    const u32x4 z4 = (u32x4){0u, 0u, 0u, 0u};
    for (int lp = 0; lp + m < 32; ++lp) {
        u32x4* d = (u32x4*)(TW + (size_t)((lp + m) * 16 + i) * 512 + lp * 16);
        d[0] = o0; d[1] = o1;
        if (m > 0) { u32x4* dz = (u32x4*)(TW + (size_t)(lp * 16 + i) * 512 + (lp + m) * 16); dz[0] = z4; dz[1] = z4; }
    }
}
__device__ __forceinline__ void prep_s5_W_item(const Params& p, int item) {
    const int gid = item * 256 + threadIdx.x;
    const int g = gid >> 11, q = (gid >> 5) & 63, lp = gid & 31;
    const float are = p.in[7][g * 64 + q], aim = p.in[8][g * 64 + q];
    const float dt = __expf(p.in[9][g]);
    const cpx z = cmul(cexp_pow(are, aim, dt, 31 - lp), s5_coef(are, aim, dt));
    const float* br = p.in[10] + ((size_t)g * 64 + q) * 16; const float* bi = p.in[11] + ((size_t)g * 64 + q) * 16;
    float wr[16], wi[16];
#pragma unroll
    for (int j = 0; j < 16; ++j) { wr[j] = z.re * br[j] - z.im * bi[j]; wi[j] = z.re * bi[j] + z.im * br[j]; }
    bf16_t* TW = (bf16_t*)(p.ws + WS_TW) + (size_t)g * 640 * 512;
    u32x4* d0 = (u32x4*)(TW + (size_t)(512 + q) * 512 + lp * 16);
    u32x4* d1 = (u32x4*)(TW + (size_t)(576 + q) * 512 + lp * 16);
    d0[0] = (u32x4){pk2(wr[0], wr[1]), pk2(wr[2], wr[3]), pk2(wr[4], wr[5]), pk2(wr[6], wr[7])};
    d0[1] = (u32x4){pk2(wr[8], wr[9]), pk2(wr[10], wr[11]), pk2(wr[12], wr[13]), pk2(wr[14], wr[15])};
    d1[0] = (u32x4){pk2(wi[0], wi[1]), pk2(wi[2], wi[3]), pk2(wi[4], wi[5]), pk2(wi[6], wi[7])};
    d1[1] = (u32x4){pk2(wi[8], wi[9]), pk2(wi[10], wi[11]), pk2(wi[12], wi[13]), pk2(wi[14], wi[15])};
}
__device__ __forceinline__ void prep_s5_V_item(const Params& p, int item) {
    const int gid = item * 256 + threadIdx.x;
    const int g = gid >> 14, l = (gid >> 9) & 31, i = (gid >> 5) & 15, q0 = (gid & 31) * 2;
    const float dt = __expf(p.in[9][g]);
    float vr[2], vi[2];
#pragma unroll
    for (int e = 0; e < 2; ++e) {
        const int q = q0 + e;
        const cpx z = cmul({p.in[12][((size_t)g * 16 + i) * 64 + q], p.in[13][((size_t)g * 16 + i) * 64 + q]}, cexp_pow(p.in[7][g * 64 + q], p.in[8][g * 64 + q], dt, l + 1));
        vr[e] = z.re; vi[e] = -z.im;
    }
    bf16_t* VG = (bf16_t*)(p.ws + WS_VG) + ((size_t)g * 512 + l * 16 + i) * 128;
    *(unsigned*)(VG + q0) = pk2(vr[0], vr[1]);
    *(unsigned*)(VG + 64 + q0) = pk2(vi[0], vi[1]);
}
__device__ __forceinline__ void prep_al_item(const Params& p, int item) {
    const int gid = item * 256 + threadIdx.x;
    const int g = gid >> 6;
    const float dt = __expf(p.in[9][g]);
    const cpx z = cexp_pow(p.in[7][gid], p.in[8][gid], dt, S5L);
    f32x2* AL = (f32x2*)(p.ws + WS_MISC + 4096);
    AL[gid] = (f32x2){z.re, z.im};
}
__device__ __forceinline__ void prep_rope_item(const Params& p, int item) {
    const int gid = item * 256 + threadIdx.x;
    const int pos = gid >> 5, j = gid & 31;
    const float freq = exp2f(-(float)j * (13.287712379549449f / 32.0f));
    const float ang = (float)pos * freq;
    const double rev = (double)ang * 0.15915494309189535;
    const float fr = (float)(rev - rint(rev));
    f32x2* R = (f32x2*)(p.ws + WS_ROPE);
    R[gid] = (f32x2){__builtin_amdgcn_cosf(fr), __builtin_amdgcn_sinf(fr)};
}
__device__ __forceinline__ void prep_cmpbias_item(const Params& p, int item, float* lds) {
    const int kv = item >> 3, cg0 = (item & 7) * 32;
    const float* pe = p.in[17 + kv]; const float* w1 = p.in[kv == 0 ? 19 : 21];
    const int tid = threadIdx.x, col = cg0 + (tid & 31), kg = tid >> 5;
    float s = 0.f;
#pragma unroll 8
    for (int k = kg * 256; k < kg * 256 + 256; ++k) s += pe[k] * w1[(size_t)k * 256 + col];
    lds[tid] = s;
    __syncthreads();
    if (tid < 32) {
        float t = 0.f;
#pragma unroll
        for (int q = 0; q < 8; ++q) t += lds[q * 32 + tid];
        ((float*)(p.ws + WS_MISC))[kv * 256 + cg0 + tid] = t;
    }
    __syncthreads();
}

__device__ __forceinline__ void cvt_fp8_item(const float* src, unsigned char* dst, float* inv_scale, int item, const bool slice_major) {
    const int lane = threadIdx.x & 63, row0 = item * 16 + (threadIdx.x >> 6) * 4;
    f32x4 v[4][4];
#pragma unroll
    for (int r = 0; r < 4; ++r) {
        const f32x4* sp = (const f32x4*)(src + (size_t)(row0 + r) * D + lane * 16);
#pragma unroll
        for (int q = 0; q < 4; ++q) v[r][q] = sp[q];
    }
#pragma unroll
    for (int r = 0; r < 4; ++r) {
        float m = 0.f;
#pragma unroll
        for (int q = 0; q < 4; ++q) m = fmaxf(m, fmaxf(fmaxf(fabsf(v[r][q].x), fabsf(v[r][q].y)), fmaxf(fabsf(v[r][q].z), fabsf(v[r][q].w))));
#pragma unroll
        for (int o = 1; o < 64; o <<= 1) m = fmaxf(m, __shfl_xor(m, o));
        const float sc = m > 0.f ? 224.0f / m : 1.0f;
        unsigned w[4];
#pragma unroll
        for (int q = 0; q < 4; ++q) { int t = 0; t = __builtin_amdgcn_cvt_pk_fp8_f32(v[r][q].x * sc, v[r][q].y * sc, t, false); t = __builtin_amdgcn_cvt_pk_fp8_f32(v[r][q].z * sc, v[r][q].w * sc, t, true); w[q] = (unsigned)t; }
        const int row = row0 + r;
        const u32x4 wv = (u32x4){w[0], w[1], w[2], w[3]};
        if (slice_major) *(u32x4*)(dst + (size_t)(lane >> 3) * (PE * 128) + (size_t)row * 128 + (lane & 7) * 16) = wv;
        else *(u32x4*)(dst + (size_t)row * D + lane * 16) = wv;
        if (lane == 0) inv_scale[row] = m > 0.f ? m / 224.0f : 1.0f;
    }
}
__device__ __forceinline__ void cvt_fp6_item(const float* src, unsigned char* dst, float* inv_scale, int item) {
    const int lane = threadIdx.x & 63, half = lane >> 5, gl = lane & 31, row0 = item * 16 + (threadIdx.x >> 6) * 4;
#pragma unroll
    for (int pr = 0; pr < 2; ++pr) {
        const int row = row0 + pr * 2 + half;
        const f32x4* sp = (const f32x4*)(src + (size_t)row * D + gl * 32);
        f32x4 v[8];
#pragma unroll
        for (int q = 0; q < 8; ++q) v[q] = sp[q];
        float m = 0.f;
#pragma unroll
        for (int q = 0; q < 8; ++q) m = fmaxf(m, fmaxf(fmaxf(fabsf(v[q].x), fabsf(v[q].y)), fmaxf(fabsf(v[q].z), fabsf(v[q].w))));
#pragma unroll
        for (int o = 1; o < 32; o <<= 1) m = fmaxf(m, __shfl_xor(m, o));
        const float sc = m > 0.f ? 7.5f / m : 1.0f;
        v16f x0, x1;
#pragma unroll
        for (int q = 0; q < 8; ++q) {
            x0[q * 2 + 0] = v[q].x * sc; x1[q * 2 + 0] = v[q].y * sc; x0[q * 2 + 1] = v[q].z * sc; x1[q * 2 + 1] = v[q].w * sc;
        }
        const v6u w = __builtin_amdgcn_cvt_scalef32_2xpk16_fp6_f32(x0, x1, 1.0f);
        u32x2* dp = (u32x2*)(dst + (size_t)row * 768 + gl * 24);
        dp[0] = (u32x2){w[0], w[1]}; dp[1] = (u32x2){w[2], w[3]}; dp[2] = (u32x2){w[4], w[5]};
        if (gl == 0) inv_scale[row] = m > 0.f ? m / 7.5f : 1.0f;
    }
}
constexpr int P0_MOD = 384;
constexpr int P0_T_WIN = 16 * 16, P0_T_WGLU = 16 * 32, P0_T_WPROJ = 16 * 41, P0_T_WK1 = 32 * 4, P0_T_WK2 = 4 * 1, P0_T_WO = 16 * 16, P0_T_WQ = 16 * 32;
constexpr int P0_SUBK = (2 * 8 * 2 * 128 * 128) / 8192;
constexpr int P0_TAB = PE / 16;
constexpr int P0_S5T = 128, P0_S5W = 512, P0_S5V = 4096, P0_AL = 16, P0_ROPE = 2048, P0_CB = 16, P0_ZERO = 10 + 2;

__device__ __forceinline__ void phase_prep(const Params& p, float* lds, const int part) {
    const int n0 = P0_MOD;
    const int n1 = n0 + P0_T_WIN, n2 = n1 + P0_T_WGLU, n3 = n2 + P0_T_WPROJ, n4 = n3 + P0_T_WK1, n5 = n4 + P0_T_WK1, n6 = n5 + P0_T_WK2, n7 = n6 + P0_T_WK2,
              n8 = n7 + P0_T_WO, n9 = n8 + P0_T_WQ, n10 = n9 + P0_T_WQ, n11 = n10 + P0_SUBK, n12 = n11 + P0_TAB, n13 = n12 + P0_TAB,
              n14 = n13 + P0_S5T, n15 = n14 + P0_S5W, n16 = n15 + P0_S5V, n17 = n16 + P0_AL, n18 = n17 + P0_ROPE, n19 = n18 + P0_CB, n20 = n19 + 10, n21 = n20 + 2, n22 = n21 + 2;
    unsigned char* ws = p.ws;
#ifndef PREP_DUP_LO
#define PREP_DUP_LO 0
#define PREP_DUP_HI 0
#endif
    const int dupn = (PREP_DUP_HI) - (PREP_DUP_LO);
    const int nB = (n8 - n2) + (n10 - n9) + (n22 - n17);
    const int first = part == 0 ? (int)blockIdx.x : (int)blockIdx.x - 32, stride = part == 0 ? (int)gridDim.x : (int)gridDim.x - 32;
    if (first < 0 || stride <= 0) return;
    const int total = part == 0 ? (n22 - nB) + dupn : nB;
    for (int it0 = first; it0 < total; it0 += stride) {
        int it;
        if (part == 0) {
            it = it0;
            if (it >= n2) it += (n8 - n2);
            if (it >= n9) it += (n10 - n9);
            if (it0 >= (n22 - nB)) it = (PREP_DUP_LO) + (it0 - (n22 - nB));
        } else {
            it = n2 + it0;
            if (it >= n8) it += (n9 - n8);
            if (it >= n10) it += (n17 - n10);
        }
        if (it < n0) prep_mod_item(p, it, lds);
        else if (it < n1) prep_transpose_item<0>(p.in[6], 1024, 1024, (bf16_t*)(ws + WS_WIN_T), it - n0, lds);
        else if (it < n2) prep_transpose_item<1>(p.in[15], 1024, 2048, (bf16_t*)(ws + WS_WGLU_T), it - n1, lds);
        else if (it < n3) prep_transpose_item<0>(p.in[16], 1024, NPROJ, (bf16_t*)(ws + WS_WPROJ_T), it - n2, lds);
        else if (it < n4) prep_transpose_item<0>(p.in[19], 2048, 256, (bf16_t*)(ws + WS_WK1_T), it - n3, lds);
        else if (it < n5) prep_transpose_item<0>(p.in[21], 2048, 256, (bf16_t*)(ws + WS_WV1_T), it - n4, lds);
        else if (it < n6) prep_transpose_item<0>(p.in[20], 256, 64, (bf16_t*)(ws + WS_WK2_T), it - n5, lds);
        else if (it < n7) prep_transpose_item<0>(p.in[22], 256, 64, (bf16_t*)(ws + WS_WV2_T), it - n6, lds);
        else if (it < n8) prep_transpose_item<0>(p.in[23], 1024, 1024, (bf16_t*)(ws + WS_WO_T), it - n7, lds);
        else if (it < n9) prep_transpose_item<0>(p.in[24], 1024, 2048, (bf16_t*)(ws + WS_WQ_T), it - n8, lds);
        else if (it < n10) prep_transpose_item<0>(p.in[24] + (size_t)1024 * 2048, 1024, 2048, (bf16_t*)(ws + WS_WQ_T) + (size_t)2048 * 1024, it - n9, lds);
        else if (it < n11) cvt_item(p.in[25], (bf16_t*)(ws + WS_SUBK), it - n10);
        else if (it < n12) cvt_fp6_item(p.in[26], ws + WS_PU, (float*)(ws + WS_PU + 24 * MiB), it - n11);
        else if (it < n13) cvt_fp6_item(p.in[27], ws + WS_PV, (float*)(ws + WS_PV + 24 * MiB), it - n12);
        else if (it < n14) prep_s5_T_item(p, it - n13);
        else if (it < n15) prep_s5_W_item(p, it - n14);
        else if (it < n16) prep_s5_V_item(p, it - n15);
        else if (it < n17) prep_al_item(p, it - n16);
        else if (it < n18) prep_rope_item(p, it - n17);
        else if (it < n19) prep_cmpbias_item(p, it - n18, lds);
        else if (it < n20) zero_item((bf16_t*)(ws + WS_WPROJ_T) + (size_t)NPROJ * 1024, it - n19);
        else if (it < n21) zero_item((bf16_t*)(ws + WS_WK2_T) + (size_t)64 * 256, it - n20);
        else zero_item((bf16_t*)(ws + WS_WV2_T) + (size_t)64 * 256, it - n21);
    }
}

__device__ __forceinline__ void phase_norm(const Params& p, const float* X, const float* gw, const float* shift, const float* scale  , bf16_t* HM) {
    const int lane = threadIdx.x & 63, wave = threadIdx.x >> 6;
    for (int row = blockIdx.x * 4 + wave; row < T; row += gridDim.x * 4) {
        const int b = row / SEQ;
        const f32x4* xr = (const f32x4*)(X + (size_t)row * D) + lane;
        f32x4 v[4]; float s = 0.f;
#pragma unroll
        for (int j = 0; j < 4; ++j) { v[j] = xr[64 * j]; s += (v[j].x * v[j].x + v[j].y * v[j].y) + (v[j].z * v[j].z + v[j].w * v[j].w); }
        const float rs = rsqrtf(wave_sum(s) * (1.0f / D) + RMS_EPS);
        u32x2* o = (u32x2*)(HM + (size_t)row * D) + lane;
#pragma unroll
        for (int j = 0; j < 4; ++j) {
            const int c = lane * 4 + 256 * j;
            const f32x4 g = *(const f32x4*)(gw + c), sh = *(const f32x4*)(shift + (size_t)b * 6144 + c), sc = *(const f32x4*)(scale + (size_t)b * 6144 + c);
            const float y0 = v[j].x * rs * g.x * (1.f + sc.x) + sh.x, y1 = v[j].y * rs * g.y * (1.f + sc.y) + sh.y;
            const float y2 = v[j].z * rs * g.z * (1.f + sc.z) + sh.z, y3 = v[j].w * rs * g.w * (1.f + sc.w) + sh.w;
            o[64 * j] = (u32x2){pk2(y0, y1), pk2(y2, y3)};
        }
    }
}
__device__ __forceinline__ void phase_final_norm(const Params& p, const float* X, float* OUT, bool dry) {
    const int lane = threadIdx.x & 63, wave = threadIdx.x >> 6;
    const float* gw = p.in[28];
    for (int row = blockIdx.x * 4 + wave; row < T; row += gridDim.x * 4) {
        const f32x4* xr = (const f32x4*)(X + (size_t)row * D) + lane;
        f32x4 v[4]; float s = 0.f;
#pragma unroll
        for (int j = 0; j < 4; ++j) { v[j] = xr[64 * j]; s += (v[j].x * v[j].x + v[j].y * v[j].y) + (v[j].z * v[j].z + v[j].w * v[j].w); }
        const float rs = rsqrtf(wave_sum(s) * (1.0f / D) + RMS_EPS);
        f32x4* o = (f32x4*)(OUT + (size_t)row * D) + lane;
#pragma unroll
        for (int j = 0; j < 4; ++j) {
            const f32x4 g = *(const f32x4*)(gw + lane * 4 + 256 * j);
            if (!dry) o[64 * j] = (f32x4){v[j].x * rs * g.x, v[j].y * rs * g.y, v[j].z * rs * g.z, v[j].w * rs * g.w};
        }
    }
}

__device__ __forceinline__ int vblock() { const int G = gridDim.x, bx = blockIdx.x; return (G % 8 == 0) ? (bx % 8) * (G / 8) + bx / 8 : bx; }
struct ALoadPlain {
    const bf16_t* A; size_t lda;
    __device__ __forceinline__ const bf16_t* base(int kt) const { return A + kt * 64; }
    __device__ __forceinline__ unsigned off(int r, int lc) const { return (unsigned)r * (unsigned)lda + (unsigned)lc * 8u; }
};
struct ALoadGroup {
    const bf16_t* A;
    __device__ __forceinline__ const bf16_t* base(int kt) const { return A + (size_t)kt * 4 * T * 16; }
    __device__ __forceinline__ unsigned off(int r, int lc) const { return ((unsigned)(lc >> 1) * (unsigned)T + (unsigned)r) * 16u + (unsigned)(lc & 1) * 8u; }
};

template <class AL>
__device__ __forceinline__ void gemm_tile2(const AL al, const bf16_t* __restrict__ Bt, size_t ldb, int nk, f32x4 (&acc)[4][4], unsigned char* lds) {
    const int tid = threadIdx.x, lane = tid & 63, wid = tid >> 6, wr = wid >> 1, wc = wid & 1, fr = lane & 15, fq = lane >> 4;
    const int lr = tid >> 3, lc = tid & 7;
#pragma unroll
    for (int mi = 0; mi < 4; ++mi)
#pragma unroll
        for (int ni = 0; ni < 4; ++ni) acc[mi][ni] = (f32x4){0.f, 0.f, 0.f, 0.f};
    u32x4 ra0[4], rb0[4], ra1[4], rb1[4];
    const int soff = lr * 128 + ((lc ^ (lr & 7)) << 4);
    unsigned offA[4], offB[4];
#pragma unroll
    for (int i = 0; i < 4; ++i) { offA[i] = al.off(lr + 32 * i, lc); offB[i] = (unsigned)(lr + 32 * i) * (unsigned)ldb + (unsigned)lc * 8u; }
#define GT_LOAD(RA, RB, kt_) do { const bf16_t* ab_ = al.base(kt_); const bf16_t* bb_ = Bt + (kt_) * 64; _Pragma("unroll") for (int i = 0; i < 4; ++i) { RA[i] = *(const u32x4*)(ab_ + offA[i]); RB[i] = *(const u32x4*)(bb_ + offB[i]); } } while (0)
#define GT_STORE(RA, RB, buf_) do { unsigned char* nb_ = lds + (buf_) * 32768; _Pragma("unroll") for (int i = 0; i < 4; ++i) { *(u32x4*)(nb_ + soff + i * 4096) = RA[i]; *(u32x4*)(nb_ + 16384 + soff + i * 4096) = RB[i]; } } while (0)
    const int aoff = (wr * 64 + fr) * 128, boff = 16384 + (wc * 64 + fr) * 128, sw = fr & 7;
#define GT_MATH(buf_) do { const unsigned char* bp_ = lds + (buf_) * 32768; _Pragma("unroll") for (int ks = 0; ks < 2; ++ks) { bf16x8 af[4], bfr[4]; const int co = ((ks * 4 + fq) ^ sw) << 4; \
        _Pragma("unroll") for (int mi = 0; mi < 4; ++mi) af[mi] = *(const bf16x8*)(bp_ + aoff + mi * 2048 + co); \
        _Pragma("unroll") for (int ni = 0; ni < 4; ++ni) bfr[ni] = *(const bf16x8*)(bp_ + boff + ni * 2048 + co); \
        _Pragma("unroll") for (int mi = 0; mi < 4; ++mi) _Pragma("unroll") for (int ni = 0; ni < 4; ++ni) acc[mi][ni] = __builtin_amdgcn_mfma_f32_16x16x32_bf16(bfr[ni], af[mi], acc[mi][ni], 0, 0, 0); } } while (0)
    GT_LOAD(ra0, rb0, 0);
    if (nk > 1) GT_LOAD(ra1, rb1, 1);
    GT_STORE(ra0, rb0, 0);
    __syncthreads();
    for (int kt = 0; kt < nk; kt += 2) {
        if (kt + 2 < nk) GT_LOAD(ra0, rb0, kt + 2);
        __builtin_amdgcn_sched_barrier(0);
        GT_MATH(0);
        __builtin_amdgcn_sched_barrier(0);
        if (kt + 1 < nk) GT_STORE(ra1, rb1, 1);
        __syncthreads();
        if (kt + 1 >= nk) break;
        if (kt + 3 < nk) GT_LOAD(ra1, rb1, kt + 3);
        __builtin_amdgcn_sched_barrier(0);
        GT_MATH(1);
        __builtin_amdgcn_sched_barrier(0);
        if (kt + 2 < nk) GT_STORE(ra0, rb0, 0);
        __syncthreads();
    }
#undef GT_LOAD
#undef GT_STORE
#undef GT_MATH
}

template <class AL>
__device__ __forceinline__ void gemm_tile1(const AL al, const bf16_t* __restrict__ Bt, size_t ldb, int nk, f32x4 (&acc)[4][4], unsigned char* lds) {
    const int tid = threadIdx.x, lane = tid & 63, wid = tid >> 6, wr = wid >> 1, wc = wid & 1, fr = lane & 15, fq = lane >> 4;
    const int lr = tid >> 3, lc = tid & 7;
#pragma unroll
    for (int mi = 0; mi < 4; ++mi)
#pragma unroll
        for (int ni = 0; ni < 4; ++ni) acc[mi][ni] = (f32x4){0.f, 0.f, 0.f, 0.f};
    u32x4 ra[4], rb[4];
    const int soff = lr * 128 + ((lc ^ (lr & 7)) << 4);
#pragma unroll
    for (int i = 0; i < 4; ++i) { ra[i] = *(const u32x4*)(al.base(0) + al.off(lr + 32 * i, lc)); rb[i] = *(const u32x4*)(Bt + (size_t)(lr + 32 * i) * ldb + lc * 8); }
#pragma unroll
    for (int i = 0; i < 4; ++i) { *(u32x4*)(lds + soff + i * 4096) = ra[i]; *(u32x4*)(lds + 16384 + soff + i * 4096) = rb[i]; }
    __syncthreads();
    const int aoff = (wr * 64 + fr) * 128, boff = 16384 + (wc * 64 + fr) * 128, sw = fr & 7;
    for (int kt = 0; kt < nk; ++kt) {
        const bool more = (kt + 1 < nk);
        if (more) {
#pragma unroll
            for (int i = 0; i < 4; ++i) { ra[i] = *(const u32x4*)(al.base(kt + 1) + al.off(lr + 32 * i, lc)); rb[i] = *(const u32x4*)(Bt + (size_t)(lr + 32 * i) * ldb + (kt + 1) * 64 + lc * 8); }
        }
        const unsigned char* buf = lds + (kt & 1) * 32768;
#pragma unroll
        for (int ks = 0; ks < 2; ++ks) {
            bf16x8 af[4], bfr[4];
            const int co = ((ks * 4 + fq) ^ sw) << 4;
#pragma unroll
            for (int mi = 0; mi < 4; ++mi) af[mi] = *(const bf16x8*)(buf + aoff + mi * 2048 + co);
#pragma unroll
            for (int ni = 0; ni < 4; ++ni) bfr[ni] = *(const bf16x8*)(buf + boff + ni * 2048 + co);
#pragma unroll
            for (int mi = 0; mi < 4; ++mi)
#pragma unroll
                for (int ni = 0; ni < 4; ++ni) acc[mi][ni] = __builtin_amdgcn_mfma_f32_16x16x32_bf16(bfr[ni], af[mi], acc[mi][ni], 0, 0, 0);
        }
        if (more) {
            unsigned char* nb = lds + ((kt + 1) & 1) * 32768;
#pragma unroll
            for (int i = 0; i < 4; ++i) { *(u32x4*)(nb + soff + i * 4096) = ra[i]; *(u32x4*)(nb + 16384 + soff + i * 4096) = rb[i]; }
        }
        __syncthreads();
    }
}

template <class AL, bool ZERO = true>
__device__ __forceinline__ void gemm_tile3(const AL al, const bf16_t* __restrict__ Bt, size_t ldb, int nk, f32x4 (&acc)[4][4], unsigned char* lds) {
    const int tid = threadIdx.x, lane = tid & 63, wid = tid >> 6, wr = wid >> 1, wc = wid & 1, fr = lane & 15, fq = lane >> 4;
    if (ZERO) {
#pragma unroll
    for (int mi = 0; mi < 4; ++mi)
#pragma unroll
        for (int ni = 0; ni < 4; ++ni) acc[mi][ni] = (f32x4){0.f, 0.f, 0.f, 0.f};
    }
    const int srow = wid * 32 + (lane >> 3), schunk = (lane & 7) ^ ((lane >> 3) & 7);
    unsigned offA[4], offB[4];
#pragma unroll
    for (int i = 0; i < 4; ++i) { offA[i] = al.off(srow + 8 * i, schunk); offB[i] = (unsigned)(srow + 8 * i) * (unsigned)ldb + (unsigned)schunk * 8u; }
#define G3_STAGE(buf_, kt_) do { const bf16_t* ab_ = al.base(kt_); const bf16_t* bb_ = Bt + (kt_) * 64; unsigned char* lb_ = lds + (buf_) * 32768 + wid * 4096; \
        _Pragma("unroll") for (int i = 0; i < 4; ++i) { \
            __builtin_amdgcn_global_load_lds((const unsigned*)(ab_ + offA[i]), (unsigned*)(lb_ + i * 1024), 16, 0, 0); \
            __builtin_amdgcn_global_load_lds((const unsigned*)(bb_ + offB[i]), (unsigned*)(lb_ + 16384 + i * 1024), 16, 0, 0); } } while (0)
    const int aoff = (wr * 64 + fr) * 128, boff = 16384 + (wc * 64 + fr) * 128, sw = fr & 7;
    G3_STAGE(0, 0);
    __syncthreads();
    for (int kt = 0; kt < nk; ++kt) {
        if (kt + 1 < nk) G3_STAGE((kt + 1) & 1, kt + 1);
        const unsigned char* buf = lds + (kt & 1) * 32768;
#pragma unroll
        for (int ks = 0; ks < 2; ++ks) {
            bf16x8 af[4], bfr[4];
            const int co = ((ks * 4 + fq) ^ sw) << 4;
#pragma unroll
            for (int mi = 0; mi < 4; ++mi) af[mi] = *(const bf16x8*)(buf + aoff + mi * 2048 + co);
#pragma unroll
            for (int ni = 0; ni < 4; ++ni) bfr[ni] = *(const bf16x8*)(buf + boff + ni * 2048 + co);
#pragma unroll
            for (int mi = 0; mi < 4; ++mi)
#pragma unroll
                for (int ni = 0; ni < 4; ++ni) acc[mi][ni] = __builtin_amdgcn_mfma_f32_16x16x32_bf16(bfr[ni], af[mi], acc[mi][ni], 0, 0, 0);
        }
        __syncthreads();
    }
#undef G3_STAGE
}

__device__ __forceinline__ void mma_ktile(const unsigned char* buf, f32x4 (&acc)[4][4]) {
    const int tid = threadIdx.x, lane = tid & 63, wid = tid >> 6, wr = wid >> 1, wc = wid & 1, fr = lane & 15, fq = lane >> 4;
    const int aoff = (wr * 64 + fr) * 128, boff = 16384 + (wc * 64 + fr) * 128, sw = fr & 7;
#pragma unroll
    for (int ks = 0; ks < 2; ++ks) {
        bf16x8 af[4], bfr[4];
        const int co = ((ks * 4 + fq) ^ sw) << 4;
#pragma unroll
        for (int mi = 0; mi < 4; ++mi) af[mi] = *(const bf16x8*)(buf + aoff + mi * 2048 + co);
#pragma unroll
        for (int ni = 0; ni < 4; ++ni) bfr[ni] = *(const bf16x8*)(buf + boff + ni * 2048 + co);
#pragma unroll
        for (int mi = 0; mi < 4; ++mi)
#pragma unroll
            for (int ni = 0; ni < 4; ++ni) acc[mi][ni] = __builtin_amdgcn_mfma_f32_16x16x32_bf16(bfr[ni], af[mi], acc[mi][ni], 0, 0, 0);
    }
}
__device__ __forceinline__ void phase_s5_win(const Params& p, unsigned char* lds) {
    const bf16_t* HM = (const bf16_t*)(p.ws + WS_HM); const bf16_t* WT = (const bf16_t*)(p.ws + WS_WIN_T);
    bf16_t* UG = (bf16_t*)(p.ws + WS_UG);
    const int lane = threadIdx.x & 63, wid = threadIdx.x >> 6, wr = wid >> 1, wc = wid & 1, fr = lane & 15, fq = lane >> 4;
    for (int id = vblock(); id < 256 * 8; id += gridDim.x) {
        const int mt = id >> 3, nt = id & 7;
        f32x4 acc[4][4];
        gemm_tile3(ALoadPlain{HM + (size_t)mt * 128 * D, (size_t)D}, WT + (size_t)nt * 128 * D, D, 16, acc, lds);
#pragma unroll
        for (int mi = 0; mi < 4; ++mi)
#pragma unroll
            for (int ni = 0; ni < 4; ++ni) {
                const int t = mt * 128 + wr * 64 + mi * 16 + fr, g = nt * 8 + wc * 4 + ni;
                const f32x4 v = acc[mi][ni];
                *(u32x2*)(UG + ((size_t)g * T + t) * 16 + fq * 4) = (u32x2){pk2(v.x, v.y), pk2(v.z, v.w)};
            }
    }
}
__device__ __forceinline__ void phase_s5_a(const Params& p, unsigned char* lds) {
    const bf16_t* UG = (const bf16_t*)(p.ws + WS_UG); const bf16_t* TW = (const bf16_t*)(p.ws + WS_TW);
    float* WST = (float*)(p.ws + WS_WST);
    const int lane = threadIdx.x & 63, wid = threadIdx.x >> 6, wr = wid >> 1, wc = wid & 1, fr = lane & 15, fq = lane >> 4;
    for (int id = vblock(); id < 64 * 8; id += gridDim.x) {
        const int g = id >> 3, mt = id & 7;
        f32x4 acc[4][4];
        gemm_tile3(ALoadPlain{UG + (size_t)g * T * 16 + (size_t)mt * 128 * 512, (size_t)512}, TW + ((size_t)g * 640 + 512) * 512, 512, 8, acc, lds);
#pragma unroll
        for (int mi = 0; mi < 4; ++mi)
#pragma unroll
            for (int ni = 0; ni < 4; ++ni) {
                const int R = mt * 128 + wr * 64 + mi * 16 + fr, c = wc * 64 + ni * 16 + fq * 4;
                *(f32x4*)(WST + ((size_t)g * 1024 + R) * 128 + c) = acc[mi][ni];
            }
    }
}
__device__ __forceinline__ void phase_s5_scan(const Params& p) {
    const int lane = threadIdx.x & 63, wave = threadIdx.x >> 6;
    const float* WST = (const float*)(p.ws + WS_WST); bf16_t* SST = (bf16_t*)(p.ws + WS_SST);
    const f32x2* AL = (const f32x2*)(p.ws + WS_MISC + 4096);
    for (int it = blockIdx.x * 4 + wave; it < 128; it += gridDim.x * 4) {
        const int b = it >> 6, g = it & 63;
        const f32x2 al = AL[g * 64 + lane];
        float sr = 0.f, si = 0.f;
        const float* wbase = WST + ((size_t)g * 1024 + b * 512) * 128 + lane;
        bf16_t* sbase = SST + ((size_t)g * 1024 + b * 512) * 128 + lane;
        for (int n0 = 0; n0 < 512; n0 += 16) {
            float wre[16], wim[16];
#pragma unroll
            for (int j = 0; j < 16; ++j) { wre[j] = wbase[(size_t)(n0 + j) * 128]; wim[j] = wbase[(size_t)(n0 + j) * 128 + 64]; }
#pragma unroll
            for (int j = 0; j < 16; ++j) {
                sbase[(size_t)(n0 + j) * 128] = (bf16_t)f2bf(sr); sbase[(size_t)(n0 + j) * 128 + 64] = (bf16_t)f2bf(si);
                const float nr = al.x * sr - al.y * si + wre[j], ni = al.x * si + al.y * sr + wim[j];
                sr = nr; si = ni;
            }
        }
    }
}
__device__ __forceinline__ void phase_s5_b(const Params& p, unsigned char* lds) {
    const bf16_t* SST = (const bf16_t*)(p.ws + WS_SST); const bf16_t* VG = (const bf16_t*)(p.ws + WS_VG);
    const bf16_t* UG = (const bf16_t*)(p.ws + WS_UG); const bf16_t* TW = (const bf16_t*)(p.ws + WS_TW);
    bf16_t* YG = (bf16_t*)(p.ws + WS_YG);
    const float* dsk = p.in[14];
    const int lane = threadIdx.x & 63, wid = threadIdx.x >> 6, wr = wid >> 1, wc = wid & 1, fr = lane & 15, fq = lane >> 4;
    for (int id = vblock(); id < 64 * 32; id += gridDim.x) {
        const int g = id >> 5, mt = (id >> 2) & 7, nt = 3 - (id & 3);
        f32x4 acc[4][4];
        gemm_tile3<ALoadPlain, true>(ALoadPlain{UG + (size_t)g * T * 16 + (size_t)mt * 128 * 512, (size_t)512}, TW + ((size_t)g * 640 + nt * 128) * 512, 512, 2 * (nt + 1), acc, lds);
        gemm_tile3<ALoadPlain, false>(ALoadPlain{SST + ((size_t)g * 1024 + mt * 128) * 128, (size_t)128}, VG + ((size_t)g * 512 + nt * 128) * 128, 128, 2, acc, lds);
        const f32x4 dv = *(const f32x4*)(dsk + g * 16 + fq * 4);
#pragma unroll
        for (int mi = 0; mi < 4; ++mi)
#pragma unroll
            for (int ni = 0; ni < 4; ++ni) {
                const int R = mt * 128 + wr * 64 + mi * 16 + fr, c = nt * 128 + wc * 64 + ni * 16 + fq * 4;
                const size_t idx = ((size_t)g * 1024 + R) * 512 + c;
                const u32x2 uu = *(const u32x2*)(UG + idx);
                const f32x4 v = acc[mi][ni];
                const float y0 = gelu_tanh(v.x + dv.x * bflo(uu.x)), y1 = gelu_tanh(v.y + dv.y * bfhi(uu.x));
                const float y2 = gelu_tanh(v.z + dv.z * bflo(uu.y)), y3 = gelu_tanh(v.w + dv.w * bfhi(uu.y));
                *(u32x2*)(YG + idx) = (u32x2){pk2(y0, y1), pk2(y2, y3)};
            }
    }
}
__device__ __forceinline__ void phase_s5_glu(const Params& p, unsigned char* lds) {
    const bf16_t* YG = (const bf16_t*)(p.ws + WS_YG); const bf16_t* WT = (const bf16_t*)(p.ws + WS_WGLU_T);
    const float* MOD = (const float*)(p.ws + WS_MOD);
    const float* X = p.in[0]; float* XO = p.out;
    const int lane = threadIdx.x & 63, wid = threadIdx.x >> 6, wr = wid >> 1, wc = wid & 1, fr = lane & 15, fq = lane >> 4;
    for (int id = vblock(); id < 256 * 16; id += gridDim.x) {
        const int mt = id >> 4, nt = id & 15;
        f32x4 acc[4][4];
        gemm_tile3(ALoadGroup{YG + (size_t)mt * 128 * 16}, WT + (size_t)nt * 128 * D, D, 16, acc, lds);
        const int b = (mt * 128) / SEQ;
#pragma unroll
        for (int mi = 0; mi < 4; ++mi)
#pragma unroll
            for (int h = 0; h < 2; ++h) {
                const int t = mt * 128 + wr * 64 + mi * 16 + fr, j = nt * 64 + wc * 32 + h * 16 + fq * 4;
                const f32x4 a = acc[mi][2 * h], gg = acc[mi][2 * h + 1];
                const f32x4 g1 = *(const f32x4*)(MOD + (size_t)(0 * 2 + b) * 6144 + 2048 + j);
                const f32x4 xi = *(const f32x4*)(X + (size_t)t * D + j);
                f32x4 o;
                o.x = xi.x + g1.x * (a.x * sigmoidf_(gg.x)); o.y = xi.y + g1.y * (a.y * sigmoidf_(gg.y));
                o.z = xi.z + g1.z * (a.z * sigmoidf_(gg.z)); o.w = xi.w + g1.w * (a.w * sigmoidf_(gg.w));
                *(f32x4*)(XO + (size_t)t * D + j) = o;
            }
    }
}
__device__ __forceinline__ void phase_peer_wq(const Params& p, int layer, unsigned char* lds) {
    const bf16_t* HM = (const bf16_t*)(p.ws + WS_HM); const bf16_t* WT = (const bf16_t*)(p.ws + WS_WQ_T) + (size_t)layer * 2048 * 1024;
    bf16_t* QK = (bf16_t*)(p.ws + WS_QK);
    const int lane = threadIdx.x & 63, wid = threadIdx.x >> 6, wr = wid >> 1, wc = wid & 1, fr = lane & 15, fq = lane >> 4;
    for (int id = vblock(); id < 256 * 16; id += gridDim.x) {
        const int mt = id >> 4, nt = id & 15;
        f32x4 acc[4][4];
        gemm_tile3(ALoadPlain{HM + (size_t)mt * 128 * D, (size_t)D}, WT + (size_t)nt * 128 * D, D, 16, acc, lds);
#pragma unroll
        for (int mi = 0; mi < 4; ++mi)
#pragma unroll
            for (int ni = 0; ni < 4; ++ni) {
                const int t = mt * 128 + wr * 64 + mi * 16 + fr, c = nt * 128 + wc * 64 + ni * 16 + fq * 4;
                const f32x4 v = acc[mi][ni];
                *(u32x2*)(QK + (size_t)t * 2048 + c) = (u32x2){pk2(v.x, v.y), pk2(v.z, v.w)};
            }
    }
}
__device__ __forceinline__ void ce_(unsigned& a, unsigned& b, const bool up) { const unsigned lo = a < b ? a : b, hi = a < b ? b : a; a = up ? lo : hi; b = up ? hi : lo; }
__device__ __forceinline__ void bitonic_sort16(unsigned* x, const bool asc) {
#pragma unroll
    for (int k = 2; k <= 16; k <<= 1)
#pragma unroll
        for (int j = k >> 1; j > 0; j >>= 1)
#pragma unroll
            for (int i = 0; i < 16; ++i) { const int l = i ^ j; if (l > i) ce_(x[i], x[l], ((i & k) == 0) == asc); }
}
__device__ __forceinline__ void bitonic_merge16(unsigned* x, const bool asc) {
#pragma unroll
    for (int j = 8; j > 0; j >>= 1)
#pragma unroll
        for (int i = 0; i < 16; ++i) { const int l = i ^ j; if (l > i) ce_(x[i], x[l], asc); }
}
__device__ __forceinline__ void phase_peer_topk(const Params& p, int layer, unsigned char* lds) {
    const bf16_t* QK = (const bf16_t*)(p.ws + WS_QK); const bf16_t* SK = (const bf16_t*)(p.ws + WS_SUBK) + (size_t)layer * 8 * 2 * 128 * 128;
    float* TOPS = (float*)(p.ws + WS_TOPS); int* TOPI = (int*)(p.ws + WS_TOPI);
    float* sc = (float*)lds;
    const int tid = threadIdx.x, lane = tid & 63, wid = tid >> 6, wr = wid >> 1, wc = wid & 1, fr = lane & 15, fq = lane >> 4;
    for (int id = vblock(); id < 256 * 16; id += gridDim.x) {
        const int mt = id >> 4, hc = id & 15;
        f32x4 acc[4][4];
        gemm_tile3(ALoadPlain{QK + (size_t)mt * 128 * 2048 + hc * 128, (size_t)2048}, SK + (size_t)hc * 128 * 128, 128, 2, acc, lds);
#pragma unroll
        for (int mi = 0; mi < 4; ++mi)
#pragma unroll
            for (int ni = 0; ni < 4; ++ni) {
                const int r = wr * 64 + mi * 16 + fr, c = wc * 64 + ni * 16 + fq * 4;
                float* d = sc + r * 129 + c;
                d[0] = acc[mi][ni].x; d[1] = acc[mi][ni].y; d[2] = acc[mi][ni].z; d[3] = acc[mi][ni].w;
            }
        __syncthreads();
        {
            const int row = tid >> 1, half = tid & 1;
            unsigned x[64];
            const float* rp = sc + row * 129 + half * 64;
#pragma unroll
            for (int j = 0; j < 64; ++j) {
                const unsigned bits = __builtin_bit_cast(unsigned, rp[j]);
                const unsigned u = bits ^ ((unsigned)((int)bits >> 31) | 0x80000000u);
                x[j] = (u & 0xFFFFFF80u) | (unsigned)(127 - (half * 64 + j));
            }
            bitonic_sort16(x, true); bitonic_sort16(x + 16, false); bitonic_sort16(x + 32, true); bitonic_sort16(x + 48, false);
#pragma unroll
            for (int i = 0; i < 16; ++i) { x[i] = x[i] > x[16 + i] ? x[i] : x[16 + i]; x[32 + i] = x[32 + i] > x[48 + i] ? x[32 + i] : x[48 + i]; }
            bitonic_merge16(x, true); bitonic_merge16(x + 32, false);
#pragma unroll
            for (int i = 0; i < 16; ++i) x[i] = x[i] > x[32 + i] ? x[i] : x[32 + i];
            bitonic_merge16(x, false);
            unsigned y[16];
#pragma unroll
            for (int i = 0; i < 16; ++i) { const unsigned o = (unsigned)__shfl_xor((int)x[15 - i], 1); y[i] = x[i] > o ? x[i] : o; }
            bitonic_merge16(y, false);
            const size_t ob = ((size_t)(mt * 128 + row) * 16 + hc) * 16;
            if (half == 0) {
                float v[16];
#pragma unroll
                for (int i = 0; i < 16; ++i) { const unsigned u = y[i] & 0xFFFFFF80u; const unsigned bits = (u & 0x80000000u) ? (u ^ 0x80000000u) : ~u; v[i] = __builtin_bit_cast(float, bits); }
#pragma unroll
                for (int q = 0; q < 4; ++q) *(f32x4*)(TOPS + ob + q * 4) = (f32x4){v[q * 4], v[q * 4 + 1], v[q * 4 + 2], v[q * 4 + 3]};
            } else {
#pragma unroll
                for (int q = 0; q < 4; ++q) *(u32x4*)(TOPI + ob + q * 4) = (u32x4){127u - (y[q * 4] & 127u), 127u - (y[q * 4 + 1] & 127u), 127u - (y[q * 4 + 2] & 127u), 127u - (y[q * 4 + 3] & 127u)};
            }
        }
        __syncthreads();
    }
}
__device__ __forceinline__ void phase_peer_wq_topk(const Params& p, int layer, unsigned char* lds) {
    const bf16_t* HM = (const bf16_t*)(p.ws + WS_HM); const bf16_t* WT = (const bf16_t*)(p.ws + WS_WQ_T) + (size_t)layer * 2048 * 1024;
    const bf16_t* SK = (const bf16_t*)(p.ws + WS_SUBK) + (size_t)layer * 8 * 2 * 128 * 128;
    float* TOPS = (float*)(p.ws + WS_TOPS); int* TOPI = (int*)(p.ws + WS_TOPI);
    float* sc = (float*)lds;
    const int tid = threadIdx.x, lane = tid & 63, wid = tid >> 6, wr = wid >> 1, wc = wid & 1, fr = lane & 15, fq = lane >> 4;
    for (int id = vblock(); id < 256 * 16; id += gridDim.x) {
        const int mt = id >> 4, hc = id & 15;
        f32x4 acc[4][4];
        gemm_tile3(ALoadPlain{HM + (size_t)mt * 128 * D, (size_t)D}, WT + (size_t)hc * 128 * D, D, 16, acc, lds);
        {
            const int srow = wid * 32 + (lane >> 3), schunk = (lane & 7) ^ ((lane >> 3) & 7);
            const bf16_t* sk = SK + (size_t)hc * 128 * 128;
#pragma unroll
            for (int kt = 0; kt < 2; ++kt)
#pragma unroll
                for (int i = 0; i < 4; ++i)
                    __builtin_amdgcn_global_load_lds((const unsigned*)(sk + (srow + 8 * i) * 128 + kt * 64 + schunk * 8), (unsigned*)(lds + kt * 32768 + 16384 + wid * 4096 + i * 1024), 16, 0, 0);
        }
#pragma unroll
        for (int mi = 0; mi < 4; ++mi)
#pragma unroll
            for (int ni = 0; ni < 4; ++ni) {
                const int r = wr * 64 + mi * 16 + fr, chunk = ni * 2 + (fq >> 1);
                const f32x4 v = acc[mi][ni];
                *(u32x2*)(lds + wc * 32768 + r * 128 + ((chunk ^ (r & 7)) << 4) + (fq & 1) * 8) = (u32x2){pk2(v.x, v.y), pk2(v.z, v.w)};
            }
        __syncthreads();
#pragma unroll
        for (int mi = 0; mi < 4; ++mi)
#pragma unroll
            for (int ni = 0; ni < 4; ++ni) acc[mi][ni] = (f32x4){0.f, 0.f, 0.f, 0.f};
        mma_ktile(lds, acc); mma_ktile(lds + 32768, acc);
        __syncthreads();
#pragma unroll
        for (int mi = 0; mi < 4; ++mi)
#pragma unroll
            for (int ni = 0; ni < 4; ++ni) {
                const int r = wr * 64 + mi * 16 + fr, c = wc * 64 + ni * 16 + fq * 4;
                float* d = sc + r * 129 + c;
                d[0] = acc[mi][ni].x; d[1] = acc[mi][ni].y; d[2] = acc[mi][ni].z; d[3] = acc[mi][ni].w;
            }
        __syncthreads();
        {
            const int row = tid >> 1, half = tid & 1;
            unsigned x[64];
            const float* rp = sc + row * 129 + half * 64;
#pragma unroll
            for (int j = 0; j < 64; ++j) {
                const unsigned bits = __builtin_bit_cast(unsigned, rp[j]);
                const unsigned u = bits ^ ((unsigned)((int)bits >> 31) | 0x80000000u);
                x[j] = (u & 0xFFFFFF80u) | (unsigned)(127 - (half * 64 + j));
            }
            bitonic_sort16(x, true); bitonic_sort16(x + 16, false); bitonic_sort16(x + 32, true); bitonic_sort16(x + 48, false);
#pragma unroll
            for (int i = 0; i < 16; ++i) { x[i] = x[i] > x[16 + i] ? x[i] : x[16 + i]; x[32 + i] = x[32 + i] > x[48 + i] ? x[32 + i] : x[48 + i]; }
            bitonic_merge16(x, true); bitonic_merge16(x + 32, false);
#pragma unroll
            for (int i = 0; i < 16; ++i) x[i] = x[i] > x[32 + i] ? x[i] : x[32 + i];
            bitonic_merge16(x, false);
            unsigned y[16];
#pragma unroll
            for (int i = 0; i < 16; ++i) { const unsigned o = (unsigned)__shfl_xor((int)x[15 - i], 1); y[i] = x[i] > o ? x[i] : o; }
            bitonic_merge16(y, false);
            const size_t ob = ((size_t)(mt * 128 + row) * 16 + hc) * 16;
            if (half == 0) {
                float v[16];
#pragma unroll
                for (int i = 0; i < 16; ++i) { const unsigned u = y[i] & 0xFFFFFF80u; const unsigned bits = (u & 0x80000000u) ? (u ^ 0x80000000u) : ~u; v[i] = __builtin_bit_cast(float, bits); }
#pragma unroll
                for (int q = 0; q < 4; ++q) *(f32x4*)(TOPS + ob + q * 4) = (f32x4){v[q * 4], v[q * 4 + 1], v[q * 4 + 2], v[q * 4 + 3]};
            } else {
#pragma unroll
                for (int q = 0; q < 4; ++q) *(u32x4*)(TOPI + ob + q * 4) = (u32x4){127u - (y[q * 4] & 127u), 127u - (y[q * 4 + 1] & 127u), 127u - (y[q * 4 + 2] & 127u), 127u - (y[q * 4 + 3] & 127u)};
            }
        }
        __syncthreads();
    }
}
__device__ __forceinline__ void phase_peer_route(const Params& p, int layer, unsigned char* lds) {
    const bf16_t* HM = (const bf16_t*)(p.ws + WS_HM); const bf16_t* WT = (const bf16_t*)(p.ws + WS_WQ_T) + (size_t)layer * 2048 * 1024;
    const bf16_t* SK = (const bf16_t*)(p.ws + WS_SUBK) + (size_t)layer * 8 * 2 * 128 * 128;
    int* EXP = (int*)(p.ws + WS_EXP); float* GATE = (float*)(p.ws + WS_GATE);
    float* sc = (float*)lds;
    unsigned* KEYS0 = (unsigned*)(lds + 66048);
    unsigned* L = (unsigned*)lds;
    const int tid = threadIdx.x, lane = tid & 63, wid = tid >> 6, wr = wid >> 1, wc = wid & 1, fr = lane & 15, fq = lane >> 4;
    for (int id = vblock(); id < 256 * 8; id += gridDim.x) {
        const int mt = id >> 3, h = id & 7;
        const int row = tid >> 1, half = tid & 1;
        unsigned y[16];
#pragma unroll 1
        for (int c = 0; c < 2; ++c) {
            const int hc = h * 2 + c;
            f32x4 acc[4][4];
            gemm_tile3(ALoadPlain{HM + (size_t)mt * 128 * D, (size_t)D}, WT + (size_t)hc * 128 * D, D, 16, acc, lds);
            {
                const int srow = wid * 32 + (lane >> 3), schunk = (lane & 7) ^ ((lane >> 3) & 7);
                const bf16_t* sk = SK + (size_t)hc * 128 * 128;
#pragma unroll
                for (int kt = 0; kt < 2; ++kt)
#pragma unroll
                    for (int i = 0; i < 4; ++i)
                        __builtin_amdgcn_global_load_lds((const unsigned*)(sk + (srow + 8 * i) * 128 + kt * 64 + schunk * 8), (unsigned*)(lds + kt * 32768 + 16384 + wid * 4096 + i * 1024), 16, 0, 0);
            }
#pragma unroll
            for (int mi = 0; mi < 4; ++mi)
#pragma unroll
                for (int ni = 0; ni < 4; ++ni) {
                    const int r = wr * 64 + mi * 16 + fr, chunk = ni * 2 + (fq >> 1);
                    const f32x4 v = acc[mi][ni];
                    *(u32x2*)(lds + wc * 32768 + r * 128 + ((chunk ^ (r & 7)) << 4) + (fq & 1) * 8) = (u32x2){pk2(v.x, v.y), pk2(v.z, v.w)};
                }
            __syncthreads();
#pragma unroll
            for (int mi = 0; mi < 4; ++mi)
#pragma unroll
                for (int ni = 0; ni < 4; ++ni) acc[mi][ni] = (f32x4){0.f, 0.f, 0.f, 0.f};
            mma_ktile(lds, acc); mma_ktile(lds + 32768, acc);
            __syncthreads();
#pragma unroll
            for (int mi = 0; mi < 4; ++mi)
#pragma unroll
                for (int ni = 0; ni < 4; ++ni) {
                    const int r = wr * 64 + mi * 16 + fr, cc = wc * 64 + ni * 16 + fq * 4;
                    float* d = sc + r * 129 + cc;
                    d[0] = acc[mi][ni].x; d[1] = acc[mi][ni].y; d[2] = acc[mi][ni].z; d[3] = acc[mi][ni].w;
                }
            __syncthreads();
            {
                unsigned x[64];
                const float* rp = sc + row * 129 + half * 64;
#pragma unroll
                for (int j = 0; j < 64; ++j) {
                    const unsigned bits = __builtin_bit_cast(unsigned, rp[j]);
                    const unsigned u = bits ^ ((unsigned)((int)bits >> 31) | 0x80000000u);
                    x[j] = (u & 0xFFFFFF80u) | (unsigned)(127 - (half * 64 + j));
                }
                bitonic_sort16(x, true); bitonic_sort16(x + 16, false); bitonic_sort16(x + 32, true); bitonic_sort16(x + 48, false);
#pragma unroll
                for (int i = 0; i < 16; ++i) { x[i] = x[i] > x[16 + i] ? x[i] : x[16 + i]; x[32 + i] = x[32 + i] > x[48 + i] ? x[32 + i] : x[48 + i]; }
                bitonic_merge16(x, true); bitonic_merge16(x + 32, false);
#pragma unroll
                for (int i = 0; i < 16; ++i) x[i] = x[i] > x[32 + i] ? x[i] : x[32 + i];
                bitonic_merge16(x, false);
#pragma unroll
                for (int i = 0; i < 16; ++i) { const unsigned o = (unsigned)__shfl_xor((int)x[15 - i], 1); y[i] = x[i] > o ? x[i] : o; }
                bitonic_merge16(y, false);
            }
            if (c == 0 && half == 0) {
#pragma unroll
                for (int i = 0; i < 16; ++i) KEYS0[i * 128 + row] = y[i];
            }
            __syncthreads();
        }
        {
            unsigned kk[16];
#pragma unroll
            for (int i = 0; i < 16; ++i) kk[i] = half ? KEYS0[i * 128 + row] : y[i];
            const int sb = half ? 0 : 16, ib = half ? 32 : 48;
#pragma unroll
            for (int i = 0; i < 16; ++i) {
                const unsigned u = kk[i] & 0xFFFFFF80u; const unsigned bits = (u & 0x80000000u) ? (u ^ 0x80000000u) : ~u;
                L[(sb + i) * 128 + row] = bits; L[(ib + i) * 128 + row] = 127u - (kk[i] & 127u);
            }
        }
        __syncthreads();
        if (tid < 128) {
            const int col = tid;
            float val[16];
            const float s20 = __builtin_bit_cast(float, L[16 * 128 + col]);
#pragma unroll
            for (int a = 0; a < 16; ++a) val[a] = __builtin_bit_cast(float, L[a * 128 + col]) + s20;
            unsigned long long P = 0ull;
            float ts[16]; int te[16];
#pragma unroll
            for (int r = 0; r < 16; ++r) {
                float best = val[0]; int ba = 0;
#pragma unroll
                for (int a = 1; a < 16; ++a) if (val[a] > best) { best = val[a]; ba = a; }
                const int b = (int)((P >> (4 * ba)) & 15ull);
                const int i1 = (int)L[(32 + ba) * 128 + col], i2 = (int)L[(48 + b) * 128 + col];
                ts[r] = best; te[r] = i1 * 128 + i2;
                const int nb = b + 1;
                float newv = -3.0e38f;
                if (nb < 16) { newv = __builtin_bit_cast(float, L[ba * 128 + col]) + __builtin_bit_cast(float, L[(16 + nb) * 128 + col]); P += 1ull << (4 * ba); }
#pragma unroll
                for (int a = 0; a < 16; ++a) val[a] = (a == ba) ? newv : val[a];
            }
            const float m0 = ts[0];
            float sum = 0.f;
#pragma unroll
            for (int r = 0; r < 16; ++r) { ts[r] = __expf(ts[r] - m0); sum += ts[r]; }
            const float inv = 1.0f / sum;
            const size_t ob = ((size_t)(mt * 128 + col) * 8 + h) * 16;
#pragma unroll
            for (int q = 0; q < 4; ++q) {
                *(u32x4*)(EXP + ob + q * 4) = (u32x4){(unsigned)te[q * 4], (unsigned)te[q * 4 + 1], (unsigned)te[q * 4 + 2], (unsigned)te[q * 4 + 3]};
                *(f32x4*)(GATE + ob + q * 4) = (f32x4){ts[q * 4] * inv, ts[q * 4 + 1] * inv, ts[q * 4 + 2] * inv, ts[q * 4 + 3] * inv};
            }
        }
        __syncthreads();
    }
}
__device__ __forceinline__ void phase_peer_combine(const Params& p, unsigned char* lds) {
    const float* TOPS = (const float*)(p.ws + WS_TOPS); const int* TOPI = (const int*)(p.ws + WS_TOPI);
    int* EXP = (int*)(p.ws + WS_EXP); float* GATE = (float*)(p.ws + WS_GATE);
    unsigned* L = (unsigned*)lds;
    const int tid = threadIdx.x;
    for (int it = blockIdx.x; it < (T * 8) / 256; it += gridDim.x) {
        const size_t th = (size_t)it * 256 + tid;
        const u32x4* S4 = (const u32x4*)(TOPS + th * 32); const u32x4* I4 = (const u32x4*)(TOPI + th * 32);
#pragma unroll
        for (int a4 = 0; a4 < 8; ++a4) {
            const u32x4 s = S4[a4], i = I4[a4];
            L[(a4 * 4 + 0) * 256 + tid] = s.x; L[(a4 * 4 + 1) * 256 + tid] = s.y; L[(a4 * 4 + 2) * 256 + tid] = s.z; L[(a4 * 4 + 3) * 256 + tid] = s.w;
            L[(32 + a4 * 4 + 0) * 256 + tid] = i.x; L[(32 + a4 * 4 + 1) * 256 + tid] = i.y; L[(32 + a4 * 4 + 2) * 256 + tid] = i.z; L[(32 + a4 * 4 + 3) * 256 + tid] = i.w;
        }
        float val[16];
        const float s20 = __builtin_bit_cast(float, L[16 * 256 + tid]);
#pragma unroll
        for (int a = 0; a < 16; ++a) val[a] = __builtin_bit_cast(float, L[a * 256 + tid]) + s20;
        unsigned long long P = 0ull;
        float ts[16]; int te[16];
#pragma unroll
        for (int r = 0; r < 16; ++r) {
            float best = val[0]; int ba = 0;
#pragma unroll
            for (int a = 1; a < 16; ++a) if (val[a] > best) { best = val[a]; ba = a; }
            const int b = (int)((P >> (4 * ba)) & 15ull);
            const int i1 = (int)L[(32 + ba) * 256 + tid], i2 = (int)L[(48 + b) * 256 + tid];
            ts[r] = best; te[r] = i1 * 128 + i2;
            const int nb = b + 1;
            float newv = -3.0e38f;
            if (nb < 16) { newv = __builtin_bit_cast(float, L[ba * 256 + tid]) + __builtin_bit_cast(float, L[(16 + nb) * 256 + tid]); P += 1ull << (4 * ba); }
#pragma unroll
            for (int a = 0; a < 16; ++a) val[a] = (a == ba) ? newv : val[a];
        }
        const float m0 = ts[0];
        float sum = 0.f;
#pragma unroll
        for (int r = 0; r < 16; ++r) { ts[r] = __expf(ts[r] - m0); sum += ts[r]; }
        const float inv = 1.0f / sum;
#pragma unroll
        for (int r = 0; r < 16; ++r) ts[r] *= inv;
#pragma unroll
        for (int r = 0; r < 16; ++r) { EXP[th * 16 + r] = te[r]; GATE[th * 16 + r] = ts[r]; }
    }
}

__device__ __forceinline__ void fma8(const unsigned w0, const unsigned w1, const float a, float* acc) {
    const f32x2 p0 = __builtin_amdgcn_cvt_pk_f32_fp8((int)w0, false), p1 = __builtin_amdgcn_cvt_pk_f32_fp8((int)w0, true);
    const f32x2 p2 = __builtin_amdgcn_cvt_pk_f32_fp8((int)w1, false), p3 = __builtin_amdgcn_cvt_pk_f32_fp8((int)w1, true);
    acc[0] += a * p0.x; acc[1] += a * p0.y; acc[2] += a * p1.x; acc[3] += a * p1.y;
    acc[4] += a * p2.x; acc[5] += a * p2.y; acc[6] += a * p3.x; acc[7] += a * p3.y;
}
__device__ __forceinline__ float dot8(const unsigned w0, const unsigned w1, const float* h, float s) {
    const f32x2 p0 = __builtin_amdgcn_cvt_pk_f32_fp8((int)w0, false), p1 = __builtin_amdgcn_cvt_pk_f32_fp8((int)w0, true);
    const f32x2 p2 = __builtin_amdgcn_cvt_pk_f32_fp8((int)w1, false), p3 = __builtin_amdgcn_cvt_pk_f32_fp8((int)w1, true);
    s += p0.x * h[0]; s += p0.y * h[1]; s += p1.x * h[2]; s += p1.y * h[3];
    s += p2.x * h[4]; s += p2.y * h[5]; s += p3.x * h[6]; s += p3.y * h[7];
    return s;
}
__device__ __forceinline__ void phase_peer_apply(const Params& p, int layer, unsigned char* lds, bool dry) {
    const int lane = threadIdx.x & 63, wave = threadIdx.x >> 6;
    float* ldsw = (float*)lds + wave * (64 * 65);
    const bf16_t* HM = (const bf16_t*)(p.ws + WS_HM);
    const unsigned char* PU = p.ws + WS_PU; const unsigned char* PV = p.ws + WS_PV;
    const float* SU = (const float*)(p.ws + WS_PU + 24 * MiB); const float* SV = (const float*)(p.ws + WS_PV + 24 * MiB);
    const int* EXP = (const int*)(p.ws + WS_EXP); const float* GATE = (const float*)(p.ws + WS_GATE);
    const float* MOD = (const float*)(p.ws + WS_MOD);
    float* X = p.out;
    for (int t = blockIdx.x * 4 + wave; t < T; t += gridDim.x * 4) {
        const u32x4 ha = *(const u32x4*)(HM + (size_t)t * D + lane * 16), hb = *(const u32x4*)(HM + (size_t)t * D + lane * 16 + 8);
        float hf[16];
        hf[0] = bflo(ha.x); hf[1] = bfhi(ha.x); hf[2] = bflo(ha.y); hf[3] = bfhi(ha.y); hf[4] = bflo(ha.z); hf[5] = bfhi(ha.z); hf[6] = bflo(ha.w); hf[7] = bfhi(ha.w);
        hf[8] = bflo(hb.x); hf[9] = bfhi(hb.x); hf[10] = bflo(hb.y); hf[11] = bfhi(hb.y); hf[12] = bflo(hb.z); hf[13] = bfhi(hb.z); hf[14] = bflo(hb.w); hf[15] = bfhi(hb.w);
        const int e0_ = EXP[(size_t)t * 128 + lane], e1_ = EXP[(size_t)t * 128 + 64 + lane];
        const float g0 = GATE[(size_t)t * 128 + lane], g1 = GATE[(size_t)t * 128 + 64 + lane];
        const float su0 = SU[e0_], su1 = SU[e1_], sv0 = SV[e0_], sv1 = SV[e1_];
        u32x4 buf[16];
        float act0 = 0.f, act1 = 0.f;
        float acc[16];
#pragma unroll
        for (int i = 0; i < 16; ++i) acc[i] = 0.f;
#ifndef APPLY_L2PROBE
#define APPLY_L2PROBE 0
#endif
        for (int prep_ = 0; prep_ < 1 + APPLY_L2PROBE; ++prep_) {
        const int emask = (APPLY_L2PROBE && prep_ == 0) ? 2047 : 0x7fffffff;
        const int e0 = e0_ & emask, e1 = e1_ & emask;
#pragma unroll
        for (int j = 0; j < 16; ++j) { const int e_ = __builtin_amdgcn_readlane(e0, j); buf[j] = *(const u32x4*)(PU + (size_t)e_ * D + lane * 16); }
#pragma unroll
        for (int bt = 0; bt < 16; ++bt) {
#pragma unroll
            for (int j = 0; j < 16; ++j) {
                if (bt < 8) {
                    float s_ = dot8(buf[j].x, buf[j].y, hf, 0.f); s_ = dot8(buf[j].z, buf[j].w, hf + 8, s_);
                    ldsw[((bt & 3) * 16 + j) * 65 + lane] = s_;
                } else {
                    const float av_ = ((bt & 7) < 4) ? act0 : act1;
                    const float a_ = __builtin_bit_cast(float, __builtin_amdgcn_readlane(__builtin_bit_cast(int, av_), (bt & 3) * 16 + j));
                    fma8(buf[j].x, buf[j].y, a_, acc); fma8(buf[j].z, buf[j].w, a_, acc + 8);
                }
                if (bt + 1 < 16) {
                    const int nb = bt + 1;
                    const int e_ = __builtin_amdgcn_readlane(((nb & 7) < 4) ? e0 : e1, (nb & 3) * 16 + j);
                    buf[j] = *(const u32x4*)(((nb < 8) ? PU : PV) + (size_t)e_ * D + lane * 16);
                }
            }
            if (bt == 3 || bt == 7) {
                float tot_ = 0.f;
#pragma unroll 16
                for (int q = 0; q < 64; ++q) tot_ += ldsw[lane * 65 + q];
                if (bt == 3) act0 = gelu_tanh(tot_ * su0) * g0 * sv0; else act1 = gelu_tanh(tot_ * su1) * g1 * sv1;
            }
        }
        if (APPLY_L2PROBE && prep_ == 0 && p.ph_hi >= 0) {
#pragma unroll
            for (int i = 0; i < 16; ++i) acc[i] = 0.f;
        }
        }
        const int b = t / SEQ;
        const float* g2 = MOD + (size_t)(layer * 2 + b) * 6144 + 5120;
        float* xr = X + (size_t)t * D + lane * 16;
        f32x4 xs[4]; float ss = 0.f;
#pragma unroll
        for (int q = 0; q < 4; ++q) {
            const f32x4 g = *(const f32x4*)(g2 + lane * 16 + q * 4); f32x4 x = *(const f32x4*)(xr + q * 4);
            x.x += g.x * acc[q * 4 + 0]; x.y += g.y * acc[q * 4 + 1]; x.z += g.z * acc[q * 4 + 2]; x.w += g.w * acc[q * 4 + 3];
            xs[q] = x; ss += (x.x * x.x + x.y * x.y) + (x.z * x.z + x.w * x.w);
        }
        const float rs = rsqrtf(wave_sum(ss) * (1.0f / D) + RMS_EPS);
        if (!dry) {
            if (layer == 0) {
                const float* gw = p.in[2] + D + lane * 16; const float* sh = MOD + (size_t)(2 + b) * 6144 + lane * 16; const float* sc = sh + 1024;
                u32x4 o[2];
#pragma unroll
                for (int q = 0; q < 4; ++q) {
                    *(f32x4*)(xr + q * 4) = xs[q];
                    const f32x4 g = *(const f32x4*)(gw + q * 4), s1 = *(const f32x4*)(sc + q * 4), s0 = *(const f32x4*)(sh + q * 4);
                    const float y0 = xs[q].x * rs * g.x * (1.f + s1.x) + s0.x, y1 = xs[q].y * rs * g.y * (1.f + s1.y) + s0.y;
                    const float y2 = xs[q].z * rs * g.z * (1.f + s1.z) + s0.z, y3 = xs[q].w * rs * g.w * (1.f + s1.w) + s0.w;
                    if (q & 1) { o[q >> 1].z = pk2(y0, y1); o[q >> 1].w = pk2(y2, y3); } else { o[q >> 1].x = pk2(y0, y1); o[q >> 1].y = pk2(y2, y3); }
                }
                bf16_t* hm = (bf16_t*)(p.ws + WS_HM) + (size_t)t * D + lane * 16;
                *(u32x4*)hm = o[0]; *(u32x4*)(hm + 8) = o[1];
            } else {
                const float* gw = p.in[28] + lane * 16;
#pragma unroll
                for (int q = 0; q < 4; ++q) {
                    const f32x4 g = *(const f32x4*)(gw + q * 4);
                    *(f32x4*)(xr + q * 4) = (f32x4){xs[q].x * rs * g.x, xs[q].y * rs * g.y, xs[q].z * rs * g.z, xs[q].w * rs * g.w};
                }
            }
        }
    }
}

__device__ __forceinline__ void phase_peer_apply6(const Params& p, int layer, unsigned char* lds, bool dry) {
    const int lane = threadIdx.x & 63, wave = threadIdx.x >> 6, half = lane >> 5, gl = lane & 31;
    float* ldsw = (float*)lds + wave * (64 * 33);
    const bf16_t* HM = (const bf16_t*)(p.ws + WS_HM);
    const unsigned char* PU = p.ws + WS_PU; const unsigned char* PV = p.ws + WS_PV;
    const float* SU = (const float*)(p.ws + WS_PU + 24 * MiB); const float* SV = (const float*)(p.ws + WS_PV + 24 * MiB);
    const int* EXP = (const int*)(p.ws + WS_EXP); const float* GATE = (const float*)(p.ws + WS_GATE);
    const float* MOD = (const float*)(p.ws + WS_MOD);
    float* X = p.out;
    for (int t = blockIdx.x * 4 + wave; t < T; t += gridDim.x * 4) {
        float hf[32];
        {
            const u32x4* hp = (const u32x4*)(HM + (size_t)t * D + gl * 32);
#pragma unroll
            for (int q = 0; q < 4; ++q) { const u32x4 w = hp[q];
                hf[q * 8 + 0] = bflo(w.x); hf[q * 8 + 1] = bfhi(w.x); hf[q * 8 + 2] = bflo(w.y); hf[q * 8 + 3] = bfhi(w.y);
                hf[q * 8 + 4] = bflo(w.z); hf[q * 8 + 5] = bfhi(w.z); hf[q * 8 + 6] = bflo(w.w); hf[q * 8 + 7] = bfhi(w.w); }
        }
        const int e0 = EXP[(size_t)t * 128 + lane], e1 = EXP[(size_t)t * 128 + 64 + lane];
        const float g0 = GATE[(size_t)t * 128 + lane], g1 = GATE[(size_t)t * 128 + 64 + lane];
        const float su0 = SU[e0], su1 = SU[e1], sv0 = SV[e0], sv1 = SV[e1];
        u32x2 buf[8][3];
        float act0 = 0.f, act1 = 0.f;
        float acc[32];
#pragma unroll
        for (int i = 0; i < 32; ++i) acc[i] = 0.f;
#define A6_LOAD(slot, nb) do { const int es_ = (((nb) & 7) < 4) ? e0 : e1; const int ia_ = ((nb) & 3) * 16 + 2 * (slot); \
            const int ea_ = __builtin_amdgcn_readlane(es_, ia_), eb_ = __builtin_amdgcn_readlane(es_, ia_ + 1); const int e_ = half ? eb_ : ea_; \
            const u32x2* rp_ = (const u32x2*)((((nb) < 8) ? PU : PV) + (size_t)e_ * 768 + gl * 24); buf[slot][0] = rp_[0]; buf[slot][1] = rp_[1]; buf[slot][2] = rp_[2]; } while (0)
#pragma unroll
        for (int j = 0; j < 8; ++j) A6_LOAD(j, 0);
#pragma unroll 1
        for (int bt = 0; bt < 8; ++bt) {
#pragma unroll
            for (int j = 0; j < 8; ++j) {
                v6u w; w[0] = buf[j][0].x; w[1] = buf[j][0].y; w[2] = buf[j][1].x; w[3] = buf[j][1].y; w[4] = buf[j][2].x; w[5] = buf[j][2].y;
                const v32f y = __builtin_amdgcn_cvt_scalef32_pk32_f32_fp6(w, 1.0f);
                float s0_ = 0.f, s1_ = 0.f;
#pragma unroll
                for (int i = 0; i < 16; ++i) { s0_ += y[i] * hf[i]; s1_ += y[16 + i] * hf[16 + i]; }
                ldsw[(((bt & 3) * 16 + 2 * j) + half) * 33 + gl] = s0_ + s1_;
                A6_LOAD(j, bt + 1);
            }
            if (bt == 3 || bt == 7) {
                float tot_ = 0.f;
#pragma unroll
                for (int q = 0; q < 32; ++q) tot_ += ldsw[lane * 33 + q];
                if (bt == 3) act0 = gelu_tanh(tot_ * su0) * g0 * sv0; else act1 = gelu_tanh(tot_ * su1) * g1 * sv1;
            }
        }
#pragma unroll 1
        for (int bt = 8; bt < 16; ++bt) {
            const float av_ = (bt < 12) ? act0 : act1;
#pragma unroll
            for (int j = 0; j < 8; ++j) {
                v6u w; w[0] = buf[j][0].x; w[1] = buf[j][0].y; w[2] = buf[j][1].x; w[3] = buf[j][1].y; w[4] = buf[j][2].x; w[5] = buf[j][2].y;
                const v32f y = __builtin_amdgcn_cvt_scalef32_pk32_f32_fp6(w, 1.0f);
                const int ia_ = (bt & 3) * 16 + 2 * j;
                const float aa_ = __builtin_bit_cast(float, __builtin_amdgcn_readlane(__builtin_bit_cast(int, av_), ia_));
                const float ab_ = __builtin_bit_cast(float, __builtin_amdgcn_readlane(__builtin_bit_cast(int, av_), ia_ + 1));
                const float a_ = half ? ab_ : aa_;
#pragma unroll
                for (int i = 0; i < 32; ++i) acc[i] += a_ * y[i];
                if (bt + 1 < 16) A6_LOAD(j, bt + 1);
            }
        }
#undef A6_LOAD
#pragma unroll
        for (int i = 0; i < 32; ++i) acc[i] += __shfl_xor(acc[i], 32);
        const int b = t / SEQ;
        const float* g2 = MOD + (size_t)(layer * 2 + b) * 6144 + 5120 + gl * 32;
        float* xr = X + (size_t)t * D + gl * 32;
        f32x4 xs[8]; float ss = 0.f;
#pragma unroll
        for (int q = 0; q < 8; ++q) {
            const f32x4 g = *(const f32x4*)(g2 + q * 4); f32x4 x = *(const f32x4*)(xr + q * 4);
            x.x += g.x * acc[q * 4 + 0]; x.y += g.y * acc[q * 4 + 1]; x.z += g.z * acc[q * 4 + 2]; x.w += g.w * acc[q * 4 + 3];
            xs[q] = x; if (half == 0) ss += (x.x * x.x + x.y * x.y) + (x.z * x.z + x.w * x.w);
        }
        const float rs = rsqrtf(wave_sum(ss) * (1.0f / D) + RMS_EPS);
        if (!dry && half == 0) {
            if (layer == 0) {
                const float* gw = p.in[2] + D + gl * 32; const float* sh = MOD + (size_t)(2 + b) * 6144 + gl * 32; const float* sc = sh + 1024;
                bf16_t* hm = (bf16_t*)(p.ws + WS_HM) + (size_t)t * D + gl * 32;
#pragma unroll
                for (int q2 = 0; q2 < 4; ++q2) {
                    u32x4 o;
#pragma unroll
                    for (int hq = 0; hq < 2; ++hq) {
                        const int q = q2 * 2 + hq;
                        *(f32x4*)(xr + q * 4) = xs[q];
                        const f32x4 g = *(const f32x4*)(gw + q * 4), s1 = *(const f32x4*)(sc + q * 4), s0 = *(const f32x4*)(sh + q * 4);
                        const float y0 = xs[q].x * rs * g.x * (1.f + s1.x) + s0.x, y1 = xs[q].y * rs * g.y * (1.f + s1.y) + s0.y;
                        const float y2 = xs[q].z * rs * g.z * (1.f + s1.z) + s0.z, y3 = xs[q].w * rs * g.w * (1.f + s1.w) + s0.w;
                        if (hq) { o.z = pk2(y0, y1); o.w = pk2(y2, y3); } else { o.x = pk2(y0, y1); o.y = pk2(y2, y3); }
                    }
                    *(u32x4*)(hm + q2 * 8) = o;
                }
            } else {
                const float* gw = p.in[28] + gl * 32;
#pragma unroll
                for (int q = 0; q < 8; ++q) {
                    const f32x4 g = *(const f32x4*)(gw + q * 4);
                    *(f32x4*)(xr + q * 4) = (f32x4){xs[q].x * rs * g.x, xs[q].y * rs * g.y, xs[q].z * rs * g.z, xs[q].w * rs * g.w};
                }
            }
        }
    }
}
__device__ __forceinline__ void phase_tab1(const Params& p) {
    const int first = vblock() - 256, stride = (int)gridDim.x - 256;
    if (first < 0 || stride <= 0) {
        if (stride <= 0) { for (int it = blockIdx.x; it < 2 * P0_TAB; it += gridDim.x) {
            if (it < P0_TAB) cvt_fp6_item(p.in[26] + (size_t)PE * D, p.ws + WS_PU, (float*)(p.ws + WS_PU + 24 * MiB), it);
            else cvt_fp6_item(p.in[27] + (size_t)PE * D, p.ws + WS_PV, (float*)(p.ws + WS_PV + 24 * MiB), it - P0_TAB); } }
        return;
    }
    for (int it = first; it < 2 * P0_TAB; it += stride) {
        if (it < P0_TAB) cvt_fp6_item(p.in[26] + (size_t)PE * D, p.ws + WS_PU, (float*)(p.ws + WS_PU + 24 * MiB), it);
        else cvt_fp6_item(p.in[27] + (size_t)PE * D, p.ws + WS_PV, (float*)(p.ws + WS_PV + 24 * MiB), it - P0_TAB);
    }
}
__device__ __forceinline__ void phase_nsa_proj(const Params& p, unsigned char* lds) {
    const bf16_t* HM = (const bf16_t*)(p.ws + WS_HM); const bf16_t* WT = (const bf16_t*)(p.ws + WS_WPROJ_T);
    const f32x2* ROPE = (const f32x2*)(p.ws + WS_ROPE);
    bf16_t* Q = (bf16_t*)(p.ws + WS_Q); float* NGT = (float*)(p.ws + WS_NG);
    const int lane = threadIdx.x & 63, wid = threadIdx.x >> 6, wr = wid >> 1, wc = wid & 1, fr = lane & 15, fq = lane >> 4;
    for (int id = vblock(); id < 256 * 21; id += gridDim.x) {
        const int mt = id / 21, nt = id % 21;
        f32x4 acc[4][4];
        gemm_tile3(ALoadPlain{HM + (size_t)mt * 128 * D, (size_t)D}, WT + (size_t)nt * 128 * D, D, 16, acc, lds);
        const int c0 = nt * 128 + wc * 64;
        if (c0 >= 2624) continue;
        const int b = (mt * 128) / SEQ;
        if (c0 == 2560) {
#pragma unroll
            for (int mi = 0; mi < 4; ++mi)
#pragma unroll
                for (int ni = 0; ni < 3; ++ni) {
                    const int t = mt * 128 + wr * 64 + mi * 16 + fr;
                    const f32x4 v = acc[mi][ni];
                    *(f32x4*)(NGT + (size_t)t * 48 + ni * 16 + fq * 4) = (f32x4){sigmoidf_(v.x), sigmoidf_(v.y), sigmoidf_(v.z), sigmoidf_(v.w)};
                }
            continue;
        }
        int sec = -1, g = 0;
        if (c0 >= 1024) { sec = (c0 - 1024) >> 8; g = ((c0 - 1024) & 255) >> 6; }
        const bool dorope = (sec == -1) || (sec == 2) || (sec == 4);
        const float scl = (sec == -1) ? 0.125f : 1.0f;
        const size_t secoff[6] = {WS_KC, WS_VC, WS_KS, WS_VST, WS_KW, WS_VWT};
        size_t so = WS_Q;
#pragma unroll
        for (int q = 0; q < 6; ++q) if (sec == q) so = secoff[q];
        bf16_t* OUT = (bf16_t*)(p.ws + so);
        const bool vt = (sec == 3) || (sec == 5);
        float kblk_am = 0.f;
#pragma unroll
        for (int pass = 0; pass < 2; ++pass) {
        if (pass == 1 && sec == 2) {
#pragma unroll
            for (int o = 1; o < 64; o <<= 1) kblk_am = fmaxf(kblk_am, __shfl_xor(kblk_am, o));
            if (lane == 0) ((float*)(p.ws + WS_KS + 12 * MiB))[(size_t)(b * 4 + g) * 256 + ((mt * 128 + wr * 64 - b * SEQ) >> 6)] = kblk_am > 0.f ? kblk_am / 224.0f : 1.0f;
        }
#pragma unroll
        for (int mi = 0; mi < 4; ++mi) {
            const int t = mt * 128 + wr * 64 + mi * 16 + fr, s = t - b * SEQ;
            if (dorope && pass == 0) {
#pragma unroll
                for (int ni = 0; ni < 2; ++ni) {
                    const f32x4* rp = (const f32x4*)(ROPE + (size_t)s * 32 + ni * 16 + fq * 4);
                    const f32x4 r0 = rp[0], r1 = rp[1];
                    const f32x4 x1 = acc[mi][ni], x2 = acc[mi][ni + 2];
                    acc[mi][ni] = (f32x4){x1.x * r0.x - x2.x * r0.y, x1.y * r0.z - x2.y * r0.w, x1.z * r1.x - x2.z * r1.y, x1.w * r1.z - x2.w * r1.w};
                    acc[mi][ni + 2] = (f32x4){x1.x * r0.y + x2.x * r0.x, x1.y * r0.w + x2.y * r0.z, x1.z * r1.y + x2.z * r1.x, x1.w * r1.w + x2.w * r1.z};
                }
            }
            if (pass == 0) {
                if (sec == 2) {
#pragma unroll
                    for (int ni = 0; ni < 4; ++ni) { const f32x4 v = acc[mi][ni]; kblk_am = fmaxf(kblk_am, fmaxf(fmaxf(fabsf(v.x), fabsf(v.y)), fmaxf(fabsf(v.z), fabsf(v.w)))); }
                }
                continue;
            }
            if (sec == -1 || sec == 2) {
                float am = kblk_am;
                if (sec == -1) {
                    am = 0.f;
#pragma unroll
                    for (int ni = 0; ni < 4; ++ni) { const f32x4 v = acc[mi][ni] * scl; am = fmaxf(am, fmaxf(fmaxf(fabsf(v.x), fabsf(v.y)), fmaxf(fabsf(v.z), fabsf(v.w)))); }
                    am = fmaxf(am, __shfl_xor(am, 16)); am = fmaxf(am, __shfl_xor(am, 32));
                }
                const float qs = am > 0.f ? 224.0f / am : 1.0f;
                unsigned char* O8 = (sec == -1) ? (p.ws + WS_Q8 + (size_t)t * 1024 + c0) : (p.ws + WS_KS + ((size_t)(b * 4 + g) * SEQ + s) * 64);
#pragma unroll
                for (int ni = 0; ni < 4; ++ni) {
                    const f32x4 v = acc[mi][ni] * (scl * qs);
                    int w = 0; w = __builtin_amdgcn_cvt_pk_fp8_f32(v.x, v.y, w, false); w = __builtin_amdgcn_cvt_pk_fp8_f32(v.z, v.w, w, true);
                    *(int*)(O8 + ni * 16 + fq * 4) = w;
                }
                if (fq == 0 && sec == -1) ((float*)(p.ws + WS_Q8 + 32 * MiB))[(size_t)t * 16 + (c0 >> 6)] = am > 0.f ? am / 224.0f : 1.0f;
            }
            if (sec == 2) continue;
#pragma unroll
            for (int ni = 0; ni < 4; ++ni) {
                const f32x4 v = acc[mi][ni] * scl;
                const int d = ni * 16 + fq * 4;
                if (sec == -1) {
                    *(u32x2*)(OUT + (size_t)t * 1024 + c0 + d) = (u32x2){pk2(v.x, v.y), pk2(v.z, v.w)};
                } else if (sec == 4) {
                    const size_t idx = (size_t)(b * 4 + g) * SEQ * 64 + (size_t)(s >> 5) * 2048 + ((((s >> 4) & 1) * 2 + (ni >> 1)) * 16 + (s & 15)) * 32 + ((ni & 1) * 2 + (fq >> 1)) * 8 + (fq & 1) * 4;
                    *(u32x2*)(OUT + idx) = (u32x2){pk2(v.x, v.y), pk2(v.z, v.w)};
                } else if (!vt) {
                    *(u32x2*)(OUT + ((size_t)(b * 4 + g) * SEQ + s) * 64 + d) = (u32x2){pk2(v.x, v.y), pk2(v.z, v.w)};
                } else if (sec == 5) {
                    const int key = s & 31;
                    bf16_t* o = OUT + (size_t)(b * 4 + g) * SEQ * 64 + (size_t)(s >> 5) * 2048 + ((ni * 2 + (key >> 4)) * 16 + fq * 4) * 16 + ((key >> 2) & 3) * 4 + (key & 3);
                    o[0] = (bf16_t)f2bf(v.x); o[16] = (bf16_t)f2bf(v.y); o[32] = (bf16_t)f2bf(v.z); o[48] = (bf16_t)f2bf(v.w);
                }
            }
        }
        }
        if (sec == 3) {
            const int s0 = mt * 128 + wr * 64 - b * SEQ, jb = s0 >> 6;
            unsigned char* V8 = p.ws + WS_VST + (size_t)((b * 4 + g) * 256 + jb) * 4096;
            float am = 0.f;
#pragma unroll
            for (int mi = 0; mi < 4; ++mi)
#pragma unroll
                for (int ni = 0; ni < 4; ++ni) { const f32x4 v = acc[mi][ni]; am = fmaxf(am, fmaxf(fmaxf(fabsf(v.x), fabsf(v.y)), fmaxf(fabsf(v.z), fabsf(v.w)))); }
#pragma unroll
            for (int o = 1; o < 64; o <<= 1) am = fmaxf(am, __shfl_xor(am, o));
            const float qs = am > 0.f ? 224.0f / am : 1.0f;
            if (lane == 0) ((float*)(p.ws + WS_VST + 12 * MiB))[(size_t)(b * 4 + g) * 256 + jb] = am > 0.f ? am / 224.0f : 1.0f;
#pragma unroll
            for (int ni = 0; ni < 4; ++ni) {
                const int d = ni * 16 + fq * 4;
#pragma unroll
                for (int mi = 0; mi < 4; ++mi) {
                    const f32x4 v = acc[mi][ni] * qs;
                    int w = 0; w = __builtin_amdgcn_cvt_pk_fp8_f32(v.x, v.y, w, false); w = __builtin_amdgcn_cvt_pk_fp8_f32(v.z, v.w, w, true);
                    unsigned char* o = V8 + (size_t)d * 64 + mi * 16 + fr;
                    o[0] = (unsigned char)(w & 255); o[64] = (unsigned char)((w >> 8) & 255); o[128] = (unsigned char)((w >> 16) & 255); o[192] = (unsigned char)((unsigned)w >> 24);
                }
            }
        }
    }
}
__device__ __forceinline__ void phase_nsa_cmp1(const Params& p, unsigned char* lds) {
    bf16_t* HID = (bf16_t*)(p.ws + WS_HID);
    const float* bias = (const float*)(p.ws + WS_MISC);
    const int lane = threadIdx.x & 63, wid = threadIdx.x >> 6, wr = wid >> 1, wc = wid & 1, fr = lane & 15, fq = lane >> 4;
    for (int id = vblock(); id < 256; id += gridDim.x) {
        const int kv = id >> 7, bg = (id >> 4) & 7, mt = (id >> 1) & 7, nt = id & 1;
        const bf16_t* A = (const bf16_t*)(p.ws + (kv ? WS_VC : WS_KC)) + (size_t)bg * SEQ * 64 + (size_t)mt * 128 * 1024;
        const bf16_t* B = (const bf16_t*)(p.ws + (kv ? WS_WV1_T : WS_WK1_T)) + (size_t)nt * 128 * 2048;
        f32x4 acc[4][4];
        gemm_tile3(ALoadPlain{A, (size_t)1024}, B, 2048, 32, acc, lds);
#pragma unroll
        for (int mi = 0; mi < 4; ++mi)
#pragma unroll
            for (int ni = 0; ni < 4; ++ni) {
                const int n = mt * 128 + wr * 64 + mi * 16 + fr, c = nt * 128 + wc * 64 + ni * 16 + fq * 4;
                const f32x4 bv = *(const f32x4*)(bias + kv * 256 + c);
                const f32x4 v = acc[mi][ni] + bv;
                *(u32x2*)(HID + (((size_t)kv * 8 + bg) * 1024 + n) * 256 + c) = (u32x2){pk2(gelu_tanh(v.x), gelu_tanh(v.y)), pk2(gelu_tanh(v.z), gelu_tanh(v.w))};
            }
    }
}
__device__ __forceinline__ void phase_nsa_cmp2(const Params& p, unsigned char* lds) {
    const bf16_t* HID = (const bf16_t*)(p.ws + WS_HID);
    const f32x2* ROPE = (const f32x2*)(p.ws + WS_ROPE);
    bf16_t* KCMP = (bf16_t*)(p.ws + WS_KCMP); bf16_t* VCMPT = (bf16_t*)(p.ws + WS_VCMPT);
    const int lane = threadIdx.x & 63, wid = threadIdx.x >> 6, wr = wid >> 1, wc = wid & 1, fr = lane & 15, fq = lane >> 4;
    for (int id = vblock(); id < 128; id += gridDim.x) {
        const int kv = id >> 6, mt = id & 63;
        const bf16_t* A = HID + ((size_t)kv * 8192 + (size_t)mt * 128) * 256;
        const bf16_t* B = (const bf16_t*)(p.ws + (kv ? WS_WV2_T : WS_WK2_T));
        f32x4 acc[4][4];
        gemm_tile3(ALoadPlain{A, (size_t)256}, B, 256, 4, acc, lds);
        if (wc == 1) continue;
#pragma unroll
        for (int mi = 0; mi < 4; ++mi) {
            const int R = mt * 128 + wr * 64 + mi * 16 + fr, bg = R >> 10, n = R & 1023;
            if (kv == 0) {
                int pos = n * 16 + 31; pos = pos > SEQ - 1 ? SEQ - 1 : pos;
#pragma unroll
                for (int ni = 0; ni < 2; ++ni) {
                    const f32x4* rp = (const f32x4*)(ROPE + (size_t)pos * 32 + ni * 16 + fq * 4);
                    const f32x4 r0 = rp[0], r1 = rp[1];
                    const f32x4 x1 = acc[mi][ni], x2 = acc[mi][ni + 2];
                    acc[mi][ni] = (f32x4){x1.x * r0.x - x2.x * r0.y, x1.y * r0.z - x2.y * r0.w, x1.z * r1.x - x2.z * r1.y, x1.w * r1.z - x2.w * r1.w};
                    acc[mi][ni + 2] = (f32x4){x1.x * r0.y + x2.x * r0.x, x1.y * r0.w + x2.y * r0.z, x1.z * r1.y + x2.z * r1.x, x1.w * r1.w + x2.w * r1.z};
                }
#pragma unroll
                for (int ni = 0; ni < 4; ++ni) {
                    const f32x4 v = acc[mi][ni];
                    const size_t idx = (size_t)bg * 1024 * 64 + (size_t)(n >> 5) * 2048 + ((((n >> 4) & 1) * 2 + (ni >> 1)) * 16 + (n & 15)) * 32 + ((ni & 1) * 2 + (fq >> 1)) * 8 + (fq & 1) * 4;
                    *(u32x2*)(KCMP + idx) = (u32x2){pk2(v.x, v.y), pk2(v.z, v.w)};
                }
            } else {
#pragma unroll
                for (int ni = 0; ni < 4; ++ni) {
                    const f32x4 v = acc[mi][ni];
                    const int key = n & 31;
                    bf16_t* o = VCMPT + (size_t)bg * 1024 * 64 + (size_t)(n >> 5) * 2048 + ((ni * 2 + (key >> 4)) * 16 + fq * 4) * 16 + ((key >> 2) & 3) * 4 + (key & 3);
                    o[0] = (bf16_t)f2bf(v.x); o[16] = (bf16_t)f2bf(v.y); o[32] = (bf16_t)f2bf(v.z); o[48] = (bf16_t)f2bf(v.w);
                }
            }
        }
    }
}
__device__ __forceinline__ void phase_nsa_wo(const Params& p, unsigned char* lds, bool dry) {
    const bf16_t* O = (const bf16_t*)(p.ws + WS_O); const bf16_t* WT = (const bf16_t*)(p.ws + WS_WO_T);
    const float* MOD = (const float*)(p.ws + WS_MOD);
    float* X = p.out;
    const int lane = threadIdx.x & 63, wid = threadIdx.x >> 6, wr = wid >> 1, wc = wid & 1, fr = lane & 15, fq = lane >> 4;
    for (int id = vblock(); id < 256 * 8; id += gridDim.x) {
        const int mt = id >> 3, nt = id & 7;
        f32x4 acc[4][4];
        gemm_tile3(ALoadPlain{O + (size_t)mt * 128 * D, (size_t)D}, WT + (size_t)nt * 128 * D, D, 16, acc, lds);
        const int b = (mt * 128) / SEQ;
#pragma unroll
        for (int mi = 0; mi < 4; ++mi)
#pragma unroll
            for (int ni = 0; ni < 4; ++ni) {
                const int t = mt * 128 + wr * 64 + mi * 16 + fr, c = nt * 128 + wc * 64 + ni * 16 + fq * 4;
                const f32x4 g1 = *(const f32x4*)(MOD + (size_t)(1 * 2 + b) * 6144 + 2048 + c);
                float* xp = X + (size_t)t * D + c;
                const f32x4 x = *(const f32x4*)xp; const f32x4 v = acc[mi][ni];
                if (!dry) *(f32x4*)xp = (f32x4){x.x + g1.x * v.x, x.y + g1.y * v.y, x.z + g1.z * v.z, x.w + g1.w * v.w};
            }
    }
}
__device__ __forceinline__ bf16x8 pack8(const f32x4 a, const f32x4 b) {
    u32x4 w; w.x = pk2(a.x, a.y); w.y = pk2(a.z, a.w); w.z = pk2(b.x, b.y); w.w = pk2(b.z, b.w);
    return __builtin_bit_cast(bf16x8, w);
}
__device__ __forceinline__ bf16x8 ldv8(const bf16_t* plo, const bf16_t* phi) {
    const u32x2 lo = *(const u32x2*)plo, hi = *(const u32x2*)phi;
    u32x4 w; w.x = lo.x; w.y = lo.y; w.z = hi.x; w.w = hi.y;
    return __builtin_bit_cast(bf16x8, w);
}
__device__ __forceinline__ float red4(float v) { v += __shfl_xor(v, 16); v += __shfl_xor(v, 32); return v; }
__device__ __forceinline__ float max4(float v) { v = fmaxf(v, __shfl_xor(v, 16)); v = fmaxf(v, __shfl_xor(v, 32)); return v; }
#define NEGBIG (-1.0e30f)

__device__ __forceinline__ void phase_nsa_attn(const Params& p, unsigned char* lds, const int rep_cmp, const int rep_win, const int rep_sel) {
    const int lane = threadIdx.x & 63, wave = threadIdx.x >> 6, fr = lane & 15, fq = lane >> 4;
    unsigned char* WL = lds + wave * 18432;
    float* IMP = (float*)WL;
    int* SEL = (int*)(WL + 17408);
    const bf16_t* Q = (const bf16_t*)(p.ws + WS_Q);
    const bf16_t* KCMP = (const bf16_t*)(p.ws + WS_KCMP); const bf16_t* VCMPT = (const bf16_t*)(p.ws + WS_VCMPT);
    const bf16_t* KW = (const bf16_t*)(p.ws + WS_KW); const bf16_t* VWT = (const bf16_t*)(p.ws + WS_VWT);
    const float* NGT = (const float*)(p.ws + WS_NG);
    bf16_t* O = (bf16_t*)(p.ws + WS_O);
    const f32x4 z4 = (f32x4){0.f, 0.f, 0.f, 0.f};
    for (int bi = blockIdx.x; bi < 2048; bi += gridDim.x) {
        const int bg = bi & 7, quad = 255 - (bi >> 3), t0 = (quad * 4 + wave) * 16, b = bg >> 2, g = bg & 3;
        const int cur = t0 >> 6;
        const size_t tok = (size_t)b * SEQ + t0 + fr;
        const int tq = t0 + fr;
        bf16x8 qf[4][2];
#pragma unroll
        for (int r = 0; r < 4; ++r)
#pragma unroll
            for (int ks = 0; ks < 2; ++ks) qf[r][ks] = *(const bf16x8*)(Q + tok * 1024 + (g * 4 + r) * 64 + ks * 32 + fq * 8);
        f32x4 acc[4][4];
        for (int rep = 0; rep < rep_win; ++rep) {
            const bf16_t* kwb = KW + (size_t)bg * SEQ * 64; const bf16_t* vwb = VWT + (size_t)bg * SEQ * 64;
            float mw[4], lw[4];
#pragma unroll
            for (int r = 0; r < 4; ++r) { mw[r] = NEGBIG; lw[r] = 0.f;
#pragma unroll
                for (int df = 0; df < 4; ++df) acc[r][df] = z4; }
            int kmin = t0 - 511; kmin = kmin < 0 ? 0 : kmin; kmin &= ~31;
            bf16x8 nkf[2][2];
#define WIN_LOAD(kb_) do { _Pragma("unroll") for (int f = 0; f < 2; ++f) _Pragma("unroll") for (int ks = 0; ks < 2; ++ks) nkf[f][ks] = *(const bf16x8*)(kwb + (size_t)((kb_) >> 5) * 2048 + ((f * 2 + ks) * 16 + fr) * 32 + fq * 8); } while (0)
            WIN_LOAD(kmin);
            for (int kb = kmin; kb <= t0 + 15; kb += 32) {
                bf16x8 kf[2][2], vf[4];
#pragma unroll
                for (int f = 0; f < 2; ++f) { kf[f][0] = nkf[f][0]; kf[f][1] = nkf[f][1]; }
#pragma unroll
                for (int df = 0; df < 4; ++df) { const bf16_t* vp = vwb + (size_t)(kb >> 5) * 2048 + (df * 32 + fr) * 16 + fq * 4; vf[df] = ldv8(vp, vp + 256); }
                { const int kn = (kb + 32 <= t0 + 15) ? kb + 32 : kb; WIN_LOAD(kn); }
#pragma unroll
                for (int r = 0; r < 4; ++r) {
                    f32x4 st[2];
#pragma unroll
                    for (int f = 0; f < 2; ++f) {
                        st[f] = __builtin_amdgcn_mfma_f32_16x16x32_bf16(kf[f][0], qf[r][0], z4, 0, 0, 0);
                        st[f] = __builtin_amdgcn_mfma_f32_16x16x32_bf16(kf[f][1], qf[r][1], st[f], 0, 0, 0);
                    }
                    float mx = NEGBIG;
#pragma unroll
                    for (int f = 0; f < 2; ++f)
#pragma unroll
                        for (int e = 0; e < 4; ++e) { const int key = kb + f * 16 + fq * 4 + e; const bool ok = (key <= tq) && (key > tq - 512); if (ok) mx = fmaxf(mx, st[f][e]); }
                    float mn = mw[r], al = 1.0f;
                    if (__builtin_amdgcn_ballot_w64(mx > mw[r] + 8.0f) != 0ull) { mn = fmaxf(mw[r], max4(mx)); al = __expf(mw[r] - mn); }
                    float ps = 0.f;
#pragma unroll
                    for (int f = 0; f < 2; ++f)
#pragma unroll
                        for (int e = 0; e < 4; ++e) { const int key = kb + f * 16 + fq * 4 + e; const bool ok = (key <= tq) && (key > tq - 512); const float pv = ok ? __expf(st[f][e] - mn) : 0.f; st[f][e] = pv; ps += pv; }
                    lw[r] = lw[r] * al + ps; mw[r] = mn;
                    const bf16x8 pf = pack8(st[0], st[1]);
#pragma unroll
                    for (int df = 0; df < 4; ++df) { acc[r][df] = acc[r][df] * al; acc[r][df] = __builtin_amdgcn_mfma_f32_16x16x32_bf16(vf[df], pf, acc[r][df], 0, 0, 0); }
                    __builtin_amdgcn_sched_barrier(0);
                }
            }
#pragma unroll
            for (int r = 0; r < 4; ++r) {
                const float l = red4(lw[r]); const float sc = NGT[tok * 48 + (g * 4 + r) * 3 + 2] / l;
#pragma unroll
                for (int df = 0; df < 4; ++df) acc[r][df] = acc[r][df] * sc;
            }
#undef WIN_LOAD
        }
        const int nmax_tile = (t0 >> 4) - 1, nmax_lane = (t0 >> 4) - 2 + (fr == 15 ? 1 : 0);
        const bf16_t* kcb = KCMP + (size_t)bg * 1024 * 64; const bf16_t* vcb = VCMPT + (size_t)bg * 64 * 1024;
        for (int rep = 0; rep < rep_cmp; ++rep) {
            const bool dry = (rep + 1 < rep_cmp);
            float mc[4], lc[4], invl[4];
#pragma unroll
            for (int r = 0; r < 4; ++r) { mc[r] = NEGBIG; lc[r] = 0.f; }
            bf16x8 nkc[2][2], nvc[4];
#define CMPK_LOAD(nb_) do { _Pragma("unroll") for (int f = 0; f < 2; ++f) _Pragma("unroll") for (int ks = 0; ks < 2; ++ks) nkc[f][ks] = *(const bf16x8*)(kcb + (size_t)((nb_) >> 5) * 2048 + ((f * 2 + ks) * 16 + fr) * 32 + fq * 8); } while (0)
#define CMPV_LOAD(nb_) do { _Pragma("unroll") for (int df = 0; df < 4; ++df) { const bf16_t* vp = vcb + (size_t)((nb_) >> 5) * 2048 + (df * 32 + fr) * 16 + fq * 4; nvc[df] = ldv8(vp, vp + 256); } } while (0)
            CMPK_LOAD(0);
            for (int nb = 0; nb <= nmax_tile; nb += 32) {
                bf16x8 kf[2][2];
#pragma unroll
                for (int f = 0; f < 2; ++f) { kf[f][0] = nkc[f][0]; kf[f][1] = nkc[f][1]; }
                { const int nn = (nb + 32 <= nmax_tile) ? nb + 32 : 0; CMPK_LOAD(nn); }
#pragma unroll
                for (int r = 0; r < 4; ++r) {
                    f32x4 st[2];
#pragma unroll
                    for (int f = 0; f < 2; ++f) {
                        st[f] = __builtin_amdgcn_mfma_f32_16x16x32_bf16(kf[f][0], qf[r][0], z4, 0, 0, 0);
                        st[f] = __builtin_amdgcn_mfma_f32_16x16x32_bf16(kf[f][1], qf[r][1], st[f], 0, 0, 0);
                    }
                    float mx = NEGBIG;
#pragma unroll
                    for (int f = 0; f < 2; ++f)
#pragma unroll
                        for (int e = 0; e < 4; ++e) { const int n = nb + f * 16 + fq * 4 + e; if (n <= nmax_lane) mx = fmaxf(mx, st[f][e]); }
                    float mn = mc[r];
                    if (__builtin_amdgcn_ballot_w64(mx > mc[r] + 8.0f) != 0ull) mn = fmaxf(mc[r], max4(mx));
                    float ps = 0.f;
#pragma unroll
                    for (int f = 0; f < 2; ++f)
#pragma unroll
                        for (int e = 0; e < 4; ++e) { const int n = nb + f * 16 + fq * 4 + e; if (n <= nmax_lane) ps += __expf(st[f][e] - mn); }
                    lc[r] = lc[r] * __expf(mc[r] - mn) + ps; mc[r] = mn;
                    __builtin_amdgcn_sched_barrier(0);
                }
            }
#pragma unroll
            for (int r = 0; r < 4; ++r) { const float l = red4(lc[r]); invl[r] = l > 0.f ? 1.0f / l : 0.f; }
            for (int i = lane; i < 16 * 260; i += 64) IMP[i] = 0.f;
            float carry = 0.f;
            float gc[4];
#pragma unroll
            for (int r = 0; r < 4; ++r) gc[r] = NGT[tok * 48 + (g * 4 + r) * 3];
            for (int nb = 0; nb <= nmax_tile; nb += 32) {
                bf16x8 kf[2][2], vf[4];
#pragma unroll
                for (int f = 0; f < 2; ++f) { kf[f][0] = nkc[f][0]; kf[f][1] = nkc[f][1]; }
                CMPV_LOAD(nb);
#pragma unroll
                for (int df = 0; df < 4; ++df) vf[df] = nvc[df];
                { const int nn = (nb + 32 <= nmax_tile) ? nb + 32 : nb; CMPK_LOAD(nn); }
                f32x4 pg[2] = {z4, z4};
#pragma unroll
                for (int r = 0; r < 4; ++r) {
                    f32x4 st[2];
#pragma unroll
                    for (int f = 0; f < 2; ++f) {
                        st[f] = __builtin_amdgcn_mfma_f32_16x16x32_bf16(kf[f][0], qf[r][0], z4, 0, 0, 0);
                        st[f] = __builtin_amdgcn_mfma_f32_16x16x32_bf16(kf[f][1], qf[r][1], st[f], 0, 0, 0);
#pragma unroll
                        for (int e = 0; e < 4; ++e) { const int n = nb + f * 16 + fq * 4 + e; st[f][e] = (n <= nmax_lane) ? __expf(st[f][e] - mc[r]) * invl[r] : 0.f; }
                        pg[f] += st[f];
                    }
                    const float gg = dry ? 0.f : gc[r];
                    const bf16x8 pf = pack8(st[0] * gg, st[1] * gg);
#pragma unroll
                    for (int df = 0; df < 4; ++df) acc[r][df] = __builtin_amdgcn_mfma_f32_16x16x32_bf16(vf[df], pf, acc[r][df], 0, 0, 0);
                    __builtin_amdgcn_sched_barrier(0);
                }
                const int src = (lane - 16) & 63;
                const float s0 = __shfl(pg[0].w, src), s1 = __shfl(pg[1].w, src), sc = __shfl(carry, src);
                const float prev0 = fq > 0 ? s0 : sc, prev1 = fq > 0 ? s1 : s0;
                const float imp0 = (pg[0].x + pg[0].y) + (pg[0].z + pg[0].w) + prev0;
                const float imp1 = (pg[1].x + pg[1].y) + (pg[1].z + pg[1].w) + prev1;
                const int jb = (nb >> 2) + fq;
                IMP[fr * 260 + jb] = imp0; IMP[fr * 260 + jb + 4] = imp1;
                carry = pg[1].w;
            }
#undef CMPK_LOAD
#undef CMPV_LOAD
        }
        {
            const int nf = cur >= 2 ? 3 : cur + 1;
            if (fq == 0) {
                SEL[fr * 16 + 0] = 0;
                if (cur == 1) SEL[fr * 16 + 1] = 1;
                if (cur >= 2) { SEL[fr * 16 + 1] = cur - 1; SEL[fr * 16 + 2] = cur; }
            }
            const int ncand = cur >= 3 ? cur - 2 : 0, extra = 16 - nf;
            if (ncand <= extra) {
                if (fq == 0) { for (int k = 0; k < extra; ++k) SEL[fr * 16 + nf + k] = (k < ncand) ? 1 + k : -1; }
            } else {
                for (int rnd = 0; rnd < extra; ++rnd) {
                    float bv = -1.0f; int bj = 1 << 20;
                    for (int jb = 1 + fq; jb <= cur - 2; jb += 4) { const float v = IMP[fr * 260 + jb]; if (v > bv) { bv = v; bj = jb; } }
#pragma unroll
                    for (int o = 16; o <= 32; o <<= 1) {
                        const float ov = __shfl_xor(bv, o); const int oj = __shfl_xor(bj, o);
                        if (ov > bv || (ov == bv && oj < bj)) { bv = ov; bj = oj; }
                    }
                    if (fq == 0) SEL[fr * 16 + nf + rnd] = bj;
                    if (((bj - 1) & 3) == fq) IMP[fr * 260 + bj] = -2.0f;
                }
            }
        }
#pragma unroll
        for (int r = 0; r < 4; ++r)
#pragma unroll
            for (int df = 0; df < 4; ++df) {
                const f32x4 v = acc[r][df];
                *(u32x2*)(O + tok * 1024 + (g * 4 + r) * 64 + df * 16 + fq * 4) = (u32x2){pk2(v.x, v.y), pk2(v.z, v.w)};
            }
        asm volatile("s_waitcnt vmcnt(0)" ::: "memory");
        unsigned selp[4];
        {
            const u32x4* sp = (const u32x4*)(SEL + fr * 16);
#pragma unroll
            for (int q = 0; q < 4; ++q) { const u32x4 w = sp[q]; selp[q] = (w.x & 255u) | ((w.y & 255u) << 8) | ((w.z & 255u) << 16) | ((w.w & 255u) << 24); }
        }
        for (int rep = 0; rep < rep_sel; ++rep) {
            const bool dry = (rep + 1 < rep_sel);
            const unsigned char* k8b = p.ws + WS_KS + (size_t)bg * SEQ * 64; const unsigned char* v8b = p.ws + WS_VST + (size_t)bg * 256 * 4096;
            const float* skb = (const float*)(p.ws + WS_KS + 12 * MiB) + (size_t)bg * 256; const float* svb = (const float*)(p.ws + WS_VST + 12 * MiB) + (size_t)bg * 256;
            const unsigned char* Q8 = p.ws + WS_Q8; const float* SQ8 = (const float*)(p.ws + WS_Q8 + 32 * MiB);
            const int nv = cur + 1 < 16 ? cur + 1 : 16, npair = (nv + 1) >> 1, total = 16 * npair;
            const int lrow = lane >> 2, lch = lane & 3;
            const int woff = lrow * 72 + lch * 16;
            const int rr = fr & 3;
            u32x4 sk[2][4], sv[2][4]; float ssk[2], ssv[2];
            int jbn[2];
#define SEL_GET(tokI, slotK) ((int)(((unsigned)__builtin_amdgcn_readlane((int)(((slotK) >> 2) == 0 ? selp[0] : ((slotK) >> 2) == 1 ? selp[1] : ((slotK) >> 2) == 2 ? selp[2] : selp[3]), (tokI)) >> (((slotK) & 3) * 8)) & 255u))
#define SEL_ISSUE(tokI, pairP) do { \
                const int k0_ = 2 * (pairP), k1_ = (2 * (pairP) + 1 < nv) ? 2 * (pairP) + 1 : k0_; \
                jbn[0] = __builtin_amdgcn_readfirstlane(SEL_GET(tokI, k0_)); jbn[1] = __builtin_amdgcn_readfirstlane(SEL_GET(tokI, k1_)); \
                _Pragma("unroll") for (int u = 0; u < 2; ++u) { \
                    const unsigned char* kb_ = k8b + (size_t)jbn[u] * 4096; const unsigned char* vb_ = v8b + (size_t)jbn[u] * 4096; \
                    _Pragma("unroll") for (int j = 0; j < 4; ++j) { sk[u][j] = *(const u32x4*)(kb_ + j * 1024 + lane * 16); sv[u][j] = *(const u32x4*)(vb_ + j * 1024 + lane * 16); } \
                    ssk[u] = skb[jbn[u]]; ssv[u] = svb[jbn[u]]; } } while (0)
            SEL_ISSUE(0, 0);
            long qs8[2] = {0, 0};
            float sq = 0.f, ms = NEGBIG, ls = 0.f;
            f32x4 os[4] = {z4, z4, z4, z4};
            u32x2 oprev[4] = {(u32x2){0u, 0u}, (u32x2){0u, 0u}, (u32x2){0u, 0u}, (u32x2){0u, 0u}};
            int i = 0, pp = 0;
            for (int v = 0; v < total; ++v) {
                const int jb0 = jbn[0], jb1 = jbn[1];
                const bool second_valid = (2 * pp + 1 < nv);
                const float ck0 = ssk[0], ck1 = ssk[1], cv0 = ssv[0], cv1 = ssv[1];
#pragma unroll
                for (int u = 0; u < 2; ++u)
#pragma unroll
                    for (int j = 0; j < 4; ++j) {
                        unsigned char* kd = WL + u * 9216 + woff + j * 1152; unsigned char* vd = kd + 4608;
                        *(u32x2*)kd = (u32x2){sk[u][j].x, sk[u][j].y}; *(u32x2*)(kd + 8) = (u32x2){sk[u][j].z, sk[u][j].w};
                        *(u32x2*)vd = (u32x2){sv[u][j].x, sv[u][j].y}; *(u32x2*)(vd + 8) = (u32x2){sv[u][j].z, sv[u][j].w};
                    }
                if (v + 1 < total) {
                    int p2 = pp + 1, i2 = i; if (p2 == npair) { p2 = 0; i2 = i + 1; }
                    SEL_ISSUE(i2, p2);
                }
                __builtin_amdgcn_sched_barrier(0);
                const int ti = t0 + i;
                if (pp == 0) {
                    const size_t tk = (size_t)b * SEQ + ti;
#pragma unroll
                    for (int ks = 0; ks < 2; ++ks) qs8[ks] = *(const long*)(Q8 + tk * 1024 + (g * 4 + rr) * 64 + ks * 32 + fq * 8);
                    sq = SQ8[tk * 16 + g * 4 + rr] * 1.4426950408889634f;
                    ms = NEGBIG; ls = 0.f;
#pragma unroll
                    for (int df = 0; df < 4; ++df) { os[df] = z4; oprev[df] = *(const u32x2*)(O + tk * 1024 + (g * 4 + rr) * 64 + df * 16 + fq * 4); }
                }
                f32x4 st[2][4];
#pragma unroll
                for (int u = 0; u < 2; ++u)
#pragma unroll
                    for (int f = 0; f < 4; ++f) {
                        const unsigned char* kp = WL + u * 9216 + (32 * (f >> 1) + 8 * (fr >> 2) + 4 * (f & 1) + (fr & 3)) * 72 + fq * 8;
                        const long k0 = *(const long*)kp, k1 = *(const long*)(kp + 32);
                        st[u][f] = __builtin_amdgcn_mfma_f32_16x16x32_fp8_fp8(k0, qs8[0], z4, 0, 0, 0);
                        st[u][f] = __builtin_amdgcn_mfma_f32_16x16x32_fp8_fp8(k1, qs8[1], st[u][f], 0, 0, 0);
                    }
                const float c0_ = sq * ck0, c1_ = sq * ck1;
                if (jb0 == cur || jb1 == cur || !second_valid) {
#pragma unroll
                    for (int u = 0; u < 2; ++u) {
                        const int jbu = u ? jb1 : jb0;
                        const bool allbad = (u == 1) && !second_valid;
#pragma unroll
                        for (int f = 0; f < 4; ++f)
#pragma unroll
                            for (int e = 0; e < 4; ++e) { const int key = jbu * 64 + 32 * (f >> 1) + 8 * fq + 4 * (f & 1) + e; if (allbad || key > ti) st[u][f][e] = NEGBIG; }
                    }
                }
                float mx0 = NEGBIG, mx1 = NEGBIG;
#pragma unroll
                for (int f = 0; f < 4; ++f) { mx0 = fmaxf(mx0, fmaxf(fmaxf(st[0][f].x, st[0][f].y), fmaxf(st[0][f].z, st[0][f].w))); mx1 = fmaxf(mx1, fmaxf(fmaxf(st[1][f].x, st[1][f].y), fmaxf(st[1][f].z, st[1][f].w))); }
                const float mxl = fmaxf(mx0 > -1.0e29f ? mx0 * c0_ : NEGBIG, mx1 > -1.0e29f ? mx1 * c1_ : NEGBIG);
                float mn = ms, al = 1.0f;
                if (__builtin_amdgcn_ballot_w64(mxl > ms + 4.0f) != 0ull) {
                    mn = fmaxf(ms, max4(mxl));
                    al = __builtin_amdgcn_exp2f(ms - mn);
                }
                const float off = 4.0f - mn;
                float ps = 0.f;
                long pfw[2][2];
#pragma unroll
                for (int u = 0; u < 2; ++u) {
                    const float cu = u ? c1_ : c0_;
#pragma unroll
                    for (int f = 0; f < 4; ++f)
#pragma unroll
                        for (int e = 0; e < 4; ++e) { const float pv = __builtin_amdgcn_exp2f(st[u][f][e] * cu + off); st[u][f][e] = pv; ps += pv; }
#pragma unroll
                    for (int s = 0; s < 2; ++s) {
                        int w0 = 0, w1 = 0;
                        w0 = __builtin_amdgcn_cvt_pk_fp8_f32(st[u][2 * s].x, st[u][2 * s].y, w0, false); w0 = __builtin_amdgcn_cvt_pk_fp8_f32(st[u][2 * s].z, st[u][2 * s].w, w0, true);
                        w1 = __builtin_amdgcn_cvt_pk_fp8_f32(st[u][2 * s + 1].x, st[u][2 * s + 1].y, w1, false); w1 = __builtin_amdgcn_cvt_pk_fp8_f32(st[u][2 * s + 1].z, st[u][2 * s + 1].w, w1, true);
                        pfw[u][s] = (long)(((unsigned long long)(unsigned)w1 << 32) | (unsigned long long)(unsigned)w0);
                    }
                }
                ls = ls * al + ps; ms = mn;
#pragma unroll
                for (int df = 0; df < 4; ++df) os[df] = os[df] * al;
#pragma unroll
                for (int u = 0; u < 2; ++u) {
                    f32x4 pvacc[4] = {z4, z4, z4, z4};
#pragma unroll
                    for (int s = 0; s < 2; ++s) {
#pragma unroll
                        for (int df = 0; df < 4; ++df) {
                            const long vf = *(const long*)(WL + u * 9216 + 4608 + (df * 16 + fr) * 72 + 32 * s + 8 * fq);
                            pvacc[df] = __builtin_amdgcn_mfma_f32_16x16x32_fp8_fp8(vf, pfw[u][s], pvacc[df], 0, 0, 0);
                        }
                    }
                    const float cvu = u ? cv1 : cv0;
#pragma unroll
                    for (int df = 0; df < 4; ++df) os[df] = os[df] + pvacc[df] * cvu;
                    __builtin_amdgcn_sched_barrier(0);
                }
                if (pp == npair - 1) {
                    const float l = red4(ls);
                    const float gsv = NGT[((size_t)b * SEQ + ti) * 48 + (g * 4 + rr) * 3 + 1];
                    const float sc = gsv / l;
                    if (fr < 4 && !dry) {
                        bf16_t* op = O + ((size_t)b * SEQ + ti) * 1024 + (g * 4 + fr) * 64 + fq * 4;
#pragma unroll
                        for (int df = 0; df < 4; ++df) {
                            const f32x4 val = os[df] * sc; const u32x2 c = oprev[df];
                            *(u32x2*)(op + df * 16) = (u32x2){pk2(bflo(c.x) + val.x, bfhi(c.x) + val.y), pk2(bflo(c.y) + val.z, bfhi(c.y) + val.w)};
                        }
                    }
                }
                ++pp; if (pp == npair) { pp = 0; ++i; }
            }
#undef SEL_GET
#undef SEL_ISSUE
        }
    }
}
constexpr int NPHASES = 18;
#ifndef PROBE_PHASE
#define PROBE_PHASE (-1)
#endif
#ifndef ATT_REP_CMP
#define ATT_REP_CMP 1
#endif
#ifndef ATT_REP_WIN
#define ATT_REP_WIN 1
#endif
#ifndef ATT_REP_SEL
#define ATT_REP_SEL 1
#endif
#ifndef TS_PHASE
#define TS_PHASE (-1)
#endif
#ifndef TS_MULT
#define TS_MULT 4
#endif
#ifndef PROBE_REPS
#define PROBE_REPS 1
#endif
__global__ void __launch_bounds__(NTHREADS, 2) mega(Params p) {
    __shared__ __attribute__((aligned(1024))) unsigned char lds[LDS_BYTES + 16];
    unsigned* bar_st = (unsigned*)(lds + LDS_BYTES);
    cg::grid_group grid = cg::this_grid();
    const float* MOD = (const float*)(p.ws + WS_MOD);
    bf16_t* HM = (bf16_t*)(p.ws + WS_HM);
    if (threadIdx.x < 4) bar_st[threadIdx.x] = 0u;
    __syncthreads();
    XcdBarrier bar = xcd_barrier_post((unsigned*)(p.ws + WS_CTL), (volatile LAS unsigned*)bar_st);
    const int lo = p.ph_lo, hi = p.ph_hi;
    const bool dry0 = (p.ph_hi < 0);
    const int opq = (p.ph_hi < 0) ? 1 : 0;
    const bool never = (p.ph_hi < 0);
    unsigned long long ts_a = 0ull, ts_b = 0ull;
#define PHASE(k, call, drycall) if (lo <= (k) && (k) < hi) { \
        if (TS_PHASE == (k)) ts_a = __builtin_amdgcn_s_memrealtime(); \
        if (PROBE_PHASE == (k)) { for (int rep = 0; rep < PROBE_REPS; ++rep) { const bool dry = !dry0; drycall; __syncthreads(); } } \
        { const bool dry = dry0; call; } \
        if ((k) + 1 < hi) { if (never) grid.sync(); else xcd_barrier(bar); } \
        if (TS_PHASE == (k)) ts_b = __builtin_amdgcn_s_memrealtime(); }
    PHASE(0, phase_prep(p, (float*)lds, 0), phase_prep(p, (float*)lds, 0))
    PHASE(1, phase_norm(p, p.in[0], p.in[2], MOD + 0, MOD + 1024, HM), phase_norm(p, p.in[0], p.in[2], MOD + 0, MOD + 1024, HM))
    PHASE(2, phase_s5_win(p, lds), phase_s5_win(p, lds))
    PHASE(3, phase_s5_a(p, lds), phase_s5_a(p, lds))
    PHASE(4, (phase_s5_scan(p), phase_prep(p, (float*)lds, 1)), (phase_s5_scan(p), phase_prep(p, (float*)lds, 1)))
    PHASE(5, phase_s5_b(p, lds), phase_s5_b(p, lds))
    PHASE(6, phase_s5_glu(p, lds), phase_s5_glu(p, lds))
    PHASE(7, phase_norm(p, p.out, p.in[3], MOD + 3072, MOD + 4096, HM), phase_norm(p, p.out, p.in[3], MOD + 3072, MOD + 4096, HM))
    PHASE(8, phase_peer_route(p, 0, lds), phase_peer_route(p, 0, lds))
    PHASE(9, phase_peer_apply6(p, 0, lds, dry), phase_peer_apply6(p, 0, lds, dry))
    PHASE(10, phase_nsa_proj(p, lds), phase_nsa_proj(p, lds))
    PHASE(11, (phase_nsa_cmp1(p, lds), phase_tab1(p)), (phase_nsa_cmp1(p, lds), phase_tab1(p)))
    PHASE(12, phase_nsa_cmp2(p, lds), phase_nsa_cmp2(p, lds))
    PHASE(13, phase_nsa_attn(p, lds, ATT_REP_CMP + opq, ATT_REP_WIN + opq, ATT_REP_SEL + opq), phase_nsa_attn(p, lds, 1 + opq, 1 + opq, 1 + opq))
    PHASE(14, phase_nsa_wo(p, lds, dry), phase_nsa_wo(p, lds, dry))
    PHASE(15, phase_norm(p, p.out, p.in[3] + D, MOD + 2 * 6144 + 3072, MOD + 2 * 6144 + 4096, HM), phase_norm(p, p.out, p.in[3] + D, MOD + 2 * 6144 + 3072, MOD + 2 * 6144 + 4096, HM))
    PHASE(16, phase_peer_route(p, 1, lds), phase_peer_route(p, 1, lds))
    PHASE(17, phase_peer_apply6(p, 1, lds, dry), phase_peer_apply6(p, 1, lds, dry))
#undef PHASE
    if (TS_PHASE >= 0 && blockIdx.x == 0 && threadIdx.x == 0) {
        const unsigned long long t0 = __builtin_amdgcn_s_memrealtime(), want = (ts_b - ts_a) * TS_MULT;
        while (__builtin_amdgcn_s_memrealtime() - t0 < want) __builtin_amdgcn_s_sleep(8);
    }
}

extern "C" void kernel_launch(void* const* d_in, const int* in_sizes, int n_in, void* d_out, int out_size, void* d_ws, size_t ws_size, hipStream_t stream) {
    static int grid_blocks = 0;
    if (!grid_blocks) {
        int dev = 0, cus = 0, per_cu = 0;
        hipGetDevice(&dev);
        hipDeviceGetAttribute(&cus, hipDeviceAttributeMultiprocessorCount, dev);
        hipOccupancyMaxActiveBlocksPerMultiprocessor(&per_cu, mega, NTHREADS, 0);
        if (per_cu > 2) per_cu = 2;
        if (per_cu < 1) per_cu = 1;
        grid_blocks = cus * per_cu;
        if (ws_size < WS_END) fprintf(stderr, "kernel_launch: workspace too small: %zu < %zu\n", ws_size, (size_t)WS_END);
        if (n_in != 29) fprintf(stderr, "kernel_launch: expected 29 inputs, got %d\n", n_in);
    }
    hipMemsetAsync((unsigned char*)d_ws + WS_CTL, 0, 16384, stream);
    Params p{};
    for (int i = 0; i < 29; ++i) p.in[i] = (const float*)d_in[i];
    p.out = (float*)d_out; p.ws = (unsigned char*)d_ws;
#if SINGLE_LAUNCH
    p.ph_lo = 0; p.ph_hi = NPHASES;
    void* args[] = {&p};
    hipError_t e = hipLaunchCooperativeKernel((void*)mega, dim3(grid_blocks), dim3(NTHREADS), args, 0, stream);
    if (e != hipSuccess) fprintf(stderr, "cooperative launch failed: %s (grid %d)\n", hipGetErrorString(e), grid_blocks);
#else
    for (int ph = 0; ph < NPHASES; ++ph) {
        p.ph_lo = ph; p.ph_hi = ph + 1;
        hipLaunchKernelGGL(mega, dim3(grid_blocks), dim3(NTHREADS), 0, stream, p);
    }
#endif
}
```

```cpp
#include <hip/hip_runtime.h>
#include <hip/hip_cooperative_groups.h>
#include <cstdio>
#include <cstdint>
namespace cg = cooperative_groups;

#ifndef SINGLE_LAUNCH
#define SINGLE_LAUNCH 1
#endif

typedef unsigned short bf16_t;
typedef short bf16x8 __attribute__((ext_vector_type(8)));
typedef float f32x4 __attribute__((ext_vector_type(4)));
typedef float f32x2 __attribute__((ext_vector_type(2)));
typedef unsigned u32x4 __attribute__((ext_vector_type(4)));
typedef unsigned u32x2 __attribute__((ext_vector_type(2)));
typedef __bf16 bf16x2_t __attribute__((ext_vector_type(2)));
typedef float v32f __attribute__((ext_vector_type(32)));
typedef float v16f __attribute__((ext_vector_type(16)));
typedef unsigned v6u __attribute__((ext_vector_type(6)));

constexpr int D = 1024, BATCH = 2, SEQ = 16384, T = BATCH * SEQ;
constexpr int NTHREADS = 256;
constexpr float RMS_EPS = 1e-6f;
constexpr int S5G = 64, S5P = 64, S5L = 32, S5NCH = T / S5L  , S5CPB = SEQ / S5L  ;
constexpr int NH = 16, HD = 64, NG = 4, NPROJ = 2608, NPROJ_PAD = 2688, NC = 1023, NSB = 256;
constexpr int PH = 8, PK = 16, PNK = 128, PE = 16384;

constexpr size_t MiB = 1ull << 20;
constexpr size_t WS_CTL = 0;
constexpr size_t WS_MOD = 1 * MiB;
constexpr size_t WS_WIN_T = 2 * MiB;
constexpr size_t WS_WGLU_T = 4 * MiB;
constexpr size_t WS_WPROJ_T = 8 * MiB;
constexpr size_t WS_WK1_T = 14 * MiB;
constexpr size_t WS_WV1_T = 15 * MiB;
constexpr size_t WS_WK2_T = 16 * MiB;
constexpr size_t WS_WV2_T = 16 * MiB + 512 * 1024;
constexpr size_t WS_WO_T = 17 * MiB;
constexpr size_t WS_WQ_T = 19 * MiB;
constexpr size_t WS_SUBK = 27 * MiB;
constexpr size_t WS_ROPE = 28 * MiB;
constexpr size_t WS_MISC = 32 * MiB;
constexpr size_t WS_TW = 33 * MiB;
constexpr size_t WS_VG = 73 * MiB;
constexpr size_t WS_PU = 82 * MiB;
constexpr size_t WS_PV = 114 * MiB;
constexpr size_t WS_HM = 146 * MiB;
constexpr size_t WS_C = 210 * MiB;
constexpr size_t WS_UG = WS_C;
constexpr size_t WS_YI = WS_C + 64 * MiB;
constexpr size_t WS_WST = WS_C + 128 * MiB;
constexpr size_t WS_SST = WS_C + 160 * MiB;
constexpr size_t WS_YG = WS_C + 176 * MiB;
constexpr size_t WS_QK = WS_C;
constexpr size_t WS_TOPS = WS_C + 128 * MiB;
constexpr size_t WS_TOPI = WS_C + 160 * MiB;
constexpr size_t WS_EXP = WS_C + 192 * MiB;
constexpr size_t WS_GATE = WS_C + 208 * MiB;
constexpr size_t WS_ACT = WS_C + 224 * MiB;
constexpr size_t WS_Q = WS_C;
constexpr size_t WS_KC = WS_C + 64 * MiB;
constexpr size_t WS_VC = WS_C + 81 * MiB;
constexpr size_t WS_KS = WS_C + 98 * MiB;
constexpr size_t WS_VST = WS_C + 114 * MiB;
constexpr size_t WS_KW = WS_C + 130 * MiB;
constexpr size_t WS_VWT = WS_C + 146 * MiB;
constexpr size_t WS_NG = WS_C + 162 * MiB;
constexpr size_t WS_KCMP = WS_C + 170 * MiB;
constexpr size_t WS_VCMPT = WS_C + 171 * MiB;
constexpr size_t WS_HID = WS_C + 172 * MiB;
constexpr size_t WS_O = WS_C + 182 * MiB;
constexpr size_t WS_Q8 = WS_C + 246 * MiB;
constexpr size_t WS_END = WS_C + 282 * MiB;

constexpr int LDS_BYTES = 74240;

struct Params {
    const float* in[29];
    float* out;
    unsigned char* ws;
    int ph_lo, ph_hi;
};

__device__ __forceinline__ unsigned f2bf(float f) { unsigned u = __builtin_bit_cast(unsigned, f); return (u + 0x7fffu + ((u >> 16) & 1u)) >> 16; }
__device__ __forceinline__ unsigned pk2(float lo, float hi) { return f2bf(lo) | (f2bf(hi) << 16); }
__device__ __forceinline__ float bf2f(unsigned h) { return __builtin_bit_cast(float, h << 16); }
__device__ __forceinline__ float bflo(unsigned w) { return __builtin_bit_cast(float, w << 16); }
__device__ __forceinline__ float bfhi(unsigned w) { return __builtin_bit_cast(float, w & 0xffff0000u); }
__device__ __forceinline__ float gelu_tanh(float x) {
    const float u = 0.7978845608028654f * (x + 0.044715f * x * x * x);
    const float e = __expf(2.0f * u);
    const float th = 1.0f - 2.0f / (e + 1.0f);
    return 0.5f * x * (1.0f + th);
}
__device__ __forceinline__ float sigmoidf_(float x) { return 1.0f / (1.0f + __expf(-x)); }
__device__ __forceinline__ float wave_sum(float v) {
#pragma unroll
    for (int o = 1; o < 64; o <<= 1) v += __shfl_xor(v, o);
    return v;
}
__device__ __forceinline__ float dot2bf(unsigned a, unsigned b, float acc) {
    return __builtin_amdgcn_fdot2_f32_bf16(__builtin_bit_cast(bf16x2_t, a), __builtin_bit_cast(bf16x2_t, b), acc, false);
}

#define LAS __attribute__((address_space(3)))
#define XB_TMO      128
#define XB_XCNT(j)  (256  + 64 * (j))
#define XB_XSUB(j)  (1280 + 64 * (j))
#define XB_XGEN(j)  (2304 + 64 * (j))
#define XB_TOP      3328
#define XB_TOPGEN   3392
#define XCD_BAR_WORDS 3456
#define XB_SPIN_CAP (1u << 24)

__device__ __forceinline__ unsigned xb_ld(unsigned* p)              { return __hip_atomic_load(p, __ATOMIC_RELAXED, __HIP_MEMORY_SCOPE_AGENT); }
__device__ __forceinline__ unsigned xb_add(unsigned* p, unsigned v) { return __hip_atomic_fetch_add(p, v, __ATOMIC_RELAXED, __HIP_MEMORY_SCOPE_AGENT); }
__device__ __forceinline__ unsigned xb_xcc_id() { return (unsigned)__builtin_amdgcn_s_getreg((3 << 11) | 20) & 0xFu; }
#define XB_SPIN(cond, bar) do { unsigned _sp = 0; while (cond) { __builtin_amdgcn_s_sleep(1); \
    if ((++_sp & 255u) == 0u) { if (xb_ld(&(bar)[XB_TMO])) break; if (_sp > XB_SPIN_CAP) { atomicAdd(&(bar)[XB_TMO], 1u); break; } } } } while (0)

struct XcdBarrier {
    unsigned* bar; unsigned x;
    volatile LAS unsigned* st;
};

__device__ __forceinline__ XcdBarrier xcd_barrier_post(unsigned* bar, volatile LAS unsigned* st) {
    XcdBarrier b; b.bar = bar; b.x = xb_xcc_id(); b.st = st;
    if (threadIdx.x == 0) (void)xb_add(&bar[XB_XCNT(b.x)], 1u);
    return b;
}
__device__ __forceinline__ void xcd_barrier_complete(unsigned* bar, unsigned x, unsigned& nloc, unsigned& nx) {
    const unsigned G = gridDim.x * gridDim.y * gridDim.z;
    unsigned sum, cnt, mine, sp = 0u;
    for (;;) {
        sum = 0u; cnt = 0u; mine = 0u;
#pragma unroll
        for (unsigned j = 0; j < 16; ++j) { const unsigned c = xb_ld(&bar[XB_XCNT(j)]); sum += c; cnt += (c > 0u) ? 1u : 0u; mine = (j == x) ? c : mine; }
        if (sum == G) break;
        __builtin_amdgcn_s_sleep(1);
        if ((++sp & 255u) == 0u) { if (xb_ld(&bar[XB_TMO])) break; if (sp > XB_SPIN_CAP) { atomicAdd(&bar[XB_TMO], 1u); break; } }
    }
    nloc = mine > 0u ? mine : 1u; nx = cnt > 0u ? cnt : 1u;
}

__device__ __forceinline__ void xcd_barrier(const XcdBarrier& b) {
    asm volatile("s_waitcnt vmcnt(0)" ::: "memory");
    __syncthreads();
    if (threadIdx.x == 0) {
        unsigned* bar = b.bar;
        __builtin_amdgcn_s_waitcnt(0);
        unsigned nloc = b.st[0], nx = b.st[1];
        if (nloc == 0u) { xcd_barrier_complete(bar, b.x, nloc, nx); b.st[0] = nloc; b.st[1] = nx; }
        const unsigned old = xb_add(&bar[XB_XSUB(b.x)], 1u);
        const unsigned gen = old / nloc;
        if (old + 1u == (gen + 1u) * nloc) {
            __builtin_amdgcn_fence(__ATOMIC_RELEASE, "agent");
            asm volatile("s_waitcnt vmcnt(0)" ::: "memory");
            const unsigned og = xb_add(&bar[XB_TOP], 1u);
            const unsigned tg = og / nx;
            if (og + 1u == (tg + 1u) * nx) xb_add(&bar[XB_TOPGEN], 1u);
            else XB_SPIN(xb_ld(&bar[XB_TOPGEN]) == tg, bar);
            __builtin_amdgcn_fence(__ATOMIC_ACQUIRE, "agent");
            xb_add(&bar[XB_XGEN(b.x)], 1u);
            asm volatile("s_waitcnt vmcnt(0)" ::: "memory");
        } else {
            XB_SPIN(xb_ld(&bar[XB_XGEN(b.x)]) == gen, bar);
            __builtin_amdgcn_fence(__ATOMIC_ACQUIRE, "agent");
            asm volatile("s_waitcnt vmcnt(0)" ::: "memory");
        }
    }
    __syncthreads();
}
__device__ __forceinline__ void prep_mod_item(const Params& p, int item, float* lds) {
    const int layer = item / 192, cg0 = (item % 192) * 32;
    const int tid = threadIdx.x, col = cg0 + (tid & 31), kg = tid >> 5;
    const float* W = p.in[4] + (size_t)layer * D * 6 * D + col;
    const float* c = p.in[1];
    float* cact = lds + 512;
#pragma unroll
    for (int i = 0; i < 8; ++i) { const int q = tid + 256 * i; const float v = c[q]; cact[q] = v * sigmoidf_(v); }
    __syncthreads();
    float a0 = 0.f, a1 = 0.f;
    for (int k0 = kg * 128; k0 < kg * 128 + 128; k0 += 16) {
        float w[16];
#pragma unroll
        for (int u = 0; u < 16; ++u) w[u] = W[(size_t)(k0 + u) * (6 * D)];
#pragma unroll
        for (int u = 0; u < 16; ++u) { a0 += w[u] * cact[k0 + u]; a1 += w[u] * cact[1024 + k0 + u]; }
    }
    lds[tid] = a0; lds[256 + tid] = a1;
    __syncthreads();
    if (tid < 64) {
        const int b = tid >> 5, cc = tid & 31;
        float s = 0.f;
#pragma unroll
        for (int g = 0; g < 8; ++g) s += lds[b * 256 + g * 32 + cc];
        float* MOD = (float*)(p.ws + WS_MOD);
        MOD[(size_t)(layer * 2 + b) * 6144 + cg0 + cc] = s + p.in[5][(size_t)layer * 6144 + cg0 + cc];
    }
    __syncthreads();
}

template <int MODE>
__device__ __forceinline__ void prep_transpose_item(const float* W, int K, int N, bf16_t* WT, int item, float* lds) {
    const int nbn = (N + 63) / 64, kb = item / nbn, nb = item % nbn, k0 = kb * 64, n0 = nb * 64;
    const int tid = threadIdx.x;
#pragma unroll
    for (int i = 0; i < 16; ++i) {
        const int kk = (tid >> 6) + 4 * i, nn = tid & 63;
        const float v = (n0 + nn < N) ? W[(size_t)(k0 + kk) * N + n0 + nn] : 0.f;
        lds[kk * 65 + nn] = v;
    }
    __syncthreads();
    {
        const int nn = tid >> 2, ks = (tid & 3) * 16;
        const int n = n0 + nn;
        if (n < N) {
            int np = n;
            if (MODE == 1) { const int j = (n < 1024) ? n : n - 1024; np = (j >> 4) * 32 + (j & 15) + ((n < 1024) ? 0 : 16); }
            u32x4 o0, o1;
            const float* s = lds + nn;
            o0.x = pk2(s[(ks + 0) * 65], s[(ks + 1) * 65]); o0.y = pk2(s[(ks + 2) * 65], s[(ks + 3) * 65]);
            o0.z = pk2(s[(ks + 4) * 65], s[(ks + 5) * 65]); o0.w = pk2(s[(ks + 6) * 65], s[(ks + 7) * 65]);
            o1.x = pk2(s[(ks + 8) * 65], s[(ks + 9) * 65]); o1.y = pk2(s[(ks + 10) * 65], s[(ks + 11) * 65]);
            o1.z = pk2(s[(ks + 12) * 65], s[(ks + 13) * 65]); o1.w = pk2(s[(ks + 14) * 65], s[(ks + 15) * 65]);
            u32x4* dst = (u32x4*)(WT + (size_t)np * K + k0 + ks);
            dst[0] = o0; dst[1] = o1;
        }
    }
    __syncthreads();
}

__device__ __forceinline__ void cvt_item(const float* src, bf16_t* dst, int item) {
    const size_t base = (size_t)item * 8192 + threadIdx.x * 8;
#pragma unroll
    for (int i = 0; i < 4; ++i) {
        const size_t o = base + (size_t)i * 2048;
        const f32x4 a = *(const f32x4*)(src + o), b = *(const f32x4*)(src + o + 4);
        u32x4 w; w.x = pk2(a.x, a.y); w.y = pk2(a.z, a.w); w.z = pk2(b.x, b.y); w.w = pk2(b.z, b.w);
        *(u32x4*)(dst + o) = w;
    }
}
__device__ __forceinline__ void zero_item(bf16_t* dst, int item) {
    const size_t base = (size_t)item * 8192 + threadIdx.x * 8;
#pragma unroll
    for (int i = 0; i < 4; ++i) *(u32x4*)(dst + base + (size_t)i * 2048) = (u32x4){0u, 0u, 0u, 0u};
}

struct cpx { float re, im; };
__device__ __forceinline__ cpx cmul(cpx a, cpx b) { return {a.re * b.re - a.im * b.im, a.re * b.im + a.im * b.re}; }
__device__ __forceinline__ cpx cexp_pow(float are, float aim, float dt, int m) {
    const float mag = __expf(are * dt * (float)m);
    const double rev = (double)aim * (double)dt * (double)m * 0.15915494309189535;
    const float fr = (float)(rev - rint(rev));
    return {mag * __builtin_amdgcn_cosf(fr), mag * __builtin_amdgcn_sinf(fr)};
}
__device__ __forceinline__ cpx s5_coef(float are, float aim, float dt) {
    cpx ab = cexp_pow(are, aim, dt, 1);
    const float nr = ab.re - 1.0f, ni = ab.im, den = are * are + aim * aim;
    return {(nr * are + ni * aim) / den, (ni * are - nr * aim) / den};
}

__device__ __forceinline__ void prep_s5_T_item(const Params& p, int item) {
    const int gid = item * 256 + threadIdx.x;
    const int g = gid >> 9, m = (gid >> 4) & 31, i = gid & 15;
    const float* a_re = p.in[7] + g * 64; const float* a_im = p.in[8] + g * 64;
    const float dt = __expf(p.in[9][g]);
    const float* b_re = p.in[10] + (size_t)g * 64 * 16; const float* b_im = p.in[11] + (size_t)g * 64 * 16;
    const float* c_re = p.in[12] + (size_t)g * 16 * 64 + i * 64; const float* c_im = p.in[13] + (size_t)g * 16 * 64 + i * 64;
    float acc[16];
#pragma unroll
    for (int j = 0; j < 16; ++j) acc[j] = 0.f;
    for (int q = 0; q < 64; ++q) {
        const float are = a_re[q], aim = a_im[q];
        cpx z = cmul(cmul({c_re[q], c_im[q]}, cexp_pow(are, aim, dt, m)), s5_coef(are, aim, dt));
        const f32x4* br = (const f32x4*)(b_re + q * 16); const f32x4* bi = (const f32x4*)(b_im + q * 16);
#pragma unroll
        for (int j4 = 0; j4 < 4; ++j4) {
            const f32x4 r = br[j4], im = bi[j4];
            acc[j4 * 4 + 0] += z.re * r.x - z.im * im.x; acc[j4 * 4 + 1] += z.re * r.y - z.im * im.y;
            acc[j4 * 4 + 2] += z.re * r.z - z.im * im.z; acc[j4 * 4 + 3] += z.re * r.w - z.im * im.w;
        }
    }
    u32x4 o0, o1;
    o0.x = pk2(acc[0], acc[1]); o0.y = pk2(acc[2], acc[3]); o0.z = pk2(acc[4], acc[5]); o0.w = pk2(acc[6], acc[7]);
    o1.x = pk2(acc[8], acc[9]); o1.y = pk2(acc[10], acc[11]); o1.z = pk2(acc[12], acc[13]); o1.w = pk2(acc[14], acc[15]);
    bf16_t* TW = (bf16_t*)(p.ws + WS_TW) + (size_t)g * 640 * 512;
    const u32x4 z4 = (u32x4){0u, 0u, 0u, 0u};
    for (int lp = 0; lp + m < 32; ++lp) {
        u32x4* d = (u32x4*)(TW + (size_t)((lp + m) * 16 + i) * 512 + lp * 16);
        d[0] = o0; d[1] = o1;
        if (m > 0) { u32x4* dz = (u32x4*)(TW + (size_t)(lp * 16 + i) * 512 + (lp + m) * 16); dz[0] = z4; dz[1] = z4; }
    }
}
__device__ __forceinline__ void prep_s5_W_item(const Params& p, int item) {
    const int gid = item * 256 + threadIdx.x;
    const int g = gid >> 11, q = (gid >> 5) & 63, lp = gid & 31;
    const float are = p.in[7][g * 64 + q], aim = p.in[8][g * 64 + q];
    const float dt = __expf(p.in[9][g]);
    const cpx z = cmul(cexp_pow(are, aim, dt, 31 - lp), s5_coef(are, aim, dt));
    const float* br = p.in[10] + ((size_t)g * 64 + q) * 16; const float* bi = p.in[11] + ((size_t)g * 64 + q) * 16;
    float wr[16], wi[16];
#pragma unroll
    for (int j = 0; j < 16; ++j) { wr[j] = z.re * br[j] - z.im * bi[j]; wi[j] = z.re * bi[j] + z.im * br[j]; }
    bf16_t* TW = (bf16_t*)(p.ws + WS_TW) + (size_t)g * 640 * 512;
    u32x4* d0 = (u32x4*)(TW + (size_t)(512 + q) * 512 + lp * 16);
    u32x4* d1 = (u32x4*)(TW + (size_t)(576 + q) * 512 + lp * 16);
    d0[0] = (u32x4){pk2(wr[0], wr[1]), pk2(wr[2], wr[3]), pk2(wr[4], wr[5]), pk2(wr[6], wr[7])};
    d0[1] = (u32x4){pk2(wr[8], wr[9]), pk2(wr[10], wr[11]), pk2(wr[12], wr[13]), pk2(wr[14], wr[15])};
    d1[0] = (u32x4){pk2(wi[0], wi[1]), pk2(wi[2], wi[3]), pk2(wi[4], wi[5]), pk2(wi[6], wi[7])};
    d1[1] = (u32x4){pk2(wi[8], wi[9]), pk2(wi[10], wi[11]), pk2(wi[12], wi[13]), pk2(wi[14], wi[15])};
}
__device__ __forceinline__ void prep_s5_V_item(const Params& p, int item) {
    const int gid = item * 256 + threadIdx.x;
    const int g = gid >> 14, l = (gid >> 9) & 31, i = (gid >> 5) & 15, q0 = (gid & 31) * 2;
    const float dt = __expf(p.in[9][g]);
    float vr[2], vi[2];
#pragma unroll
    for (int e = 0; e < 2; ++e) {
        const int q = q0 + e;
        const cpx z = cmul({p.in[12][((size_t)g * 16 + i) * 64 + q], p.in[13][((size_t)g * 16 + i) * 64 + q]}, cexp_pow(p.in[7][g * 64 + q], p.in[8][g * 64 + q], dt, l + 1));
        vr[e] = z.re; vi[e] = -z.im;
    }
    bf16_t* VG = (bf16_t*)(p.ws + WS_VG) + ((size_t)g * 512 + l * 16 + i) * 128;
    *(unsigned*)(VG + q0) = pk2(vr[0], vr[1]);
    *(unsigned*)(VG + 64 + q0) = pk2(vi[0], vi[1]);
}
__device__ __forceinline__ void prep_al_item(const Params& p, int item) {
    const int gid = item * 256 + threadIdx.x;
    const int g = gid >> 6;
    const float dt = __expf(p.in[9][g]);
    const cpx z = cexp_pow(p.in[7][gid], p.in[8][gid], dt, S5L);
    f32x2* AL = (f32x2*)(p.ws + WS_MISC + 4096);
    AL[gid] = (f32x2){z.re, z.im};
}
__device__ __forceinline__ void prep_rope_item(const Params& p, int item) {
    const int gid = item * 256 + threadIdx.x;
    const int pos = gid >> 5, j = gid & 31;
    const float freq = exp2f(-(float)j * (13.287712379549449f / 32.0f));
    const float ang = (float)pos * freq;
    const double rev = (double)ang * 0.15915494309189535;
    const float fr = (float)(rev - rint(rev));
    f32x2* R = (f32x2*)(p.ws + WS_ROPE);
    R[gid] = (f32x2){__builtin_amdgcn_cosf(fr), __builtin_amdgcn_sinf(fr)};
}
__device__ __forceinline__ void prep_cmpbias_item(const Params& p, int item, float* lds) {
    const int kv = item >> 3, cg0 = (item & 7) * 32;
    const float* pe = p.in[17 + kv]; const float* w1 = p.in[kv == 0 ? 19 : 21];
    const int tid = threadIdx.x, col = cg0 + (tid & 31), kg = tid >> 5;
    float s = 0.f;
#pragma unroll 8
    for (int k = kg * 256; k < kg * 256 + 256; ++k) s += pe[k] * w1[(size_t)k * 256 + col];
    lds[tid] = s;
    __syncthreads();
    if (tid < 32) {
        float t = 0.f;
#pragma unroll
        for (int q = 0; q < 8; ++q) t += lds[q * 32 + tid];
        ((float*)(p.ws + WS_MISC))[kv * 256 + cg0 + tid] = t;
    }
    __syncthreads();
}

__device__ __forceinline__ void cvt_fp8_item(const float* src, unsigned char* dst, float* inv_scale, int item, const bool slice_major) {
    const int lane = threadIdx.x & 63, row0 = item * 16 + (threadIdx.x >> 6) * 4;
    f32x4 v[4][4];
#pragma unroll
    for (int r = 0; r < 4; ++r) {
        const f32x4* sp = (const f32x4*)(src + (size_t)(row0 + r) * D + lane * 16);
#pragma unroll
        for (int q = 0; q < 4; ++q) v[r][q] = sp[q];
    }
#pragma unroll
    for (int r = 0; r < 4; ++r) {
        float m = 0.f;
#pragma unroll
        for (int q = 0; q < 4; ++q) m = fmaxf(m, fmaxf(fmaxf(fabsf(v[r][q].x), fabsf(v[r][q].y)), fmaxf(fabsf(v[r][q].z), fabsf(v[r][q].w))));
#pragma unroll
        for (int o = 1; o < 64; o <<= 1) m = fmaxf(m, __shfl_xor(m, o));
        const float sc = m > 0.f ? 224.0f / m : 1.0f;
        unsigned w[4];
#pragma unroll
        for (int q = 0; q < 4; ++q) { int t = 0; t = __builtin_amdgcn_cvt_pk_fp8_f32(v[r][q].x * sc, v[r][q].y * sc, t, false); t = __builtin_amdgcn_cvt_pk_fp8_f32(v[r][q].z * sc, v[r][q].w * sc, t, true); w[q] = (unsigned)t; }
        const int row = row0 + r;
        const u32x4 wv = (u32x4){w[0], w[1], w[2], w[3]};
        if (slice_major) *(u32x4*)(dst + (size_t)(lane >> 3) * (PE * 128) + (size_t)row * 128 + (lane & 7) * 16) = wv;
        else *(u32x4*)(dst + (size_t)row * D + lane * 16) = wv;
        if (lane == 0) inv_scale[row] = m > 0.f ? m / 224.0f : 1.0f;
    }
}
__device__ __forceinline__ void cvt_fp6_item(const float* src, unsigned char* dst, float* inv_scale, int item) {
    const int lane = threadIdx.x & 63, half = lane >> 5, gl = lane & 31, row0 = item * 16 + (threadIdx.x >> 6) * 4;
#pragma unroll
    for (int pr = 0; pr < 2; ++pr) {
        const int row = row0 + pr * 2 + half;
        const f32x4* sp = (const f32x4*)(src + (size_t)row * D + gl * 32);
        f32x4 v[8];
#pragma unroll
        for (int q = 0; q < 8; ++q) v[q] = sp[q];
        float m = 0.f;
#pragma unroll
        for (int q = 0; q < 8; ++q) m = fmaxf(m, fmaxf(fmaxf(fabsf(v[q].x), fabsf(v[q].y)), fmaxf(fabsf(v[q].z), fabsf(v[q].w))));
#pragma unroll
        for (int o = 1; o < 32; o <<= 1) m = fmaxf(m, __shfl_xor(m, o));
        const float sc = m > 0.f ? 7.5f / m : 1.0f;
        v16f x0, x1;
#pragma unroll
        for (int q = 0; q < 8; ++q) {
            x0[q * 2 + 0] = v[q].x * sc; x1[q * 2 + 0] = v[q].y * sc; x0[q * 2 + 1] = v[q].z * sc; x1[q * 2 + 1] = v[q].w * sc;
        }
        const v6u w = __builtin_amdgcn_cvt_scalef32_2xpk16_fp6_f32(x0, x1, 1.0f);
        u32x2* dp = (u32x2*)(dst + (size_t)row * 768 + gl * 24);
        dp[0] = (u32x2){w[0], w[1]}; dp[1] = (u32x2){w[2], w[3]}; dp[2] = (u32x2){w[4], w[5]};
        if (gl == 0) inv_scale[row] = m > 0.f ? m / 7.5f : 1.0f;
    }
}
constexpr int P0_MOD = 384;
constexpr int P0_T_WIN = 16 * 16, P0_T_WGLU = 16 * 32, P0_T_WPROJ = 16 * 41, P0_T_WK1 = 32 * 4, P0_T_WK2 = 4 * 1, P0_T_WO = 16 * 16, P0_T_WQ = 16 * 32;
constexpr int P0_SUBK = (2 * 8 * 2 * 128 * 128) / 8192;
constexpr int P0_TAB = PE / 16;
constexpr int P0_S5T = 128, P0_S5W = 512, P0_S5V = 4096, P0_AL = 16, P0_ROPE = 2048, P0_CB = 16, P0_ZERO = 10 + 2;

__device__ __forceinline__ void phase_prep(const Params& p, float* lds, const int part) {
    const int n0 = P0_MOD;
    const int n1 = n0 + P0_T_WIN, n2 = n1 + P0_T_WGLU, n3 = n2 + P0_T_WPROJ, n4 = n3 + P0_T_WK1, n5 = n4 + P0_T_WK1, n6 = n5 + P0_T_WK2, n7 = n6 + P0_T_WK2,
              n8 = n7 + P0_T_WO, n9 = n8 + P0_T_WQ, n10 = n9 + P0_T_WQ, n11 = n10 + P0_SUBK, n12 = n11 + P0_TAB, n13 = n12 + P0_TAB,
              n14 = n13 + P0_S5T, n15 = n14 + P0_S5W, n16 = n15 + P0_S5V, n17 = n16 + P0_AL, n18 = n17 + P0_ROPE, n19 = n18 + P0_CB, n20 = n19 + 10, n21 = n20 + 2, n22 = n21 + 2;
    unsigned char* ws = p.ws;
#ifndef PREP_DUP_LO
#define PREP_DUP_LO 0
#define PREP_DUP_HI 0
#endif
    const int dupn = (PREP_DUP_HI) - (PREP_DUP_LO);
    const int nB = (n8 - n2) + (n10 - n9) + (n22 - n17);
    const int first = part == 0 ? (int)blockIdx.x : (int)blockIdx.x - 32, stride = part == 0 ? (int)gridDim.x : (int)gridDim.x - 32;
    if (first < 0 || stride <= 0) return;
    const int total = part == 0 ? (n22 - nB) + dupn : nB;
    for (int it0 = first; it0 < total; it0 += stride) {
        int it;
        if (part == 0) {
            it = it0;
            if (it >= n2) it += (n8 - n2);
            if (it >= n9) it += (n10 - n9);
            if (it0 >= (n22 - nB)) it = (PREP_DUP_LO) + (it0 - (n22 - nB));
        } else {
            it = n2 + it0;
            if (it >= n8) it += (n9 - n8);
            if (it >= n10) it += (n17 - n10);
        }
        if (it < n0) prep_mod_item(p, it, lds);
        else if (it < n1) prep_transpose_item<0>(p.in[6], 1024, 1024, (bf16_t*)(ws + WS_WIN_T), it - n0, lds);
        else if (it < n2) prep_transpose_item<1>(p.in[15], 1024, 2048, (bf16_t*)(ws + WS_WGLU_T), it - n1, lds);
        else if (it < n3) prep_transpose_item<0>(p.in[16], 1024, NPROJ, (bf16_t*)(ws + WS_WPROJ_T), it - n2, lds);
        else if (it < n4) prep_transpose_item<0>(p.in[19], 2048, 256, (bf16_t*)(ws + WS_WK1_T), it - n3, lds);
        else if (it < n5) prep_transpose_item<0>(p.in[21], 2048, 256, (bf16_t*)(ws + WS_WV1_T), it - n4, lds);
        else if (it < n6) prep_transpose_item<0>(p.in[20], 256, 64, (bf16_t*)(ws + WS_WK2_T), it - n5, lds);
        else if (it < n7) prep_transpose_item<0>(p.in[22], 256, 64, (bf16_t*)(ws + WS_WV2_T), it - n6, lds);
        else if (it < n8) prep_transpose_item<0>(p.in[23], 1024, 1024, (bf16_t*)(ws + WS_WO_T), it - n7, lds);
        else if (it < n9) prep_transpose_item<0>(p.in[24], 1024, 2048, (bf16_t*)(ws + WS_WQ_T), it - n8, lds);
        else if (it < n10) prep_transpose_item<0>(p.in[24] + (size_t)1024 * 2048, 1024, 2048, (bf16_t*)(ws + WS_WQ_T) + (size_t)2048 * 1024, it - n9, lds);
        else if (it < n11) cvt_item(p.in[25], (bf16_t*)(ws + WS_SUBK), it - n10);
        else if (it < n12) cvt_fp6_item(p.in[26], ws + WS_PU, (float*)(ws + WS_PU + 24 * MiB), it - n11);
        else if (it < n13) cvt_fp6_item(p.in[27], ws + WS_PV, (float*)(ws + WS_PV + 24 * MiB), it - n12);
        else if (it < n14) prep_s5_T_item(p, it - n13);
        else if (it < n15) prep_s5_W_item(p, it - n14);
        else if (it < n16) prep_s5_V_item(p, it - n15);
        else if (it < n17) prep_al_item(p, it - n16);
        else if (it < n18) prep_rope_item(p, it - n17);
        else if (it < n19) prep_cmpbias_item(p, it - n18, lds);
        else if (it < n20) zero_item((bf16_t*)(ws + WS_WPROJ_T) + (size_t)NPROJ * 1024, it - n19);
        else if (it < n21) zero_item((bf16_t*)(ws + WS_WK2_T) + (size_t)64 * 256, it - n20);
        else zero_item((bf16_t*)(ws + WS_WV2_T) + (size_t)64 * 256, it - n21);
    }
}

__device__ __forceinline__ void phase_norm(const Params& p, const float* X, const float* gw, const float* shift, const float* scale  , bf16_t* HM) {
    const int lane = threadIdx.x & 63, wave = threadIdx.x >> 6;
    for (int row = blockIdx.x * 4 + wave; row < T; row += gridDim.x * 4) {
        const int b = row / SEQ;
        const f32x4* xr = (const f32x4*)(X + (size_t)row * D) + lane;
        f32x4 v[4]; float s = 0.f;
#pragma unroll
        for (int j = 0; j < 4; ++j) { v[j] = xr[64 * j]; s += (v[j].x * v[j].x + v[j].y * v[j].y) + (v[j].z * v[j].z + v[j].w * v[j].w); }
        const float rs = rsqrtf(wave_sum(s) * (1.0f / D) + RMS_EPS);
        u32x2* o = (u32x2*)(HM + (size_t)row * D) + lane;
#pragma unroll
        for (int j = 0; j < 4; ++j) {
            const int c = lane * 4 + 256 * j;
            const f32x4 g = *(const f32x4*)(gw + c), sh = *(const f32x4*)(shift + (size_t)b * 6144 + c), sc = *(const f32x4*)(scale + (size_t)b * 6144 + c);
            const float y0 = v[j].x * rs * g.x * (1.f + sc.x) + sh.x, y1 = v[j].y * rs * g.y * (1.f + sc.y) + sh.y;
            const float y2 = v[j].z * rs * g.z * (1.f + sc.z) + sh.z, y3 = v[j].w * rs * g.w * (1.f + sc.w) + sh.w;
            o[64 * j] = (u32x2){pk2(y0, y1), pk2(y2, y3)};
        }
    }
}
__device__ __forceinline__ void phase_final_norm(const Params& p, const float* X, float* OUT, bool dry) {
    const int lane = threadIdx.x & 63, wave = threadIdx.x >> 6;
    const float* gw = p.in[28];
    for (int row = blockIdx.x * 4 + wave; row < T; row += gridDim.x * 4) {
        const f32x4* xr = (const f32x4*)(X + (size_t)row * D) + lane;
        f32x4 v[4]; float s = 0.f;
#pragma unroll
        for (int j = 0; j < 4; ++j) { v[j] = xr[64 * j]; s += (v[j].x * v[j].x + v[j].y * v[j].y) + (v[j].z * v[j].z + v[j].w * v[j].w); }
        const float rs = rsqrtf(wave_sum(s) * (1.0f / D) + RMS_EPS);
        f32x4* o = (f32x4*)(OUT + (size_t)row * D) + lane;
#pragma unroll
        for (int j = 0; j < 4; ++j) {
            const f32x4 g = *(const f32x4*)(gw + lane * 4 + 256 * j);
            if (!dry) o[64 * j] = (f32x4){v[j].x * rs * g.x, v[j].y * rs * g.y, v[j].z * rs * g.z, v[j].w * rs * g.w};
        }
    }
}

__device__ __forceinline__ int vblock() { const int G = gridDim.x, bx = blockIdx.x; return (G % 8 == 0) ? (bx % 8) * (G / 8) + bx / 8 : bx; }
struct ALoadPlain {
    const bf16_t* A; size_t lda;
    __device__ __forceinline__ const bf16_t* base(int kt) const { return A + kt * 64; }
    __device__ __forceinline__ unsigned off(int r, int lc) const { return (unsigned)r * (unsigned)lda + (unsigned)lc * 8u; }
};
struct ALoadGroup {
    const bf16_t* A;
    __device__ __forceinline__ const bf16_t* base(int kt) const { return A + (size_t)kt * 4 * T * 16; }
    __device__ __forceinline__ unsigned off(int r, int lc) const { return ((unsigned)(lc >> 1) * (unsigned)T + (unsigned)r) * 16u + (unsigned)(lc & 1) * 8u; }
};

template <class AL>
__device__ __forceinline__ void gemm_tile2(const AL al, const bf16_t* __restrict__ Bt, size_t ldb, int nk, f32x4 (&acc)[4][4], unsigned char* lds) {
    const int tid = threadIdx.x, lane = tid & 63, wid = tid >> 6, wr = wid >> 1, wc = wid & 1, fr = lane & 15, fq = lane >> 4;
    const int lr = tid >> 3, lc = tid & 7;
#pragma unroll
    for (int mi = 0; mi < 4; ++mi)
#pragma unroll
        for (int ni = 0; ni < 4; ++ni) acc[mi][ni] = (f32x4){0.f, 0.f, 0.f, 0.f};
    u32x4 ra0[4], rb0[4], ra1[4], rb1[4];
    const int soff = lr * 128 + ((lc ^ (lr & 7)) << 4);
    unsigned offA[4], offB[4];
#pragma unroll
    for (int i = 0; i < 4; ++i) { offA[i] = al.off(lr + 32 * i, lc); offB[i] = (unsigned)(lr + 32 * i) * (unsigned)ldb + (unsigned)lc * 8u; }
#define GT_LOAD(RA, RB, kt_) do { const bf16_t* ab_ = al.base(kt_); const bf16_t* bb_ = Bt + (kt_) * 64; _Pragma("unroll") for (int i = 0; i < 4; ++i) { RA[i] = *(const u32x4*)(ab_ + offA[i]); RB[i] = *(const u32x4*)(bb_ + offB[i]); } } while (0)
#define GT_STORE(RA, RB, buf_) do { unsigned char* nb_ = lds + (buf_) * 32768; _Pragma("unroll") for (int i = 0; i < 4; ++i) { *(u32x4*)(nb_ + soff + i * 4096) = RA[i]; *(u32x4*)(nb_ + 16384 + soff + i * 4096) = RB[i]; } } while (0)
    const int aoff = (wr * 64 + fr) * 128, boff = 16384 + (wc * 64 + fr) * 128, sw = fr & 7;
#define GT_MATH(buf_) do { const unsigned char* bp_ = lds + (buf_) * 32768; _Pragma("unroll") for (int ks = 0; ks < 2; ++ks) { bf16x8 af[4], bfr[4]; const int co = ((ks * 4 + fq) ^ sw) << 4; \
        _Pragma("unroll") for (int mi = 0; mi < 4; ++mi) af[mi] = *(const bf16x8*)(bp_ + aoff + mi * 2048 + co); \
        _Pragma("unroll") for (int ni = 0; ni < 4; ++ni) bfr[ni] = *(const bf16x8*)(bp_ + boff + ni * 2048 + co); \
        _Pragma("unroll") for (int mi = 0; mi < 4; ++mi) _Pragma("unroll") for (int ni = 0; ni < 4; ++ni) acc[mi][ni] = __builtin_amdgcn_mfma_f32_16x16x32_bf16(bfr[ni], af[mi], acc[mi][ni], 0, 0, 0); } } while (0)
    GT_LOAD(ra0, rb0, 0);
    if (nk > 1) GT_LOAD(ra1, rb1, 1);
    GT_STORE(ra0, rb0, 0);
    __syncthreads();
    for (int kt = 0; kt < nk; kt += 2) {
        if (kt + 2 < nk) GT_LOAD(ra0, rb0, kt + 2);
        __builtin_amdgcn_sched_barrier(0);
        GT_MATH(0);
        __builtin_amdgcn_sched_barrier(0);
        if (kt + 1 < nk) GT_STORE(ra1, rb1, 1);
        __syncthreads();
        if (kt + 1 >= nk) break;
        if (kt + 3 < nk) GT_LOAD(ra1, rb1, kt + 3);
        __builtin_amdgcn_sched_barrier(0);
        GT_MATH(1);
        __builtin_amdgcn_sched_barrier(0);
        if (kt + 2 < nk) GT_STORE(ra0, rb0, 0);
        __syncthreads();
    }
#undef GT_LOAD
#undef GT_STORE
#undef GT_MATH
}

template <class AL>
__device__ __forceinline__ void gemm_tile1(const AL al, const bf16_t* __restrict__ Bt, size_t ldb, int nk, f32x4 (&acc)[4][4], unsigned char* lds) {
    const int tid = threadIdx.x, lane = tid & 63, wid = tid >> 6, wr = wid >> 1, wc = wid & 1, fr = lane & 15, fq = lane >> 4;
    const int lr = tid >> 3, lc = tid & 7;
#pragma unroll
    for (int mi = 0; mi < 4; ++mi)
#pragma unroll
        for (int ni = 0; ni < 4; ++ni) acc[mi][ni] = (f32x4){0.f, 0.f, 0.f, 0.f};
    u32x4 ra[4], rb[4];
    const int soff = lr * 128 + ((lc ^ (lr & 7)) << 4);
#pragma unroll
    for (int i = 0; i < 4; ++i) { ra[i] = *(const u32x4*)(al.base(0) + al.off(lr + 32 * i, lc)); rb[i] = *(const u32x4*)(Bt + (size_t)(lr + 32 * i) * ldb + lc * 8); }
#pragma unroll
    for (int i = 0; i < 4; ++i) { *(u32x4*)(lds + soff + i * 4096) = ra[i]; *(u32x4*)(lds + 16384 + soff + i * 4096) = rb[i]; }
    __syncthreads();
    const int aoff = (wr * 64 + fr) * 128, boff = 16384 + (wc * 64 + fr) * 128, sw = fr & 7;
    for (int kt = 0; kt < nk; ++kt) {
        const bool more = (kt + 1 < nk);
        if (more) {
#pragma unroll
            for (int i = 0; i < 4; ++i) { ra[i] = *(const u32x4*)(al.base(kt + 1) + al.off(lr + 32 * i, lc)); rb[i] = *(const u32x4*)(Bt + (size_t)(lr + 32 * i) * ldb + (kt + 1) * 64 + lc * 8); }
        }
        const unsigned char* buf = lds + (kt & 1) * 32768;
#pragma unroll
        for (int ks = 0; ks < 2; ++ks) {
            bf16x8 af[4], bfr[4];
            const int co = ((ks * 4 + fq) ^ sw) << 4;
#pragma unroll
            for (int mi = 0; mi < 4; ++mi) af[mi] = *(const bf16x8*)(buf + aoff + mi * 2048 + co);
#pragma unroll
            for (int ni = 0; ni < 4; ++ni) bfr[ni] = *(const bf16x8*)(buf + boff + ni * 2048 + co);
#pragma unroll
            for (int mi = 0; mi < 4; ++mi)
#pragma unroll
                for (int ni = 0; ni < 4; ++ni) acc[mi][ni] = __builtin_amdgcn_mfma_f32_16x16x32_bf16(bfr[ni], af[mi], acc[mi][ni], 0, 0, 0);
        }
        if (more) {
            unsigned char* nb = lds + ((kt + 1) & 1) * 32768;
#pragma unroll
            for (int i = 0; i < 4; ++i) { *(u32x4*)(nb + soff + i * 4096) = ra[i]; *(u32x4*)(nb + 16384 + soff + i * 4096) = rb[i]; }
        }
        __syncthreads();
    }
}

template <class AL, bool ZERO = true>
__device__ __forceinline__ void gemm_tile3(const AL al, const bf16_t* __restrict__ Bt, size_t ldb, int nk, f32x4 (&acc)[4][4], unsigned char* lds) {
    const int tid = threadIdx.x, lane = tid & 63, wid = tid >> 6, wr = wid >> 1, wc = wid & 1, fr = lane & 15, fq = lane >> 4;
    if (ZERO) {
#pragma unroll
    for (int mi = 0; mi < 4; ++mi)
#pragma unroll
        for (int ni = 0; ni < 4; ++ni) acc[mi][ni] = (f32x4){0.f, 0.f, 0.f, 0.f};
    }
    const int srow = wid * 32 + (lane >> 3), schunk = (lane & 7) ^ ((lane >> 3) & 7);
    unsigned offA[4], offB[4];
#pragma unroll
    for (int i = 0; i < 4; ++i) { offA[i] = al.off(srow + 8 * i, schunk); offB[i] = (unsigned)(srow + 8 * i) * (unsigned)ldb + (unsigned)schunk * 8u; }
#define G3_STAGE(buf_, kt_) do { const bf16_t* ab_ = al.base(kt_); const bf16_t* bb_ = Bt + (kt_) * 64; unsigned char* lb_ = lds + (buf_) * 32768 + wid * 4096; \
        _Pragma("unroll") for (int i = 0; i < 4; ++i) { \
            __builtin_amdgcn_global_load_lds((const unsigned*)(ab_ + offA[i]), (unsigned*)(lb_ + i * 1024), 16, 0, 0); \
            __builtin_amdgcn_global_load_lds((const unsigned*)(bb_ + offB[i]), (unsigned*)(lb_ + 16384 + i * 1024), 16, 0, 0); } } while (0)
    const int aoff = (wr * 64 + fr) * 128, boff = 16384 + (wc * 64 + fr) * 128, sw = fr & 7;
    G3_STAGE(0, 0);
    __syncthreads();
    for (int kt = 0; kt < nk; ++kt) {
        if (kt + 1 < nk) G3_STAGE((kt + 1) & 1, kt + 1);
        const unsigned char* buf = lds + (kt & 1) * 32768;
#pragma unroll
        for (int ks = 0; ks < 2; ++ks) {
            bf16x8 af[4], bfr[4];
            const int co = ((ks * 4 + fq) ^ sw) << 4;
#pragma unroll
            for (int mi = 0; mi < 4; ++mi) af[mi] = *(const bf16x8*)(buf + aoff + mi * 2048 + co);
#pragma unroll
            for (int ni = 0; ni < 4; ++ni) bfr[ni] = *(const bf16x8*)(buf + boff + ni * 2048 + co);
#pragma unroll
            for (int mi = 0; mi < 4; ++mi)
#pragma unroll
                for (int ni = 0; ni < 4; ++ni) acc[mi][ni] = __builtin_amdgcn_mfma_f32_16x16x32_bf16(bfr[ni], af[mi], acc[mi][ni], 0, 0, 0);
        }
        __syncthreads();
    }
#undef G3_STAGE
}

__device__ __forceinline__ void mma_ktile(const unsigned char* buf, f32x4 (&acc)[4][4]) {
    const int tid = threadIdx.x, lane = tid & 63, wid = tid >> 6, wr = wid >> 1, wc = wid & 1, fr = lane & 15, fq = lane >> 4;
    const int aoff = (wr * 64 + fr) * 128, boff = 16384 + (wc * 64 + fr) * 128, sw = fr & 7;
#pragma unroll
    for (int ks = 0; ks < 2; ++ks) {
        bf16x8 af[4], bfr[4];
        const int co = ((ks * 4 + fq) ^ sw) << 4;
#pragma unroll
        for (int mi = 0; mi < 4; ++mi) af[mi] = *(const bf16x8*)(buf + aoff + mi * 2048 + co);
#pragma unroll
        for (int ni = 0; ni < 4; ++ni) bfr[ni] = *(const bf16x8*)(buf + boff + ni * 2048 + co);
#pragma unroll
        for (int mi = 0; mi < 4; ++mi)
#pragma unroll
            for (int ni = 0; ni < 4; ++ni) acc[mi][ni] = __builtin_amdgcn_mfma_f32_16x16x32_bf16(bfr[ni], af[mi], acc[mi][ni], 0, 0, 0);
    }
}
__device__ __forceinline__ void phase_s5_win(const Params& p, unsigned char* lds) {
    const bf16_t* HM = (const bf16_t*)(p.ws + WS_HM); const bf16_t* WT = (const bf16_t*)(p.ws + WS_WIN_T);
    bf16_t* UG = (bf16_t*)(p.ws + WS_UG);
    const int lane = threadIdx.x & 63, wid = threadIdx.x >> 6, wr = wid >> 1, wc = wid & 1, fr = lane & 15, fq = lane >> 4;
    for (int id = vblock(); id < 256 * 8; id += gridDim.x) {
        const int mt = id >> 3, nt = id & 7;
        f32x4 acc[4][4];
        gemm_tile3(ALoadPlain{HM + (size_t)mt * 128 * D, (size_t)D}, WT + (size_t)nt * 128 * D, D, 16, acc, lds);
#pragma unroll
        for (int mi = 0; mi < 4; ++mi)
#pragma unroll
            for (int ni = 0; ni < 4; ++ni) {
                const int t = mt * 128 + wr * 64 + mi * 16 + fr, g = nt * 8 + wc * 4 + ni;
                const f32x4 v = acc[mi][ni];
                *(u32x2*)(UG + ((size_t)g * T + t) * 16 + fq * 4) = (u32x2){pk2(v.x, v.y), pk2(v.z, v.w)};
            }
    }
}
__device__ __forceinline__ void phase_s5_a(const Params& p, unsigned char* lds) {
    const bf16_t* UG = (const bf16_t*)(p.ws + WS_UG); const bf16_t* TW = (const bf16_t*)(p.ws + WS_TW);
    float* WST = (float*)(p.ws + WS_WST);
    const int lane = threadIdx.x & 63, wid = threadIdx.x >> 6, wr = wid >> 1, wc = wid & 1, fr = lane & 15, fq = lane >> 4;
    for (int id = vblock(); id < 64 * 8; id += gridDim.x) {
        const int g = id >> 3, mt = id & 7;
        f32x4 acc[4][4];
        gemm_tile3(ALoadPlain{UG + (size_t)g * T * 16 + (size_t)mt * 128 * 512, (size_t)512}, TW + ((size_t)g * 640 + 512) * 512, 512, 8, acc, lds);
#pragma unroll
        for (int mi = 0; mi < 4; ++mi)
#pragma unroll
            for (int ni = 0; ni < 4; ++ni) {
                const int R = mt * 128 + wr * 64 + mi * 16 + fr, c = wc * 64 + ni * 16 + fq * 4;
                *(f32x4*)(WST + ((size_t)g * 1024 + R) * 128 + c) = acc[mi][ni];
            }
    }
}
__device__ __forceinline__ void phase_s5_scan(const Params& p) {
    const int lane = threadIdx.x & 63, wave = threadIdx.x >> 6;
    const float* WST = (const float*)(p.ws + WS_WST); bf16_t* SST = (bf16_t*)(p.ws + WS_SST);
    const f32x2* AL = (const f32x2*)(p.ws + WS_MISC + 4096);
    for (int it = blockIdx.x * 4 + wave; it < 128; it += gridDim.x * 4) {
        const int b = it >> 6, g = it & 63;
        const f32x2 al = AL[g * 64 + lane];
        float sr = 0.f, si = 0.f;
        const float* wbase = WST + ((size_t)g * 1024 + b * 512) * 128 + lane;
        bf16_t* sbase = SST + ((size_t)g * 1024 + b * 512) * 128 + lane;
        for (int n0 = 0; n0 < 512; n0 += 16) {
            float wre[16], wim[16];
#pragma unroll
            for (int j = 0; j < 16; ++j) { wre[j] = wbase[(size_t)(n0 + j) * 128]; wim[j] = wbase[(size_t)(n0 + j) * 128 + 64]; }
#pragma unroll
            for (int j = 0; j < 16; ++j) {
                sbase[(size_t)(n0 + j) * 128] = (bf16_t)f2bf(sr); sbase[(size_t)(n0 + j) * 128 + 64] = (bf16_t)f2bf(si);
                const float nr = al.x * sr - al.y * si + wre[j], ni = al.x * si + al.y * sr + wim[j];
                sr = nr; si = ni;
            }
        }
    }
}
__device__ __forceinline__ void phase_s5_b(const Params& p, unsigned char* lds) {
    const bf16_t* SST = (const bf16_t*)(p.ws + WS_SST); const bf16_t* VG = (const bf16_t*)(p.ws + WS_VG);
    const bf16_t* UG = (const bf16_t*)(p.ws + WS_UG); const bf16_t* TW = (const bf16_t*)(p.ws + WS_TW);
    bf16_t* YG = (bf16_t*)(p.ws + WS_YG);
    const float* dsk = p.in[14];
    const int lane = threadIdx.x & 63, wid = threadIdx.x >> 6, wr = wid >> 1, wc = wid & 1, fr = lane & 15, fq = lane >> 4;
    for (int id = vblock(); id < 64 * 32; id += gridDim.x) {
        const int g = id >> 5, mt = (id >> 2) & 7, nt = 3 - (id & 3);
        f32x4 acc[4][4];
        gemm_tile3<ALoadPlain, true>(ALoadPlain{UG + (size_t)g * T * 16 + (size_t)mt * 128 * 512, (size_t)512}, TW + ((size_t)g * 640 + nt * 128) * 512, 512, 2 * (nt + 1), acc, lds);
        gemm_tile3<ALoadPlain, false>(ALoadPlain{SST + ((size_t)g * 1024 + mt * 128) * 128, (size_t)128}, VG + ((size_t)g * 512 + nt * 128) * 128, 128, 2, acc, lds);
        const f32x4 dv = *(const f32x4*)(dsk + g * 16 + fq * 4);
#pragma unroll
        for (int mi = 0; mi < 4; ++mi)
#pragma unroll
            for (int ni = 0; ni < 4; ++ni) {
                const int R = mt * 128 + wr * 64 + mi * 16 + fr, c = nt * 128 + wc * 64 + ni * 16 + fq * 4;
                const size_t idx = ((size_t)g * 1024 + R) * 512 + c;
                const u32x2 uu = *(const u32x2*)(UG + idx);
                const f32x4 v = acc[mi][ni];
                const float y0 = gelu_tanh(v.x + dv.x * bflo(uu.x)), y1 = gelu_tanh(v.y + dv.y * bfhi(uu.x));
                const float y2 = gelu_tanh(v.z + dv.z * bflo(uu.y)), y3 = gelu_tanh(v.w + dv.w * bfhi(uu.y));
                *(u32x2*)(YG + idx) = (u32x2){pk2(y0, y1), pk2(y2, y3)};
            }
    }
}
__device__ __forceinline__ void phase_s5_glu(const Params& p, unsigned char* lds) {
    const bf16_t* YG = (const bf16_t*)(p.ws + WS_YG); const bf16_t* WT = (const bf16_t*)(p.ws + WS_WGLU_T);
    const float* MOD = (const float*)(p.ws + WS_MOD);
    const float* X = p.in[0]; float* XO = p.out;
    const int lane = threadIdx.x & 63, wid = threadIdx.x >> 6, wr = wid >> 1, wc = wid & 1, fr = lane & 15, fq = lane >> 4;
    for (int id = vblock(); id < 256 * 16; id += gridDim.x) {
        const int mt = id >> 4, nt = id & 15;
        f32x4 acc[4][4];
        gemm_tile3(ALoadGroup{YG + (size_t)mt * 128 * 16}, WT + (size_t)nt * 128 * D, D, 16, acc, lds);
        const int b = (mt * 128) / SEQ;
#pragma unroll
        for (int mi = 0; mi < 4; ++mi)
#pragma unroll
            for (int h = 0; h < 2; ++h) {
                const int t = mt * 128 + wr * 64 + mi * 16 + fr, j = nt * 64 + wc * 32 + h * 16 + fq * 4;
                const f32x4 a = acc[mi][2 * h], gg = acc[mi][2 * h + 1];
                const f32x4 g1 = *(const f32x4*)(MOD + (size_t)(0 * 2 + b) * 6144 + 2048 + j);
                const f32x4 xi = *(const f32x4*)(X + (size_t)t * D + j);
                f32x4 o;
                o.x = xi.x + g1.x * (a.x * sigmoidf_(gg.x)); o.y = xi.y + g1.y * (a.y * sigmoidf_(gg.y));
                o.z = xi.z + g1.z * (a.z * sigmoidf_(gg.z)); o.w = xi.w + g1.w * (a.w * sigmoidf_(gg.w));
                *(f32x4*)(XO + (size_t)t * D + j) = o;
            }
    }
}
__device__ __forceinline__ void phase_peer_wq(const Params& p, int layer, unsigned char* lds) {
    const bf16_t* HM = (const bf16_t*)(p.ws + WS_HM); const bf16_t* WT = (const bf16_t*)(p.ws + WS_WQ_T) + (size_t)layer * 2048 * 1024;
    bf16_t* QK = (bf16_t*)(p.ws + WS_QK);
    const int lane = threadIdx.x & 63, wid = threadIdx.x >> 6, wr = wid >> 1, wc = wid & 1, fr = lane & 15, fq = lane >> 4;
    for (int id = vblock(); id < 256 * 16; id += gridDim.x) {
        const int mt = id >> 4, nt = id & 15;
        f32x4 acc[4][4];
        gemm_tile3(ALoadPlain{HM + (size_t)mt * 128 * D, (size_t)D}, WT + (size_t)nt * 128 * D, D, 16, acc, lds);
#pragma unroll
        for (int mi = 0; mi < 4; ++mi)
#pragma unroll
            for (int ni = 0; ni < 4; ++ni) {
                const int t = mt * 128 + wr * 64 + mi * 16 + fr, c = nt * 128 + wc * 64 + ni * 16 + fq * 4;
                const f32x4 v = acc[mi][ni];
                *(u32x2*)(QK + (size_t)t * 2048 + c) = (u32x2){pk2(v.x, v.y), pk2(v.z, v.w)};
            }
    }
}
__device__ __forceinline__ void ce_(unsigned& a, unsigned& b, const bool up) { const unsigned lo = a < b ? a : b, hi = a < b ? b : a; a = up ? lo : hi; b = up ? hi : lo; }
__device__ __forceinline__ void bitonic_sort16(unsigned* x, const bool asc) {
#pragma unroll
    for (int k = 2; k <= 16; k <<= 1)
#pragma unroll
        for (int j = k >> 1; j > 0; j >>= 1)
#pragma unroll
            for (int i = 0; i < 16; ++i) { const int l = i ^ j; if (l > i) ce_(x[i], x[l], ((i & k) == 0) == asc); }
}
__device__ __forceinline__ void bitonic_merge16(unsigned* x, const bool asc) {
#pragma unroll
    for (int j = 8; j > 0; j >>= 1)
#pragma unroll
        for (int i = 0; i < 16; ++i) { const int l = i ^ j; if (l > i) ce_(x[i], x[l], asc); }
}
__device__ __forceinline__ void phase_peer_topk(const Params& p, int layer, unsigned char* lds) {
    const bf16_t* QK = (const bf16_t*)(p.ws + WS_QK); const bf16_t* SK = (const bf16_t*)(p.ws + WS_SUBK) + (size_t)layer * 8 * 2 * 128 * 128;
    float* TOPS = (float*)(p.ws + WS_TOPS); int* TOPI = (int*)(p.ws + WS_TOPI);
    float* sc = (float*)lds;
    const int tid = threadIdx.x, lane = tid & 63, wid = tid >> 6, wr = wid >> 1, wc = wid & 1, fr = lane & 15, fq = lane >> 4;
    for (int id = vblock(); id < 256 * 16; id += gridDim.x) {
        const int mt = id >> 4, hc = id & 15;
        f32x4 acc[4][4];
        gemm_tile3(ALoadPlain{QK + (size_t)mt * 128 * 2048 + hc * 128, (size_t)2048}, SK + (size_t)hc * 128 * 128, 128, 2, acc, lds);
#pragma unroll
        for (int mi = 0; mi < 4; ++mi)
#pragma unroll
            for (int ni = 0; ni < 4; ++ni) {
                const int r = wr * 64 + mi * 16 + fr, c = wc * 64 + ni * 16 + fq * 4;
                float* d = sc + r * 129 + c;
                d[0] = acc[mi][ni].x; d[1] = acc[mi][ni].y; d[2] = acc[mi][ni].z; d[3] = acc[mi][ni].w;
            }
        __syncthreads();
        {
            const int row = tid >> 1, half = tid & 1;
            unsigned x[64];
            const float* rp = sc + row * 129 + half * 64;
#pragma unroll
            for (int j = 0; j < 64; ++j) {
                const unsigned bits = __builtin_bit_cast(unsigned, rp[j]);
                const unsigned u = bits ^ ((unsigned)((int)bits >> 31) | 0x80000000u);
                x[j] = (u & 0xFFFFFF80u) | (unsigned)(127 - (half * 64 + j));
            }
            bitonic_sort16(x, true); bitonic_sort16(x + 16, false); bitonic_sort16(x + 32, true); bitonic_sort16(x + 48, false);
#pragma unroll
            for (int i = 0; i < 16; ++i) { x[i] = x[i] > x[16 + i] ? x[i] : x[16 + i]; x[32 + i] = x[32 + i] > x[48 + i] ? x[32 + i] : x[48 + i]; }
            bitonic_merge16(x, true); bitonic_merge16(x + 32, false);
#pragma unroll
            for (int i = 0; i < 16; ++i) x[i] = x[i] > x[32 + i] ? x[i] : x[32 + i];
            bitonic_merge16(x, false);
            unsigned y[16];
#pragma unroll
            for (int i = 0; i < 16; ++i) { const unsigned o = (unsigned)__shfl_xor((int)x[15 - i], 1); y[i] = x[i] > o ? x[i] : o; }
            bitonic_merge16(y, false);
            const size_t ob = ((size_t)(mt * 128 + row) * 16 + hc) * 16;
            if (half == 0) {
                float v[16];
#pragma unroll
                for (int i = 0; i < 16; ++i) { const unsigned u = y[i] & 0xFFFFFF80u; const unsigned bits = (u & 0x80000000u) ? (u ^ 0x80000000u) : ~u; v[i] = __builtin_bit_cast(float, bits); }
#pragma unroll
                for (int q = 0; q < 4; ++q) *(f32x4*)(TOPS + ob + q * 4) = (f32x4){v[q * 4], v[q * 4 + 1], v[q * 4 + 2], v[q * 4 + 3]};
            } else {
#pragma unroll
                for (int q = 0; q < 4; ++q) *(u32x4*)(TOPI + ob + q * 4) = (u32x4){127u - (y[q * 4] & 127u), 127u - (y[q * 4 + 1] & 127u), 127u - (y[q * 4 + 2] & 127u), 127u - (y[q * 4 + 3] & 127u)};
            }
        }
        __syncthreads();
    }
}
__device__ __forceinline__ void phase_peer_wq_topk(const Params& p, int layer, unsigned char* lds) {
    const bf16_t* HM = (const bf16_t*)(p.ws + WS_HM); const bf16_t* WT = (const bf16_t*)(p.ws + WS_WQ_T) + (size_t)layer * 2048 * 1024;
    const bf16_t* SK = (const bf16_t*)(p.ws + WS_SUBK) + (size_t)layer * 8 * 2 * 128 * 128;
    float* TOPS = (float*)(p.ws + WS_TOPS); int* TOPI = (int*)(p.ws + WS_TOPI);
    float* sc = (float*)lds;
    const int tid = threadIdx.x, lane = tid & 63, wid = tid >> 6, wr = wid >> 1, wc = wid & 1, fr = lane & 15, fq = lane >> 4;
    for (int id = vblock(); id < 256 * 16; id += gridDim.x) {
        const int mt = id >> 4, hc = id & 15;
        f32x4 acc[4][4];
        gemm_tile3(ALoadPlain{HM + (size_t)mt * 128 * D, (size_t)D}, WT + (size_t)hc * 128 * D, D, 16, acc, lds);
        {
            const int srow = wid * 32 + (lane >> 3), schunk = (lane & 7) ^ ((lane >> 3) & 7);
            const bf16_t* sk = SK + (size_t)hc * 128 * 128;
#pragma unroll
            for (int kt = 0; kt < 2; ++kt)
#pragma unroll
                for (int i = 0; i < 4; ++i)
                    __builtin_amdgcn_global_load_lds((const unsigned*)(sk + (srow + 8 * i) * 128 + kt * 64 + schunk * 8), (unsigned*)(lds + kt * 32768 + 16384 + wid * 4096 + i * 1024), 16, 0, 0);
        }
#pragma unroll
        for (int mi = 0; mi < 4; ++mi)
#pragma unroll
            for (int ni = 0; ni < 4; ++ni) {
                const int r = wr * 64 + mi * 16 + fr, chunk = ni * 2 + (fq >> 1);
                const f32x4 v = acc[mi][ni];
                *(u32x2*)(lds + wc * 32768 + r * 128 + ((chunk ^ (r & 7)) << 4) + (fq & 1) * 8) = (u32x2){pk2(v.x, v.y), pk2(v.z, v.w)};
            }
        __syncthreads();
#pragma unroll
        for (int mi = 0; mi < 4; ++mi)
#pragma unroll
            for (int ni = 0; ni < 4; ++ni) acc[mi][ni] = (f32x4){0.f, 0.f, 0.f, 0.f};
        mma_ktile(lds, acc); mma_ktile(lds + 32768, acc);
        __syncthreads();
#pragma unroll
        for (int mi = 0; mi < 4; ++mi)
#pragma unroll
            for (int ni = 0; ni < 4; ++ni) {
                const int r = wr * 64 + mi * 16 + fr, c = wc * 64 + ni * 16 + fq * 4;
                float* d = sc + r * 129 + c;
                d[0] = acc[mi][ni].x; d[1] = acc[mi][ni].y; d[2] = acc[mi][ni].z; d[3] = acc[mi][ni].w;
            }
        __syncthreads();
        {
            const int row = tid >> 1, half = tid & 1;
            unsigned x[64];
            const float* rp = sc + row * 129 + half * 64;
#pragma unroll
            for (int j = 0; j < 64; ++j) {
                const unsigned bits = __builtin_bit_cast(unsigned, rp[j]);
                const unsigned u = bits ^ ((unsigned)((int)bits >> 31) | 0x80000000u);
                x[j] = (u & 0xFFFFFF80u) | (unsigned)(127 - (half * 64 + j));
            }
            bitonic_sort16(x, true); bitonic_sort16(x + 16, false); bitonic_sort16(x + 32, true); bitonic_sort16(x + 48, false);
#pragma unroll
            for (int i = 0; i < 16; ++i) { x[i] = x[i] > x[16 + i] ? x[i] : x[16 + i]; x[32 + i] = x[32 + i] > x[48 + i] ? x[32 + i] : x[48 + i]; }
            bitonic_merge16(x, true); bitonic_merge16(x + 32, false);
#pragma unroll
            for (int i = 0; i < 16; ++i) x[i] = x[i] > x[32 + i] ? x[i] : x[32 + i];
            bitonic_merge16(x, false);
            unsigned y[16];
#pragma unroll
            for (int i = 0; i < 16; ++i) { const unsigned o = (unsigned)__shfl_xor((int)x[15 - i], 1); y[i] = x[i] > o ? x[i] : o; }
            bitonic_merge16(y, false);
            const size_t ob = ((size_t)(mt * 128 + row) * 16 + hc) * 16;
            if (half == 0) {
                float v[16];
#pragma unroll
                for (int i = 0; i < 16; ++i) { const unsigned u = y[i] & 0xFFFFFF80u; const unsigned bits = (u & 0x80000000u) ? (u ^ 0x80000000u) : ~u; v[i] = __builtin_bit_cast(float, bits); }
#pragma unroll
                for (int q = 0; q < 4; ++q) *(f32x4*)(TOPS + ob + q * 4) = (f32x4){v[q * 4], v[q * 4 + 1], v[q * 4 + 2], v[q * 4 + 3]};
            } else {
#pragma unroll
                for (int q = 0; q < 4; ++q) *(u32x4*)(TOPI + ob + q * 4) = (u32x4){127u - (y[q * 4] & 127u), 127u - (y[q * 4 + 1] & 127u), 127u - (y[q * 4 + 2] & 127u), 127u - (y[q * 4 + 3] & 127u)};
            }
        }
        __syncthreads();
    }
}
__device__ __forceinline__ void phase_peer_route(const Params& p, int layer, unsigned char* lds) {
    const bf16_t* HM = (const bf16_t*)(p.ws + WS_HM); const bf16_t* WT = (const bf16_t*)(p.ws + WS_WQ_T) + (size_t)layer * 2048 * 1024;
    const bf16_t* SK = (const bf16_t*)(p.ws + WS_SUBK) + (size_t)layer * 8 * 2 * 128 * 128;
    int* EXP = (int*)(p.ws + WS_EXP); float* GATE = (float*)(p.ws + WS_GATE);
    float* sc = (float*)lds;
    unsigned* KEYS0 = (unsigned*)(lds + 66048);
    unsigned* L = (unsigned*)lds;
    const int tid = threadIdx.x, lane = tid & 63, wid = tid >> 6, wr = wid >> 1, wc = wid & 1, fr = lane & 15, fq = lane >> 4;
    for (int id = vblock(); id < 256 * 8; id += gridDim.x) {
        const int mt = id >> 3, h = id & 7;
        const int row = tid >> 1, half = tid & 1;
        unsigned y[16];
#pragma unroll 1
        for (int c = 0; c < 2; ++c) {
            const int hc = h * 2 + c;
            f32x4 acc[4][4];
            gemm_tile3(ALoadPlain{HM + (size_t)mt * 128 * D, (size_t)D}, WT + (size_t)hc * 128 * D, D, 16, acc, lds);
            {
                const int srow = wid * 32 + (lane >> 3), schunk = (lane & 7) ^ ((lane >> 3) & 7);
                const bf16_t* sk = SK + (size_t)hc * 128 * 128;
#pragma unroll
                for (int kt = 0; kt < 2; ++kt)
#pragma unroll
                    for (int i = 0; i < 4; ++i)
                        __builtin_amdgcn_global_load_lds((const unsigned*)(sk + (srow + 8 * i) * 128 + kt * 64 + schunk * 8), (unsigned*)(lds + kt * 32768 + 16384 + wid * 4096 + i * 1024), 16, 0, 0);
            }
#pragma unroll
            for (int mi = 0; mi < 4; ++mi)
#pragma unroll
                for (int ni = 0; ni < 4; ++ni) {
                    const int r = wr * 64 + mi * 16 + fr, chunk = ni * 2 + (fq >> 1);
                    const f32x4 v = acc[mi][ni];
                    *(u32x2*)(lds + wc * 32768 + r * 128 + ((chunk ^ (r & 7)) << 4) + (fq & 1) * 8) = (u32x2){pk2(v.x, v.y), pk2(v.z, v.w)};
                }
            __syncthreads();
#pragma unroll
            for (int mi = 0; mi < 4; ++mi)
#pragma unroll
                for (int ni = 0; ni < 4; ++ni) acc[mi][ni] = (f32x4){0.f, 0.f, 0.f, 0.f};
            mma_ktile(lds, acc); mma_ktile(lds + 32768, acc);
            __syncthreads();
#pragma unroll
            for (int mi = 0; mi < 4; ++mi)
#pragma unroll
                for (int ni = 0; ni < 4; ++ni) {
                    const int r = wr * 64 + mi * 16 + fr, cc = wc * 64 + ni * 16 + fq * 4;
                    float* d = sc + r * 129 + cc;
                    d[0] = acc[mi][ni].x; d[1] = acc[mi][ni].y; d[2] = acc[mi][ni].z; d[3] = acc[mi][ni].w;
                }
            __syncthreads();
            {
                unsigned x[64];
                const float* rp = sc + row * 129 + half * 64;
#pragma unroll
                for (int j = 0; j < 64; ++j) {
                    const unsigned bits = __builtin_bit_cast(unsigned, rp[j]);
                    const unsigned u = bits ^ ((unsigned)((int)bits >> 31) | 0x80000000u);
                    x[j] = (u & 0xFFFFFF80u) | (unsigned)(127 - (half * 64 + j));
                }
                bitonic_sort16(x, true); bitonic_sort16(x + 16, false); bitonic_sort16(x + 32, true); bitonic_sort16(x + 48, false);
#pragma unroll
                for (int i = 0; i < 16; ++i) { x[i] = x[i] > x[16 + i] ? x[i] : x[16 + i]; x[32 + i] = x[32 + i] > x[48 + i] ? x[32 + i] : x[48 + i]; }
                bitonic_merge16(x, true); bitonic_merge16(x + 32, false);
#pragma unroll
                for (int i = 0; i < 16; ++i) x[i] = x[i] > x[32 + i] ? x[i] : x[32 + i];
                bitonic_merge16(x, false);
#pragma unroll
                for (int i = 0; i < 16; ++i) { const unsigned o = (unsigned)__shfl_xor((int)x[15 - i], 1); y[i] = x[i] > o ? x[i] : o; }
                bitonic_merge16(y, false);
            }
            if (c == 0 && half == 0) {
#pragma unroll
                for (int i = 0; i < 16; ++i) KEYS0[i * 128 + row] = y[i];
            }
            __syncthreads();
        }
        {
            unsigned kk[16];
#pragma unroll
            for (int i = 0; i < 16; ++i) kk[i] = half ? KEYS0[i * 128 + row] : y[i];
            const int sb = half ? 0 : 16, ib = half ? 32 : 48;
#pragma unroll
            for (int i = 0; i < 16; ++i) {
                const unsigned u = kk[i] & 0xFFFFFF80u; const unsigned bits = (u & 0x80000000u) ? (u ^ 0x80000000u) : ~u;
                L[(sb + i) * 128 + row] = bits; L[(ib + i) * 128 + row] = 127u - (kk[i] & 127u);
            }
        }
        __syncthreads();
        if (tid < 128) {
            const int col = tid;
            float val[16];
            const float s20 = __builtin_bit_cast(float, L[16 * 128 + col]);
#pragma unroll
            for (int a = 0; a < 16; ++a) val[a] = __builtin_bit_cast(float, L[a * 128 + col]) + s20;
            unsigned long long P = 0ull;
            float ts[16]; int te[16];
#pragma unroll
            for (int r = 0; r < 16; ++r) {
                float best = val[0]; int ba = 0;
#pragma unroll
                for (int a = 1; a < 16; ++a) if (val[a] > best) { best = val[a]; ba = a; }
                const int b = (int)((P >> (4 * ba)) & 15ull);
                const int i1 = (int)L[(32 + ba) * 128 + col], i2 = (int)L[(48 + b) * 128 + col];
                ts[r] = best; te[r] = i1 * 128 + i2;
                const int nb = b + 1;
                float newv = -3.0e38f;
                if (nb < 16) { newv = __builtin_bit_cast(float, L[ba * 128 + col]) + __builtin_bit_cast(float, L[(16 + nb) * 128 + col]); P += 1ull << (4 * ba); }
#pragma unroll
                for (int a = 0; a < 16; ++a) val[a] = (a == ba) ? newv : val[a];
            }
            const float m0 = ts[0];
            float sum = 0.f;
#pragma unroll
            for (int r = 0; r < 16; ++r) { ts[r] = __expf(ts[r] - m0); sum += ts[r]; }
            const float inv = 1.0f / sum;
            const size_t ob = ((size_t)(mt * 128 + col) * 8 + h) * 16;
#pragma unroll
            for (int q = 0; q < 4; ++q) {
                *(u32x4*)(EXP + ob + q * 4) = (u32x4){(unsigned)te[q * 4], (unsigned)te[q * 4 + 1], (unsigned)te[q * 4 + 2], (unsigned)te[q * 4 + 3]};
                *(f32x4*)(GATE + ob + q * 4) = (f32x4){ts[q * 4] * inv, ts[q * 4 + 1] * inv, ts[q * 4 + 2] * inv, ts[q * 4 + 3] * inv};
            }
        }
        __syncthreads();
    }
}
__device__ __forceinline__ void phase_peer_combine(const Params& p, unsigned char* lds) {
    const float* TOPS = (const float*)(p.ws + WS_TOPS); const int* TOPI = (const int*)(p.ws + WS_TOPI);
    int* EXP = (int*)(p.ws + WS_EXP); float* GATE = (float*)(p.ws + WS_GATE);
    unsigned* L = (unsigned*)lds;
    const int tid = threadIdx.x;
    for (int it = blockIdx.x; it < (T * 8) / 256; it += gridDim.x) {
        const size_t th = (size_t)it * 256 + tid;
        const u32x4* S4 = (const u32x4*)(TOPS + th * 32); const u32x4* I4 = (const u32x4*)(TOPI + th * 32);
#pragma unroll
        for (int a4 = 0; a4 < 8; ++a4) {
            const u32x4 s = S4[a4], i = I4[a4];
            L[(a4 * 4 + 0) * 256 + tid] = s.x; L[(a4 * 4 + 1) * 256 + tid] = s.y; L[(a4 * 4 + 2) * 256 + tid] = s.z; L[(a4 * 4 + 3) * 256 + tid] = s.w;
            L[(32 + a4 * 4 + 0) * 256 + tid] = i.x; L[(32 + a4 * 4 + 1) * 256 + tid] = i.y; L[(32 + a4 * 4 + 2) * 256 + tid] = i.z; L[(32 + a4 * 4 + 3) * 256 + tid] = i.w;
        }
        float val[16];
        const float s20 = __builtin_bit_cast(float, L[16 * 256 + tid]);
#pragma unroll
        for (int a = 0; a < 16; ++a) val[a] = __builtin_bit_cast(float, L[a * 256 + tid]) + s20;
        unsigned long long P = 0ull;
        float ts[16]; int te[16];
#pragma unroll
        for (int r = 0; r < 16; ++r) {
            float best = val[0]; int ba = 0;
#pragma unroll
            for (int a = 1; a < 16; ++a) if (val[a] > best) { best = val[a]; ba = a; }
            const int b = (int)((P >> (4 * ba)) & 15ull);
            const int i1 = (int)L[(32 + ba) * 256 + tid], i2 = (int)L[(48 + b) * 256 + tid];
            ts[r] = best; te[r] = i1 * 128 + i2;
            const int nb = b + 1;
            float newv = -3.0e38f;
            if (nb < 16) { newv = __builtin_bit_cast(float, L[ba * 256 + tid]) + __builtin_bit_cast(float, L[(16 + nb) * 256 + tid]); P += 1ull << (4 * ba); }
#pragma unroll
            for (int a = 0; a < 16; ++a) val[a] = (a == ba) ? newv : val[a];
        }
        const float m0 = ts[0];
        float sum = 0.f;
#pragma unroll
        for (int r = 0; r < 16; ++r) { ts[r] = __expf(ts[r] - m0); sum += ts[r]; }
        const float inv = 1.0f / sum;
#pragma unroll
        for (int r = 0; r < 16; ++r) ts[r] *= inv;
#pragma unroll
        for (int r = 0; r < 16; ++r) { EXP[th * 16 + r] = te[r]; GATE[th * 16 + r] = ts[r]; }
    }
}

__device__ __forceinline__ void fma8(const unsigned w0, const unsigned w1, const float a, float* acc) {
    const f32x2 p0 = __builtin_amdgcn_cvt_pk_f32_fp8((int)w0, false), p1 = __builtin_amdgcn_cvt_pk_f32_fp8((int)w0, true);
    const f32x2 p2 = __builtin_amdgcn_cvt_pk_f32_fp8((int)w1, false), p3 = __builtin_amdgcn_cvt_pk_f32_fp8((int)w1, true);
    acc[0] += a * p0.x; acc[1] += a * p0.y; acc[2] += a * p1.x; acc[3] += a * p1.y;
    acc[4] += a * p2.x; acc[5] += a * p2.y; acc[6] += a * p3.x; acc[7] += a * p3.y;
}
__device__ __forceinline__ float dot8(const unsigned w0, const unsigned w1, const float* h, float s) {
    const f32x2 p0 = __builtin_amdgcn_cvt_pk_f32_fp8((int)w0, false), p1 = __builtin_amdgcn_cvt_pk_f32_fp8((int)w0, true);
    const f32x2 p2 = __builtin_amdgcn_cvt_pk_f32_fp8((int)w1, false), p3 = __builtin_amdgcn_cvt_pk_f32_fp8((int)w1, true);
    s += p0.x * h[0]; s += p0.y * h[1]; s += p1.x * h[2]; s += p1.y * h[3];
    s += p2.x * h[4]; s += p2.y * h[5]; s += p3.x * h[6]; s += p3.y * h[7];
    return s;
}
__device__ __forceinline__ void phase_peer_apply(const Params& p, int layer, unsigned char* lds, bool dry) {
    const int lane = threadIdx.x & 63, wave = threadIdx.x >> 6;
    float* ldsw = (float*)lds + wave * (64 * 65);
    const bf16_t* HM = (const bf16_t*)(p.ws + WS_HM);
    const unsigned char* PU = p.ws + WS_PU; const unsigned char* PV = p.ws + WS_PV;
    const float* SU = (const float*)(p.ws + WS_PU + 24 * MiB); const float* SV = (const float*)(p.ws + WS_PV + 24 * MiB);
    const int* EXP = (const int*)(p.ws + WS_EXP); const float* GATE = (const float*)(p.ws + WS_GATE);
    const float* MOD = (const float*)(p.ws + WS_MOD);
    float* X = p.out;
    for (int t = blockIdx.x * 4 + wave; t < T; t += gridDim.x * 4) {
        const u32x4 ha = *(const u32x4*)(HM + (size_t)t * D + lane * 16), hb = *(const u32x4*)(HM + (size_t)t * D + lane * 16 + 8);
        float hf[16];
        hf[0] = bflo(ha.x); hf[1] = bfhi(ha.x); hf[2] = bflo(ha.y); hf[3] = bfhi(ha.y); hf[4] = bflo(ha.z); hf[5] = bfhi(ha.z); hf[6] = bflo(ha.w); hf[7] = bfhi(ha.w);
        hf[8] = bflo(hb.x); hf[9] = bfhi(hb.x); hf[10] = bflo(hb.y); hf[11] = bfhi(hb.y); hf[12] = bflo(hb.z); hf[13] = bfhi(hb.z); hf[14] = bflo(hb.w); hf[15] = bfhi(hb.w);
        const int e0_ = EXP[(size_t)t * 128 + lane], e1_ = EXP[(size_t)t * 128 + 64 + lane];
        const float g0 = GATE[(size_t)t * 128 + lane], g1 = GATE[(size_t)t * 128 + 64 + lane];
        const float su0 = SU[e0_], su1 = SU[e1_], sv0 = SV[e0_], sv1 = SV[e1_];
        u32x4 buf[16];
        float act0 = 0.f, act1 = 0.f;
        float acc[16];
#pragma unroll
        for (int i = 0; i < 16; ++i) acc[i] = 0.f;
#ifndef APPLY_L2PROBE
#define APPLY_L2PROBE 0
#endif
        for (int prep_ = 0; prep_ < 1 + APPLY_L2PROBE; ++prep_) {
        const int emask = (APPLY_L2PROBE && prep_ == 0) ? 2047 : 0x7fffffff;
        const int e0 = e0_ & emask, e1 = e1_ & emask;
#pragma unroll
        for (int j = 0; j < 16; ++j) { const int e_ = __builtin_amdgcn_readlane(e0, j); buf[j] = *(const u32x4*)(PU + (size_t)e_ * D + lane * 16); }
#pragma unroll
        for (int bt = 0; bt < 16; ++bt) {
#pragma unroll
            for (int j = 0; j < 16; ++j) {
                if (bt < 8) {
                    float s_ = dot8(buf[j].x, buf[j].y, hf, 0.f); s_ = dot8(buf[j].z, buf[j].w, hf + 8, s_);
                    ldsw[((bt & 3) * 16 + j) * 65 + lane] = s_;
                } else {
                    const float av_ = ((bt & 7) < 4) ? act0 : act1;
                    const float a_ = __builtin_bit_cast(float, __builtin_amdgcn_readlane(__builtin_bit_cast(int, av_), (bt & 3) * 16 + j));
                    fma8(buf[j].x, buf[j].y, a_, acc); fma8(buf[j].z, buf[j].w, a_, acc + 8);
                }
                if (bt + 1 < 16) {
                    const int nb = bt + 1;
                    const int e_ = __builtin_amdgcn_readlane(((nb & 7) < 4) ? e0 : e1, (nb & 3) * 16 + j);
                    buf[j] = *(const u32x4*)(((nb < 8) ? PU : PV) + (size_t)e_ * D + lane * 16);
                }
            }
            if (bt == 3 || bt == 7) {
                float tot_ = 0.f;
#pragma unroll 16
                for (int q = 0; q < 64; ++q) tot_ += ldsw[lane * 65 + q];
                if (bt == 3) act0 = gelu_tanh(tot_ * su0) * g0 * sv0; else act1 = gelu_tanh(tot_ * su1) * g1 * sv1;
            }
        }
        if (APPLY_L2PROBE && prep_ == 0 && p.ph_hi >= 0) {
#pragma unroll
            for (int i = 0; i < 16; ++i) acc[i] = 0.f;
        }
        }
        const int b = t / SEQ;
        const float* g2 = MOD + (size_t)(layer * 2 + b) * 6144 + 5120;
        float* xr = X + (size_t)t * D + lane * 16;
        f32x4 xs[4]; float ss = 0.f;
#pragma unroll
        for (int q = 0; q < 4; ++q) {
            const f32x4 g = *(const f32x4*)(g2 + lane * 16 + q * 4); f32x4 x = *(const f32x4*)(xr + q * 4);
            x.x += g.x * acc[q * 4 + 0]; x.y += g.y * acc[q * 4 + 1]; x.z += g.z * acc[q * 4 + 2]; x.w += g.w * acc[q * 4 + 3];
            xs[q] = x; ss += (x.x * x.x + x.y * x.y) + (x.z * x.z + x.w * x.w);
        }
        const float rs = rsqrtf(wave_sum(ss) * (1.0f / D) + RMS_EPS);
        if (!dry) {
            if (layer == 0) {
                const float* gw = p.in[2] + D + lane * 16; const float* sh = MOD + (size_t)(2 + b) * 6144 + lane * 16; const float* sc = sh + 1024;
                u32x4 o[2];
#pragma unroll
                for (int q = 0; q < 4; ++q) {
                    *(f32x4*)(xr + q * 4) = xs[q];
                    const f32x4 g = *(const f32x4*)(gw + q * 4), s1 = *(const f32x4*)(sc + q * 4), s0 = *(const f32x4*)(sh + q * 4);
                    const float y0 = xs[q].x * rs * g.x * (1.f + s1.x) + s0.x, y1 = xs[q].y * rs * g.y * (1.f + s1.y) + s0.y;
                    const float y2 = xs[q].z * rs * g.z * (1.f + s1.z) + s0.z, y3 = xs[q].w * rs * g.w * (1.f + s1.w) + s0.w;
                    if (q & 1) { o[q >> 1].z = pk2(y0, y1); o[q >> 1].w = pk2(y2, y3); } else { o[q >> 1].x = pk2(y0, y1); o[q >> 1].y = pk2(y2, y3); }
                }
                bf16_t* hm = (bf16_t*)(p.ws + WS_HM) + (size_t)t * D + lane * 16;
                *(u32x4*)hm = o[0]; *(u32x4*)(hm + 8) = o[1];
            } else {
                const float* gw = p.in[28] + lane * 16;
#pragma unroll
                for (int q = 0; q < 4; ++q) {
                    const f32x4 g = *(const f32x4*)(gw + q * 4);
                    *(f32x4*)(xr + q * 4) = (f32x4){xs[q].x * rs * g.x, xs[q].y * rs * g.y, xs[q].z * rs * g.z, xs[q].w * rs * g.w};
                }
            }
        }
    }
}

__device__ __forceinline__ void phase_peer_apply6(const Params& p, int layer, unsigned char* lds, bool dry) {
    const int lane = threadIdx.x & 63, wave = threadIdx.x >> 6, half = lane >> 5, gl = lane & 31;
    float* ldsw = (float*)lds + wave * (64 * 33);
    const bf16_t* HM = (const bf16_t*)(p.ws + WS_HM);
    const unsigned char* PU = p.ws + WS_PU; const unsigned char* PV = p.ws + WS_PV;
    const float* SU = (const float*)(p.ws + WS_PU + 24 * MiB); const float* SV = (const float*)(p.ws + WS_PV + 24 * MiB);
    const int* EXP = (const int*)(p.ws + WS_EXP); const float* GATE = (const float*)(p.ws + WS_GATE);
    const float* MOD = (const float*)(p.ws + WS_MOD);
    float* X = p.out;
    for (int t = blockIdx.x * 4 + wave; t < T; t += gridDim.x * 4) {
        float hf[32];
        {
            const u32x4* hp = (const u32x4*)(HM + (size_t)t * D + gl * 32);
#pragma unroll
            for (int q = 0; q < 4; ++q) { const u32x4 w = hp[q];
                hf[q * 8 + 0] = bflo(w.x); hf[q * 8 + 1] = bfhi(w.x); hf[q * 8 + 2] = bflo(w.y); hf[q * 8 + 3] = bfhi(w.y);
                hf[q * 8 + 4] = bflo(w.z); hf[q * 8 + 5] = bfhi(w.z); hf[q * 8 + 6] = bflo(w.w); hf[q * 8 + 7] = bfhi(w.w); }
        }
        const int e0 = EXP[(size_t)t * 128 + lane], e1 = EXP[(size_t)t * 128 + 64 + lane];
        const float g0 = GATE[(size_t)t * 128 + lane], g1 = GATE[(size_t)t * 128 + 64 + lane];
        const float su0 = SU[e0], su1 = SU[e1], sv0 = SV[e0], sv1 = SV[e1];
        u32x2 buf[8][3];
        float act0 = 0.f, act1 = 0.f;
        float acc[32];
#pragma unroll
        for (int i = 0; i < 32; ++i) acc[i] = 0.f;
#define A6_LOAD(slot, nb) do { const int es_ = (((nb) & 7) < 4) ? e0 : e1; const int ia_ = ((nb) & 3) * 16 + 2 * (slot); \
            const int ea_ = __builtin_amdgcn_readlane(es_, ia_), eb_ = __builtin_amdgcn_readlane(es_, ia_ + 1); const int e_ = half ? eb_ : ea_; \
            const u32x2* rp_ = (const u32x2*)((((nb) < 8) ? PU : PV) + (size_t)e_ * 768 + gl * 24); buf[slot][0] = rp_[0]; buf[slot][1] = rp_[1]; buf[slot][2] = rp_[2]; } while (0)
#pragma unroll
        for (int j = 0; j < 8; ++j) A6_LOAD(j, 0);
#pragma unroll 1
        for (int bt = 0; bt < 8; ++bt) {
#pragma unroll
            for (int j = 0; j < 8; ++j) {
                v6u w; w[0] = buf[j][0].x; w[1] = buf[j][0].y; w[2] = buf[j][1].x; w[3] = buf[j][1].y; w[4] = buf[j][2].x; w[5] = buf[j][2].y;
                const v32f y = __builtin_amdgcn_cvt_scalef32_pk32_f32_fp6(w, 1.0f);
                float s0_ = 0.f, s1_ = 0.f;
#pragma unroll
                for (int i = 0; i < 16; ++i) { s0_ += y[i] * hf[i]; s1_ += y[16 + i] * hf[16 + i]; }
                ldsw[(((bt & 3) * 16 + 2 * j) + half) * 33 + gl] = s0_ + s1_;
                A6_LOAD(j, bt + 1);
            }
            if (bt == 3 || bt == 7) {
                float tot_ = 0.f;
#pragma unroll
                for (int q = 0; q < 32; ++q) tot_ += ldsw[lane * 33 + q];
                if (bt == 3) act0 = gelu_tanh(tot_ * su0) * g0 * sv0; else act1 = gelu_tanh(tot_ * su1) * g1 * sv1;
            }
        }
#pragma unroll 1
        for (int bt = 8; bt < 16; ++bt) {
            const float av_ = (bt < 12) ? act0 : act1;
#pragma unroll
            for (int j = 0; j < 8; ++j) {
                v6u w; w[0] = buf[j][0].x; w[1] = buf[j][0].y; w[2] = buf[j][1].x; w[3] = buf[j][1].y; w[4] = buf[j][2].x; w[5] = buf[j][2].y;
                const v32f y = __builtin_amdgcn_cvt_scalef32_pk32_f32_fp6(w, 1.0f);
                const int ia_ = (bt & 3) * 16 + 2 * j;
                const float aa_ = __builtin_bit_cast(float, __builtin_amdgcn_readlane(__builtin_bit_cast(int, av_), ia_));
                const float ab_ = __builtin_bit_cast(float, __builtin_amdgcn_readlane(__builtin_bit_cast(int, av_), ia_ + 1));
                const float a_ = half ? ab_ : aa_;
#pragma unroll
                for (int i = 0; i < 32; ++i) acc[i] += a_ * y[i];
                if (bt + 1 < 16) A6_LOAD(j, bt + 1);
            }
        }
#undef A6_LOAD
#pragma unroll
        for (int i = 0; i < 32; ++i) acc[i] += __shfl_xor(acc[i], 32);
        const int b = t / SEQ;
        const float* g2 = MOD + (size_t)(layer * 2 + b) * 6144 + 5120 + gl * 32;
        float* xr = X + (size_t)t * D + gl * 32;
        f32x4 xs[8]; float ss = 0.f;
#pragma unroll
        for (int q = 0; q < 8; ++q) {
            const f32x4 g = *(const f32x4*)(g2 + q * 4); f32x4 x = *(const f32x4*)(xr + q * 4);
            x.x += g.x * acc[q * 4 + 0]; x.y += g.y * acc[q * 4 + 1]; x.z += g.z * acc[q * 4 + 2]; x.w += g.w * acc[q * 4 + 3];
            xs[q] = x; if (half == 0) ss += (x.x * x.x + x.y * x.y) + (x.z * x.z + x.w * x.w);
        }
        const float rs = rsqrtf(wave_sum(ss) * (1.0f / D) + RMS_EPS);
        if (!dry && half == 0) {
            if (layer == 0) {
                const float* gw = p.in[2] + D + gl * 32; const float* sh = MOD + (size_t)(2 + b) * 6144 + gl * 32; const float* sc = sh + 1024;
                bf16_t* hm = (bf16_t*)(p.ws + WS_HM) + (size_t)t * D + gl * 32;
#pragma unroll
                for (int q2 = 0; q2 < 4; ++q2) {
                    u32x4 o;
#pragma unroll
                    for (int hq = 0; hq < 2; ++hq) {
                        const int q = q2 * 2 + hq;
                        *(f32x4*)(xr + q * 4) = xs[q];
                        const f32x4 g = *(const f32x4*)(gw + q * 4), s1 = *(const f32x4*)(sc + q * 4), s0 = *(const f32x4*)(sh + q * 4);
                        const float y0 = xs[q].x * rs * g.x * (1.f + s1.x) + s0.x, y1 = xs[q].y * rs * g.y * (1.f + s1.y) + s0.y;
                        const float y2 = xs[q].z * rs * g.z * (1.f + s1.z) + s0.z, y3 = xs[q].w * rs * g.w * (1.f + s1.w) + s0.w;
                        if (hq) { o.z = pk2(y0, y1); o.w = pk2(y2, y3); } else { o.x = pk2(y0, y1); o.y = pk2(y2, y3); }
                    }
                    *(u32x4*)(hm + q2 * 8) = o;
                }
            } else {
                const float* gw = p.in[28] + gl * 32;
#pragma unroll
                for (int q = 0; q < 8; ++q) {
                    const f32x4 g = *(const f32x4*)(gw + q * 4);
                    *(f32x4*)(xr + q * 4) = (f32x4){xs[q].x * rs * g.x, xs[q].y * rs * g.y, xs[q].z * rs * g.z, xs[q].w * rs * g.w};
                }
            }
        }
    }
}
__device__ __forceinline__ void phase_tab1(const Params& p) {
    const int first = vblock() - 256, stride = (int)gridDim.x - 256;
    if (first < 0 || stride <= 0) {
        if (stride <= 0) { for (int it = blockIdx.x; it < 2 * P0_TAB; it += gridDim.x) {
            if (it < P0_TAB) cvt_fp6_item(p.in[26] + (size_t)PE * D, p.ws + WS_PU, (float*)(p.ws + WS_PU + 24 * MiB), it);
            else cvt_fp6_item(p.in[27] + (size_t)PE * D, p.ws + WS_PV, (float*)(p.ws + WS_PV + 24 * MiB), it - P0_TAB); } }
        return;
    }
    for (int it = first; it < 2 * P0_TAB; it += stride) {
        if (it < P0_TAB) cvt_fp6_item(p.in[26] + (size_t)PE * D, p.ws + WS_PU, (float*)(p.ws + WS_PU + 24 * MiB), it);
        else cvt_fp6_item(p.in[27] + (size_t)PE * D, p.ws + WS_PV, (float*)(p.ws + WS_PV + 24 * MiB), it - P0_TAB);
    }
}
__device__ __forceinline__ void phase_nsa_proj(const Params& p, unsigned char* lds) {
    const bf16_t* HM = (const bf16_t*)(p.ws + WS_HM); const bf16_t* WT = (const bf16_t*)(p.ws + WS_WPROJ_T);
    const f32x2* ROPE = (const f32x2*)(p.ws + WS_ROPE);
    bf16_t* Q = (bf16_t*)(p.ws + WS_Q); float* NGT = (float*)(p.ws + WS_NG);
    const int lane = threadIdx.x & 63, wid = threadIdx.x >> 6, wr = wid >> 1, wc = wid & 1, fr = lane & 15, fq = lane >> 4;
    for (int id = vblock(); id < 256 * 21; id += gridDim.x) {
        const int mt = id / 21, nt = id % 21;
        f32x4 acc[4][4];
        gemm_tile3(ALoadPlain{HM + (size_t)mt * 128 * D, (size_t)D}, WT + (size_t)nt * 128 * D, D, 16, acc, lds);
        const int c0 = nt * 128 + wc * 64;
        if (c0 >= 2624) continue;
        const int b = (mt * 128) / SEQ;
        if (c0 == 2560) {
#pragma unroll
            for (int mi = 0; mi < 4; ++mi)
#pragma unroll
                for (int ni = 0; ni < 3; ++ni) {
                    const int t = mt * 128 + wr * 64 + mi * 16 + fr;
                    const f32x4 v = acc[mi][ni];
                    *(f32x4*)(NGT + (size_t)t * 48 + ni * 16 + fq * 4) = (f32x4){sigmoidf_(v.x), sigmoidf_(v.y), sigmoidf_(v.z), sigmoidf_(v.w)};
                }
            continue;
        }
        int sec = -1, g = 0;
        if (c0 >= 1024) { sec = (c0 - 1024) >> 8; g = ((c0 - 1024) & 255) >> 6; }
        const bool dorope = (sec == -1) || (sec == 2) || (sec == 4);
        const float scl = (sec == -1) ? 0.125f : 1.0f;
        const size_t secoff[6] = {WS_KC, WS_VC, WS_KS, WS_VST, WS_KW, WS_VWT};
        size_t so = WS_Q;
#pragma unroll
        for (int q = 0; q < 6; ++q) if (sec == q) so = secoff[q];
        bf16_t* OUT = (bf16_t*)(p.ws + so);
        const bool vt = (sec == 3) || (sec == 5);
        float kblk_am = 0.f;
#pragma unroll
        for (int pass = 0; pass < 2; ++pass) {
        if (pass == 1 && sec == 2) {
#pragma unroll
            for (int o = 1; o < 64; o <<= 1) kblk_am = fmaxf(kblk_am, __shfl_xor(kblk_am, o));
            if (lane == 0) ((float*)(p.ws + WS_KS + 12 * MiB))[(size_t)(b * 4 + g) * 256 + ((mt * 128 + wr * 64 - b * SEQ) >> 6)] = kblk_am > 0.f ? kblk_am / 224.0f : 1.0f;
        }
#pragma unroll
        for (int mi = 0; mi < 4; ++mi) {
            const int t = mt * 128 + wr * 64 + mi * 16 + fr, s = t - b * SEQ;
            if (dorope && pass == 0) {
#pragma unroll
                for (int ni = 0; ni < 2; ++ni) {
                    const f32x4* rp = (const f32x4*)(ROPE + (size_t)s * 32 + ni * 16 + fq * 4);
                    const f32x4 r0 = rp[0], r1 = rp[1];
                    const f32x4 x1 = acc[mi][ni], x2 = acc[mi][ni + 2];
                    acc[mi][ni] = (f32x4){x1.x * r0.x - x2.x * r0.y, x1.y * r0.z - x2.y * r0.w, x1.z * r1.x - x2.z * r1.y, x1.w * r1.z - x2.w * r1.w};
                    acc[mi][ni + 2] = (f32x4){x1.x * r0.y + x2.x * r0.x, x1.y * r0.w + x2.y * r0.z, x1.z * r1.y + x2.z * r1.x, x1.w * r1.w + x2.w * r1.z};
                }
            }
            if (pass == 0) {
                if (sec == 2) {
#pragma unroll
                    for (int ni = 0; ni < 4; ++ni) { const f32x4 v = acc[mi][ni]; kblk_am = fmaxf(kblk_am, fmaxf(fmaxf(fabsf(v.x), fabsf(v.y)), fmaxf(fabsf(v.z), fabsf(v.w)))); }
                }
                continue;
            }
            if (sec == -1 || sec == 2) {
                float am = kblk_am;
                if (sec == -1) {
                    am = 0.f;
#pragma unroll
                    for (int ni = 0; ni < 4; ++ni) { const f32x4 v = acc[mi][ni] * scl; am = fmaxf(am, fmaxf(fmaxf(fabsf(v.x), fabsf(v.y)), fmaxf(fabsf(v.z), fabsf(v.w)))); }
                    am = fmaxf(am, __shfl_xor(am, 16)); am = fmaxf(am, __shfl_xor(am, 32));
                }
                const float qs = am > 0.f ? 224.0f / am : 1.0f;
                unsigned char* O8 = (sec == -1) ? (p.ws + WS_Q8 + (size_t)t * 1024 + c0) : (p.ws + WS_KS + ((size_t)(b * 4 + g) * SEQ + s) * 64);
#pragma unroll
                for (int ni = 0; ni < 4; ++ni) {
                    const f32x4 v = acc[mi][ni] * (scl * qs);
                    int w = 0; w = __builtin_amdgcn_cvt_pk_fp8_f32(v.x, v.y, w, false); w = __builtin_amdgcn_cvt_pk_fp8_f32(v.z, v.w, w, true);
                    *(int*)(O8 + ni * 16 + fq * 4) = w;
                }
                if (fq == 0 && sec == -1) ((float*)(p.ws + WS_Q8 + 32 * MiB))[(size_t)t * 16 + (c0 >> 6)] = am > 0.f ? am / 224.0f : 1.0f;
            }
            if (sec == 2) continue;
#pragma unroll
            for (int ni = 0; ni < 4; ++ni) {
                const f32x4 v = acc[mi][ni] * scl;
                const int d = ni * 16 + fq * 4;
                if (sec == -1) {
                    *(u32x2*)(OUT + (size_t)t * 1024 + c0 + d) = (u32x2){pk2(v.x, v.y), pk2(v.z, v.w)};
                } else if (sec == 4) {
                    const size_t idx = (size_t)(b * 4 + g) * SEQ * 64 + (size_t)(s >> 5) * 2048 + ((((s >> 4) & 1) * 2 + (ni >> 1)) * 16 + (s & 15)) * 32 + ((ni & 1) * 2 + (fq >> 1)) * 8 + (fq & 1) * 4;
                    *(u32x2*)(OUT + idx) = (u32x2){pk2(v.x, v.y), pk2(v.z, v.w)};
                } else if (!vt) {
                    *(u32x2*)(OUT + ((size_t)(b * 4 + g) * SEQ + s) * 64 + d) = (u32x2){pk2(v.x, v.y), pk2(v.z, v.w)};
                } else if (sec == 5) {
                    const int key = s & 31;
                    bf16_t* o = OUT + (size_t)(b * 4 + g) * SEQ * 64 + (size_t)(s >> 5) * 2048 + ((ni * 2 + (key >> 4)) * 16 + fq * 4) * 16 + ((key >> 2) & 3) * 4 + (key & 3);
                    o[0] = (bf16_t)f2bf(v.x); o[16] = (bf16_t)f2bf(v.y); o[32] = (bf16_t)f2bf(v.z); o[48] = (bf16_t)f2bf(v.w);
                }
            }
        }
        }
        if (sec == 3) {
            const int s0 = mt * 128 + wr * 64 - b * SEQ, jb = s0 >> 6;
            unsigned char* V8 = p.ws + WS_VST + (size_t)((b * 4 + g) * 256 + jb) * 4096;
            float am = 0.f;
#pragma unroll
            for (int mi = 0; mi < 4; ++mi)
#pragma unroll
                for (int ni = 0; ni < 4; ++ni) { const f32x4 v = acc[mi][ni]; am = fmaxf(am, fmaxf(fmaxf(fabsf(v.x), fabsf(v.y)), fmaxf(fabsf(v.z), fabsf(v.w)))); }
#pragma unroll
            for (int o = 1; o < 64; o <<= 1) am = fmaxf(am, __shfl_xor(am, o));
            const float qs = am > 0.f ? 224.0f / am : 1.0f;
            if (lane == 0) ((float*)(p.ws + WS_VST + 12 * MiB))[(size_t)(b * 4 + g) * 256 + jb] = am > 0.f ? am / 224.0f : 1.0f;
#pragma unroll
            for (int ni = 0; ni < 4; ++ni) {
                const int d = ni * 16 + fq * 4;
#pragma unroll
                for (int mi = 0; mi < 4; ++mi) {
                    const f32x4 v = acc[mi][ni] * qs;
                    int w = 0; w = __builtin_amdgcn_cvt_pk_fp8_f32(v.x, v.y, w, false); w = __builtin_amdgcn_cvt_pk_fp8_f32(v.z, v.w, w, true);
                    unsigned char* o = V8 + (size_t)d * 64 + mi * 16 + fr;
                    o[0] = (unsigned char)(w & 255); o[64] = (unsigned char)((w >> 8) & 255); o[128] = (unsigned char)((w >> 16) & 255); o[192] = (unsigned char)((unsigned)w >> 24);
                }
            }
        }
    }
}
__device__ __forceinline__ void phase_nsa_cmp1(const Params& p, unsigned char* lds) {
    bf16_t* HID = (bf16_t*)(p.ws + WS_HID);
    const float* bias = (const float*)(p.ws + WS_MISC);
    const int lane = threadIdx.x & 63, wid = threadIdx.x >> 6, wr = wid >> 1, wc = wid & 1, fr = lane & 15, fq = lane >> 4;
    for (int id = vblock(); id < 256; id += gridDim.x) {
        const int kv = id >> 7, bg = (id >> 4) & 7, mt = (id >> 1) & 7, nt = id & 1;
        const bf16_t* A = (const bf16_t*)(p.ws + (kv ? WS_VC : WS_KC)) + (size_t)bg * SEQ * 64 + (size_t)mt * 128 * 1024;
        const bf16_t* B = (const bf16_t*)(p.ws + (kv ? WS_WV1_T : WS_WK1_T)) + (size_t)nt * 128 * 2048;
        f32x4 acc[4][4];
        gemm_tile3(ALoadPlain{A, (size_t)1024}, B, 2048, 32, acc, lds);
#pragma unroll
        for (int mi = 0; mi < 4; ++mi)
#pragma unroll
            for (int ni = 0; ni < 4; ++ni) {
                const int n = mt * 128 + wr * 64 + mi * 16 + fr, c = nt * 128 + wc * 64 + ni * 16 + fq * 4;
                const f32x4 bv = *(const f32x4*)(bias + kv * 256 + c);
                const f32x4 v = acc[mi][ni] + bv;
                *(u32x2*)(HID + (((size_t)kv * 8 + bg) * 1024 + n) * 256 + c) = (u32x2){pk2(gelu_tanh(v.x), gelu_tanh(v.y)), pk2(gelu_tanh(v.z), gelu_tanh(v.w))};
            }
    }
}
__device__ __forceinline__ void phase_nsa_cmp2(const Params& p, unsigned char* lds) {
    const bf16_t* HID = (const bf16_t*)(p.ws + WS_HID);
    const f32x2* ROPE = (const f32x2*)(p.ws + WS_ROPE);
    bf16_t* KCMP = (bf16_t*)(p.ws + WS_KCMP); bf16_t* VCMPT = (bf16_t*)(p.ws + WS_VCMPT);
    const int lane = threadIdx.x & 63, wid = threadIdx.x >> 6, wr = wid >> 1, wc = wid & 1, fr = lane & 15, fq = lane >> 4;
    for (int id = vblock(); id < 128; id += gridDim.x) {
        const int kv = id >> 6, mt = id & 63;
        const bf16_t* A = HID + ((size_t)kv * 8192 + (size_t)mt * 128) * 256;
        const bf16_t* B = (const bf16_t*)(p.ws + (kv ? WS_WV2_T : WS_WK2_T));
        f32x4 acc[4][4];
        gemm_tile3(ALoadPlain{A, (size_t)256}, B, 256, 4, acc, lds);
        if (wc == 1) continue;
#pragma unroll
        for (int mi = 0; mi < 4; ++mi) {
            const int R = mt * 128 + wr * 64 + mi * 16 + fr, bg = R >> 10, n = R & 1023;
            if (kv == 0) {
                int pos = n * 16 + 31; pos = pos > SEQ - 1 ? SEQ - 1 : pos;
#pragma unroll
                for (int ni = 0; ni < 2; ++ni) {
                    const f32x4* rp = (const f32x4*)(ROPE + (size_t)pos * 32 + ni * 16 + fq * 4);
                    const f32x4 r0 = rp[0], r1 = rp[1];
                    const f32x4 x1 = acc[mi][ni], x2 = acc[mi][ni + 2];
                    acc[mi][ni] = (f32x4){x1.x * r0.x - x2.x * r0.y, x1.y * r0.z - x2.y * r0.w, x1.z * r1.x - x2.z * r1.y, x1.w * r1.z - x2.w * r1.w};
                    acc[mi][ni + 2] = (f32x4){x1.x * r0.y + x2.x * r0.x, x1.y * r0.w + x2.y * r0.z, x1.z * r1.y + x2.z * r1.x, x1.w * r1.w + x2.w * r1.z};
                }
#pragma unroll
                for (int ni = 0; ni < 4; ++ni) {
                    const f32x4 v = acc[mi][ni];
                    const size_t idx = (size_t)bg * 1024 * 64 + (size_t)(n >> 5) * 2048 + ((((n >> 4) & 1) * 2 + (ni >> 1)) * 16 + (n & 15)) * 32 + ((ni & 1) * 2 + (fq >> 1)) * 8 + (fq & 1) * 4;
                    *(u32x2*)(KCMP + idx) = (u32x2){pk2(v.x, v.y), pk2(v.z, v.w)};
                }
            } else {
#pragma unroll
                for (int ni = 0; ni < 4; ++ni) {
                    const f32x4 v = acc[mi][ni];
                    const int key = n & 31;
                    bf16_t* o = VCMPT + (size_t)bg * 1024 * 64 + (size_t)(n >> 5) * 2048 + ((ni * 2 + (key >> 4)) * 16 + fq * 4) * 16 + ((key >> 2) & 3) * 4 + (key & 3);
                    o[0] = (bf16_t)f2bf(v.x); o[16] = (bf16_t)f2bf(v.y); o[32] = (bf16_t)f2bf(v.z); o[48] = (bf16_t)f2bf(v.w);
                }
            }
        }
    }
}
__device__ __forceinline__ void phase_nsa_wo(const Params& p, unsigned char* lds, bool dry) {
    const bf16_t* O = (const bf16_t*)(p.ws + WS_O); const bf16_t* WT = (const bf16_t*)(p.ws + WS_WO_T);
    const float* MOD = (const float*)(p.ws + WS_MOD);
    float* X = p.out;
    const int lane = threadIdx.x & 63, wid = threadIdx.x >> 6, wr = wid >> 1, wc = wid & 1, fr = lane & 15, fq = lane >> 4;
    for (int id = vblock(); id < 256 * 8; id += gridDim.x) {
        const int mt = id >> 3, nt = id & 7;
        f32x4 acc[4][4];
        gemm_tile3(ALoadPlain{O + (size_t)mt * 128 * D, (size_t)D}, WT + (size_t)nt * 128 * D, D, 16, acc, lds);
        const int b = (mt * 128) / SEQ;
#pragma unroll
        for (int mi = 0; mi < 4; ++mi)
#pragma unroll
            for (int ni = 0; ni < 4; ++ni) {
                const int t = mt * 128 + wr * 64 + mi * 16 + fr, c = nt * 128 + wc * 64 + ni * 16 + fq * 4;
                const f32x4 g1 = *(const f32x4*)(MOD + (size_t)(1 * 2 + b) * 6144 + 2048 + c);
                float* xp = X + (size_t)t * D + c;
                const f32x4 x = *(const f32x4*)xp; const f32x4 v = acc[mi][ni];
                if (!dry) *(f32x4*)xp = (f32x4){x.x + g1.x * v.x, x.y + g1.y * v.y, x.z + g1.z * v.z, x.w + g1.w * v.w};
            }
    }
}
__device__ __forceinline__ bf16x8 pack8(const f32x4 a, const f32x4 b) {
    u32x4 w; w.x = pk2(a.x, a.y); w.y = pk2(a.z, a.w); w.z = pk2(b.x, b.y); w.w = pk2(b.z, b.w);
    return __builtin_bit_cast(bf16x8, w);
}
__device__ __forceinline__ bf16x8 ldv8(const bf16_t* plo, const bf16_t* phi) {
    const u32x2 lo = *(const u32x2*)plo, hi = *(const u32x2*)phi;
    u32x4 w; w.x = lo.x; w.y = lo.y; w.z = hi.x; w.w = hi.y;
    return __builtin_bit_cast(bf16x8, w);
}
__device__ __forceinline__ float red4(float v) { v += __shfl_xor(v, 16); v += __shfl_xor(v, 32); return v; }
__device__ __forceinline__ float max4(float v) { v = fmaxf(v, __shfl_xor(v, 16)); v = fmaxf(v, __shfl_xor(v, 32)); return v; }
#define NEGBIG (-1.0e30f)

__device__ __forceinline__ void phase_nsa_attn(const Params& p, unsigned char* lds, const int rep_cmp, const int rep_win, const int rep_sel) {
    const int lane = threadIdx.x & 63, wave = threadIdx.x >> 6, fr = lane & 15, fq = lane >> 4;
    unsigned char* WL = lds + wave * 18432;
    float* IMP = (float*)WL;
    int* SEL = (int*)(WL + 17408);
    const bf16_t* Q = (const bf16_t*)(p.ws + WS_Q);
    const bf16_t* KCMP = (const bf16_t*)(p.ws + WS_KCMP); const bf16_t* VCMPT = (const bf16_t*)(p.ws + WS_VCMPT);
    const bf16_t* KW = (const bf16_t*)(p.ws + WS_KW); const bf16_t* VWT = (const bf16_t*)(p.ws + WS_VWT);
    const float* NGT = (const float*)(p.ws + WS_NG);
    bf16_t* O = (bf16_t*)(p.ws + WS_O);
    const f32x4 z4 = (f32x4){0.f, 0.f, 0.f, 0.f};
    for (int bi = blockIdx.x; bi < 2048; bi += gridDim.x) {
        const int bg = bi & 7, quad = 255 - (bi >> 3), t0 = (quad * 4 + wave) * 16, b = bg >> 2, g = bg & 3;
        const int cur = t0 >> 6;
        const size_t tok = (size_t)b * SEQ + t0 + fr;
        const int tq = t0 + fr;
        bf16x8 qf[4][2];
#pragma unroll
        for (int r = 0; r < 4; ++r)
#pragma unroll
            for (int ks = 0; ks < 2; ++ks) qf[r][ks] = *(const bf16x8*)(Q + tok * 1024 + (g * 4 + r) * 64 + ks * 32 + fq * 8);
        f32x4 acc[4][4];
        for (int rep = 0; rep < rep_win; ++rep) {
            const bf16_t* kwb = KW + (size_t)bg * SEQ * 64; const bf16_t* vwb = VWT + (size_t)bg * SEQ * 64;
            float mw[4], lw[4];
#pragma unroll
            for (int r = 0; r < 4; ++r) { mw[r] = NEGBIG; lw[r] = 0.f;
#pragma unroll
                for (int df = 0; df < 4; ++df) acc[r][df] = z4; }
            int kmin = t0 - 511; kmin = kmin < 0 ? 0 : kmin; kmin &= ~31;
            bf16x8 nkf[2][2];
#define WIN_LOAD(kb_) do { _Pragma("unroll") for (int f = 0; f < 2; ++f) _Pragma("unroll") for (int ks = 0; ks < 2; ++ks) nkf[f][ks] = *(const bf16x8*)(kwb + (size_t)((kb_) >> 5) * 2048 + ((f * 2 + ks) * 16 + fr) * 32 + fq * 8); } while (0)
            WIN_LOAD(kmin);
            for (int kb = kmin; kb <= t0 + 15; kb += 32) {
                bf16x8 kf[2][2], vf[4];
#pragma unroll
                for (int f = 0; f < 2; ++f) { kf[f][0] = nkf[f][0]; kf[f][1] = nkf[f][1]; }
#pragma unroll
                for (int df = 0; df < 4; ++df) { const bf16_t* vp = vwb + (size_t)(kb >> 5) * 2048 + (df * 32 + fr) * 16 + fq * 4; vf[df] = ldv8(vp, vp + 256); }
                { const int kn = (kb + 32 <= t0 + 15) ? kb + 32 : kb; WIN_LOAD(kn); }
#pragma unroll
                for (int r = 0; r < 4; ++r) {
                    f32x4 st[2];
#pragma unroll
                    for (int f = 0; f < 2; ++f) {
                        st[f] = __builtin_amdgcn_mfma_f32_16x16x32_bf16(kf[f][0], qf[r][0], z4, 0, 0, 0);
                        st[f] = __builtin_amdgcn_mfma_f32_16x16x32_bf16(kf[f][1], qf[r][1], st[f], 0, 0, 0);
                    }
                    float mx = NEGBIG;
#pragma unroll
                    for (int f = 0; f < 2; ++f)
#pragma unroll
                        for (int e = 0; e < 4; ++e) { const int key = kb + f * 16 + fq * 4 + e; const bool ok = (key <= tq) && (key > tq - 512); if (ok) mx = fmaxf(mx, st[f][e]); }
                    float mn = mw[r], al = 1.0f;
                    if (__builtin_amdgcn_ballot_w64(mx > mw[r] + 8.0f) != 0ull) { mn = fmaxf(mw[r], max4(mx)); al = __expf(mw[r] - mn); }
                    float ps = 0.f;
#pragma unroll
                    for (int f = 0; f < 2; ++f)
#pragma unroll
                        for (int e = 0; e < 4; ++e) { const int key = kb + f * 16 + fq * 4 + e; const bool ok = (key <= tq) && (key > tq - 512); const float pv = ok ? __expf(st[f][e] - mn) : 0.f; st[f][e] = pv; ps += pv; }
                    lw[r] = lw[r] * al + ps; mw[r] = mn;
                    const bf16x8 pf = pack8(st[0], st[1]);
#pragma unroll
                    for (int df = 0; df < 4; ++df) { acc[r][df] = acc[r][df] * al; acc[r][df] = __builtin_amdgcn_mfma_f32_16x16x32_bf16(vf[df], pf, acc[r][df], 0, 0, 0); }
                    __builtin_amdgcn_sched_barrier(0);
                }
            }
#pragma unroll
            for (int r = 0; r < 4; ++r) {
                const float l = red4(lw[r]); const float sc = NGT[tok * 48 + (g * 4 + r) * 3 + 2] / l;
#pragma unroll
                for (int df = 0; df < 4; ++df) acc[r][df] = acc[r][df] * sc;
            }
#undef WIN_LOAD
        }
        const int nmax_tile = (t0 >> 4) - 1, nmax_lane = (t0 >> 4) - 2 + (fr == 15 ? 1 : 0);
        const bf16_t* kcb = KCMP + (size_t)bg * 1024 * 64; const bf16_t* vcb = VCMPT + (size_t)bg * 64 * 1024;
        for (int rep = 0; rep < rep_cmp; ++rep) {
            const bool dry = (rep + 1 < rep_cmp);
            float mc[4], lc[4], invl[4];
#pragma unroll
            for (int r = 0; r < 4; ++r) { mc[r] = NEGBIG; lc[r] = 0.f; }
            bf16x8 nkc[2][2], nvc[4];
#define CMPK_LOAD(nb_) do { _Pragma("unroll") for (int f = 0; f < 2; ++f) _Pragma("unroll") for (int ks = 0; ks < 2; ++ks) nkc[f][ks] = *(const bf16x8*)(kcb + (size_t)((nb_) >> 5) * 2048 + ((f * 2 + ks) * 16 + fr) * 32 + fq * 8); } while (0)
#define CMPV_LOAD(nb_) do { _Pragma("unroll") for (int df = 0; df < 4; ++df) { const bf16_t* vp = vcb + (size_t)((nb_) >> 5) * 2048 + (df * 32 + fr) * 16 + fq * 4; nvc[df] = ldv8(vp, vp + 256); } } while (0)
            CMPK_LOAD(0);
            for (int nb = 0; nb <= nmax_tile; nb += 32) {
                bf16x8 kf[2][2];
#pragma unroll
                for (int f = 0; f < 2; ++f) { kf[f][0] = nkc[f][0]; kf[f][1] = nkc[f][1]; }
                { const int nn = (nb + 32 <= nmax_tile) ? nb + 32 : 0; CMPK_LOAD(nn); }
#pragma unroll
                for (int r = 0; r < 4; ++r) {
                    f32x4 st[2];
#pragma unroll
                    for (int f = 0; f < 2; ++f) {
                        st[f] = __builtin_amdgcn_mfma_f32_16x16x32_bf16(kf[f][0], qf[r][0], z4, 0, 0, 0);
                        st[f] = __builtin_amdgcn_mfma_f32_16x16x32_bf16(kf[f][1], qf[r][1], st[f], 0, 0, 0);
                    }
                    float mx = NEGBIG;
#pragma unroll
                    for (int f = 0; f < 2; ++f)
#pragma unroll
                        for (int e = 0; e < 4; ++e) { const int n = nb + f * 16 + fq * 4 + e; if (n <= nmax_lane) mx = fmaxf(mx, st[f][e]); }
                    float mn = mc[r];
                    if (__builtin_amdgcn_ballot_w64(mx > mc[r] + 8.0f) != 0ull) mn = fmaxf(mc[r], max4(mx));
                    float ps = 0.f;
#pragma unroll
                    for (int f = 0; f < 2; ++f)
#pragma unroll
                        for (int e = 0; e < 4; ++e) { const int n = nb + f * 16 + fq * 4 + e; if (n <= nmax_lane) ps += __expf(st[f][e] - mn); }
                    lc[r] = lc[r] * __expf(mc[r] - mn) + ps; mc[r] = mn;
                    __builtin_amdgcn_sched_barrier(0);
                }
            }
#pragma unroll
            for (int r = 0; r < 4; ++r) { const float l = red4(lc[r]); invl[r] = l > 0.f ? 1.0f / l : 0.f; }
            for (int i = lane; i < 16 * 260; i += 64) IMP[i] = 0.f;
            float carry = 0.f;
            float gc[4];
#pragma unroll
            for (int r = 0; r < 4; ++r) gc[r] = NGT[tok * 48 + (g * 4 + r) * 3];
            for (int nb = 0; nb <= nmax_tile; nb += 32) {
                bf16x8 kf[2][2], vf[4];
#pragma unroll
                for (int f = 0; f < 2; ++f) { kf[f][0] = nkc[f][0]; kf[f][1] = nkc[f][1]; }
                CMPV_LOAD(nb);
#pragma unroll
                for (int df = 0; df < 4; ++df) vf[df] = nvc[df];
                { const int nn = (nb + 32 <= nmax_tile) ? nb + 32 : nb; CMPK_LOAD(nn); }
                f32x4 pg[2] = {z4, z4};
#pragma unroll
                for (int r = 0; r < 4; ++r) {
                    f32x4 st[2];
#pragma unroll
                    for (int f = 0; f < 2; ++f) {
                        st[f] = __builtin_amdgcn_mfma_f32_16x16x32_bf16(kf[f][0], qf[r][0], z4, 0, 0, 0);
                        st[f] = __builtin_amdgcn_mfma_f32_16x16x32_bf16(kf[f][1], qf[r][1], st[f], 0, 0, 0);
#pragma unroll
                        for (int e = 0; e < 4; ++e) { const int n = nb + f * 16 + fq * 4 + e; st[f][e] = (n <= nmax_lane) ? __expf(st[f][e] - mc[r]) * invl[r] : 0.f; }
                        pg[f] += st[f];
                    }
                    const float gg = dry ? 0.f : gc[r];
                    const bf16x8 pf = pack8(st[0] * gg, st[1] * gg);
#pragma unroll
                    for (int df = 0; df < 4; ++df) acc[r][df] = __builtin_amdgcn_mfma_f32_16x16x32_bf16(vf[df], pf, acc[r][df], 0, 0, 0);
                    __builtin_amdgcn_sched_barrier(0);
                }
                const int src = (lane - 16) & 63;
                const float s0 = __shfl(pg[0].w, src), s1 = __shfl(pg[1].w, src), sc = __shfl(carry, src);
                const float prev0 = fq > 0 ? s0 : sc, prev1 = fq > 0 ? s1 : s0;
                const float imp0 = (pg[0].x + pg[0].y) + (pg[0].z + pg[0].w) + prev0;
                const float imp1 = (pg[1].x + pg[1].y) + (pg[1].z + pg[1].w) + prev1;
                const int jb = (nb >> 2) + fq;
                IMP[fr * 260 + jb] = imp0; IMP[fr * 260 + jb + 4] = imp1;
                carry = pg[1].w;
            }
#undef CMPK_LOAD
#undef CMPV_LOAD
        }
        {
            const int nf = cur >= 2 ? 3 : cur + 1;
            if (fq == 0) {
                SEL[fr * 16 + 0] = 0;
                if (cur == 1) SEL[fr * 16 + 1] = 1;
                if (cur >= 2) { SEL[fr * 16 + 1] = cur - 1; SEL[fr * 16 + 2] = cur; }
            }
            const int ncand = cur >= 3 ? cur - 2 : 0, extra = 16 - nf;
            if (ncand <= extra) {
                if (fq == 0) { for (int k = 0; k < extra; ++k) SEL[fr * 16 + nf + k] = (k < ncand) ? 1 + k : -1; }
            } else {
                for (int rnd = 0; rnd < extra; ++rnd) {
                    float bv = -1.0f; int bj = 1 << 20;
                    for (int jb = 1 + fq; jb <= cur - 2; jb += 4) { const float v = IMP[fr * 260 + jb]; if (v > bv) { bv = v; bj = jb; } }
#pragma unroll
                    for (int o = 16; o <= 32; o <<= 1) {
                        const float ov = __shfl_xor(bv, o); const int oj = __shfl_xor(bj, o);
                        if (ov > bv || (ov == bv && oj < bj)) { bv = ov; bj = oj; }
                    }
                    if (fq == 0) SEL[fr * 16 + nf + rnd] = bj;
                    if (((bj - 1) & 3) == fq) IMP[fr * 260 + bj] = -2.0f;
                }
            }
        }
#pragma unroll
        for (int r = 0; r < 4; ++r)
#pragma unroll
            for (int df = 0; df < 4; ++df) {
                const f32x4 v = acc[r][df];
                *(u32x2*)(O + tok * 1024 + (g * 4 + r) * 64 + df * 16 + fq * 4) = (u32x2){pk2(v.x, v.y), pk2(v.z, v.w)};
            }
        asm volatile("s_waitcnt vmcnt(0)" ::: "memory");
        unsigned selp[4];
        {
            const u32x4* sp = (const u32x4*)(SEL + fr * 16);
#pragma unroll
            for (int q = 0; q < 4; ++q) { const u32x4 w = sp[q]; selp[q] = (w.x & 255u) | ((w.y & 255u) << 8) | ((w.z & 255u) << 16) | ((w.w & 255u) << 24); }
        }
        for (int rep = 0; rep < rep_sel; ++rep) {
            const bool dry = (rep + 1 < rep_sel);
            const unsigned char* k8b = p.ws + WS_KS + (size_t)bg * SEQ * 64; const unsigned char* v8b = p.ws + WS_VST + (size_t)bg * 256 * 4096;
            const float* skb = (const float*)(p.ws + WS_KS + 12 * MiB) + (size_t)bg * 256; const float* svb = (const float*)(p.ws + WS_VST + 12 * MiB) + (size_t)bg * 256;
            const unsigned char* Q8 = p.ws + WS_Q8; const float* SQ8 = (const float*)(p.ws + WS_Q8 + 32 * MiB);
            const int nv = cur + 1 < 16 ? cur + 1 : 16, npair = (nv + 1) >> 1, total = 16 * npair;
            const int lrow = lane >> 2, lch = lane & 3;
            const int woff = lrow * 72 + lch * 16;
            const int rr = fr & 3;
            u32x4 sk[2][4], sv[2][4]; float ssk[2], ssv[2];
            int jbn[2];
#define SEL_GET(tokI, slotK) ((int)(((unsigned)__builtin_amdgcn_readlane((int)(((slotK) >> 2) == 0 ? selp[0] : ((slotK) >> 2) == 1 ? selp[1] : ((slotK) >> 2) == 2 ? selp[2] : selp[3]), (tokI)) >> (((slotK) & 3) * 8)) & 255u))
#define SEL_ISSUE(tokI, pairP) do { \
                const int k0_ = 2 * (pairP), k1_ = (2 * (pairP) + 1 < nv) ? 2 * (pairP) + 1 : k0_; \
                jbn[0] = __builtin_amdgcn_readfirstlane(SEL_GET(tokI, k0_)); jbn[1] = __builtin_amdgcn_readfirstlane(SEL_GET(tokI, k1_)); \
                _Pragma("unroll") for (int u = 0; u < 2; ++u) { \
                    const unsigned char* kb_ = k8b + (size_t)jbn[u] * 4096; const unsigned char* vb_ = v8b + (size_t)jbn[u] * 4096; \
                    _Pragma("unroll") for (int j = 0; j < 4; ++j) { sk[u][j] = *(const u32x4*)(kb_ + j * 1024 + lane * 16); sv[u][j] = *(const u32x4*)(vb_ + j * 1024 + lane * 16); } \
                    ssk[u] = skb[jbn[u]]; ssv[u] = svb[jbn[u]]; } } while (0)
            SEL_ISSUE(0, 0);
            long qs8[2] = {0, 0};
            float sq = 0.f, ms = NEGBIG, ls = 0.f;
            f32x4 os[4] = {z4, z4, z4, z4};
            u32x2 oprev[4] = {(u32x2){0u, 0u}, (u32x2){0u, 0u}, (u32x2){0u, 0u}, (u32x2){0u, 0u}};
            int i = 0, pp = 0;
            for (int v = 0; v < total; ++v) {
                const int jb0 = jbn[0], jb1 = jbn[1];
                const bool second_valid = (2 * pp + 1 < nv);
                const float ck0 = ssk[0], ck1 = ssk[1], cv0 = ssv[0], cv1 = ssv[1];
#pragma unroll
                for (int u = 0; u < 2; ++u)
#pragma unroll
                    for (int j = 0; j < 4; ++j) {
                        unsigned char* kd = WL + u * 9216 + woff + j * 1152; unsigned char* vd = kd + 4608;
                        *(u32x2*)kd = (u32x2){sk[u][j].x, sk[u][j].y}; *(u32x2*)(kd + 8) = (u32x2){sk[u][j].z, sk[u][j].w};
                        *(u32x2*)vd = (u32x2){sv[u][j].x, sv[u][j].y}; *(u32x2*)(vd + 8) = (u32x2){sv[u][j].z, sv[u][j].w};
                    }
                if (v + 1 < total) {
                    int p2 = pp + 1, i2 = i; if (p2 == npair) { p2 = 0; i2 = i + 1; }
                    SEL_ISSUE(i2, p2);
                }
                __builtin_amdgcn_sched_barrier(0);
                const int ti = t0 + i;
                if (pp == 0) {
                    const size_t tk = (size_t)b * SEQ + ti;
#pragma unroll
                    for (int ks = 0; ks < 2; ++ks) qs8[ks] = *(const long*)(Q8 + tk * 1024 + (g * 4 + rr) * 64 + ks * 32 + fq * 8);
                    sq = SQ8[tk * 16 + g * 4 + rr] * 1.4426950408889634f;
                    ms = NEGBIG; ls = 0.f;
#pragma unroll
                    for (int df = 0; df < 4; ++df) { os[df] = z4; oprev[df] = *(const u32x2*)(O + tk * 1024 + (g * 4 + rr) * 64 + df * 16 + fq * 4); }
                }
                f32x4 st[2][4];
#pragma unroll
                for (int u = 0; u < 2; ++u)
#pragma unroll
                    for (int f = 0; f < 4; ++f) {
                        const unsigned char* kp = WL + u * 9216 + (32 * (f >> 1) + 8 * (fr >> 2) + 4 * (f & 1) + (fr & 3)) * 72 + fq * 8;
                        const long k0 = *(const long*)kp, k1 = *(const long*)(kp + 32);
                        st[u][f] = __builtin_amdgcn_mfma_f32_16x16x32_fp8_fp8(k0, qs8[0], z4, 0, 0, 0);
                        st[u][f] = __builtin_amdgcn_mfma_f32_16x16x32_fp8_fp8(k1, qs8[1], st[u][f], 0, 0, 0);
                    }
                const int jq = fr >> 2;
                const bool jb_ = (jq & 1) != 0, ju_ = (jq & 2) != 0;
                f32x4 a0, a1;
#pragma unroll
                for (int e = 0; e < 4; ++e) {
                    const float t00 = jb_ ? st[0][2][e] : st[0][0][e], t10 = jb_ ? st[1][2][e] : st[1][0][e];
                    const float t01 = jb_ ? st[0][3][e] : st[0][1][e], t11 = jb_ ? st[1][3][e] : st[1][1][e];
                    a0[e] = ju_ ? t10 : t00; a1[e] = ju_ ? t11 : t01;
                }
                const float c_own = sq * (ju_ ? ck1 : ck0);
                const float cv_own = ju_ ? cv1 : cv0;
                if (jb0 == cur || jb1 == cur || !second_valid) {
                    const int jbu = ju_ ? jb1 : jb0;
                    const bool allbad = ju_ && !second_valid;
                    const int key0 = jbu * 64 + 32 * (jq & 1) + 8 * fq;
#pragma unroll
                    for (int e = 0; e < 4; ++e) { if (allbad || key0 + e > ti) a0[e] = NEGBIG; if (allbad || key0 + 4 + e > ti) a1[e] = NEGBIG; }
                }
                const float mxr = fmaxf(fmaxf(fmaxf(a0.x, a0.y), fmaxf(a0.z, a0.w)), fmaxf(fmaxf(a1.x, a1.y), fmaxf(a1.z, a1.w)));
                const float mxl = mxr > -1.0e29f ? mxr * c_own : NEGBIG;
                float mn = ms;
                if (__builtin_amdgcn_ballot_w64(mxl > ms + 4.0f) != 0ull) {
                    float m16 = max4(mxl); m16 = fmaxf(m16, __shfl_xor(m16, 4)); m16 = fmaxf(m16, __shfl_xor(m16, 8));
                    mn = fmaxf(ms, m16);
                    const float al = __builtin_amdgcn_exp2f(ms - mn);
                    ls *= al;
#pragma unroll
                    for (int df = 0; df < 4; ++df) os[df] = os[df] * al;
                }
                const float off = 4.0f - mn;
                float ps = 0.f;
#pragma unroll
                for (int e = 0; e < 4; ++e) { a0[e] = __builtin_amdgcn_exp2f(a0[e] * c_own + off); a1[e] = __builtin_amdgcn_exp2f(a1[e] * c_own + off); ps += a0[e] + a1[e]; }
                ls += ps; ms = mn;
                int w0 = 0, w1 = 0;
                w0 = __builtin_amdgcn_cvt_pk_fp8_f32(a0.x, a0.y, w0, false); w0 = __builtin_amdgcn_cvt_pk_fp8_f32(a0.z, a0.w, w0, true);
                w1 = __builtin_amdgcn_cvt_pk_fp8_f32(a1.x, a1.y, w1, false); w1 = __builtin_amdgcn_cvt_pk_fp8_f32(a1.z, a1.w, w1, true);
                f32x4 pvacc[4] = {z4, z4, z4, z4};
#pragma unroll
                for (int u = 0; u < 2; ++u)
#pragma unroll
                    for (int s = 0; s < 2; ++s) {
                        const bool mine = (jq == 2 * u + s);
                        const long pf = (long)(((unsigned long long)(unsigned)(mine ? w1 : 0) << 32) | (unsigned long long)(unsigned)(mine ? w0 : 0));
#pragma unroll
                        for (int df = 0; df < 4; ++df) {
                            const long vf = *(const long*)(WL + u * 9216 + 4608 + (df * 16 + fr) * 72 + 32 * s + 8 * fq);
                            pvacc[df] = __builtin_amdgcn_mfma_f32_16x16x32_fp8_fp8(vf, pf, pvacc[df], 0, 0, 0);
                        }
                    }
#pragma unroll
                for (int df = 0; df < 4; ++df) os[df] = os[df] + pvacc[df] * cv_own;
                if (pp == npair - 1) {
                    float l = red4(ls); l += __shfl_xor(l, 4); l += __shfl_xor(l, 8);
#pragma unroll
                    for (int df = 0; df < 4; ++df)
#pragma unroll
                        for (int e = 0; e < 4; ++e) { float v_ = os[df][e]; v_ += __shfl_xor(v_, 4); v_ += __shfl_xor(v_, 8); os[df][e] = v_; }
                    const float gsv = NGT[((size_t)b * SEQ + ti) * 48 + (g * 4 + rr) * 3 + 1];
                    const float sc = gsv / l;
                    if (fr < 4 && !dry) {
                        bf16_t* op = O + ((size_t)b * SEQ + ti) * 1024 + (g * 4 + fr) * 64 + fq * 4;
#pragma unroll
                        for (int df = 0; df < 4; ++df) {
                            const f32x4 val = os[df] * sc; const u32x2 c = oprev[df];
                            *(u32x2*)(op + df * 16) = (u32x2){pk2(bflo(c.x) + val.x, bfhi(c.x) + val.y), pk2(bflo(c.y) + val.z, bfhi(c.y) + val.w)};
                        }
                    }
                }
                ++pp; if (pp == npair) { pp = 0; ++i; }
            }
#undef SEL_GET
#undef SEL_ISSUE
        }
    }
}
constexpr int NPHASES = 18;
#ifndef PROBE_PHASE
#define PROBE_PHASE (-1)
#endif
#ifndef ATT_REP_CMP
#define ATT_REP_CMP 1
#endif
#ifndef ATT_REP_WIN
#define ATT_REP_WIN 1
#endif
#ifndef ATT_REP_SEL
#define ATT_REP_SEL 1
#endif
#ifndef TS_PHASE
#define TS_PHASE (-1)
#endif
#ifndef TS_MULT
#define TS_MULT 4
#endif
#ifndef PROBE_REPS
#define PROBE_REPS 1
#endif
__global__ void __launch_bounds__(NTHREADS, 2) mega(Params p) {
    __shared__ __attribute__((aligned(1024))) unsigned char lds[LDS_BYTES + 16];
    unsigned* bar_st = (unsigned*)(lds + LDS_BYTES);
    cg::grid_group grid = cg::this_grid();
    const float* MOD = (const float*)(p.ws + WS_MOD);
    bf16_t* HM = (bf16_t*)(p.ws + WS_HM);
    if (threadIdx.x < 4) bar_st[threadIdx.x] = 0u;
    __syncthreads();
    XcdBarrier bar = xcd_barrier_post((unsigned*)(p.ws + WS_CTL), (volatile LAS unsigned*)bar_st);
    const int lo = p.ph_lo, hi = p.ph_hi;
    const bool dry0 = (p.ph_hi < 0);
    const int opq = (p.ph_hi < 0) ? 1 : 0;
    const bool never = (p.ph_hi < 0);
    unsigned long long ts_a = 0ull, ts_b = 0ull;
#define PHASE(k, call, drycall) if (lo <= (k) && (k) < hi) { \
        if (TS_PHASE == (k)) ts_a = __builtin_amdgcn_s_memrealtime(); \
        if (PROBE_PHASE == (k)) { for (int rep = 0; rep < PROBE_REPS; ++rep) { const bool dry = !dry0; drycall; __syncthreads(); } } \
        { const bool dry = dry0; call; } \
        if ((k) + 1 < hi) { if (never) grid.sync(); else xcd_barrier(bar); } \
        if (TS_PHASE == (k)) ts_b = __builtin_amdgcn_s_memrealtime(); }
    PHASE(0, phase_prep(p, (float*)lds, 0), phase_prep(p, (float*)lds, 0))
    PHASE(1, phase_norm(p, p.in[0], p.in[2], MOD + 0, MOD + 1024, HM), phase_norm(p, p.in[0], p.in[2], MOD + 0, MOD + 1024, HM))
    PHASE(2, phase_s5_win(p, lds), phase_s5_win(p, lds))
    PHASE(3, phase_s5_a(p, lds), phase_s5_a(p, lds))
    PHASE(4, (phase_s5_scan(p), phase_prep(p, (float*)lds, 1)), (phase_s5_scan(p), phase_prep(p, (float*)lds, 1)))
    PHASE(5, phase_s5_b(p, lds), phase_s5_b(p, lds))
    PHASE(6, phase_s5_glu(p, lds), phase_s5_glu(p, lds))
    PHASE(7, phase_norm(p, p.out, p.in[3], MOD + 3072, MOD + 4096, HM), phase_norm(p, p.out, p.in[3], MOD + 3072, MOD + 4096, HM))
    PHASE(8, phase_peer_route(p, 0, lds), phase_peer_route(p, 0, lds))
    PHASE(9, phase_peer_apply6(p, 0, lds, dry), phase_peer_apply6(p, 0, lds, dry))
    PHASE(10, phase_nsa_proj(p, lds), phase_nsa_proj(p, lds))
    PHASE(11, (phase_nsa_cmp1(p, lds), phase_tab1(p)), (phase_nsa_cmp1(p, lds), phase_tab1(p)))
    PHASE(12, phase_nsa_cmp2(p, lds), phase_nsa_cmp2(p, lds))
    PHASE(13, phase_nsa_attn(p, lds, ATT_REP_CMP + opq, ATT_REP_WIN + opq, ATT_REP_SEL + opq), phase_nsa_attn(p, lds, 1 + opq, 1 + opq, 1 + opq))
    PHASE(14, phase_nsa_wo(p, lds, dry), phase_nsa_wo(p, lds, dry))
    PHASE(15, phase_norm(p, p.out, p.in[3] + D, MOD + 2 * 6144 + 3072, MOD + 2 * 6144 + 4096, HM), phase_norm(p, p.out, p.in[3] + D, MOD + 2 * 6144 + 3072, MOD + 2 * 6144 + 4096, HM))
    PHASE(16, phase_peer_route(p, 1, lds), phase_peer_route(p, 1, lds))
    PHASE(17, phase_peer_apply6(p, 1, lds, dry), phase_peer_apply6(p, 1, lds, dry))
#undef PHASE
    if (TS_PHASE >= 0 && blockIdx.x == 0 && threadIdx.x == 0) {
        const unsigned long long t0 = __builtin_amdgcn_s_memrealtime(), want = (ts_b - ts_a) * TS_MULT;
        while (__builtin_amdgcn_s_memrealtime() - t0 < want) __builtin_amdgcn_s_sleep(8);
    }
}

extern "C" void kernel_launch(void* const* d_in, const int* in_sizes, int n_in, void* d_out, int out_size, void* d_ws, size_t ws_size, hipStream_t stream) {
    static int grid_blocks = 0;
    if (!grid_blocks) {
        int dev = 0, cus = 0, per_cu = 0;
        hipGetDevice(&dev);
        hipDeviceGetAttribute(&cus, hipDeviceAttributeMultiprocessorCount, dev);
        hipOccupancyMaxActiveBlocksPerMultiprocessor(&per_cu, mega, NTHREADS, 0);
        if (per_cu > 2) per_cu = 2;
        if (per_cu < 1) per_cu = 1;
        grid_blocks = cus * per_cu;
        if (ws_size < WS_END) fprintf(stderr, "kernel_launch: workspace too small: %zu < %zu\n", ws_size, (size_t)WS_END);
        if (n_in != 29) fprintf(stderr, "kernel_launch: expected 29 inputs, got %d\n", n_in);
    }
    hipMemsetAsync((unsigned char*)d_ws + WS_CTL, 0, 16384, stream);
    Params p{};
    for (int i = 0; i < 29; ++i) p.in[i] = (const float*)d_in[i];
    p.out = (float*)d_out; p.ws = (unsigned char*)d_ws;
#if SINGLE_LAUNCH
    p.ph_lo = 0; p.ph_hi = NPHASES;
    void* args[] = {&p};
    hipError_t e = hipLaunchCooperativeKernel((void*)mega, dim3(grid_blocks), dim3(NTHREADS), args, 0, stream);
    if (e != hipSuccess) fprintf(stderr, "cooperative launch failed: %s (grid %d)\n", hipGetErrorString(e), grid_blocks);
#else
    for (int ph = 0; ph < NPHASES; ++ph) {
        p.ph_lo = ph; p.ph_hi = ph + 1;
        hipLaunchKernelGGL(mega, dim3(grid_blocks), dim3(NTHREADS), 0, stream, p);
    }
#endif
}
```

```cpp
#include <hip/hip_runtime.h>
#include <hip/hip_cooperative_groups.h>
#include <cstdio>
#include <cstdint>
namespace cg = cooperative_groups;

#ifndef SINGLE_LAUNCH
#define SINGLE_LAUNCH 1
#endif

typedef unsigned short bf16_t;
typedef short bf16x8 __attribute__((ext_vector_type(8)));
typedef float f32x4 __attribute__((ext_vector_type(4)));
typedef float f32x2 __attribute__((ext_vector_type(2)));
typedef unsigned u32x4 __attribute__((ext_vector_type(4)));
typedef unsigned u32x2 __attribute__((ext_vector_type(2)));
typedef __bf16 bf16x2_t __attribute__((ext_vector_type(2)));
typedef float v32f __attribute__((ext_vector_type(32)));
typedef float v16f __attribute__((ext_vector_type(16)));
typedef unsigned v6u __attribute__((ext_vector_type(6)));
typedef int v8i __attribute__((ext_vector_type(8)));

constexpr int D = 1024, BATCH = 2, SEQ = 16384, T = BATCH * SEQ;
constexpr int NTHREADS = 256;
constexpr float RMS_EPS = 1e-6f;
constexpr int S5G = 64, S5P = 64, S5L = 32, S5NCH = T / S5L  , S5CPB = SEQ / S5L  ;
constexpr int NH = 16, HD = 64, NG = 4, NPROJ = 2608, NPROJ_PAD = 2688, NC = 1023, NSB = 256;
constexpr int PH = 8, PK = 16, PNK = 128, PE = 16384;

constexpr size_t MiB = 1ull << 20;
constexpr size_t WS_CTL = 0;
constexpr size_t WS_MOD = 1 * MiB;
constexpr size_t WS_WIN_T = 2 * MiB;
constexpr size_t WS_WGLU_T = 4 * MiB;
constexpr size_t WS_WPROJ_T = 8 * MiB;
constexpr size_t WS_WK1_T = 14 * MiB;
constexpr size_t WS_WV1_T = 15 * MiB;
constexpr size_t WS_WK2_T = 16 * MiB;
constexpr size_t WS_WV2_T = 16 * MiB + 512 * 1024;
constexpr size_t WS_WO_T = 17 * MiB;
constexpr size_t WS_WQ_T = 19 * MiB;
constexpr size_t WS_SUBK = 27 * MiB;
constexpr size_t WS_ROPE = 28 * MiB;
constexpr size_t WS_MISC = 32 * MiB;
constexpr size_t WS_TW = 33 * MiB;
constexpr size_t WS_VG = 73 * MiB;
constexpr size_t WS_PU = 82 * MiB;
constexpr size_t WS_PV = 114 * MiB;
constexpr size_t WS_HM = 146 * MiB;
constexpr size_t WS_C = 210 * MiB;
constexpr size_t WS_UG = WS_C;
constexpr size_t WS_YI = WS_C + 64 * MiB;
constexpr size_t WS_WST = WS_C + 128 * MiB;
constexpr size_t WS_SST = WS_C + 160 * MiB;
constexpr size_t WS_YG = WS_C + 176 * MiB;
constexpr size_t WS_QK = WS_C;
constexpr size_t WS_TOPS = WS_C + 128 * MiB;
constexpr size_t WS_TOPI = WS_C + 160 * MiB;
constexpr size_t WS_EXP = WS_C + 192 * MiB;
constexpr size_t WS_GATE = WS_C + 208 * MiB;
constexpr size_t WS_ACT = WS_C + 224 * MiB;
constexpr size_t WS_Q = WS_C;
constexpr size_t WS_KC = WS_C + 64 * MiB;
constexpr size_t WS_VC = WS_C + 81 * MiB;
constexpr size_t WS_KS = WS_C + 98 * MiB;
constexpr size_t WS_VST = WS_C + 114 * MiB;
constexpr size_t WS_KW = WS_C + 130 * MiB;
constexpr size_t WS_VWT = WS_C + 146 * MiB;
constexpr size_t WS_NG = WS_C + 162 * MiB;
constexpr size_t WS_KCMP = WS_C + 170 * MiB;
constexpr size_t WS_VCMPT = WS_C + 171 * MiB;
constexpr size_t WS_HID = WS_C + 172 * MiB;
constexpr size_t WS_O = WS_C + 182 * MiB;
constexpr size_t WS_Q8 = WS_C + 246 * MiB;
constexpr size_t WS_END = WS_C + 282 * MiB;

constexpr int LDS_BYTES = 74240;

struct Params {
    const float* in[29];
    float* out;
    unsigned char* ws;
    int ph_lo, ph_hi;
};

__device__ __forceinline__ unsigned f2bf(float f) { unsigned u = __builtin_bit_cast(unsigned, f); return (u + 0x7fffu + ((u >> 16) & 1u)) >> 16; }
__device__ __forceinline__ unsigned pk2(float lo, float hi) { return f2bf(lo) | (f2bf(hi) << 16); }
__device__ __forceinline__ float bf2f(unsigned h) { return __builtin_bit_cast(float, h << 16); }
__device__ __forceinline__ float bflo(unsigned w) { return __builtin_bit_cast(float, w << 16); }
__device__ __forceinline__ float bfhi(unsigned w) { return __builtin_bit_cast(float, w & 0xffff0000u); }
__device__ __forceinline__ float gelu_tanh(float x) {
    const float u = 0.7978845608028654f * (x + 0.044715f * x * x * x);
    const float e = __expf(2.0f * u);
    const float th = 1.0f - 2.0f / (e + 1.0f);
    return 0.5f * x * (1.0f + th);
}
__device__ __forceinline__ float sigmoidf_(float x) { return 1.0f / (1.0f + __expf(-x)); }
__device__ __forceinline__ float wave_sum(float v) {
#pragma unroll
    for (int o = 1; o < 64; o <<= 1) v += __shfl_xor(v, o);
    return v;
}
__device__ __forceinline__ float dot2bf(unsigned a, unsigned b, float acc) {
    return __builtin_amdgcn_fdot2_f32_bf16(__builtin_bit_cast(bf16x2_t, a), __builtin_bit_cast(bf16x2_t, b), acc, false);
}

#define LAS __attribute__((address_space(3)))
#define XB_TMO      128
#define XB_XCNT(j)  (256  + 64 * (j))
#define XB_XSUB(j)  (1280 + 64 * (j))
#define XB_XGEN(j)  (2304 + 64 * (j))
#define XB_TOP      3328
#define XB_TOPGEN   3392
#define XCD_BAR_WORDS 3456
#define XB_SPIN_CAP (1u << 24)

__device__ __forceinline__ unsigned xb_ld(unsigned* p)              { return __hip_atomic_load(p, __ATOMIC_RELAXED, __HIP_MEMORY_SCOPE_AGENT); }
__device__ __forceinline__ unsigned xb_add(unsigned* p, unsigned v) { return __hip_atomic_fetch_add(p, v, __ATOMIC_RELAXED, __HIP_MEMORY_SCOPE_AGENT); }
__device__ __forceinline__ unsigned xb_xcc_id() { return (unsigned)__builtin_amdgcn_s_getreg((3 << 11) | 20) & 0xFu; }
#define XB_SPIN(cond, bar) do { unsigned _sp = 0; while (cond) { __builtin_amdgcn_s_sleep(1); \
    if ((++_sp & 255u) == 0u) { if (xb_ld(&(bar)[XB_TMO])) break; if (_sp > XB_SPIN_CAP) { atomicAdd(&(bar)[XB_TMO], 1u); break; } } } } while (0)

struct XcdBarrier {
    unsigned* bar; unsigned x;
    volatile LAS unsigned* st;
};

__device__ __forceinline__ XcdBarrier xcd_barrier_post(unsigned* bar, volatile LAS unsigned* st) {
    XcdBarrier b; b.bar = bar; b.x = xb_xcc_id(); b.st = st;
    if (threadIdx.x == 0) (void)xb_add(&bar[XB_XCNT(b.x)], 1u);
    return b;
}
__device__ __forceinline__ void xcd_barrier_complete(unsigned* bar, unsigned x, unsigned& nloc, unsigned& nx) {
    const unsigned G = gridDim.x * gridDim.y * gridDim.z;
    unsigned sum, cnt, mine, sp = 0u;
    for (;;) {
        sum = 0u; cnt = 0u; mine = 0u;
#pragma unroll
        for (unsigned j = 0; j < 16; ++j) { const unsigned c = xb_ld(&bar[XB_XCNT(j)]); sum += c; cnt += (c > 0u) ? 1u : 0u; mine = (j == x) ? c : mine; }
        if (sum == G) break;
        __builtin_amdgcn_s_sleep(1);
        if ((++sp & 255u) == 0u) { if (xb_ld(&bar[XB_TMO])) break; if (sp > XB_SPIN_CAP) { atomicAdd(&bar[XB_TMO], 1u); break; } }
    }
    nloc = mine > 0u ? mine : 1u; nx = cnt > 0u ? cnt : 1u;
}

__device__ __forceinline__ void xcd_barrier(const XcdBarrier& b) {
    asm volatile("s_waitcnt vmcnt(0)" ::: "memory");
    __syncthreads();
    if (threadIdx.x == 0) {
        unsigned* bar = b.bar;
        __builtin_amdgcn_s_waitcnt(0);
        unsigned nloc = b.st[0], nx = b.st[1];
        if (nloc == 0u) { xcd_barrier_complete(bar, b.x, nloc, nx); b.st[0] = nloc; b.st[1] = nx; }
        const unsigned old = xb_add(&bar[XB_XSUB(b.x)], 1u);
        const unsigned gen = old / nloc;
        if (old + 1u == (gen + 1u) * nloc) {
            __builtin_amdgcn_fence(__ATOMIC_RELEASE, "agent");
            asm volatile("s_waitcnt vmcnt(0)" ::: "memory");
            const unsigned og = xb_add(&bar[XB_TOP], 1u);
            const unsigned tg = og / nx;
            if (og + 1u == (tg + 1u) * nx) xb_add(&bar[XB_TOPGEN], 1u);
            else XB_SPIN(xb_ld(&bar[XB_TOPGEN]) == tg, bar);
            __builtin_amdgcn_fence(__ATOMIC_ACQUIRE, "agent");
            xb_add(&bar[XB_XGEN(b.x)], 1u);
            asm volatile("s_waitcnt vmcnt(0)" ::: "memory");
        } else {
            XB_SPIN(xb_ld(&bar[XB_XGEN(b.x)]) == gen, bar);
            __builtin_amdgcn_fence(__ATOMIC_ACQUIRE, "agent");
            asm volatile("s_waitcnt vmcnt(0)" ::: "memory");
        }
    }
    __syncthreads();
}
__device__ __forceinline__ void prep_mod_item(const Params& p, int item, float* lds) {
    const int layer = item / 192, cg0 = (item % 192) * 32;
    const int tid = threadIdx.x, col = cg0 + (tid & 31), kg = tid >> 5;
    const float* W = p.in[4] + (size_t)layer * D * 6 * D + col;
    const float* c = p.in[1];
    float* cact = lds + 512;
#pragma unroll
    for (int i = 0; i < 8; ++i) { const int q = tid + 256 * i; const float v = c[q]; cact[q] = v * sigmoidf_(v); }
    __syncthreads();
    float a0 = 0.f, a1 = 0.f;
    for (int k0 = kg * 128; k0 < kg * 128 + 128; k0 += 16) {
        float w[16];
#pragma unroll
        for (int u = 0; u < 16; ++u) w[u] = W[(size_t)(k0 + u) * (6 * D)];
#pragma unroll
        for (int u = 0; u < 16; ++u) { a0 += w[u] * cact[k0 + u]; a1 += w[u] * cact[1024 + k0 + u]; }
    }
    lds[tid] = a0; lds[256 + tid] = a1;
    __syncthreads();
    if (tid < 64) {
        const int b = tid >> 5, cc = tid & 31;
        float s = 0.f;
#pragma unroll
        for (int g = 0; g < 8; ++g) s += lds[b * 256 + g * 32 + cc];
        float* MOD = (float*)(p.ws + WS_MOD);
        MOD[(size_t)(layer * 2 + b) * 6144 + cg0 + cc] = s + p.in[5][(size_t)layer * 6144 + cg0 + cc];
    }
    __syncthreads();
}

template <int MODE>
__device__ __forceinline__ void prep_transpose_item(const float* W, int K, int N, bf16_t* WT, int item, float* lds) {
    const int nbn = (N + 63) / 64, kb = item / nbn, nb = item % nbn, k0 = kb * 64, n0 = nb * 64;
    const int tid = threadIdx.x;
#pragma unroll
    for (int i = 0; i < 16; ++i) {
        const int kk = (tid >> 6) + 4 * i, nn = tid & 63;
        const float v = (n0 + nn < N) ? W[(size_t)(k0 + kk) * N + n0 + nn] : 0.f;
        lds[kk * 65 + nn] = v;
    }
    __syncthreads();
    {
        const int nn = tid >> 2, ks = (tid & 3) * 16;
        const int n = n0 + nn;
        if (n < N) {
            int np = n;
            if (MODE == 1) { const int j = (n < 1024) ? n : n - 1024; np = (j >> 4) * 32 + (j & 15) + ((n < 1024) ? 0 : 16); }
            u32x4 o0, o1;
            const float* s = lds + nn;
            o0.x = pk2(s[(ks + 0) * 65], s[(ks + 1) * 65]); o0.y = pk2(s[(ks + 2) * 65], s[(ks + 3) * 65]);
            o0.z = pk2(s[(ks + 4) * 65], s[(ks + 5) * 65]); o0.w = pk2(s[(ks + 6) * 65], s[(ks + 7) * 65]);
            o1.x = pk2(s[(ks + 8) * 65], s[(ks + 9) * 65]); o1.y = pk2(s[(ks + 10) * 65], s[(ks + 11) * 65]);
            o1.z = pk2(s[(ks + 12) * 65], s[(ks + 13) * 65]); o1.w = pk2(s[(ks + 14) * 65], s[(ks + 15) * 65]);
            u32x4* dst = (u32x4*)(WT + (size_t)np * K + k0 + ks);
            dst[0] = o0; dst[1] = o1;
        }
    }
    __syncthreads();
}

__device__ __forceinline__ void cvt_item(const float* src, bf16_t* dst, int item) {
    const size_t base = (size_t)item * 8192 + threadIdx.x * 8;
#pragma unroll
    for (int i = 0; i < 4; ++i) {
        const size_t o = base + (size_t)i * 2048;
        const f32x4 a = *(const f32x4*)(src + o), b = *(const f32x4*)(src + o + 4);
        u32x4 w; w.x = pk2(a.x, a.y); w.y = pk2(a.z, a.w); w.z = pk2(b.x, b.y); w.w = pk2(b.z, b.w);
        *(u32x4*)(dst + o) = w;
    }
}
__device__ __forceinline__ void zero_item(bf16_t* dst, int item) {
    const size_t base = (size_t)item * 8192 + threadIdx.x * 8;
#pragma unroll
    for (int i = 0; i < 4; ++i) *(u32x4*)(dst + base + (size_t)i * 2048) = (u32x4){0u, 0u, 0u, 0u};
}

struct cpx { float re, im; };
__device__ __forceinline__ cpx cmul(cpx a, cpx b) { return {a.re * b.re - a.im * b.im, a.re * b.im + a.im * b.re}; }
__device__ __forceinline__ cpx cexp_pow(float are, float aim, float dt, int m) {
    const float mag = __expf(are * dt * (float)m);
    const double rev = (double)aim * (double)dt * (double)m * 0.15915494309189535;
    const float fr = (float)(rev - rint(rev));
    return {mag * __builtin_amdgcn_cosf(fr), mag * __builtin_amdgcn_sinf(fr)};
}
__device__ __forceinline__ cpx s5_coef(float are, float aim, float dt) {
    cpx ab = cexp_pow(are, aim, dt, 1);
    const float nr = ab.re - 1.0f, ni = ab.im, den = are * are + aim * aim;
    return {(nr * are + ni * aim) / den, (ni * are - nr * aim) / den};
}

__device__ __forceinline__ void prep_s5_T_item(const Params& p, int item) {
    const int gid = item * 256 + threadIdx.x;
    const int g = gid >> 9, m = (gid >> 4) & 31, i = gid & 15;
    const float* a_re = p.in[7] + g * 64; const float* a_im = p.in[8] + g * 64;
    const float dt = __expf(p.in[9][g]);
    const float* b_re = p.in[10] + (size_t)g * 64 * 16; const float* b_im = p.in[11] + (size_t)g * 64 * 16;
    const float* c_re = p.in[12] + (size_t)g * 16 * 64 + i * 64; const float* c_im = p.in[13] + (size_t)g * 16 * 64 + i * 64;
    float acc[16];
#pragma unroll
    for (int j = 0; j < 16; ++j) acc[j] = 0.f;
    for (int q = 0; q < 64; ++q) {
        const float are = a_re[q], aim = a_im[q];
        cpx z = cmul(cmul({c_re[q], c_im[q]}, cexp_pow(are, aim, dt, m)), s5_coef(are, aim, dt));
        const f32x4* br = (const f32x4*)(b_re + q * 16); const f32x4* bi = (const f32x4*)(b_im + q * 16);
#pragma unroll
        for (int j4 = 0; j4 < 4; ++j4) {
            const f32x4 r = br[j4], im = bi[j4];
            acc[j4 * 4 + 0] += z.re * r.x - z.im * im.x; acc[j4 * 4 + 1] += z.re * r.y - z.im * im.y;
            acc[j4 * 4 + 2] += z.re * r.z - z.im * im.z; acc[j4 * 4 + 3] += z.re * r.w - z.im * im.w;
        }
    }
    u32x4 o0, o1;
    o0.x = pk2(acc[0], acc[1]); o0.y = pk2(acc[2], acc[3]); o0.z = pk2(acc[4], acc[5]); o0.w = pk2(acc[6], acc[7]);
    o1.x = pk2(acc[8], acc[9]); o1.y = pk2(acc[10], acc[11]); o1.z = pk2(acc[12], acc[13]); o1.w = pk2(acc[14], acc[15]);
    bf16_t* TW = (bf16_t*)(p.ws + WS_TW) + (size_t)g * 640 * 512;
    const u32x4 z4 = (u32x4){0u, 0u, 0u, 0u};
    for (int lp = 0; lp + m < 32; ++lp) {
        u32x4* d = (u32x4*)(TW + (size_t)((lp + m) * 16 + i) * 512 + lp * 16);
        d[0] = o0; d[1] = o1;
        if (m > 0) { u32x4* dz = (u32x4*)(TW + (size_t)(lp * 16 + i) * 512 + (lp + m) * 16); dz[0] = z4; dz[1] = z4; }
    }
}
__device__ __forceinline__ void prep_s5_W_item(const Params& p, int item) {
    const int gid = item * 256 + threadIdx.x;
    const int g = gid >> 11, q = (gid >> 5) & 63, lp = gid & 31;
    const float are = p.in[7][g * 64 + q], aim = p.in[8][g * 64 + q];
    const float dt = __expf(p.in[9][g]);
    const cpx z = cmul(cexp_pow(are, aim, dt, 31 - lp), s5_coef(are, aim, dt));
    const float* br = p.in[10] + ((size_t)g * 64 + q) * 16; const float* bi = p.in[11] + ((size_t)g * 64 + q) * 16;
    float wr[16], wi[16];
#pragma unroll
    for (int j = 0; j < 16; ++j) { wr[j] = z.re * br[j] - z.im * bi[j]; wi[j] = z.re * bi[j] + z.im * br[j]; }
    bf16_t* TW = (bf16_t*)(p.ws + WS_TW) + (size_t)g * 640 * 512;
    u32x4* d0 = (u32x4*)(TW + (size_t)(512 + q) * 512 + lp * 16);
    u32x4* d1 = (u32x4*)(TW + (size_t)(576 + q) * 512 + lp * 16);
    d0[0] = (u32x4){pk2(wr[0], wr[1]), pk2(wr[2], wr[3]), pk2(wr[4], wr[5]), pk2(wr[6], wr[7])};
    d0[1] = (u32x4){pk2(wr[8], wr[9]), pk2(wr[10], wr[11]), pk2(wr[12], wr[13]), pk2(wr[14], wr[15])};
    d1[0] = (u32x4){pk2(wi[0], wi[1]), pk2(wi[2], wi[3]), pk2(wi[4], wi[5]), pk2(wi[6], wi[7])};
    d1[1] = (u32x4){pk2(wi[8], wi[9]), pk2(wi[10], wi[11]), pk2(wi[12], wi[13]), pk2(wi[14], wi[15])};
}
__device__ __forceinline__ void prep_s5_V_item(const Params& p, int item) {
    const int gid = item * 256 + threadIdx.x;
    const int g = gid >> 14, l = (gid >> 9) & 31, i = (gid >> 5) & 15, q0 = (gid & 31) * 2;
    const float dt = __expf(p.in[9][g]);
    float vr[2], vi[2];
#pragma unroll
    for (int e = 0; e < 2; ++e) {
        const int q = q0 + e;
        const cpx z = cmul({p.in[12][((size_t)g * 16 + i) * 64 + q], p.in[13][((size_t)g * 16 + i) * 64 + q]}, cexp_pow(p.in[7][g * 64 + q], p.in[8][g * 64 + q], dt, l + 1));
        vr[e] = z.re; vi[e] = -z.im;
    }
    bf16_t* VG = (bf16_t*)(p.ws + WS_VG) + ((size_t)g * 512 + l * 16 + i) * 128;
    *(unsigned*)(VG + q0) = pk2(vr[0], vr[1]);
    *(unsigned*)(VG + 64 + q0) = pk2(vi[0], vi[1]);
}
__device__ __forceinline__ void prep_al_item(const Params& p, int item) {
    const int gid = item * 256 + threadIdx.x;
    const int g = gid >> 6;
    const float dt = __expf(p.in[9][g]);
    const cpx z = cexp_pow(p.in[7][gid], p.in[8][gid], dt, S5L);
    f32x2* AL = (f32x2*)(p.ws + WS_MISC + 4096);
    AL[gid] = (f32x2){z.re, z.im};
}
__device__ __forceinline__ void prep_rope_item(const Params& p, int item) {
    const int gid = item * 256 + threadIdx.x;
    const int pos = gid >> 5, j = gid & 31;
    const float freq = exp2f(-(float)j * (13.287712379549449f / 32.0f));
    const float ang = (float)pos * freq;
    const double rev = (double)ang * 0.15915494309189535;
    const float fr = (float)(rev - rint(rev));
    f32x2* R = (f32x2*)(p.ws + WS_ROPE);
    R[gid] = (f32x2){__builtin_amdgcn_cosf(fr), __builtin_amdgcn_sinf(fr)};
}
__device__ __forceinline__ void prep_cmpbias_item(const Params& p, int item, float* lds) {
    const int kv = item >> 3, cg0 = (item & 7) * 32;
    const float* pe = p.in[17 + kv]; const float* w1 = p.in[kv == 0 ? 19 : 21];
    const int tid = threadIdx.x, col = cg0 + (tid & 31), kg = tid >> 5;
    float s = 0.f;
#pragma unroll 8
    for (int k = kg * 256; k < kg * 256 + 256; ++k) s += pe[k] * w1[(size_t)k * 256 + col];
    lds[tid] = s;
    __syncthreads();
    if (tid < 32) {
        float t = 0.f;
#pragma unroll
        for (int q = 0; q < 8; ++q) t += lds[q * 32 + tid];
        ((float*)(p.ws + WS_MISC))[kv * 256 + cg0 + tid] = t;
    }
    __syncthreads();
}

__device__ __forceinline__ void cvt_fp8_item(const float* src, unsigned char* dst, float* inv_scale, int item, const bool slice_major) {
    const int lane = threadIdx.x & 63, row0 = item * 16 + (threadIdx.x >> 6) * 4;
    f32x4 v[4][4];
#pragma unroll
    for (int r = 0; r < 4; ++r) {
        const f32x4* sp = (const f32x4*)(src + (size_t)(row0 + r) * D + lane * 16);
#pragma unroll
        for (int q = 0; q < 4; ++q) v[r][q] = sp[q];
    }
#pragma unroll
    for (int r = 0; r < 4; ++r) {
        float m = 0.f;
#pragma unroll
        for (int q = 0; q < 4; ++q) m = fmaxf(m, fmaxf(fmaxf(fabsf(v[r][q].x), fabsf(v[r][q].y)), fmaxf(fabsf(v[r][q].z), fabsf(v[r][q].w))));
#pragma unroll
        for (int o = 1; o < 64; o <<= 1) m = fmaxf(m, __shfl_xor(m, o));
        const float sc = m > 0.f ? 224.0f / m : 1.0f;
        unsigned w[4];
#pragma unroll
        for (int q = 0; q < 4; ++q) { int t = 0; t = __builtin_amdgcn_cvt_pk_fp8_f32(v[r][q].x * sc, v[r][q].y * sc, t, false); t = __builtin_amdgcn_cvt_pk_fp8_f32(v[r][q].z * sc, v[r][q].w * sc, t, true); w[q] = (unsigned)t; }
        const int row = row0 + r;
        const u32x4 wv = (u32x4){w[0], w[1], w[2], w[3]};
        if (slice_major) *(u32x4*)(dst + (size_t)(lane >> 3) * (PE * 128) + (size_t)row * 128 + (lane & 7) * 16) = wv;
        else *(u32x4*)(dst + (size_t)row * D + lane * 16) = wv;
        if (lane == 0) inv_scale[row] = m > 0.f ? m / 224.0f : 1.0f;
    }
}
__device__ __forceinline__ void cvt_fp6_item(const float* src, unsigned char* dst, float* inv_scale, int item) {
    const int lane = threadIdx.x & 63, half = lane >> 5, gl = lane & 31, row0 = item * 16 + (threadIdx.x >> 6) * 4;
#pragma unroll
    for (int pr = 0; pr < 2; ++pr) {
        const int row = row0 + pr * 2 + half;
        const f32x4* sp = (const f32x4*)(src + (size_t)row * D + gl * 32);
        f32x4 v[8];
#pragma unroll
        for (int q = 0; q < 8; ++q) v[q] = sp[q];
        float m = 0.f;
#pragma unroll
        for (int q = 0; q < 8; ++q) m = fmaxf(m, fmaxf(fmaxf(fabsf(v[q].x), fabsf(v[q].y)), fmaxf(fabsf(v[q].z), fabsf(v[q].w))));
#pragma unroll
        for (int o = 1; o < 32; o <<= 1) m = fmaxf(m, __shfl_xor(m, o));
        const float sc = m > 0.f ? 7.5f / m : 1.0f;
        v16f x0, x1;
#pragma unroll
        for (int q = 0; q < 8; ++q) {
            x0[q * 2 + 0] = v[q].x * sc; x1[q * 2 + 0] = v[q].y * sc; x0[q * 2 + 1] = v[q].z * sc; x1[q * 2 + 1] = v[q].w * sc;
        }
        const v6u w = __builtin_amdgcn_cvt_scalef32_2xpk16_fp6_f32(x0, x1, 1.0f);
        u32x2* dp = (u32x2*)(dst + (size_t)row * 768 + gl * 24);
        dp[0] = (u32x2){w[0], w[1]}; dp[1] = (u32x2){w[2], w[3]}; dp[2] = (u32x2){w[4], w[5]};
        if (gl == 0) inv_scale[row] = m > 0.f ? m / 7.5f : 1.0f;
    }
}
constexpr int P0_MOD = 384;
constexpr int P0_T_WIN = 16 * 16, P0_T_WGLU = 16 * 32, P0_T_WPROJ = 16 * 41, P0_T_WK1 = 32 * 4, P0_T_WK2 = 4 * 1, P0_T_WO = 16 * 16, P0_T_WQ = 16 * 32;
constexpr int P0_SUBK = (2 * 8 * 2 * 128 * 128) / 8192;
constexpr int P0_TAB = PE / 16;
constexpr int P0_S5T = 128, P0_S5W = 512, P0_S5V = 4096, P0_AL = 16, P0_ROPE = 2048, P0_CB = 16, P0_ZERO = 10 + 2;

__device__ __forceinline__ void phase_prep(const Params& p, float* lds, const int part) {
    const int n0 = P0_MOD;
    const int n1 = n0 + P0_T_WIN, n2 = n1 + P0_T_WGLU, n3 = n2 + P0_T_WPROJ, n4 = n3 + P0_T_WK1, n5 = n4 + P0_T_WK1, n6 = n5 + P0_T_WK2, n7 = n6 + P0_T_WK2,
              n8 = n7 + P0_T_WO, n9 = n8 + P0_T_WQ, n10 = n9 + P0_T_WQ, n11 = n10 + P0_SUBK, n12 = n11 + P0_TAB, n13 = n12 + P0_TAB,
              n14 = n13 + P0_S5T, n15 = n14 + P0_S5W, n16 = n15 + P0_S5V, n17 = n16 + P0_AL, n18 = n17 + P0_ROPE, n19 = n18 + P0_CB, n20 = n19 + 10, n21 = n20 + 2, n22 = n21 + 2;
    unsigned char* ws = p.ws;
#ifndef PREP_DUP_LO
#define PREP_DUP_LO 0
#define PREP_DUP_HI 0
#endif
    const int dupn = (PREP_DUP_HI) - (PREP_DUP_LO);
    const int nB = (n8 - n2) + (n10 - n9) + (n22 - n17);
    const int first = part == 0 ? (int)blockIdx.x : (int)blockIdx.x - 32, stride = part == 0 ? (int)gridDim.x : (int)gridDim.x - 32;
    if (first < 0 || stride <= 0) return;
    const int total = part == 0 ? (n22 - nB) + dupn : nB;
    for (int it0 = first; it0 < total; it0 += stride) {
        int it;
        if (part == 0) {
            it = it0;
            if (it >= n2) it += (n8 - n2);
            if (it >= n9) it += (n10 - n9);
            if (it0 >= (n22 - nB)) it = (PREP_DUP_LO) + (it0 - (n22 - nB));
        } else {
            it = n2 + it0;
            if (it >= n8) it += (n9 - n8);
            if (it >= n10) it += (n17 - n10);
        }
        if (it < n0) prep_mod_item(p, it, lds);
        else if (it < n1) prep_transpose_item<0>(p.in[6], 1024, 1024, (bf16_t*)(ws + WS_WIN_T), it - n0, lds);
        else if (it < n2) prep_transpose_item<1>(p.in[15], 1024, 2048, (bf16_t*)(ws + WS_WGLU_T), it - n1, lds);
        else if (it < n3) prep_transpose_item<0>(p.in[16], 1024, NPROJ, (bf16_t*)(ws + WS_WPROJ_T), it - n2, lds);
        else if (it < n4) prep_transpose_item<0>(p.in[19], 2048, 256, (bf16_t*)(ws + WS_WK1_T), it - n3, lds);
        else if (it < n5) prep_transpose_item<0>(p.in[21], 2048, 256, (bf16_t*)(ws + WS_WV1_T), it - n4, lds);
        else if (it < n6) prep_transpose_item<0>(p.in[20], 256, 64, (bf16_t*)(ws + WS_WK2_T), it - n5, lds);
        else if (it < n7) prep_transpose_item<0>(p.in[22], 256, 64, (bf16_t*)(ws + WS_WV2_T), it - n6, lds);
        else if (it < n8) prep_transpose_item<0>(p.in[23], 1024, 1024, (bf16_t*)(ws + WS_WO_T), it - n7, lds);
        else if (it < n9) prep_transpose_item<0>(p.in[24], 1024, 2048, (bf16_t*)(ws + WS_WQ_T), it - n8, lds);
        else if (it < n10) prep_transpose_item<0>(p.in[24] + (size_t)1024 * 2048, 1024, 2048, (bf16_t*)(ws + WS_WQ_T) + (size_t)2048 * 1024, it - n9, lds);
        else if (it < n11) cvt_item(p.in[25], (bf16_t*)(ws + WS_SUBK), it - n10);
        else if (it < n12) cvt_fp6_item(p.in[26], ws + WS_PU, (float*)(ws + WS_PU + 24 * MiB), it - n11);
        else if (it < n13) cvt_fp6_item(p.in[27], ws + WS_PV, (float*)(ws + WS_PV + 24 * MiB), it - n12);
        else if (it < n14) prep_s5_T_item(p, it - n13);
        else if (it < n15) prep_s5_W_item(p, it - n14);
        else if (it < n16) prep_s5_V_item(p, it - n15);
        else if (it < n17) prep_al_item(p, it - n16);
        else if (it < n18) prep_rope_item(p, it - n17);
        else if (it < n19) prep_cmpbias_item(p, it - n18, lds);
        else if (it < n20) zero_item((bf16_t*)(ws + WS_WPROJ_T) + (size_t)NPROJ * 1024, it - n19);
        else if (it < n21) zero_item((bf16_t*)(ws + WS_WK2_T) + (size_t)64 * 256, it - n20);
        else zero_item((bf16_t*)(ws + WS_WV2_T) + (size_t)64 * 256, it - n21);
    }
}

__device__ __forceinline__ void phase_norm(const Params& p, const float* X, const float* gw, const float* shift, const float* scale  , bf16_t* HM) {
    const int lane = threadIdx.x & 63, wave = threadIdx.x >> 6;
    for (int row = blockIdx.x * 4 + wave; row < T; row += gridDim.x * 4) {
        const int b = row / SEQ;
        const f32x4* xr = (const f32x4*)(X + (size_t)row * D) + lane;
        f32x4 v[4]; float s = 0.f;
#pragma unroll
        for (int j = 0; j < 4; ++j) { v[j] = xr[64 * j]; s += (v[j].x * v[j].x + v[j].y * v[j].y) + (v[j].z * v[j].z + v[j].w * v[j].w); }
        const float rs = rsqrtf(wave_sum(s) * (1.0f / D) + RMS_EPS);
        u32x2* o = (u32x2*)(HM + (size_t)row * D) + lane;
#pragma unroll
        for (int j = 0; j < 4; ++j) {
            const int c = lane * 4 + 256 * j;
            const f32x4 g = *(const f32x4*)(gw + c), sh = *(const f32x4*)(shift + (size_t)b * 6144 + c), sc = *(const f32x4*)(scale + (size_t)b * 6144 + c);
            const float y0 = v[j].x * rs * g.x * (1.f + sc.x) + sh.x, y1 = v[j].y * rs * g.y * (1.f + sc.y) + sh.y;
            const float y2 = v[j].z * rs * g.z * (1.f + sc.z) + sh.z, y3 = v[j].w * rs * g.w * (1.f + sc.w) + sh.w;
            o[64 * j] = (u32x2){pk2(y0, y1), pk2(y2, y3)};
        }
    }
}
__device__ __forceinline__ void phase_final_norm(const Params& p, const float* X, float* OUT, bool dry) {
    const int lane = threadIdx.x & 63, wave = threadIdx.x >> 6;
    const float* gw = p.in[28];
    for (int row = blockIdx.x * 4 + wave; row < T; row += gridDim.x * 4) {
        const f32x4* xr = (const f32x4*)(X + (size_t)row * D) + lane;
        f32x4 v[4]; float s = 0.f;
#pragma unroll
        for (int j = 0; j < 4; ++j) { v[j] = xr[64 * j]; s += (v[j].x * v[j].x + v[j].y * v[j].y) + (v[j].z * v[j].z + v[j].w * v[j].w); }
        const float rs = rsqrtf(wave_sum(s) * (1.0f / D) + RMS_EPS);
        f32x4* o = (f32x4*)(OUT + (size_t)row * D) + lane;
#pragma unroll
        for (int j = 0; j < 4; ++j) {
            const f32x4 g = *(const f32x4*)(gw + lane * 4 + 256 * j);
            if (!dry) o[64 * j] = (f32x4){v[j].x * rs * g.x, v[j].y * rs * g.y, v[j].z * rs * g.z, v[j].w * rs * g.w};
        }
    }
}

__device__ __forceinline__ int vblock() { const int G = gridDim.x, bx = blockIdx.x; return (G % 8 == 0) ? (bx % 8) * (G / 8) + bx / 8 : bx; }
struct ALoadPlain {
    const bf16_t* A; size_t lda;
    __device__ __forceinline__ const bf16_t* base(int kt) const { return A + kt * 64; }
    __device__ __forceinline__ unsigned off(int r, int lc) const { return (unsigned)r * (unsigned)lda + (unsigned)lc * 8u; }
};
struct ALoadGroup {
    const bf16_t* A;
    __device__ __forceinline__ const bf16_t* base(int kt) const { return A + (size_t)kt * 4 * T * 16; }
    __device__ __forceinline__ unsigned off(int r, int lc) const { return ((unsigned)(lc >> 1) * (unsigned)T + (unsigned)r) * 16u + (unsigned)(lc & 1) * 8u; }
};

template <class AL>
__device__ __forceinline__ void gemm_tile2(const AL al, const bf16_t* __restrict__ Bt, size_t ldb, int nk, f32x4 (&acc)[4][4], unsigned char* lds) {
    const int tid = threadIdx.x, lane = tid & 63, wid = tid >> 6, wr = wid >> 1, wc = wid & 1, fr = lane & 15, fq = lane >> 4;
    const int lr = tid >> 3, lc = tid & 7;
#pragma unroll
    for (int mi = 0; mi < 4; ++mi)
#pragma unroll
        for (int ni = 0; ni < 4; ++ni) acc[mi][ni] = (f32x4){0.f, 0.f, 0.f, 0.f};
    u32x4 ra0[4], rb0[4], ra1[4], rb1[4];
    const int soff = lr * 128 + ((lc ^ (lr & 7)) << 4);
    unsigned offA[4], offB[4];
#pragma unroll
    for (int i = 0; i < 4; ++i) { offA[i] = al.off(lr + 32 * i, lc); offB[i] = (unsigned)(lr + 32 * i) * (unsigned)ldb + (unsigned)lc * 8u; }
#define GT_LOAD(RA, RB, kt_) do { const bf16_t* ab_ = al.base(kt_); const bf16_t* bb_ = Bt + (kt_) * 64; _Pragma("unroll") for (int i = 0; i < 4; ++i) { RA[i] = *(const u32x4*)(ab_ + offA[i]); RB[i] = *(const u32x4*)(bb_ + offB[i]); } } while (0)
#define GT_STORE(RA, RB, buf_) do { unsigned char* nb_ = lds + (buf_) * 32768; _Pragma("unroll") for (int i = 0; i < 4; ++i) { *(u32x4*)(nb_ + soff + i * 4096) = RA[i]; *(u32x4*)(nb_ + 16384 + soff + i * 4096) = RB[i]; } } while (0)
    const int aoff = (wr * 64 + fr) * 128, boff = 16384 + (wc * 64 + fr) * 128, sw = fr & 7;
#define GT_MATH(buf_) do { const unsigned char* bp_ = lds + (buf_) * 32768; _Pragma("unroll") for (int ks = 0; ks < 2; ++ks) { bf16x8 af[4], bfr[4]; const int co = ((ks * 4 + fq) ^ sw) << 4; \
        _Pragma("unroll") for (int mi = 0; mi < 4; ++mi) af[mi] = *(const bf16x8*)(bp_ + aoff + mi * 2048 + co); \
        _Pragma("unroll") for (int ni = 0; ni < 4; ++ni) bfr[ni] = *(const bf16x8*)(bp_ + boff + ni * 2048 + co); \
        _Pragma("unroll") for (int mi = 0; mi < 4; ++mi) _Pragma("unroll") for (int ni = 0; ni < 4; ++ni) acc[mi][ni] = __builtin_amdgcn_mfma_f32_16x16x32_bf16(bfr[ni], af[mi], acc[mi][ni], 0, 0, 0); } } while (0)
    GT_LOAD(ra0, rb0, 0);
    if (nk > 1) GT_LOAD(ra1, rb1, 1);
    GT_STORE(ra0, rb0, 0);
    __syncthreads();
    for (int kt = 0; kt < nk; kt += 2) {
        if (kt + 2 < nk) GT_LOAD(ra0, rb0, kt + 2);
        __builtin_amdgcn_sched_barrier(0);
        GT_MATH(0);
        __builtin_amdgcn_sched_barrier(0);
        if (kt + 1 < nk) GT_STORE(ra1, rb1, 1);
        __syncthreads();
        if (kt + 1 >= nk) break;
        if (kt + 3 < nk) GT_LOAD(ra1, rb1, kt + 3);
        __builtin_amdgcn_sched_barrier(0);
        GT_MATH(1);
        __builtin_amdgcn_sched_barrier(0);
        if (kt + 2 < nk) GT_STORE(ra0, rb0, 0);
        __syncthreads();
    }
#undef GT_LOAD
#undef GT_STORE
#undef GT_MATH
}

template <class AL>
__device__ __forceinline__ void gemm_tile1(const AL al, const bf16_t* __restrict__ Bt, size_t ldb, int nk, f32x4 (&acc)[4][4], unsigned char* lds) {
    const int tid = threadIdx.x, lane = tid & 63, wid = tid >> 6, wr = wid >> 1, wc = wid & 1, fr = lane & 15, fq = lane >> 4;
    const int lr = tid >> 3, lc = tid & 7;
#pragma unroll
    for (int mi = 0; mi < 4; ++mi)
#pragma unroll
        for (int ni = 0; ni < 4; ++ni) acc[mi][ni] = (f32x4){0.f, 0.f, 0.f, 0.f};
    u32x4 ra[4], rb[4];
    const int soff = lr * 128 + ((lc ^ (lr & 7)) << 4);
#pragma unroll
    for (int i = 0; i < 4; ++i) { ra[i] = *(const u32x4*)(al.base(0) + al.off(lr + 32 * i, lc)); rb[i] = *(const u32x4*)(Bt + (size_t)(lr + 32 * i) * ldb + lc * 8); }
#pragma unroll
    for (int i = 0; i < 4; ++i) { *(u32x4*)(lds + soff + i * 4096) = ra[i]; *(u32x4*)(lds + 16384 + soff + i * 4096) = rb[i]; }
    __syncthreads();
    const int aoff = (wr * 64 + fr) * 128, boff = 16384 + (wc * 64 + fr) * 128, sw = fr & 7;
    for (int kt = 0; kt < nk; ++kt) {
        const bool more = (kt + 1 < nk);
        if (more) {
#pragma unroll
            for (int i = 0; i < 4; ++i) { ra[i] = *(const u32x4*)(al.base(kt + 1) + al.off(lr + 32 * i, lc)); rb[i] = *(const u32x4*)(Bt + (size_t)(lr + 32 * i) * ldb + (kt + 1) * 64 + lc * 8); }
        }
        const unsigned char* buf = lds + (kt & 1) * 32768;
#pragma unroll
        for (int ks = 0; ks < 2; ++ks) {
            bf16x8 af[4], bfr[4];
            const int co = ((ks * 4 + fq) ^ sw) << 4;
#pragma unroll
            for (int mi = 0; mi < 4; ++mi) af[mi] = *(const bf16x8*)(buf + aoff + mi * 2048 + co);
#pragma unroll
            for (int ni = 0; ni < 4; ++ni) bfr[ni] = *(const bf16x8*)(buf + boff + ni * 2048 + co);
#pragma unroll
            for (int mi = 0; mi < 4; ++mi)
#pragma unroll
                for (int ni = 0; ni < 4; ++ni) acc[mi][ni] = __builtin_amdgcn_mfma_f32_16x16x32_bf16(bfr[ni], af[mi], acc[mi][ni], 0, 0, 0);
        }
        if (more) {
            unsigned char* nb = lds + ((kt + 1) & 1) * 32768;
#pragma unroll
            for (int i = 0; i < 4; ++i) { *(u32x4*)(nb + soff + i * 4096) = ra[i]; *(u32x4*)(nb + 16384 + soff + i * 4096) = rb[i]; }
        }
        __syncthreads();
    }
}

template <class AL, bool ZERO = true>
__device__ __forceinline__ void gemm_tile3(const AL al, const bf16_t* __restrict__ Bt, size_t ldb, int nk, f32x4 (&acc)[4][4], unsigned char* lds) {
    const int tid = threadIdx.x, lane = tid & 63, wid = tid >> 6, wr = wid >> 1, wc = wid & 1, fr = lane & 15, fq = lane >> 4;
    if (ZERO) {
#pragma unroll
    for (int mi = 0; mi < 4; ++mi)
#pragma unroll
        for (int ni = 0; ni < 4; ++ni) acc[mi][ni] = (f32x4){0.f, 0.f, 0.f, 0.f};
    }
    const int srow = wid * 32 + (lane >> 3), schunk = (lane & 7) ^ ((lane >> 3) & 7);
    unsigned offA[4], offB[4];
#pragma unroll
    for (int i = 0; i < 4; ++i) { offA[i] = al.off(srow + 8 * i, schunk); offB[i] = (unsigned)(srow + 8 * i) * (unsigned)ldb + (unsigned)schunk * 8u; }
#define G3_STAGE(buf_, kt_) do { const bf16_t* ab_ = al.base(kt_); const bf16_t* bb_ = Bt + (kt_) * 64; unsigned char* lb_ = lds + (buf_) * 32768 + wid * 4096; \
        _Pragma("unroll") for (int i = 0; i < 4; ++i) { \
            __builtin_amdgcn_global_load_lds((const unsigned*)(ab_ + offA[i]), (unsigned*)(lb_ + i * 1024), 16, 0, 0); \
            __builtin_amdgcn_global_load_lds((const unsigned*)(bb_ + offB[i]), (unsigned*)(lb_ + 16384 + i * 1024), 16, 0, 0); } } while (0)
    const int aoff = (wr * 64 + fr) * 128, boff = 16384 + (wc * 64 + fr) * 128, sw = fr & 7;
    G3_STAGE(0, 0);
    __syncthreads();
    for (int kt = 0; kt < nk; ++kt) {
        if (kt + 1 < nk) G3_STAGE((kt + 1) & 1, kt + 1);
        const unsigned char* buf = lds + (kt & 1) * 32768;
#pragma unroll
        for (int ks = 0; ks < 2; ++ks) {
            bf16x8 af[4], bfr[4];
            const int co = ((ks * 4 + fq) ^ sw) << 4;
#pragma unroll
            for (int mi = 0; mi < 4; ++mi) af[mi] = *(const bf16x8*)(buf + aoff + mi * 2048 + co);
#pragma unroll
            for (int ni = 0; ni < 4; ++ni) bfr[ni] = *(const bf16x8*)(buf + boff + ni * 2048 + co);
#pragma unroll
            for (int mi = 0; mi < 4; ++mi)
#pragma unroll
                for (int ni = 0; ni < 4; ++ni) acc[mi][ni] = __builtin_amdgcn_mfma_f32_16x16x32_bf16(bfr[ni], af[mi], acc[mi][ni], 0, 0, 0);
        }
        __syncthreads();
    }
#undef G3_STAGE
}

__device__ __forceinline__ void mma_ktile(const unsigned char* buf, f32x4 (&acc)[4][4]) {
    const int tid = threadIdx.x, lane = tid & 63, wid = tid >> 6, wr = wid >> 1, wc = wid & 1, fr = lane & 15, fq = lane >> 4;
    const int aoff = (wr * 64 + fr) * 128, boff = 16384 + (wc * 64 + fr) * 128, sw = fr & 7;
#pragma unroll
    for (int ks = 0; ks < 2; ++ks) {
        bf16x8 af[4], bfr[4];
        const int co = ((ks * 4 + fq) ^ sw) << 4;
#pragma unroll
        for (int mi = 0; mi < 4; ++mi) af[mi] = *(const bf16x8*)(buf + aoff + mi * 2048 + co);
#pragma unroll
        for (int ni = 0; ni < 4; ++ni) bfr[ni] = *(const bf16x8*)(buf + boff + ni * 2048 + co);
#pragma unroll
        for (int mi = 0; mi < 4; ++mi)
#pragma unroll
            for (int ni = 0; ni < 4; ++ni) acc[mi][ni] = __builtin_amdgcn_mfma_f32_16x16x32_bf16(bfr[ni], af[mi], acc[mi][ni], 0, 0, 0);
    }
}
__device__ __forceinline__ void phase_s5_win(const Params& p, unsigned char* lds) {
    const bf16_t* HM = (const bf16_t*)(p.ws + WS_HM); const bf16_t* WT = (const bf16_t*)(p.ws + WS_WIN_T);
    bf16_t* UG = (bf16_t*)(p.ws + WS_UG);
    const int lane = threadIdx.x & 63, wid = threadIdx.x >> 6, wr = wid >> 1, wc = wid & 1, fr = lane & 15, fq = lane >> 4;
    for (int id = vblock(); id < 256 * 8; id += gridDim.x) {
        const int mt = id >> 3, nt = id & 7;
        f32x4 acc[4][4];
        gemm_tile3(ALoadPlain{HM + (size_t)mt * 128 * D, (size_t)D}, WT + (size_t)nt * 128 * D, D, 16, acc, lds);
#pragma unroll
        for (int mi = 0; mi < 4; ++mi)
#pragma unroll
            for (int ni = 0; ni < 4; ++ni) {
                const int t = mt * 128 + wr * 64 + mi * 16 + fr, g = nt * 8 + wc * 4 + ni;
                const f32x4 v = acc[mi][ni];
                *(u32x2*)(UG + ((size_t)g * T + t) * 16 + fq * 4) = (u32x2){pk2(v.x, v.y), pk2(v.z, v.w)};
            }
    }
}
__device__ __forceinline__ void phase_s5_a(const Params& p, unsigned char* lds) {
    const bf16_t* UG = (const bf16_t*)(p.ws + WS_UG); const bf16_t* TW = (const bf16_t*)(p.ws + WS_TW);
    float* WST = (float*)(p.ws + WS_WST);
    const int lane = threadIdx.x & 63, wid = threadIdx.x >> 6, wr = wid >> 1, wc = wid & 1, fr = lane & 15, fq = lane >> 4;
    for (int id = vblock(); id < 64 * 8; id += gridDim.x) {
        const int g = id >> 3, mt = id & 7;
        f32x4 acc[4][4];
        gemm_tile3(ALoadPlain{UG + (size_t)g * T * 16 + (size_t)mt * 128 * 512, (size_t)512}, TW + ((size_t)g * 640 + 512) * 512, 512, 8, acc, lds);
#pragma unroll
        for (int mi = 0; mi < 4; ++mi)
#pragma unroll
            for (int ni = 0; ni < 4; ++ni) {
                const int R = mt * 128 + wr * 64 + mi * 16 + fr, c = wc * 64 + ni * 16 + fq * 4;
                *(f32x4*)(WST + ((size_t)g * 1024 + R) * 128 + c) = acc[mi][ni];
            }
    }
}
__device__ __forceinline__ void phase_s5_scan(const Params& p) {
    const int lane = threadIdx.x & 63, wave = threadIdx.x >> 6;
    const float* WST = (const float*)(p.ws + WS_WST); bf16_t* SST = (bf16_t*)(p.ws + WS_SST);
    const f32x2* AL = (const f32x2*)(p.ws + WS_MISC + 4096);
    for (int it = blockIdx.x * 4 + wave; it < 128; it += gridDim.x * 4) {
        const int b = it >> 6, g = it & 63;
        const f32x2 al = AL[g * 64 + lane];
        float sr = 0.f, si = 0.f;
        const float* wbase = WST + ((size_t)g * 1024 + b * 512) * 128 + lane;
        bf16_t* sbase = SST + ((size_t)g * 1024 + b * 512) * 128 + lane;
        for (int n0 = 0; n0 < 512; n0 += 16) {
            float wre[16], wim[16];
#pragma unroll
            for (int j = 0; j < 16; ++j) { wre[j] = wbase[(size_t)(n0 + j) * 128]; wim[j] = wbase[(size_t)(n0 + j) * 128 + 64]; }
#pragma unroll
            for (int j = 0; j < 16; ++j) {
                sbase[(size_t)(n0 + j) * 128] = (bf16_t)f2bf(sr); sbase[(size_t)(n0 + j) * 128 + 64] = (bf16_t)f2bf(si);
                const float nr = al.x * sr - al.y * si + wre[j], ni = al.x * si + al.y * sr + wim[j];
                sr = nr; si = ni;
            }
        }
    }
}
__device__ __forceinline__ void phase_s5_b(const Params& p, unsigned char* lds) {
    const bf16_t* SST = (const bf16_t*)(p.ws + WS_SST); const bf16_t* VG = (const bf16_t*)(p.ws + WS_VG);
    const bf16_t* UG = (const bf16_t*)(p.ws + WS_UG); const bf16_t* TW = (const bf16_t*)(p.ws + WS_TW);
    bf16_t* YG = (bf16_t*)(p.ws + WS_YG);
    const float* dsk = p.in[14];
    const int lane = threadIdx.x & 63, wid = threadIdx.x >> 6, wr = wid >> 1, wc = wid & 1, fr = lane & 15, fq = lane >> 4;
    for (int id = vblock(); id < 64 * 32; id += gridDim.x) {
        const int g = id >> 5, mt = (id >> 2) & 7, nt = 3 - (id & 3);
        f32x4 acc[4][4];
        gemm_tile3<ALoadPlain, true>(ALoadPlain{UG + (size_t)g * T * 16 + (size_t)mt * 128 * 512, (size_t)512}, TW + ((size_t)g * 640 + nt * 128) * 512, 512, 2 * (nt + 1), acc, lds);
        gemm_tile3<ALoadPlain, false>(ALoadPlain{SST + ((size_t)g * 1024 + mt * 128) * 128, (size_t)128}, VG + ((size_t)g * 512 + nt * 128) * 128, 128, 2, acc, lds);
        const f32x4 dv = *(const f32x4*)(dsk + g * 16 + fq * 4);
#pragma unroll
        for (int mi = 0; mi < 4; ++mi)
#pragma unroll
            for (int ni = 0; ni < 4; ++ni) {
                const int R = mt * 128 + wr * 64 + mi * 16 + fr, c = nt * 128 + wc * 64 + ni * 16 + fq * 4;
                const size_t idx = ((size_t)g * 1024 + R) * 512 + c;
                const u32x2 uu = *(const u32x2*)(UG + idx);
                const f32x4 v = acc[mi][ni];
                const float y0 = gelu_tanh(v.x + dv.x * bflo(uu.x)), y1 = gelu_tanh(v.y + dv.y * bfhi(uu.x));
                const float y2 = gelu_tanh(v.z + dv.z * bflo(uu.y)), y3 = gelu_tanh(v.w + dv.w * bfhi(uu.y));
                *(u32x2*)(YG + idx) = (u32x2){pk2(y0, y1), pk2(y2, y3)};
            }
    }
}
__device__ __forceinline__ void phase_s5_glu(const Params& p, unsigned char* lds) {
    const bf16_t* YG = (const bf16_t*)(p.ws + WS_YG); const bf16_t* WT = (const bf16_t*)(p.ws + WS_WGLU_T);
    const float* MOD = (const float*)(p.ws + WS_MOD);
    const float* X = p.in[0]; float* XO = p.out;
    const int lane = threadIdx.x & 63, wid = threadIdx.x >> 6, wr = wid >> 1, wc = wid & 1, fr = lane & 15, fq = lane >> 4;
    for (int id = vblock(); id < 256 * 16; id += gridDim.x) {
        const int mt = id >> 4, nt = id & 15;
        f32x4 acc[4][4];
        gemm_tile3(ALoadGroup{YG + (size_t)mt * 128 * 16}, WT + (size_t)nt * 128 * D, D, 16, acc, lds);
        const int b = (mt * 128) / SEQ;
#pragma unroll
        for (int mi = 0; mi < 4; ++mi)
#pragma unroll
            for (int h = 0; h < 2; ++h) {
                const int t = mt * 128 + wr * 64 + mi * 16 + fr, j = nt * 64 + wc * 32 + h * 16 + fq * 4;
                const f32x4 a = acc[mi][2 * h], gg = acc[mi][2 * h + 1];
                const f32x4 g1 = *(const f32x4*)(MOD + (size_t)(0 * 2 + b) * 6144 + 2048 + j);
                const f32x4 xi = *(const f32x4*)(X + (size_t)t * D + j);
                f32x4 o;
                o.x = xi.x + g1.x * (a.x * sigmoidf_(gg.x)); o.y = xi.y + g1.y * (a.y * sigmoidf_(gg.y));
                o.z = xi.z + g1.z * (a.z * sigmoidf_(gg.z)); o.w = xi.w + g1.w * (a.w * sigmoidf_(gg.w));
                *(f32x4*)(XO + (size_t)t * D + j) = o;
            }
    }
}
__device__ __forceinline__ void phase_peer_wq(const Params& p, int layer, unsigned char* lds) {
    const bf16_t* HM = (const bf16_t*)(p.ws + WS_HM); const bf16_t* WT = (const bf16_t*)(p.ws + WS_WQ_T) + (size_t)layer * 2048 * 1024;
    bf16_t* QK = (bf16_t*)(p.ws + WS_QK);
    const int lane = threadIdx.x & 63, wid = threadIdx.x >> 6, wr = wid >> 1, wc = wid & 1, fr = lane & 15, fq = lane >> 4;
    for (int id = vblock(); id < 256 * 16; id += gridDim.x) {
        const int mt = id >> 4, nt = id & 15;
        f32x4 acc[4][4];
        gemm_tile3(ALoadPlain{HM + (size_t)mt * 128 * D, (size_t)D}, WT + (size_t)nt * 128 * D, D, 16, acc, lds);
#pragma unroll
        for (int mi = 0; mi < 4; ++mi)
#pragma unroll
            for (int ni = 0; ni < 4; ++ni) {
                const int t = mt * 128 + wr * 64 + mi * 16 + fr, c = nt * 128 + wc * 64 + ni * 16 + fq * 4;
                const f32x4 v = acc[mi][ni];
                *(u32x2*)(QK + (size_t)t * 2048 + c) = (u32x2){pk2(v.x, v.y), pk2(v.z, v.w)};
            }
    }
}
__device__ __forceinline__ void ce_(unsigned& a, unsigned& b, const bool up) { const unsigned lo = a < b ? a : b, hi = a < b ? b : a; a = up ? lo : hi; b = up ? hi : lo; }
__device__ __forceinline__ void bitonic_sort16(unsigned* x, const bool asc) {
#pragma unroll
    for (int k = 2; k <= 16; k <<= 1)
#pragma unroll
        for (int j = k >> 1; j > 0; j >>= 1)
#pragma unroll
            for (int i = 0; i < 16; ++i) { const int l = i ^ j; if (l > i) ce_(x[i], x[l], ((i & k) == 0) == asc); }
}
__device__ __forceinline__ void bitonic_merge16(unsigned* x, const bool asc) {
#pragma unroll
    for (int j = 8; j > 0; j >>= 1)
#pragma unroll
        for (int i = 0; i < 16; ++i) { const int l = i ^ j; if (l > i) ce_(x[i], x[l], asc); }
}
__device__ __forceinline__ void phase_peer_topk(const Params& p, int layer, unsigned char* lds) {
    const bf16_t* QK = (const bf16_t*)(p.ws + WS_QK); const bf16_t* SK = (const bf16_t*)(p.ws + WS_SUBK) + (size_t)layer * 8 * 2 * 128 * 128;
    float* TOPS = (float*)(p.ws + WS_TOPS); int* TOPI = (int*)(p.ws + WS_TOPI);
    float* sc = (float*)lds;
    const int tid = threadIdx.x, lane = tid & 63, wid = tid >> 6, wr = wid >> 1, wc = wid & 1, fr = lane & 15, fq = lane >> 4;
    for (int id = vblock(); id < 256 * 16; id += gridDim.x) {
        const int mt = id >> 4, hc = id & 15;
        f32x4 acc[4][4];
        gemm_tile3(ALoadPlain{QK + (size_t)mt * 128 * 2048 + hc * 128, (size_t)2048}, SK + (size_t)hc * 128 * 128, 128, 2, acc, lds);
#pragma unroll
        for (int mi = 0; mi < 4; ++mi)
#pragma unroll
            for (int ni = 0; ni < 4; ++ni) {
                const int r = wr * 64 + mi * 16 + fr, c = wc * 64 + ni * 16 + fq * 4;
                float* d = sc + r * 129 + c;
                d[0] = acc[mi][ni].x; d[1] = acc[mi][ni].y; d[2] = acc[mi][ni].z; d[3] = acc[mi][ni].w;
            }
        __syncthreads();
        {
            const int row = tid >> 1, half = tid & 1;
            unsigned x[64];
            const float* rp = sc + row * 129 + half * 64;
#pragma unroll
            for (int j = 0; j < 64; ++j) {
                const unsigned bits = __builtin_bit_cast(unsigned, rp[j]);
                const unsigned u = bits ^ ((unsigned)((int)bits >> 31) | 0x80000000u);
                x[j] = (u & 0xFFFFFF80u) | (unsigned)(127 - (half * 64 + j));
            }
            bitonic_sort16(x, true); bitonic_sort16(x + 16, false); bitonic_sort16(x + 32, true); bitonic_sort16(x + 48, false);
#pragma unroll
            for (int i = 0; i < 16; ++i) { x[i] = x[i] > x[16 + i] ? x[i] : x[16 + i]; x[32 + i] = x[32 + i] > x[48 + i] ? x[32 + i] : x[48 + i]; }
            bitonic_merge16(x, true); bitonic_merge16(x + 32, false);
#pragma unroll
            for (int i = 0; i < 16; ++i) x[i] = x[i] > x[32 + i] ? x[i] : x[32 + i];
            bitonic_merge16(x, false);
            unsigned y[16];
#pragma unroll
            for (int i = 0; i < 16; ++i) { const unsigned o = (unsigned)__shfl_xor((int)x[15 - i], 1); y[i] = x[i] > o ? x[i] : o; }
            bitonic_merge16(y, false);
            const size_t ob = ((size_t)(mt * 128 + row) * 16 + hc) * 16;
            if (half == 0) {
                float v[16];
#pragma unroll
                for (int i = 0; i < 16; ++i) { const unsigned u = y[i] & 0xFFFFFF80u; const unsigned bits = (u & 0x80000000u) ? (u ^ 0x80000000u) : ~u; v[i] = __builtin_bit_cast(float, bits); }
#pragma unroll
                for (int q = 0; q < 4; ++q) *(f32x4*)(TOPS + ob + q * 4) = (f32x4){v[q * 4], v[q * 4 + 1], v[q * 4 + 2], v[q * 4 + 3]};
            } else {
#pragma unroll
                for (int q = 0; q < 4; ++q) *(u32x4*)(TOPI + ob + q * 4) = (u32x4){127u - (y[q * 4] & 127u), 127u - (y[q * 4 + 1] & 127u), 127u - (y[q * 4 + 2] & 127u), 127u - (y[q * 4 + 3] & 127u)};
            }
        }
        __syncthreads();
    }
}
__device__ __forceinline__ void phase_peer_wq_topk(const Params& p, int layer, unsigned char* lds) {
    const bf16_t* HM = (const bf16_t*)(p.ws + WS_HM); const bf16_t* WT = (const bf16_t*)(p.ws + WS_WQ_T) + (size_t)layer * 2048 * 1024;
    const bf16_t* SK = (const bf16_t*)(p.ws + WS_SUBK) + (size_t)layer * 8 * 2 * 128 * 128;
    float* TOPS = (float*)(p.ws + WS_TOPS); int* TOPI = (int*)(p.ws + WS_TOPI);
    float* sc = (float*)lds;
    const int tid = threadIdx.x, lane = tid & 63, wid = tid >> 6, wr = wid >> 1, wc = wid & 1, fr = lane & 15, fq = lane >> 4;
    for (int id = vblock(); id < 256 * 16; id += gridDim.x) {
        const int mt = id >> 4, hc = id & 15;
        f32x4 acc[4][4];
        gemm_tile3(ALoadPlain{HM + (size_t)mt * 128 * D, (size_t)D}, WT + (size_t)hc * 128 * D, D, 16, acc, lds);
        {
            const int srow = wid * 32 + (lane >> 3), schunk = (lane & 7) ^ ((lane >> 3) & 7);
            const bf16_t* sk = SK + (size_t)hc * 128 * 128;
#pragma unroll
            for (int kt = 0; kt < 2; ++kt)
#pragma unroll
                for (int i = 0; i < 4; ++i)
                    __builtin_amdgcn_global_load_lds((const unsigned*)(sk + (srow + 8 * i) * 128 + kt * 64 + schunk * 8), (unsigned*)(lds + kt * 32768 + 16384 + wid * 4096 + i * 1024), 16, 0, 0);
        }
#pragma unroll
        for (int mi = 0; mi < 4; ++mi)
#pragma unroll
            for (int ni = 0; ni < 4; ++ni) {
                const int r = wr * 64 + mi * 16 + fr, chunk = ni * 2 + (fq >> 1);
                const f32x4 v = acc[mi][ni];
                *(u32x2*)(lds + wc * 32768 + r * 128 + ((chunk ^ (r & 7)) << 4) + (fq & 1) * 8) = (u32x2){pk2(v.x, v.y), pk2(v.z, v.w)};
            }
        __syncthreads();
#pragma unroll
        for (int mi = 0; mi < 4; ++mi)
#pragma unroll
            for (int ni = 0; ni < 4; ++ni) acc[mi][ni] = (f32x4){0.f, 0.f, 0.f, 0.f};
        mma_ktile(lds, acc); mma_ktile(lds + 32768, acc);
        __syncthreads();
#pragma unroll
        for (int mi = 0; mi < 4; ++mi)
#pragma unroll
            for (int ni = 0; ni < 4; ++ni) {
                const int r = wr * 64 + mi * 16 + fr, c = wc * 64 + ni * 16 + fq * 4;
                float* d = sc + r * 129 + c;
                d[0] = acc[mi][ni].x; d[1] = acc[mi][ni].y; d[2] = acc[mi][ni].z; d[3] = acc[mi][ni].w;
            }
        __syncthreads();
        {
            const int row = tid >> 1, half = tid & 1;
            unsigned x[64];
            const float* rp = sc + row * 129 + half * 64;
#pragma unroll
            for (int j = 0; j < 64; ++j) {
                const unsigned bits = __builtin_bit_cast(unsigned, rp[j]);
                const unsigned u = bits ^ ((unsigned)((int)bits >> 31) | 0x80000000u);
                x[j] = (u & 0xFFFFFF80u) | (unsigned)(127 - (half * 64 + j));
            }
            bitonic_sort16(x, true); bitonic_sort16(x + 16, false); bitonic_sort16(x + 32, true); bitonic_sort16(x + 48, false);
#pragma unroll
            for (int i = 0; i < 16; ++i) { x[i] = x[i] > x[16 + i] ? x[i] : x[16 + i]; x[32 + i] = x[32 + i] > x[48 + i] ? x[32 + i] : x[48 + i]; }
            bitonic_merge16(x, true); bitonic_merge16(x + 32, false);
#pragma unroll
            for (int i = 0; i < 16; ++i) x[i] = x[i] > x[32 + i] ? x[i] : x[32 + i];
            bitonic_merge16(x, false);
            unsigned y[16];
#pragma unroll
            for (int i = 0; i < 16; ++i) { const unsigned o = (unsigned)__shfl_xor((int)x[15 - i], 1); y[i] = x[i] > o ? x[i] : o; }
            bitonic_merge16(y, false);
            const size_t ob = ((size_t)(mt * 128 + row) * 16 + hc) * 16;
            if (half == 0) {
                float v[16];
#pragma unroll
                for (int i = 0; i < 16; ++i) { const unsigned u = y[i] & 0xFFFFFF80u; const unsigned bits = (u & 0x80000000u) ? (u ^ 0x80000000u) : ~u; v[i] = __builtin_bit_cast(float, bits); }
#pragma unroll
                for (int q = 0; q < 4; ++q) *(f32x4*)(TOPS + ob + q * 4) = (f32x4){v[q * 4], v[q * 4 + 1], v[q * 4 + 2], v[q * 4 + 3]};
            } else {
#pragma unroll
                for (int q = 0; q < 4; ++q) *(u32x4*)(TOPI + ob + q * 4) = (u32x4){127u - (y[q * 4] & 127u), 127u - (y[q * 4 + 1] & 127u), 127u - (y[q * 4 + 2] & 127u), 127u - (y[q * 4 + 3] & 127u)};
            }
        }
        __syncthreads();
    }
}
__device__ __forceinline__ void phase_peer_route(const Params& p, int layer, unsigned char* lds) {
    const bf16_t* HM = (const bf16_t*)(p.ws + WS_HM); const bf16_t* WT = (const bf16_t*)(p.ws + WS_WQ_T) + (size_t)layer * 2048 * 1024;
    const bf16_t* SK = (const bf16_t*)(p.ws + WS_SUBK) + (size_t)layer * 8 * 2 * 128 * 128;
    int* EXP = (int*)(p.ws + WS_EXP); float* GATE = (float*)(p.ws + WS_GATE);
    float* sc = (float*)lds;
    unsigned* KEYS0 = (unsigned*)(lds + 66048);
    unsigned* L = (unsigned*)lds;
    const int tid = threadIdx.x, lane = tid & 63, wid = tid >> 6, wr = wid >> 1, wc = wid & 1, fr = lane & 15, fq = lane >> 4;
    for (int id = vblock(); id < 256 * 8; id += gridDim.x) {
        const int mt = id >> 3, h = id & 7;
        const int row = tid >> 1, half = tid & 1;
        unsigned y[16];
#pragma unroll 1
        for (int c = 0; c < 2; ++c) {
            const int hc = h * 2 + c;
            f32x4 acc[4][4];
            gemm_tile3(ALoadPlain{HM + (size_t)mt * 128 * D, (size_t)D}, WT + (size_t)hc * 128 * D, D, 16, acc, lds);
            {
                const int srow = wid * 32 + (lane >> 3), schunk = (lane & 7) ^ ((lane >> 3) & 7);
                const bf16_t* sk = SK + (size_t)hc * 128 * 128;
#pragma unroll
                for (int kt = 0; kt < 2; ++kt)
#pragma unroll
                    for (int i = 0; i < 4; ++i)
                        __builtin_amdgcn_global_load_lds((const unsigned*)(sk + (srow + 8 * i) * 128 + kt * 64 + schunk * 8), (unsigned*)(lds + kt * 32768 + 16384 + wid * 4096 + i * 1024), 16, 0, 0);
            }
#pragma unroll
            for (int mi = 0; mi < 4; ++mi)
#pragma unroll
                for (int ni = 0; ni < 4; ++ni) {
                    const int r = wr * 64 + mi * 16 + fr, chunk = ni * 2 + (fq >> 1);
                    const f32x4 v = acc[mi][ni];
                    *(u32x2*)(lds + wc * 32768 + r * 128 + ((chunk ^ (r & 7)) << 4) + (fq & 1) * 8) = (u32x2){pk2(v.x, v.y), pk2(v.z, v.w)};
                }
            __syncthreads();
#pragma unroll
            for (int mi = 0; mi < 4; ++mi)
#pragma unroll
                for (int ni = 0; ni < 4; ++ni) acc[mi][ni] = (f32x4){0.f, 0.f, 0.f, 0.f};
            mma_ktile(lds, acc); mma_ktile(lds + 32768, acc);
            __syncthreads();
#pragma unroll
            for (int mi = 0; mi < 4; ++mi)
#pragma unroll
                for (int ni = 0; ni < 4; ++ni) {
                    const int r = wr * 64 + mi * 16 + fr, cc = wc * 64 + ni * 16 + fq * 4;
                    float* d = sc + r * 129 + cc;
                    d[0] = acc[mi][ni].x; d[1] = acc[mi][ni].y; d[2] = acc[mi][ni].z; d[3] = acc[mi][ni].w;
                }
            __syncthreads();
            {
                unsigned x[64];
                const float* rp = sc + row * 129 + half * 64;
#pragma unroll
                for (int j = 0; j < 64; ++j) {
                    const unsigned bits = __builtin_bit_cast(unsigned, rp[j]);
                    const unsigned u = bits ^ ((unsigned)((int)bits >> 31) | 0x80000000u);
                    x[j] = (u & 0xFFFFFF80u) | (unsigned)(127 - (half * 64 + j));
                }
                bitonic_sort16(x, true); bitonic_sort16(x + 16, false); bitonic_sort16(x + 32, true); bitonic_sort16(x + 48, false);
#pragma unroll
                for (int i = 0; i < 16; ++i) { x[i] = x[i] > x[16 + i] ? x[i] : x[16 + i]; x[32 + i] = x[32 + i] > x[48 + i] ? x[32 + i] : x[48 + i]; }
                bitonic_merge16(x, true); bitonic_merge16(x + 32, false);
#pragma unroll
                for (int i = 0; i < 16; ++i) x[i] = x[i] > x[32 + i] ? x[i] : x[32 + i];
                bitonic_merge16(x, false);
#pragma unroll
                for (int i = 0; i < 16; ++i) { const unsigned o = (unsigned)__shfl_xor((int)x[15 - i], 1); y[i] = x[i] > o ? x[i] : o; }
                bitonic_merge16(y, false);
            }
            if (c == 0 && half == 0) {
#pragma unroll
                for (int i = 0; i < 16; ++i) KEYS0[i * 128 + row] = y[i];
            }
            __syncthreads();
        }
        {
            unsigned kk[16];
#pragma unroll
            for (int i = 0; i < 16; ++i) kk[i] = half ? KEYS0[i * 128 + row] : y[i];
            const int sb = half ? 0 : 16, ib = half ? 32 : 48;
#pragma unroll
            for (int i = 0; i < 16; ++i) {
                const unsigned u = kk[i] & 0xFFFFFF80u; const unsigned bits = (u & 0x80000000u) ? (u ^ 0x80000000u) : ~u;
                L[(sb + i) * 128 + row] = bits; L[(ib + i) * 128 + row] = 127u - (kk[i] & 127u);
            }
        }
        __syncthreads();
        if (tid < 128) {
            const int col = tid;
            float val[16];
            const float s20 = __builtin_bit_cast(float, L[16 * 128 + col]);
#pragma unroll
            for (int a = 0; a < 16; ++a) val[a] = __builtin_bit_cast(float, L[a * 128 + col]) + s20;
            unsigned long long P = 0ull;
            float ts[16]; int te[16];
#pragma unroll
            for (int r = 0; r < 16; ++r) {
                float best = val[0]; int ba = 0;
#pragma unroll
                for (int a = 1; a < 16; ++a) if (val[a] > best) { best = val[a]; ba = a; }
                const int b = (int)((P >> (4 * ba)) & 15ull);
                const int i1 = (int)L[(32 + ba) * 128 + col], i2 = (int)L[(48 + b) * 128 + col];
                ts[r] = best; te[r] = i1 * 128 + i2;
                const int nb = b + 1;
                float newv = -3.0e38f;
                if (nb < 16) { newv = __builtin_bit_cast(float, L[ba * 128 + col]) + __builtin_bit_cast(float, L[(16 + nb) * 128 + col]); P += 1ull << (4 * ba); }
#pragma unroll
                for (int a = 0; a < 16; ++a) val[a] = (a == ba) ? newv : val[a];
            }
            const float m0 = ts[0];
            float sum = 0.f;
#pragma unroll
            for (int r = 0; r < 16; ++r) { ts[r] = __expf(ts[r] - m0); sum += ts[r]; }
            const float inv = 1.0f / sum;
            const size_t ob = ((size_t)(mt * 128 + col) * 8 + h) * 16;
#pragma unroll
            for (int q = 0; q < 4; ++q) {
                *(u32x4*)(EXP + ob + q * 4) = (u32x4){(unsigned)te[q * 4], (unsigned)te[q * 4 + 1], (unsigned)te[q * 4 + 2], (unsigned)te[q * 4 + 3]};
                *(f32x4*)(GATE + ob + q * 4) = (f32x4){ts[q * 4] * inv, ts[q * 4 + 1] * inv, ts[q * 4 + 2] * inv, ts[q * 4 + 3] * inv};
            }
        }
        __syncthreads();
    }
}
__device__ __forceinline__ void phase_peer_combine(const Params& p, unsigned char* lds) {
    const float* TOPS = (const float*)(p.ws + WS_TOPS); const int* TOPI = (const int*)(p.ws + WS_TOPI);
    int* EXP = (int*)(p.ws + WS_EXP); float* GATE = (float*)(p.ws + WS_GATE);
    unsigned* L = (unsigned*)lds;
    const int tid = threadIdx.x;
    for (int it = blockIdx.x; it < (T * 8) / 256; it += gridDim.x) {
        const size_t th = (size_t)it * 256 + tid;
        const u32x4* S4 = (const u32x4*)(TOPS + th * 32); const u32x4* I4 = (const u32x4*)(TOPI + th * 32);
#pragma unroll
        for (int a4 = 0; a4 < 8; ++a4) {
            const u32x4 s = S4[a4], i = I4[a4];
            L[(a4 * 4 + 0) * 256 + tid] = s.x; L[(a4 * 4 + 1) * 256 + tid] = s.y; L[(a4 * 4 + 2) * 256 + tid] = s.z; L[(a4 * 4 + 3) * 256 + tid] = s.w;
            L[(32 + a4 * 4 + 0) * 256 + tid] = i.x; L[(32 + a4 * 4 + 1) * 256 + tid] = i.y; L[(32 + a4 * 4 + 2) * 256 + tid] = i.z; L[(32 + a4 * 4 + 3) * 256 + tid] = i.w;
        }
        float val[16];
        const float s20 = __builtin_bit_cast(float, L[16 * 256 + tid]);
#pragma unroll
        for (int a = 0; a < 16; ++a) val[a] = __builtin_bit_cast(float, L[a * 256 + tid]) + s20;
        unsigned long long P = 0ull;
        float ts[16]; int te[16];
#pragma unroll
        for (int r = 0; r < 16; ++r) {
            float best = val[0]; int ba = 0;
#pragma unroll
            for (int a = 1; a < 16; ++a) if (val[a] > best) { best = val[a]; ba = a; }
            const int b = (int)((P >> (4 * ba)) & 15ull);
            const int i1 = (int)L[(32 + ba) * 256 + tid], i2 = (int)L[(48 + b) * 256 + tid];
            ts[r] = best; te[r] = i1 * 128 + i2;
            const int nb = b + 1;
            float newv = -3.0e38f;
            if (nb < 16) { newv = __builtin_bit_cast(float, L[ba * 256 + tid]) + __builtin_bit_cast(float, L[(16 + nb) * 256 + tid]); P += 1ull << (4 * ba); }
#pragma unroll
            for (int a = 0; a < 16; ++a) val[a] = (a == ba) ? newv : val[a];
        }
        const float m0 = ts[0];
        float sum = 0.f;
#pragma unroll
        for (int r = 0; r < 16; ++r) { ts[r] = __expf(ts[r] - m0); sum += ts[r]; }
        const float inv = 1.0f / sum;
#pragma unroll
        for (int r = 0; r < 16; ++r) ts[r] *= inv;
#pragma unroll
        for (int r = 0; r < 16; ++r) { EXP[th * 16 + r] = te[r]; GATE[th * 16 + r] = ts[r]; }
    }
}

__device__ __forceinline__ void fma8(const unsigned w0, const unsigned w1, const float a, float* acc) {
    const f32x2 p0 = __builtin_amdgcn_cvt_pk_f32_fp8((int)w0, false), p1 = __builtin_amdgcn_cvt_pk_f32_fp8((int)w0, true);
    const f32x2 p2 = __builtin_amdgcn_cvt_pk_f32_fp8((int)w1, false), p3 = __builtin_amdgcn_cvt_pk_f32_fp8((int)w1, true);
    acc[0] += a * p0.x; acc[1] += a * p0.y; acc[2] += a * p1.x; acc[3] += a * p1.y;
    acc[4] += a * p2.x; acc[5] += a * p2.y; acc[6] += a * p3.x; acc[7] += a * p3.y;
}
__device__ __forceinline__ float dot8(const unsigned w0, const unsigned w1, const float* h, float s) {
    const f32x2 p0 = __builtin_amdgcn_cvt_pk_f32_fp8((int)w0, false), p1 = __builtin_amdgcn_cvt_pk_f32_fp8((int)w0, true);
    const f32x2 p2 = __builtin_amdgcn_cvt_pk_f32_fp8((int)w1, false), p3 = __builtin_amdgcn_cvt_pk_f32_fp8((int)w1, true);
    s += p0.x * h[0]; s += p0.y * h[1]; s += p1.x * h[2]; s += p1.y * h[3];
    s += p2.x * h[4]; s += p2.y * h[5]; s += p3.x * h[6]; s += p3.y * h[7];
    return s;
}
__device__ __forceinline__ void phase_peer_apply(const Params& p, int layer, unsigned char* lds, bool dry) {
    const int lane = threadIdx.x & 63, wave = threadIdx.x >> 6;
    float* ldsw = (float*)lds + wave * (64 * 65);
    const bf16_t* HM = (const bf16_t*)(p.ws + WS_HM);
    const unsigned char* PU = p.ws + WS_PU; const unsigned char* PV = p.ws + WS_PV;
    const float* SU = (const float*)(p.ws + WS_PU + 24 * MiB); const float* SV = (const float*)(p.ws + WS_PV + 24 * MiB);
    const int* EXP = (const int*)(p.ws + WS_EXP); const float* GATE = (const float*)(p.ws + WS_GATE);
    const float* MOD = (const float*)(p.ws + WS_MOD);
    float* X = p.out;
    for (int t = blockIdx.x * 4 + wave; t < T; t += gridDim.x * 4) {
        const u32x4 ha = *(const u32x4*)(HM + (size_t)t * D + lane * 16), hb = *(const u32x4*)(HM + (size_t)t * D + lane * 16 + 8);
        float hf[16];
        hf[0] = bflo(ha.x); hf[1] = bfhi(ha.x); hf[2] = bflo(ha.y); hf[3] = bfhi(ha.y); hf[4] = bflo(ha.z); hf[5] = bfhi(ha.z); hf[6] = bflo(ha.w); hf[7] = bfhi(ha.w);
        hf[8] = bflo(hb.x); hf[9] = bfhi(hb.x); hf[10] = bflo(hb.y); hf[11] = bfhi(hb.y); hf[12] = bflo(hb.z); hf[13] = bfhi(hb.z); hf[14] = bflo(hb.w); hf[15] = bfhi(hb.w);
        const int e0_ = EXP[(size_t)t * 128 + lane], e1_ = EXP[(size_t)t * 128 + 64 + lane];
        const float g0 = GATE[(size_t)t * 128 + lane], g1 = GATE[(size_t)t * 128 + 64 + lane];
        const float su0 = SU[e0_], su1 = SU[e1_], sv0 = SV[e0_], sv1 = SV[e1_];
        u32x4 buf[16];
        float act0 = 0.f, act1 = 0.f;
        float acc[16];
#pragma unroll
        for (int i = 0; i < 16; ++i) acc[i] = 0.f;
#ifndef APPLY_L2PROBE
#define APPLY_L2PROBE 0
#endif
        for (int prep_ = 0; prep_ < 1 + APPLY_L2PROBE; ++prep_) {
        const int emask = (APPLY_L2PROBE && prep_ == 0) ? 2047 : 0x7fffffff;
        const int e0 = e0_ & emask, e1 = e1_ & emask;
#pragma unroll
        for (int j = 0; j < 16; ++j) { const int e_ = __builtin_amdgcn_readlane(e0, j); buf[j] = *(const u32x4*)(PU + (size_t)e_ * D + lane * 16); }
#pragma unroll
        for (int bt = 0; bt < 16; ++bt) {
#pragma unroll
            for (int j = 0; j < 16; ++j) {
                if (bt < 8) {
                    float s_ = dot8(buf[j].x, buf[j].y, hf, 0.f); s_ = dot8(buf[j].z, buf[j].w, hf + 8, s_);
                    ldsw[((bt & 3) * 16 + j) * 65 + lane] = s_;
                } else {
                    const float av_ = ((bt & 7) < 4) ? act0 : act1;
                    const float a_ = __builtin_bit_cast(float, __builtin_amdgcn_readlane(__builtin_bit_cast(int, av_), (bt & 3) * 16 + j));
                    fma8(buf[j].x, buf[j].y, a_, acc); fma8(buf[j].z, buf[j].w, a_, acc + 8);
                }
                if (bt + 1 < 16) {
                    const int nb = bt + 1;
                    const int e_ = __builtin_amdgcn_readlane(((nb & 7) < 4) ? e0 : e1, (nb & 3) * 16 + j);
                    buf[j] = *(const u32x4*)(((nb < 8) ? PU : PV) + (size_t)e_ * D + lane * 16);
                }
            }
            if (bt == 3 || bt == 7) {
                float tot_ = 0.f;
#pragma unroll 16
                for (int q = 0; q < 64; ++q) tot_ += ldsw[lane * 65 + q];
                if (bt == 3) act0 = gelu_tanh(tot_ * su0) * g0 * sv0; else act1 = gelu_tanh(tot_ * su1) * g1 * sv1;
            }
        }
        if (APPLY_L2PROBE && prep_ == 0 && p.ph_hi >= 0) {
#pragma unroll
            for (int i = 0; i < 16; ++i) acc[i] = 0.f;
        }
        }
        const int b = t / SEQ;
        const float* g2 = MOD + (size_t)(layer * 2 + b) * 6144 + 5120;
        float* xr = X + (size_t)t * D + lane * 16;
        f32x4 xs[4]; float ss = 0.f;
#pragma unroll
        for (int q = 0; q < 4; ++q) {
            const f32x4 g = *(const f32x4*)(g2 + lane * 16 + q * 4); f32x4 x = *(const f32x4*)(xr + q * 4);
            x.x += g.x * acc[q * 4 + 0]; x.y += g.y * acc[q * 4 + 1]; x.z += g.z * acc[q * 4 + 2]; x.w += g.w * acc[q * 4 + 3];
            xs[q] = x; ss += (x.x * x.x + x.y * x.y) + (x.z * x.z + x.w * x.w);
        }
        const float rs = rsqrtf(wave_sum(ss) * (1.0f / D) + RMS_EPS);
        if (!dry) {
            if (layer == 0) {
                const float* gw = p.in[2] + D + lane * 16; const float* sh = MOD + (size_t)(2 + b) * 6144 + lane * 16; const float* sc = sh + 1024;
                u32x4 o[2];
#pragma unroll
                for (int q = 0; q < 4; ++q) {
                    *(f32x4*)(xr + q * 4) = xs[q];
                    const f32x4 g = *(const f32x4*)(gw + q * 4), s1 = *(const f32x4*)(sc + q * 4), s0 = *(const f32x4*)(sh + q * 4);
                    const float y0 = xs[q].x * rs * g.x * (1.f + s1.x) + s0.x, y1 = xs[q].y * rs * g.y * (1.f + s1.y) + s0.y;
                    const float y2 = xs[q].z * rs * g.z * (1.f + s1.z) + s0.z, y3 = xs[q].w * rs * g.w * (1.f + s1.w) + s0.w;
                    if (q & 1) { o[q >> 1].z = pk2(y0, y1); o[q >> 1].w = pk2(y2, y3); } else { o[q >> 1].x = pk2(y0, y1); o[q >> 1].y = pk2(y2, y3); }
                }
                bf16_t* hm = (bf16_t*)(p.ws + WS_HM) + (size_t)t * D + lane * 16;
                *(u32x4*)hm = o[0]; *(u32x4*)(hm + 8) = o[1];
            } else {
                const float* gw = p.in[28] + lane * 16;
#pragma unroll
                for (int q = 0; q < 4; ++q) {
                    const f32x4 g = *(const f32x4*)(gw + q * 4);
                    *(f32x4*)(xr + q * 4) = (f32x4){xs[q].x * rs * g.x, xs[q].y * rs * g.y, xs[q].z * rs * g.z, xs[q].w * rs * g.w};
                }
            }
        }
    }
}

__device__ __forceinline__ void phase_peer_apply6(const Params& p, int layer, unsigned char* lds, bool dry) {
    const int lane = threadIdx.x & 63, wave = threadIdx.x >> 6, half = lane >> 5, gl = lane & 31;
    float* ldsw = (float*)lds + wave * (64 * 33);
    const bf16_t* HM = (const bf16_t*)(p.ws + WS_HM);
    const unsigned char* PU = p.ws + WS_PU; const unsigned char* PV = p.ws + WS_PV;
    const float* SU = (const float*)(p.ws + WS_PU + 24 * MiB); const float* SV = (const float*)(p.ws + WS_PV + 24 * MiB);
    const int* EXP = (const int*)(p.ws + WS_EXP); const float* GATE = (const float*)(p.ws + WS_GATE);
    const float* MOD = (const float*)(p.ws + WS_MOD);
    float* X = p.out;
    for (int t = blockIdx.x * 4 + wave; t < T; t += gridDim.x * 4) {
        float hf[32];
        {
            const u32x4* hp = (const u32x4*)(HM + (size_t)t * D + gl * 32);
#pragma unroll
            for (int q = 0; q < 4; ++q) { const u32x4 w = hp[q];
                hf[q * 8 + 0] = bflo(w.x); hf[q * 8 + 1] = bfhi(w.x); hf[q * 8 + 2] = bflo(w.y); hf[q * 8 + 3] = bfhi(w.y);
                hf[q * 8 + 4] = bflo(w.z); hf[q * 8 + 5] = bfhi(w.z); hf[q * 8 + 6] = bflo(w.w); hf[q * 8 + 7] = bfhi(w.w); }
        }
        const int e0 = EXP[(size_t)t * 128 + lane], e1 = EXP[(size_t)t * 128 + 64 + lane];
        const float g0 = GATE[(size_t)t * 128 + lane], g1 = GATE[(size_t)t * 128 + 64 + lane];
        const float su0 = SU[e0], su1 = SU[e1], sv0 = SV[e0], sv1 = SV[e1];
        u32x2 buf[8][3];
        float act0 = 0.f, act1 = 0.f;
        float acc[32];
#pragma unroll
        for (int i = 0; i < 32; ++i) acc[i] = 0.f;
#define A6_LOAD(slot, nb) do { const int es_ = (((nb) & 7) < 4) ? e0 : e1; const int ia_ = ((nb) & 3) * 16 + 2 * (slot); \
            const int ea_ = __builtin_amdgcn_readlane(es_, ia_), eb_ = __builtin_amdgcn_readlane(es_, ia_ + 1); const int e_ = half ? eb_ : ea_; \
            const u32x2* rp_ = (const u32x2*)((((nb) < 8) ? PU : PV) + (size_t)e_ * 768 + gl * 24); buf[slot][0] = rp_[0]; buf[slot][1] = rp_[1]; buf[slot][2] = rp_[2]; } while (0)
#pragma unroll
        for (int j = 0; j < 8; ++j) A6_LOAD(j, 0);
#pragma unroll 1
        for (int bt = 0; bt < 8; ++bt) {
#pragma unroll
            for (int j = 0; j < 8; ++j) {
                v6u w; w[0] = buf[j][0].x; w[1] = buf[j][0].y; w[2] = buf[j][1].x; w[3] = buf[j][1].y; w[4] = buf[j][2].x; w[5] = buf[j][2].y;
                const v32f y = __builtin_amdgcn_cvt_scalef32_pk32_f32_fp6(w, 1.0f);
                float s0_ = 0.f, s1_ = 0.f;
#pragma unroll
                for (int i = 0; i < 16; ++i) { s0_ += y[i] * hf[i]; s1_ += y[16 + i] * hf[16 + i]; }
                ldsw[(((bt & 3) * 16 + 2 * j) + half) * 33 + gl] = s0_ + s1_;
                A6_LOAD(j, bt + 1);
            }
            if (bt == 3 || bt == 7) {
                float tot_ = 0.f;
#pragma unroll
                for (int q = 0; q < 32; ++q) tot_ += ldsw[lane * 33 + q];
                if (bt == 3) act0 = gelu_tanh(tot_ * su0) * g0 * sv0; else act1 = gelu_tanh(tot_ * su1) * g1 * sv1;
            }
        }
#pragma unroll 1
        for (int bt = 8; bt < 16; ++bt) {
            const float av_ = (bt < 12) ? act0 : act1;
#pragma unroll
            for (int j = 0; j < 8; ++j) {
                v6u w; w[0] = buf[j][0].x; w[1] = buf[j][0].y; w[2] = buf[j][1].x; w[3] = buf[j][1].y; w[4] = buf[j][2].x; w[5] = buf[j][2].y;
                const v32f y = __builtin_amdgcn_cvt_scalef32_pk32_f32_fp6(w, 1.0f);
                const int ia_ = (bt & 3) * 16 + 2 * j;
                const float aa_ = __builtin_bit_cast(float, __builtin_amdgcn_readlane(__builtin_bit_cast(int, av_), ia_));
                const float ab_ = __builtin_bit_cast(float, __builtin_amdgcn_readlane(__builtin_bit_cast(int, av_), ia_ + 1));
                const float a_ = half ? ab_ : aa_;
#pragma unroll
                for (int i = 0; i < 32; ++i) acc[i] += a_ * y[i];
                if (bt + 1 < 16) A6_LOAD(j, bt + 1);
            }
        }
#undef A6_LOAD
#pragma unroll
        for (int i = 0; i < 32; ++i) acc[i] += __shfl_xor(acc[i], 32);
        const int b = t / SEQ;
        const float* g2 = MOD + (size_t)(layer * 2 + b) * 6144 + 5120 + gl * 32;
        float* xr = X + (size_t)t * D + gl * 32;
        f32x4 xs[8]; float ss = 0.f;
#pragma unroll
        for (int q = 0; q < 8; ++q) {
            const f32x4 g = *(const f32x4*)(g2 + q * 4); f32x4 x = *(const f32x4*)(xr + q * 4);
            x.x += g.x * acc[q * 4 + 0]; x.y += g.y * acc[q * 4 + 1]; x.z += g.z * acc[q * 4 + 2]; x.w += g.w * acc[q * 4 + 3];
            xs[q] = x; if (half == 0) ss += (x.x * x.x + x.y * x.y) + (x.z * x.z + x.w * x.w);
        }
        const float rs = rsqrtf(wave_sum(ss) * (1.0f / D) + RMS_EPS);
        if (!dry && half == 0) {
            if (layer == 0) {
                const float* gw = p.in[2] + D + gl * 32; const float* sh = MOD + (size_t)(2 + b) * 6144 + gl * 32; const float* sc = sh + 1024;
                bf16_t* hm = (bf16_t*)(p.ws + WS_HM) + (size_t)t * D + gl * 32;
#pragma unroll
                for (int q2 = 0; q2 < 4; ++q2) {
                    u32x4 o;
#pragma unroll
                    for (int hq = 0; hq < 2; ++hq) {
                        const int q = q2 * 2 + hq;
                        *(f32x4*)(xr + q * 4) = xs[q];
                        const f32x4 g = *(const f32x4*)(gw + q * 4), s1 = *(const f32x4*)(sc + q * 4), s0 = *(const f32x4*)(sh + q * 4);
                        const float y0 = xs[q].x * rs * g.x * (1.f + s1.x) + s0.x, y1 = xs[q].y * rs * g.y * (1.f + s1.y) + s0.y;
                        const float y2 = xs[q].z * rs * g.z * (1.f + s1.z) + s0.z, y3 = xs[q].w * rs * g.w * (1.f + s1.w) + s0.w;
                        if (hq) { o.z = pk2(y0, y1); o.w = pk2(y2, y3); } else { o.x = pk2(y0, y1); o.y = pk2(y2, y3); }
                    }
                    *(u32x4*)(hm + q2 * 8) = o;
                }
            } else {
                const float* gw = p.in[28] + gl * 32;
#pragma unroll
                for (int q = 0; q < 8; ++q) {
                    const f32x4 g = *(const f32x4*)(gw + q * 4);
                    *(f32x4*)(xr + q * 4) = (f32x4){xs[q].x * rs * g.x, xs[q].y * rs * g.y, xs[q].z * rs * g.z, xs[q].w * rs * g.w};
                }
            }
        }
    }
}
__device__ __forceinline__ void phase_tab1(const Params& p) {
    const int first = vblock() - 256, stride = (int)gridDim.x - 256;
    if (first < 0 || stride <= 0) {
        if (stride <= 0) { for (int it = blockIdx.x; it < 2 * P0_TAB; it += gridDim.x) {
            if (it < P0_TAB) cvt_fp6_item(p.in[26] + (size_t)PE * D, p.ws + WS_PU, (float*)(p.ws + WS_PU + 24 * MiB), it);
            else cvt_fp6_item(p.in[27] + (size_t)PE * D, p.ws + WS_PV, (float*)(p.ws + WS_PV + 24 * MiB), it - P0_TAB); } }
        return;
    }
    for (int it = first; it < 2 * P0_TAB; it += stride) {
        if (it < P0_TAB) cvt_fp6_item(p.in[26] + (size_t)PE * D, p.ws + WS_PU, (float*)(p.ws + WS_PU + 24 * MiB), it);
        else cvt_fp6_item(p.in[27] + (size_t)PE * D, p.ws + WS_PV, (float*)(p.ws + WS_PV + 24 * MiB), it - P0_TAB);
    }
}
__device__ __forceinline__ void phase_nsa_proj(const Params& p, unsigned char* lds) {
    const bf16_t* HM = (const bf16_t*)(p.ws + WS_HM); const bf16_t* WT = (const bf16_t*)(p.ws + WS_WPROJ_T);
    const f32x2* ROPE = (const f32x2*)(p.ws + WS_ROPE);
    bf16_t* Q = (bf16_t*)(p.ws + WS_Q); float* NGT = (float*)(p.ws + WS_NG);
    const int lane = threadIdx.x & 63, wid = threadIdx.x >> 6, wr = wid >> 1, wc = wid & 1, fr = lane & 15, fq = lane >> 4;
    for (int id = vblock(); id < 256 * 21; id += gridDim.x) {
        const int mt = id / 21, nt = id % 21;
        f32x4 acc[4][4];
        gemm_tile3(ALoadPlain{HM + (size_t)mt * 128 * D, (size_t)D}, WT + (size_t)nt * 128 * D, D, 16, acc, lds);
        const int c0 = nt * 128 + wc * 64;
        if (c0 >= 2624) continue;
        const int b = (mt * 128) / SEQ;
        if (c0 == 2560) {
#pragma unroll
            for (int mi = 0; mi < 4; ++mi)
#pragma unroll
                for (int ni = 0; ni < 3; ++ni) {
                    const int t = mt * 128 + wr * 64 + mi * 16 + fr;
                    const f32x4 v = acc[mi][ni];
                    *(f32x4*)(NGT + (size_t)t * 48 + ni * 16 + fq * 4) = (f32x4){sigmoidf_(v.x), sigmoidf_(v.y), sigmoidf_(v.z), sigmoidf_(v.w)};
                }
            continue;
        }
        int sec = -1, g = 0;
        if (c0 >= 1024) { sec = (c0 - 1024) >> 8; g = ((c0 - 1024) & 255) >> 6; }
        const bool dorope = (sec == -1) || (sec == 2) || (sec == 4);
        const float scl = (sec == -1) ? 0.125f : 1.0f;
        const size_t secoff[6] = {WS_KC, WS_VC, WS_KS, WS_VST, WS_KW, WS_VWT};
        size_t so = WS_Q;
#pragma unroll
        for (int q = 0; q < 6; ++q) if (sec == q) so = secoff[q];
        bf16_t* OUT = (bf16_t*)(p.ws + so);
        const bool vt = (sec == 3) || (sec == 5);
        float kblk_am = 0.f;
#pragma unroll
        for (int pass = 0; pass < 2; ++pass) {
        if (pass == 1 && sec == 2) {
#pragma unroll
            for (int o = 1; o < 64; o <<= 1) kblk_am = fmaxf(kblk_am, __shfl_xor(kblk_am, o));
            if (lane == 0) ((float*)(p.ws + WS_KS + 12 * MiB))[(size_t)(b * 4 + g) * 256 + ((mt * 128 + wr * 64 - b * SEQ) >> 6)] = kblk_am > 0.f ? kblk_am / 224.0f : 1.0f;
        }
#pragma unroll
        for (int mi = 0; mi < 4; ++mi) {
            const int t = mt * 128 + wr * 64 + mi * 16 + fr, s = t - b * SEQ;
            if (dorope && pass == 0) {
#pragma unroll
                for (int ni = 0; ni < 2; ++ni) {
                    const f32x4* rp = (const f32x4*)(ROPE + (size_t)s * 32 + ni * 16 + fq * 4);
                    const f32x4 r0 = rp[0], r1 = rp[1];
                    const f32x4 x1 = acc[mi][ni], x2 = acc[mi][ni + 2];
                    acc[mi][ni] = (f32x4){x1.x * r0.x - x2.x * r0.y, x1.y * r0.z - x2.y * r0.w, x1.z * r1.x - x2.z * r1.y, x1.w * r1.z - x2.w * r1.w};
                    acc[mi][ni + 2] = (f32x4){x1.x * r0.y + x2.x * r0.x, x1.y * r0.w + x2.y * r0.z, x1.z * r1.y + x2.z * r1.x, x1.w * r1.w + x2.w * r1.z};
                }
            }
            if (pass == 0) {
                if (sec == 2) {
#pragma unroll
                    for (int ni = 0; ni < 4; ++ni) { const f32x4 v = acc[mi][ni]; kblk_am = fmaxf(kblk_am, fmaxf(fmaxf(fabsf(v.x), fabsf(v.y)), fmaxf(fabsf(v.z), fabsf(v.w)))); }
                }
                continue;
            }
            if (sec == -1 || sec == 2) {
                float am = kblk_am;
                if (sec == -1) {
                    am = 0.f;
#pragma unroll
                    for (int ni = 0; ni < 4; ++ni) { const f32x4 v = acc[mi][ni] * scl; am = fmaxf(am, fmaxf(fmaxf(fabsf(v.x), fabsf(v.y)), fmaxf(fabsf(v.z), fabsf(v.w)))); }
                    am = fmaxf(am, __shfl_xor(am, 16)); am = fmaxf(am, __shfl_xor(am, 32));
                }
                const float qs = am > 0.f ? 224.0f / am : 1.0f;
                unsigned char* O8 = (sec == -1) ? (p.ws + WS_Q8 + (size_t)t * 1024 + c0) : (p.ws + WS_KS + ((size_t)(b * 4 + g) * SEQ + s) * 64);
#pragma unroll
                for (int ni = 0; ni < 4; ++ni) {
                    const f32x4 v = acc[mi][ni] * (scl * qs);
                    int w = 0; w = __builtin_amdgcn_cvt_pk_fp8_f32(v.x, v.y, w, false); w = __builtin_amdgcn_cvt_pk_fp8_f32(v.z, v.w, w, true);
                    *(int*)(O8 + ni * 16 + fq * 4) = w;
                }
                if (fq == 0 && sec == -1) ((float*)(p.ws + WS_Q8 + 32 * MiB))[(size_t)t * 16 + (c0 >> 6)] = am > 0.f ? am / 224.0f : 1.0f;
            }
            if (sec == 2) continue;
#pragma unroll
            for (int ni = 0; ni < 4; ++ni) {
                const f32x4 v = acc[mi][ni] * scl;
                const int d = ni * 16 + fq * 4;
                if (sec == -1) {
                    *(u32x2*)(OUT + (size_t)t * 1024 + c0 + d) = (u32x2){pk2(v.x, v.y), pk2(v.z, v.w)};
                } else if (sec == 4) {
                    const size_t idx = (size_t)(b * 4 + g) * SEQ * 64 + (size_t)(s >> 5) * 2048 + ((((s >> 4) & 1) * 2 + (ni >> 1)) * 16 + (s & 15)) * 32 + ((ni & 1) * 2 + (fq >> 1)) * 8 + (fq & 1) * 4;
                    *(u32x2*)(OUT + idx) = (u32x2){pk2(v.x, v.y), pk2(v.z, v.w)};
                } else if (!vt) {
                    *(u32x2*)(OUT + ((size_t)(b * 4 + g) * SEQ + s) * 64 + d) = (u32x2){pk2(v.x, v.y), pk2(v.z, v.w)};
                } else if (sec == 5) {
                    const int key = s & 31;
                    bf16_t* o = OUT + (size_t)(b * 4 + g) * SEQ * 64 + (size_t)(s >> 5) * 2048 + ((ni * 2 + (key >> 4)) * 16 + fq * 4) * 16 + ((key >> 2) & 3) * 4 + (key & 3);
                    o[0] = (bf16_t)f2bf(v.x); o[16] = (bf16_t)f2bf(v.y); o[32] = (bf16_t)f2bf(v.z); o[48] = (bf16_t)f2bf(v.w);
                }
            }
        }
        }
        if (sec == 3) {
            const int s0 = mt * 128 + wr * 64 - b * SEQ, jb = s0 >> 6;
            unsigned char* V8 = p.ws + WS_VST + (size_t)((b * 4 + g) * 256 + jb) * 4096;
            float am = 0.f;
#pragma unroll
            for (int mi = 0; mi < 4; ++mi)
#pragma unroll
                for (int ni = 0; ni < 4; ++ni) { const f32x4 v = acc[mi][ni]; am = fmaxf(am, fmaxf(fmaxf(fabsf(v.x), fabsf(v.y)), fmaxf(fabsf(v.z), fabsf(v.w)))); }
#pragma unroll
            for (int o = 1; o < 64; o <<= 1) am = fmaxf(am, __shfl_xor(am, o));
            const float qs = am > 0.f ? 224.0f / am : 1.0f;
            if (lane == 0) ((float*)(p.ws + WS_VST + 12 * MiB))[(size_t)(b * 4 + g) * 256 + jb] = am > 0.f ? am / 224.0f : 1.0f;
#pragma unroll
            for (int ni = 0; ni < 4; ++ni) {
                const int d = ni * 16 + fq * 4;
#pragma unroll
                for (int mi = 0; mi < 4; ++mi) {
                    const f32x4 v = acc[mi][ni] * qs;
                    int w = 0; w = __builtin_amdgcn_cvt_pk_fp8_f32(v.x, v.y, w, false); w = __builtin_amdgcn_cvt_pk_fp8_f32(v.z, v.w, w, true);
                    unsigned char* o = V8 + (size_t)d * 64 + mi * 16 + fr;
                    o[0] = (unsigned char)(w & 255); o[64] = (unsigned char)((w >> 8) & 255); o[128] = (unsigned char)((w >> 16) & 255); o[192] = (unsigned char)((unsigned)w >> 24);
                }
            }
        }
    }
}
__device__ __forceinline__ void phase_nsa_cmp1(const Params& p, unsigned char* lds) {
    bf16_t* HID = (bf16_t*)(p.ws + WS_HID);
    const float* bias = (const float*)(p.ws + WS_MISC);
    const int lane = threadIdx.x & 63, wid = threadIdx.x >> 6, wr = wid >> 1, wc = wid & 1, fr = lane & 15, fq = lane >> 4;
    for (int id = vblock(); id < 256; id += gridDim.x) {
        const int kv = id >> 7, bg = (id >> 4) & 7, mt = (id >> 1) & 7, nt = id & 1;
        const bf16_t* A = (const bf16_t*)(p.ws + (kv ? WS_VC : WS_KC)) + (size_t)bg * SEQ * 64 + (size_t)mt * 128 * 1024;
        const bf16_t* B = (const bf16_t*)(p.ws + (kv ? WS_WV1_T : WS_WK1_T)) + (size_t)nt * 128 * 2048;
        f32x4 acc[4][4];
        gemm_tile3(ALoadPlain{A, (size_t)1024}, B, 2048, 32, acc, lds);
#pragma unroll
        for (int mi = 0; mi < 4; ++mi)
#pragma unroll
            for (int ni = 0; ni < 4; ++ni) {
                const int n = mt * 128 + wr * 64 + mi * 16 + fr, c = nt * 128 + wc * 64 + ni * 16 + fq * 4;
                const f32x4 bv = *(const f32x4*)(bias + kv * 256 + c);
                const f32x4 v = acc[mi][ni] + bv;
                *(u32x2*)(HID + (((size_t)kv * 8 + bg) * 1024 + n) * 256 + c) = (u32x2){pk2(gelu_tanh(v.x), gelu_tanh(v.y)), pk2(gelu_tanh(v.z), gelu_tanh(v.w))};
            }
    }
}
__device__ __forceinline__ void phase_nsa_cmp2(const Params& p, unsigned char* lds) {
    const bf16_t* HID = (const bf16_t*)(p.ws + WS_HID);
    const f32x2* ROPE = (const f32x2*)(p.ws + WS_ROPE);
    bf16_t* KCMP = (bf16_t*)(p.ws + WS_KCMP); bf16_t* VCMPT = (bf16_t*)(p.ws + WS_VCMPT);
    const int lane = threadIdx.x & 63, wid = threadIdx.x >> 6, wr = wid >> 1, wc = wid & 1, fr = lane & 15, fq = lane >> 4;
    for (int id = vblock(); id < 128; id += gridDim.x) {
        const int kv = id >> 6, mt = id & 63;
        const bf16_t* A = HID + ((size_t)kv * 8192 + (size_t)mt * 128) * 256;
        const bf16_t* B = (const bf16_t*)(p.ws + (kv ? WS_WV2_T : WS_WK2_T));
        f32x4 acc[4][4];
        gemm_tile3(ALoadPlain{A, (size_t)256}, B, 256, 4, acc, lds);
        if (wc == 1) continue;
#pragma unroll
        for (int mi = 0; mi < 4; ++mi) {
            const int R = mt * 128 + wr * 64 + mi * 16 + fr, bg = R >> 10, n = R & 1023;
            if (kv == 0) {
                int pos = n * 16 + 31; pos = pos > SEQ - 1 ? SEQ - 1 : pos;
#pragma unroll
                for (int ni = 0; ni < 2; ++ni) {
                    const f32x4* rp = (const f32x4*)(ROPE + (size_t)pos * 32 + ni * 16 + fq * 4);
                    const f32x4 r0 = rp[0], r1 = rp[1];
                    const f32x4 x1 = acc[mi][ni], x2 = acc[mi][ni + 2];
                    acc[mi][ni] = (f32x4){x1.x * r0.x - x2.x * r0.y, x1.y * r0.z - x2.y * r0.w, x1.z * r1.x - x2.z * r1.y, x1.w * r1.z - x2.w * r1.w};
                    acc[mi][ni + 2] = (f32x4){x1.x * r0.y + x2.x * r0.x, x1.y * r0.w + x2.y * r0.z, x1.z * r1.y + x2.z * r1.x, x1.w * r1.w + x2.w * r1.z};
                }
#pragma unroll
                for (int ni = 0; ni < 4; ++ni) {
                    const f32x4 v = acc[mi][ni];
                    const size_t idx = (size_t)bg * 1024 * 64 + (size_t)(n >> 5) * 2048 + ((((n >> 4) & 1) * 2 + (ni >> 1)) * 16 + (n & 15)) * 32 + ((ni & 1) * 2 + (fq >> 1)) * 8 + (fq & 1) * 4;
                    *(u32x2*)(KCMP + idx) = (u32x2){pk2(v.x, v.y), pk2(v.z, v.w)};
                }
            } else {
#pragma unroll
                for (int ni = 0; ni < 4; ++ni) {
                    const f32x4 v = acc[mi][ni];
                    const int key = n & 31;
                    bf16_t* o = VCMPT + (size_t)bg * 1024 * 64 + (size_t)(n >> 5) * 2048 + ((ni * 2 + (key >> 4)) * 16 + fq * 4) * 16 + ((key >> 2) & 3) * 4 + (key & 3);
                    o[0] = (bf16_t)f2bf(v.x); o[16] = (bf16_t)f2bf(v.y); o[32] = (bf16_t)f2bf(v.z); o[48] = (bf16_t)f2bf(v.w);
                }
            }
        }
    }
}
__device__ __forceinline__ void phase_nsa_wo(const Params& p, unsigned char* lds, bool dry) {
    const bf16_t* O = (const bf16_t*)(p.ws + WS_O); const bf16_t* WT = (const bf16_t*)(p.ws + WS_WO_T);
    const float* MOD = (const float*)(p.ws + WS_MOD);
    float* X = p.out;
    const int lane = threadIdx.x & 63, wid = threadIdx.x >> 6, wr = wid >> 1, wc = wid & 1, fr = lane & 15, fq = lane >> 4;
    for (int id = vblock(); id < 256 * 8; id += gridDim.x) {
        const int mt = id >> 3, nt = id & 7;
        f32x4 acc[4][4];
        gemm_tile3(ALoadPlain{O + (size_t)mt * 128 * D, (size_t)D}, WT + (size_t)nt * 128 * D, D, 16, acc, lds);
        const int b = (mt * 128) / SEQ;
#pragma unroll
        for (int mi = 0; mi < 4; ++mi)
#pragma unroll
            for (int ni = 0; ni < 4; ++ni) {
                const int t = mt * 128 + wr * 64 + mi * 16 + fr, c = nt * 128 + wc * 64 + ni * 16 + fq * 4;
                const f32x4 g1 = *(const f32x4*)(MOD + (size_t)(1 * 2 + b) * 6144 + 2048 + c);
                float* xp = X + (size_t)t * D + c;
                const f32x4 x = *(const f32x4*)xp; const f32x4 v = acc[mi][ni];
                if (!dry) *(f32x4*)xp = (f32x4){x.x + g1.x * v.x, x.y + g1.y * v.y, x.z + g1.z * v.z, x.w + g1.w * v.w};
            }
    }
}
__device__ __forceinline__ bf16x8 pack8(const f32x4 a, const f32x4 b) {
    u32x4 w; w.x = pk2(a.x, a.y); w.y = pk2(a.z, a.w); w.z = pk2(b.x, b.y); w.w = pk2(b.z, b.w);
    return __builtin_bit_cast(bf16x8, w);
}
__device__ __forceinline__ bf16x8 ldv8(const bf16_t* plo, const bf16_t* phi) {
    const u32x2 lo = *(const u32x2*)plo, hi = *(const u32x2*)phi;
    u32x4 w; w.x = lo.x; w.y = lo.y; w.z = hi.x; w.w = hi.y;
    return __builtin_bit_cast(bf16x8, w);
}
__device__ __forceinline__ float red4(float v) { v += __shfl_xor(v, 16); v += __shfl_xor(v, 32); return v; }
__device__ __forceinline__ float max4(float v) { v = fmaxf(v, __shfl_xor(v, 16)); v = fmaxf(v, __shfl_xor(v, 32)); return v; }
#define NEGBIG (-1.0e30f)

__device__ __forceinline__ void phase_nsa_attn(const Params& p, unsigned char* lds, const int rep_cmp, const int rep_win, const int rep_sel) {
    const int lane = threadIdx.x & 63, wave = threadIdx.x >> 6, fr = lane & 15, fq = lane >> 4;
    unsigned char* WL = lds + wave * 18432;
    float* IMP = (float*)WL;
    int* SEL = (int*)(WL + 17408);
    const bf16_t* Q = (const bf16_t*)(p.ws + WS_Q);
    const bf16_t* KCMP = (const bf16_t*)(p.ws + WS_KCMP); const bf16_t* VCMPT = (const bf16_t*)(p.ws + WS_VCMPT);
    const bf16_t* KW = (const bf16_t*)(p.ws + WS_KW); const bf16_t* VWT = (const bf16_t*)(p.ws + WS_VWT);
    const float* NGT = (const float*)(p.ws + WS_NG);
    bf16_t* O = (bf16_t*)(p.ws + WS_O);
    const f32x4 z4 = (f32x4){0.f, 0.f, 0.f, 0.f};
    for (int bi = blockIdx.x; bi < 2048; bi += gridDim.x) {
        const int bg = bi & 7, quad = 255 - (bi >> 3), t0 = (quad * 4 + wave) * 16, b = bg >> 2, g = bg & 3;
        const int cur = t0 >> 6;
        const size_t tok = (size_t)b * SEQ + t0 + fr;
        const int tq = t0 + fr;
        bf16x8 qf[4][2];
#pragma unroll
        for (int r = 0; r < 4; ++r)
#pragma unroll
            for (int ks = 0; ks < 2; ++ks) qf[r][ks] = *(const bf16x8*)(Q + tok * 1024 + (g * 4 + r) * 64 + ks * 32 + fq * 8);
        f32x4 acc[4][4];
        for (int rep = 0; rep < rep_win; ++rep) {
            const bf16_t* kwb = KW + (size_t)bg * SEQ * 64; const bf16_t* vwb = VWT + (size_t)bg * SEQ * 64;
            float mw[4], lw[4];
#pragma unroll
            for (int r = 0; r < 4; ++r) { mw[r] = NEGBIG; lw[r] = 0.f;
#pragma unroll
                for (int df = 0; df < 4; ++df) acc[r][df] = z4; }
            int kmin = t0 - 511; kmin = kmin < 0 ? 0 : kmin; kmin &= ~31;
            bf16x8 nkf[2][2];
#define WIN_LOAD(kb_) do { _Pragma("unroll") for (int f = 0; f < 2; ++f) _Pragma("unroll") for (int ks = 0; ks < 2; ++ks) nkf[f][ks] = *(const bf16x8*)(kwb + (size_t)((kb_) >> 5) * 2048 + ((f * 2 + ks) * 16 + fr) * 32 + fq * 8); } while (0)
            WIN_LOAD(kmin);
            for (int kb = kmin; kb <= t0 + 15; kb += 32) {
                bf16x8 kf[2][2], vf[4];
#pragma unroll
                for (int f = 0; f < 2; ++f) { kf[f][0] = nkf[f][0]; kf[f][1] = nkf[f][1]; }
#pragma unroll
                for (int df = 0; df < 4; ++df) { const bf16_t* vp = vwb + (size_t)(kb >> 5) * 2048 + (df * 32 + fr) * 16 + fq * 4; vf[df] = ldv8(vp, vp + 256); }
                { const int kn = (kb + 32 <= t0 + 15) ? kb + 32 : kb; WIN_LOAD(kn); }
#pragma unroll
                for (int r = 0; r < 4; ++r) {
                    f32x4 st[2];
#pragma unroll
                    for (int f = 0; f < 2; ++f) {
                        st[f] = __builtin_amdgcn_mfma_f32_16x16x32_bf16(kf[f][0], qf[r][0], z4, 0, 0, 0);
                        st[f] = __builtin_amdgcn_mfma_f32_16x16x32_bf16(kf[f][1], qf[r][1], st[f], 0, 0, 0);
                    }
                    float mx = NEGBIG;
#pragma unroll
                    for (int f = 0; f < 2; ++f)
#pragma unroll
                        for (int e = 0; e < 4; ++e) { const int key = kb + f * 16 + fq * 4 + e; const bool ok = (key <= tq) && (key > tq - 512); if (ok) mx = fmaxf(mx, st[f][e]); }
                    float mn = mw[r], al = 1.0f;
                    if (__builtin_amdgcn_ballot_w64(mx > mw[r] + 8.0f) != 0ull) { mn = fmaxf(mw[r], max4(mx)); al = __expf(mw[r] - mn); }
                    float ps = 0.f;
#pragma unroll
                    for (int f = 0; f < 2; ++f)
#pragma unroll
                        for (int e = 0; e < 4; ++e) { const int key = kb + f * 16 + fq * 4 + e; const bool ok = (key <= tq) && (key > tq - 512); const float pv = ok ? __expf(st[f][e] - mn) : 0.f; st[f][e] = pv; ps += pv; }
                    lw[r] = lw[r] * al + ps; mw[r] = mn;
                    const bf16x8 pf = pack8(st[0], st[1]);
#pragma unroll
                    for (int df = 0; df < 4; ++df) { acc[r][df] = acc[r][df] * al; acc[r][df] = __builtin_amdgcn_mfma_f32_16x16x32_bf16(vf[df], pf, acc[r][df], 0, 0, 0); }
                    __builtin_amdgcn_sched_barrier(0);
                }
            }
#pragma unroll
            for (int r = 0; r < 4; ++r) {
                const float l = red4(lw[r]); const float sc = NGT[tok * 48 + (g * 4 + r) * 3 + 2] / l;
#pragma unroll
                for (int df = 0; df < 4; ++df) acc[r][df] = acc[r][df] * sc;
            }
#undef WIN_LOAD
        }
        const int nmax_tile = (t0 >> 4) - 1, nmax_lane = (t0 >> 4) - 2 + (fr == 15 ? 1 : 0);
        const bf16_t* kcb = KCMP + (size_t)bg * 1024 * 64; const bf16_t* vcb = VCMPT + (size_t)bg * 64 * 1024;
        for (int rep = 0; rep < rep_cmp; ++rep) {
            const bool dry = (rep + 1 < rep_cmp);
            float mc[4], lc[4], invl[4];
#pragma unroll
            for (int r = 0; r < 4; ++r) { mc[r] = NEGBIG; lc[r] = 0.f; }
            bf16x8 nkc[2][2], nvc[4];
#define CMPK_LOAD(nb_) do { _Pragma("unroll") for (int f = 0; f < 2; ++f) _Pragma("unroll") for (int ks = 0; ks < 2; ++ks) nkc[f][ks] = *(const bf16x8*)(kcb + (size_t)((nb_) >> 5) * 2048 + ((f * 2 + ks) * 16 + fr) * 32 + fq * 8); } while (0)
#define CMPV_LOAD(nb_) do { _Pragma("unroll") for (int df = 0; df < 4; ++df) { const bf16_t* vp = vcb + (size_t)((nb_) >> 5) * 2048 + (df * 32 + fr) * 16 + fq * 4; nvc[df] = ldv8(vp, vp + 256); } } while (0)
            CMPK_LOAD(0);
            for (int nb = 0; nb <= nmax_tile; nb += 32) {
                bf16x8 kf[2][2];
#pragma unroll
                for (int f = 0; f < 2; ++f) { kf[f][0] = nkc[f][0]; kf[f][1] = nkc[f][1]; }
                { const int nn = (nb + 32 <= nmax_tile) ? nb + 32 : 0; CMPK_LOAD(nn); }
#pragma unroll
                for (int r = 0; r < 4; ++r) {
                    f32x4 st[2];
#pragma unroll
                    for (int f = 0; f < 2; ++f) {
                        st[f] = __builtin_amdgcn_mfma_f32_16x16x32_bf16(kf[f][0], qf[r][0], z4, 0, 0, 0);
                        st[f] = __builtin_amdgcn_mfma_f32_16x16x32_bf16(kf[f][1], qf[r][1], st[f], 0, 0, 0);
                    }
                    float mx = NEGBIG;
#pragma unroll
                    for (int f = 0; f < 2; ++f)
#pragma unroll
                        for (int e = 0; e < 4; ++e) { const int n = nb + f * 16 + fq * 4 + e; if (n <= nmax_lane) mx = fmaxf(mx, st[f][e]); }
                    float mn = mc[r];
                    if (__builtin_amdgcn_ballot_w64(mx > mc[r] + 8.0f) != 0ull) mn = fmaxf(mc[r], max4(mx));
                    float ps = 0.f;
#pragma unroll
                    for (int f = 0; f < 2; ++f)
#pragma unroll
                        for (int e = 0; e < 4; ++e) { const int n = nb + f * 16 + fq * 4 + e; if (n <= nmax_lane) ps += __expf(st[f][e] - mn); }
                    lc[r] = lc[r] * __expf(mc[r] - mn) + ps; mc[r] = mn;
                    __builtin_amdgcn_sched_barrier(0);
                }
            }
#pragma unroll
            for (int r = 0; r < 4; ++r) { const float l = red4(lc[r]); invl[r] = l > 0.f ? 1.0f / l : 0.f; }
            for (int i = lane; i < 16 * 260; i += 64) IMP[i] = 0.f;
            float carry = 0.f;
            float gc[4];
#pragma unroll
            for (int r = 0; r < 4; ++r) gc[r] = NGT[tok * 48 + (g * 4 + r) * 3];
            for (int nb = 0; nb <= nmax_tile; nb += 32) {
                bf16x8 kf[2][2], vf[4];
#pragma unroll
                for (int f = 0; f < 2; ++f) { kf[f][0] = nkc[f][0]; kf[f][1] = nkc[f][1]; }
                CMPV_LOAD(nb);
#pragma unroll
                for (int df = 0; df < 4; ++df) vf[df] = nvc[df];
                { const int nn = (nb + 32 <= nmax_tile) ? nb + 32 : nb; CMPK_LOAD(nn); }
                f32x4 pg[2] = {z4, z4};
#pragma unroll
                for (int r = 0; r < 4; ++r) {
                    f32x4 st[2];
#pragma unroll
                    for (int f = 0; f < 2; ++f) {
                        st[f] = __builtin_amdgcn_mfma_f32_16x16x32_bf16(kf[f][0], qf[r][0], z4, 0, 0, 0);
                        st[f] = __builtin_amdgcn_mfma_f32_16x16x32_bf16(kf[f][1], qf[r][1], st[f], 0, 0, 0);
#pragma unroll
                        for (int e = 0; e < 4; ++e) { const int n = nb + f * 16 + fq * 4 + e; st[f][e] = (n <= nmax_lane) ? __expf(st[f][e] - mc[r]) * invl[r] : 0.f; }
                        pg[f] += st[f];
                    }
                    const float gg = dry ? 0.f : gc[r];
                    const bf16x8 pf = pack8(st[0] * gg, st[1] * gg);
#pragma unroll
                    for (int df = 0; df < 4; ++df) acc[r][df] = __builtin_amdgcn_mfma_f32_16x16x32_bf16(vf[df], pf, acc[r][df], 0, 0, 0);
                    __builtin_amdgcn_sched_barrier(0);
                }
                const int src = (lane - 16) & 63;
                const float s0 = __shfl(pg[0].w, src), s1 = __shfl(pg[1].w, src), sc = __shfl(carry, src);
                const float prev0 = fq > 0 ? s0 : sc, prev1 = fq > 0 ? s1 : s0;
                const float imp0 = (pg[0].x + pg[0].y) + (pg[0].z + pg[0].w) + prev0;
                const float imp1 = (pg[1].x + pg[1].y) + (pg[1].z + pg[1].w) + prev1;
                const int jb = (nb >> 2) + fq;
                IMP[fr * 260 + jb] = imp0; IMP[fr * 260 + jb + 4] = imp1;
                carry = pg[1].w;
            }
#undef CMPK_LOAD
#undef CMPV_LOAD
        }
        {
            const int nf = cur >= 2 ? 3 : cur + 1;
            if (fq == 0) {
                SEL[fr * 16 + 0] = 0;
                if (cur == 1) SEL[fr * 16 + 1] = 1;
                if (cur >= 2) { SEL[fr * 16 + 1] = cur - 1; SEL[fr * 16 + 2] = cur; }
            }
            const int ncand = cur >= 3 ? cur - 2 : 0, extra = 16 - nf;
            if (ncand <= extra) {
                if (fq == 0) { for (int k = 0; k < extra; ++k) SEL[fr * 16 + nf + k] = (k < ncand) ? 1 + k : -1; }
            } else {
                for (int rnd = 0; rnd < extra; ++rnd) {
                    float bv = -1.0f; int bj = 1 << 20;
                    for (int jb = 1 + fq; jb <= cur - 2; jb += 4) { const float v = IMP[fr * 260 + jb]; if (v > bv) { bv = v; bj = jb; } }
#pragma unroll
                    for (int o = 16; o <= 32; o <<= 1) {
                        const float ov = __shfl_xor(bv, o); const int oj = __shfl_xor(bj, o);
                        if (ov > bv || (ov == bv && oj < bj)) { bv = ov; bj = oj; }
                    }
                    if (fq == 0) SEL[fr * 16 + nf + rnd] = bj;
                    if (((bj - 1) & 3) == fq) IMP[fr * 260 + bj] = -2.0f;
                }
            }
        }
#pragma unroll
        for (int r = 0; r < 4; ++r)
#pragma unroll
            for (int df = 0; df < 4; ++df) {
                const f32x4 v = acc[r][df];
                *(u32x2*)(O + tok * 1024 + (g * 4 + r) * 64 + df * 16 + fq * 4) = (u32x2){pk2(v.x, v.y), pk2(v.z, v.w)};
            }
        asm volatile("s_waitcnt vmcnt(0)" ::: "memory");
        unsigned selp[4];
        {
            const u32x4* sp = (const u32x4*)(SEL + fr * 16);
#pragma unroll
            for (int q = 0; q < 4; ++q) { const u32x4 w = sp[q]; selp[q] = (w.x & 255u) | ((w.y & 255u) << 8) | ((w.z & 255u) << 16) | ((w.w & 255u) << 24); }
        }
        for (int rep = 0; rep < rep_sel; ++rep) {
            const bool dry = (rep + 1 < rep_sel);
            const unsigned char* k8b = p.ws + WS_KS + (size_t)bg * SEQ * 64; const unsigned char* v8b = p.ws + WS_VST + (size_t)bg * 256 * 4096;
            const float* skb = (const float*)(p.ws + WS_KS + 12 * MiB) + (size_t)bg * 256; const float* svb = (const float*)(p.ws + WS_VST + 12 * MiB) + (size_t)bg * 256;
            const unsigned char* Q8 = p.ws + WS_Q8; const float* SQ8 = (const float*)(p.ws + WS_Q8 + 32 * MiB);
            const int nv = cur + 1 < 16 ? cur + 1 : 16, npair = (nv + 1) >> 1, total = 16 * npair;
            const int lrow = lane >> 2, lch = lane & 3;
            int woffk[4];
#pragma unroll
            for (int j = 0; j < 4; ++j) woffk[j] = lrow * 64 + ((lch ^ j) << 4) + j * 1024;
            const int woffv = lrow * 64 + ((lch ^ ((lrow >> 2) & 3)) << 4) + 4096;
            const int rr = fr & 3;
            const int jq = fr >> 2;
            const int rdk = (16 * jq + rr) * 64 + ((fq ^ jq) << 4);
            const int rdv = fr * 64 + ((fq ^ jq) << 4) + 4096;
            u32x4 sk[2][4], sv[2][4]; float ssk[2], ssv[2];
            int jbn[2];
#define SEL_GET(tokI, slotK) ((int)(((unsigned)__builtin_amdgcn_readlane((int)(((slotK) >> 2) == 0 ? selp[0] : ((slotK) >> 2) == 1 ? selp[1] : ((slotK) >> 2) == 2 ? selp[2] : selp[3]), (tokI)) >> (((slotK) & 3) * 8)) & 255u))
#define SEL_ISSUE(tokI, pairP) do { \
                const int k0_ = 2 * (pairP), k1_ = (2 * (pairP) + 1 < nv) ? 2 * (pairP) + 1 : k0_; \
                jbn[0] = __builtin_amdgcn_readfirstlane(SEL_GET(tokI, k0_)); jbn[1] = __builtin_amdgcn_readfirstlane(SEL_GET(tokI, k1_)); \
                _Pragma("unroll") for (int u = 0; u < 2; ++u) { \
                    const unsigned char* kb_ = k8b + (size_t)jbn[u] * 4096; const unsigned char* vb_ = v8b + (size_t)jbn[u] * 4096; \
                    _Pragma("unroll") for (int j = 0; j < 4; ++j) { sk[u][j] = *(const u32x4*)(kb_ + j * 1024 + lane * 16); sv[u][j] = *(const u32x4*)(vb_ + j * 1024 + lane * 16); } \
                    ssk[u] = skb[jbn[u]]; ssv[u] = svb[jbn[u]]; } } while (0)
            SEL_ISSUE(0, 0);
            v8i bq[2] = {(v8i){0, 0, 0, 0, 0, 0, 0, 0}, (v8i){0, 0, 0, 0, 0, 0, 0, 0}};
            float sq = 0.f, ms = NEGBIG, ls = 0.f;
            f32x4 os[4] = {z4, z4, z4, z4};
            u32x2 oprev[4] = {(u32x2){0u, 0u}, (u32x2){0u, 0u}, (u32x2){0u, 0u}, (u32x2){0u, 0u}};
            int i = 0, pp = 0;
            for (int v = 0; v < total; ++v) {
                const int jb0 = jbn[0], jb1 = jbn[1];
                const bool second_valid = (2 * pp + 1 < nv);
                const float ck0 = ssk[0], ck1 = ssk[1], cv0 = ssv[0], cv1 = ssv[1];
#pragma unroll
                for (int u = 0; u < 2; ++u)
#pragma unroll
                    for (int j = 0; j < 4; ++j) {
                        *(u32x4*)(WL + u * 8192 + woffk[j]) = sk[u][j];
                        *(u32x4*)(WL + u * 8192 + woffv + j * 1024) = sv[u][j];
                    }
                if (v + 1 < total) {
                    int p2 = pp + 1, i2 = i; if (p2 == npair) { p2 = 0; i2 = i + 1; }
                    SEL_ISSUE(i2, p2);
                }
                __builtin_amdgcn_sched_barrier(0);
                const int ti = t0 + i;
                if (pp == 0) {
                    const size_t tk = (size_t)b * SEQ + ti;
                    {
                        const u32x4 q16 = *(const u32x4*)(Q8 + tk * 1024 + (g * 4 + rr) * 64 + fq * 16);
#pragma unroll
                        for (int P = 0; P < 2; ++P) {
                            const bool lo = (jq == 2 * P), hi = (jq == 2 * P + 1);
                            bq[P] = (v8i){lo ? (int)q16.x : 0, lo ? (int)q16.y : 0, lo ? (int)q16.z : 0, lo ? (int)q16.w : 0,
                                          hi ? (int)q16.x : 0, hi ? (int)q16.y : 0, hi ? (int)q16.z : 0, hi ? (int)q16.w : 0};
                        }
                    }
                    sq = SQ8[tk * 16 + g * 4 + rr] * 1.4426950408889634f;
                    ms = NEGBIG; ls = 0.f;
#pragma unroll
                    for (int df = 0; df < 4; ++df) { os[df] = z4; oprev[df] = *(const u32x2*)(O + tk * 1024 + (g * 4 + rr) * 64 + df * 16 + fq * 4); }
                }
                f32x4 sc4[4];
#pragma unroll
                for (int m = 0; m < 4; ++m) {
                    const int P = m >> 1, h = m & 1;
                    const u32x4 klo = *(const u32x4*)(WL + P * 8192 + rdk + (4 * h) * 64), khi = *(const u32x4*)(WL + P * 8192 + rdk + (8 + 4 * h) * 64);
                    const v8i ka = (v8i){(int)klo.x, (int)klo.y, (int)klo.z, (int)klo.w, (int)khi.x, (int)khi.y, (int)khi.z, (int)khi.w};
                    sc4[m] = __builtin_amdgcn_mfma_scale_f32_16x16x128_f8f6f4(ka, bq[P], z4, 0, 0, 0, 0x7f7f7f7f, 0, 0x7f7f7f7f);
                }
                const bool jb_ = (jq & 1) != 0, ju_ = (jq & 2) != 0;
                f32x4 a0, a1;
#pragma unroll
                for (int e = 0; e < 4; ++e) { a0[e] = ju_ ? sc4[2][e] : sc4[0][e]; a1[e] = ju_ ? sc4[3][e] : sc4[1][e]; }
                const float c_own = sq * (ju_ ? ck1 : ck0);
                const float cv_own = ju_ ? cv1 : cv0;
                if (jb0 == cur || jb1 == cur || !second_valid) {
                    const int jbu = ju_ ? jb1 : jb0;
                    const bool allbad = ju_ && !second_valid;
                    const int key0 = jbu * 64 + 16 * fq + 8 * (jq & 1);
#pragma unroll
                    for (int e = 0; e < 4; ++e) { if (allbad || key0 + e > ti) a0[e] = NEGBIG; if (allbad || key0 + 4 + e > ti) a1[e] = NEGBIG; }
                }
                const float mxr = fmaxf(fmaxf(fmaxf(a0.x, a0.y), fmaxf(a0.z, a0.w)), fmaxf(fmaxf(a1.x, a1.y), fmaxf(a1.z, a1.w)));
                const float mxl = mxr > -1.0e29f ? mxr * c_own : NEGBIG;
                float mn = ms;
                if (__builtin_amdgcn_ballot_w64(mxl > ms + 4.0f) != 0ull) {
                    float m16 = max4(mxl); m16 = fmaxf(m16, __shfl_xor(m16, 4)); m16 = fmaxf(m16, __shfl_xor(m16, 8));
                    mn = fmaxf(ms, m16);
                    const float al = __builtin_amdgcn_exp2f(ms - mn);
                    ls *= al;
#pragma unroll
                    for (int df = 0; df < 4; ++df) os[df] = os[df] * al;
                }
                const float off = 4.0f - mn;
                float ps = 0.f;
#pragma unroll
                for (int e = 0; e < 4; ++e) { a0[e] = __builtin_amdgcn_exp2f(a0[e] * c_own + off); a1[e] = __builtin_amdgcn_exp2f(a1[e] * c_own + off); ps += a0[e] + a1[e]; }
                ls += ps; ms = mn;
                int w0 = 0, w1 = 0;
                w0 = __builtin_amdgcn_cvt_pk_fp8_f32(a0.x, a0.y, w0, false); w0 = __builtin_amdgcn_cvt_pk_fp8_f32(a0.z, a0.w, w0, true);
                w1 = __builtin_amdgcn_cvt_pk_fp8_f32(a1.x, a1.y, w1, false); w1 = __builtin_amdgcn_cvt_pk_fp8_f32(a1.z, a1.w, w1, true);
                const v8i pb = (v8i){jq == 0 ? w0 : 0, jq == 0 ? w1 : 0, jq == 1 ? w0 : 0, jq == 1 ? w1 : 0, jq == 2 ? w0 : 0, jq == 2 ? w1 : 0, jq == 3 ? w0 : 0, jq == 3 ? w1 : 0};
#pragma unroll
                for (int df = 0; df < 4; ++df) {
                    const u32x4 v0 = *(const u32x4*)(WL + rdv + df * 1024), v1 = *(const u32x4*)(WL + 8192 + rdv + df * 1024);
                    const v8i va = (v8i){(int)v0.x, (int)v0.y, (int)v0.z, (int)v0.w, (int)v1.x, (int)v1.y, (int)v1.z, (int)v1.w};
                    const f32x4 pv = __builtin_amdgcn_mfma_scale_f32_16x16x128_f8f6f4(va, pb, z4, 0, 0, 0, 0x7f7f7f7f, 0, 0x7f7f7f7f);
                    os[df] = os[df] + pv * cv_own;
                }
                if (pp == npair - 1) {
                    float l = red4(ls); l += __shfl_xor(l, 4); l += __shfl_xor(l, 8);
#pragma unroll
                    for (int df = 0; df < 4; ++df)
#pragma unroll
                        for (int e = 0; e < 4; ++e) { float v_ = os[df][e]; v_ += __shfl_xor(v_, 4); v_ += __shfl_xor(v_, 8); os[df][e] = v_; }
                    const float gsv = NGT[((size_t)b * SEQ + ti) * 48 + (g * 4 + rr) * 3 + 1];
                    const float sc = gsv / l;
                    if (fr < 4 && !dry) {
                        bf16_t* op = O + ((size_t)b * SEQ + ti) * 1024 + (g * 4 + fr) * 64 + fq * 4;
#pragma unroll
                        for (int df = 0; df < 4; ++df) {
                            const f32x4 val = os[df] * sc; const u32x2 c = oprev[df];
                            *(u32x2*)(op + df * 16) = (u32x2){pk2(bflo(c.x) + val.x, bfhi(c.x) + val.y), pk2(bflo(c.y) + val.z, bfhi(c.y) + val.w)};
                        }
                    }
                }
                ++pp; if (pp == npair) { pp = 0; ++i; }
            }
#undef SEL_GET
#undef SEL_ISSUE
        }
    }
}
constexpr int NPHASES = 18;
#ifndef PROBE_PHASE
#define PROBE_PHASE (-1)
#endif
#ifndef ATT_REP_CMP
#define ATT_REP_CMP 1
#endif
#ifndef ATT_REP_WIN
#define ATT_REP_WIN 1
#endif
#ifndef ATT_REP_SEL
#define ATT_REP_SEL 1
#endif
#ifndef TS_PHASE
#define TS_PHASE (-1)
#endif
#ifndef TS_MULT
#define TS_MULT 4
#endif
#ifndef PROBE_REPS
#define PROBE_REPS 1
#endif
__global__ void __launch_bounds__(NTHREADS, 2) mega(Params p) {
    __shared__ __attribute__((aligned(1024))) unsigned char lds[LDS_BYTES + 16];
    unsigned* bar_st = (unsigned*)(lds + LDS_BYTES);
    cg::grid_group grid = cg::this_grid();
    const float* MOD = (const float*)(p.ws + WS_MOD);
    bf16_t* HM = (bf16_t*)(p.ws + WS_HM);
    if (threadIdx.x < 4) bar_st[threadIdx.x] = 0u;
    __syncthreads();
    XcdBarrier bar = xcd_barrier_post((unsigned*)(p.ws + WS_CTL), (volatile LAS unsigned*)bar_st);
    const int lo = p.ph_lo, hi = p.ph_hi;
    const bool dry0 = (p.ph_hi < 0);
    const int opq = (p.ph_hi < 0) ? 1 : 0;
    const bool never = (p.ph_hi < 0);
    unsigned long long ts_a = 0ull, ts_b = 0ull;
#define PHASE(k, call, drycall) if (lo <= (k) && (k) < hi) { \
        if (TS_PHASE == (k)) ts_a = __builtin_amdgcn_s_memrealtime(); \
        if (PROBE_PHASE == (k)) { for (int rep = 0; rep < PROBE_REPS; ++rep) { const bool dry = !dry0; drycall; __syncthreads(); } } \
        { const bool dry = dry0; call; } \
        if ((k) + 1 < hi) { if (never) grid.sync(); else xcd_barrier(bar); } \
        if (TS_PHASE == (k)) ts_b = __builtin_amdgcn_s_memrealtime(); }
    PHASE(0, phase_prep(p, (float*)lds, 0), phase_prep(p, (float*)lds, 0))
    PHASE(1, phase_norm(p, p.in[0], p.in[2], MOD + 0, MOD + 1024, HM), phase_norm(p, p.in[0], p.in[2], MOD + 0, MOD + 1024, HM))
    PHASE(2, phase_s5_win(p, lds), phase_s5_win(p, lds))
    PHASE(3, phase_s5_a(p, lds), phase_s5_a(p, lds))
    PHASE(4, (phase_s5_scan(p), phase_prep(p, (float*)lds, 1)), (phase_s5_scan(p), phase_prep(p, (float*)lds, 1)))
    PHASE(5, phase_s5_b(p, lds), phase_s5_b(p, lds))
    PHASE(6, phase_s5_glu(p, lds), phase_s5_glu(p, lds))
    PHASE(7, phase_norm(p, p.out, p.in[3], MOD + 3072, MOD + 4096, HM), phase_norm(p, p.out, p.in[3], MOD + 3072, MOD + 4096, HM))
    PHASE(8, phase_peer_route(p, 0, lds), phase_peer_route(p, 0, lds))
    PHASE(9, phase_peer_apply6(p, 0, lds, dry), phase_peer_apply6(p, 0, lds, dry))
    PHASE(10, phase_nsa_proj(p, lds), phase_nsa_proj(p, lds))
    PHASE(11, (phase_nsa_cmp1(p, lds), phase_tab1(p)), (phase_nsa_cmp1(p, lds), phase_tab1(p)))
    PHASE(12, phase_nsa_cmp2(p, lds), phase_nsa_cmp2(p, lds))
    PHASE(13, phase_nsa_attn(p, lds, ATT_REP_CMP + opq, ATT_REP_WIN + opq, ATT_REP_SEL + opq), phase_nsa_attn(p, lds, 1 + opq, 1 + opq, 1 + opq))
    PHASE(14, phase_nsa_wo(p, lds, dry), phase_nsa_wo(p, lds, dry))
    PHASE(15, phase_norm(p, p.out, p.in[3] + D, MOD + 2 * 6144 + 3072, MOD + 2 * 6144 + 4096, HM), phase_norm(p, p.out, p.in[3] + D, MOD + 2 * 6144 + 3072, MOD + 2 * 6144 + 4096, HM))
    PHASE(16, phase_peer_route(p, 1, lds), phase_peer_route(p, 1, lds))
    PHASE(17, phase_peer_apply6(p, 1, lds, dry), phase_peer_apply6(p, 1, lds, dry))
#undef PHASE
    if (TS_PHASE >= 0 && blockIdx.x == 0 && threadIdx.x == 0) {
        const unsigned long long t0 = __builtin_amdgcn_s_memrealtime(), want = (ts_b - ts_a) * TS_MULT;
        while (__builtin_amdgcn_s_memrealtime() - t0 < want) __builtin_amdgcn_s_sleep(8);
    }
}

extern "C" void kernel_launch(void* const* d_in, const int* in_sizes, int n_in, void* d_out, int out_size, void* d_ws, size_t ws_size, hipStream_t stream) {
    static int grid_blocks = 0;
    if (!grid_blocks) {
        int dev = 0, cus = 0, per_cu = 0;
        hipGetDevice(&dev);
        hipDeviceGetAttribute(&cus, hipDeviceAttributeMultiprocessorCount, dev);
        hipOccupancyMaxActiveBlocksPerMultiprocessor(&per_cu, mega, NTHREADS, 0);
        if (per_cu > 2) per_cu = 2;
        if (per_cu < 1) per_cu = 1;
        grid_blocks = cus * per_cu;
        if (ws_size < WS_END) fprintf(stderr, "kernel_launch: workspace too small: %zu < %zu\n", ws_size, (size_t)WS_END);
        if (n_in != 29) fprintf(stderr, "kernel_launch: expected 29 inputs, got %d\n", n_in);
    }
    hipMemsetAsync((unsigned char*)d_ws + WS_CTL, 0, 16384, stream);
    Params p{};
    for (int i = 0; i < 29; ++i) p.in[i] = (const float*)d_in[i];
    p.out = (float*)d_out; p.ws = (unsigned char*)d_ws;
#if SINGLE_LAUNCH
    p.ph_lo = 0; p.ph_hi = NPHASES;
    void* args[] = {&p};
    hipError_t e = hipLaunchCooperativeKernel((void*)mega, dim3(grid_blocks), dim3(NTHREADS), args, 0, stream);
    if (e != hipSuccess) fprintf(stderr, "cooperative launch failed: %s (grid %d)\n", hipGetErrorString(e), grid_blocks);
#else
    for (int ph = 0; ph < NPHASES; ++ph) {
        p.ph_lo = ph; p.ph_hi = ph + 1;
        hipLaunchKernelGGL(mega, dim3(grid_blocks), dim3(NTHREADS), 0, stream, p);
    }
#endif
}
```

```cpp
#include <hip/hip_runtime.h>
#include <hip/hip_cooperative_groups.h>
#include <cstdio>
#include <cstdint>
namespace cg = cooperative_groups;

#ifndef SINGLE_LAUNCH
#define SINGLE_LAUNCH 1
#endif

typedef unsigned short bf16_t;
typedef short bf16x8 __attribute__((ext_vector_type(8)));
typedef float f32x4 __attribute__((ext_vector_type(4)));
typedef float f32x2 __attribute__((ext_vector_type(2)));
typedef unsigned u32x4 __attribute__((ext_vector_type(4)));
typedef unsigned u32x2 __attribute__((ext_vector_type(2)));
typedef __bf16 bf16x2_t __attribute__((ext_vector_type(2)));
typedef float v32f __attribute__((ext_vector_type(32)));
typedef float v16f __attribute__((ext_vector_type(16)));
typedef unsigned v6u __attribute__((ext_vector_type(6)));
typedef int v8i __attribute__((ext_vector_type(8)));

constexpr int D = 1024, BATCH = 2, SEQ = 16384, T = BATCH * SEQ;
constexpr int NTHREADS = 256;
constexpr float RMS_EPS = 1e-6f;
constexpr int S5G = 64, S5P = 64, S5L = 32, S5NCH = T / S5L  , S5CPB = SEQ / S5L  ;
constexpr int NH = 16, HD = 64, NG = 4, NPROJ = 2608, NPROJ_PAD = 2688, NC = 1023, NSB = 256;
constexpr int PH = 8, PK = 16, PNK = 128, PE = 16384;

constexpr size_t MiB = 1ull << 20;
constexpr size_t WS_CTL = 0;
constexpr size_t WS_MOD = 1 * MiB;
constexpr size_t WS_WIN_T = 2 * MiB;
constexpr size_t WS_WGLU_T = 4 * MiB;
constexpr size_t WS_WPROJ_T = 8 * MiB;
constexpr size_t WS_WK1_T = 14 * MiB;
constexpr size_t WS_WV1_T = 15 * MiB;
constexpr size_t WS_WK2_T = 16 * MiB;
constexpr size_t WS_WV2_T = 16 * MiB + 512 * 1024;
constexpr size_t WS_WO_T = 17 * MiB;
constexpr size_t WS_WQ_T = 19 * MiB;
constexpr size_t WS_SUBK = 27 * MiB;
constexpr size_t WS_ROPE = 28 * MiB;
constexpr size_t WS_MISC = 32 * MiB;
constexpr size_t WS_TW = 33 * MiB;
constexpr size_t WS_VG = 73 * MiB;
constexpr size_t WS_PU = 82 * MiB;
constexpr size_t WS_PV = 114 * MiB;
constexpr size_t WS_HM = 146 * MiB;
constexpr size_t WS_C = 210 * MiB;
constexpr size_t WS_UG = WS_C;
constexpr size_t WS_YI = WS_C + 64 * MiB;
constexpr size_t WS_WST = WS_C + 128 * MiB;
constexpr size_t WS_SST = WS_C + 160 * MiB;
constexpr size_t WS_YG = WS_C + 176 * MiB;
constexpr size_t WS_QK = WS_C;
constexpr size_t WS_TOPS = WS_C + 128 * MiB;
constexpr size_t WS_TOPI = WS_C + 160 * MiB;
constexpr size_t WS_EXP = WS_C + 192 * MiB;
constexpr size_t WS_GATE = WS_C + 208 * MiB;
constexpr size_t WS_ACT = WS_C + 224 * MiB;
constexpr size_t WS_Q = WS_C;
constexpr size_t WS_KC = WS_C + 64 * MiB;
constexpr size_t WS_VC = WS_C + 81 * MiB;
constexpr size_t WS_KS = WS_C + 98 * MiB;
constexpr size_t WS_VST = WS_C + 114 * MiB;
constexpr size_t WS_KW = WS_C + 130 * MiB;
constexpr size_t WS_VWT = WS_C + 146 * MiB;
constexpr size_t WS_NG = WS_C + 162 * MiB;
constexpr size_t WS_KCMP = WS_C + 170 * MiB;
constexpr size_t WS_VCMPT = WS_C + 171 * MiB;
constexpr size_t WS_HID = WS_C + 172 * MiB;
constexpr size_t WS_O = WS_C + 182 * MiB;
constexpr size_t WS_KSB = WS_O;
constexpr size_t WS_VSB = WS_O + 16 * MiB;
constexpr size_t WS_Q8 = WS_C + 246 * MiB;
constexpr size_t WS_END = WS_C + 282 * MiB;

constexpr int LDS_BYTES = 74240;

struct Params {
    const float* in[29];
    float* out;
    unsigned char* ws;
    int ph_lo, ph_hi;
};

__device__ __forceinline__ unsigned f2bf(float f) { unsigned u = __builtin_bit_cast(unsigned, f); return (u + 0x7fffu + ((u >> 16) & 1u)) >> 16; }
__device__ __forceinline__ unsigned pk2(float lo, float hi) { return f2bf(lo) | (f2bf(hi) << 16); }
__device__ __forceinline__ float bf2f(unsigned h) { return __builtin_bit_cast(float, h << 16); }
__device__ __forceinline__ float bflo(unsigned w) { return __builtin_bit_cast(float, w << 16); }
__device__ __forceinline__ float bfhi(unsigned w) { return __builtin_bit_cast(float, w & 0xffff0000u); }
__device__ __forceinline__ float gelu_tanh(float x) {
    const float u = 0.7978845608028654f * (x + 0.044715f * x * x * x);
    const float e = __expf(2.0f * u);
    const float th = 1.0f - 2.0f / (e + 1.0f);
    return 0.5f * x * (1.0f + th);
}
__device__ __forceinline__ float sigmoidf_(float x) { return 1.0f / (1.0f + __expf(-x)); }
__device__ __forceinline__ float wave_sum(float v) {
#pragma unroll
    for (int o = 1; o < 64; o <<= 1) v += __shfl_xor(v, o);
    return v;
}
__device__ __forceinline__ float dot2bf(unsigned a, unsigned b, float acc) {
    return __builtin_amdgcn_fdot2_f32_bf16(__builtin_bit_cast(bf16x2_t, a), __builtin_bit_cast(bf16x2_t, b), acc, false);
}

#define LAS __attribute__((address_space(3)))
#define XB_TMO      128
#define XB_XCNT(j)  (256  + 64 * (j))
#define XB_XSUB(j)  (1280 + 64 * (j))
#define XB_XGEN(j)  (2304 + 64 * (j))
#define XB_TOP      3328
#define XB_TOPGEN   3392
#define XCD_BAR_WORDS 3456
#define XB_SPIN_CAP (1u << 24)

__device__ __forceinline__ unsigned xb_ld(unsigned* p)              { return __hip_atomic_load(p, __ATOMIC_RELAXED, __HIP_MEMORY_SCOPE_AGENT); }
__device__ __forceinline__ unsigned xb_add(unsigned* p, unsigned v) { return __hip_atomic_fetch_add(p, v, __ATOMIC_RELAXED, __HIP_MEMORY_SCOPE_AGENT); }
__device__ __forceinline__ unsigned xb_xcc_id() { return (unsigned)__builtin_amdgcn_s_getreg((3 << 11) | 20) & 0xFu; }
#define XB_SPIN(cond, bar) do { unsigned _sp = 0; while (cond) { __builtin_amdgcn_s_sleep(1); \
    if ((++_sp & 255u) == 0u) { if (xb_ld(&(bar)[XB_TMO])) break; if (_sp > XB_SPIN_CAP) { atomicAdd(&(bar)[XB_TMO], 1u); break; } } } } while (0)

struct XcdBarrier {
    unsigned* bar; unsigned x;
    volatile LAS unsigned* st;
};

__device__ __forceinline__ XcdBarrier xcd_barrier_post(unsigned* bar, volatile LAS unsigned* st) {
    XcdBarrier b; b.bar = bar; b.x = xb_xcc_id(); b.st = st;
    if (threadIdx.x == 0) (void)xb_add(&bar[XB_XCNT(b.x)], 1u);
    return b;
}
__device__ __forceinline__ void xcd_barrier_complete(unsigned* bar, unsigned x, unsigned& nloc, unsigned& nx) {
    const unsigned G = gridDim.x * gridDim.y * gridDim.z;
    unsigned sum, cnt, mine, sp = 0u;
    for (;;) {
        sum = 0u; cnt = 0u; mine = 0u;
#pragma unroll
        for (unsigned j = 0; j < 16; ++j) { const unsigned c = xb_ld(&bar[XB_XCNT(j)]); sum += c; cnt += (c > 0u) ? 1u : 0u; mine = (j == x) ? c : mine; }
        if (sum == G) break;
        __builtin_amdgcn_s_sleep(1);
        if ((++sp & 255u) == 0u) { if (xb_ld(&bar[XB_TMO])) break; if (sp > XB_SPIN_CAP) { atomicAdd(&bar[XB_TMO], 1u); break; } }
    }
    nloc = mine > 0u ? mine : 1u; nx = cnt > 0u ? cnt : 1u;
}

__device__ __forceinline__ void xcd_barrier(const XcdBarrier& b) {
    asm volatile("s_waitcnt vmcnt(0)" ::: "memory");
    __syncthreads();
    if (threadIdx.x == 0) {
        unsigned* bar = b.bar;
        __builtin_amdgcn_s_waitcnt(0);
        unsigned nloc = b.st[0], nx = b.st[1];
        if (nloc == 0u) { xcd_barrier_complete(bar, b.x, nloc, nx); b.st[0] = nloc; b.st[1] = nx; }
        const unsigned old = xb_add(&bar[XB_XSUB(b.x)], 1u);
        const unsigned gen = old / nloc;
        if (old + 1u == (gen + 1u) * nloc) {
            __builtin_amdgcn_fence(__ATOMIC_RELEASE, "agent");
            asm volatile("s_waitcnt vmcnt(0)" ::: "memory");
            const unsigned og = xb_add(&bar[XB_TOP], 1u);
            const unsigned tg = og / nx;
            if (og + 1u == (tg + 1u) * nx) xb_add(&bar[XB_TOPGEN], 1u);
            else XB_SPIN(xb_ld(&bar[XB_TOPGEN]) == tg, bar);
            __builtin_amdgcn_fence(__ATOMIC_ACQUIRE, "agent");
            xb_add(&bar[XB_XGEN(b.x)], 1u);
            asm volatile("s_waitcnt vmcnt(0)" ::: "memory");
        } else {
            XB_SPIN(xb_ld(&bar[XB_XGEN(b.x)]) == gen, bar);
            __builtin_amdgcn_fence(__ATOMIC_ACQUIRE, "agent");
            asm volatile("s_waitcnt vmcnt(0)" ::: "memory");
        }
    }
    __syncthreads();
}
__device__ __forceinline__ void prep_mod_item(const Params& p, int item, float* lds) {
    const int layer = item / 192, cg0 = (item % 192) * 32;
    const int tid = threadIdx.x, col = cg0 + (tid & 31), kg = tid >> 5;
    const float* W = p.in[4] + (size_t)layer * D * 6 * D + col;
    const float* c = p.in[1];
    float* cact = lds + 512;
#pragma unroll
    for (int i = 0; i < 8; ++i) { const int q = tid + 256 * i; const float v = c[q]; cact[q] = v * sigmoidf_(v); }
    __syncthreads();
    float a0 = 0.f, a1 = 0.f;
    for (int k0 = kg * 128; k0 < kg * 128 + 128; k0 += 16) {
        float w[16];
#pragma unroll
        for (int u = 0; u < 16; ++u) w[u] = W[(size_t)(k0 + u) * (6 * D)];
#pragma unroll
        for (int u = 0; u < 16; ++u) { a0 += w[u] * cact[k0 + u]; a1 += w[u] * cact[1024 + k0 + u]; }
    }
    lds[tid] = a0; lds[256 + tid] = a1;
    __syncthreads();
    if (tid < 64) {
        const int b = tid >> 5, cc = tid & 31;
        float s = 0.f;
#pragma unroll
        for (int g = 0; g < 8; ++g) s += lds[b * 256 + g * 32 + cc];
        float* MOD = (float*)(p.ws + WS_MOD);
        MOD[(size_t)(layer * 2 + b) * 6144 + cg0 + cc] = s + p.in[5][(size_t)layer * 6144 + cg0 + cc];
    }
    __syncthreads();
}

template <int MODE>
__device__ __forceinline__ void prep_transpose_item(const float* W, int K, int N, bf16_t* WT, int item, float* lds) {
    const int nbn = (N + 63) / 64, kb = item / nbn, nb = item % nbn, k0 = kb * 64, n0 = nb * 64;
    const int tid = threadIdx.x;
#pragma unroll
    for (int i = 0; i < 16; ++i) {
        const int kk = (tid >> 6) + 4 * i, nn = tid & 63;
        const float v = (n0 + nn < N) ? W[(size_t)(k0 + kk) * N + n0 + nn] : 0.f;
        lds[kk * 65 + nn] = v;
    }
    __syncthreads();
    {
        const int nn = tid >> 2, ks = (tid & 3) * 16;
        const int n = n0 + nn;
        if (n < N) {
            int np = n;
            if (MODE == 1) { const int j = (n < 1024) ? n : n - 1024; np = (j >> 4) * 32 + (j & 15) + ((n < 1024) ? 0 : 16); }
            u32x4 o0, o1;
            const float* s = lds + nn;
            o0.x = pk2(s[(ks + 0) * 65], s[(ks + 1) * 65]); o0.y = pk2(s[(ks + 2) * 65], s[(ks + 3) * 65]);
            o0.z = pk2(s[(ks + 4) * 65], s[(ks + 5) * 65]); o0.w = pk2(s[(ks + 6) * 65], s[(ks + 7) * 65]);
            o1.x = pk2(s[(ks + 8) * 65], s[(ks + 9) * 65]); o1.y = pk2(s[(ks + 10) * 65], s[(ks + 11) * 65]);
            o1.z = pk2(s[(ks + 12) * 65], s[(ks + 13) * 65]); o1.w = pk2(s[(ks + 14) * 65], s[(ks + 15) * 65]);
            u32x4* dst = (u32x4*)(WT + (size_t)np * K + k0 + ks);
            dst[0] = o0; dst[1] = o1;
        }
    }
    __syncthreads();
}

__device__ __forceinline__ void cvt_item(const float* src, bf16_t* dst, int item) {
    const size_t base = (size_t)item * 8192 + threadIdx.x * 8;
#pragma unroll
    for (int i = 0; i < 4; ++i) {
        const size_t o = base + (size_t)i * 2048;
        const f32x4 a = *(const f32x4*)(src + o), b = *(const f32x4*)(src + o + 4);
        u32x4 w; w.x = pk2(a.x, a.y); w.y = pk2(a.z, a.w); w.z = pk2(b.x, b.y); w.w = pk2(b.z, b.w);
        *(u32x4*)(dst + o) = w;
    }
}
__device__ __forceinline__ void zero_item(bf16_t* dst, int item) {
    const size_t base = (size_t)item * 8192 + threadIdx.x * 8;
#pragma unroll
    for (int i = 0; i < 4; ++i) *(u32x4*)(dst + base + (size_t)i * 2048) = (u32x4){0u, 0u, 0u, 0u};
}

struct cpx { float re, im; };
__device__ __forceinline__ cpx cmul(cpx a, cpx b) { return {a.re * b.re - a.im * b.im, a.re * b.im + a.im * b.re}; }
__device__ __forceinline__ cpx cexp_pow(float are, float aim, float dt, int m) {
    const float mag = __expf(are * dt * (float)m);
    const double rev = (double)aim * (double)dt * (double)m * 0.15915494309189535;
    const float fr = (float)(rev - rint(rev));
    return {mag * __builtin_amdgcn_cosf(fr), mag * __builtin_amdgcn_sinf(fr)};
}
__device__ __forceinline__ cpx s5_coef(float are, float aim, float dt) {
    cpx ab = cexp_pow(are, aim, dt, 1);
    const float nr = ab.re - 1.0f, ni = ab.im, den = are * are + aim * aim;
    return {(nr * are + ni * aim) / den, (ni * are - nr * aim) / den};
}

__device__ __forceinline__ void prep_s5_T_item(const Params& p, int item) {
    const int gid = item * 256 + threadIdx.x;
    const int g = gid >> 9, m = (gid >> 4) & 31, i = gid & 15;
    const float* a_re = p.in[7] + g * 64; const float* a_im = p.in[8] + g * 64;
    const float dt = __expf(p.in[9][g]);
    const float* b_re = p.in[10] + (size_t)g * 64 * 16; const float* b_im = p.in[11] + (size_t)g * 64 * 16;
    const float* c_re = p.in[12] + (size_t)g * 16 * 64 + i * 64; const float* c_im = p.in[13] + (size_t)g * 16 * 64 + i * 64;
    float acc[16];
#pragma unroll
    for (int j = 0; j < 16; ++j) acc[j] = 0.f;
    for (int q = 0; q < 64; ++q) {
        const float are = a_re[q], aim = a_im[q];
        cpx z = cmul(cmul({c_re[q], c_im[q]}, cexp_pow(are, aim, dt, m)), s5_coef(are, aim, dt));
        const f32x4* br = (const f32x4*)(b_re + q * 16); const f32x4* bi = (const f32x4*)(b_im + q * 16);
#pragma unroll
        for (int j4 = 0; j4 < 4; ++j4) {
            const f32x4 r = br[j4], im = bi[j4];
            acc[j4 * 4 + 0] += z.re * r.x - z.im * im.x; acc[j4 * 4 + 1] += z.re * r.y - z.im * im.y;
            acc[j4 * 4 + 2] += z.re * r.z - z.im * im.z; acc[j4 * 4 + 3] += z.re * r.w - z.im * im.w;
        }
    }
    u32x4 o0, o1;
    o0.x = pk2(acc[0], acc[1]); o0.y = pk2(acc[2], acc[3]); o0.z = pk2(acc[4], acc[5]); o0.w = pk2(acc[6], acc[7]);
    o1.x = pk2(acc[8], acc[9]); o1.y = pk2(acc[10], acc[11]); o1.z = pk2(acc[12], acc[13]); o1.w = pk2(acc[14], acc[15]);
    bf16_t* TW = (bf16_t*)(p.ws + WS_TW) + (size_t)g * 640 * 512;
    const u32x4 z4 = (u32x4){0u, 0u, 0u, 0u};
    for (int lp = 0; lp + m < 32; ++lp) {
        u32x4* d = (u32x4*)(TW + (size_t)((lp + m) * 16 + i) * 512 + lp * 16);
        d[0] = o0; d[1] = o1;
        if (m > 0) { u32x4* dz = (u32x4*)(TW + (size_t)(lp * 16 + i) * 512 + (lp + m) * 16); dz[0] = z4; dz[1] = z4; }
    }
}
__device__ __forceinline__ void prep_s5_W_item(const Params& p, int item) {
    const int gid = item * 256 + threadIdx.x;
    const int g = gid >> 11, q = (gid >> 5) & 63, lp = gid & 31;
    const float are = p.in[7][g * 64 + q], aim = p.in[8][g * 64 + q];
    const float dt = __expf(p.in[9][g]);
    const cpx z = cmul(cexp_pow(are, aim, dt, 31 - lp), s5_coef(are, aim, dt));
    const float* br = p.in[10] + ((size_t)g * 64 + q) * 16; const float* bi = p.in[11] + ((size_t)g * 64 + q) * 16;
    float wr[16], wi[16];
#pragma unroll
    for (int j = 0; j < 16; ++j) { wr[j] = z.re * br[j] - z.im * bi[j]; wi[j] = z.re * bi[j] + z.im * br[j]; }
    bf16_t* TW = (bf16_t*)(p.ws + WS_TW) + (size_t)g * 640 * 512;
    u32x4* d0 = (u32x4*)(TW + (size_t)(512 + q) * 512 + lp * 16);
    u32x4* d1 = (u32x4*)(TW + (size_t)(576 + q) * 512 + lp * 16);
    d0[0] = (u32x4){pk2(wr[0], wr[1]), pk2(wr[2], wr[3]), pk2(wr[4], wr[5]), pk2(wr[6], wr[7])};
    d0[1] = (u32x4){pk2(wr[8], wr[9]), pk2(wr[10], wr[11]), pk2(wr[12], wr[13]), pk2(wr[14], wr[15])};
    d1[0] = (u32x4){pk2(wi[0], wi[1]), pk2(wi[2], wi[3]), pk2(wi[4], wi[5]), pk2(wi[6], wi[7])};
    d1[1] = (u32x4){pk2(wi[8], wi[9]), pk2(wi[10], wi[11]), pk2(wi[12], wi[13]), pk2(wi[14], wi[15])};
}
__device__ __forceinline__ void prep_s5_V_item(const Params& p, int item) {
    const int gid = item * 256 + threadIdx.x;
    const int g = gid >> 14, l = (gid >> 9) & 31, i = (gid >> 5) & 15, q0 = (gid & 31) * 2;
    const float dt = __expf(p.in[9][g]);
    float vr[2], vi[2];
#pragma unroll
    for (int e = 0; e < 2; ++e) {
        const int q = q0 + e;
        const cpx z = cmul({p.in[12][((size_t)g * 16 + i) * 64 + q], p.in[13][((size_t)g * 16 + i) * 64 + q]}, cexp_pow(p.in[7][g * 64 + q], p.in[8][g * 64 + q], dt, l + 1));
        vr[e] = z.re; vi[e] = -z.im;
    }
    bf16_t* VG = (bf16_t*)(p.ws + WS_VG) + ((size_t)g * 512 + l * 16 + i) * 128;
    *(unsigned*)(VG + q0) = pk2(vr[0], vr[1]);
    *(unsigned*)(VG + 64 + q0) = pk2(vi[0], vi[1]);
}
__device__ __forceinline__ void prep_al_item(const Params& p, int item) {
    const int gid = item * 256 + threadIdx.x;
    const int g = gid >> 6;
    const float dt = __expf(p.in[9][g]);
    const cpx z = cexp_pow(p.in[7][gid], p.in[8][gid], dt, S5L);
    f32x2* AL = (f32x2*)(p.ws + WS_MISC + 4096);
    AL[gid] = (f32x2){z.re, z.im};
}
__device__ __forceinline__ void prep_rope_item(const Params& p, int item) {
    const int gid = item * 256 + threadIdx.x;
    const int pos = gid >> 5, j = gid & 31;
    const float freq = exp2f(-(float)j * (13.287712379549449f / 32.0f));
    const float ang = (float)pos * freq;
    const double rev = (double)ang * 0.15915494309189535;
    const float fr = (float)(rev - rint(rev));
    f32x2* R = (f32x2*)(p.ws + WS_ROPE);
    R[gid] = (f32x2){__builtin_amdgcn_cosf(fr), __builtin_amdgcn_sinf(fr)};
}
__device__ __forceinline__ void prep_cmpbias_item(const Params& p, int item, float* lds) {
    const int kv = item >> 3, cg0 = (item & 7) * 32;
    const float* pe = p.in[17 + kv]; const float* w1 = p.in[kv == 0 ? 19 : 21];
    const int tid = threadIdx.x, col = cg0 + (tid & 31), kg = tid >> 5;
    float s = 0.f;
#pragma unroll 8
    for (int k = kg * 256; k < kg * 256 + 256; ++k) s += pe[k] * w1[(size_t)k * 256 + col];
    lds[tid] = s;
    __syncthreads();
    if (tid < 32) {
        float t = 0.f;
#pragma unroll
        for (int q = 0; q < 8; ++q) t += lds[q * 32 + tid];
        ((float*)(p.ws + WS_MISC))[kv * 256 + cg0 + tid] = t;
    }
    __syncthreads();
}

__device__ __forceinline__ void cvt_fp8_item(const float* src, unsigned char* dst, float* inv_scale, int item, const bool slice_major) {
    const int lane = threadIdx.x & 63, row0 = item * 16 + (threadIdx.x >> 6) * 4;
    f32x4 v[4][4];
#pragma unroll
    for (int r = 0; r < 4; ++r) {
        const f32x4* sp = (const f32x4*)(src + (size_t)(row0 + r) * D + lane * 16);
#pragma unroll
        for (int q = 0; q < 4; ++q) v[r][q] = sp[q];
    }
#pragma unroll
    for (int r = 0; r < 4; ++r) {
        float m = 0.f;
#pragma unroll
        for (int q = 0; q < 4; ++q) m = fmaxf(m, fmaxf(fmaxf(fabsf(v[r][q].x), fabsf(v[r][q].y)), fmaxf(fabsf(v[r][q].z), fabsf(v[r][q].w))));
#pragma unroll
        for (int o = 1; o < 64; o <<= 1) m = fmaxf(m, __shfl_xor(m, o));
        const float sc = m > 0.f ? 224.0f / m : 1.0f;
        unsigned w[4];
#pragma unroll
        for (int q = 0; q < 4; ++q) { int t = 0; t = __builtin_amdgcn_cvt_pk_fp8_f32(v[r][q].x * sc, v[r][q].y * sc, t, false); t = __builtin_amdgcn_cvt_pk_fp8_f32(v[r][q].z * sc, v[r][q].w * sc, t, true); w[q] = (unsigned)t; }
        const int row = row0 + r;
        const u32x4 wv = (u32x4){w[0], w[1], w[2], w[3]};
        if (slice_major) *(u32x4*)(dst + (size_t)(lane >> 3) * (PE * 128) + (size_t)row * 128 + (lane & 7) * 16) = wv;
        else *(u32x4*)(dst + (size_t)row * D + lane * 16) = wv;
        if (lane == 0) inv_scale[row] = m > 0.f ? m / 224.0f : 1.0f;
    }
}
__device__ __forceinline__ void cvt_fp6_item(const float* src, unsigned char* dst, float* inv_scale, int item) {
    const int lane = threadIdx.x & 63, half = lane >> 5, gl = lane & 31, row0 = item * 16 + (threadIdx.x >> 6) * 4;
#pragma unroll
    for (int pr = 0; pr < 2; ++pr) {
        const int row = row0 + pr * 2 + half;
        const f32x4* sp = (const f32x4*)(src + (size_t)row * D + gl * 32);
        f32x4 v[8];
#pragma unroll
        for (int q = 0; q < 8; ++q) v[q] = sp[q];
        float m = 0.f;
#pragma unroll
        for (int q = 0; q < 8; ++q) m = fmaxf(m, fmaxf(fmaxf(fabsf(v[q].x), fabsf(v[q].y)), fmaxf(fabsf(v[q].z), fabsf(v[q].w))));
#pragma unroll
        for (int o = 1; o < 32; o <<= 1) m = fmaxf(m, __shfl_xor(m, o));
        const float sc = m > 0.f ? 7.5f / m : 1.0f;
        v16f x0, x1;
#pragma unroll
        for (int q = 0; q < 8; ++q) {
            x0[q * 2 + 0] = v[q].x * sc; x1[q * 2 + 0] = v[q].y * sc; x0[q * 2 + 1] = v[q].z * sc; x1[q * 2 + 1] = v[q].w * sc;
        }
        const v6u w = __builtin_amdgcn_cvt_scalef32_2xpk16_fp6_f32(x0, x1, 1.0f);
        u32x2* dp = (u32x2*)(dst + (size_t)row * 768 + gl * 24);
        dp[0] = (u32x2){w[0], w[1]}; dp[1] = (u32x2){w[2], w[3]}; dp[2] = (u32x2){w[4], w[5]};
        if (gl == 0) inv_scale[row] = m > 0.f ? m / 7.5f : 1.0f;
    }
}
constexpr int P0_MOD = 384;
constexpr int P0_T_WIN = 16 * 16, P0_T_WGLU = 16 * 32, P0_T_WPROJ = 16 * 41, P0_T_WK1 = 32 * 4, P0_T_WK2 = 4 * 1, P0_T_WO = 16 * 16, P0_T_WQ = 16 * 32;
constexpr int P0_SUBK = (2 * 8 * 2 * 128 * 128) / 8192;
constexpr int P0_TAB = PE / 16;
constexpr int P0_S5T = 128, P0_S5W = 512, P0_S5V = 4096, P0_AL = 16, P0_ROPE = 2048, P0_CB = 16, P0_ZERO = 10 + 2;

__device__ __forceinline__ void phase_prep(const Params& p, float* lds, const int part) {
    const int n0 = P0_MOD;
    const int n1 = n0 + P0_T_WIN, n2 = n1 + P0_T_WGLU, n3 = n2 + P0_T_WPROJ, n4 = n3 + P0_T_WK1, n5 = n4 + P0_T_WK1, n6 = n5 + P0_T_WK2, n7 = n6 + P0_T_WK2,
              n8 = n7 + P0_T_WO, n9 = n8 + P0_T_WQ, n10 = n9 + P0_T_WQ, n11 = n10 + P0_SUBK, n12 = n11 + P0_TAB, n13 = n12 + P0_TAB,
              n14 = n13 + P0_S5T, n15 = n14 + P0_S5W, n16 = n15 + P0_S5V, n17 = n16 + P0_AL, n18 = n17 + P0_ROPE, n19 = n18 + P0_CB, n20 = n19 + 10, n21 = n20 + 2, n22 = n21 + 2;
    unsigned char* ws = p.ws;
#ifndef PREP_DUP_LO
#define PREP_DUP_LO 0
#define PREP_DUP_HI 0
#endif
    const int dupn = (PREP_DUP_HI) - (PREP_DUP_LO);
    const int nB = (n8 - n2) + (n10 - n9) + (n22 - n17);
    const int first = part == 0 ? (int)blockIdx.x : (int)blockIdx.x - 32, stride = part == 0 ? (int)gridDim.x : (int)gridDim.x - 32;
    if (first < 0 || stride <= 0) return;
    const int total = part == 0 ? (n22 - nB) + dupn : nB;
    for (int it0 = first; it0 < total; it0 += stride) {
        int it;
        if (part == 0) {
            it = it0;
            if (it >= n2) it += (n8 - n2);
            if (it >= n9) it += (n10 - n9);
            if (it0 >= (n22 - nB)) it = (PREP_DUP_LO) + (it0 - (n22 - nB));
        } else {
            it = n2 + it0;
            if (it >= n8) it += (n9 - n8);
            if (it >= n10) it += (n17 - n10);
        }
        if (it < n0) prep_mod_item(p, it, lds);
        else if (it < n1) prep_transpose_item<0>(p.in[6], 1024, 1024, (bf16_t*)(ws + WS_WIN_T), it - n0, lds);
        else if (it < n2) prep_transpose_item<1>(p.in[15], 1024, 2048, (bf16_t*)(ws + WS_WGLU_T), it - n1, lds);
        else if (it < n3) prep_transpose_item<0>(p.in[16], 1024, NPROJ, (bf16_t*)(ws + WS_WPROJ_T), it - n2, lds);
        else if (it < n4) prep_transpose_item<0>(p.in[19], 2048, 256, (bf16_t*)(ws + WS_WK1_T), it - n3, lds);
        else if (it < n5) prep_transpose_item<0>(p.in[21], 2048, 256, (bf16_t*)(ws + WS_WV1_T), it - n4, lds);
        else if (it < n6) prep_transpose_item<0>(p.in[20], 256, 64, (bf16_t*)(ws + WS_WK2_T), it - n5, lds);
        else if (it < n7) prep_transpose_item<0>(p.in[22], 256, 64, (bf16_t*)(ws + WS_WV2_T), it - n6, lds);
        else if (it < n8) prep_transpose_item<0>(p.in[23], 1024, 1024, (bf16_t*)(ws + WS_WO_T), it - n7, lds);
        else if (it < n9) prep_transpose_item<0>(p.in[24], 1024, 2048, (bf16_t*)(ws + WS_WQ_T), it - n8, lds);
        else if (it < n10) prep_transpose_item<0>(p.in[24] + (size_t)1024 * 2048, 1024, 2048, (bf16_t*)(ws + WS_WQ_T) + (size_t)2048 * 1024, it - n9, lds);
        else if (it < n11) cvt_item(p.in[25], (bf16_t*)(ws + WS_SUBK), it - n10);
        else if (it < n12) cvt_fp6_item(p.in[26], ws + WS_PU, (float*)(ws + WS_PU + 24 * MiB), it - n11);
        else if (it < n13) cvt_fp6_item(p.in[27], ws + WS_PV, (float*)(ws + WS_PV + 24 * MiB), it - n12);
        else if (it < n14) prep_s5_T_item(p, it - n13);
        else if (it < n15) prep_s5_W_item(p, it - n14);
        else if (it < n16) prep_s5_V_item(p, it - n15);
        else if (it < n17) prep_al_item(p, it - n16);
        else if (it < n18) prep_rope_item(p, it - n17);
        else if (it < n19) prep_cmpbias_item(p, it - n18, lds);
        else if (it < n20) zero_item((bf16_t*)(ws + WS_WPROJ_T) + (size_t)NPROJ * 1024, it - n19);
        else if (it < n21) zero_item((bf16_t*)(ws + WS_WK2_T) + (size_t)64 * 256, it - n20);
        else zero_item((bf16_t*)(ws + WS_WV2_T) + (size_t)64 * 256, it - n21);
    }
}

__device__ __forceinline__ void phase_norm(const Params& p, const float* X, const float* gw, const float* shift, const float* scale  , bf16_t* HM) {
    const int lane = threadIdx.x & 63, wave = threadIdx.x >> 6;
    for (int row = blockIdx.x * 4 + wave; row < T; row += gridDim.x * 4) {
        const int b = row / SEQ;
        const f32x4* xr = (const f32x4*)(X + (size_t)row * D) + lane;
        f32x4 v[4]; float s = 0.f;
#pragma unroll
        for (int j = 0; j < 4; ++j) { v[j] = xr[64 * j]; s += (v[j].x * v[j].x + v[j].y * v[j].y) + (v[j].z * v[j].z + v[j].w * v[j].w); }
        const float rs = rsqrtf(wave_sum(s) * (1.0f / D) + RMS_EPS);
        u32x2* o = (u32x2*)(HM + (size_t)row * D) + lane;
#pragma unroll
        for (int j = 0; j < 4; ++j) {
            const int c = lane * 4 + 256 * j;
            const f32x4 g = *(const f32x4*)(gw + c), sh = *(const f32x4*)(shift + (size_t)b * 6144 + c), sc = *(const f32x4*)(scale + (size_t)b * 6144 + c);
            const float y0 = v[j].x * rs * g.x * (1.f + sc.x) + sh.x, y1 = v[j].y * rs * g.y * (1.f + sc.y) + sh.y;
            const float y2 = v[j].z * rs * g.z * (1.f + sc.z) + sh.z, y3 = v[j].w * rs * g.w * (1.f + sc.w) + sh.w;
            o[64 * j] = (u32x2){pk2(y0, y1), pk2(y2, y3)};
        }
    }
}
__device__ __forceinline__ void phase_final_norm(const Params& p, const float* X, float* OUT, bool dry) {
    const int lane = threadIdx.x & 63, wave = threadIdx.x >> 6;
    const float* gw = p.in[28];
    for (int row = blockIdx.x * 4 + wave; row < T; row += gridDim.x * 4) {
        const f32x4* xr = (const f32x4*)(X + (size_t)row * D) + lane;
        f32x4 v[4]; float s = 0.f;
#pragma unroll
        for (int j = 0; j < 4; ++j) { v[j] = xr[64 * j]; s += (v[j].x * v[j].x + v[j].y * v[j].y) + (v[j].z * v[j].z + v[j].w * v[j].w); }
        const float rs = rsqrtf(wave_sum(s) * (1.0f / D) + RMS_EPS);
        f32x4* o = (f32x4*)(OUT + (size_t)row * D) + lane;
#pragma unroll
        for (int j = 0; j < 4; ++j) {
            const f32x4 g = *(const f32x4*)(gw + lane * 4 + 256 * j);
            if (!dry) o[64 * j] = (f32x4){v[j].x * rs * g.x, v[j].y * rs * g.y, v[j].z * rs * g.z, v[j].w * rs * g.w};
        }
    }
}

__device__ __forceinline__ int vblock() { const int G = gridDim.x, bx = blockIdx.x; return (G % 8 == 0) ? (bx % 8) * (G / 8) + bx / 8 : bx; }
struct ALoadPlain {
    const bf16_t* A; size_t lda;
    __device__ __forceinline__ const bf16_t* base(int kt) const { return A + kt * 64; }
    __device__ __forceinline__ unsigned off(int r, int lc) const { return (unsigned)r * (unsigned)lda + (unsigned)lc * 8u; }
};
struct ALoadGroup {
    const bf16_t* A;
    __device__ __forceinline__ const bf16_t* base(int kt) const { return A + (size_t)kt * 4 * T * 16; }
    __device__ __forceinline__ unsigned off(int r, int lc) const { return ((unsigned)(lc >> 1) * (unsigned)T + (unsigned)r) * 16u + (unsigned)(lc & 1) * 8u; }
};

template <class AL>
__device__ __forceinline__ void gemm_tile2(const AL al, const bf16_t* __restrict__ Bt, size_t ldb, int nk, f32x4 (&acc)[4][4], unsigned char* lds) {
    const int tid = threadIdx.x, lane = tid & 63, wid = tid >> 6, wr = wid >> 1, wc = wid & 1, fr = lane & 15, fq = lane >> 4;
    const int lr = tid >> 3, lc = tid & 7;
#pragma unroll
    for (int mi = 0; mi < 4; ++mi)
#pragma unroll
        for (int ni = 0; ni < 4; ++ni) acc[mi][ni] = (f32x4){0.f, 0.f, 0.f, 0.f};
    u32x4 ra0[4], rb0[4], ra1[4], rb1[4];
    const int soff = lr * 128 + ((lc ^ (lr & 7)) << 4);
    unsigned offA[4], offB[4];
#pragma unroll
    for (int i = 0; i < 4; ++i) { offA[i] = al.off(lr + 32 * i, lc); offB[i] = (unsigned)(lr + 32 * i) * (unsigned)ldb + (unsigned)lc * 8u; }
#define GT_LOAD(RA, RB, kt_) do { const bf16_t* ab_ = al.base(kt_); const bf16_t* bb_ = Bt + (kt_) * 64; _Pragma("unroll") for (int i = 0; i < 4; ++i) { RA[i] = *(const u32x4*)(ab_ + offA[i]); RB[i] = *(const u32x4*)(bb_ + offB[i]); } } while (0)
#define GT_STORE(RA, RB, buf_) do { unsigned char* nb_ = lds + (buf_) * 32768; _Pragma("unroll") for (int i = 0; i < 4; ++i) { *(u32x4*)(nb_ + soff + i * 4096) = RA[i]; *(u32x4*)(nb_ + 16384 + soff + i * 4096) = RB[i]; } } while (0)
    const int aoff = (wr * 64 + fr) * 128, boff = 16384 + (wc * 64 + fr) * 128, sw = fr & 7;
#define GT_MATH(buf_) do { const unsigned char* bp_ = lds + (buf_) * 32768; _Pragma("unroll") for (int ks = 0; ks < 2; ++ks) { bf16x8 af[4], bfr[4]; const int co = ((ks * 4 + fq) ^ sw) << 4; \
        _Pragma("unroll") for (int mi = 0; mi < 4; ++mi) af[mi] = *(const bf16x8*)(bp_ + aoff + mi * 2048 + co); \
        _Pragma("unroll") for (int ni = 0; ni < 4; ++ni) bfr[ni] = *(const bf16x8*)(bp_ + boff + ni * 2048 + co); \
        _Pragma("unroll") for (int mi = 0; mi < 4; ++mi) _Pragma("unroll") for (int ni = 0; ni < 4; ++ni) acc[mi][ni] = __builtin_amdgcn_mfma_f32_16x16x32_bf16(bfr[ni], af[mi], acc[mi][ni], 0, 0, 0); } } while (0)
    GT_LOAD(ra0, rb0, 0);
    if (nk > 1) GT_LOAD(ra1, rb1, 1);
    GT_STORE(ra0, rb0, 0);
    __syncthreads();
    for (int kt = 0; kt < nk; kt += 2) {
        if (kt + 2 < nk) GT_LOAD(ra0, rb0, kt + 2);
        __builtin_amdgcn_sched_barrier(0);
        GT_MATH(0);
        __builtin_amdgcn_sched_barrier(0);
        if (kt + 1 < nk) GT_STORE(ra1, rb1, 1);
        __syncthreads();
        if (kt + 1 >= nk) break;
        if (kt + 3 < nk) GT_LOAD(ra1, rb1, kt + 3);
        __builtin_amdgcn_sched_barrier(0);
        GT_MATH(1);
        __builtin_amdgcn_sched_barrier(0);
        if (kt + 2 < nk) GT_STORE(ra0, rb0, 0);
        __syncthreads();
    }
#undef GT_LOAD
#undef GT_STORE
#undef GT_MATH
}

template <class AL>
__device__ __forceinline__ void gemm_tile1(const AL al, const bf16_t* __restrict__ Bt, size_t ldb, int nk, f32x4 (&acc)[4][4], unsigned char* lds) {
    const int tid = threadIdx.x, lane = tid & 63, wid = tid >> 6, wr = wid >> 1, wc = wid & 1, fr = lane & 15, fq = lane >> 4;
    const int lr = tid >> 3, lc = tid & 7;
#pragma unroll
    for (int mi = 0; mi < 4; ++mi)
#pragma unroll
        for (int ni = 0; ni < 4; ++ni) acc[mi][ni] = (f32x4){0.f, 0.f, 0.f, 0.f};
    u32x4 ra[4], rb[4];
    const int soff = lr * 128 + ((lc ^ (lr & 7)) << 4);
#pragma unroll
    for (int i = 0; i < 4; ++i) { ra[i] = *(const u32x4*)(al.base(0) + al.off(lr + 32 * i, lc)); rb[i] = *(const u32x4*)(Bt + (size_t)(lr + 32 * i) * ldb + lc * 8); }
#pragma unroll
    for (int i = 0; i < 4; ++i) { *(u32x4*)(lds + soff + i * 4096) = ra[i]; *(u32x4*)(lds + 16384 + soff + i * 4096) = rb[i]; }
    __syncthreads();
    const int aoff = (wr * 64 + fr) * 128, boff = 16384 + (wc * 64 + fr) * 128, sw = fr & 7;
    for (int kt = 0; kt < nk; ++kt) {
        const bool more = (kt + 1 < nk);
        if (more) {
#pragma unroll
            for (int i = 0; i < 4; ++i) { ra[i] = *(const u32x4*)(al.base(kt + 1) + al.off(lr + 32 * i, lc)); rb[i] = *(const u32x4*)(Bt + (size_t)(lr + 32 * i) * ldb + (kt + 1) * 64 + lc * 8); }
        }
        const unsigned char* buf = lds + (kt & 1) * 32768;
#pragma unroll
        for (int ks = 0; ks < 2; ++ks) {
            bf16x8 af[4], bfr[4];
            const int co = ((ks * 4 + fq) ^ sw) << 4;
#pragma unroll
            for (int mi = 0; mi < 4; ++mi) af[mi] = *(const bf16x8*)(buf + aoff + mi * 2048 + co);
#pragma unroll
            for (int ni = 0; ni < 4; ++ni) bfr[ni] = *(const bf16x8*)(buf + boff + ni * 2048 + co);
#pragma unroll
            for (int mi = 0; mi < 4; ++mi)
#pragma unroll
                for (int ni = 0; ni < 4; ++ni) acc[mi][ni] = __builtin_amdgcn_mfma_f32_16x16x32_bf16(bfr[ni], af[mi], acc[mi][ni], 0, 0, 0);
        }
        if (more) {
            unsigned char* nb = lds + ((kt + 1) & 1) * 32768;
#pragma unroll
            for (int i = 0; i < 4; ++i) { *(u32x4*)(nb + soff + i * 4096) = ra[i]; *(u32x4*)(nb + 16384 + soff + i * 4096) = rb[i]; }
        }
        __syncthreads();
    }
}

template <class AL, bool ZERO = true>
__device__ __forceinline__ void gemm_tile3(const AL al, const bf16_t* __restrict__ Bt, size_t ldb, int nk, f32x4 (&acc)[4][4], unsigned char* lds) {
    const int tid = threadIdx.x, lane = tid & 63, wid = tid >> 6, wr = wid >> 1, wc = wid & 1, fr = lane & 15, fq = lane >> 4;
    if (ZERO) {
#pragma unroll
    for (int mi = 0; mi < 4; ++mi)
#pragma unroll
        for (int ni = 0; ni < 4; ++ni) acc[mi][ni] = (f32x4){0.f, 0.f, 0.f, 0.f};
    }
    const int srow = wid * 32 + (lane >> 3), schunk = (lane & 7) ^ ((lane >> 3) & 7);
    unsigned offA[4], offB[4];
#pragma unroll
    for (int i = 0; i < 4; ++i) { offA[i] = al.off(srow + 8 * i, schunk); offB[i] = (unsigned)(srow + 8 * i) * (unsigned)ldb + (unsigned)schunk * 8u; }
#define G3_STAGE(buf_, kt_) do { const bf16_t* ab_ = al.base(kt_); const bf16_t* bb_ = Bt + (kt_) * 64; unsigned char* lb_ = lds + (buf_) * 32768 + wid * 4096; \
        _Pragma("unroll") for (int i = 0; i < 4; ++i) { \
            __builtin_amdgcn_global_load_lds((const unsigned*)(ab_ + offA[i]), (unsigned*)(lb_ + i * 1024), 16, 0, 0); \
            __builtin_amdgcn_global_load_lds((const unsigned*)(bb_ + offB[i]), (unsigned*)(lb_ + 16384 + i * 1024), 16, 0, 0); } } while (0)
    const int aoff = (wr * 64 + fr) * 128, boff = 16384 + (wc * 64 + fr) * 128, sw = fr & 7;
    G3_STAGE(0, 0);
    __syncthreads();
    for (int kt = 0; kt < nk; ++kt) {
        if (kt + 1 < nk) G3_STAGE((kt + 1) & 1, kt + 1);
        const unsigned char* buf = lds + (kt & 1) * 32768;
#pragma unroll
        for (int ks = 0; ks < 2; ++ks) {
            bf16x8 af[4], bfr[4];
            const int co = ((ks * 4 + fq) ^ sw) << 4;
#pragma unroll
            for (int mi = 0; mi < 4; ++mi) af[mi] = *(const bf16x8*)(buf + aoff + mi * 2048 + co);
#pragma unroll
            for (int ni = 0; ni < 4; ++ni) bfr[ni] = *(const bf16x8*)(buf + boff + ni * 2048 + co);
#pragma unroll
            for (int mi = 0; mi < 4; ++mi)
#pragma unroll
                for (int ni = 0; ni < 4; ++ni) acc[mi][ni] = __builtin_amdgcn_mfma_f32_16x16x32_bf16(bfr[ni], af[mi], acc[mi][ni], 0, 0, 0);
        }
        __syncthreads();
    }
#undef G3_STAGE
}

__device__ __forceinline__ void mma_ktile(const unsigned char* buf, f32x4 (&acc)[4][4]) {
    const int tid = threadIdx.x, lane = tid & 63, wid = tid >> 6, wr = wid >> 1, wc = wid & 1, fr = lane & 15, fq = lane >> 4;
    const int aoff = (wr * 64 + fr) * 128, boff = 16384 + (wc * 64 + fr) * 128, sw = fr & 7;
#pragma unroll
    for (int ks = 0; ks < 2; ++ks) {
        bf16x8 af[4], bfr[4];
        const int co = ((ks * 4 + fq) ^ sw) << 4;
#pragma unroll
        for (int mi = 0; mi < 4; ++mi) af[mi] = *(const bf16x8*)(buf + aoff + mi * 2048 + co);
#pragma unroll
        for (int ni = 0; ni < 4; ++ni) bfr[ni] = *(const bf16x8*)(buf + boff + ni * 2048 + co);
#pragma unroll
        for (int mi = 0; mi < 4; ++mi)
#pragma unroll
            for (int ni = 0; ni < 4; ++ni) acc[mi][ni] = __builtin_amdgcn_mfma_f32_16x16x32_bf16(bfr[ni], af[mi], acc[mi][ni], 0, 0, 0);
    }
}
__device__ __forceinline__ void phase_s5_win(const Params& p, unsigned char* lds) {
    const bf16_t* HM = (const bf16_t*)(p.ws + WS_HM); const bf16_t* WT = (const bf16_t*)(p.ws + WS_WIN_T);
    bf16_t* UG = (bf16_t*)(p.ws + WS_UG);
    const int lane = threadIdx.x & 63, wid = threadIdx.x >> 6, wr = wid >> 1, wc = wid & 1, fr = lane & 15, fq = lane >> 4;
    for (int id = vblock(); id < 256 * 8; id += gridDim.x) {
        const int mt = id >> 3, nt = id & 7;
        f32x4 acc[4][4];
        gemm_tile3(ALoadPlain{HM + (size_t)mt * 128 * D, (size_t)D}, WT + (size_t)nt * 128 * D, D, 16, acc, lds);
#pragma unroll
        for (int mi = 0; mi < 4; ++mi)
#pragma unroll
            for (int ni = 0; ni < 4; ++ni) {
                const int t = mt * 128 + wr * 64 + mi * 16 + fr, g = nt * 8 + wc * 4 + ni;
                const f32x4 v = acc[mi][ni];
                *(u32x2*)(UG + ((size_t)g * T + t) * 16 + fq * 4) = (u32x2){pk2(v.x, v.y), pk2(v.z, v.w)};
            }
    }
}
__device__ __forceinline__ void phase_s5_a(const Params& p, unsigned char* lds) {
    const bf16_t* UG = (const bf16_t*)(p.ws + WS_UG); const bf16_t* TW = (const bf16_t*)(p.ws + WS_TW);
    float* WST = (float*)(p.ws + WS_WST);
    const int lane = threadIdx.x & 63, wid = threadIdx.x >> 6, wr = wid >> 1, wc = wid & 1, fr = lane & 15, fq = lane >> 4;
    for (int id = vblock(); id < 64 * 8; id += gridDim.x) {
        const int g = id >> 3, mt = id & 7;
        f32x4 acc[4][4];
        gemm_tile3(ALoadPlain{UG + (size_t)g * T * 16 + (size_t)mt * 128 * 512, (size_t)512}, TW + ((size_t)g * 640 + 512) * 512, 512, 8, acc, lds);
#pragma unroll
        for (int mi = 0; mi < 4; ++mi)
#pragma unroll
            for (int ni = 0; ni < 4; ++ni) {
                const int R = mt * 128 + wr * 64 + mi * 16 + fr, c = wc * 64 + ni * 16 + fq * 4;
                *(f32x4*)(WST + ((size_t)g * 1024 + R) * 128 + c) = acc[mi][ni];
            }
    }
}
__device__ __forceinline__ void phase_s5_scan(const Params& p) {
    const int lane = threadIdx.x & 63, wave = threadIdx.x >> 6;
    const float* WST = (const float*)(p.ws + WS_WST); bf16_t* SST = (bf16_t*)(p.ws + WS_SST);
    const f32x2* AL = (const f32x2*)(p.ws + WS_MISC + 4096);
    for (int it = blockIdx.x * 4 + wave; it < 128; it += gridDim.x * 4) {
        const int b = it >> 6, g = it & 63;
        const f32x2 al = AL[g * 64 + lane];
        float sr = 0.f, si = 0.f;
        const float* wbase = WST + ((size_t)g * 1024 + b * 512) * 128 + lane;
        bf16_t* sbase = SST + ((size_t)g * 1024 + b * 512) * 128 + lane;
        for (int n0 = 0; n0 < 512; n0 += 16) {
            float wre[16], wim[16];
#pragma unroll
            for (int j = 0; j < 16; ++j) { wre[j] = wbase[(size_t)(n0 + j) * 128]; wim[j] = wbase[(size_t)(n0 + j) * 128 + 64]; }
#pragma unroll
            for (int j = 0; j < 16; ++j) {
                sbase[(size_t)(n0 + j) * 128] = (bf16_t)f2bf(sr); sbase[(size_t)(n0 + j) * 128 + 64] = (bf16_t)f2bf(si);
                const float nr = al.x * sr - al.y * si + wre[j], ni = al.x * si + al.y * sr + wim[j];
                sr = nr; si = ni;
            }
        }
    }
}
__device__ __forceinline__ void phase_s5_b(const Params& p, unsigned char* lds) {
    const bf16_t* SST = (const bf16_t*)(p.ws + WS_SST); const bf16_t* VG = (const bf16_t*)(p.ws + WS_VG);
    const bf16_t* UG = (const bf16_t*)(p.ws + WS_UG); const bf16_t* TW = (const bf16_t*)(p.ws + WS_TW);
    bf16_t* YG = (bf16_t*)(p.ws + WS_YG);
    const float* dsk = p.in[14];
    const int lane = threadIdx.x & 63, wid = threadIdx.x >> 6, wr = wid >> 1, wc = wid & 1, fr = lane & 15, fq = lane >> 4;
    for (int id = vblock(); id < 64 * 32; id += gridDim.x) {
        const int g = id >> 5, mt = (id >> 2) & 7, nt = 3 - (id & 3);
        f32x4 acc[4][4];
        gemm_tile3<ALoadPlain, true>(ALoadPlain{UG + (size_t)g * T * 16 + (size_t)mt * 128 * 512, (size_t)512}, TW + ((size_t)g * 640 + nt * 128) * 512, 512, 2 * (nt + 1), acc, lds);
        gemm_tile3<ALoadPlain, false>(ALoadPlain{SST + ((size_t)g * 1024 + mt * 128) * 128, (size_t)128}, VG + ((size_t)g * 512 + nt * 128) * 128, 128, 2, acc, lds);
        const f32x4 dv = *(const f32x4*)(dsk + g * 16 + fq * 4);
#pragma unroll
        for (int mi = 0; mi < 4; ++mi)
#pragma unroll
            for (int ni = 0; ni < 4; ++ni) {
                const int R = mt * 128 + wr * 64 + mi * 16 + fr, c = nt * 128 + wc * 64 + ni * 16 + fq * 4;
                const size_t idx = ((size_t)g * 1024 + R) * 512 + c;
                const u32x2 uu = *(const u32x2*)(UG + idx);
                const f32x4 v = acc[mi][ni];
                const float y0 = gelu_tanh(v.x + dv.x * bflo(uu.x)), y1 = gelu_tanh(v.y + dv.y * bfhi(uu.x));
                const float y2 = gelu_tanh(v.z + dv.z * bflo(uu.y)), y3 = gelu_tanh(v.w + dv.w * bfhi(uu.y));
                *(u32x2*)(YG + idx) = (u32x2){pk2(y0, y1), pk2(y2, y3)};
            }
    }
}
__device__ __forceinline__ void phase_s5_glu(const Params& p, unsigned char* lds) {
    const bf16_t* YG = (const bf16_t*)(p.ws + WS_YG); const bf16_t* WT = (const bf16_t*)(p.ws + WS_WGLU_T);
    const float* MOD = (const float*)(p.ws + WS_MOD);
    const float* X = p.in[0]; float* XO = p.out;
    const int lane = threadIdx.x & 63, wid = threadIdx.x >> 6, wr = wid >> 1, wc = wid & 1, fr = lane & 15, fq = lane >> 4;
    for (int id = vblock(); id < 256 * 16; id += gridDim.x) {
        const int mt = id >> 4, nt = id & 15;
        f32x4 acc[4][4];
        gemm_tile3(ALoadGroup{YG + (size_t)mt * 128 * 16}, WT + (size_t)nt * 128 * D, D, 16, acc, lds);
        const int b = (mt * 128) / SEQ;
#pragma unroll
        for (int mi = 0; mi < 4; ++mi)
#pragma unroll
            for (int h = 0; h < 2; ++h) {
                const int t = mt * 128 + wr * 64 + mi * 16 + fr, j = nt * 64 + wc * 32 + h * 16 + fq * 4;
                const f32x4 a = acc[mi][2 * h], gg = acc[mi][2 * h + 1];
                const f32x4 g1 = *(const f32x4*)(MOD + (size_t)(0 * 2 + b) * 6144 + 2048 + j);
                const f32x4 xi = *(const f32x4*)(X + (size_t)t * D + j);
                f32x4 o;
                o.x = xi.x + g1.x * (a.x * sigmoidf_(gg.x)); o.y = xi.y + g1.y * (a.y * sigmoidf_(gg.y));
                o.z = xi.z + g1.z * (a.z * sigmoidf_(gg.z)); o.w = xi.w + g1.w * (a.w * sigmoidf_(gg.w));
                *(f32x4*)(XO + (size_t)t * D + j) = o;
            }
    }
}
__device__ __forceinline__ void phase_peer_wq(const Params& p, int layer, unsigned char* lds) {
    const bf16_t* HM = (const bf16_t*)(p.ws + WS_HM); const bf16_t* WT = (const bf16_t*)(p.ws + WS_WQ_T) + (size_t)layer * 2048 * 1024;
    bf16_t* QK = (bf16_t*)(p.ws + WS_QK);
    const int lane = threadIdx.x & 63, wid = threadIdx.x >> 6, wr = wid >> 1, wc = wid & 1, fr = lane & 15, fq = lane >> 4;
    for (int id = vblock(); id < 256 * 16; id += gridDim.x) {
        const int mt = id >> 4, nt = id & 15;
        f32x4 acc[4][4];
        gemm_tile3(ALoadPlain{HM + (size_t)mt * 128 * D, (size_t)D}, WT + (size_t)nt * 128 * D, D, 16, acc, lds);
#pragma unroll
        for (int mi = 0; mi < 4; ++mi)
#pragma unroll
            for (int ni = 0; ni < 4; ++ni) {
                const int t = mt * 128 + wr * 64 + mi * 16 + fr, c = nt * 128 + wc * 64 + ni * 16 + fq * 4;
                const f32x4 v = acc[mi][ni];
                *(u32x2*)(QK + (size_t)t * 2048 + c) = (u32x2){pk2(v.x, v.y), pk2(v.z, v.w)};
            }
    }
}
__device__ __forceinline__ void ce_(unsigned& a, unsigned& b, const bool up) { const unsigned lo = a < b ? a : b, hi = a < b ? b : a; a = up ? lo : hi; b = up ? hi : lo; }
__device__ __forceinline__ void bitonic_sort16(unsigned* x, const bool asc) {
#pragma unroll
    for (int k = 2; k <= 16; k <<= 1)
#pragma unroll
        for (int j = k >> 1; j > 0; j >>= 1)
#pragma unroll
            for (int i = 0; i < 16; ++i) { const int l = i ^ j; if (l > i) ce_(x[i], x[l], ((i & k) == 0) == asc); }
}
__device__ __forceinline__ void bitonic_merge16(unsigned* x, const bool asc) {
#pragma unroll
    for (int j = 8; j > 0; j >>= 1)
#pragma unroll
        for (int i = 0; i < 16; ++i) { const int l = i ^ j; if (l > i) ce_(x[i], x[l], asc); }
}
__device__ __forceinline__ void phase_peer_topk(const Params& p, int layer, unsigned char* lds) {
    const bf16_t* QK = (const bf16_t*)(p.ws + WS_QK); const bf16_t* SK = (const bf16_t*)(p.ws + WS_SUBK) + (size_t)layer * 8 * 2 * 128 * 128;
    float* TOPS = (float*)(p.ws + WS_TOPS); int* TOPI = (int*)(p.ws + WS_TOPI);
    float* sc = (float*)lds;
    const int tid = threadIdx.x, lane = tid & 63, wid = tid >> 6, wr = wid >> 1, wc = wid & 1, fr = lane & 15, fq = lane >> 4;
    for (int id = vblock(); id < 256 * 16; id += gridDim.x) {
        const int mt = id >> 4, hc = id & 15;
        f32x4 acc[4][4];
        gemm_tile3(ALoadPlain{QK + (size_t)mt * 128 * 2048 + hc * 128, (size_t)2048}, SK + (size_t)hc * 128 * 128, 128, 2, acc, lds);
#pragma unroll
        for (int mi = 0; mi < 4; ++mi)
#pragma unroll
            for (int ni = 0; ni < 4; ++ni) {
                const int r = wr * 64 + mi * 16 + fr, c = wc * 64 + ni * 16 + fq * 4;
                float* d = sc + r * 129 + c;
                d[0] = acc[mi][ni].x; d[1] = acc[mi][ni].y; d[2] = acc[mi][ni].z; d[3] = acc[mi][ni].w;
            }
        __syncthreads();
        {
            const int row = tid >> 1, half = tid & 1;
            unsigned x[64];
            const float* rp = sc + row * 129 + half * 64;
#pragma unroll
            for (int j = 0; j < 64; ++j) {
                const unsigned bits = __builtin_bit_cast(unsigned, rp[j]);
                const unsigned u = bits ^ ((unsigned)((int)bits >> 31) | 0x80000000u);
                x[j] = (u & 0xFFFFFF80u) | (unsigned)(127 - (half * 64 + j));
            }
            bitonic_sort16(x, true); bitonic_sort16(x + 16, false); bitonic_sort16(x + 32, true); bitonic_sort16(x + 48, false);
#pragma unroll
            for (int i = 0; i < 16; ++i) { x[i] = x[i] > x[16 + i] ? x[i] : x[16 + i]; x[32 + i] = x[32 + i] > x[48 + i] ? x[32 + i] : x[48 + i]; }
            bitonic_merge16(x, true); bitonic_merge16(x + 32, false);
#pragma unroll
            for (int i = 0; i < 16; ++i) x[i] = x[i] > x[32 + i] ? x[i] : x[32 + i];
            bitonic_merge16(x, false);
            unsigned y[16];
#pragma unroll
            for (int i = 0; i < 16; ++i) { const unsigned o = (unsigned)__shfl_xor((int)x[15 - i], 1); y[i] = x[i] > o ? x[i] : o; }
            bitonic_merge16(y, false);
            const size_t ob = ((size_t)(mt * 128 + row) * 16 + hc) * 16;
            if (half == 0) {
                float v[16];
#pragma unroll
                for (int i = 0; i < 16; ++i) { const unsigned u = y[i] & 0xFFFFFF80u; const unsigned bits = (u & 0x80000000u) ? (u ^ 0x80000000u) : ~u; v[i] = __builtin_bit_cast(float, bits); }
#pragma unroll
                for (int q = 0; q < 4; ++q) *(f32x4*)(TOPS + ob + q * 4) = (f32x4){v[q * 4], v[q * 4 + 1], v[q * 4 + 2], v[q * 4 + 3]};
            } else {
#pragma unroll
                for (int q = 0; q < 4; ++q) *(u32x4*)(TOPI + ob + q * 4) = (u32x4){127u - (y[q * 4] & 127u), 127u - (y[q * 4 + 1] & 127u), 127u - (y[q * 4 + 2] & 127u), 127u - (y[q * 4 + 3] & 127u)};
            }
        }
        __syncthreads();
    }
}
__device__ __forceinline__ void phase_peer_wq_topk(const Params& p, int layer, unsigned char* lds) {
    const bf16_t* HM = (const bf16_t*)(p.ws + WS_HM); const bf16_t* WT = (const bf16_t*)(p.ws + WS_WQ_T) + (size_t)layer * 2048 * 1024;
    const bf16_t* SK = (const bf16_t*)(p.ws + WS_SUBK) + (size_t)layer * 8 * 2 * 128 * 128;
    float* TOPS = (float*)(p.ws + WS_TOPS); int* TOPI = (int*)(p.ws + WS_TOPI);
    float* sc = (float*)lds;
    const int tid = threadIdx.x, lane = tid & 63, wid = tid >> 6, wr = wid >> 1, wc = wid & 1, fr = lane & 15, fq = lane >> 4;
    for (int id = vblock(); id < 256 * 16; id += gridDim.x) {
        const int mt = id >> 4, hc = id & 15;
        f32x4 acc[4][4];
        gemm_tile3(ALoadPlain{HM + (size_t)mt * 128 * D, (size_t)D}, WT + (size_t)hc * 128 * D, D, 16, acc, lds);
        {
            const int srow = wid * 32 + (lane >> 3), schunk = (lane & 7) ^ ((lane >> 3) & 7);
            const bf16_t* sk = SK + (size_t)hc * 128 * 128;
#pragma unroll
            for (int kt = 0; kt < 2; ++kt)
#pragma unroll
                for (int i = 0; i < 4; ++i)
                    __builtin_amdgcn_global_load_lds((const unsigned*)(sk + (srow + 8 * i) * 128 + kt * 64 + schunk * 8), (unsigned*)(lds + kt * 32768 + 16384 + wid * 4096 + i * 1024), 16, 0, 0);
        }
#pragma unroll
        for (int mi = 0; mi < 4; ++mi)
#pragma unroll
            for (int ni = 0; ni < 4; ++ni) {
                const int r = wr * 64 + mi * 16 + fr, chunk = ni * 2 + (fq >> 1);
                const f32x4 v = acc[mi][ni];
                *(u32x2*)(lds + wc * 32768 + r * 128 + ((chunk ^ (r & 7)) << 4) + (fq & 1) * 8) = (u32x2){pk2(v.x, v.y), pk2(v.z, v.w)};
            }
        __syncthreads();
#pragma unroll
        for (int mi = 0; mi < 4; ++mi)
#pragma unroll
            for (int ni = 0; ni < 4; ++ni) acc[mi][ni] = (f32x4){0.f, 0.f, 0.f, 0.f};
        mma_ktile(lds, acc); mma_ktile(lds + 32768, acc);
        __syncthreads();
#pragma unroll
        for (int mi = 0; mi < 4; ++mi)
#pragma unroll
            for (int ni = 0; ni < 4; ++ni) {
                const int r = wr * 64 + mi * 16 + fr, c = wc * 64 + ni * 16 + fq * 4;
                float* d = sc + r * 129 + c;
                d[0] = acc[mi][ni].x; d[1] = acc[mi][ni].y; d[2] = acc[mi][ni].z; d[3] = acc[mi][ni].w;
            }
        __syncthreads();
        {
            const int row = tid >> 1, half = tid & 1;
            unsigned x[64];
            const float* rp = sc + row * 129 + half * 64;
#pragma unroll
            for (int j = 0; j < 64; ++j) {
                const unsigned bits = __builtin_bit_cast(unsigned, rp[j]);
                const unsigned u = bits ^ ((unsigned)((int)bits >> 31) | 0x80000000u);
                x[j] = (u & 0xFFFFFF80u) | (unsigned)(127 - (half * 64 + j));
            }
            bitonic_sort16(x, true); bitonic_sort16(x + 16, false); bitonic_sort16(x + 32, true); bitonic_sort16(x + 48, false);
#pragma unroll
            for (int i = 0; i < 16; ++i) { x[i] = x[i] > x[16 + i] ? x[i] : x[16 + i]; x[32 + i] = x[32 + i] > x[48 + i] ? x[32 + i] : x[48 + i]; }
            bitonic_merge16(x, true); bitonic_merge16(x + 32, false);
#pragma unroll
            for (int i = 0; i < 16; ++i) x[i] = x[i] > x[32 + i] ? x[i] : x[32 + i];
            bitonic_merge16(x, false);
            unsigned y[16];
#pragma unroll
            for (int i = 0; i < 16; ++i) { const unsigned o = (unsigned)__shfl_xor((int)x[15 - i], 1); y[i] = x[i] > o ? x[i] : o; }
            bitonic_merge16(y, false);
            const size_t ob = ((size_t)(mt * 128 + row) * 16 + hc) * 16;
            if (half == 0) {
                float v[16];
#pragma unroll
                for (int i = 0; i < 16; ++i) { const unsigned u = y[i] & 0xFFFFFF80u; const unsigned bits = (u & 0x80000000u) ? (u ^ 0x80000000u) : ~u; v[i] = __builtin_bit_cast(float, bits); }
#pragma unroll
                for (int q = 0; q < 4; ++q) *(f32x4*)(TOPS + ob + q * 4) = (f32x4){v[q * 4], v[q * 4 + 1], v[q * 4 + 2], v[q * 4 + 3]};
            } else {
#pragma unroll
                for (int q = 0; q < 4; ++q) *(u32x4*)(TOPI + ob + q * 4) = (u32x4){127u - (y[q * 4] & 127u), 127u - (y[q * 4 + 1] & 127u), 127u - (y[q * 4 + 2] & 127u), 127u - (y[q * 4 + 3] & 127u)};
            }
        }
        __syncthreads();
    }
}
__device__ __forceinline__ void phase_peer_route(const Params& p, int layer, unsigned char* lds) {
    const bf16_t* HM = (const bf16_t*)(p.ws + WS_HM); const bf16_t* WT = (const bf16_t*)(p.ws + WS_WQ_T) + (size_t)layer * 2048 * 1024;
    const bf16_t* SK = (const bf16_t*)(p.ws + WS_SUBK) + (size_t)layer * 8 * 2 * 128 * 128;
    int* EXP = (int*)(p.ws + WS_EXP); float* GATE = (float*)(p.ws + WS_GATE);
    float* sc = (float*)lds;
    unsigned* KEYS0 = (unsigned*)(lds + 66048);
    unsigned* L = (unsigned*)lds;
    const int tid = threadIdx.x, lane = tid & 63, wid = tid >> 6, wr = wid >> 1, wc = wid & 1, fr = lane & 15, fq = lane >> 4;
    for (int id = vblock(); id < 256 * 8; id += gridDim.x) {
        const int mt = id >> 3, h = id & 7;
        const int row = tid >> 1, half = tid & 1;
        unsigned y[16];
#pragma unroll 1
        for (int c = 0; c < 2; ++c) {
            const int hc = h * 2 + c;
            f32x4 acc[4][4];
            gemm_tile3(ALoadPlain{HM + (size_t)mt * 128 * D, (size_t)D}, WT + (size_t)hc * 128 * D, D, 16, acc, lds);
            {
                const int srow = wid * 32 + (lane >> 3), schunk = (lane & 7) ^ ((lane >> 3) & 7);
                const bf16_t* sk = SK + (size_t)hc * 128 * 128;
#pragma unroll
                for (int kt = 0; kt < 2; ++kt)
#pragma unroll
                    for (int i = 0; i < 4; ++i)
                        __builtin_amdgcn_global_load_lds((const unsigned*)(sk + (srow + 8 * i) * 128 + kt * 64 + schunk * 8), (unsigned*)(lds + kt * 32768 + 16384 + wid * 4096 + i * 1024), 16, 0, 0);
            }
#pragma unroll
            for (int mi = 0; mi < 4; ++mi)
#pragma unroll
                for (int ni = 0; ni < 4; ++ni) {
                    const int r = wr * 64 + mi * 16 + fr, chunk = ni * 2 + (fq >> 1);
                    const f32x4 v = acc[mi][ni];
                    *(u32x2*)(lds + wc * 32768 + r * 128 + ((chunk ^ (r & 7)) << 4) + (fq & 1) * 8) = (u32x2){pk2(v.x, v.y), pk2(v.z, v.w)};
                }
            __syncthreads();
#pragma unroll
            for (int mi = 0; mi < 4; ++mi)
#pragma unroll
                for (int ni = 0; ni < 4; ++ni) acc[mi][ni] = (f32x4){0.f, 0.f, 0.f, 0.f};
            mma_ktile(lds, acc); mma_ktile(lds + 32768, acc);
            __syncthreads();
#pragma unroll
            for (int mi = 0; mi < 4; ++mi)
#pragma unroll
                for (int ni = 0; ni < 4; ++ni) {
                    const int r = wr * 64 + mi * 16 + fr, cc = wc * 64 + ni * 16 + fq * 4;
                    float* d = sc + r * 129 + cc;
                    d[0] = acc[mi][ni].x; d[1] = acc[mi][ni].y; d[2] = acc[mi][ni].z; d[3] = acc[mi][ni].w;
                }
            __syncthreads();
            {
                unsigned x[64];
                const float* rp = sc + row * 129 + half * 64;
#pragma unroll
                for (int j = 0; j < 64; ++j) {
                    const unsigned bits = __builtin_bit_cast(unsigned, rp[j]);
                    const unsigned u = bits ^ ((unsigned)((int)bits >> 31) | 0x80000000u);
                    x[j] = (u & 0xFFFFFF80u) | (unsigned)(127 - (half * 64 + j));
                }
                bitonic_sort16(x, true); bitonic_sort16(x + 16, false); bitonic_sort16(x + 32, true); bitonic_sort16(x + 48, false);
#pragma unroll
                for (int i = 0; i < 16; ++i) { x[i] = x[i] > x[16 + i] ? x[i] : x[16 + i]; x[32 + i] = x[32 + i] > x[48 + i] ? x[32 + i] : x[48 + i]; }
                bitonic_merge16(x, true); bitonic_merge16(x + 32, false);
#pragma unroll
                for (int i = 0; i < 16; ++i) x[i] = x[i] > x[32 + i] ? x[i] : x[32 + i];
                bitonic_merge16(x, false);
#pragma unroll
                for (int i = 0; i < 16; ++i) { const unsigned o = (unsigned)__shfl_xor((int)x[15 - i], 1); y[i] = x[i] > o ? x[i] : o; }
                bitonic_merge16(y, false);
            }
            if (c == 0 && half == 0) {
#pragma unroll
                for (int i = 0; i < 16; ++i) KEYS0[i * 128 + row] = y[i];
            }
            __syncthreads();
        }
        {
            unsigned kk[16];
#pragma unroll
            for (int i = 0; i < 16; ++i) kk[i] = half ? KEYS0[i * 128 + row] : y[i];
            const int sb = half ? 0 : 16, ib = half ? 32 : 48;
#pragma unroll
            for (int i = 0; i < 16; ++i) {
                const unsigned u = kk[i] & 0xFFFFFF80u; const unsigned bits = (u & 0x80000000u) ? (u ^ 0x80000000u) : ~u;
                L[(sb + i) * 128 + row] = bits; L[(ib + i) * 128 + row] = 127u - (kk[i] & 127u);
            }
        }
        __syncthreads();
        if (tid < 128) {
            const int col = tid;
            float val[16];
            const float s20 = __builtin_bit_cast(float, L[16 * 128 + col]);
#pragma unroll
            for (int a = 0; a < 16; ++a) val[a] = __builtin_bit_cast(float, L[a * 128 + col]) + s20;
            unsigned long long P = 0ull;
            float ts[16]; int te[16];
#pragma unroll
            for (int r = 0; r < 16; ++r) {
                float best = val[0]; int ba = 0;
#pragma unroll
                for (int a = 1; a < 16; ++a) if (val[a] > best) { best = val[a]; ba = a; }
                const int b = (int)((P >> (4 * ba)) & 15ull);
                const int i1 = (int)L[(32 + ba) * 128 + col], i2 = (int)L[(48 + b) * 128 + col];
                ts[r] = best; te[r] = i1 * 128 + i2;
                const int nb = b + 1;
                float newv = -3.0e38f;
                if (nb < 16) { newv = __builtin_bit_cast(float, L[ba * 128 + col]) + __builtin_bit_cast(float, L[(16 + nb) * 128 + col]); P += 1ull << (4 * ba); }
#pragma unroll
                for (int a = 0; a < 16; ++a) val[a] = (a == ba) ? newv : val[a];
            }
            const float m0 = ts[0];
            float sum = 0.f;
#pragma unroll
            for (int r = 0; r < 16; ++r) { ts[r] = __expf(ts[r] - m0); sum += ts[r]; }
            const float inv = 1.0f / sum;
            const size_t ob = ((size_t)(mt * 128 + col) * 8 + h) * 16;
#pragma unroll
            for (int q = 0; q < 4; ++q) {
                *(u32x4*)(EXP + ob + q * 4) = (u32x4){(unsigned)te[q * 4], (unsigned)te[q * 4 + 1], (unsigned)te[q * 4 + 2], (unsigned)te[q * 4 + 3]};
                *(f32x4*)(GATE + ob + q * 4) = (f32x4){ts[q * 4] * inv, ts[q * 4 + 1] * inv, ts[q * 4 + 2] * inv, ts[q * 4 + 3] * inv};
            }
        }
        __syncthreads();
    }
}
__device__ __forceinline__ void phase_peer_combine(const Params& p, unsigned char* lds) {
    const float* TOPS = (const float*)(p.ws + WS_TOPS); const int* TOPI = (const int*)(p.ws + WS_TOPI);
    int* EXP = (int*)(p.ws + WS_EXP); float* GATE = (float*)(p.ws + WS_GATE);
    unsigned* L = (unsigned*)lds;
    const int tid = threadIdx.x;
    for (int it = blockIdx.x; it < (T * 8) / 256; it += gridDim.x) {
        const size_t th = (size_t)it * 256 + tid;
        const u32x4* S4 = (const u32x4*)(TOPS + th * 32); const u32x4* I4 = (const u32x4*)(TOPI + th * 32);
#pragma unroll
        for (int a4 = 0; a4 < 8; ++a4) {
            const u32x4 s = S4[a4], i = I4[a4];
            L[(a4 * 4 + 0) * 256 + tid] = s.x; L[(a4 * 4 + 1) * 256 + tid] = s.y; L[(a4 * 4 + 2) * 256 + tid] = s.z; L[(a4 * 4 + 3) * 256 + tid] = s.w;
            L[(32 + a4 * 4 + 0) * 256 + tid] = i.x; L[(32 + a4 * 4 + 1) * 256 + tid] = i.y; L[(32 + a4 * 4 + 2) * 256 + tid] = i.z; L[(32 + a4 * 4 + 3) * 256 + tid] = i.w;
        }
        float val[16];
        const float s20 = __builtin_bit_cast(float, L[16 * 256 + tid]);
#pragma unroll
        for (int a = 0; a < 16; ++a) val[a] = __builtin_bit_cast(float, L[a * 256 + tid]) + s20;
        unsigned long long P = 0ull;
        float ts[16]; int te[16];
#pragma unroll
        for (int r = 0; r < 16; ++r) {
            float best = val[0]; int ba = 0;
#pragma unroll
            for (int a = 1; a < 16; ++a) if (val[a] > best) { best = val[a]; ba = a; }
            const int b = (int)((P >> (4 * ba)) & 15ull);
            const int i1 = (int)L[(32 + ba) * 256 + tid], i2 = (int)L[(48 + b) * 256 + tid];
            ts[r] = best; te[r] = i1 * 128 + i2;
            const int nb = b + 1;
            float newv = -3.0e38f;
            if (nb < 16) { newv = __builtin_bit_cast(float, L[ba * 256 + tid]) + __builtin_bit_cast(float, L[(16 + nb) * 256 + tid]); P += 1ull << (4 * ba); }
#pragma unroll
            for (int a = 0; a < 16; ++a) val[a] = (a == ba) ? newv : val[a];
        }
        const float m0 = ts[0];
        float sum = 0.f;
#pragma unroll
        for (int r = 0; r < 16; ++r) { ts[r] = __expf(ts[r] - m0); sum += ts[r]; }
        const float inv = 1.0f / sum;
#pragma unroll
        for (int r = 0; r < 16; ++r) ts[r] *= inv;
#pragma unroll
        for (int r = 0; r < 16; ++r) { EXP[th * 16 + r] = te[r]; GATE[th * 16 + r] = ts[r]; }
    }
}

__device__ __forceinline__ void fma8(const unsigned w0, const unsigned w1, const float a, float* acc) {
    const f32x2 p0 = __builtin_amdgcn_cvt_pk_f32_fp8((int)w0, false), p1 = __builtin_amdgcn_cvt_pk_f32_fp8((int)w0, true);
    const f32x2 p2 = __builtin_amdgcn_cvt_pk_f32_fp8((int)w1, false), p3 = __builtin_amdgcn_cvt_pk_f32_fp8((int)w1, true);
    acc[0] += a * p0.x; acc[1] += a * p0.y; acc[2] += a * p1.x; acc[3] += a * p1.y;
    acc[4] += a * p2.x; acc[5] += a * p2.y; acc[6] += a * p3.x; acc[7] += a * p3.y;
}
__device__ __forceinline__ float dot8(const unsigned w0, const unsigned w1, const float* h, float s) {
    const f32x2 p0 = __builtin_amdgcn_cvt_pk_f32_fp8((int)w0, false), p1 = __builtin_amdgcn_cvt_pk_f32_fp8((int)w0, true);
    const f32x2 p2 = __builtin_amdgcn_cvt_pk_f32_fp8((int)w1, false), p3 = __builtin_amdgcn_cvt_pk_f32_fp8((int)w1, true);
    s += p0.x * h[0]; s += p0.y * h[1]; s += p1.x * h[2]; s += p1.y * h[3];
    s += p2.x * h[4]; s += p2.y * h[5]; s += p3.x * h[6]; s += p3.y * h[7];
    return s;
}
__device__ __forceinline__ void phase_peer_apply(const Params& p, int layer, unsigned char* lds, bool dry) {
    const int lane = threadIdx.x & 63, wave = threadIdx.x >> 6;
    float* ldsw = (float*)lds + wave * (64 * 65);
    const bf16_t* HM = (const bf16_t*)(p.ws + WS_HM);
    const unsigned char* PU = p.ws + WS_PU; const unsigned char* PV = p.ws + WS_PV;
    const float* SU = (const float*)(p.ws + WS_PU + 24 * MiB); const float* SV = (const float*)(p.ws + WS_PV + 24 * MiB);
    const int* EXP = (const int*)(p.ws + WS_EXP); const float* GATE = (const float*)(p.ws + WS_GATE);
    const float* MOD = (const float*)(p.ws + WS_MOD);
    float* X = p.out;
    for (int t = blockIdx.x * 4 + wave; t < T; t += gridDim.x * 4) {
        const u32x4 ha = *(const u32x4*)(HM + (size_t)t * D + lane * 16), hb = *(const u32x4*)(HM + (size_t)t * D + lane * 16 + 8);
        float hf[16];
        hf[0] = bflo(ha.x); hf[1] = bfhi(ha.x); hf[2] = bflo(ha.y); hf[3] = bfhi(ha.y); hf[4] = bflo(ha.z); hf[5] = bfhi(ha.z); hf[6] = bflo(ha.w); hf[7] = bfhi(ha.w);
        hf[8] = bflo(hb.x); hf[9] = bfhi(hb.x); hf[10] = bflo(hb.y); hf[11] = bfhi(hb.y); hf[12] = bflo(hb.z); hf[13] = bfhi(hb.z); hf[14] = bflo(hb.w); hf[15] = bfhi(hb.w);
        const int e0_ = EXP[(size_t)t * 128 + lane], e1_ = EXP[(size_t)t * 128 + 64 + lane];
        const float g0 = GATE[(size_t)t * 128 + lane], g1 = GATE[(size_t)t * 128 + 64 + lane];
        const float su0 = SU[e0_], su1 = SU[e1_], sv0 = SV[e0_], sv1 = SV[e1_];
        u32x4 buf[16];
        float act0 = 0.f, act1 = 0.f;
        float acc[16];
#pragma unroll
        for (int i = 0; i < 16; ++i) acc[i] = 0.f;
#ifndef APPLY_L2PROBE
#define APPLY_L2PROBE 0
#endif
        for (int prep_ = 0; prep_ < 1 + APPLY_L2PROBE; ++prep_) {
        const int emask = (APPLY_L2PROBE && prep_ == 0) ? 2047 : 0x7fffffff;
        const int e0 = e0_ & emask, e1 = e1_ & emask;
#pragma unroll
        for (int j = 0; j < 16; ++j) { const int e_ = __builtin_amdgcn_readlane(e0, j); buf[j] = *(const u32x4*)(PU + (size_t)e_ * D + lane * 16); }
#pragma unroll
        for (int bt = 0; bt < 16; ++bt) {
#pragma unroll
            for (int j = 0; j < 16; ++j) {
                if (bt < 8) {
                    float s_ = dot8(buf[j].x, buf[j].y, hf, 0.f); s_ = dot8(buf[j].z, buf[j].w, hf + 8, s_);
                    ldsw[((bt & 3) * 16 + j) * 65 + lane] = s_;
                } else {
                    const float av_ = ((bt & 7) < 4) ? act0 : act1;
                    const float a_ = __builtin_bit_cast(float, __builtin_amdgcn_readlane(__builtin_bit_cast(int, av_), (bt & 3) * 16 + j));
                    fma8(buf[j].x, buf[j].y, a_, acc); fma8(buf[j].z, buf[j].w, a_, acc + 8);
                }
                if (bt + 1 < 16) {
                    const int nb = bt + 1;
                    const int e_ = __builtin_amdgcn_readlane(((nb & 7) < 4) ? e0 : e1, (nb & 3) * 16 + j);
                    buf[j] = *(const u32x4*)(((nb < 8) ? PU : PV) + (size_t)e_ * D + lane * 16);
                }
            }
            if (bt == 3 || bt == 7) {
                float tot_ = 0.f;
#pragma unroll 16
                for (int q = 0; q < 64; ++q) tot_ += ldsw[lane * 65 + q];
                if (bt == 3) act0 = gelu_tanh(tot_ * su0) * g0 * sv0; else act1 = gelu_tanh(tot_ * su1) * g1 * sv1;
            }
        }
        if (APPLY_L2PROBE && prep_ == 0 && p.ph_hi >= 0) {
#pragma unroll
            for (int i = 0; i < 16; ++i) acc[i] = 0.f;
        }
        }
        const int b = t / SEQ;
        const float* g2 = MOD + (size_t)(layer * 2 + b) * 6144 + 5120;
        float* xr = X + (size_t)t * D + lane * 16;
        f32x4 xs[4]; float ss = 0.f;
#pragma unroll
        for (int q = 0; q < 4; ++q) {
            const f32x4 g = *(const f32x4*)(g2 + lane * 16 + q * 4); f32x4 x = *(const f32x4*)(xr + q * 4);
            x.x += g.x * acc[q * 4 + 0]; x.y += g.y * acc[q * 4 + 1]; x.z += g.z * acc[q * 4 + 2]; x.w += g.w * acc[q * 4 + 3];
            xs[q] = x; ss += (x.x * x.x + x.y * x.y) + (x.z * x.z + x.w * x.w);
        }
        const float rs = rsqrtf(wave_sum(ss) * (1.0f / D) + RMS_EPS);
        if (!dry) {
            if (layer == 0) {
                const float* gw = p.in[2] + D + lane * 16; const float* sh = MOD + (size_t)(2 + b) * 6144 + lane * 16; const float* sc = sh + 1024;
                u32x4 o[2];
#pragma unroll
                for (int q = 0; q < 4; ++q) {
                    *(f32x4*)(xr + q * 4) = xs[q];
                    const f32x4 g = *(const f32x4*)(gw + q * 4), s1 = *(const f32x4*)(sc + q * 4), s0 = *(const f32x4*)(sh + q * 4);
                    const float y0 = xs[q].x * rs * g.x * (1.f + s1.x) + s0.x, y1 = xs[q].y * rs * g.y * (1.f + s1.y) + s0.y;
                    const float y2 = xs[q].z * rs * g.z * (1.f + s1.z) + s0.z, y3 = xs[q].w * rs * g.w * (1.f + s1.w) + s0.w;
                    if (q & 1) { o[q >> 1].z = pk2(y0, y1); o[q >> 1].w = pk2(y2, y3); } else { o[q >> 1].x = pk2(y0, y1); o[q >> 1].y = pk2(y2, y3); }
                }
                bf16_t* hm = (bf16_t*)(p.ws + WS_HM) + (size_t)t * D + lane * 16;
                *(u32x4*)hm = o[0]; *(u32x4*)(hm + 8) = o[1];
            } else {
                const float* gw = p.in[28] + lane * 16;
#pragma unroll
                for (int q = 0; q < 4; ++q) {
                    const f32x4 g = *(const f32x4*)(gw + q * 4);
                    *(f32x4*)(xr + q * 4) = (f32x4){xs[q].x * rs * g.x, xs[q].y * rs * g.y, xs[q].z * rs * g.z, xs[q].w * rs * g.w};
                }
            }
        }
    }
}

__device__ __forceinline__ void phase_peer_apply6(const Params& p, int layer, unsigned char* lds, bool dry) {
    const int lane = threadIdx.x & 63, wave = threadIdx.x >> 6, half = lane >> 5, gl = lane & 31;
    float* ldsw = (float*)lds + wave * (64 * 33);
    const bf16_t* HM = (const bf16_t*)(p.ws + WS_HM);
    const unsigned char* PU = p.ws + WS_PU; const unsigned char* PV = p.ws + WS_PV;
    const float* SU = (const float*)(p.ws + WS_PU + 24 * MiB); const float* SV = (const float*)(p.ws + WS_PV + 24 * MiB);
    const int* EXP = (const int*)(p.ws + WS_EXP); const float* GATE = (const float*)(p.ws + WS_GATE);
    const float* MOD = (const float*)(p.ws + WS_MOD);
    float* X = p.out;
    for (int t = blockIdx.x * 4 + wave; t < T; t += gridDim.x * 4) {
        float hf[32];
        {
            const u32x4* hp = (const u32x4*)(HM + (size_t)t * D + gl * 32);
#pragma unroll
            for (int q = 0; q < 4; ++q) { const u32x4 w = hp[q];
                hf[q * 8 + 0] = bflo(w.x); hf[q * 8 + 1] = bfhi(w.x); hf[q * 8 + 2] = bflo(w.y); hf[q * 8 + 3] = bfhi(w.y);
                hf[q * 8 + 4] = bflo(w.z); hf[q * 8 + 5] = bfhi(w.z); hf[q * 8 + 6] = bflo(w.w); hf[q * 8 + 7] = bfhi(w.w); }
        }
        const int e0 = EXP[(size_t)t * 128 + lane], e1 = EXP[(size_t)t * 128 + 64 + lane];
        const float g0 = GATE[(size_t)t * 128 + lane], g1 = GATE[(size_t)t * 128 + 64 + lane];
        const float su0 = SU[e0], su1 = SU[e1], sv0 = SV[e0], sv1 = SV[e1];
        u32x2 buf[8][3];
        float act0 = 0.f, act1 = 0.f;
        float acc[32];
#pragma unroll
        for (int i = 0; i < 32; ++i) acc[i] = 0.f;
#define A6_LOAD(slot, nb) do { const int es_ = (((nb) & 7) < 4) ? e0 : e1; const int ia_ = ((nb) & 3) * 16 + 2 * (slot); \
            const int ea_ = __builtin_amdgcn_readlane(es_, ia_), eb_ = __builtin_amdgcn_readlane(es_, ia_ + 1); const int e_ = half ? eb_ : ea_; \
            const u32x2* rp_ = (const u32x2*)((((nb) < 8) ? PU : PV) + (size_t)e_ * 768 + gl * 24); buf[slot][0] = rp_[0]; buf[slot][1] = rp_[1]; buf[slot][2] = rp_[2]; } while (0)
#pragma unroll
        for (int j = 0; j < 8; ++j) A6_LOAD(j, 0);
#pragma unroll 1
        for (int bt = 0; bt < 8; ++bt) {
#pragma unroll
            for (int j = 0; j < 8; ++j) {
                v6u w; w[0] = buf[j][0].x; w[1] = buf[j][0].y; w[2] = buf[j][1].x; w[3] = buf[j][1].y; w[4] = buf[j][2].x; w[5] = buf[j][2].y;
                const v32f y = __builtin_amdgcn_cvt_scalef32_pk32_f32_fp6(w, 1.0f);
                float s0_ = 0.f, s1_ = 0.f;
#pragma unroll
                for (int i = 0; i < 16; ++i) { s0_ += y[i] * hf[i]; s1_ += y[16 + i] * hf[16 + i]; }
                ldsw[(((bt & 3) * 16 + 2 * j) + half) * 33 + gl] = s0_ + s1_;
                A6_LOAD(j, bt + 1);
            }
            if (bt == 3 || bt == 7) {
                float tot_ = 0.f;
#pragma unroll
                for (int q = 0; q < 32; ++q) tot_ += ldsw[lane * 33 + q];
                if (bt == 3) act0 = gelu_tanh(tot_ * su0) * g0 * sv0; else act1 = gelu_tanh(tot_ * su1) * g1 * sv1;
            }
        }
#pragma unroll 1
        for (int bt = 8; bt < 16; ++bt) {
            const float av_ = (bt < 12) ? act0 : act1;
#pragma unroll
            for (int j = 0; j < 8; ++j) {
                v6u w; w[0] = buf[j][0].x; w[1] = buf[j][0].y; w[2] = buf[j][1].x; w[3] = buf[j][1].y; w[4] = buf[j][2].x; w[5] = buf[j][2].y;
                const v32f y = __builtin_amdgcn_cvt_scalef32_pk32_f32_fp6(w, 1.0f);
                const int ia_ = (bt & 3) * 16 + 2 * j;
                const float aa_ = __builtin_bit_cast(float, __builtin_amdgcn_readlane(__builtin_bit_cast(int, av_), ia_));
                const float ab_ = __builtin_bit_cast(float, __builtin_amdgcn_readlane(__builtin_bit_cast(int, av_), ia_ + 1));
                const float a_ = half ? ab_ : aa_;
#pragma unroll
                for (int i = 0; i < 32; ++i) acc[i] += a_ * y[i];
                if (bt + 1 < 16) A6_LOAD(j, bt + 1);
            }
        }
#undef A6_LOAD
#pragma unroll
        for (int i = 0; i < 32; ++i) acc[i] += __shfl_xor(acc[i], 32);
        const int b = t / SEQ;
        const float* g2 = MOD + (size_t)(layer * 2 + b) * 6144 + 5120 + gl * 32;
        float* xr = X + (size_t)t * D + gl * 32;
        f32x4 xs[8]; float ss = 0.f;
#pragma unroll
        for (int q = 0; q < 8; ++q) {
            const f32x4 g = *(const f32x4*)(g2 + q * 4); f32x4 x = *(const f32x4*)(xr + q * 4);
            x.x += g.x * acc[q * 4 + 0]; x.y += g.y * acc[q * 4 + 1]; x.z += g.z * acc[q * 4 + 2]; x.w += g.w * acc[q * 4 + 3];
            xs[q] = x; if (half == 0) ss += (x.x * x.x + x.y * x.y) + (x.z * x.z + x.w * x.w);
        }
        const float rs = rsqrtf(wave_sum(ss) * (1.0f / D) + RMS_EPS);
        if (!dry && half == 0) {
            if (layer == 0) {
                const float* gw = p.in[2] + D + gl * 32; const float* sh = MOD + (size_t)(2 + b) * 6144 + gl * 32; const float* sc = sh + 1024;
                bf16_t* hm = (bf16_t*)(p.ws + WS_HM) + (size_t)t * D + gl * 32;
#pragma unroll
                for (int q2 = 0; q2 < 4; ++q2) {
                    u32x4 o;
#pragma unroll
                    for (int hq = 0; hq < 2; ++hq) {
                        const int q = q2 * 2 + hq;
                        *(f32x4*)(xr + q * 4) = xs[q];
                        const f32x4 g = *(const f32x4*)(gw + q * 4), s1 = *(const f32x4*)(sc + q * 4), s0 = *(const f32x4*)(sh + q * 4);
                        const float y0 = xs[q].x * rs * g.x * (1.f + s1.x) + s0.x, y1 = xs[q].y * rs * g.y * (1.f + s1.y) + s0.y;
                        const float y2 = xs[q].z * rs * g.z * (1.f + s1.z) + s0.z, y3 = xs[q].w * rs * g.w * (1.f + s1.w) + s0.w;
                        if (hq) { o.z = pk2(y0, y1); o.w = pk2(y2, y3); } else { o.x = pk2(y0, y1); o.y = pk2(y2, y3); }
                    }
                    *(u32x4*)(hm + q2 * 8) = o;
                }
            } else {
                const float* gw = p.in[28] + gl * 32;
#pragma unroll
                for (int q = 0; q < 8; ++q) {
                    const f32x4 g = *(const f32x4*)(gw + q * 4);
                    *(f32x4*)(xr + q * 4) = (f32x4){xs[q].x * rs * g.x, xs[q].y * rs * g.y, xs[q].z * rs * g.z, xs[q].w * rs * g.w};
                }
            }
        }
    }
}
__device__ __forceinline__ void phase_tab1(const Params& p) {
    const int first = vblock() - 256, stride = (int)gridDim.x - 256;
    if (first < 0 || stride <= 0) {
        if (stride <= 0) { for (int it = blockIdx.x; it < 2 * P0_TAB; it += gridDim.x) {
            if (it < P0_TAB) cvt_fp6_item(p.in[26] + (size_t)PE * D, p.ws + WS_PU, (float*)(p.ws + WS_PU + 24 * MiB), it);
            else cvt_fp6_item(p.in[27] + (size_t)PE * D, p.ws + WS_PV, (float*)(p.ws + WS_PV + 24 * MiB), it - P0_TAB); } }
        return;
    }
    for (int it = first; it < 2 * P0_TAB; it += stride) {
        if (it < P0_TAB) cvt_fp6_item(p.in[26] + (size_t)PE * D, p.ws + WS_PU, (float*)(p.ws + WS_PU + 24 * MiB), it);
        else cvt_fp6_item(p.in[27] + (size_t)PE * D, p.ws + WS_PV, (float*)(p.ws + WS_PV + 24 * MiB), it - P0_TAB);
    }
}
__device__ __forceinline__ void phase_nsa_proj(const Params& p, unsigned char* lds) {
    const bf16_t* HM = (const bf16_t*)(p.ws + WS_HM); const bf16_t* WT = (const bf16_t*)(p.ws + WS_WPROJ_T);
    const f32x2* ROPE = (const f32x2*)(p.ws + WS_ROPE);
    bf16_t* Q = (bf16_t*)(p.ws + WS_Q); float* NGT = (float*)(p.ws + WS_NG);
    const int lane = threadIdx.x & 63, wid = threadIdx.x >> 6, wr = wid >> 1, wc = wid & 1, fr = lane & 15, fq = lane >> 4;
    for (int id = vblock(); id < 256 * 21; id += gridDim.x) {
        const int mt = id / 21, nt = id % 21;
        f32x4 acc[4][4];
        gemm_tile3(ALoadPlain{HM + (size_t)mt * 128 * D, (size_t)D}, WT + (size_t)nt * 128 * D, D, 16, acc, lds);
        const int c0 = nt * 128 + wc * 64;
        if (c0 >= 2624) continue;
        const int b = (mt * 128) / SEQ;
        if (c0 == 2560) {
#pragma unroll
            for (int mi = 0; mi < 4; ++mi)
#pragma unroll
                for (int ni = 0; ni < 3; ++ni) {
                    const int t = mt * 128 + wr * 64 + mi * 16 + fr;
                    const f32x4 v = acc[mi][ni];
                    *(f32x4*)(NGT + (size_t)t * 48 + ni * 16 + fq * 4) = (f32x4){sigmoidf_(v.x), sigmoidf_(v.y), sigmoidf_(v.z), sigmoidf_(v.w)};
                }
            continue;
        }
        int sec = -1, g = 0;
        if (c0 >= 1024) { sec = (c0 - 1024) >> 8; g = ((c0 - 1024) & 255) >> 6; }
        const bool dorope = (sec == -1) || (sec == 2) || (sec == 4);
        const float scl = (sec == -1) ? 0.125f : 1.0f;
        const size_t secoff[6] = {WS_KC, WS_VC, WS_KSB, WS_VSB, WS_KW, WS_VWT};
        size_t so = WS_Q;
#pragma unroll
        for (int q = 0; q < 6; ++q) if (sec == q) so = secoff[q];
        bf16_t* OUT = (bf16_t*)(p.ws + so);
        const bool vt = (sec == 3) || (sec == 5);
        float kblk_am = 0.f;
#pragma unroll
        for (int pass = 0; pass < 2; ++pass) {
        if (pass == 1 && sec == 2) {
#pragma unroll
            for (int o = 1; o < 64; o <<= 1) kblk_am = fmaxf(kblk_am, __shfl_xor(kblk_am, o));
            if (lane == 0) ((float*)(p.ws + WS_KS + 12 * MiB))[(size_t)(b * 4 + g) * 256 + ((mt * 128 + wr * 64 - b * SEQ) >> 6)] = kblk_am > 0.f ? kblk_am / 7.5f : 1.0f;
        }
#pragma unroll
        for (int mi = 0; mi < 4; ++mi) {
            const int t = mt * 128 + wr * 64 + mi * 16 + fr, s = t - b * SEQ;
            if (dorope && pass == 0) {
#pragma unroll
                for (int ni = 0; ni < 2; ++ni) {
                    const f32x4* rp = (const f32x4*)(ROPE + (size_t)s * 32 + ni * 16 + fq * 4);
                    const f32x4 r0 = rp[0], r1 = rp[1];
                    const f32x4 x1 = acc[mi][ni], x2 = acc[mi][ni + 2];
                    acc[mi][ni] = (f32x4){x1.x * r0.x - x2.x * r0.y, x1.y * r0.z - x2.y * r0.w, x1.z * r1.x - x2.z * r1.y, x1.w * r1.z - x2.w * r1.w};
                    acc[mi][ni + 2] = (f32x4){x1.x * r0.y + x2.x * r0.x, x1.y * r0.w + x2.y * r0.z, x1.z * r1.y + x2.z * r1.x, x1.w * r1.w + x2.w * r1.z};
                }
            }
            if (pass == 0) {
                if (sec == 2) {
#pragma unroll
                    for (int ni = 0; ni < 4; ++ni) { const f32x4 v = acc[mi][ni]; kblk_am = fmaxf(kblk_am, fmaxf(fmaxf(fabsf(v.x), fabsf(v.y)), fmaxf(fabsf(v.z), fabsf(v.w)))); }
                }
                continue;
            }
            if (sec == -1) {
                float am = 0.f;
#pragma unroll
                for (int ni = 0; ni < 4; ++ni) { const f32x4 v = acc[mi][ni] * scl; am = fmaxf(am, fmaxf(fmaxf(fabsf(v.x), fabsf(v.y)), fmaxf(fabsf(v.z), fabsf(v.w)))); }
                am = fmaxf(am, __shfl_xor(am, 16)); am = fmaxf(am, __shfl_xor(am, 32));
                const float qs = am > 0.f ? 224.0f / am : 1.0f;
                unsigned char* O8 = p.ws + WS_Q8 + (size_t)t * 1024 + c0;
#pragma unroll
                for (int ni = 0; ni < 4; ++ni) {
                    const f32x4 v = acc[mi][ni] * (scl * qs);
                    int w = 0; w = __builtin_amdgcn_cvt_pk_fp8_f32(v.x, v.y, w, false); w = __builtin_amdgcn_cvt_pk_fp8_f32(v.z, v.w, w, true);
                    *(int*)(O8 + ni * 16 + fq * 4) = w;
                }
                if (fq == 0) ((float*)(p.ws + WS_Q8 + 32 * MiB))[(size_t)t * 16 + (c0 >> 6)] = am > 0.f ? am / 224.0f : 1.0f;
            }
#pragma unroll
            for (int ni = 0; ni < 4; ++ni) {
                const f32x4 v = acc[mi][ni] * scl;
                const int d = ni * 16 + fq * 4;
                if (sec == -1) {
                    *(u32x2*)(OUT + (size_t)t * 1024 + c0 + d) = (u32x2){pk2(v.x, v.y), pk2(v.z, v.w)};
                } else if (sec == 4) {
                    const size_t idx = (size_t)(b * 4 + g) * SEQ * 64 + (size_t)(s >> 5) * 2048 + ((((s >> 4) & 1) * 2 + (ni >> 1)) * 16 + (s & 15)) * 32 + ((ni & 1) * 2 + (fq >> 1)) * 8 + (fq & 1) * 4;
                    *(u32x2*)(OUT + idx) = (u32x2){pk2(v.x, v.y), pk2(v.z, v.w)};
                } else if (!vt) {
                    *(u32x2*)(OUT + ((size_t)(b * 4 + g) * SEQ + s) * 64 + d) = (u32x2){pk2(v.x, v.y), pk2(v.z, v.w)};
                } else if (sec == 5) {
                    const int key = s & 31;
                    bf16_t* o = OUT + (size_t)(b * 4 + g) * SEQ * 64 + (size_t)(s >> 5) * 2048 + ((ni * 2 + (key >> 4)) * 16 + fq * 4) * 16 + ((key >> 2) & 3) * 4 + (key & 3);
                    o[0] = (bf16_t)f2bf(v.x); o[16] = (bf16_t)f2bf(v.y); o[32] = (bf16_t)f2bf(v.z); o[48] = (bf16_t)f2bf(v.w);
                }
            }
        }
        }
        if (sec == 3) {
            const int s0 = mt * 128 + wr * 64 - b * SEQ, jb = s0 >> 6;
            bf16_t* VB = (bf16_t*)(p.ws + WS_VSB) + (size_t)((b * 4 + g) * 256 + jb) * 4096;
#pragma unroll
            for (int ni = 0; ni < 4; ++ni) {
                const int d = ni * 16 + fq * 4;
#pragma unroll
                for (int mi = 0; mi < 4; ++mi) {
                    const f32x4 v = acc[mi][ni];
                    bf16_t* o = VB + (size_t)d * 64 + mi * 16 + fr;
                    o[0] = (bf16_t)f2bf(v.x); o[64] = (bf16_t)f2bf(v.y); o[128] = (bf16_t)f2bf(v.z); o[192] = (bf16_t)f2bf(v.w);
                }
            }
        }
    }
}
__device__ __forceinline__ void phase_pack6(const Params& p) {
    const int lane = threadIdx.x & 63, wave = threadIdx.x >> 6;
    int first = vblock() - 128, stride = (int)gridDim.x - 128;
    if (stride <= 0) { first = blockIdx.x; stride = (int)gridDim.x; }
    else if (first < 0) return;
    const bf16_t* KSB = (const bf16_t*)(p.ws + WS_KSB); const bf16_t* VSB = (const bf16_t*)(p.ws + WS_VSB);
    const float* KSC = (const float*)(p.ws + WS_KS + 12 * MiB);
    unsigned char* V6S = p.ws + WS_VST + 12 * MiB;
    for (int it = first * 4 + wave; it < 4096; it += stride * 4) {
        const int kv = it >> 11, blk = it & 2047;
#pragma unroll
        for (int half = 0; half < 2; ++half) {
            const int task = half * 64 + lane;
            u32x4 w4[4];
            float mul;
            if (kv == 0) {
                const int rho = task >> 2, dq = task & 3;
                const int k0 = 32 * ((rho >> 2) & 1) + 16 * (rho >> 4) + 4 * ((rho >> 3) & 1) + (rho & 3);
                const u32x4* s0 = (const u32x4*)(KSB + ((size_t)blk * 64 + k0) * 64 + dq * 16);
                w4[0] = s0[0]; w4[1] = s0[1]; w4[2] = s0[64]; w4[3] = s0[65];
                mul = 1.0f / KSC[blk];
            } else {
                const u32x4* s0 = (const u32x4*)(VSB + (size_t)blk * 4096 + (size_t)task * 32);
                w4[0] = s0[0]; w4[1] = s0[1]; w4[2] = s0[2]; w4[3] = s0[3];
                float am = 0.f;
#pragma unroll
                for (int q = 0; q < 4; ++q) {
                    am = fmaxf(am, fmaxf(fmaxf(fabsf(bflo(w4[q].x)), fabsf(bfhi(w4[q].x))), fmaxf(fabsf(bflo(w4[q].y)), fabsf(bfhi(w4[q].y)))));
                    am = fmaxf(am, fmaxf(fmaxf(fabsf(bflo(w4[q].z)), fabsf(bfhi(w4[q].z))), fmaxf(fabsf(bflo(w4[q].w)), fabsf(bfhi(w4[q].w)))));
                }
                const unsigned eb = (__float_as_uint(am * (1.0f / 7.5f)) + 0x7FFFFFu) >> 23;
                mul = __uint_as_float((254u - eb) << 23);
                const int d = task >> 1, hf = task & 1;
                V6S[(size_t)blk * 128 + (hf * 16 + (d & 15)) * 4 + (d >> 4)] = (unsigned char)eb;
            }
            v16f x0, x1;
#pragma unroll
            for (int q = 0; q < 4; ++q) {
                x0[q * 4 + 0] = bflo(w4[q].x) * mul; x1[q * 4 + 0] = bfhi(w4[q].x) * mul; x0[q * 4 + 1] = bflo(w4[q].y) * mul; x1[q * 4 + 1] = bfhi(w4[q].y) * mul;
                x0[q * 4 + 2] = bflo(w4[q].z) * mul; x1[q * 4 + 2] = bfhi(w4[q].z) * mul; x0[q * 4 + 3] = bflo(w4[q].w) * mul; x1[q * 4 + 3] = bfhi(w4[q].w) * mul;
            }
            const v6u w = __builtin_amdgcn_cvt_scalef32_2xpk16_fp6_f32(x0, x1, 1.0f);
            u32x2* dp = (u32x2*)(p.ws + (kv ? WS_VST : WS_KS) + (size_t)blk * 3072 + (size_t)task * 24);
            dp[0] = (u32x2){w[0], w[1]}; dp[1] = (u32x2){w[2], w[3]}; dp[2] = (u32x2){w[4], w[5]};
        }
    }
}
__device__ __forceinline__ void phase_nsa_cmp1(const Params& p, unsigned char* lds) {
    bf16_t* HID = (bf16_t*)(p.ws + WS_HID);
    const float* bias = (const float*)(p.ws + WS_MISC);
    const int lane = threadIdx.x & 63, wid = threadIdx.x >> 6, wr = wid >> 1, wc = wid & 1, fr = lane & 15, fq = lane >> 4;
    for (int id = vblock(); id < 256; id += gridDim.x) {
        const int kv = id >> 7, bg = (id >> 4) & 7, mt = (id >> 1) & 7, nt = id & 1;
        const bf16_t* A = (const bf16_t*)(p.ws + (kv ? WS_VC : WS_KC)) + (size_t)bg * SEQ * 64 + (size_t)mt * 128 * 1024;
        const bf16_t* B = (const bf16_t*)(p.ws + (kv ? WS_WV1_T : WS_WK1_T)) + (size_t)nt * 128 * 2048;
        f32x4 acc[4][4];
        gemm_tile3(ALoadPlain{A, (size_t)1024}, B, 2048, 32, acc, lds);
#pragma unroll
        for (int mi = 0; mi < 4; ++mi)
#pragma unroll
            for (int ni = 0; ni < 4; ++ni) {
                const int n = mt * 128 + wr * 64 + mi * 16 + fr, c = nt * 128 + wc * 64 + ni * 16 + fq * 4;
                const f32x4 bv = *(const f32x4*)(bias + kv * 256 + c);
                const f32x4 v = acc[mi][ni] + bv;
                *(u32x2*)(HID + (((size_t)kv * 8 + bg) * 1024 + n) * 256 + c) = (u32x2){pk2(gelu_tanh(v.x), gelu_tanh(v.y)), pk2(gelu_tanh(v.z), gelu_tanh(v.w))};
            }
    }
}
__device__ __forceinline__ void phase_nsa_cmp2(const Params& p, unsigned char* lds) {
    const bf16_t* HID = (const bf16_t*)(p.ws + WS_HID);
    const f32x2* ROPE = (const f32x2*)(p.ws + WS_ROPE);
    bf16_t* KCMP = (bf16_t*)(p.ws + WS_KCMP); bf16_t* VCMPT = (bf16_t*)(p.ws + WS_VCMPT);
    const int lane = threadIdx.x & 63, wid = threadIdx.x >> 6, wr = wid >> 1, wc = wid & 1, fr = lane & 15, fq = lane >> 4;
    for (int id = vblock(); id < 128; id += gridDim.x) {
        const int kv = id >> 6, mt = id & 63;
        const bf16_t* A = HID + ((size_t)kv * 8192 + (size_t)mt * 128) * 256;
        const bf16_t* B = (const bf16_t*)(p.ws + (kv ? WS_WV2_T : WS_WK2_T));
        f32x4 acc[4][4];
        gemm_tile3(ALoadPlain{A, (size_t)256}, B, 256, 4, acc, lds);
        if (wc == 1) continue;
#pragma unroll
        for (int mi = 0; mi < 4; ++mi) {
            const int R = mt * 128 + wr * 64 + mi * 16 + fr, bg = R >> 10, n = R & 1023;
            if (kv == 0) {
                int pos = n * 16 + 31; pos = pos > SEQ - 1 ? SEQ - 1 : pos;
#pragma unroll
                for (int ni = 0; ni < 2; ++ni) {
                    const f32x4* rp = (const f32x4*)(ROPE + (size_t)pos * 32 + ni * 16 + fq * 4);
                    const f32x4 r0 = rp[0], r1 = rp[1];
                    const f32x4 x1 = acc[mi][ni], x2 = acc[mi][ni + 2];
                    acc[mi][ni] = (f32x4){x1.x * r0.x - x2.x * r0.y, x1.y * r0.z - x2.y * r0.w, x1.z * r1.x - x2.z * r1.y, x1.w * r1.z - x2.w * r1.w};
                    acc[mi][ni + 2] = (f32x4){x1.x * r0.y + x2.x * r0.x, x1.y * r0.w + x2.y * r0.z, x1.z * r1.y + x2.z * r1.x, x1.w * r1.w + x2.w * r1.z};
                }
#pragma unroll
                for (int ni = 0; ni < 4; ++ni) {
                    const f32x4 v = acc[mi][ni];
                    const size_t idx = (size_t)bg * 1024 * 64 + (size_t)(n >> 5) * 2048 + ((((n >> 4) & 1) * 2 + (ni >> 1)) * 16 + (n & 15)) * 32 + ((ni & 1) * 2 + (fq >> 1)) * 8 + (fq & 1) * 4;
                    *(u32x2*)(KCMP + idx) = (u32x2){pk2(v.x, v.y), pk2(v.z, v.w)};
                }
            } else {
#pragma unroll
                for (int ni = 0; ni < 4; ++ni) {
                    const f32x4 v = acc[mi][ni];
                    const int key = n & 31;
                    bf16_t* o = VCMPT + (size_t)bg * 1024 * 64 + (size_t)(n >> 5) * 2048 + ((ni * 2 + (key >> 4)) * 16 + fq * 4) * 16 + ((key >> 2) & 3) * 4 + (key & 3);
                    o[0] = (bf16_t)f2bf(v.x); o[16] = (bf16_t)f2bf(v.y); o[32] = (bf16_t)f2bf(v.z); o[48] = (bf16_t)f2bf(v.w);
                }
            }
        }
    }
}
__device__ __forceinline__ void phase_nsa_wo(const Params& p, unsigned char* lds, bool dry) {
    const bf16_t* O = (const bf16_t*)(p.ws + WS_O); const bf16_t* WT = (const bf16_t*)(p.ws + WS_WO_T);
    const float* MOD = (const float*)(p.ws + WS_MOD);
    float* X = p.out;
    const int lane = threadIdx.x & 63, wid = threadIdx.x >> 6, wr = wid >> 1, wc = wid & 1, fr = lane & 15, fq = lane >> 4;
    for (int id = vblock(); id < 256 * 8; id += gridDim.x) {
        const int mt = id >> 3, nt = id & 7;
        f32x4 acc[4][4];
        gemm_tile3(ALoadPlain{O + (size_t)mt * 128 * D, (size_t)D}, WT + (size_t)nt * 128 * D, D, 16, acc, lds);
        const int b = (mt * 128) / SEQ;
#pragma unroll
        for (int mi = 0; mi < 4; ++mi)
#pragma unroll
            for (int ni = 0; ni < 4; ++ni) {
                const int t = mt * 128 + wr * 64 + mi * 16 + fr, c = nt * 128 + wc * 64 + ni * 16 + fq * 4;
                const f32x4 g1 = *(const f32x4*)(MOD + (size_t)(1 * 2 + b) * 6144 + 2048 + c);
                float* xp = X + (size_t)t * D + c;
                const f32x4 x = *(const f32x4*)xp; const f32x4 v = acc[mi][ni];
                if (!dry) *(f32x4*)xp = (f32x4){x.x + g1.x * v.x, x.y + g1.y * v.y, x.z + g1.z * v.z, x.w + g1.w * v.w};
            }
    }
}
__device__ __forceinline__ bf16x8 pack8(const f32x4 a, const f32x4 b) {
    u32x4 w; w.x = pk2(a.x, a.y); w.y = pk2(a.z, a.w); w.z = pk2(b.x, b.y); w.w = pk2(b.z, b.w);
    return __builtin_bit_cast(bf16x8, w);
}
__device__ __forceinline__ bf16x8 ldv8(const bf16_t* plo, const bf16_t* phi) {
    const u32x2 lo = *(const u32x2*)plo, hi = *(const u32x2*)phi;
    u32x4 w; w.x = lo.x; w.y = lo.y; w.z = hi.x; w.w = hi.y;
    return __builtin_bit_cast(bf16x8, w);
}
__device__ __forceinline__ float red4(float v) { v += __shfl_xor(v, 16); v += __shfl_xor(v, 32); return v; }
__device__ __forceinline__ float max4(float v) { v = fmaxf(v, __shfl_xor(v, 16)); v = fmaxf(v, __shfl_xor(v, 32)); return v; }
#define NEGBIG (-1.0e30f)

__device__ __forceinline__ void phase_nsa_attn(const Params& p, unsigned char* lds, const int rep_cmp, const int rep_win, const int rep_sel) {
    const int lane = threadIdx.x & 63, wave = threadIdx.x >> 6, fr = lane & 15, fq = lane >> 4;
    unsigned char* WL = lds + wave * 18432;
    float* IMP = (float*)WL;
    int* SEL = (int*)(WL + 17408);
    const bf16_t* Q = (const bf16_t*)(p.ws + WS_Q);
    const bf16_t* KCMP = (const bf16_t*)(p.ws + WS_KCMP); const bf16_t* VCMPT = (const bf16_t*)(p.ws + WS_VCMPT);
    const bf16_t* KW = (const bf16_t*)(p.ws + WS_KW); const bf16_t* VWT = (const bf16_t*)(p.ws + WS_VWT);
    const float* NGT = (const float*)(p.ws + WS_NG);
    bf16_t* O = (bf16_t*)(p.ws + WS_O);
    const f32x4 z4 = (f32x4){0.f, 0.f, 0.f, 0.f};
    for (int bi = blockIdx.x; bi < 2048; bi += gridDim.x) {
        const int bg = bi & 7, quad = 255 - (bi >> 3), t0 = (quad * 4 + wave) * 16, b = bg >> 2, g = bg & 3;
        const int cur = t0 >> 6;
        const size_t tok = (size_t)b * SEQ + t0 + fr;
        const int tq = t0 + fr;
        bf16x8 qf[4][2];
#pragma unroll
        for (int r = 0; r < 4; ++r)
#pragma unroll
            for (int ks = 0; ks < 2; ++ks) qf[r][ks] = *(const bf16x8*)(Q + tok * 1024 + (g * 4 + r) * 64 + ks * 32 + fq * 8);
        f32x4 acc[4][4];
        for (int rep = 0; rep < rep_win; ++rep) {
            const bf16_t* kwb = KW + (size_t)bg * SEQ * 64; const bf16_t* vwb = VWT + (size_t)bg * SEQ * 64;
            float mw[4], lw[4];
#pragma unroll
            for (int r = 0; r < 4; ++r) { mw[r] = NEGBIG; lw[r] = 0.f;
#pragma unroll
                for (int df = 0; df < 4; ++df) acc[r][df] = z4; }
            int kmin = t0 - 511; kmin = kmin < 0 ? 0 : kmin; kmin &= ~31;
            bf16x8 nkf[2][2];
#define WIN_LOAD(kb_) do { _Pragma("unroll") for (int f = 0; f < 2; ++f) _Pragma("unroll") for (int ks = 0; ks < 2; ++ks) nkf[f][ks] = *(const bf16x8*)(kwb + (size_t)((kb_) >> 5) * 2048 + ((f * 2 + ks) * 16 + fr) * 32 + fq * 8); } while (0)
            WIN_LOAD(kmin);
            for (int kb = kmin; kb <= t0 + 15; kb += 32) {
                bf16x8 kf[2][2], vf[4];
#pragma unroll
                for (int f = 0; f < 2; ++f) { kf[f][0] = nkf[f][0]; kf[f][1] = nkf[f][1]; }
#pragma unroll
                for (int df = 0; df < 4; ++df) { const bf16_t* vp = vwb + (size_t)(kb >> 5) * 2048 + (df * 32 + fr) * 16 + fq * 4; vf[df] = ldv8(vp, vp + 256); }
                { const int kn = (kb + 32 <= t0 + 15) ? kb + 32 : kb; WIN_LOAD(kn); }
#pragma unroll
                for (int r = 0; r < 4; ++r) {
                    f32x4 st[2];
#pragma unroll
                    for (int f = 0; f < 2; ++f) {
                        st[f] = __builtin_amdgcn_mfma_f32_16x16x32_bf16(kf[f][0], qf[r][0], z4, 0, 0, 0);
                        st[f] = __builtin_amdgcn_mfma_f32_16x16x32_bf16(kf[f][1], qf[r][1], st[f], 0, 0, 0);
                    }
                    float mx = NEGBIG;
#pragma unroll
                    for (int f = 0; f < 2; ++f)
#pragma unroll
                        for (int e = 0; e < 4; ++e) { const int key = kb + f * 16 + fq * 4 + e; const bool ok = (key <= tq) && (key > tq - 512); if (ok) mx = fmaxf(mx, st[f][e]); }
                    float mn = mw[r], al = 1.0f;
                    if (__builtin_amdgcn_ballot_w64(mx > mw[r] + 8.0f) != 0ull) { mn = fmaxf(mw[r], max4(mx)); al = __expf(mw[r] - mn); }
                    float ps = 0.f;
#pragma unroll
                    for (int f = 0; f < 2; ++f)
#pragma unroll
                        for (int e = 0; e < 4; ++e) { const int key = kb + f * 16 + fq * 4 + e; const bool ok = (key <= tq) && (key > tq - 512); const float pv = ok ? __expf(st[f][e] - mn) : 0.f; st[f][e] = pv; ps += pv; }
                    lw[r] = lw[r] * al + ps; mw[r] = mn;
                    const bf16x8 pf = pack8(st[0], st[1]);
#pragma unroll
                    for (int df = 0; df < 4; ++df) { acc[r][df] = acc[r][df] * al; acc[r][df] = __builtin_amdgcn_mfma_f32_16x16x32_bf16(vf[df], pf, acc[r][df], 0, 0, 0); }
                    __builtin_amdgcn_sched_barrier(0);
                }
            }
#pragma unroll
            for (int r = 0; r < 4; ++r) {
                const float l = red4(lw[r]); const float sc = NGT[tok * 48 + (g * 4 + r) * 3 + 2] / l;
#pragma unroll
                for (int df = 0; df < 4; ++df) acc[r][df] = acc[r][df] * sc;
            }
#undef WIN_LOAD
        }
        const int nmax_tile = (t0 >> 4) - 1, nmax_lane = (t0 >> 4) - 2 + (fr == 15 ? 1 : 0);
        const bf16_t* kcb = KCMP + (size_t)bg * 1024 * 64; const bf16_t* vcb = VCMPT + (size_t)bg * 64 * 1024;
        for (int rep = 0; rep < rep_cmp; ++rep) {
            const bool dry = (rep + 1 < rep_cmp);
            float mc[4], lc[4], invl[4];
#pragma unroll
            for (int r = 0; r < 4; ++r) { mc[r] = NEGBIG; lc[r] = 0.f; }
            bf16x8 nkc[2][2], nvc[4];
#define CMPK_LOAD(nb_) do { _Pragma("unroll") for (int f = 0; f < 2; ++f) _Pragma("unroll") for (int ks = 0; ks < 2; ++ks) nkc[f][ks] = *(const bf16x8*)(kcb + (size_t)((nb_) >> 5) * 2048 + ((f * 2 + ks) * 16 + fr) * 32 + fq * 8); } while (0)
#define CMPV_LOAD(nb_) do { _Pragma("unroll") for (int df = 0; df < 4; ++df) { const bf16_t* vp = vcb + (size_t)((nb_) >> 5) * 2048 + (df * 32 + fr) * 16 + fq * 4; nvc[df] = ldv8(vp, vp + 256); } } while (0)
            CMPK_LOAD(0);
            for (int nb = 0; nb <= nmax_tile; nb += 32) {
                bf16x8 kf[2][2];
#pragma unroll
                for (int f = 0; f < 2; ++f) { kf[f][0] = nkc[f][0]; kf[f][1] = nkc[f][1]; }
                { const int nn = (nb + 32 <= nmax_tile) ? nb + 32 : 0; CMPK_LOAD(nn); }
#pragma unroll
                for (int r = 0; r < 4; ++r) {
                    f32x4 st[2];
#pragma unroll
                    for (int f = 0; f < 2; ++f) {
                        st[f] = __builtin_amdgcn_mfma_f32_16x16x32_bf16(kf[f][0], qf[r][0], z4, 0, 0, 0);
                        st[f] = __builtin_amdgcn_mfma_f32_16x16x32_bf16(kf[f][1], qf[r][1], st[f], 0, 0, 0);
                    }
                    float mx = NEGBIG;
#pragma unroll
                    for (int f = 0; f < 2; ++f)
#pragma unroll
                        for (int e = 0; e < 4; ++e) { const int n = nb + f * 16 + fq * 4 + e; if (n <= nmax_lane) mx = fmaxf(mx, st[f][e]); }
                    float mn = mc[r];
                    if (__builtin_amdgcn_ballot_w64(mx > mc[r] + 8.0f) != 0ull) mn = fmaxf(mc[r], max4(mx));
                    float ps = 0.f;
#pragma unroll
                    for (int f = 0; f < 2; ++f)
#pragma unroll
                        for (int e = 0; e < 4; ++e) { const int n = nb + f * 16 + fq * 4 + e; if (n <= nmax_lane) ps += __expf(st[f][e] - mn); }
                    lc[r] = lc[r] * __expf(mc[r] - mn) + ps; mc[r] = mn;
                    __builtin_amdgcn_sched_barrier(0);
                }
            }
#pragma unroll
            for (int r = 0; r < 4; ++r) { const float l = red4(lc[r]); invl[r] = l > 0.f ? 1.0f / l : 0.f; }
            for (int i = lane; i < 16 * 260; i += 64) IMP[i] = 0.f;
            float carry = 0.f;
            float gc[4];
#pragma unroll
            for (int r = 0; r < 4; ++r) gc[r] = NGT[tok * 48 + (g * 4 + r) * 3];
            for (int nb = 0; nb <= nmax_tile; nb += 32) {
                bf16x8 kf[2][2], vf[4];
#pragma unroll
                for (int f = 0; f < 2; ++f) { kf[f][0] = nkc[f][0]; kf[f][1] = nkc[f][1]; }
                CMPV_LOAD(nb);
#pragma unroll
                for (int df = 0; df < 4; ++df) vf[df] = nvc[df];
                { const int nn = (nb + 32 <= nmax_tile) ? nb + 32 : nb; CMPK_LOAD(nn); }
                f32x4 pg[2] = {z4, z4};
#pragma unroll
                for (int r = 0; r < 4; ++r) {
                    f32x4 st[2];
#pragma unroll
                    for (int f = 0; f < 2; ++f) {
                        st[f] = __builtin_amdgcn_mfma_f32_16x16x32_bf16(kf[f][0], qf[r][0], z4, 0, 0, 0);
                        st[f] = __builtin_amdgcn_mfma_f32_16x16x32_bf16(kf[f][1], qf[r][1], st[f], 0, 0, 0);
#pragma unroll
                        for (int e = 0; e < 4; ++e) { const int n = nb + f * 16 + fq * 4 + e; st[f][e] = (n <= nmax_lane) ? __expf(st[f][e] - mc[r]) * invl[r] : 0.f; }
                        pg[f] += st[f];
                    }
                    const float gg = dry ? 0.f : gc[r];
                    const bf16x8 pf = pack8(st[0] * gg, st[1] * gg);
#pragma unroll
                    for (int df = 0; df < 4; ++df) acc[r][df] = __builtin_amdgcn_mfma_f32_16x16x32_bf16(vf[df], pf, acc[r][df], 0, 0, 0);
                    __builtin_amdgcn_sched_barrier(0);
                }
                const int src = (lane - 16) & 63;
                const float s0 = __shfl(pg[0].w, src), s1 = __shfl(pg[1].w, src), sc = __shfl(carry, src);
                const float prev0 = fq > 0 ? s0 : sc, prev1 = fq > 0 ? s1 : s0;
                const float imp0 = (pg[0].x + pg[0].y) + (pg[0].z + pg[0].w) + prev0;
                const float imp1 = (pg[1].x + pg[1].y) + (pg[1].z + pg[1].w) + prev1;
                const int jb = (nb >> 2) + fq;
                IMP[fr * 260 + jb] = imp0; IMP[fr * 260 + jb + 4] = imp1;
                carry = pg[1].w;
            }
#undef CMPK_LOAD
#undef CMPV_LOAD
        }
        {
            const int nf = cur >= 2 ? 3 : cur + 1;
            if (fq == 0) {
                SEL[fr * 16 + 0] = 0;
                if (cur == 1) SEL[fr * 16 + 1] = 1;
                if (cur >= 2) { SEL[fr * 16 + 1] = cur - 1; SEL[fr * 16 + 2] = cur; }
            }
            const int ncand = cur >= 3 ? cur - 2 : 0, extra = 16 - nf;
            if (ncand <= extra) {
                if (fq == 0) { for (int k = 0; k < extra; ++k) SEL[fr * 16 + nf + k] = (k < ncand) ? 1 + k : -1; }
            } else {
                for (int rnd = 0; rnd < extra; ++rnd) {
                    float bv = -1.0f; int bj = 1 << 20;
                    for (int jb = 1 + fq; jb <= cur - 2; jb += 4) { const float v = IMP[fr * 260 + jb]; if (v > bv) { bv = v; bj = jb; } }
#pragma unroll
                    for (int o = 16; o <= 32; o <<= 1) {
                        const float ov = __shfl_xor(bv, o); const int oj = __shfl_xor(bj, o);
                        if (ov > bv || (ov == bv && oj < bj)) { bv = ov; bj = oj; }
                    }
                    if (fq == 0) SEL[fr * 16 + nf + rnd] = bj;
                    if (((bj - 1) & 3) == fq) IMP[fr * 260 + bj] = -2.0f;
                }
            }
        }
#pragma unroll
        for (int r = 0; r < 4; ++r)
#pragma unroll
            for (int df = 0; df < 4; ++df) {
                const f32x4 v = acc[r][df];
                *(u32x2*)(O + tok * 1024 + (g * 4 + r) * 64 + df * 16 + fq * 4) = (u32x2){pk2(v.x, v.y), pk2(v.z, v.w)};
            }
        asm volatile("s_waitcnt vmcnt(0)" ::: "memory");
        unsigned selp[4];
        {
            const u32x4* sp = (const u32x4*)(SEL + fr * 16);
#pragma unroll
            for (int q = 0; q < 4; ++q) { const u32x4 w = sp[q]; selp[q] = (w.x & 255u) | ((w.y & 255u) << 8) | ((w.z & 255u) << 16) | ((w.w & 255u) << 24); }
        }
        for (int rep = 0; rep < rep_sel; ++rep) {
            const bool dry = (rep + 1 < rep_sel);
            const unsigned char* k6b = p.ws + WS_KS + (size_t)bg * 256 * 3072; const unsigned char* v6b = p.ws + WS_VST + (size_t)bg * 256 * 3072;
            const float* skb = (const float*)(p.ws + WS_KS + 12 * MiB) + (size_t)bg * 256;
            const unsigned char* v6s = p.ws + WS_VST + 12 * MiB + (size_t)bg * 256 * 128 + ((fq & 1) * 16 + fr) * 4;
            const unsigned char* Q8 = p.ws + WS_Q8; const float* SQ8 = (const float*)(p.ws + WS_Q8 + 32 * MiB);
            const int nv = cur + 1 < 16 ? cur + 1 : 16, npair = (nv + 1) >> 1, total = 16 * npair;
            const int rr = fr & 3;
            const int jq = fr >> 2;
            const bool fhi = (fq >> 1) != 0;
            const int rdk = (fr >> 3) * 3088 + (fr & 7) * 96 + fq * 24;
            const int rdv = 6176 + (fq >> 1) * 3088 + fr * 48 + (fq & 1) * 24;
            u32x4 sk[2][3], sv[2][3]; float ssk[2]; unsigned vscn;
            int jbn[2];
#define SEL_GET(tokI, slotK) ((int)(((unsigned)__builtin_amdgcn_readlane((int)(((slotK) >> 2) == 0 ? selp[0] : ((slotK) >> 2) == 1 ? selp[1] : ((slotK) >> 2) == 2 ? selp[2] : selp[3]), (tokI)) >> (((slotK) & 3) * 8)) & 255u))
#define SEL_ISSUE(tokI, pairP) do { \
                const int k0_ = 2 * (pairP), k1_ = (2 * (pairP) + 1 < nv) ? 2 * (pairP) + 1 : k0_; \
                jbn[0] = __builtin_amdgcn_readfirstlane(SEL_GET(tokI, k0_)); jbn[1] = __builtin_amdgcn_readfirstlane(SEL_GET(tokI, k1_)); \
                _Pragma("unroll") for (int u = 0; u < 2; ++u) { \
                    const unsigned char* kb_ = k6b + (size_t)jbn[u] * 3072; const unsigned char* vb_ = v6b + (size_t)jbn[u] * 3072; \
                    _Pragma("unroll") for (int j = 0; j < 3; ++j) { sk[u][j] = *(const u32x4*)(kb_ + j * 1024 + lane * 16); sv[u][j] = *(const u32x4*)(vb_ + j * 1024 + lane * 16); } \
                    ssk[u] = skb[jbn[u]]; } \
                vscn = *(const unsigned*)(v6s + (size_t)(fhi ? jbn[1] : jbn[0]) * 128); } while (0)
            SEL_ISSUE(0, 0);
            v8i bq[2] = {(v8i){0, 0, 0, 0, 0, 0, 0, 0}, (v8i){0, 0, 0, 0, 0, 0, 0, 0}};
            float sq = 0.f, ms = NEGBIG, ls = 0.f;
            f32x4 os[4] = {z4, z4, z4, z4};
            u32x2 oprev[4] = {(u32x2){0u, 0u}, (u32x2){0u, 0u}, (u32x2){0u, 0u}, (u32x2){0u, 0u}};
            int i = 0, pp = 0;
            for (int v = 0; v < total; ++v) {
                const int jb0 = jbn[0], jb1 = jbn[1];
                const bool second_valid = (2 * pp + 1 < nv);
                const float ck0 = ssk[0], ck1 = ssk[1];
                const int vsc = (int)vscn;
#pragma unroll
                for (int u = 0; u < 2; ++u)
#pragma unroll
                    for (int j = 0; j < 3; ++j) {
                        *(u32x4*)(WL + u * 3088 + j * 1024 + lane * 16) = sk[u][j];
                        *(u32x4*)(WL + 6176 + u * 3088 + j * 1024 + lane * 16) = sv[u][j];
                    }
                if (v + 1 < total) {
                    int p2 = pp + 1, i2 = i; if (p2 == npair) { p2 = 0; i2 = i + 1; }
                    SEL_ISSUE(i2, p2);
                }
                __builtin_amdgcn_sched_barrier(0);
                const int ti = t0 + i;
                if (pp == 0) {
                    const size_t tk = (size_t)b * SEQ + ti;
                    {
                        const u32x4 q16 = *(const u32x4*)(Q8 + tk * 1024 + (g * 4 + rr) * 64 + fq * 16);
#pragma unroll
                        for (int P = 0; P < 2; ++P) {
                            const bool lo = (jq == 2 * P), hi = (jq == 2 * P + 1);
                            bq[P] = (v8i){lo ? (int)q16.x : 0, lo ? (int)q16.y : 0, lo ? (int)q16.z : 0, lo ? (int)q16.w : 0,
                                          hi ? (int)q16.x : 0, hi ? (int)q16.y : 0, hi ? (int)q16.z : 0, hi ? (int)q16.w : 0};
                        }
                    }
                    sq = SQ8[tk * 16 + g * 4 + rr] * 1.4426950408889634f;
                    ms = NEGBIG; ls = 0.f;
#pragma unroll
                    for (int df = 0; df < 4; ++df) { os[df] = z4; oprev[df] = *(const u32x2*)(O + tk * 1024 + (g * 4 + rr) * 64 + df * 16 + fq * 4); }
                }
                f32x4 sc4[4];
#define SEL_S(m_) do { \
                    const unsigned char* ap_ = WL + rdk + (m_) * 768; \
                    const u32x2 r0_ = *(const u32x2*)ap_, r1_ = *(const u32x2*)(ap_ + 8), r2_ = *(const u32x2*)(ap_ + 16); \
                    const v8i ka_ = (v8i){(int)r0_.x, (int)r0_.y, (int)r1_.x, (int)r1_.y, (int)r2_.x, (int)r2_.y, 0, 0}; \
                    sc4[m_] = __builtin_amdgcn_mfma_scale_f32_16x16x128_f8f6f4(ka_, bq[(m_) >> 1], z4, 2, 0, 0, 0x7f7f7f7f, 0, 0x7f7f7f7f); } while (0)
                SEL_S(0); SEL_S(1); SEL_S(2); SEL_S(3);
#undef SEL_S
                const bool ju_ = (jq & 2) != 0;
                f32x4 a0, a1;
#pragma unroll
                for (int e = 0; e < 4; ++e) { a0[e] = ju_ ? sc4[2][e] : sc4[0][e]; a1[e] = ju_ ? sc4[3][e] : sc4[1][e]; }
                const float c_own = sq * (fhi ? ck1 : ck0);
                if (jb0 == cur || jb1 == cur || !second_valid) {
                    const int jbu = fhi ? jb1 : jb0;
                    const bool allbad = fhi && !second_valid;
                    const int key0 = jbu * 64 + 32 * (fq & 1) + 8 * jq;
#pragma unroll
                    for (int e = 0; e < 4; ++e) { if (allbad || key0 + e > ti) a0[e] = NEGBIG; if (allbad || key0 + 4 + e > ti) a1[e] = NEGBIG; }
                }
                const float mxr = fmaxf(fmaxf(fmaxf(a0.x, a0.y), fmaxf(a0.z, a0.w)), fmaxf(fmaxf(a1.x, a1.y), fmaxf(a1.z, a1.w)));
                const float mxl = mxr > -1.0e29f ? mxr * c_own : NEGBIG;
                float mn = ms;
                if (__builtin_amdgcn_ballot_w64(mxl > ms + 4.0f) != 0ull) {
                    float m16 = max4(mxl); m16 = fmaxf(m16, __shfl_xor(m16, 4)); m16 = fmaxf(m16, __shfl_xor(m16, 8));
                    mn = fmaxf(ms, m16);
                    const float al = __builtin_amdgcn_exp2f(ms - mn);
                    ls *= al;
#pragma unroll
                    for (int df = 0; df < 4; ++df) os[df] = os[df] * al;
                }
                const float off = 4.0f - mn;
                float ps = 0.f;
#pragma unroll
                for (int e = 0; e < 4; ++e) { a0[e] = __builtin_amdgcn_exp2f(a0[e] * c_own + off); a1[e] = __builtin_amdgcn_exp2f(a1[e] * c_own + off); ps += a0[e] + a1[e]; }
                ls += ps; ms = mn;
                int w0 = 0, w1 = 0;
                w0 = __builtin_amdgcn_cvt_pk_fp8_f32(a0.x, a0.y, w0, false); w0 = __builtin_amdgcn_cvt_pk_fp8_f32(a0.z, a0.w, w0, true);
                w1 = __builtin_amdgcn_cvt_pk_fp8_f32(a1.x, a1.y, w1, false); w1 = __builtin_amdgcn_cvt_pk_fp8_f32(a1.z, a1.w, w1, true);
                const v8i pb = (v8i){jq == 0 ? w0 : 0, jq == 0 ? w1 : 0, jq == 1 ? w0 : 0, jq == 1 ? w1 : 0, jq == 2 ? w0 : 0, jq == 2 ? w1 : 0, jq == 3 ? w0 : 0, jq == 3 ? w1 : 0};
#define SEL_PV(df_) do { \
                    const unsigned char* ap_ = WL + rdv + (df_) * 768; \
                    const u32x2 r0_ = *(const u32x2*)ap_, r1_ = *(const u32x2*)(ap_ + 8), r2_ = *(const u32x2*)(ap_ + 16); \
                    const v8i va_ = (v8i){(int)r0_.x, (int)r0_.y, (int)r1_.x, (int)r1_.y, (int)r2_.x, (int)r2_.y, 0, 0}; \
                    os[df_] = __builtin_amdgcn_mfma_scale_f32_16x16x128_f8f6f4(va_, pb, os[df_], 2, 0, df_, vsc, 0, 0x7f7f7f7f); } while (0)
                SEL_PV(0); SEL_PV(1); SEL_PV(2); SEL_PV(3);
#undef SEL_PV
                if (pp == npair - 1) {
                    float l = red4(ls); l += __shfl_xor(l, 4); l += __shfl_xor(l, 8);
#pragma unroll
                    for (int df = 0; df < 4; ++df)
#pragma unroll
                        for (int e = 0; e < 4; ++e) { float v_ = os[df][e]; v_ += __shfl_xor(v_, 4); v_ += __shfl_xor(v_, 8); os[df][e] = v_; }
                    const float gsv = NGT[((size_t)b * SEQ + ti) * 48 + (g * 4 + rr) * 3 + 1];
                    const float sc = gsv / l;
                    if (fr < 4 && !dry) {
                        bf16_t* op = O + ((size_t)b * SEQ + ti) * 1024 + (g * 4 + fr) * 64 + fq * 4;
#pragma unroll
                        for (int df = 0; df < 4; ++df) {
                            const f32x4 val = os[df] * sc; const u32x2 c = oprev[df];
                            *(u32x2*)(op + df * 16) = (u32x2){pk2(bflo(c.x) + val.x, bfhi(c.x) + val.y), pk2(bflo(c.y) + val.z, bfhi(c.y) + val.w)};
                        }
                    }
                }
                ++pp; if (pp == npair) { pp = 0; ++i; }
            }
#undef SEL_GET
#undef SEL_ISSUE
        }
    }
}
constexpr int NPHASES = 18;
#ifndef PROBE_PHASE
#define PROBE_PHASE (-1)
#endif
#ifndef ATT_REP_CMP
#define ATT_REP_CMP 1
#endif
#ifndef ATT_REP_WIN
#define ATT_REP_WIN 1
#endif
#ifndef ATT_REP_SEL
#define ATT_REP_SEL 1
#endif
#ifndef TS_PHASE
#define TS_PHASE (-1)
#endif
#ifndef TS_MULT
#define TS_MULT 4
#endif
#ifndef PROBE_REPS
#define PROBE_REPS 1
#endif
__global__ void __launch_bounds__(NTHREADS, 2) mega(Params p) {
    __shared__ __attribute__((aligned(1024))) unsigned char lds[LDS_BYTES + 16];
    unsigned* bar_st = (unsigned*)(lds + LDS_BYTES);
    cg::grid_group grid = cg::this_grid();
    const float* MOD = (const float*)(p.ws + WS_MOD);
    bf16_t* HM = (bf16_t*)(p.ws + WS_HM);
    if (threadIdx.x < 4) bar_st[threadIdx.x] = 0u;
    __syncthreads();
    XcdBarrier bar = xcd_barrier_post((unsigned*)(p.ws + WS_CTL), (volatile LAS unsigned*)bar_st);
    const int lo = p.ph_lo, hi = p.ph_hi;
    const bool dry0 = (p.ph_hi < 0);
    const int opq = (p.ph_hi < 0) ? 1 : 0;
    const bool never = (p.ph_hi < 0);
    unsigned long long ts_a = 0ull, ts_b = 0ull;
#define PHASE(k, call, drycall) if (lo <= (k) && (k) < hi) { \
        if (TS_PHASE == (k)) ts_a = __builtin_amdgcn_s_memrealtime(); \
        if (PROBE_PHASE == (k)) { for (int rep = 0; rep < PROBE_REPS; ++rep) { const bool dry = !dry0; drycall; __syncthreads(); } } \
        { const bool dry = dry0; call; } \
        if ((k) + 1 < hi) { if (never) grid.sync(); else xcd_barrier(bar); } \
        if (TS_PHASE == (k)) ts_b = __builtin_amdgcn_s_memrealtime(); }
    PHASE(0, phase_prep(p, (float*)lds, 0), phase_prep(p, (float*)lds, 0))
    PHASE(1, phase_norm(p, p.in[0], p.in[2], MOD + 0, MOD + 1024, HM), phase_norm(p, p.in[0], p.in[2], MOD + 0, MOD + 1024, HM))
    PHASE(2, phase_s5_win(p, lds), phase_s5_win(p, lds))
    PHASE(3, phase_s5_a(p, lds), phase_s5_a(p, lds))
    PHASE(4, (phase_s5_scan(p), phase_prep(p, (float*)lds, 1)), (phase_s5_scan(p), phase_prep(p, (float*)lds, 1)))
    PHASE(5, phase_s5_b(p, lds), phase_s5_b(p, lds))
    PHASE(6, phase_s5_glu(p, lds), phase_s5_glu(p, lds))
    PHASE(7, phase_norm(p, p.out, p.in[3], MOD + 3072, MOD + 4096, HM), phase_norm(p, p.out, p.in[3], MOD + 3072, MOD + 4096, HM))
    PHASE(8, phase_peer_route(p, 0, lds), phase_peer_route(p, 0, lds))
    PHASE(9, phase_peer_apply6(p, 0, lds, dry), phase_peer_apply6(p, 0, lds, dry))
    PHASE(10, phase_nsa_proj(p, lds), phase_nsa_proj(p, lds))
    PHASE(11, (phase_nsa_cmp1(p, lds), phase_tab1(p)), (phase_nsa_cmp1(p, lds), phase_tab1(p)))
    PHASE(12, (phase_nsa_cmp2(p, lds), phase_pack6(p)), (phase_nsa_cmp2(p, lds), phase_pack6(p)))
    PHASE(13, phase_nsa_attn(p, lds, ATT_REP_CMP + opq, ATT_REP_WIN + opq, ATT_REP_SEL + opq), phase_nsa_attn(p, lds, 1 + opq, 1 + opq, 1 + opq))
    PHASE(14, phase_nsa_wo(p, lds, dry), phase_nsa_wo(p, lds, dry))
    PHASE(15, phase_norm(p, p.out, p.in[3] + D, MOD + 2 * 6144 + 3072, MOD + 2 * 6144 + 4096, HM), phase_norm(p, p.out, p.in[3] + D, MOD + 2 * 6144 + 3072, MOD + 2 * 6144 + 4096, HM))
    PHASE(16, phase_peer_route(p, 1, lds), phase_peer_route(p, 1, lds))
    PHASE(17, phase_peer_apply6(p, 1, lds, dry), phase_peer_apply6(p, 1, lds, dry))
#undef PHASE
    if (TS_PHASE >= 0 && blockIdx.x == 0 && threadIdx.x == 0) {
        const unsigned long long t0 = __builtin_amdgcn_s_memrealtime(), want = (ts_b - ts_a) * TS_MULT;
        while (__builtin_amdgcn_s_memrealtime() - t0 < want) __builtin_amdgcn_s_sleep(8);
    }
}

extern "C" void kernel_launch(void* const* d_in, const int* in_sizes, int n_in, void* d_out, int out_size, void* d_ws, size_t ws_size, hipStream_t stream) {
    static int grid_blocks = 0;
    if (!grid_blocks) {
        int dev = 0, cus = 0, per_cu = 0;
        hipGetDevice(&dev);
        hipDeviceGetAttribute(&cus, hipDeviceAttributeMultiprocessorCount, dev);
        hipOccupancyMaxActiveBlocksPerMultiprocessor(&per_cu, mega, NTHREADS, 0);
        if (per_cu > 2) per_cu = 2;
        if (per_cu < 1) per_cu = 1;
        grid_blocks = cus * per_cu;
        if (ws_size < WS_END) fprintf(stderr, "kernel_launch: workspace too small: %zu < %zu\n", ws_size, (size_t)WS_END);
        if (n_in != 29) fprintf(stderr, "kernel_launch: expected 29 inputs, got %d\n", n_in);
    }
    hipMemsetAsync((unsigned char*)d_ws + WS_CTL, 0, 16384, stream);
    Params p{};
    for (int i = 0; i < 29; ++i) p.in[i] = (const float*)d_in[i];
    p.out = (float*)d_out; p.ws = (unsigned char*)d_ws;
#if SINGLE_LAUNCH
    p.ph_lo = 0; p.ph_hi = NPHASES;
    void* args[] = {&p};
    hipError_t e = hipLaunchCooperativeKernel((void*)mega, dim3(grid_blocks), dim3(NTHREADS), args, 0, stream);
    if (e != hipSuccess) fprintf(stderr, "cooperative launch failed: %s (grid %d)\n", hipGetErrorString(e), grid_blocks);
#else
    for (int ph = 0; ph < NPHASES; ++ph) {
        p.ph_lo = ph; p.ph_hi = ph + 1;
        hipLaunchKernelGGL(mega, dim3(grid_blocks), dim3(NTHREADS), 0, stream, p);
    }
#endif
}
```

```cpp
#include <hip/hip_runtime.h>
#include <hip/hip_cooperative_groups.h>
#include <cstdio>
#include <cstdint>
namespace cg = cooperative_groups;

#ifndef SINGLE_LAUNCH
#define SINGLE_LAUNCH 1
#endif

typedef unsigned short bf16_t;
typedef short bf16x8 __attribute__((ext_vector_type(8)));
typedef float f32x4 __attribute__((ext_vector_type(4)));
typedef float f32x2 __attribute__((ext_vector_type(2)));
typedef unsigned u32x4 __attribute__((ext_vector_type(4)));
typedef unsigned u32x2 __attribute__((ext_vector_type(2)));
typedef __bf16 bf16x2_t __attribute__((ext_vector_type(2)));
typedef float v32f __attribute__((ext_vector_type(32)));
typedef float v16f __attribute__((ext_vector_type(16)));
typedef unsigned v6u __attribute__((ext_vector_type(6)));
typedef int v8i __attribute__((ext_vector_type(8)));
typedef float v2f __attribute__((ext_vector_type(2)));
typedef unsigned v16u __attribute__((ext_vector_type(16)));

constexpr int D = 1024, BATCH = 2, SEQ = 16384, T = BATCH * SEQ;
constexpr int NTHREADS = 256;
constexpr float RMS_EPS = 1e-6f;
constexpr int S5G = 64, S5P = 64, S5L = 32, S5NCH = T / S5L  , S5CPB = SEQ / S5L  ;
constexpr int NH = 16, HD = 64, NG = 4, NPROJ = 2608, NPROJ_PAD = 2688, NC = 1023, NSB = 256;
constexpr int PH = 8, PK = 16, PNK = 128, PE = 16384;

constexpr size_t MiB = 1ull << 20;
constexpr size_t WS_CTL = 0;
constexpr size_t WS_MOD = 1 * MiB;
constexpr size_t WS_WIN_T = 2 * MiB;
constexpr size_t WS_WGLU_T = 4 * MiB;
constexpr size_t WS_WPROJ_T = 8 * MiB;
constexpr size_t WS_WK1_T = 14 * MiB;
constexpr size_t WS_WV1_T = 15 * MiB;
constexpr size_t WS_WK2_T = 16 * MiB;
constexpr size_t WS_WV2_T = 16 * MiB + 512 * 1024;
constexpr size_t WS_WO_T = 17 * MiB;
constexpr size_t WS_WQ_T = 19 * MiB;
constexpr size_t WS_SUBK = 27 * MiB;
constexpr size_t WS_ROPE = 28 * MiB;
constexpr size_t WS_MISC = 32 * MiB;
constexpr size_t WS_TW = 33 * MiB;
constexpr size_t WS_VG = 73 * MiB;
constexpr size_t WS_PU = 98 * MiB;
constexpr size_t WS_PV = 99 * MiB;
constexpr size_t WS_XB = 33 * MiB;
constexpr int PROW = 1024;
constexpr size_t WS_HM = 146 * MiB;
constexpr size_t WS_C = 210 * MiB;
constexpr size_t WS_UG = WS_C;
constexpr size_t WS_YI = WS_C + 64 * MiB;
constexpr size_t WS_WST = WS_C + 128 * MiB;
constexpr size_t WS_SST = WS_C + 160 * MiB;
constexpr size_t WS_YG = WS_C + 176 * MiB;
constexpr size_t WS_QK = WS_C;
constexpr size_t WS_TOPS = WS_C + 128 * MiB;
constexpr size_t WS_TOPI = WS_C + 160 * MiB;
constexpr size_t WS_EXP = WS_C + 192 * MiB;
constexpr size_t WS_GATE = WS_C + 208 * MiB;
constexpr size_t WS_ACT = WS_C + 224 * MiB;
constexpr size_t WS_Q = WS_C;
constexpr size_t WS_KC = WS_C + 64 * MiB;
constexpr size_t WS_VC = WS_C + 81 * MiB;
constexpr size_t WS_KS = WS_C + 98 * MiB;
constexpr size_t WS_VST = WS_C + 114 * MiB;
constexpr size_t WS_KW = WS_C + 130 * MiB;
constexpr size_t WS_VWT = WS_C + 146 * MiB;
constexpr size_t WS_NG = WS_C + 162 * MiB;
constexpr size_t WS_KCMP = WS_C + 170 * MiB;
constexpr size_t WS_VCMPT = WS_C + 171 * MiB;
constexpr size_t WS_HID = WS_C + 172 * MiB;
constexpr size_t WS_O = WS_C + 182 * MiB;
constexpr size_t WS_KSB = WS_O;
constexpr size_t WS_VSB = WS_O + 16 * MiB;
constexpr size_t WS_Q8 = WS_C + 246 * MiB;
constexpr size_t WS_END = WS_C + 282 * MiB;

constexpr int LDS_BYTES = 74240;

struct Params {
    const float* in[29];
    float* out;
    unsigned char* ws;
    int ph_lo, ph_hi;
};

__device__ __forceinline__ unsigned f2bf(float f) { unsigned u = __builtin_bit_cast(unsigned, f); return (u + 0x7fffu + ((u >> 16) & 1u)) >> 16; }
__device__ __forceinline__ unsigned pk2(float lo, float hi) { return f2bf(lo) | (f2bf(hi) << 16); }
__device__ __forceinline__ float bf2f(unsigned h) { return __builtin_bit_cast(float, h << 16); }
__device__ __forceinline__ float bflo(unsigned w) { return __builtin_bit_cast(float, w << 16); }
__device__ __forceinline__ float bfhi(unsigned w) { return __builtin_bit_cast(float, w & 0xffff0000u); }
__device__ __forceinline__ float gelu_tanh(float x) {
    const float u = 0.7978845608028654f * (x + 0.044715f * x * x * x);
    const float e = __expf(2.0f * u);
    const float th = 1.0f - 2.0f / (e + 1.0f);
    return 0.5f * x * (1.0f + th);
}
__device__ __forceinline__ float sigmoidf_(float x) { return 1.0f / (1.0f + __expf(-x)); }
__device__ __forceinline__ float wave_sum(float v) {
#pragma unroll
    for (int o = 1; o < 64; o <<= 1) v += __shfl_xor(v, o);
    return v;
}
__device__ __forceinline__ float dot2bf(unsigned a, unsigned b, float acc) {
    return __builtin_amdgcn_fdot2_f32_bf16(__builtin_bit_cast(bf16x2_t, a), __builtin_bit_cast(bf16x2_t, b), acc, false);
}

#define LAS __attribute__((address_space(3)))
#define XB_TMO      128
#define XB_XCNT(j)  (256  + 64 * (j))
#define XB_XSUB(j)  (1280 + 64 * (j))
#define XB_XGEN(j)  (2304 + 64 * (j))
#define XB_TOP      3328
#define XB_TOPGEN   3392
#define XCD_BAR_WORDS 3456
#define XB_SPIN_CAP (1u << 24)

__device__ __forceinline__ unsigned xb_ld(unsigned* p)              { return __hip_atomic_load(p, __ATOMIC_RELAXED, __HIP_MEMORY_SCOPE_AGENT); }
__device__ __forceinline__ unsigned xb_add(unsigned* p, unsigned v) { return __hip_atomic_fetch_add(p, v, __ATOMIC_RELAXED, __HIP_MEMORY_SCOPE_AGENT); }
__device__ __forceinline__ unsigned xb_xcc_id() { return (unsigned)__builtin_amdgcn_s_getreg((3 << 11) | 20) & 0xFu; }
#define XB_SPIN(cond, bar) do { unsigned _sp = 0; while (cond) { __builtin_amdgcn_s_sleep(1); \
    if ((++_sp & 255u) == 0u) { if (xb_ld(&(bar)[XB_TMO])) break; if (_sp > XB_SPIN_CAP) { atomicAdd(&(bar)[XB_TMO], 1u); break; } } } } while (0)

struct XcdBarrier {
    unsigned* bar; unsigned x;
    volatile LAS unsigned* st;
};

__device__ __forceinline__ XcdBarrier xcd_barrier_post(unsigned* bar, volatile LAS unsigned* st) {
    XcdBarrier b; b.bar = bar; b.x = xb_xcc_id(); b.st = st;
    if (threadIdx.x == 0) (void)xb_add(&bar[XB_XCNT(b.x)], 1u);
    return b;
}
__device__ __forceinline__ void xcd_barrier_complete(unsigned* bar, unsigned x, unsigned& nloc, unsigned& nx) {
    const unsigned G = gridDim.x * gridDim.y * gridDim.z;
    unsigned sum, cnt, mine, sp = 0u;
    for (;;) {
        sum = 0u; cnt = 0u; mine = 0u;
#pragma unroll
        for (unsigned j = 0; j < 16; ++j) { const unsigned c = xb_ld(&bar[XB_XCNT(j)]); sum += c; cnt += (c > 0u) ? 1u : 0u; mine = (j == x) ? c : mine; }
        if (sum == G) break;
        __builtin_amdgcn_s_sleep(1);
        if ((++sp & 255u) == 0u) { if (xb_ld(&bar[XB_TMO])) break; if (sp > XB_SPIN_CAP) { atomicAdd(&bar[XB_TMO], 1u); break; } }
    }
    nloc = mine > 0u ? mine : 1u; nx = cnt > 0u ? cnt : 1u;
}

__device__ __forceinline__ void xcd_barrier(const XcdBarrier& b) {
    asm volatile("s_waitcnt vmcnt(0)" ::: "memory");
    __syncthreads();
    if (threadIdx.x == 0) {
        unsigned* bar = b.bar;
        __builtin_amdgcn_s_waitcnt(0);
        unsigned nloc = b.st[0], nx = b.st[1];
        if (nloc == 0u) { xcd_barrier_complete(bar, b.x, nloc, nx); b.st[0] = nloc; b.st[1] = nx; }
        const unsigned old = xb_add(&bar[XB_XSUB(b.x)], 1u);
        const unsigned gen = old / nloc;
        if (old + 1u == (gen + 1u) * nloc) {
            __builtin_amdgcn_fence(__ATOMIC_RELEASE, "agent");
            asm volatile("s_waitcnt vmcnt(0)" ::: "memory");
            const unsigned og = xb_add(&bar[XB_TOP], 1u);
            const unsigned tg = og / nx;
            if (og + 1u == (tg + 1u) * nx) xb_add(&bar[XB_TOPGEN], 1u);
            else XB_SPIN(xb_ld(&bar[XB_TOPGEN]) == tg, bar);
            __builtin_amdgcn_fence(__ATOMIC_ACQUIRE, "agent");
            xb_add(&bar[XB_XGEN(b.x)], 1u);
            asm volatile("s_waitcnt vmcnt(0)" ::: "memory");
        } else {
            XB_SPIN(xb_ld(&bar[XB_XGEN(b.x)]) == gen, bar);
            __builtin_amdgcn_fence(__ATOMIC_ACQUIRE, "agent");
            asm volatile("s_waitcnt vmcnt(0)" ::: "memory");
        }
    }
    __syncthreads();
}
__device__ __forceinline__ void prep_mod_item(const Params& p, int item, float* lds) {
    const int layer = item / 192, cg0 = (item % 192) * 32;
    const int tid = threadIdx.x, col = cg0 + (tid & 31), kg = tid >> 5;
    const float* W = p.in[4] + (size_t)layer * D * 6 * D + col;
    const float* c = p.in[1];
    float* cact = lds + 512;
#pragma unroll
    for (int i = 0; i < 8; ++i) { const int q = tid + 256 * i; const float v = c[q]; cact[q] = v * sigmoidf_(v); }
    __syncthreads();
    float a0 = 0.f, a1 = 0.f;
    for (int k0 = kg * 128; k0 < kg * 128 + 128; k0 += 16) {
        float w[16];
#pragma unroll
        for (int u = 0; u < 16; ++u) w[u] = W[(size_t)(k0 + u) * (6 * D)];
#pragma unroll
        for (int u = 0; u < 16; ++u) { a0 += w[u] * cact[k0 + u]; a1 += w[u] * cact[1024 + k0 + u]; }
    }
    lds[tid] = a0; lds[256 + tid] = a1;
    __syncthreads();
    if (tid < 64) {
        const int b = tid >> 5, cc = tid & 31;
        float s = 0.f;
#pragma unroll
        for (int g = 0; g < 8; ++g) s += lds[b * 256 + g * 32 + cc];
        float* MOD = (float*)(p.ws + WS_MOD);
        MOD[(size_t)(layer * 2 + b) * 6144 + cg0 + cc] = s + p.in[5][(size_t)layer * 6144 + cg0 + cc];
    }
    __syncthreads();
}

template <int MODE>
__device__ __forceinline__ void prep_transpose_item(const float* W, int K, int N, bf16_t* WT, int item, float* lds) {
    const int nbn = (N + 63) / 64, kb = item / nbn, nb = item % nbn, k0 = kb * 64, n0 = nb * 64;
    const int tid = threadIdx.x;
#pragma unroll
    for (int i = 0; i < 16; ++i) {
        const int kk = (tid >> 6) + 4 * i, nn = tid & 63;
        const float v = (n0 + nn < N) ? W[(size_t)(k0 + kk) * N + n0 + nn] : 0.f;
        lds[kk * 65 + nn] = v;
    }
    __syncthreads();
    {
        const int nn = tid >> 2, ks = (tid & 3) * 16;
        const int n = n0 + nn;
        if (n < N) {
            int np = n;
            if (MODE == 1) { const int j = (n < 1024) ? n : n - 1024; np = (j >> 4) * 32 + (j & 15) + ((n < 1024) ? 0 : 16); }
            u32x4 o0, o1;
            const float* s = lds + nn;
            o0.x = pk2(s[(ks + 0) * 65], s[(ks + 1) * 65]); o0.y = pk2(s[(ks + 2) * 65], s[(ks + 3) * 65]);
            o0.z = pk2(s[(ks + 4) * 65], s[(ks + 5) * 65]); o0.w = pk2(s[(ks + 6) * 65], s[(ks + 7) * 65]);
            o1.x = pk2(s[(ks + 8) * 65], s[(ks + 9) * 65]); o1.y = pk2(s[(ks + 10) * 65], s[(ks + 11) * 65]);
            o1.z = pk2(s[(ks + 12) * 65], s[(ks + 13) * 65]); o1.w = pk2(s[(ks + 14) * 65], s[(ks + 15) * 65]);
            u32x4* dst = (u32x4*)(WT + (size_t)np * K + k0 + ks);
            dst[0] = o0; dst[1] = o1;
        }
    }
    __syncthreads();
}

__device__ __forceinline__ void cvt_item(const float* src, bf16_t* dst, int item) {
    const size_t base = (size_t)item * 8192 + threadIdx.x * 8;
#pragma unroll
    for (int i = 0; i < 4; ++i) {
        const size_t o = base + (size_t)i * 2048;
        const f32x4 a = *(const f32x4*)(src + o), b = *(const f32x4*)(src + o + 4);
        u32x4 w; w.x = pk2(a.x, a.y); w.y = pk2(a.z, a.w); w.z = pk2(b.x, b.y); w.w = pk2(b.z, b.w);
        *(u32x4*)(dst + o) = w;
    }
}
__device__ __forceinline__ void zero_item(bf16_t* dst, int item) {
    const size_t base = (size_t)item * 8192 + threadIdx.x * 8;
#pragma unroll
    for (int i = 0; i < 4; ++i) *(u32x4*)(dst + base + (size_t)i * 2048) = (u32x4){0u, 0u, 0u, 0u};
}

struct cpx { float re, im; };
__device__ __forceinline__ cpx cmul(cpx a, cpx b) { return {a.re * b.re - a.im * b.im, a.re * b.im + a.im * b.re}; }
__device__ __forceinline__ cpx cexp_pow(float are, float aim, float dt, int m) {
    const float mag = __expf(are * dt * (float)m);
    const double rev = (double)aim * (double)dt * (double)m * 0.15915494309189535;
    const float fr = (float)(rev - rint(rev));
    return {mag * __builtin_amdgcn_cosf(fr), mag * __builtin_amdgcn_sinf(fr)};
}
__device__ __forceinline__ cpx s5_coef(float are, float aim, float dt) {
    cpx ab = cexp_pow(are, aim, dt, 1);
    const float nr = ab.re - 1.0f, ni = ab.im, den = are * are + aim * aim;
    return {(nr * are + ni * aim) / den, (ni * are - nr * aim) / den};
}

__device__ __forceinline__ void prep_s5_T_item(const Params& p, int item) {
    const int gid = item * 256 + threadIdx.x;
    const int g = gid >> 9, m = (gid >> 4) & 31, i = gid & 15;
    const float* a_re = p.in[7] + g * 64; const float* a_im = p.in[8] + g * 64;
    const float dt = __expf(p.in[9][g]);
    const float* b_re = p.in[10] + (size_t)g * 64 * 16; const float* b_im = p.in[11] + (size_t)g * 64 * 16;
    const float* c_re = p.in[12] + (size_t)g * 16 * 64 + i * 64; const float* c_im = p.in[13] + (size_t)g * 16 * 64 + i * 64;
    float acc[16];
#pragma unroll
    for (int j = 0; j < 16; ++j) acc[j] = 0.f;
    for (int q = 0; q < 64; ++q) {
        const float are = a_re[q], aim = a_im[q];
        cpx z = cmul(cmul({c_re[q], c_im[q]}, cexp_pow(are, aim, dt, m)), s5_coef(are, aim, dt));
        const f32x4* br = (const f32x4*)(b_re + q * 16); const f32x4* bi = (const f32x4*)(b_im + q * 16);
#pragma unroll
        for (int j4 = 0; j4 < 4; ++j4) {
            const f32x4 r = br[j4], im = bi[j4];
            acc[j4 * 4 + 0] += z.re * r.x - z.im * im.x; acc[j4 * 4 + 1] += z.re * r.y - z.im * im.y;
            acc[j4 * 4 + 2] += z.re * r.z - z.im * im.z; acc[j4 * 4 + 3] += z.re * r.w - z.im * im.w;
        }
    }
    u32x4 o0, o1;
    o0.x = pk2(acc[0], acc[1]); o0.y = pk2(acc[2], acc[3]); o0.z = pk2(acc[4], acc[5]); o0.w = pk2(acc[6], acc[7]);
    o1.x = pk2(acc[8], acc[9]); o1.y = pk2(acc[10], acc[11]); o1.z = pk2(acc[12], acc[13]); o1.w = pk2(acc[14], acc[15]);
    bf16_t* TW = (bf16_t*)(p.ws + WS_TW) + (size_t)g * 640 * 512;
    const u32x4 z4 = (u32x4){0u, 0u, 0u, 0u};
    for (int lp = 0; lp + m < 32; ++lp) {
        u32x4* d = (u32x4*)(TW + (size_t)((lp + m) * 16 + i) * 512 + lp * 16);
        d[0] = o0; d[1] = o1;
        if (m > 0) { u32x4* dz = (u32x4*)(TW + (size_t)(lp * 16 + i) * 512 + (lp + m) * 16); dz[0] = z4; dz[1] = z4; }
    }
}
__device__ __forceinline__ void prep_s5_W_item(const Params& p, int item) {
    const int gid = item * 256 + threadIdx.x;
    const int g = gid >> 11, q = (gid >> 5) & 63, lp = gid & 31;
    const float are = p.in[7][g * 64 + q], aim = p.in[8][g * 64 + q];
    const float dt = __expf(p.in[9][g]);
    const cpx z = cmul(cexp_pow(are, aim, dt, 31 - lp), s5_coef(are, aim, dt));
    const float* br = p.in[10] + ((size_t)g * 64 + q) * 16; const float* bi = p.in[11] + ((size_t)g * 64 + q) * 16;
    float wr[16], wi[16];
#pragma unroll
    for (int j = 0; j < 16; ++j) { wr[j] = z.re * br[j] - z.im * bi[j]; wi[j] = z.re * bi[j] + z.im * br[j]; }
    bf16_t* TW = (bf16_t*)(p.ws + WS_TW) + (size_t)g * 640 * 512;
    u32x4* d0 = (u32x4*)(TW + (size_t)(512 + q) * 512 + lp * 16);
    u32x4* d1 = (u32x4*)(TW + (size_t)(576 + q) * 512 + lp * 16);
    d0[0] = (u32x4){pk2(wr[0], wr[1]), pk2(wr[2], wr[3]), pk2(wr[4], wr[5]), pk2(wr[6], wr[7])};
    d0[1] = (u32x4){pk2(wr[8], wr[9]), pk2(wr[10], wr[11]), pk2(wr[12], wr[13]), pk2(wr[14], wr[15])};
    d1[0] = (u32x4){pk2(wi[0], wi[1]), pk2(wi[2], wi[3]), pk2(wi[4], wi[5]), pk2(wi[6], wi[7])};
    d1[1] = (u32x4){pk2(wi[8], wi[9]), pk2(wi[10], wi[11]), pk2(wi[12], wi[13]), pk2(wi[14], wi[15])};
}
__device__ __forceinline__ void prep_s5_V_item(const Params& p, int item) {
    const int gid = item * 256 + threadIdx.x;
    const int g = gid >> 14, l = (gid >> 9) & 31, i = (gid >> 5) & 15, q0 = (gid & 31) * 2;
    const float dt = __expf(p.in[9][g]);
    float vr[2], vi[2];
#pragma unroll
    for (int e = 0; e < 2; ++e) {
        const int q = q0 + e;
        const cpx z = cmul({p.in[12][((size_t)g * 16 + i) * 64 + q], p.in[13][((size_t)g * 16 + i) * 64 + q]}, cexp_pow(p.in[7][g * 64 + q], p.in[8][g * 64 + q], dt, l + 1));
        vr[e] = z.re; vi[e] = -z.im;
    }
    bf16_t* VG = (bf16_t*)(p.ws + WS_VG) + ((size_t)g * 512 + l * 16 + i) * 128;
    *(unsigned*)(VG + q0) = pk2(vr[0], vr[1]);
    *(unsigned*)(VG + 64 + q0) = pk2(vi[0], vi[1]);
}
__device__ __forceinline__ void prep_al_item(const Params& p, int item) {
    const int gid = item * 256 + threadIdx.x;
    const int g = gid >> 6;
    const float dt = __expf(p.in[9][g]);
    const cpx z = cexp_pow(p.in[7][gid], p.in[8][gid], dt, S5L);
    f32x2* AL = (f32x2*)(p.ws + WS_MISC + 4096);
    AL[gid] = (f32x2){z.re, z.im};
}
__device__ __forceinline__ void prep_rope_item(const Params& p, int item) {
    const int gid = item * 256 + threadIdx.x;
    const int pos = gid >> 5, j = gid & 31;
    const float freq = exp2f(-(float)j * (13.287712379549449f / 32.0f));
    const float ang = (float)pos * freq;
    const double rev = (double)ang * 0.15915494309189535;
    const float fr = (float)(rev - rint(rev));
    f32x2* R = (f32x2*)(p.ws + WS_ROPE);
    R[gid] = (f32x2){__builtin_amdgcn_cosf(fr), __builtin_amdgcn_sinf(fr)};
}
__device__ __forceinline__ void prep_cmpbias_item(const Params& p, int item, float* lds) {
    const int kv = item >> 3, cg0 = (item & 7) * 32;
    const float* pe = p.in[17 + kv]; const float* w1 = p.in[kv == 0 ? 19 : 21];
    const int tid = threadIdx.x, col = cg0 + (tid & 31), kg = tid >> 5;
    float s = 0.f;
#pragma unroll 8
    for (int k = kg * 256; k < kg * 256 + 256; ++k) s += pe[k] * w1[(size_t)k * 256 + col];
    lds[tid] = s;
    __syncthreads();
    if (tid < 32) {
        float t = 0.f;
#pragma unroll
        for (int q = 0; q < 8; ++q) t += lds[q * 32 + tid];
        ((float*)(p.ws + WS_MISC))[kv * 256 + cg0 + tid] = t;
    }
    __syncthreads();
}

__device__ __forceinline__ void cvt_fp8_item(const float* src, unsigned char* dst, float* inv_scale, int item, const bool slice_major) {
    const int lane = threadIdx.x & 63, row0 = item * 16 + (threadIdx.x >> 6) * 4;
    f32x4 v[4][4];
#pragma unroll
    for (int r = 0; r < 4; ++r) {
        const f32x4* sp = (const f32x4*)(src + (size_t)(row0 + r) * D + lane * 16);
#pragma unroll
        for (int q = 0; q < 4; ++q) v[r][q] = sp[q];
    }
#pragma unroll
    for (int r = 0; r < 4; ++r) {
        float m = 0.f;
#pragma unroll
        for (int q = 0; q < 4; ++q) m = fmaxf(m, fmaxf(fmaxf(fabsf(v[r][q].x), fabsf(v[r][q].y)), fmaxf(fabsf(v[r][q].z), fabsf(v[r][q].w))));
#pragma unroll
        for (int o = 1; o < 64; o <<= 1) m = fmaxf(m, __shfl_xor(m, o));
        const float sc = m > 0.f ? 224.0f / m : 1.0f;
        unsigned w[4];
#pragma unroll
        for (int q = 0; q < 4; ++q) { int t = 0; t = __builtin_amdgcn_cvt_pk_fp8_f32(v[r][q].x * sc, v[r][q].y * sc, t, false); t = __builtin_amdgcn_cvt_pk_fp8_f32(v[r][q].z * sc, v[r][q].w * sc, t, true); w[q] = (unsigned)t; }
        const int row = row0 + r;
        const u32x4 wv = (u32x4){w[0], w[1], w[2], w[3]};
        if (slice_major) *(u32x4*)(dst + (size_t)(lane >> 3) * (PE * 128) + (size_t)row * 128 + (lane & 7) * 16) = wv;
        else *(u32x4*)(dst + (size_t)row * D + lane * 16) = wv;
        if (lane == 0) inv_scale[row] = m > 0.f ? m / 224.0f : 1.0f;
    }
}
__device__ __forceinline__ void cvt_fp6_item(const float* src, unsigned char* dst, float* inv_scale, int item, int rec_off = 0) {
    const int lane = threadIdx.x & 63, half = lane >> 5, gl = lane & 31, row0 = item * 16 + (threadIdx.x >> 6) * 4;
#pragma unroll
    for (int pr = 0; pr < 2; ++pr) {
        const int row = row0 + pr * 2 + half;
        const f32x4* sp = (const f32x4*)(src + (size_t)row * D + gl * 32);
        f32x4 v[8];
#pragma unroll
        for (int q = 0; q < 8; ++q) v[q] = sp[q];
        float m = 0.f;
#pragma unroll
        for (int q = 0; q < 8; ++q) m = fmaxf(m, fmaxf(fmaxf(fabsf(v[q].x), fabsf(v[q].y)), fmaxf(fabsf(v[q].z), fabsf(v[q].w))));
#pragma unroll
        for (int o = 1; o < 32; o <<= 1) m = fmaxf(m, __shfl_xor(m, o));
        const float sc = m > 0.f ? 7.5f / m : 1.0f;
        v16f x0, x1;
#pragma unroll
        for (int q = 0; q < 8; ++q) {
            x0[q * 2 + 0] = v[q].x * sc; x1[q * 2 + 0] = v[q].y * sc; x0[q * 2 + 1] = v[q].z * sc; x1[q * 2 + 1] = v[q].w * sc;
        }
        const v6u w = __builtin_amdgcn_cvt_scalef32_2xpk16_fp6_f32(x0, x1, 1.0f);
        u32x2* dp = (u32x2*)(dst + (size_t)row * PROW + rec_off + gl * 24);
        dp[0] = (u32x2){w[0], w[1]}; dp[1] = (u32x2){w[2], w[3]}; dp[2] = (u32x2){w[4], w[5]};
        if (gl == 0) inv_scale[row] = m > 0.f ? m / 7.5f : 1.0f;
    }
}
__device__ __forceinline__ void cvt_fp4_item(const float* src, unsigned char* dst, float* inv_scale, int item, int rec_off) {
    const int lane = threadIdx.x & 63, half = lane >> 5, gl = lane & 31, row0 = item * 16 + (threadIdx.x >> 6) * 4;
#pragma unroll
    for (int pr = 0; pr < 2; ++pr) {
        const int row = row0 + pr * 2 + half;
        const f32x4* sp = (const f32x4*)(src + (size_t)row * D + gl * 32);
        f32x4 v[8];
#pragma unroll
        for (int q = 0; q < 8; ++q) v[q] = sp[q];
        float m = 0.f;
#pragma unroll
        for (int q = 0; q < 8; ++q) m = fmaxf(m, fmaxf(fmaxf(fabsf(v[q].x), fabsf(v[q].y)), fmaxf(fabsf(v[q].z), fabsf(v[q].w))));
#pragma unroll
        for (int o = 1; o < 32; o <<= 1) m = fmaxf(m, __shfl_xor(m, o));
        const float sc = m > 0.f ? 6.0f / m : 1.0f;
        u32x4 w = (u32x4){0u, 0u, 0u, 0u};
#define F4_PACK2(qa_, qb_, dw_) do { unsigned d_ = 0u; \
            d_ = __builtin_amdgcn_cvt_scalef32_pk_fp4_f32(d_, v[qa_].x * sc, v[qa_].y * sc, 1.0f, 0); d_ = __builtin_amdgcn_cvt_scalef32_pk_fp4_f32(d_, v[qa_].z * sc, v[qa_].w * sc, 1.0f, 1); \
            d_ = __builtin_amdgcn_cvt_scalef32_pk_fp4_f32(d_, v[qb_].x * sc, v[qb_].y * sc, 1.0f, 2); d_ = __builtin_amdgcn_cvt_scalef32_pk_fp4_f32(d_, v[qb_].z * sc, v[qb_].w * sc, 1.0f, 3); \
            w[dw_] = d_; } while (0)
        F4_PACK2(0, 1, 0); F4_PACK2(2, 3, 1); F4_PACK2(4, 5, 2); F4_PACK2(6, 7, 3);
#undef F4_PACK2
        *(u32x4*)(dst + (size_t)row * PROW + rec_off + gl * 16) = w;
        if (gl == 0) inv_scale[row] = m > 0.f ? m / 6.0f : 1.0f;
    }
}
constexpr int P0_MOD = 384;
constexpr int P0_T_WIN = 16 * 16, P0_T_WGLU = 16 * 32, P0_T_WPROJ = 16 * 41, P0_T_WK1 = 32 * 4, P0_T_WK2 = 4 * 1, P0_T_WO = 16 * 16, P0_T_WQ = 16 * 32;
constexpr int P0_SUBK = (2 * 8 * 2 * 128 * 128) / 8192;
constexpr int P0_TAB = PE / 16;
constexpr int P0_S5T = 128, P0_S5W = 512, P0_S5V = 4096, P0_AL = 16, P0_ROPE = 2048, P0_CB = 16, P0_ZERO = 10 + 2;

__device__ __forceinline__ void phase_prep(const Params& p, float* lds, const int part) {
    const int n0 = P0_MOD;
    const int n1 = n0 + P0_T_WIN, n2 = n1 + P0_T_WGLU, n3 = n2 + P0_T_WPROJ, n4 = n3 + P0_T_WK1, n5 = n4 + P0_T_WK1, n6 = n5 + P0_T_WK2, n7 = n6 + P0_T_WK2,
              n8 = n7 + P0_T_WO, n9 = n8 + P0_T_WQ, n10 = n9 + P0_T_WQ, n11 = n10 + P0_SUBK, n12 = n11 + P0_TAB, n13 = n12 + P0_TAB,
              n14 = n13 + P0_S5T, n15 = n14 + P0_S5W, n16 = n15 + P0_S5V, n17 = n16 + P0_AL, n18 = n17 + P0_ROPE, n19 = n18 + P0_CB, n20 = n19 + 10, n21 = n20 + 2, n22 = n21 + 2;
    unsigned char* ws = p.ws;
#ifndef PREP_DUP_LO
#define PREP_DUP_LO 0
#define PREP_DUP_HI 0
#endif
    const int dupn = (PREP_DUP_HI) - (PREP_DUP_LO);
    const int nB = (n8 - n2) + (n10 - n9) + (n22 - n17);
    const int first = part == 0 ? (int)blockIdx.x : (int)blockIdx.x - 32, stride = part == 0 ? (int)gridDim.x : (int)gridDim.x - 32;
    if (first < 0 || stride <= 0) return;
    const int total = part == 0 ? (n22 - nB) + dupn : nB;
    for (int it0 = first; it0 < total; it0 += stride) {
        int it;
        if (part == 0) {
            it = it0;
            if (it >= n2) it += (n8 - n2);
            if (it >= n9) it += (n10 - n9);
            if (it0 >= (n22 - nB)) it = (PREP_DUP_LO) + (it0 - (n22 - nB));
        } else {
            it = n2 + it0;
            if (it >= n8) it += (n9 - n8);
            if (it >= n10) it += (n17 - n10);
        }
        if (it < n0) prep_mod_item(p, it, lds);
        else if (it < n1) prep_transpose_item<0>(p.in[6], 1024, 1024, (bf16_t*)(ws + WS_WIN_T), it - n0, lds);
        else if (it < n2) prep_transpose_item<1>(p.in[15], 1024, 2048, (bf16_t*)(ws + WS_WGLU_T), it - n1, lds);
        else if (it < n3) prep_transpose_item<0>(p.in[16], 1024, NPROJ, (bf16_t*)(ws + WS_WPROJ_T), it - n2, lds);
        else if (it < n4) prep_transpose_item<0>(p.in[19], 2048, 256, (bf16_t*)(ws + WS_WK1_T), it - n3, lds);
        else if (it < n5) prep_transpose_item<0>(p.in[21], 2048, 256, (bf16_t*)(ws + WS_WV1_T), it - n4, lds);
        else if (it < n6) prep_transpose_item<0>(p.in[20], 256, 64, (bf16_t*)(ws + WS_WK2_T), it - n5, lds);
        else if (it < n7) prep_transpose_item<0>(p.in[22], 256, 64, (bf16_t*)(ws + WS_WV2_T), it - n6, lds);
        else if (it < n8) prep_transpose_item<0>(p.in[23], 1024, 1024, (bf16_t*)(ws + WS_WO_T), it - n7, lds);
        else if (it < n9) prep_transpose_item<0>(p.in[24], 1024, 2048, (bf16_t*)(ws + WS_WQ_T), it - n8, lds);
        else if (it < n10) prep_transpose_item<0>(p.in[24] + (size_t)1024 * 2048, 1024, 2048, (bf16_t*)(ws + WS_WQ_T) + (size_t)2048 * 1024, it - n9, lds);
        else if (it < n11) cvt_item(p.in[25], (bf16_t*)(ws + WS_SUBK), it - n10);
        else if (it < n12) cvt_fp4_item(p.in[26], ws + WS_PU, (float*)(ws + WS_PU + 24 * MiB), it - n11, 0);
        else if (it < n13) cvt_fp4_item(p.in[27], ws + WS_PU, (float*)(ws + WS_PV + 24 * MiB), it - n12, 512);
        else if (it < n14) prep_s5_T_item(p, it - n13);
        else if (it < n15) prep_s5_W_item(p, it - n14);
        else if (it < n16) prep_s5_V_item(p, it - n15);
        else if (it < n17) prep_al_item(p, it - n16);
        else if (it < n18) prep_rope_item(p, it - n17);
        else if (it < n19) prep_cmpbias_item(p, it - n18, lds);
        else if (it < n20) zero_item((bf16_t*)(ws + WS_WPROJ_T) + (size_t)NPROJ * 1024, it - n19);
        else if (it < n21) zero_item((bf16_t*)(ws + WS_WK2_T) + (size_t)64 * 256, it - n20);
        else zero_item((bf16_t*)(ws + WS_WV2_T) + (size_t)64 * 256, it - n21);
    }
}

__device__ __forceinline__ void phase_norm(const Params& p, const float* X, const float* gw, const float* shift, const float* scale  , bf16_t* HM) {
    const int lane = threadIdx.x & 63, wave = threadIdx.x >> 6;
    const int rstep = (int)gridDim.x * 4;
    int row = blockIdx.x * 4 + wave;
    if (row >= T) return;
    f32x4 v[4], ca[4], cb[4];
    int bcur = -1;
    {
        const f32x4* xr = (const f32x4*)(X + (size_t)row * D) + lane;
#pragma unroll
        for (int j = 0; j < 4; ++j) v[j] = xr[64 * j];
    }
    for (; row < T; row += rstep) {
        const int b = row / SEQ;
        if (b != bcur) {
            bcur = b;
#pragma unroll
            for (int j = 0; j < 4; ++j) {
                const int c = lane * 4 + 256 * j;
                const f32x4 g = *(const f32x4*)(gw + c), sh = *(const f32x4*)(shift + (size_t)b * 6144 + c), sc = *(const f32x4*)(scale + (size_t)b * 6144 + c);
                ca[j] = (f32x4){g.x * (1.f + sc.x), g.y * (1.f + sc.y), g.z * (1.f + sc.z), g.w * (1.f + sc.w)}; cb[j] = sh;
            }
        }
        f32x4 w[4]; float s = 0.f;
#pragma unroll
        for (int j = 0; j < 4; ++j) { w[j] = v[j]; s += (w[j].x * w[j].x + w[j].y * w[j].y) + (w[j].z * w[j].z + w[j].w * w[j].w); }
        if (row + rstep < T) {
            const f32x4* xn = (const f32x4*)(X + (size_t)(row + rstep) * D) + lane;
#pragma unroll
            for (int j = 0; j < 4; ++j) v[j] = xn[64 * j];
        }
        const float rs = rsqrtf(wave_sum(s) * (1.0f / D) + RMS_EPS);
        u32x2* o = (u32x2*)(HM + (size_t)row * D) + lane;
#pragma unroll
        for (int j = 0; j < 4; ++j) {
            const float y0 = w[j].x * rs * ca[j].x + cb[j].x, y1 = w[j].y * rs * ca[j].y + cb[j].y;
            const float y2 = w[j].z * rs * ca[j].z + cb[j].z, y3 = w[j].w * rs * ca[j].w + cb[j].w;
            o[64 * j] = (u32x2){pk2(y0, y1), pk2(y2, y3)};
        }
    }
}
__device__ __forceinline__ void phase_norm_b(const Params& p, const bf16_t* X, const float* gw, const float* shift, const float* scale  , bf16_t* HM) {
    const int lane = threadIdx.x & 63, wave = threadIdx.x >> 6;
    const int rstep = (int)gridDim.x * 4;
    int row = blockIdx.x * 4 + wave;
    if (row >= T) return;
    f32x4 v[4], ca[4], cb[4];
    int bcur = -1;
    {
        const u32x2* xr = (const u32x2*)(X + (size_t)row * D) + lane;
#pragma unroll
        for (int j = 0; j < 4; ++j) { const u32x2 r_ = xr[64 * j]; v[j] = (f32x4){bflo(r_.x), bfhi(r_.x), bflo(r_.y), bfhi(r_.y)}; }
    }
    for (; row < T; row += rstep) {
        const int b = row / SEQ;
        if (b != bcur) {
            bcur = b;
#pragma unroll
            for (int j = 0; j < 4; ++j) {
                const int c = lane * 4 + 256 * j;
                const f32x4 g = *(const f32x4*)(gw + c), sh = *(const f32x4*)(shift + (size_t)b * 6144 + c), sc = *(const f32x4*)(scale + (size_t)b * 6144 + c);
                ca[j] = (f32x4){g.x * (1.f + sc.x), g.y * (1.f + sc.y), g.z * (1.f + sc.z), g.w * (1.f + sc.w)}; cb[j] = sh;
            }
        }
        f32x4 w[4]; float s = 0.f;
#pragma unroll
        for (int j = 0; j < 4; ++j) { w[j] = v[j]; s += (w[j].x * w[j].x + w[j].y * w[j].y) + (w[j].z * w[j].z + w[j].w * w[j].w); }
        if (row + rstep < T) {
            const u32x2* xn = (const u32x2*)(X + (size_t)(row + rstep) * D) + lane;
#pragma unroll
            for (int j = 0; j < 4; ++j) { const u32x2 r_ = xn[64 * j]; v[j] = (f32x4){bflo(r_.x), bfhi(r_.x), bflo(r_.y), bfhi(r_.y)}; }
        }
        const float rs = rsqrtf(wave_sum(s) * (1.0f / D) + RMS_EPS);
        u32x2* o = (u32x2*)(HM + (size_t)row * D) + lane;
#pragma unroll
        for (int j = 0; j < 4; ++j) {
            const float y0 = w[j].x * rs * ca[j].x + cb[j].x, y1 = w[j].y * rs * ca[j].y + cb[j].y;
            const float y2 = w[j].z * rs * ca[j].z + cb[j].z, y3 = w[j].w * rs * ca[j].w + cb[j].w;
            o[64 * j] = (u32x2){pk2(y0, y1), pk2(y2, y3)};
        }
    }
}
__device__ __forceinline__ void phase_final_norm(const Params& p, const float* X, float* OUT, bool dry) {
    const int lane = threadIdx.x & 63, wave = threadIdx.x >> 6;
    const float* gw = p.in[28];
    for (int row = blockIdx.x * 4 + wave; row < T; row += gridDim.x * 4) {
        const f32x4* xr = (const f32x4*)(X + (size_t)row * D) + lane;
        f32x4 v[4]; float s = 0.f;
#pragma unroll
        for (int j = 0; j < 4; ++j) { v[j] = xr[64 * j]; s += (v[j].x * v[j].x + v[j].y * v[j].y) + (v[j].z * v[j].z + v[j].w * v[j].w); }
        const float rs = rsqrtf(wave_sum(s) * (1.0f / D) + RMS_EPS);
        f32x4* o = (f32x4*)(OUT + (size_t)row * D) + lane;
#pragma unroll
        for (int j = 0; j < 4; ++j) {
            const f32x4 g = *(const f32x4*)(gw + lane * 4 + 256 * j);
            if (!dry) o[64 * j] = (f32x4){v[j].x * rs * g.x, v[j].y * rs * g.y, v[j].z * rs * g.z, v[j].w * rs * g.w};
        }
    }
}

__device__ __forceinline__ int vblock() { const int G = gridDim.x, bx = blockIdx.x; return (G % 8 == 0) ? (bx % 8) * (G / 8) + bx / 8 : bx; }
struct ALoadPlain {
    const bf16_t* A; size_t lda;
    __device__ __forceinline__ const bf16_t* base(int kt) const { return A + kt * 64; }
    __device__ __forceinline__ unsigned off(int r, int lc) const { return (unsigned)r * (unsigned)lda + (unsigned)lc * 8u; }
};
struct ALoadGroup {
    const bf16_t* A;
    __device__ __forceinline__ const bf16_t* base(int kt) const { return A + (size_t)kt * 4 * T * 16; }
    __device__ __forceinline__ unsigned off(int r, int lc) const { return ((unsigned)(lc >> 1) * (unsigned)T + (unsigned)r) * 16u + (unsigned)(lc & 1) * 8u; }
};

template <class AL>
__device__ __forceinline__ void gemm_tile2(const AL al, const bf16_t* __restrict__ Bt, size_t ldb, int nk, f32x4 (&acc)[4][4], unsigned char* lds) {
    const int tid = threadIdx.x, lane = tid & 63, wid = tid >> 6, wr = wid >> 1, wc = wid & 1, fr = lane & 15, fq = lane >> 4;
    const int lr = tid >> 3, lc = tid & 7;
#pragma unroll
    for (int mi = 0; mi < 4; ++mi)
#pragma unroll
        for (int ni = 0; ni < 4; ++ni) acc[mi][ni] = (f32x4){0.f, 0.f, 0.f, 0.f};
    u32x4 ra0[4], rb0[4], ra1[4], rb1[4];
    const int soff = lr * 128 + ((lc ^ (lr & 7)) << 4);
    unsigned offA[4], offB[4];
#pragma unroll
    for (int i = 0; i < 4; ++i) { offA[i] = al.off(lr + 32 * i, lc); offB[i] = (unsigned)(lr + 32 * i) * (unsigned)ldb + (unsigned)lc * 8u; }
#define GT_LOAD(RA, RB, kt_) do { const bf16_t* ab_ = al.base(kt_); const bf16_t* bb_ = Bt + (kt_) * 64; _Pragma("unroll") for (int i = 0; i < 4; ++i) { RA[i] = *(const u32x4*)(ab_ + offA[i]); RB[i] = *(const u32x4*)(bb_ + offB[i]); } } while (0)
#define GT_STORE(RA, RB, buf_) do { unsigned char* nb_ = lds + (buf_) * 32768; _Pragma("unroll") for (int i = 0; i < 4; ++i) { *(u32x4*)(nb_ + soff + i * 4096) = RA[i]; *(u32x4*)(nb_ + 16384 + soff + i * 4096) = RB[i]; } } while (0)
    const int aoff = (wr * 64 + fr) * 128, boff = 16384 + (wc * 64 + fr) * 128, sw = fr & 7;
#define GT_MATH(buf_) do { const unsigned char* bp_ = lds + (buf_) * 32768; _Pragma("unroll") for (int ks = 0; ks < 2; ++ks) { bf16x8 af[4], bfr[4]; const int co = ((ks * 4 + fq) ^ sw) << 4; \
        _Pragma("unroll") for (int mi = 0; mi < 4; ++mi) af[mi] = *(const bf16x8*)(bp_ + aoff + mi * 2048 + co); \
        _Pragma("unroll") for (int ni = 0; ni < 4; ++ni) bfr[ni] = *(const bf16x8*)(bp_ + boff + ni * 2048 + co); \
        _Pragma("unroll") for (int mi = 0; mi < 4; ++mi) _Pragma("unroll") for (int ni = 0; ni < 4; ++ni) acc[mi][ni] = __builtin_amdgcn_mfma_f32_16x16x32_bf16(bfr[ni], af[mi], acc[mi][ni], 0, 0, 0); } } while (0)
    GT_LOAD(ra0, rb0, 0);
    if (nk > 1) GT_LOAD(ra1, rb1, 1);
    GT_STORE(ra0, rb0, 0);
    __syncthreads();
    for (int kt = 0; kt < nk; kt += 2) {
        if (kt + 2 < nk) GT_LOAD(ra0, rb0, kt + 2);
        __builtin_amdgcn_sched_barrier(0);
        GT_MATH(0);
        __builtin_amdgcn_sched_barrier(0);
        if (kt + 1 < nk) GT_STORE(ra1, rb1, 1);
        __syncthreads();
        if (kt + 1 >= nk) break;
        if (kt + 3 < nk) GT_LOAD(ra1, rb1, kt + 3);
        __builtin_amdgcn_sched_barrier(0);
        GT_MATH(1);
        __builtin_amdgcn_sched_barrier(0);
        if (kt + 2 < nk) GT_STORE(ra0, rb0, 0);
        __syncthreads();
    }
#undef GT_LOAD
#undef GT_STORE
#undef GT_MATH
}

template <class AL>
__device__ __forceinline__ void gemm_tile1(const AL al, const bf16_t* __restrict__ Bt, size_t ldb, int nk, f32x4 (&acc)[4][4], unsigned char* lds) {
    const int tid = threadIdx.x, lane = tid & 63, wid = tid >> 6, wr = wid >> 1, wc = wid & 1, fr = lane & 15, fq = lane >> 4;
    const int lr = tid >> 3, lc = tid & 7;
#pragma unroll
    for (int mi = 0; mi < 4; ++mi)
#pragma unroll
        for (int ni = 0; ni < 4; ++ni) acc[mi][ni] = (f32x4){0.f, 0.f, 0.f, 0.f};
    u32x4 ra[4], rb[4];
    const int soff = lr * 128 + ((lc ^ (lr & 7)) << 4);
#pragma unroll
    for (int i = 0; i < 4; ++i) { ra[i] = *(const u32x4*)(al.base(0) + al.off(lr + 32 * i, lc)); rb[i] = *(const u32x4*)(Bt + (size_t)(lr + 32 * i) * ldb + lc * 8); }
#pragma unroll
    for (int i = 0; i < 4; ++i) { *(u32x4*)(lds + soff + i * 4096) = ra[i]; *(u32x4*)(lds + 16384 + soff + i * 4096) = rb[i]; }
    __syncthreads();
    const int aoff = (wr * 64 + fr) * 128, boff = 16384 + (wc * 64 + fr) * 128, sw = fr & 7;
    for (int kt = 0; kt < nk; ++kt) {
        const bool more = (kt + 1 < nk);
        if (more) {
#pragma unroll
            for (int i = 0; i < 4; ++i) { ra[i] = *(const u32x4*)(al.base(kt + 1) + al.off(lr + 32 * i, lc)); rb[i] = *(const u32x4*)(Bt + (size_t)(lr + 32 * i) * ldb + (kt + 1) * 64 + lc * 8); }
        }
        const unsigned char* buf = lds + (kt & 1) * 32768;
#pragma unroll
        for (int ks = 0; ks < 2; ++ks) {
            bf16x8 af[4], bfr[4];
            const int co = ((ks * 4 + fq) ^ sw) << 4;
#pragma unroll
            for (int mi = 0; mi < 4; ++mi) af[mi] = *(const bf16x8*)(buf + aoff + mi * 2048 + co);
#pragma unroll
            for (int ni = 0; ni < 4; ++ni) bfr[ni] = *(const bf16x8*)(buf + boff + ni * 2048 + co);
#pragma unroll
            for (int mi = 0; mi < 4; ++mi)
#pragma unroll
                for (int ni = 0; ni < 4; ++ni) acc[mi][ni] = __builtin_amdgcn_mfma_f32_16x16x32_bf16(bfr[ni], af[mi], acc[mi][ni], 0, 0, 0);
        }
        if (more) {
            unsigned char* nb = lds + ((kt + 1) & 1) * 32768;
#pragma unroll
            for (int i = 0; i < 4; ++i) { *(u32x4*)(nb + soff + i * 4096) = ra[i]; *(u32x4*)(nb + 16384 + soff + i * 4096) = rb[i]; }
        }
        __syncthreads();
    }
}

template <class AL, bool ZERO = true>
__device__ __forceinline__ void gemm_tile3(const AL al, const bf16_t* __restrict__ Bt, size_t ldb, int nk, f32x4 (&acc)[4][4], unsigned char* lds) {
    const int tid = threadIdx.x, lane = tid & 63, wid = tid >> 6, wr = wid >> 1, wc = wid & 1, fr = lane & 15, fq = lane >> 4;
    if (ZERO) {
#pragma unroll
    for (int mi = 0; mi < 4; ++mi)
#pragma unroll
        for (int ni = 0; ni < 4; ++ni) acc[mi][ni] = (f32x4){0.f, 0.f, 0.f, 0.f};
    }
    const int srow = wid * 32 + (lane >> 3), schunk = (lane & 7) ^ ((lane >> 3) & 7);
    unsigned offA[4], offB[4];
#pragma unroll
    for (int i = 0; i < 4; ++i) { offA[i] = al.off(srow + 8 * i, schunk); offB[i] = (unsigned)(srow + 8 * i) * (unsigned)ldb + (unsigned)schunk * 8u; }
#define G3_STAGE(buf_, kt_) do { const bf16_t* ab_ = al.base(kt_); const bf16_t* bb_ = Bt + (kt_) * 64; unsigned char* lb_ = lds + (buf_) * 32768 + wid * 4096; \
        _Pragma("unroll") for (int i = 0; i < 4; ++i) { \
            __builtin_amdgcn_global_load_lds((const unsigned*)(ab_ + offA[i]), (unsigned*)(lb_ + i * 1024), 16, 0, 0); \
            __builtin_amdgcn_global_load_lds((const unsigned*)(bb_ + offB[i]), (unsigned*)(lb_ + 16384 + i * 1024), 16, 0, 0); } } while (0)
    const int aoff = (wr * 64 + fr) * 128, boff = 16384 + (wc * 64 + fr) * 128, sw = fr & 7;
    G3_STAGE(0, 0);
    __syncthreads();
    for (int kt = 0; kt < nk; ++kt) {
        if (kt + 1 < nk) G3_STAGE((kt + 1) & 1, kt + 1);
        const unsigned char* buf = lds + (kt & 1) * 32768;
#pragma unroll
        for (int ks = 0; ks < 2; ++ks) {
            bf16x8 af[4], bfr[4];
            const int co = ((ks * 4 + fq) ^ sw) << 4;
#pragma unroll
            for (int mi = 0; mi < 4; ++mi) af[mi] = *(const bf16x8*)(buf + aoff + mi * 2048 + co);
#pragma unroll
            for (int ni = 0; ni < 4; ++ni) bfr[ni] = *(const bf16x8*)(buf + boff + ni * 2048 + co);
#pragma unroll
            for (int mi = 0; mi < 4; ++mi)
#pragma unroll
                for (int ni = 0; ni < 4; ++ni) acc[mi][ni] = __builtin_amdgcn_mfma_f32_16x16x32_bf16(bfr[ni], af[mi], acc[mi][ni], 0, 0, 0);
        }
        __syncthreads();
    }
#undef G3_STAGE
}

__device__ __forceinline__ void mma_ktile(const unsigned char* buf, f32x4 (&acc)[4][4]) {
    const int tid = threadIdx.x, lane = tid & 63, wid = tid >> 6, wr = wid >> 1, wc = wid & 1, fr = lane & 15, fq = lane >> 4;
    const int aoff = (wr * 64 + fr) * 128, boff = 16384 + (wc * 64 + fr) * 128, sw = fr & 7;
#pragma unroll
    for (int ks = 0; ks < 2; ++ks) {
        bf16x8 af[4], bfr[4];
        const int co = ((ks * 4 + fq) ^ sw) << 4;
#pragma unroll
        for (int mi = 0; mi < 4; ++mi) af[mi] = *(const bf16x8*)(buf + aoff + mi * 2048 + co);
#pragma unroll
        for (int ni = 0; ni < 4; ++ni) bfr[ni] = *(const bf16x8*)(buf + boff + ni * 2048 + co);
#pragma unroll
        for (int mi = 0; mi < 4; ++mi)
#pragma unroll
            for (int ni = 0; ni < 4; ++ni) acc[mi][ni] = __builtin_amdgcn_mfma_f32_16x16x32_bf16(bfr[ni], af[mi], acc[mi][ni], 0, 0, 0);
    }
}
__device__ __forceinline__ void phase_s5_win(const Params& p, unsigned char* lds) {
    const bf16_t* HM = (const bf16_t*)(p.ws + WS_HM); const bf16_t* WT = (const bf16_t*)(p.ws + WS_WIN_T);
    bf16_t* UG = (bf16_t*)(p.ws + WS_UG);
    const int lane = threadIdx.x & 63, wid = threadIdx.x >> 6, wr = wid >> 1, wc = wid & 1, fr = lane & 15, fq = lane >> 4;
    for (int id = vblock(); id < 256 * 8; id += gridDim.x) {
        const int mt = id >> 3, nt = id & 7;
        f32x4 acc[4][4];
        gemm_tile3(ALoadPlain{HM + (size_t)mt * 128 * D, (size_t)D}, WT + (size_t)nt * 128 * D, D, 16, acc, lds);
#pragma unroll
        for (int mi = 0; mi < 4; ++mi)
#pragma unroll
            for (int ni = 0; ni < 4; ++ni) {
                const int t = mt * 128 + wr * 64 + mi * 16 + fr, g = nt * 8 + wc * 4 + ni;
                const f32x4 v = acc[mi][ni];
                *(u32x2*)(UG + ((size_t)g * T + t) * 16 + fq * 4) = (u32x2){pk2(v.x, v.y), pk2(v.z, v.w)};
            }
    }
}
__device__ __forceinline__ void phase_s5_a(const Params& p, unsigned char* lds) {
    const bf16_t* UG = (const bf16_t*)(p.ws + WS_UG); const bf16_t* TW = (const bf16_t*)(p.ws + WS_TW);
    float* WST = (float*)(p.ws + WS_WST);
    const int lane = threadIdx.x & 63, wid = threadIdx.x >> 6, wr = wid >> 1, wc = wid & 1, fr = lane & 15, fq = lane >> 4;
    for (int id = vblock(); id < 64 * 8; id += gridDim.x) {
        const int g = id >> 3, mt = id & 7;
        f32x4 acc[4][4];
        gemm_tile3(ALoadPlain{UG + (size_t)g * T * 16 + (size_t)mt * 128 * 512, (size_t)512}, TW + ((size_t)g * 640 + 512) * 512, 512, 8, acc, lds);
#pragma unroll
        for (int mi = 0; mi < 4; ++mi)
#pragma unroll
            for (int ni = 0; ni < 4; ++ni) {
                const int R = mt * 128 + wr * 64 + mi * 16 + fr, c = wc * 64 + ni * 16 + fq * 4;
                *(f32x4*)(WST + ((size_t)g * 1024 + R) * 128 + c) = acc[mi][ni];
            }
    }
}
__device__ __forceinline__ void phase_s5_scan(const Params& p) {
    const int lane = threadIdx.x & 63, wave = threadIdx.x >> 6;
    const float* WST = (const float*)(p.ws + WS_WST); bf16_t* SST = (bf16_t*)(p.ws + WS_SST);
    const f32x2* AL = (const f32x2*)(p.ws + WS_MISC + 4096);
    for (int it = blockIdx.x * 4 + wave; it < 128; it += gridDim.x * 4) {
        const int b = it >> 6, g = it & 63;
        const f32x2 al = AL[g * 64 + lane];
        float sr = 0.f, si = 0.f;
        const float* wbase = WST + ((size_t)g * 1024 + b * 512) * 128 + lane;
        bf16_t* sbase = SST + ((size_t)g * 1024 + b * 512) * 128 + lane;
        float nre[16], nim[16];
#pragma unroll
        for (int j = 0; j < 16; ++j) { nre[j] = wbase[(size_t)j * 128]; nim[j] = wbase[(size_t)j * 128 + 64]; }
        for (int n0 = 0; n0 < 512; n0 += 16) {
            float wre[16], wim[16];
#pragma unroll
            for (int j = 0; j < 16; ++j) { wre[j] = nre[j]; wim[j] = nim[j]; }
            if (n0 + 16 < 512) {
#pragma unroll
                for (int j = 0; j < 16; ++j) { nre[j] = wbase[(size_t)(n0 + 16 + j) * 128]; nim[j] = wbase[(size_t)(n0 + 16 + j) * 128 + 64]; }
            }
#pragma unroll
            for (int j = 0; j < 16; ++j) {
                sbase[(size_t)(n0 + j) * 128] = (bf16_t)f2bf(sr); sbase[(size_t)(n0 + j) * 128 + 64] = (bf16_t)f2bf(si);
                const float nr = al.x * sr - al.y * si + wre[j], ni = al.x * si + al.y * sr + wim[j];
                sr = nr; si = ni;
            }
        }
    }
}
__device__ __forceinline__ void phase_s5_b(const Params& p, unsigned char* lds) {
    const bf16_t* SST = (const bf16_t*)(p.ws + WS_SST); const bf16_t* VG = (const bf16_t*)(p.ws + WS_VG);
    const bf16_t* UG = (const bf16_t*)(p.ws + WS_UG); const bf16_t* TW = (const bf16_t*)(p.ws + WS_TW);
    bf16_t* YG = (bf16_t*)(p.ws + WS_YG);
    const float* dsk = p.in[14];
    const int lane = threadIdx.x & 63, wid = threadIdx.x >> 6, wr = wid >> 1, wc = wid & 1, fr = lane & 15, fq = lane >> 4;
    for (int id = vblock(); id < 64 * 32; id += gridDim.x) {
        const int g = id >> 5, mt = (id >> 2) & 7, nt = 3 - ((id + id / (int)gridDim.x) & 3);
        f32x4 acc[4][4];
        gemm_tile3<ALoadPlain, true>(ALoadPlain{UG + (size_t)g * T * 16 + (size_t)mt * 128 * 512, (size_t)512}, TW + ((size_t)g * 640 + nt * 128) * 512, 512, 2 * (nt + 1), acc, lds);
        gemm_tile3<ALoadPlain, false>(ALoadPlain{SST + ((size_t)g * 1024 + mt * 128) * 128, (size_t)128}, VG + ((size_t)g * 512 + nt * 128) * 128, 128, 2, acc, lds);
        const f32x4 dv = *(const f32x4*)(dsk + g * 16 + fq * 4);
#pragma unroll
        for (int mi = 0; mi < 4; ++mi)
#pragma unroll
            for (int ni = 0; ni < 4; ++ni) {
                const int R = mt * 128 + wr * 64 + mi * 16 + fr, c = nt * 128 + wc * 64 + ni * 16 + fq * 4;
                const size_t idx = ((size_t)g * 1024 + R) * 512 + c;
                const u32x2 uu = *(const u32x2*)(UG + idx);
                const f32x4 v = acc[mi][ni];
                const float y0 = gelu_tanh(v.x + dv.x * bflo(uu.x)), y1 = gelu_tanh(v.y + dv.y * bfhi(uu.x));
                const float y2 = gelu_tanh(v.z + dv.z * bflo(uu.y)), y3 = gelu_tanh(v.w + dv.w * bfhi(uu.y));
                *(u32x2*)(YG + idx) = (u32x2){pk2(y0, y1), pk2(y2, y3)};
            }
    }
}
__device__ __forceinline__ void phase_s5_glu(const Params& p, unsigned char* lds) {
    const bf16_t* YG = (const bf16_t*)(p.ws + WS_YG); const bf16_t* WT = (const bf16_t*)(p.ws + WS_WGLU_T);
    const float* MOD = (const float*)(p.ws + WS_MOD);
    const float* X = p.in[0]; bf16_t* XO = (bf16_t*)(p.ws + WS_XB);
    const int lane = threadIdx.x & 63, wid = threadIdx.x >> 6, wr = wid >> 1, wc = wid & 1, fr = lane & 15, fq = lane >> 4;
    for (int id = vblock(); id < 256 * 16; id += gridDim.x) {
        const int grp = id >> 6, wi = id & 63, mt = (grp >> 1) * 8 + (wi >> 3), nt = (grp & 1) * 8 + (wi & 7);
        f32x4 acc[4][4], xr[4][2];
#pragma unroll
        for (int mi = 0; mi < 4; ++mi)
#pragma unroll
            for (int h = 0; h < 2; ++h) xr[mi][h] = *(const f32x4*)(X + (size_t)(mt * 128 + wr * 64 + mi * 16 + fr) * D + nt * 64 + wc * 32 + h * 16 + fq * 4);
        gemm_tile3(ALoadGroup{YG + (size_t)mt * 128 * 16}, WT + (size_t)nt * 128 * D, D, 16, acc, lds);
        const int b = (mt * 128) / SEQ;
#pragma unroll
        for (int mi = 0; mi < 4; ++mi)
#pragma unroll
            for (int h = 0; h < 2; ++h) {
                const int t = mt * 128 + wr * 64 + mi * 16 + fr, j = nt * 64 + wc * 32 + h * 16 + fq * 4;
                const f32x4 a = acc[mi][2 * h], gg = acc[mi][2 * h + 1];
                const f32x4 g1 = *(const f32x4*)(MOD + (size_t)(0 * 2 + b) * 6144 + 2048 + j);
                const f32x4 xi = xr[mi][h];
                f32x4 o;
                o.x = xi.x + g1.x * (a.x * sigmoidf_(gg.x)); o.y = xi.y + g1.y * (a.y * sigmoidf_(gg.y));
                o.z = xi.z + g1.z * (a.z * sigmoidf_(gg.z)); o.w = xi.w + g1.w * (a.w * sigmoidf_(gg.w));
                *(u32x2*)(XO + (size_t)t * D + j) = (u32x2){pk2(o.x, o.y), pk2(o.z, o.w)};
            }
    }
}
__device__ __forceinline__ void phase_peer_wq(const Params& p, int layer, unsigned char* lds) {
    const bf16_t* HM = (const bf16_t*)(p.ws + WS_HM); const bf16_t* WT = (const bf16_t*)(p.ws + WS_WQ_T) + (size_t)layer * 2048 * 1024;
    bf16_t* QK = (bf16_t*)(p.ws + WS_QK);
    const int lane = threadIdx.x & 63, wid = threadIdx.x >> 6, wr = wid >> 1, wc = wid & 1, fr = lane & 15, fq = lane >> 4;
    for (int id = vblock(); id < 256 * 16; id += gridDim.x) {
        const int mt = id >> 4, nt = id & 15;
        f32x4 acc[4][4];
        gemm_tile3(ALoadPlain{HM + (size_t)mt * 128 * D, (size_t)D}, WT + (size_t)nt * 128 * D, D, 16, acc, lds);
#pragma unroll
        for (int mi = 0; mi < 4; ++mi)
#pragma unroll
            for (int ni = 0; ni < 4; ++ni) {
                const int t = mt * 128 + wr * 64 + mi * 16 + fr, c = nt * 128 + wc * 64 + ni * 16 + fq * 4;
                const f32x4 v = acc[mi][ni];
                *(u32x2*)(QK + (size_t)t * 2048 + c) = (u32x2){pk2(v.x, v.y), pk2(v.z, v.w)};
            }
    }
}
__device__ __forceinline__ void ce_(unsigned& a, unsigned& b, const bool up) { const unsigned lo = a < b ? a : b, hi = a < b ? b : a; a = up ? lo : hi; b = up ? hi : lo; }
__device__ __forceinline__ void bitonic_sort16(unsigned* x, const bool asc) {
#pragma unroll
    for (int k = 2; k <= 16; k <<= 1)
#pragma unroll
        for (int j = k >> 1; j > 0; j >>= 1)
#pragma unroll
            for (int i = 0; i < 16; ++i) { const int l = i ^ j; if (l > i) ce_(x[i], x[l], ((i & k) == 0) == asc); }
}
__device__ __forceinline__ void bitonic_merge16(unsigned* x, const bool asc) {
#pragma unroll
    for (int j = 8; j > 0; j >>= 1)
#pragma unroll
        for (int i = 0; i < 16; ++i) { const int l = i ^ j; if (l > i) ce_(x[i], x[l], asc); }
}
__device__ __forceinline__ void phase_peer_topk(const Params& p, int layer, unsigned char* lds) {
    const bf16_t* QK = (const bf16_t*)(p.ws + WS_QK); const bf16_t* SK = (const bf16_t*)(p.ws + WS_SUBK) + (size_t)layer * 8 * 2 * 128 * 128;
    float* TOPS = (float*)(p.ws + WS_TOPS); int* TOPI = (int*)(p.ws + WS_TOPI);
    float* sc = (float*)lds;
    const int tid = threadIdx.x, lane = tid & 63, wid = tid >> 6, wr = wid >> 1, wc = wid & 1, fr = lane & 15, fq = lane >> 4;
    for (int id = vblock(); id < 256 * 16; id += gridDim.x) {
        const int mt = id >> 4, hc = id & 15;
        f32x4 acc[4][4];
        gemm_tile3(ALoadPlain{QK + (size_t)mt * 128 * 2048 + hc * 128, (size_t)2048}, SK + (size_t)hc * 128 * 128, 128, 2, acc, lds);
#pragma unroll
        for (int mi = 0; mi < 4; ++mi)
#pragma unroll
            for (int ni = 0; ni < 4; ++ni) {
                const int r = wr * 64 + mi * 16 + fr, c = wc * 64 + ni * 16 + fq * 4;
                float* d = sc + r * 129 + c;
                d[0] = acc[mi][ni].x; d[1] = acc[mi][ni].y; d[2] = acc[mi][ni].z; d[3] = acc[mi][ni].w;
            }
        __syncthreads();
        {
            const int row = tid >> 1, half = tid & 1;
            unsigned x[64];
            const float* rp = sc + row * 129 + half * 64;
#pragma unroll
            for (int j = 0; j < 64; ++j) {
                const unsigned bits = __builtin_bit_cast(unsigned, rp[j]);
                const unsigned u = bits ^ ((unsigned)((int)bits >> 31) | 0x80000000u);
                x[j] = (u & 0xFFFFFF80u) | (unsigned)(127 - (half * 64 + j));
            }
            bitonic_sort16(x, true); bitonic_sort16(x + 16, false); bitonic_sort16(x + 32, true); bitonic_sort16(x + 48, false);
#pragma unroll
            for (int i = 0; i < 16; ++i) { x[i] = x[i] > x[16 + i] ? x[i] : x[16 + i]; x[32 + i] = x[32 + i] > x[48 + i] ? x[32 + i] : x[48 + i]; }
            bitonic_merge16(x, true); bitonic_merge16(x + 32, false);
#pragma unroll
            for (int i = 0; i < 16; ++i) x[i] = x[i] > x[32 + i] ? x[i] : x[32 + i];
            bitonic_merge16(x, false);
            unsigned y[16];
#pragma unroll
            for (int i = 0; i < 16; ++i) { const unsigned o = (unsigned)__shfl_xor((int)x[15 - i], 1); y[i] = x[i] > o ? x[i] : o; }
            bitonic_merge16(y, false);
            const size_t ob = ((size_t)(mt * 128 + row) * 16 + hc) * 16;
            if (half == 0) {
                float v[16];
#pragma unroll
                for (int i = 0; i < 16; ++i) { const unsigned u = y[i] & 0xFFFFFF80u; const unsigned bits = (u & 0x80000000u) ? (u ^ 0x80000000u) : ~u; v[i] = __builtin_bit_cast(float, bits); }
#pragma unroll
                for (int q = 0; q < 4; ++q) *(f32x4*)(TOPS + ob + q * 4) = (f32x4){v[q * 4], v[q * 4 + 1], v[q * 4 + 2], v[q * 4 + 3]};
            } else {
#pragma unroll
                for (int q = 0; q < 4; ++q) *(u32x4*)(TOPI + ob + q * 4) = (u32x4){127u - (y[q * 4] & 127u), 127u - (y[q * 4 + 1] & 127u), 127u - (y[q * 4 + 2] & 127u), 127u - (y[q * 4 + 3] & 127u)};
            }
        }
        __syncthreads();
    }
}
__device__ __forceinline__ void phase_peer_wq_topk(const Params& p, int layer, unsigned char* lds) {
    const bf16_t* HM = (const bf16_t*)(p.ws + WS_HM); const bf16_t* WT = (const bf16_t*)(p.ws + WS_WQ_T) + (size_t)layer * 2048 * 1024;
    const bf16_t* SK = (const bf16_t*)(p.ws + WS_SUBK) + (size_t)layer * 8 * 2 * 128 * 128;
    float* TOPS = (float*)(p.ws + WS_TOPS); int* TOPI = (int*)(p.ws + WS_TOPI);
    float* sc = (float*)lds;
    const int tid = threadIdx.x, lane = tid & 63, wid = tid >> 6, wr = wid >> 1, wc = wid & 1, fr = lane & 15, fq = lane >> 4;
    for (int id = vblock(); id < 256 * 16; id += gridDim.x) {
        const int mt = id >> 4, hc = id & 15;
        f32x4 acc[4][4];
        gemm_tile3(ALoadPlain{HM + (size_t)mt * 128 * D, (size_t)D}, WT + (size_t)hc * 128 * D, D, 16, acc, lds);
        {
            const int srow = wid * 32 + (lane >> 3), schunk = (lane & 7) ^ ((lane >> 3) & 7);
            const bf16_t* sk = SK + (size_t)hc * 128 * 128;
#pragma unroll
            for (int kt = 0; kt < 2; ++kt)
#pragma unroll
                for (int i = 0; i < 4; ++i)
                    __builtin_amdgcn_global_load_lds((const unsigned*)(sk + (srow + 8 * i) * 128 + kt * 64 + schunk * 8), (unsigned*)(lds + kt * 32768 + 16384 + wid * 4096 + i * 1024), 16, 0, 0);
        }
#pragma unroll
        for (int mi = 0; mi < 4; ++mi)
#pragma unroll
            for (int ni = 0; ni < 4; ++ni) {
                const int r = wr * 64 + mi * 16 + fr, chunk = ni * 2 + (fq >> 1);
                const f32x4 v = acc[mi][ni];
                *(u32x2*)(lds + wc * 32768 + r * 128 + ((chunk ^ (r & 7)) << 4) + (fq & 1) * 8) = (u32x2){pk2(v.x, v.y), pk2(v.z, v.w)};
            }
        __syncthreads();
#pragma unroll
        for (int mi = 0; mi < 4; ++mi)
#pragma unroll
            for (int ni = 0; ni < 4; ++ni) acc[mi][ni] = (f32x4){0.f, 0.f, 0.f, 0.f};
        mma_ktile(lds, acc); mma_ktile(lds + 32768, acc);
        __syncthreads();
#pragma unroll
        for (int mi = 0; mi < 4; ++mi)
#pragma unroll
            for (int ni = 0; ni < 4; ++ni) {
                const int r = wr * 64 + mi * 16 + fr, c = wc * 64 + ni * 16 + fq * 4;
                float* d = sc + r * 129 + c;
                d[0] = acc[mi][ni].x; d[1] = acc[mi][ni].y; d[2] = acc[mi][ni].z; d[3] = acc[mi][ni].w;
            }
        __syncthreads();
        {
            const int row = tid >> 1, half = tid & 1;
            unsigned x[64];
            const float* rp = sc + row * 129 + half * 64;
#pragma unroll
            for (int j = 0; j < 64; ++j) {
                const unsigned bits = __builtin_bit_cast(unsigned, rp[j]);
                const unsigned u = bits ^ ((unsigned)((int)bits >> 31) | 0x80000000u);
                x[j] = (u & 0xFFFFFF80u) | (unsigned)(127 - (half * 64 + j));
            }
            bitonic_sort16(x, true); bitonic_sort16(x + 16, false); bitonic_sort16(x + 32, true); bitonic_sort16(x + 48, false);
#pragma unroll
            for (int i = 0; i < 16; ++i) { x[i] = x[i] > x[16 + i] ? x[i] : x[16 + i]; x[32 + i] = x[32 + i] > x[48 + i] ? x[32 + i] : x[48 + i]; }
            bitonic_merge16(x, true); bitonic_merge16(x + 32, false);
#pragma unroll
            for (int i = 0; i < 16; ++i) x[i] = x[i] > x[32 + i] ? x[i] : x[32 + i];
            bitonic_merge16(x, false);
            unsigned y[16];
#pragma unroll
            for (int i = 0; i < 16; ++i) { const unsigned o = (unsigned)__shfl_xor((int)x[15 - i], 1); y[i] = x[i] > o ? x[i] : o; }
            bitonic_merge16(y, false);
            const size_t ob = ((size_t)(mt * 128 + row) * 16 + hc) * 16;
            if (half == 0) {
                float v[16];
#pragma unroll
                for (int i = 0; i < 16; ++i) { const unsigned u = y[i] & 0xFFFFFF80u; const unsigned bits = (u & 0x80000000u) ? (u ^ 0x80000000u) : ~u; v[i] = __builtin_bit_cast(float, bits); }
#pragma unroll
                for (int q = 0; q < 4; ++q) *(f32x4*)(TOPS + ob + q * 4) = (f32x4){v[q * 4], v[q * 4 + 1], v[q * 4 + 2], v[q * 4 + 3]};
            } else {
#pragma unroll
                for (int q = 0; q < 4; ++q) *(u32x4*)(TOPI + ob + q * 4) = (u32x4){127u - (y[q * 4] & 127u), 127u - (y[q * 4 + 1] & 127u), 127u - (y[q * 4 + 2] & 127u), 127u - (y[q * 4 + 3] & 127u)};
            }
        }
        __syncthreads();
    }
}
__device__ __forceinline__ void phase_peer_route(const Params& p, int layer, unsigned char* lds) {
    const bf16_t* HM = (const bf16_t*)(p.ws + WS_HM); const bf16_t* WT = (const bf16_t*)(p.ws + WS_WQ_T) + (size_t)layer * 2048 * 1024;
    const bf16_t* SK = (const bf16_t*)(p.ws + WS_SUBK) + (size_t)layer * 8 * 2 * 128 * 128;
    int* EXP = (int*)(p.ws + WS_EXP); float* GATE = (float*)(p.ws + WS_GATE);
    float* sc = (float*)lds;
    unsigned* KEYS0 = (unsigned*)(lds + 66048);
    unsigned* L = (unsigned*)lds;
    const int tid = threadIdx.x, lane = tid & 63, wid = tid >> 6, wr = wid >> 1, wc = wid & 1, fr = lane & 15, fq = lane >> 4;
    for (int id = vblock(); id < 256 * 8; id += gridDim.x) {
        const int mt = id >> 3, h = id & 7;
        const int row = tid >> 1, half = tid & 1;
        unsigned y[16];
#pragma unroll 1
        for (int c = 0; c < 2; ++c) {
            const int hc = h * 2 + c;
            f32x4 acc[4][4];
            gemm_tile3(ALoadPlain{HM + (size_t)mt * 128 * D, (size_t)D}, WT + (size_t)hc * 128 * D, D, 16, acc, lds);
            {
                const int srow = wid * 32 + (lane >> 3), schunk = (lane & 7) ^ ((lane >> 3) & 7);
                const bf16_t* sk = SK + (size_t)hc * 128 * 128;
#pragma unroll
                for (int kt = 0; kt < 2; ++kt)
#pragma unroll
                    for (int i = 0; i < 4; ++i)
                        __builtin_amdgcn_global_load_lds((const unsigned*)(sk + (srow + 8 * i) * 128 + kt * 64 + schunk * 8), (unsigned*)(lds + kt * 32768 + 16384 + wid * 4096 + i * 1024), 16, 0, 0);
            }
#pragma unroll
            for (int mi = 0; mi < 4; ++mi)
#pragma unroll
                for (int ni = 0; ni < 4; ++ni) {
                    const int r = wr * 64 + mi * 16 + fr, chunk = ni * 2 + (fq >> 1);
                    const f32x4 v = acc[mi][ni];
                    *(u32x2*)(lds + wc * 32768 + r * 128 + ((chunk ^ (r & 7)) << 4) + (fq & 1) * 8) = (u32x2){pk2(v.x, v.y), pk2(v.z, v.w)};
                }
            __syncthreads();
#pragma unroll
            for (int mi = 0; mi < 4; ++mi)
#pragma unroll
                for (int ni = 0; ni < 4; ++ni) acc[mi][ni] = (f32x4){0.f, 0.f, 0.f, 0.f};
            mma_ktile(lds, acc); mma_ktile(lds + 32768, acc);
            __syncthreads();
#pragma unroll
            for (int mi = 0; mi < 4; ++mi)
#pragma unroll
                for (int ni = 0; ni < 4; ++ni) {
                    const int r = wr * 64 + mi * 16 + fr, cc = wc * 64 + ni * 16 + fq * 4;
                    float* d = sc + r * 129 + cc;
                    d[0] = acc[mi][ni].x; d[1] = acc[mi][ni].y; d[2] = acc[mi][ni].z; d[3] = acc[mi][ni].w;
                }
            __syncthreads();
            {
                unsigned x[64];
                const float* rp = sc + row * 129 + half * 64;
#pragma unroll
                for (int j = 0; j < 64; ++j) {
                    const unsigned bits = __builtin_bit_cast(unsigned, rp[j]);
                    const unsigned u = bits ^ ((unsigned)((int)bits >> 31) | 0x80000000u);
                    x[j] = (u & 0xFFFFFF80u) | (unsigned)(127 - (half * 64 + j));
                }
                bitonic_sort16(x, true); bitonic_sort16(x + 16, false); bitonic_sort16(x + 32, true); bitonic_sort16(x + 48, false);
#pragma unroll
                for (int i = 0; i < 16; ++i) { x[i] = x[i] > x[16 + i] ? x[i] : x[16 + i]; x[32 + i] = x[32 + i] > x[48 + i] ? x[32 + i] : x[48 + i]; }
                bitonic_merge16(x, true); bitonic_merge16(x + 32, false);
#pragma unroll
                for (int i = 0; i < 16; ++i) x[i] = x[i] > x[32 + i] ? x[i] : x[32 + i];
                bitonic_merge16(x, false);
#pragma unroll
                for (int i = 0; i < 16; ++i) { const unsigned o = (unsigned)__shfl_xor((int)x[15 - i], 1); y[i] = x[i] > o ? x[i] : o; }
                bitonic_merge16(y, false);
            }
            if (c == 0 && half == 0) {
#pragma unroll
                for (int i = 0; i < 16; ++i) KEYS0[i * 128 + row] = y[i];
            }
            __syncthreads();
        }
        {
            unsigned kk[16];
#pragma unroll
            for (int i = 0; i < 16; ++i) kk[i] = half ? KEYS0[i * 128 + row] : y[i];
            const int sb = half ? 0 : 16, ib = half ? 32 : 48;
#pragma unroll
            for (int i = 0; i < 16; ++i) {
                const unsigned u = kk[i] & 0xFFFFFF80u; const unsigned bits = (u & 0x80000000u) ? (u ^ 0x80000000u) : ~u;
                L[(sb + i) * 128 + row] = bits; L[(ib + i) * 128 + row] = 127u - (kk[i] & 127u);
            }
        }
        __syncthreads();
        if (tid < 128) {
            const int col = tid;
            float val[16];
            const float s20 = __builtin_bit_cast(float, L[16 * 128 + col]);
#pragma unroll
            for (int a = 0; a < 16; ++a) val[a] = __builtin_bit_cast(float, L[a * 128 + col]) + s20;
            unsigned long long P = 0ull;
            float ts[16]; int te[16];
#pragma unroll
            for (int r = 0; r < 16; ++r) {
                float best = val[0]; int ba = 0;
#pragma unroll
                for (int a = 1; a < 16; ++a) if (val[a] > best) { best = val[a]; ba = a; }
                const int b = (int)((P >> (4 * ba)) & 15ull);
                const int i1 = (int)L[(32 + ba) * 128 + col], i2 = (int)L[(48 + b) * 128 + col];
                ts[r] = best; te[r] = i1 * 128 + i2;
                const int nb = b + 1;
                float newv = -3.0e38f;
                if (nb < 16) { newv = __builtin_bit_cast(float, L[ba * 128 + col]) + __builtin_bit_cast(float, L[(16 + nb) * 128 + col]); P += 1ull << (4 * ba); }
#pragma unroll
                for (int a = 0; a < 16; ++a) val[a] = (a == ba) ? newv : val[a];
            }
            const float m0 = ts[0];
            float sum = 0.f;
#pragma unroll
            for (int r = 0; r < 16; ++r) { ts[r] = __expf(ts[r] - m0); sum += ts[r]; }
            const float inv = 1.0f / sum;
            const size_t ob = ((size_t)(mt * 128 + col) * 8 + h) * 16;
            const float* SUt = (const float*)(p.ws + WS_PU + 24 * MiB); const float* SVt = (const float*)(p.ws + WS_PV + 24 * MiB);
            float* SUE = (float*)(p.ws + WS_ACT);
            float svv[16], suv[16];
#pragma unroll
            for (int r = 0; r < 16; ++r) { svv[r] = SVt[te[r]]; suv[r] = SUt[te[r]]; }
#pragma unroll
            for (int q = 0; q < 4; ++q) {
                *(u32x4*)(EXP + ob + q * 4) = (u32x4){(unsigned)te[q * 4] * (unsigned)PROW, (unsigned)te[q * 4 + 1] * (unsigned)PROW, (unsigned)te[q * 4 + 2] * (unsigned)PROW, (unsigned)te[q * 4 + 3] * (unsigned)PROW};
                *(f32x4*)(GATE + ob + q * 4) = (f32x4){ts[q * 4] * inv * svv[q * 4], ts[q * 4 + 1] * inv * svv[q * 4 + 1], ts[q * 4 + 2] * inv * svv[q * 4 + 2], ts[q * 4 + 3] * inv * svv[q * 4 + 3]};
                *(f32x4*)(SUE + ob + q * 4) = (f32x4){suv[q * 4], suv[q * 4 + 1], suv[q * 4 + 2], suv[q * 4 + 3]};
            }
        }
        __syncthreads();
    }
}
__device__ __forceinline__ void phase_peer_combine(const Params& p, unsigned char* lds) {
    const float* TOPS = (const float*)(p.ws + WS_TOPS); const int* TOPI = (const int*)(p.ws + WS_TOPI);
    int* EXP = (int*)(p.ws + WS_EXP); float* GATE = (float*)(p.ws + WS_GATE);
    unsigned* L = (unsigned*)lds;
    const int tid = threadIdx.x;
    for (int it = blockIdx.x; it < (T * 8) / 256; it += gridDim.x) {
        const size_t th = (size_t)it * 256 + tid;
        const u32x4* S4 = (const u32x4*)(TOPS + th * 32); const u32x4* I4 = (const u32x4*)(TOPI + th * 32);
#pragma unroll
        for (int a4 = 0; a4 < 8; ++a4) {
            const u32x4 s = S4[a4], i = I4[a4];
            L[(a4 * 4 + 0) * 256 + tid] = s.x; L[(a4 * 4 + 1) * 256 + tid] = s.y; L[(a4 * 4 + 2) * 256 + tid] = s.z; L[(a4 * 4 + 3) * 256 + tid] = s.w;
            L[(32 + a4 * 4 + 0) * 256 + tid] = i.x; L[(32 + a4 * 4 + 1) * 256 + tid] = i.y; L[(32 + a4 * 4 + 2) * 256 + tid] = i.z; L[(32 + a4 * 4 + 3) * 256 + tid] = i.w;
        }
        float val[16];
        const float s20 = __builtin_bit_cast(float, L[16 * 256 + tid]);
#pragma unroll
        for (int a = 0; a < 16; ++a) val[a] = __builtin_bit_cast(float, L[a * 256 + tid]) + s20;
        unsigned long long P = 0ull;
        float ts[16]; int te[16];
#pragma unroll
        for (int r = 0; r < 16; ++r) {
            float best = val[0]; int ba = 0;
#pragma unroll
            for (int a = 1; a < 16; ++a) if (val[a] > best) { best = val[a]; ba = a; }
            const int b = (int)((P >> (4 * ba)) & 15ull);
            const int i1 = (int)L[(32 + ba) * 256 + tid], i2 = (int)L[(48 + b) * 256 + tid];
            ts[r] = best; te[r] = i1 * 128 + i2;
            const int nb = b + 1;
            float newv = -3.0e38f;
            if (nb < 16) { newv = __builtin_bit_cast(float, L[ba * 256 + tid]) + __builtin_bit_cast(float, L[(16 + nb) * 256 + tid]); P += 1ull << (4 * ba); }
#pragma unroll
            for (int a = 0; a < 16; ++a) val[a] = (a == ba) ? newv : val[a];
        }
        const float m0 = ts[0];
        float sum = 0.f;
#pragma unroll
        for (int r = 0; r < 16; ++r) { ts[r] = __expf(ts[r] - m0); sum += ts[r]; }
        const float inv = 1.0f / sum;
#pragma unroll
        for (int r = 0; r < 16; ++r) ts[r] *= inv;
#pragma unroll
        for (int r = 0; r < 16; ++r) { EXP[th * 16 + r] = te[r]; GATE[th * 16 + r] = ts[r]; }
    }
}

__device__ __forceinline__ void fma8(const unsigned w0, const unsigned w1, const float a, float* acc) {
    const f32x2 p0 = __builtin_amdgcn_cvt_pk_f32_fp8((int)w0, false), p1 = __builtin_amdgcn_cvt_pk_f32_fp8((int)w0, true);
    const f32x2 p2 = __builtin_amdgcn_cvt_pk_f32_fp8((int)w1, false), p3 = __builtin_amdgcn_cvt_pk_f32_fp8((int)w1, true);
    acc[0] += a * p0.x; acc[1] += a * p0.y; acc[2] += a * p1.x; acc[3] += a * p1.y;
    acc[4] += a * p2.x; acc[5] += a * p2.y; acc[6] += a * p3.x; acc[7] += a * p3.y;
}
__device__ __forceinline__ float dot8(const unsigned w0, const unsigned w1, const float* h, float s) {
    const f32x2 p0 = __builtin_amdgcn_cvt_pk_f32_fp8((int)w0, false), p1 = __builtin_amdgcn_cvt_pk_f32_fp8((int)w0, true);
    const f32x2 p2 = __builtin_amdgcn_cvt_pk_f32_fp8((int)w1, false), p3 = __builtin_amdgcn_cvt_pk_f32_fp8((int)w1, true);
    s += p0.x * h[0]; s += p0.y * h[1]; s += p1.x * h[2]; s += p1.y * h[3];
    s += p2.x * h[4]; s += p2.y * h[5]; s += p3.x * h[6]; s += p3.y * h[7];
    return s;
}
__device__ __forceinline__ void phase_peer_apply(const Params& p, int layer, unsigned char* lds, bool dry) {
    const int lane = threadIdx.x & 63, wave = threadIdx.x >> 6;
    float* ldsw = (float*)lds + wave * (64 * 65);
    const bf16_t* HM = (const bf16_t*)(p.ws + WS_HM);
    const unsigned char* PU = p.ws + WS_PU; const unsigned char* PV = p.ws + WS_PV;
    const float* SU = (const float*)(p.ws + WS_PU + 24 * MiB); const float* SV = (const float*)(p.ws + WS_PV + 24 * MiB);
    const int* EXP = (const int*)(p.ws + WS_EXP); const float* GATE = (const float*)(p.ws + WS_GATE);
    const float* MOD = (const float*)(p.ws + WS_MOD);
    float* X = p.out;
    for (int t = blockIdx.x * 4 + wave; t < T; t += gridDim.x * 4) {
        const u32x4 ha = *(const u32x4*)(HM + (size_t)t * D + lane * 16), hb = *(const u32x4*)(HM + (size_t)t * D + lane * 16 + 8);
        float hf[16];
        hf[0] = bflo(ha.x); hf[1] = bfhi(ha.x); hf[2] = bflo(ha.y); hf[3] = bfhi(ha.y); hf[4] = bflo(ha.z); hf[5] = bfhi(ha.z); hf[6] = bflo(ha.w); hf[7] = bfhi(ha.w);
        hf[8] = bflo(hb.x); hf[9] = bfhi(hb.x); hf[10] = bflo(hb.y); hf[11] = bfhi(hb.y); hf[12] = bflo(hb.z); hf[13] = bfhi(hb.z); hf[14] = bflo(hb.w); hf[15] = bfhi(hb.w);
        const int e0_ = EXP[(size_t)t * 128 + lane], e1_ = EXP[(size_t)t * 128 + 64 + lane];
        const float g0 = GATE[(size_t)t * 128 + lane], g1 = GATE[(size_t)t * 128 + 64 + lane];
        const float su0 = SU[e0_], su1 = SU[e1_], sv0 = SV[e0_], sv1 = SV[e1_];
        u32x4 buf[16];
        float act0 = 0.f, act1 = 0.f;
        float acc[16];
#pragma unroll
        for (int i = 0; i < 16; ++i) acc[i] = 0.f;
#ifndef APPLY_L2PROBE
#define APPLY_L2PROBE 0
#endif
        for (int prep_ = 0; prep_ < 1 + APPLY_L2PROBE; ++prep_) {
        const int emask = (APPLY_L2PROBE && prep_ == 0) ? 2047 : 0x7fffffff;
        const int e0 = e0_ & emask, e1 = e1_ & emask;
#pragma unroll
        for (int j = 0; j < 16; ++j) { const int e_ = __builtin_amdgcn_readlane(e0, j); buf[j] = *(const u32x4*)(PU + (size_t)e_ * D + lane * 16); }
#pragma unroll
        for (int bt = 0; bt < 16; ++bt) {
#pragma unroll
            for (int j = 0; j < 16; ++j) {
                if (bt < 8) {
                    float s_ = dot8(buf[j].x, buf[j].y, hf, 0.f); s_ = dot8(buf[j].z, buf[j].w, hf + 8, s_);
                    ldsw[((bt & 3) * 16 + j) * 65 + lane] = s_;
                } else {
                    const float av_ = ((bt & 7) < 4) ? act0 : act1;
                    const float a_ = __builtin_bit_cast(float, __builtin_amdgcn_readlane(__builtin_bit_cast(int, av_), (bt & 3) * 16 + j));
                    fma8(buf[j].x, buf[j].y, a_, acc); fma8(buf[j].z, buf[j].w, a_, acc + 8);
                }
                if (bt + 1 < 16) {
                    const int nb = bt + 1;
                    const int e_ = __builtin_amdgcn_readlane(((nb & 7) < 4) ? e0 : e1, (nb & 3) * 16 + j);
                    buf[j] = *(const u32x4*)(((nb < 8) ? PU : PV) + (size_t)e_ * D + lane * 16);
                }
            }
            if (bt == 3 || bt == 7) {
                float tot_ = 0.f;
#pragma unroll 16
                for (int q = 0; q < 64; ++q) tot_ += ldsw[lane * 65 + q];
                if (bt == 3) act0 = gelu_tanh(tot_ * su0) * g0 * sv0; else act1 = gelu_tanh(tot_ * su1) * g1 * sv1;
            }
        }
        if (APPLY_L2PROBE && prep_ == 0 && p.ph_hi >= 0) {
#pragma unroll
            for (int i = 0; i < 16; ++i) acc[i] = 0.f;
        }
        }
        const int b = t / SEQ;
        const float* g2 = MOD + (size_t)(layer * 2 + b) * 6144 + 5120;
        float* xr = X + (size_t)t * D + lane * 16;
        f32x4 xs[4]; float ss = 0.f;
#pragma unroll
        for (int q = 0; q < 4; ++q) {
            const f32x4 g = *(const f32x4*)(g2 + lane * 16 + q * 4); f32x4 x = *(const f32x4*)(xr + q * 4);
            x.x += g.x * acc[q * 4 + 0]; x.y += g.y * acc[q * 4 + 1]; x.z += g.z * acc[q * 4 + 2]; x.w += g.w * acc[q * 4 + 3];
            xs[q] = x; ss += (x.x * x.x + x.y * x.y) + (x.z * x.z + x.w * x.w);
        }
        const float rs = rsqrtf(wave_sum(ss) * (1.0f / D) + RMS_EPS);
        if (!dry) {
            if (layer == 0) {
                const float* gw = p.in[2] + D + lane * 16; const float* sh = MOD + (size_t)(2 + b) * 6144 + lane * 16; const float* sc = sh + 1024;
                u32x4 o[2];
#pragma unroll
                for (int q = 0; q < 4; ++q) {
                    *(f32x4*)(xr + q * 4) = xs[q];
                    const f32x4 g = *(const f32x4*)(gw + q * 4), s1 = *(const f32x4*)(sc + q * 4), s0 = *(const f32x4*)(sh + q * 4);
                    const float y0 = xs[q].x * rs * g.x * (1.f + s1.x) + s0.x, y1 = xs[q].y * rs * g.y * (1.f + s1.y) + s0.y;
                    const float y2 = xs[q].z * rs * g.z * (1.f + s1.z) + s0.z, y3 = xs[q].w * rs * g.w * (1.f + s1.w) + s0.w;
                    if (q & 1) { o[q >> 1].z = pk2(y0, y1); o[q >> 1].w = pk2(y2, y3); } else { o[q >> 1].x = pk2(y0, y1); o[q >> 1].y = pk2(y2, y3); }
                }
                bf16_t* hm = (bf16_t*)(p.ws + WS_HM) + (size_t)t * D + lane * 16;
                *(u32x4*)hm = o[0]; *(u32x4*)(hm + 8) = o[1];
            } else {
                const float* gw = p.in[28] + lane * 16;
#pragma unroll
                for (int q = 0; q < 4; ++q) {
                    const f32x4 g = *(const f32x4*)(gw + q * 4);
                    *(f32x4*)(xr + q * 4) = (f32x4){xs[q].x * rs * g.x, xs[q].y * rs * g.y, xs[q].z * rs * g.z, xs[q].w * rs * g.w};
                }
            }
        }
    }
}

__device__ __forceinline__ void phase_peer_apply6(const Params& p, int layer, unsigned char* lds, bool dry) {
    const int lane = threadIdx.x & 63, wave = threadIdx.x >> 6, half = lane >> 5, gl = lane & 31;
    float* ldsw = (float*)lds + wave * (64 * 33);
    const bf16_t* HM = (const bf16_t*)(p.ws + WS_HM);
    const unsigned char* PU = p.ws + WS_PU; const unsigned char* PV = p.ws + WS_PV;
    const float* SU = (const float*)(p.ws + WS_PU + 24 * MiB); const float* SV = (const float*)(p.ws + WS_PV + 24 * MiB);
    const int* EXP = (const int*)(p.ws + WS_EXP); const float* GATE = (const float*)(p.ws + WS_GATE);
    const float* MOD = (const float*)(p.ws + WS_MOD);
    float* X = p.out;
    const int tstep = (int)gridDim.x * 4;
    int t = blockIdx.x * 4 + wave;
    int e0 = 0, e1 = 0; float g0 = 0.f, g1 = 0.f;
    u32x4 hraw[4] = {(u32x4){0u, 0u, 0u, 0u}, (u32x4){0u, 0u, 0u, 0u}, (u32x4){0u, 0u, 0u, 0u}, (u32x4){0u, 0u, 0u, 0u}};
    u32x2 buf[8][3];
#define A6_LOADX(slot, nb, E0_, E1_) do { const int es_ = (((nb) & 7) < 4) ? (E0_) : (E1_); const int ia_ = ((nb) & 3) * 16 + 2 * (slot); \
            const int ea_ = __builtin_amdgcn_readlane(es_, ia_), eb_ = __builtin_amdgcn_readlane(es_, ia_ + 1); const int e_ = half ? eb_ : ea_; \
            if (((nb) & 15) < 8) { const u32x2* rp_ = (const u32x2*)(PU + (size_t)e_ * PROW + gl * 24); buf[slot][0] = rp_[0]; buf[slot][1] = rp_[1]; buf[slot][2] = rp_[2]; } \
            else { const u32x2* rp_ = (const u32x2*)(PU + (size_t)e_ * PROW + 768 + gl * 16); buf[slot][0] = rp_[0]; buf[slot][1] = rp_[1]; } } while (0)
#define A6_LOAD(slot, nb) A6_LOADX(slot, nb, e0, e1)
    if (t < T) {
        e0 = EXP[(size_t)t * 128 + lane]; e1 = EXP[(size_t)t * 128 + 64 + lane];
        g0 = GATE[(size_t)t * 128 + lane]; g1 = GATE[(size_t)t * 128 + 64 + lane];
        const u32x4* hp = (const u32x4*)(HM + (size_t)t * D + gl * 32);
#pragma unroll
        for (int q = 0; q < 4; ++q) hraw[q] = hp[q];
#pragma unroll
        for (int j = 0; j < 8; ++j) A6_LOAD(j, 0);
    }
    for (; t < T; t += tstep) {
        const int tn = t + tstep; const bool more = tn < T;
        int e0n = 0, e1n = 0; float g0n = 0.f, g1n = 0.f;
        if (more) { e0n = EXP[(size_t)tn * 128 + lane]; e1n = EXP[(size_t)tn * 128 + 64 + lane]; g0n = GATE[(size_t)tn * 128 + lane]; g1n = GATE[(size_t)tn * 128 + 64 + lane]; }
        float hf[32];
#pragma unroll
        for (int q = 0; q < 4; ++q) { const u32x4 w = hraw[q];
            hf[q * 8 + 0] = bflo(w.x); hf[q * 8 + 1] = bfhi(w.x); hf[q * 8 + 2] = bflo(w.y); hf[q * 8 + 3] = bfhi(w.y);
            hf[q * 8 + 4] = bflo(w.z); hf[q * 8 + 5] = bfhi(w.z); hf[q * 8 + 6] = bflo(w.w); hf[q * 8 + 7] = bfhi(w.w); }
        const float su0 = SU[e0], su1 = SU[e1], sv0 = SV[e0], sv1 = SV[e1];
        float act0 = 0.f, act1 = 0.f;
        float acc[32];
#pragma unroll
        for (int i = 0; i < 32; ++i) acc[i] = 0.f;
#pragma unroll 1
        for (int bt = 0; bt < 8; ++bt) {
#pragma unroll
            for (int j = 0; j < 8; ++j) {
                v6u w; w[0] = buf[j][0].x; w[1] = buf[j][0].y; w[2] = buf[j][1].x; w[3] = buf[j][1].y; w[4] = buf[j][2].x; w[5] = buf[j][2].y;
                const v32f y = __builtin_amdgcn_cvt_scalef32_pk32_f32_fp6(w, 1.0f);
                float s0_ = 0.f, s1_ = 0.f;
#pragma unroll
                for (int i = 0; i < 16; ++i) { s0_ += y[i] * hf[i]; s1_ += y[16 + i] * hf[16 + i]; }
                ldsw[(((bt & 3) * 16 + 2 * j) + half) * 33 + gl] = s0_ + s1_;
                A6_LOAD(j, bt + 1);
            }
            if (bt == 3 || bt == 7) {
                float tot_ = 0.f;
#pragma unroll
                for (int q = 0; q < 32; ++q) tot_ += ldsw[lane * 33 + q];
                if (bt == 3) act0 = gelu_tanh(tot_ * su0) * g0 * sv0; else act1 = gelu_tanh(tot_ * su1) * g1 * sv1;
            }
        }
#pragma unroll 1
        for (int bt = 8; bt < 16; ++bt) {
            const float av_ = (bt < 12) ? act0 : act1;
#pragma unroll
            for (int j = 0; j < 8; ++j) {
                float y[32];
                {
                    const unsigned w4_[4] = {buf[j][0].x, buf[j][0].y, buf[j][1].x, buf[j][1].y};
#pragma unroll
                    for (int q = 0; q < 4; ++q) {
                        const v2f y0_ = __builtin_amdgcn_cvt_scalef32_pk_f32_fp4(w4_[q], 1.0f, 0), y1_ = __builtin_amdgcn_cvt_scalef32_pk_f32_fp4(w4_[q], 1.0f, 1);
                        const v2f y2_ = __builtin_amdgcn_cvt_scalef32_pk_f32_fp4(w4_[q], 1.0f, 2), y3_ = __builtin_amdgcn_cvt_scalef32_pk_f32_fp4(w4_[q], 1.0f, 3);
                        y[q * 8 + 0] = y0_.x; y[q * 8 + 1] = y0_.y; y[q * 8 + 2] = y1_.x; y[q * 8 + 3] = y1_.y; y[q * 8 + 4] = y2_.x; y[q * 8 + 5] = y2_.y; y[q * 8 + 6] = y3_.x; y[q * 8 + 7] = y3_.y;
                    }
                }
                const int ia_ = (bt & 3) * 16 + 2 * j;
                const float aa_ = __builtin_bit_cast(float, __builtin_amdgcn_readlane(__builtin_bit_cast(int, av_), ia_));
                const float ab_ = __builtin_bit_cast(float, __builtin_amdgcn_readlane(__builtin_bit_cast(int, av_), ia_ + 1));
                const float a_ = half ? ab_ : aa_;
#pragma unroll
                for (int i = 0; i < 32; ++i) acc[i] += a_ * y[i];
                if (bt + 1 < 16) A6_LOAD(j, bt + 1); else if (more) A6_LOADX(j, 0, e0n, e1n);
            }
        }
        if (more) {
            const u32x4* hp = (const u32x4*)(HM + (size_t)tn * D + gl * 32);
#pragma unroll
            for (int q = 0; q < 4; ++q) hraw[q] = hp[q];
        }
#pragma unroll
        for (int i = 0; i < 32; ++i) acc[i] += __shfl_xor(acc[i], 32);
        const int b = t / SEQ;
        const float* g2 = MOD + (size_t)(layer * 2 + b) * 6144 + 5120 + gl * 32;
        float* xr = X + (size_t)t * D + gl * 32;
        f32x4 xs[8]; float ss = 0.f;
#pragma unroll
        for (int q = 0; q < 8; ++q) {
            const f32x4 g = *(const f32x4*)(g2 + q * 4); f32x4 x = *(const f32x4*)(xr + q * 4);
            x.x += g.x * acc[q * 4 + 0]; x.y += g.y * acc[q * 4 + 1]; x.z += g.z * acc[q * 4 + 2]; x.w += g.w * acc[q * 4 + 3];
            xs[q] = x; if (half == 0) ss += (x.x * x.x + x.y * x.y) + (x.z * x.z + x.w * x.w);
        }
        const float rs = rsqrtf(wave_sum(ss) * (1.0f / D) + RMS_EPS);
        if (!dry && half == 0) {
            if (layer == 0) {
                const float* gw = p.in[2] + D + gl * 32; const float* sh = MOD + (size_t)(2 + b) * 6144 + gl * 32; const float* sc = sh + 1024;
                bf16_t* hm = (bf16_t*)(p.ws + WS_HM) + (size_t)t * D + gl * 32;
#pragma unroll
                for (int q2 = 0; q2 < 4; ++q2) {
                    u32x4 o;
#pragma unroll
                    for (int hq = 0; hq < 2; ++hq) {
                        const int q = q2 * 2 + hq;
                        *(f32x4*)(xr + q * 4) = xs[q];
                        const f32x4 g = *(const f32x4*)(gw + q * 4), s1 = *(const f32x4*)(sc + q * 4), s0 = *(const f32x4*)(sh + q * 4);
                        const float y0 = xs[q].x * rs * g.x * (1.f + s1.x) + s0.x, y1 = xs[q].y * rs * g.y * (1.f + s1.y) + s0.y;
                        const float y2 = xs[q].z * rs * g.z * (1.f + s1.z) + s0.z, y3 = xs[q].w * rs * g.w * (1.f + s1.w) + s0.w;
                        if (hq) { o.z = pk2(y0, y1); o.w = pk2(y2, y3); } else { o.x = pk2(y0, y1); o.y = pk2(y2, y3); }
                    }
                    *(u32x4*)(hm + q2 * 8) = o;
                }
            } else {
                const float* gw = p.in[28] + gl * 32;
#pragma unroll
                for (int q = 0; q < 8; ++q) {
                    const f32x4 g = *(const f32x4*)(gw + q * 4);
                    *(f32x4*)(xr + q * 4) = (f32x4){xs[q].x * rs * g.x, xs[q].y * rs * g.y, xs[q].z * rs * g.z, xs[q].w * rs * g.w};
                }
            }
        }
        e0 = e0n; e1 = e1n; g0 = g0n; g1 = g1n;
    }
#undef A6_LOAD
#undef A6_LOADX
}

__device__ __forceinline__ void half_sums_dpp(float v, float& lo, float& hi) {
#define DPP_ADD_(ctrl_, rmask_) v += __builtin_bit_cast(float, __builtin_amdgcn_update_dpp(0, __builtin_bit_cast(int, v), ctrl_, rmask_, 0xF, false))
    DPP_ADD_(0xB1, 0xF); DPP_ADD_(0x4E, 0xF); DPP_ADD_(0x124, 0xF); DPP_ADD_(0x128, 0xF); DPP_ADD_(0x142, 0xA);
#undef DPP_ADD_
    lo = __builtin_bit_cast(float, __builtin_amdgcn_readlane(__builtin_bit_cast(int, v), 31)); hi = __builtin_bit_cast(float, __builtin_amdgcn_readlane(__builtin_bit_cast(int, v), 63));
}
__device__ __forceinline__ float half_sum_dpp(float v, int half) {
#define DPP_ADD_(ctrl_, rmask_) v += __builtin_bit_cast(float, __builtin_amdgcn_update_dpp(0, __builtin_bit_cast(int, v), ctrl_, rmask_, 0xF, false))
    DPP_ADD_(0xB1, 0xF);
    DPP_ADD_(0x4E, 0xF);
    DPP_ADD_(0x124, 0xF);
    DPP_ADD_(0x128, 0xF);
    DPP_ADD_(0x142, 0xA);
#undef DPP_ADD_
    const float lo = __builtin_bit_cast(float, __builtin_amdgcn_readlane(__builtin_bit_cast(int, v), 31)), hi = __builtin_bit_cast(float, __builtin_amdgcn_readlane(__builtin_bit_cast(int, v), 63));
    return half ? hi : lo;
}
__device__ __forceinline__ void phase_peer_apply7(const Params& p, int layer, unsigned char* lds, bool dry) {
    const int lane = threadIdx.x & 63, wave = __builtin_amdgcn_readfirstlane((int)(threadIdx.x >> 6)), half = lane >> 5, gl = lane & 31;
    const bf16_t* HM = (const bf16_t*)(p.ws + WS_HM);
    const unsigned char* TAB = p.ws + WS_PU;
    const unsigned* EXP = (const unsigned*)(p.ws + WS_EXP); const float* GATE = (const float*)(p.ws + WS_GATE); const float* SUE = (const float*)(p.ws + WS_ACT);
    const float* MOD = (const float*)(p.ws + WS_MOD);
    float* X = p.out;
    const int tstep = (int)gridDim.x * 4;
    int t = blockIdx.x * 4 + wave;
    unsigned e0 = 0u, e1 = 0u; float su0 = 0.f, su1 = 0.f, c0 = 0.f, c1 = 0.f;
    u32x4 hw4[4] = {(u32x4){0u, 0u, 0u, 0u}, (u32x4){0u, 0u, 0u, 0u}, (u32x4){0u, 0u, 0u, 0u}, (u32x4){0u, 0u, 0u, 0u}};
    u32x2 bu[8][2], bv[8][2];
#define A7_LOAD(slot, k, E0_, E1_) do { const unsigned es_ = (((k) & 63) < 32) ? (E0_) : (E1_); const int ia_ = (k) & 31; \
            const unsigned oa_ = (unsigned)__builtin_amdgcn_readlane((int)es_, ia_), ob_ = (unsigned)__builtin_amdgcn_readlane((int)es_, ia_ + 32); const unsigned or_ = half ? ob_ : oa_; \
            const u32x2* ru_ = (const u32x2*)(TAB + (or_ + (unsigned)gl * 16u)); const u32x2* rv_ = (const u32x2*)(TAB + (or_ + 512u + (unsigned)gl * 16u)); \
            bu[slot][0] = ru_[0]; bu[slot][1] = ru_[1]; bv[slot][0] = rv_[0]; bv[slot][1] = rv_[1]; } while (0)
    if (t < T) {
        e0 = EXP[(unsigned)t * 128u + lane]; e1 = EXP[(unsigned)t * 128u + 64u + lane];
        c0 = GATE[(unsigned)t * 128u + lane]; c1 = GATE[(unsigned)t * 128u + 64u + lane];
        su0 = SUE[(unsigned)t * 128u + lane]; su1 = SUE[(unsigned)t * 128u + 64u + lane];
        const u32x4* hp = (const u32x4*)((const unsigned char*)HM + ((unsigned)t * 2048u + (unsigned)gl * 64u));
#pragma unroll
        for (int q = 0; q < 4; ++q) hw4[q] = hp[q];
#pragma unroll
        for (int j = 0; j < 8; ++j) A7_LOAD(j, j, e0, e1);
    }
    for (; t < T; t += tstep) {
        const int tn = t + tstep; const bool more = tn < T;
        unsigned e0n = 0u, e1n = 0u; float su0n = 0.f, su1n = 0.f, c0n = 0.f, c1n = 0.f;
        if (more) {
            e0n = EXP[(unsigned)tn * 128u + lane]; e1n = EXP[(unsigned)tn * 128u + 64u + lane];
            c0n = GATE[(unsigned)tn * 128u + lane]; c1n = GATE[(unsigned)tn * 128u + 64u + lane];
            su0n = SUE[(unsigned)tn * 128u + lane]; su1n = SUE[(unsigned)tn * 128u + 64u + lane];
        }
        float acc[32];
#pragma unroll
        for (int i = 0; i < 32; ++i) acc[i] = 0.f;
#pragma unroll 2
        for (int bt = 0; bt < 8; ++bt) {
            const float sus_ = (bt < 4) ? su0 : su1, cs_ = (bt < 4) ? c0 : c1;
            float pj[8];
#pragma unroll
            for (int j = 0; j < 8; ++j) {
                const unsigned wu_[4] = {bu[j][0].x, bu[j][0].y, bu[j][1].x, bu[j][1].y};
                float s0_ = 0.f, s1_ = 0.f;
#pragma unroll
                for (int q = 0; q < 4; ++q) {
                    const unsigned y0_ = __builtin_bit_cast(unsigned, __builtin_amdgcn_cvt_scalef32_pk_bf16_fp4(wu_[q], 1.0f, 0)), y1_ = __builtin_bit_cast(unsigned, __builtin_amdgcn_cvt_scalef32_pk_bf16_fp4(wu_[q], 1.0f, 1));
                    const unsigned y2_ = __builtin_bit_cast(unsigned, __builtin_amdgcn_cvt_scalef32_pk_bf16_fp4(wu_[q], 1.0f, 2)), y3_ = __builtin_bit_cast(unsigned, __builtin_amdgcn_cvt_scalef32_pk_bf16_fp4(wu_[q], 1.0f, 3));
                    s0_ = dot2bf(y0_, hw4[q][0], s0_); s1_ = dot2bf(y1_, hw4[q][1], s1_); s0_ = dot2bf(y2_, hw4[q][2], s0_); s1_ = dot2bf(y3_, hw4[q][3], s1_);
                }
                pj[j] = s0_ + s1_;
            }
            float hv;
            {
#define DPPF_(x_, ctrl_) __builtin_bit_cast(float, __builtin_amdgcn_update_dpp(0, __builtin_bit_cast(int, (x_)), ctrl_, 0xF, 0xF, false))
                const bool b0_ = (lane & 1) != 0, b1_ = (lane & 2) != 0, b2_ = (lane & 4) != 0;
                float q4[4], r2[2];
#pragma unroll
                for (int m = 0; m < 4; ++m) { const float keep_ = b0_ ? pj[2 * m + 1] : pj[2 * m], send_ = b0_ ? pj[2 * m] : pj[2 * m + 1]; q4[m] = keep_ + DPPF_(send_, 0xB1); }
#pragma unroll
                for (int m = 0; m < 2; ++m) { const float keep_ = b1_ ? q4[2 * m + 1] : q4[2 * m], send_ = b1_ ? q4[2 * m] : q4[2 * m + 1]; r2[m] = keep_ + DPPF_(send_, 0x4E); }
#pragma unroll
                for (int m = 0; m < 2; ++m) { r2[m] += DPPF_(r2[m], 0x124); r2[m] += DPPF_(r2[m], 0x128); }
                float t_ = b2_ ? r2[1] : r2[0];
                t_ += __builtin_bit_cast(float, __builtin_amdgcn_ds_swizzle(__builtin_bit_cast(int, t_), 0x401F));
#undef DPPF_
                hv = t_;
            }
            const int lb_ = (bt & 3) * 8;
            if (bt == 7 && more) {
                const u32x4* hp = (const u32x4*)((const unsigned char*)HM + ((unsigned)tn * 2048u + (unsigned)gl * 64u));
#pragma unroll
                for (int q = 0; q < 4; ++q) hw4[q] = hp[q];
            }
            const float av_ = gelu_tanh(hv * sus_) * cs_;
#pragma unroll
            for (int j = 0; j < 8; ++j) {
                const float aa_ = __builtin_bit_cast(float, __builtin_amdgcn_readlane(__builtin_bit_cast(int, av_), lb_ + j)), ab_ = __builtin_bit_cast(float, __builtin_amdgcn_readlane(__builtin_bit_cast(int, av_), lb_ + j + 32));
                const float a_ = half ? ab_ : aa_;
                {
                    const unsigned w4_[4] = {bv[j][0].x, bv[j][0].y, bv[j][1].x, bv[j][1].y};
#pragma unroll
                    for (int q = 0; q < 4; ++q) {
                        const v2f y0_ = __builtin_amdgcn_cvt_scalef32_pk_f32_fp4(w4_[q], 1.0f, 0), y1_ = __builtin_amdgcn_cvt_scalef32_pk_f32_fp4(w4_[q], 1.0f, 1);
                        const v2f y2_ = __builtin_amdgcn_cvt_scalef32_pk_f32_fp4(w4_[q], 1.0f, 2), y3_ = __builtin_amdgcn_cvt_scalef32_pk_f32_fp4(w4_[q], 1.0f, 3);
                        acc[q * 8 + 0] += a_ * y0_.x; acc[q * 8 + 1] += a_ * y0_.y; acc[q * 8 + 2] += a_ * y1_.x; acc[q * 8 + 3] += a_ * y1_.y;
                        acc[q * 8 + 4] += a_ * y2_.x; acc[q * 8 + 5] += a_ * y2_.y; acc[q * 8 + 6] += a_ * y3_.x; acc[q * 8 + 7] += a_ * y3_.y;
                    }
                }
                const int kn_ = bt * 8 + j + 8;
                if (kn_ < 64) A7_LOAD(j, kn_, e0, e1); else if (more) A7_LOAD(j, kn_, e0n, e1n);
            }
        }
        int gle = gl; asm volatile("" : "+v"(gle));
#pragma unroll
        for (int i = 0; i < 32; ++i) acc[i] += __shfl_xor(acc[i], 32);
        const int b = t / SEQ;
        const float* g2 = MOD + (size_t)(layer * 2 + b) * 6144 + 5120 + gle * 32;
        bf16_t* xr = (bf16_t*)(p.ws + WS_XB) + (size_t)t * D + gle * 32;
        u32x4 xw[4];
#pragma unroll
        for (int q = 0; q < 4; ++q) xw[q] = *(const u32x4*)(xr + q * 8);
        f32x4 xs[8]; float ss = 0.f;
#pragma unroll
        for (int q = 0; q < 8; ++q) {
            const f32x4 g = *(const f32x4*)(g2 + q * 4);
            const unsigned w0_ = (q & 1) ? xw[q >> 1].z : xw[q >> 1].x, w1_ = (q & 1) ? xw[q >> 1].w : xw[q >> 1].y;
            f32x4 x = (f32x4){bflo(w0_), bfhi(w0_), bflo(w1_), bfhi(w1_)};
            x.x += g.x * acc[q * 4 + 0]; x.y += g.y * acc[q * 4 + 1]; x.z += g.z * acc[q * 4 + 2]; x.w += g.w * acc[q * 4 + 3];
            xs[q] = x; if (half == 0) ss += (x.x * x.x + x.y * x.y) + (x.z * x.z + x.w * x.w);
        }
        const float rs = rsqrtf(wave_sum(ss) * (1.0f / D) + RMS_EPS);
        if (!dry && half == 0) {
            if (layer == 0) {
                const float* gw = p.in[2] + D + gle * 32; const float* sh = MOD + (size_t)(2 + b) * 6144 + gle * 32; const float* sc = sh + 1024;
                bf16_t* hm = (bf16_t*)(p.ws + WS_HM) + (size_t)t * D + gle * 32;
#pragma unroll
                for (int q2 = 0; q2 < 4; ++q2) {
                    u32x4 o;
#pragma unroll
                    for (int hq = 0; hq < 2; ++hq) {
                        const int q = q2 * 2 + hq;
                        *(u32x2*)(xr + q * 4) = (u32x2){pk2(xs[q].x, xs[q].y), pk2(xs[q].z, xs[q].w)};
                        const f32x4 g = *(const f32x4*)(gw + q * 4), s1 = *(const f32x4*)(sc + q * 4), s0 = *(const f32x4*)(sh + q * 4);
                        const float y0 = xs[q].x * rs * g.x * (1.f + s1.x) + s0.x, y1 = xs[q].y * rs * g.y * (1.f + s1.y) + s0.y;
                        const float y2 = xs[q].z * rs * g.z * (1.f + s1.z) + s0.z, y3 = xs[q].w * rs * g.w * (1.f + s1.w) + s0.w;
                        if (hq) { o.z = pk2(y0, y1); o.w = pk2(y2, y3); } else { o.x = pk2(y0, y1); o.y = pk2(y2, y3); }
                    }
                    *(u32x4*)(hm + q2 * 8) = o;
                }
            } else {
                const float* gw = p.in[28] + gle * 32;
                float* outr = X + (size_t)t * D + gle * 32;
#pragma unroll
                for (int q = 0; q < 8; ++q) {
                    const f32x4 g = *(const f32x4*)(gw + q * 4);
                    *(f32x4*)(outr + q * 4) = (f32x4){xs[q].x * rs * g.x, xs[q].y * rs * g.y, xs[q].z * rs * g.z, xs[q].w * rs * g.w};
                }
            }
        }
        e0 = e0n; e1 = e1n; su0 = su0n; su1 = su1n; c0 = c0n; c1 = c1n;
    }
#undef A7_LOAD
}
__device__ __forceinline__ void phase_tab1(const Params& p) {
    const int first = vblock() - 256, stride = (int)gridDim.x - 256;
    if (first < 0 || stride <= 0) {
        if (stride <= 0) { for (int it = blockIdx.x; it < 2 * P0_TAB; it += gridDim.x) {
            if (it < P0_TAB) cvt_fp4_item(p.in[26] + (size_t)PE * D, p.ws + WS_PU, (float*)(p.ws + WS_PU + 24 * MiB), it, 0);
            else cvt_fp4_item(p.in[27] + (size_t)PE * D, p.ws + WS_PU, (float*)(p.ws + WS_PV + 24 * MiB), it - P0_TAB, 512); } }
        return;
    }
    for (int it = first; it < 2 * P0_TAB; it += stride) {
        if (it < P0_TAB) cvt_fp4_item(p.in[26] + (size_t)PE * D, p.ws + WS_PU, (float*)(p.ws + WS_PU + 24 * MiB), it, 0);
        else cvt_fp4_item(p.in[27] + (size_t)PE * D, p.ws + WS_PU, (float*)(p.ws + WS_PV + 24 * MiB), it - P0_TAB, 512);
    }
}
__device__ __forceinline__ void phase_nsa_proj(const Params& p, unsigned char* lds) {
    const bf16_t* HM = (const bf16_t*)(p.ws + WS_HM); const bf16_t* WT = (const bf16_t*)(p.ws + WS_WPROJ_T);
    const f32x2* ROPE = (const f32x2*)(p.ws + WS_ROPE);
    bf16_t* Q = (bf16_t*)(p.ws + WS_Q); float* NGT = (float*)(p.ws + WS_NG);
    const int lane = threadIdx.x & 63, wid = threadIdx.x >> 6, wr = wid >> 1, wc = wid & 1, fr = lane & 15, fq = lane >> 4;
    for (int id = vblock(); id < 256 * 21; id += gridDim.x) {
        const int mt = id / 21, nt = id % 21;
        f32x4 acc[4][4];
        gemm_tile3(ALoadPlain{HM + (size_t)mt * 128 * D, (size_t)D}, WT + (size_t)nt * 128 * D, D, 16, acc, lds);
        const int c0 = nt * 128 + wc * 64;
        if (c0 >= 2624) continue;
        const int b = (mt * 128) / SEQ;
        if (c0 == 2560) {
#pragma unroll
            for (int mi = 0; mi < 4; ++mi)
#pragma unroll
                for (int ni = 0; ni < 3; ++ni) {
                    const int t = mt * 128 + wr * 64 + mi * 16 + fr;
                    const f32x4 v = acc[mi][ni];
                    *(f32x4*)(NGT + (size_t)t * 48 + ni * 16 + fq * 4) = (f32x4){sigmoidf_(v.x), sigmoidf_(v.y), sigmoidf_(v.z), sigmoidf_(v.w)};
                }
            continue;
        }
        int sec = -1, g = 0;
        if (c0 >= 1024) { sec = (c0 - 1024) >> 8; g = ((c0 - 1024) & 255) >> 6; }
        const bool dorope = (sec == -1) || (sec == 2) || (sec == 4);
        const float scl = (sec == -1) ? 0.125f : 1.0f;
        const size_t secoff[6] = {WS_KC, WS_VC, WS_KSB, WS_VSB, WS_KW, WS_VWT};
        size_t so = WS_Q;
#pragma unroll
        for (int q = 0; q < 6; ++q) if (sec == q) so = secoff[q];
        bf16_t* OUT = (bf16_t*)(p.ws + so);
        const bool vt = (sec == 3) || (sec == 5);
        float kblk_am = 0.f;
#pragma unroll
        for (int pass = 0; pass < 2; ++pass) {
        if (pass == 1 && sec == 2) {
#pragma unroll
            for (int o = 1; o < 64; o <<= 1) kblk_am = fmaxf(kblk_am, __shfl_xor(kblk_am, o));
            if (lane == 0) ((float*)(p.ws + WS_KS + 12 * MiB))[(size_t)(b * 4 + g) * 256 + ((mt * 128 + wr * 64 - b * SEQ) >> 6)] = kblk_am > 0.f ? kblk_am / 7.5f : 1.0f;
        }
#pragma unroll
        for (int mi = 0; mi < 4; ++mi) {
            const int t = mt * 128 + wr * 64 + mi * 16 + fr, s = t - b * SEQ;
            if (dorope && pass == 0) {
#pragma unroll
                for (int ni = 0; ni < 2; ++ni) {
                    const f32x4* rp = (const f32x4*)(ROPE + (size_t)s * 32 + ni * 16 + fq * 4);
                    const f32x4 r0 = rp[0], r1 = rp[1];
                    const f32x4 x1 = acc[mi][ni], x2 = acc[mi][ni + 2];
                    acc[mi][ni] = (f32x4){x1.x * r0.x - x2.x * r0.y, x1.y * r0.z - x2.y * r0.w, x1.z * r1.x - x2.z * r1.y, x1.w * r1.z - x2.w * r1.w};
                    acc[mi][ni + 2] = (f32x4){x1.x * r0.y + x2.x * r0.x, x1.y * r0.w + x2.y * r0.z, x1.z * r1.y + x2.z * r1.x, x1.w * r1.w + x2.w * r1.z};
                }
            }
            if (pass == 0) {
                if (sec == 2) {
#pragma unroll
                    for (int ni = 0; ni < 4; ++ni) { const f32x4 v = acc[mi][ni]; kblk_am = fmaxf(kblk_am, fmaxf(fmaxf(fabsf(v.x), fabsf(v.y)), fmaxf(fabsf(v.z), fabsf(v.w)))); }
                }
                continue;
            }
            if (sec == -1) {
                float am = 0.f;
#pragma unroll
                for (int ni = 0; ni < 4; ++ni) { const f32x4 v = acc[mi][ni] * scl; am = fmaxf(am, fmaxf(fmaxf(fabsf(v.x), fabsf(v.y)), fmaxf(fabsf(v.z), fabsf(v.w)))); }
                am = fmaxf(am, __shfl_xor(am, 16)); am = fmaxf(am, __shfl_xor(am, 32));
                const float qs = am > 0.f ? 224.0f / am : 1.0f;
                unsigned char* O8 = p.ws + WS_Q8 + (size_t)t * 1024 + c0;
#pragma unroll
                for (int ni = 0; ni < 4; ++ni) {
                    const f32x4 v = acc[mi][ni] * (scl * qs);
                    int w = 0; w = __builtin_amdgcn_cvt_pk_fp8_f32(v.x, v.y, w, false); w = __builtin_amdgcn_cvt_pk_fp8_f32(v.z, v.w, w, true);
                    *(int*)(O8 + ni * 16 + fq * 4) = w;
                }
                if (fq == 0) ((float*)(p.ws + WS_Q8 + 32 * MiB))[(size_t)t * 16 + (c0 >> 6)] = am > 0.f ? am / 224.0f : 1.0f;
            }
#pragma unroll
            for (int ni = 0; ni < 4; ++ni) {
                const f32x4 v = acc[mi][ni] * scl;
                const int d = ni * 16 + fq * 4;
                if (sec == -1) {
                    *(u32x2*)(OUT + (size_t)t * 1024 + c0 + d) = (u32x2){pk2(v.x, v.y), pk2(v.z, v.w)};
                } else if (sec == 4) {
                    const size_t idx = (size_t)(b * 4 + g) * SEQ * 64 + (size_t)(s >> 5) * 2048 + ((((s >> 4) & 1) * 2 + (ni >> 1)) * 16 + (s & 15)) * 32 + ((ni & 1) * 2 + (fq >> 1)) * 8 + (fq & 1) * 4;
                    *(u32x2*)(OUT + idx) = (u32x2){pk2(v.x, v.y), pk2(v.z, v.w)};
                } else if (!vt) {
                    *(u32x2*)(OUT + ((size_t)(b * 4 + g) * SEQ + s) * 64 + d) = (u32x2){pk2(v.x, v.y), pk2(v.z, v.w)};
                } else if (sec == 5) {
                    const int key = s & 31;
                    bf16_t* o = OUT + (size_t)(b * 4 + g) * SEQ * 64 + (size_t)(s >> 5) * 2048 + ((ni * 2 + (key >> 4)) * 16 + fq * 4) * 16 + ((key >> 2) & 3) * 4 + (key & 3);
                    o[0] = (bf16_t)f2bf(v.x); o[16] = (bf16_t)f2bf(v.y); o[32] = (bf16_t)f2bf(v.z); o[48] = (bf16_t)f2bf(v.w);
                }
            }
        }
        }
        if (sec == 3) {
            const int s0 = mt * 128 + wr * 64 - b * SEQ, jb = s0 >> 6;
            bf16_t* VB = (bf16_t*)(p.ws + WS_VSB) + (size_t)((b * 4 + g) * 256 + jb) * 4096;
#pragma unroll
            for (int ni = 0; ni < 4; ++ni) {
                const int d = ni * 16 + fq * 4;
#pragma unroll
                for (int mi = 0; mi < 4; ++mi) {
                    const f32x4 v = acc[mi][ni];
                    bf16_t* o = VB + (size_t)d * 64 + mi * 16 + fr;
                    o[0] = (bf16_t)f2bf(v.x); o[64] = (bf16_t)f2bf(v.y); o[128] = (bf16_t)f2bf(v.z); o[192] = (bf16_t)f2bf(v.w);
                }
            }
        }
    }
}
__device__ __forceinline__ unsigned fp4_code(float x) {
    const float a = fabsf(x);
    const unsigned c = (a > 0.25f ? 1u : 0u) + (a > 0.75f ? 1u : 0u) + (a > 1.25f ? 1u : 0u) + (a > 1.75f ? 1u : 0u) + (a > 2.5f ? 1u : 0u) + (a > 3.5f ? 1u : 0u) + (a > 5.0f ? 1u : 0u);
    return c | (x < 0.f ? 8u : 0u);
}
__device__ __forceinline__ void phase_pack6(const Params& p) {
    const int lane = threadIdx.x & 63, wave = threadIdx.x >> 6;
    int first = vblock() - 128, stride = (int)gridDim.x - 128;
    if (stride <= 0) { first = blockIdx.x; stride = (int)gridDim.x; }
    else if (first < 0) return;
    const bf16_t* KSB = (const bf16_t*)(p.ws + WS_KSB); const bf16_t* VSB = (const bf16_t*)(p.ws + WS_VSB);
    const float* KSC = (const float*)(p.ws + WS_KS + 12 * MiB);
    unsigned char* V6S = p.ws + WS_VST + 12 * MiB;
    for (int it = first * 4 + wave; it < 4096; it += stride * 4) {
        const int kv = it >> 11, blk = it & 2047;
#pragma unroll
        for (int half = 0; half < 2; ++half) {
            const int task = half * 64 + lane;
            u32x4 w4[4];
            float mul;
            if (kv == 0) {
                const int rho = task >> 2, dq = task & 3;
                const int k0 = 32 * ((rho >> 2) & 1) + 16 * (rho >> 4) + 4 * ((rho >> 3) & 1) + (rho & 3);
                const u32x4* s0 = (const u32x4*)(KSB + ((size_t)blk * 64 + k0) * 64 + dq * 16);
                w4[0] = s0[0]; w4[1] = s0[1]; w4[2] = s0[64]; w4[3] = s0[65];
                mul = 1.0f / KSC[blk];
                v16f x0, x1;
#pragma unroll
                for (int q = 0; q < 4; ++q) {
                    x0[q * 4 + 0] = bflo(w4[q].x) * mul; x1[q * 4 + 0] = bfhi(w4[q].x) * mul; x0[q * 4 + 1] = bflo(w4[q].y) * mul; x1[q * 4 + 1] = bfhi(w4[q].y) * mul;
                    x0[q * 4 + 2] = bflo(w4[q].z) * mul; x1[q * 4 + 2] = bfhi(w4[q].z) * mul; x0[q * 4 + 3] = bflo(w4[q].w) * mul; x1[q * 4 + 3] = bfhi(w4[q].w) * mul;
                }
                const v6u w = __builtin_amdgcn_cvt_scalef32_2xpk16_fp6_f32(x0, x1, 1.0f);
                u32x2* dp = (u32x2*)(p.ws + WS_KS + (size_t)blk * 3072 + (size_t)task * 24);
                dp[0] = (u32x2){w[0], w[1]}; dp[1] = (u32x2){w[2], w[3]}; dp[2] = (u32x2){w[4], w[5]};
            } else {
                const u32x4* s0 = (const u32x4*)(VSB + (size_t)blk * 4096 + (size_t)task * 32);
                w4[0] = s0[0]; w4[1] = s0[1]; w4[2] = s0[2]; w4[3] = s0[3];
                float am = 0.f;
#pragma unroll
                for (int q = 0; q < 4; ++q) {
                    am = fmaxf(am, fmaxf(fmaxf(fabsf(bflo(w4[q].x)), fabsf(bfhi(w4[q].x))), fmaxf(fabsf(bflo(w4[q].y)), fabsf(bfhi(w4[q].y)))));
                    am = fmaxf(am, fmaxf(fmaxf(fabsf(bflo(w4[q].z)), fabsf(bfhi(w4[q].z))), fmaxf(fabsf(bflo(w4[q].w)), fabsf(bfhi(w4[q].w)))));
                }
                const unsigned eb = (__float_as_uint(am * (1.0f / 6.0f)) + 0x7FFFFFu) >> 23;
                mul = __uint_as_float((254u - eb) << 23);
                const int d = task >> 1, hf = task & 1;
                V6S[(size_t)blk * 128 + (hf * 16 + (d & 15)) * 4 + (d >> 4)] = (unsigned char)eb;
                u32x4 o;
#pragma unroll
                for (int q = 0; q < 4; ++q) {
                    const unsigned ww[4] = {w4[q].x, w4[q].y, w4[q].z, w4[q].w};
                    unsigned acc8 = 0u;
#pragma unroll
                    for (int e = 0; e < 4; ++e) acc8 |= (fp4_code(bflo(ww[e]) * mul) << (8 * e)) | (fp4_code(bfhi(ww[e]) * mul) << (8 * e + 4));
                    o[q] = acc8;
                }
                *(u32x4*)(p.ws + WS_VST + (size_t)blk * 2048 + (size_t)task * 16) = o;
            }
        }
    }
}
__device__ __forceinline__ void phase_nsa_cmp1(const Params& p, unsigned char* lds) {
    bf16_t* HID = (bf16_t*)(p.ws + WS_HID);
    const float* bias = (const float*)(p.ws + WS_MISC);
    const int lane = threadIdx.x & 63, wid = threadIdx.x >> 6, wr = wid >> 1, wc = wid & 1, fr = lane & 15, fq = lane >> 4;
    for (int id = vblock(); id < 256; id += gridDim.x) {
        const int kv = id >> 7, bg = (id >> 4) & 7, mt = (id >> 1) & 7, nt = id & 1;
        const bf16_t* A = (const bf16_t*)(p.ws + (kv ? WS_VC : WS_KC)) + (size_t)bg * SEQ * 64 + (size_t)mt * 128 * 1024;
        const bf16_t* B = (const bf16_t*)(p.ws + (kv ? WS_WV1_T : WS_WK1_T)) + (size_t)nt * 128 * 2048;
        f32x4 acc[4][4];
        gemm_tile3(ALoadPlain{A, (size_t)1024}, B, 2048, 32, acc, lds);
#pragma unroll
        for (int mi = 0; mi < 4; ++mi)
#pragma unroll
            for (int ni = 0; ni < 4; ++ni) {
                const int n = mt * 128 + wr * 64 + mi * 16 + fr, c = nt * 128 + wc * 64 + ni * 16 + fq * 4;
                const f32x4 bv = *(const f32x4*)(bias + kv * 256 + c);
                const f32x4 v = acc[mi][ni] + bv;
                *(u32x2*)(HID + (((size_t)kv * 8 + bg) * 1024 + n) * 256 + c) = (u32x2){pk2(gelu_tanh(v.x), gelu_tanh(v.y)), pk2(gelu_tanh(v.z), gelu_tanh(v.w))};
            }
    }
}
__device__ __forceinline__ void phase_nsa_cmp2(const Params& p, unsigned char* lds) {
    const bf16_t* HID = (const bf16_t*)(p.ws + WS_HID);
    const f32x2* ROPE = (const f32x2*)(p.ws + WS_ROPE);
    bf16_t* KCMP = (bf16_t*)(p.ws + WS_KCMP); bf16_t* VCMPT = (bf16_t*)(p.ws + WS_VCMPT);
    const int lane = threadIdx.x & 63, wid = threadIdx.x >> 6, wr = wid >> 1, wc = wid & 1, fr = lane & 15, fq = lane >> 4;
    for (int id = vblock(); id < 128; id += gridDim.x) {
        const int kv = id >> 6, mt = id & 63;
        const bf16_t* A = HID + ((size_t)kv * 8192 + (size_t)mt * 128) * 256;
        const bf16_t* B = (const bf16_t*)(p.ws + (kv ? WS_WV2_T : WS_WK2_T));
        f32x4 acc[4][4];
        gemm_tile3(ALoadPlain{A, (size_t)256}, B, 256, 4, acc, lds);
        if (wc == 1) continue;
#pragma unroll
        for (int mi = 0; mi < 4; ++mi) {
            const int R = mt * 128 + wr * 64 + mi * 16 + fr, bg = R >> 10, n = R & 1023;
            if (kv == 0) {
                int pos = n * 16 + 31; pos = pos > SEQ - 1 ? SEQ - 1 : pos;
#pragma unroll
                for (int ni = 0; ni < 2; ++ni) {
                    const f32x4* rp = (const f32x4*)(ROPE + (size_t)pos * 32 + ni * 16 + fq * 4);
                    const f32x4 r0 = rp[0], r1 = rp[1];
                    const f32x4 x1 = acc[mi][ni], x2 = acc[mi][ni + 2];
                    acc[mi][ni] = (f32x4){x1.x * r0.x - x2.x * r0.y, x1.y * r0.z - x2.y * r0.w, x1.z * r1.x - x2.z * r1.y, x1.w * r1.z - x2.w * r1.w};
                    acc[mi][ni + 2] = (f32x4){x1.x * r0.y + x2.x * r0.x, x1.y * r0.w + x2.y * r0.z, x1.z * r1.y + x2.z * r1.x, x1.w * r1.w + x2.w * r1.z};
                }
#pragma unroll
                for (int ni = 0; ni < 4; ++ni) {
                    const f32x4 v = acc[mi][ni];
                    const size_t idx = (size_t)bg * 1024 * 64 + (size_t)(n >> 5) * 2048 + ((((n >> 4) & 1) * 2 + (ni >> 1)) * 16 + (n & 15)) * 32 + ((ni & 1) * 2 + (fq >> 1)) * 8 + (fq & 1) * 4;
                    *(u32x2*)(KCMP + idx) = (u32x2){pk2(v.x, v.y), pk2(v.z, v.w)};
                }
            } else {
#pragma unroll
                for (int ni = 0; ni < 4; ++ni) {
                    const f32x4 v = acc[mi][ni];
                    const int key = n & 31;
                    bf16_t* o = VCMPT + (size_t)bg * 1024 * 64 + (size_t)(n >> 5) * 2048 + ((ni * 2 + (key >> 4)) * 16 + fq * 4) * 16 + ((key >> 2) & 3) * 4 + (key & 3);
                    o[0] = (bf16_t)f2bf(v.x); o[16] = (bf16_t)f2bf(v.y); o[32] = (bf16_t)f2bf(v.z); o[48] = (bf16_t)f2bf(v.w);
                }
            }
        }
    }
}
__device__ __forceinline__ void phase_nsa_wo(const Params& p, unsigned char* lds, bool dry) {
    const bf16_t* O = (const bf16_t*)(p.ws + WS_O); const bf16_t* WT = (const bf16_t*)(p.ws + WS_WO_T);
    const float* MOD = (const float*)(p.ws + WS_MOD);
    bf16_t* X = (bf16_t*)(p.ws + WS_XB);
    const int lane = threadIdx.x & 63, wid = threadIdx.x >> 6, wr = wid >> 1, wc = wid & 1, fr = lane & 15, fq = lane >> 4;
    for (int id = vblock(); id < 256 * 8; id += gridDim.x) {
        const int mt = id >> 3, nt = id & 7;
        f32x4 acc[4][4]; u32x2 xr[4][4];
#pragma unroll
        for (int mi = 0; mi < 4; ++mi)
#pragma unroll
            for (int ni = 0; ni < 4; ++ni) xr[mi][ni] = *(const u32x2*)(X + (size_t)(mt * 128 + wr * 64 + mi * 16 + fr) * D + nt * 128 + wc * 64 + ni * 16 + fq * 4);
        gemm_tile3(ALoadPlain{O + (size_t)mt * 128 * D, (size_t)D}, WT + (size_t)nt * 128 * D, D, 16, acc, lds);
        const int b = (mt * 128) / SEQ;
#pragma unroll
        for (int mi = 0; mi < 4; ++mi)
#pragma unroll
            for (int ni = 0; ni < 4; ++ni) {
                const int t = mt * 128 + wr * 64 + mi * 16 + fr, c = nt * 128 + wc * 64 + ni * 16 + fq * 4;
                const f32x4 g1 = *(const f32x4*)(MOD + (size_t)(1 * 2 + b) * 6144 + 2048 + c);
                bf16_t* xp = X + (size_t)t * D + c;
                const u32x2 xw = xr[mi][ni]; const f32x4 v = acc[mi][ni];
                if (!dry) *(u32x2*)xp = (u32x2){pk2(bflo(xw.x) + g1.x * v.x, bfhi(xw.x) + g1.y * v.y), pk2(bflo(xw.y) + g1.z * v.z, bfhi(xw.y) + g1.w * v.w)};
            }
    }
}
__device__ __forceinline__ bf16x8 pack8(const f32x4 a, const f32x4 b) {
    u32x4 w; w.x = pk2(a.x, a.y); w.y = pk2(a.z, a.w); w.z = pk2(b.x, b.y); w.w = pk2(b.z, b.w);
    return __builtin_bit_cast(bf16x8, w);
}
__device__ __forceinline__ bf16x8 ldv8(const bf16_t* plo, const bf16_t* phi) {
    const u32x2 lo = *(const u32x2*)plo, hi = *(const u32x2*)phi;
    u32x4 w; w.x = lo.x; w.y = lo.y; w.z = hi.x; w.w = hi.y;
    return __builtin_bit_cast(bf16x8, w);
}
__device__ __forceinline__ float red4(float v) { v += __shfl_xor(v, 16); v += __shfl_xor(v, 32); return v; }
__device__ __forceinline__ float max4(float v) { v = fmaxf(v, __shfl_xor(v, 16)); v = fmaxf(v, __shfl_xor(v, 32)); return v; }
__device__ __forceinline__ float rep4_sum(float v) {
    v += __builtin_bit_cast(float, __builtin_amdgcn_update_dpp(__builtin_bit_cast(int, v), __builtin_bit_cast(int, v), 0x124, 0xF, 0xF, false));
    v += __builtin_bit_cast(float, __builtin_amdgcn_update_dpp(__builtin_bit_cast(int, v), __builtin_bit_cast(int, v), 0x128, 0xF, 0xF, false));
    return v;
}
__device__ __forceinline__ float rep4_max(float v) {
    v = fmaxf(v, __builtin_bit_cast(float, __builtin_amdgcn_update_dpp(__builtin_bit_cast(int, v), __builtin_bit_cast(int, v), 0x124, 0xF, 0xF, false)));
    v = fmaxf(v, __builtin_bit_cast(float, __builtin_amdgcn_update_dpp(__builtin_bit_cast(int, v), __builtin_bit_cast(int, v), 0x128, 0xF, 0xF, false)));
    return v;
}
#define NEGBIG (-1.0e30f)
#ifndef TS_SECTION
#define TS_SECTION (-1)
#endif
#define TSS_MARK(sec_) do { if (TS_SECTION >= 0) { const unsigned long long now_ = __builtin_amdgcn_s_memrealtime(); if (TS_SECTION == (sec_)) tss_acc += (unsigned)(now_ - tss_last); tss_last = now_; } } while (0)

__device__ __forceinline__ void phase_nsa_attn(const Params& p, unsigned char* lds, const int rep_cmp, const int rep_win, const int rep_sel) {
    const int lane = threadIdx.x & 63, wave = threadIdx.x >> 6, fr = lane & 15, fq = lane >> 4;
    unsigned char* WL = lds + wave * 18432;
    float* IMP = (float*)WL;
    int* SEL = (int*)(WL + 17408);
    const bf16_t* Q = (const bf16_t*)(p.ws + WS_Q);
    const bf16_t* KCMP = (const bf16_t*)(p.ws + WS_KCMP); const bf16_t* VCMPT = (const bf16_t*)(p.ws + WS_VCMPT);
    const bf16_t* KW = (const bf16_t*)(p.ws + WS_KW); const bf16_t* VWT = (const bf16_t*)(p.ws + WS_VWT);
    const float* NGT = (const float*)(p.ws + WS_NG);
    bf16_t* O = (bf16_t*)(p.ws + WS_O);
    const f32x4 z4 = (f32x4){0.f, 0.f, 0.f, 0.f};
    unsigned long long tss_last = 0ull; unsigned tss_acc = 0u;
    for (int bi = blockIdx.x; bi < 2048; bi += gridDim.x) {
        TSS_MARK(-2);
        int quad = 255 - (bi >> 3);
        if (gridDim.x == 512) { const int k = bi >> 9, j = (bi >> 3) & 63; quad = (k == 0) ? 255 - j : (k == 1) ? 128 + j : (k == 2) ? 127 - j : j; }
        const int bg = bi & 7, t0 = (quad * 4 + wave) * 16, b = bg >> 2, g = bg & 3;
        const int cur = t0 >> 6;
        const size_t tok = (size_t)b * SEQ + t0 + fr;
        const int tq = t0 + fr;
        bf16x8 qf[4][2];
#pragma unroll
        for (int r = 0; r < 4; ++r)
#pragma unroll
            for (int ks = 0; ks < 2; ++ks) qf[r][ks] = *(const bf16x8*)(Q + tok * 1024 + (g * 4 + r) * 64 + ks * 32 + fq * 8);
        f32x4 acc[4][4];
        for (int rep = 0; rep < rep_win; ++rep) {
            const bf16_t* kwb = KW + (size_t)bg * SEQ * 64; const bf16_t* vwb = VWT + (size_t)bg * SEQ * 64;
            float mw[4], lw[4];
#pragma unroll
            for (int r = 0; r < 4; ++r) { mw[r] = NEGBIG; lw[r] = 0.f;
#pragma unroll
                for (int df = 0; df < 4; ++df) acc[r][df] = z4; }
            int kmin = t0 - 511; kmin = kmin < 0 ? 0 : kmin; kmin &= ~31;
            bf16x8 nkf[2][2];
#define WIN_LOAD(kb_) do { _Pragma("unroll") for (int f = 0; f < 2; ++f) _Pragma("unroll") for (int ks = 0; ks < 2; ++ks) nkf[f][ks] = *(const bf16x8*)(kwb + (size_t)((kb_) >> 5) * 2048 + ((f * 2 + ks) * 16 + fr) * 32 + fq * 8); } while (0)
            WIN_LOAD(kmin);
            for (int kb = kmin; kb <= t0 + 15; kb += 32) {
                bf16x8 kf[2][2], vf[4];
#pragma unroll
                for (int f = 0; f < 2; ++f) { kf[f][0] = nkf[f][0]; kf[f][1] = nkf[f][1]; }
#pragma unroll
                for (int df = 0; df < 4; ++df) { const bf16_t* vp = vwb + (size_t)(kb >> 5) * 2048 + (df * 32 + fr) * 16 + fq * 4; vf[df] = ldv8(vp, vp + 256); }
                { const int kn = (kb + 32 <= t0 + 15) ? kb + 32 : kb; WIN_LOAD(kn); }
#define WIN_HEADS(MASKED) _Pragma("unroll") for (int r = 0; r < 4; ++r) { \
                    f32x4 st[2]; \
                    _Pragma("unroll") for (int f = 0; f < 2; ++f) { \
                        st[f] = __builtin_amdgcn_mfma_f32_16x16x32_bf16(kf[f][0], qf[r][0], z4, 0, 0, 0); \
                        st[f] = __builtin_amdgcn_mfma_f32_16x16x32_bf16(kf[f][1], qf[r][1], st[f], 0, 0, 0); } \
                    float mx = NEGBIG; \
                    _Pragma("unroll") for (int f = 0; f < 2; ++f) _Pragma("unroll") for (int e = 0; e < 4; ++e) { \
                        const int key = kb + f * 16 + fq * 4 + e; const bool ok = !(MASKED) || ((key <= tq) && (key > tq - 512)); if (ok) mx = fmaxf(mx, st[f][e]); } \
                    float mn = mw[r]; \
                    if (__builtin_amdgcn_ballot_w64(mx > mw[r] + 8.0f) != 0ull) { \
                        mn = fmaxf(mw[r], max4(mx)); const float al = __expf(mw[r] - mn); lw[r] *= al; \
                        _Pragma("unroll") for (int df = 0; df < 4; ++df) acc[r][df] = acc[r][df] * al; } \
                    const float mnl = mn * 1.4426950408889634f; \
                    float ps = 0.f; \
                    _Pragma("unroll") for (int f = 0; f < 2; ++f) _Pragma("unroll") for (int e = 0; e < 4; ++e) { \
                        const int key = kb + f * 16 + fq * 4 + e; const bool ok = !(MASKED) || ((key <= tq) && (key > tq - 512)); \
                        const float pv = ok ? __builtin_amdgcn_exp2f(st[f][e] * 1.4426950408889634f - mnl) : 0.f; st[f][e] = pv; ps += pv; } \
                    lw[r] += ps; mw[r] = mn; \
                    const bf16x8 pf = pack8(st[0], st[1]); \
                    _Pragma("unroll") for (int df = 0; df < 4; ++df) acc[r][df] = __builtin_amdgcn_mfma_f32_16x16x32_bf16(vf[df], pf, acc[r][df], 0, 0, 0); \
                    __builtin_amdgcn_sched_barrier(0); }
                if ((kb + 31 <= t0) && (kb > t0 + 15 - 512)) { WIN_HEADS(0) } else { WIN_HEADS(1) }
#undef WIN_HEADS
            }
#pragma unroll
            for (int r = 0; r < 4; ++r) {
                const float l = red4(lw[r]); const float sc = NGT[tok * 48 + (g * 4 + r) * 3 + 2] / l;
#pragma unroll
                for (int df = 0; df < 4; ++df) acc[r][df] = acc[r][df] * sc;
            }
#undef WIN_LOAD
        }
        TSS_MARK(0);
        const int nmax_tile = (t0 >> 4) - 1, nmax_lane = (t0 >> 4) - 2 + (fr == 15 ? 1 : 0);
        const bf16_t* kcb = KCMP + (size_t)bg * 1024 * 64; const bf16_t* vcb = VCMPT + (size_t)bg * 64 * 1024;
        for (int rep = 0; rep < rep_cmp; ++rep) {
            const bool dry = (rep + 1 < rep_cmp);
            float mc[4], lc[4], invl[4];
#pragma unroll
            for (int r = 0; r < 4; ++r) { mc[r] = NEGBIG; lc[r] = 0.f; }
            bf16x8 nkc[2][2], nvc[4];
#define CMPK_LOAD(nb_) do { _Pragma("unroll") for (int f = 0; f < 2; ++f) _Pragma("unroll") for (int ks = 0; ks < 2; ++ks) nkc[f][ks] = *(const bf16x8*)(kcb + (size_t)((nb_) >> 5) * 2048 + ((f * 2 + ks) * 16 + fr) * 32 + fq * 8); } while (0)
#define CMPV_LOAD(nb_) do { _Pragma("unroll") for (int df = 0; df < 4; ++df) { const bf16_t* vp = vcb + (size_t)((nb_) >> 5) * 2048 + (df * 32 + fr) * 16 + fq * 4; nvc[df] = ldv8(vp, vp + 256); } } while (0)
            CMPK_LOAD(0);
            for (int nb = 0; nb <= nmax_tile; nb += 32) {
                bf16x8 kf[2][2];
#pragma unroll
                for (int f = 0; f < 2; ++f) { kf[f][0] = nkc[f][0]; kf[f][1] = nkc[f][1]; }
                { const int nn = (nb + 32 <= nmax_tile) ? nb + 32 : 0; CMPK_LOAD(nn); }
#define CMP1_HEADS(MASKED) _Pragma("unroll") for (int r = 0; r < 4; ++r) { \
                    f32x4 st[2]; \
                    _Pragma("unroll") for (int f = 0; f < 2; ++f) { \
                        st[f] = __builtin_amdgcn_mfma_f32_16x16x32_bf16(kf[f][0], qf[r][0], z4, 0, 0, 0); \
                        st[f] = __builtin_amdgcn_mfma_f32_16x16x32_bf16(kf[f][1], qf[r][1], st[f], 0, 0, 0); } \
                    float mx = NEGBIG; \
                    _Pragma("unroll") for (int f = 0; f < 2; ++f) _Pragma("unroll") for (int e = 0; e < 4; ++e) { const int n = nb + f * 16 + fq * 4 + e; if (!(MASKED) || n <= nmax_lane) mx = fmaxf(mx, st[f][e]); } \
                    float mn = mc[r];                                      \
                    if (__builtin_amdgcn_ballot_w64(mx > mc[r] + 8.0f) != 0ull) { mn = fmaxf(mc[r], max4(mx)); lc[r] *= __expf(mc[r] - mn); } \
                    const float mnl = mn * 1.4426950408889634f; \
                    float ps = 0.f; \
                    _Pragma("unroll") for (int f = 0; f < 2; ++f) _Pragma("unroll") for (int e = 0; e < 4; ++e) { const int n = nb + f * 16 + fq * 4 + e; if (!(MASKED) || n <= nmax_lane) ps += __builtin_amdgcn_exp2f(st[f][e] * 1.4426950408889634f - mnl); } \
                    lc[r] += ps; mc[r] = mn; \
                    __builtin_amdgcn_sched_barrier(0); }
                if (nb + 31 <= (t0 >> 4) - 2) { CMP1_HEADS(0) } else { CMP1_HEADS(1) }
#undef CMP1_HEADS
            }
#pragma unroll
            for (int r = 0; r < 4; ++r) { const float l = red4(lc[r]); invl[r] = l > 0.f ? 1.0f / l : 0.f; }
            for (int i = lane; i < 16 * 260; i += 64) IMP[i] = 0.f;
            float carry = 0.f;
            float gc[4];
#pragma unroll
            for (int r = 0; r < 4; ++r) gc[r] = NGT[tok * 48 + (g * 4 + r) * 3];
            float mcl[4];
#pragma unroll
            for (int r = 0; r < 4; ++r) mcl[r] = mc[r] * 1.4426950408889634f;
            for (int nb = 0; nb <= nmax_tile; nb += 32) {
                bf16x8 kf[2][2], vf[4];
#pragma unroll
                for (int f = 0; f < 2; ++f) { kf[f][0] = nkc[f][0]; kf[f][1] = nkc[f][1]; }
                CMPV_LOAD(nb);
#pragma unroll
                for (int df = 0; df < 4; ++df) vf[df] = nvc[df];
                { const int nn = (nb + 32 <= nmax_tile) ? nb + 32 : nb; CMPK_LOAD(nn); }
                f32x4 pg[2] = {z4, z4};
#define CMP2_HEADS(MASKED) _Pragma("unroll") for (int r = 0; r < 4; ++r) { \
                    f32x4 st[2]; \
                    _Pragma("unroll") for (int f = 0; f < 2; ++f) { \
                        st[f] = __builtin_amdgcn_mfma_f32_16x16x32_bf16(kf[f][0], qf[r][0], z4, 0, 0, 0); \
                        st[f] = __builtin_amdgcn_mfma_f32_16x16x32_bf16(kf[f][1], qf[r][1], st[f], 0, 0, 0); \
                        _Pragma("unroll") for (int e = 0; e < 4; ++e) { const int n = nb + f * 16 + fq * 4 + e; \
                            st[f][e] = (!(MASKED) || n <= nmax_lane) ? __builtin_amdgcn_exp2f(st[f][e] * 1.4426950408889634f - mcl[r]) * invl[r] : 0.f; } \
                        pg[f] += st[f]; } \
                    const float gg = dry ? 0.f : gc[r]; \
                    const bf16x8 pf = pack8(st[0] * gg, st[1] * gg); \
                    _Pragma("unroll") for (int df = 0; df < 4; ++df) acc[r][df] = __builtin_amdgcn_mfma_f32_16x16x32_bf16(vf[df], pf, acc[r][df], 0, 0, 0); \
                    __builtin_amdgcn_sched_barrier(0); }
                if (nb + 31 <= (t0 >> 4) - 2) { CMP2_HEADS(0) } else { CMP2_HEADS(1) }
#undef CMP2_HEADS
                const int src = (lane - 16) & 63;
                const float s0 = __shfl(pg[0].w, src), s1 = __shfl(pg[1].w, src), sc = __shfl(carry, src);
                const float prev0 = fq > 0 ? s0 : sc, prev1 = fq > 0 ? s1 : s0;
                const float imp0 = (pg[0].x + pg[0].y) + (pg[0].z + pg[0].w) + prev0;
                const float imp1 = (pg[1].x + pg[1].y) + (pg[1].z + pg[1].w) + prev1;
                const int jb = (nb >> 2) + fq;
                IMP[fr * 260 + jb] = imp0; IMP[fr * 260 + jb + 4] = imp1;
                carry = pg[1].w;
            }
#undef CMPK_LOAD
#undef CMPV_LOAD
        }
        TSS_MARK(1);
        {
            const int nf = cur >= 2 ? 3 : cur + 1;
            if (fq == 0) {
                SEL[fr * 16 + 0] = 0;
                if (cur == 1) SEL[fr * 16 + 1] = 1;
                if (cur >= 2) { SEL[fr * 16 + 1] = cur - 1; SEL[fr * 16 + 2] = cur; }
            }
            const int ncand = cur >= 3 ? cur - 2 : 0, extra = 16 - nf;
            if (ncand <= extra) {
                if (fq == 0) { for (int k = 0; k < extra; ++k) SEL[fr * 16 + nf + k] = (k < ncand) ? 1 + k : -1; }
            } else {
#define SEL_KEY(v_, jb_) ((((jb_) >= 1) && ((jb_) <= cur - 2) && ((v_) >= 0.f)) ? ((__float_as_uint(v_) & 0xFFFFFF00u) | (unsigned)(255 - (jb_))) : 0u)
                unsigned cm[16];
#pragma unroll
                for (int c = 0; c < 16; ++c) {
                    const int jb4 = 16 * c + 4 * fq;
                    unsigned k_ = 0u;
                    if (16 * c <= cur - 2) {
                        const f32x4 v4 = *(const f32x4*)(IMP + fr * 260 + jb4);
                        const unsigned k0_ = SEL_KEY(v4.x, jb4), k1_ = SEL_KEY(v4.y, jb4 + 1), k2_ = SEL_KEY(v4.z, jb4 + 2), k3_ = SEL_KEY(v4.w, jb4 + 3);
                        k_ = max(max(k0_, k1_), max(k2_, k3_));
                    }
                    cm[c] = k_;
                }
                for (int rnd = 0; rnd < extra; ++rnd) {
                    unsigned m_ = max(max(max(cm[0], cm[1]), max(cm[2], cm[3])), max(max(cm[4], cm[5]), max(cm[6], cm[7])));
                    m_ = max(m_, max(max(max(cm[8], cm[9]), max(cm[10], cm[11])), max(max(cm[12], cm[13]), max(cm[14], cm[15]))));
                    m_ = max(m_, (unsigned)__shfl_xor((int)m_, 16)); m_ = max(m_, (unsigned)__shfl_xor((int)m_, 32));
                    const int bj = 255 - (int)(m_ & 255u);
                    if (fq == 0) SEL[fr * 16 + nf + rnd] = bj;
                    const bool own_ = (((bj >> 2) & 3) == fq);
                    if (own_) IMP[fr * 260 + bj] = -2.0f;
                    const int cw_ = own_ ? (bj >> 4) : -1;
                    const int jb4 = (bj & ~15) + 4 * fq;
                    const f32x4 v4 = *(const f32x4*)(IMP + fr * 260 + jb4);
                    const unsigned k0_ = SEL_KEY(v4.x, jb4), k1_ = SEL_KEY(v4.y, jb4 + 1), k2_ = SEL_KEY(v4.z, jb4 + 2), k3_ = SEL_KEY(v4.w, jb4 + 3);
                    const unsigned nk_ = max(max(k0_, k1_), max(k2_, k3_));
#pragma unroll
                    for (int c = 0; c < 16; ++c) cm[c] = (cw_ == c) ? nk_ : cm[c];
                }
#undef SEL_KEY
            }
        }
#pragma unroll
        for (int r = 0; r < 4; ++r)
#pragma unroll
            for (int df = 0; df < 4; ++df) {
                const f32x4 v = acc[r][df];
                *(u32x2*)(O + tok * 1024 + (g * 4 + r) * 64 + df * 16 + fq * 4) = (u32x2){pk2(v.x, v.y), pk2(v.z, v.w)};
            }
        asm volatile("s_waitcnt vmcnt(0)" ::: "memory");
        unsigned selp[4];
        {
            const u32x4* sp = (const u32x4*)(SEL + fr * 16);
#pragma unroll
            for (int q = 0; q < 4; ++q) { const u32x4 w = sp[q]; selp[q] = (w.x & 255u) | ((w.y & 255u) << 8) | ((w.z & 255u) << 16) | ((w.w & 255u) << 24); }
        }
        TSS_MARK(2);
        const int t0_v = t0, b_v = b, g_v = g;
        int lane_s = lane; asm volatile("" : "+v"(lane_s));
        for (int rep = 0; rep < rep_sel; ++rep) {
            const int lane = lane_s, fr = lane & 15, fq = lane >> 4;
            const int t0 = __builtin_amdgcn_readfirstlane(t0_v), cur = t0 >> 6, b = __builtin_amdgcn_readfirstlane(b_v), g = __builtin_amdgcn_readfirstlane(g_v), bg = b * 4 + g;
            const bool dry = (rep + 1 < rep_sel);
            const unsigned char* k6b = p.ws + WS_KS + (size_t)bg * 256 * 3072; const unsigned char* v6b = p.ws + WS_VST + (size_t)bg * 256 * 2048;
            const float* skb = (const float*)(p.ws + WS_KS + 12 * MiB) + (size_t)bg * 256;
            const unsigned char* v6s = p.ws + WS_VST + 12 * MiB + (size_t)bg * 256 * 128 + ((fq & 1) * 16 + fr) * 4;
            const unsigned char* Q8 = p.ws + WS_Q8; const float* SQ8 = (const float*)(p.ws + WS_Q8 + 32 * MiB);
            const int nv = cur + 1 < 16 ? cur + 1 : 16, npair = (nv + 1) >> 1, total = 16 * npair;
            const int rr = fr & 3;
            const int jq = fr >> 2;
            const bool fhi = (fq >> 1) != 0;
            const int rdk = (fr >> 3) * 3088 + (fr & 7) * 96 + fq * 24;
            const int rdv = 6176 + (fq >> 1) * 2048 + fr * 32 + (((fq & 1) ^ ((fr >> 3) & 1)) << 4);
            const int wrv = 6176 + (lane >> 1) * 32 + (((lane & 1) ^ ((lane >> 4) & 1)) << 4);
            u32x4 sk[2][3], sv[2][2]; float ssk[2]; unsigned vscn;
            int jbn[2];
            int tsel[4] = {0, 0, 0, 0};
#define SEL_GET(slotK) ((int)(((unsigned)(((slotK) >> 2) == 0 ? tsel[0] : ((slotK) >> 2) == 1 ? tsel[1] : ((slotK) >> 2) == 2 ? tsel[2] : tsel[3]) >> (((slotK) & 3) * 8)) & 255u))
#define SEL_ISSUE(tokI, pairP) do { \
                if ((pairP) == 0) { _Pragma("unroll") for (int q_ = 0; q_ < 4; ++q_) tsel[q_] = __builtin_amdgcn_readlane((int)selp[q_], (tokI)); } \
                const int k0_ = 2 * (pairP), k1_ = (2 * (pairP) + 1 < nv) ? 2 * (pairP) + 1 : k0_; \
                jbn[0] = SEL_GET(k0_); jbn[1] = SEL_GET(k1_); \
                _Pragma("unroll") for (int u = 0; u < 2; ++u) { \
                    const unsigned char* kb_ = k6b + (size_t)jbn[u] * 3072; const unsigned char* vb_ = v6b + (size_t)jbn[u] * 2048; \
                    _Pragma("unroll") for (int j = 0; j < 3; ++j) sk[u][j] = *(const u32x4*)(kb_ + j * 1024 + lane * 16); \
                    _Pragma("unroll") for (int j = 0; j < 2; ++j) sv[u][j] = *(const u32x4*)(vb_ + j * 1024 + lane * 16); \
                    ssk[u] = skb[jbn[u]]; } \
                vscn = *(const unsigned*)(v6s + (size_t)(fhi ? jbn[1] : jbn[0]) * 128); } while (0)
            SEL_ISSUE(0, 0);
            v8i bq[2] = {(v8i){0, 0, 0, 0, 0, 0, 0, 0}, (v8i){0, 0, 0, 0, 0, 0, 0, 0}};
            float sq = 0.f, ms = NEGBIG, ls = 0.f;
            f32x4 os[4] = {z4, z4, z4, z4};
            u32x2 oprev[4] = {(u32x2){0u, 0u}, (u32x2){0u, 0u}, (u32x2){0u, 0u}, (u32x2){0u, 0u}};
            int i = 0, pp = 0;
            for (int v = 0; v < total; ++v) {
                const int jb0 = jbn[0], jb1 = jbn[1];
                const bool second_valid = (2 * pp + 1 < nv);
                const float ck0 = ssk[0], ck1 = ssk[1];
                const int vsc = (int)vscn;
#pragma unroll
                for (int u = 0; u < 2; ++u)
#pragma unroll
                    for (int j = 0; j < 3; ++j) {
                        *(u32x4*)(WL + u * 3088 + j * 1024 + lane * 16) = sk[u][j];
                        if (j < 2) *(u32x4*)(WL + wrv + u * 2048 + j * 1024) = sv[u][j];
                    }
                if (v + 1 < total) {
                    int p2 = pp + 1, i2 = i; if (p2 == npair) { p2 = 0; i2 = i + 1; }
                    SEL_ISSUE(i2, p2);
                }
                const int ti = t0 + i;
                if (pp == 0) {
                    const size_t tk = (size_t)b * SEQ + ti;
                    {
                        const u32x4 q16 = *(const u32x4*)(Q8 + tk * 1024 + (g * 4 + rr) * 64 + fq * 16);
#pragma unroll
                        for (int P = 0; P < 2; ++P) {
                            const bool lo = (jq == 2 * P), hi = (jq == 2 * P + 1);
                            bq[P] = (v8i){lo ? (int)q16.x : 0, lo ? (int)q16.y : 0, lo ? (int)q16.z : 0, lo ? (int)q16.w : 0,
                                          hi ? (int)q16.x : 0, hi ? (int)q16.y : 0, hi ? (int)q16.z : 0, hi ? (int)q16.w : 0};
                        }
                    }
                    sq = SQ8[tk * 16 + g * 4 + rr] * 1.4426950408889634f;
                    ms = NEGBIG; ls = 0.f;
#pragma unroll
                    for (int df = 0; df < 4; ++df) { os[df] = z4; oprev[df] = *(const u32x2*)(O + tk * 1024 + (g * 4 + rr) * 64 + df * 16 + fq * 4); }
                }
                f32x4 a0, a1;
#define SEL_S(m_, acc_) do { \
                    const unsigned char* ap_ = WL + rdk + (m_) * 768; \
                    const u32x2 r0_ = *(const u32x2*)ap_, r1_ = *(const u32x2*)(ap_ + 8), r2_ = *(const u32x2*)(ap_ + 16); \
                    const v8i ka_ = (v8i){(int)r0_.x, (int)r0_.y, (int)r1_.x, (int)r1_.y, (int)r2_.x, (int)r2_.y, 0, 0}; \
                    acc_ = __builtin_amdgcn_mfma_scale_f32_16x16x128_f8f6f4(ka_, bq[(m_) >> 1], acc_, 2, 0, 0, 0x7f7f7f7f, 0, 0x7f7f7f7f); } while (0)
                a0 = z4; a1 = z4;
                SEL_S(0, a0); SEL_S(1, a1); SEL_S(2, a0); SEL_S(3, a1);
#undef SEL_S
                const float c_own = sq * (fhi ? ck1 : ck0);
                if (jb0 == cur || jb1 == cur || !second_valid) {
                    const int jbu = fhi ? jb1 : jb0;
                    const bool allbad = fhi && !second_valid;
                    const int key0 = jbu * 64 + 32 * (fq & 1) + 8 * jq;
#pragma unroll
                    for (int e = 0; e < 4; ++e) { if (allbad || key0 + e > ti) a0[e] = NEGBIG; if (allbad || key0 + 4 + e > ti) a1[e] = NEGBIG; }
                }
                const float mxr = fmaxf(fmaxf(fmaxf(a0.x, a0.y), fmaxf(a0.z, a0.w)), fmaxf(fmaxf(a1.x, a1.y), fmaxf(a1.z, a1.w)));
                const float mxl = mxr > -1.0e29f ? mxr * c_own : NEGBIG;
                float mn = ms;
                if (__builtin_amdgcn_ballot_w64(mxl > ms + 4.0f) != 0ull) {
                    const float m16 = rep4_max(max4(mxl));
                    mn = fmaxf(ms, m16);
                    const float al = __builtin_amdgcn_exp2f(ms - mn);
                    ls *= al;
#pragma unroll
                    for (int df = 0; df < 4; ++df) os[df] = os[df] * al;
                }
                const float off = 4.0f - mn;
                float ps = 0.f;
#pragma unroll
                for (int e = 0; e < 4; ++e) { a0[e] = __builtin_amdgcn_exp2f(a0[e] * c_own + off); a1[e] = __builtin_amdgcn_exp2f(a1[e] * c_own + off); ps += a0[e] + a1[e]; }
                ls += ps; ms = mn;
                int w0 = 0, w1 = 0;
                w0 = __builtin_amdgcn_cvt_pk_fp8_f32(a0.x, a0.y, w0, false); w0 = __builtin_amdgcn_cvt_pk_fp8_f32(a0.z, a0.w, w0, true);
                w1 = __builtin_amdgcn_cvt_pk_fp8_f32(a1.x, a1.y, w1, false); w1 = __builtin_amdgcn_cvt_pk_fp8_f32(a1.z, a1.w, w1, true);
                const v8i pb = (v8i){jq == 0 ? w0 : 0, jq == 0 ? w1 : 0, jq == 1 ? w0 : 0, jq == 1 ? w1 : 0, jq == 2 ? w0 : 0, jq == 2 ? w1 : 0, jq == 3 ? w0 : 0, jq == 3 ? w1 : 0};
#define SEL_PV(df_) do { \
                    const u32x4 r_ = *(const u32x4*)(WL + rdv + (df_) * 512); \
                    const v8i va_ = (v8i){(int)r_.x, (int)r_.y, (int)r_.z, (int)r_.w, 0, 0, 0, 0}; \
                    os[df_] = __builtin_amdgcn_mfma_scale_f32_16x16x128_f8f6f4(va_, pb, os[df_], 4, 0, df_, vsc, 0, 0x7f7f7f7f); } while (0)
                SEL_PV(0); SEL_PV(1); SEL_PV(2); SEL_PV(3);
#undef SEL_PV
                if (pp == npair - 1) {
                    const float l = rep4_sum(red4(ls));
#pragma unroll
                    for (int df = 0; df < 4; ++df)
#pragma unroll
                        for (int e = 0; e < 4; ++e) os[df][e] = rep4_sum(os[df][e]);
                    const float gsv = NGT[((size_t)b * SEQ + ti) * 48 + (g * 4 + rr) * 3 + 1];
                    const float sc = gsv / l;
                    if (fr < 4 && !dry) {
                        bf16_t* op = O + ((size_t)b * SEQ + ti) * 1024 + (g * 4 + fr) * 64 + fq * 4;
#pragma unroll
                        for (int df = 0; df < 4; ++df) {
                            const f32x4 val = os[df] * sc; const u32x2 c = oprev[df];
                            *(u32x2*)(op + df * 16) = (u32x2){pk2(bflo(c.x) + val.x, bfhi(c.x) + val.y), pk2(bflo(c.y) + val.z, bfhi(c.y) + val.w)};
                        }
                    }
                }
                ++pp; if (pp == npair) { pp = 0; ++i; }
            }
#undef SEL_GET
#undef SEL_ISSUE
        }
        TSS_MARK(3);
    }
    if (TS_SECTION >= 0 && blockIdx.x == 0 && threadIdx.x == 0) ((unsigned*)(lds + LDS_BYTES))[2] = tss_acc;
}
constexpr int NPHASES = 18;
#ifndef PROBE_PHASE
#define PROBE_PHASE (-1)
#endif
#ifndef ATT_REP_CMP
#define ATT_REP_CMP 1
#endif
#ifndef ATT_REP_WIN
#define ATT_REP_WIN 1
#endif
#ifndef ATT_REP_SEL
#define ATT_REP_SEL 1
#endif
#ifndef TS_PHASE
#define TS_PHASE (-1)
#endif
#ifndef TS_MULT
#define TS_MULT 4
#endif
#ifndef PROBE_REPS
#define PROBE_REPS 1
#endif
__global__ void __launch_bounds__(NTHREADS, 2) mega(Params p) {
    __shared__ __attribute__((aligned(1024))) unsigned char lds[LDS_BYTES + 16];
    unsigned* bar_st = (unsigned*)(lds + LDS_BYTES);
    cg::grid_group grid = cg::this_grid();
    const float* MOD = (const float*)(p.ws + WS_MOD);
    bf16_t* HM = (bf16_t*)(p.ws + WS_HM);
    if (threadIdx.x < 4) bar_st[threadIdx.x] = 0u;
    __syncthreads();
    XcdBarrier bar = xcd_barrier_post((unsigned*)(p.ws + WS_CTL), (volatile LAS unsigned*)bar_st);
    const int lo = p.ph_lo, hi = p.ph_hi;
    const bool dry0 = (p.ph_hi < 0);
    const int opq = (p.ph_hi < 0) ? 1 : 0;
    const bool never = (p.ph_hi < 0);
    unsigned long long ts_a = 0ull, ts_b = 0ull;
#define PHASE(k, call, drycall) if (lo <= (k) && (k) < hi) { \
        if (TS_PHASE == (k)) ts_a = __builtin_amdgcn_s_memrealtime(); \
        if (PROBE_PHASE == (k)) { for (int rep = 0; rep < PROBE_REPS; ++rep) { const bool dry = !dry0; drycall; __syncthreads(); } } \
        { const bool dry = dry0; call; } \
        if ((k) + 1 < hi) { if (never) grid.sync(); else xcd_barrier(bar); } \
        if (TS_PHASE == (k)) ts_b = __builtin_amdgcn_s_memrealtime(); }
    PHASE(0, phase_prep(p, (float*)lds, 0), phase_prep(p, (float*)lds, 0))
    PHASE(1, phase_norm(p, p.in[0], p.in[2], MOD + 0, MOD + 1024, HM), phase_norm(p, p.in[0], p.in[2], MOD + 0, MOD + 1024, HM))
    PHASE(2, phase_s5_win(p, lds), phase_s5_win(p, lds))
    PHASE(3, phase_s5_a(p, lds), phase_s5_a(p, lds))
    PHASE(4, (phase_s5_scan(p), phase_prep(p, (float*)lds, 1)), (phase_s5_scan(p), phase_prep(p, (float*)lds, 1)))
    PHASE(5, phase_s5_b(p, lds), phase_s5_b(p, lds))
    PHASE(6, phase_s5_glu(p, lds), phase_s5_glu(p, lds))
    PHASE(7, phase_norm_b(p, (const bf16_t*)(p.ws + WS_XB), p.in[3], MOD + 3072, MOD + 4096, HM), phase_norm_b(p, (const bf16_t*)(p.ws + WS_XB), p.in[3], MOD + 3072, MOD + 4096, HM))
    PHASE(8, phase_peer_route(p, 0, lds), phase_peer_route(p, 0, lds))
    PHASE(9, phase_peer_apply7(p, 0, lds, dry), phase_peer_apply7(p, 0, lds, dry))
    PHASE(10, phase_nsa_proj(p, lds), phase_nsa_proj(p, lds))
    PHASE(11, (phase_nsa_cmp1(p, lds), phase_tab1(p)), (phase_nsa_cmp1(p, lds), phase_tab1(p)))
    PHASE(12, (phase_nsa_cmp2(p, lds), phase_pack6(p)), (phase_nsa_cmp2(p, lds), phase_pack6(p)))
    PHASE(13, phase_nsa_attn(p, lds, ATT_REP_CMP + opq, ATT_REP_WIN + opq, ATT_REP_SEL + opq), phase_nsa_attn(p, lds, 1 + opq, 1 + opq, 1 + opq))
    PHASE(14, phase_nsa_wo(p, lds, dry), phase_nsa_wo(p, lds, dry))
    PHASE(15, phase_norm_b(p, (const bf16_t*)(p.ws + WS_XB), p.in[3] + D, MOD + 2 * 6144 + 3072, MOD + 2 * 6144 + 4096, HM), phase_norm_b(p, (const bf16_t*)(p.ws + WS_XB), p.in[3] + D, MOD + 2 * 6144 + 3072, MOD + 2 * 6144 + 4096, HM))
    PHASE(16, phase_peer_route(p, 1, lds), phase_peer_route(p, 1, lds))
    PHASE(17, phase_peer_apply7(p, 1, lds, dry), phase_peer_apply7(p, 1, lds, dry))
#undef PHASE
    if (TS_SECTION >= 0 && blockIdx.x == 0 && threadIdx.x == 0) {
        const unsigned long long t0 = __builtin_amdgcn_s_memrealtime(), want = (unsigned long long)bar_st[2] * TS_MULT;
        while (__builtin_amdgcn_s_memrealtime() - t0 < want) __builtin_amdgcn_s_sleep(8);
    }
    if (TS_PHASE >= 0 && blockIdx.x == 0 && threadIdx.x == 0) {
        const unsigned long long t0 = __builtin_amdgcn_s_memrealtime(), want = (ts_b - ts_a) * TS_MULT;
        while (__builtin_amdgcn_s_memrealtime() - t0 < want) __builtin_amdgcn_s_sleep(8);
    }
}

extern "C" void kernel_launch(void* const* d_in, const int* in_sizes, int n_in, void* d_out, int out_size, void* d_ws, size_t ws_size, hipStream_t stream) {
    static int grid_blocks = 0;
    if (!grid_blocks) {
        int dev = 0, cus = 0, per_cu = 0;
        hipGetDevice(&dev);
        hipDeviceGetAttribute(&cus, hipDeviceAttributeMultiprocessorCount, dev);
        hipOccupancyMaxActiveBlocksPerMultiprocessor(&per_cu, mega, NTHREADS, 0);
        if (per_cu > 2) per_cu = 2;
        if (per_cu < 1) per_cu = 1;
        grid_blocks = cus * per_cu;
        if (ws_size < WS_END) fprintf(stderr, "kernel_launch: workspace too small: %zu < %zu\n", ws_size, (size_t)WS_END);
        if (n_in != 29) fprintf(stderr, "kernel_launch: expected 29 inputs, got %d\n", n_in);
    }
    hipMemsetAsync((unsigned char*)d_ws + WS_CTL, 0, 16384, stream);
    Params p{};
    for (int i = 0; i < 29; ++i) p.in[i] = (const float*)d_in[i];
    p.out = (float*)d_out; p.ws = (unsigned char*)d_ws;
#if SINGLE_LAUNCH
    p.ph_lo = 0; p.ph_hi = NPHASES;
    void* args[] = {&p};
    hipError_t e = hipLaunchCooperativeKernel((void*)mega, dim3(grid_blocks), dim3(NTHREADS), args, 0, stream);
    if (e != hipSuccess) fprintf(stderr, "cooperative launch failed: %s (grid %d)\n", hipGetErrorString(e), grid_blocks);
#else
    for (int ph = 0; ph < NPHASES; ++ph) {
        p.ph_lo = ph; p.ph_hi = ph + 1;
        hipLaunchKernelGGL(mega, dim3(grid_blocks), dim3(NTHREADS), 0, stream, p);
    }
#endif
}
```
